# Optimizing an MI355X kernel written in HIP

```python
import math
import jax
import jax.numpy as jnp
from jax import lax
import numpy as np

D_MODEL = 1024
BATCH = 2
SEQ = 16384
DEPTH = 2

CTX_LEN = 256
GRID_W = 64

N_BRANCH = 4
BRANCH_W = D_MODEL // N_BRANCH

MLA_HEADS = 4
MLA_NOPE = 64
MLA_ROPE = 32
MLA_V = 64
MLA_Q_LORA = 256
MLA_KV_LORA = 128
ML_HEADS = 4
ML_DH = 64
ML_CONV = 3
ML_CHUNK = 64
GLA_HEADS = 4
GLA_DK = 32
GLA_DV = 64
GLA_RANK = 16
GLA_TAU = 16.0
GLA_CHUNK = 64
DIFF_HEADS = 4
DIFF_DQK = 32
DIFF_DV = 64
ROPE_DIM = 32
ROPE_BASE = 10000.0
Q_BLOCK = 128
N_EXPERTS = 16
EC_CAPACITY = 2
EXPERT_FF = 1408

NEG_BIG = -1e30
EPS = 1e-6

MLA_COLS = (MLA_Q_LORA, MLA_KV_LORA, MLA_ROPE)
ML_COLS = (2 * ML_HEADS * ML_DH, ML_HEADS * ML_DH, ML_HEADS * ML_DH, 2 * ML_HEADS, 2 * ML_HEADS)
GLA_COLS = (GLA_HEADS * GLA_DK, GLA_HEADS * GLA_DK, GLA_HEADS * GLA_DV, GLA_HEADS * GLA_DV, 2 * GLA_RANK)
DIFF_COLS = (DIFF_HEADS * 2 * DIFF_DQK, DIFF_HEADS * 2 * DIFF_DQK, DIFF_HEADS * DIFF_DV)
MIXER_COLS = (sum(MLA_COLS), sum(ML_COLS), sum(GLA_COLS), sum(DIFF_COLS))
N_IN = sum(MIXER_COLS)

kernel_name = 'hybrid_mla_mlstm_gla_diffattn_ecmoe_block'


def _split(z, sizes):
    return jnp.split(z, np.cumsum(sizes)[:-1].tolist(), axis=-1)


def _chunk(a, size):
    return a.reshape((a.shape[0], a.shape[1] // size, size) + a.shape[2:])


def _flip(a, direction):
    return a if (a is None or direction == 0) else jnp.flip(a, axis=1)


def rms_norm(x, g):
    xf = x.astype(jnp.float32)
    y = xf * lax.rsqrt(jnp.mean(xf * xf, axis=-1, keepdims=True) + EPS)
    return (y * g.astype(jnp.float32)).astype(x.dtype)


def head_rms(x, g, n_heads):
    shp = x.shape
    xh = x.reshape(shp[:-1] + (n_heads, shp[-1] // n_heads))
    return rms_norm(xh, g.reshape(n_heads, -1)).reshape(shp)


def modulate(x, g, shift, scale):
    return rms_norm(x, g) * (1 + scale[:, None]) + shift[:, None]


def axial_rope_tables(rows):
    nf = ROPE_DIM // 4
    row = jnp.repeat(jnp.arange(rows), GRID_W)
    col = jnp.tile(jnp.arange(GRID_W), rows)
    inv_freq = ROPE_BASE ** (-jnp.arange(nf, dtype=jnp.float32) / nf)
    ang = jnp.stack([row, col], axis=-1).astype(jnp.float32)[..., None] * inv_freq
    return jnp.cos(ang), jnp.sin(ang)


def apply_rope(x, rope):
    cos, sin = rope
    nf = ROPE_DIM // 4
    shp = x.shape
    xr = x.astype(jnp.float32).reshape(shp[:-1] + (2, 2, nf))
    x1, x2 = xr[..., 0, :], xr[..., 1, :]
    bshape = cos.shape[:1] + (1,) * (x.ndim - 3) + cos.shape[1:]
    cb, sb = cos.reshape(bshape), sin.reshape(bshape)
    out = jnp.stack([x1 * cb - x2 * sb, x2 * cb + x1 * sb], axis=-2)
    return out.reshape(shp).astype(x.dtype)


def sweep_query_blocks(q, block_fn):
    b, t = q.shape[0], q.shape[1]
    qb = q.reshape((b, t // Q_BLOCK, Q_BLOCK) + q.shape[2:]).swapaxes(0, 1)
    out = lax.map(block_fn, qb).swapaxes(0, 1)
    return out.reshape((b, t) + out.shape[3:])


def mla_attention(q, k, v):
    scale = (MLA_NOPE + MLA_ROPE) ** -0.5

    def blk(qb):
        s = jnp.einsum('bqhd,bkhd->bhqk', qb, k).astype(jnp.float32) * scale
        p = jax.nn.softmax(s, axis=-1).astype(v.dtype)
        return jnp.einsum('bhqk,bkhd->bqhd', p, v)

    return sweep_query_blocks(q, blk)


def diff_attention(q, k, v, lam):
    scale = DIFF_DQK ** -0.5

    def blk(qb):
        s = jnp.einsum('bqhmd,bkhmd->bhmqk', qb, k).astype(jnp.float32) * scale
        p = jax.nn.softmax(s, axis=-1)
        a = (p[:, :, 0] - lam * p[:, :, 1]).astype(v.dtype)
        return jnp.einsum('bhqk,bkhd->bqhd', a, v)

    return sweep_query_blocks(q, blk)


def short_conv(x, w, b):
    pad = ML_CONV // 2
    t = x.shape[1]
    xp = jnp.pad(x, ((0, 0), (pad, pad), (0, 0)))
    return sum(xp[:, j:j + t] * w[j] for j in range(ML_CONV)) + b


def mlstm_dir(q, k, v, ig, lf, init, want_out):
    kc, vc, igc, lfc = (_chunk(a, ML_CHUNK) for a in (k, v, ig, lf))
    bcum = jnp.cumsum(lfc, axis=2)
    b_end = bcum[:, :, -1]
    w_log = b_end[:, :, None] - bcum + igc
    m_loc = jnp.max(w_log, axis=2)
    w = jnp.exp(w_log - m_loc[:, :, None])
    c_loc = jnp.einsum('bclh,bclhv,bclhk->bchvk', w, vc, kc)
    n_loc = jnp.einsum('bclh,bclhk->bchk', w, kc)

    def step(carry, inp):
        c_st, n_st, m_st = carry
        be, ml, cl, nl = inp
        m_new = jnp.maximum(be + m_st, ml)
        a = jnp.exp(be + m_st - m_new)
        g = jnp.exp(ml - m_new)
        c_new = a[..., None, None] * c_st + g[..., None, None] * cl
        n_new = a[..., None] * n_st + g[..., None] * nl
        return (c_new, n_new, m_new), (c_st, n_st, m_st)

    xs = tuple(jnp.moveaxis(a, 1, 0) for a in (b_end, m_loc, c_loc, n_loc))
    final, starts = lax.scan(step, init, xs)
    if not want_out:
        return None, final
    c0, n0, m0 = (jnp.moveaxis(a, 0, 1) for a in starts)
    qc = _chunk(q, ML_CHUNK)
    causal = jnp.tril(jnp.ones((ML_CHUNK, ML_CHUNK), dtype=bool))
    bt = jnp.swapaxes(bcum, 2, 3)
    it = jnp.swapaxes(igc, 2, 3)
    d_log = jnp.where(causal, bt[..., :, None] - bt[..., None, :] + it[..., None, :], -jnp.inf)
    inter = bt + m0[..., None]
    m_t = jnp.maximum(inter, jnp.max(d_log, axis=-1))
    s = jnp.exp(d_log - m_t[..., None]) * jnp.einsum('bclhd,bcshd->bchls', qc, kc)
    a_int = jnp.exp(inter - m_t)
    num = jnp.einsum('bchls,bcshv->bclhv', s, vc) + jnp.einsum('bchl,bclhk,bchvk->bclhv', a_int, qc, c0)
    den = jnp.sum(s, axis=-1) + a_int * jnp.einsum('bclhk,bchk->bchl', qc, n0)
    h = num / jnp.swapaxes(jnp.maximum(jnp.abs(den), jnp.exp(-m_t)), 2, 3)[..., None]
    return h.reshape(v.shape), final


def gla_dir(q, k, v, lg, init, want_out):
    kc, vc, gc = (_chunk(a, GLA_CHUNK) for a in (k, v, lg))
    gcum = jnp.cumsum(gc, axis=2)
    g_end = gcum[:, :, -1]
    s_loc = jnp.einsum('bclhk,bclhv->bchkv', kc * jnp.exp(g_end[:, :, None] - gcum), vc)

    def step(s_st, inp):
        ge, sl = inp
        return jnp.exp(ge)[..., None] * s_st + sl, s_st

    final, starts = lax.scan(step, init, (jnp.moveaxis(g_end, 1, 0), jnp.moveaxis(s_loc, 1, 0)))
    if not want_out:
        return None, final
    s0 = jnp.moveaxis(starts, 0, 1)
    causal = jnp.tril(jnp.ones((GLA_CHUNK, GLA_CHUNK), dtype=bool))
    q_dec = _chunk(q, GLA_CHUNK) * jnp.exp(gcum)
    att = jnp.einsum('bclhk,bcshk->bchls', q_dec, kc * jnp.exp(-gcum))
    att = jnp.where(causal, att, 0.0)
    o = jnp.einsum('bchls,bcshv->bclhv', att, vc) + jnp.einsum('bclhk,bchkv->bclhv', q_dec, s0)
    return o.reshape(v.shape), final


def run_bidirectional(dir_fn, ctx_inputs, lat_inputs, init, need_ctx):
    out_c, out_l = None, None
    for d in range(2):
        h_c, fin_c = dir_fn(*[_flip(a, d) for a in ctx_inputs[d]], init, need_ctx)
        h_l, _ = dir_fn(*[_flip(a, d) for a in lat_inputs[d]], fin_c, True)
        h_l = _flip(h_l, d)
        out_l = h_l if out_l is None else out_l + h_l
        if need_ctx:
            h_c = _flip(h_c, d)
            out_c = h_c if out_c is None else out_c + h_c
    return out_c, out_l


def mla_branch(zc, zl, rope, g_q_lat, w_uq, g_kv_lat, w_ukv, need_ctx):
    def queries(z, rot):
        q_lat = _split(z, MLA_COLS)[0]
        q = (rms_norm(q_lat, g_q_lat) @ w_uq).reshape(z.shape[:2] + (MLA_HEADS, MLA_NOPE + MLA_ROPE))
        q_nope, q_rope = q[..., :MLA_NOPE], q[..., MLA_NOPE:]
        if rot is not None:
            q_rope = apply_rope(q_rope, rot)
        return jnp.concatenate([q_nope, q_rope], axis=-1)

    def keys_values(z, rot):
        _, kv_lat, k_rope = _split(z, MLA_COLS)
        kv = (rms_norm(kv_lat, g_kv_lat) @ w_ukv).reshape(z.shape[:2] + (MLA_HEADS, MLA_NOPE + MLA_V))
        k_nope, v = kv[..., :MLA_NOPE], kv[..., MLA_NOPE:]
        k_rope = k_rope[:, :, None, :]
        if rot is not None:
            k_rope = apply_rope(k_rope, rot)
        k = jnp.concatenate([k_nope, jnp.broadcast_to(k_rope, k_nope.shape[:-1] + (MLA_ROPE,))], axis=-1)
        return k, v

    def flat(y):
        return y.reshape(y.shape[:2] + (MLA_HEADS * MLA_V,))

    k_c, v_c = keys_values(zc, None)
    k_l, v_l = keys_values(zl, rope)
    y_l = mla_attention(queries(zl, rope), jnp.concatenate([k_c, k_l], axis=1), jnp.concatenate([v_c, v_l], axis=1))
    y_c = flat(mla_attention(queries(zc, None), k_c, v_c)) if need_ctx else None
    return y_c, flat(y_l)


def mlstm_branch(zc, zl, w_conv, b_conv, b_igate, b_fgate, g_out, need_ctx):
    def prep(z):
        bsz, t = z.shape[:2]
        hd = (bsz, t, ML_HEADS, ML_DH)
        qk, v, o, ig, fg = _split(z, ML_COLS)
        qk = jax.nn.silu(short_conv(qk, w_conv, b_conv)).astype(jnp.float32)
        q = qk[..., :ML_HEADS * ML_DH].reshape(hd)
        k = qk[..., ML_HEADS * ML_DH:].reshape(hd) * ML_DH ** -0.5
        v = v.astype(jnp.float32).reshape(hd)
        ig = ig.astype(jnp.float32).reshape(bsz, t, 2, ML_HEADS) + b_igate
        lf = jax.nn.log_sigmoid(fg.astype(jnp.float32).reshape(bsz, t, 2, ML_HEADS) + b_fgate)
        return q, k, v, o, ig, lf

    q_c, k_c, v_c, o_c, ig_c, lf_c = prep(zc)
    q_l, k_l, v_l, o_l, ig_l, lf_l = prep(zl)
    bsz = zl.shape[0]
    init = (jnp.zeros((bsz, ML_HEADS, ML_DH, ML_DH), jnp.float32),
            jnp.zeros((bsz, ML_HEADS, ML_DH), jnp.float32),
            jnp.full((bsz, ML_HEADS), NEG_BIG, jnp.float32))
    ctx_in = [(q_c if need_ctx else None, k_c, v_c, ig_c[:, :, d], lf_c[:, :, d]) for d in range(2)]
    lat_in = [(q_l, k_l, v_l, ig_l[:, :, d], lf_l[:, :, d]) for d in range(2)]
    h_c, h_l = run_bidirectional(mlstm_dir, ctx_in, lat_in, init, need_ctx)

    def finish(h, o):
        return jax.nn.sigmoid(o) * head_rms(h.reshape(o.shape).astype(o.dtype), g_out, ML_HEADS)

    return (finish(h_c, o_c) if need_ctx else None), finish(h_l, o_l)


def gla_branch(zc, zl, w_alpha2, b_alpha, g_out, need_ctx):
    def prep(z):
        bsz, t = z.shape[:2]
        q, k, v, r, a = _split(z, GLA_COLS)
        q = q.astype(jnp.float32).reshape(bsz, t, GLA_HEADS, GLA_DK) * GLA_DK ** -0.5
        k = k.astype(jnp.float32).reshape(bsz, t, GLA_HEADS, GLA_DK)
        v = v.astype(jnp.float32).reshape(bsz, t, GLA_HEADS, GLA_DV)
        zg = jnp.einsum('btnr,nrk->btnk', a.reshape(bsz, t, 2, GLA_RANK), w_alpha2) + b_alpha
        lg = (jax.nn.log_sigmoid(zg.astype(jnp.float32)) / GLA_TAU).reshape(bsz, t, 2, GLA_HEADS, GLA_DK)
        return q, k, v, r, lg

    q_c, k_c, v_c, r_c, lg_c = prep(zc)
    q_l, k_l, v_l, r_l, lg_l = prep(zl)
    init = jnp.zeros((zl.shape[0], GLA_HEADS, GLA_DK, GLA_DV), jnp.float32)
    ctx_in = [(q_c if need_ctx else None, k_c, v_c, lg_c[:, :, d]) for d in range(2)]
    lat_in = [(q_l, k_l, v_l, lg_l[:, :, d]) for d in range(2)]
    o_c, o_l = run_bidirectional(gla_dir, ctx_in, lat_in, init, need_ctx)

    def finish(o, r):
        return jax.nn.silu(r) * head_rms(o.reshape(r.shape).astype(r.dtype), g_out, GLA_HEADS)

    return (finish(o_c, r_c) if need_ctx else None), finish(o_l, r_l)


def diff_branch(zc, zl, rope, diff_lambda, g_out, lam_init, need_ctx):
    lv = diff_lambda.astype(jnp.float32)
    lam = jnp.exp(jnp.sum(lv[0] * lv[1])) - jnp.exp(jnp.sum(lv[2] * lv[3])) + lam_init

    def qkv(z, rot):
        bsz, t = z.shape[:2]
        q, k, v = _split(z, DIFF_COLS)
        qk_shape = (bsz, t, DIFF_HEADS, 2, DIFF_DQK)
        q, k = q.reshape(qk_shape), k.reshape(qk_shape)
        if rot is not None:
            q, k = apply_rope(q, rot), apply_rope(k, rot)
        return q, k, v.reshape(bsz, t, DIFF_HEADS, DIFF_DV)

    def finish(o):
        o = o.reshape(o.shape[:2] + (DIFF_HEADS * DIFF_DV,))
        return head_rms(o, g_out, DIFF_HEADS) * (1.0 - lam_init)

    q_c, k_c, v_c = qkv(zc, None)
    q_l, k_l, v_l = qkv(zl, rope)
    y_l = finish(diff_attention(q_l, jnp.concatenate([k_c, k_l], axis=1), jnp.concatenate([v_c, v_l], axis=1), lam))
    y_c = finish(diff_attention(q_c, k_c, v_c, lam)) if need_ctx else None
    return y_c, y_l


def merge_branches(h, ys, w_branch, w_gate, b_gate, w_out):
    y = jnp.stack(ys, axis=2)
    p = jnp.einsum('btnc,ncd->btnd', y, w_branch)
    g = jax.nn.sigmoid(h @ w_gate + b_gate).reshape(p.shape)
    return jnp.sum(g * p, axis=2) @ w_out


def ec_moe(h, w_router, w_e_gate, w_e_up, w_e_down):
    b, t, d = h.shape
    cap = EC_CAPACITY * t // N_EXPERTS
    aff = jax.nn.softmax((h @ w_router).astype(jnp.float32), axis=-1)
    vals, idx = lax.top_k(jnp.swapaxes(aff, 1, 2), cap)
    xs = jax.vmap(lambda hb, ib: hb[ib])(h, idx)
    hid = jax.nn.silu(jnp.einsum('becd,edf->becf', xs, w_e_gate)) * jnp.einsum('becd,edf->becf', xs, w_e_up)
    ys = jnp.einsum('becf,efd->becd', hid, w_e_down) * vals[..., None].astype(h.dtype)
    return jax.vmap(lambda yb, ib: jnp.zeros((t, d), yb.dtype).at[ib.reshape(-1)].add(yb.reshape(-1, d)))(ys, idx)


def hybrid_layer(x_c, x_l, silu_c, silu_cc, rope, layer_idx, need_ctx,
                 w_ada, b_ada, g_mix_pre, g_mix_post, g_ffn_pre, g_ffn_post, w_in,
                 g_q_lat, w_uq, g_kv_lat, w_ukv,
                 w_conv, b_conv, b_igate, b_fgate, g_mlstm_out,
                 w_alpha2, b_alpha, g_gla_out,
                 diff_lambda, g_diff_out,
                 w_branch, w_gate, b_gate, w_out,
                 w_router, w_e_gate, w_e_up, w_e_down):
    lam_init = 0.8 - 0.6 * math.exp(-0.3 * layer_idx)
    mod_l = jnp.split(silu_c @ w_ada + b_ada, 6, axis=-1)
    mod_c = jnp.split(silu_cc @ w_ada + b_ada, 6, axis=-1)

    h_l = modulate(x_l, g_mix_pre, mod_l[0], mod_l[1])
    h_c = modulate(x_c, g_mix_pre, mod_c[0], mod_c[1])
    z_l = _split(h_l @ w_in, MIXER_COLS)
    z_c = _split(h_c @ w_in, MIXER_COLS)
    a_c, a_l = mla_branch(z_c[0], z_l[0], rope, g_q_lat, w_uq, g_kv_lat, w_ukv, need_ctx)
    b_c, b_l = mlstm_branch(z_c[1], z_l[1], w_conv, b_conv, b_igate, b_fgate, g_mlstm_out, need_ctx)
    c_c, c_l = gla_branch(z_c[2], z_l[2], w_alpha2, b_alpha, g_gla_out, need_ctx)
    d_c, d_l = diff_branch(z_c[3], z_l[3], rope, diff_lambda, g_diff_out, lam_init, need_ctx)
    y_l = merge_branches(h_l, (a_l, b_l, c_l, d_l), w_branch, w_gate, b_gate, w_out)
    x_l = x_l + mod_l[2][:, None] * rms_norm(y_l, g_mix_post)

    f_l = ec_moe(modulate(x_l, g_ffn_pre, mod_l[3], mod_l[4]), w_router, w_e_gate, w_e_up, w_e_down)
    x_l = x_l + mod_l[5][:, None] * rms_norm(f_l, g_ffn_post)

    if need_ctx:
        y_c = merge_branches(h_c, (a_c, b_c, c_c, d_c), w_branch, w_gate, b_gate, w_out)
        x_c = x_c + mod_c[2][:, None] * rms_norm(y_c, g_mix_post)
        f_c = ec_moe(modulate(x_c, g_ffn_pre, mod_c[3], mod_c[4]), w_router, w_e_gate, w_e_up, w_e_down)
        x_c = x_c + mod_c[5][:, None] * rms_norm(f_c, g_ffn_post)
    return x_c, x_l


def setup_inputs(seed: int = 0) -> dict:
    key = jax.random.key(seed)
    ks = iter(jax.random.split(key, 40))
    L, D = DEPTH, D_MODEL

    def nrm(shape, scale):
        return jax.random.normal(next(ks), shape, jnp.float32) * scale

    def gain(shape):
        return 1.0 + nrm(shape, 0.02)

    return {
        'x': nrm((BATCH, SEQ, D), 1.0),
        'c': nrm((BATCH, D), 1.0),
        'ctx': nrm((BATCH, CTX_LEN, D), 1.0),
        'c_ctx': nrm((D,), 1.0),
        'w_ada': nrm((L, D, 6 * D), 0.5 * D ** -0.5),
        'b_ada': nrm((L, 6 * D), 0.01),
        'g_mix_pre': gain((L, D)),
        'g_mix_post': gain((L, D)),
        'g_ffn_pre': gain((L, D)),
        'g_ffn_post': gain((L, D)),
        'w_in': nrm((L, D, N_IN), D ** -0.5),
        'g_q_lat': gain((L, MLA_Q_LORA)),
        'w_uq': nrm((L, MLA_Q_LORA, MLA_HEADS * (MLA_NOPE + MLA_ROPE)), MLA_Q_LORA ** -0.5),
        'g_kv_lat': gain((L, MLA_KV_LORA)),
        'w_ukv': nrm((L, MLA_KV_LORA, MLA_HEADS * (MLA_NOPE + MLA_V)), MLA_KV_LORA ** -0.5),
        'w_conv': nrm((L, ML_CONV, 2 * ML_HEADS * ML_DH), ML_CONV ** -0.5),
        'b_conv': nrm((L, 2 * ML_HEADS * ML_DH), 0.01),
        'b_igate': nrm((L, 2, ML_HEADS), 0.1),
        'b_fgate': jnp.linspace(3.0, 6.0, ML_HEADS)[None, None] + nrm((L, 2, ML_HEADS), 0.1),
        'g_mlstm_out': gain((L, ML_HEADS * ML_DH)),
        'w_alpha2': nrm((L, 2, GLA_RANK, GLA_HEADS * GLA_DK), GLA_RANK ** -0.5),
        'b_alpha': nrm((L, 2, GLA_HEADS * GLA_DK), 0.01),
        'g_gla_out': gain((L, GLA_HEADS * GLA_DV)),
        'diff_lambda': nrm((L, 4, DIFF_DQK), 0.1),
        'g_diff_out': gain((L, DIFF_HEADS * DIFF_DV)),
        'w_branch': nrm((L, N_BRANCH, BRANCH_W, D), BRANCH_W ** -0.5),
        'w_gate': nrm((L, D, N_BRANCH * D), D ** -0.5),
        'b_gate': nrm((L, N_BRANCH * D), 0.01),
        'w_out': nrm((L, D, D), D ** -0.5),
        'w_router': nrm((L, D, N_EXPERTS), D ** -0.5),
        'w_e_gate': nrm((L, N_EXPERTS, D, EXPERT_FF), D ** -0.5),
        'w_e_up': nrm((L, N_EXPERTS, D, EXPERT_FF), D ** -0.5),
        'w_e_down': nrm((L, N_EXPERTS, EXPERT_FF, D), EXPERT_FF ** -0.5),
    }


def reference(x, c, ctx, c_ctx, w_ada, b_ada, g_mix_pre, g_mix_post, g_ffn_pre, g_ffn_post, w_in,
              g_q_lat, w_uq, g_kv_lat, w_ukv, w_conv, b_conv, b_igate, b_fgate, g_mlstm_out,
              w_alpha2, b_alpha, g_gla_out, diff_lambda, g_diff_out,
              w_branch, w_gate, b_gate, w_out, w_router, w_e_gate, w_e_up, w_e_down):
    rows = x.shape[1] // GRID_W
    rope = axial_rope_tables(rows)
    silu_c = jax.nn.silu(c)
    silu_cc = jax.nn.silu(c_ctx)[None]
    x_c, x_l = ctx, x
    for i in range(DEPTH):
        x_c, x_l = hybrid_layer(
            x_c, x_l, silu_c, silu_cc, rope, i, i < DEPTH - 1,
            w_ada[i], b_ada[i], g_mix_pre[i], g_mix_post[i], g_ffn_pre[i], g_ffn_post[i], w_in[i],
            g_q_lat[i], w_uq[i], g_kv_lat[i], w_ukv[i],
            w_conv[i], b_conv[i], b_igate[i], b_fgate[i], g_mlstm_out[i],
            w_alpha2[i], b_alpha[i], g_gla_out[i],
            diff_lambda[i], g_diff_out[i],
            w_branch[i], w_gate[i], b_gate[i], w_out[i],
            w_router[i], w_e_gate[i], w_e_up[i], w_e_down[i])
    return x_l
```

```cpp
#ifndef CPU_EMU
#include <hip/hip_runtime.h>
#endif
#include <stdint.h>
#include <stddef.h>

#ifndef T_LAT
#define T_LAT 16384
#endif
#ifndef T_CTX
#define T_CTX 256
#endif

#ifndef MK_MULTI
#define MK_MULTI 0
#endif
#define DI __device__ __forceinline__
typedef unsigned short bf16_t;
typedef short bf16x8 __attribute__((ext_vector_type(8)));
typedef short s16x4 __attribute__((ext_vector_type(4)));
typedef float f32x4 __attribute__((ext_vector_type(4)));
typedef float f32x16 __attribute__((ext_vector_type(16)));
typedef unsigned u32x4 __attribute__((ext_vector_type(4)));
typedef unsigned u32x2 __attribute__((ext_vector_type(2)));
typedef float f32x2 __attribute__((ext_vector_type(2)));

#ifdef CPU_EMU
static inline float u2f(unsigned u) { float f; memcpy(&f, &u, 4); return f; }
static inline unsigned f2u(float f) { unsigned u; memcpy(&u, &f, 4); return u; }
#define MFMA32(a, b, c) emu_mfma_32x32x16((a), (b), (c))
#define MFMA16(a, b, c) emu_mfma_16x16x32((a), (b), (c))
static inline float fast_exp2(float x) { return exp2f(x); }
static inline float fast_rcp(float x) { return 1.0f / x; }
static inline float fast_rsq(float x) { return 1.0f / sqrtf(x); }
static inline float hw_sin_rev(float x) { return sinf(6.283185307179586f * x); }
static inline float hw_cos_rev(float x) { return cosf(6.283185307179586f * x); }
#define LAUNCH(kern, grid, block, lds, stream, ...) emu::launch(dim3(grid), dim3(block), (size_t)(lds), [=]() { kern(__VA_ARGS__); })
#define DYN_LDS(name) char* name = emu_dynlds()
#define SCHED_BARRIER()
#define TIDX ((int)threadIdx.x)
#define WAVE_SYNC() emu::wave_barrier()
template <int M> static inline float xor_sum(float v) { return v + __shfl_xor(v, M); }
template <int M> static inline float xor_max(float v) { return fmaxf(v, __shfl_xor(v, M)); }
template <int M> static inline int xor_sum_i(int v) { return v + __shfl_xor(v, M); }
static inline int lane_bcast(int v, int src) { return __shfl(v, src); }
static inline int lane_up(int v, int d, int lane) { (void)lane; return __shfl_up(v, d); }
#else
DI float u2f(unsigned u) { return __uint_as_float(u); }
DI unsigned f2u(float f) { return __float_as_uint(f); }
#define MFMA32(a, b, c) __builtin_amdgcn_mfma_f32_32x32x16_bf16((a), (b), (c), 0, 0, 0)
#define MFMA16(a, b, c) __builtin_amdgcn_mfma_f32_16x16x32_bf16((a), (b), (c), 0, 0, 0)
DI float fast_exp2(float x) { return __builtin_amdgcn_exp2f(x); }
DI float fast_rcp(float x) { return __builtin_amdgcn_rcpf(x); }
DI float fast_rsq(float x) { return __builtin_amdgcn_rsqf(x); }
DI float hw_sin_rev(float x) { return __builtin_amdgcn_sinf(x); }
DI float hw_cos_rev(float x) { return __builtin_amdgcn_cosf(x); }
#define LAUNCH(kern, grid, block, lds, stream, ...) kern<<<dim3(grid), dim3(block), (lds), (stream)>>>(__VA_ARGS__)
#define DYN_LDS(name) extern __shared__ __attribute__((aligned(16))) char name[]
#define SCHED_BARRIER() __builtin_amdgcn_sched_barrier(0)
DI int tid_fresh() { int t = (int)threadIdx.x; asm volatile("" : "+v"(t)); return t; }
#define TIDX tid_fresh()
#define WAVE_SYNC() __builtin_amdgcn_wave_barrier()
#ifdef USE_SHFL
template <int M> DI float xor_sum(float v) { return v + __shfl_xor(v, M); }
template <int M> DI float xor_max(float v) { return fmaxf(v, __shfl_xor(v, M)); }
template <int M> DI int xor_sum_i(int v) { return v + __shfl_xor(v, M); }
DI int lane_bcast(int v, int src) { return __shfl(v, src); }
DI int lane_up(int v, int d, int lane) { (void)lane; return __shfl_up(v, d); }
#else
template <int M> DI int xor_partner_bits(int bits) { return __builtin_amdgcn_ds_swizzle(bits, (M << 10) | 0x1f); }
DI void half_swap(unsigned& a, unsigned& b) { asm volatile("s_nop 1\n\tv_permlane32_swap_b32 %0, %1\n\ts_nop 1" : "+v"(a), "+v"(b)); }
template <int M> DI float xor_sum(float v) {
  if constexpr (M < 32) return v + __builtin_bit_cast(float, xor_partner_bits<M>(__builtin_bit_cast(int, v)));
  else { unsigned a = __builtin_bit_cast(unsigned, v), b = a; half_swap(a, b); return __builtin_bit_cast(float, a) + __builtin_bit_cast(float, b); }
}
template <int M> DI float xor_max(float v) {
  if constexpr (M < 32) return fmaxf(v, __builtin_bit_cast(float, xor_partner_bits<M>(__builtin_bit_cast(int, v))));
  else { unsigned a = __builtin_bit_cast(unsigned, v), b = a; half_swap(a, b); return fmaxf(__builtin_bit_cast(float, a), __builtin_bit_cast(float, b)); }
}
template <int M> DI int xor_sum_i(int v) {
  if constexpr (M < 32) return v + xor_partner_bits<M>(v);
  else { unsigned a = (unsigned)v, b = a; half_swap(a, b); return (int)(a + b); }
}
DI int lane_bcast(int v, int src) { return __builtin_amdgcn_readlane(v, src); }
DI int lane_up(int v, int d, int lane) { return __builtin_amdgcn_ds_bpermute(((lane - d) & 63) << 2, v); }
#endif
#endif

DI float bf2f(bf16_t v) { return u2f(((unsigned)v) << 16); }
#ifdef CPU_EMU
DI bf16_t f2bf(float f) { unsigned u = f2u(f); u += 0x7fffu + ((u >> 16) & 1u); return (bf16_t)(u >> 16); }
DI unsigned pack2bf(float lo, float hi) { return (unsigned)f2bf(lo) | ((unsigned)f2bf(hi) << 16); }
static inline bool wave_any(bool pr) { int v = pr ? 1 : 0; v |= __shfl_xor(v, 1); v |= __shfl_xor(v, 2); v |= __shfl_xor(v, 4); v |= __shfl_xor(v, 8); v |= __shfl_xor(v, 16); v |= __shfl_xor(v, 32); return v != 0; }
#else
typedef float f32x2_ __attribute__((ext_vector_type(2)));
typedef __bf16 bf16x2_hw __attribute__((ext_vector_type(2)));
DI unsigned pack2bf(float lo, float hi) { const f32x2_ v = {lo, hi}; return __builtin_bit_cast(unsigned, __builtin_convertvector(v, bf16x2_hw)); }
DI bf16_t f2bf(float f) { return (bf16_t)(pack2bf(f, f) & 0xffffu); }
DI bool wave_any(bool pr) { return __builtin_amdgcn_ballot_w64(pr) != 0ull; }
#endif
DI float sigmoidf_(float x) { return 1.0f / (1.0f + expf(-x)); }
DI float siluf_(float x) { return x / (1.0f + expf(-x)); }
DI float logsigmoidf_(float x) { return fminf(x, 0.0f) - log1pf(expf(-fabsf(x))); }

constexpr int D = 1024, NB = 2, TL = T_LAT, TC = T_CTX, TK = TL + TC;
constexpr int RL = NB * TL, RC = NB * TC, R = RL + RC;
constexpr int NZ = 3024, NZP = 3072;
constexpr int ZC_QLAT = 0, ZC_KVLAT = 256, ZC_KROPE = 384, ZC_MLQK = 416, ZC_MLV = 928, ZC_MLO = 1184, ZC_MLIG = 1440,
              ZC_MLFG = 1448, ZC_GQ = 1456, ZC_GK = 1584, ZC_GV = 1712, ZC_GR = 1968, ZC_GA = 2224, ZC_DQ = 2256,
              ZC_DK = 2512, ZC_DV = 2768;
constexpr int NCK = TK / 64, NCC = TC / 64, NCL = TL / 64;
constexpr int NE = 16, FF = 1408, CAPL = 2 * TL / 16, CAPC = 2 * TC / 16, CAPT = CAPL + CAPC, NSLOT = NB * CAPT;
constexpr size_t WSZ_IN = (size_t)NZP * D, WSZ_UQ = 384 * 256, WSZ_UKV = 512 * 128, WSZ_GATE = (size_t)4096 * D, WSZ_BR = (size_t)4 * D * 256, WSZ_OUT = (size_t)D * D;
constexpr int NUNIT = NB * 2 * NCK * 4;
constexpr float LOG2E = 1.4426950408889634f;
constexpr float QS_MLA = 0.10206207261596577f * LOG2E;
constexpr float QS_DIFF = 0.17677669529663687f * LOG2E;

DI int row_of(int b, int s) { return s < TC ? RL + b * TC + s : b * TL + (s - TC); }
DI void bs_of(int r, int& b, int& s) { if (r < RL) { b = r / TL; s = TC + (r % TL); } else { int q = r - RL; b = q / TC; s = q % TC; } }
DI int seq_of(int d, int p) { return d == 0 ? p : (p < TC ? TC - 1 - p : TK - 1 - (p - TC)); }
DI int step_of(int d, int c) { return d == 0 ? c : (c < NCC ? NCC - 1 - c : NCC + (NCK - 1 - c)); }

struct Params {
  const float *x, *c, *ctx, *c_ctx, *w_ada, *b_ada, *g_mix_pre, *g_mix_post, *g_ffn_pre, *g_ffn_post, *w_in, *g_q_lat, *w_uq,
      *g_kv_lat, *w_ukv, *w_conv, *b_conv, *b_igate, *b_fgate, *g_mlstm_out, *w_alpha2, *b_alpha, *g_gla_out, *diff_lambda,
      *g_diff_out, *w_branch, *w_gate, *b_gate, *w_out, *w_router, *w_e_gate, *w_e_up, *w_e_down;
  float* out;
  float *mods, *xc;
  bf16_t *H, *Z, *Qm, *Km, *Vtm, *Qd, *Kd, *Vtd, *MQ, *MK, *Y, *MG, *YO, *HID, *YE, *MVt, *GVt;
  float *BC, *IGS, *GC, *MC, *MN, *MM, *GS, *HD, *OD, *AFF, *SELV;
  int *SEL, *INV;
  bf16_t *Wt_in, *Wt_uq, *Wt_ukv, *Wt_gate, *Wt_branch, *Wt_out, *Wt_eg, *Wt_eu, *Wt_ed;
  unsigned* bar;
  size_t ws_need;
};

static inline size_t al256(size_t x) { return (x + 255) & ~(size_t)255; }
static inline void map_workspace(Params& p, char* ws) {
  size_t o = 0;
  auto take = [&](size_t bytes) { size_t r = o; o += al256(bytes); return ws + r; };
  p.bar = (unsigned*)take(16384);
  p.mods = (float*)take((size_t)2 * 3 * 6144 * 4);
  p.xc = (float*)take((size_t)RC * D * 4);
  p.BC = (float*)take((size_t)NB * 2 * TK * 4 * 4);
  p.IGS = (float*)take((size_t)NB * 2 * TK * 4 * 4);
  p.AFF = (float*)take((size_t)NB * NE * TK * 4);
  p.SEL = (int*)take((size_t)NE * NSLOT * 4);
  p.SELV = (float*)take((size_t)NE * NSLOT * 4);
  p.INV = (int*)take((size_t)R * NE * 4);
  p.MM = (float*)take((size_t)NUNIT * 4 * 4);
  p.MN = (float*)take((size_t)NUNIT * 64 * 4);
  p.Wt_in = (bf16_t*)take((size_t)2 * WSZ_IN * 2);
  p.Wt_uq = (bf16_t*)take((size_t)2 * WSZ_UQ * 2);
  p.Wt_ukv = (bf16_t*)take((size_t)2 * WSZ_UKV * 2);
  p.Wt_gate = (bf16_t*)take((size_t)2 * WSZ_GATE * 2);
  p.Wt_branch = (bf16_t*)take((size_t)2 * WSZ_BR * 2);
  p.Wt_out = (bf16_t*)take((size_t)2 * WSZ_OUT * 2);
  p.H = (bf16_t*)take((size_t)R * D * 2);
  size_t szA = (size_t)R * NZP * 2, szHID = (size_t)NE * NSLOT * FF * 2;
  char* A = take(szA > szHID ? szA : szHID);
  p.Z = (bf16_t*)A; p.HID = (bf16_t*)A;
  size_t szQm = al256((size_t)NB * 4 * TK * 96 * 2), szVt = al256((size_t)NB * 4 * 64 * TK * 2), szQd = al256((size_t)NB * 8 * TK * 32 * 2);
  size_t szB1 = 2 * szQm + 2 * szVt + 2 * szQd;
  size_t szHD = al256((size_t)2 * NB * TK * 256 * 4);
  size_t szYE = (size_t)NE * NSLOT * D * 2;
  size_t szB = szB1; if (2 * szHD > szB) szB = 2 * szHD; if (szYE > szB) szB = szYE;
  char* Bq = take(szB);
  p.Qm = (bf16_t*)Bq; p.Km = (bf16_t*)(Bq + szQm); p.Vtm = (bf16_t*)(Bq + 2 * szQm);
  p.Qd = (bf16_t*)(Bq + 2 * szQm + szVt); p.Kd = (bf16_t*)(Bq + 2 * szQm + szVt + szQd); p.Vtd = (bf16_t*)(Bq + 2 * szQm + szVt + 2 * szQd);
  p.YE = (bf16_t*)Bq;
  p.GC = (float*)take((size_t)NB * 2 * TK * 128 * 4);
  p.MVt = (bf16_t*)take((size_t)NB * 4 * 64 * TK * 2);
  p.GVt = (bf16_t*)take((size_t)NB * 4 * 64 * TK * 2);
  size_t szW = (size_t)NE * FF * D * 2;
  size_t szMC = (size_t)NUNIT * 4096 * 4, szRD = (size_t)R * D * 2;
  size_t szC = szMC; if (szRD > szC) szC = szRD; if (szW > szC) szC = szW;
  char* C = take(szC);
  p.MC = (float*)C; p.MG = (bf16_t*)C; p.Wt_eg = (bf16_t*)C;
  size_t szMQ = al256((size_t)NB * TK * 256 * 2), szGS = (size_t)NUNIT * 2048 * 4;
  size_t szD = 2 * szMQ + szGS; if (szW > szD) szD = szW;
  char* Dq = take(szD);
  p.MQ = (bf16_t*)Dq; p.MK = (bf16_t*)(Dq + szMQ); p.GS = (float*)(Dq + 2 * szMQ); p.Wt_eu = (bf16_t*)Dq;
  size_t szF = 2 * szRD > szW ? 2 * szRD : szW;
  char* F = take(szF);
  p.Y = (bf16_t*)F; p.YO = (bf16_t*)(F + szRD); p.Wt_ed = (bf16_t*)F;
  p.HD = (float*)Bq; p.OD = (float*)(Bq + szHD);
  p.ws_need = o;
}
#define GTID ((long)blockIdx.x * blockDim.x + threadIdx.x)

DI float lam_of(const Params& p, int layer, float& lam_init) {
  const float* lv = p.diff_lambda + layer * 128;
  float s1 = 0.f, s2 = 0.f;
  for (int i = 0; i < 32; ++i) { s1 += lv[i] * lv[32 + i]; s2 += lv[64 + i] * lv[96 + i]; }
  lam_init = layer == 0 ? 0.2f : 0.35550906759096f;
  return expf(s1) - expf(s2) + lam_init;
}
DI void rope_cs(int s, int jj, float& cs, float& sn) {
  int t = s - TC;
  int pos = (jj < 16) ? (t / 64) : (t % 64);
  float ang = (float)pos * exp2f(-1.6609640474436813f * (float)(jj & 7));
  double rev = (double)ang * 0.15915494309189535;
  rev -= floor(rev + 0.5);
  float rf = (float)rev;
  cs = hw_cos_rev(rf); sn = hw_sin_rev(rf);
}
template <class G> DI float rope_elem(G get, int s, int jj) {
  if (s < TC) return get(jj);
  float cs, sn; rope_cs(s, jj, cs, sn);
  float a = get(jj), b = get(jj ^ 8);
  return (jj & 8) ? (a * cs + b * sn) : (a * cs - b * sn);
}

DI void nvb_mods(long GI, const Params& p) {
  long i = GI; if (i >= 2 * 3 * 6144) return;
  int col = (int)(i % 6144), w = (int)((i / 6144) % 3), l = (int)(i / (3 * 6144));
  const float* cv = w < 2 ? p.c + w * 1024 : p.c_ctx;
  const float* W = p.w_ada + (size_t)l * 1024 * 6144;
  float acc = 0.f;
  for (int k = 0; k < 1024; ++k) acc += siluf_(cv[k]) * W[(size_t)k * 6144 + col];
  p.mods[i] = acc + p.b_ada[l * 6144 + col];
}
__global__ void __launch_bounds__(256) nv_wt(const float* in, bf16_t* out, int K, int N, int NP, long in_bs, long out_bs, const float* gain) {
  long i = GTID; if (i >= (long)NP * K) return;
  int k = (int)(i % K), n = (int)(i / K);
  const float* I = in + (size_t)blockIdx.y * in_bs; bf16_t* O = out + (size_t)blockIdx.y * out_bs;
  O[(size_t)n * K + k] = n < N ? f2bf(I[(size_t)k * N + n] * (gain ? gain[k] : 1.0f)) : (bf16_t)0;
}
__global__ void __launch_bounds__(256) nv_modulate(Params p, int layer, int which, const float* xl, const float* xcx, int nrows) {
  long r = GTID; if (r >= nrows) return;
  int w = r < RL ? (int)(r / TL) : 2;
  const float* mb = p.mods + (size_t)(layer * 3 + w) * 6144;
  const float* shift = mb + (which ? 3 : 0) * 1024; const float* scale = mb + (which ? 4 : 1) * 1024;
  const float* g = (which ? p.g_ffn_pre : p.g_mix_pre) + layer * 1024;
  const float* x = r < RL ? xl + (size_t)r * D : xcx + (size_t)(r - RL) * D;
  float ss = 0.f; for (int k = 0; k < D; ++k) ss += x[k] * x[k];
  float rstd = 1.0f / sqrtf(ss / D + 1e-6f);
  for (int k = 0; k < D; ++k) p.H[(size_t)r * D + k] = f2bf(x[k] * rstd * g[k] * (1.f + scale[k]) + shift[k]);
}
__global__ void __launch_bounds__(256) nv_gemm(const bf16_t* A, int lda, const bf16_t* Bt, int ldb, int M, int N, int K, bf16_t* C, int ldc) {
  long i = GTID; if (i >= (long)M * N) return;
  int n = (int)(i % N), m = (int)(i / N);
  const bf16_t* a = A + (size_t)m * lda; const bf16_t* b = Bt + (size_t)n * ldb;
  float acc = 0.f;
  for (int k = 0; k < K; ++k) acc += bf2f(a[k]) * bf2f(b[k]);
  C[(size_t)m * ldc + n] = f2bf(acc);
}
__global__ void __launch_bounds__(256) nv_mla_q(Params p, int layer) {
  long i = GTID; if (i >= (long)R * 4 * 96) return;
  int j = (int)(i % 96), h = (int)((i / 96) % 4), r = (int)(i / 384);
  int b, s; bs_of(r, b, s);
  const bf16_t* z = p.Z + (size_t)r * NZP + ZC_QLAT;
  const float* g = p.g_q_lat + layer * 256; const float* W = p.w_uq + (size_t)layer * 256 * 384;
  float ss = 0.f; for (int k = 0; k < 256; ++k) { float v = bf2f(z[k]); ss += v * v; }
  float rstd = 1.0f / sqrtf(ss / 256 + 1e-6f);
  auto dot = [&](int col) { float a = 0.f; for (int k = 0; k < 256; ++k) a += bf2f(z[k]) * rstd * g[k] * W[(size_t)k * 384 + col]; return a; };
  float v;
  if (j < 64) v = dot(h * 96 + j);
  else v = rope_elem([&](int jj) { return dot(h * 96 + 64 + jj); }, s, j - 64);
  p.Qm[(((size_t)b * 4 + h) * TK + s) * 96 + j] = f2bf(v * QS_MLA);
}
__global__ void __launch_bounds__(256) nv_mla_kv(Params p, int layer) {
  long i = GTID; if (i >= (long)R * 4 * 160) return;
  int j = (int)(i % 160), h = (int)((i / 160) % 4), r = (int)(i / 640);
  int b, s; bs_of(r, b, s);
  const bf16_t* z = p.Z + (size_t)r * NZP;
  if (j < 128) {
    const bf16_t* zl = z + ZC_KVLAT; const float* g = p.g_kv_lat + layer * 128; const float* W = p.w_ukv + (size_t)layer * 128 * 512;
    float ss = 0.f; for (int k = 0; k < 128; ++k) { float v = bf2f(zl[k]); ss += v * v; }
    float rstd = 1.0f / sqrtf(ss / 128 + 1e-6f);
    float a = 0.f; for (int k = 0; k < 128; ++k) a += bf2f(zl[k]) * rstd * g[k] * W[(size_t)k * 512 + h * 128 + j];
    if (j < 64) p.Km[(((size_t)b * 4 + h) * TK + s) * 96 + j] = f2bf(a);
    else p.Vtm[(((size_t)b * 4 + h) * 64 + (j - 64)) * TK + s] = f2bf(a);
  } else {
    int jj = j - 128;
    float v = rope_elem([&](int q) { return bf2f(z[ZC_KROPE + q]); }, s, jj);
    p.Km[(((size_t)b * 4 + h) * TK + s) * 96 + 64 + jj] = f2bf(v);
  }
}
__global__ void __launch_bounds__(256) nv_diff_prep(Params p) {
  long i = GTID; if (i >= (long)R * 768) return;
  int c = (int)(i % 768), r = (int)(i / 768);
  int b, s; bs_of(r, b, s);
  const bf16_t* z = p.Z + (size_t)r * NZP;
  if (c < 512) {
    int qk = c / 256, cc = c % 256, hm = cc / 32, jj = cc % 32;
    const bf16_t* src = z + (qk ? ZC_DK : ZC_DQ) + hm * 32;
    float v = rope_elem([&](int q) { return bf2f(src[q]); }, s, jj);
    if (qk == 0) p.Qd[(((size_t)b * 8 + hm) * TK + s) * 32 + jj] = f2bf(v * QS_DIFF);
    else p.Kd[(((size_t)b * 8 + hm) * TK + s) * 32 + jj] = f2bf(v);
  } else {
    int cc = c - 512, h = cc / 64, dv = cc % 64;
    p.Vtd[(((size_t)b * 4 + h) * 64 + dv) * TK + s] = z[ZC_DV + cc];
  }
}
__global__ void __launch_bounds__(256) nv_ml_prep(Params p, int layer) {
  long i = GTID; if (i >= (long)R * 512) return;
  int ch = (int)(i % 512), r = (int)(i / 512);
  int b, s; bs_of(r, b, s);
  bool first = (s == 0) || (s == TC), last = (s == TC - 1) || (s == TK - 1);
  const float* w = p.w_conv + (size_t)layer * 3 * 512;
  float acc = p.b_conv[layer * 512 + ch];
  acc += bf2f(p.Z[(size_t)r * NZP + ZC_MLQK + ch]) * w[512 + ch];
  if (!first) acc += bf2f(p.Z[(size_t)row_of(b, s - 1) * NZP + ZC_MLQK + ch]) * w[ch];
  if (!last) acc += bf2f(p.Z[(size_t)row_of(b, s + 1) * NZP + ZC_MLQK + ch]) * w[1024 + ch];
  float v = siluf_(acc);
  if (ch < 256) p.MQ[((size_t)b * TK + s) * 256 + ch] = f2bf(v);
  else p.MK[((size_t)b * TK + s) * 256 + ch - 256] = f2bf(v * 0.125f);
}
DI void nvb_ml_gates(long GI, const Params& p, int layer) {
  long i = GI; if (i >= (long)NB * 2 * NCK * 4) return;
  int h = (int)(i % 4), j = (int)((i / 4) % NCK), d = (int)((i / (4 * NCK)) % 2), b = (int)(i / (8 * NCK));
  float bi = p.b_igate[layer * 8 + d * 4 + h], bfg = p.b_fgate[layer * 8 + d * 4 + h];
  float cum = 0.f;
  for (int l = 0; l < 64; ++l) {
    int pp = 64 * j + l, s = seq_of(d, pp); const bf16_t* z = p.Z + (size_t)row_of(b, s) * NZP;
    float ig = bf2f(z[ZC_MLIG + d * 4 + h]) + bi;
    float lf = logsigmoidf_(bf2f(z[ZC_MLFG + d * 4 + h]) + bfg);
    cum += lf;
    size_t o = (((size_t)b * 2 + d) * TK + pp) * 4 + h;
    p.BC[o] = cum; p.IGS[o] = ig;
  }
}
DI void nvb_gla_cum(long GI, const Params& p, int layer) {
  long i = GI; if (i >= (long)NB * 2 * NCK * 128) return;
  int ch = (int)(i % 128), j = (int)((i / 128) % NCK), d = (int)((i / (128 * NCK)) % 2), b = (int)(i / (256 * NCK));
  const float* W = p.w_alpha2 + (size_t)layer * 2 * 16 * 128 + (size_t)d * 16 * 128;
  float ba = p.b_alpha[layer * 256 + d * 128 + ch];
  float cum = 0.f;
  for (int l = 0; l < 64; ++l) {
    int pp = 64 * j + l, s = seq_of(d, pp); const bf16_t* z = p.Z + (size_t)row_of(b, s) * NZP + ZC_GA + d * 16;
    float zg = ba; for (int q = 0; q < 16; ++q) zg += bf2f(z[q]) * W[q * 128 + ch];
    cum += logsigmoidf_(zg) * (1.0f / 16.0f);
    p.GC[(((size_t)b * 2 + d) * TK + pp) * 128 + ch] = cum;
  }
}
__global__ void __launch_bounds__(256) nv_attn_mla(Params p, int need_ctx) {
  long i = GTID; if (i >= (long)NB * 4 * TK) return;
  int s = (int)(i % TK), h = (int)((i / TK) % 4), b = (int)(i / (4 * TK));
  if (s < TC && !need_ctx) return;
  int nk = s < TC ? TC : TK;
  const bf16_t* q = p.Qm + (((size_t)b * 4 + h) * TK + s) * 96;
  const bf16_t* K = p.Km + ((size_t)b * 4 + h) * TK * 96;
  const bf16_t* Vt = p.Vtm + ((size_t)b * 4 + h) * 64 * TK;
  float qf[96], o[64];
  _Pragma("unroll") for (int k = 0; k < 96; ++k) qf[k] = bf2f(q[k]);
  _Pragma("unroll") for (int k = 0; k < 64; ++k) o[k] = 0.f;
  float m = -1e30f, l = 0.f;
  for (int t = 0; t < nk; ++t) {
    float sc = 0.f; _Pragma("unroll") for (int k = 0; k < 96; ++k) sc += qf[k] * bf2f(K[(size_t)t * 96 + k]);
    float mn = fmaxf(m, sc), a = exp2f(m - mn), pr = exp2f(sc - mn);
    l = l * a + pr;
    _Pragma("unroll") for (int k = 0; k < 64; ++k) o[k] = o[k] * a + pr * bf2f(Vt[(size_t)k * TK + t]);
    m = mn;
  }
  int r = row_of(b, s);
  _Pragma("unroll") for (int k = 0; k < 64; ++k) p.Y[(size_t)r * D + h * 64 + k] = f2bf(o[k] / l);
}
__global__ void __launch_bounds__(256) nv_attn_diff(Params p, int layer, int need_ctx) {
  long i = GTID; if (i >= (long)NB * 4 * TK) return;
  int s = (int)(i % TK), h = (int)((i / TK) % 4), b = (int)(i / (4 * TK));
  if (s < TC && !need_ctx) return;
  int nk = s < TC ? TC : TK;
  float lam_init; float lam = lam_of(p, layer, lam_init);
  const bf16_t* Vt = p.Vtd + ((size_t)b * 4 + h) * 64 * TK;
  float res[64];
  _Pragma("unroll") for (int k = 0; k < 64; ++k) res[k] = 0.f;
  _Pragma("unroll") for (int mp = 0; mp < 2; ++mp) {
    const bf16_t* q = p.Qd + (((size_t)b * 8 + h * 2 + mp) * TK + s) * 32;
    const bf16_t* K = p.Kd + ((size_t)b * 8 + h * 2 + mp) * TK * 32;
    float qf[32], o[64];
    _Pragma("unroll") for (int k = 0; k < 32; ++k) qf[k] = bf2f(q[k]);
    _Pragma("unroll") for (int k = 0; k < 64; ++k) o[k] = 0.f;
    float m = -1e30f, l = 0.f;
    for (int t = 0; t < nk; ++t) {
      float sc = 0.f; _Pragma("unroll") for (int k = 0; k < 32; ++k) sc += qf[k] * bf2f(K[(size_t)t * 32 + k]);
      float mn = fmaxf(m, sc), a = exp2f(m - mn), pr = exp2f(sc - mn);
      l = l * a + pr;
      _Pragma("unroll") for (int k = 0; k < 64; ++k) o[k] = o[k] * a + pr * bf2f(Vt[(size_t)k * TK + t]);
      m = mn;
    }
    float wgt = mp == 0 ? 1.f : -lam;
    _Pragma("unroll") for (int k = 0; k < 64; ++k) res[k] += wgt * o[k] / l;
  }
  float ss = 0.f; _Pragma("unroll") for (int k = 0; k < 64; ++k) ss += res[k] * res[k];
  float rstd = 1.0f / sqrtf(ss / 64 + 1e-6f);
  int r = row_of(b, s);
  _Pragma("unroll") for (int k = 0; k < 64; ++k) p.Y[(size_t)r * D + 768 + h * 64 + k] = f2bf(res[k] * rstd * p.g_diff_out[layer * 256 + h * 64 + k] * (1.f - lam_init));
}
DI void nvb_ml_local(long GI, const Params& p) {
  long i = GI; if (i >= (long)NUNIT * 4160) return;
  int e = (int)(i % 4160); long u = i / 4160;
  int h = (int)(u % 4), j = (int)((u / 4) % NCK), d = (int)((u / (4 * NCK)) % 2), b = (int)(u / (8 * NCK));
  const float* bc = p.BC + (((size_t)b * 2 + d) * TK + 64 * j) * 4 + h; const float* ig = p.IGS + (((size_t)b * 2 + d) * TK + 64 * j) * 4 + h;
  float bend = bc[63 * 4], ml = -1e30f;
  for (int l = 0; l < 64; ++l) ml = fmaxf(ml, bend - bc[l * 4] + ig[l * 4]);
  if (e == 4096 + 0) { p.MM[u * 4 + 0] = ml; p.MM[u * 4 + 1] = bend; }
  float acc = 0.f;
  if (e < 4096) {
    int v = e / 64, k = e % 64;
    for (int l = 0; l < 64; ++l) {
      int s = seq_of(d, 64 * j + l); float w = expf(bend - bc[l * 4] + ig[l * 4] - ml);
      acc += w * bf2f(p.Z[(size_t)row_of(b, s) * NZP + ZC_MLV + h * 64 + v]) * bf2f(p.MK[((size_t)b * TK + s) * 256 + h * 64 + k]);
    }
    p.MC[(size_t)u * 4096 + e] = acc;
  } else {
    int k = e - 4096;
    for (int l = 0; l < 64; ++l) {
      int s = seq_of(d, 64 * j + l); float w = expf(bend - bc[l * 4] + ig[l * 4] - ml);
      acc += w * bf2f(p.MK[((size_t)b * TK + s) * 256 + h * 64 + k]);
    }
    p.MN[(size_t)u * 64 + k] = acc;
  }
}
DI void nvb_ml_scan(long GI, const Params& p) {
  long i = GI; if (i >= (long)NB * 2 * 4 * 4160) return;
  int e = (int)(i % 4160); int ch = (int)(i / 4160); int h = ch % 4, bd = ch / 4;
  float st = 0.f, m = -1e30f;
  for (int j = 0; j < NCK; ++j) {
    size_t u = ((size_t)bd * NCK + j) * 4 + h;
    float ml = p.MM[u * 4 + 0], be = p.MM[u * 4 + 1];
    float mn = fmaxf(be + m, ml), a = expf(be + m - mn), g = expf(ml - mn);
    float* slot = e < 4096 ? &p.MC[u * 4096 + e] : &p.MN[u * 64 + (e - 4096)];
    float loc = *slot; *slot = st; st = a * st + g * loc;
    if (e == 0) p.MM[u * 4 + 2] = m;
    m = mn;
  }
}
DI void nvb_ml_out(long GI, const Params& p, int need_ctx) {
  long i = GI; if (i >= (long)NUNIT * 4096) return;
  int v = (int)(i % 64), l = (int)((i / 64) % 64); long u = i / 4096;
  int h = (int)(u % 4), j = (int)((u / 4) % NCK), d = (int)((u / (4 * NCK)) % 2), b = (int)(u / (8 * NCK));
  if (j < NCC && !need_ctx) return;
  const float* bc = p.BC + (((size_t)b * 2 + d) * TK + 64 * j) * 4 + h; const float* ig = p.IGS + (((size_t)b * 2 + d) * TK + 64 * j) * 4 + h;
  float m0 = p.MM[u * 4 + 2];
  int sl = seq_of(d, 64 * j + l);
  const bf16_t* q = p.MQ + ((size_t)b * TK + sl) * 256 + h * 64;
  float bl = bc[l * 4];
  float inter = bl + m0, mt = inter;
  for (int t = 0; t <= l; ++t) mt = fmaxf(mt, bl - bc[t * 4] + ig[t * 4]);
  float num = 0.f, den = 0.f;
  for (int t = 0; t <= l; ++t) {
    int st = seq_of(d, 64 * j + t);
    const bf16_t* k = p.MK + ((size_t)b * TK + st) * 256 + h * 64;
    float qk = 0.f; for (int c = 0; c < 64; ++c) qk += bf2f(q[c]) * bf2f(k[c]);
    float sv = expf(bl - bc[t * 4] + ig[t * 4] - mt) * qk;
    num += sv * bf2f(p.Z[(size_t)row_of(b, st) * NZP + ZC_MLV + h * 64 + v]); den += sv;
  }
  float ai = expf(inter - mt);
  float qc = 0.f, qn = 0.f;
  for (int c = 0; c < 64; ++c) { qc += bf2f(q[c]) * p.MC[(size_t)u * 4096 + v * 64 + c]; qn += bf2f(q[c]) * p.MN[(size_t)u * 64 + c]; }
  num += ai * qc; den += ai * qn;
  p.HD[(((size_t)d * NB + b) * TK + sl) * 256 + h * 64 + v] = num / fmaxf(fabsf(den), expf(-mt));
}
DI void nvb_ml_finish(long GI, const Params& p, int layer, int need_ctx) {
  long i = GI; if (i >= (long)R * 4) return;
  int h = (int)(i % 4), r = (int)(i / 4); int b, s; bs_of(r, b, s);
  if (s < TC && !need_ctx) return;
  const float* h0 = p.HD + (((size_t)0 * NB + b) * TK + s) * 256 + h * 64; const float* h1 = p.HD + (((size_t)1 * NB + b) * TK + s) * 256 + h * 64;
  float ss = 0.f; for (int v = 0; v < 64; ++v) { float t = h0[v] + h1[v]; ss += t * t; }
  float rstd = 1.0f / sqrtf(ss / 64 + 1e-6f);
  for (int v = 0; v < 64; ++v) {
    float o = bf2f(p.Z[(size_t)r * NZP + ZC_MLO + h * 64 + v]);
    p.Y[(size_t)r * D + 256 + h * 64 + v] = f2bf(sigmoidf_(o) * (h0[v] + h1[v]) * rstd * p.g_mlstm_out[layer * 256 + h * 64 + v]);
  }
}
DI void nvb_gla_local(long GI, const Params& p) {
  long i = GI; if (i >= (long)NUNIT * 2048) return;
  int v = (int)(i % 64), k = (int)((i / 64) % 32); long u = i / 2048;
  int h = (int)(u % 4), j = (int)((u / 4) % NCK), d = (int)((u / (4 * NCK)) % 2), b = (int)(u / (8 * NCK));
  const float* gc = p.GC + (((size_t)b * 2 + d) * TK + 64 * j) * 128 + h * 32 + k;
  float ge = gc[63 * 128], acc = 0.f;
  for (int l = 0; l < 64; ++l) {
    int s = seq_of(d, 64 * j + l); const bf16_t* z = p.Z + (size_t)row_of(b, s) * NZP;
    acc += bf2f(z[ZC_GK + h * 32 + k]) * expf(ge - gc[l * 128]) * bf2f(z[ZC_GV + h * 64 + v]);
  }
  p.GS[(size_t)u * 2048 + v * 32 + k] = acc;
}
DI void nvb_gla_scan(long GI, const Params& p) {
  long i = GI; if (i >= (long)NB * 2 * 4 * 2048) return;
  int e = (int)(i % 2048); int ch = (int)(i / 2048); int h = ch % 4, bd = ch / 4; int k = e % 32;
  float st = 0.f;
  for (int j = 0; j < NCK; ++j) {
    size_t u = ((size_t)bd * NCK + j) * 4 + h;
    float ge = p.GC[((size_t)bd * TK + 64 * j + 63) * 128 + h * 32 + k];
    float loc = p.GS[u * 2048 + e]; p.GS[u * 2048 + e] = st; st = expf(ge) * st + loc;
  }
}
DI void nvb_gla_out(long GI, const Params& p, int need_ctx) {
  long i = GI; if (i >= (long)NUNIT * 4096) return;
  int v = (int)(i % 64), l = (int)((i / 64) % 64); long u = i / 4096;
  int h = (int)(u % 4), j = (int)((u / 4) % NCK), d = (int)((u / (4 * NCK)) % 2), b = (int)(u / (8 * NCK));
  if (j < NCC && !need_ctx) return;
  const float* gc = p.GC + (((size_t)b * 2 + d) * TK + 64 * j) * 128 + h * 32;
  int sl = seq_of(d, 64 * j + l);
  const bf16_t* q = p.Z + (size_t)row_of(b, sl) * NZP + ZC_GQ + h * 32;
  const float qs = 0.17677669529663687f;
  float acc = 0.f;
  for (int t = 0; t <= l; ++t) {
    int st = seq_of(d, 64 * j + t); const bf16_t* z = p.Z + (size_t)row_of(b, st) * NZP;
    float att = 0.f; for (int k = 0; k < 32; ++k) att += bf2f(q[k]) * qs * expf(gc[l * 128 + k] - gc[t * 128 + k]) * bf2f(z[ZC_GK + h * 32 + k]);
    acc += att * bf2f(z[ZC_GV + h * 64 + v]);
  }
  for (int k = 0; k < 32; ++k) acc += bf2f(q[k]) * qs * expf(gc[l * 128 + k]) * p.GS[(size_t)u * 2048 + v * 32 + k];
  p.OD[(((size_t)d * NB + b) * TK + sl) * 256 + h * 64 + v] = acc;
}
DI void nvb_gla_finish(long GI, const Params& p, int layer, int need_ctx) {
  long i = GI; if (i >= (long)R * 4) return;
  int h = (int)(i % 4), r = (int)(i / 4); int b, s; bs_of(r, b, s);
  if (s < TC && !need_ctx) return;
  const float* h0 = p.OD + (((size_t)0 * NB + b) * TK + s) * 256 + h * 64; const float* h1 = p.OD + (((size_t)1 * NB + b) * TK + s) * 256 + h * 64;
  float ss = 0.f; for (int v = 0; v < 64; ++v) { float t = h0[v] + h1[v]; ss += t * t; }
  float rstd = 1.0f / sqrtf(ss / 64 + 1e-6f);
  for (int v = 0; v < 64; ++v) {
    float rr = bf2f(p.Z[(size_t)r * NZP + ZC_GR + h * 64 + v]);
    p.Y[(size_t)r * D + 512 + h * 64 + v] = f2bf(siluf_(rr) * (h0[v] + h1[v]) * rstd * p.g_gla_out[layer * 256 + h * 64 + v]);
  }
}
__global__ void __launch_bounds__(256) nv_merge(Params p, int layer, int nrows) {
  long i = GTID; if (i >= (long)nrows * D) return;
  int j = (int)(i % D), r = (int)(i / D);
  float acc = 0.f;
  for (int n = 0; n < 4; ++n) {
    const bf16_t* wg = p.Wt_gate + (size_t)(n * 1024 + j) * D; const bf16_t* wb = p.Wt_branch + ((size_t)n * D + j) * 256;
    float g = p.b_gate[layer * 4096 + n * 1024 + j], pr = 0.f;
    for (int k = 0; k < D; ++k) g += bf2f(p.H[(size_t)r * D + k]) * bf2f(wg[k]);
    for (int k = 0; k < 256; ++k) pr += bf2f(p.Y[(size_t)r * D + n * 256 + k]) * bf2f(wb[k]);
    acc += sigmoidf_(g) * pr;
  }
  p.MG[(size_t)r * D + j] = f2bf(acc);
}
__global__ void __launch_bounds__(256) nv_resid_mix(Params p, int layer, const float* xl_in, const float* xc_in, int nrows) {
  long r = GTID; if (r >= nrows) return;
  int w = r < RL ? (int)(r / TL) : 2;
  const float* mb = p.mods + (size_t)(layer * 3 + w) * 6144;
  const float* xin = r < RL ? xl_in + (size_t)r * D : xc_in + (size_t)(r - RL) * D;
  float* xo = r < RL ? p.out + (size_t)r * D : p.xc + (size_t)(r - RL) * D;
  const bf16_t* yo = p.YO + (size_t)r * D;
  float ss = 0.f; for (int k = 0; k < D; ++k) { float v = bf2f(yo[k]); ss += v * v; }
  float rstd = 1.0f / sqrtf(ss / D + 1e-6f);
  float s2 = 0.f;
  for (int k = 0; k < D; ++k) { float xn = xin[k] + mb[2 * 1024 + k] * bf2f(yo[k]) * rstd * p.g_mix_post[layer * 1024 + k]; xo[k] = xn; s2 += xn * xn; }
  float rstd2 = 1.0f / sqrtf(s2 / D + 1e-6f);
  float lg[16]; _Pragma("unroll") for (int e = 0; e < 16; ++e) lg[e] = 0.f;
  const float* wr = p.w_router + (size_t)layer * D * 16;
  for (int k = 0; k < D; ++k) {
    float h2 = xo[k] * rstd2 * p.g_ffn_pre[layer * 1024 + k] * (1.f + mb[4 * 1024 + k]) + mb[3 * 1024 + k];
    p.H[(size_t)r * D + k] = f2bf(h2);
    _Pragma("unroll") for (int e = 0; e < 16; ++e) lg[e] += h2 * wr[k * 16 + e];
  }
  float mx = lg[0]; _Pragma("unroll") for (int e = 1; e < 16; ++e) mx = fmaxf(mx, lg[e]);
  float sm = 0.f; _Pragma("unroll") for (int e = 0; e < 16; ++e) { lg[e] = expf(lg[e] - mx); sm += lg[e]; }
  int b, s; bs_of((int)r, b, s);
  _Pragma("unroll") for (int e = 0; e < 16; ++e) p.AFF[((size_t)b * NE + e) * TK + s] = lg[e] / sm;
}
__global__ void __launch_bounds__(256) nv_topk(Params p, int need_ctx) {
  long i = GTID; if (i >= NB * NE * 2) return;
  int seg = (int)(i % 2), e = (int)((i / 2) % NE), b = (int)(i / (2 * NE));
  int s0 = seg ? TC : 0, n = seg ? TL : TC, cap = seg ? CAPL : CAPC, slot0 = seg ? b * CAPL : NB * CAPL + b * CAPC;
  if (seg == 0 && !need_ctx) { for (int q = 0; q < cap; ++q) p.SEL[(size_t)e * NSLOT + slot0 + q] = -1; return; }
  const float* a = p.AFF + ((size_t)b * NE + e) * TK + s0;
  unsigned thr = 0;
  for (int bit = 31; bit >= 0; --bit) {
    unsigned cand = thr | (1u << bit); int cnt = 0;
    for (int t = 0; t < n; ++t) cnt += (f2u(a[t]) >= cand);
    if (cnt >= cap) thr = cand;
  }
  int ngt = 0; for (int t = 0; t < n; ++t) ngt += (f2u(a[t]) > thr);
  int neq = cap - ngt, q = 0;
  for (int t = 0; t < n; ++t) {
    unsigned u = f2u(a[t]); int r = row_of(b, s0 + t); int sel = -1;
    if (u > thr) sel = q++; else if (u == thr && neq > 0) { sel = q++; --neq; }
    if (sel >= 0) { p.SEL[(size_t)e * NSLOT + slot0 + sel] = r; p.SELV[(size_t)e * NSLOT + slot0 + sel] = a[t]; }
    p.INV[(size_t)r * NE + e] = sel >= 0 ? slot0 + sel : -1;
  }
}
__global__ void __launch_bounds__(256) nv_moe1(Params p) {
  long i = GTID; if (i >= (long)NE * NSLOT * FF) return;
  int f = (int)(i % FF), slot = (int)((i / FF) % NSLOT), e = (int)(i / ((long)FF * NSLOT));
  int r = p.SEL[(size_t)e * NSLOT + slot];
  float out = 0.f;
  if (r >= 0) {
    const bf16_t* wg = p.Wt_eg + ((size_t)e * FF + f) * D; const bf16_t* wu = p.Wt_eu + ((size_t)e * FF + f) * D; const bf16_t* h = p.H + (size_t)r * D;
    float g = 0.f, u = 0.f; for (int k = 0; k < D; ++k) { float hv = bf2f(h[k]); g += hv * bf2f(wg[k]); u += hv * bf2f(wu[k]); }
    out = siluf_(g) * u;
  }
  p.HID[((size_t)e * NSLOT + slot) * FF + f] = f2bf(out);
}
__global__ void __launch_bounds__(256) nv_moe2(Params p) {
  long i = GTID; if (i >= (long)NE * NSLOT * D) return;
  int j = (int)(i % D), slot = (int)((i / D) % NSLOT), e = (int)(i / ((long)D * NSLOT));
  int r = p.SEL[(size_t)e * NSLOT + slot];
  float out = 0.f;
  if (r >= 0) {
    const bf16_t* wd = p.Wt_ed + ((size_t)e * D + j) * FF; const bf16_t* h = p.HID + ((size_t)e * NSLOT + slot) * FF;
    float a = 0.f; for (int k = 0; k < FF; ++k) a += bf2f(h[k]) * bf2f(wd[k]);
    out = a * p.SELV[(size_t)e * NSLOT + slot];
  }
  p.YE[((size_t)e * NSLOT + slot) * D + j] = f2bf(out);
}
__global__ void __launch_bounds__(256) nv_resid_ffn(Params p, int layer, int nrows) {
  long r = GTID; if (r >= nrows) return;
  int w = r < RL ? (int)(r / TL) : 2;
  const float* mb = p.mods + (size_t)(layer * 3 + w) * 6144;
  float* xo = r < RL ? p.out + (size_t)r * D : p.xc + (size_t)(r - RL) * D;
  float ss = 0.f;
  for (int k = 0; k < D; ++k) {
    float f = 0.f;
    for (int e = 0; e < NE; ++e) { int sl = p.INV[(size_t)r * NE + e]; if (sl >= 0) f += bf2f(p.YE[((size_t)e * NSLOT + sl) * D + k]); }
    ss += f * f;
  }
  float rstd = 1.0f / sqrtf(ss / D + 1e-6f);
  for (int k = 0; k < D; ++k) {
    float f = 0.f;
    for (int e = 0; e < NE; ++e) { int sl = p.INV[(size_t)r * NE + e]; if (sl >= 0) f += bf2f(p.YE[((size_t)e * NSLOT + sl) * D + k]); }
    xo[k] += mb[5 * 1024 + k] * f * rstd * p.g_ffn_post[layer * 1024 + k];
  }
}

__global__ void __launch_bounds__(256) nv_mods(Params p) { nvb_mods(GTID, p); }
__global__ void __launch_bounds__(256) nv_ml_gates(Params p, int layer) { nvb_ml_gates(GTID, p, layer); }
__global__ void __launch_bounds__(256) nv_gla_cum(Params p, int layer) { nvb_gla_cum(GTID, p, layer); }
__global__ void __launch_bounds__(256) nv_ml_local(Params p) { nvb_ml_local(GTID, p); }
__global__ void __launch_bounds__(256) nv_ml_scan(Params p) { nvb_ml_scan(GTID, p); }
__global__ void __launch_bounds__(256) nv_ml_out(Params p, int need_ctx) { nvb_ml_out(GTID, p, need_ctx); }
__global__ void __launch_bounds__(256) nv_ml_finish(Params p, int layer, int need_ctx) { nvb_ml_finish(GTID, p, layer, need_ctx); }
__global__ void __launch_bounds__(256) nv_gla_local(Params p) { nvb_gla_local(GTID, p); }
__global__ void __launch_bounds__(256) nv_gla_scan(Params p) { nvb_gla_scan(GTID, p); }
__global__ void __launch_bounds__(256) nv_gla_out(Params p, int need_ctx) { nvb_gla_out(GTID, p, need_ctx); }
__global__ void __launch_bounds__(256) nv_gla_finish(Params p, int layer, int need_ctx) { nvb_gla_finish(GTID, p, layer, need_ctx); }
constexpr int LROW = 144;
constexpr int A_BYTES = 128 * LROW;
constexpr int NTHR = 256;
#ifndef ATT_THR
#define ATT_THR 16.0f
#endif

DI u32x4 ldg16(const void* p) { return *(const u32x4*)p; }
DI void sts16(char* p, u32x4 v) { *(u32x4*)p = v; }
DI bf16x8 lds_frag(const char* p) { return *(const bf16x8*)p; }

template <int WN>
DI void gemm_kloop(f32x4 (&acc)[4][WN], const bf16_t* const (&ap)[4], const bf16_t* const (&bp)[WN], int nk, char* lds) {
  constexpr int STAGE = A_BYTES + 32 * WN * LROW;
  const int t = TIDX, lane = t & 63, wid = t >> 6, wr = wid >> 1, wc = wid & 1;
  const int lr = t >> 3, lcb = (t & 7) * 16;
  const int fr = lane & 15, fq = lane >> 4;
  const int aoff = (wr * 64 + fr) * LROW + fq * 16, boff = A_BYTES + (wc * WN * 16 + fr) * LROW + fq * 16, soff = lr * LROW + lcb;
  u32x4 ra0[4], rb0[WN], ra1[4], rb1[WN];
  auto gload = [&](u32x4 (&ra)[4], u32x4 (&rb)[WN], int kt) {
#pragma unroll
    for (int i = 0; i < 4; ++i) ra[i] = ldg16(ap[i] + kt * 64);
#pragma unroll
    for (int i = 0; i < WN; ++i) rb[i] = ldg16(bp[i] + kt * 64);
  };
  auto sstore = [&](const u32x4 (&ra)[4], const u32x4 (&rb)[WN], char* st) {
#pragma unroll
    for (int i = 0; i < 4; ++i) sts16(st + soff + 32 * i * LROW, ra[i]);
#pragma unroll
    for (int i = 0; i < WN; ++i) sts16(st + A_BYTES + soff + 32 * i * LROW, rb[i]);
  };
  auto compute = [&](const char* cur) {
#pragma unroll
    for (int ks = 0; ks < 2; ++ks) {
      bf16x8 af[4], bfr[WN];
#pragma unroll
      for (int m = 0; m < 4; ++m) af[m] = lds_frag(cur + aoff + m * 16 * LROW + ks * 64);
#pragma unroll
      for (int n = 0; n < WN; ++n) bfr[n] = lds_frag(cur + boff + n * 16 * LROW + ks * 64);
#pragma unroll
      for (int m = 0; m < 4; ++m)
#pragma unroll
        for (int n = 0; n < WN; ++n) acc[m][n] = MFMA16(bfr[n], af[m], acc[m][n]);
    }
  };
  gload(ra0, rb0, 0);
  gload(ra1, rb1, 1);
  sstore(ra0, rb0, lds);
  __syncthreads();
#pragma unroll 1
  for (int kt = 0; kt < nk; kt += 2) {
    if (kt + 2 < nk) gload(ra0, rb0, kt + 2);
    compute(lds);
    sstore(ra1, rb1, lds + STAGE);
    __syncthreads();
    if (kt + 3 < nk) gload(ra1, rb1, kt + 3);
    compute(lds + STAGE);
    if (kt + 2 < nk) sstore(ra0, rb0, lds);
    __syncthreads();
  }
}
template <int WN> DI void acc_zero(f32x4 (&acc)[4][WN]) {
#pragma unroll
  for (int m = 0; m < 4; ++m)
#pragma unroll
    for (int n = 0; n < WN; ++n) acc[m][n] = (f32x4){0.f, 0.f, 0.f, 0.f};
}
DI void st_bf16x4(bf16_t* p, f32x4 v) { u32x2 o; o.x = pack2bf(v.x, v.y); o.y = pack2bf(v.z, v.w); *(u32x2*)p = o; }

DI void gemm_plain_tile(const bf16_t* A, int lda, const bf16_t* Bt, int ldb, int K, bf16_t* C, int ldc, int tm, int tn, char* lds) {
  const int t = TIDX, lane = t & 63, wid = t >> 6, wr = wid >> 1, wc = wid & 1, lr = t >> 3, lc = (t & 7) * 8, fr = lane & 15, fq = lane >> 4;
  const bf16_t* ap[4]; const bf16_t* bp[4];
#pragma unroll
  for (int i = 0; i < 4; ++i) { ap[i] = A + (size_t)(tm * 128 + lr + 32 * i) * lda + lc; bp[i] = Bt + (size_t)(tn * 128 + lr + 32 * i) * ldb + lc; }
  f32x4 acc[4][4]; acc_zero<4>(acc);
  gemm_kloop<4>(acc, ap, bp, K / 64, lds);
#pragma unroll
  for (int m = 0; m < 4; ++m)
#pragma unroll
    for (int n = 0; n < 4; ++n)
      st_bf16x4(C + (size_t)(tm * 128 + wr * 64 + m * 16 + fr) * ldc + tn * 128 + wc * 64 + n * 16 + 4 * fq, acc[m][n]);
}
DI void ph_gemm_plain(const bf16_t* A, int lda, const bf16_t* Bt, int ldb, int M, int N, int K, bf16_t* C, int ldc, char* lds, int bid, int nblk) {
  const int ntn = N / 128, nt = (M / 128) * ntn;
  for (int tile = bid; tile < nt; tile += nblk) gemm_plain_tile(A, lda, Bt, ldb, K, C, ldc, tile / ntn, tile % ntn, lds);
}
DI void ph_mla_up(const Params& p, int layer, bf16_t* QRAW, bf16_t* KVRAW, char* lds, int bid, int nblk) {
  const int ntq = (R / 128) * 3, ntkv = (R / 128) * 4;
  for (int tile = bid; tile < ntq + ntkv; tile += nblk) {
    if (tile < ntq) gemm_plain_tile(p.Z + ZC_QLAT, NZP, p.Wt_uq + layer * WSZ_UQ, 256, 256, QRAW, 384, tile / 3, tile % 3, lds);
    else { int u = tile - ntq; gemm_plain_tile(p.Z + ZC_KVLAT, NZP, p.Wt_ukv + layer * WSZ_UKV, 128, 128, KVRAW, 512, u / 4, u % 4, lds); }
  }
}
constexpr int LROW32 = 80;
template <int WM, int WN, bool DEEP>
DI void gemm_kloop_g(f32x4 (&acc)[WM][WN], const bf16_t* const (&ap)[WM / 2], const bf16_t* const (&bp)[WN / 2], int nk, char* lds) {
  constexpr int NA = WM / 2, NBB = WN / 2, A_B = 32 * WM * LROW32, STAGE = (32 * WM + 32 * WN) * LROW32;
  const int t = TIDX, lane = t & 63, wid = t >> 6, wr = wid >> 1, wc = wid & 1, fr = lane & 15, fq = lane >> 4;
  const int aoff = (wr * 16 * WM + fr) * LROW32 + fq * 16, boff = A_B + (wc * 16 * WN + fr) * LROW32 + fq * 16, soff = (t >> 2) * LROW32 + (t & 3) * 16;
  u32x4 ra0[NA], rb0[NBB], ra1[NA], rb1[NBB];
  auto gload = [&](u32x4 (&ra)[NA], u32x4 (&rb)[NBB], int kt) {
#pragma unroll
    for (int i = 0; i < NA; ++i) ra[i] = ldg16(ap[i] + kt * 32);
#pragma unroll
    for (int i = 0; i < NBB; ++i) rb[i] = ldg16(bp[i] + kt * 32);
  };
  auto sstore = [&](const u32x4 (&ra)[NA], const u32x4 (&rb)[NBB], char* st) {
#pragma unroll
    for (int i = 0; i < NA; ++i) sts16(st + soff + 64 * i * LROW32, ra[i]);
#pragma unroll
    for (int i = 0; i < NBB; ++i) sts16(st + A_B + soff + 64 * i * LROW32, rb[i]);
  };
  auto compute = [&](const char* cur) {
    bf16x8 af[WM];
#pragma unroll
    for (int m = 0; m < WM; ++m) af[m] = lds_frag(cur + aoff + m * 16 * LROW32);
#pragma unroll
    for (int n = 0; n < WN; ++n) {
      const bf16x8 bfr = lds_frag(cur + boff + n * 16 * LROW32);
#pragma unroll
      for (int m = 0; m < WM; ++m) acc[m][n] = MFMA16(bfr, af[m], acc[m][n]);
    }
  };
  gload(ra0, rb0, 0);
  if (DEEP) gload(ra1, rb1, 1);
  sstore(ra0, rb0, lds);
  __syncthreads();
#pragma unroll 1
  for (int kt = 0; kt < nk; kt += 2) {
    if (DEEP) { if (kt + 2 < nk) gload(ra0, rb0, kt + 2); } else gload(ra1, rb1, kt + 1);
    compute(lds);
    sstore(ra1, rb1, lds + STAGE);
    __syncthreads();
    if (DEEP) { if (kt + 3 < nk) gload(ra1, rb1, kt + 3); } else if (kt + 2 < nk) gload(ra0, rb0, kt + 2);
    compute(lds + STAGE);
    if (kt + 2 < nk) sstore(ra0, rb0, lds);
    __syncthreads();
  }
}
template <int WM, int WN> DI void acc_zero_g(f32x4 (&acc)[WM][WN]) {
#pragma unroll
  for (int m = 0; m < WM; ++m)
#pragma unroll
    for (int n = 0; n < WN; ++n) acc[m][n] = (f32x4){0.f, 0.f, 0.f, 0.f};
}
DI void ph_merge(const Params& p, int layer, int rows, char* lds, int bid, int nblk) {
  const int t = TIDX, lane = t & 63, wid = t >> 6, wr = wid >> 1, wc = wid & 1, fr = lane & 15, fq = lane >> 4;
  const int lr = t >> 2, lc = (t & 3) * 8;
  const int ntn = D / 64, nt = (rows / 128) * ntn;
#pragma unroll 1
  for (int tile = bid; tile < nt; tile += nblk) {
    const int tm = tile / ntn, tn = tile % ntn;
    f32x4 accS[4][2]; acc_zero_g<4, 2>(accS);
#pragma unroll 1
    for (int np = 0; np < 2; ++np) {
      f32x4 accG[4][4]; acc_zero_g<4, 4>(accG);
      {
        const bf16_t* ap[2]; const bf16_t* bp[2];
#pragma unroll
        for (int i = 0; i < 2; ++i) ap[i] = p.H + (size_t)(tm * 128 + lr + 64 * i) * D + lc;
#pragma unroll
        for (int i = 0; i < 2; ++i) { const int rho = lr + 64 * i, wci = rho >> 6, n = 2 * np + ((rho >> 5) & 1), c = rho & 31;
          bp[i] = p.Wt_gate + layer * WSZ_GATE + ((size_t)n * 1024 + tn * 64 + wci * 32 + c) * D + lc; }
        gemm_kloop_g<4, 4, true>(accG, ap, bp, D / 32, lds);
      }
#pragma unroll 1
      for (int q = 0; q < 2; ++q) {
        const int n = 2 * np + q;
        f32x4 accP[4][2]; acc_zero_g<4, 2>(accP);
        const bf16_t* ap[2]; const bf16_t* bp[1];
#pragma unroll
        for (int i = 0; i < 2; ++i) ap[i] = p.Y + (size_t)(tm * 128 + lr + 64 * i) * D + n * 256 + lc;
        bp[0] = p.Wt_branch + layer * WSZ_BR + ((size_t)n * D + tn * 64 + lr) * 256 + lc;
        gemm_kloop_g<4, 2, false>(accP, ap, bp, 8, lds);
#pragma unroll
        for (int nn = 0; nn < 2; ++nn) {
          const f32x4 bv = *(const f32x4*)(p.b_gate + layer * 4096 + n * 1024 + tn * 64 + wc * 32 + nn * 16 + 4 * fq);
#pragma unroll
          for (int m = 0; m < 4; ++m)
#pragma unroll
            for (int j = 0; j < 4; ++j) { const float g = q ? accG[m][2 + nn][j] : accG[m][nn][j]; accS[m][nn][j] += accP[m][nn][j] * fast_rcp(1.0f + fast_exp2(-LOG2E * (g + bv[j]))); }
        }
      }
    }
#pragma unroll
    for (int m = 0; m < 4; ++m)
#pragma unroll
      for (int nn = 0; nn < 2; ++nn)
        st_bf16x4(p.MG + (size_t)(tm * 128 + wr * 64 + m * 16 + fr) * D + tn * 64 + wc * 32 + nn * 16 + 4 * fq, accS[m][nn]);
  }
}
template <int WM>
DI void gemm_plain_tile_g(const bf16_t* A, int lda, const bf16_t* Bt, int ldb, int K, bf16_t* C, int ldc, int row0, int col0, char* lds) {
  const int t = TIDX, lane = t & 63, wid = t >> 6, wr = wid >> 1, wc = wid & 1, fr = lane & 15, fq = lane >> 4, lr = t >> 2, lc = (t & 3) * 8;
  const bf16_t* ap[WM / 2]; const bf16_t* bp[2];
#pragma unroll
  for (int i = 0; i < WM / 2; ++i) ap[i] = A + (size_t)(row0 + lr + 64 * i) * lda + lc;
#pragma unroll
  for (int i = 0; i < 2; ++i) bp[i] = Bt + (size_t)(col0 + lr + 64 * i) * ldb + lc;
  f32x4 acc[WM][4]; acc_zero_g<WM, 4>(acc);
  gemm_kloop_g<WM, 4, true>(acc, ap, bp, K / 32, lds);
#pragma unroll
  for (int m = 0; m < WM; ++m)
#pragma unroll
    for (int n = 0; n < 4; ++n)
      st_bf16x4(C + (size_t)(row0 + wr * 16 * WM + m * 16 + fr) * ldc + col0 + wc * 64 + n * 16 + 4 * fq, acc[m][n]);
}
DI void ph_gemm_plain2(const bf16_t* A, int lda, const bf16_t* Bt, int ldb, int M, int N, int K, bf16_t* C, int ldc, char* lds, int bid, int nblk) {
  const int ntn = N / 128, nt = (M / 256) * ntn, nfull = (nt / nblk) * nblk;
#pragma unroll 1
  for (int tile = bid; tile < nfull; tile += nblk) gemm_plain_tile_g<8>(A, lda, Bt, ldb, K, C, ldc, (tile / ntn) * 256, (tile % ntn) * 128, lds);
#pragma unroll 1
  for (int h = bid; h < 2 * (nt - nfull); h += nblk) { const int tile = nfull + (h >> 1); gemm_plain_tile_g<4>(A, lda, Bt, ldb, K, C, ldc, (tile / ntn) * 256 + (h & 1) * 128, (tile % ntn) * 128, lds); }
}
DI void gemm_kloop32(f32x16 (&acc)[2][2], const bf16_t* const (&ap)[4], const bf16_t* const (&bp)[4], int nk, char* lds) {
  constexpr int STAGE = A_BYTES + 128 * LROW;
  const int t = TIDX, lane = t & 63, wid = t >> 6, wr = wid >> 1, wc = wid & 1, l31 = lane & 31, hh = lane >> 5;
  const int aoff = (wr * 64 + l31) * LROW + hh * 16, boff = A_BYTES + (wc * 64 + l31) * LROW + hh * 16, soff = (t >> 3) * LROW + (t & 7) * 16;
  u32x4 ra0[4], rb0[4], ra1[4], rb1[4];
  auto gload = [&](u32x4 (&ra)[4], u32x4 (&rb)[4], int kt) {
#pragma unroll
    for (int i = 0; i < 4; ++i) { ra[i] = ldg16(ap[i] + kt * 64); rb[i] = ldg16(bp[i] + kt * 64); }
  };
  auto sstore = [&](const u32x4 (&ra)[4], const u32x4 (&rb)[4], char* st) {
#pragma unroll
    for (int i = 0; i < 4; ++i) { sts16(st + soff + 32 * i * LROW, ra[i]); sts16(st + A_BYTES + soff + 32 * i * LROW, rb[i]); }
  };
  auto compute = [&](const char* cur) {
#pragma unroll
    for (int ks = 0; ks < 4; ++ks) {
      bf16x8 af[2], bfr[2];
#pragma unroll
      for (int m = 0; m < 2; ++m) af[m] = lds_frag(cur + aoff + m * 32 * LROW + ks * 32);
#pragma unroll
      for (int n = 0; n < 2; ++n) bfr[n] = lds_frag(cur + boff + n * 32 * LROW + ks * 32);
#pragma unroll
      for (int m = 0; m < 2; ++m)
#pragma unroll
        for (int n = 0; n < 2; ++n) acc[m][n] = MFMA32(bfr[n], af[m], acc[m][n]);
    }
  };
  gload(ra0, rb0, 0); gload(ra1, rb1, 1);
  sstore(ra0, rb0, lds);
  __syncthreads();
#pragma unroll 1
  for (int kt = 0; kt < nk; kt += 2) {
    if (kt + 2 < nk) gload(ra0, rb0, kt + 2);
    compute(lds);
    sstore(ra1, rb1, lds + STAGE);
    __syncthreads();
    if (kt + 3 < nk) gload(ra1, rb1, kt + 3);
    compute(lds + STAGE);
    if (kt + 2 < nk) sstore(ra0, rb0, lds);
    __syncthreads();
  }
}
DI void ph_gemm_plain32(const bf16_t* A, int lda, const bf16_t* Bt, int ldb, int M, int N, int K, bf16_t* C, int ldc, char* lds, int bid, int nblk) {
  const int t = TIDX, lane = t & 63, wid = t >> 6, wr = wid >> 1, wc = wid & 1, lr = t >> 3, lc = (t & 7) * 8, l31 = lane & 31, hh = lane >> 5;
  const int ntn = N / 128, nt = (M / 128) * ntn;
#pragma unroll 1
  for (int tile = bid; tile < nt; tile += nblk) {
    const int tm = tile / ntn, tn = tile % ntn;
    const bf16_t* ap[4]; const bf16_t* bp[4];
#pragma unroll
    for (int i = 0; i < 4; ++i) { ap[i] = A + (size_t)(tm * 128 + lr + 32 * i) * lda + lc; bp[i] = Bt + (size_t)(tn * 128 + lr + 32 * i) * ldb + lc; }
    f32x16 acc[2][2];
#pragma unroll
    for (int m = 0; m < 2; ++m)
#pragma unroll
      for (int n = 0; n < 2; ++n) acc[m][n] = (f32x16)(0.f);
    gemm_kloop32(acc, ap, bp, K / 64, lds);
#pragma unroll
    for (int m = 0; m < 2; ++m)
#pragma unroll
      for (int n = 0; n < 2; ++n)
#pragma unroll
        for (int g = 0; g < 4; ++g) {
          f32x4 o = {acc[m][n][4 * g], acc[m][n][4 * g + 1], acc[m][n][4 * g + 2], acc[m][n][4 * g + 3]};
          st_bf16x4(C + (size_t)(tm * 128 + wr * 64 + m * 32 + l31) * ldc + tn * 128 + wc * 64 + n * 32 + 8 * g + 4 * hh, o);
        }
  }
}
DI void ph_moe1(const Params& p, int need_ctx, char* lds, int bid, int nblk) {
  const int t = TIDX, lane = t & 63, wid = t >> 6, wr = wid >> 1, wc = wid & 1, lr = t >> 3, lc = (t & 7) * 8, fr = lane & 15, fq = lane >> 4;
  constexpr int NTN = FF / 64;
  const int NTM = need_ctx ? (NSLOT + 127) / 128 : (NB * CAPL) / 128;
  for (int tile = bid; tile < NE * NTM * NTN; tile += nblk) {
    const int e = tile / (NTM * NTN), rem = tile % (NTM * NTN), tm = rem / NTN, tn = rem % NTN;
    const bf16_t* ap[4]; const bf16_t* bp[4];
#pragma unroll
    for (int i = 0; i < 4; ++i) {
      const int slot = tm * 128 + lr + 32 * i;
      int r = slot < NSLOT ? p.SEL[(size_t)e * NSLOT + slot] : -1;
      ap[i] = p.H + (size_t)(r < 0 ? 0 : r) * D + lc;
      const int rho = lr + 32 * i, wci = rho >> 6, gu = (rho >> 5) & 1, col = wci * 32 + (rho & 31);
      bp[i] = (gu ? p.Wt_eu : p.Wt_eg) + ((size_t)e * FF + tn * 64 + col) * D + lc;
    }
    f32x4 acc[4][4]; acc_zero<4>(acc);
    gemm_kloop<4>(acc, ap, bp, D / 64, lds);
#pragma unroll
    for (int m = 0; m < 4; ++m) {
      const int slot = tm * 128 + wr * 64 + m * 16 + fr;
      const bool valid = slot < NSLOT && p.SEL[(size_t)e * NSLOT + (slot < NSLOT ? slot : 0)] >= 0;
#pragma unroll
      for (int n = 0; n < 2; ++n) {
        f32x4 o;
#pragma unroll
        for (int j = 0; j < 4; ++j) { const float g = acc[m][n][j], u = acc[m][n + 2][j]; o[j] = valid ? g * u * fast_rcp(1.0f + fast_exp2(-LOG2E * g)) : 0.f; }
        if (slot < NSLOT) st_bf16x4(p.HID + ((size_t)e * NSLOT + slot) * FF + tn * 64 + wc * 32 + n * 16 + 4 * fq, o);
      }
    }
  }
}
DI void ph_moe2(const Params& p, int need_ctx, char* lds, int bid, int nblk) {
  const int t = TIDX, lane = t & 63, wid = t >> 6, wr = wid >> 1, wc = wid & 1, lr = t >> 3, lc = (t & 7) * 8, fr = lane & 15, fq = lane >> 4;
  constexpr int NTN = D / 128;
  const int NTM = need_ctx ? (NSLOT + 127) / 128 : (NB * CAPL) / 128;
  for (int tile = bid; tile < NE * NTM * NTN; tile += nblk) {
    const int e = tile / (NTM * NTN), rem = tile % (NTM * NTN), tm = rem / NTN, tn = rem % NTN;
    const bf16_t* ap[4]; const bf16_t* bp[4];
#pragma unroll
    for (int i = 0; i < 4; ++i) {
      int slot = tm * 128 + lr + 32 * i; if (slot >= NSLOT) slot = NSLOT - 1;
      ap[i] = p.HID + ((size_t)e * NSLOT + slot) * FF + lc;
      bp[i] = p.Wt_ed + ((size_t)e * D + tn * 128 + lr + 32 * i) * FF + lc;
    }
    f32x4 acc[4][4]; acc_zero<4>(acc);
    gemm_kloop<4>(acc, ap, bp, FF / 64, lds);
#pragma unroll
    for (int m = 0; m < 4; ++m) {
      const int slot = tm * 128 + wr * 64 + m * 16 + fr;
      if (slot < NSLOT) {
        const float val = p.SEL[(size_t)e * NSLOT + slot] >= 0 ? p.SELV[(size_t)e * NSLOT + slot] : 0.f;
#pragma unroll
        for (int n = 0; n < 4; ++n) {
          f32x4 o = acc[m][n]; o.x *= val; o.y *= val; o.z *= val; o.w *= val;
          st_bf16x4(p.YE + ((size_t)e * NSLOT + slot) * D + tn * 128 + wc * 64 + n * 16 + 4 * fq, o);
        }
      }
    }
  }
}
constexpr int GEMM_LDS = 2 * (A_BYTES + 128 * LROW);

DI void unpack8(u32x4 v, float (&f)[8]) {
  f[0] = u2f(v.x << 16); f[1] = u2f(v.x & 0xffff0000u); f[2] = u2f(v.y << 16); f[3] = u2f(v.y & 0xffff0000u);
  f[4] = u2f(v.z << 16); f[5] = u2f(v.z & 0xffff0000u); f[6] = u2f(v.w << 16); f[7] = u2f(v.w & 0xffff0000u);
}
DI u32x4 pack8f(const float (&f)[8]) { u32x4 v; v.x = pack2bf(f[0], f[1]); v.y = pack2bf(f[2], f[3]); v.z = pack2bf(f[4], f[5]); v.w = pack2bf(f[6], f[7]); return v; }
DI void rope8(float (&a)[8], const float (&pr)[8], int cc, const float* cs, const float* sn) {
  const int ax = (cc >> 1) * 8; const bool second = cc & 1;
#pragma unroll
  for (int i = 0; i < 8; ++i) a[i] = second ? a[i] * cs[ax + i] + pr[i] * sn[ax + i] : a[i] * cs[ax + i] - pr[i] * sn[ax + i];
}
constexpr int PREP_LDS = 64 * 4 + 2 * 512 * 4 + 32 * 528;
template <int PARTS = 3>
DI void ph_prep(const Params& p, int layer, const bf16_t* QRAW, const bf16_t* KVRAW, char* lds, int bid, int nblk) {
  float* s_rstd = (float*)lds;
  float* s_cs = s_rstd + 64;
  float* s_sn = s_cs + 512;
  bf16_t* s_t = (bf16_t*)(s_sn + 512);
  const int t = TIDX;
  constexpr int UPB = TK / 32, NU = NB * UPB;
  const float* wcv = p.w_conv + (size_t)layer * 3 * 512;
#pragma unroll 1
  for (int u = bid; u < NU; u += nblk) {
    int b, s0;
    if (u < NB * (TL / 32)) { b = u / (TL / 32); s0 = TC + (u % (TL / 32)) * 32; } else { const int v = u - NB * (TL / 32); b = v / (TC / 32); s0 = (v % (TC / 32)) * 32; }
    const int r0 = row_of(b, s0);
    {
      const int tok = t >> 3, part = t & 7;
      const bf16_t* z = p.Z + (size_t)(r0 + tok) * NZP;
      float sq = 0.f, sk = 0.f, f[8];
#pragma unroll
      for (int k = 0; k < 4; ++k) { unpack8(ldg16(z + ZC_QLAT + part * 32 + k * 8), f);
#pragma unroll
        for (int i = 0; i < 8; ++i) sq += f[i] * f[i]; }
#pragma unroll
      for (int k = 0; k < 2; ++k) { unpack8(ldg16(z + ZC_KVLAT + part * 16 + k * 8), f);
#pragma unroll
        for (int i = 0; i < 8; ++i) sk += f[i] * f[i]; }
      sq = xor_sum<1>(sq); sk = xor_sum<1>(sk);
      sq = xor_sum<2>(sq); sk = xor_sum<2>(sk);
      sq = xor_sum<4>(sq); sk = xor_sum<4>(sk);
      if (part == 0) { s_rstd[tok * 2] = 1.0f / sqrtf(sq * (1.0f / 256) + 1e-6f); s_rstd[tok * 2 + 1] = 1.0f / sqrtf(sk * (1.0f / 128) + 1e-6f); }
    }
    for (int i = t; i < 512; i += NTHR) {
      const int tok = i >> 4, af = i & 15, s = s0 + tok;
      float cs = 1.f, sn = 0.f;
      if (s >= TC) rope_cs(s, (af >> 3) * 16 + (af & 7), cs, sn);
      s_cs[i] = cs; s_sn[i] = sn;
    }
    __syncthreads();
    if (PARTS & 1) {
#pragma unroll 2
    for (int i = t; i < 32 * 48; i += NTHR) {
      const int tok = i / 48, c = i % 48, h = c / 12, ch = c % 12;
      const float rq = s_rstd[tok * 2] * QS_MLA, rkv = s_rstd[tok * 2 + 1];
      const bf16_t* q = QRAW + (size_t)(r0 + tok) * 384 + h * 96;
      float a[8], pr[8];
      unpack8(ldg16(q + ch * 8), a);
      if (ch >= 8) { unpack8(ldg16(q + 64 + ((ch - 8) ^ 1) * 8), pr); rope8(a, pr, ch - 8, s_cs + tok * 16, s_sn + tok * 16); }
#pragma unroll
      for (int e = 0; e < 8; ++e) a[e] *= rq;
      *(u32x4*)(p.Qm + (((size_t)b * 4 + h) * TK + s0 + tok) * 96 + ch * 8) = pack8f(a);
      if (ch < 8) {
        unpack8(ldg16(KVRAW + (size_t)(r0 + tok) * 512 + h * 128 + ch * 8), a);
#pragma unroll
        for (int e = 0; e < 8; ++e) a[e] *= rkv;
      } else {
        const bf16_t* z = p.Z + (size_t)(r0 + tok) * NZP + ZC_KROPE;
        unpack8(ldg16(z + (ch - 8) * 8), a); unpack8(ldg16(z + ((ch - 8) ^ 1) * 8), pr);
        rope8(a, pr, ch - 8, s_cs + tok * 16, s_sn + tok * 16);
      }
      *(u32x4*)(p.Km + (((size_t)b * 4 + h) * TK + s0 + tok) * 96 + ch * 8) = pack8f(a);
    }
#pragma unroll 2
    for (int i = t; i < 32 * 64; i += NTHR) {
      const int tok = i >> 6, c = i & 63, qk = c >> 5, hm = (c >> 2) & 7, cc = c & 3;
      const bf16_t* src = p.Z + (size_t)(r0 + tok) * NZP + (qk ? ZC_DK : ZC_DQ) + hm * 32;
      float a[8], pr[8];
      unpack8(ldg16(src + cc * 8), a); unpack8(ldg16(src + (cc ^ 1) * 8), pr);
      rope8(a, pr, cc, s_cs + tok * 16, s_sn + tok * 16);
      if (qk == 0) {
#pragma unroll
        for (int e = 0; e < 8; ++e) a[e] *= QS_DIFF;
        *(u32x4*)(p.Qd + (((size_t)b * 8 + hm) * TK + s0 + tok) * 32 + cc * 8) = pack8f(a);
      } else *(u32x4*)(p.Kd + (((size_t)b * 8 + hm) * TK + s0 + tok) * 32 + cc * 8) = pack8f(a);
    }
#pragma unroll 2
    for (int i = t; i < 32 * 64; i += NTHR) {
      const int tok = i >> 6, c8 = (i & 63) * 8, s = s0 + tok;
      const bool first = (s == 0) || (s == TC), last = (s == TC - 1) || (s == TK - 1);
      const bf16_t* z = p.Z + (size_t)(r0 + tok) * NZP + ZC_MLQK + c8;
      float x0[8], xm[8], xp[8], o[8];
      unpack8(ldg16(z), x0);
      if (!first) unpack8(ldg16(z - NZP), xm);
      if (!last) unpack8(ldg16(z + NZP), xp);
      float bc8[8], w0[8], w1[8], w2[8];
      *(f32x4*)bc8 = *(const f32x4*)(p.b_conv + layer * 512 + c8); *(f32x4*)(bc8 + 4) = *(const f32x4*)(p.b_conv + layer * 512 + c8 + 4);
      *(f32x4*)w0 = *(const f32x4*)(wcv + c8); *(f32x4*)(w0 + 4) = *(const f32x4*)(wcv + c8 + 4);
      *(f32x4*)w1 = *(const f32x4*)(wcv + 512 + c8); *(f32x4*)(w1 + 4) = *(const f32x4*)(wcv + 512 + c8 + 4);
      *(f32x4*)w2 = *(const f32x4*)(wcv + 1024 + c8); *(f32x4*)(w2 + 4) = *(const f32x4*)(wcv + 1024 + c8 + 4);
#pragma unroll
      for (int e = 0; e < 8; ++e) {
        float acc = bc8[e] + x0[e] * w1[e];
        if (!first) acc += xm[e] * w0[e];
        if (!last) acc += xp[e] * w2[e];
        o[e] = acc * fast_rcp(1.0f + fast_exp2(-LOG2E * acc));
      }
      if (c8 < 256) *(u32x4*)(p.MQ + ((size_t)b * TK + s) * 256 + c8) = pack8f(o);
      else {
#pragma unroll
        for (int e = 0; e < 8; ++e) o[e] *= 0.125f;
        *(u32x4*)(p.MK + ((size_t)b * TK + s) * 256 + c8 - 256) = pack8f(o);
      }
    }
    }
#pragma unroll 1
    for (int w = 0; w < ((PARTS & 2) ? 4 : 0); ++w) {
      __syncthreads();
#pragma unroll
      for (int k = 0; k < 4; ++k) {
        const int i = t + k * NTHR, tok = i >> 5, c8 = (i & 31) * 8;
        u32x4 v;
        if (w == 0) { float a[8]; const int h = c8 >> 6; unpack8(ldg16(KVRAW + (size_t)(r0 + tok) * 512 + h * 128 + 64 + (c8 & 63)), a); const float rkv = s_rstd[tok * 2 + 1];
#pragma unroll
          for (int e = 0; e < 8; ++e) a[e] *= rkv;
          v = pack8f(a); }
        else v = ldg16(p.Z + (size_t)(r0 + tok) * NZP + (w == 1 ? ZC_DV : (w == 2 ? ZC_MLV : ZC_GV)) + c8);
        *(u32x4*)(s_t + tok * 264 + c8) = v;
      }
      __syncthreads();
      bf16_t* dst = w == 0 ? p.Vtm : (w == 1 ? p.Vtd : (w == 2 ? p.MVt : p.GVt));
#pragma unroll
      for (int k = 0; k < 4; ++k) {
        const int i = t + k * NTHR, tg = i & 3, ch = i >> 2;
        u32x4 v;
        v.x = (unsigned)s_t[(tg * 8 + 0) * 264 + ch] | ((unsigned)s_t[(tg * 8 + 1) * 264 + ch] << 16);
        v.y = (unsigned)s_t[(tg * 8 + 2) * 264 + ch] | ((unsigned)s_t[(tg * 8 + 3) * 264 + ch] << 16);
        v.z = (unsigned)s_t[(tg * 8 + 4) * 264 + ch] | ((unsigned)s_t[(tg * 8 + 5) * 264 + ch] << 16);
        v.w = (unsigned)s_t[(tg * 8 + 6) * 264 + ch] | ((unsigned)s_t[(tg * 8 + 7) * 264 + ch] << 16);
        *(u32x4*)(dst + (((size_t)b * 4 + (ch >> 6)) * 64 + (ch & 63)) * TK + s0 + tg * 8) = v;
      }
    }
    __syncthreads();
  }
}
constexpr int VROW = 136;
constexpr int VROW_A = 144;
template <int DQK> struct AttnCfg {
  static constexpr int KROW = DQK * 2 + 16;
  static constexpr int KBYTES = 64 * KROW, VBYTES = 64 * VROW_A, STAGE = KBYTES + VBYTES;
  static constexpr int KCH = 64 * DQK * 2 / 16 / NTHR;
};
DI bf16x8 pack8(const f32x16& x, int s) {
  u32x4 pk; pk.x = pack2bf(x[8 * s], x[8 * s + 1]); pk.y = pack2bf(x[8 * s + 2], x[8 * s + 3]); pk.z = pack2bf(x[8 * s + 4], x[8 * s + 5]); pk.w = pack2bf(x[8 * s + 6], x[8 * s + 7]);
  return __builtin_bit_cast(bf16x8, pk);
}
template <int DQK, int NMAP, int VAR = 0>
DI void attn_unit(const bf16_t* __restrict__ Qb, const bf16_t* __restrict__ Kb, size_t mstride, const bf16_t* __restrict__ Vt, int q0, int nkeys,
                  f32x16 (&O)[NMAP][2], float (&lsum)[NMAP], char* lds) {
  constexpr int DM = DQK / NMAP;
  constexpr int KS = DM / 16;
  using C = AttnCfg<DQK>;
  constexpr int CPM = 64 * DM * 2 / 16;
  constexpr int CPR = DM * 2 / 16;
  const int t = TIDX, lane = t & 63, wid = t >> 6, l31 = lane & 31, hh = lane >> 5;
  bf16x8 qf[NMAP][KS];
#pragma unroll
  for (int m = 0; m < NMAP; ++m)
#pragma unroll
    for (int ks = 0; ks < KS; ++ks) qf[m][ks] = *(const bf16x8*)(Qb + m * mstride + (size_t)(q0 + wid * 32 + l31) * DM + ks * 16 + 8 * hh);
  float mref[NMAP];
#pragma unroll
  for (int m = 0; m < NMAP; ++m) { mref[m] = 0.f; lsum[m] = 0.f; O[m][0] = (f32x16)(0.f); O[m][1] = (f32x16)(0.f); }
  u32x4 rk[C::KCH], rv[2];
  const bf16_t* kg[C::KCH]; int klds[C::KCH];
#pragma unroll
  for (int i = 0; i < C::KCH; ++i) { const int c = t + i * NTHR, m = c / CPM, cc = c % CPM; kg[i] = Kb + m * mstride + cc * 8; klds[i] = (cc / CPR) * C::KROW + m * DM * 2 + (cc % CPR) * 16; }
  const bf16_t* vg = Vt + (size_t)(t >> 3) * TK + (t & 7) * 8;
  const int vlds = C::KBYTES + (t >> 3) * VROW_A + ((t & 7) >> 1) * 32 + ((t & 1) ? 8 : 0);
  const int kfoff = l31 * C::KROW + 16 * hh, vfoff = C::KBYTES + l31 * VROW_A + 16 * hh;
  const int nt = nkeys / 64;
#pragma unroll
  for (int i = 0; i < C::KCH; ++i) rk[i] = ldg16(kg[i]);
  rv[0] = ldg16(vg); rv[1] = ldg16(vg + (size_t)32 * TK);
#pragma unroll 1
  for (int kt = 0; kt < nt; ++kt) {
    char* cur = lds + (kt & 1) * C::STAGE;
    if (VAR != 2) {
#pragma unroll
    for (int i = 0; i < C::KCH; ++i) sts16(cur + klds[i], rk[i]);
#pragma unroll
    for (int i = 0; i < 2; ++i) { char* d = cur + vlds + i * 32 * VROW_A; u32x2 lo, hi; lo.x = rv[i].x; lo.y = rv[i].y; hi.x = rv[i].z; hi.y = rv[i].w; *(u32x2*)d = lo; *(u32x2*)(d + 16) = hi; }
    __syncthreads();
    }
    if (VAR != 2 && kt + 1 < nt) {
#pragma unroll
      for (int i = 0; i < C::KCH; ++i) rk[i] = ldg16(kg[i] + (size_t)(kt + 1) * 64 * DM);
      rv[0] = ldg16(vg + (kt + 1) * 64); rv[1] = ldg16(vg + (size_t)32 * TK + (kt + 1) * 64);
    }
    bf16x8 kf[NMAP][2][KS];
#pragma unroll
    for (int k2 = 0; k2 < 2; ++k2)
#pragma unroll
      for (int ks = 0; ks < KS; ++ks) kf[0][k2][ks] = lds_frag(cur + kfoff + k2 * 32 * C::KROW + ks * 32);
    f32x16 S[NMAP][2];
    S[0][0] = (f32x16)(0.f); S[0][1] = (f32x16)(0.f);
#pragma unroll
    for (int ks = 0; ks < KS; ++ks)
#pragma unroll
      for (int k2 = 0; k2 < 2; ++k2) S[0][k2] = MFMA32(kf[0][k2][ks], qf[0][ks], S[0][k2]);
    bf16x8 vf[4][2];
#pragma unroll
    for (int kst = 0; kst < 4; ++kst)
#pragma unroll
      for (int dvt = 0; dvt < 2; ++dvt) vf[kst][dvt] = lds_frag(cur + vfoff + dvt * 32 * VROW_A + kst * 32);
#pragma unroll
    for (int m = 1; m < NMAP; ++m)
#pragma unroll
      for (int k2 = 0; k2 < 2; ++k2)
#pragma unroll
        for (int ks = 0; ks < KS; ++ks) kf[m][k2][ks] = lds_frag(cur + kfoff + k2 * 32 * C::KROW + m * DM * 2 + ks * 32);
#pragma unroll
    for (int m = 0; m < NMAP; ++m) {
      if (m > 0) {
        S[m][0] = (f32x16)(0.f); S[m][1] = (f32x16)(0.f);
#pragma unroll
        for (int ks = 0; ks < KS; ++ks)
#pragma unroll
          for (int k2 = 0; k2 < 2; ++k2) S[m][k2] = MFMA32(kf[m][k2][ks], qf[m][ks], S[m][k2]);
      }
      if (VAR != 1) {
      if ((kt & 7) == 0) {
        float mx = fmaxf(S[m][0][0], S[m][1][0]);
#pragma unroll
        for (int i = 1; i < 16; ++i) mx = fmaxf(mx, fmaxf(S[m][0][i], S[m][1][i]));
        mx = xor_max<32>(mx);
        const float rel = mx - mref[m];
        const float delta = (kt == 0) ? ((mx > ATT_THR || mx < -ATT_THR) ? mx : 0.0f) : (rel > ATT_THR ? rel : 0.0f);
        if (wave_any(delta != 0.0f)) {
          const float alpha = fast_exp2(-delta);
          mref[m] += delta; lsum[m] *= alpha;
#pragma unroll
          for (int dvt = 0; dvt < 2; ++dvt)
#pragma unroll
            for (int i = 0; i < 16; ++i) O[m][dvt][i] *= alpha;
        }
      }
      if (wave_any(mref[m] != 0.0f)) {
        const f32x2 nm = {-mref[m], -mref[m]};
#pragma unroll
        for (int k2 = 0; k2 < 2; ++k2)
#pragma unroll
          for (int i = 0; i < 16; i += 2) { const f32x2 x = (f32x2){S[m][k2][i], S[m][k2][i + 1]} + nm; S[m][k2][i] = x.x; S[m][k2][i + 1] = x.y; }
      }
      f32x2 ps2 = {0.f, 0.f};
#pragma unroll
      for (int k2 = 0; k2 < 2; ++k2)
#pragma unroll
        for (int i = 0; i < 16; i += 2) {
          const float e0 = fast_exp2(S[m][k2][i]), e1 = fast_exp2(S[m][k2][i + 1]);
          S[m][k2][i] = e0; S[m][k2][i + 1] = e1; ps2 += (f32x2){e0, e1};
        }
      lsum[m] += ps2.x + ps2.y;
      } else lsum[m] += 1.0f;
#pragma unroll
      for (int kst = 0; kst < 4; ++kst) {
        const bf16x8 pf = pack8(S[m][kst >> 1], kst & 1);
#pragma unroll
        for (int dvt = 0; dvt < 2; ++dvt) O[m][dvt] = MFMA32(vf[kst][dvt], pf, O[m][dvt]);
      }
    }
  }
  __syncthreads();
#pragma unroll
  for (int m = 0; m < NMAP; ++m) lsum[m] = xor_sum<32>(lsum[m]);
}
constexpr int ATT_QB = TK / 128;
constexpr int ATT_LDS = 2 * AttnCfg<96>::STAGE;
constexpr int ATT_QBL = TL / 128, ATT_QBC = TC / 128, ATT_LAT_UNITS = NB * 4 * ATT_QBL, ATT_UNITS = ATT_LAT_UNITS + NB * 4 * ATT_QBC;
DI void att_unit(int u, int& bh, int& qb) {
  if (u < ATT_LAT_UNITS) { bh = u / ATT_QBL; qb = ATT_QBC + u % ATT_QBL; } else { const int v = u - ATT_LAT_UNITS; bh = v / ATT_QBC; qb = v % ATT_QBC; }
}
DI void ph_attn_diff(const Params& p, int layer, int need_ctx, char* lds, int bid, int nblk) {
  const int lane = TIDX & 63, wid = TIDX >> 6, l31 = lane & 31, hh = lane >> 5;
  float lam_init; const float lam = lam_of(p, layer, lam_init);
#pragma unroll 1
  for (int u = bid; u < (need_ctx ? ATT_UNITS : ATT_LAT_UNITS); u += nblk) {
    int bh, qb; att_unit(u, bh, qb);
    const int b = bh >> 2, h = bh & 3, q0 = qb * 128;
    const int r = row_of(b, q0 + wid * 32 + l31);
    f32x16 O[2][2]; float ls[2];
    attn_unit<64, 2>(p.Qd + ((size_t)b * 8 + h * 2) * TK * 32, p.Kd + ((size_t)b * 8 + h * 2) * TK * 32, (size_t)TK * 32, p.Vtd + ((size_t)b * 4 + h) * 64 * TK, q0,
                     q0 < TC ? TC : TK, O, ls, lds);
    const float i0 = 1.0f / ls[0], i1 = lam / ls[1];
    float ss = 0.f;
#pragma unroll
    for (int dvt = 0; dvt < 2; ++dvt)
#pragma unroll
      for (int i = 0; i < 16; ++i) { const float o = O[0][dvt][i] * i0 - O[1][dvt][i] * i1; O[0][dvt][i] = o; ss += o * o; }
    ss = xor_sum<32>(ss);
    const float rstd = (1.0f - lam_init) / sqrtf(ss * (1.0f / 64) + 1e-6f);
    const float* gd = p.g_diff_out + layer * 256 + h * 64;
#pragma unroll
    for (int dvt = 0; dvt < 2; ++dvt)
#pragma unroll
      for (int g = 0; g < 4; ++g) {
        const int dv = dvt * 32 + 8 * g + 4 * hh;
        const f32x4 gv = *(const f32x4*)(gd + dv);
        f32x4 o = {O[0][dvt][4 * g] * rstd * gv[0], O[0][dvt][4 * g + 1] * rstd * gv[1], O[0][dvt][4 * g + 2] * rstd * gv[2], O[0][dvt][4 * g + 3] * rstd * gv[3]};
        st_bf16x4(p.Y + (size_t)r * D + 768 + h * 64 + dv, o);
      }
  }
}
DI void ph_attn_mla(const Params& p, int need_ctx, char* lds, int bid, int nblk) {
  const int lane = TIDX & 63, wid = TIDX >> 6, l31 = lane & 31, hh = lane >> 5;
#pragma unroll 1
  for (int u = bid; u < (need_ctx ? ATT_UNITS : ATT_LAT_UNITS); u += nblk) {
    int bh, qb; att_unit(u, bh, qb);
    const int b = bh >> 2, h = bh & 3, q0 = qb * 128;
    const int r = row_of(b, q0 + wid * 32 + l31);
    f32x16 O[1][2]; float ls[1];
    attn_unit<96, 1>(p.Qm + ((size_t)b * 4 + h) * TK * 96, p.Km + ((size_t)b * 4 + h) * TK * 96, 0, p.Vtm + ((size_t)b * 4 + h) * 64 * TK, q0, q0 < TC ? TC : TK, O, ls, lds);
    const float inv = 1.0f / ls[0];
#pragma unroll
    for (int dvt = 0; dvt < 2; ++dvt)
#pragma unroll
      for (int g = 0; g < 4; ++g) {
        f32x4 o = {O[0][dvt][4 * g] * inv, O[0][dvt][4 * g + 1] * inv, O[0][dvt][4 * g + 2] * inv, O[0][dvt][4 * g + 3] * inv};
        st_bf16x4(p.Y + (size_t)r * D + h * 64 + dvt * 32 + 8 * g + 4 * hh, o);
      }
  }
}
template <int VAR> DI void ph_attn_mla_probe(const Params& p, char* lds, int bid, int nblk) {
  const int lane = TIDX & 63, wid = TIDX >> 6, l31 = lane & 31, hh = lane >> 5;
#pragma unroll 1
  for (int u = bid; u < ATT_LAT_UNITS; u += nblk) {
    int bh, qb; att_unit(u, bh, qb);
    const int b = bh >> 2, h = bh & 3, q0 = qb * 128;
    const int r = row_of(b, q0 + wid * 32 + l31);
    f32x16 O[1][2]; float ls[1];
    attn_unit<96, 1, VAR>(p.Qm + ((size_t)b * 4 + h) * TK * 96, p.Km + ((size_t)b * 4 + h) * TK * 96, 0, p.Vtm + ((size_t)b * 4 + h) * 64 * TK, q0, TK, O, ls, lds);
    const float inv = 1.0f / ls[0];
#pragma unroll
    for (int dvt = 0; dvt < 2; ++dvt)
#pragma unroll
      for (int g = 0; g < 4; ++g) {
        f32x4 o = {O[0][dvt][4 * g] * inv, O[0][dvt][4 * g + 1] * inv, O[0][dvt][4 * g + 2] * inv, O[0][dvt][4 * g + 3] * inv};
        *(f32x4*)(p.out + (size_t)r * D + h * 64 + dvt * 32 + 8 * g + 4 * hh) = o;
      }
  }
}
DI void ph_attn(const Params& p, int layer, int need_ctx, char* lds, int bid, int nblk) {
  ph_attn_diff(p, layer, need_ctx, lds, bid, nblk);
  ph_attn_mla(p, need_ctx, lds, bid, nblk);
}

DI float wave_sum(float v) {
  v = xor_sum<1>(v); v = xor_sum<2>(v); v = xor_sum<4>(v); v = xor_sum<8>(v); v = xor_sum<16>(v); v = xor_sum<32>(v);
  return v;
}
DI void ld_row16(const float* row, int lane, f32x4 (&v)[4]) {
#pragma unroll
  for (int i = 0; i < 4; ++i) v[i] = *(const f32x4*)(row + 256 * i + 4 * lane);
}
DI void ld_row16_bf(const bf16_t* row, int lane, f32x4 (&v)[4]) {
#pragma unroll
  for (int i = 0; i < 4; ++i) { const u32x2 u = *(const u32x2*)(row + 256 * i + 4 * lane); v[i] = (f32x4){u2f(u.x << 16), u2f(u.x & 0xffff0000u), u2f(u.y << 16), u2f(u.y & 0xffff0000u)}; }
}
DI void ph_modulate(const Params& p, int layer, const float* xl, const float* xcx, int bid, int nblk) {
  const int lane = TIDX & 63, wid = TIDX >> 6;
  const float* g = p.g_mix_pre + layer * 1024;
  for (int r = bid * 4 + wid; r < R; r += nblk * 4) {
    const int w = r < RL ? r / TL : 2;
    const float* mb = p.mods + (size_t)(layer * 3 + w) * 6144;
    const float* x = r < RL ? xl + (size_t)r * D : xcx + (size_t)(r - RL) * D;
    f32x4 xv[4], gv[4], sc[4], sh[4];
    ld_row16(x, lane, xv); ld_row16(g, lane, gv); ld_row16(mb + 1024, lane, sc); ld_row16(mb, lane, sh);
    float ss = 0.f;
#pragma unroll
    for (int i = 0; i < 4; ++i)
#pragma unroll
      for (int e = 0; e < 4; ++e) ss += xv[i][e] * xv[i][e];
    const float rstd = 1.0f / sqrtf(wave_sum(ss) * (1.0f / D) + 1e-6f);
#pragma unroll
    for (int i = 0; i < 4; ++i) {
      f32x4 o;
#pragma unroll
      for (int e = 0; e < 4; ++e) o[e] = xv[i][e] * rstd * gv[i][e] * (1.f + sc[i][e]) + sh[i][e];
      st_bf16x4(p.H + (size_t)r * D + 256 * i + 4 * lane, o);
    }
  }
}
DI void ph_resid_mix(const Params& p, int layer, const float* xl_in, const float* xc_in, int rows, int bid, int nblk) {
  const int lane = TIDX & 63, wid = TIDX >> 6;
  const float* wr = p.w_router + (size_t)layer * D * 16;
  for (int r = bid * 4 + wid; r < rows; r += nblk * 4) {
    const int w = r < RL ? r / TL : 2;
    const float* mb = p.mods + (size_t)(layer * 3 + w) * 6144;
    const float* xin = r < RL ? xl_in + (size_t)r * D : xc_in + (size_t)(r - RL) * D;
    float* xo = r < RL ? p.out + (size_t)r * D : p.xc + (size_t)(r - RL) * D;
    f32x4 yv[4], xv[4], a[4], c[4];
    ld_row16_bf(p.YO + (size_t)r * D, lane, yv); ld_row16(xin, lane, xv);
    float ss = 0.f;
#pragma unroll
    for (int i = 0; i < 4; ++i)
#pragma unroll
      for (int e = 0; e < 4; ++e) ss += yv[i][e] * yv[i][e];
    const float rstd = 1.0f / sqrtf(wave_sum(ss) * (1.0f / D) + 1e-6f);
    ld_row16(mb + 2 * 1024, lane, a); ld_row16(p.g_mix_post + layer * 1024, lane, c);
    float s2 = 0.f;
#pragma unroll
    for (int i = 0; i < 4; ++i) {
#pragma unroll
      for (int e = 0; e < 4; ++e) { xv[i][e] += a[i][e] * yv[i][e] * rstd * c[i][e]; s2 += xv[i][e] * xv[i][e]; }
      *(f32x4*)(xo + 256 * i + 4 * lane) = xv[i];
    }
    const float rstd2 = 1.0f / sqrtf(wave_sum(s2) * (1.0f / D) + 1e-6f);
    ld_row16(p.g_ffn_pre + layer * 1024, lane, a); ld_row16(mb + 4 * 1024, lane, c); ld_row16(mb + 3 * 1024, lane, yv);
    float lg[16];
#pragma unroll
    for (int e = 0; e < 16; ++e) lg[e] = 0.f;
#pragma unroll
    for (int i = 0; i < 4; ++i) {
      f32x4 h2;
#pragma unroll
      for (int e = 0; e < 4; ++e) h2[e] = xv[i][e] * rstd2 * a[i][e] * (1.f + c[i][e]) + yv[i][e];
      st_bf16x4(p.H + (size_t)r * D + 256 * i + 4 * lane, h2);
#pragma unroll
      for (int e = 0; e < 4; ++e) {
        const float* wk = wr + (size_t)(256 * i + 4 * lane + e) * 16;
#pragma unroll
        for (int q = 0; q < 4; ++q) { const f32x4 wv = *(const f32x4*)(wk + 4 * q); lg[4 * q] += h2[e] * wv[0]; lg[4 * q + 1] += h2[e] * wv[1]; lg[4 * q + 2] += h2[e] * wv[2]; lg[4 * q + 3] += h2[e] * wv[3]; }
      }
    }
#pragma unroll
    for (int e = 0; e < 16; ++e) lg[e] = wave_sum(lg[e]);
    float mx = lg[0];
#pragma unroll
    for (int e = 1; e < 16; ++e) mx = fmaxf(mx, lg[e]);
    float sm = 0.f;
#pragma unroll
    for (int e = 0; e < 16; ++e) { lg[e] = expf(lg[e] - mx); sm += lg[e]; }
    int b, s; bs_of(r, b, s);
    float mine = 0.f;
#pragma unroll
    for (int e = 0; e < 16; ++e) mine = (lane == e) ? lg[e] / sm : mine;
    if (lane < 16) p.AFF[((size_t)b * NE + lane) * TK + s] = mine;
  }
}
DI void ph_resid_ffn(const Params& p, int layer, int rows, int bid, int nblk) {
  const int lane = TIDX & 63, wid = TIDX >> 6;
  for (int r = bid * 4 + wid; r < rows; r += nblk * 4) {
    const int w = r < RL ? r / TL : 2;
    const float* mb = p.mods + (size_t)(layer * 3 + w) * 6144;
    float* xo = r < RL ? p.out + (size_t)r * D : p.xc + (size_t)(r - RL) * D;
    const int myinv = lane < NE ? p.INV[(size_t)r * NE + lane] : -1;
    f32x4 f[4];
#pragma unroll
    for (int i = 0; i < 4; ++i) f[i] = (f32x4){0.f, 0.f, 0.f, 0.f};
    for (int e = 0; e < NE; ++e) {
      const int sl = lane_bcast(myinv, e);
      if (sl >= 0) { f32x4 yv[4]; ld_row16_bf(p.YE + ((size_t)e * NSLOT + sl) * D, lane, yv);
#pragma unroll
        for (int i = 0; i < 4; ++i) f[i] += yv[i]; }
    }
    float ss = 0.f;
#pragma unroll
    for (int i = 0; i < 4; ++i)
#pragma unroll
      for (int e = 0; e < 4; ++e) ss += f[i][e] * f[i][e];
    const float rstd = 1.0f / sqrtf(wave_sum(ss) * (1.0f / D) + 1e-6f);
    f32x4 a[4], c[4], xv[4];
    ld_row16(mb + 5 * 1024, lane, a); ld_row16(p.g_ffn_post + layer * 1024, lane, c); ld_row16(xo, lane, xv);
#pragma unroll
    for (int i = 0; i < 4; ++i) {
#pragma unroll
      for (int e = 0; e < 4; ++e) xv[i][e] += a[i][e] * f[i][e] * rstd * c[i][e];
      *(f32x4*)(xo + 256 * i + 4 * lane) = xv[i];
    }
  }
}
DI void ph_mods(const Params& p, char* lds, int bid, int nblk) {
  float* sc = (float*)lds;
  const int t = TIDX;
  for (int i = t; i < 3 * 1024; i += NTHR) { const float v = i < 2048 ? p.c[i] : p.c_ctx[i - 2048]; sc[i] = v / (1.0f + expf(-v)); }
  __syncthreads();
#pragma unroll 1
  for (long gi = (long)bid * NTHR + t; gi < 2 * 3 * 6144; gi += (long)nblk * NTHR) {
    const int col = (int)(gi % 6144), w = (int)((gi / 6144) % 3), l = (int)(gi / (3 * 6144));
    const float* W = p.w_ada + (size_t)l * 1024 * 6144 + col; const float* s = sc + w * 1024;
    float acc[8];
#pragma unroll
    for (int q = 0; q < 8; ++q) acc[q] = 0.f;
#pragma unroll 1
    for (int k = 0; k < 1024; k += 8) {
#pragma unroll
      for (int q = 0; q < 8; ++q) acc[q] += s[k + q] * W[(size_t)(k + q) * 6144];
    }
    p.mods[gi] = ((acc[0] + acc[1]) + (acc[2] + acc[3])) + ((acc[4] + acc[5]) + (acc[6] + acc[7])) + p.b_ada[l * 6144 + col];
  }
  __syncthreads();
}
constexpr int TOPK_LDS = TL * 4 + 2048;
DI int block_sum_i(int v, int* red) {
  const int lane = TIDX & 63, wid = TIDX >> 6;
  v = xor_sum_i<1>(v); v = xor_sum_i<2>(v); v = xor_sum_i<4>(v); v = xor_sum_i<8>(v); v = xor_sum_i<16>(v); v = xor_sum_i<32>(v);
  __syncthreads();
  if (lane == 0) red[wid] = v;
  __syncthreads();
  return red[0] + red[1] + red[2] + red[3];
}
DI int block_excl_scan(int v, int* red) {
  const int lane = TIDX & 63, wid = TIDX >> 6;
  int inc = v;
#pragma unroll
  for (int d = 1; d < 64; d <<= 1) { const int o = lane_up(inc, d, lane); if (lane >= d) inc += o; }
  __syncthreads();
  if (lane == 63) red[wid] = inc;
  __syncthreads();
  int base = 0;
  for (int q = 0; q < wid; ++q) base += red[q];
  return base + inc - v;
}
DI void ph_topk(const Params& p, int need_ctx, char* lds, int bid, int nblk) {
  unsigned* vals = (unsigned*)lds; int* red = (int*)(lds + TL * 4 + 1024);
  const int t = TIDX;
  for (int u = bid; u < NB * NE * 2; u += nblk) {
    const int seg = u & 1, e = (u >> 1) % NE, b = u / (2 * NE);
    const int s0 = seg ? TC : 0, n = seg ? TL : TC, cap = seg ? CAPL : CAPC, slot0 = seg ? b * CAPL : NB * CAPL + b * CAPC;
    if (seg == 0 && !need_ctx) { for (int q = t; q < cap; q += NTHR) p.SEL[(size_t)e * NSLOT + slot0 + q] = -1; continue; }
    const float* a = p.AFF + ((size_t)b * NE + e) * TK + s0;
    const int vpt = (n + NTHR - 1) / NTHR, i0 = t * vpt, i1 = (i0 + vpt < n) ? i0 + vpt : n;
    for (int i = t; i < n; i += NTHR) vals[i + i / vpt] = f2u(a[i]);
    __syncthreads();
    unsigned thr = 0;
    for (int bit = 31; bit >= 0; --bit) {
      const unsigned cand = thr | (1u << bit);
      int cnt = 0;
      for (int i = i0; i < i1; ++i) cnt += (vals[i + t] >= cand);
      if (block_sum_i(cnt, red) >= cap) thr = cand;
    }
    int cgt = 0, ceq = 0;
    for (int i = i0; i < i1; ++i) { cgt += (vals[i + t] > thr); ceq += (vals[i + t] == thr); }
    const int ngt = block_sum_i(cgt, red);
    const int neq = cap - ngt;
    int eqoff = block_excl_scan(ceq, red);
    int csel = 0;
    { int er = eqoff; for (int i = i0; i < i1; ++i) { if (vals[i + t] > thr) ++csel; else if (vals[i + t] == thr) { if (er < neq) ++csel; ++er; } } }
    int q = block_excl_scan(csel, red);
    for (int i = i0; i < i1; ++i) {
      const unsigned v = vals[i + t]; int sel = -1;
      if (v > thr) sel = q++; else if (v == thr) { if (eqoff < neq) sel = q++; ++eqoff; }
      const int r = row_of(b, s0 + i);
      if (sel >= 0) { p.SEL[(size_t)e * NSLOT + slot0 + sel] = r; p.SELV[(size_t)e * NSLOT + slot0 + sel] = u2f(v); }
      p.INV[(size_t)r * NE + e] = sel >= 0 ? slot0 + sel : -1;
    }
    __syncthreads();
  }
}
DI void ph_wt(const float* in, bf16_t* out, int K, int N, int NP, int nbatch, long in_bs, long out_bs, const float* gain, char* lds, int bid, int nblk) {
  float* tile = (float*)lds;
  const int t = TIDX, tk = K / 64, tn = NP / 64, ntile = nbatch * tk * tn;
  f32x4 v[4];
  auto gload = [&](int u) {
    const int bt = u / (tk * tn), rem = u % (tk * tn), k0 = (rem / tn) * 64, n0 = (rem % tn) * 64;
    const float* I = in + (size_t)bt * in_bs;
#pragma unroll
    for (int i = 0; i < 4; ++i) {
      const int idx = t + i * NTHR, kk = idx >> 4, n4 = (idx & 15) * 4;
      v[i] = (f32x4){0.f, 0.f, 0.f, 0.f};
      if (n0 + n4 < N) v[i] = *(const f32x4*)(I + (size_t)(k0 + kk) * N + n0 + n4);
      if (gain) { const float g = gain[k0 + kk]; v[i][0] *= g; v[i][1] *= g; v[i][2] *= g; v[i][3] *= g; }
    }
  };
  if (bid < ntile) gload(bid);
#pragma unroll 1
  for (int u = bid; u < ntile; u += nblk) {
    const int bt = u / (tk * tn), rem = u % (tk * tn), k0 = (rem / tn) * 64, n0 = (rem % tn) * 64;
    bf16_t* O = out + (size_t)bt * out_bs;
#pragma unroll
    for (int i = 0; i < 4; ++i) { const int idx = t + i * NTHR, kk = idx >> 4, n4 = (idx & 15) * 4; float* d = tile + kk * 65 + n4; d[0] = v[i][0]; d[1] = v[i][1]; d[2] = v[i][2]; d[3] = v[i][3]; }
    __syncthreads();
    if (u + nblk < ntile) gload(u + nblk);
#pragma unroll
    for (int i = 0; i < 2; ++i) {
      const int idx = t + i * NTHR, kg = idx & 7, nn = idx >> 3;
      float a[8];
#pragma unroll
      for (int e = 0; e < 8; ++e) a[e] = tile[(kg * 8 + e) * 65 + nn];
      u32x4 o; o.x = pack2bf(a[0], a[1]); o.y = pack2bf(a[2], a[3]); o.z = pack2bf(a[4], a[5]); o.w = pack2bf(a[6], a[7]);
      *(u32x4*)(O + (size_t)(n0 + nn) * K + k0 + kg * 8) = o;
    }
    __syncthreads();
  }
}
DI float wave_max(float v) {
  v = xor_max<1>(v); v = xor_max<2>(v); v = xor_max<4>(v); v = xor_max<8>(v); v = xor_max<16>(v); v = xor_max<32>(v);
  return v;
}
DI bf16x8 cvt8(const float* f) {
  const f32x4 a = *(const f32x4*)f, b = *(const f32x4*)(f + 4);
  u32x4 pk; pk.x = pack2bf(a[0], a[1]); pk.y = pack2bf(a[2], a[3]); pk.z = pack2bf(b[0], b[1]); pk.w = pack2bf(b[2], b[3]);
  return __builtin_bit_cast(bf16x8, pk);
}
constexpr int SCAN_UNITS = NB * NCK * 4, SCAN_LAT_UNITS = NB * NCL * 4;
DI void scan_unit(int u, int& b, int& c, int& h) {
  h = u & 3;
  if (u < SCAN_LAT_UNITS) { c = NCC + (u >> 2) % NCL; b = u / (4 * NCL); } else { const int v = u - SCAN_LAT_UNITS; c = (v >> 2) % NCC; b = v / (4 * NCC); }
}

DI void ph_ml_local(const Params& p, char* lds, int bid, int nblk) {
  bf16_t* sK = (bf16_t*)lds;
  float* sW = (float*)(lds + 64 * 132);
  const int t = TIDX, lane = t & 63, wid = t >> 6, l31 = lane & 31, hh = lane >> 5;
  const int d = wid & 1, vt = wid >> 1;
#pragma unroll 1
  for (int u = bid; u < SCAN_UNITS; u += nblk) {
    int b, c, h; scan_unit(u, b, c, h);
    {
      const int row = t >> 2, seg = (t & 3) * 16;
      const bf16_t* src = p.MK + ((size_t)b * TK + 64 * c + row) * 256 + h * 64 + seg;
      const u32x4 a = ldg16(src), bb = ldg16(src + 8);
      unsigned* dst = (unsigned*)((char*)sK + row * 132 + seg * 2);
      dst[0] = a.x; dst[1] = a.y; dst[2] = a.z; dst[3] = a.w; dst[4] = bb.x; dst[5] = bb.y; dst[6] = bb.z; dst[7] = bb.w;
    }
    if (t < 128) {
      const int dd = t >> 6, l = t & 63, j = step_of(dd, c), pos = dd ? 63 - l : l;
      const size_t o = (((size_t)b * 2 + dd) * TK + 64 * j) * 4 + h;
      const float bend = p.BC[o + 63 * 4], wl = bend - p.BC[o + pos * 4] + p.IGS[o + pos * 4];
      const float ml = wave_max(wl);
      sW[dd * 64 + l] = expf(wl - ml);
      if (l == 0) { const size_t uu = (((size_t)b * 2 + dd) * NCK + j) * 4 + h; p.MM[uu * 4] = ml; p.MM[uu * 4 + 1] = bend; }
    }
    __syncthreads();
    const int j = step_of(d, c);
    const size_t uu = (((size_t)b * 2 + d) * NCK + j) * 4 + h;
    f32x16 acc[2]; acc[0] = (f32x16)(0.f); acc[1] = (f32x16)(0.f);
    const bf16_t* vsrc = p.MVt + (((size_t)b * 4 + h) * 64 + vt * 32 + l31) * TK + 64 * c;
#pragma unroll
    for (int ks = 0; ks < 4; ++ks) {
      const bf16x8 a = *(const bf16x8*)(vsrc + ks * 16 + 8 * hh);
      const float* w = sW + d * 64 + ks * 16 + 8 * hh;
      u32x4 pk;
      pk.x = pack2bf(bf2f((bf16_t)a[0]) * w[0], bf2f((bf16_t)a[1]) * w[1]); pk.y = pack2bf(bf2f((bf16_t)a[2]) * w[2], bf2f((bf16_t)a[3]) * w[3]);
      pk.z = pack2bf(bf2f((bf16_t)a[4]) * w[4], bf2f((bf16_t)a[5]) * w[5]); pk.w = pack2bf(bf2f((bf16_t)a[6]) * w[6], bf2f((bf16_t)a[7]) * w[7]);
      const bf16x8 af = __builtin_bit_cast(bf16x8, pk);
#pragma unroll
      for (int kt = 0; kt < 2; ++kt) {
        bf16x8 bfr;
#pragma unroll
        for (int q = 0; q < 8; ++q) bfr[q] = (short)sK[(ks * 16 + 8 * hh + q) * 66 + kt * 32 + l31];
        acc[kt] = MFMA32(af, bfr, acc[kt]);
      }
    }
#pragma unroll
    for (int kt = 0; kt < 2; ++kt)
#pragma unroll
      for (int i = 0; i < 16; ++i) p.MC[uu * 4096 + (size_t)(vt * 32 + (i & 3) + 8 * (i >> 2) + 4 * hh) * 64 + kt * 32 + l31] = acc[kt][i];
    float nl = 0.f;
    for (int q = 0; q < 32; ++q) { const int l = hh * 32 + q; nl += sW[d * 64 + l] * bf2f(sK[l * 66 + vt * 32 + l31]); }
    nl = xor_sum<32>(nl);
    if (hh == 0) p.MN[uu * 64 + vt * 32 + l31] = nl;
    __syncthreads();
  }
}
DI void ph_ml_scan(const Params& p, int bid, int nblk) {
  for (long gi = (long)bid * NTHR + TIDX; gi < (long)NB * 2 * 4 * 4160; gi += (long)nblk * NTHR) {
    const int e = (int)(gi % 4160), ch = (int)(gi / 4160), h = ch & 3, bd = ch >> 2;
    float* base = e < 4096 ? p.MC + (((size_t)bd * NCK) * 4 + h) * 4096 + e : p.MN + (((size_t)bd * NCK) * 4 + h) * 64 + (e - 4096);
    const size_t stride = e < 4096 ? 4 * 4096 : 4 * 64;
    float* mm = p.MM + (((size_t)bd * NCK) * 4 + h) * 4;
    float st = 0.f, m = -1e30f;
    float cl[8], cm[8], cb[8], nl[8], nm[8], nb[8];
#pragma unroll
    for (int q = 0; q < 8; ++q) { cl[q] = base[(size_t)q * stride]; cm[q] = mm[q * 16]; cb[q] = mm[q * 16 + 1]; }
#pragma unroll 1
    for (int jb = 0; jb < NCK; jb += 8) {
#pragma unroll
      for (int q = 0; q < 8; ++q) { const int j = jb + 8 + q; if (j < NCK) { nl[q] = base[(size_t)j * stride]; nm[q] = mm[j * 16]; nb[q] = mm[j * 16 + 1]; } }
#pragma unroll
      for (int q = 0; q < 8; ++q) {
        const int j = jb + q;
        if (j < NCK) {
          const float mn = fmaxf(cb[q] + m, cm[q]), a = expf(cb[q] + m - mn), g = expf(cm[q] - mn);
          base[(size_t)j * stride] = st;
          st = a * st + g * cl[q];
          if (e == 0) mm[j * 16 + 2] = m;
          m = mn;
        }
      }
#pragma unroll
      for (int q = 0; q < 8; ++q) { cl[q] = nl[q]; cm[q] = nm[q]; cb[q] = nb[q]; }
    }
  }
}
DI void ph_gla_scan(const Params& p, int bid, int nblk) {
  for (long gi = (long)bid * NTHR + TIDX; gi < (long)NB * 2 * 4 * 2048; gi += (long)nblk * NTHR) {
    const int e = (int)(gi % 2048), ch = (int)(gi / 2048), h = ch & 3, bd = ch >> 2, k = e & 31;
    float* base = p.GS + (((size_t)bd * NCK) * 4 + h) * 2048 + e;
    const float* ge = p.GC + ((size_t)bd * TK + 63) * 128 + h * 32 + k;
    float st = 0.f;
    float cl[8], cg[8], nl[8], ng[8];
#pragma unroll
    for (int q = 0; q < 8; ++q) { cl[q] = base[(size_t)q * 4 * 2048]; cg[q] = ge[(size_t)q * 64 * 128]; }
#pragma unroll 1
    for (int jb = 0; jb < NCK; jb += 8) {
#pragma unroll
      for (int q = 0; q < 8; ++q) { const int j = jb + 8 + q; if (j < NCK) { nl[q] = base[(size_t)j * 4 * 2048]; ng[q] = ge[(size_t)j * 64 * 128]; } }
#pragma unroll
      for (int q = 0; q < 8; ++q) {
        const int j = jb + q;
        if (j < NCK) { base[(size_t)j * 4 * 2048] = st; st = expf(cg[q]) * st + cl[q]; }
      }
#pragma unroll
      for (int q = 0; q < 8; ++q) { cl[q] = nl[q]; cg[q] = ng[q]; }
    }
  }
}
constexpr int MO_K = 0, MO_V = 64 * 144, MO_A = MO_V + 64 * VROW, MO_PM = MO_A + 512, MO_N0 = MO_PM + 512, MO_X = MO_N0 + 512, MO_LDS = MO_X + 16384;
DI void ph_ml_out(const Params& p, int layer, int need_ctx, char* lds, int bid, int nblk) {
  float* sA = (float*)(lds + MO_A); float* sPM = (float*)(lds + MO_PM); float* sN0 = (float*)(lds + MO_N0); float* sX = (float*)(lds + MO_X);
  const int t = TIDX, lane = t & 63, wid = t >> 6, l31 = lane & 31, hh = lane >> 5;
  const int lt = wid & 1, d = wid >> 1;
#pragma unroll 1
  for (int u = bid; u < (need_ctx ? SCAN_UNITS : SCAN_LAT_UNITS); u += nblk) {
    int b, c, h; scan_unit(u, b, c, h);
    {
      const int row = t >> 2, seg = (t & 3) * 16;
      const bf16_t* ks = p.MK + ((size_t)b * TK + 64 * c + row) * 256 + h * 64 + seg;
      sts16(lds + MO_K + row * 144 + seg * 2, ldg16(ks)); sts16(lds + MO_K + row * 144 + seg * 2 + 16, ldg16(ks + 8));
      const bf16_t* vs = p.MVt + (((size_t)b * 4 + h) * 64 + row) * TK + 64 * c + seg;
      const u32x4 v0 = ldg16(vs), v1 = ldg16(vs + 8);
      u32x2* dv = (u32x2*)(lds + MO_V + row * VROW + seg * 2);
      u32x2 q; q.x = v0.x; q.y = v0.y; dv[0] = q; q.x = v0.z; q.y = v0.w; dv[1] = q; q.x = v1.x; q.y = v1.y; dv[2] = q; q.x = v1.z; q.y = v1.w; dv[3] = q;
    }
    if (t < 128) {
      const int dd = t >> 6, s = t & 63, j = step_of(dd, c), pos = dd ? 63 - s : s;
      const size_t o = (((size_t)b * 2 + dd) * TK + 64 * j) * 4 + h;
      sA[dd * 64 + s] = p.IGS[o + pos * 4] - p.BC[o + pos * 4];
      const size_t uu = (((size_t)b * 2 + dd) * NCK + j) * 4 + h;
      sN0[dd * 64 + s] = p.MN[uu * 64 + s];
    }
    __syncthreads();
    if (t < 2) {
      float m = -1e30f;
      if (t == 0) { for (int s = 0; s < 64; ++s) { m = fmaxf(m, sA[s]); sPM[s] = m; } }
      else { for (int s = 63; s >= 0; --s) { m = fmaxf(m, sA[64 + s]); sPM[64 + s] = m; } }
    }
    __syncthreads();
    const int j = step_of(d, c);
    const size_t uu = (((size_t)b * 2 + d) * NCK + j) * 4 + h;
    const int l = lt * 32 + l31, pos = d ? 63 - l : l;
    const float bl = p.BC[(((size_t)b * 2 + d) * TK + 64 * j + pos) * 4 + h];
    const float inter = bl + p.MM[uu * 4 + 2];
    const float mt = fmaxf(inter, bl + sPM[d * 64 + l]);
    const float aint = expf(inter - mt);
    bf16x8 qf[4];
#pragma unroll
    for (int ks = 0; ks < 4; ++ks) qf[ks] = *(const bf16x8*)(p.MQ + ((size_t)b * TK + 64 * c + l) * 256 + h * 64 + ks * 16 + 8 * hh);
    f32x16 num[2]; num[0] = (f32x16)(0.f); num[1] = (f32x16)(0.f);
    float den = 0.f;
#pragma unroll
    for (int st = 0; st < 2; ++st) {
      if (d == 0 ? st <= lt : st >= lt) {
        f32x16 S = (f32x16)(0.f);
#pragma unroll
        for (int ks = 0; ks < 4; ++ks) S = MFMA32(lds_frag(lds + MO_K + (st * 32 + l31) * 144 + (ks * 16 + 8 * hh) * 2), qf[ks], S);
#pragma unroll
        for (int i = 0; i < 16; ++i) {
          const int s = st * 32 + (i & 3) + 8 * (i >> 2) + 4 * hh;
          const bool ok = d == 0 ? s <= l : s >= l;
          const float e = ok ? fast_exp2((bl + sA[d * 64 + s] - mt) * LOG2E) * S[i] : 0.f;
          S[i] = e; den += e;
        }
#pragma unroll
        for (int kst = 0; kst < 2; ++kst) {
          const bf16x8 pf = pack8(S, kst);
#pragma unroll
          for (int vt = 0; vt < 2; ++vt) {
            const char* vp = lds + MO_V + (vt * 32 + l31) * VROW + (st * 32 + kst * 16 + 4 * hh) * 2;
            const s16x4 lo = *(const s16x4*)vp, hi = *(const s16x4*)(vp + 16);
            num[vt] = MFMA32(__builtin_shufflevector(lo, hi, 0, 1, 2, 3, 4, 5, 6, 7), pf, num[vt]);
          }
        }
      }
    }
    f32x16 accI[2]; accI[0] = (f32x16)(0.f); accI[1] = (f32x16)(0.f);
#pragma unroll
    for (int vt = 0; vt < 2; ++vt)
#pragma unroll
      for (int ks = 0; ks < 4; ++ks) accI[vt] = MFMA32(cvt8(p.MC + uu * 4096 + (size_t)(vt * 32 + l31) * 64 + ks * 16 + 8 * hh), qf[ks], accI[vt]);
    float qn = 0.f;
#pragma unroll
    for (int ks = 0; ks < 4; ++ks)
#pragma unroll
      for (int q = 0; q < 8; ++q) qn += bf2f((bf16_t)qf[ks][q]) * sN0[d * 64 + ks * 16 + 8 * hh + q];
    den = xor_sum<32>(den + aint * qn);
    const float inv = 1.0f / fmaxf(fabsf(den), expf(-mt));
#pragma unroll
    for (int vt = 0; vt < 2; ++vt)
#pragma unroll
      for (int i = 0; i < 16; ++i) num[vt][i] = (num[vt][i] + aint * accI[vt][i]) * inv;
    if (d == 1) {
#pragma unroll
      for (int vt = 0; vt < 2; ++vt)
#pragma unroll
        for (int i = 0; i < 16; ++i) sX[(lt * 32 + vt * 16 + i) * 64 + lane] = num[vt][i];
    }
    __syncthreads();
    if (d == 0) {
      float ss = 0.f;
#pragma unroll
      for (int vt = 0; vt < 2; ++vt)
#pragma unroll
        for (int i = 0; i < 16; ++i) { num[vt][i] += sX[(lt * 32 + vt * 16 + i) * 64 + lane]; ss += num[vt][i] * num[vt][i]; }
      ss = xor_sum<32>(ss);
      const float rstd = 1.0f / sqrtf(ss * (1.0f / 64) + 1e-6f);
      const int r = row_of(b, 64 * c + l);
#pragma unroll
      for (int vt = 0; vt < 2; ++vt)
#pragma unroll
        for (int g = 0; g < 4; ++g) {
          const int v0 = vt * 32 + 8 * g + 4 * hh;
          const u32x2 ou = *(const u32x2*)(p.Z + (size_t)r * NZP + ZC_MLO + h * 64 + v0);
          const f32x4 gv = *(const f32x4*)(p.g_mlstm_out + layer * 256 + h * 64 + v0);
          const float o0 = u2f(ou.x << 16), o1 = u2f(ou.x & 0xffff0000u), o2 = u2f(ou.y << 16), o3 = u2f(ou.y & 0xffff0000u);
          f32x4 y = {sigmoidf_(o0) * num[vt][4 * g] * rstd * gv[0], sigmoidf_(o1) * num[vt][4 * g + 1] * rstd * gv[1],
                     sigmoidf_(o2) * num[vt][4 * g + 2] * rstd * gv[2], sigmoidf_(o3) * num[vt][4 * g + 3] * rstd * gv[3]};
          st_bf16x4(p.Y + (size_t)r * D + 256 + h * 64 + v0, y);
        }
    }
    __syncthreads();
  }
}
DI void ph_gla_local(const Params& p, char* lds, int bid, int nblk) {
  bf16_t* sKd = (bf16_t*)lds;
  const int t = TIDX, lane = t & 63, wid = t >> 6, l31 = lane & 31, hh = lane >> 5;
  const int d = wid & 1, vt = wid >> 1;
#pragma unroll 1
  for (int u = bid; u < SCAN_UNITS; u += nblk) {
    int b, c, h; scan_unit(u, b, c, h);
    {
      const int dd = t >> 7, l = (t >> 1) & 63, k0 = (t & 1) * 16, j = step_of(dd, c), pos = dd ? 63 - l : l;
      const float* gcr = p.GC + (((size_t)b * 2 + dd) * TK + 64 * j + pos) * 128 + h * 32 + k0;
      const float* ger = p.GC + (((size_t)b * 2 + dd) * TK + 64 * j + 63) * 128 + h * 32 + k0;
      const bf16_t* kr = p.Z + (size_t)row_of(b, 64 * c + l) * NZP + ZC_GK + h * 32 + k0;
#pragma unroll
      for (int q = 0; q < 16; ++q) sKd[(dd * 64 + l) * 33 + k0 + q] = f2bf(bf2f(kr[q]) * fast_exp2((ger[q] - gcr[q]) * LOG2E));
    }
    __syncthreads();
    const int j = step_of(d, c);
    const size_t uu = (((size_t)b * 2 + d) * NCK + j) * 4 + h;
    f32x16 acc = (f32x16)(0.f);
    const bf16_t* vsrc = p.GVt + (((size_t)b * 4 + h) * 64 + vt * 32 + l31) * TK + 64 * c;
#pragma unroll
    for (int ks = 0; ks < 4; ++ks) {
      const bf16x8 af = *(const bf16x8*)(vsrc + ks * 16 + 8 * hh);
      bf16x8 bfr;
#pragma unroll
      for (int q = 0; q < 8; ++q) bfr[q] = (short)sKd[(d * 64 + ks * 16 + 8 * hh + q) * 33 + l31];
      acc = MFMA32(af, bfr, acc);
    }
#pragma unroll
    for (int i = 0; i < 16; ++i) p.GS[uu * 2048 + (size_t)(vt * 32 + (i & 3) + 8 * (i >> 2) + 4 * hh) * 32 + l31] = acc[i];
    __syncthreads();
  }
}
constexpr int GO_Q = 0, GO_K = 2 * 64 * 80, GO_V = 2 * GO_K, GO_X = GO_V + 64 * VROW, GO_LDS = GO_X + 16384;
DI void ph_gla_out(const Params& p, int layer, int need_ctx, char* lds, int bid, int nblk) {
  float* sX = (float*)(lds + GO_X);
  const int t = TIDX, lane = t & 63, wid = t >> 6, l31 = lane & 31, hh = lane >> 5;
  const int lt = wid & 1, d = wid >> 1;
#pragma unroll 1
  for (int u = bid; u < (need_ctx ? SCAN_UNITS : SCAN_LAT_UNITS); u += nblk) {
    int b, c, h; scan_unit(u, b, c, h);
    {
      const int dd = t >> 7, l = (t >> 1) & 63, k0 = (t & 1) * 16, j = step_of(dd, c), pos = dd ? 63 - l : l;
      const float* gcr = p.GC + (((size_t)b * 2 + dd) * TK + 64 * j + pos) * 128 + h * 32 + k0;
      const bf16_t* zr = p.Z + (size_t)row_of(b, 64 * c + l) * NZP;
      bf16_t* qd = (bf16_t*)(lds + GO_Q + (dd * 64 + l) * 80) + k0; bf16_t* kd = (bf16_t*)(lds + GO_K + (dd * 64 + l) * 80) + k0;
#pragma unroll
      for (int q = 0; q < 16; ++q) {
        const float g = gcr[q];
        qd[q] = f2bf(bf2f(zr[ZC_GQ + h * 32 + k0 + q]) * 0.17677669529663687f * fast_exp2(g * LOG2E));
        kd[q] = f2bf(bf2f(zr[ZC_GK + h * 32 + k0 + q]) * fast_exp2(-g * LOG2E));
      }
      const int row = t >> 2, seg = (t & 3) * 16;
      const bf16_t* vs = p.GVt + (((size_t)b * 4 + h) * 64 + row) * TK + 64 * c + seg;
      const u32x4 v0 = ldg16(vs), v1 = ldg16(vs + 8);
      u32x2* dv = (u32x2*)(lds + GO_V + row * VROW + seg * 2);
      u32x2 q2; q2.x = v0.x; q2.y = v0.y; dv[0] = q2; q2.x = v0.z; q2.y = v0.w; dv[1] = q2; q2.x = v1.x; q2.y = v1.y; dv[2] = q2; q2.x = v1.z; q2.y = v1.w; dv[3] = q2;
    }
    __syncthreads();
    const int j = step_of(d, c);
    const size_t uu = (((size_t)b * 2 + d) * NCK + j) * 4 + h;
    const int l = lt * 32 + l31;
    bf16x8 qf[2];
#pragma unroll
    for (int ks = 0; ks < 2; ++ks) qf[ks] = lds_frag(lds + GO_Q + (d * 64 + l) * 80 + (ks * 16 + 8 * hh) * 2);
    f32x16 O[2]; O[0] = (f32x16)(0.f); O[1] = (f32x16)(0.f);
#pragma unroll
    for (int st = 0; st < 2; ++st) {
      if (d == 0 ? st <= lt : st >= lt) {
        f32x16 S = (f32x16)(0.f);
#pragma unroll
        for (int ks = 0; ks < 2; ++ks) S = MFMA32(lds_frag(lds + GO_K + (d * 64 + st * 32 + l31) * 80 + (ks * 16 + 8 * hh) * 2), qf[ks], S);
#pragma unroll
        for (int i = 0; i < 16; ++i) {
          const int s = st * 32 + (i & 3) + 8 * (i >> 2) + 4 * hh;
          const bool ok = d == 0 ? s <= l : s >= l;
          S[i] = ok ? S[i] : 0.f;
        }
#pragma unroll
        for (int kst = 0; kst < 2; ++kst) {
          const bf16x8 pf = pack8(S, kst);
#pragma unroll
          for (int vt = 0; vt < 2; ++vt) {
            const char* vp = lds + GO_V + (vt * 32 + l31) * VROW + (st * 32 + kst * 16 + 4 * hh) * 2;
            const s16x4 lo = *(const s16x4*)vp, hi = *(const s16x4*)(vp + 16);
            O[vt] = MFMA32(__builtin_shufflevector(lo, hi, 0, 1, 2, 3, 4, 5, 6, 7), pf, O[vt]);
          }
        }
      }
    }
#pragma unroll
    for (int vt = 0; vt < 2; ++vt)
#pragma unroll
      for (int ks = 0; ks < 2; ++ks) O[vt] = MFMA32(cvt8(p.GS + uu * 2048 + (size_t)(vt * 32 + l31) * 32 + ks * 16 + 8 * hh), qf[ks], O[vt]);
    if (d == 1) {
#pragma unroll
      for (int vt = 0; vt < 2; ++vt)
#pragma unroll
        for (int i = 0; i < 16; ++i) sX[(lt * 32 + vt * 16 + i) * 64 + lane] = O[vt][i];
    }
    __syncthreads();
    if (d == 0) {
      float ss = 0.f;
#pragma unroll
      for (int vt = 0; vt < 2; ++vt)
#pragma unroll
        for (int i = 0; i < 16; ++i) { O[vt][i] += sX[(lt * 32 + vt * 16 + i) * 64 + lane]; ss += O[vt][i] * O[vt][i]; }
      ss = xor_sum<32>(ss);
      const float rstd = 1.0f / sqrtf(ss * (1.0f / 64) + 1e-6f);
      const int r = row_of(b, 64 * c + l);
#pragma unroll
      for (int vt = 0; vt < 2; ++vt)
#pragma unroll
        for (int g = 0; g < 4; ++g) {
          const int v0 = vt * 32 + 8 * g + 4 * hh;
          const u32x2 ru = *(const u32x2*)(p.Z + (size_t)r * NZP + ZC_GR + h * 64 + v0);
          const f32x4 gv = *(const f32x4*)(p.g_gla_out + layer * 256 + h * 64 + v0);
          const float r0 = u2f(ru.x << 16), r1 = u2f(ru.x & 0xffff0000u), r2 = u2f(ru.y << 16), r3 = u2f(ru.y & 0xffff0000u);
          f32x4 y = {siluf_(r0) * O[vt][4 * g] * rstd * gv[0], siluf_(r1) * O[vt][4 * g + 1] * rstd * gv[1],
                     siluf_(r2) * O[vt][4 * g + 2] * rstd * gv[2], siluf_(r3) * O[vt][4 * g + 3] * rstd * gv[3]};
          st_bf16x4(p.Y + (size_t)r * D + 512 + h * 64 + v0, y);
        }
    }
    __syncthreads();
  }
}

DI float fast_logsigmoid(float x) {
  const float e = fast_exp2(-fabsf(x) * LOG2E);
#ifdef CPU_EMU
  return fminf(x, 0.f) - log1pf(e);
#else
  return fminf(x, 0.f) - 0.6931471805599453f * __builtin_amdgcn_logf(1.0f + e);
#endif
}
DI float wave_incl_scan(float v, int lane) {
#pragma unroll
  for (int dd = 1; dd < 64; dd <<= 1) { const float o = u2f((unsigned)lane_up((int)f2u(v), dd, lane)); if (lane >= dd) v += o; }
  return v;
}
constexpr int GCUM_LDS = 4 * 64 * 33 * 4;
DI void ph_gates_cum(const Params& p, int layer, char* lds, int bid, int nblk) {
  const int t = TIDX, lane = t & 63, wid = t >> 6;
  float* stg = (float*)lds + wid * 64 * 33;
  const float* wal = p.w_alpha2 + (size_t)layer * 2 * 16 * 128;
#pragma unroll 1
  for (int u = bid * 4 + wid; u < NB * 2 * NCK; u += nblk * 4) {
    const int j = u % NCK, d = (u / NCK) & 1, b = u / (2 * NCK);
    const int pp = 64 * j + lane, s = seq_of(d, pp);
    const bf16_t* z = p.Z + (size_t)row_of(b, s) * NZP;
    const size_t ob = ((size_t)b * 2 + d) * TK + pp;
    {
      const u32x2 iu = *(const u32x2*)(z + ZC_MLIG + d * 4), fu = *(const u32x2*)(z + ZC_MLFG + d * 4);
      const float ig[4] = {u2f(iu.x << 16), u2f(iu.x & 0xffff0000u), u2f(iu.y << 16), u2f(iu.y & 0xffff0000u)};
      const float fg[4] = {u2f(fu.x << 16), u2f(fu.x & 0xffff0000u), u2f(fu.y << 16), u2f(fu.y & 0xffff0000u)};
      f32x4 oc, oi;
#pragma unroll
      for (int h = 0; h < 4; ++h) {
        oi[h] = ig[h] + p.b_igate[layer * 8 + d * 4 + h];
        oc[h] = wave_incl_scan(fast_logsigmoid(fg[h] + p.b_fgate[layer * 8 + d * 4 + h]), lane);
      }
      *(f32x4*)(p.BC + ob * 4) = oc; *(f32x4*)(p.IGS + ob * 4) = oi;
    }
    float a[16];
    { float f0[8], f1[8]; unpack8(ldg16(z + ZC_GA + d * 16), f0); unpack8(ldg16(z + ZC_GA + d * 16 + 8), f1);
#pragma unroll
      for (int q = 0; q < 8; ++q) { a[q] = f0[q]; a[8 + q] = f1[q]; } }
    const float* W = wal + (size_t)d * 16 * 128;
#pragma unroll 1
    for (int cg = 0; cg < 4; ++cg) {
#pragma unroll 4
      for (int c = 0; c < 32; ++c) {
        const int ch = cg * 32 + c;
        float zg = p.b_alpha[layer * 256 + d * 128 + ch];
#pragma unroll
        for (int q = 0; q < 16; ++q) zg += a[q] * W[q * 128 + ch];
        stg[lane * 33 + c] = wave_incl_scan(fast_logsigmoid(zg) * (1.0f / 16.0f), lane);
      }
      WAVE_SYNC();
#pragma unroll
      for (int k = 0; k < 32; ++k) { const int pos = k * 2 + (lane >> 5), c = lane & 31; p.GC[(((size_t)b * 2 + d) * TK + 64 * j + pos) * 128 + cg * 32 + c] = stg[pos * 33 + c]; }
      WAVE_SYNC();
    }
  }
}
#define XB_TMO      128
#define XB_XCNT(j)  (256  + 64 * (j))
#define XB_XSUB(j)  (1280 + 64 * (j))
#define XB_XGEN(j)  (2304 + 64 * (j))
#define XB_TOP      3328
#define XB_TOPGEN   3392
#define XCD_BAR_WORDS 3456
#define XB_SPIN_CAP (1u << 28)
#define LAS __attribute__((address_space(3)))

__device__ __forceinline__ unsigned xb_ld(unsigned* p)              { return __hip_atomic_load(p, __ATOMIC_RELAXED, __HIP_MEMORY_SCOPE_AGENT); }
__device__ __forceinline__ unsigned xb_add(unsigned* p, unsigned v) { return __hip_atomic_fetch_add(p, v, __ATOMIC_RELAXED, __HIP_MEMORY_SCOPE_AGENT); }
__device__ __forceinline__ unsigned xb_xcc_id() { return (unsigned)__builtin_amdgcn_s_getreg((3 << 11) | 20) & 0xFu; }
#define XB_SPIN(cond, bar) do { unsigned _sp = 0; while (cond) { __builtin_amdgcn_s_sleep(1); \
    if ((++_sp & 255u) == 0u) { if (xb_ld(&(bar)[XB_TMO])) break; if (_sp > XB_SPIN_CAP) { atomicAdd(&(bar)[XB_TMO], 1u); break; } } } } while (0)

struct XcdBarrier {
    unsigned* bar; unsigned x;
    volatile LAS unsigned* st;
};

__device__ __forceinline__ XcdBarrier xcd_barrier_post(unsigned* bar, volatile LAS unsigned* st) {
    XcdBarrier b; b.bar = bar; b.x = xb_xcc_id(); b.st = st;
    if (threadIdx.x == 0) (void)xb_add(&bar[XB_XCNT(b.x)], 1u);
    return b;
}
__device__ __forceinline__ void xcd_barrier_complete(unsigned* bar, unsigned x, unsigned& nloc, unsigned& nx) {
    const unsigned G = gridDim.x * gridDim.y * gridDim.z;
    unsigned sum, cnt, mine, sp = 0u;
    for (;;) {
        sum = 0u; cnt = 0u; mine = 0u;
#pragma unroll
        for (unsigned j = 0; j < 16; ++j) { const unsigned c = xb_ld(&bar[XB_XCNT(j)]); sum += c; cnt += (c > 0u) ? 1u : 0u; mine = (j == x) ? c : mine; }
        if (sum == G) break;
        __builtin_amdgcn_s_sleep(1);
        if ((++sp & 255u) == 0u) { if (xb_ld(&bar[XB_TMO])) break; if (sp > XB_SPIN_CAP) { atomicAdd(&bar[XB_TMO], 1u); break; } }
    }
    nloc = mine > 0u ? mine : 1u; nx = cnt > 0u ? cnt : 1u;
}

__device__ __forceinline__ void xcd_barrier(const XcdBarrier& b) {
    asm volatile("s_waitcnt vmcnt(0)" ::: "memory");
    __syncthreads();
    if (threadIdx.x == 0) {
        unsigned* bar = b.bar;
        __builtin_amdgcn_s_waitcnt(0);
        unsigned nloc = b.st[0], nx = b.st[1];
        if (nloc == 0u) { xcd_barrier_complete(bar, b.x, nloc, nx); b.st[0] = nloc; b.st[1] = nx; }
        const unsigned old = xb_add(&bar[XB_XSUB(b.x)], 1u);
        const unsigned gen = old / nloc;
        if (old + 1u == (gen + 1u) * nloc) {
            __builtin_amdgcn_fence(__ATOMIC_RELEASE, "agent");
            asm volatile("s_waitcnt vmcnt(0)" ::: "memory");
            const unsigned og = xb_add(&bar[XB_TOP], 1u);
            const unsigned tg = og / nx;
            if (og + 1u == (tg + 1u) * nx) xb_add(&bar[XB_TOPGEN], 1u);
            else XB_SPIN(xb_ld(&bar[XB_TOPGEN]) == tg, bar);
            __builtin_amdgcn_fence(__ATOMIC_ACQUIRE, "agent");
            xb_add(&bar[XB_XGEN(b.x)], 1u);
            asm volatile("s_waitcnt vmcnt(0)" ::: "memory");
        } else {
            XB_SPIN(xb_ld(&bar[XB_XGEN(b.x)]) == gen, bar);
            __builtin_amdgcn_fence(__ATOMIC_ACQUIRE, "agent");
            asm volatile("s_waitcnt vmcnt(0)" ::: "memory");
        }
    }
    __syncthreads();
}

#define GS_LOOP(N, CALL) for (long gi = (long)bid * NTHR + TIDX; gi < (long)(N); gi += (long)nblk * NTHR) { CALL; }
#ifndef PROBE
#define PROBE 0
#endif
#ifndef FAST_SCAN
#define FAST_SCAN 1
#endif
constexpr int N_PHASES = 16;
constexpr int MEGA_LDS = GEMM_LDS > TOPK_LDS ? GEMM_LDS : TOPK_LDS;

template <int PH>
DI void run_phase(const Params& p, int l, char* lds, int bid, int nblk) {
  const int need_ctx = (l == 0);
  const int rows = need_ctx ? R : RL;
  const float* xl_in = l == 0 ? p.x : p.out;
  const float* xc_in = l == 0 ? p.ctx : p.xc;
  bf16_t* QRAW = p.YO; bf16_t* KVRAW = p.YO + (size_t)R * 384;
  if constexpr (PH == 0) {
    ph_mods(p, lds, bid, nblk);
#pragma unroll 1
    for (int ll = 0; ll < 2; ++ll) {
      ph_wt(p.w_in + (size_t)ll * D * NZ, p.Wt_in + ll * WSZ_IN, D, NZ, NZP, 1, 0L, 0L, nullptr, lds, bid, nblk);
      ph_wt(p.w_gate + (size_t)ll * D * 4096, p.Wt_gate + ll * WSZ_GATE, D, 4096, 4096, 1, 0L, 0L, nullptr, lds, bid, nblk);
      ph_wt(p.w_branch + (size_t)ll * 4 * 256 * D, p.Wt_branch + ll * WSZ_BR, 256, D, D, 4, (long)256 * D, (long)D * 256, nullptr, lds, bid, nblk);
      ph_wt(p.w_out + (size_t)ll * D * D, p.Wt_out + ll * WSZ_OUT, D, D, D, 1, 0L, 0L, nullptr, lds, bid, nblk);
      ph_wt(p.w_uq + (size_t)ll * 256 * 384, p.Wt_uq + ll * WSZ_UQ, 256, 384, 384, 1, 0L, 0L, p.g_q_lat + ll * 256, lds, bid, nblk);
      ph_wt(p.w_ukv + (size_t)ll * 128 * 512, p.Wt_ukv + ll * WSZ_UKV, 128, 512, 512, 1, 0L, 0L, p.g_kv_lat + ll * 128, lds, bid, nblk);
    }
  } else if constexpr (PH == 1) {
    ph_modulate(p, l, xl_in, xc_in, bid, nblk);
  } else if constexpr (PH == 2) {
    ph_gemm_plain(p.H, D, p.Wt_in + l * WSZ_IN, D, R, NZP, D, p.Z, NZP, lds, bid, nblk);
#if PROBE == 5
    ph_gemm_plain(p.H, D, p.Wt_in + l * WSZ_IN, D, R, NZP, D, p.Z, NZP, lds, bid, nblk);
#endif
  } else if constexpr (PH == 3) {
    ph_mla_up(p, l, QRAW, KVRAW, lds, bid, nblk);
  } else if constexpr (PH == 4) {
    ph_prep(p, l, QRAW, KVRAW, lds, bid, nblk);
#if PROBE == 41
    ph_prep(p, l, QRAW, KVRAW, lds, bid, nblk);
#elif PROBE == 43
    ph_prep<1>(p, l, QRAW, KVRAW, lds, bid, nblk);
#elif PROBE == 44
    ph_prep<2>(p, l, QRAW, KVRAW, lds, bid, nblk);
#endif
    __syncthreads();
    ph_gates_cum(p, l, lds, bid, nblk);
#if PROBE == 42
    ph_gates_cum(p, l, lds, bid, nblk);
#endif
  } else if constexpr (PH == 5) {
#if FAST_SCAN
    ph_ml_local(p, lds, bid, nblk);
    ph_gla_local(p, lds, bid, nblk);
#else
    GS_LOOP((long)NUNIT * 4160, nvb_ml_local(gi, p));
    GS_LOOP((long)NUNIT * 2048, nvb_gla_local(gi, p));
#endif
  } else if constexpr (PH == 6) {
#if FAST_SCAN
    ph_ml_scan(p, bid, nblk);
    ph_gla_scan(p, bid, nblk);
#else
    GS_LOOP((long)NB * 2 * 4 * 4160, nvb_ml_scan(gi, p));
    GS_LOOP((long)NB * 2 * 4 * 2048, nvb_gla_scan(gi, p));
#endif
    ph_attn(p, l, need_ctx, lds, bid, nblk);
#if PROBE >= 10 && PROBE < 20
    if (l == 0) ph_attn_mla_probe<PROBE - 10>(p, lds, bid, nblk);
#elif PROBE == 1
    ph_attn_diff(p, l, need_ctx, lds, bid, nblk);
#elif PROBE == 2
    ph_attn_mla(p, need_ctx, lds, bid, nblk);
#endif
  } else if constexpr (PH == 7) {
#if FAST_SCAN
    ph_ml_out(p, l, need_ctx, lds, bid, nblk);
    ph_gla_out(p, l, need_ctx, lds, bid, nblk);
#else
    GS_LOOP((long)NUNIT * 4096, nvb_ml_out(gi, p, need_ctx));
    GS_LOOP((long)NUNIT * 4096, nvb_gla_out(gi, p, need_ctx));
#endif
  } else if constexpr (PH == 8) {
#if !FAST_SCAN
    GS_LOOP((long)R * 4, nvb_ml_finish(gi, p, l, need_ctx));
    GS_LOOP((long)R * 4, nvb_gla_finish(gi, p, l, need_ctx));
#endif
  } else if constexpr (PH == 9) {
    ph_merge(p, l, rows, lds, bid, nblk);
#if PROBE == 3
    ph_merge(p, l, rows, lds, bid, nblk);
#endif
  } else if constexpr (PH == 10) {
    ph_gemm_plain(p.MG, D, p.Wt_out + l * WSZ_OUT, D, rows, D, D, p.YO, D, lds, bid, nblk);
  } else if constexpr (PH == 11) {
    ph_resid_mix(p, l, xl_in, xc_in, rows, bid, nblk);
  } else if constexpr (PH == 12) {
    ph_topk(p, need_ctx, lds, bid, nblk);
    ph_wt(p.w_e_gate + (size_t)l * NE * D * FF, p.Wt_eg, D, FF, FF, NE, (long)D * FF, (long)FF * D, nullptr, lds, bid, nblk);
    ph_wt(p.w_e_up + (size_t)l * NE * D * FF, p.Wt_eu, D, FF, FF, NE, (long)D * FF, (long)FF * D, nullptr, lds, bid, nblk);
    ph_wt(p.w_e_down + (size_t)l * NE * FF * D, p.Wt_ed, FF, D, D, NE, (long)FF * D, (long)D * FF, nullptr, lds, bid, nblk);
  } else if constexpr (PH == 13) {
    ph_moe1(p, need_ctx, lds, bid, nblk);
#if PROBE == 4
    ph_moe1(p, need_ctx, lds, bid, nblk);
#endif
  } else if constexpr (PH == 14) {
    ph_moe2(p, need_ctx, lds, bid, nblk);
#if PROBE == 4
    ph_moe2(p, need_ctx, lds, bid, nblk);
#endif
  } else if constexpr (PH == 15) {
    ph_resid_ffn(p, l, rows, bid, nblk);
  }
}

template <int PH> __global__ void __launch_bounds__(256, 2) k_phase(Params p, int l) {
  DYN_LDS(lds);
  run_phase<PH>(p, l, lds, blockIdx.x, gridDim.x);
}

#if !defined(CPU_EMU) && !MK_MULTI
typedef const Params __attribute__((address_space(4)))* KParams;
DI KParams kp_fresh() { KParams k = (KParams)__builtin_amdgcn_kernarg_segment_ptr(); asm volatile("" : "+s"(k)); return k; }
#define PHASE(PH, L) do { asm volatile("; PHASE_MARK " #PH); KParams k_ = kp_fresh(); run_phase<PH>(*(const Params*)k_, (L), lds, bid, nblk); if (PROBE == 20 + PH || (PROBE == 99 && (PH == 4 || PH == 5))) { __syncthreads(); run_phase<PH>(*(const Params*)k_, (L), lds, bid, nblk); } XcdBarrier b_ = bar; asm volatile("" : "+s"(b_.bar), "+s"(b_.x)); xcd_barrier(b_); if (PROBE == 50) xcd_barrier(b_); } while (0)
__global__ void __launch_bounds__(256, 2) k_mega(Params pv) {
  DYN_LDS(lds_all);
  if (threadIdx.x == 0) *(uint4*)lds_all = make_uint4(0u, 0u, 0u, 0u);
  __syncthreads();
  XcdBarrier bar = xcd_barrier_post(pv.bar, (volatile LAS unsigned*)lds_all);
  char* lds = lds_all + 256;
  const int bid = blockIdx.x, nblk = gridDim.x;
  PHASE(0, 0);
#pragma unroll 1
  for (int l = 0; l < 2; ++l) {
    PHASE(1, l); PHASE(2, l); PHASE(3, l); PHASE(4, l); PHASE(5, l); PHASE(6, l); PHASE(7, l);
#if !FAST_SCAN
    PHASE(8, l);
#endif

    PHASE(9, l); PHASE(10, l); PHASE(11, l); PHASE(12, l); PHASE(13, l); PHASE(14, l); PHASE(15, l);
  }
}
#endif
#ifdef CPU_EMU
void emu_check(const Params& p, int layer, int stage);
#define EMU_CHECK(stg) emu_check(p, l, stg)
static int g_nlayers = getenv("NLAYERS") ? atoi(getenv("NLAYERS")) : 2;
#else
#define EMU_CHECK(stg)
#endif
static void fill_params(Params& p, void* const* d_in, void* d_out, void* d_ws) {
  const float** f = (const float**)&p;
  for (int i = 0; i < 33; ++i) f[i] = (const float*)d_in[i];
  p.out = (float*)d_out;
  map_workspace(p, (char*)d_ws);
}
#define LAUNCH_PHASE(PH, L) LAUNCH((k_phase<PH>), grid, 256, MEGA_LDS, stream, p, L)

extern "C" void kernel_launch(void* const* d_in, const int* in_sizes, int n_in, void* d_out, int out_size, void* d_ws,
                              size_t ws_size, hipStream_t stream) {
  Params p{};
  fill_params(p, d_in, d_out, d_ws);
  if (p.ws_need > ws_size) return;
#ifdef CPU_EMU
  const int grid = 16;
  LAUNCH_PHASE(0, 0);
  for (int l = 0; l < g_nlayers; ++l) {
    LAUNCH_PHASE(1, l); LAUNCH_PHASE(2, l); LAUNCH_PHASE(3, l); LAUNCH_PHASE(4, l); LAUNCH_PHASE(5, l); LAUNCH_PHASE(6, l); LAUNCH_PHASE(7, l); LAUNCH_PHASE(8, l);
    EMU_CHECK(1);
    LAUNCH_PHASE(9, l); LAUNCH_PHASE(10, l); LAUNCH_PHASE(11, l);
    EMU_CHECK(2);
    LAUNCH_PHASE(12, l); LAUNCH_PHASE(13, l); LAUNCH_PHASE(14, l); LAUNCH_PHASE(15, l);
    EMU_CHECK(3);
  }
#else
  static int grid = 0;
  if (grid == 0) {
    int dev = 0, cus = 0, per_cu = 0;
    (void)hipGetDevice(&dev);
    (void)hipDeviceGetAttribute(&cus, hipDeviceAttributeMultiprocessorCount, dev);
#if MK_MULTI
    (void)hipFuncSetAttribute((const void*)k_phase<0>, hipFuncAttributeMaxDynamicSharedMemorySize, MEGA_LDS);
    (void)hipFuncSetAttribute((const void*)k_phase<1>, hipFuncAttributeMaxDynamicSharedMemorySize, MEGA_LDS);
    (void)hipFuncSetAttribute((const void*)k_phase<2>, hipFuncAttributeMaxDynamicSharedMemorySize, MEGA_LDS);
    (void)hipFuncSetAttribute((const void*)k_phase<3>, hipFuncAttributeMaxDynamicSharedMemorySize, MEGA_LDS);
    (void)hipFuncSetAttribute((const void*)k_phase<4>, hipFuncAttributeMaxDynamicSharedMemorySize, MEGA_LDS);
    (void)hipFuncSetAttribute((const void*)k_phase<5>, hipFuncAttributeMaxDynamicSharedMemorySize, MEGA_LDS);
    (void)hipFuncSetAttribute((const void*)k_phase<6>, hipFuncAttributeMaxDynamicSharedMemorySize, MEGA_LDS);
    (void)hipFuncSetAttribute((const void*)k_phase<7>, hipFuncAttributeMaxDynamicSharedMemorySize, MEGA_LDS);
    (void)hipFuncSetAttribute((const void*)k_phase<8>, hipFuncAttributeMaxDynamicSharedMemorySize, MEGA_LDS);
    (void)hipFuncSetAttribute((const void*)k_phase<9>, hipFuncAttributeMaxDynamicSharedMemorySize, MEGA_LDS);
    (void)hipFuncSetAttribute((const void*)k_phase<10>, hipFuncAttributeMaxDynamicSharedMemorySize, MEGA_LDS);
    (void)hipFuncSetAttribute((const void*)k_phase<11>, hipFuncAttributeMaxDynamicSharedMemorySize, MEGA_LDS);
    (void)hipFuncSetAttribute((const void*)k_phase<12>, hipFuncAttributeMaxDynamicSharedMemorySize, MEGA_LDS);
    (void)hipFuncSetAttribute((const void*)k_phase<13>, hipFuncAttributeMaxDynamicSharedMemorySize, MEGA_LDS);
    (void)hipFuncSetAttribute((const void*)k_phase<14>, hipFuncAttributeMaxDynamicSharedMemorySize, MEGA_LDS);
    (void)hipFuncSetAttribute((const void*)k_phase<15>, hipFuncAttributeMaxDynamicSharedMemorySize, MEGA_LDS);
    grid = (cus > 0 ? cus : 256) * 2;
#else
    if (hipFuncSetAttribute((const void*)k_mega, hipFuncAttributeMaxDynamicSharedMemorySize, MEGA_LDS + 256) != hipSuccess) { grid = -1; return; }
    if (hipOccupancyMaxActiveBlocksPerMultiprocessor(&per_cu, (const void*)k_mega, 256, MEGA_LDS + 256) != hipSuccess) per_cu = 0;
    (void)hipGetLastError();
    if (per_cu < 1) { grid = -1; return; }
    grid = (cus > 0 ? cus : 256) * (per_cu < 2 ? per_cu : 2);
#endif
  }
  if (grid < 0) return;
#if MK_MULTI
  LAUNCH_PHASE(0, 0);
  for (int l = 0; l < 2; ++l) {
    LAUNCH_PHASE(1, l); LAUNCH_PHASE(2, l); LAUNCH_PHASE(3, l); LAUNCH_PHASE(4, l); LAUNCH_PHASE(5, l); LAUNCH_PHASE(6, l); LAUNCH_PHASE(7, l); LAUNCH_PHASE(8, l);
    LAUNCH_PHASE(9, l); LAUNCH_PHASE(10, l); LAUNCH_PHASE(11, l); LAUNCH_PHASE(12, l); LAUNCH_PHASE(13, l); LAUNCH_PHASE(14, l); LAUNCH_PHASE(15, l);
  }
#else
  (void)hipMemsetAsync(p.bar, 0, XCD_BAR_WORDS * sizeof(unsigned), stream);
  k_mega<<<dim3(grid), dim3(256), MEGA_LDS + 256, stream>>>(p);
#endif
#endif
}
```

```cpp
#ifndef CPU_EMU
#include <hip/hip_runtime.h>
#endif
#include <stdint.h>
#include <stddef.h>

#ifndef T_LAT
#define T_LAT 16384
#endif
#ifndef T_CTX
#define T_CTX 256
#endif

#ifndef MK_MULTI
#define MK_MULTI 0
#endif
#define DI __device__ __forceinline__
typedef unsigned short bf16_t;
typedef short bf16x8 __attribute__((ext_vector_type(8)));
typedef short s16x4 __attribute__((ext_vector_type(4)));
typedef float f32x4 __attribute__((ext_vector_type(4)));
typedef float f32x16 __attribute__((ext_vector_type(16)));
typedef unsigned u32x4 __attribute__((ext_vector_type(4)));
typedef unsigned u32x2 __attribute__((ext_vector_type(2)));
typedef float f32x2 __attribute__((ext_vector_type(2)));

#ifdef CPU_EMU
static inline float u2f(unsigned u) { float f; memcpy(&f, &u, 4); return f; }
static inline unsigned f2u(float f) { unsigned u; memcpy(&u, &f, 4); return u; }
#define MFMA32(a, b, c) emu_mfma_32x32x16((a), (b), (c))
#define MFMA16(a, b, c) emu_mfma_16x16x32((a), (b), (c))
static inline float fast_exp2(float x) { return exp2f(x); }
static inline float fast_rcp(float x) { return 1.0f / x; }
static inline float fast_rsq(float x) { return 1.0f / sqrtf(x); }
static inline float hw_sin_rev(float x) { return sinf(6.283185307179586f * x); }
static inline float hw_cos_rev(float x) { return cosf(6.283185307179586f * x); }
#define LAUNCH(kern, grid, block, lds, stream, ...) emu::launch(dim3(grid), dim3(block), (size_t)(lds), [=]() { kern(__VA_ARGS__); })
#define DYN_LDS(name) char* name = emu_dynlds()
#define SCHED_BARRIER()
#define TIDX ((int)threadIdx.x)
#define WAVE_SYNC() emu::wave_barrier()
template <int M> static inline float xor_sum(float v) { return v + __shfl_xor(v, M); }
template <int M> static inline float xor_max(float v) { return fmaxf(v, __shfl_xor(v, M)); }
template <int M> static inline int xor_sum_i(int v) { return v + __shfl_xor(v, M); }
static inline int lane_bcast(int v, int src) { return __shfl(v, src); }
static inline int lane_up(int v, int d, int lane) { (void)lane; return __shfl_up(v, d); }
#else
DI float u2f(unsigned u) { return __uint_as_float(u); }
DI unsigned f2u(float f) { return __float_as_uint(f); }
#define MFMA32(a, b, c) __builtin_amdgcn_mfma_f32_32x32x16_bf16((a), (b), (c), 0, 0, 0)
#define MFMA16(a, b, c) __builtin_amdgcn_mfma_f32_16x16x32_bf16((a), (b), (c), 0, 0, 0)
DI float fast_exp2(float x) { return __builtin_amdgcn_exp2f(x); }
DI float fast_rcp(float x) { return __builtin_amdgcn_rcpf(x); }
DI float fast_rsq(float x) { return __builtin_amdgcn_rsqf(x); }
DI float hw_sin_rev(float x) { return __builtin_amdgcn_sinf(x); }
DI float hw_cos_rev(float x) { return __builtin_amdgcn_cosf(x); }
#define LAUNCH(kern, grid, block, lds, stream, ...) kern<<<dim3(grid), dim3(block), (lds), (stream)>>>(__VA_ARGS__)
#define DYN_LDS(name) extern __shared__ __attribute__((aligned(16))) char name[]
#define SCHED_BARRIER() __builtin_amdgcn_sched_barrier(0)
DI int tid_fresh() { int t = (int)threadIdx.x; asm volatile("" : "+v"(t)); return t; }
#define TIDX tid_fresh()
#define WAVE_SYNC() __builtin_amdgcn_wave_barrier()
#ifdef USE_SHFL
template <int M> DI float xor_sum(float v) { return v + __shfl_xor(v, M); }
template <int M> DI float xor_max(float v) { return fmaxf(v, __shfl_xor(v, M)); }
template <int M> DI int xor_sum_i(int v) { return v + __shfl_xor(v, M); }
DI int lane_bcast(int v, int src) { return __shfl(v, src); }
DI int lane_up(int v, int d, int lane) { (void)lane; return __shfl_up(v, d); }
#else
template <int M> DI int xor_partner_bits(int bits) { return __builtin_amdgcn_ds_swizzle(bits, (M << 10) | 0x1f); }
DI void half_swap(unsigned& a, unsigned& b) { asm volatile("s_nop 1\n\tv_permlane32_swap_b32 %0, %1\n\ts_nop 1" : "+v"(a), "+v"(b)); }
template <int M> DI float xor_sum(float v) {
  if constexpr (M < 32) return v + __builtin_bit_cast(float, xor_partner_bits<M>(__builtin_bit_cast(int, v)));
  else { unsigned a = __builtin_bit_cast(unsigned, v), b = a; half_swap(a, b); return __builtin_bit_cast(float, a) + __builtin_bit_cast(float, b); }
}
template <int M> DI float xor_max(float v) {
  if constexpr (M < 32) return fmaxf(v, __builtin_bit_cast(float, xor_partner_bits<M>(__builtin_bit_cast(int, v))));
  else { unsigned a = __builtin_bit_cast(unsigned, v), b = a; half_swap(a, b); return fmaxf(__builtin_bit_cast(float, a), __builtin_bit_cast(float, b)); }
}
template <int M> DI int xor_sum_i(int v) {
  if constexpr (M < 32) return v + xor_partner_bits<M>(v);
  else { unsigned a = (unsigned)v, b = a; half_swap(a, b); return (int)(a + b); }
}
DI int lane_bcast(int v, int src) { return __builtin_amdgcn_readlane(v, src); }
DI int lane_up(int v, int d, int lane) { return __builtin_amdgcn_ds_bpermute(((lane - d) & 63) << 2, v); }
#endif
#endif

DI float bf2f(bf16_t v) { return u2f(((unsigned)v) << 16); }
#ifdef CPU_EMU
DI bf16_t f2bf(float f) { unsigned u = f2u(f); u += 0x7fffu + ((u >> 16) & 1u); return (bf16_t)(u >> 16); }
DI unsigned pack2bf(float lo, float hi) { return (unsigned)f2bf(lo) | ((unsigned)f2bf(hi) << 16); }
static inline bool wave_any(bool pr) { int v = pr ? 1 : 0; v |= __shfl_xor(v, 1); v |= __shfl_xor(v, 2); v |= __shfl_xor(v, 4); v |= __shfl_xor(v, 8); v |= __shfl_xor(v, 16); v |= __shfl_xor(v, 32); return v != 0; }
#else
typedef float f32x2_ __attribute__((ext_vector_type(2)));
typedef __bf16 bf16x2_hw __attribute__((ext_vector_type(2)));
DI unsigned pack2bf(float lo, float hi) { const f32x2_ v = {lo, hi}; return __builtin_bit_cast(unsigned, __builtin_convertvector(v, bf16x2_hw)); }
DI bf16_t f2bf(float f) { return (bf16_t)(pack2bf(f, f) & 0xffffu); }
DI bool wave_any(bool pr) { return __builtin_amdgcn_ballot_w64(pr) != 0ull; }
#endif
DI float sigmoidf_(float x) { return 1.0f / (1.0f + expf(-x)); }
DI float siluf_(float x) { return x / (1.0f + expf(-x)); }
DI float logsigmoidf_(float x) { return fminf(x, 0.0f) - log1pf(expf(-fabsf(x))); }

constexpr int D = 1024, NB = 2, TL = T_LAT, TC = T_CTX, TK = TL + TC;
constexpr int RL = NB * TL, RC = NB * TC, R = RL + RC;
constexpr int NZ = 3024, NZP = 3072;
constexpr int ZC_QLAT = 0, ZC_KVLAT = 256, ZC_KROPE = 384, ZC_MLQK = 416, ZC_MLV = 928, ZC_MLO = 1184, ZC_MLIG = 1440,
              ZC_MLFG = 1448, ZC_GQ = 1456, ZC_GK = 1584, ZC_GV = 1712, ZC_GR = 1968, ZC_GA = 2224, ZC_DQ = 2256,
              ZC_DK = 2512, ZC_DV = 2768;
constexpr int NCK = TK / 64, NCC = TC / 64, NCL = TL / 64;
constexpr int NE = 16, FF = 1408, CAPL = 2 * TL / 16, CAPC = 2 * TC / 16, CAPT = CAPL + CAPC, NSLOT = NB * CAPT;
constexpr size_t WSZ_IN = (size_t)NZP * D, WSZ_UQ = 384 * 256, WSZ_UKV = 512 * 128, WSZ_GATE = (size_t)4096 * D, WSZ_BR = (size_t)4 * D * 256, WSZ_OUT = (size_t)D * D;
constexpr int NUNIT = NB * 2 * NCK * 4;
constexpr float LOG2E = 1.4426950408889634f;
constexpr float QS_MLA = 0.10206207261596577f * LOG2E;
constexpr float QS_DIFF = 0.17677669529663687f * LOG2E;

DI int row_of(int b, int s) { return s < TC ? RL + b * TC + s : b * TL + (s - TC); }
DI void bs_of(int r, int& b, int& s) { if (r < RL) { b = r / TL; s = TC + (r % TL); } else { int q = r - RL; b = q / TC; s = q % TC; } }
DI int seq_of(int d, int p) { return d == 0 ? p : (p < TC ? TC - 1 - p : TK - 1 - (p - TC)); }
DI int step_of(int d, int c) { return d == 0 ? c : (c < NCC ? NCC - 1 - c : NCC + (NCK - 1 - c)); }

struct Params {
  const float *x, *c, *ctx, *c_ctx, *w_ada, *b_ada, *g_mix_pre, *g_mix_post, *g_ffn_pre, *g_ffn_post, *w_in, *g_q_lat, *w_uq,
      *g_kv_lat, *w_ukv, *w_conv, *b_conv, *b_igate, *b_fgate, *g_mlstm_out, *w_alpha2, *b_alpha, *g_gla_out, *diff_lambda,
      *g_diff_out, *w_branch, *w_gate, *b_gate, *w_out, *w_router, *w_e_gate, *w_e_up, *w_e_down;
  float* out;
  float *mods, *xc;
  bf16_t *H, *Z, *Qm, *Km, *Vtm, *Qd, *Kd, *Vtd, *MQ, *MK, *Y, *MG, *YO, *HID, *YE, *MVt, *GVt;
  float *BC, *IGS, *GC, *MC, *MN, *MM, *GS, *HD, *OD, *AFF, *SELV;
  int *SEL, *INV;
  bf16_t *Wt_in, *Wt_uq, *Wt_ukv, *Wt_gate, *Wt_branch, *Wt_out, *Wt_eg, *Wt_eu, *Wt_ed;
  unsigned* bar;
  size_t ws_need;
};

static inline size_t al256(size_t x) { return (x + 255) & ~(size_t)255; }
static inline void map_workspace(Params& p, char* ws) {
  size_t o = 0;
  auto take = [&](size_t bytes) { size_t r = o; o += al256(bytes); return ws + r; };
  p.bar = (unsigned*)take(16384);
  p.mods = (float*)take((size_t)2 * 3 * 6144 * 4);
  p.xc = (float*)take((size_t)RC * D * 4);
  p.BC = (float*)take((size_t)NB * 2 * TK * 4 * 4);
  p.IGS = (float*)take((size_t)NB * 2 * TK * 4 * 4);
  p.AFF = (float*)take((size_t)NB * NE * TK * 4);
  p.SEL = (int*)take((size_t)NE * NSLOT * 4);
  p.SELV = (float*)take((size_t)NE * NSLOT * 4);
  p.INV = (int*)take((size_t)R * NE * 4);
  p.MM = (float*)take((size_t)NUNIT * 4 * 4);
  p.MN = (float*)take((size_t)NUNIT * 64 * 4);
  p.Wt_in = (bf16_t*)take((size_t)2 * WSZ_IN * 2);
  p.Wt_uq = (bf16_t*)take((size_t)2 * WSZ_UQ * 2);
  p.Wt_ukv = (bf16_t*)take((size_t)2 * WSZ_UKV * 2);
  p.Wt_gate = (bf16_t*)take((size_t)2 * WSZ_GATE * 2);
  p.Wt_branch = (bf16_t*)take((size_t)2 * WSZ_BR * 2);
  p.Wt_out = (bf16_t*)take((size_t)2 * WSZ_OUT * 2);
  p.H = (bf16_t*)take((size_t)R * D * 2);
  size_t szA = (size_t)R * NZP * 2, szHID = (size_t)NE * NSLOT * FF * 2;
  char* A = take(szA > szHID ? szA : szHID);
  p.Z = (bf16_t*)A; p.HID = (bf16_t*)A;
  size_t szQm = al256((size_t)NB * 4 * TK * 96 * 2), szVt = al256((size_t)NB * 4 * 64 * TK * 2), szQd = al256((size_t)NB * 8 * TK * 32 * 2);
  size_t szB1 = 2 * szQm + 2 * szVt + 2 * szQd;
  size_t szHD = al256((size_t)2 * NB * TK * 256 * 4);
  size_t szYE = (size_t)NE * NSLOT * D * 2;
  size_t szB = szB1; if (2 * szHD > szB) szB = 2 * szHD; if (szYE > szB) szB = szYE;
  char* Bq = take(szB);
  p.Qm = (bf16_t*)Bq; p.Km = (bf16_t*)(Bq + szQm); p.Vtm = (bf16_t*)(Bq + 2 * szQm);
  p.Qd = (bf16_t*)(Bq + 2 * szQm + szVt); p.Kd = (bf16_t*)(Bq + 2 * szQm + szVt + szQd); p.Vtd = (bf16_t*)(Bq + 2 * szQm + szVt + 2 * szQd);
  p.YE = (bf16_t*)Bq;
  p.GC = (float*)take((size_t)NB * 2 * TK * 128 * 4);
  p.MVt = (bf16_t*)take((size_t)NB * 4 * 64 * TK * 2);
  p.GVt = (bf16_t*)take((size_t)NB * 4 * 64 * TK * 2);
  size_t szW = (size_t)NE * FF * D * 2;
  size_t szMC = (size_t)NUNIT * 4096 * 4, szRD = (size_t)R * D * 2;
  size_t szC = szMC; if (szRD > szC) szC = szRD; if (szW > szC) szC = szW;
  char* C = take(szC);
  p.MC = (float*)C; p.MG = (bf16_t*)C; p.Wt_eg = (bf16_t*)C;
  size_t szMQ = al256((size_t)NB * TK * 256 * 2), szGS = (size_t)NUNIT * 2048 * 4;
  size_t szD = 2 * szMQ + szGS; if (szW > szD) szD = szW;
  char* Dq = take(szD);
  p.MQ = (bf16_t*)Dq; p.MK = (bf16_t*)(Dq + szMQ); p.GS = (float*)(Dq + 2 * szMQ); p.Wt_eu = (bf16_t*)Dq;
  size_t szF = 2 * szRD > szW ? 2 * szRD : szW;
  char* F = take(szF);
  p.Y = (bf16_t*)F; p.YO = (bf16_t*)(F + szRD); p.Wt_ed = (bf16_t*)F;
  p.HD = (float*)Bq; p.OD = (float*)(Bq + szHD);
  p.ws_need = o;
}
#define GTID ((long)blockIdx.x * blockDim.x + threadIdx.x)

DI float lam_of(const Params& p, int layer, float& lam_init) {
  const float* lv = p.diff_lambda + layer * 128;
  float s1 = 0.f, s2 = 0.f;
  for (int i = 0; i < 32; ++i) { s1 += lv[i] * lv[32 + i]; s2 += lv[64 + i] * lv[96 + i]; }
  lam_init = layer == 0 ? 0.2f : 0.35550906759096f;
  return expf(s1) - expf(s2) + lam_init;
}
DI void rope_cs(int s, int jj, float& cs, float& sn) {
  int t = s - TC;
  int pos = (jj < 16) ? (t / 64) : (t % 64);
  float ang = (float)pos * exp2f(-1.6609640474436813f * (float)(jj & 7));
  double rev = (double)ang * 0.15915494309189535;
  rev -= floor(rev + 0.5);
  float rf = (float)rev;
  cs = hw_cos_rev(rf); sn = hw_sin_rev(rf);
}
template <class G> DI float rope_elem(G get, int s, int jj) {
  if (s < TC) return get(jj);
  float cs, sn; rope_cs(s, jj, cs, sn);
  float a = get(jj), b = get(jj ^ 8);
  return (jj & 8) ? (a * cs + b * sn) : (a * cs - b * sn);
}

DI void nvb_mods(long GI, const Params& p) {
  long i = GI; if (i >= 2 * 3 * 6144) return;
  int col = (int)(i % 6144), w = (int)((i / 6144) % 3), l = (int)(i / (3 * 6144));
  const float* cv = w < 2 ? p.c + w * 1024 : p.c_ctx;
  const float* W = p.w_ada + (size_t)l * 1024 * 6144;
  float acc = 0.f;
  for (int k = 0; k < 1024; ++k) acc += siluf_(cv[k]) * W[(size_t)k * 6144 + col];
  p.mods[i] = acc + p.b_ada[l * 6144 + col];
}
__global__ void __launch_bounds__(256) nv_wt(const float* in, bf16_t* out, int K, int N, int NP, long in_bs, long out_bs, const float* gain) {
  long i = GTID; if (i >= (long)NP * K) return;
  int k = (int)(i % K), n = (int)(i / K);
  const float* I = in + (size_t)blockIdx.y * in_bs; bf16_t* O = out + (size_t)blockIdx.y * out_bs;
  O[(size_t)n * K + k] = n < N ? f2bf(I[(size_t)k * N + n] * (gain ? gain[k] : 1.0f)) : (bf16_t)0;
}
__global__ void __launch_bounds__(256) nv_modulate(Params p, int layer, int which, const float* xl, const float* xcx, int nrows) {
  long r = GTID; if (r >= nrows) return;
  int w = r < RL ? (int)(r / TL) : 2;
  const float* mb = p.mods + (size_t)(layer * 3 + w) * 6144;
  const float* shift = mb + (which ? 3 : 0) * 1024; const float* scale = mb + (which ? 4 : 1) * 1024;
  const float* g = (which ? p.g_ffn_pre : p.g_mix_pre) + layer * 1024;
  const float* x = r < RL ? xl + (size_t)r * D : xcx + (size_t)(r - RL) * D;
  float ss = 0.f; for (int k = 0; k < D; ++k) ss += x[k] * x[k];
  float rstd = 1.0f / sqrtf(ss / D + 1e-6f);
  for (int k = 0; k < D; ++k) p.H[(size_t)r * D + k] = f2bf(x[k] * rstd * g[k] * (1.f + scale[k]) + shift[k]);
}
__global__ void __launch_bounds__(256) nv_gemm(const bf16_t* A, int lda, const bf16_t* Bt, int ldb, int M, int N, int K, bf16_t* C, int ldc) {
  long i = GTID; if (i >= (long)M * N) return;
  int n = (int)(i % N), m = (int)(i / N);
  const bf16_t* a = A + (size_t)m * lda; const bf16_t* b = Bt + (size_t)n * ldb;
  float acc = 0.f;
  for (int k = 0; k < K; ++k) acc += bf2f(a[k]) * bf2f(b[k]);
  C[(size_t)m * ldc + n] = f2bf(acc);
}
__global__ void __launch_bounds__(256) nv_mla_q(Params p, int layer) {
  long i = GTID; if (i >= (long)R * 4 * 96) return;
  int j = (int)(i % 96), h = (int)((i / 96) % 4), r = (int)(i / 384);
  int b, s; bs_of(r, b, s);
  const bf16_t* z = p.Z + (size_t)r * NZP + ZC_QLAT;
  const float* g = p.g_q_lat + layer * 256; const float* W = p.w_uq + (size_t)layer * 256 * 384;
  float ss = 0.f; for (int k = 0; k < 256; ++k) { float v = bf2f(z[k]); ss += v * v; }
  float rstd = 1.0f / sqrtf(ss / 256 + 1e-6f);
  auto dot = [&](int col) { float a = 0.f; for (int k = 0; k < 256; ++k) a += bf2f(z[k]) * rstd * g[k] * W[(size_t)k * 384 + col]; return a; };
  float v;
  if (j < 64) v = dot(h * 96 + j);
  else v = rope_elem([&](int jj) { return dot(h * 96 + 64 + jj); }, s, j - 64);
  p.Qm[(((size_t)b * 4 + h) * TK + s) * 96 + j] = f2bf(v * QS_MLA);
}
__global__ void __launch_bounds__(256) nv_mla_kv(Params p, int layer) {
  long i = GTID; if (i >= (long)R * 4 * 160) return;
  int j = (int)(i % 160), h = (int)((i / 160) % 4), r = (int)(i / 640);
  int b, s; bs_of(r, b, s);
  const bf16_t* z = p.Z + (size_t)r * NZP;
  if (j < 128) {
    const bf16_t* zl = z + ZC_KVLAT; const float* g = p.g_kv_lat + layer * 128; const float* W = p.w_ukv + (size_t)layer * 128 * 512;
    float ss = 0.f; for (int k = 0; k < 128; ++k) { float v = bf2f(zl[k]); ss += v * v; }
    float rstd = 1.0f / sqrtf(ss / 128 + 1e-6f);
    float a = 0.f; for (int k = 0; k < 128; ++k) a += bf2f(zl[k]) * rstd * g[k] * W[(size_t)k * 512 + h * 128 + j];
    if (j < 64) p.Km[(((size_t)b * 4 + h) * TK + s) * 96 + j] = f2bf(a);
    else p.Vtm[(((size_t)b * 4 + h) * 64 + (j - 64)) * TK + s] = f2bf(a);
  } else {
    int jj = j - 128;
    float v = rope_elem([&](int q) { return bf2f(z[ZC_KROPE + q]); }, s, jj);
    p.Km[(((size_t)b * 4 + h) * TK + s) * 96 + 64 + jj] = f2bf(v);
  }
}
__global__ void __launch_bounds__(256) nv_diff_prep(Params p) {
  long i = GTID; if (i >= (long)R * 768) return;
  int c = (int)(i % 768), r = (int)(i / 768);
  int b, s; bs_of(r, b, s);
  const bf16_t* z = p.Z + (size_t)r * NZP;
  if (c < 512) {
    int qk = c / 256, cc = c % 256, hm = cc / 32, jj = cc % 32;
    const bf16_t* src = z + (qk ? ZC_DK : ZC_DQ) + hm * 32;
    float v = rope_elem([&](int q) { return bf2f(src[q]); }, s, jj);
    if (qk == 0) p.Qd[(((size_t)b * 8 + hm) * TK + s) * 32 + jj] = f2bf(v * QS_DIFF);
    else p.Kd[(((size_t)b * 8 + hm) * TK + s) * 32 + jj] = f2bf(v);
  } else {
    int cc = c - 512, h = cc / 64, dv = cc % 64;
    p.Vtd[(((size_t)b * 4 + h) * 64 + dv) * TK + s] = z[ZC_DV + cc];
  }
}
__global__ void __launch_bounds__(256) nv_ml_prep(Params p, int layer) {
  long i = GTID; if (i >= (long)R * 512) return;
  int ch = (int)(i % 512), r = (int)(i / 512);
  int b, s; bs_of(r, b, s);
  bool first = (s == 0) || (s == TC), last = (s == TC - 1) || (s == TK - 1);
  const float* w = p.w_conv + (size_t)layer * 3 * 512;
  float acc = p.b_conv[layer * 512 + ch];
  acc += bf2f(p.Z[(size_t)r * NZP + ZC_MLQK + ch]) * w[512 + ch];
  if (!first) acc += bf2f(p.Z[(size_t)row_of(b, s - 1) * NZP + ZC_MLQK + ch]) * w[ch];
  if (!last) acc += bf2f(p.Z[(size_t)row_of(b, s + 1) * NZP + ZC_MLQK + ch]) * w[1024 + ch];
  float v = siluf_(acc);
  if (ch < 256) p.MQ[((size_t)b * TK + s) * 256 + ch] = f2bf(v);
  else p.MK[((size_t)b * TK + s) * 256 + ch - 256] = f2bf(v * 0.125f);
}
DI void nvb_ml_gates(long GI, const Params& p, int layer) {
  long i = GI; if (i >= (long)NB * 2 * NCK * 4) return;
  int h = (int)(i % 4), j = (int)((i / 4) % NCK), d = (int)((i / (4 * NCK)) % 2), b = (int)(i / (8 * NCK));
  float bi = p.b_igate[layer * 8 + d * 4 + h], bfg = p.b_fgate[layer * 8 + d * 4 + h];
  float cum = 0.f;
  for (int l = 0; l < 64; ++l) {
    int pp = 64 * j + l, s = seq_of(d, pp); const bf16_t* z = p.Z + (size_t)row_of(b, s) * NZP;
    float ig = bf2f(z[ZC_MLIG + d * 4 + h]) + bi;
    float lf = logsigmoidf_(bf2f(z[ZC_MLFG + d * 4 + h]) + bfg);
    cum += lf;
    size_t o = (((size_t)b * 2 + d) * TK + pp) * 4 + h;
    p.BC[o] = cum; p.IGS[o] = ig;
  }
}
DI void nvb_gla_cum(long GI, const Params& p, int layer) {
  long i = GI; if (i >= (long)NB * 2 * NCK * 128) return;
  int ch = (int)(i % 128), j = (int)((i / 128) % NCK), d = (int)((i / (128 * NCK)) % 2), b = (int)(i / (256 * NCK));
  const float* W = p.w_alpha2 + (size_t)layer * 2 * 16 * 128 + (size_t)d * 16 * 128;
  float ba = p.b_alpha[layer * 256 + d * 128 + ch];
  float cum = 0.f;
  for (int l = 0; l < 64; ++l) {
    int pp = 64 * j + l, s = seq_of(d, pp); const bf16_t* z = p.Z + (size_t)row_of(b, s) * NZP + ZC_GA + d * 16;
    float zg = ba; for (int q = 0; q < 16; ++q) zg += bf2f(z[q]) * W[q * 128 + ch];
    cum += logsigmoidf_(zg) * (1.0f / 16.0f);
    p.GC[(((size_t)b * 2 + d) * TK + pp) * 128 + ch] = cum;
  }
}
__global__ void __launch_bounds__(256) nv_attn_mla(Params p, int need_ctx) {
  long i = GTID; if (i >= (long)NB * 4 * TK) return;
  int s = (int)(i % TK), h = (int)((i / TK) % 4), b = (int)(i / (4 * TK));
  if (s < TC && !need_ctx) return;
  int nk = s < TC ? TC : TK;
  const bf16_t* q = p.Qm + (((size_t)b * 4 + h) * TK + s) * 96;
  const bf16_t* K = p.Km + ((size_t)b * 4 + h) * TK * 96;
  const bf16_t* Vt = p.Vtm + ((size_t)b * 4 + h) * 64 * TK;
  float qf[96], o[64];
  _Pragma("unroll") for (int k = 0; k < 96; ++k) qf[k] = bf2f(q[k]);
  _Pragma("unroll") for (int k = 0; k < 64; ++k) o[k] = 0.f;
  float m = -1e30f, l = 0.f;
  for (int t = 0; t < nk; ++t) {
    float sc = 0.f; _Pragma("unroll") for (int k = 0; k < 96; ++k) sc += qf[k] * bf2f(K[(size_t)t * 96 + k]);
    float mn = fmaxf(m, sc), a = exp2f(m - mn), pr = exp2f(sc - mn);
    l = l * a + pr;
    _Pragma("unroll") for (int k = 0; k < 64; ++k) o[k] = o[k] * a + pr * bf2f(Vt[(size_t)k * TK + t]);
    m = mn;
  }
  int r = row_of(b, s);
  _Pragma("unroll") for (int k = 0; k < 64; ++k) p.Y[(size_t)r * D + h * 64 + k] = f2bf(o[k] / l);
}
__global__ void __launch_bounds__(256) nv_attn_diff(Params p, int layer, int need_ctx) {
  long i = GTID; if (i >= (long)NB * 4 * TK) return;
  int s = (int)(i % TK), h = (int)((i / TK) % 4), b = (int)(i / (4 * TK));
  if (s < TC && !need_ctx) return;
  int nk = s < TC ? TC : TK;
  float lam_init; float lam = lam_of(p, layer, lam_init);
  const bf16_t* Vt = p.Vtd + ((size_t)b * 4 + h) * 64 * TK;
  float res[64];
  _Pragma("unroll") for (int k = 0; k < 64; ++k) res[k] = 0.f;
  _Pragma("unroll") for (int mp = 0; mp < 2; ++mp) {
    const bf16_t* q = p.Qd + (((size_t)b * 8 + h * 2 + mp) * TK + s) * 32;
    const bf16_t* K = p.Kd + ((size_t)b * 8 + h * 2 + mp) * TK * 32;
    float qf[32], o[64];
    _Pragma("unroll") for (int k = 0; k < 32; ++k) qf[k] = bf2f(q[k]);
    _Pragma("unroll") for (int k = 0; k < 64; ++k) o[k] = 0.f;
    float m = -1e30f, l = 0.f;
    for (int t = 0; t < nk; ++t) {
      float sc = 0.f; _Pragma("unroll") for (int k = 0; k < 32; ++k) sc += qf[k] * bf2f(K[(size_t)t * 32 + k]);
      float mn = fmaxf(m, sc), a = exp2f(m - mn), pr = exp2f(sc - mn);
      l = l * a + pr;
      _Pragma("unroll") for (int k = 0; k < 64; ++k) o[k] = o[k] * a + pr * bf2f(Vt[(size_t)k * TK + t]);
      m = mn;
    }
    float wgt = mp == 0 ? 1.f : -lam;
    _Pragma("unroll") for (int k = 0; k < 64; ++k) res[k] += wgt * o[k] / l;
  }
  float ss = 0.f; _Pragma("unroll") for (int k = 0; k < 64; ++k) ss += res[k] * res[k];
  float rstd = 1.0f / sqrtf(ss / 64 + 1e-6f);
  int r = row_of(b, s);
  _Pragma("unroll") for (int k = 0; k < 64; ++k) p.Y[(size_t)r * D + 768 + h * 64 + k] = f2bf(res[k] * rstd * p.g_diff_out[layer * 256 + h * 64 + k] * (1.f - lam_init));
}
DI void nvb_ml_local(long GI, const Params& p) {
  long i = GI; if (i >= (long)NUNIT * 4160) return;
  int e = (int)(i % 4160); long u = i / 4160;
  int h = (int)(u % 4), j = (int)((u / 4) % NCK), d = (int)((u / (4 * NCK)) % 2), b = (int)(u / (8 * NCK));
  const float* bc = p.BC + (((size_t)b * 2 + d) * TK + 64 * j) * 4 + h; const float* ig = p.IGS + (((size_t)b * 2 + d) * TK + 64 * j) * 4 + h;
  float bend = bc[63 * 4], ml = -1e30f;
  for (int l = 0; l < 64; ++l) ml = fmaxf(ml, bend - bc[l * 4] + ig[l * 4]);
  if (e == 4096 + 0) { p.MM[u * 4 + 0] = ml; p.MM[u * 4 + 1] = bend; }
  float acc = 0.f;
  if (e < 4096) {
    int v = e / 64, k = e % 64;
    for (int l = 0; l < 64; ++l) {
      int s = seq_of(d, 64 * j + l); float w = expf(bend - bc[l * 4] + ig[l * 4] - ml);
      acc += w * bf2f(p.Z[(size_t)row_of(b, s) * NZP + ZC_MLV + h * 64 + v]) * bf2f(p.MK[((size_t)b * TK + s) * 256 + h * 64 + k]);
    }
    p.MC[(size_t)u * 4096 + e] = acc;
  } else {
    int k = e - 4096;
    for (int l = 0; l < 64; ++l) {
      int s = seq_of(d, 64 * j + l); float w = expf(bend - bc[l * 4] + ig[l * 4] - ml);
      acc += w * bf2f(p.MK[((size_t)b * TK + s) * 256 + h * 64 + k]);
    }
    p.MN[(size_t)u * 64 + k] = acc;
  }
}
DI void nvb_ml_scan(long GI, const Params& p) {
  long i = GI; if (i >= (long)NB * 2 * 4 * 4160) return;
  int e = (int)(i % 4160); int ch = (int)(i / 4160); int h = ch % 4, bd = ch / 4;
  float st = 0.f, m = -1e30f;
  for (int j = 0; j < NCK; ++j) {
    size_t u = ((size_t)bd * NCK + j) * 4 + h;
    float ml = p.MM[u * 4 + 0], be = p.MM[u * 4 + 1];
    float mn = fmaxf(be + m, ml), a = expf(be + m - mn), g = expf(ml - mn);
    float* slot = e < 4096 ? &p.MC[u * 4096 + e] : &p.MN[u * 64 + (e - 4096)];
    float loc = *slot; *slot = st; st = a * st + g * loc;
    if (e == 0) p.MM[u * 4 + 2] = m;
    m = mn;
  }
}
DI void nvb_ml_out(long GI, const Params& p, int need_ctx) {
  long i = GI; if (i >= (long)NUNIT * 4096) return;
  int v = (int)(i % 64), l = (int)((i / 64) % 64); long u = i / 4096;
  int h = (int)(u % 4), j = (int)((u / 4) % NCK), d = (int)((u / (4 * NCK)) % 2), b = (int)(u / (8 * NCK));
  if (j < NCC && !need_ctx) return;
  const float* bc = p.BC + (((size_t)b * 2 + d) * TK + 64 * j) * 4 + h; const float* ig = p.IGS + (((size_t)b * 2 + d) * TK + 64 * j) * 4 + h;
  float m0 = p.MM[u * 4 + 2];
  int sl = seq_of(d, 64 * j + l);
  const bf16_t* q = p.MQ + ((size_t)b * TK + sl) * 256 + h * 64;
  float bl = bc[l * 4];
  float inter = bl + m0, mt = inter;
  for (int t = 0; t <= l; ++t) mt = fmaxf(mt, bl - bc[t * 4] + ig[t * 4]);
  float num = 0.f, den = 0.f;
  for (int t = 0; t <= l; ++t) {
    int st = seq_of(d, 64 * j + t);
    const bf16_t* k = p.MK + ((size_t)b * TK + st) * 256 + h * 64;
    float qk = 0.f; for (int c = 0; c < 64; ++c) qk += bf2f(q[c]) * bf2f(k[c]);
    float sv = expf(bl - bc[t * 4] + ig[t * 4] - mt) * qk;
    num += sv * bf2f(p.Z[(size_t)row_of(b, st) * NZP + ZC_MLV + h * 64 + v]); den += sv;
  }
  float ai = expf(inter - mt);
  float qc = 0.f, qn = 0.f;
  for (int c = 0; c < 64; ++c) { qc += bf2f(q[c]) * p.MC[(size_t)u * 4096 + v * 64 + c]; qn += bf2f(q[c]) * p.MN[(size_t)u * 64 + c]; }
  num += ai * qc; den += ai * qn;
  p.HD[(((size_t)d * NB + b) * TK + sl) * 256 + h * 64 + v] = num / fmaxf(fabsf(den), expf(-mt));
}
DI void nvb_ml_finish(long GI, const Params& p, int layer, int need_ctx) {
  long i = GI; if (i >= (long)R * 4) return;
  int h = (int)(i % 4), r = (int)(i / 4); int b, s; bs_of(r, b, s);
  if (s < TC && !need_ctx) return;
  const float* h0 = p.HD + (((size_t)0 * NB + b) * TK + s) * 256 + h * 64; const float* h1 = p.HD + (((size_t)1 * NB + b) * TK + s) * 256 + h * 64;
  float ss = 0.f; for (int v = 0; v < 64; ++v) { float t = h0[v] + h1[v]; ss += t * t; }
  float rstd = 1.0f / sqrtf(ss / 64 + 1e-6f);
  for (int v = 0; v < 64; ++v) {
    float o = bf2f(p.Z[(size_t)r * NZP + ZC_MLO + h * 64 + v]);
    p.Y[(size_t)r * D + 256 + h * 64 + v] = f2bf(sigmoidf_(o) * (h0[v] + h1[v]) * rstd * p.g_mlstm_out[layer * 256 + h * 64 + v]);
  }
}
DI void nvb_gla_local(long GI, const Params& p) {
  long i = GI; if (i >= (long)NUNIT * 2048) return;
  int v = (int)(i % 64), k = (int)((i / 64) % 32); long u = i / 2048;
  int h = (int)(u % 4), j = (int)((u / 4) % NCK), d = (int)((u / (4 * NCK)) % 2), b = (int)(u / (8 * NCK));
  const float* gc = p.GC + (((size_t)b * 2 + d) * TK + 64 * j) * 128 + h * 32 + k;
  float ge = gc[63 * 128], acc = 0.f;
  for (int l = 0; l < 64; ++l) {
    int s = seq_of(d, 64 * j + l); const bf16_t* z = p.Z + (size_t)row_of(b, s) * NZP;
    acc += bf2f(z[ZC_GK + h * 32 + k]) * expf(ge - gc[l * 128]) * bf2f(z[ZC_GV + h * 64 + v]);
  }
  p.GS[(size_t)u * 2048 + v * 32 + k] = acc;
}
DI void nvb_gla_scan(long GI, const Params& p) {
  long i = GI; if (i >= (long)NB * 2 * 4 * 2048) return;
  int e = (int)(i % 2048); int ch = (int)(i / 2048); int h = ch % 4, bd = ch / 4; int k = e % 32;
  float st = 0.f;
  for (int j = 0; j < NCK; ++j) {
    size_t u = ((size_t)bd * NCK + j) * 4 + h;
    float ge = p.GC[((size_t)bd * TK + 64 * j + 63) * 128 + h * 32 + k];
    float loc = p.GS[u * 2048 + e]; p.GS[u * 2048 + e] = st; st = expf(ge) * st + loc;
  }
}
DI void nvb_gla_out(long GI, const Params& p, int need_ctx) {
  long i = GI; if (i >= (long)NUNIT * 4096) return;
  int v = (int)(i % 64), l = (int)((i / 64) % 64); long u = i / 4096;
  int h = (int)(u % 4), j = (int)((u / 4) % NCK), d = (int)((u / (4 * NCK)) % 2), b = (int)(u / (8 * NCK));
  if (j < NCC && !need_ctx) return;
  const float* gc = p.GC + (((size_t)b * 2 + d) * TK + 64 * j) * 128 + h * 32;
  int sl = seq_of(d, 64 * j + l);
  const bf16_t* q = p.Z + (size_t)row_of(b, sl) * NZP + ZC_GQ + h * 32;
  const float qs = 0.17677669529663687f;
  float acc = 0.f;
  for (int t = 0; t <= l; ++t) {
    int st = seq_of(d, 64 * j + t); const bf16_t* z = p.Z + (size_t)row_of(b, st) * NZP;
    float att = 0.f; for (int k = 0; k < 32; ++k) att += bf2f(q[k]) * qs * expf(gc[l * 128 + k] - gc[t * 128 + k]) * bf2f(z[ZC_GK + h * 32 + k]);
    acc += att * bf2f(z[ZC_GV + h * 64 + v]);
  }
  for (int k = 0; k < 32; ++k) acc += bf2f(q[k]) * qs * expf(gc[l * 128 + k]) * p.GS[(size_t)u * 2048 + v * 32 + k];
  p.OD[(((size_t)d * NB + b) * TK + sl) * 256 + h * 64 + v] = acc;
}
DI void nvb_gla_finish(long GI, const Params& p, int layer, int need_ctx) {
  long i = GI; if (i >= (long)R * 4) return;
  int h = (int)(i % 4), r = (int)(i / 4); int b, s; bs_of(r, b, s);
  if (s < TC && !need_ctx) return;
  const float* h0 = p.OD + (((size_t)0 * NB + b) * TK + s) * 256 + h * 64; const float* h1 = p.OD + (((size_t)1 * NB + b) * TK + s) * 256 + h * 64;
  float ss = 0.f; for (int v = 0; v < 64; ++v) { float t = h0[v] + h1[v]; ss += t * t; }
  float rstd = 1.0f / sqrtf(ss / 64 + 1e-6f);
  for (int v = 0; v < 64; ++v) {
    float rr = bf2f(p.Z[(size_t)r * NZP + ZC_GR + h * 64 + v]);
    p.Y[(size_t)r * D + 512 + h * 64 + v] = f2bf(siluf_(rr) * (h0[v] + h1[v]) * rstd * p.g_gla_out[layer * 256 + h * 64 + v]);
  }
}
__global__ void __launch_bounds__(256) nv_merge(Params p, int layer, int nrows) {
  long i = GTID; if (i >= (long)nrows * D) return;
  int j = (int)(i % D), r = (int)(i / D);
  float acc = 0.f;
  for (int n = 0; n < 4; ++n) {
    const bf16_t* wg = p.Wt_gate + (size_t)(n * 1024 + j) * D; const bf16_t* wb = p.Wt_branch + ((size_t)n * D + j) * 256;
    float g = p.b_gate[layer * 4096 + n * 1024 + j], pr = 0.f;
    for (int k = 0; k < D; ++k) g += bf2f(p.H[(size_t)r * D + k]) * bf2f(wg[k]);
    for (int k = 0; k < 256; ++k) pr += bf2f(p.Y[(size_t)r * D + n * 256 + k]) * bf2f(wb[k]);
    acc += sigmoidf_(g) * pr;
  }
  p.MG[(size_t)r * D + j] = f2bf(acc);
}
__global__ void __launch_bounds__(256) nv_resid_mix(Params p, int layer, const float* xl_in, const float* xc_in, int nrows) {
  long r = GTID; if (r >= nrows) return;
  int w = r < RL ? (int)(r / TL) : 2;
  const float* mb = p.mods + (size_t)(layer * 3 + w) * 6144;
  const float* xin = r < RL ? xl_in + (size_t)r * D : xc_in + (size_t)(r - RL) * D;
  float* xo = r < RL ? p.out + (size_t)r * D : p.xc + (size_t)(r - RL) * D;
  const bf16_t* yo = p.YO + (size_t)r * D;
  float ss = 0.f; for (int k = 0; k < D; ++k) { float v = bf2f(yo[k]); ss += v * v; }
  float rstd = 1.0f / sqrtf(ss / D + 1e-6f);
  float s2 = 0.f;
  for (int k = 0; k < D; ++k) { float xn = xin[k] + mb[2 * 1024 + k] * bf2f(yo[k]) * rstd * p.g_mix_post[layer * 1024 + k]; xo[k] = xn; s2 += xn * xn; }
  float rstd2 = 1.0f / sqrtf(s2 / D + 1e-6f);
  float lg[16]; _Pragma("unroll") for (int e = 0; e < 16; ++e) lg[e] = 0.f;
  const float* wr = p.w_router + (size_t)layer * D * 16;
  for (int k = 0; k < D; ++k) {
    float h2 = xo[k] * rstd2 * p.g_ffn_pre[layer * 1024 + k] * (1.f + mb[4 * 1024 + k]) + mb[3 * 1024 + k];
    p.H[(size_t)r * D + k] = f2bf(h2);
    _Pragma("unroll") for (int e = 0; e < 16; ++e) lg[e] += h2 * wr[k * 16 + e];
  }
  float mx = lg[0]; _Pragma("unroll") for (int e = 1; e < 16; ++e) mx = fmaxf(mx, lg[e]);
  float sm = 0.f; _Pragma("unroll") for (int e = 0; e < 16; ++e) { lg[e] = expf(lg[e] - mx); sm += lg[e]; }
  int b, s; bs_of((int)r, b, s);
  _Pragma("unroll") for (int e = 0; e < 16; ++e) p.AFF[((size_t)b * NE + e) * TK + s] = lg[e] / sm;
}
__global__ void __launch_bounds__(256) nv_topk(Params p, int need_ctx) {
  long i = GTID; if (i >= NB * NE * 2) return;
  int seg = (int)(i % 2), e = (int)((i / 2) % NE), b = (int)(i / (2 * NE));
  int s0 = seg ? TC : 0, n = seg ? TL : TC, cap = seg ? CAPL : CAPC, slot0 = seg ? b * CAPL : NB * CAPL + b * CAPC;
  if (seg == 0 && !need_ctx) { for (int q = 0; q < cap; ++q) p.SEL[(size_t)e * NSLOT + slot0 + q] = -1; return; }
  const float* a = p.AFF + ((size_t)b * NE + e) * TK + s0;
  unsigned thr = 0;
  for (int bit = 31; bit >= 0; --bit) {
    unsigned cand = thr | (1u << bit); int cnt = 0;
    for (int t = 0; t < n; ++t) cnt += (f2u(a[t]) >= cand);
    if (cnt >= cap) thr = cand;
  }
  int ngt = 0; for (int t = 0; t < n; ++t) ngt += (f2u(a[t]) > thr);
  int neq = cap - ngt, q = 0;
  for (int t = 0; t < n; ++t) {
    unsigned u = f2u(a[t]); int r = row_of(b, s0 + t); int sel = -1;
    if (u > thr) sel = q++; else if (u == thr && neq > 0) { sel = q++; --neq; }
    if (sel >= 0) { p.SEL[(size_t)e * NSLOT + slot0 + sel] = r; p.SELV[(size_t)e * NSLOT + slot0 + sel] = a[t]; }
    p.INV[(size_t)r * NE + e] = sel >= 0 ? slot0 + sel : -1;
  }
}
__global__ void __launch_bounds__(256) nv_moe1(Params p) {
  long i = GTID; if (i >= (long)NE * NSLOT * FF) return;
  int f = (int)(i % FF), slot = (int)((i / FF) % NSLOT), e = (int)(i / ((long)FF * NSLOT));
  int r = p.SEL[(size_t)e * NSLOT + slot];
  float out = 0.f;
  if (r >= 0) {
    const bf16_t* wg = p.Wt_eg + ((size_t)e * FF + f) * D; const bf16_t* wu = p.Wt_eu + ((size_t)e * FF + f) * D; const bf16_t* h = p.H + (size_t)r * D;
    float g = 0.f, u = 0.f; for (int k = 0; k < D; ++k) { float hv = bf2f(h[k]); g += hv * bf2f(wg[k]); u += hv * bf2f(wu[k]); }
    out = siluf_(g) * u;
  }
  p.HID[((size_t)e * NSLOT + slot) * FF + f] = f2bf(out);
}
__global__ void __launch_bounds__(256) nv_moe2(Params p) {
  long i = GTID; if (i >= (long)NE * NSLOT * D) return;
  int j = (int)(i % D), slot = (int)((i / D) % NSLOT), e = (int)(i / ((long)D * NSLOT));
  int r = p.SEL[(size_t)e * NSLOT + slot];
  float out = 0.f;
  if (r >= 0) {
    const bf16_t* wd = p.Wt_ed + ((size_t)e * D + j) * FF; const bf16_t* h = p.HID + ((size_t)e * NSLOT + slot) * FF;
    float a = 0.f; for (int k = 0; k < FF; ++k) a += bf2f(h[k]) * bf2f(wd[k]);
    out = a * p.SELV[(size_t)e * NSLOT + slot];
  }
  p.YE[((size_t)e * NSLOT + slot) * D + j] = f2bf(out);
}
__global__ void __launch_bounds__(256) nv_resid_ffn(Params p, int layer, int nrows) {
  long r = GTID; if (r >= nrows) return;
  int w = r < RL ? (int)(r / TL) : 2;
  const float* mb = p.mods + (size_t)(layer * 3 + w) * 6144;
  float* xo = r < RL ? p.out + (size_t)r * D : p.xc + (size_t)(r - RL) * D;
  float ss = 0.f;
  for (int k = 0; k < D; ++k) {
    float f = 0.f;
    for (int e = 0; e < NE; ++e) { int sl = p.INV[(size_t)r * NE + e]; if (sl >= 0) f += bf2f(p.YE[((size_t)e * NSLOT + sl) * D + k]); }
    ss += f * f;
  }
  float rstd = 1.0f / sqrtf(ss / D + 1e-6f);
  for (int k = 0; k < D; ++k) {
    float f = 0.f;
    for (int e = 0; e < NE; ++e) { int sl = p.INV[(size_t)r * NE + e]; if (sl >= 0) f += bf2f(p.YE[((size_t)e * NSLOT + sl) * D + k]); }
    xo[k] += mb[5 * 1024 + k] * f * rstd * p.g_ffn_post[layer * 1024 + k];
  }
}

__global__ void __launch_bounds__(256) nv_mods(Params p) { nvb_mods(GTID, p); }
__global__ void __launch_bounds__(256) nv_ml_gates(Params p, int layer) { nvb_ml_gates(GTID, p, layer); }
__global__ void __launch_bounds__(256) nv_gla_cum(Params p, int layer) { nvb_gla_cum(GTID, p, layer); }
__global__ void __launch_bounds__(256) nv_ml_local(Params p) { nvb_ml_local(GTID, p); }
__global__ void __launch_bounds__(256) nv_ml_scan(Params p) { nvb_ml_scan(GTID, p); }
__global__ void __launch_bounds__(256) nv_ml_out(Params p, int need_ctx) { nvb_ml_out(GTID, p, need_ctx); }
__global__ void __launch_bounds__(256) nv_ml_finish(Params p, int layer, int need_ctx) { nvb_ml_finish(GTID, p, layer, need_ctx); }
__global__ void __launch_bounds__(256) nv_gla_local(Params p) { nvb_gla_local(GTID, p); }
__global__ void __launch_bounds__(256) nv_gla_scan(Params p) { nvb_gla_scan(GTID, p); }
__global__ void __launch_bounds__(256) nv_gla_out(Params p, int need_ctx) { nvb_gla_out(GTID, p, need_ctx); }
__global__ void __launch_bounds__(256) nv_gla_finish(Params p, int layer, int need_ctx) { nvb_gla_finish(GTID, p, layer, need_ctx); }
constexpr int LROW = 144;
constexpr int A_BYTES = 128 * LROW;
constexpr int NTHR = 256;
#ifndef ATT_THR
#define ATT_THR 16.0f
#endif

DI u32x4 ldg16(const void* p) { return *(const u32x4*)p; }
DI void sts16(char* p, u32x4 v) { *(u32x4*)p = v; }
DI bf16x8 lds_frag(const char* p) { return *(const bf16x8*)p; }

template <int WN>
DI void gemm_kloop(f32x4 (&acc)[4][WN], const bf16_t* const (&ap)[4], const bf16_t* const (&bp)[WN], int nk, char* lds) {
  constexpr int STAGE = A_BYTES + 32 * WN * LROW;
  const int t = TIDX, lane = t & 63, wid = t >> 6, wr = wid >> 1, wc = wid & 1;
  const int lr = t >> 3, lcb = (t & 7) * 16;
  const int fr = lane & 15, fq = lane >> 4;
  const int aoff = (wr * 64 + fr) * LROW + fq * 16, boff = A_BYTES + (wc * WN * 16 + fr) * LROW + fq * 16, soff = lr * LROW + lcb;
  u32x4 ra0[4], rb0[WN], ra1[4], rb1[WN];
  auto gload = [&](u32x4 (&ra)[4], u32x4 (&rb)[WN], int kt) {
#pragma unroll
    for (int i = 0; i < 4; ++i) ra[i] = ldg16(ap[i] + kt * 64);
#pragma unroll
    for (int i = 0; i < WN; ++i) rb[i] = ldg16(bp[i] + kt * 64);
  };
  auto sstore = [&](const u32x4 (&ra)[4], const u32x4 (&rb)[WN], char* st) {
#pragma unroll
    for (int i = 0; i < 4; ++i) sts16(st + soff + 32 * i * LROW, ra[i]);
#pragma unroll
    for (int i = 0; i < WN; ++i) sts16(st + A_BYTES + soff + 32 * i * LROW, rb[i]);
  };
  auto compute = [&](const char* cur) {
#pragma unroll
    for (int ks = 0; ks < 2; ++ks) {
      bf16x8 af[4], bfr[WN];
#pragma unroll
      for (int m = 0; m < 4; ++m) af[m] = lds_frag(cur + aoff + m * 16 * LROW + ks * 64);
#pragma unroll
      for (int n = 0; n < WN; ++n) bfr[n] = lds_frag(cur + boff + n * 16 * LROW + ks * 64);
#pragma unroll
      for (int m = 0; m < 4; ++m)
#pragma unroll
        for (int n = 0; n < WN; ++n) acc[m][n] = MFMA16(bfr[n], af[m], acc[m][n]);
    }
  };
  gload(ra0, rb0, 0);
  gload(ra1, rb1, 1);
  sstore(ra0, rb0, lds);
  __syncthreads();
#pragma unroll 1
  for (int kt = 0; kt < nk; kt += 2) {
    if (kt + 2 < nk) gload(ra0, rb0, kt + 2);
    compute(lds);
    sstore(ra1, rb1, lds + STAGE);
    __syncthreads();
    if (kt + 3 < nk) gload(ra1, rb1, kt + 3);
    compute(lds + STAGE);
    if (kt + 2 < nk) sstore(ra0, rb0, lds);
    __syncthreads();
  }
}
template <int WN> DI void acc_zero(f32x4 (&acc)[4][WN]) {
#pragma unroll
  for (int m = 0; m < 4; ++m)
#pragma unroll
    for (int n = 0; n < WN; ++n) acc[m][n] = (f32x4){0.f, 0.f, 0.f, 0.f};
}
DI void st_bf16x4(bf16_t* p, f32x4 v) { u32x2 o; o.x = pack2bf(v.x, v.y); o.y = pack2bf(v.z, v.w); *(u32x2*)p = o; }

template <int WN, class RowOk>
DI void store_wave_tile(const f32x4 (&acc)[4][WN], bf16_t* C, size_t ldc, char* ldsw, int lane, RowOk row_ok) {
  constexpr int PITCH = WN * 32 + 16, CPR = WN * 2;
  const int fr = lane & 15, fq = lane >> 4;
#pragma unroll
  for (int m = 0; m < 4; ++m)
#pragma unroll
    for (int n = 0; n < WN; ++n) { u32x2 o; o.x = pack2bf(acc[m][n][0], acc[m][n][1]); o.y = pack2bf(acc[m][n][2], acc[m][n][3]); *(u32x2*)(ldsw + (m * 16 + fr) * PITCH + n * 32 + fq * 8) = o; }
  WAVE_SYNC();
  constexpr int RPP = 64 / CPR;
#pragma unroll
  for (int ps = 0; ps < 64 / RPP; ++ps) {
    const int r = ps * RPP + lane / CPR, c = lane % CPR;
    const u32x4 v = *(const u32x4*)(ldsw + r * PITCH + c * 16);
    if (row_ok(r)) *(u32x4*)(C + (size_t)r * ldc + c * 8) = v;
  }
  WAVE_SYNC();
}
template <int NOSTORE = 0>
DI void gemm_plain_tile(const bf16_t* A, int lda, const bf16_t* Bt, int ldb, int K, bf16_t* C, int ldc, int tm, int tn, char* lds) {
  const int t = TIDX, lane = t & 63, wid = t >> 6, wr = wid >> 1, wc = wid & 1, lr = t >> 3, lc = (t & 7) * 8, fr = lane & 15, fq = lane >> 4;
  const bf16_t* ap[4]; const bf16_t* bp[4];
#pragma unroll
  for (int i = 0; i < 4; ++i) { ap[i] = A + (size_t)(tm * 128 + lr + 32 * i) * lda + lc; bp[i] = Bt + (size_t)(tn * 128 + lr + 32 * i) * ldb + lc; }
  f32x4 acc[4][4]; acc_zero<4>(acc);
  gemm_kloop<4>(acc, ap, bp, K / 64, lds);
  if (NOSTORE) { float s = 0.f;
#pragma unroll
    for (int m = 0; m < 4; ++m)
#pragma unroll
      for (int n = 0; n < 4; ++n) s += acc[m][n][0] + acc[m][n][3];
    if (s == 123456.789f) C[0] = 1; return; }
  store_wave_tile<4>(acc, C + (size_t)(tm * 128 + wr * 64) * ldc + tn * 128 + wc * 64, (size_t)ldc, lds + wid * (64 * 144), lane, [](int) { return true; });
  __syncthreads();
}
template <int NOSTORE = 0>
DI void ph_gemm_plain(const bf16_t* A, int lda, const bf16_t* Bt, int ldb, int M, int N, int K, bf16_t* C, int ldc, char* lds, int bid, int nblk) {
  const int ntn = N / 128, nt = (M / 128) * ntn;
  for (int tile = bid; tile < nt; tile += nblk) gemm_plain_tile<NOSTORE>(A, lda, Bt, ldb, K, C, ldc, tile / ntn, tile % ntn, lds);
}
DI void ph_mla_up(const Params& p, int layer, bf16_t* QRAW, bf16_t* KVRAW, char* lds, int bid, int nblk) {
  const int ntq = (R / 128) * 3, ntkv = (R / 128) * 4;
  for (int tile = bid; tile < ntq + ntkv; tile += nblk) {
    if (tile < ntq) gemm_plain_tile(p.Z + ZC_QLAT, NZP, p.Wt_uq + layer * WSZ_UQ, 256, 256, QRAW, 384, tile / 3, tile % 3, lds);
    else { int u = tile - ntq; gemm_plain_tile(p.Z + ZC_KVLAT, NZP, p.Wt_ukv + layer * WSZ_UKV, 128, 128, KVRAW, 512, u / 4, u % 4, lds); }
  }
}
constexpr int LROW32 = 80;
template <int WM, int WN, bool DEEP>
DI void gemm_kloop_g(f32x4 (&acc)[WM][WN], const bf16_t* const (&ap)[WM / 2], const bf16_t* const (&bp)[WN / 2], int nk, char* lds) {
  constexpr int NA = WM / 2, NBB = WN / 2, A_B = 32 * WM * LROW32, STAGE = (32 * WM + 32 * WN) * LROW32;
  const int t = TIDX, lane = t & 63, wid = t >> 6, wr = wid >> 1, wc = wid & 1, fr = lane & 15, fq = lane >> 4;
  const int aoff = (wr * 16 * WM + fr) * LROW32 + fq * 16, boff = A_B + (wc * 16 * WN + fr) * LROW32 + fq * 16, soff = (t >> 2) * LROW32 + (t & 3) * 16;
  u32x4 ra0[NA], rb0[NBB], ra1[NA], rb1[NBB];
  auto gload = [&](u32x4 (&ra)[NA], u32x4 (&rb)[NBB], int kt) {
#pragma unroll
    for (int i = 0; i < NA; ++i) ra[i] = ldg16(ap[i] + kt * 32);
#pragma unroll
    for (int i = 0; i < NBB; ++i) rb[i] = ldg16(bp[i] + kt * 32);
  };
  auto sstore = [&](const u32x4 (&ra)[NA], const u32x4 (&rb)[NBB], char* st) {
#pragma unroll
    for (int i = 0; i < NA; ++i) sts16(st + soff + 64 * i * LROW32, ra[i]);
#pragma unroll
    for (int i = 0; i < NBB; ++i) sts16(st + A_B + soff + 64 * i * LROW32, rb[i]);
  };
  auto compute = [&](const char* cur) {
    bf16x8 af[WM];
#pragma unroll
    for (int m = 0; m < WM; ++m) af[m] = lds_frag(cur + aoff + m * 16 * LROW32);
#pragma unroll
    for (int n = 0; n < WN; ++n) {
      const bf16x8 bfr = lds_frag(cur + boff + n * 16 * LROW32);
#pragma unroll
      for (int m = 0; m < WM; ++m) acc[m][n] = MFMA16(bfr, af[m], acc[m][n]);
    }
  };
  gload(ra0, rb0, 0);
  if (DEEP) gload(ra1, rb1, 1);
  sstore(ra0, rb0, lds);
  __syncthreads();
#pragma unroll 1
  for (int kt = 0; kt < nk; kt += 2) {
    if (DEEP) { if (kt + 2 < nk) gload(ra0, rb0, kt + 2); } else gload(ra1, rb1, kt + 1);
    compute(lds);
    sstore(ra1, rb1, lds + STAGE);
    __syncthreads();
    if (DEEP) { if (kt + 3 < nk) gload(ra1, rb1, kt + 3); } else if (kt + 2 < nk) gload(ra0, rb0, kt + 2);
    compute(lds + STAGE);
    if (kt + 2 < nk) sstore(ra0, rb0, lds);
    __syncthreads();
  }
}
template <int WM, int WN> DI void acc_zero_g(f32x4 (&acc)[WM][WN]) {
#pragma unroll
  for (int m = 0; m < WM; ++m)
#pragma unroll
    for (int n = 0; n < WN; ++n) acc[m][n] = (f32x4){0.f, 0.f, 0.f, 0.f};
}
DI void ph_merge(const Params& p, int layer, int rows, char* lds, int bid, int nblk) {
  const int t = TIDX, lane = t & 63, wid = t >> 6, wr = wid >> 1, wc = wid & 1, fr = lane & 15, fq = lane >> 4;
  const int lr = t >> 2, lc = (t & 3) * 8;
  const int ntn = D / 64, nt = (rows / 128) * ntn;
#pragma unroll 1
  for (int tile = bid; tile < nt; tile += nblk) {
    const int tm = tile / ntn, tn = tile % ntn;
    f32x4 accS[4][2]; acc_zero_g<4, 2>(accS);
#pragma unroll 1
    for (int np = 0; np < 2; ++np) {
      f32x4 accG[4][4]; acc_zero_g<4, 4>(accG);
      {
        const bf16_t* ap[2]; const bf16_t* bp[2];
#pragma unroll
        for (int i = 0; i < 2; ++i) ap[i] = p.H + (size_t)(tm * 128 + lr + 64 * i) * D + lc;
#pragma unroll
        for (int i = 0; i < 2; ++i) { const int rho = lr + 64 * i, wci = rho >> 6, n = 2 * np + ((rho >> 5) & 1), c = rho & 31;
          bp[i] = p.Wt_gate + layer * WSZ_GATE + ((size_t)n * 1024 + tn * 64 + wci * 32 + c) * D + lc; }
        gemm_kloop_g<4, 4, true>(accG, ap, bp, D / 32, lds);
      }
#pragma unroll 1
      for (int q = 0; q < 2; ++q) {
        const int n = 2 * np + q;
        f32x4 accP[4][2]; acc_zero_g<4, 2>(accP);
        const bf16_t* ap[2]; const bf16_t* bp[1];
#pragma unroll
        for (int i = 0; i < 2; ++i) ap[i] = p.Y + (size_t)(tm * 128 + lr + 64 * i) * D + n * 256 + lc;
        bp[0] = p.Wt_branch + layer * WSZ_BR + ((size_t)n * D + tn * 64 + lr) * 256 + lc;
        gemm_kloop_g<4, 2, false>(accP, ap, bp, 8, lds);
#pragma unroll
        for (int nn = 0; nn < 2; ++nn) {
          const f32x4 bv = *(const f32x4*)(p.b_gate + layer * 4096 + n * 1024 + tn * 64 + wc * 32 + nn * 16 + 4 * fq);
#pragma unroll
          for (int m = 0; m < 4; ++m)
#pragma unroll
            for (int j = 0; j < 4; ++j) { const float g = q ? accG[m][2 + nn][j] : accG[m][nn][j]; accS[m][nn][j] += accP[m][nn][j] * fast_rcp(1.0f + fast_exp2(-LOG2E * (g + bv[j]))); }
        }
      }
    }
    store_wave_tile<2>(accS, p.MG + (size_t)(tm * 128 + wr * 64) * D + tn * 64 + wc * 32, (size_t)D, lds + wid * (64 * 80), lane, [](int) { return true; });
    __syncthreads();
  }
}
template <int WM>
DI void gemm_plain_tile_g(const bf16_t* A, int lda, const bf16_t* Bt, int ldb, int K, bf16_t* C, int ldc, int row0, int col0, char* lds) {
  const int t = TIDX, lane = t & 63, wid = t >> 6, wr = wid >> 1, wc = wid & 1, fr = lane & 15, fq = lane >> 4, lr = t >> 2, lc = (t & 3) * 8;
  const bf16_t* ap[WM / 2]; const bf16_t* bp[2];
#pragma unroll
  for (int i = 0; i < WM / 2; ++i) ap[i] = A + (size_t)(row0 + lr + 64 * i) * lda + lc;
#pragma unroll
  for (int i = 0; i < 2; ++i) bp[i] = Bt + (size_t)(col0 + lr + 64 * i) * ldb + lc;
  f32x4 acc[WM][4]; acc_zero_g<WM, 4>(acc);
  gemm_kloop_g<WM, 4, true>(acc, ap, bp, K / 32, lds);
#pragma unroll
  for (int m = 0; m < WM; ++m)
#pragma unroll
    for (int n = 0; n < 4; ++n)
      st_bf16x4(C + (size_t)(row0 + wr * 16 * WM + m * 16 + fr) * ldc + col0 + wc * 64 + n * 16 + 4 * fq, acc[m][n]);
}
DI void ph_gemm_plain2(const bf16_t* A, int lda, const bf16_t* Bt, int ldb, int M, int N, int K, bf16_t* C, int ldc, char* lds, int bid, int nblk) {
  const int ntn = N / 128, nt = (M / 256) * ntn, nfull = (nt / nblk) * nblk;
#pragma unroll 1
  for (int tile = bid; tile < nfull; tile += nblk) gemm_plain_tile_g<8>(A, lda, Bt, ldb, K, C, ldc, (tile / ntn) * 256, (tile % ntn) * 128, lds);
#pragma unroll 1
  for (int h = bid; h < 2 * (nt - nfull); h += nblk) { const int tile = nfull + (h >> 1); gemm_plain_tile_g<4>(A, lda, Bt, ldb, K, C, ldc, (tile / ntn) * 256 + (h & 1) * 128, (tile % ntn) * 128, lds); }
}
DI void gemm_kloop32(f32x16 (&acc)[2][2], const bf16_t* const (&ap)[4], const bf16_t* const (&bp)[4], int nk, char* lds) {
  constexpr int STAGE = A_BYTES + 128 * LROW;
  const int t = TIDX, lane = t & 63, wid = t >> 6, wr = wid >> 1, wc = wid & 1, l31 = lane & 31, hh = lane >> 5;
  const int aoff = (wr * 64 + l31) * LROW + hh * 16, boff = A_BYTES + (wc * 64 + l31) * LROW + hh * 16, soff = (t >> 3) * LROW + (t & 7) * 16;
  u32x4 ra0[4], rb0[4], ra1[4], rb1[4];
  auto gload = [&](u32x4 (&ra)[4], u32x4 (&rb)[4], int kt) {
#pragma unroll
    for (int i = 0; i < 4; ++i) { ra[i] = ldg16(ap[i] + kt * 64); rb[i] = ldg16(bp[i] + kt * 64); }
  };
  auto sstore = [&](const u32x4 (&ra)[4], const u32x4 (&rb)[4], char* st) {
#pragma unroll
    for (int i = 0; i < 4; ++i) { sts16(st + soff + 32 * i * LROW, ra[i]); sts16(st + A_BYTES + soff + 32 * i * LROW, rb[i]); }
  };
  auto compute = [&](const char* cur) {
#pragma unroll
    for (int ks = 0; ks < 4; ++ks) {
      bf16x8 af[2], bfr[2];
#pragma unroll
      for (int m = 0; m < 2; ++m) af[m] = lds_frag(cur + aoff + m * 32 * LROW + ks * 32);
#pragma unroll
      for (int n = 0; n < 2; ++n) bfr[n] = lds_frag(cur + boff + n * 32 * LROW + ks * 32);
#pragma unroll
      for (int m = 0; m < 2; ++m)
#pragma unroll
        for (int n = 0; n < 2; ++n) acc[m][n] = MFMA32(bfr[n], af[m], acc[m][n]);
    }
  };
  gload(ra0, rb0, 0); gload(ra1, rb1, 1);
  sstore(ra0, rb0, lds);
  __syncthreads();
#pragma unroll 1
  for (int kt = 0; kt < nk; kt += 2) {
    if (kt + 2 < nk) gload(ra0, rb0, kt + 2);
    compute(lds);
    sstore(ra1, rb1, lds + STAGE);
    __syncthreads();
    if (kt + 3 < nk) gload(ra1, rb1, kt + 3);
    compute(lds + STAGE);
    if (kt + 2 < nk) sstore(ra0, rb0, lds);
    __syncthreads();
  }
}
DI void ph_gemm_plain32(const bf16_t* A, int lda, const bf16_t* Bt, int ldb, int M, int N, int K, bf16_t* C, int ldc, char* lds, int bid, int nblk) {
  const int t = TIDX, lane = t & 63, wid = t >> 6, wr = wid >> 1, wc = wid & 1, lr = t >> 3, lc = (t & 7) * 8, l31 = lane & 31, hh = lane >> 5;
  const int ntn = N / 128, nt = (M / 128) * ntn;
#pragma unroll 1
  for (int tile = bid; tile < nt; tile += nblk) {
    const int tm = tile / ntn, tn = tile % ntn;
    const bf16_t* ap[4]; const bf16_t* bp[4];
#pragma unroll
    for (int i = 0; i < 4; ++i) { ap[i] = A + (size_t)(tm * 128 + lr + 32 * i) * lda + lc; bp[i] = Bt + (size_t)(tn * 128 + lr + 32 * i) * ldb + lc; }
    f32x16 acc[2][2];
#pragma unroll
    for (int m = 0; m < 2; ++m)
#pragma unroll
      for (int n = 0; n < 2; ++n) acc[m][n] = (f32x16)(0.f);
    gemm_kloop32(acc, ap, bp, K / 64, lds);
#pragma unroll
    for (int m = 0; m < 2; ++m)
#pragma unroll
      for (int n = 0; n < 2; ++n)
#pragma unroll
        for (int g = 0; g < 4; ++g) {
          f32x4 o = {acc[m][n][4 * g], acc[m][n][4 * g + 1], acc[m][n][4 * g + 2], acc[m][n][4 * g + 3]};
          st_bf16x4(C + (size_t)(tm * 128 + wr * 64 + m * 32 + l31) * ldc + tn * 128 + wc * 64 + n * 32 + 8 * g + 4 * hh, o);
        }
  }
}
template <int MODE>
DI void ph_gemm_probe(const bf16_t* A, int lda, const bf16_t* Bt, int ldb, int M, int N, int K, float* sink, char* lds, int bid, int nblk) {
  const int t = TIDX, lane = t & 63, wid = t >> 6, wr = wid >> 1, wc = wid & 1, lr = t >> 3, lc = (t & 7) * 8, fr = lane & 15, fq = lane >> 4;
  const int ntn = N / 128, nt = (M / 128) * ntn, nk = K / 64;
  constexpr int STAGE = A_BYTES + 128 * LROW;
  const int aoff = (wr * 64 + fr) * LROW + fq * 16, boff = A_BYTES + (wc * 64 + fr) * LROW + fq * 16;
#pragma unroll 1
  for (int tile = bid; tile < nt; tile += nblk) {
    f32x4 acc[4][4]; acc_zero<4>(acc);
    bf16x8 af[4], bfr[4];
    const int tm = tile / ntn, tn = tile % ntn;
    const bf16_t* ap[4]; const bf16_t* bp[4];
#pragma unroll
    for (int i = 0; i < 4; ++i) { ap[i] = A + (size_t)(tm * 128 + lr + 32 * i) * lda + lc; bp[i] = Bt + (size_t)(tn * 128 + lr + 32 * i) * ldb + lc; }
    u32x4 ra[4], rb[4], junk = {0u, 0u, 0u, 0u};
#pragma unroll
    for (int i = 0; i < 4; ++i) { ra[i] = junk; rb[i] = junk; }
#pragma unroll 1
    for (int kt = 0; kt < nk; ++kt) {
      const char* cur = lds + (kt & 1) * STAGE;
#pragma unroll
      for (int i = 0; i < 4; ++i) { ra[i] = ldg16(ap[i] + kt * 64); if (MODE == 3) rb[i] = ldg16(bp[i] + kt * 64); }
#pragma unroll
      for (int ks = 0; ks < 2; ++ks) {
#pragma unroll
        for (int m = 0; m < 4; ++m) { af[m] = lds_frag(cur + aoff + m * 16 * LROW + ks * 64); bfr[m] = lds_frag(cur + boff + m * 16 * LROW + ks * 64); }
#pragma unroll
        for (int m = 0; m < 4; ++m)
#pragma unroll
          for (int n = 0; n < 4; ++n) acc[m][n] = MFMA16(bfr[n], af[m], acc[m][n]);
      }
      junk.x ^= ra[0].x ^ ra[1].y ^ ra[2].z ^ ra[3].w ^ rb[0].x ^ rb[1].y ^ rb[2].z ^ rb[3].w;
      __syncthreads();
    }
    float s = (float)(junk.x & 1u);
#pragma unroll
    for (int m = 0; m < 4; ++m)
#pragma unroll
      for (int n = 0; n < 4; ++n) s += acc[m][n][0] + acc[m][n][3];
    if (s == 123456.789f) sink[0] = s;
  }
}
DI void ph_moe1(const Params& p, int need_ctx, char* lds, int bid, int nblk) {
  const int t = TIDX, lane = t & 63, wid = t >> 6, wr = wid >> 1, wc = wid & 1, lr = t >> 3, lc = (t & 7) * 8, fr = lane & 15, fq = lane >> 4;
  constexpr int NTN = FF / 64;
  const int NTM = need_ctx ? (NSLOT + 127) / 128 : (NB * CAPL) / 128;
  for (int tile = bid; tile < NE * NTM * NTN; tile += nblk) {
    const int e = tile / (NTM * NTN), rem = tile % (NTM * NTN), tm = rem / NTN, tn = rem % NTN;
    const bf16_t* ap[4]; const bf16_t* bp[4];
#pragma unroll
    for (int i = 0; i < 4; ++i) {
      const int slot = tm * 128 + lr + 32 * i;
      int r = slot < NSLOT ? p.SEL[(size_t)e * NSLOT + slot] : -1;
      ap[i] = p.H + (size_t)(r < 0 ? 0 : r) * D + lc;
      const int rho = lr + 32 * i, wci = rho >> 6, gu = (rho >> 5) & 1, col = wci * 32 + (rho & 31);
      bp[i] = (gu ? p.Wt_eu : p.Wt_eg) + ((size_t)e * FF + tn * 64 + col) * D + lc;
    }
    f32x4 acc[4][4]; acc_zero<4>(acc);
    gemm_kloop<4>(acc, ap, bp, D / 64, lds);
    f32x4 hid[4][2];
#pragma unroll
    for (int m = 0; m < 4; ++m) {
      const int slot = tm * 128 + wr * 64 + m * 16 + fr;
      const bool valid = slot < NSLOT && p.SEL[(size_t)e * NSLOT + (slot < NSLOT ? slot : 0)] >= 0;
#pragma unroll
      for (int n = 0; n < 2; ++n)
#pragma unroll
        for (int j = 0; j < 4; ++j) { const float g = acc[m][n][j], u = acc[m][n + 2][j]; hid[m][n][j] = valid ? g * u * fast_rcp(1.0f + fast_exp2(-LOG2E * g)) : 0.f; }
    }
    const int slot0 = tm * 128 + wr * 64;
    store_wave_tile<2>(hid, p.HID + ((size_t)e * NSLOT + slot0) * FF + tn * 64 + wc * 32, (size_t)FF, lds + wid * (64 * 80), lane, [&](int r) { return slot0 + r < NSLOT; });
    __syncthreads();
  }
}
DI void ph_moe2(const Params& p, int need_ctx, char* lds, int bid, int nblk) {
  const int t = TIDX, lane = t & 63, wid = t >> 6, wr = wid >> 1, wc = wid & 1, lr = t >> 3, lc = (t & 7) * 8, fr = lane & 15, fq = lane >> 4;
  constexpr int NTN = D / 128;
  const int NTM = need_ctx ? (NSLOT + 127) / 128 : (NB * CAPL) / 128;
  for (int tile = bid; tile < NE * NTM * NTN; tile += nblk) {
    const int e = tile / (NTM * NTN), rem = tile % (NTM * NTN), tm = rem / NTN, tn = rem % NTN;
    const bf16_t* ap[4]; const bf16_t* bp[4];
#pragma unroll
    for (int i = 0; i < 4; ++i) {
      int slot = tm * 128 + lr + 32 * i; if (slot >= NSLOT) slot = NSLOT - 1;
      ap[i] = p.HID + ((size_t)e * NSLOT + slot) * FF + lc;
      bp[i] = p.Wt_ed + ((size_t)e * D + tn * 128 + lr + 32 * i) * FF + lc;
    }
    f32x4 acc[4][4]; acc_zero<4>(acc);
    gemm_kloop<4>(acc, ap, bp, FF / 64, lds);
#pragma unroll
    for (int m = 0; m < 4; ++m) {
      const int slot = tm * 128 + wr * 64 + m * 16 + fr;
      const float val = (slot < NSLOT && p.SEL[(size_t)e * NSLOT + (slot < NSLOT ? slot : 0)] >= 0) ? p.SELV[(size_t)e * NSLOT + slot] : 0.f;
#pragma unroll
      for (int n = 0; n < 4; ++n) { acc[m][n].x *= val; acc[m][n].y *= val; acc[m][n].z *= val; acc[m][n].w *= val; }
    }
    const int slot0 = tm * 128 + wr * 64;
    store_wave_tile<4>(acc, p.YE + ((size_t)e * NSLOT + slot0) * D + tn * 128 + wc * 64, (size_t)D, lds + wid * (64 * 144), lane, [&](int r) { return slot0 + r < NSLOT; });
    __syncthreads();
  }
}
constexpr int GEMM_LDS = 2 * (A_BYTES + 128 * LROW);

DI void unpack8(u32x4 v, float (&f)[8]) {
  f[0] = u2f(v.x << 16); f[1] = u2f(v.x & 0xffff0000u); f[2] = u2f(v.y << 16); f[3] = u2f(v.y & 0xffff0000u);
  f[4] = u2f(v.z << 16); f[5] = u2f(v.z & 0xffff0000u); f[6] = u2f(v.w << 16); f[7] = u2f(v.w & 0xffff0000u);
}
DI u32x4 pack8f(const float (&f)[8]) { u32x4 v; v.x = pack2bf(f[0], f[1]); v.y = pack2bf(f[2], f[3]); v.z = pack2bf(f[4], f[5]); v.w = pack2bf(f[6], f[7]); return v; }
DI void rope8(float (&a)[8], const float (&pr)[8], int cc, const float* cs, const float* sn) {
  const int ax = (cc >> 1) * 8; const bool second = cc & 1;
#pragma unroll
  for (int i = 0; i < 8; ++i) a[i] = second ? a[i] * cs[ax + i] + pr[i] * sn[ax + i] : a[i] * cs[ax + i] - pr[i] * sn[ax + i];
}
constexpr int PREP_LDS = 64 * 4 + 2 * 512 * 4 + 32 * 528;
template <int PARTS = 3>
DI void ph_prep(const Params& p, int layer, const bf16_t* QRAW, const bf16_t* KVRAW, char* lds, int bid, int nblk) {
  float* s_rstd = (float*)lds;
  float* s_cs = s_rstd + 64;
  float* s_sn = s_cs + 512;
  bf16_t* s_t = (bf16_t*)(s_sn + 512);
  const int t = TIDX;
  constexpr int UPB = TK / 32, NU = NB * UPB;
  const float* wcv = p.w_conv + (size_t)layer * 3 * 512;
#pragma unroll 1
  for (int u = bid; u < NU; u += nblk) {
    int b, s0;
    if (u < NB * (TL / 32)) { b = u / (TL / 32); s0 = TC + (u % (TL / 32)) * 32; } else { const int v = u - NB * (TL / 32); b = v / (TC / 32); s0 = (v % (TC / 32)) * 32; }
    const int r0 = row_of(b, s0);
    {
      const int tok = t >> 3, part = t & 7;
      const bf16_t* z = p.Z + (size_t)(r0 + tok) * NZP;
      float sq = 0.f, sk = 0.f, f[8];
#pragma unroll
      for (int k = 0; k < 4; ++k) { unpack8(ldg16(z + ZC_QLAT + part * 32 + k * 8), f);
#pragma unroll
        for (int i = 0; i < 8; ++i) sq += f[i] * f[i]; }
#pragma unroll
      for (int k = 0; k < 2; ++k) { unpack8(ldg16(z + ZC_KVLAT + part * 16 + k * 8), f);
#pragma unroll
        for (int i = 0; i < 8; ++i) sk += f[i] * f[i]; }
      sq = xor_sum<1>(sq); sk = xor_sum<1>(sk);
      sq = xor_sum<2>(sq); sk = xor_sum<2>(sk);
      sq = xor_sum<4>(sq); sk = xor_sum<4>(sk);
      if (part == 0) { s_rstd[tok * 2] = 1.0f / sqrtf(sq * (1.0f / 256) + 1e-6f); s_rstd[tok * 2 + 1] = 1.0f / sqrtf(sk * (1.0f / 128) + 1e-6f); }
    }
    for (int i = t; i < 512; i += NTHR) {
      const int tok = i >> 4, af = i & 15, s = s0 + tok;
      float cs = 1.f, sn = 0.f;
      if (s >= TC) rope_cs(s, (af >> 3) * 16 + (af & 7), cs, sn);
      s_cs[i] = cs; s_sn[i] = sn;
    }
    __syncthreads();
    if (PARTS & 1) {
#pragma unroll 2
    for (int i = t; i < 32 * 48; i += NTHR) {
      const int tok = i / 48, c = i % 48, h = c / 12, ch = c % 12;
      const float rq = s_rstd[tok * 2] * QS_MLA, rkv = s_rstd[tok * 2 + 1];
      const bf16_t* q = QRAW + (size_t)(r0 + tok) * 384 + h * 96;
      float a[8], pr[8];
      unpack8(ldg16(q + ch * 8), a);
      if (ch >= 8) { unpack8(ldg16(q + 64 + ((ch - 8) ^ 1) * 8), pr); rope8(a, pr, ch - 8, s_cs + tok * 16, s_sn + tok * 16); }
#pragma unroll
      for (int e = 0; e < 8; ++e) a[e] *= rq;
      *(u32x4*)(p.Qm + (((size_t)b * 4 + h) * TK + s0 + tok) * 96 + ch * 8) = pack8f(a);
      if (ch < 8) {
        unpack8(ldg16(KVRAW + (size_t)(r0 + tok) * 512 + h * 128 + ch * 8), a);
#pragma unroll
        for (int e = 0; e < 8; ++e) a[e] *= rkv;
      } else {
        const bf16_t* z = p.Z + (size_t)(r0 + tok) * NZP + ZC_KROPE;
        unpack8(ldg16(z + (ch - 8) * 8), a); unpack8(ldg16(z + ((ch - 8) ^ 1) * 8), pr);
        rope8(a, pr, ch - 8, s_cs + tok * 16, s_sn + tok * 16);
      }
      *(u32x4*)(p.Km + (((size_t)b * 4 + h) * TK + s0 + tok) * 96 + ch * 8) = pack8f(a);
    }
#pragma unroll 2
    for (int i = t; i < 32 * 64; i += NTHR) {
      const int tok = i >> 6, c = i & 63, qk = c >> 5, hm = (c >> 2) & 7, cc = c & 3;
      const bf16_t* src = p.Z + (size_t)(r0 + tok) * NZP + (qk ? ZC_DK : ZC_DQ) + hm * 32;
      float a[8], pr[8];
      unpack8(ldg16(src + cc * 8), a); unpack8(ldg16(src + (cc ^ 1) * 8), pr);
      rope8(a, pr, cc, s_cs + tok * 16, s_sn + tok * 16);
      if (qk == 0) {
#pragma unroll
        for (int e = 0; e < 8; ++e) a[e] *= QS_DIFF;
        *(u32x4*)(p.Qd + (((size_t)b * 8 + hm) * TK + s0 + tok) * 32 + cc * 8) = pack8f(a);
      } else *(u32x4*)(p.Kd + (((size_t)b * 8 + hm) * TK + s0 + tok) * 32 + cc * 8) = pack8f(a);
    }
#pragma unroll 2
    for (int i = t; i < 32 * 64; i += NTHR) {
      const int tok = i >> 6, c8 = (i & 63) * 8, s = s0 + tok;
      const bool first = (s == 0) || (s == TC), last = (s == TC - 1) || (s == TK - 1);
      const bf16_t* z = p.Z + (size_t)(r0 + tok) * NZP + ZC_MLQK + c8;
      float x0[8], xm[8], xp[8], o[8];
      unpack8(ldg16(z), x0);
      if (!first) unpack8(ldg16(z - NZP), xm);
      if (!last) unpack8(ldg16(z + NZP), xp);
      float bc8[8], w0[8], w1[8], w2[8];
      *(f32x4*)bc8 = *(const f32x4*)(p.b_conv + layer * 512 + c8); *(f32x4*)(bc8 + 4) = *(const f32x4*)(p.b_conv + layer * 512 + c8 + 4);
      *(f32x4*)w0 = *(const f32x4*)(wcv + c8); *(f32x4*)(w0 + 4) = *(const f32x4*)(wcv + c8 + 4);
      *(f32x4*)w1 = *(const f32x4*)(wcv + 512 + c8); *(f32x4*)(w1 + 4) = *(const f32x4*)(wcv + 512 + c8 + 4);
      *(f32x4*)w2 = *(const f32x4*)(wcv + 1024 + c8); *(f32x4*)(w2 + 4) = *(const f32x4*)(wcv + 1024 + c8 + 4);
#pragma unroll
      for (int e = 0; e < 8; ++e) {
        float acc = bc8[e] + x0[e] * w1[e];
        if (!first) acc += xm[e] * w0[e];
        if (!last) acc += xp[e] * w2[e];
        o[e] = acc * fast_rcp(1.0f + fast_exp2(-LOG2E * acc));
      }
      if (c8 < 256) *(u32x4*)(p.MQ + ((size_t)b * TK + s) * 256 + c8) = pack8f(o);
      else {
#pragma unroll
        for (int e = 0; e < 8; ++e) o[e] *= 0.125f;
        *(u32x4*)(p.MK + ((size_t)b * TK + s) * 256 + c8 - 256) = pack8f(o);
      }
    }
    }
#pragma unroll 1
    for (int w = 0; w < ((PARTS & 2) ? 4 : 0); ++w) {
      __syncthreads();
#pragma unroll
      for (int k = 0; k < 4; ++k) {
        const int i = t + k * NTHR, tok = i >> 5, c8 = (i & 31) * 8;
        u32x4 v;
        if (w == 0) { float a[8]; const int h = c8 >> 6; unpack8(ldg16(KVRAW + (size_t)(r0 + tok) * 512 + h * 128 + 64 + (c8 & 63)), a); const float rkv = s_rstd[tok * 2 + 1];
#pragma unroll
          for (int e = 0; e < 8; ++e) a[e] *= rkv;
          v = pack8f(a); }
        else v = ldg16(p.Z + (size_t)(r0 + tok) * NZP + (w == 1 ? ZC_DV : (w == 2 ? ZC_MLV : ZC_GV)) + c8);
        *(u32x4*)(s_t + tok * 264 + c8) = v;
      }
      __syncthreads();
      bf16_t* dst = w == 0 ? p.Vtm : (w == 1 ? p.Vtd : (w == 2 ? p.MVt : p.GVt));
#pragma unroll
      for (int k = 0; k < 4; ++k) {
        const int i = t + k * NTHR, tg = i & 3, ch = i >> 2;
        u32x4 v;
        v.x = (unsigned)s_t[(tg * 8 + 0) * 264 + ch] | ((unsigned)s_t[(tg * 8 + 1) * 264 + ch] << 16);
        v.y = (unsigned)s_t[(tg * 8 + 2) * 264 + ch] | ((unsigned)s_t[(tg * 8 + 3) * 264 + ch] << 16);
        v.z = (unsigned)s_t[(tg * 8 + 4) * 264 + ch] | ((unsigned)s_t[(tg * 8 + 5) * 264 + ch] << 16);
        v.w = (unsigned)s_t[(tg * 8 + 6) * 264 + ch] | ((unsigned)s_t[(tg * 8 + 7) * 264 + ch] << 16);
        *(u32x4*)(dst + (((size_t)b * 4 + (ch >> 6)) * 64 + (ch & 63)) * TK + s0 + tg * 8) = v;
      }
    }
    __syncthreads();
  }
}
constexpr int VROW = 136;
constexpr int VROW_A = 144;
template <int DQK> struct AttnCfg {
  static constexpr int KROW = DQK * 2 + 16;
  static constexpr int KBYTES = 64 * KROW, VBYTES = 64 * VROW_A, STAGE = KBYTES + VBYTES;
  static constexpr int KCH = 64 * DQK * 2 / 16 / NTHR;
};
DI bf16x8 pack8(const f32x16& x, int s) {
  u32x4 pk; pk.x = pack2bf(x[8 * s], x[8 * s + 1]); pk.y = pack2bf(x[8 * s + 2], x[8 * s + 3]); pk.z = pack2bf(x[8 * s + 4], x[8 * s + 5]); pk.w = pack2bf(x[8 * s + 6], x[8 * s + 7]);
  return __builtin_bit_cast(bf16x8, pk);
}
template <int DQK, int NMAP, int VAR = 0>
DI void attn_unit(const bf16_t* __restrict__ Qb, const bf16_t* __restrict__ Kb, size_t mstride, const bf16_t* __restrict__ Vt, int q0, int nkeys,
                  f32x16 (&O)[NMAP][2], float (&lsum)[NMAP], char* lds) {
  constexpr int DM = DQK / NMAP;
  constexpr int KS = DM / 16;
  using C = AttnCfg<DQK>;
  constexpr int CPM = 64 * DM * 2 / 16;
  constexpr int CPR = DM * 2 / 16;
  const int t = TIDX, lane = t & 63, wid = t >> 6, l31 = lane & 31, hh = lane >> 5;
  bf16x8 qf[NMAP][KS];
#pragma unroll
  for (int m = 0; m < NMAP; ++m)
#pragma unroll
    for (int ks = 0; ks < KS; ++ks) qf[m][ks] = *(const bf16x8*)(Qb + m * mstride + (size_t)(q0 + wid * 32 + l31) * DM + ks * 16 + 8 * hh);
  float mref[NMAP];
#pragma unroll
  for (int m = 0; m < NMAP; ++m) { mref[m] = 0.f; lsum[m] = 0.f; O[m][0] = (f32x16)(0.f); O[m][1] = (f32x16)(0.f); }
  u32x4 rk[C::KCH], rv[2];
  const bf16_t* kg[C::KCH]; int klds[C::KCH];
#pragma unroll
  for (int i = 0; i < C::KCH; ++i) { const int c = t + i * NTHR, m = c / CPM, cc = c % CPM; kg[i] = Kb + m * mstride + cc * 8; klds[i] = (cc / CPR) * C::KROW + m * DM * 2 + (cc % CPR) * 16; }
  const bf16_t* vg = Vt + (size_t)(t >> 3) * TK + (t & 7) * 8;
  const int vlds = C::KBYTES + (t >> 3) * VROW_A + ((t & 7) >> 1) * 32 + ((t & 1) ? 8 : 0);
  const int kfoff = l31 * C::KROW + 16 * hh, vfoff = C::KBYTES + l31 * VROW_A + 16 * hh;
  const int nt = nkeys / 64;
#pragma unroll
  for (int i = 0; i < C::KCH; ++i) rk[i] = ldg16(kg[i]);
  rv[0] = ldg16(vg); rv[1] = ldg16(vg + (size_t)32 * TK);
#pragma unroll 1
  for (int kt = 0; kt < nt; ++kt) {
    char* cur = lds + (kt & 1) * C::STAGE;
    if (VAR != 2) {
#pragma unroll
    for (int i = 0; i < C::KCH; ++i) sts16(cur + klds[i], rk[i]);
#pragma unroll
    for (int i = 0; i < 2; ++i) { char* d = cur + vlds + i * 32 * VROW_A; u32x2 lo, hi; lo.x = rv[i].x; lo.y = rv[i].y; hi.x = rv[i].z; hi.y = rv[i].w; *(u32x2*)d = lo; *(u32x2*)(d + 16) = hi; }
    __syncthreads();
    }
    if (VAR != 2 && kt + 1 < nt) {
#pragma unroll
      for (int i = 0; i < C::KCH; ++i) rk[i] = ldg16(kg[i] + (size_t)(kt + 1) * 64 * DM);
      rv[0] = ldg16(vg + (kt + 1) * 64); rv[1] = ldg16(vg + (size_t)32 * TK + (kt + 1) * 64);
    }
    bf16x8 kf[NMAP][2][KS];
#pragma unroll
    for (int k2 = 0; k2 < 2; ++k2)
#pragma unroll
      for (int ks = 0; ks < KS; ++ks) kf[0][k2][ks] = lds_frag(cur + kfoff + k2 * 32 * C::KROW + ks * 32);
    f32x16 S[NMAP][2];
    S[0][0] = (f32x16)(0.f); S[0][1] = (f32x16)(0.f);
#pragma unroll
    for (int ks = 0; ks < KS; ++ks)
#pragma unroll
      for (int k2 = 0; k2 < 2; ++k2) S[0][k2] = MFMA32(kf[0][k2][ks], qf[0][ks], S[0][k2]);
    bf16x8 vf[4][2];
#pragma unroll
    for (int kst = 0; kst < 4; ++kst)
#pragma unroll
      for (int dvt = 0; dvt < 2; ++dvt) vf[kst][dvt] = lds_frag(cur + vfoff + dvt * 32 * VROW_A + kst * 32);
#pragma unroll
    for (int m = 1; m < NMAP; ++m)
#pragma unroll
      for (int k2 = 0; k2 < 2; ++k2)
#pragma unroll
        for (int ks = 0; ks < KS; ++ks) kf[m][k2][ks] = lds_frag(cur + kfoff + k2 * 32 * C::KROW + m * DM * 2 + ks * 32);
#pragma unroll
    for (int m = 0; m < NMAP; ++m) {
      if (m > 0) {
        S[m][0] = (f32x16)(0.f); S[m][1] = (f32x16)(0.f);
#pragma unroll
        for (int ks = 0; ks < KS; ++ks)
#pragma unroll
          for (int k2 = 0; k2 < 2; ++k2) S[m][k2] = MFMA32(kf[m][k2][ks], qf[m][ks], S[m][k2]);
      }
      if (VAR != 1) {
      if ((kt & 7) == 0) {
        float mx = fmaxf(S[m][0][0], S[m][1][0]);
#pragma unroll
        for (int i = 1; i < 16; ++i) mx = fmaxf(mx, fmaxf(S[m][0][i], S[m][1][i]));
        mx = xor_max<32>(mx);
        const float rel = mx - mref[m];
        const float delta = (kt == 0) ? ((mx > ATT_THR || mx < -ATT_THR) ? mx : 0.0f) : (rel > ATT_THR ? rel : 0.0f);
        if (wave_any(delta != 0.0f)) {
          const float alpha = fast_exp2(-delta);
          mref[m] += delta; lsum[m] *= alpha;
#pragma unroll
          for (int dvt = 0; dvt < 2; ++dvt)
#pragma unroll
            for (int i = 0; i < 16; ++i) O[m][dvt][i] *= alpha;
        }
      }
      if (wave_any(mref[m] != 0.0f)) {
        const f32x2 nm = {-mref[m], -mref[m]};
#pragma unroll
        for (int k2 = 0; k2 < 2; ++k2)
#pragma unroll
          for (int i = 0; i < 16; i += 2) { const f32x2 x = (f32x2){S[m][k2][i], S[m][k2][i + 1]} + nm; S[m][k2][i] = x.x; S[m][k2][i + 1] = x.y; }
      }
      f32x2 ps2 = {0.f, 0.f};
#pragma unroll
      for (int k2 = 0; k2 < 2; ++k2)
#pragma unroll
        for (int i = 0; i < 16; i += 2) {
          const float e0 = fast_exp2(S[m][k2][i]), e1 = fast_exp2(S[m][k2][i + 1]);
          S[m][k2][i] = e0; S[m][k2][i + 1] = e1; ps2 += (f32x2){e0, e1};
        }
      lsum[m] += ps2.x + ps2.y;
      } else lsum[m] += 1.0f;
#pragma unroll
      for (int kst = 0; kst < 4; ++kst) {
        const bf16x8 pf = pack8(S[m][kst >> 1], kst & 1);
#pragma unroll
        for (int dvt = 0; dvt < 2; ++dvt) O[m][dvt] = MFMA32(vf[kst][dvt], pf, O[m][dvt]);
      }
    }
  }
  __syncthreads();
#pragma unroll
  for (int m = 0; m < NMAP; ++m) lsum[m] = xor_sum<32>(lsum[m]);
}
constexpr int ATT_QB = TK / 128;
constexpr int ATT_LDS = 2 * AttnCfg<96>::STAGE;
constexpr int ATT_QBL = TL / 128, ATT_QBC = TC / 128, ATT_LAT_UNITS = NB * 4 * ATT_QBL, ATT_UNITS = ATT_LAT_UNITS + NB * 4 * ATT_QBC;
DI void att_unit(int u, int& bh, int& qb) {
  if (u < ATT_LAT_UNITS) { bh = u / ATT_QBL; qb = ATT_QBC + u % ATT_QBL; } else { const int v = u - ATT_LAT_UNITS; bh = v / ATT_QBC; qb = v % ATT_QBC; }
}
DI void ph_attn_diff(const Params& p, int layer, int need_ctx, char* lds, int bid, int nblk) {
  const int lane = TIDX & 63, wid = TIDX >> 6, l31 = lane & 31, hh = lane >> 5;
  float lam_init; const float lam = lam_of(p, layer, lam_init);
#pragma unroll 1
  for (int u = bid; u < (need_ctx ? ATT_UNITS : ATT_LAT_UNITS); u += nblk) {
    int bh, qb; att_unit(u, bh, qb);
    const int b = bh >> 2, h = bh & 3, q0 = qb * 128;
    const int r = row_of(b, q0 + wid * 32 + l31);
    f32x16 O[2][2]; float ls[2];
    attn_unit<64, 2>(p.Qd + ((size_t)b * 8 + h * 2) * TK * 32, p.Kd + ((size_t)b * 8 + h * 2) * TK * 32, (size_t)TK * 32, p.Vtd + ((size_t)b * 4 + h) * 64 * TK, q0,
                     q0 < TC ? TC : TK, O, ls, lds);
    const float i0 = 1.0f / ls[0], i1 = lam / ls[1];
    float ss = 0.f;
#pragma unroll
    for (int dvt = 0; dvt < 2; ++dvt)
#pragma unroll
      for (int i = 0; i < 16; ++i) { const float o = O[0][dvt][i] * i0 - O[1][dvt][i] * i1; O[0][dvt][i] = o; ss += o * o; }
    ss = xor_sum<32>(ss);
    const float rstd = (1.0f - lam_init) / sqrtf(ss * (1.0f / 64) + 1e-6f);
    const float* gd = p.g_diff_out + layer * 256 + h * 64;
#pragma unroll
    for (int dvt = 0; dvt < 2; ++dvt)
#pragma unroll
      for (int g = 0; g < 4; ++g) {
        const int dv = dvt * 32 + 8 * g + 4 * hh;
        const f32x4 gv = *(const f32x4*)(gd + dv);
        f32x4 o = {O[0][dvt][4 * g] * rstd * gv[0], O[0][dvt][4 * g + 1] * rstd * gv[1], O[0][dvt][4 * g + 2] * rstd * gv[2], O[0][dvt][4 * g + 3] * rstd * gv[3]};
        st_bf16x4(p.Y + (size_t)r * D + 768 + h * 64 + dv, o);
      }
  }
}
DI void ph_attn_mla(const Params& p, int need_ctx, char* lds, int bid, int nblk) {
  const int lane = TIDX & 63, wid = TIDX >> 6, l31 = lane & 31, hh = lane >> 5;
#pragma unroll 1
  for (int u = bid; u < (need_ctx ? ATT_UNITS : ATT_LAT_UNITS); u += nblk) {
    int bh, qb; att_unit(u, bh, qb);
    const int b = bh >> 2, h = bh & 3, q0 = qb * 128;
    const int r = row_of(b, q0 + wid * 32 + l31);
    f32x16 O[1][2]; float ls[1];
    attn_unit<96, 1>(p.Qm + ((size_t)b * 4 + h) * TK * 96, p.Km + ((size_t)b * 4 + h) * TK * 96, 0, p.Vtm + ((size_t)b * 4 + h) * 64 * TK, q0, q0 < TC ? TC : TK, O, ls, lds);
    const float inv = 1.0f / ls[0];
#pragma unroll
    for (int dvt = 0; dvt < 2; ++dvt)
#pragma unroll
      for (int g = 0; g < 4; ++g) {
        f32x4 o = {O[0][dvt][4 * g] * inv, O[0][dvt][4 * g + 1] * inv, O[0][dvt][4 * g + 2] * inv, O[0][dvt][4 * g + 3] * inv};
        st_bf16x4(p.Y + (size_t)r * D + h * 64 + dvt * 32 + 8 * g + 4 * hh, o);
      }
  }
}
template <int VAR> DI void ph_attn_mla_probe(const Params& p, char* lds, int bid, int nblk) {
  const int lane = TIDX & 63, wid = TIDX >> 6, l31 = lane & 31, hh = lane >> 5;
#pragma unroll 1
  for (int u = bid; u < ATT_LAT_UNITS; u += nblk) {
    int bh, qb; att_unit(u, bh, qb);
    const int b = bh >> 2, h = bh & 3, q0 = qb * 128;
    const int r = row_of(b, q0 + wid * 32 + l31);
    f32x16 O[1][2]; float ls[1];
    attn_unit<96, 1, VAR>(p.Qm + ((size_t)b * 4 + h) * TK * 96, p.Km + ((size_t)b * 4 + h) * TK * 96, 0, p.Vtm + ((size_t)b * 4 + h) * 64 * TK, q0, TK, O, ls, lds);
    const float inv = 1.0f / ls[0];
#pragma unroll
    for (int dvt = 0; dvt < 2; ++dvt)
#pragma unroll
      for (int g = 0; g < 4; ++g) {
        f32x4 o = {O[0][dvt][4 * g] * inv, O[0][dvt][4 * g + 1] * inv, O[0][dvt][4 * g + 2] * inv, O[0][dvt][4 * g + 3] * inv};
        *(f32x4*)(p.out + (size_t)r * D + h * 64 + dvt * 32 + 8 * g + 4 * hh) = o;
      }
  }
}
DI void ph_attn(const Params& p, int layer, int need_ctx, char* lds, int bid, int nblk) {
  ph_attn_diff(p, layer, need_ctx, lds, bid, nblk);
  ph_attn_mla(p, need_ctx, lds, bid, nblk);
}

DI float wave_sum(float v) {
  v = xor_sum<1>(v); v = xor_sum<2>(v); v = xor_sum<4>(v); v = xor_sum<8>(v); v = xor_sum<16>(v); v = xor_sum<32>(v);
  return v;
}
DI void ld_row16(const float* row, int lane, f32x4 (&v)[4]) {
#pragma unroll
  for (int i = 0; i < 4; ++i) v[i] = *(const f32x4*)(row + 256 * i + 4 * lane);
}
DI void ld_row16_bf(const bf16_t* row, int lane, f32x4 (&v)[4]) {
#pragma unroll
  for (int i = 0; i < 4; ++i) { const u32x2 u = *(const u32x2*)(row + 256 * i + 4 * lane); v[i] = (f32x4){u2f(u.x << 16), u2f(u.x & 0xffff0000u), u2f(u.y << 16), u2f(u.y & 0xffff0000u)}; }
}
DI void ph_modulate(const Params& p, int layer, const float* xl, const float* xcx, int bid, int nblk) {
  const int lane = TIDX & 63, wid = TIDX >> 6;
  const float* g = p.g_mix_pre + layer * 1024;
  for (int r = bid * 4 + wid; r < R; r += nblk * 4) {
    const int w = r < RL ? r / TL : 2;
    const float* mb = p.mods + (size_t)(layer * 3 + w) * 6144;
    const float* x = r < RL ? xl + (size_t)r * D : xcx + (size_t)(r - RL) * D;
    f32x4 xv[4], gv[4], sc[4], sh[4];
    ld_row16(x, lane, xv); ld_row16(g, lane, gv); ld_row16(mb + 1024, lane, sc); ld_row16(mb, lane, sh);
    float ss = 0.f;
#pragma unroll
    for (int i = 0; i < 4; ++i)
#pragma unroll
      for (int e = 0; e < 4; ++e) ss += xv[i][e] * xv[i][e];
    const float rstd = 1.0f / sqrtf(wave_sum(ss) * (1.0f / D) + 1e-6f);
#pragma unroll
    for (int i = 0; i < 4; ++i) {
      f32x4 o;
#pragma unroll
      for (int e = 0; e < 4; ++e) o[e] = xv[i][e] * rstd * gv[i][e] * (1.f + sc[i][e]) + sh[i][e];
      st_bf16x4(p.H + (size_t)r * D + 256 * i + 4 * lane, o);
    }
  }
}
DI void ph_resid_mix(const Params& p, int layer, const float* xl_in, const float* xc_in, int rows, int bid, int nblk) {
  const int lane = TIDX & 63, wid = TIDX >> 6;
  const float* wr = p.w_router + (size_t)layer * D * 16;
  for (int r = bid * 4 + wid; r < rows; r += nblk * 4) {
    const int w = r < RL ? r / TL : 2;
    const float* mb = p.mods + (size_t)(layer * 3 + w) * 6144;
    const float* xin = r < RL ? xl_in + (size_t)r * D : xc_in + (size_t)(r - RL) * D;
    float* xo = r < RL ? p.out + (size_t)r * D : p.xc + (size_t)(r - RL) * D;
    f32x4 yv[4], xv[4], a[4], c[4];
    ld_row16_bf(p.YO + (size_t)r * D, lane, yv); ld_row16(xin, lane, xv);
    float ss = 0.f;
#pragma unroll
    for (int i = 0; i < 4; ++i)
#pragma unroll
      for (int e = 0; e < 4; ++e) ss += yv[i][e] * yv[i][e];
    const float rstd = 1.0f / sqrtf(wave_sum(ss) * (1.0f / D) + 1e-6f);
    ld_row16(mb + 2 * 1024, lane, a); ld_row16(p.g_mix_post + layer * 1024, lane, c);
    float s2 = 0.f;
#pragma unroll
    for (int i = 0; i < 4; ++i) {
#pragma unroll
      for (int e = 0; e < 4; ++e) { xv[i][e] += a[i][e] * yv[i][e] * rstd * c[i][e]; s2 += xv[i][e] * xv[i][e]; }
      *(f32x4*)(xo + 256 * i + 4 * lane) = xv[i];
    }
    const float rstd2 = 1.0f / sqrtf(wave_sum(s2) * (1.0f / D) + 1e-6f);
    ld_row16(p.g_ffn_pre + layer * 1024, lane, a); ld_row16(mb + 4 * 1024, lane, c); ld_row16(mb + 3 * 1024, lane, yv);
    float lg[16];
#pragma unroll
    for (int e = 0; e < 16; ++e) lg[e] = 0.f;
#pragma unroll
    for (int i = 0; i < 4; ++i) {
      f32x4 h2;
#pragma unroll
      for (int e = 0; e < 4; ++e) h2[e] = xv[i][e] * rstd2 * a[i][e] * (1.f + c[i][e]) + yv[i][e];
      st_bf16x4(p.H + (size_t)r * D + 256 * i + 4 * lane, h2);
#pragma unroll
      for (int e = 0; e < 4; ++e) {
        const float* wk = wr + (size_t)(256 * i + 4 * lane + e) * 16;
#pragma unroll
        for (int q = 0; q < 4; ++q) { const f32x4 wv = *(const f32x4*)(wk + 4 * q); lg[4 * q] += h2[e] * wv[0]; lg[4 * q + 1] += h2[e] * wv[1]; lg[4 * q + 2] += h2[e] * wv[2]; lg[4 * q + 3] += h2[e] * wv[3]; }
      }
    }
#pragma unroll
    for (int e = 0; e < 16; ++e) lg[e] = wave_sum(lg[e]);
    float mx = lg[0];
#pragma unroll
    for (int e = 1; e < 16; ++e) mx = fmaxf(mx, lg[e]);
    float sm = 0.f;
#pragma unroll
    for (int e = 0; e < 16; ++e) { lg[e] = expf(lg[e] - mx); sm += lg[e]; }
    int b, s; bs_of(r, b, s);
    float mine = 0.f;
#pragma unroll
    for (int e = 0; e < 16; ++e) mine = (lane == e) ? lg[e] / sm : mine;
    if (lane < 16) p.AFF[((size_t)b * NE + lane) * TK + s] = mine;
  }
}
DI void ph_resid_ffn(const Params& p, int layer, int rows, int bid, int nblk) {
  const int lane = TIDX & 63, wid = TIDX >> 6;
  for (int r = bid * 4 + wid; r < rows; r += nblk * 4) {
    const int w = r < RL ? r / TL : 2;
    const float* mb = p.mods + (size_t)(layer * 3 + w) * 6144;
    float* xo = r < RL ? p.out + (size_t)r * D : p.xc + (size_t)(r - RL) * D;
    const int myinv = lane < NE ? p.INV[(size_t)r * NE + lane] : -1;
    f32x4 f[4];
#pragma unroll
    for (int i = 0; i < 4; ++i) f[i] = (f32x4){0.f, 0.f, 0.f, 0.f};
    for (int e = 0; e < NE; ++e) {
      const int sl = lane_bcast(myinv, e);
      if (sl >= 0) { f32x4 yv[4]; ld_row16_bf(p.YE + ((size_t)e * NSLOT + sl) * D, lane, yv);
#pragma unroll
        for (int i = 0; i < 4; ++i) f[i] += yv[i]; }
    }
    float ss = 0.f;
#pragma unroll
    for (int i = 0; i < 4; ++i)
#pragma unroll
      for (int e = 0; e < 4; ++e) ss += f[i][e] * f[i][e];
    const float rstd = 1.0f / sqrtf(wave_sum(ss) * (1.0f / D) + 1e-6f);
    f32x4 a[4], c[4], xv[4];
    ld_row16(mb + 5 * 1024, lane, a); ld_row16(p.g_ffn_post + layer * 1024, lane, c); ld_row16(xo, lane, xv);
#pragma unroll
    for (int i = 0; i < 4; ++i) {
#pragma unroll
      for (int e = 0; e < 4; ++e) xv[i][e] += a[i][e] * f[i][e] * rstd * c[i][e];
      *(f32x4*)(xo + 256 * i + 4 * lane) = xv[i];
    }
  }
}
DI void ph_mods(const Params& p, char* lds, int bid, int nblk) {
  float* sc = (float*)lds;
  const int t = TIDX;
  for (int i = t; i < 3 * 1024; i += NTHR) { const float v = i < 2048 ? p.c[i] : p.c_ctx[i - 2048]; sc[i] = v / (1.0f + expf(-v)); }
  __syncthreads();
#pragma unroll 1
  for (long gi = (long)bid * NTHR + t; gi < 2 * 3 * 6144; gi += (long)nblk * NTHR) {
    const int col = (int)(gi % 6144), w = (int)((gi / 6144) % 3), l = (int)(gi / (3 * 6144));
    const float* W = p.w_ada + (size_t)l * 1024 * 6144 + col; const float* s = sc + w * 1024;
    float acc[8];
#pragma unroll
    for (int q = 0; q < 8; ++q) acc[q] = 0.f;
#pragma unroll 1
    for (int k = 0; k < 1024; k += 8) {
#pragma unroll
      for (int q = 0; q < 8; ++q) acc[q] += s[k + q] * W[(size_t)(k + q) * 6144];
    }
    p.mods[gi] = ((acc[0] + acc[1]) + (acc[2] + acc[3])) + ((acc[4] + acc[5]) + (acc[6] + acc[7])) + p.b_ada[l * 6144 + col];
  }
  __syncthreads();
}
constexpr int TOPK_LDS = TL * 4 + 2048;
DI int block_sum_i(int v, int* red) {
  const int lane = TIDX & 63, wid = TIDX >> 6;
  v = xor_sum_i<1>(v); v = xor_sum_i<2>(v); v = xor_sum_i<4>(v); v = xor_sum_i<8>(v); v = xor_sum_i<16>(v); v = xor_sum_i<32>(v);
  __syncthreads();
  if (lane == 0) red[wid] = v;
  __syncthreads();
  return red[0] + red[1] + red[2] + red[3];
}
DI int block_excl_scan(int v, int* red) {
  const int lane = TIDX & 63, wid = TIDX >> 6;
  int inc = v;
#pragma unroll
  for (int d = 1; d < 64; d <<= 1) { const int o = lane_up(inc, d, lane); if (lane >= d) inc += o; }
  __syncthreads();
  if (lane == 63) red[wid] = inc;
  __syncthreads();
  int base = 0;
  for (int q = 0; q < wid; ++q) base += red[q];
  return base + inc - v;
}
DI void ph_topk(const Params& p, int need_ctx, char* lds, int bid, int nblk) {
  unsigned* vals = (unsigned*)lds; int* red = (int*)(lds + TL * 4 + 1024);
  const int t = TIDX;
  for (int u = bid; u < NB * NE * 2; u += nblk) {
    const int seg = u & 1, e = (u >> 1) % NE, b = u / (2 * NE);
    const int s0 = seg ? TC : 0, n = seg ? TL : TC, cap = seg ? CAPL : CAPC, slot0 = seg ? b * CAPL : NB * CAPL + b * CAPC;
    if (seg == 0 && !need_ctx) { for (int q = t; q < cap; q += NTHR) p.SEL[(size_t)e * NSLOT + slot0 + q] = -1; continue; }
    const float* a = p.AFF + ((size_t)b * NE + e) * TK + s0;
    const int vpt = (n + NTHR - 1) / NTHR, i0 = t * vpt, i1 = (i0 + vpt < n) ? i0 + vpt : n;
    for (int i = t; i < n; i += NTHR) vals[i + i / vpt] = f2u(a[i]);
    __syncthreads();
    unsigned thr = 0;
    for (int bit = 31; bit >= 0; --bit) {
      const unsigned cand = thr | (1u << bit);
      int cnt = 0;
      for (int i = i0; i < i1; ++i) cnt += (vals[i + t] >= cand);
      if (block_sum_i(cnt, red) >= cap) thr = cand;
    }
    int cgt = 0, ceq = 0;
    for (int i = i0; i < i1; ++i) { cgt += (vals[i + t] > thr); ceq += (vals[i + t] == thr); }
    const int ngt = block_sum_i(cgt, red);
    const int neq = cap - ngt;
    int eqoff = block_excl_scan(ceq, red);
    int csel = 0;
    { int er = eqoff; for (int i = i0; i < i1; ++i) { if (vals[i + t] > thr) ++csel; else if (vals[i + t] == thr) { if (er < neq) ++csel; ++er; } } }
    int q = block_excl_scan(csel, red);
    for (int i = i0; i < i1; ++i) {
      const unsigned v = vals[i + t]; int sel = -1;
      if (v > thr) sel = q++; else if (v == thr) { if (eqoff < neq) sel = q++; ++eqoff; }
      const int r = row_of(b, s0 + i);
      if (sel >= 0) { p.SEL[(size_t)e * NSLOT + slot0 + sel] = r; p.SELV[(size_t)e * NSLOT + slot0 + sel] = u2f(v); }
      p.INV[(size_t)r * NE + e] = sel >= 0 ? slot0 + sel : -1;
    }
    __syncthreads();
  }
}
DI void ph_wt(const float* in, bf16_t* out, int K, int N, int NP, int nbatch, long in_bs, long out_bs, const float* gain, char* lds, int bid, int nblk) {
  float* tile = (float*)lds;
  const int t = TIDX, tk = K / 64, tn = NP / 64, ntile = nbatch * tk * tn;
  f32x4 v[4];
  auto gload = [&](int u) {
    const int bt = u / (tk * tn), rem = u % (tk * tn), k0 = (rem / tn) * 64, n0 = (rem % tn) * 64;
    const float* I = in + (size_t)bt * in_bs;
#pragma unroll
    for (int i = 0; i < 4; ++i) {
      const int idx = t + i * NTHR, kk = idx >> 4, n4 = (idx & 15) * 4;
      v[i] = (f32x4){0.f, 0.f, 0.f, 0.f};
      if (n0 + n4 < N) v[i] = *(const f32x4*)(I + (size_t)(k0 + kk) * N + n0 + n4);
      if (gain) { const float g = gain[k0 + kk]; v[i][0] *= g; v[i][1] *= g; v[i][2] *= g; v[i][3] *= g; }
    }
  };
  if (bid < ntile) gload(bid);
#pragma unroll 1
  for (int u = bid; u < ntile; u += nblk) {
    const int bt = u / (tk * tn), rem = u % (tk * tn), k0 = (rem / tn) * 64, n0 = (rem % tn) * 64;
    bf16_t* O = out + (size_t)bt * out_bs;
#pragma unroll
    for (int i = 0; i < 4; ++i) { const int idx = t + i * NTHR, kk = idx >> 4, n4 = (idx & 15) * 4; float* d = tile + kk * 65 + n4; d[0] = v[i][0]; d[1] = v[i][1]; d[2] = v[i][2]; d[3] = v[i][3]; }
    __syncthreads();
    if (u + nblk < ntile) gload(u + nblk);
#pragma unroll
    for (int i = 0; i < 2; ++i) {
      const int idx = t + i * NTHR, kg = idx & 7, nn = idx >> 3;
      float a[8];
#pragma unroll
      for (int e = 0; e < 8; ++e) a[e] = tile[(kg * 8 + e) * 65 + nn];
      u32x4 o; o.x = pack2bf(a[0], a[1]); o.y = pack2bf(a[2], a[3]); o.z = pack2bf(a[4], a[5]); o.w = pack2bf(a[6], a[7]);
      *(u32x4*)(O + (size_t)(n0 + nn) * K + k0 + kg * 8) = o;
    }
    __syncthreads();
  }
}
DI float wave_max(float v) {
  v = xor_max<1>(v); v = xor_max<2>(v); v = xor_max<4>(v); v = xor_max<8>(v); v = xor_max<16>(v); v = xor_max<32>(v);
  return v;
}
DI bf16x8 cvt8(const float* f) {
  const f32x4 a = *(const f32x4*)f, b = *(const f32x4*)(f + 4);
  u32x4 pk; pk.x = pack2bf(a[0], a[1]); pk.y = pack2bf(a[2], a[3]); pk.z = pack2bf(b[0], b[1]); pk.w = pack2bf(b[2], b[3]);
  return __builtin_bit_cast(bf16x8, pk);
}
constexpr int SCAN_UNITS = NB * NCK * 4, SCAN_LAT_UNITS = NB * NCL * 4;
DI void scan_unit(int u, int& b, int& c, int& h) {
  h = u & 3;
  if (u < SCAN_LAT_UNITS) { c = NCC + (u >> 2) % NCL; b = u / (4 * NCL); } else { const int v = u - SCAN_LAT_UNITS; c = (v >> 2) % NCC; b = v / (4 * NCC); }
}

DI void ph_ml_local(const Params& p, char* lds, int bid, int nblk) {
  bf16_t* sK = (bf16_t*)lds;
  float* sW = (float*)(lds + 64 * 132);
  const int t = TIDX, lane = t & 63, wid = t >> 6, l31 = lane & 31, hh = lane >> 5;
  const int d = wid & 1, vt = wid >> 1;
#pragma unroll 1
  for (int u = bid; u < SCAN_UNITS; u += nblk) {
    int b, c, h; scan_unit(u, b, c, h);
    {
      const int row = t >> 2, seg = (t & 3) * 16;
      const bf16_t* src = p.MK + ((size_t)b * TK + 64 * c + row) * 256 + h * 64 + seg;
      const u32x4 a = ldg16(src), bb = ldg16(src + 8);
      unsigned* dst = (unsigned*)((char*)sK + row * 132 + seg * 2);
      dst[0] = a.x; dst[1] = a.y; dst[2] = a.z; dst[3] = a.w; dst[4] = bb.x; dst[5] = bb.y; dst[6] = bb.z; dst[7] = bb.w;
    }
    if (t < 128) {
      const int dd = t >> 6, l = t & 63, j = step_of(dd, c), pos = dd ? 63 - l : l;
      const size_t o = (((size_t)b * 2 + dd) * TK + 64 * j) * 4 + h;
      const float bend = p.BC[o + 63 * 4], wl = bend - p.BC[o + pos * 4] + p.IGS[o + pos * 4];
      const float ml = wave_max(wl);
      sW[dd * 64 + l] = expf(wl - ml);
      if (l == 0) { const size_t uu = (((size_t)b * 2 + dd) * NCK + j) * 4 + h; p.MM[uu * 4] = ml; p.MM[uu * 4 + 1] = bend; }
    }
    __syncthreads();
    const int j = step_of(d, c);
    const size_t uu = (((size_t)b * 2 + d) * NCK + j) * 4 + h;
    f32x16 acc[2]; acc[0] = (f32x16)(0.f); acc[1] = (f32x16)(0.f);
    const bf16_t* vsrc = p.MVt + (((size_t)b * 4 + h) * 64 + vt * 32 + l31) * TK + 64 * c;
#pragma unroll
    for (int ks = 0; ks < 4; ++ks) {
      const bf16x8 a = *(const bf16x8*)(vsrc + ks * 16 + 8 * hh);
      const float* w = sW + d * 64 + ks * 16 + 8 * hh;
      u32x4 pk;
      pk.x = pack2bf(bf2f((bf16_t)a[0]) * w[0], bf2f((bf16_t)a[1]) * w[1]); pk.y = pack2bf(bf2f((bf16_t)a[2]) * w[2], bf2f((bf16_t)a[3]) * w[3]);
      pk.z = pack2bf(bf2f((bf16_t)a[4]) * w[4], bf2f((bf16_t)a[5]) * w[5]); pk.w = pack2bf(bf2f((bf16_t)a[6]) * w[6], bf2f((bf16_t)a[7]) * w[7]);
      const bf16x8 af = __builtin_bit_cast(bf16x8, pk);
#pragma unroll
      for (int kt = 0; kt < 2; ++kt) {
        bf16x8 bfr;
#pragma unroll
        for (int q = 0; q < 8; ++q) bfr[q] = (short)sK[(ks * 16 + 8 * hh + q) * 66 + kt * 32 + l31];
        acc[kt] = MFMA32(af, bfr, acc[kt]);
      }
    }
#pragma unroll
    for (int kt = 0; kt < 2; ++kt)
#pragma unroll
      for (int i = 0; i < 16; ++i) p.MC[uu * 4096 + (size_t)(vt * 32 + (i & 3) + 8 * (i >> 2) + 4 * hh) * 64 + kt * 32 + l31] = acc[kt][i];
    float nl = 0.f;
    for (int q = 0; q < 32; ++q) { const int l = hh * 32 + q; nl += sW[d * 64 + l] * bf2f(sK[l * 66 + vt * 32 + l31]); }
    nl = xor_sum<32>(nl);
    if (hh == 0) p.MN[uu * 64 + vt * 32 + l31] = nl;
    __syncthreads();
  }
}
DI void ph_ml_scan(const Params& p, int bid, int nblk) {
  for (long gi = (long)bid * NTHR + TIDX; gi < (long)NB * 2 * 4 * 4160; gi += (long)nblk * NTHR) {
    const int e = (int)(gi % 4160), ch = (int)(gi / 4160), h = ch & 3, bd = ch >> 2;
    float* base = e < 4096 ? p.MC + (((size_t)bd * NCK) * 4 + h) * 4096 + e : p.MN + (((size_t)bd * NCK) * 4 + h) * 64 + (e - 4096);
    const size_t stride = e < 4096 ? 4 * 4096 : 4 * 64;
    float* mm = p.MM + (((size_t)bd * NCK) * 4 + h) * 4;
    float st = 0.f, m = -1e30f;
    float cl[8], cm[8], cb[8], nl[8], nm[8], nb[8];
#pragma unroll
    for (int q = 0; q < 8; ++q) { cl[q] = base[(size_t)q * stride]; cm[q] = mm[q * 16]; cb[q] = mm[q * 16 + 1]; }
#pragma unroll 1
    for (int jb = 0; jb < NCK; jb += 8) {
#pragma unroll
      for (int q = 0; q < 8; ++q) { const int j = jb + 8 + q; if (j < NCK) { nl[q] = base[(size_t)j * stride]; nm[q] = mm[j * 16]; nb[q] = mm[j * 16 + 1]; } }
#pragma unroll
      for (int q = 0; q < 8; ++q) {
        const int j = jb + q;
        if (j < NCK) {
          const float mn = fmaxf(cb[q] + m, cm[q]), a = expf(cb[q] + m - mn), g = expf(cm[q] - mn);
          base[(size_t)j * stride] = st;
          st = a * st + g * cl[q];
          if (e == 0) mm[j * 16 + 2] = m;
          m = mn;
        }
      }
#pragma unroll
      for (int q = 0; q < 8; ++q) { cl[q] = nl[q]; cm[q] = nm[q]; cb[q] = nb[q]; }
    }
  }
}
DI void ph_gla_scan(const Params& p, int bid, int nblk) {
  for (long gi = (long)bid * NTHR + TIDX; gi < (long)NB * 2 * 4 * 2048; gi += (long)nblk * NTHR) {
    const int e = (int)(gi % 2048), ch = (int)(gi / 2048), h = ch & 3, bd = ch >> 2, k = e & 31;
    float* base = p.GS + (((size_t)bd * NCK) * 4 + h) * 2048 + e;
    const float* ge = p.GC + ((size_t)bd * TK + 63) * 128 + h * 32 + k;
    float st = 0.f;
    float cl[8], cg[8], nl[8], ng[8];
#pragma unroll
    for (int q = 0; q < 8; ++q) { cl[q] = base[(size_t)q * 4 * 2048]; cg[q] = ge[(size_t)q * 64 * 128]; }
#pragma unroll 1
    for (int jb = 0; jb < NCK; jb += 8) {
#pragma unroll
      for (int q = 0; q < 8; ++q) { const int j = jb + 8 + q; if (j < NCK) { nl[q] = base[(size_t)j * 4 * 2048]; ng[q] = ge[(size_t)j * 64 * 128]; } }
#pragma unroll
      for (int q = 0; q < 8; ++q) {
        const int j = jb + q;
        if (j < NCK) { base[(size_t)j * 4 * 2048] = st; st = expf(cg[q]) * st + cl[q]; }
      }
#pragma unroll
      for (int q = 0; q < 8; ++q) { cl[q] = nl[q]; cg[q] = ng[q]; }
    }
  }
}
constexpr int MO_K = 0, MO_V = 64 * 144, MO_A = MO_V + 64 * VROW, MO_PM = MO_A + 512, MO_N0 = MO_PM + 512, MO_X = MO_N0 + 512, MO_LDS = MO_X + 16384;
DI void ph_ml_out(const Params& p, int layer, int need_ctx, char* lds, int bid, int nblk) {
  float* sA = (float*)(lds + MO_A); float* sPM = (float*)(lds + MO_PM); float* sN0 = (float*)(lds + MO_N0); float* sX = (float*)(lds + MO_X);
  const int t = TIDX, lane = t & 63, wid = t >> 6, l31 = lane & 31, hh = lane >> 5;
  const int lt = wid & 1, d = wid >> 1;
#pragma unroll 1
  for (int u = bid; u < (need_ctx ? SCAN_UNITS : SCAN_LAT_UNITS); u += nblk) {
    int b, c, h; scan_unit(u, b, c, h);
    {
      const int row = t >> 2, seg = (t & 3) * 16;
      const bf16_t* ks = p.MK + ((size_t)b * TK + 64 * c + row) * 256 + h * 64 + seg;
      sts16(lds + MO_K + row * 144 + seg * 2, ldg16(ks)); sts16(lds + MO_K + row * 144 + seg * 2 + 16, ldg16(ks + 8));
      const bf16_t* vs = p.MVt + (((size_t)b * 4 + h) * 64 + row) * TK + 64 * c + seg;
      const u32x4 v0 = ldg16(vs), v1 = ldg16(vs + 8);
      u32x2* dv = (u32x2*)(lds + MO_V + row * VROW + seg * 2);
      u32x2 q; q.x = v0.x; q.y = v0.y; dv[0] = q; q.x = v0.z; q.y = v0.w; dv[1] = q; q.x = v1.x; q.y = v1.y; dv[2] = q; q.x = v1.z; q.y = v1.w; dv[3] = q;
    }
    if (t < 128) {
      const int dd = t >> 6, s = t & 63, j = step_of(dd, c), pos = dd ? 63 - s : s;
      const size_t o = (((size_t)b * 2 + dd) * TK + 64 * j) * 4 + h;
      sA[dd * 64 + s] = p.IGS[o + pos * 4] - p.BC[o + pos * 4];
      const size_t uu = (((size_t)b * 2 + dd) * NCK + j) * 4 + h;
      sN0[dd * 64 + s] = p.MN[uu * 64 + s];
    }
    __syncthreads();
    if (t < 2) {
      float m = -1e30f;
      if (t == 0) { for (int s = 0; s < 64; ++s) { m = fmaxf(m, sA[s]); sPM[s] = m; } }
      else { for (int s = 63; s >= 0; --s) { m = fmaxf(m, sA[64 + s]); sPM[64 + s] = m; } }
    }
    __syncthreads();
    const int j = step_of(d, c);
    const size_t uu = (((size_t)b * 2 + d) * NCK + j) * 4 + h;
    const int l = lt * 32 + l31, pos = d ? 63 - l : l;
    const float bl = p.BC[(((size_t)b * 2 + d) * TK + 64 * j + pos) * 4 + h];
    const float inter = bl + p.MM[uu * 4 + 2];
    const float mt = fmaxf(inter, bl + sPM[d * 64 + l]);
    const float aint = expf(inter - mt);
    bf16x8 qf[4];
#pragma unroll
    for (int ks = 0; ks < 4; ++ks) qf[ks] = *(const bf16x8*)(p.MQ + ((size_t)b * TK + 64 * c + l) * 256 + h * 64 + ks * 16 + 8 * hh);
    f32x16 num[2]; num[0] = (f32x16)(0.f); num[1] = (f32x16)(0.f);
    float den = 0.f;
#pragma unroll
    for (int st = 0; st < 2; ++st) {
      if (d == 0 ? st <= lt : st >= lt) {
        f32x16 S = (f32x16)(0.f);
#pragma unroll
        for (int ks = 0; ks < 4; ++ks) S = MFMA32(lds_frag(lds + MO_K + (st * 32 + l31) * 144 + (ks * 16 + 8 * hh) * 2), qf[ks], S);
#pragma unroll
        for (int i = 0; i < 16; ++i) {
          const int s = st * 32 + (i & 3) + 8 * (i >> 2) + 4 * hh;
          const bool ok = d == 0 ? s <= l : s >= l;
          const float e = ok ? fast_exp2((bl + sA[d * 64 + s] - mt) * LOG2E) * S[i] : 0.f;
          S[i] = e; den += e;
        }
#pragma unroll
        for (int kst = 0; kst < 2; ++kst) {
          const bf16x8 pf = pack8(S, kst);
#pragma unroll
          for (int vt = 0; vt < 2; ++vt) {
            const char* vp = lds + MO_V + (vt * 32 + l31) * VROW + (st * 32 + kst * 16 + 4 * hh) * 2;
            const s16x4 lo = *(const s16x4*)vp, hi = *(const s16x4*)(vp + 16);
            num[vt] = MFMA32(__builtin_shufflevector(lo, hi, 0, 1, 2, 3, 4, 5, 6, 7), pf, num[vt]);
          }
        }
      }
    }
    f32x16 accI[2]; accI[0] = (f32x16)(0.f); accI[1] = (f32x16)(0.f);
#pragma unroll
    for (int vt = 0; vt < 2; ++vt)
#pragma unroll
      for (int ks = 0; ks < 4; ++ks) accI[vt] = MFMA32(cvt8(p.MC + uu * 4096 + (size_t)(vt * 32 + l31) * 64 + ks * 16 + 8 * hh), qf[ks], accI[vt]);
    float qn = 0.f;
#pragma unroll
    for (int ks = 0; ks < 4; ++ks)
#pragma unroll
      for (int q = 0; q < 8; ++q) qn += bf2f((bf16_t)qf[ks][q]) * sN0[d * 64 + ks * 16 + 8 * hh + q];
    den = xor_sum<32>(den + aint * qn);
    const float inv = 1.0f / fmaxf(fabsf(den), expf(-mt));
#pragma unroll
    for (int vt = 0; vt < 2; ++vt)
#pragma unroll
      for (int i = 0; i < 16; ++i) num[vt][i] = (num[vt][i] + aint * accI[vt][i]) * inv;
    if (d == 1) {
#pragma unroll
      for (int vt = 0; vt < 2; ++vt)
#pragma unroll
        for (int i = 0; i < 16; ++i) sX[(lt * 32 + vt * 16 + i) * 64 + lane] = num[vt][i];
    }
    __syncthreads();
    if (d == 0) {
      float ss = 0.f;
#pragma unroll
      for (int vt = 0; vt < 2; ++vt)
#pragma unroll
        for (int i = 0; i < 16; ++i) { num[vt][i] += sX[(lt * 32 + vt * 16 + i) * 64 + lane]; ss += num[vt][i] * num[vt][i]; }
      ss = xor_sum<32>(ss);
      const float rstd = 1.0f / sqrtf(ss * (1.0f / 64) + 1e-6f);
      const int r = row_of(b, 64 * c + l);
#pragma unroll
      for (int vt = 0; vt < 2; ++vt)
#pragma unroll
        for (int g = 0; g < 4; ++g) {
          const int v0 = vt * 32 + 8 * g + 4 * hh;
          const u32x2 ou = *(const u32x2*)(p.Z + (size_t)r * NZP + ZC_MLO + h * 64 + v0);
          const f32x4 gv = *(const f32x4*)(p.g_mlstm_out + layer * 256 + h * 64 + v0);
          const float o0 = u2f(ou.x << 16), o1 = u2f(ou.x & 0xffff0000u), o2 = u2f(ou.y << 16), o3 = u2f(ou.y & 0xffff0000u);
          f32x4 y = {sigmoidf_(o0) * num[vt][4 * g] * rstd * gv[0], sigmoidf_(o1) * num[vt][4 * g + 1] * rstd * gv[1],
                     sigmoidf_(o2) * num[vt][4 * g + 2] * rstd * gv[2], sigmoidf_(o3) * num[vt][4 * g + 3] * rstd * gv[3]};
          st_bf16x4(p.Y + (size_t)r * D + 256 + h * 64 + v0, y);
        }
    }
    __syncthreads();
  }
}
DI void ph_gla_local(const Params& p, char* lds, int bid, int nblk) {
  bf16_t* sKd = (bf16_t*)lds;
  const int t = TIDX, lane = t & 63, wid = t >> 6, l31 = lane & 31, hh = lane >> 5;
  const int d = wid & 1, vt = wid >> 1;
#pragma unroll 1
  for (int u = bid; u < SCAN_UNITS; u += nblk) {
    int b, c, h; scan_unit(u, b, c, h);
    {
      const int dd = t >> 7, l = (t >> 1) & 63, k0 = (t & 1) * 16, j = step_of(dd, c), pos = dd ? 63 - l : l;
      const float* gcr = p.GC + (((size_t)b * 2 + dd) * TK + 64 * j + pos) * 128 + h * 32 + k0;
      const float* ger = p.GC + (((size_t)b * 2 + dd) * TK + 64 * j + 63) * 128 + h * 32 + k0;
      const bf16_t* kr = p.Z + (size_t)row_of(b, 64 * c + l) * NZP + ZC_GK + h * 32 + k0;
#pragma unroll
      for (int q = 0; q < 16; ++q) sKd[(dd * 64 + l) * 33 + k0 + q] = f2bf(bf2f(kr[q]) * fast_exp2((ger[q] - gcr[q]) * LOG2E));
    }
    __syncthreads();
    const int j = step_of(d, c);
    const size_t uu = (((size_t)b * 2 + d) * NCK + j) * 4 + h;
    f32x16 acc = (f32x16)(0.f);
    const bf16_t* vsrc = p.GVt + (((size_t)b * 4 + h) * 64 + vt * 32 + l31) * TK + 64 * c;
#pragma unroll
    for (int ks = 0; ks < 4; ++ks) {
      const bf16x8 af = *(const bf16x8*)(vsrc + ks * 16 + 8 * hh);
      bf16x8 bfr;
#pragma unroll
      for (int q = 0; q < 8; ++q) bfr[q] = (short)sKd[(d * 64 + ks * 16 + 8 * hh + q) * 33 + l31];
      acc = MFMA32(af, bfr, acc);
    }
#pragma unroll
    for (int i = 0; i < 16; ++i) p.GS[uu * 2048 + (size_t)(vt * 32 + (i & 3) + 8 * (i >> 2) + 4 * hh) * 32 + l31] = acc[i];
    __syncthreads();
  }
}
constexpr int GO_Q = 0, GO_K = 2 * 64 * 80, GO_V = 2 * GO_K, GO_X = GO_V + 64 * VROW, GO_LDS = GO_X + 16384;
DI void ph_gla_out(const Params& p, int layer, int need_ctx, char* lds, int bid, int nblk) {
  float* sX = (float*)(lds + GO_X);
  const int t = TIDX, lane = t & 63, wid = t >> 6, l31 = lane & 31, hh = lane >> 5;
  const int lt = wid & 1, d = wid >> 1;
#pragma unroll 1
  for (int u = bid; u < (need_ctx ? SCAN_UNITS : SCAN_LAT_UNITS); u += nblk) {
    int b, c, h; scan_unit(u, b, c, h);
    {
      const int dd = t >> 7, l = (t >> 1) & 63, k0 = (t & 1) * 16, j = step_of(dd, c), pos = dd ? 63 - l : l;
      const float* gcr = p.GC + (((size_t)b * 2 + dd) * TK + 64 * j + pos) * 128 + h * 32 + k0;
      const bf16_t* zr = p.Z + (size_t)row_of(b, 64 * c + l) * NZP;
      bf16_t* qd = (bf16_t*)(lds + GO_Q + (dd * 64 + l) * 80) + k0; bf16_t* kd = (bf16_t*)(lds + GO_K + (dd * 64 + l) * 80) + k0;
#pragma unroll
      for (int q = 0; q < 16; ++q) {
        const float g = gcr[q];
        qd[q] = f2bf(bf2f(zr[ZC_GQ + h * 32 + k0 + q]) * 0.17677669529663687f * fast_exp2(g * LOG2E));
        kd[q] = f2bf(bf2f(zr[ZC_GK + h * 32 + k0 + q]) * fast_exp2(-g * LOG2E));
      }
      const int row = t >> 2, seg = (t & 3) * 16;
      const bf16_t* vs = p.GVt + (((size_t)b * 4 + h) * 64 + row) * TK + 64 * c + seg;
      const u32x4 v0 = ldg16(vs), v1 = ldg16(vs + 8);
      u32x2* dv = (u32x2*)(lds + GO_V + row * VROW + seg * 2);
      u32x2 q2; q2.x = v0.x; q2.y = v0.y; dv[0] = q2; q2.x = v0.z; q2.y = v0.w; dv[1] = q2; q2.x = v1.x; q2.y = v1.y; dv[2] = q2; q2.x = v1.z; q2.y = v1.w; dv[3] = q2;
    }
    __syncthreads();
    const int j = step_of(d, c);
    const size_t uu = (((size_t)b * 2 + d) * NCK + j) * 4 + h;
    const int l = lt * 32 + l31;
    bf16x8 qf[2];
#pragma unroll
    for (int ks = 0; ks < 2; ++ks) qf[ks] = lds_frag(lds + GO_Q + (d * 64 + l) * 80 + (ks * 16 + 8 * hh) * 2);
    f32x16 O[2]; O[0] = (f32x16)(0.f); O[1] = (f32x16)(0.f);
#pragma unroll
    for (int st = 0; st < 2; ++st) {
      if (d == 0 ? st <= lt : st >= lt) {
        f32x16 S = (f32x16)(0.f);
#pragma unroll
        for (int ks = 0; ks < 2; ++ks) S = MFMA32(lds_frag(lds + GO_K + (d * 64 + st * 32 + l31) * 80 + (ks * 16 + 8 * hh) * 2), qf[ks], S);
#pragma unroll
        for (int i = 0; i < 16; ++i) {
          const int s = st * 32 + (i & 3) + 8 * (i >> 2) + 4 * hh;
          const bool ok = d == 0 ? s <= l : s >= l;
          S[i] = ok ? S[i] : 0.f;
        }
#pragma unroll
        for (int kst = 0; kst < 2; ++kst) {
          const bf16x8 pf = pack8(S, kst);
#pragma unroll
          for (int vt = 0; vt < 2; ++vt) {
            const char* vp = lds + GO_V + (vt * 32 + l31) * VROW + (st * 32 + kst * 16 + 4 * hh) * 2;
            const s16x4 lo = *(const s16x4*)vp, hi = *(const s16x4*)(vp + 16);
            O[vt] = MFMA32(__builtin_shufflevector(lo, hi, 0, 1, 2, 3, 4, 5, 6, 7), pf, O[vt]);
          }
        }
      }
    }
#pragma unroll
    for (int vt = 0; vt < 2; ++vt)
#pragma unroll
      for (int ks = 0; ks < 2; ++ks) O[vt] = MFMA32(cvt8(p.GS + uu * 2048 + (size_t)(vt * 32 + l31) * 32 + ks * 16 + 8 * hh), qf[ks], O[vt]);
    if (d == 1) {
#pragma unroll
      for (int vt = 0; vt < 2; ++vt)
#pragma unroll
        for (int i = 0; i < 16; ++i) sX[(lt * 32 + vt * 16 + i) * 64 + lane] = O[vt][i];
    }
    __syncthreads();
    if (d == 0) {
      float ss = 0.f;
#pragma unroll
      for (int vt = 0; vt < 2; ++vt)
#pragma unroll
        for (int i = 0; i < 16; ++i) { O[vt][i] += sX[(lt * 32 + vt * 16 + i) * 64 + lane]; ss += O[vt][i] * O[vt][i]; }
      ss = xor_sum<32>(ss);
      const float rstd = 1.0f / sqrtf(ss * (1.0f / 64) + 1e-6f);
      const int r = row_of(b, 64 * c + l);
#pragma unroll
      for (int vt = 0; vt < 2; ++vt)
#pragma unroll
        for (int g = 0; g < 4; ++g) {
          const int v0 = vt * 32 + 8 * g + 4 * hh;
          const u32x2 ru = *(const u32x2*)(p.Z + (size_t)r * NZP + ZC_GR + h * 64 + v0);
          const f32x4 gv = *(const f32x4*)(p.g_gla_out + layer * 256 + h * 64 + v0);
          const float r0 = u2f(ru.x << 16), r1 = u2f(ru.x & 0xffff0000u), r2 = u2f(ru.y << 16), r3 = u2f(ru.y & 0xffff0000u);
          f32x4 y = {siluf_(r0) * O[vt][4 * g] * rstd * gv[0], siluf_(r1) * O[vt][4 * g + 1] * rstd * gv[1],
                     siluf_(r2) * O[vt][4 * g + 2] * rstd * gv[2], siluf_(r3) * O[vt][4 * g + 3] * rstd * gv[3]};
          st_bf16x4(p.Y + (size_t)r * D + 512 + h * 64 + v0, y);
        }
    }
    __syncthreads();
  }
}

DI float fast_logsigmoid(float x) {
  const float e = fast_exp2(-fabsf(x) * LOG2E);
#ifdef CPU_EMU
  return fminf(x, 0.f) - log1pf(e);
#else
  return fminf(x, 0.f) - 0.6931471805599453f * __builtin_amdgcn_logf(1.0f + e);
#endif
}
DI float wave_incl_scan(float v, int lane) {
#pragma unroll
  for (int dd = 1; dd < 64; dd <<= 1) { const float o = u2f((unsigned)lane_up((int)f2u(v), dd, lane)); if (lane >= dd) v += o; }
  return v;
}
constexpr int GCUM_LDS = 4 * 64 * 33 * 4;
DI void ph_gates_cum(const Params& p, int layer, char* lds, int bid, int nblk) {
  const int t = TIDX, lane = t & 63, wid = t >> 6;
  float* stg = (float*)lds + wid * 64 * 33;
  const float* wal = p.w_alpha2 + (size_t)layer * 2 * 16 * 128;
#pragma unroll 1
  for (int u = bid * 4 + wid; u < NB * 2 * NCK; u += nblk * 4) {
    const int j = u % NCK, d = (u / NCK) & 1, b = u / (2 * NCK);
    const int pp = 64 * j + lane, s = seq_of(d, pp);
    const bf16_t* z = p.Z + (size_t)row_of(b, s) * NZP;
    const size_t ob = ((size_t)b * 2 + d) * TK + pp;
    {
      const u32x2 iu = *(const u32x2*)(z + ZC_MLIG + d * 4), fu = *(const u32x2*)(z + ZC_MLFG + d * 4);
      const float ig[4] = {u2f(iu.x << 16), u2f(iu.x & 0xffff0000u), u2f(iu.y << 16), u2f(iu.y & 0xffff0000u)};
      const float fg[4] = {u2f(fu.x << 16), u2f(fu.x & 0xffff0000u), u2f(fu.y << 16), u2f(fu.y & 0xffff0000u)};
      f32x4 oc, oi;
#pragma unroll
      for (int h = 0; h < 4; ++h) {
        oi[h] = ig[h] + p.b_igate[layer * 8 + d * 4 + h];
        oc[h] = wave_incl_scan(fast_logsigmoid(fg[h] + p.b_fgate[layer * 8 + d * 4 + h]), lane);
      }
      *(f32x4*)(p.BC + ob * 4) = oc; *(f32x4*)(p.IGS + ob * 4) = oi;
    }
    float a[16];
    { float f0[8], f1[8]; unpack8(ldg16(z + ZC_GA + d * 16), f0); unpack8(ldg16(z + ZC_GA + d * 16 + 8), f1);
#pragma unroll
      for (int q = 0; q < 8; ++q) { a[q] = f0[q]; a[8 + q] = f1[q]; } }
    const float* W = wal + (size_t)d * 16 * 128;
#pragma unroll 1
    for (int cg = 0; cg < 4; ++cg) {
#pragma unroll 4
      for (int c = 0; c < 32; ++c) {
        const int ch = cg * 32 + c;
        float zg = p.b_alpha[layer * 256 + d * 128 + ch];
#pragma unroll
        for (int q = 0; q < 16; ++q) zg += a[q] * W[q * 128 + ch];
        stg[lane * 33 + c] = wave_incl_scan(fast_logsigmoid(zg) * (1.0f / 16.0f), lane);
      }
      WAVE_SYNC();
#pragma unroll
      for (int k = 0; k < 32; ++k) { const int pos = k * 2 + (lane >> 5), c = lane & 31; p.GC[(((size_t)b * 2 + d) * TK + 64 * j + pos) * 128 + cg * 32 + c] = stg[pos * 33 + c]; }
      WAVE_SYNC();
    }
  }
}
#define XB_TMO      128
#define XB_XCNT(j)  (256  + 64 * (j))
#define XB_XSUB(j)  (1280 + 64 * (j))
#define XB_XGEN(j)  (2304 + 64 * (j))
#define XB_TOP      3328
#define XB_TOPGEN   3392
#define XCD_BAR_WORDS 3456
#define XB_SPIN_CAP (1u << 28)
#define LAS __attribute__((address_space(3)))

__device__ __forceinline__ unsigned xb_ld(unsigned* p)              { return __hip_atomic_load(p, __ATOMIC_RELAXED, __HIP_MEMORY_SCOPE_AGENT); }
__device__ __forceinline__ unsigned xb_add(unsigned* p, unsigned v) { return __hip_atomic_fetch_add(p, v, __ATOMIC_RELAXED, __HIP_MEMORY_SCOPE_AGENT); }
__device__ __forceinline__ unsigned xb_xcc_id() { return (unsigned)__builtin_amdgcn_s_getreg((3 << 11) | 20) & 0xFu; }
#define XB_SPIN(cond, bar) do { unsigned _sp = 0; while (cond) { __builtin_amdgcn_s_sleep(1); \
    if ((++_sp & 255u) == 0u) { if (xb_ld(&(bar)[XB_TMO])) break; if (_sp > XB_SPIN_CAP) { atomicAdd(&(bar)[XB_TMO], 1u); break; } } } } while (0)

struct XcdBarrier {
    unsigned* bar; unsigned x;
    volatile LAS unsigned* st;
};

__device__ __forceinline__ XcdBarrier xcd_barrier_post(unsigned* bar, volatile LAS unsigned* st) {
    XcdBarrier b; b.bar = bar; b.x = xb_xcc_id(); b.st = st;
    if (threadIdx.x == 0) (void)xb_add(&bar[XB_XCNT(b.x)], 1u);
    return b;
}
__device__ __forceinline__ void xcd_barrier_complete(unsigned* bar, unsigned x, unsigned& nloc, unsigned& nx) {
    const unsigned G = gridDim.x * gridDim.y * gridDim.z;
    unsigned sum, cnt, mine, sp = 0u;
    for (;;) {
        sum = 0u; cnt = 0u; mine = 0u;
#pragma unroll
        for (unsigned j = 0; j < 16; ++j) { const unsigned c = xb_ld(&bar[XB_XCNT(j)]); sum += c; cnt += (c > 0u) ? 1u : 0u; mine = (j == x) ? c : mine; }
        if (sum == G) break;
        __builtin_amdgcn_s_sleep(1);
        if ((++sp & 255u) == 0u) { if (xb_ld(&bar[XB_TMO])) break; if (sp > XB_SPIN_CAP) { atomicAdd(&bar[XB_TMO], 1u); break; } }
    }
    nloc = mine > 0u ? mine : 1u; nx = cnt > 0u ? cnt : 1u;
}

__device__ __forceinline__ void xcd_barrier(const XcdBarrier& b) {
    asm volatile("s_waitcnt vmcnt(0)" ::: "memory");
    __syncthreads();
    if (threadIdx.x == 0) {
        unsigned* bar = b.bar;
        __builtin_amdgcn_s_waitcnt(0);
        unsigned nloc = b.st[0], nx = b.st[1];
        if (nloc == 0u) { xcd_barrier_complete(bar, b.x, nloc, nx); b.st[0] = nloc; b.st[1] = nx; }
        const unsigned old = xb_add(&bar[XB_XSUB(b.x)], 1u);
        const unsigned gen = old / nloc;
        if (old + 1u == (gen + 1u) * nloc) {
            __builtin_amdgcn_fence(__ATOMIC_RELEASE, "agent");
            asm volatile("s_waitcnt vmcnt(0)" ::: "memory");
            const unsigned og = xb_add(&bar[XB_TOP], 1u);
            const unsigned tg = og / nx;
            if (og + 1u == (tg + 1u) * nx) xb_add(&bar[XB_TOPGEN], 1u);
            else XB_SPIN(xb_ld(&bar[XB_TOPGEN]) == tg, bar);
            __builtin_amdgcn_fence(__ATOMIC_ACQUIRE, "agent");
            xb_add(&bar[XB_XGEN(b.x)], 1u);
            asm volatile("s_waitcnt vmcnt(0)" ::: "memory");
        } else {
            XB_SPIN(xb_ld(&bar[XB_XGEN(b.x)]) == gen, bar);
            __builtin_amdgcn_fence(__ATOMIC_ACQUIRE, "agent");
            asm volatile("s_waitcnt vmcnt(0)" ::: "memory");
        }
    }
    __syncthreads();
}

#define GS_LOOP(N, CALL) for (long gi = (long)bid * NTHR + TIDX; gi < (long)(N); gi += (long)nblk * NTHR) { CALL; }
#ifndef PROBE
#define PROBE 0
#endif
#ifndef FAST_SCAN
#define FAST_SCAN 1
#endif
constexpr int N_PHASES = 16;
constexpr int MEGA_LDS = GEMM_LDS > TOPK_LDS ? GEMM_LDS : TOPK_LDS;

template <int PH>
DI void run_phase(const Params& p, int l, char* lds, int bid, int nblk) {
  const int need_ctx = (l == 0);
  const int rows = need_ctx ? R : RL;
  const float* xl_in = l == 0 ? p.x : p.out;
  const float* xc_in = l == 0 ? p.ctx : p.xc;
  bf16_t* QRAW = p.YO; bf16_t* KVRAW = p.YO + (size_t)R * 384;
  if constexpr (PH == 0) {
    ph_mods(p, lds, bid, nblk);
#pragma unroll 1
    for (int ll = 0; ll < 2; ++ll) {
      ph_wt(p.w_in + (size_t)ll * D * NZ, p.Wt_in + ll * WSZ_IN, D, NZ, NZP, 1, 0L, 0L, nullptr, lds, bid, nblk);
      ph_wt(p.w_gate + (size_t)ll * D * 4096, p.Wt_gate + ll * WSZ_GATE, D, 4096, 4096, 1, 0L, 0L, nullptr, lds, bid, nblk);
      ph_wt(p.w_branch + (size_t)ll * 4 * 256 * D, p.Wt_branch + ll * WSZ_BR, 256, D, D, 4, (long)256 * D, (long)D * 256, nullptr, lds, bid, nblk);
      ph_wt(p.w_out + (size_t)ll * D * D, p.Wt_out + ll * WSZ_OUT, D, D, D, 1, 0L, 0L, nullptr, lds, bid, nblk);
      ph_wt(p.w_uq + (size_t)ll * 256 * 384, p.Wt_uq + ll * WSZ_UQ, 256, 384, 384, 1, 0L, 0L, p.g_q_lat + ll * 256, lds, bid, nblk);
      ph_wt(p.w_ukv + (size_t)ll * 128 * 512, p.Wt_ukv + ll * WSZ_UKV, 128, 512, 512, 1, 0L, 0L, p.g_kv_lat + ll * 128, lds, bid, nblk);
    }
  } else if constexpr (PH == 1) {
    ph_modulate(p, l, xl_in, xc_in, bid, nblk);
  } else if constexpr (PH == 2) {
    ph_gemm_plain(p.H, D, p.Wt_in + l * WSZ_IN, D, R, NZP, D, p.Z, NZP, lds, bid, nblk);
#if PROBE == 63
    ph_gemm_probe<3>(p.H, D, p.Wt_in + l * WSZ_IN, D, R, NZP, D, p.mods + 40000, lds, bid, nblk);
#elif PROBE == 66
    ph_gemm_probe<6>(p.H, D, p.Wt_in + l * WSZ_IN, D, R, NZP, D, p.mods + 40000, lds, bid, nblk);
#elif PROBE == 67
    ph_gemm_plain<1>(p.H, D, p.Wt_in + l * WSZ_IN, D, R, NZP, D, p.Z, NZP, lds, bid, nblk);
#elif PROBE == 5
    ph_gemm_plain(p.H, D, p.Wt_in + l * WSZ_IN, D, R, NZP, D, p.Z, NZP, lds, bid, nblk);
#endif
  } else if constexpr (PH == 3) {
    ph_mla_up(p, l, QRAW, KVRAW, lds, bid, nblk);
  } else if constexpr (PH == 4) {
    ph_prep(p, l, QRAW, KVRAW, lds, bid, nblk);
#if PROBE == 41
    ph_prep(p, l, QRAW, KVRAW, lds, bid, nblk);
#elif PROBE == 43
    ph_prep<1>(p, l, QRAW, KVRAW, lds, bid, nblk);
#elif PROBE == 44
    ph_prep<2>(p, l, QRAW, KVRAW, lds, bid, nblk);
#endif
    __syncthreads();
    ph_gates_cum(p, l, lds, bid, nblk);
#if PROBE == 42
    ph_gates_cum(p, l, lds, bid, nblk);
#endif
  } else if constexpr (PH == 5) {
#if FAST_SCAN
    ph_ml_local(p, lds, bid, nblk);
    ph_gla_local(p, lds, bid, nblk);
#else
    GS_LOOP((long)NUNIT * 4160, nvb_ml_local(gi, p));
    GS_LOOP((long)NUNIT * 2048, nvb_gla_local(gi, p));
#endif
  } else if constexpr (PH == 6) {
#if FAST_SCAN
    ph_ml_scan(p, bid, nblk);
    ph_gla_scan(p, bid, nblk);
#else
    GS_LOOP((long)NB * 2 * 4 * 4160, nvb_ml_scan(gi, p));
    GS_LOOP((long)NB * 2 * 4 * 2048, nvb_gla_scan(gi, p));
#endif
    ph_attn(p, l, need_ctx, lds, bid, nblk);
#if PROBE >= 10 && PROBE < 20
    if (l == 0) ph_attn_mla_probe<PROBE - 10>(p, lds, bid, nblk);
#elif PROBE == 1
    ph_attn_diff(p, l, need_ctx, lds, bid, nblk);
#elif PROBE == 2
    ph_attn_mla(p, need_ctx, lds, bid, nblk);
#endif
  } else if constexpr (PH == 7) {
#if FAST_SCAN
    ph_ml_out(p, l, need_ctx, lds, bid, nblk);
    ph_gla_out(p, l, need_ctx, lds, bid, nblk);
#else
    GS_LOOP((long)NUNIT * 4096, nvb_ml_out(gi, p, need_ctx));
    GS_LOOP((long)NUNIT * 4096, nvb_gla_out(gi, p, need_ctx));
#endif
  } else if constexpr (PH == 8) {
#if !FAST_SCAN
    GS_LOOP((long)R * 4, nvb_ml_finish(gi, p, l, need_ctx));
    GS_LOOP((long)R * 4, nvb_gla_finish(gi, p, l, need_ctx));
#endif
  } else if constexpr (PH == 9) {
    ph_merge(p, l, rows, lds, bid, nblk);
#if PROBE == 3
    ph_merge(p, l, rows, lds, bid, nblk);
#endif
  } else if constexpr (PH == 10) {
    ph_gemm_plain(p.MG, D, p.Wt_out + l * WSZ_OUT, D, rows, D, D, p.YO, D, lds, bid, nblk);
  } else if constexpr (PH == 11) {
    ph_resid_mix(p, l, xl_in, xc_in, rows, bid, nblk);
  } else if constexpr (PH == 12) {
    ph_topk(p, need_ctx, lds, bid, nblk);
    ph_wt(p.w_e_gate + (size_t)l * NE * D * FF, p.Wt_eg, D, FF, FF, NE, (long)D * FF, (long)FF * D, nullptr, lds, bid, nblk);
    ph_wt(p.w_e_up + (size_t)l * NE * D * FF, p.Wt_eu, D, FF, FF, NE, (long)D * FF, (long)FF * D, nullptr, lds, bid, nblk);
    ph_wt(p.w_e_down + (size_t)l * NE * FF * D, p.Wt_ed, FF, D, D, NE, (long)FF * D, (long)D * FF, nullptr, lds, bid, nblk);
  } else if constexpr (PH == 13) {
    ph_moe1(p, need_ctx, lds, bid, nblk);
#if PROBE == 4
    ph_moe1(p, need_ctx, lds, bid, nblk);
#endif
  } else if constexpr (PH == 14) {
    ph_moe2(p, need_ctx, lds, bid, nblk);
#if PROBE == 4
    ph_moe2(p, need_ctx, lds, bid, nblk);
#endif
  } else if constexpr (PH == 15) {
    ph_resid_ffn(p, l, rows, bid, nblk);
  }
}

template <int PH> __global__ void __launch_bounds__(256, 2) k_phase(Params p, int l) {
  DYN_LDS(lds);
  run_phase<PH>(p, l, lds, blockIdx.x, gridDim.x);
}

#if !defined(CPU_EMU) && !MK_MULTI
typedef const Params __attribute__((address_space(4)))* KParams;
DI KParams kp_fresh() { KParams k = (KParams)__builtin_amdgcn_kernarg_segment_ptr(); asm volatile("" : "+s"(k)); return k; }
#define PHASE(PH, L) do { asm volatile("; PHASE_MARK " #PH); KParams k_ = kp_fresh(); run_phase<PH>(*(const Params*)k_, (L), lds, bid, nblk); if (PROBE == 20 + PH || (PROBE == 99 && (PH == 4 || PH == 5))) { __syncthreads(); run_phase<PH>(*(const Params*)k_, (L), lds, bid, nblk); } XcdBarrier b_ = bar; asm volatile("" : "+s"(b_.bar), "+s"(b_.x)); xcd_barrier(b_); if (PROBE == 50) xcd_barrier(b_); } while (0)
__global__ void __launch_bounds__(256, 2) k_mega(Params pv) {
  DYN_LDS(lds_all);
  if (threadIdx.x == 0) *(uint4*)lds_all = make_uint4(0u, 0u, 0u, 0u);
  __syncthreads();
  XcdBarrier bar = xcd_barrier_post(pv.bar, (volatile LAS unsigned*)lds_all);
  char* lds = lds_all + 256;
  const int bid = blockIdx.x, nblk = gridDim.x;
  PHASE(0, 0);
#pragma unroll 1
  for (int l = 0; l < 2; ++l) {
    PHASE(1, l); PHASE(2, l); PHASE(3, l); PHASE(4, l); PHASE(5, l); PHASE(6, l); PHASE(7, l);
#if !FAST_SCAN
    PHASE(8, l);
#endif

    PHASE(9, l); PHASE(10, l); PHASE(11, l); PHASE(12, l); PHASE(13, l); PHASE(14, l); PHASE(15, l);
  }
}
#endif
#ifdef CPU_EMU
void emu_check(const Params& p, int layer, int stage);
#define EMU_CHECK(stg) emu_check(p, l, stg)
static int g_nlayers = getenv("NLAYERS") ? atoi(getenv("NLAYERS")) : 2;
#else
#define EMU_CHECK(stg)
#endif
static void fill_params(Params& p, void* const* d_in, void* d_out, void* d_ws) {
  const float** f = (const float**)&p;
  for (int i = 0; i < 33; ++i) f[i] = (const float*)d_in[i];
  p.out = (float*)d_out;
  map_workspace(p, (char*)d_ws);
}
#define LAUNCH_PHASE(PH, L) LAUNCH((k_phase<PH>), grid, 256, MEGA_LDS, stream, p, L)

extern "C" void kernel_launch(void* const* d_in, const int* in_sizes, int n_in, void* d_out, int out_size, void* d_ws,
                              size_t ws_size, hipStream_t stream) {
  Params p{};
  fill_params(p, d_in, d_out, d_ws);
  if (p.ws_need > ws_size) return;
#ifdef CPU_EMU
  const int grid = 16;
  LAUNCH_PHASE(0, 0);
  for (int l = 0; l < g_nlayers; ++l) {
    LAUNCH_PHASE(1, l); LAUNCH_PHASE(2, l); LAUNCH_PHASE(3, l); LAUNCH_PHASE(4, l); LAUNCH_PHASE(5, l); LAUNCH_PHASE(6, l); LAUNCH_PHASE(7, l); LAUNCH_PHASE(8, l);
    EMU_CHECK(1);
    LAUNCH_PHASE(9, l); LAUNCH_PHASE(10, l); LAUNCH_PHASE(11, l);
    EMU_CHECK(2);
    LAUNCH_PHASE(12, l); LAUNCH_PHASE(13, l); LAUNCH_PHASE(14, l); LAUNCH_PHASE(15, l);
    EMU_CHECK(3);
  }
#else
  static int grid = 0;
  if (grid == 0) {
    int dev = 0, cus = 0, per_cu = 0;
    (void)hipGetDevice(&dev);
    (void)hipDeviceGetAttribute(&cus, hipDeviceAttributeMultiprocessorCount, dev);
#if MK_MULTI
    (void)hipFuncSetAttribute((const void*)k_phase<0>, hipFuncAttributeMaxDynamicSharedMemorySize, MEGA_LDS);
    (void)hipFuncSetAttribute((const void*)k_phase<1>, hipFuncAttributeMaxDynamicSharedMemorySize, MEGA_LDS);
    (void)hipFuncSetAttribute((const void*)k_phase<2>, hipFuncAttributeMaxDynamicSharedMemorySize, MEGA_LDS);
    (void)hipFuncSetAttribute((const void*)k_phase<3>, hipFuncAttributeMaxDynamicSharedMemorySize, MEGA_LDS);
    (void)hipFuncSetAttribute((const void*)k_phase<4>, hipFuncAttributeMaxDynamicSharedMemorySize, MEGA_LDS);
    (void)hipFuncSetAttribute((const void*)k_phase<5>, hipFuncAttributeMaxDynamicSharedMemorySize, MEGA_LDS);
    (void)hipFuncSetAttribute((const void*)k_phase<6>, hipFuncAttributeMaxDynamicSharedMemorySize, MEGA_LDS);
    (void)hipFuncSetAttribute((const void*)k_phase<7>, hipFuncAttributeMaxDynamicSharedMemorySize, MEGA_LDS);
    (void)hipFuncSetAttribute((const void*)k_phase<8>, hipFuncAttributeMaxDynamicSharedMemorySize, MEGA_LDS);
    (void)hipFuncSetAttribute((const void*)k_phase<9>, hipFuncAttributeMaxDynamicSharedMemorySize, MEGA_LDS);
    (void)hipFuncSetAttribute((const void*)k_phase<10>, hipFuncAttributeMaxDynamicSharedMemorySize, MEGA_LDS);
    (void)hipFuncSetAttribute((const void*)k_phase<11>, hipFuncAttributeMaxDynamicSharedMemorySize, MEGA_LDS);
    (void)hipFuncSetAttribute((const void*)k_phase<12>, hipFuncAttributeMaxDynamicSharedMemorySize, MEGA_LDS);
    (void)hipFuncSetAttribute((const void*)k_phase<13>, hipFuncAttributeMaxDynamicSharedMemorySize, MEGA_LDS);
    (void)hipFuncSetAttribute((const void*)k_phase<14>, hipFuncAttributeMaxDynamicSharedMemorySize, MEGA_LDS);
    (void)hipFuncSetAttribute((const void*)k_phase<15>, hipFuncAttributeMaxDynamicSharedMemorySize, MEGA_LDS);
    grid = (cus > 0 ? cus : 256) * 2;
#else
    if (hipFuncSetAttribute((const void*)k_mega, hipFuncAttributeMaxDynamicSharedMemorySize, MEGA_LDS + 256) != hipSuccess) { grid = -1; return; }
    if (hipOccupancyMaxActiveBlocksPerMultiprocessor(&per_cu, (const void*)k_mega, 256, MEGA_LDS + 256) != hipSuccess) per_cu = 0;
    (void)hipGetLastError();
    if (per_cu < 1) { grid = -1; return; }
    grid = (cus > 0 ? cus : 256) * (per_cu < 2 ? per_cu : 2);
#endif
  }
  if (grid < 0) return;
#if MK_MULTI
  LAUNCH_PHASE(0, 0);
  for (int l = 0; l < 2; ++l) {
    LAUNCH_PHASE(1, l); LAUNCH_PHASE(2, l); LAUNCH_PHASE(3, l); LAUNCH_PHASE(4, l); LAUNCH_PHASE(5, l); LAUNCH_PHASE(6, l); LAUNCH_PHASE(7, l); LAUNCH_PHASE(8, l);
    LAUNCH_PHASE(9, l); LAUNCH_PHASE(10, l); LAUNCH_PHASE(11, l); LAUNCH_PHASE(12, l); LAUNCH_PHASE(13, l); LAUNCH_PHASE(14, l); LAUNCH_PHASE(15, l);
  }
#else
  (void)hipMemsetAsync(p.bar, 0, XCD_BAR_WORDS * sizeof(unsigned), stream);
  k_mega<<<dim3(grid), dim3(256), MEGA_LDS + 256, stream>>>(p);
#endif
#endif
}
```

```cpp
#ifndef CPU_EMU
#include <hip/hip_runtime.h>
#endif
#include <stdint.h>
#include <stddef.h>

#ifndef T_LAT
#define T_LAT 16384
#endif
#ifndef T_CTX
#define T_CTX 256
#endif

#ifndef MK_MULTI
#define MK_MULTI 0
#endif
#define DI __device__ __forceinline__
typedef unsigned short bf16_t;
typedef short bf16x8 __attribute__((ext_vector_type(8)));
typedef short s16x4 __attribute__((ext_vector_type(4)));
typedef float f32x4 __attribute__((ext_vector_type(4)));
typedef float f32x16 __attribute__((ext_vector_type(16)));
typedef unsigned u32x4 __attribute__((ext_vector_type(4)));
typedef unsigned u32x2 __attribute__((ext_vector_type(2)));
typedef float f32x2 __attribute__((ext_vector_type(2)));

#ifdef CPU_EMU
static inline float u2f(unsigned u) { float f; memcpy(&f, &u, 4); return f; }
static inline unsigned f2u(float f) { unsigned u; memcpy(&u, &f, 4); return u; }
#define MFMA32(a, b, c) emu_mfma_32x32x16((a), (b), (c))
#define MFMA16(a, b, c) emu_mfma_16x16x32((a), (b), (c))
static inline float fast_exp2(float x) { return exp2f(x); }
static inline float fast_rcp(float x) { return 1.0f / x; }
static inline float fast_rsq(float x) { return 1.0f / sqrtf(x); }
static inline float hw_sin_rev(float x) { return sinf(6.283185307179586f * x); }
static inline float hw_cos_rev(float x) { return cosf(6.283185307179586f * x); }
#define LAUNCH(kern, grid, block, lds, stream, ...) emu::launch(dim3(grid), dim3(block), (size_t)(lds), [=]() { kern(__VA_ARGS__); })
#define DYN_LDS(name) char* name = emu_dynlds()
#define SCHED_BARRIER()
#define TIDX ((int)threadIdx.x)
#define WAVE_SYNC() emu::wave_barrier()
#define SETPRIO(x)
template <int M> static inline float xor_sum(float v) { return v + __shfl_xor(v, M); }
template <int M> static inline float xor_max(float v) { return fmaxf(v, __shfl_xor(v, M)); }
template <int M> static inline int xor_sum_i(int v) { return v + __shfl_xor(v, M); }
static inline int lane_bcast(int v, int src) { return __shfl(v, src); }
static inline int lane_up(int v, int d, int lane) { (void)lane; return __shfl_up(v, d); }
#else
DI float u2f(unsigned u) { return __uint_as_float(u); }
DI unsigned f2u(float f) { return __float_as_uint(f); }
#define MFMA32(a, b, c) __builtin_amdgcn_mfma_f32_32x32x16_bf16((a), (b), (c), 0, 0, 0)
#define MFMA16(a, b, c) __builtin_amdgcn_mfma_f32_16x16x32_bf16((a), (b), (c), 0, 0, 0)
DI float fast_exp2(float x) { return __builtin_amdgcn_exp2f(x); }
DI float fast_rcp(float x) { return __builtin_amdgcn_rcpf(x); }
DI float fast_rsq(float x) { return __builtin_amdgcn_rsqf(x); }
DI float hw_sin_rev(float x) { return __builtin_amdgcn_sinf(x); }
DI float hw_cos_rev(float x) { return __builtin_amdgcn_cosf(x); }
#define LAUNCH(kern, grid, block, lds, stream, ...) kern<<<dim3(grid), dim3(block), (lds), (stream)>>>(__VA_ARGS__)
#define DYN_LDS(name) extern __shared__ __attribute__((aligned(16))) char name[]
#define SCHED_BARRIER() __builtin_amdgcn_sched_barrier(0)
DI int tid_fresh() { int t = (int)threadIdx.x; asm volatile("" : "+v"(t)); return t; }
#define TIDX tid_fresh()
#define WAVE_SYNC() __builtin_amdgcn_wave_barrier()
#define SETPRIO(x) __builtin_amdgcn_s_setprio(x)
#ifdef USE_SHFL
template <int M> DI float xor_sum(float v) { return v + __shfl_xor(v, M); }
template <int M> DI float xor_max(float v) { return fmaxf(v, __shfl_xor(v, M)); }
template <int M> DI int xor_sum_i(int v) { return v + __shfl_xor(v, M); }
DI int lane_bcast(int v, int src) { return __shfl(v, src); }
DI int lane_up(int v, int d, int lane) { (void)lane; return __shfl_up(v, d); }
#else
template <int M> DI int xor_partner_bits(int bits) { return __builtin_amdgcn_ds_swizzle(bits, (M << 10) | 0x1f); }
DI void half_swap(unsigned& a, unsigned& b) { asm volatile("s_nop 1\n\tv_permlane32_swap_b32 %0, %1\n\ts_nop 1" : "+v"(a), "+v"(b)); }
template <int M> DI float xor_sum(float v) {
  if constexpr (M < 32) return v + __builtin_bit_cast(float, xor_partner_bits<M>(__builtin_bit_cast(int, v)));
  else { unsigned a = __builtin_bit_cast(unsigned, v), b = a; half_swap(a, b); return __builtin_bit_cast(float, a) + __builtin_bit_cast(float, b); }
}
template <int M> DI float xor_max(float v) {
  if constexpr (M < 32) return fmaxf(v, __builtin_bit_cast(float, xor_partner_bits<M>(__builtin_bit_cast(int, v))));
  else { unsigned a = __builtin_bit_cast(unsigned, v), b = a; half_swap(a, b); return fmaxf(__builtin_bit_cast(float, a), __builtin_bit_cast(float, b)); }
}
template <int M> DI int xor_sum_i(int v) {
  if constexpr (M < 32) return v + xor_partner_bits<M>(v);
  else { unsigned a = (unsigned)v, b = a; half_swap(a, b); return (int)(a + b); }
}
DI int lane_bcast(int v, int src) { return __builtin_amdgcn_readlane(v, src); }
DI int lane_up(int v, int d, int lane) { return __builtin_amdgcn_ds_bpermute(((lane - d) & 63) << 2, v); }
#endif
#endif

DI float bf2f(bf16_t v) { return u2f(((unsigned)v) << 16); }
#ifdef CPU_EMU
DI bf16_t f2bf(float f) { unsigned u = f2u(f); u += 0x7fffu + ((u >> 16) & 1u); return (bf16_t)(u >> 16); }
DI unsigned pack2bf(float lo, float hi) { return (unsigned)f2bf(lo) | ((unsigned)f2bf(hi) << 16); }
static inline bool wave_any(bool pr) { int v = pr ? 1 : 0; v |= __shfl_xor(v, 1); v |= __shfl_xor(v, 2); v |= __shfl_xor(v, 4); v |= __shfl_xor(v, 8); v |= __shfl_xor(v, 16); v |= __shfl_xor(v, 32); return v != 0; }
#else
typedef float f32x2_ __attribute__((ext_vector_type(2)));
typedef __bf16 bf16x2_hw __attribute__((ext_vector_type(2)));
DI unsigned pack2bf(float lo, float hi) { const f32x2_ v = {lo, hi}; return __builtin_bit_cast(unsigned, __builtin_convertvector(v, bf16x2_hw)); }
DI bf16_t f2bf(float f) { return (bf16_t)(pack2bf(f, f) & 0xffffu); }
DI bool wave_any(bool pr) { return __builtin_amdgcn_ballot_w64(pr) != 0ull; }
#endif
DI float sigmoidf_(float x) { return 1.0f / (1.0f + expf(-x)); }
DI float siluf_(float x) { return x / (1.0f + expf(-x)); }
DI float logsigmoidf_(float x) { return fminf(x, 0.0f) - log1pf(expf(-fabsf(x))); }

constexpr int D = 1024, NB = 2, TL = T_LAT, TC = T_CTX, TK = TL + TC;
constexpr int RL = NB * TL, RC = NB * TC, R = RL + RC;
constexpr int NZ = 3024, NZP = 3072;
constexpr int ZC_QLAT = 0, ZC_KVLAT = 256, ZC_KROPE = 384, ZC_MLQK = 416, ZC_MLV = 928, ZC_MLO = 1184, ZC_MLIG = 1440,
              ZC_MLFG = 1448, ZC_GQ = 1456, ZC_GK = 1584, ZC_GV = 1712, ZC_GR = 1968, ZC_GA = 2224, ZC_DQ = 2256,
              ZC_DK = 2512, ZC_DV = 2768;
constexpr int NCK = TK / 64, NCC = TC / 64, NCL = TL / 64;
constexpr int NE = 16, FF = 1408, CAPL = 2 * TL / 16, CAPC = 2 * TC / 16, CAPT = CAPL + CAPC, NSLOT = NB * CAPT;
constexpr size_t WSZ_IN = (size_t)NZP * D, WSZ_UQ = 384 * 256, WSZ_UKV = 512 * 128, WSZ_GATE = (size_t)4096 * D, WSZ_BR = (size_t)4 * D * 256, WSZ_OUT = (size_t)D * D;
constexpr int NUNIT = NB * 2 * NCK * 4;
constexpr float LOG2E = 1.4426950408889634f;
constexpr float QS_MLA = 0.10206207261596577f * LOG2E;
constexpr float QS_DIFF = 0.17677669529663687f * LOG2E;

DI int row_of(int b, int s) { return s < TC ? RL + b * TC + s : b * TL + (s - TC); }
DI void bs_of(int r, int& b, int& s) { if (r < RL) { b = r / TL; s = TC + (r % TL); } else { int q = r - RL; b = q / TC; s = q % TC; } }
DI int seq_of(int d, int p) { return d == 0 ? p : (p < TC ? TC - 1 - p : TK - 1 - (p - TC)); }
DI int step_of(int d, int c) { return d == 0 ? c : (c < NCC ? NCC - 1 - c : NCC + (NCK - 1 - c)); }

struct Params {
  const float *x, *c, *ctx, *c_ctx, *w_ada, *b_ada, *g_mix_pre, *g_mix_post, *g_ffn_pre, *g_ffn_post, *w_in, *g_q_lat, *w_uq,
      *g_kv_lat, *w_ukv, *w_conv, *b_conv, *b_igate, *b_fgate, *g_mlstm_out, *w_alpha2, *b_alpha, *g_gla_out, *diff_lambda,
      *g_diff_out, *w_branch, *w_gate, *b_gate, *w_out, *w_router, *w_e_gate, *w_e_up, *w_e_down;
  float* out;
  float *mods, *xc;
  bf16_t *H, *Z, *Qm, *Km, *Vtm, *Qd, *Kd, *Vtd, *MQ, *MK, *Y, *MG, *YO, *HID, *YE, *MVt, *GVt;
  float *BC, *IGS, *GC, *MC, *MN, *MM, *GS, *HD, *OD, *AFF, *SELV;
  int *SEL, *INV;
  bf16_t *Wt_in, *Wt_uq, *Wt_ukv, *Wt_gate, *Wt_branch, *Wt_out, *Wt_eg, *Wt_eu, *Wt_ed;
  unsigned* bar;
  size_t ws_need;
};

static inline size_t al256(size_t x) { return (x + 255) & ~(size_t)255; }
static inline void map_workspace(Params& p, char* ws) {
  size_t o = 0;
  auto take = [&](size_t bytes) { size_t r = o; o += al256(bytes); return ws + r; };
  p.bar = (unsigned*)take(16384);
  p.mods = (float*)take((size_t)2 * 3 * 6144 * 4);
  p.xc = (float*)take((size_t)RC * D * 4);
  p.BC = (float*)take((size_t)NB * 2 * TK * 4 * 4);
  p.IGS = (float*)take((size_t)NB * 2 * TK * 4 * 4);
  p.AFF = (float*)take((size_t)NB * NE * TK * 4);
  p.SEL = (int*)take((size_t)NE * NSLOT * 4);
  p.SELV = (float*)take((size_t)NE * NSLOT * 4);
  p.INV = (int*)take((size_t)R * NE * 4);
  p.MM = (float*)take((size_t)NUNIT * 4 * 4);
  p.MN = (float*)take((size_t)NUNIT * 64 * 4);
  p.Wt_in = (bf16_t*)take((size_t)2 * WSZ_IN * 2);
  p.Wt_uq = (bf16_t*)take((size_t)2 * WSZ_UQ * 2);
  p.Wt_ukv = (bf16_t*)take((size_t)2 * WSZ_UKV * 2);
  p.Wt_gate = (bf16_t*)take((size_t)2 * WSZ_GATE * 2);
  p.Wt_branch = (bf16_t*)take((size_t)2 * WSZ_BR * 2);
  p.Wt_out = (bf16_t*)take((size_t)2 * WSZ_OUT * 2);
  p.H = (bf16_t*)take((size_t)R * D * 2);
  size_t szA = (size_t)R * NZP * 2, szHID = (size_t)NE * NSLOT * FF * 2;
  char* A = take(szA > szHID ? szA : szHID);
  p.Z = (bf16_t*)A; p.HID = (bf16_t*)A;
  size_t szQm = al256((size_t)NB * 4 * TK * 96 * 2), szVt = al256((size_t)NB * 4 * 64 * TK * 2), szQd = al256((size_t)NB * 8 * TK * 32 * 2);
  size_t szB1 = 2 * szQm + 2 * szVt + 2 * szQd;
  size_t szHD = al256((size_t)2 * NB * TK * 256 * 4);
  size_t szYE = (size_t)NE * NSLOT * D * 2;
  size_t szB = szB1; if (2 * szHD > szB) szB = 2 * szHD; if (szYE > szB) szB = szYE;
  char* Bq = take(szB);
  p.Qm = (bf16_t*)Bq; p.Km = (bf16_t*)(Bq + szQm); p.Vtm = (bf16_t*)(Bq + 2 * szQm);
  p.Qd = (bf16_t*)(Bq + 2 * szQm + szVt); p.Kd = (bf16_t*)(Bq + 2 * szQm + szVt + szQd); p.Vtd = (bf16_t*)(Bq + 2 * szQm + szVt + 2 * szQd);
  p.YE = (bf16_t*)Bq;
  p.GC = (float*)take((size_t)NB * 2 * TK * 128 * 4);
  p.MVt = (bf16_t*)take((size_t)NB * 4 * 64 * TK * 2);
  p.GVt = (bf16_t*)take((size_t)NB * 4 * 64 * TK * 2);
  size_t szW = (size_t)NE * FF * D * 2;
  size_t szMC = (size_t)NUNIT * 4096 * 4, szRD = (size_t)R * D * 2;
  size_t szC = szMC; if (szRD > szC) szC = szRD; if (szW > szC) szC = szW;
  char* C = take(szC);
  p.MC = (float*)C; p.MG = (bf16_t*)C; p.Wt_eg = (bf16_t*)C;
  size_t szMQ = al256((size_t)NB * TK * 256 * 2), szGS = (size_t)NUNIT * 2048 * 4;
  size_t szD = 2 * szMQ + szGS; if (szW > szD) szD = szW;
  char* Dq = take(szD);
  p.MQ = (bf16_t*)Dq; p.MK = (bf16_t*)(Dq + szMQ); p.GS = (float*)(Dq + 2 * szMQ); p.Wt_eu = (bf16_t*)Dq;
  size_t szF = 2 * szRD > szW ? 2 * szRD : szW;
  char* F = take(szF);
  p.Y = (bf16_t*)F; p.YO = (bf16_t*)(F + szRD); p.Wt_ed = (bf16_t*)F;
  p.HD = (float*)Bq; p.OD = (float*)(Bq + szHD);
  p.ws_need = o;
}
#define GTID ((long)blockIdx.x * blockDim.x + threadIdx.x)

DI float lam_of(const Params& p, int layer, float& lam_init) {
  const float* lv = p.diff_lambda + layer * 128;
  float s1 = 0.f, s2 = 0.f;
  for (int i = 0; i < 32; ++i) { s1 += lv[i] * lv[32 + i]; s2 += lv[64 + i] * lv[96 + i]; }
  lam_init = layer == 0 ? 0.2f : 0.35550906759096f;
  return expf(s1) - expf(s2) + lam_init;
}
DI void rope_cs(int s, int jj, float& cs, float& sn) {
  int t = s - TC;
  int pos = (jj < 16) ? (t / 64) : (t % 64);
  float ang = (float)pos * exp2f(-1.6609640474436813f * (float)(jj & 7));
  double rev = (double)ang * 0.15915494309189535;
  rev -= floor(rev + 0.5);
  float rf = (float)rev;
  cs = hw_cos_rev(rf); sn = hw_sin_rev(rf);
}
template <class G> DI float rope_elem(G get, int s, int jj) {
  if (s < TC) return get(jj);
  float cs, sn; rope_cs(s, jj, cs, sn);
  float a = get(jj), b = get(jj ^ 8);
  return (jj & 8) ? (a * cs + b * sn) : (a * cs - b * sn);
}

DI void nvb_mods(long GI, const Params& p) {
  long i = GI; if (i >= 2 * 3 * 6144) return;
  int col = (int)(i % 6144), w = (int)((i / 6144) % 3), l = (int)(i / (3 * 6144));
  const float* cv = w < 2 ? p.c + w * 1024 : p.c_ctx;
  const float* W = p.w_ada + (size_t)l * 1024 * 6144;
  float acc = 0.f;
  for (int k = 0; k < 1024; ++k) acc += siluf_(cv[k]) * W[(size_t)k * 6144 + col];
  p.mods[i] = acc + p.b_ada[l * 6144 + col];
}
__global__ void __launch_bounds__(256) nv_wt(const float* in, bf16_t* out, int K, int N, int NP, long in_bs, long out_bs, const float* gain) {
  long i = GTID; if (i >= (long)NP * K) return;
  int k = (int)(i % K), n = (int)(i / K);
  const float* I = in + (size_t)blockIdx.y * in_bs; bf16_t* O = out + (size_t)blockIdx.y * out_bs;
  O[(size_t)n * K + k] = n < N ? f2bf(I[(size_t)k * N + n] * (gain ? gain[k] : 1.0f)) : (bf16_t)0;
}
__global__ void __launch_bounds__(256) nv_modulate(Params p, int layer, int which, const float* xl, const float* xcx, int nrows) {
  long r = GTID; if (r >= nrows) return;
  int w = r < RL ? (int)(r / TL) : 2;
  const float* mb = p.mods + (size_t)(layer * 3 + w) * 6144;
  const float* shift = mb + (which ? 3 : 0) * 1024; const float* scale = mb + (which ? 4 : 1) * 1024;
  const float* g = (which ? p.g_ffn_pre : p.g_mix_pre) + layer * 1024;
  const float* x = r < RL ? xl + (size_t)r * D : xcx + (size_t)(r - RL) * D;
  float ss = 0.f; for (int k = 0; k < D; ++k) ss += x[k] * x[k];
  float rstd = 1.0f / sqrtf(ss / D + 1e-6f);
  for (int k = 0; k < D; ++k) p.H[(size_t)r * D + k] = f2bf(x[k] * rstd * g[k] * (1.f + scale[k]) + shift[k]);
}
__global__ void __launch_bounds__(256) nv_gemm(const bf16_t* A, int lda, const bf16_t* Bt, int ldb, int M, int N, int K, bf16_t* C, int ldc) {
  long i = GTID; if (i >= (long)M * N) return;
  int n = (int)(i % N), m = (int)(i / N);
  const bf16_t* a = A + (size_t)m * lda; const bf16_t* b = Bt + (size_t)n * ldb;
  float acc = 0.f;
  for (int k = 0; k < K; ++k) acc += bf2f(a[k]) * bf2f(b[k]);
  C[(size_t)m * ldc + n] = f2bf(acc);
}
__global__ void __launch_bounds__(256) nv_mla_q(Params p, int layer) {
  long i = GTID; if (i >= (long)R * 4 * 96) return;
  int j = (int)(i % 96), h = (int)((i / 96) % 4), r = (int)(i / 384);
  int b, s; bs_of(r, b, s);
  const bf16_t* z = p.Z + (size_t)r * NZP + ZC_QLAT;
  const float* g = p.g_q_lat + layer * 256; const float* W = p.w_uq + (size_t)layer * 256 * 384;
  float ss = 0.f; for (int k = 0; k < 256; ++k) { float v = bf2f(z[k]); ss += v * v; }
  float rstd = 1.0f / sqrtf(ss / 256 + 1e-6f);
  auto dot = [&](int col) { float a = 0.f; for (int k = 0; k < 256; ++k) a += bf2f(z[k]) * rstd * g[k] * W[(size_t)k * 384 + col]; return a; };
  float v;
  if (j < 64) v = dot(h * 96 + j);
  else v = rope_elem([&](int jj) { return dot(h * 96 + 64 + jj); }, s, j - 64);
  p.Qm[(((size_t)b * 4 + h) * TK + s) * 96 + j] = f2bf(v * QS_MLA);
}
__global__ void __launch_bounds__(256) nv_mla_kv(Params p, int layer) {
  long i = GTID; if (i >= (long)R * 4 * 160) return;
  int j = (int)(i % 160), h = (int)((i / 160) % 4), r = (int)(i / 640);
  int b, s; bs_of(r, b, s);
  const bf16_t* z = p.Z + (size_t)r * NZP;
  if (j < 128) {
    const bf16_t* zl = z + ZC_KVLAT; const float* g = p.g_kv_lat + layer * 128; const float* W = p.w_ukv + (size_t)layer * 128 * 512;
    float ss = 0.f; for (int k = 0; k < 128; ++k) { float v = bf2f(zl[k]); ss += v * v; }
    float rstd = 1.0f / sqrtf(ss / 128 + 1e-6f);
    float a = 0.f; for (int k = 0; k < 128; ++k) a += bf2f(zl[k]) * rstd * g[k] * W[(size_t)k * 512 + h * 128 + j];
    if (j < 64) p.Km[(((size_t)b * 4 + h) * TK + s) * 96 + j] = f2bf(a);
    else p.Vtm[(((size_t)b * 4 + h) * 64 + (j - 64)) * TK + s] = f2bf(a);
  } else {
    int jj = j - 128;
    float v = rope_elem([&](int q) { return bf2f(z[ZC_KROPE + q]); }, s, jj);
    p.Km[(((size_t)b * 4 + h) * TK + s) * 96 + 64 + jj] = f2bf(v);
  }
}
__global__ void __launch_bounds__(256) nv_diff_prep(Params p) {
  long i = GTID; if (i >= (long)R * 768) return;
  int c = (int)(i % 768), r = (int)(i / 768);
  int b, s; bs_of(r, b, s);
  const bf16_t* z = p.Z + (size_t)r * NZP;
  if (c < 512) {
    int qk = c / 256, cc = c % 256, hm = cc / 32, jj = cc % 32;
    const bf16_t* src = z + (qk ? ZC_DK : ZC_DQ) + hm * 32;
    float v = rope_elem([&](int q) { return bf2f(src[q]); }, s, jj);
    if (qk == 0) p.Qd[(((size_t)b * 8 + hm) * TK + s) * 32 + jj] = f2bf(v * QS_DIFF);
    else p.Kd[(((size_t)b * 8 + hm) * TK + s) * 32 + jj] = f2bf(v);
  } else {
    int cc = c - 512, h = cc / 64, dv = cc % 64;
    p.Vtd[(((size_t)b * 4 + h) * 64 + dv) * TK + s] = z[ZC_DV + cc];
  }
}
__global__ void __launch_bounds__(256) nv_ml_prep(Params p, int layer) {
  long i = GTID; if (i >= (long)R * 512) return;
  int ch = (int)(i % 512), r = (int)(i / 512);
  int b, s; bs_of(r, b, s);
  bool first = (s == 0) || (s == TC), last = (s == TC - 1) || (s == TK - 1);
  const float* w = p.w_conv + (size_t)layer * 3 * 512;
  float acc = p.b_conv[layer * 512 + ch];
  acc += bf2f(p.Z[(size_t)r * NZP + ZC_MLQK + ch]) * w[512 + ch];
  if (!first) acc += bf2f(p.Z[(size_t)row_of(b, s - 1) * NZP + ZC_MLQK + ch]) * w[ch];
  if (!last) acc += bf2f(p.Z[(size_t)row_of(b, s + 1) * NZP + ZC_MLQK + ch]) * w[1024 + ch];
  float v = siluf_(acc);
  if (ch < 256) p.MQ[((size_t)b * TK + s) * 256 + ch] = f2bf(v);
  else p.MK[((size_t)b * TK + s) * 256 + ch - 256] = f2bf(v * 0.125f);
}
DI void nvb_ml_gates(long GI, const Params& p, int layer) {
  long i = GI; if (i >= (long)NB * 2 * NCK * 4) return;
  int h = (int)(i % 4), j = (int)((i / 4) % NCK), d = (int)((i / (4 * NCK)) % 2), b = (int)(i / (8 * NCK));
  float bi = p.b_igate[layer * 8 + d * 4 + h], bfg = p.b_fgate[layer * 8 + d * 4 + h];
  float cum = 0.f;
  for (int l = 0; l < 64; ++l) {
    int pp = 64 * j + l, s = seq_of(d, pp); const bf16_t* z = p.Z + (size_t)row_of(b, s) * NZP;
    float ig = bf2f(z[ZC_MLIG + d * 4 + h]) + bi;
    float lf = logsigmoidf_(bf2f(z[ZC_MLFG + d * 4 + h]) + bfg);
    cum += lf;
    size_t o = (((size_t)b * 2 + d) * TK + pp) * 4 + h;
    p.BC[o] = cum; p.IGS[o] = ig;
  }
}
DI void nvb_gla_cum(long GI, const Params& p, int layer) {
  long i = GI; if (i >= (long)NB * 2 * NCK * 128) return;
  int ch = (int)(i % 128), j = (int)((i / 128) % NCK), d = (int)((i / (128 * NCK)) % 2), b = (int)(i / (256 * NCK));
  const float* W = p.w_alpha2 + (size_t)layer * 2 * 16 * 128 + (size_t)d * 16 * 128;
  float ba = p.b_alpha[layer * 256 + d * 128 + ch];
  float cum = 0.f;
  for (int l = 0; l < 64; ++l) {
    int pp = 64 * j + l, s = seq_of(d, pp); const bf16_t* z = p.Z + (size_t)row_of(b, s) * NZP + ZC_GA + d * 16;
    float zg = ba; for (int q = 0; q < 16; ++q) zg += bf2f(z[q]) * W[q * 128 + ch];
    cum += logsigmoidf_(zg) * (1.0f / 16.0f);
    p.GC[(((size_t)b * 2 + d) * TK + pp) * 128 + ch] = cum;
  }
}
__global__ void __launch_bounds__(256) nv_attn_mla(Params p, int need_ctx) {
  long i = GTID; if (i >= (long)NB * 4 * TK) return;
  int s = (int)(i % TK), h = (int)((i / TK) % 4), b = (int)(i / (4 * TK));
  if (s < TC && !need_ctx) return;
  int nk = s < TC ? TC : TK;
  const bf16_t* q = p.Qm + (((size_t)b * 4 + h) * TK + s) * 96;
  const bf16_t* K = p.Km + ((size_t)b * 4 + h) * TK * 96;
  const bf16_t* Vt = p.Vtm + ((size_t)b * 4 + h) * 64 * TK;
  float qf[96], o[64];
  _Pragma("unroll") for (int k = 0; k < 96; ++k) qf[k] = bf2f(q[k]);
  _Pragma("unroll") for (int k = 0; k < 64; ++k) o[k] = 0.f;
  float m = -1e30f, l = 0.f;
  for (int t = 0; t < nk; ++t) {
    float sc = 0.f; _Pragma("unroll") for (int k = 0; k < 96; ++k) sc += qf[k] * bf2f(K[(size_t)t * 96 + k]);
    float mn = fmaxf(m, sc), a = exp2f(m - mn), pr = exp2f(sc - mn);
    l = l * a + pr;
    _Pragma("unroll") for (int k = 0; k < 64; ++k) o[k] = o[k] * a + pr * bf2f(Vt[(size_t)k * TK + t]);
    m = mn;
  }
  int r = row_of(b, s);
  _Pragma("unroll") for (int k = 0; k < 64; ++k) p.Y[(size_t)r * D + h * 64 + k] = f2bf(o[k] / l);
}
__global__ void __launch_bounds__(256) nv_attn_diff(Params p, int layer, int need_ctx) {
  long i = GTID; if (i >= (long)NB * 4 * TK) return;
  int s = (int)(i % TK), h = (int)((i / TK) % 4), b = (int)(i / (4 * TK));
  if (s < TC && !need_ctx) return;
  int nk = s < TC ? TC : TK;
  float lam_init; float lam = lam_of(p, layer, lam_init);
  const bf16_t* Vt = p.Vtd + ((size_t)b * 4 + h) * 64 * TK;
  float res[64];
  _Pragma("unroll") for (int k = 0; k < 64; ++k) res[k] = 0.f;
  _Pragma("unroll") for (int mp = 0; mp < 2; ++mp) {
    const bf16_t* q = p.Qd + (((size_t)b * 8 + h * 2 + mp) * TK + s) * 32;
    const bf16_t* K = p.Kd + ((size_t)b * 8 + h * 2 + mp) * TK * 32;
    float qf[32], o[64];
    _Pragma("unroll") for (int k = 0; k < 32; ++k) qf[k] = bf2f(q[k]);
    _Pragma("unroll") for (int k = 0; k < 64; ++k) o[k] = 0.f;
    float m = -1e30f, l = 0.f;
    for (int t = 0; t < nk; ++t) {
      float sc = 0.f; _Pragma("unroll") for (int k = 0; k < 32; ++k) sc += qf[k] * bf2f(K[(size_t)t * 32 + k]);
      float mn = fmaxf(m, sc), a = exp2f(m - mn), pr = exp2f(sc - mn);
      l = l * a + pr;
      _Pragma("unroll") for (int k = 0; k < 64; ++k) o[k] = o[k] * a + pr * bf2f(Vt[(size_t)k * TK + t]);
      m = mn;
    }
    float wgt = mp == 0 ? 1.f : -lam;
    _Pragma("unroll") for (int k = 0; k < 64; ++k) res[k] += wgt * o[k] / l;
  }
  float ss = 0.f; _Pragma("unroll") for (int k = 0; k < 64; ++k) ss += res[k] * res[k];
  float rstd = 1.0f / sqrtf(ss / 64 + 1e-6f);
  int r = row_of(b, s);
  _Pragma("unroll") for (int k = 0; k < 64; ++k) p.Y[(size_t)r * D + 768 + h * 64 + k] = f2bf(res[k] * rstd * p.g_diff_out[layer * 256 + h * 64 + k] * (1.f - lam_init));
}
DI void nvb_ml_local(long GI, const Params& p) {
  long i = GI; if (i >= (long)NUNIT * 4160) return;
  int e = (int)(i % 4160); long u = i / 4160;
  int h = (int)(u % 4), j = (int)((u / 4) % NCK), d = (int)((u / (4 * NCK)) % 2), b = (int)(u / (8 * NCK));
  const float* bc = p.BC + (((size_t)b * 2 + d) * TK + 64 * j) * 4 + h; const float* ig = p.IGS + (((size_t)b * 2 + d) * TK + 64 * j) * 4 + h;
  float bend = bc[63 * 4], ml = -1e30f;
  for (int l = 0; l < 64; ++l) ml = fmaxf(ml, bend - bc[l * 4] + ig[l * 4]);
  if (e == 4096 + 0) { p.MM[u * 4 + 0] = ml; p.MM[u * 4 + 1] = bend; }
  float acc = 0.f;
  if (e < 4096) {
    int v = e / 64, k = e % 64;
    for (int l = 0; l < 64; ++l) {
      int s = seq_of(d, 64 * j + l); float w = expf(bend - bc[l * 4] + ig[l * 4] - ml);
      acc += w * bf2f(p.Z[(size_t)row_of(b, s) * NZP + ZC_MLV + h * 64 + v]) * bf2f(p.MK[((size_t)b * TK + s) * 256 + h * 64 + k]);
    }
    p.MC[(size_t)u * 4096 + e] = acc;
  } else {
    int k = e - 4096;
    for (int l = 0; l < 64; ++l) {
      int s = seq_of(d, 64 * j + l); float w = expf(bend - bc[l * 4] + ig[l * 4] - ml);
      acc += w * bf2f(p.MK[((size_t)b * TK + s) * 256 + h * 64 + k]);
    }
    p.MN[(size_t)u * 64 + k] = acc;
  }
}
DI void nvb_ml_scan(long GI, const Params& p) {
  long i = GI; if (i >= (long)NB * 2 * 4 * 4160) return;
  int e = (int)(i % 4160); int ch = (int)(i / 4160); int h = ch % 4, bd = ch / 4;
  float st = 0.f, m = -1e30f;
  for (int j = 0; j < NCK; ++j) {
    size_t u = ((size_t)bd * NCK + j) * 4 + h;
    float ml = p.MM[u * 4 + 0], be = p.MM[u * 4 + 1];
    float mn = fmaxf(be + m, ml), a = expf(be + m - mn), g = expf(ml - mn);
    float* slot = e < 4096 ? &p.MC[u * 4096 + e] : &p.MN[u * 64 + (e - 4096)];
    float loc = *slot; *slot = st; st = a * st + g * loc;
    if (e == 0) p.MM[u * 4 + 2] = m;
    m = mn;
  }
}
DI void nvb_ml_out(long GI, const Params& p, int need_ctx) {
  long i = GI; if (i >= (long)NUNIT * 4096) return;
  int v = (int)(i % 64), l = (int)((i / 64) % 64); long u = i / 4096;
  int h = (int)(u % 4), j = (int)((u / 4) % NCK), d = (int)((u / (4 * NCK)) % 2), b = (int)(u / (8 * NCK));
  if (j < NCC && !need_ctx) return;
  const float* bc = p.BC + (((size_t)b * 2 + d) * TK + 64 * j) * 4 + h; const float* ig = p.IGS + (((size_t)b * 2 + d) * TK + 64 * j) * 4 + h;
  float m0 = p.MM[u * 4 + 2];
  int sl = seq_of(d, 64 * j + l);
  const bf16_t* q = p.MQ + ((size_t)b * TK + sl) * 256 + h * 64;
  float bl = bc[l * 4];
  float inter = bl + m0, mt = inter;
  for (int t = 0; t <= l; ++t) mt = fmaxf(mt, bl - bc[t * 4] + ig[t * 4]);
  float num = 0.f, den = 0.f;
  for (int t = 0; t <= l; ++t) {
    int st = seq_of(d, 64 * j + t);
    const bf16_t* k = p.MK + ((size_t)b * TK + st) * 256 + h * 64;
    float qk = 0.f; for (int c = 0; c < 64; ++c) qk += bf2f(q[c]) * bf2f(k[c]);
    float sv = expf(bl - bc[t * 4] + ig[t * 4] - mt) * qk;
    num += sv * bf2f(p.Z[(size_t)row_of(b, st) * NZP + ZC_MLV + h * 64 + v]); den += sv;
  }
  float ai = expf(inter - mt);
  float qc = 0.f, qn = 0.f;
  for (int c = 0; c < 64; ++c) { qc += bf2f(q[c]) * p.MC[(size_t)u * 4096 + v * 64 + c]; qn += bf2f(q[c]) * p.MN[(size_t)u * 64 + c]; }
  num += ai * qc; den += ai * qn;
  p.HD[(((size_t)d * NB + b) * TK + sl) * 256 + h * 64 + v] = num / fmaxf(fabsf(den), expf(-mt));
}
DI void nvb_ml_finish(long GI, const Params& p, int layer, int need_ctx) {
  long i = GI; if (i >= (long)R * 4) return;
  int h = (int)(i % 4), r = (int)(i / 4); int b, s; bs_of(r, b, s);
  if (s < TC && !need_ctx) return;
  const float* h0 = p.HD + (((size_t)0 * NB + b) * TK + s) * 256 + h * 64; const float* h1 = p.HD + (((size_t)1 * NB + b) * TK + s) * 256 + h * 64;
  float ss = 0.f; for (int v = 0; v < 64; ++v) { float t = h0[v] + h1[v]; ss += t * t; }
  float rstd = 1.0f / sqrtf(ss / 64 + 1e-6f);
  for (int v = 0; v < 64; ++v) {
    float o = bf2f(p.Z[(size_t)r * NZP + ZC_MLO + h * 64 + v]);
    p.Y[(size_t)r * D + 256 + h * 64 + v] = f2bf(sigmoidf_(o) * (h0[v] + h1[v]) * rstd * p.g_mlstm_out[layer * 256 + h * 64 + v]);
  }
}
DI void nvb_gla_local(long GI, const Params& p) {
  long i = GI; if (i >= (long)NUNIT * 2048) return;
  int v = (int)(i % 64), k = (int)((i / 64) % 32); long u = i / 2048;
  int h = (int)(u % 4), j = (int)((u / 4) % NCK), d = (int)((u / (4 * NCK)) % 2), b = (int)(u / (8 * NCK));
  const float* gc = p.GC + (((size_t)b * 2 + d) * TK + 64 * j) * 128 + h * 32 + k;
  float ge = gc[63 * 128], acc = 0.f;
  for (int l = 0; l < 64; ++l) {
    int s = seq_of(d, 64 * j + l); const bf16_t* z = p.Z + (size_t)row_of(b, s) * NZP;
    acc += bf2f(z[ZC_GK + h * 32 + k]) * expf(ge - gc[l * 128]) * bf2f(z[ZC_GV + h * 64 + v]);
  }
  p.GS[(size_t)u * 2048 + v * 32 + k] = acc;
}
DI void nvb_gla_scan(long GI, const Params& p) {
  long i = GI; if (i >= (long)NB * 2 * 4 * 2048) return;
  int e = (int)(i % 2048); int ch = (int)(i / 2048); int h = ch % 4, bd = ch / 4; int k = e % 32;
  float st = 0.f;
  for (int j = 0; j < NCK; ++j) {
    size_t u = ((size_t)bd * NCK + j) * 4 + h;
    float ge = p.GC[((size_t)bd * TK + 64 * j + 63) * 128 + h * 32 + k];
    float loc = p.GS[u * 2048 + e]; p.GS[u * 2048 + e] = st; st = expf(ge) * st + loc;
  }
}
DI void nvb_gla_out(long GI, const Params& p, int need_ctx) {
  long i = GI; if (i >= (long)NUNIT * 4096) return;
  int v = (int)(i % 64), l = (int)((i / 64) % 64); long u = i / 4096;
  int h = (int)(u % 4), j = (int)((u / 4) % NCK), d = (int)((u / (4 * NCK)) % 2), b = (int)(u / (8 * NCK));
  if (j < NCC && !need_ctx) return;
  const float* gc = p.GC + (((size_t)b * 2 + d) * TK + 64 * j) * 128 + h * 32;
  int sl = seq_of(d, 64 * j + l);
  const bf16_t* q = p.Z + (size_t)row_of(b, sl) * NZP + ZC_GQ + h * 32;
  const float qs = 0.17677669529663687f;
  float acc = 0.f;
  for (int t = 0; t <= l; ++t) {
    int st = seq_of(d, 64 * j + t); const bf16_t* z = p.Z + (size_t)row_of(b, st) * NZP;
    float att = 0.f; for (int k = 0; k < 32; ++k) att += bf2f(q[k]) * qs * expf(gc[l * 128 + k] - gc[t * 128 + k]) * bf2f(z[ZC_GK + h * 32 + k]);
    acc += att * bf2f(z[ZC_GV + h * 64 + v]);
  }
  for (int k = 0; k < 32; ++k) acc += bf2f(q[k]) * qs * expf(gc[l * 128 + k]) * p.GS[(size_t)u * 2048 + v * 32 + k];
  p.OD[(((size_t)d * NB + b) * TK + sl) * 256 + h * 64 + v] = acc;
}
DI void nvb_gla_finish(long GI, const Params& p, int layer, int need_ctx) {
  long i = GI; if (i >= (long)R * 4) return;
  int h = (int)(i % 4), r = (int)(i / 4); int b, s; bs_of(r, b, s);
  if (s < TC && !need_ctx) return;
  const float* h0 = p.OD + (((size_t)0 * NB + b) * TK + s) * 256 + h * 64; const float* h1 = p.OD + (((size_t)1 * NB + b) * TK + s) * 256 + h * 64;
  float ss = 0.f; for (int v = 0; v < 64; ++v) { float t = h0[v] + h1[v]; ss += t * t; }
  float rstd = 1.0f / sqrtf(ss / 64 + 1e-6f);
  for (int v = 0; v < 64; ++v) {
    float rr = bf2f(p.Z[(size_t)r * NZP + ZC_GR + h * 64 + v]);
    p.Y[(size_t)r * D + 512 + h * 64 + v] = f2bf(siluf_(rr) * (h0[v] + h1[v]) * rstd * p.g_gla_out[layer * 256 + h * 64 + v]);
  }
}
__global__ void __launch_bounds__(256) nv_merge(Params p, int layer, int nrows) {
  long i = GTID; if (i >= (long)nrows * D) return;
  int j = (int)(i % D), r = (int)(i / D);
  float acc = 0.f;
  for (int n = 0; n < 4; ++n) {
    const bf16_t* wg = p.Wt_gate + (size_t)(n * 1024 + j) * D; const bf16_t* wb = p.Wt_branch + ((size_t)n * D + j) * 256;
    float g = p.b_gate[layer * 4096 + n * 1024 + j], pr = 0.f;
    for (int k = 0; k < D; ++k) g += bf2f(p.H[(size_t)r * D + k]) * bf2f(wg[k]);
    for (int k = 0; k < 256; ++k) pr += bf2f(p.Y[(size_t)r * D + n * 256 + k]) * bf2f(wb[k]);
    acc += sigmoidf_(g) * pr;
  }
  p.MG[(size_t)r * D + j] = f2bf(acc);
}
__global__ void __launch_bounds__(256) nv_resid_mix(Params p, int layer, const float* xl_in, const float* xc_in, int nrows) {
  long r = GTID; if (r >= nrows) return;
  int w = r < RL ? (int)(r / TL) : 2;
  const float* mb = p.mods + (size_t)(layer * 3 + w) * 6144;
  const float* xin = r < RL ? xl_in + (size_t)r * D : xc_in + (size_t)(r - RL) * D;
  float* xo = r < RL ? p.out + (size_t)r * D : p.xc + (size_t)(r - RL) * D;
  const bf16_t* yo = p.YO + (size_t)r * D;
  float ss = 0.f; for (int k = 0; k < D; ++k) { float v = bf2f(yo[k]); ss += v * v; }
  float rstd = 1.0f / sqrtf(ss / D + 1e-6f);
  float s2 = 0.f;
  for (int k = 0; k < D; ++k) { float xn = xin[k] + mb[2 * 1024 + k] * bf2f(yo[k]) * rstd * p.g_mix_post[layer * 1024 + k]; xo[k] = xn; s2 += xn * xn; }
  float rstd2 = 1.0f / sqrtf(s2 / D + 1e-6f);
  float lg[16]; _Pragma("unroll") for (int e = 0; e < 16; ++e) lg[e] = 0.f;
  const float* wr = p.w_router + (size_t)layer * D * 16;
  for (int k = 0; k < D; ++k) {
    float h2 = xo[k] * rstd2 * p.g_ffn_pre[layer * 1024 + k] * (1.f + mb[4 * 1024 + k]) + mb[3 * 1024 + k];
    p.H[(size_t)r * D + k] = f2bf(h2);
    _Pragma("unroll") for (int e = 0; e < 16; ++e) lg[e] += h2 * wr[k * 16 + e];
  }
  float mx = lg[0]; _Pragma("unroll") for (int e = 1; e < 16; ++e) mx = fmaxf(mx, lg[e]);
  float sm = 0.f; _Pragma("unroll") for (int e = 0; e < 16; ++e) { lg[e] = expf(lg[e] - mx); sm += lg[e]; }
  int b, s; bs_of((int)r, b, s);
  _Pragma("unroll") for (int e = 0; e < 16; ++e) p.AFF[((size_t)b * NE + e) * TK + s] = lg[e] / sm;
}
__global__ void __launch_bounds__(256) nv_topk(Params p, int need_ctx) {
  long i = GTID; if (i >= NB * NE * 2) return;
  int seg = (int)(i % 2), e = (int)((i / 2) % NE), b = (int)(i / (2 * NE));
  int s0 = seg ? TC : 0, n = seg ? TL : TC, cap = seg ? CAPL : CAPC, slot0 = seg ? b * CAPL : NB * CAPL + b * CAPC;
  if (seg == 0 && !need_ctx) { for (int q = 0; q < cap; ++q) p.SEL[(size_t)e * NSLOT + slot0 + q] = -1; return; }
  const float* a = p.AFF + ((size_t)b * NE + e) * TK + s0;
  unsigned thr = 0;
  for (int bit = 31; bit >= 0; --bit) {
    unsigned cand = thr | (1u << bit); int cnt = 0;
    for (int t = 0; t < n; ++t) cnt += (f2u(a[t]) >= cand);
    if (cnt >= cap) thr = cand;
  }
  int ngt = 0; for (int t = 0; t < n; ++t) ngt += (f2u(a[t]) > thr);
  int neq = cap - ngt, q = 0;
  for (int t = 0; t < n; ++t) {
    unsigned u = f2u(a[t]); int r = row_of(b, s0 + t); int sel = -1;
    if (u > thr) sel = q++; else if (u == thr && neq > 0) { sel = q++; --neq; }
    if (sel >= 0) { p.SEL[(size_t)e * NSLOT + slot0 + sel] = r; p.SELV[(size_t)e * NSLOT + slot0 + sel] = a[t]; }
    p.INV[(size_t)r * NE + e] = sel >= 0 ? slot0 + sel : -1;
  }
}
__global__ void __launch_bounds__(256) nv_moe1(Params p) {
  long i = GTID; if (i >= (long)NE * NSLOT * FF) return;
  int f = (int)(i % FF), slot = (int)((i / FF) % NSLOT), e = (int)(i / ((long)FF * NSLOT));
  int r = p.SEL[(size_t)e * NSLOT + slot];
  float out = 0.f;
  if (r >= 0) {
    const bf16_t* wg = p.Wt_eg + ((size_t)e * FF + f) * D; const bf16_t* wu = p.Wt_eu + ((size_t)e * FF + f) * D; const bf16_t* h = p.H + (size_t)r * D;
    float g = 0.f, u = 0.f; for (int k = 0; k < D; ++k) { float hv = bf2f(h[k]); g += hv * bf2f(wg[k]); u += hv * bf2f(wu[k]); }
    out = siluf_(g) * u;
  }
  p.HID[((size_t)e * NSLOT + slot) * FF + f] = f2bf(out);
}
__global__ void __launch_bounds__(256) nv_moe2(Params p) {
  long i = GTID; if (i >= (long)NE * NSLOT * D) return;
  int j = (int)(i % D), slot = (int)((i / D) % NSLOT), e = (int)(i / ((long)D * NSLOT));
  int r = p.SEL[(size_t)e * NSLOT + slot];
  float out = 0.f;
  if (r >= 0) {
    const bf16_t* wd = p.Wt_ed + ((size_t)e * D + j) * FF; const bf16_t* h = p.HID + ((size_t)e * NSLOT + slot) * FF;
    float a = 0.f; for (int k = 0; k < FF; ++k) a += bf2f(h[k]) * bf2f(wd[k]);
    out = a * p.SELV[(size_t)e * NSLOT + slot];
  }
  p.YE[((size_t)e * NSLOT + slot) * D + j] = f2bf(out);
}
__global__ void __launch_bounds__(256) nv_resid_ffn(Params p, int layer, int nrows) {
  long r = GTID; if (r >= nrows) return;
  int w = r < RL ? (int)(r / TL) : 2;
  const float* mb = p.mods + (size_t)(layer * 3 + w) * 6144;
  float* xo = r < RL ? p.out + (size_t)r * D : p.xc + (size_t)(r - RL) * D;
  float ss = 0.f;
  for (int k = 0; k < D; ++k) {
    float f = 0.f;
    for (int e = 0; e < NE; ++e) { int sl = p.INV[(size_t)r * NE + e]; if (sl >= 0) f += bf2f(p.YE[((size_t)e * NSLOT + sl) * D + k]); }
    ss += f * f;
  }
  float rstd = 1.0f / sqrtf(ss / D + 1e-6f);
  for (int k = 0; k < D; ++k) {
    float f = 0.f;
    for (int e = 0; e < NE; ++e) { int sl = p.INV[(size_t)r * NE + e]; if (sl >= 0) f += bf2f(p.YE[((size_t)e * NSLOT + sl) * D + k]); }
    xo[k] += mb[5 * 1024 + k] * f * rstd * p.g_ffn_post[layer * 1024 + k];
  }
}

__global__ void __launch_bounds__(256) nv_mods(Params p) { nvb_mods(GTID, p); }
__global__ void __launch_bounds__(256) nv_ml_gates(Params p, int layer) { nvb_ml_gates(GTID, p, layer); }
__global__ void __launch_bounds__(256) nv_gla_cum(Params p, int layer) { nvb_gla_cum(GTID, p, layer); }
__global__ void __launch_bounds__(256) nv_ml_local(Params p) { nvb_ml_local(GTID, p); }
__global__ void __launch_bounds__(256) nv_ml_scan(Params p) { nvb_ml_scan(GTID, p); }
__global__ void __launch_bounds__(256) nv_ml_out(Params p, int need_ctx) { nvb_ml_out(GTID, p, need_ctx); }
__global__ void __launch_bounds__(256) nv_ml_finish(Params p, int layer, int need_ctx) { nvb_ml_finish(GTID, p, layer, need_ctx); }
__global__ void __launch_bounds__(256) nv_gla_local(Params p) { nvb_gla_local(GTID, p); }
__global__ void __launch_bounds__(256) nv_gla_scan(Params p) { nvb_gla_scan(GTID, p); }
__global__ void __launch_bounds__(256) nv_gla_out(Params p, int need_ctx) { nvb_gla_out(GTID, p, need_ctx); }
__global__ void __launch_bounds__(256) nv_gla_finish(Params p, int layer, int need_ctx) { nvb_gla_finish(GTID, p, layer, need_ctx); }
constexpr int LROW = 144;
constexpr int A_BYTES = 128 * LROW;
constexpr int NTHR = 256;
#ifndef ATT_THR
#define ATT_THR 16.0f
#endif

DI u32x4 ldg16(const void* p) { return *(const u32x4*)p; }
DI void sts16(char* p, u32x4 v) { *(u32x4*)p = v; }
DI bf16x8 lds_frag(const char* p) { return *(const bf16x8*)p; }

template <int WN>
DI void gemm_kloop(f32x4 (&acc)[4][WN], const bf16_t* const (&ap)[4], const bf16_t* const (&bp)[WN], int nk, char* lds) {
  constexpr int STAGE = A_BYTES + 32 * WN * LROW;
  const int t = TIDX, lane = t & 63, wid = t >> 6, wr = wid >> 1, wc = wid & 1;
  const int lr = t >> 3, lcb = (t & 7) * 16;
  const int fr = lane & 15, fq = lane >> 4;
  const int aoff = (wr * 64 + fr) * LROW + fq * 16, boff = A_BYTES + (wc * WN * 16 + fr) * LROW + fq * 16, soff = lr * LROW + lcb;
  u32x4 ra0[4], rb0[WN], ra1[4], rb1[WN];
  auto gload = [&](u32x4 (&ra)[4], u32x4 (&rb)[WN], int kt) {
#pragma unroll
    for (int i = 0; i < 4; ++i) ra[i] = ldg16(ap[i] + kt * 64);
#pragma unroll
    for (int i = 0; i < WN; ++i) rb[i] = ldg16(bp[i] + kt * 64);
  };
  auto sstore = [&](const u32x4 (&ra)[4], const u32x4 (&rb)[WN], char* st) {
#pragma unroll
    for (int i = 0; i < 4; ++i) sts16(st + soff + 32 * i * LROW, ra[i]);
#pragma unroll
    for (int i = 0; i < WN; ++i) sts16(st + A_BYTES + soff + 32 * i * LROW, rb[i]);
  };
  auto compute = [&](const char* cur) {
#pragma unroll
    for (int ks = 0; ks < 2; ++ks) {
      bf16x8 af[4], bfr[WN];
#pragma unroll
      for (int m = 0; m < 4; ++m) af[m] = lds_frag(cur + aoff + m * 16 * LROW + ks * 64);
#pragma unroll
      for (int n = 0; n < WN; ++n) bfr[n] = lds_frag(cur + boff + n * 16 * LROW + ks * 64);
#pragma unroll
      for (int m = 0; m < 4; ++m)
#pragma unroll
        for (int n = 0; n < WN; ++n) acc[m][n] = MFMA16(bfr[n], af[m], acc[m][n]);
    }
  };
  gload(ra0, rb0, 0);
  gload(ra1, rb1, 1);
  sstore(ra0, rb0, lds);
  __syncthreads();
#pragma unroll 1
  for (int kt = 0; kt < nk; kt += 2) {
    if (kt + 2 < nk) gload(ra0, rb0, kt + 2);
    compute(lds);
    sstore(ra1, rb1, lds + STAGE);
    __syncthreads();
    if (kt + 3 < nk) gload(ra1, rb1, kt + 3);
    compute(lds + STAGE);
    if (kt + 2 < nk) sstore(ra0, rb0, lds);
    __syncthreads();
  }
}
template <int WN> DI void acc_zero(f32x4 (&acc)[4][WN]) {
#pragma unroll
  for (int m = 0; m < 4; ++m)
#pragma unroll
    for (int n = 0; n < WN; ++n) acc[m][n] = (f32x4){0.f, 0.f, 0.f, 0.f};
}
DI void st_bf16x4(bf16_t* p, f32x4 v) { u32x2 o; o.x = pack2bf(v.x, v.y); o.y = pack2bf(v.z, v.w); *(u32x2*)p = o; }

template <int WN, class RowOk>
DI void store_wave_tile(const f32x4 (&acc)[4][WN], bf16_t* C, size_t ldc, char* ldsw, int lane, RowOk row_ok) {
  constexpr int PITCH = WN * 32 + 16, CPR = WN * 2;
  const int fr = lane & 15, fq = lane >> 4;
#pragma unroll
  for (int m = 0; m < 4; ++m)
#pragma unroll
    for (int n = 0; n < WN; ++n) { u32x2 o; o.x = pack2bf(acc[m][n][0], acc[m][n][1]); o.y = pack2bf(acc[m][n][2], acc[m][n][3]); *(u32x2*)(ldsw + (m * 16 + fr) * PITCH + n * 32 + fq * 8) = o; }
  WAVE_SYNC();
  constexpr int RPP = 64 / CPR;
#pragma unroll
  for (int ps = 0; ps < 64 / RPP; ++ps) {
    const int r = ps * RPP + lane / CPR, c = lane % CPR;
    const u32x4 v = *(const u32x4*)(ldsw + r * PITCH + c * 16);
    if (row_ok(r)) *(u32x4*)(C + (size_t)r * ldc + c * 8) = v;
  }
  WAVE_SYNC();
}
template <int NOSTORE = 0>
DI void gemm_plain_tile(const bf16_t* A, int lda, const bf16_t* Bt, int ldb, int K, bf16_t* C, int ldc, int tm, int tn, char* lds) {
  const int t = TIDX, lane = t & 63, wid = t >> 6, wr = wid >> 1, wc = wid & 1, lr = t >> 3, lc = (t & 7) * 8, fr = lane & 15, fq = lane >> 4;
  const bf16_t* ap[4]; const bf16_t* bp[4];
#pragma unroll
  for (int i = 0; i < 4; ++i) { ap[i] = A + (size_t)(tm * 128 + lr + 32 * i) * lda + lc; bp[i] = Bt + (size_t)(tn * 128 + lr + 32 * i) * ldb + lc; }
  f32x4 acc[4][4]; acc_zero<4>(acc);
  gemm_kloop<4>(acc, ap, bp, K / 64, lds);
  if (NOSTORE) { float s = 0.f;
#pragma unroll
    for (int m = 0; m < 4; ++m)
#pragma unroll
      for (int n = 0; n < 4; ++n) s += acc[m][n][0] + acc[m][n][3];
    if (s == 123456.789f) C[0] = 1; return; }
  store_wave_tile<4>(acc, C + (size_t)(tm * 128 + wr * 64) * ldc + tn * 128 + wc * 64, (size_t)ldc, lds + wid * (64 * 144), lane, [](int) { return true; });
  __syncthreads();
}
template <int NOSTORE = 0>
DI void ph_gemm_plain(const bf16_t* A, int lda, const bf16_t* Bt, int ldb, int M, int N, int K, bf16_t* C, int ldc, char* lds, int bid, int nblk) {
  const int ntn = N / 128, nt = (M / 128) * ntn;
  for (int tile = bid; tile < nt; tile += nblk) gemm_plain_tile<NOSTORE>(A, lda, Bt, ldb, K, C, ldc, tile / ntn, tile % ntn, lds);
}
DI void ph_mla_up(const Params& p, int layer, bf16_t* QRAW, bf16_t* KVRAW, char* lds, int bid, int nblk) {
  const int ntq = (R / 128) * 3, ntkv = (R / 128) * 4;
  for (int tile = bid; tile < ntq + ntkv; tile += nblk) {
    if (tile < ntq) gemm_plain_tile(p.Z + ZC_QLAT, NZP, p.Wt_uq + layer * WSZ_UQ, 256, 256, QRAW, 384, tile / 3, tile % 3, lds);
    else { int u = tile - ntq; gemm_plain_tile(p.Z + ZC_KVLAT, NZP, p.Wt_ukv + layer * WSZ_UKV, 128, 128, KVRAW, 512, u / 4, u % 4, lds); }
  }
}
constexpr int LROW32 = 80;
template <int WM, int WN, bool DEEP>
DI void gemm_kloop_g(f32x4 (&acc)[WM][WN], const bf16_t* const (&ap)[WM / 2], const bf16_t* const (&bp)[WN / 2], int nk, char* lds) {
  constexpr int NA = WM / 2, NBB = WN / 2, A_B = 32 * WM * LROW32, STAGE = (32 * WM + 32 * WN) * LROW32;
  const int t = TIDX, lane = t & 63, wid = t >> 6, wr = wid >> 1, wc = wid & 1, fr = lane & 15, fq = lane >> 4;
  const int aoff = (wr * 16 * WM + fr) * LROW32 + fq * 16, boff = A_B + (wc * 16 * WN + fr) * LROW32 + fq * 16, soff = (t >> 2) * LROW32 + (t & 3) * 16;
  u32x4 ra0[NA], rb0[NBB], ra1[NA], rb1[NBB];
  auto gload = [&](u32x4 (&ra)[NA], u32x4 (&rb)[NBB], int kt) {
#pragma unroll
    for (int i = 0; i < NA; ++i) ra[i] = ldg16(ap[i] + kt * 32);
#pragma unroll
    for (int i = 0; i < NBB; ++i) rb[i] = ldg16(bp[i] + kt * 32);
  };
  auto sstore = [&](const u32x4 (&ra)[NA], const u32x4 (&rb)[NBB], char* st) {
#pragma unroll
    for (int i = 0; i < NA; ++i) sts16(st + soff + 64 * i * LROW32, ra[i]);
#pragma unroll
    for (int i = 0; i < NBB; ++i) sts16(st + A_B + soff + 64 * i * LROW32, rb[i]);
  };
  auto compute = [&](const char* cur) {
    bf16x8 af[WM];
#pragma unroll
    for (int m = 0; m < WM; ++m) af[m] = lds_frag(cur + aoff + m * 16 * LROW32);
#pragma unroll
    for (int n = 0; n < WN; ++n) {
      const bf16x8 bfr = lds_frag(cur + boff + n * 16 * LROW32);
#pragma unroll
      for (int m = 0; m < WM; ++m) acc[m][n] = MFMA16(bfr, af[m], acc[m][n]);
    }
  };
  gload(ra0, rb0, 0);
  if (DEEP) gload(ra1, rb1, 1);
  sstore(ra0, rb0, lds);
  __syncthreads();
#pragma unroll 1
  for (int kt = 0; kt < nk; kt += 2) {
    if (DEEP) { if (kt + 2 < nk) gload(ra0, rb0, kt + 2); } else gload(ra1, rb1, kt + 1);
    compute(lds);
    sstore(ra1, rb1, lds + STAGE);
    __syncthreads();
    if (DEEP) { if (kt + 3 < nk) gload(ra1, rb1, kt + 3); } else if (kt + 2 < nk) gload(ra0, rb0, kt + 2);
    compute(lds + STAGE);
    if (kt + 2 < nk) sstore(ra0, rb0, lds);
    __syncthreads();
  }
}
template <int WM, int WN> DI void acc_zero_g(f32x4 (&acc)[WM][WN]) {
#pragma unroll
  for (int m = 0; m < WM; ++m)
#pragma unroll
    for (int n = 0; n < WN; ++n) acc[m][n] = (f32x4){0.f, 0.f, 0.f, 0.f};
}
DI void ph_merge(const Params& p, int layer, int rows, char* lds, int bid, int nblk) {
  const int t = TIDX, lane = t & 63, wid = t >> 6, wr = wid >> 1, wc = wid & 1, fr = lane & 15, fq = lane >> 4;
  const int lr = t >> 2, lc = (t & 3) * 8;
  const int ntn = D / 64, nt = (rows / 128) * ntn;
#pragma unroll 1
  for (int tile = bid; tile < nt; tile += nblk) {
    const int tm = tile / ntn, tn = tile % ntn;
    f32x4 accS[4][2]; acc_zero_g<4, 2>(accS);
#pragma unroll 1
    for (int np = 0; np < 2; ++np) {
      f32x4 accG[4][4]; acc_zero_g<4, 4>(accG);
      {
        const bf16_t* ap[2]; const bf16_t* bp[2];
#pragma unroll
        for (int i = 0; i < 2; ++i) ap[i] = p.H + (size_t)(tm * 128 + lr + 64 * i) * D + lc;
#pragma unroll
        for (int i = 0; i < 2; ++i) { const int rho = lr + 64 * i, wci = rho >> 6, n = 2 * np + ((rho >> 5) & 1), c = rho & 31;
          bp[i] = p.Wt_gate + layer * WSZ_GATE + ((size_t)n * 1024 + tn * 64 + wci * 32 + c) * D + lc; }
        gemm_kloop_g<4, 4, true>(accG, ap, bp, D / 32, lds);
      }
#pragma unroll 1
      for (int q = 0; q < 2; ++q) {
        const int n = 2 * np + q;
        f32x4 accP[4][2]; acc_zero_g<4, 2>(accP);
        const bf16_t* ap[2]; const bf16_t* bp[1];
#pragma unroll
        for (int i = 0; i < 2; ++i) ap[i] = p.Y + (size_t)(tm * 128 + lr + 64 * i) * D + n * 256 + lc;
        bp[0] = p.Wt_branch + layer * WSZ_BR + ((size_t)n * D + tn * 64 + lr) * 256 + lc;
        gemm_kloop_g<4, 2, false>(accP, ap, bp, 8, lds);
#pragma unroll
        for (int nn = 0; nn < 2; ++nn) {
          const f32x4 bv = *(const f32x4*)(p.b_gate + layer * 4096 + n * 1024 + tn * 64 + wc * 32 + nn * 16 + 4 * fq);
#pragma unroll
          for (int m = 0; m < 4; ++m)
#pragma unroll
            for (int j = 0; j < 4; ++j) { const float g = q ? accG[m][2 + nn][j] : accG[m][nn][j]; accS[m][nn][j] += accP[m][nn][j] * fast_rcp(1.0f + fast_exp2(-LOG2E * (g + bv[j]))); }
        }
      }
    }
    store_wave_tile<2>(accS, p.MG + (size_t)(tm * 128 + wr * 64) * D + tn * 64 + wc * 32, (size_t)D, lds + wid * (64 * 80), lane, [](int) { return true; });
    __syncthreads();
  }
}
template <int WM>
DI void gemm_plain_tile_g(const bf16_t* A, int lda, const bf16_t* Bt, int ldb, int K, bf16_t* C, int ldc, int row0, int col0, char* lds) {
  const int t = TIDX, lane = t & 63, wid = t >> 6, wr = wid >> 1, wc = wid & 1, fr = lane & 15, fq = lane >> 4, lr = t >> 2, lc = (t & 3) * 8;
  const bf16_t* ap[WM / 2]; const bf16_t* bp[2];
#pragma unroll
  for (int i = 0; i < WM / 2; ++i) ap[i] = A + (size_t)(row0 + lr + 64 * i) * lda + lc;
#pragma unroll
  for (int i = 0; i < 2; ++i) bp[i] = Bt + (size_t)(col0 + lr + 64 * i) * ldb + lc;
  f32x4 acc[WM][4]; acc_zero_g<WM, 4>(acc);
  gemm_kloop_g<WM, 4, true>(acc, ap, bp, K / 32, lds);
#pragma unroll
  for (int m = 0; m < WM; ++m)
#pragma unroll
    for (int n = 0; n < 4; ++n)
      st_bf16x4(C + (size_t)(row0 + wr * 16 * WM + m * 16 + fr) * ldc + col0 + wc * 64 + n * 16 + 4 * fq, acc[m][n]);
}
DI void ph_gemm_plain2(const bf16_t* A, int lda, const bf16_t* Bt, int ldb, int M, int N, int K, bf16_t* C, int ldc, char* lds, int bid, int nblk) {
  const int ntn = N / 128, nt = (M / 256) * ntn, nfull = (nt / nblk) * nblk;
#pragma unroll 1
  for (int tile = bid; tile < nfull; tile += nblk) gemm_plain_tile_g<8>(A, lda, Bt, ldb, K, C, ldc, (tile / ntn) * 256, (tile % ntn) * 128, lds);
#pragma unroll 1
  for (int h = bid; h < 2 * (nt - nfull); h += nblk) { const int tile = nfull + (h >> 1); gemm_plain_tile_g<4>(A, lda, Bt, ldb, K, C, ldc, (tile / ntn) * 256 + (h & 1) * 128, (tile % ntn) * 128, lds); }
}
DI void gemm_kloop32(f32x16 (&acc)[2][2], const bf16_t* const (&ap)[4], const bf16_t* const (&bp)[4], int nk, char* lds) {
  constexpr int STAGE = A_BYTES + 128 * LROW;
  const int t = TIDX, lane = t & 63, wid = t >> 6, wr = wid >> 1, wc = wid & 1, l31 = lane & 31, hh = lane >> 5;
  const int aoff = (wr * 64 + l31) * LROW + hh * 16, boff = A_BYTES + (wc * 64 + l31) * LROW + hh * 16, soff = (t >> 3) * LROW + (t & 7) * 16;
  u32x4 ra0[4], rb0[4], ra1[4], rb1[4];
  auto gload = [&](u32x4 (&ra)[4], u32x4 (&rb)[4], int kt) {
#pragma unroll
    for (int i = 0; i < 4; ++i) { ra[i] = ldg16(ap[i] + kt * 64); rb[i] = ldg16(bp[i] + kt * 64); }
  };
  auto sstore = [&](const u32x4 (&ra)[4], const u32x4 (&rb)[4], char* st) {
#pragma unroll
    for (int i = 0; i < 4; ++i) { sts16(st + soff + 32 * i * LROW, ra[i]); sts16(st + A_BYTES + soff + 32 * i * LROW, rb[i]); }
  };
  auto compute = [&](const char* cur) {
#pragma unroll
    for (int ks = 0; ks < 4; ++ks) {
      bf16x8 af[2], bfr[2];
#pragma unroll
      for (int m = 0; m < 2; ++m) af[m] = lds_frag(cur + aoff + m * 32 * LROW + ks * 32);
#pragma unroll
      for (int n = 0; n < 2; ++n) bfr[n] = lds_frag(cur + boff + n * 32 * LROW + ks * 32);
#pragma unroll
      for (int m = 0; m < 2; ++m)
#pragma unroll
        for (int n = 0; n < 2; ++n) acc[m][n] = MFMA32(bfr[n], af[m], acc[m][n]);
    }
  };
  gload(ra0, rb0, 0); gload(ra1, rb1, 1);
  sstore(ra0, rb0, lds);
  __syncthreads();
#pragma unroll 1
  for (int kt = 0; kt < nk; kt += 2) {
    if (kt + 2 < nk) gload(ra0, rb0, kt + 2);
    compute(lds);
    sstore(ra1, rb1, lds + STAGE);
    __syncthreads();
    if (kt + 3 < nk) gload(ra1, rb1, kt + 3);
    compute(lds + STAGE);
    if (kt + 2 < nk) sstore(ra0, rb0, lds);
    __syncthreads();
  }
}
DI void ph_gemm_plain32(const bf16_t* A, int lda, const bf16_t* Bt, int ldb, int M, int N, int K, bf16_t* C, int ldc, char* lds, int bid, int nblk) {
  const int t = TIDX, lane = t & 63, wid = t >> 6, wr = wid >> 1, wc = wid & 1, lr = t >> 3, lc = (t & 7) * 8, l31 = lane & 31, hh = lane >> 5;
  const int ntn = N / 128, nt = (M / 128) * ntn;
#pragma unroll 1
  for (int tile = bid; tile < nt; tile += nblk) {
    const int tm = tile / ntn, tn = tile % ntn;
    const bf16_t* ap[4]; const bf16_t* bp[4];
#pragma unroll
    for (int i = 0; i < 4; ++i) { ap[i] = A + (size_t)(tm * 128 + lr + 32 * i) * lda + lc; bp[i] = Bt + (size_t)(tn * 128 + lr + 32 * i) * ldb + lc; }
    f32x16 acc[2][2];
#pragma unroll
    for (int m = 0; m < 2; ++m)
#pragma unroll
      for (int n = 0; n < 2; ++n) acc[m][n] = (f32x16)(0.f);
    gemm_kloop32(acc, ap, bp, K / 64, lds);
#pragma unroll
    for (int m = 0; m < 2; ++m)
#pragma unroll
      for (int n = 0; n < 2; ++n)
#pragma unroll
        for (int g = 0; g < 4; ++g) {
          f32x4 o = {acc[m][n][4 * g], acc[m][n][4 * g + 1], acc[m][n][4 * g + 2], acc[m][n][4 * g + 3]};
          st_bf16x4(C + (size_t)(tm * 128 + wr * 64 + m * 32 + l31) * ldc + tn * 128 + wc * 64 + n * 32 + 8 * g + 4 * hh, o);
        }
  }
}
template <int MODE>
DI void ph_gemm_probe(const bf16_t* A, int lda, const bf16_t* Bt, int ldb, int M, int N, int K, float* sink, char* lds, int bid, int nblk) {
  const int t = TIDX, lane = t & 63, wid = t >> 6, wr = wid >> 1, wc = wid & 1, lr = t >> 3, lc = (t & 7) * 8, fr = lane & 15, fq = lane >> 4;
  const int ntn = N / 128, nt = (M / 128) * ntn, nk = K / 64;
  constexpr int STAGE = A_BYTES + 128 * LROW;
  const int aoff = (wr * 64 + fr) * LROW + fq * 16, boff = A_BYTES + (wc * 64 + fr) * LROW + fq * 16;
#pragma unroll 1
  for (int tile = bid; tile < nt; tile += nblk) {
    f32x4 acc[4][4]; acc_zero<4>(acc);
    bf16x8 af[4], bfr[4];
    const int tm = tile / ntn, tn = tile % ntn;
    const bf16_t* ap[4]; const bf16_t* bp[4];
#pragma unroll
    for (int i = 0; i < 4; ++i) { ap[i] = A + (size_t)(tm * 128 + lr + 32 * i) * lda + lc; bp[i] = Bt + (size_t)(tn * 128 + lr + 32 * i) * ldb + lc; }
    u32x4 ra[4], rb[4], junk = {0u, 0u, 0u, 0u};
#pragma unroll
    for (int i = 0; i < 4; ++i) { ra[i] = junk; rb[i] = junk; }
#pragma unroll 1
    for (int kt = 0; kt < nk; ++kt) {
      const char* cur = lds + (kt & 1) * STAGE;
#pragma unroll
      for (int i = 0; i < 4; ++i) { ra[i] = ldg16(ap[i] + kt * 64); if (MODE == 3) rb[i] = ldg16(bp[i] + kt * 64); }
#pragma unroll
      for (int ks = 0; ks < 2; ++ks) {
#pragma unroll
        for (int m = 0; m < 4; ++m) { af[m] = lds_frag(cur + aoff + m * 16 * LROW + ks * 64); bfr[m] = lds_frag(cur + boff + m * 16 * LROW + ks * 64); }
#pragma unroll
        for (int m = 0; m < 4; ++m)
#pragma unroll
          for (int n = 0; n < 4; ++n) acc[m][n] = MFMA16(bfr[n], af[m], acc[m][n]);
      }
      junk.x ^= ra[0].x ^ ra[1].y ^ ra[2].z ^ ra[3].w ^ rb[0].x ^ rb[1].y ^ rb[2].z ^ rb[3].w;
      __syncthreads();
    }
    float s = (float)(junk.x & 1u);
#pragma unroll
    for (int m = 0; m < 4; ++m)
#pragma unroll
      for (int n = 0; n < 4; ++n) s += acc[m][n][0] + acc[m][n][3];
    if (s == 123456.789f) sink[0] = s;
  }
}
DI void ph_moe1(const Params& p, int need_ctx, char* lds, int bid, int nblk) {
  const int t = TIDX, lane = t & 63, wid = t >> 6, wr = wid >> 1, wc = wid & 1, lr = t >> 3, lc = (t & 7) * 8, fr = lane & 15, fq = lane >> 4;
  constexpr int NTN = FF / 64;
  const int NTM = need_ctx ? (NSLOT + 127) / 128 : (NB * CAPL) / 128;
  for (int tile = bid; tile < NE * NTM * NTN; tile += nblk) {
    const int e = tile / (NTM * NTN), rem = tile % (NTM * NTN), tm = rem / NTN, tn = rem % NTN;
    const bf16_t* ap[4]; const bf16_t* bp[4];
#pragma unroll
    for (int i = 0; i < 4; ++i) {
      const int slot = tm * 128 + lr + 32 * i;
      int r = slot < NSLOT ? p.SEL[(size_t)e * NSLOT + slot] : -1;
      ap[i] = p.H + (size_t)(r < 0 ? 0 : r) * D + lc;
      const int rho = lr + 32 * i, wci = rho >> 6, gu = (rho >> 5) & 1, col = wci * 32 + (rho & 31);
      bp[i] = (gu ? p.Wt_eu : p.Wt_eg) + ((size_t)e * FF + tn * 64 + col) * D + lc;
    }
    f32x4 acc[4][4]; acc_zero<4>(acc);
    gemm_kloop<4>(acc, ap, bp, D / 64, lds);
    f32x4 hid[4][2];
#pragma unroll
    for (int m = 0; m < 4; ++m) {
      const int slot = tm * 128 + wr * 64 + m * 16 + fr;
      const bool valid = slot < NSLOT && p.SEL[(size_t)e * NSLOT + (slot < NSLOT ? slot : 0)] >= 0;
#pragma unroll
      for (int n = 0; n < 2; ++n)
#pragma unroll
        for (int j = 0; j < 4; ++j) { const float g = acc[m][n][j], u = acc[m][n + 2][j]; hid[m][n][j] = valid ? g * u * fast_rcp(1.0f + fast_exp2(-LOG2E * g)) : 0.f; }
    }
    const int slot0 = tm * 128 + wr * 64;
    store_wave_tile<2>(hid, p.HID + ((size_t)e * NSLOT + slot0) * FF + tn * 64 + wc * 32, (size_t)FF, lds + wid * (64 * 80), lane, [&](int r) { return slot0 + r < NSLOT; });
    __syncthreads();
  }
}
DI void ph_moe2(const Params& p, int need_ctx, char* lds, int bid, int nblk) {
  const int t = TIDX, lane = t & 63, wid = t >> 6, wr = wid >> 1, wc = wid & 1, lr = t >> 3, lc = (t & 7) * 8, fr = lane & 15, fq = lane >> 4;
  constexpr int NTN = D / 128;
  const int NTM = need_ctx ? (NSLOT + 127) / 128 : (NB * CAPL) / 128;
  for (int tile = bid; tile < NE * NTM * NTN; tile += nblk) {
    const int e = tile / (NTM * NTN), rem = tile % (NTM * NTN), tm = rem / NTN, tn = rem % NTN;
    const bf16_t* ap[4]; const bf16_t* bp[4];
#pragma unroll
    for (int i = 0; i < 4; ++i) {
      int slot = tm * 128 + lr + 32 * i; if (slot >= NSLOT) slot = NSLOT - 1;
      ap[i] = p.HID + ((size_t)e * NSLOT + slot) * FF + lc;
      bp[i] = p.Wt_ed + ((size_t)e * D + tn * 128 + lr + 32 * i) * FF + lc;
    }
    f32x4 acc[4][4]; acc_zero<4>(acc);
    gemm_kloop<4>(acc, ap, bp, FF / 64, lds);
#pragma unroll
    for (int m = 0; m < 4; ++m) {
      const int slot = tm * 128 + wr * 64 + m * 16 + fr;
      const float val = (slot < NSLOT && p.SEL[(size_t)e * NSLOT + (slot < NSLOT ? slot : 0)] >= 0) ? p.SELV[(size_t)e * NSLOT + slot] : 0.f;
#pragma unroll
      for (int n = 0; n < 4; ++n) { acc[m][n].x *= val; acc[m][n].y *= val; acc[m][n].z *= val; acc[m][n].w *= val; }
    }
    const int slot0 = tm * 128 + wr * 64;
    store_wave_tile<4>(acc, p.YE + ((size_t)e * NSLOT + slot0) * D + tn * 128 + wc * 64, (size_t)D, lds + wid * (64 * 144), lane, [&](int r) { return slot0 + r < NSLOT; });
    __syncthreads();
  }
}
constexpr int GEMM_LDS = 2 * (A_BYTES + 128 * LROW);

DI void unpack8(u32x4 v, float (&f)[8]) {
  f[0] = u2f(v.x << 16); f[1] = u2f(v.x & 0xffff0000u); f[2] = u2f(v.y << 16); f[3] = u2f(v.y & 0xffff0000u);
  f[4] = u2f(v.z << 16); f[5] = u2f(v.z & 0xffff0000u); f[6] = u2f(v.w << 16); f[7] = u2f(v.w & 0xffff0000u);
}
DI u32x4 pack8f(const float (&f)[8]) { u32x4 v; v.x = pack2bf(f[0], f[1]); v.y = pack2bf(f[2], f[3]); v.z = pack2bf(f[4], f[5]); v.w = pack2bf(f[6], f[7]); return v; }
DI void rope8(float (&a)[8], const float (&pr)[8], int cc, const float* cs, const float* sn) {
  const int ax = (cc >> 1) * 8; const bool second = cc & 1;
#pragma unroll
  for (int i = 0; i < 8; ++i) a[i] = second ? a[i] * cs[ax + i] + pr[i] * sn[ax + i] : a[i] * cs[ax + i] - pr[i] * sn[ax + i];
}
constexpr int PREP_LDS = 64 * 4 + 2 * 512 * 4 + 32 * 528;
template <int PARTS = 3>
DI void ph_prep(const Params& p, int layer, const bf16_t* QRAW, const bf16_t* KVRAW, char* lds, int bid, int nblk) {
  float* s_rstd = (float*)lds;
  float* s_cs = s_rstd + 64;
  float* s_sn = s_cs + 512;
  bf16_t* s_t = (bf16_t*)(s_sn + 512);
  const int t = TIDX;
  constexpr int UPB = TK / 32, NU = NB * UPB;
  const float* wcv = p.w_conv + (size_t)layer * 3 * 512;
#pragma unroll 1
  for (int u = bid; u < NU; u += nblk) {
    int b, s0;
    if (u < NB * (TL / 32)) { b = u / (TL / 32); s0 = TC + (u % (TL / 32)) * 32; } else { const int v = u - NB * (TL / 32); b = v / (TC / 32); s0 = (v % (TC / 32)) * 32; }
    const int r0 = row_of(b, s0);
    {
      const int tok = t >> 3, part = t & 7;
      const bf16_t* z = p.Z + (size_t)(r0 + tok) * NZP;
      float sq = 0.f, sk = 0.f, f[8];
#pragma unroll
      for (int k = 0; k < 4; ++k) { unpack8(ldg16(z + ZC_QLAT + part * 32 + k * 8), f);
#pragma unroll
        for (int i = 0; i < 8; ++i) sq += f[i] * f[i]; }
#pragma unroll
      for (int k = 0; k < 2; ++k) { unpack8(ldg16(z + ZC_KVLAT + part * 16 + k * 8), f);
#pragma unroll
        for (int i = 0; i < 8; ++i) sk += f[i] * f[i]; }
      sq = xor_sum<1>(sq); sk = xor_sum<1>(sk);
      sq = xor_sum<2>(sq); sk = xor_sum<2>(sk);
      sq = xor_sum<4>(sq); sk = xor_sum<4>(sk);
      if (part == 0) { s_rstd[tok * 2] = 1.0f / sqrtf(sq * (1.0f / 256) + 1e-6f); s_rstd[tok * 2 + 1] = 1.0f / sqrtf(sk * (1.0f / 128) + 1e-6f); }
    }
    for (int i = t; i < 512; i += NTHR) {
      const int tok = i >> 4, af = i & 15, s = s0 + tok;
      float cs = 1.f, sn = 0.f;
      if (s >= TC) rope_cs(s, (af >> 3) * 16 + (af & 7), cs, sn);
      s_cs[i] = cs; s_sn[i] = sn;
    }
    __syncthreads();
    if (PARTS & 1) {
#pragma unroll 2
    for (int i = t; i < 32 * 48; i += NTHR) {
      const int tok = i / 48, c = i % 48, h = c / 12, ch = c % 12;
      const float rq = s_rstd[tok * 2] * QS_MLA, rkv = s_rstd[tok * 2 + 1];
      const bf16_t* q = QRAW + (size_t)(r0 + tok) * 384 + h * 96;
      float a[8], pr[8];
      unpack8(ldg16(q + ch * 8), a);
      if (ch >= 8) { unpack8(ldg16(q + 64 + ((ch - 8) ^ 1) * 8), pr); rope8(a, pr, ch - 8, s_cs + tok * 16, s_sn + tok * 16); }
#pragma unroll
      for (int e = 0; e < 8; ++e) a[e] *= rq;
      *(u32x4*)(p.Qm + (((size_t)b * 4 + h) * TK + s0 + tok) * 96 + ch * 8) = pack8f(a);
      if (ch < 8) {
        unpack8(ldg16(KVRAW + (size_t)(r0 + tok) * 512 + h * 128 + ch * 8), a);
#pragma unroll
        for (int e = 0; e < 8; ++e) a[e] *= rkv;
      } else {
        const bf16_t* z = p.Z + (size_t)(r0 + tok) * NZP + ZC_KROPE;
        unpack8(ldg16(z + (ch - 8) * 8), a); unpack8(ldg16(z + ((ch - 8) ^ 1) * 8), pr);
        rope8(a, pr, ch - 8, s_cs + tok * 16, s_sn + tok * 16);
      }
      *(u32x4*)(p.Km + (((size_t)b * 4 + h) * TK + s0 + tok) * 96 + ch * 8) = pack8f(a);
    }
#pragma unroll 2
    for (int i = t; i < 32 * 64; i += NTHR) {
      const int tok = i >> 6, c = i & 63, qk = c >> 5, hm = (c >> 2) & 7, cc = c & 3;
      const bf16_t* src = p.Z + (size_t)(r0 + tok) * NZP + (qk ? ZC_DK : ZC_DQ) + hm * 32;
      float a[8], pr[8];
      unpack8(ldg16(src + cc * 8), a); unpack8(ldg16(src + (cc ^ 1) * 8), pr);
      rope8(a, pr, cc, s_cs + tok * 16, s_sn + tok * 16);
      if (qk == 0) {
#pragma unroll
        for (int e = 0; e < 8; ++e) a[e] *= QS_DIFF;
        *(u32x4*)(p.Qd + (((size_t)b * 8 + hm) * TK + s0 + tok) * 32 + cc * 8) = pack8f(a);
      } else *(u32x4*)(p.Kd + (((size_t)b * 8 + hm) * TK + s0 + tok) * 32 + cc * 8) = pack8f(a);
    }
#pragma unroll 2
    for (int i = t; i < 32 * 64; i += NTHR) {
      const int tok = i >> 6, c8 = (i & 63) * 8, s = s0 + tok;
      const bool first = (s == 0) || (s == TC), last = (s == TC - 1) || (s == TK - 1);
      const bf16_t* z = p.Z + (size_t)(r0 + tok) * NZP + ZC_MLQK + c8;
      float x0[8], xm[8], xp[8], o[8];
      unpack8(ldg16(z), x0);
      if (!first) unpack8(ldg16(z - NZP), xm);
      if (!last) unpack8(ldg16(z + NZP), xp);
      float bc8[8], w0[8], w1[8], w2[8];
      *(f32x4*)bc8 = *(const f32x4*)(p.b_conv + layer * 512 + c8); *(f32x4*)(bc8 + 4) = *(const f32x4*)(p.b_conv + layer * 512 + c8 + 4);
      *(f32x4*)w0 = *(const f32x4*)(wcv + c8); *(f32x4*)(w0 + 4) = *(const f32x4*)(wcv + c8 + 4);
      *(f32x4*)w1 = *(const f32x4*)(wcv + 512 + c8); *(f32x4*)(w1 + 4) = *(const f32x4*)(wcv + 512 + c8 + 4);
      *(f32x4*)w2 = *(const f32x4*)(wcv + 1024 + c8); *(f32x4*)(w2 + 4) = *(const f32x4*)(wcv + 1024 + c8 + 4);
#pragma unroll
      for (int e = 0; e < 8; ++e) {
        float acc = bc8[e] + x0[e] * w1[e];
        if (!first) acc += xm[e] * w0[e];
        if (!last) acc += xp[e] * w2[e];
        o[e] = acc * fast_rcp(1.0f + fast_exp2(-LOG2E * acc));
      }
      if (c8 < 256) *(u32x4*)(p.MQ + ((size_t)b * TK + s) * 256 + c8) = pack8f(o);
      else {
#pragma unroll
        for (int e = 0; e < 8; ++e) o[e] *= 0.125f;
        *(u32x4*)(p.MK + ((size_t)b * TK + s) * 256 + c8 - 256) = pack8f(o);
      }
    }
    }
#pragma unroll 1
    for (int w = 0; w < ((PARTS & 2) ? 4 : 0); ++w) {
      __syncthreads();
#pragma unroll
      for (int k = 0; k < 4; ++k) {
        const int i = t + k * NTHR, tok = i >> 5, c8 = (i & 31) * 8;
        u32x4 v;
        if (w == 0) { float a[8]; const int h = c8 >> 6; unpack8(ldg16(KVRAW + (size_t)(r0 + tok) * 512 + h * 128 + 64 + (c8 & 63)), a); const float rkv = s_rstd[tok * 2 + 1];
#pragma unroll
          for (int e = 0; e < 8; ++e) a[e] *= rkv;
          v = pack8f(a); }
        else v = ldg16(p.Z + (size_t)(r0 + tok) * NZP + (w == 1 ? ZC_DV : (w == 2 ? ZC_MLV : ZC_GV)) + c8);
        *(u32x4*)(s_t + tok * 264 + c8) = v;
      }
      __syncthreads();
      bf16_t* dst = w == 0 ? p.Vtm : (w == 1 ? p.Vtd : (w == 2 ? p.MVt : p.GVt));
#pragma unroll
      for (int k = 0; k < 4; ++k) {
        const int i = t + k * NTHR, tg = i & 3, ch = i >> 2;
        u32x4 v;
        v.x = (unsigned)s_t[(tg * 8 + 0) * 264 + ch] | ((unsigned)s_t[(tg * 8 + 1) * 264 + ch] << 16);
        v.y = (unsigned)s_t[(tg * 8 + 2) * 264 + ch] | ((unsigned)s_t[(tg * 8 + 3) * 264 + ch] << 16);
        v.z = (unsigned)s_t[(tg * 8 + 4) * 264 + ch] | ((unsigned)s_t[(tg * 8 + 5) * 264 + ch] << 16);
        v.w = (unsigned)s_t[(tg * 8 + 6) * 264 + ch] | ((unsigned)s_t[(tg * 8 + 7) * 264 + ch] << 16);
        *(u32x4*)(dst + (((size_t)b * 4 + (ch >> 6)) * 64 + (ch & 63)) * TK + s0 + tg * 8) = v;
      }
    }
    __syncthreads();
  }
}
constexpr int VROW = 136;
constexpr int VROW_A = 144;
template <int DQK> struct AttnCfg {
  static constexpr int KROW = DQK * 2 + 16;
  static constexpr int KBYTES = 64 * KROW, VBYTES = 64 * VROW_A, STAGE = KBYTES + VBYTES;
  static constexpr int KCH = 64 * DQK * 2 / 16 / NTHR;
};
DI bf16x8 pack8(const f32x16& x, int s) {
  u32x4 pk; pk.x = pack2bf(x[8 * s], x[8 * s + 1]); pk.y = pack2bf(x[8 * s + 2], x[8 * s + 3]); pk.z = pack2bf(x[8 * s + 4], x[8 * s + 5]); pk.w = pack2bf(x[8 * s + 6], x[8 * s + 7]);
  return __builtin_bit_cast(bf16x8, pk);
}
template <int DQK, int NMAP, int VAR = 0>
DI void attn_unit(const bf16_t* __restrict__ Qb, const bf16_t* __restrict__ Kb, size_t mstride, const bf16_t* __restrict__ Vt, int q0, int nkeys,
                  f32x16 (&O)[NMAP][2], float (&lsum)[NMAP], char* lds) {
  constexpr int DM = DQK / NMAP;
  constexpr int KS = DM / 16;
  using C = AttnCfg<DQK>;
  constexpr int CPM = 64 * DM * 2 / 16;
  constexpr int CPR = DM * 2 / 16;
  const int t = TIDX, lane = t & 63, wid = t >> 6, l31 = lane & 31, hh = lane >> 5;
  bf16x8 qf[NMAP][KS];
#pragma unroll
  for (int m = 0; m < NMAP; ++m)
#pragma unroll
    for (int ks = 0; ks < KS; ++ks) qf[m][ks] = *(const bf16x8*)(Qb + m * mstride + (size_t)(q0 + wid * 32 + l31) * DM + ks * 16 + 8 * hh);
  float mref[NMAP];
#pragma unroll
  for (int m = 0; m < NMAP; ++m) { mref[m] = 0.f; lsum[m] = 0.f; O[m][0] = (f32x16)(0.f); O[m][1] = (f32x16)(0.f); }
  u32x4 rk[C::KCH], rv[2];
  const bf16_t* kg[C::KCH]; int klds[C::KCH];
#pragma unroll
  for (int i = 0; i < C::KCH; ++i) { const int c = t + i * NTHR, m = c / CPM, cc = c % CPM; kg[i] = Kb + m * mstride + cc * 8; klds[i] = (cc / CPR) * C::KROW + m * DM * 2 + (cc % CPR) * 16; }
  const bf16_t* vg = Vt + (size_t)(t >> 3) * TK + (t & 7) * 8;
  const int vlds = C::KBYTES + (t >> 3) * VROW_A + ((t & 7) >> 1) * 32 + ((t & 1) ? 8 : 0);
  const int kfoff = l31 * C::KROW + 16 * hh, vfoff = C::KBYTES + l31 * VROW_A + 16 * hh;
  const int nt = nkeys / 64;
#pragma unroll
  for (int i = 0; i < C::KCH; ++i) rk[i] = ldg16(kg[i]);
  rv[0] = ldg16(vg); rv[1] = ldg16(vg + (size_t)32 * TK);
#pragma unroll 1
  for (int kt = 0; kt < nt; ++kt) {
    char* cur = lds + (kt & 1) * C::STAGE;
    if (VAR != 2) {
#pragma unroll
    for (int i = 0; i < C::KCH; ++i) sts16(cur + klds[i], rk[i]);
#pragma unroll
    for (int i = 0; i < 2; ++i) { char* d = cur + vlds + i * 32 * VROW_A; u32x2 lo, hi; lo.x = rv[i].x; lo.y = rv[i].y; hi.x = rv[i].z; hi.y = rv[i].w; *(u32x2*)d = lo; *(u32x2*)(d + 16) = hi; }
    __syncthreads();
    }
    if (VAR != 2 && kt + 1 < nt) {
#pragma unroll
      for (int i = 0; i < C::KCH; ++i) rk[i] = ldg16(kg[i] + (size_t)(kt + 1) * 64 * DM);
      rv[0] = ldg16(vg + (kt + 1) * 64); rv[1] = ldg16(vg + (size_t)32 * TK + (kt + 1) * 64);
    }
    bf16x8 kf[NMAP][2][KS];
#pragma unroll
    for (int k2 = 0; k2 < 2; ++k2)
#pragma unroll
      for (int ks = 0; ks < KS; ++ks) kf[0][k2][ks] = lds_frag(cur + kfoff + k2 * 32 * C::KROW + ks * 32);
    f32x16 S[NMAP][2];
    S[0][0] = (f32x16)(0.f); S[0][1] = (f32x16)(0.f);
#pragma unroll
    for (int ks = 0; ks < KS; ++ks)
#pragma unroll
      for (int k2 = 0; k2 < 2; ++k2) S[0][k2] = MFMA32(kf[0][k2][ks], qf[0][ks], S[0][k2]);
    bf16x8 vf[4][2];
#pragma unroll
    for (int kst = 0; kst < 4; ++kst)
#pragma unroll
      for (int dvt = 0; dvt < 2; ++dvt) vf[kst][dvt] = lds_frag(cur + vfoff + dvt * 32 * VROW_A + kst * 32);
#pragma unroll
    for (int m = 1; m < NMAP; ++m)
#pragma unroll
      for (int k2 = 0; k2 < 2; ++k2)
#pragma unroll
        for (int ks = 0; ks < KS; ++ks) kf[m][k2][ks] = lds_frag(cur + kfoff + k2 * 32 * C::KROW + m * DM * 2 + ks * 32);
#pragma unroll
    for (int m = 0; m < NMAP; ++m) {
      if (m > 0) {
        S[m][0] = (f32x16)(0.f); S[m][1] = (f32x16)(0.f);
#pragma unroll
        for (int ks = 0; ks < KS; ++ks)
#pragma unroll
          for (int k2 = 0; k2 < 2; ++k2) S[m][k2] = MFMA32(kf[m][k2][ks], qf[m][ks], S[m][k2]);
      }
      if (VAR != 1) {
      if ((kt & 7) == 0) {
        float mx = fmaxf(S[m][0][0], S[m][1][0]);
#pragma unroll
        for (int i = 1; i < 16; ++i) mx = fmaxf(mx, fmaxf(S[m][0][i], S[m][1][i]));
        mx = xor_max<32>(mx);
        const float rel = mx - mref[m];
        const float delta = (kt == 0) ? ((mx > ATT_THR || mx < -ATT_THR) ? mx : 0.0f) : (rel > ATT_THR ? rel : 0.0f);
        if (wave_any(delta != 0.0f)) {
          const float alpha = fast_exp2(-delta);
          mref[m] += delta; lsum[m] *= alpha;
#pragma unroll
          for (int dvt = 0; dvt < 2; ++dvt)
#pragma unroll
            for (int i = 0; i < 16; ++i) O[m][dvt][i] *= alpha;
        }
      }
      if (wave_any(mref[m] != 0.0f)) {
        const f32x2 nm = {-mref[m], -mref[m]};
#pragma unroll
        for (int k2 = 0; k2 < 2; ++k2)
#pragma unroll
          for (int i = 0; i < 16; i += 2) { const f32x2 x = (f32x2){S[m][k2][i], S[m][k2][i + 1]} + nm; S[m][k2][i] = x.x; S[m][k2][i + 1] = x.y; }
      }
      f32x2 ps2 = {0.f, 0.f};
#pragma unroll
      for (int k2 = 0; k2 < 2; ++k2)
#pragma unroll
        for (int i = 0; i < 16; i += 2) {
          const float e0 = fast_exp2(S[m][k2][i]), e1 = fast_exp2(S[m][k2][i + 1]);
          S[m][k2][i] = e0; S[m][k2][i + 1] = e1; ps2 += (f32x2){e0, e1};
        }
      lsum[m] += ps2.x + ps2.y;
      } else lsum[m] += 1.0f;
#pragma unroll
      for (int kst = 0; kst < 4; ++kst) {
        const bf16x8 pf = pack8(S[m][kst >> 1], kst & 1);
#pragma unroll
        for (int dvt = 0; dvt < 2; ++dvt) O[m][dvt] = MFMA32(vf[kst][dvt], pf, O[m][dvt]);
      }
    }
  }
  __syncthreads();
#pragma unroll
  for (int m = 0; m < NMAP; ++m) lsum[m] = xor_sum<32>(lsum[m]);
}
constexpr int ATT_QB = TK / 128;
constexpr int ATT_LDS = 2 * AttnCfg<96>::STAGE;
constexpr int ATT_QBL = TL / 128, ATT_QBC = TC / 128, ATT_LAT_UNITS = NB * 4 * ATT_QBL, ATT_UNITS = ATT_LAT_UNITS + NB * 4 * ATT_QBC;
DI void att_unit(int u, int& bh, int& qb) {
  if (u < ATT_LAT_UNITS) { bh = u / ATT_QBL; qb = ATT_QBC + u % ATT_QBL; } else { const int v = u - ATT_LAT_UNITS; bh = v / ATT_QBC; qb = v % ATT_QBC; }
}
DI void ph_attn_diff(const Params& p, int layer, int need_ctx, char* lds, int bid, int nblk) {
  const int lane = TIDX & 63, wid = TIDX >> 6, l31 = lane & 31, hh = lane >> 5;
  float lam_init; const float lam = lam_of(p, layer, lam_init);
#pragma unroll 1
  for (int u = bid; u < (need_ctx ? ATT_UNITS : ATT_LAT_UNITS); u += nblk) {
    int bh, qb; att_unit(u, bh, qb);
    const int b = bh >> 2, h = bh & 3, q0 = qb * 128;
    const int r = row_of(b, q0 + wid * 32 + l31);
    f32x16 O[2][2]; float ls[2];
    attn_unit<64, 2>(p.Qd + ((size_t)b * 8 + h * 2) * TK * 32, p.Kd + ((size_t)b * 8 + h * 2) * TK * 32, (size_t)TK * 32, p.Vtd + ((size_t)b * 4 + h) * 64 * TK, q0,
                     q0 < TC ? TC : TK, O, ls, lds);
    const float i0 = 1.0f / ls[0], i1 = lam / ls[1];
    float ss = 0.f;
#pragma unroll
    for (int dvt = 0; dvt < 2; ++dvt)
#pragma unroll
      for (int i = 0; i < 16; ++i) { const float o = O[0][dvt][i] * i0 - O[1][dvt][i] * i1; O[0][dvt][i] = o; ss += o * o; }
    ss = xor_sum<32>(ss);
    const float rstd = (1.0f - lam_init) / sqrtf(ss * (1.0f / 64) + 1e-6f);
    const float* gd = p.g_diff_out + layer * 256 + h * 64;
#pragma unroll
    for (int dvt = 0; dvt < 2; ++dvt)
#pragma unroll
      for (int g = 0; g < 4; ++g) {
        const int dv = dvt * 32 + 8 * g + 4 * hh;
        const f32x4 gv = *(const f32x4*)(gd + dv);
        f32x4 o = {O[0][dvt][4 * g] * rstd * gv[0], O[0][dvt][4 * g + 1] * rstd * gv[1], O[0][dvt][4 * g + 2] * rstd * gv[2], O[0][dvt][4 * g + 3] * rstd * gv[3]};
        st_bf16x4(p.Y + (size_t)r * D + 768 + h * 64 + dv, o);
      }
  }
}
DI void ph_attn_mla(const Params& p, int need_ctx, char* lds, int bid, int nblk) {
  const int lane = TIDX & 63, wid = TIDX >> 6, l31 = lane & 31, hh = lane >> 5;
#pragma unroll 1
  for (int u = bid; u < (need_ctx ? ATT_UNITS : ATT_LAT_UNITS); u += nblk) {
    int bh, qb; att_unit(u, bh, qb);
    const int b = bh >> 2, h = bh & 3, q0 = qb * 128;
    const int r = row_of(b, q0 + wid * 32 + l31);
    f32x16 O[1][2]; float ls[1];
    attn_unit<96, 1>(p.Qm + ((size_t)b * 4 + h) * TK * 96, p.Km + ((size_t)b * 4 + h) * TK * 96, 0, p.Vtm + ((size_t)b * 4 + h) * 64 * TK, q0, q0 < TC ? TC : TK, O, ls, lds);
    const float inv = 1.0f / ls[0];
#pragma unroll
    for (int dvt = 0; dvt < 2; ++dvt)
#pragma unroll
      for (int g = 0; g < 4; ++g) {
        f32x4 o = {O[0][dvt][4 * g] * inv, O[0][dvt][4 * g + 1] * inv, O[0][dvt][4 * g + 2] * inv, O[0][dvt][4 * g + 3] * inv};
        st_bf16x4(p.Y + (size_t)r * D + h * 64 + dvt * 32 + 8 * g + 4 * hh, o);
      }
  }
}
template <int VAR> DI void ph_attn_mla_probe(const Params& p, char* lds, int bid, int nblk) {
  const int lane = TIDX & 63, wid = TIDX >> 6, l31 = lane & 31, hh = lane >> 5;
#pragma unroll 1
  for (int u = bid; u < ATT_LAT_UNITS; u += nblk) {
    int bh, qb; att_unit(u, bh, qb);
    const int b = bh >> 2, h = bh & 3, q0 = qb * 128;
    const int r = row_of(b, q0 + wid * 32 + l31);
    f32x16 O[1][2]; float ls[1];
    attn_unit<96, 1, VAR>(p.Qm + ((size_t)b * 4 + h) * TK * 96, p.Km + ((size_t)b * 4 + h) * TK * 96, 0, p.Vtm + ((size_t)b * 4 + h) * 64 * TK, q0, TK, O, ls, lds);
    const float inv = 1.0f / ls[0];
#pragma unroll
    for (int dvt = 0; dvt < 2; ++dvt)
#pragma unroll
      for (int g = 0; g < 4; ++g) {
        f32x4 o = {O[0][dvt][4 * g] * inv, O[0][dvt][4 * g + 1] * inv, O[0][dvt][4 * g + 2] * inv, O[0][dvt][4 * g + 3] * inv};
        *(f32x4*)(p.out + (size_t)r * D + h * 64 + dvt * 32 + 8 * g + 4 * hh) = o;
      }
  }
}
DI void ph_attn(const Params& p, int layer, int need_ctx, char* lds, int bid, int nblk) {
  ph_attn_diff(p, layer, need_ctx, lds, bid, nblk);
  ph_attn_mla(p, need_ctx, lds, bid, nblk);
}

DI float wave_sum(float v) {
  v = xor_sum<1>(v); v = xor_sum<2>(v); v = xor_sum<4>(v); v = xor_sum<8>(v); v = xor_sum<16>(v); v = xor_sum<32>(v);
  return v;
}
DI void ld_row16(const float* row, int lane, f32x4 (&v)[4]) {
#pragma unroll
  for (int i = 0; i < 4; ++i) v[i] = *(const f32x4*)(row + 256 * i + 4 * lane);
}
DI void ld_row16_bf(const bf16_t* row, int lane, f32x4 (&v)[4]) {
#pragma unroll
  for (int i = 0; i < 4; ++i) { const u32x2 u = *(const u32x2*)(row + 256 * i + 4 * lane); v[i] = (f32x4){u2f(u.x << 16), u2f(u.x & 0xffff0000u), u2f(u.y << 16), u2f(u.y & 0xffff0000u)}; }
}
DI void ph_modulate(const Params& p, int layer, const float* xl, const float* xcx, int bid, int nblk) {
  const int lane = TIDX & 63, wid = TIDX >> 6;
  const float* g = p.g_mix_pre + layer * 1024;
  for (int r = bid * 4 + wid; r < R; r += nblk * 4) {
    const int w = r < RL ? r / TL : 2;
    const float* mb = p.mods + (size_t)(layer * 3 + w) * 6144;
    const float* x = r < RL ? xl + (size_t)r * D : xcx + (size_t)(r - RL) * D;
    f32x4 xv[4], gv[4], sc[4], sh[4];
    ld_row16(x, lane, xv); ld_row16(g, lane, gv); ld_row16(mb + 1024, lane, sc); ld_row16(mb, lane, sh);
    float ss = 0.f;
#pragma unroll
    for (int i = 0; i < 4; ++i)
#pragma unroll
      for (int e = 0; e < 4; ++e) ss += xv[i][e] * xv[i][e];
    const float rstd = 1.0f / sqrtf(wave_sum(ss) * (1.0f / D) + 1e-6f);
#pragma unroll
    for (int i = 0; i < 4; ++i) {
      f32x4 o;
#pragma unroll
      for (int e = 0; e < 4; ++e) o[e] = xv[i][e] * rstd * gv[i][e] * (1.f + sc[i][e]) + sh[i][e];
      st_bf16x4(p.H + (size_t)r * D + 256 * i + 4 * lane, o);
    }
  }
}
DI void ph_resid_mix(const Params& p, int layer, const float* xl_in, const float* xc_in, int rows, int bid, int nblk) {
  const int lane = TIDX & 63, wid = TIDX >> 6;
  const float* wr = p.w_router + (size_t)layer * D * 16;
  for (int r = bid * 4 + wid; r < rows; r += nblk * 4) {
    const int w = r < RL ? r / TL : 2;
    const float* mb = p.mods + (size_t)(layer * 3 + w) * 6144;
    const float* xin = r < RL ? xl_in + (size_t)r * D : xc_in + (size_t)(r - RL) * D;
    float* xo = r < RL ? p.out + (size_t)r * D : p.xc + (size_t)(r - RL) * D;
    f32x4 yv[4], xv[4], a[4], c[4];
    ld_row16_bf(p.YO + (size_t)r * D, lane, yv); ld_row16(xin, lane, xv);
    float ss = 0.f;
#pragma unroll
    for (int i = 0; i < 4; ++i)
#pragma unroll
      for (int e = 0; e < 4; ++e) ss += yv[i][e] * yv[i][e];
    const float rstd = 1.0f / sqrtf(wave_sum(ss) * (1.0f / D) + 1e-6f);
    ld_row16(mb + 2 * 1024, lane, a); ld_row16(p.g_mix_post + layer * 1024, lane, c);
    float s2 = 0.f;
#pragma unroll
    for (int i = 0; i < 4; ++i) {
#pragma unroll
      for (int e = 0; e < 4; ++e) { xv[i][e] += a[i][e] * yv[i][e] * rstd * c[i][e]; s2 += xv[i][e] * xv[i][e]; }
      *(f32x4*)(xo + 256 * i + 4 * lane) = xv[i];
    }
    const float rstd2 = 1.0f / sqrtf(wave_sum(s2) * (1.0f / D) + 1e-6f);
    ld_row16(p.g_ffn_pre + layer * 1024, lane, a); ld_row16(mb + 4 * 1024, lane, c); ld_row16(mb + 3 * 1024, lane, yv);
    float lg[16];
#pragma unroll
    for (int e = 0; e < 16; ++e) lg[e] = 0.f;
#pragma unroll
    for (int i = 0; i < 4; ++i) {
      f32x4 h2;
#pragma unroll
      for (int e = 0; e < 4; ++e) h2[e] = xv[i][e] * rstd2 * a[i][e] * (1.f + c[i][e]) + yv[i][e];
      st_bf16x4(p.H + (size_t)r * D + 256 * i + 4 * lane, h2);
#pragma unroll
      for (int e = 0; e < 4; ++e) {
        const float* wk = wr + (size_t)(256 * i + 4 * lane + e) * 16;
#pragma unroll
        for (int q = 0; q < 4; ++q) { const f32x4 wv = *(const f32x4*)(wk + 4 * q); lg[4 * q] += h2[e] * wv[0]; lg[4 * q + 1] += h2[e] * wv[1]; lg[4 * q + 2] += h2[e] * wv[2]; lg[4 * q + 3] += h2[e] * wv[3]; }
      }
    }
#pragma unroll
    for (int e = 0; e < 16; ++e) lg[e] = wave_sum(lg[e]);
    float mx = lg[0];
#pragma unroll
    for (int e = 1; e < 16; ++e) mx = fmaxf(mx, lg[e]);
    float sm = 0.f;
#pragma unroll
    for (int e = 0; e < 16; ++e) { lg[e] = expf(lg[e] - mx); sm += lg[e]; }
    int b, s; bs_of(r, b, s);
    float mine = 0.f;
#pragma unroll
    for (int e = 0; e < 16; ++e) mine = (lane == e) ? lg[e] / sm : mine;
    if (lane < 16) p.AFF[((size_t)b * NE + lane) * TK + s] = mine;
  }
}
DI void ph_resid_ffn(const Params& p, int layer, int rows, int bid, int nblk) {
  const int lane = TIDX & 63, wid = TIDX >> 6;
  for (int r = bid * 4 + wid; r < rows; r += nblk * 4) {
    const int w = r < RL ? r / TL : 2;
    const float* mb = p.mods + (size_t)(layer * 3 + w) * 6144;
    float* xo = r < RL ? p.out + (size_t)r * D : p.xc + (size_t)(r - RL) * D;
    const int myinv = lane < NE ? p.INV[(size_t)r * NE + lane] : -1;
    f32x4 f[4];
#pragma unroll
    for (int i = 0; i < 4; ++i) f[i] = (f32x4){0.f, 0.f, 0.f, 0.f};
    for (int e = 0; e < NE; ++e) {
      const int sl = lane_bcast(myinv, e);
      if (sl >= 0) { f32x4 yv[4]; ld_row16_bf(p.YE + ((size_t)e * NSLOT + sl) * D, lane, yv);
#pragma unroll
        for (int i = 0; i < 4; ++i) f[i] += yv[i]; }
    }
    float ss = 0.f;
#pragma unroll
    for (int i = 0; i < 4; ++i)
#pragma unroll
      for (int e = 0; e < 4; ++e) ss += f[i][e] * f[i][e];
    const float rstd = 1.0f / sqrtf(wave_sum(ss) * (1.0f / D) + 1e-6f);
    f32x4 a[4], c[4], xv[4];
    ld_row16(mb + 5 * 1024, lane, a); ld_row16(p.g_ffn_post + layer * 1024, lane, c); ld_row16(xo, lane, xv);
#pragma unroll
    for (int i = 0; i < 4; ++i) {
#pragma unroll
      for (int e = 0; e < 4; ++e) xv[i][e] += a[i][e] * f[i][e] * rstd * c[i][e];
      *(f32x4*)(xo + 256 * i + 4 * lane) = xv[i];
    }
  }
}
DI void ph_mods(const Params& p, char* lds, int bid, int nblk) {
  float* sc = (float*)lds;
  const int t = TIDX;
  for (int i = t; i < 3 * 1024; i += NTHR) { const float v = i < 2048 ? p.c[i] : p.c_ctx[i - 2048]; sc[i] = v / (1.0f + expf(-v)); }
  __syncthreads();
#pragma unroll 1
  for (long gi = (long)bid * NTHR + t; gi < 2 * 3 * 6144; gi += (long)nblk * NTHR) {
    const int col = (int)(gi % 6144), w = (int)((gi / 6144) % 3), l = (int)(gi / (3 * 6144));
    const float* W = p.w_ada + (size_t)l * 1024 * 6144 + col; const float* s = sc + w * 1024;
    float acc[8];
#pragma unroll
    for (int q = 0; q < 8; ++q) acc[q] = 0.f;
#pragma unroll 1
    for (int k = 0; k < 1024; k += 8) {
#pragma unroll
      for (int q = 0; q < 8; ++q) acc[q] += s[k + q] * W[(size_t)(k + q) * 6144];
    }
    p.mods[gi] = ((acc[0] + acc[1]) + (acc[2] + acc[3])) + ((acc[4] + acc[5]) + (acc[6] + acc[7])) + p.b_ada[l * 6144 + col];
  }
  __syncthreads();
}
constexpr int TOPK_LDS = TL * 4 + 2048;
DI int block_sum_i(int v, int* red) {
  const int lane = TIDX & 63, wid = TIDX >> 6;
  v = xor_sum_i<1>(v); v = xor_sum_i<2>(v); v = xor_sum_i<4>(v); v = xor_sum_i<8>(v); v = xor_sum_i<16>(v); v = xor_sum_i<32>(v);
  __syncthreads();
  if (lane == 0) red[wid] = v;
  __syncthreads();
  return red[0] + red[1] + red[2] + red[3];
}
DI int block_excl_scan(int v, int* red) {
  const int lane = TIDX & 63, wid = TIDX >> 6;
  int inc = v;
#pragma unroll
  for (int d = 1; d < 64; d <<= 1) { const int o = lane_up(inc, d, lane); if (lane >= d) inc += o; }
  __syncthreads();
  if (lane == 63) red[wid] = inc;
  __syncthreads();
  int base = 0;
  for (int q = 0; q < wid; ++q) base += red[q];
  return base + inc - v;
}
DI void ph_topk(const Params& p, int need_ctx, char* lds, int bid, int nblk) {
  unsigned* vals = (unsigned*)lds; int* red = (int*)(lds + TL * 4 + 1024);
  const int t = TIDX;
  for (int u = bid; u < NB * NE * 2; u += nblk) {
    const int seg = u & 1, e = (u >> 1) % NE, b = u / (2 * NE);
    const int s0 = seg ? TC : 0, n = seg ? TL : TC, cap = seg ? CAPL : CAPC, slot0 = seg ? b * CAPL : NB * CAPL + b * CAPC;
    if (seg == 0 && !need_ctx) { for (int q = t; q < cap; q += NTHR) p.SEL[(size_t)e * NSLOT + slot0 + q] = -1; continue; }
    const float* a = p.AFF + ((size_t)b * NE + e) * TK + s0;
    const int vpt = (n + NTHR - 1) / NTHR, i0 = t * vpt, i1 = (i0 + vpt < n) ? i0 + vpt : n;
    for (int i = t; i < n; i += NTHR) vals[i + i / vpt] = f2u(a[i]);
    __syncthreads();
    unsigned thr = 0;
    for (int bit = 31; bit >= 0; --bit) {
      const unsigned cand = thr | (1u << bit);
      int cnt = 0;
      for (int i = i0; i < i1; ++i) cnt += (vals[i + t] >= cand);
      if (block_sum_i(cnt, red) >= cap) thr = cand;
    }
    int cgt = 0, ceq = 0;
    for (int i = i0; i < i1; ++i) { cgt += (vals[i + t] > thr); ceq += (vals[i + t] == thr); }
    const int ngt = block_sum_i(cgt, red);
    const int neq = cap - ngt;
    int eqoff = block_excl_scan(ceq, red);
    int csel = 0;
    { int er = eqoff; for (int i = i0; i < i1; ++i) { if (vals[i + t] > thr) ++csel; else if (vals[i + t] == thr) { if (er < neq) ++csel; ++er; } } }
    int q = block_excl_scan(csel, red);
    for (int i = i0; i < i1; ++i) {
      const unsigned v = vals[i + t]; int sel = -1;
      if (v > thr) sel = q++; else if (v == thr) { if (eqoff < neq) sel = q++; ++eqoff; }
      const int r = row_of(b, s0 + i);
      if (sel >= 0) { p.SEL[(size_t)e * NSLOT + slot0 + sel] = r; p.SELV[(size_t)e * NSLOT + slot0 + sel] = u2f(v); }
      p.INV[(size_t)r * NE + e] = sel >= 0 ? slot0 + sel : -1;
    }
    __syncthreads();
  }
}
DI void ph_wt(const float* in, bf16_t* out, int K, int N, int NP, int nbatch, long in_bs, long out_bs, const float* gain, char* lds, int bid, int nblk) {
  float* tile = (float*)lds;
  const int t = TIDX, tk = K / 64, tn = NP / 64, ntile = nbatch * tk * tn;
  f32x4 v[4];
  auto gload = [&](int u) {
    const int bt = u / (tk * tn), rem = u % (tk * tn), k0 = (rem / tn) * 64, n0 = (rem % tn) * 64;
    const float* I = in + (size_t)bt * in_bs;
#pragma unroll
    for (int i = 0; i < 4; ++i) {
      const int idx = t + i * NTHR, kk = idx >> 4, n4 = (idx & 15) * 4;
      v[i] = (f32x4){0.f, 0.f, 0.f, 0.f};
      if (n0 + n4 < N) v[i] = *(const f32x4*)(I + (size_t)(k0 + kk) * N + n0 + n4);
      if (gain) { const float g = gain[k0 + kk]; v[i][0] *= g; v[i][1] *= g; v[i][2] *= g; v[i][3] *= g; }
    }
  };
  if (bid < ntile) gload(bid);
#pragma unroll 1
  for (int u = bid; u < ntile; u += nblk) {
    const int bt = u / (tk * tn), rem = u % (tk * tn), k0 = (rem / tn) * 64, n0 = (rem % tn) * 64;
    bf16_t* O = out + (size_t)bt * out_bs;
#pragma unroll
    for (int i = 0; i < 4; ++i) { const int idx = t + i * NTHR, kk = idx >> 4, n4 = (idx & 15) * 4; float* d = tile + kk * 65 + n4; d[0] = v[i][0]; d[1] = v[i][1]; d[2] = v[i][2]; d[3] = v[i][3]; }
    __syncthreads();
    if (u + nblk < ntile) gload(u + nblk);
#pragma unroll
    for (int i = 0; i < 2; ++i) {
      const int idx = t + i * NTHR, kg = idx & 7, nn = idx >> 3;
      float a[8];
#pragma unroll
      for (int e = 0; e < 8; ++e) a[e] = tile[(kg * 8 + e) * 65 + nn];
      u32x4 o; o.x = pack2bf(a[0], a[1]); o.y = pack2bf(a[2], a[3]); o.z = pack2bf(a[4], a[5]); o.w = pack2bf(a[6], a[7]);
      *(u32x4*)(O + (size_t)(n0 + nn) * K + k0 + kg * 8) = o;
    }
    __syncthreads();
  }
}
DI float wave_max(float v) {
  v = xor_max<1>(v); v = xor_max<2>(v); v = xor_max<4>(v); v = xor_max<8>(v); v = xor_max<16>(v); v = xor_max<32>(v);
  return v;
}
DI bf16x8 cvt8(const float* f) {
  const f32x4 a = *(const f32x4*)f, b = *(const f32x4*)(f + 4);
  u32x4 pk; pk.x = pack2bf(a[0], a[1]); pk.y = pack2bf(a[2], a[3]); pk.z = pack2bf(b[0], b[1]); pk.w = pack2bf(b[2], b[3]);
  return __builtin_bit_cast(bf16x8, pk);
}
constexpr int SCAN_UNITS = NB * NCK * 4, SCAN_LAT_UNITS = NB * NCL * 4;
DI void scan_unit(int u, int& b, int& c, int& h) {
  h = u & 3;
  if (u < SCAN_LAT_UNITS) { c = NCC + (u >> 2) % NCL; b = u / (4 * NCL); } else { const int v = u - SCAN_LAT_UNITS; c = (v >> 2) % NCC; b = v / (4 * NCC); }
}

DI void ph_ml_local(const Params& p, char* lds, int bid, int nblk) {
  bf16_t* sK = (bf16_t*)lds;
  float* sW = (float*)(lds + 64 * 132);
  const int t = TIDX, lane = t & 63, wid = t >> 6, l31 = lane & 31, hh = lane >> 5;
  const int d = wid & 1, vt = wid >> 1;
#pragma unroll 1
  for (int u = bid; u < SCAN_UNITS; u += nblk) {
    int b, c, h; scan_unit(u, b, c, h);
    {
      const int row = t >> 2, seg = (t & 3) * 16;
      const bf16_t* src = p.MK + ((size_t)b * TK + 64 * c + row) * 256 + h * 64 + seg;
      const u32x4 a = ldg16(src), bb = ldg16(src + 8);
      unsigned* dst = (unsigned*)((char*)sK + row * 132 + seg * 2);
      dst[0] = a.x; dst[1] = a.y; dst[2] = a.z; dst[3] = a.w; dst[4] = bb.x; dst[5] = bb.y; dst[6] = bb.z; dst[7] = bb.w;
    }
    if (t < 128) {
      const int dd = t >> 6, l = t & 63, j = step_of(dd, c), pos = dd ? 63 - l : l;
      const size_t o = (((size_t)b * 2 + dd) * TK + 64 * j) * 4 + h;
      const float bend = p.BC[o + 63 * 4], wl = bend - p.BC[o + pos * 4] + p.IGS[o + pos * 4];
      const float ml = wave_max(wl);
      sW[dd * 64 + l] = expf(wl - ml);
      if (l == 0) { const size_t uu = (((size_t)b * 2 + dd) * NCK + j) * 4 + h; p.MM[uu * 4] = ml; p.MM[uu * 4 + 1] = bend; }
    }
    __syncthreads();
    const int j = step_of(d, c);
    const size_t uu = (((size_t)b * 2 + d) * NCK + j) * 4 + h;
    f32x16 acc[2]; acc[0] = (f32x16)(0.f); acc[1] = (f32x16)(0.f);
    const bf16_t* vsrc = p.MVt + (((size_t)b * 4 + h) * 64 + vt * 32 + l31) * TK + 64 * c;
#pragma unroll
    for (int ks = 0; ks < 4; ++ks) {
      const bf16x8 a = *(const bf16x8*)(vsrc + ks * 16 + 8 * hh);
      const float* w = sW + d * 64 + ks * 16 + 8 * hh;
      u32x4 pk;
      pk.x = pack2bf(bf2f((bf16_t)a[0]) * w[0], bf2f((bf16_t)a[1]) * w[1]); pk.y = pack2bf(bf2f((bf16_t)a[2]) * w[2], bf2f((bf16_t)a[3]) * w[3]);
      pk.z = pack2bf(bf2f((bf16_t)a[4]) * w[4], bf2f((bf16_t)a[5]) * w[5]); pk.w = pack2bf(bf2f((bf16_t)a[6]) * w[6], bf2f((bf16_t)a[7]) * w[7]);
      const bf16x8 af = __builtin_bit_cast(bf16x8, pk);
#pragma unroll
      for (int kt = 0; kt < 2; ++kt) {
        bf16x8 bfr;
#pragma unroll
        for (int q = 0; q < 8; ++q) bfr[q] = (short)sK[(ks * 16 + 8 * hh + q) * 66 + kt * 32 + l31];
        acc[kt] = MFMA32(af, bfr, acc[kt]);
      }
    }
#pragma unroll
    for (int kt = 0; kt < 2; ++kt)
#pragma unroll
      for (int i = 0; i < 16; ++i) p.MC[uu * 4096 + (size_t)(vt * 32 + (i & 3) + 8 * (i >> 2) + 4 * hh) * 64 + kt * 32 + l31] = acc[kt][i];
    float nl = 0.f;
    for (int q = 0; q < 32; ++q) { const int l = hh * 32 + q; nl += sW[d * 64 + l] * bf2f(sK[l * 66 + vt * 32 + l31]); }
    nl = xor_sum<32>(nl);
    if (hh == 0) p.MN[uu * 64 + vt * 32 + l31] = nl;
    __syncthreads();
  }
}
DI void ph_ml_scan(const Params& p, int bid, int nblk) {
  for (long gi = (long)bid * NTHR + TIDX; gi < (long)NB * 2 * 4 * 4160; gi += (long)nblk * NTHR) {
    const int e = (int)(gi % 4160), ch = (int)(gi / 4160), h = ch & 3, bd = ch >> 2;
    float* base = e < 4096 ? p.MC + (((size_t)bd * NCK) * 4 + h) * 4096 + e : p.MN + (((size_t)bd * NCK) * 4 + h) * 64 + (e - 4096);
    const size_t stride = e < 4096 ? 4 * 4096 : 4 * 64;
    float* mm = p.MM + (((size_t)bd * NCK) * 4 + h) * 4;
    float st = 0.f, m = -1e30f;
    float cl[8], cm[8], cb[8], nl[8], nm[8], nb[8];
#pragma unroll
    for (int q = 0; q < 8; ++q) { cl[q] = base[(size_t)q * stride]; cm[q] = mm[q * 16]; cb[q] = mm[q * 16 + 1]; }
#pragma unroll 1
    for (int jb = 0; jb < NCK; jb += 8) {
#pragma unroll
      for (int q = 0; q < 8; ++q) { const int j = jb + 8 + q; if (j < NCK) { nl[q] = base[(size_t)j * stride]; nm[q] = mm[j * 16]; nb[q] = mm[j * 16 + 1]; } }
#pragma unroll
      for (int q = 0; q < 8; ++q) {
        const int j = jb + q;
        if (j < NCK) {
          const float mn = fmaxf(cb[q] + m, cm[q]), a = expf(cb[q] + m - mn), g = expf(cm[q] - mn);
          base[(size_t)j * stride] = st;
          st = a * st + g * cl[q];
          if (e == 0) mm[j * 16 + 2] = m;
          m = mn;
        }
      }
#pragma unroll
      for (int q = 0; q < 8; ++q) { cl[q] = nl[q]; cm[q] = nm[q]; cb[q] = nb[q]; }
    }
  }
}
DI void ph_gla_scan(const Params& p, int bid, int nblk) {
  for (long gi = (long)bid * NTHR + TIDX; gi < (long)NB * 2 * 4 * 2048; gi += (long)nblk * NTHR) {
    const int e = (int)(gi % 2048), ch = (int)(gi / 2048), h = ch & 3, bd = ch >> 2, k = e & 31;
    float* base = p.GS + (((size_t)bd * NCK) * 4 + h) * 2048 + e;
    const float* ge = p.GC + ((size_t)bd * TK + 63) * 128 + h * 32 + k;
    float st = 0.f;
    float cl[8], cg[8], nl[8], ng[8];
#pragma unroll
    for (int q = 0; q < 8; ++q) { cl[q] = base[(size_t)q * 4 * 2048]; cg[q] = ge[(size_t)q * 64 * 128]; }
#pragma unroll 1
    for (int jb = 0; jb < NCK; jb += 8) {
#pragma unroll
      for (int q = 0; q < 8; ++q) { const int j = jb + 8 + q; if (j < NCK) { nl[q] = base[(size_t)j * 4 * 2048]; ng[q] = ge[(size_t)j * 64 * 128]; } }
#pragma unroll
      for (int q = 0; q < 8; ++q) {
        const int j = jb + q;
        if (j < NCK) { base[(size_t)j * 4 * 2048] = st; st = expf(cg[q]) * st + cl[q]; }
      }
#pragma unroll
      for (int q = 0; q < 8; ++q) { cl[q] = nl[q]; cg[q] = ng[q]; }
    }
  }
}
constexpr int MO_K = 0, MO_V = 64 * 144, MO_A = MO_V + 64 * VROW, MO_PM = MO_A + 512, MO_N0 = MO_PM + 512, MO_X = MO_N0 + 512, MO_LDS = MO_X + 16384;
DI void ph_ml_out(const Params& p, int layer, int need_ctx, char* lds, int bid, int nblk) {
  float* sA = (float*)(lds + MO_A); float* sPM = (float*)(lds + MO_PM); float* sN0 = (float*)(lds + MO_N0); float* sX = (float*)(lds + MO_X);
  const int t = TIDX, lane = t & 63, wid = t >> 6, l31 = lane & 31, hh = lane >> 5;
  const int lt = wid & 1, d = wid >> 1;
#pragma unroll 1
  for (int u = bid; u < (need_ctx ? SCAN_UNITS : SCAN_LAT_UNITS); u += nblk) {
    int b, c, h; scan_unit(u, b, c, h);
    {
      const int row = t >> 2, seg = (t & 3) * 16;
      const bf16_t* ks = p.MK + ((size_t)b * TK + 64 * c + row) * 256 + h * 64 + seg;
      sts16(lds + MO_K + row * 144 + seg * 2, ldg16(ks)); sts16(lds + MO_K + row * 144 + seg * 2 + 16, ldg16(ks + 8));
      const bf16_t* vs = p.MVt + (((size_t)b * 4 + h) * 64 + row) * TK + 64 * c + seg;
      const u32x4 v0 = ldg16(vs), v1 = ldg16(vs + 8);
      u32x2* dv = (u32x2*)(lds + MO_V + row * VROW + seg * 2);
      u32x2 q; q.x = v0.x; q.y = v0.y; dv[0] = q; q.x = v0.z; q.y = v0.w; dv[1] = q; q.x = v1.x; q.y = v1.y; dv[2] = q; q.x = v1.z; q.y = v1.w; dv[3] = q;
    }
    if (t < 128) {
      const int dd = t >> 6, s = t & 63, j = step_of(dd, c), pos = dd ? 63 - s : s;
      const size_t o = (((size_t)b * 2 + dd) * TK + 64 * j) * 4 + h;
      sA[dd * 64 + s] = p.IGS[o + pos * 4] - p.BC[o + pos * 4];
      const size_t uu = (((size_t)b * 2 + dd) * NCK + j) * 4 + h;
      sN0[dd * 64 + s] = p.MN[uu * 64 + s];
    }
    __syncthreads();
    if (t < 2) {
      float m = -1e30f;
      if (t == 0) { for (int s = 0; s < 64; ++s) { m = fmaxf(m, sA[s]); sPM[s] = m; } }
      else { for (int s = 63; s >= 0; --s) { m = fmaxf(m, sA[64 + s]); sPM[64 + s] = m; } }
    }
    __syncthreads();
    const int j = step_of(d, c);
    const size_t uu = (((size_t)b * 2 + d) * NCK + j) * 4 + h;
    const int l = lt * 32 + l31, pos = d ? 63 - l : l;
    const float bl = p.BC[(((size_t)b * 2 + d) * TK + 64 * j + pos) * 4 + h];
    const float inter = bl + p.MM[uu * 4 + 2];
    const float mt = fmaxf(inter, bl + sPM[d * 64 + l]);
    const float aint = expf(inter - mt);
    bf16x8 qf[4];
#pragma unroll
    for (int ks = 0; ks < 4; ++ks) qf[ks] = *(const bf16x8*)(p.MQ + ((size_t)b * TK + 64 * c + l) * 256 + h * 64 + ks * 16 + 8 * hh);
    f32x16 num[2]; num[0] = (f32x16)(0.f); num[1] = (f32x16)(0.f);
    float den = 0.f;
#pragma unroll
    for (int st = 0; st < 2; ++st) {
      if (d == 0 ? st <= lt : st >= lt) {
        f32x16 S = (f32x16)(0.f);
#pragma unroll
        for (int ks = 0; ks < 4; ++ks) S = MFMA32(lds_frag(lds + MO_K + (st * 32 + l31) * 144 + (ks * 16 + 8 * hh) * 2), qf[ks], S);
#pragma unroll
        for (int i = 0; i < 16; ++i) {
          const int s = st * 32 + (i & 3) + 8 * (i >> 2) + 4 * hh;
          const bool ok = d == 0 ? s <= l : s >= l;
          const float e = ok ? fast_exp2((bl + sA[d * 64 + s] - mt) * LOG2E) * S[i] : 0.f;
          S[i] = e; den += e;
        }
#pragma unroll
        for (int kst = 0; kst < 2; ++kst) {
          const bf16x8 pf = pack8(S, kst);
#pragma unroll
          for (int vt = 0; vt < 2; ++vt) {
            const char* vp = lds + MO_V + (vt * 32 + l31) * VROW + (st * 32 + kst * 16 + 4 * hh) * 2;
            const s16x4 lo = *(const s16x4*)vp, hi = *(const s16x4*)(vp + 16);
            num[vt] = MFMA32(__builtin_shufflevector(lo, hi, 0, 1, 2, 3, 4, 5, 6, 7), pf, num[vt]);
          }
        }
      }
    }
    f32x16 accI[2]; accI[0] = (f32x16)(0.f); accI[1] = (f32x16)(0.f);
#pragma unroll
    for (int vt = 0; vt < 2; ++vt)
#pragma unroll
      for (int ks = 0; ks < 4; ++ks) accI[vt] = MFMA32(cvt8(p.MC + uu * 4096 + (size_t)(vt * 32 + l31) * 64 + ks * 16 + 8 * hh), qf[ks], accI[vt]);
    float qn = 0.f;
#pragma unroll
    for (int ks = 0; ks < 4; ++ks)
#pragma unroll
      for (int q = 0; q < 8; ++q) qn += bf2f((bf16_t)qf[ks][q]) * sN0[d * 64 + ks * 16 + 8 * hh + q];
    den = xor_sum<32>(den + aint * qn);
    const float inv = 1.0f / fmaxf(fabsf(den), expf(-mt));
#pragma unroll
    for (int vt = 0; vt < 2; ++vt)
#pragma unroll
      for (int i = 0; i < 16; ++i) num[vt][i] = (num[vt][i] + aint * accI[vt][i]) * inv;
    if (d == 1) {
#pragma unroll
      for (int vt = 0; vt < 2; ++vt)
#pragma unroll
        for (int i = 0; i < 16; ++i) sX[(lt * 32 + vt * 16 + i) * 64 + lane] = num[vt][i];
    }
    __syncthreads();
    if (d == 0) {
      float ss = 0.f;
#pragma unroll
      for (int vt = 0; vt < 2; ++vt)
#pragma unroll
        for (int i = 0; i < 16; ++i) { num[vt][i] += sX[(lt * 32 + vt * 16 + i) * 64 + lane]; ss += num[vt][i] * num[vt][i]; }
      ss = xor_sum<32>(ss);
      const float rstd = 1.0f / sqrtf(ss * (1.0f / 64) + 1e-6f);
      const int r = row_of(b, 64 * c + l);
#pragma unroll
      for (int vt = 0; vt < 2; ++vt)
#pragma unroll
        for (int g = 0; g < 4; ++g) {
          const int v0 = vt * 32 + 8 * g + 4 * hh;
          const u32x2 ou = *(const u32x2*)(p.Z + (size_t)r * NZP + ZC_MLO + h * 64 + v0);
          const f32x4 gv = *(const f32x4*)(p.g_mlstm_out + layer * 256 + h * 64 + v0);
          const float o0 = u2f(ou.x << 16), o1 = u2f(ou.x & 0xffff0000u), o2 = u2f(ou.y << 16), o3 = u2f(ou.y & 0xffff0000u);
          f32x4 y = {sigmoidf_(o0) * num[vt][4 * g] * rstd * gv[0], sigmoidf_(o1) * num[vt][4 * g + 1] * rstd * gv[1],
                     sigmoidf_(o2) * num[vt][4 * g + 2] * rstd * gv[2], sigmoidf_(o3) * num[vt][4 * g + 3] * rstd * gv[3]};
          st_bf16x4(p.Y + (size_t)r * D + 256 + h * 64 + v0, y);
        }
    }
    __syncthreads();
  }
}
DI void ph_gla_local(const Params& p, char* lds, int bid, int nblk) {
  bf16_t* sKd = (bf16_t*)lds;
  const int t = TIDX, lane = t & 63, wid = t >> 6, l31 = lane & 31, hh = lane >> 5;
  const int d = wid & 1, vt = wid >> 1;
#pragma unroll 1
  for (int u = bid; u < SCAN_UNITS; u += nblk) {
    int b, c, h; scan_unit(u, b, c, h);
    {
      const int dd = t >> 7, l = (t >> 1) & 63, k0 = (t & 1) * 16, j = step_of(dd, c), pos = dd ? 63 - l : l;
      const float* gcr = p.GC + (((size_t)b * 2 + dd) * TK + 64 * j + pos) * 128 + h * 32 + k0;
      const float* ger = p.GC + (((size_t)b * 2 + dd) * TK + 64 * j + 63) * 128 + h * 32 + k0;
      const bf16_t* kr = p.Z + (size_t)row_of(b, 64 * c + l) * NZP + ZC_GK + h * 32 + k0;
#pragma unroll
      for (int q = 0; q < 16; ++q) sKd[(dd * 64 + l) * 33 + k0 + q] = f2bf(bf2f(kr[q]) * fast_exp2((ger[q] - gcr[q]) * LOG2E));
    }
    __syncthreads();
    const int j = step_of(d, c);
    const size_t uu = (((size_t)b * 2 + d) * NCK + j) * 4 + h;
    f32x16 acc = (f32x16)(0.f);
    const bf16_t* vsrc = p.GVt + (((size_t)b * 4 + h) * 64 + vt * 32 + l31) * TK + 64 * c;
#pragma unroll
    for (int ks = 0; ks < 4; ++ks) {
      const bf16x8 af = *(const bf16x8*)(vsrc + ks * 16 + 8 * hh);
      bf16x8 bfr;
#pragma unroll
      for (int q = 0; q < 8; ++q) bfr[q] = (short)sKd[(d * 64 + ks * 16 + 8 * hh + q) * 33 + l31];
      acc = MFMA32(af, bfr, acc);
    }
#pragma unroll
    for (int i = 0; i < 16; ++i) p.GS[uu * 2048 + (size_t)(vt * 32 + (i & 3) + 8 * (i >> 2) + 4 * hh) * 32 + l31] = acc[i];
    __syncthreads();
  }
}
constexpr int GO_Q = 0, GO_K = 2 * 64 * 80, GO_V = 2 * GO_K, GO_X = GO_V + 64 * VROW, GO_LDS = GO_X + 16384;
DI void ph_gla_out(const Params& p, int layer, int need_ctx, char* lds, int bid, int nblk) {
  float* sX = (float*)(lds + GO_X);
  const int t = TIDX, lane = t & 63, wid = t >> 6, l31 = lane & 31, hh = lane >> 5;
  const int lt = wid & 1, d = wid >> 1;
#pragma unroll 1
  for (int u = bid; u < (need_ctx ? SCAN_UNITS : SCAN_LAT_UNITS); u += nblk) {
    int b, c, h; scan_unit(u, b, c, h);
    {
      const int dd = t >> 7, l = (t >> 1) & 63, k0 = (t & 1) * 16, j = step_of(dd, c), pos = dd ? 63 - l : l;
      const float* gcr = p.GC + (((size_t)b * 2 + dd) * TK + 64 * j + pos) * 128 + h * 32 + k0;
      const bf16_t* zr = p.Z + (size_t)row_of(b, 64 * c + l) * NZP;
      bf16_t* qd = (bf16_t*)(lds + GO_Q + (dd * 64 + l) * 80) + k0; bf16_t* kd = (bf16_t*)(lds + GO_K + (dd * 64 + l) * 80) + k0;
#pragma unroll
      for (int q = 0; q < 16; ++q) {
        const float g = gcr[q];
        qd[q] = f2bf(bf2f(zr[ZC_GQ + h * 32 + k0 + q]) * 0.17677669529663687f * fast_exp2(g * LOG2E));
        kd[q] = f2bf(bf2f(zr[ZC_GK + h * 32 + k0 + q]) * fast_exp2(-g * LOG2E));
      }
      const int row = t >> 2, seg = (t & 3) * 16;
      const bf16_t* vs = p.GVt + (((size_t)b * 4 + h) * 64 + row) * TK + 64 * c + seg;
      const u32x4 v0 = ldg16(vs), v1 = ldg16(vs + 8);
      u32x2* dv = (u32x2*)(lds + GO_V + row * VROW + seg * 2);
      u32x2 q2; q2.x = v0.x; q2.y = v0.y; dv[0] = q2; q2.x = v0.z; q2.y = v0.w; dv[1] = q2; q2.x = v1.x; q2.y = v1.y; dv[2] = q2; q2.x = v1.z; q2.y = v1.w; dv[3] = q2;
    }
    __syncthreads();
    const int j = step_of(d, c);
    const size_t uu = (((size_t)b * 2 + d) * NCK + j) * 4 + h;
    const int l = lt * 32 + l31;
    bf16x8 qf[2];
#pragma unroll
    for (int ks = 0; ks < 2; ++ks) qf[ks] = lds_frag(lds + GO_Q + (d * 64 + l) * 80 + (ks * 16 + 8 * hh) * 2);
    f32x16 O[2]; O[0] = (f32x16)(0.f); O[1] = (f32x16)(0.f);
#pragma unroll
    for (int st = 0; st < 2; ++st) {
      if (d == 0 ? st <= lt : st >= lt) {
        f32x16 S = (f32x16)(0.f);
#pragma unroll
        for (int ks = 0; ks < 2; ++ks) S = MFMA32(lds_frag(lds + GO_K + (d * 64 + st * 32 + l31) * 80 + (ks * 16 + 8 * hh) * 2), qf[ks], S);
#pragma unroll
        for (int i = 0; i < 16; ++i) {
          const int s = st * 32 + (i & 3) + 8 * (i >> 2) + 4 * hh;
          const bool ok = d == 0 ? s <= l : s >= l;
          S[i] = ok ? S[i] : 0.f;
        }
#pragma unroll
        for (int kst = 0; kst < 2; ++kst) {
          const bf16x8 pf = pack8(S, kst);
#pragma unroll
          for (int vt = 0; vt < 2; ++vt) {
            const char* vp = lds + GO_V + (vt * 32 + l31) * VROW + (st * 32 + kst * 16 + 4 * hh) * 2;
            const s16x4 lo = *(const s16x4*)vp, hi = *(const s16x4*)(vp + 16);
            O[vt] = MFMA32(__builtin_shufflevector(lo, hi, 0, 1, 2, 3, 4, 5, 6, 7), pf, O[vt]);
          }
        }
      }
    }
#pragma unroll
    for (int vt = 0; vt < 2; ++vt)
#pragma unroll
      for (int ks = 0; ks < 2; ++ks) O[vt] = MFMA32(cvt8(p.GS + uu * 2048 + (size_t)(vt * 32 + l31) * 32 + ks * 16 + 8 * hh), qf[ks], O[vt]);
    if (d == 1) {
#pragma unroll
      for (int vt = 0; vt < 2; ++vt)
#pragma unroll
        for (int i = 0; i < 16; ++i) sX[(lt * 32 + vt * 16 + i) * 64 + lane] = O[vt][i];
    }
    __syncthreads();
    if (d == 0) {
      float ss = 0.f;
#pragma unroll
      for (int vt = 0; vt < 2; ++vt)
#pragma unroll
        for (int i = 0; i < 16; ++i) { O[vt][i] += sX[(lt * 32 + vt * 16 + i) * 64 + lane]; ss += O[vt][i] * O[vt][i]; }
      ss = xor_sum<32>(ss);
      const float rstd = 1.0f / sqrtf(ss * (1.0f / 64) + 1e-6f);
      const int r = row_of(b, 64 * c + l);
#pragma unroll
      for (int vt = 0; vt < 2; ++vt)
#pragma unroll
        for (int g = 0; g < 4; ++g) {
          const int v0 = vt * 32 + 8 * g + 4 * hh;
          const u32x2 ru = *(const u32x2*)(p.Z + (size_t)r * NZP + ZC_GR + h * 64 + v0);
          const f32x4 gv = *(const f32x4*)(p.g_gla_out + layer * 256 + h * 64 + v0);
          const float r0 = u2f(ru.x << 16), r1 = u2f(ru.x & 0xffff0000u), r2 = u2f(ru.y << 16), r3 = u2f(ru.y & 0xffff0000u);
          f32x4 y = {siluf_(r0) * O[vt][4 * g] * rstd * gv[0], siluf_(r1) * O[vt][4 * g + 1] * rstd * gv[1],
                     siluf_(r2) * O[vt][4 * g + 2] * rstd * gv[2], siluf_(r3) * O[vt][4 * g + 3] * rstd * gv[3]};
          st_bf16x4(p.Y + (size_t)r * D + 512 + h * 64 + v0, y);
        }
    }
    __syncthreads();
  }
}

DI float fast_logsigmoid(float x) {
  const float e = fast_exp2(-fabsf(x) * LOG2E);
#ifdef CPU_EMU
  return fminf(x, 0.f) - log1pf(e);
#else
  return fminf(x, 0.f) - 0.6931471805599453f * __builtin_amdgcn_logf(1.0f + e);
#endif
}
DI float wave_incl_scan(float v, int lane) {
#pragma unroll
  for (int dd = 1; dd < 64; dd <<= 1) { const float o = u2f((unsigned)lane_up((int)f2u(v), dd, lane)); if (lane >= dd) v += o; }
  return v;
}
constexpr int GCUM_LDS = 4 * 64 * 33 * 4;
DI void ph_gates_cum(const Params& p, int layer, char* lds, int bid, int nblk) {
  const int t = TIDX, lane = t & 63, wid = t >> 6;
  float* stg = (float*)lds + wid * 64 * 33;
  const float* wal = p.w_alpha2 + (size_t)layer * 2 * 16 * 128;
#pragma unroll 1
  for (int u = bid * 4 + wid; u < NB * 2 * NCK; u += nblk * 4) {
    const int j = u % NCK, d = (u / NCK) & 1, b = u / (2 * NCK);
    const int pp = 64 * j + lane, s = seq_of(d, pp);
    const bf16_t* z = p.Z + (size_t)row_of(b, s) * NZP;
    const size_t ob = ((size_t)b * 2 + d) * TK + pp;
    {
      const u32x2 iu = *(const u32x2*)(z + ZC_MLIG + d * 4), fu = *(const u32x2*)(z + ZC_MLFG + d * 4);
      const float ig[4] = {u2f(iu.x << 16), u2f(iu.x & 0xffff0000u), u2f(iu.y << 16), u2f(iu.y & 0xffff0000u)};
      const float fg[4] = {u2f(fu.x << 16), u2f(fu.x & 0xffff0000u), u2f(fu.y << 16), u2f(fu.y & 0xffff0000u)};
      f32x4 oc, oi;
#pragma unroll
      for (int h = 0; h < 4; ++h) {
        oi[h] = ig[h] + p.b_igate[layer * 8 + d * 4 + h];
        oc[h] = wave_incl_scan(fast_logsigmoid(fg[h] + p.b_fgate[layer * 8 + d * 4 + h]), lane);
      }
      *(f32x4*)(p.BC + ob * 4) = oc; *(f32x4*)(p.IGS + ob * 4) = oi;
    }
    float a[16];
    { float f0[8], f1[8]; unpack8(ldg16(z + ZC_GA + d * 16), f0); unpack8(ldg16(z + ZC_GA + d * 16 + 8), f1);
#pragma unroll
      for (int q = 0; q < 8; ++q) { a[q] = f0[q]; a[8 + q] = f1[q]; } }
    const float* W = wal + (size_t)d * 16 * 128;
#pragma unroll 1
    for (int cg = 0; cg < 4; ++cg) {
#pragma unroll 4
      for (int c = 0; c < 32; ++c) {
        const int ch = cg * 32 + c;
        float zg = p.b_alpha[layer * 256 + d * 128 + ch];
#pragma unroll
        for (int q = 0; q < 16; ++q) zg += a[q] * W[q * 128 + ch];
        stg[lane * 33 + c] = wave_incl_scan(fast_logsigmoid(zg) * (1.0f / 16.0f), lane);
      }
      WAVE_SYNC();
#pragma unroll
      for (int k = 0; k < 32; ++k) { const int pos = k * 2 + (lane >> 5), c = lane & 31; p.GC[(((size_t)b * 2 + d) * TK + 64 * j + pos) * 128 + cg * 32 + c] = stg[pos * 33 + c]; }
      WAVE_SYNC();
    }
  }
}
#define XB_TMO      128
#define XB_XCNT(j)  (256  + 64 * (j))
#define XB_XSUB(j)  (1280 + 64 * (j))
#define XB_XGEN(j)  (2304 + 64 * (j))
#define XB_TOP      3328
#define XB_TOPGEN   3392
#define XCD_BAR_WORDS 3456
#define XB_SPIN_CAP (1u << 28)
#define LAS __attribute__((address_space(3)))

__device__ __forceinline__ unsigned xb_ld(unsigned* p)              { return __hip_atomic_load(p, __ATOMIC_RELAXED, __HIP_MEMORY_SCOPE_AGENT); }
__device__ __forceinline__ unsigned xb_add(unsigned* p, unsigned v) { return __hip_atomic_fetch_add(p, v, __ATOMIC_RELAXED, __HIP_MEMORY_SCOPE_AGENT); }
__device__ __forceinline__ unsigned xb_xcc_id() { return (unsigned)__builtin_amdgcn_s_getreg((3 << 11) | 20) & 0xFu; }
#define XB_SPIN(cond, bar) do { unsigned _sp = 0; while (cond) { __builtin_amdgcn_s_sleep(1); \
    if ((++_sp & 255u) == 0u) { if (xb_ld(&(bar)[XB_TMO])) break; if (_sp > XB_SPIN_CAP) { atomicAdd(&(bar)[XB_TMO], 1u); break; } } } } while (0)

struct XcdBarrier {
    unsigned* bar; unsigned x;
    volatile LAS unsigned* st;
};

__device__ __forceinline__ XcdBarrier xcd_barrier_post(unsigned* bar, volatile LAS unsigned* st) {
    XcdBarrier b; b.bar = bar; b.x = xb_xcc_id(); b.st = st;
    if (threadIdx.x == 0) (void)xb_add(&bar[XB_XCNT(b.x)], 1u);
    return b;
}
__device__ __forceinline__ void xcd_barrier_complete(unsigned* bar, unsigned x, unsigned& nloc, unsigned& nx) {
    const unsigned G = gridDim.x * gridDim.y * gridDim.z;
    unsigned sum, cnt, mine, sp = 0u;
    for (;;) {
        sum = 0u; cnt = 0u; mine = 0u;
#pragma unroll
        for (unsigned j = 0; j < 16; ++j) { const unsigned c = xb_ld(&bar[XB_XCNT(j)]); sum += c; cnt += (c > 0u) ? 1u : 0u; mine = (j == x) ? c : mine; }
        if (sum == G) break;
        __builtin_amdgcn_s_sleep(1);
        if ((++sp & 255u) == 0u) { if (xb_ld(&bar[XB_TMO])) break; if (sp > XB_SPIN_CAP) { atomicAdd(&bar[XB_TMO], 1u); break; } }
    }
    nloc = mine > 0u ? mine : 1u; nx = cnt > 0u ? cnt : 1u;
}

__device__ __forceinline__ void xcd_barrier(const XcdBarrier& b) {
    asm volatile("s_waitcnt vmcnt(0)" ::: "memory");
    __syncthreads();
    if (threadIdx.x == 0) {
        unsigned* bar = b.bar;
        __builtin_amdgcn_s_waitcnt(0);
        unsigned nloc = b.st[0], nx = b.st[1];
        if (nloc == 0u) { xcd_barrier_complete(bar, b.x, nloc, nx); b.st[0] = nloc; b.st[1] = nx; }
        const unsigned old = xb_add(&bar[XB_XSUB(b.x)], 1u);
        const unsigned gen = old / nloc;
        if (old + 1u == (gen + 1u) * nloc) {
            __builtin_amdgcn_fence(__ATOMIC_RELEASE, "agent");
            asm volatile("s_waitcnt vmcnt(0)" ::: "memory");
            const unsigned og = xb_add(&bar[XB_TOP], 1u);
            const unsigned tg = og / nx;
            if (og + 1u == (tg + 1u) * nx) xb_add(&bar[XB_TOPGEN], 1u);
            else XB_SPIN(xb_ld(&bar[XB_TOPGEN]) == tg, bar);
            __builtin_amdgcn_fence(__ATOMIC_ACQUIRE, "agent");
            xb_add(&bar[XB_XGEN(b.x)], 1u);
            asm volatile("s_waitcnt vmcnt(0)" ::: "memory");
        } else {
            XB_SPIN(xb_ld(&bar[XB_XGEN(b.x)]) == gen, bar);
            __builtin_amdgcn_fence(__ATOMIC_ACQUIRE, "agent");
            asm volatile("s_waitcnt vmcnt(0)" ::: "memory");
        }
    }
    __syncthreads();
}

#define GS_LOOP(N, CALL) for (long gi = (long)bid * NTHR + TIDX; gi < (long)(N); gi += (long)nblk * NTHR) { CALL; }
#ifndef PROBE
#define PROBE 0
#endif
#ifndef FAST_SCAN
#define FAST_SCAN 1
#endif
constexpr int N_PHASES = 16;
constexpr int MEGA_LDS = GEMM_LDS > TOPK_LDS ? GEMM_LDS : TOPK_LDS;

template <int PH>
DI void run_phase(const Params& p, int l, char* lds, int bid, int nblk) {
  const int need_ctx = (l == 0);
  const int rows = need_ctx ? R : RL;
  const float* xl_in = l == 0 ? p.x : p.out;
  const float* xc_in = l == 0 ? p.ctx : p.xc;
  bf16_t* QRAW = p.YO; bf16_t* KVRAW = p.YO + (size_t)R * 384;
  if constexpr (PH == 0) {
    ph_mods(p, lds, bid, nblk);
#pragma unroll 1
    for (int ll = 0; ll < 2; ++ll) {
      ph_wt(p.w_in + (size_t)ll * D * NZ, p.Wt_in + ll * WSZ_IN, D, NZ, NZP, 1, 0L, 0L, nullptr, lds, bid, nblk);
      ph_wt(p.w_gate + (size_t)ll * D * 4096, p.Wt_gate + ll * WSZ_GATE, D, 4096, 4096, 1, 0L, 0L, nullptr, lds, bid, nblk);
      ph_wt(p.w_branch + (size_t)ll * 4 * 256 * D, p.Wt_branch + ll * WSZ_BR, 256, D, D, 4, (long)256 * D, (long)D * 256, nullptr, lds, bid, nblk);
      ph_wt(p.w_out + (size_t)ll * D * D, p.Wt_out + ll * WSZ_OUT, D, D, D, 1, 0L, 0L, nullptr, lds, bid, nblk);
      ph_wt(p.w_uq + (size_t)ll * 256 * 384, p.Wt_uq + ll * WSZ_UQ, 256, 384, 384, 1, 0L, 0L, p.g_q_lat + ll * 256, lds, bid, nblk);
      ph_wt(p.w_ukv + (size_t)ll * 128 * 512, p.Wt_ukv + ll * WSZ_UKV, 128, 512, 512, 1, 0L, 0L, p.g_kv_lat + ll * 128, lds, bid, nblk);
    }
  } else if constexpr (PH == 1) {
    ph_modulate(p, l, xl_in, xc_in, bid, nblk);
  } else if constexpr (PH == 2) {
    ph_gemm_plain(p.H, D, p.Wt_in + l * WSZ_IN, D, R, NZP, D, p.Z, NZP, lds, bid, nblk);
#if PROBE == 63
    ph_gemm_probe<3>(p.H, D, p.Wt_in + l * WSZ_IN, D, R, NZP, D, p.mods + 40000, lds, bid, nblk);
#elif PROBE == 66
    ph_gemm_probe<6>(p.H, D, p.Wt_in + l * WSZ_IN, D, R, NZP, D, p.mods + 40000, lds, bid, nblk);
#elif PROBE == 67
    ph_gemm_plain<1>(p.H, D, p.Wt_in + l * WSZ_IN, D, R, NZP, D, p.Z, NZP, lds, bid, nblk);
#elif PROBE == 5
    ph_gemm_plain(p.H, D, p.Wt_in + l * WSZ_IN, D, R, NZP, D, p.Z, NZP, lds, bid, nblk);
#endif
  } else if constexpr (PH == 3) {
    ph_mla_up(p, l, QRAW, KVRAW, lds, bid, nblk);
  } else if constexpr (PH == 4) {
    ph_prep(p, l, QRAW, KVRAW, lds, bid, nblk);
#if PROBE == 41
    ph_prep(p, l, QRAW, KVRAW, lds, bid, nblk);
#elif PROBE == 43
    ph_prep<1>(p, l, QRAW, KVRAW, lds, bid, nblk);
#elif PROBE == 44
    ph_prep<2>(p, l, QRAW, KVRAW, lds, bid, nblk);
#endif
    __syncthreads();
    ph_gates_cum(p, l, lds, bid, nblk);
#if PROBE == 42
    ph_gates_cum(p, l, lds, bid, nblk);
#endif
  } else if constexpr (PH == 5) {
#if FAST_SCAN
    ph_ml_local(p, lds, bid, nblk);
    ph_gla_local(p, lds, bid, nblk);
#else
    GS_LOOP((long)NUNIT * 4160, nvb_ml_local(gi, p));
    GS_LOOP((long)NUNIT * 2048, nvb_gla_local(gi, p));
#endif
  } else if constexpr (PH == 6) {
#if FAST_SCAN
    ph_ml_scan(p, bid, nblk);
    ph_gla_scan(p, (bid + nblk - 260 % nblk) % nblk, nblk);
#else
    GS_LOOP((long)NB * 2 * 4 * 4160, nvb_ml_scan(gi, p));
    GS_LOOP((long)NB * 2 * 4 * 2048, nvb_gla_scan(gi, p));
#endif
    ph_attn(p, l, need_ctx, lds, bid, nblk);
#if PROBE >= 10 && PROBE < 20
    if (l == 0) ph_attn_mla_probe<PROBE - 10>(p, lds, bid, nblk);
#elif PROBE == 1
    ph_attn_diff(p, l, need_ctx, lds, bid, nblk);
#elif PROBE == 2
    ph_attn_mla(p, need_ctx, lds, bid, nblk);
#endif
  } else if constexpr (PH == 7) {
#if FAST_SCAN
    ph_ml_out(p, l, need_ctx, lds, bid, nblk);
    ph_gla_out(p, l, need_ctx, lds, bid, nblk);
#else
    GS_LOOP((long)NUNIT * 4096, nvb_ml_out(gi, p, need_ctx));
    GS_LOOP((long)NUNIT * 4096, nvb_gla_out(gi, p, need_ctx));
#endif
  } else if constexpr (PH == 8) {
#if !FAST_SCAN
    GS_LOOP((long)R * 4, nvb_ml_finish(gi, p, l, need_ctx));
    GS_LOOP((long)R * 4, nvb_gla_finish(gi, p, l, need_ctx));
#endif
  } else if constexpr (PH == 9) {
    ph_merge(p, l, rows, lds, bid, nblk);
#if PROBE == 3
    ph_merge(p, l, rows, lds, bid, nblk);
#endif
  } else if constexpr (PH == 10) {
    ph_gemm_plain(p.MG, D, p.Wt_out + l * WSZ_OUT, D, rows, D, D, p.YO, D, lds, bid, nblk);
  } else if constexpr (PH == 11) {
    ph_resid_mix(p, l, xl_in, xc_in, rows, bid, nblk);
  } else if constexpr (PH == 12) {
    ph_topk(p, need_ctx, lds, bid, nblk);
    ph_wt(p.w_e_gate + (size_t)l * NE * D * FF, p.Wt_eg, D, FF, FF, NE, (long)D * FF, (long)FF * D, nullptr, lds, bid, nblk);
    ph_wt(p.w_e_up + (size_t)l * NE * D * FF, p.Wt_eu, D, FF, FF, NE, (long)D * FF, (long)FF * D, nullptr, lds, bid, nblk);
    ph_wt(p.w_e_down + (size_t)l * NE * FF * D, p.Wt_ed, FF, D, D, NE, (long)FF * D, (long)D * FF, nullptr, lds, bid, nblk);
  } else if constexpr (PH == 13) {
    ph_moe1(p, need_ctx, lds, bid, nblk);
#if PROBE == 4
    ph_moe1(p, need_ctx, lds, bid, nblk);
#endif
  } else if constexpr (PH == 14) {
    ph_moe2(p, need_ctx, lds, bid, nblk);
#if PROBE == 4
    ph_moe2(p, need_ctx, lds, bid, nblk);
#endif
  } else if constexpr (PH == 15) {
    ph_resid_ffn(p, l, rows, bid, nblk);
  }
}

template <int PH> __global__ void __launch_bounds__(256, 2) k_phase(Params p, int l) {
  DYN_LDS(lds);
  run_phase<PH>(p, l, lds, blockIdx.x, gridDim.x);
}

#if !defined(CPU_EMU) && !MK_MULTI
typedef const Params __attribute__((address_space(4)))* KParams;
DI KParams kp_fresh() { KParams k = (KParams)__builtin_amdgcn_kernarg_segment_ptr(); asm volatile("" : "+s"(k)); return k; }
#define PHASE(PH, L) do { asm volatile("; PHASE_MARK " #PH); KParams k_ = kp_fresh(); run_phase<PH>(*(const Params*)k_, (L), lds, bid, nblk); if (PROBE == 20 + PH || (PROBE == 99 && (PH == 4 || PH == 5))) { __syncthreads(); run_phase<PH>(*(const Params*)k_, (L), lds, bid, nblk); } XcdBarrier b_ = bar; asm volatile("" : "+s"(b_.bar), "+s"(b_.x)); xcd_barrier(b_); if (PROBE == 50) xcd_barrier(b_); } while (0)
__global__ void __launch_bounds__(256, 2) k_mega(Params pv) {
  DYN_LDS(lds_all);
  if (threadIdx.x == 0) *(uint4*)lds_all = make_uint4(0u, 0u, 0u, 0u);
  __syncthreads();
  XcdBarrier bar = xcd_barrier_post(pv.bar, (volatile LAS unsigned*)lds_all);
  char* lds = lds_all + 256;
  const int bid = blockIdx.x, nblk = gridDim.x;
  PHASE(0, 0);
#pragma unroll 1
  for (int l = 0; l < 2; ++l) {
    PHASE(1, l); PHASE(2, l); PHASE(3, l); PHASE(4, l); PHASE(5, l); PHASE(6, l); PHASE(7, l);
#if !FAST_SCAN
    PHASE(8, l);
#endif

    PHASE(9, l); PHASE(10, l); PHASE(11, l); PHASE(12, l); PHASE(13, l); PHASE(14, l); PHASE(15, l);
  }
}
#endif
#ifdef CPU_EMU
void emu_check(const Params& p, int layer, int stage);
#define EMU_CHECK(stg) emu_check(p, l, stg)
static int g_nlayers = getenv("NLAYERS") ? atoi(getenv("NLAYERS")) : 2;
#else
#define EMU_CHECK(stg)
#endif
static void fill_params(Params& p, void* const* d_in, void* d_out, void* d_ws) {
  const float** f = (const float**)&p;
  for (int i = 0; i < 33; ++i) f[i] = (const float*)d_in[i];
  p.out = (float*)d_out;
  map_workspace(p, (char*)d_ws);
}
#define LAUNCH_PHASE(PH, L) LAUNCH((k_phase<PH>), grid, 256, MEGA_LDS, stream, p, L)

extern "C" void kernel_launch(void* const* d_in, const int* in_sizes, int n_in, void* d_out, int out_size, void* d_ws,
                              size_t ws_size, hipStream_t stream) {
  Params p{};
  fill_params(p, d_in, d_out, d_ws);
  if (p.ws_need > ws_size) return;
#ifdef CPU_EMU
  const int grid = 16;
  LAUNCH_PHASE(0, 0);
  for (int l = 0; l < g_nlayers; ++l) {
    LAUNCH_PHASE(1, l); LAUNCH_PHASE(2, l); LAUNCH_PHASE(3, l); LAUNCH_PHASE(4, l); LAUNCH_PHASE(5, l); LAUNCH_PHASE(6, l); LAUNCH_PHASE(7, l); LAUNCH_PHASE(8, l);
    EMU_CHECK(1);
    LAUNCH_PHASE(9, l); LAUNCH_PHASE(10, l); LAUNCH_PHASE(11, l);
    EMU_CHECK(2);
    LAUNCH_PHASE(12, l); LAUNCH_PHASE(13, l); LAUNCH_PHASE(14, l); LAUNCH_PHASE(15, l);
    EMU_CHECK(3);
  }
#else
  static int grid = 0;
  if (grid == 0) {
    int dev = 0, cus = 0, per_cu = 0;
    (void)hipGetDevice(&dev);
    (void)hipDeviceGetAttribute(&cus, hipDeviceAttributeMultiprocessorCount, dev);
#if MK_MULTI
    (void)hipFuncSetAttribute((const void*)k_phase<0>, hipFuncAttributeMaxDynamicSharedMemorySize, MEGA_LDS);
    (void)hipFuncSetAttribute((const void*)k_phase<1>, hipFuncAttributeMaxDynamicSharedMemorySize, MEGA_LDS);
    (void)hipFuncSetAttribute((const void*)k_phase<2>, hipFuncAttributeMaxDynamicSharedMemorySize, MEGA_LDS);
    (void)hipFuncSetAttribute((const void*)k_phase<3>, hipFuncAttributeMaxDynamicSharedMemorySize, MEGA_LDS);
    (void)hipFuncSetAttribute((const void*)k_phase<4>, hipFuncAttributeMaxDynamicSharedMemorySize, MEGA_LDS);
    (void)hipFuncSetAttribute((const void*)k_phase<5>, hipFuncAttributeMaxDynamicSharedMemorySize, MEGA_LDS);
    (void)hipFuncSetAttribute((const void*)k_phase<6>, hipFuncAttributeMaxDynamicSharedMemorySize, MEGA_LDS);
    (void)hipFuncSetAttribute((const void*)k_phase<7>, hipFuncAttributeMaxDynamicSharedMemorySize, MEGA_LDS);
    (void)hipFuncSetAttribute((const void*)k_phase<8>, hipFuncAttributeMaxDynamicSharedMemorySize, MEGA_LDS);
    (void)hipFuncSetAttribute((const void*)k_phase<9>, hipFuncAttributeMaxDynamicSharedMemorySize, MEGA_LDS);
    (void)hipFuncSetAttribute((const void*)k_phase<10>, hipFuncAttributeMaxDynamicSharedMemorySize, MEGA_LDS);
    (void)hipFuncSetAttribute((const void*)k_phase<11>, hipFuncAttributeMaxDynamicSharedMemorySize, MEGA_LDS);
    (void)hipFuncSetAttribute((const void*)k_phase<12>, hipFuncAttributeMaxDynamicSharedMemorySize, MEGA_LDS);
    (void)hipFuncSetAttribute((const void*)k_phase<13>, hipFuncAttributeMaxDynamicSharedMemorySize, MEGA_LDS);
    (void)hipFuncSetAttribute((const void*)k_phase<14>, hipFuncAttributeMaxDynamicSharedMemorySize, MEGA_LDS);
    (void)hipFuncSetAttribute((const void*)k_phase<15>, hipFuncAttributeMaxDynamicSharedMemorySize, MEGA_LDS);
    grid = (cus > 0 ? cus : 256) * 2;
#else
    if (hipFuncSetAttribute((const void*)k_mega, hipFuncAttributeMaxDynamicSharedMemorySize, MEGA_LDS + 256) != hipSuccess) { grid = -1; return; }
    if (hipOccupancyMaxActiveBlocksPerMultiprocessor(&per_cu, (const void*)k_mega, 256, MEGA_LDS + 256) != hipSuccess) per_cu = 0;
    (void)hipGetLastError();
    if (per_cu < 1) { grid = -1; return; }
    grid = (cus > 0 ? cus : 256) * (per_cu < 2 ? per_cu : 2);
#endif
  }
  if (grid < 0) return;
#if MK_MULTI
  LAUNCH_PHASE(0, 0);
  for (int l = 0; l < 2; ++l) {
    LAUNCH_PHASE(1, l); LAUNCH_PHASE(2, l); LAUNCH_PHASE(3, l); LAUNCH_PHASE(4, l); LAUNCH_PHASE(5, l); LAUNCH_PHASE(6, l); LAUNCH_PHASE(7, l); LAUNCH_PHASE(8, l);
    LAUNCH_PHASE(9, l); LAUNCH_PHASE(10, l); LAUNCH_PHASE(11, l); LAUNCH_PHASE(12, l); LAUNCH_PHASE(13, l); LAUNCH_PHASE(14, l); LAUNCH_PHASE(15, l);
  }
#else
  (void)hipMemsetAsync(p.bar, 0, XCD_BAR_WORDS * sizeof(unsigned), stream);
  k_mega<<<dim3(grid), dim3(256), MEGA_LDS + 256, stream>>>(p);
#endif
#endif
}
```

```cpp
#ifndef CPU_EMU
#include <hip/hip_runtime.h>
#endif
#include <stdint.h>
#include <stddef.h>

#ifndef T_LAT
#define T_LAT 16384
#endif
#ifndef T_CTX
#define T_CTX 256
#endif

#ifndef MK_MULTI
#define MK_MULTI 0
#endif
#define DI __device__ __forceinline__
typedef unsigned short bf16_t;
typedef short bf16x8 __attribute__((ext_vector_type(8)));
typedef short s16x4 __attribute__((ext_vector_type(4)));
typedef float f32x4 __attribute__((ext_vector_type(4)));
typedef float f32x16 __attribute__((ext_vector_type(16)));
typedef unsigned u32x4 __attribute__((ext_vector_type(4)));
typedef unsigned u32x2 __attribute__((ext_vector_type(2)));
typedef float f32x2 __attribute__((ext_vector_type(2)));

#ifdef CPU_EMU
static inline float u2f(unsigned u) { float f; memcpy(&f, &u, 4); return f; }
static inline unsigned f2u(float f) { unsigned u; memcpy(&u, &f, 4); return u; }
#define MFMA32(a, b, c) emu_mfma_32x32x16((a), (b), (c))
#define MFMA16(a, b, c) emu_mfma_16x16x32((a), (b), (c))
static inline float fast_exp2(float x) { return exp2f(x); }
static inline float fast_rcp(float x) { return 1.0f / x; }
static inline float fast_rsq(float x) { return 1.0f / sqrtf(x); }
static inline float hw_sin_rev(float x) { return sinf(6.283185307179586f * x); }
static inline float hw_cos_rev(float x) { return cosf(6.283185307179586f * x); }
#define LAUNCH(kern, grid, block, lds, stream, ...) emu::launch(dim3(grid), dim3(block), (size_t)(lds), [=]() { kern(__VA_ARGS__); })
#define DYN_LDS(name) char* name = emu_dynlds()
#define SCHED_BARRIER()
#define TIDX ((int)threadIdx.x)
#define WAVE_SYNC() emu::wave_barrier()
#define SETPRIO(x)
template <int M> static inline float xor_sum(float v) { return v + __shfl_xor(v, M); }
template <int M> static inline float xor_max(float v) { return fmaxf(v, __shfl_xor(v, M)); }
template <int M> static inline int xor_sum_i(int v) { return v + __shfl_xor(v, M); }
static inline int lane_bcast(int v, int src) { return __shfl(v, src); }
static inline int lane_up(int v, int d, int lane) { (void)lane; return __shfl_up(v, d); }
#else
DI float u2f(unsigned u) { return __uint_as_float(u); }
DI unsigned f2u(float f) { return __float_as_uint(f); }
#define MFMA32(a, b, c) __builtin_amdgcn_mfma_f32_32x32x16_bf16((a), (b), (c), 0, 0, 0)
#define MFMA16(a, b, c) __builtin_amdgcn_mfma_f32_16x16x32_bf16((a), (b), (c), 0, 0, 0)
DI float fast_exp2(float x) { return __builtin_amdgcn_exp2f(x); }
DI float fast_rcp(float x) { return __builtin_amdgcn_rcpf(x); }
DI float fast_rsq(float x) { return __builtin_amdgcn_rsqf(x); }
DI float hw_sin_rev(float x) { return __builtin_amdgcn_sinf(x); }
DI float hw_cos_rev(float x) { return __builtin_amdgcn_cosf(x); }
#define LAUNCH(kern, grid, block, lds, stream, ...) kern<<<dim3(grid), dim3(block), (lds), (stream)>>>(__VA_ARGS__)
#define DYN_LDS(name) extern __shared__ __attribute__((aligned(16))) char name[]
#define SCHED_BARRIER() __builtin_amdgcn_sched_barrier(0)
DI int tid_fresh() { int t = (int)threadIdx.x; asm volatile("" : "+v"(t)); return t; }
#define TIDX tid_fresh()
#define WAVE_SYNC() __builtin_amdgcn_wave_barrier()
#define SETPRIO(x) __builtin_amdgcn_s_setprio(x)
#ifdef USE_SHFL
template <int M> DI float xor_sum(float v) { return v + __shfl_xor(v, M); }
template <int M> DI float xor_max(float v) { return fmaxf(v, __shfl_xor(v, M)); }
template <int M> DI int xor_sum_i(int v) { return v + __shfl_xor(v, M); }
DI int lane_bcast(int v, int src) { return __shfl(v, src); }
DI int lane_up(int v, int d, int lane) { (void)lane; return __shfl_up(v, d); }
#else
template <int M> DI int xor_partner_bits(int bits) { return __builtin_amdgcn_ds_swizzle(bits, (M << 10) | 0x1f); }
DI void half_swap(unsigned& a, unsigned& b) { asm volatile("s_nop 1\n\tv_permlane32_swap_b32 %0, %1\n\ts_nop 1" : "+v"(a), "+v"(b)); }
template <int M> DI float xor_sum(float v) {
  if constexpr (M < 32) return v + __builtin_bit_cast(float, xor_partner_bits<M>(__builtin_bit_cast(int, v)));
  else { unsigned a = __builtin_bit_cast(unsigned, v), b = a; half_swap(a, b); return __builtin_bit_cast(float, a) + __builtin_bit_cast(float, b); }
}
template <int M> DI float xor_max(float v) {
  if constexpr (M < 32) return fmaxf(v, __builtin_bit_cast(float, xor_partner_bits<M>(__builtin_bit_cast(int, v))));
  else { unsigned a = __builtin_bit_cast(unsigned, v), b = a; half_swap(a, b); return fmaxf(__builtin_bit_cast(float, a), __builtin_bit_cast(float, b)); }
}
template <int M> DI int xor_sum_i(int v) {
  if constexpr (M < 32) return v + xor_partner_bits<M>(v);
  else { unsigned a = (unsigned)v, b = a; half_swap(a, b); return (int)(a + b); }
}
DI int lane_bcast(int v, int src) { return __builtin_amdgcn_readlane(v, src); }
DI int lane_up(int v, int d, int lane) { return __builtin_amdgcn_ds_bpermute(((lane - d) & 63) << 2, v); }
#endif
#endif

DI float bf2f(bf16_t v) { return u2f(((unsigned)v) << 16); }
#ifdef CPU_EMU
DI bf16_t f2bf(float f) { unsigned u = f2u(f); u += 0x7fffu + ((u >> 16) & 1u); return (bf16_t)(u >> 16); }
DI unsigned pack2bf(float lo, float hi) { return (unsigned)f2bf(lo) | ((unsigned)f2bf(hi) << 16); }
static inline bool wave_any(bool pr) { int v = pr ? 1 : 0; v |= __shfl_xor(v, 1); v |= __shfl_xor(v, 2); v |= __shfl_xor(v, 4); v |= __shfl_xor(v, 8); v |= __shfl_xor(v, 16); v |= __shfl_xor(v, 32); return v != 0; }
#else
typedef float f32x2_ __attribute__((ext_vector_type(2)));
typedef __bf16 bf16x2_hw __attribute__((ext_vector_type(2)));
DI unsigned pack2bf(float lo, float hi) { const f32x2_ v = {lo, hi}; return __builtin_bit_cast(unsigned, __builtin_convertvector(v, bf16x2_hw)); }
DI bf16_t f2bf(float f) { return (bf16_t)(pack2bf(f, f) & 0xffffu); }
DI bool wave_any(bool pr) { return __builtin_amdgcn_ballot_w64(pr) != 0ull; }
#endif
DI float sigmoidf_(float x) { return 1.0f / (1.0f + expf(-x)); }
DI float siluf_(float x) { return x / (1.0f + expf(-x)); }
DI float logsigmoidf_(float x) { return fminf(x, 0.0f) - log1pf(expf(-fabsf(x))); }

constexpr int D = 1024, NB = 2, TL = T_LAT, TC = T_CTX, TK = TL + TC;
constexpr int RL = NB * TL, RC = NB * TC, R = RL + RC;
constexpr int NZ = 3024, NZP = 3072;
constexpr int ZC_QLAT = 0, ZC_KVLAT = 256, ZC_KROPE = 384, ZC_MLQK = 416, ZC_MLV = 928, ZC_MLO = 1184, ZC_MLIG = 1440,
              ZC_MLFG = 1448, ZC_GQ = 1456, ZC_GK = 1584, ZC_GV = 1712, ZC_GR = 1968, ZC_GA = 2224, ZC_DQ = 2256,
              ZC_DK = 2512, ZC_DV = 2768;
constexpr int NCK = TK / 64, NCC = TC / 64, NCL = TL / 64;
constexpr int NE = 16, FF = 1408, CAPL = 2 * TL / 16, CAPC = 2 * TC / 16, CAPT = CAPL + CAPC, NSLOT = NB * CAPT;
constexpr size_t WSZ_IN = (size_t)NZP * D, WSZ_UQ = 384 * 256, WSZ_UKV = 512 * 128, WSZ_GATE = (size_t)4096 * D, WSZ_BR = (size_t)4 * D * 256, WSZ_OUT = (size_t)D * D;
constexpr int NUNIT = NB * 2 * NCK * 4;
constexpr float LOG2E = 1.4426950408889634f;
constexpr float QS_MLA = 0.10206207261596577f * LOG2E;
constexpr float QS_DIFF = 0.17677669529663687f * LOG2E;

DI int row_of(int b, int s) { return s < TC ? RL + b * TC + s : b * TL + (s - TC); }
DI void bs_of(int r, int& b, int& s) { if (r < RL) { b = r / TL; s = TC + (r % TL); } else { int q = r - RL; b = q / TC; s = q % TC; } }
DI int seq_of(int d, int p) { return d == 0 ? p : (p < TC ? TC - 1 - p : TK - 1 - (p - TC)); }
DI int step_of(int d, int c) { return d == 0 ? c : (c < NCC ? NCC - 1 - c : NCC + (NCK - 1 - c)); }

struct Params {
  const float *x, *c, *ctx, *c_ctx, *w_ada, *b_ada, *g_mix_pre, *g_mix_post, *g_ffn_pre, *g_ffn_post, *w_in, *g_q_lat, *w_uq,
      *g_kv_lat, *w_ukv, *w_conv, *b_conv, *b_igate, *b_fgate, *g_mlstm_out, *w_alpha2, *b_alpha, *g_gla_out, *diff_lambda,
      *g_diff_out, *w_branch, *w_gate, *b_gate, *w_out, *w_router, *w_e_gate, *w_e_up, *w_e_down;
  float* out;
  float *mods, *xc;
  bf16_t *H, *Z, *Qm, *Km, *Vtm, *Qd, *Kd, *Vtd, *MQ, *MK, *Y, *MG, *YO, *HID, *YE, *MVt, *GVt;
  float *BC, *IGS, *GC, *MC, *MN, *MM, *GS, *HD, *OD, *AFF, *SELV;
  int *SEL, *INV;
  bf16_t *Wt_in, *Wt_uq, *Wt_ukv, *Wt_gate, *Wt_branch, *Wt_out, *Wt_eg, *Wt_eu, *Wt_ed;
  unsigned* bar;
  size_t ws_need;
};

static inline size_t al256(size_t x) { return (x + 255) & ~(size_t)255; }
static inline void map_workspace(Params& p, char* ws) {
  size_t o = 0;
  auto take = [&](size_t bytes) { size_t r = o; o += al256(bytes); return ws + r; };
  p.bar = (unsigned*)take(16384);
  p.mods = (float*)take((size_t)2 * 3 * 6144 * 4);
  p.xc = (float*)take((size_t)RC * D * 4);
  p.BC = (float*)take((size_t)NB * 2 * TK * 4 * 4);
  p.IGS = (float*)take((size_t)NB * 2 * TK * 4 * 4);
  p.AFF = (float*)take((size_t)NB * NE * TK * 4);
  p.SEL = (int*)take((size_t)NE * NSLOT * 4);
  p.SELV = (float*)take((size_t)NE * NSLOT * 4);
  p.INV = (int*)take((size_t)R * NE * 4);
  p.MM = (float*)take((size_t)NUNIT * 4 * 4);
  p.MN = (float*)take((size_t)NUNIT * 64 * 4);
  p.Wt_in = (bf16_t*)take((size_t)2 * WSZ_IN * 2);
  p.Wt_uq = (bf16_t*)take((size_t)2 * WSZ_UQ * 2);
  p.Wt_ukv = (bf16_t*)take((size_t)2 * WSZ_UKV * 2);
  p.Wt_gate = (bf16_t*)take((size_t)2 * WSZ_GATE * 2);
  p.Wt_branch = (bf16_t*)take((size_t)2 * WSZ_BR * 2);
  p.Wt_out = (bf16_t*)take((size_t)2 * WSZ_OUT * 2);
  p.H = (bf16_t*)take((size_t)R * D * 2);
  size_t szA = (size_t)R * NZP * 2, szHID = (size_t)NE * NSLOT * FF * 2;
  char* A = take(szA > szHID ? szA : szHID);
  p.Z = (bf16_t*)A; p.HID = (bf16_t*)A;
  size_t szQm = al256((size_t)NB * 4 * TK * 96 * 2), szVt = al256((size_t)NB * 4 * 64 * TK * 2), szQd = al256((size_t)NB * 8 * TK * 32 * 2);
  size_t szB1 = 2 * szQm + 2 * szVt + 2 * szQd;
  size_t szHD = al256((size_t)2 * NB * TK * 256 * 4);
  size_t szYE = (size_t)NE * NSLOT * D * 2;
  size_t szB = szB1; if (2 * szHD > szB) szB = 2 * szHD; if (szYE > szB) szB = szYE;
  char* Bq = take(szB);
  p.Qm = (bf16_t*)Bq; p.Km = (bf16_t*)(Bq + szQm); p.Vtm = (bf16_t*)(Bq + 2 * szQm);
  p.Qd = (bf16_t*)(Bq + 2 * szQm + szVt); p.Kd = (bf16_t*)(Bq + 2 * szQm + szVt + szQd); p.Vtd = (bf16_t*)(Bq + 2 * szQm + szVt + 2 * szQd);
  p.YE = (bf16_t*)Bq;
  p.GC = (float*)take((size_t)NB * 2 * TK * 128 * 4);
  p.MVt = (bf16_t*)take((size_t)NB * 4 * 64 * TK * 2);
  p.GVt = (bf16_t*)take((size_t)NB * 4 * 64 * TK * 2);
  size_t szW = (size_t)NE * FF * D * 2;
  size_t szMC = (size_t)NUNIT * 4096 * 4, szRD = (size_t)R * D * 2;
  size_t szC = szMC; if (szRD > szC) szC = szRD; if (szW > szC) szC = szW;
  char* C = take(szC);
  p.MC = (float*)C; p.MG = (bf16_t*)C; p.Wt_eg = (bf16_t*)C;
  size_t szMQ = al256((size_t)NB * TK * 256 * 2), szGS = (size_t)NUNIT * 2048 * 4;
  size_t szD = 2 * szMQ + szGS; if (szW > szD) szD = szW;
  char* Dq = take(szD);
  p.MQ = (bf16_t*)Dq; p.MK = (bf16_t*)(Dq + szMQ); p.GS = (float*)(Dq + 2 * szMQ); p.Wt_eu = (bf16_t*)Dq;
  size_t szF = 2 * szRD > szW ? 2 * szRD : szW;
  char* F = take(szF);
  p.Y = (bf16_t*)F; p.YO = (bf16_t*)(F + szRD); p.Wt_ed = (bf16_t*)F;
  p.HD = (float*)Bq; p.OD = (float*)(Bq + szHD);
  p.ws_need = o;
}
#define GTID ((long)blockIdx.x * blockDim.x + threadIdx.x)

DI float lam_of(const Params& p, int layer, float& lam_init) {
  const float* lv = p.diff_lambda + layer * 128;
  float s1 = 0.f, s2 = 0.f;
  for (int i = 0; i < 32; ++i) { s1 += lv[i] * lv[32 + i]; s2 += lv[64 + i] * lv[96 + i]; }
  lam_init = layer == 0 ? 0.2f : 0.35550906759096f;
  return expf(s1) - expf(s2) + lam_init;
}
DI void rope_cs(int s, int jj, float& cs, float& sn) {
  int t = s - TC;
  int pos = (jj < 16) ? (t / 64) : (t % 64);
  float ang = (float)pos * exp2f(-1.6609640474436813f * (float)(jj & 7));
  double rev = (double)ang * 0.15915494309189535;
  rev -= floor(rev + 0.5);
  float rf = (float)rev;
  cs = hw_cos_rev(rf); sn = hw_sin_rev(rf);
}
template <class G> DI float rope_elem(G get, int s, int jj) {
  if (s < TC) return get(jj);
  float cs, sn; rope_cs(s, jj, cs, sn);
  float a = get(jj), b = get(jj ^ 8);
  return (jj & 8) ? (a * cs + b * sn) : (a * cs - b * sn);
}

DI void nvb_mods(long GI, const Params& p) {
  long i = GI; if (i >= 2 * 3 * 6144) return;
  int col = (int)(i % 6144), w = (int)((i / 6144) % 3), l = (int)(i / (3 * 6144));
  const float* cv = w < 2 ? p.c + w * 1024 : p.c_ctx;
  const float* W = p.w_ada + (size_t)l * 1024 * 6144;
  float acc = 0.f;
  for (int k = 0; k < 1024; ++k) acc += siluf_(cv[k]) * W[(size_t)k * 6144 + col];
  p.mods[i] = acc + p.b_ada[l * 6144 + col];
}
__global__ void __launch_bounds__(256) nv_wt(const float* in, bf16_t* out, int K, int N, int NP, long in_bs, long out_bs, const float* gain) {
  long i = GTID; if (i >= (long)NP * K) return;
  int k = (int)(i % K), n = (int)(i / K);
  const float* I = in + (size_t)blockIdx.y * in_bs; bf16_t* O = out + (size_t)blockIdx.y * out_bs;
  O[(size_t)n * K + k] = n < N ? f2bf(I[(size_t)k * N + n] * (gain ? gain[k] : 1.0f)) : (bf16_t)0;
}
__global__ void __launch_bounds__(256) nv_modulate(Params p, int layer, int which, const float* xl, const float* xcx, int nrows) {
  long r = GTID; if (r >= nrows) return;
  int w = r < RL ? (int)(r / TL) : 2;
  const float* mb = p.mods + (size_t)(layer * 3 + w) * 6144;
  const float* shift = mb + (which ? 3 : 0) * 1024; const float* scale = mb + (which ? 4 : 1) * 1024;
  const float* g = (which ? p.g_ffn_pre : p.g_mix_pre) + layer * 1024;
  const float* x = r < RL ? xl + (size_t)r * D : xcx + (size_t)(r - RL) * D;
  float ss = 0.f; for (int k = 0; k < D; ++k) ss += x[k] * x[k];
  float rstd = 1.0f / sqrtf(ss / D + 1e-6f);
  for (int k = 0; k < D; ++k) p.H[(size_t)r * D + k] = f2bf(x[k] * rstd * g[k] * (1.f + scale[k]) + shift[k]);
}
__global__ void __launch_bounds__(256) nv_gemm(const bf16_t* A, int lda, const bf16_t* Bt, int ldb, int M, int N, int K, bf16_t* C, int ldc) {
  long i = GTID; if (i >= (long)M * N) return;
  int n = (int)(i % N), m = (int)(i / N);
  const bf16_t* a = A + (size_t)m * lda; const bf16_t* b = Bt + (size_t)n * ldb;
  float acc = 0.f;
  for (int k = 0; k < K; ++k) acc += bf2f(a[k]) * bf2f(b[k]);
  C[(size_t)m * ldc + n] = f2bf(acc);
}
__global__ void __launch_bounds__(256) nv_mla_q(Params p, int layer) {
  long i = GTID; if (i >= (long)R * 4 * 96) return;
  int j = (int)(i % 96), h = (int)((i / 96) % 4), r = (int)(i / 384);
  int b, s; bs_of(r, b, s);
  const bf16_t* z = p.Z + (size_t)r * NZP + ZC_QLAT;
  const float* g = p.g_q_lat + layer * 256; const float* W = p.w_uq + (size_t)layer * 256 * 384;
  float ss = 0.f; for (int k = 0; k < 256; ++k) { float v = bf2f(z[k]); ss += v * v; }
  float rstd = 1.0f / sqrtf(ss / 256 + 1e-6f);
  auto dot = [&](int col) { float a = 0.f; for (int k = 0; k < 256; ++k) a += bf2f(z[k]) * rstd * g[k] * W[(size_t)k * 384 + col]; return a; };
  float v;
  if (j < 64) v = dot(h * 96 + j);
  else v = rope_elem([&](int jj) { return dot(h * 96 + 64 + jj); }, s, j - 64);
  p.Qm[(((size_t)b * 4 + h) * TK + s) * 96 + j] = f2bf(v * QS_MLA);
}
__global__ void __launch_bounds__(256) nv_mla_kv(Params p, int layer) {
  long i = GTID; if (i >= (long)R * 4 * 160) return;
  int j = (int)(i % 160), h = (int)((i / 160) % 4), r = (int)(i / 640);
  int b, s; bs_of(r, b, s);
  const bf16_t* z = p.Z + (size_t)r * NZP;
  if (j < 128) {
    const bf16_t* zl = z + ZC_KVLAT; const float* g = p.g_kv_lat + layer * 128; const float* W = p.w_ukv + (size_t)layer * 128 * 512;
    float ss = 0.f; for (int k = 0; k < 128; ++k) { float v = bf2f(zl[k]); ss += v * v; }
    float rstd = 1.0f / sqrtf(ss / 128 + 1e-6f);
    float a = 0.f; for (int k = 0; k < 128; ++k) a += bf2f(zl[k]) * rstd * g[k] * W[(size_t)k * 512 + h * 128 + j];
    if (j < 64) p.Km[(((size_t)b * 4 + h) * TK + s) * 96 + j] = f2bf(a);
    else p.Vtm[(((size_t)b * 4 + h) * 64 + (j - 64)) * TK + s] = f2bf(a);
  } else {
    int jj = j - 128;
    float v = rope_elem([&](int q) { return bf2f(z[ZC_KROPE + q]); }, s, jj);
    p.Km[(((size_t)b * 4 + h) * TK + s) * 96 + 64 + jj] = f2bf(v);
  }
}
__global__ void __launch_bounds__(256) nv_diff_prep(Params p) {
  long i = GTID; if (i >= (long)R * 768) return;
  int c = (int)(i % 768), r = (int)(i / 768);
  int b, s; bs_of(r, b, s);
  const bf16_t* z = p.Z + (size_t)r * NZP;
  if (c < 512) {
    int qk = c / 256, cc = c % 256, hm = cc / 32, jj = cc % 32;
    const bf16_t* src = z + (qk ? ZC_DK : ZC_DQ) + hm * 32;
    float v = rope_elem([&](int q) { return bf2f(src[q]); }, s, jj);
    if (qk == 0) p.Qd[(((size_t)b * 8 + hm) * TK + s) * 32 + jj] = f2bf(v * QS_DIFF);
    else p.Kd[(((size_t)b * 8 + hm) * TK + s) * 32 + jj] = f2bf(v);
  } else {
    int cc = c - 512, h = cc / 64, dv = cc % 64;
    p.Vtd[(((size_t)b * 4 + h) * 64 + dv) * TK + s] = z[ZC_DV + cc];
  }
}
__global__ void __launch_bounds__(256) nv_ml_prep(Params p, int layer) {
  long i = GTID; if (i >= (long)R * 512) return;
  int ch = (int)(i % 512), r = (int)(i / 512);
  int b, s; bs_of(r, b, s);
  bool first = (s == 0) || (s == TC), last = (s == TC - 1) || (s == TK - 1);
  const float* w = p.w_conv + (size_t)layer * 3 * 512;
  float acc = p.b_conv[layer * 512 + ch];
  acc += bf2f(p.Z[(size_t)r * NZP + ZC_MLQK + ch]) * w[512 + ch];
  if (!first) acc += bf2f(p.Z[(size_t)row_of(b, s - 1) * NZP + ZC_MLQK + ch]) * w[ch];
  if (!last) acc += bf2f(p.Z[(size_t)row_of(b, s + 1) * NZP + ZC_MLQK + ch]) * w[1024 + ch];
  float v = siluf_(acc);
  if (ch < 256) p.MQ[((size_t)b * TK + s) * 256 + ch] = f2bf(v);
  else p.MK[((size_t)b * TK + s) * 256 + ch - 256] = f2bf(v * 0.125f);
}
DI void nvb_ml_gates(long GI, const Params& p, int layer) {
  long i = GI; if (i >= (long)NB * 2 * NCK * 4) return;
  int h = (int)(i % 4), j = (int)((i / 4) % NCK), d = (int)((i / (4 * NCK)) % 2), b = (int)(i / (8 * NCK));
  float bi = p.b_igate[layer * 8 + d * 4 + h], bfg = p.b_fgate[layer * 8 + d * 4 + h];
  float cum = 0.f;
  for (int l = 0; l < 64; ++l) {
    int pp = 64 * j + l, s = seq_of(d, pp); const bf16_t* z = p.Z + (size_t)row_of(b, s) * NZP;
    float ig = bf2f(z[ZC_MLIG + d * 4 + h]) + bi;
    float lf = logsigmoidf_(bf2f(z[ZC_MLFG + d * 4 + h]) + bfg);
    cum += lf;
    size_t o = (((size_t)b * 2 + d) * TK + pp) * 4 + h;
    p.BC[o] = cum; p.IGS[o] = ig;
  }
}
DI void nvb_gla_cum(long GI, const Params& p, int layer) {
  long i = GI; if (i >= (long)NB * 2 * NCK * 128) return;
  int ch = (int)(i % 128), j = (int)((i / 128) % NCK), d = (int)((i / (128 * NCK)) % 2), b = (int)(i / (256 * NCK));
  const float* W = p.w_alpha2 + (size_t)layer * 2 * 16 * 128 + (size_t)d * 16 * 128;
  float ba = p.b_alpha[layer * 256 + d * 128 + ch];
  float cum = 0.f;
  for (int l = 0; l < 64; ++l) {
    int pp = 64 * j + l, s = seq_of(d, pp); const bf16_t* z = p.Z + (size_t)row_of(b, s) * NZP + ZC_GA + d * 16;
    float zg = ba; for (int q = 0; q < 16; ++q) zg += bf2f(z[q]) * W[q * 128 + ch];
    cum += logsigmoidf_(zg) * (1.0f / 16.0f);
    p.GC[(((size_t)b * 2 + d) * TK + pp) * 128 + ch] = cum;
  }
}
__global__ void __launch_bounds__(256) nv_attn_mla(Params p, int need_ctx) {
  long i = GTID; if (i >= (long)NB * 4 * TK) return;
  int s = (int)(i % TK), h = (int)((i / TK) % 4), b = (int)(i / (4 * TK));
  if (s < TC && !need_ctx) return;
  int nk = s < TC ? TC : TK;
  const bf16_t* q = p.Qm + (((size_t)b * 4 + h) * TK + s) * 96;
  const bf16_t* K = p.Km + ((size_t)b * 4 + h) * TK * 96;
  const bf16_t* Vt = p.Vtm + ((size_t)b * 4 + h) * 64 * TK;
  float qf[96], o[64];
  _Pragma("unroll") for (int k = 0; k < 96; ++k) qf[k] = bf2f(q[k]);
  _Pragma("unroll") for (int k = 0; k < 64; ++k) o[k] = 0.f;
  float m = -1e30f, l = 0.f;
  for (int t = 0; t < nk; ++t) {
    float sc = 0.f; _Pragma("unroll") for (int k = 0; k < 96; ++k) sc += qf[k] * bf2f(K[(size_t)t * 96 + k]);
    float mn = fmaxf(m, sc), a = exp2f(m - mn), pr = exp2f(sc - mn);
    l = l * a + pr;
    _Pragma("unroll") for (int k = 0; k < 64; ++k) o[k] = o[k] * a + pr * bf2f(Vt[(size_t)k * TK + t]);
    m = mn;
  }
  int r = row_of(b, s);
  _Pragma("unroll") for (int k = 0; k < 64; ++k) p.Y[(size_t)r * D + h * 64 + k] = f2bf(o[k] / l);
}
__global__ void __launch_bounds__(256) nv_attn_diff(Params p, int layer, int need_ctx) {
  long i = GTID; if (i >= (long)NB * 4 * TK) return;
  int s = (int)(i % TK), h = (int)((i / TK) % 4), b = (int)(i / (4 * TK));
  if (s < TC && !need_ctx) return;
  int nk = s < TC ? TC : TK;
  float lam_init; float lam = lam_of(p, layer, lam_init);
  const bf16_t* Vt = p.Vtd + ((size_t)b * 4 + h) * 64 * TK;
  float res[64];
  _Pragma("unroll") for (int k = 0; k < 64; ++k) res[k] = 0.f;
  _Pragma("unroll") for (int mp = 0; mp < 2; ++mp) {
    const bf16_t* q = p.Qd + (((size_t)b * 8 + h * 2 + mp) * TK + s) * 32;
    const bf16_t* K = p.Kd + ((size_t)b * 8 + h * 2 + mp) * TK * 32;
    float qf[32], o[64];
    _Pragma("unroll") for (int k = 0; k < 32; ++k) qf[k] = bf2f(q[k]);
    _Pragma("unroll") for (int k = 0; k < 64; ++k) o[k] = 0.f;
    float m = -1e30f, l = 0.f;
    for (int t = 0; t < nk; ++t) {
      float sc = 0.f; _Pragma("unroll") for (int k = 0; k < 32; ++k) sc += qf[k] * bf2f(K[(size_t)t * 32 + k]);
      float mn = fmaxf(m, sc), a = exp2f(m - mn), pr = exp2f(sc - mn);
      l = l * a + pr;
      _Pragma("unroll") for (int k = 0; k < 64; ++k) o[k] = o[k] * a + pr * bf2f(Vt[(size_t)k * TK + t]);
      m = mn;
    }
    float wgt = mp == 0 ? 1.f : -lam;
    _Pragma("unroll") for (int k = 0; k < 64; ++k) res[k] += wgt * o[k] / l;
  }
  float ss = 0.f; _Pragma("unroll") for (int k = 0; k < 64; ++k) ss += res[k] * res[k];
  float rstd = 1.0f / sqrtf(ss / 64 + 1e-6f);
  int r = row_of(b, s);
  _Pragma("unroll") for (int k = 0; k < 64; ++k) p.Y[(size_t)r * D + 768 + h * 64 + k] = f2bf(res[k] * rstd * p.g_diff_out[layer * 256 + h * 64 + k] * (1.f - lam_init));
}
DI void nvb_ml_local(long GI, const Params& p) {
  long i = GI; if (i >= (long)NUNIT * 4160) return;
  int e = (int)(i % 4160); long u = i / 4160;
  int h = (int)(u % 4), j = (int)((u / 4) % NCK), d = (int)((u / (4 * NCK)) % 2), b = (int)(u / (8 * NCK));
  const float* bc = p.BC + (((size_t)b * 2 + d) * TK + 64 * j) * 4 + h; const float* ig = p.IGS + (((size_t)b * 2 + d) * TK + 64 * j) * 4 + h;
  float bend = bc[63 * 4], ml = -1e30f;
  for (int l = 0; l < 64; ++l) ml = fmaxf(ml, bend - bc[l * 4] + ig[l * 4]);
  if (e == 4096 + 0) { p.MM[u * 4 + 0] = ml; p.MM[u * 4 + 1] = bend; }
  float acc = 0.f;
  if (e < 4096) {
    int v = e / 64, k = e % 64;
    for (int l = 0; l < 64; ++l) {
      int s = seq_of(d, 64 * j + l); float w = expf(bend - bc[l * 4] + ig[l * 4] - ml);
      acc += w * bf2f(p.Z[(size_t)row_of(b, s) * NZP + ZC_MLV + h * 64 + v]) * bf2f(p.MK[((size_t)b * TK + s) * 256 + h * 64 + k]);
    }
    p.MC[(size_t)u * 4096 + e] = acc;
  } else {
    int k = e - 4096;
    for (int l = 0; l < 64; ++l) {
      int s = seq_of(d, 64 * j + l); float w = expf(bend - bc[l * 4] + ig[l * 4] - ml);
      acc += w * bf2f(p.MK[((size_t)b * TK + s) * 256 + h * 64 + k]);
    }
    p.MN[(size_t)u * 64 + k] = acc;
  }
}
DI void nvb_ml_scan(long GI, const Params& p) {
  long i = GI; if (i >= (long)NB * 2 * 4 * 4160) return;
  int e = (int)(i % 4160); int ch = (int)(i / 4160); int h = ch % 4, bd = ch / 4;
  float st = 0.f, m = -1e30f;
  for (int j = 0; j < NCK; ++j) {
    size_t u = ((size_t)bd * NCK + j) * 4 + h;
    float ml = p.MM[u * 4 + 0], be = p.MM[u * 4 + 1];
    float mn = fmaxf(be + m, ml), a = expf(be + m - mn), g = expf(ml - mn);
    float* slot = e < 4096 ? &p.MC[u * 4096 + e] : &p.MN[u * 64 + (e - 4096)];
    float loc = *slot; *slot = st; st = a * st + g * loc;
    if (e == 0) p.MM[u * 4 + 2] = m;
    m = mn;
  }
}
DI void nvb_ml_out(long GI, const Params& p, int need_ctx) {
  long i = GI; if (i >= (long)NUNIT * 4096) return;
  int v = (int)(i % 64), l = (int)((i / 64) % 64); long u = i / 4096;
  int h = (int)(u % 4), j = (int)((u / 4) % NCK), d = (int)((u / (4 * NCK)) % 2), b = (int)(u / (8 * NCK));
  if (j < NCC && !need_ctx) return;
  const float* bc = p.BC + (((size_t)b * 2 + d) * TK + 64 * j) * 4 + h; const float* ig = p.IGS + (((size_t)b * 2 + d) * TK + 64 * j) * 4 + h;
  float m0 = p.MM[u * 4 + 2];
  int sl = seq_of(d, 64 * j + l);
  const bf16_t* q = p.MQ + ((size_t)b * TK + sl) * 256 + h * 64;
  float bl = bc[l * 4];
  float inter = bl + m0, mt = inter;
  for (int t = 0; t <= l; ++t) mt = fmaxf(mt, bl - bc[t * 4] + ig[t * 4]);
  float num = 0.f, den = 0.f;
  for (int t = 0; t <= l; ++t) {
    int st = seq_of(d, 64 * j + t);
    const bf16_t* k = p.MK + ((size_t)b * TK + st) * 256 + h * 64;
    float qk = 0.f; for (int c = 0; c < 64; ++c) qk += bf2f(q[c]) * bf2f(k[c]);
    float sv = expf(bl - bc[t * 4] + ig[t * 4] - mt) * qk;
    num += sv * bf2f(p.Z[(size_t)row_of(b, st) * NZP + ZC_MLV + h * 64 + v]); den += sv;
  }
  float ai = expf(inter - mt);
  float qc = 0.f, qn = 0.f;
  for (int c = 0; c < 64; ++c) { qc += bf2f(q[c]) * p.MC[(size_t)u * 4096 + v * 64 + c]; qn += bf2f(q[c]) * p.MN[(size_t)u * 64 + c]; }
  num += ai * qc; den += ai * qn;
  p.HD[(((size_t)d * NB + b) * TK + sl) * 256 + h * 64 + v] = num / fmaxf(fabsf(den), expf(-mt));
}
DI void nvb_ml_finish(long GI, const Params& p, int layer, int need_ctx) {
  long i = GI; if (i >= (long)R * 4) return;
  int h = (int)(i % 4), r = (int)(i / 4); int b, s; bs_of(r, b, s);
  if (s < TC && !need_ctx) return;
  const float* h0 = p.HD + (((size_t)0 * NB + b) * TK + s) * 256 + h * 64; const float* h1 = p.HD + (((size_t)1 * NB + b) * TK + s) * 256 + h * 64;
  float ss = 0.f; for (int v = 0; v < 64; ++v) { float t = h0[v] + h1[v]; ss += t * t; }
  float rstd = 1.0f / sqrtf(ss / 64 + 1e-6f);
  for (int v = 0; v < 64; ++v) {
    float o = bf2f(p.Z[(size_t)r * NZP + ZC_MLO + h * 64 + v]);
    p.Y[(size_t)r * D + 256 + h * 64 + v] = f2bf(sigmoidf_(o) * (h0[v] + h1[v]) * rstd * p.g_mlstm_out[layer * 256 + h * 64 + v]);
  }
}
DI void nvb_gla_local(long GI, const Params& p) {
  long i = GI; if (i >= (long)NUNIT * 2048) return;
  int v = (int)(i % 64), k = (int)((i / 64) % 32); long u = i / 2048;
  int h = (int)(u % 4), j = (int)((u / 4) % NCK), d = (int)((u / (4 * NCK)) % 2), b = (int)(u / (8 * NCK));
  const float* gc = p.GC + (((size_t)b * 2 + d) * TK + 64 * j) * 128 + h * 32 + k;
  float ge = gc[63 * 128], acc = 0.f;
  for (int l = 0; l < 64; ++l) {
    int s = seq_of(d, 64 * j + l); const bf16_t* z = p.Z + (size_t)row_of(b, s) * NZP;
    acc += bf2f(z[ZC_GK + h * 32 + k]) * expf(ge - gc[l * 128]) * bf2f(z[ZC_GV + h * 64 + v]);
  }
  p.GS[(size_t)u * 2048 + v * 32 + k] = acc;
}
DI void nvb_gla_scan(long GI, const Params& p) {
  long i = GI; if (i >= (long)NB * 2 * 4 * 2048) return;
  int e = (int)(i % 2048); int ch = (int)(i / 2048); int h = ch % 4, bd = ch / 4; int k = e % 32;
  float st = 0.f;
  for (int j = 0; j < NCK; ++j) {
    size_t u = ((size_t)bd * NCK + j) * 4 + h;
    float ge = p.GC[((size_t)bd * TK + 64 * j + 63) * 128 + h * 32 + k];
    float loc = p.GS[u * 2048 + e]; p.GS[u * 2048 + e] = st; st = expf(ge) * st + loc;
  }
}
DI void nvb_gla_out(long GI, const Params& p, int need_ctx) {
  long i = GI; if (i >= (long)NUNIT * 4096) return;
  int v = (int)(i % 64), l = (int)((i / 64) % 64); long u = i / 4096;
  int h = (int)(u % 4), j = (int)((u / 4) % NCK), d = (int)((u / (4 * NCK)) % 2), b = (int)(u / (8 * NCK));
  if (j < NCC && !need_ctx) return;
  const float* gc = p.GC + (((size_t)b * 2 + d) * TK + 64 * j) * 128 + h * 32;
  int sl = seq_of(d, 64 * j + l);
  const bf16_t* q = p.Z + (size_t)row_of(b, sl) * NZP + ZC_GQ + h * 32;
  const float qs = 0.17677669529663687f;
  float acc = 0.f;
  for (int t = 0; t <= l; ++t) {
    int st = seq_of(d, 64 * j + t); const bf16_t* z = p.Z + (size_t)row_of(b, st) * NZP;
    float att = 0.f; for (int k = 0; k < 32; ++k) att += bf2f(q[k]) * qs * expf(gc[l * 128 + k] - gc[t * 128 + k]) * bf2f(z[ZC_GK + h * 32 + k]);
    acc += att * bf2f(z[ZC_GV + h * 64 + v]);
  }
  for (int k = 0; k < 32; ++k) acc += bf2f(q[k]) * qs * expf(gc[l * 128 + k]) * p.GS[(size_t)u * 2048 + v * 32 + k];
  p.OD[(((size_t)d * NB + b) * TK + sl) * 256 + h * 64 + v] = acc;
}
DI void nvb_gla_finish(long GI, const Params& p, int layer, int need_ctx) {
  long i = GI; if (i >= (long)R * 4) return;
  int h = (int)(i % 4), r = (int)(i / 4); int b, s; bs_of(r, b, s);
  if (s < TC && !need_ctx) return;
  const float* h0 = p.OD + (((size_t)0 * NB + b) * TK + s) * 256 + h * 64; const float* h1 = p.OD + (((size_t)1 * NB + b) * TK + s) * 256 + h * 64;
  float ss = 0.f; for (int v = 0; v < 64; ++v) { float t = h0[v] + h1[v]; ss += t * t; }
  float rstd = 1.0f / sqrtf(ss / 64 + 1e-6f);
  for (int v = 0; v < 64; ++v) {
    float rr = bf2f(p.Z[(size_t)r * NZP + ZC_GR + h * 64 + v]);
    p.Y[(size_t)r * D + 512 + h * 64 + v] = f2bf(siluf_(rr) * (h0[v] + h1[v]) * rstd * p.g_gla_out[layer * 256 + h * 64 + v]);
  }
}
__global__ void __launch_bounds__(256) nv_merge(Params p, int layer, int nrows) {
  long i = GTID; if (i >= (long)nrows * D) return;
  int j = (int)(i % D), r = (int)(i / D);
  float acc = 0.f;
  for (int n = 0; n < 4; ++n) {
    const bf16_t* wg = p.Wt_gate + (size_t)(n * 1024 + j) * D; const bf16_t* wb = p.Wt_branch + ((size_t)n * D + j) * 256;
    float g = p.b_gate[layer * 4096 + n * 1024 + j], pr = 0.f;
    for (int k = 0; k < D; ++k) g += bf2f(p.H[(size_t)r * D + k]) * bf2f(wg[k]);
    for (int k = 0; k < 256; ++k) pr += bf2f(p.Y[(size_t)r * D + n * 256 + k]) * bf2f(wb[k]);
    acc += sigmoidf_(g) * pr;
  }
  p.MG[(size_t)r * D + j] = f2bf(acc);
}
__global__ void __launch_bounds__(256) nv_resid_mix(Params p, int layer, const float* xl_in, const float* xc_in, int nrows) {
  long r = GTID; if (r >= nrows) return;
  int w = r < RL ? (int)(r / TL) : 2;
  const float* mb = p.mods + (size_t)(layer * 3 + w) * 6144;
  const float* xin = r < RL ? xl_in + (size_t)r * D : xc_in + (size_t)(r - RL) * D;
  float* xo = r < RL ? p.out + (size_t)r * D : p.xc + (size_t)(r - RL) * D;
  const bf16_t* yo = p.YO + (size_t)r * D;
  float ss = 0.f; for (int k = 0; k < D; ++k) { float v = bf2f(yo[k]); ss += v * v; }
  float rstd = 1.0f / sqrtf(ss / D + 1e-6f);
  float s2 = 0.f;
  for (int k = 0; k < D; ++k) { float xn = xin[k] + mb[2 * 1024 + k] * bf2f(yo[k]) * rstd * p.g_mix_post[layer * 1024 + k]; xo[k] = xn; s2 += xn * xn; }
  float rstd2 = 1.0f / sqrtf(s2 / D + 1e-6f);
  float lg[16]; _Pragma("unroll") for (int e = 0; e < 16; ++e) lg[e] = 0.f;
  const float* wr = p.w_router + (size_t)layer * D * 16;
  for (int k = 0; k < D; ++k) {
    float h2 = xo[k] * rstd2 * p.g_ffn_pre[layer * 1024 + k] * (1.f + mb[4 * 1024 + k]) + mb[3 * 1024 + k];
    p.H[(size_t)r * D + k] = f2bf(h2);
    _Pragma("unroll") for (int e = 0; e < 16; ++e) lg[e] += h2 * wr[k * 16 + e];
  }
  float mx = lg[0]; _Pragma("unroll") for (int e = 1; e < 16; ++e) mx = fmaxf(mx, lg[e]);
  float sm = 0.f; _Pragma("unroll") for (int e = 0; e < 16; ++e) { lg[e] = expf(lg[e] - mx); sm += lg[e]; }
  int b, s; bs_of((int)r, b, s);
  _Pragma("unroll") for (int e = 0; e < 16; ++e) p.AFF[((size_t)b * NE + e) * TK + s] = lg[e] / sm;
}
__global__ void __launch_bounds__(256) nv_topk(Params p, int need_ctx) {
  long i = GTID; if (i >= NB * NE * 2) return;
  int seg = (int)(i % 2), e = (int)((i / 2) % NE), b = (int)(i / (2 * NE));
  int s0 = seg ? TC : 0, n = seg ? TL : TC, cap = seg ? CAPL : CAPC, slot0 = seg ? b * CAPL : NB * CAPL + b * CAPC;
  if (seg == 0 && !need_ctx) { for (int q = 0; q < cap; ++q) p.SEL[(size_t)e * NSLOT + slot0 + q] = -1; return; }
  const float* a = p.AFF + ((size_t)b * NE + e) * TK + s0;
  unsigned thr = 0;
  for (int bit = 31; bit >= 0; --bit) {
    unsigned cand = thr | (1u << bit); int cnt = 0;
    for (int t = 0; t < n; ++t) cnt += (f2u(a[t]) >= cand);
    if (cnt >= cap) thr = cand;
  }
  int ngt = 0; for (int t = 0; t < n; ++t) ngt += (f2u(a[t]) > thr);
  int neq = cap - ngt, q = 0;
  for (int t = 0; t < n; ++t) {
    unsigned u = f2u(a[t]); int r = row_of(b, s0 + t); int sel = -1;
    if (u > thr) sel = q++; else if (u == thr && neq > 0) { sel = q++; --neq; }
    if (sel >= 0) { p.SEL[(size_t)e * NSLOT + slot0 + sel] = r; p.SELV[(size_t)e * NSLOT + slot0 + sel] = a[t]; }
    p.INV[(size_t)r * NE + e] = sel >= 0 ? slot0 + sel : -1;
  }
}
__global__ void __launch_bounds__(256) nv_moe1(Params p) {
  long i = GTID; if (i >= (long)NE * NSLOT * FF) return;
  int f = (int)(i % FF), slot = (int)((i / FF) % NSLOT), e = (int)(i / ((long)FF * NSLOT));
  int r = p.SEL[(size_t)e * NSLOT + slot];
  float out = 0.f;
  if (r >= 0) {
    const bf16_t* wg = p.Wt_eg + ((size_t)e * FF + f) * D; const bf16_t* wu = p.Wt_eu + ((size_t)e * FF + f) * D; const bf16_t* h = p.H + (size_t)r * D;
    float g = 0.f, u = 0.f; for (int k = 0; k < D; ++k) { float hv = bf2f(h[k]); g += hv * bf2f(wg[k]); u += hv * bf2f(wu[k]); }
    out = siluf_(g) * u;
  }
  p.HID[((size_t)e * NSLOT + slot) * FF + f] = f2bf(out);
}
__global__ void __launch_bounds__(256) nv_moe2(Params p) {
  long i = GTID; if (i >= (long)NE * NSLOT * D) return;
  int j = (int)(i % D), slot = (int)((i / D) % NSLOT), e = (int)(i / ((long)D * NSLOT));
  int r = p.SEL[(size_t)e * NSLOT + slot];
  float out = 0.f;
  if (r >= 0) {
    const bf16_t* wd = p.Wt_ed + ((size_t)e * D + j) * FF; const bf16_t* h = p.HID + ((size_t)e * NSLOT + slot) * FF;
    float a = 0.f; for (int k = 0; k < FF; ++k) a += bf2f(h[k]) * bf2f(wd[k]);
    out = a * p.SELV[(size_t)e * NSLOT + slot];
  }
  p.YE[((size_t)e * NSLOT + slot) * D + j] = f2bf(out);
}
__global__ void __launch_bounds__(256) nv_resid_ffn(Params p, int layer, int nrows) {
  long r = GTID; if (r >= nrows) return;
  int w = r < RL ? (int)(r / TL) : 2;
  const float* mb = p.mods + (size_t)(layer * 3 + w) * 6144;
  float* xo = r < RL ? p.out + (size_t)r * D : p.xc + (size_t)(r - RL) * D;
  float ss = 0.f;
  for (int k = 0; k < D; ++k) {
    float f = 0.f;
    for (int e = 0; e < NE; ++e) { int sl = p.INV[(size_t)r * NE + e]; if (sl >= 0) f += bf2f(p.YE[((size_t)e * NSLOT + sl) * D + k]); }
    ss += f * f;
  }
  float rstd = 1.0f / sqrtf(ss / D + 1e-6f);
  for (int k = 0; k < D; ++k) {
    float f = 0.f;
    for (int e = 0; e < NE; ++e) { int sl = p.INV[(size_t)r * NE + e]; if (sl >= 0) f += bf2f(p.YE[((size_t)e * NSLOT + sl) * D + k]); }
    xo[k] += mb[5 * 1024 + k] * f * rstd * p.g_ffn_post[layer * 1024 + k];
  }
}

__global__ void __launch_bounds__(256) nv_mods(Params p) { nvb_mods(GTID, p); }
__global__ void __launch_bounds__(256) nv_ml_gates(Params p, int layer) { nvb_ml_gates(GTID, p, layer); }
__global__ void __launch_bounds__(256) nv_gla_cum(Params p, int layer) { nvb_gla_cum(GTID, p, layer); }
__global__ void __launch_bounds__(256) nv_ml_local(Params p) { nvb_ml_local(GTID, p); }
__global__ void __launch_bounds__(256) nv_ml_scan(Params p) { nvb_ml_scan(GTID, p); }
__global__ void __launch_bounds__(256) nv_ml_out(Params p, int need_ctx) { nvb_ml_out(GTID, p, need_ctx); }
__global__ void __launch_bounds__(256) nv_ml_finish(Params p, int layer, int need_ctx) { nvb_ml_finish(GTID, p, layer, need_ctx); }
__global__ void __launch_bounds__(256) nv_gla_local(Params p) { nvb_gla_local(GTID, p); }
__global__ void __launch_bounds__(256) nv_gla_scan(Params p) { nvb_gla_scan(GTID, p); }
__global__ void __launch_bounds__(256) nv_gla_out(Params p, int need_ctx) { nvb_gla_out(GTID, p, need_ctx); }
__global__ void __launch_bounds__(256) nv_gla_finish(Params p, int layer, int need_ctx) { nvb_gla_finish(GTID, p, layer, need_ctx); }
constexpr int LROW = 144;
constexpr int A_BYTES = 128 * LROW;
constexpr int NTHR = 256;
#ifndef ATT_THR
#define ATT_THR 16.0f
#endif

DI int xcd_swz(int u, int nt) { return (nt & 7) ? u : (u & 7) * (nt >> 3) + (u >> 3); }
DI u32x4 ldg16(const void* p) { return *(const u32x4*)p; }
DI void sts16(char* p, u32x4 v) { *(u32x4*)p = v; }
DI bf16x8 lds_frag(const char* p) { return *(const bf16x8*)p; }

template <int WN>
DI void gemm_kloop(f32x4 (&acc)[4][WN], const bf16_t* const (&ap)[4], const bf16_t* const (&bp)[WN], int nk, char* lds) {
  constexpr int STAGE = A_BYTES + 32 * WN * LROW;
  const int t = TIDX, lane = t & 63, wid = t >> 6, wr = wid >> 1, wc = wid & 1;
  const int lr = t >> 3, lcb = (t & 7) * 16;
  const int fr = lane & 15, fq = lane >> 4;
  const int aoff = (wr * 64 + fr) * LROW + fq * 16, boff = A_BYTES + (wc * WN * 16 + fr) * LROW + fq * 16, soff = lr * LROW + lcb;
  u32x4 ra0[4], rb0[WN], ra1[4], rb1[WN];
  auto gload = [&](u32x4 (&ra)[4], u32x4 (&rb)[WN], int kt) {
#pragma unroll
    for (int i = 0; i < 4; ++i) ra[i] = ldg16(ap[i] + kt * 64);
#pragma unroll
    for (int i = 0; i < WN; ++i) rb[i] = ldg16(bp[i] + kt * 64);
  };
  auto sstore = [&](const u32x4 (&ra)[4], const u32x4 (&rb)[WN], char* st) {
#pragma unroll
    for (int i = 0; i < 4; ++i) sts16(st + soff + 32 * i * LROW, ra[i]);
#pragma unroll
    for (int i = 0; i < WN; ++i) sts16(st + A_BYTES + soff + 32 * i * LROW, rb[i]);
  };
  auto compute = [&](const char* cur) {
#pragma unroll
    for (int ks = 0; ks < 2; ++ks) {
      bf16x8 af[4], bfr[WN];
#pragma unroll
      for (int m = 0; m < 4; ++m) af[m] = lds_frag(cur + aoff + m * 16 * LROW + ks * 64);
#pragma unroll
      for (int n = 0; n < WN; ++n) bfr[n] = lds_frag(cur + boff + n * 16 * LROW + ks * 64);
#pragma unroll
      for (int m = 0; m < 4; ++m)
#pragma unroll
        for (int n = 0; n < WN; ++n) acc[m][n] = MFMA16(bfr[n], af[m], acc[m][n]);
    }
  };
  gload(ra0, rb0, 0);
  gload(ra1, rb1, 1);
  sstore(ra0, rb0, lds);
  __syncthreads();
#pragma unroll 1
  for (int kt = 0; kt < nk; kt += 2) {
    if (kt + 2 < nk) gload(ra0, rb0, kt + 2);
    compute(lds);
    sstore(ra1, rb1, lds + STAGE);
    __syncthreads();
    if (kt + 3 < nk) gload(ra1, rb1, kt + 3);
    compute(lds + STAGE);
    if (kt + 2 < nk) sstore(ra0, rb0, lds);
    __syncthreads();
  }
}
template <int WN> DI void acc_zero(f32x4 (&acc)[4][WN]) {
#pragma unroll
  for (int m = 0; m < 4; ++m)
#pragma unroll
    for (int n = 0; n < WN; ++n) acc[m][n] = (f32x4){0.f, 0.f, 0.f, 0.f};
}
DI void st_bf16x4(bf16_t* p, f32x4 v) { u32x2 o; o.x = pack2bf(v.x, v.y); o.y = pack2bf(v.z, v.w); *(u32x2*)p = o; }

template <int WN, class RowOk>
DI void store_wave_tile(const f32x4 (&acc)[4][WN], bf16_t* C, size_t ldc, char* ldsw, int lane, RowOk row_ok) {
  constexpr int PITCH = WN * 32 + 16, CPR = WN * 2;
  const int fr = lane & 15, fq = lane >> 4;
#pragma unroll
  for (int m = 0; m < 4; ++m)
#pragma unroll
    for (int n = 0; n < WN; ++n) { u32x2 o; o.x = pack2bf(acc[m][n][0], acc[m][n][1]); o.y = pack2bf(acc[m][n][2], acc[m][n][3]); *(u32x2*)(ldsw + (m * 16 + fr) * PITCH + n * 32 + fq * 8) = o; }
  WAVE_SYNC();
  constexpr int RPP = 64 / CPR;
#pragma unroll
  for (int ps = 0; ps < 64 / RPP; ++ps) {
    const int r = ps * RPP + lane / CPR, c = lane % CPR;
    const u32x4 v = *(const u32x4*)(ldsw + r * PITCH + c * 16);
    if (row_ok(r)) *(u32x4*)(C + (size_t)r * ldc + c * 8) = v;
  }
  WAVE_SYNC();
}
template <int NOSTORE = 0>
DI void gemm_plain_tile(const bf16_t* A, int lda, const bf16_t* Bt, int ldb, int K, bf16_t* C, int ldc, int tm, int tn, char* lds) {
  const int t = TIDX, lane = t & 63, wid = t >> 6, wr = wid >> 1, wc = wid & 1, lr = t >> 3, lc = (t & 7) * 8, fr = lane & 15, fq = lane >> 4;
  const bf16_t* ap[4]; const bf16_t* bp[4];
#pragma unroll
  for (int i = 0; i < 4; ++i) { ap[i] = A + (size_t)(tm * 128 + lr + 32 * i) * lda + lc; bp[i] = Bt + (size_t)(tn * 128 + lr + 32 * i) * ldb + lc; }
  f32x4 acc[4][4]; acc_zero<4>(acc);
  gemm_kloop<4>(acc, ap, bp, K / 64, lds);
  if (NOSTORE) { float s = 0.f;
#pragma unroll
    for (int m = 0; m < 4; ++m)
#pragma unroll
      for (int n = 0; n < 4; ++n) s += acc[m][n][0] + acc[m][n][3];
    if (s == 123456.789f) C[0] = 1; return; }
  store_wave_tile<4>(acc, C + (size_t)(tm * 128 + wr * 64) * ldc + tn * 128 + wc * 64, (size_t)ldc, lds + wid * (64 * 144), lane, [](int) { return true; });
  __syncthreads();
}
template <int NOSTORE = 0>
DI void ph_gemm_plain(const bf16_t* A, int lda, const bf16_t* Bt, int ldb, int M, int N, int K, bf16_t* C, int ldc, char* lds, int bid, int nblk) {
  const int ntn = N / 128, nt = (M / 128) * ntn;
  for (int u = bid; u < nt; u += nblk) { const int tile = xcd_swz(u, nt); gemm_plain_tile<NOSTORE>(A, lda, Bt, ldb, K, C, ldc, tile / ntn, tile % ntn, lds); }
}
DI void ph_mla_up(const Params& p, int layer, bf16_t* QRAW, bf16_t* KVRAW, char* lds, int bid, int nblk) {
  const int ntq = (R / 128) * 3, ntkv = (R / 128) * 4;
  for (int tile = bid; tile < ntq + ntkv; tile += nblk) {
    if (tile < ntq) gemm_plain_tile(p.Z + ZC_QLAT, NZP, p.Wt_uq + layer * WSZ_UQ, 256, 256, QRAW, 384, tile / 3, tile % 3, lds);
    else { int u = tile - ntq; gemm_plain_tile(p.Z + ZC_KVLAT, NZP, p.Wt_ukv + layer * WSZ_UKV, 128, 128, KVRAW, 512, u / 4, u % 4, lds); }
  }
}
constexpr int LROW32 = 80;
template <int WM, int WN, bool DEEP>
DI void gemm_kloop_g(f32x4 (&acc)[WM][WN], const bf16_t* const (&ap)[WM / 2], const bf16_t* const (&bp)[WN / 2], int nk, char* lds) {
  constexpr int NA = WM / 2, NBB = WN / 2, A_B = 32 * WM * LROW32, STAGE = (32 * WM + 32 * WN) * LROW32;
  const int t = TIDX, lane = t & 63, wid = t >> 6, wr = wid >> 1, wc = wid & 1, fr = lane & 15, fq = lane >> 4;
  const int aoff = (wr * 16 * WM + fr) * LROW32 + fq * 16, boff = A_B + (wc * 16 * WN + fr) * LROW32 + fq * 16, soff = (t >> 2) * LROW32 + (t & 3) * 16;
  u32x4 ra0[NA], rb0[NBB], ra1[NA], rb1[NBB];
  auto gload = [&](u32x4 (&ra)[NA], u32x4 (&rb)[NBB], int kt) {
#pragma unroll
    for (int i = 0; i < NA; ++i) ra[i] = ldg16(ap[i] + kt * 32);
#pragma unroll
    for (int i = 0; i < NBB; ++i) rb[i] = ldg16(bp[i] + kt * 32);
  };
  auto sstore = [&](const u32x4 (&ra)[NA], const u32x4 (&rb)[NBB], char* st) {
#pragma unroll
    for (int i = 0; i < NA; ++i) sts16(st + soff + 64 * i * LROW32, ra[i]);
#pragma unroll
    for (int i = 0; i < NBB; ++i) sts16(st + A_B + soff + 64 * i * LROW32, rb[i]);
  };
  auto compute = [&](const char* cur) {
    bf16x8 af[WM];
#pragma unroll
    for (int m = 0; m < WM; ++m) af[m] = lds_frag(cur + aoff + m * 16 * LROW32);
#pragma unroll
    for (int n = 0; n < WN; ++n) {
      const bf16x8 bfr = lds_frag(cur + boff + n * 16 * LROW32);
#pragma unroll
      for (int m = 0; m < WM; ++m) acc[m][n] = MFMA16(bfr, af[m], acc[m][n]);
    }
  };
  gload(ra0, rb0, 0);
  if (DEEP) gload(ra1, rb1, 1);
  sstore(ra0, rb0, lds);
  __syncthreads();
#pragma unroll 1
  for (int kt = 0; kt < nk; kt += 2) {
    if (DEEP) { if (kt + 2 < nk) gload(ra0, rb0, kt + 2); } else gload(ra1, rb1, kt + 1);
    compute(lds);
    sstore(ra1, rb1, lds + STAGE);
    __syncthreads();
    if (DEEP) { if (kt + 3 < nk) gload(ra1, rb1, kt + 3); } else if (kt + 2 < nk) gload(ra0, rb0, kt + 2);
    compute(lds + STAGE);
    if (kt + 2 < nk) sstore(ra0, rb0, lds);
    __syncthreads();
  }
}
template <int WM, int WN> DI void acc_zero_g(f32x4 (&acc)[WM][WN]) {
#pragma unroll
  for (int m = 0; m < WM; ++m)
#pragma unroll
    for (int n = 0; n < WN; ++n) acc[m][n] = (f32x4){0.f, 0.f, 0.f, 0.f};
}
DI void ph_merge(const Params& p, int layer, int rows, char* lds, int bid, int nblk) {
  const int t = TIDX, lane = t & 63, wid = t >> 6, wr = wid >> 1, wc = wid & 1, fr = lane & 15, fq = lane >> 4;
  const int lr = t >> 2, lc = (t & 3) * 8;
  const int ntn = D / 64, nt = (rows / 128) * ntn;
#pragma unroll 1
  for (int u = bid; u < nt; u += nblk) {
    const int tile = xcd_swz(u, nt), tm = tile / ntn, tn = tile % ntn;
    f32x4 accS[4][2]; acc_zero_g<4, 2>(accS);
#pragma unroll 1
    for (int np = 0; np < 2; ++np) {
      f32x4 accG[4][4]; acc_zero_g<4, 4>(accG);
      {
        const bf16_t* ap[2]; const bf16_t* bp[2];
#pragma unroll
        for (int i = 0; i < 2; ++i) ap[i] = p.H + (size_t)(tm * 128 + lr + 64 * i) * D + lc;
#pragma unroll
        for (int i = 0; i < 2; ++i) { const int rho = lr + 64 * i, wci = rho >> 6, n = 2 * np + ((rho >> 5) & 1), c = rho & 31;
          bp[i] = p.Wt_gate + layer * WSZ_GATE + ((size_t)n * 1024 + tn * 64 + wci * 32 + c) * D + lc; }
        gemm_kloop_g<4, 4, true>(accG, ap, bp, D / 32, lds);
      }
#pragma unroll 1
      for (int q = 0; q < 2; ++q) {
        const int n = 2 * np + q;
        f32x4 accP[4][2]; acc_zero_g<4, 2>(accP);
        const bf16_t* ap[2]; const bf16_t* bp[1];
#pragma unroll
        for (int i = 0; i < 2; ++i) ap[i] = p.Y + (size_t)(tm * 128 + lr + 64 * i) * D + n * 256 + lc;
        bp[0] = p.Wt_branch + layer * WSZ_BR + ((size_t)n * D + tn * 64 + lr) * 256 + lc;
        gemm_kloop_g<4, 2, false>(accP, ap, bp, 8, lds);
#pragma unroll
        for (int nn = 0; nn < 2; ++nn) {
          const f32x4 bv = *(const f32x4*)(p.b_gate + layer * 4096 + n * 1024 + tn * 64 + wc * 32 + nn * 16 + 4 * fq);
#pragma unroll
          for (int m = 0; m < 4; ++m)
#pragma unroll
            for (int j = 0; j < 4; ++j) { const float g = q ? accG[m][2 + nn][j] : accG[m][nn][j]; accS[m][nn][j] += accP[m][nn][j] * fast_rcp(1.0f + fast_exp2(-LOG2E * (g + bv[j]))); }
        }
      }
    }
    store_wave_tile<2>(accS, p.MG + (size_t)(tm * 128 + wr * 64) * D + tn * 64 + wc * 32, (size_t)D, lds + wid * (64 * 80), lane, [](int) { return true; });
    __syncthreads();
  }
}
template <int WM>
DI void gemm_plain_tile_g(const bf16_t* A, int lda, const bf16_t* Bt, int ldb, int K, bf16_t* C, int ldc, int row0, int col0, char* lds) {
  const int t = TIDX, lane = t & 63, wid = t >> 6, wr = wid >> 1, wc = wid & 1, fr = lane & 15, fq = lane >> 4, lr = t >> 2, lc = (t & 3) * 8;
  const bf16_t* ap[WM / 2]; const bf16_t* bp[2];
#pragma unroll
  for (int i = 0; i < WM / 2; ++i) ap[i] = A + (size_t)(row0 + lr + 64 * i) * lda + lc;
#pragma unroll
  for (int i = 0; i < 2; ++i) bp[i] = Bt + (size_t)(col0 + lr + 64 * i) * ldb + lc;
  f32x4 acc[WM][4]; acc_zero_g<WM, 4>(acc);
  gemm_kloop_g<WM, 4, true>(acc, ap, bp, K / 32, lds);
#pragma unroll
  for (int m = 0; m < WM; ++m)
#pragma unroll
    for (int n = 0; n < 4; ++n)
      st_bf16x4(C + (size_t)(row0 + wr * 16 * WM + m * 16 + fr) * ldc + col0 + wc * 64 + n * 16 + 4 * fq, acc[m][n]);
}
DI void ph_gemm_plain2(const bf16_t* A, int lda, const bf16_t* Bt, int ldb, int M, int N, int K, bf16_t* C, int ldc, char* lds, int bid, int nblk) {
  const int ntn = N / 128, nt = (M / 256) * ntn, nfull = (nt / nblk) * nblk;
#pragma unroll 1
  for (int tile = bid; tile < nfull; tile += nblk) gemm_plain_tile_g<8>(A, lda, Bt, ldb, K, C, ldc, (tile / ntn) * 256, (tile % ntn) * 128, lds);
#pragma unroll 1
  for (int h = bid; h < 2 * (nt - nfull); h += nblk) { const int tile = nfull + (h >> 1); gemm_plain_tile_g<4>(A, lda, Bt, ldb, K, C, ldc, (tile / ntn) * 256 + (h & 1) * 128, (tile % ntn) * 128, lds); }
}
DI void gemm_kloop32(f32x16 (&acc)[2][2], const bf16_t* const (&ap)[4], const bf16_t* const (&bp)[4], int nk, char* lds) {
  constexpr int STAGE = A_BYTES + 128 * LROW;
  const int t = TIDX, lane = t & 63, wid = t >> 6, wr = wid >> 1, wc = wid & 1, l31 = lane & 31, hh = lane >> 5;
  const int aoff = (wr * 64 + l31) * LROW + hh * 16, boff = A_BYTES + (wc * 64 + l31) * LROW + hh * 16, soff = (t >> 3) * LROW + (t & 7) * 16;
  u32x4 ra0[4], rb0[4], ra1[4], rb1[4];
  auto gload = [&](u32x4 (&ra)[4], u32x4 (&rb)[4], int kt) {
#pragma unroll
    for (int i = 0; i < 4; ++i) { ra[i] = ldg16(ap[i] + kt * 64); rb[i] = ldg16(bp[i] + kt * 64); }
  };
  auto sstore = [&](const u32x4 (&ra)[4], const u32x4 (&rb)[4], char* st) {
#pragma unroll
    for (int i = 0; i < 4; ++i) { sts16(st + soff + 32 * i * LROW, ra[i]); sts16(st + A_BYTES + soff + 32 * i * LROW, rb[i]); }
  };
  auto compute = [&](const char* cur) {
#pragma unroll
    for (int ks = 0; ks < 4; ++ks) {
      bf16x8 af[2], bfr[2];
#pragma unroll
      for (int m = 0; m < 2; ++m) af[m] = lds_frag(cur + aoff + m * 32 * LROW + ks * 32);
#pragma unroll
      for (int n = 0; n < 2; ++n) bfr[n] = lds_frag(cur + boff + n * 32 * LROW + ks * 32);
#pragma unroll
      for (int m = 0; m < 2; ++m)
#pragma unroll
        for (int n = 0; n < 2; ++n) acc[m][n] = MFMA32(bfr[n], af[m], acc[m][n]);
    }
  };
  gload(ra0, rb0, 0); gload(ra1, rb1, 1);
  sstore(ra0, rb0, lds);
  __syncthreads();
#pragma unroll 1
  for (int kt = 0; kt < nk; kt += 2) {
    if (kt + 2 < nk) gload(ra0, rb0, kt + 2);
    compute(lds);
    sstore(ra1, rb1, lds + STAGE);
    __syncthreads();
    if (kt + 3 < nk) gload(ra1, rb1, kt + 3);
    compute(lds + STAGE);
    if (kt + 2 < nk) sstore(ra0, rb0, lds);
    __syncthreads();
  }
}
DI void ph_gemm_plain32(const bf16_t* A, int lda, const bf16_t* Bt, int ldb, int M, int N, int K, bf16_t* C, int ldc, char* lds, int bid, int nblk) {
  const int t = TIDX, lane = t & 63, wid = t >> 6, wr = wid >> 1, wc = wid & 1, lr = t >> 3, lc = (t & 7) * 8, l31 = lane & 31, hh = lane >> 5;
  const int ntn = N / 128, nt = (M / 128) * ntn;
#pragma unroll 1
  for (int tile = bid; tile < nt; tile += nblk) {
    const int tm = tile / ntn, tn = tile % ntn;
    const bf16_t* ap[4]; const bf16_t* bp[4];
#pragma unroll
    for (int i = 0; i < 4; ++i) { ap[i] = A + (size_t)(tm * 128 + lr + 32 * i) * lda + lc; bp[i] = Bt + (size_t)(tn * 128 + lr + 32 * i) * ldb + lc; }
    f32x16 acc[2][2];
#pragma unroll
    for (int m = 0; m < 2; ++m)
#pragma unroll
      for (int n = 0; n < 2; ++n) acc[m][n] = (f32x16)(0.f);
    gemm_kloop32(acc, ap, bp, K / 64, lds);
#pragma unroll
    for (int m = 0; m < 2; ++m)
#pragma unroll
      for (int n = 0; n < 2; ++n)
#pragma unroll
        for (int g = 0; g < 4; ++g) {
          f32x4 o = {acc[m][n][4 * g], acc[m][n][4 * g + 1], acc[m][n][4 * g + 2], acc[m][n][4 * g + 3]};
          st_bf16x4(C + (size_t)(tm * 128 + wr * 64 + m * 32 + l31) * ldc + tn * 128 + wc * 64 + n * 32 + 8 * g + 4 * hh, o);
        }
  }
}
template <int MODE>
DI void ph_gemm_probe(const bf16_t* A, int lda, const bf16_t* Bt, int ldb, int M, int N, int K, float* sink, char* lds, int bid, int nblk) {
  const int t = TIDX, lane = t & 63, wid = t >> 6, wr = wid >> 1, wc = wid & 1, lr = t >> 3, lc = (t & 7) * 8, fr = lane & 15, fq = lane >> 4;
  const int ntn = N / 128, nt = (M / 128) * ntn, nk = K / 64;
  constexpr int STAGE = A_BYTES + 128 * LROW;
  const int aoff = (wr * 64 + fr) * LROW + fq * 16, boff = A_BYTES + (wc * 64 + fr) * LROW + fq * 16;
#pragma unroll 1
  for (int tile = bid; tile < nt; tile += nblk) {
    f32x4 acc[4][4]; acc_zero<4>(acc);
    bf16x8 af[4], bfr[4];
    const int tm = tile / ntn, tn = tile % ntn;
    const bf16_t* ap[4]; const bf16_t* bp[4];
#pragma unroll
    for (int i = 0; i < 4; ++i) { ap[i] = A + (size_t)(tm * 128 + lr + 32 * i) * lda + lc; bp[i] = Bt + (size_t)(tn * 128 + lr + 32 * i) * ldb + lc; }
    u32x4 ra[4], rb[4], junk = {0u, 0u, 0u, 0u};
#pragma unroll
    for (int i = 0; i < 4; ++i) { ra[i] = junk; rb[i] = junk; }
#pragma unroll 1
    for (int kt = 0; kt < nk; ++kt) {
      const char* cur = lds + (kt & 1) * STAGE;
#pragma unroll
      for (int i = 0; i < 4; ++i) { ra[i] = ldg16(ap[i] + kt * 64); if (MODE == 3) rb[i] = ldg16(bp[i] + kt * 64); }
#pragma unroll
      for (int ks = 0; ks < 2; ++ks) {
#pragma unroll
        for (int m = 0; m < 4; ++m) { af[m] = lds_frag(cur + aoff + m * 16 * LROW + ks * 64); bfr[m] = lds_frag(cur + boff + m * 16 * LROW + ks * 64); }
#pragma unroll
        for (int m = 0; m < 4; ++m)
#pragma unroll
          for (int n = 0; n < 4; ++n) acc[m][n] = MFMA16(bfr[n], af[m], acc[m][n]);
      }
      junk.x ^= ra[0].x ^ ra[1].y ^ ra[2].z ^ ra[3].w ^ rb[0].x ^ rb[1].y ^ rb[2].z ^ rb[3].w;
      __syncthreads();
    }
    float s = (float)(junk.x & 1u);
#pragma unroll
    for (int m = 0; m < 4; ++m)
#pragma unroll
      for (int n = 0; n < 4; ++n) s += acc[m][n][0] + acc[m][n][3];
    if (s == 123456.789f) sink[0] = s;
  }
}
DI void ph_moe1(const Params& p, int need_ctx, char* lds, int bid, int nblk) {
  const int t = TIDX, lane = t & 63, wid = t >> 6, wr = wid >> 1, wc = wid & 1, lr = t >> 3, lc = (t & 7) * 8, fr = lane & 15, fq = lane >> 4;
  constexpr int NTN = FF / 64;
  const int NTM = need_ctx ? (NSLOT + 127) / 128 : (NB * CAPL) / 128;
  for (int u = bid; u < NE * NTM * NTN; u += nblk) {
    const int tile = xcd_swz(u, NE * NTM * NTN), e = tile / (NTM * NTN), rem = tile % (NTM * NTN), tm = rem / NTN, tn = rem % NTN;
    const bf16_t* ap[4]; const bf16_t* bp[4];
#pragma unroll
    for (int i = 0; i < 4; ++i) {
      const int slot = tm * 128 + lr + 32 * i;
      int r = slot < NSLOT ? p.SEL[(size_t)e * NSLOT + slot] : -1;
      ap[i] = p.H + (size_t)(r < 0 ? 0 : r) * D + lc;
      const int rho = lr + 32 * i, wci = rho >> 6, gu = (rho >> 5) & 1, col = wci * 32 + (rho & 31);
      bp[i] = (gu ? p.Wt_eu : p.Wt_eg) + ((size_t)e * FF + tn * 64 + col) * D + lc;
    }
    f32x4 acc[4][4]; acc_zero<4>(acc);
    gemm_kloop<4>(acc, ap, bp, D / 64, lds);
    f32x4 hid[4][2];
#pragma unroll
    for (int m = 0; m < 4; ++m) {
      const int slot = tm * 128 + wr * 64 + m * 16 + fr;
      const bool valid = slot < NSLOT && p.SEL[(size_t)e * NSLOT + (slot < NSLOT ? slot : 0)] >= 0;
#pragma unroll
      for (int n = 0; n < 2; ++n)
#pragma unroll
        for (int j = 0; j < 4; ++j) { const float g = acc[m][n][j], u = acc[m][n + 2][j]; hid[m][n][j] = valid ? g * u * fast_rcp(1.0f + fast_exp2(-LOG2E * g)) : 0.f; }
    }
    const int slot0 = tm * 128 + wr * 64;
    store_wave_tile<2>(hid, p.HID + ((size_t)e * NSLOT + slot0) * FF + tn * 64 + wc * 32, (size_t)FF, lds + wid * (64 * 80), lane, [&](int r) { return slot0 + r < NSLOT; });
    __syncthreads();
  }
}
DI void ph_moe2(const Params& p, int need_ctx, char* lds, int bid, int nblk) {
  const int t = TIDX, lane = t & 63, wid = t >> 6, wr = wid >> 1, wc = wid & 1, lr = t >> 3, lc = (t & 7) * 8, fr = lane & 15, fq = lane >> 4;
  constexpr int NTN = D / 128;
  const int NTM = need_ctx ? (NSLOT + 127) / 128 : (NB * CAPL) / 128;
  for (int u = bid; u < NE * NTM * NTN; u += nblk) {
    const int tile = xcd_swz(u, NE * NTM * NTN), e = tile / (NTM * NTN), rem = tile % (NTM * NTN), tm = rem / NTN, tn = rem % NTN;
    const bf16_t* ap[4]; const bf16_t* bp[4];
#pragma unroll
    for (int i = 0; i < 4; ++i) {
      int slot = tm * 128 + lr + 32 * i; if (slot >= NSLOT) slot = NSLOT - 1;
      ap[i] = p.HID + ((size_t)e * NSLOT + slot) * FF + lc;
      bp[i] = p.Wt_ed + ((size_t)e * D + tn * 128 + lr + 32 * i) * FF + lc;
    }
    f32x4 acc[4][4]; acc_zero<4>(acc);
    gemm_kloop<4>(acc, ap, bp, FF / 64, lds);
#pragma unroll
    for (int m = 0; m < 4; ++m) {
      const int slot = tm * 128 + wr * 64 + m * 16 + fr;
      const float val = (slot < NSLOT && p.SEL[(size_t)e * NSLOT + (slot < NSLOT ? slot : 0)] >= 0) ? p.SELV[(size_t)e * NSLOT + slot] : 0.f;
#pragma unroll
      for (int n = 0; n < 4; ++n) { acc[m][n].x *= val; acc[m][n].y *= val; acc[m][n].z *= val; acc[m][n].w *= val; }
    }
    const int slot0 = tm * 128 + wr * 64;
    store_wave_tile<4>(acc, p.YE + ((size_t)e * NSLOT + slot0) * D + tn * 128 + wc * 64, (size_t)D, lds + wid * (64 * 144), lane, [&](int r) { return slot0 + r < NSLOT; });
    __syncthreads();
  }
}
constexpr int GEMM_LDS = 2 * (A_BYTES + 128 * LROW);

DI void unpack8(u32x4 v, float (&f)[8]) {
  f[0] = u2f(v.x << 16); f[1] = u2f(v.x & 0xffff0000u); f[2] = u2f(v.y << 16); f[3] = u2f(v.y & 0xffff0000u);
  f[4] = u2f(v.z << 16); f[5] = u2f(v.z & 0xffff0000u); f[6] = u2f(v.w << 16); f[7] = u2f(v.w & 0xffff0000u);
}
DI u32x4 pack8f(const float (&f)[8]) { u32x4 v; v.x = pack2bf(f[0], f[1]); v.y = pack2bf(f[2], f[3]); v.z = pack2bf(f[4], f[5]); v.w = pack2bf(f[6], f[7]); return v; }
DI void rope8(float (&a)[8], const float (&pr)[8], int cc, const float* cs, const float* sn) {
  const int ax = (cc >> 1) * 8; const bool second = cc & 1;
#pragma unroll
  for (int i = 0; i < 8; ++i) a[i] = second ? a[i] * cs[ax + i] + pr[i] * sn[ax + i] : a[i] * cs[ax + i] - pr[i] * sn[ax + i];
}
constexpr int PREP_LDS = 64 * 4 + 2 * 512 * 4 + 32 * 528;
template <int PARTS = 3>
DI void ph_prep(const Params& p, int layer, const bf16_t* QRAW, const bf16_t* KVRAW, char* lds, int bid, int nblk) {
  float* s_rstd = (float*)lds;
  float* s_cs = s_rstd + 64;
  float* s_sn = s_cs + 512;
  bf16_t* s_t = (bf16_t*)(s_sn + 512);
  const int t = TIDX;
  constexpr int UPB = TK / 32, NU = NB * UPB;
  const float* wcv = p.w_conv + (size_t)layer * 3 * 512;
#pragma unroll 1
  for (int u = bid; u < NU; u += nblk) {
    int b, s0;
    if (u < NB * (TL / 32)) { b = u / (TL / 32); s0 = TC + (u % (TL / 32)) * 32; } else { const int v = u - NB * (TL / 32); b = v / (TC / 32); s0 = (v % (TC / 32)) * 32; }
    const int r0 = row_of(b, s0);
    {
      const int tok = t >> 3, part = t & 7;
      const bf16_t* z = p.Z + (size_t)(r0 + tok) * NZP;
      float sq = 0.f, sk = 0.f, f[8];
#pragma unroll
      for (int k = 0; k < 4; ++k) { unpack8(ldg16(z + ZC_QLAT + part * 32 + k * 8), f);
#pragma unroll
        for (int i = 0; i < 8; ++i) sq += f[i] * f[i]; }
#pragma unroll
      for (int k = 0; k < 2; ++k) { unpack8(ldg16(z + ZC_KVLAT + part * 16 + k * 8), f);
#pragma unroll
        for (int i = 0; i < 8; ++i) sk += f[i] * f[i]; }
      sq = xor_sum<1>(sq); sk = xor_sum<1>(sk);
      sq = xor_sum<2>(sq); sk = xor_sum<2>(sk);
      sq = xor_sum<4>(sq); sk = xor_sum<4>(sk);
      if (part == 0) { s_rstd[tok * 2] = 1.0f / sqrtf(sq * (1.0f / 256) + 1e-6f); s_rstd[tok * 2 + 1] = 1.0f / sqrtf(sk * (1.0f / 128) + 1e-6f); }
    }
    for (int i = t; i < 512; i += NTHR) {
      const int tok = i >> 4, af = i & 15, s = s0 + tok;
      float cs = 1.f, sn = 0.f;
      if (s >= TC) rope_cs(s, (af >> 3) * 16 + (af & 7), cs, sn);
      s_cs[i] = cs; s_sn[i] = sn;
    }
    __syncthreads();
    if (PARTS & 1) {
#pragma unroll 2
    for (int i = t; i < 32 * 48; i += NTHR) {
      const int tok = i / 48, c = i % 48, h = c / 12, ch = c % 12;
      const float rq = s_rstd[tok * 2] * QS_MLA, rkv = s_rstd[tok * 2 + 1];
      const bf16_t* q = QRAW + (size_t)(r0 + tok) * 384 + h * 96;
      float a[8], pr[8];
      unpack8(ldg16(q + ch * 8), a);
      if (ch >= 8) { unpack8(ldg16(q + 64 + ((ch - 8) ^ 1) * 8), pr); rope8(a, pr, ch - 8, s_cs + tok * 16, s_sn + tok * 16); }
#pragma unroll
      for (int e = 0; e < 8; ++e) a[e] *= rq;
      *(u32x4*)(p.Qm + (((size_t)b * 4 + h) * TK + s0 + tok) * 96 + ch * 8) = pack8f(a);
      if (ch < 8) {
        unpack8(ldg16(KVRAW + (size_t)(r0 + tok) * 512 + h * 128 + ch * 8), a);
#pragma unroll
        for (int e = 0; e < 8; ++e) a[e] *= rkv;
      } else {
        const bf16_t* z = p.Z + (size_t)(r0 + tok) * NZP + ZC_KROPE;
        unpack8(ldg16(z + (ch - 8) * 8), a); unpack8(ldg16(z + ((ch - 8) ^ 1) * 8), pr);
        rope8(a, pr, ch - 8, s_cs + tok * 16, s_sn + tok * 16);
      }
      *(u32x4*)(p.Km + (((size_t)b * 4 + h) * TK + s0 + tok) * 96 + ch * 8) = pack8f(a);
    }
#pragma unroll 2
    for (int i = t; i < 32 * 64; i += NTHR) {
      const int tok = i >> 6, c = i & 63, qk = c >> 5, hm = (c >> 2) & 7, cc = c & 3;
      const bf16_t* src = p.Z + (size_t)(r0 + tok) * NZP + (qk ? ZC_DK : ZC_DQ) + hm * 32;
      float a[8], pr[8];
      unpack8(ldg16(src + cc * 8), a); unpack8(ldg16(src + (cc ^ 1) * 8), pr);
      rope8(a, pr, cc, s_cs + tok * 16, s_sn + tok * 16);
      if (qk == 0) {
#pragma unroll
        for (int e = 0; e < 8; ++e) a[e] *= QS_DIFF;
        *(u32x4*)(p.Qd + (((size_t)b * 8 + hm) * TK + s0 + tok) * 32 + cc * 8) = pack8f(a);
      } else *(u32x4*)(p.Kd + (((size_t)b * 8 + hm) * TK + s0 + tok) * 32 + cc * 8) = pack8f(a);
    }
#pragma unroll 2
    for (int i = t; i < 32 * 64; i += NTHR) {
      const int tok = i >> 6, c8 = (i & 63) * 8, s = s0 + tok;
      const bool first = (s == 0) || (s == TC), last = (s == TC - 1) || (s == TK - 1);
      const bf16_t* z = p.Z + (size_t)(r0 + tok) * NZP + ZC_MLQK + c8;
      float x0[8], xm[8], xp[8], o[8];
      unpack8(ldg16(z), x0);
      if (!first) unpack8(ldg16(z - NZP), xm);
      if (!last) unpack8(ldg16(z + NZP), xp);
      float bc8[8], w0[8], w1[8], w2[8];
      *(f32x4*)bc8 = *(const f32x4*)(p.b_conv + layer * 512 + c8); *(f32x4*)(bc8 + 4) = *(const f32x4*)(p.b_conv + layer * 512 + c8 + 4);
      *(f32x4*)w0 = *(const f32x4*)(wcv + c8); *(f32x4*)(w0 + 4) = *(const f32x4*)(wcv + c8 + 4);
      *(f32x4*)w1 = *(const f32x4*)(wcv + 512 + c8); *(f32x4*)(w1 + 4) = *(const f32x4*)(wcv + 512 + c8 + 4);
      *(f32x4*)w2 = *(const f32x4*)(wcv + 1024 + c8); *(f32x4*)(w2 + 4) = *(const f32x4*)(wcv + 1024 + c8 + 4);
#pragma unroll
      for (int e = 0; e < 8; ++e) {
        float acc = bc8[e] + x0[e] * w1[e];
        if (!first) acc += xm[e] * w0[e];
        if (!last) acc += xp[e] * w2[e];
        o[e] = acc * fast_rcp(1.0f + fast_exp2(-LOG2E * acc));
      }
      if (c8 < 256) *(u32x4*)(p.MQ + ((size_t)b * TK + s) * 256 + c8) = pack8f(o);
      else {
#pragma unroll
        for (int e = 0; e < 8; ++e) o[e] *= 0.125f;
        *(u32x4*)(p.MK + ((size_t)b * TK + s) * 256 + c8 - 256) = pack8f(o);
      }
    }
    }
#pragma unroll 1
    for (int w = 0; w < ((PARTS & 2) ? 4 : 0); ++w) {
      __syncthreads();
#pragma unroll
      for (int k = 0; k < 4; ++k) {
        const int i = t + k * NTHR, tok = i >> 5, c8 = (i & 31) * 8;
        u32x4 v;
        if (w == 0) { float a[8]; const int h = c8 >> 6; unpack8(ldg16(KVRAW + (size_t)(r0 + tok) * 512 + h * 128 + 64 + (c8 & 63)), a); const float rkv = s_rstd[tok * 2 + 1];
#pragma unroll
          for (int e = 0; e < 8; ++e) a[e] *= rkv;
          v = pack8f(a); }
        else v = ldg16(p.Z + (size_t)(r0 + tok) * NZP + (w == 1 ? ZC_DV : (w == 2 ? ZC_MLV : ZC_GV)) + c8);
        *(u32x4*)(s_t + tok * 264 + c8) = v;
      }
      __syncthreads();
      bf16_t* dst = w == 0 ? p.Vtm : (w == 1 ? p.Vtd : (w == 2 ? p.MVt : p.GVt));
#pragma unroll
      for (int k = 0; k < 4; ++k) {
        const int i = t + k * NTHR, tg = i & 3, ch = i >> 2;
        u32x4 v;
        v.x = (unsigned)s_t[(tg * 8 + 0) * 264 + ch] | ((unsigned)s_t[(tg * 8 + 1) * 264 + ch] << 16);
        v.y = (unsigned)s_t[(tg * 8 + 2) * 264 + ch] | ((unsigned)s_t[(tg * 8 + 3) * 264 + ch] << 16);
        v.z = (unsigned)s_t[(tg * 8 + 4) * 264 + ch] | ((unsigned)s_t[(tg * 8 + 5) * 264 + ch] << 16);
        v.w = (unsigned)s_t[(tg * 8 + 6) * 264 + ch] | ((unsigned)s_t[(tg * 8 + 7) * 264 + ch] << 16);
        *(u32x4*)(dst + (((size_t)b * 4 + (ch >> 6)) * 64 + (ch & 63)) * TK + s0 + tg * 8) = v;
      }
    }
    __syncthreads();
  }
}
constexpr int VROW = 136;
constexpr int VROW_A = 144;
template <int DQK> struct AttnCfg {
  static constexpr int KROW = DQK * 2 + 16;
  static constexpr int KBYTES = 64 * KROW, VBYTES = 64 * VROW_A, STAGE = KBYTES + VBYTES;
  static constexpr int KCH = 64 * DQK * 2 / 16 / NTHR;
};
DI bf16x8 pack8(const f32x16& x, int s) {
  u32x4 pk; pk.x = pack2bf(x[8 * s], x[8 * s + 1]); pk.y = pack2bf(x[8 * s + 2], x[8 * s + 3]); pk.z = pack2bf(x[8 * s + 4], x[8 * s + 5]); pk.w = pack2bf(x[8 * s + 6], x[8 * s + 7]);
  return __builtin_bit_cast(bf16x8, pk);
}
template <int DQK, int NMAP, int VAR = 0>
DI void attn_unit(const bf16_t* __restrict__ Qb, const bf16_t* __restrict__ Kb, size_t mstride, const bf16_t* __restrict__ Vt, int q0, int nkeys,
                  f32x16 (&O)[NMAP][2], float (&lsum)[NMAP], char* lds) {
  constexpr int DM = DQK / NMAP;
  constexpr int KS = DM / 16;
  using C = AttnCfg<DQK>;
  constexpr int CPM = 64 * DM * 2 / 16;
  constexpr int CPR = DM * 2 / 16;
  const int t = TIDX, lane = t & 63, wid = t >> 6, l31 = lane & 31, hh = lane >> 5;
  bf16x8 qf[NMAP][KS];
#pragma unroll
  for (int m = 0; m < NMAP; ++m)
#pragma unroll
    for (int ks = 0; ks < KS; ++ks) qf[m][ks] = *(const bf16x8*)(Qb + m * mstride + (size_t)(q0 + wid * 32 + l31) * DM + ks * 16 + 8 * hh);
  float mref[NMAP];
#pragma unroll
  for (int m = 0; m < NMAP; ++m) { mref[m] = 0.f; lsum[m] = 0.f; O[m][0] = (f32x16)(0.f); O[m][1] = (f32x16)(0.f); }
  u32x4 rk[C::KCH], rv[2];
  const bf16_t* kg[C::KCH]; int klds[C::KCH];
#pragma unroll
  for (int i = 0; i < C::KCH; ++i) { const int c = t + i * NTHR, m = c / CPM, cc = c % CPM; kg[i] = Kb + m * mstride + cc * 8; klds[i] = (cc / CPR) * C::KROW + m * DM * 2 + (cc % CPR) * 16; }
  const bf16_t* vg = Vt + (size_t)(t >> 3) * TK + (t & 7) * 8;
  const int vlds = C::KBYTES + (t >> 3) * VROW_A + ((t & 7) >> 1) * 32 + ((t & 1) ? 8 : 0);
  const int kfoff = l31 * C::KROW + 16 * hh, vfoff = C::KBYTES + l31 * VROW_A + 16 * hh;
  const int nt = nkeys / 64;
#pragma unroll
  for (int i = 0; i < C::KCH; ++i) rk[i] = ldg16(kg[i]);
  rv[0] = ldg16(vg); rv[1] = ldg16(vg + (size_t)32 * TK);
#pragma unroll 1
  for (int kt = 0; kt < nt; ++kt) {
    char* cur = lds + (kt & 1) * C::STAGE;
    if (VAR != 2) {
#pragma unroll
    for (int i = 0; i < C::KCH; ++i) sts16(cur + klds[i], rk[i]);
#pragma unroll
    for (int i = 0; i < 2; ++i) { char* d = cur + vlds + i * 32 * VROW_A; u32x2 lo, hi; lo.x = rv[i].x; lo.y = rv[i].y; hi.x = rv[i].z; hi.y = rv[i].w; *(u32x2*)d = lo; *(u32x2*)(d + 16) = hi; }
    __syncthreads();
    }
    if (VAR != 2 && kt + 1 < nt) {
#pragma unroll
      for (int i = 0; i < C::KCH; ++i) rk[i] = ldg16(kg[i] + (size_t)(kt + 1) * 64 * DM);
      rv[0] = ldg16(vg + (kt + 1) * 64); rv[1] = ldg16(vg + (size_t)32 * TK + (kt + 1) * 64);
    }
    bf16x8 kf[NMAP][2][KS];
#pragma unroll
    for (int k2 = 0; k2 < 2; ++k2)
#pragma unroll
      for (int ks = 0; ks < KS; ++ks) kf[0][k2][ks] = lds_frag(cur + kfoff + k2 * 32 * C::KROW + ks * 32);
    f32x16 S[NMAP][2];
    S[0][0] = (f32x16)(0.f); S[0][1] = (f32x16)(0.f);
#pragma unroll
    for (int ks = 0; ks < KS; ++ks)
#pragma unroll
      for (int k2 = 0; k2 < 2; ++k2) S[0][k2] = MFMA32(kf[0][k2][ks], qf[0][ks], S[0][k2]);
    bf16x8 vf[4][2];
#pragma unroll
    for (int kst = 0; kst < 4; ++kst)
#pragma unroll
      for (int dvt = 0; dvt < 2; ++dvt) vf[kst][dvt] = lds_frag(cur + vfoff + dvt * 32 * VROW_A + kst * 32);
#pragma unroll
    for (int m = 1; m < NMAP; ++m)
#pragma unroll
      for (int k2 = 0; k2 < 2; ++k2)
#pragma unroll
        for (int ks = 0; ks < KS; ++ks) kf[m][k2][ks] = lds_frag(cur + kfoff + k2 * 32 * C::KROW + m * DM * 2 + ks * 32);
#pragma unroll
    for (int m = 0; m < NMAP; ++m) {
      if (m > 0) {
        S[m][0] = (f32x16)(0.f); S[m][1] = (f32x16)(0.f);
#pragma unroll
        for (int ks = 0; ks < KS; ++ks)
#pragma unroll
          for (int k2 = 0; k2 < 2; ++k2) S[m][k2] = MFMA32(kf[m][k2][ks], qf[m][ks], S[m][k2]);
      }
      if (VAR != 1) {
      if ((kt & 7) == 0) {
        float mx = fmaxf(S[m][0][0], S[m][1][0]);
#pragma unroll
        for (int i = 1; i < 16; ++i) mx = fmaxf(mx, fmaxf(S[m][0][i], S[m][1][i]));
        mx = xor_max<32>(mx);
        const float rel = mx - mref[m];
        const float delta = (kt == 0) ? ((mx > ATT_THR || mx < -ATT_THR) ? mx : 0.0f) : (rel > ATT_THR ? rel : 0.0f);
        if (wave_any(delta != 0.0f)) {
          const float alpha = fast_exp2(-delta);
          mref[m] += delta; lsum[m] *= alpha;
#pragma unroll
          for (int dvt = 0; dvt < 2; ++dvt)
#pragma unroll
            for (int i = 0; i < 16; ++i) O[m][dvt][i] *= alpha;
        }
      }
      if (wave_any(mref[m] != 0.0f)) {
        const f32x2 nm = {-mref[m], -mref[m]};
#pragma unroll
        for (int k2 = 0; k2 < 2; ++k2)
#pragma unroll
          for (int i = 0; i < 16; i += 2) { const f32x2 x = (f32x2){S[m][k2][i], S[m][k2][i + 1]} + nm; S[m][k2][i] = x.x; S[m][k2][i + 1] = x.y; }
      }
      f32x2 ps2 = {0.f, 0.f};
#pragma unroll
      for (int k2 = 0; k2 < 2; ++k2)
#pragma unroll
        for (int i = 0; i < 16; i += 2) {
          const float e0 = fast_exp2(S[m][k2][i]), e1 = fast_exp2(S[m][k2][i + 1]);
          S[m][k2][i] = e0; S[m][k2][i + 1] = e1; ps2 += (f32x2){e0, e1};
        }
      lsum[m] += ps2.x + ps2.y;
      } else lsum[m] += 1.0f;
#pragma unroll
      for (int kst = 0; kst < 4; ++kst) {
        const bf16x8 pf = pack8(S[m][kst >> 1], kst & 1);
#pragma unroll
        for (int dvt = 0; dvt < 2; ++dvt) O[m][dvt] = MFMA32(vf[kst][dvt], pf, O[m][dvt]);
      }
    }
  }
  __syncthreads();
#pragma unroll
  for (int m = 0; m < NMAP; ++m) lsum[m] = xor_sum<32>(lsum[m]);
}
constexpr int ATT_QB = TK / 128;
constexpr int ATT_LDS = 2 * AttnCfg<96>::STAGE;
constexpr int ATT_QBL = TL / 128, ATT_QBC = TC / 128, ATT_LAT_UNITS = NB * 4 * ATT_QBL, ATT_UNITS = ATT_LAT_UNITS + NB * 4 * ATT_QBC;
DI void att_unit(int u, int& bh, int& qb) {
  if (u < ATT_LAT_UNITS) { bh = u & 7; qb = ATT_QBC + (u >> 3); } else { const int v = u - ATT_LAT_UNITS; bh = v & 7; qb = v >> 3; }
}
DI void ph_attn_diff(const Params& p, int layer, int need_ctx, char* lds, int bid, int nblk) {
  const int lane = TIDX & 63, wid = TIDX >> 6, l31 = lane & 31, hh = lane >> 5;
  float lam_init; const float lam = lam_of(p, layer, lam_init);
#pragma unroll 1
  for (int u = bid; u < (need_ctx ? ATT_UNITS : ATT_LAT_UNITS); u += nblk) {
    int bh, qb; att_unit(u, bh, qb);
    const int b = bh >> 2, h = bh & 3, q0 = qb * 128;
    const int r = row_of(b, q0 + wid * 32 + l31);
    f32x16 O[2][2]; float ls[2];
    attn_unit<64, 2>(p.Qd + ((size_t)b * 8 + h * 2) * TK * 32, p.Kd + ((size_t)b * 8 + h * 2) * TK * 32, (size_t)TK * 32, p.Vtd + ((size_t)b * 4 + h) * 64 * TK, q0,
                     q0 < TC ? TC : TK, O, ls, lds);
    const float i0 = 1.0f / ls[0], i1 = lam / ls[1];
    float ss = 0.f;
#pragma unroll
    for (int dvt = 0; dvt < 2; ++dvt)
#pragma unroll
      for (int i = 0; i < 16; ++i) { const float o = O[0][dvt][i] * i0 - O[1][dvt][i] * i1; O[0][dvt][i] = o; ss += o * o; }
    ss = xor_sum<32>(ss);
    const float rstd = (1.0f - lam_init) / sqrtf(ss * (1.0f / 64) + 1e-6f);
    const float* gd = p.g_diff_out + layer * 256 + h * 64;
#pragma unroll
    for (int dvt = 0; dvt < 2; ++dvt)
#pragma unroll
      for (int g = 0; g < 4; ++g) {
        const int dv = dvt * 32 + 8 * g + 4 * hh;
        const f32x4 gv = *(const f32x4*)(gd + dv);
        f32x4 o = {O[0][dvt][4 * g] * rstd * gv[0], O[0][dvt][4 * g + 1] * rstd * gv[1], O[0][dvt][4 * g + 2] * rstd * gv[2], O[0][dvt][4 * g + 3] * rstd * gv[3]};
        st_bf16x4(p.Y + (size_t)r * D + 768 + h * 64 + dv, o);
      }
  }
}
DI void ph_attn_mla(const Params& p, int need_ctx, char* lds, int bid, int nblk) {
  const int lane = TIDX & 63, wid = TIDX >> 6, l31 = lane & 31, hh = lane >> 5;
#pragma unroll 1
  for (int u = bid; u < (need_ctx ? ATT_UNITS : ATT_LAT_UNITS); u += nblk) {
    int bh, qb; att_unit(u, bh, qb);
    const int b = bh >> 2, h = bh & 3, q0 = qb * 128;
    const int r = row_of(b, q0 + wid * 32 + l31);
    f32x16 O[1][2]; float ls[1];
    attn_unit<96, 1>(p.Qm + ((size_t)b * 4 + h) * TK * 96, p.Km + ((size_t)b * 4 + h) * TK * 96, 0, p.Vtm + ((size_t)b * 4 + h) * 64 * TK, q0, q0 < TC ? TC : TK, O, ls, lds);
    const float inv = 1.0f / ls[0];
#pragma unroll
    for (int dvt = 0; dvt < 2; ++dvt)
#pragma unroll
      for (int g = 0; g < 4; ++g) {
        f32x4 o = {O[0][dvt][4 * g] * inv, O[0][dvt][4 * g + 1] * inv, O[0][dvt][4 * g + 2] * inv, O[0][dvt][4 * g + 3] * inv};
        st_bf16x4(p.Y + (size_t)r * D + h * 64 + dvt * 32 + 8 * g + 4 * hh, o);
      }
  }
}
template <int VAR> DI void ph_attn_mla_probe(const Params& p, char* lds, int bid, int nblk) {
  const int lane = TIDX & 63, wid = TIDX >> 6, l31 = lane & 31, hh = lane >> 5;
#pragma unroll 1
  for (int u = bid; u < ATT_LAT_UNITS; u += nblk) {
    int bh, qb; att_unit(u, bh, qb);
    const int b = bh >> 2, h = bh & 3, q0 = qb * 128;
    const int r = row_of(b, q0 + wid * 32 + l31);
    f32x16 O[1][2]; float ls[1];
    attn_unit<96, 1, VAR>(p.Qm + ((size_t)b * 4 + h) * TK * 96, p.Km + ((size_t)b * 4 + h) * TK * 96, 0, p.Vtm + ((size_t)b * 4 + h) * 64 * TK, q0, TK, O, ls, lds);
    const float inv = 1.0f / ls[0];
#pragma unroll
    for (int dvt = 0; dvt < 2; ++dvt)
#pragma unroll
      for (int g = 0; g < 4; ++g) {
        f32x4 o = {O[0][dvt][4 * g] * inv, O[0][dvt][4 * g + 1] * inv, O[0][dvt][4 * g + 2] * inv, O[0][dvt][4 * g + 3] * inv};
        *(f32x4*)(p.out + (size_t)r * D + h * 64 + dvt * 32 + 8 * g + 4 * hh) = o;
      }
  }
}
DI void ph_attn(const Params& p, int layer, int need_ctx, char* lds, int bid, int nblk) {
  ph_attn_diff(p, layer, need_ctx, lds, bid, nblk);
  ph_attn_mla(p, need_ctx, lds, bid, nblk);
}

DI float wave_sum(float v) {
  v = xor_sum<1>(v); v = xor_sum<2>(v); v = xor_sum<4>(v); v = xor_sum<8>(v); v = xor_sum<16>(v); v = xor_sum<32>(v);
  return v;
}
DI void ld_row16(const float* row, int lane, f32x4 (&v)[4]) {
#pragma unroll
  for (int i = 0; i < 4; ++i) v[i] = *(const f32x4*)(row + 256 * i + 4 * lane);
}
DI void ld_row16_bf(const bf16_t* row, int lane, f32x4 (&v)[4]) {
#pragma unroll
  for (int i = 0; i < 4; ++i) { const u32x2 u = *(const u32x2*)(row + 256 * i + 4 * lane); v[i] = (f32x4){u2f(u.x << 16), u2f(u.x & 0xffff0000u), u2f(u.y << 16), u2f(u.y & 0xffff0000u)}; }
}
DI void ph_modulate(const Params& p, int layer, const float* xl, const float* xcx, int bid, int nblk) {
  const int lane = TIDX & 63, wid = TIDX >> 6;
  const float* g = p.g_mix_pre + layer * 1024;
  for (int r = bid * 4 + wid; r < R; r += nblk * 4) {
    const int w = r < RL ? r / TL : 2;
    const float* mb = p.mods + (size_t)(layer * 3 + w) * 6144;
    const float* x = r < RL ? xl + (size_t)r * D : xcx + (size_t)(r - RL) * D;
    f32x4 xv[4], gv[4], sc[4], sh[4];
    ld_row16(x, lane, xv); ld_row16(g, lane, gv); ld_row16(mb + 1024, lane, sc); ld_row16(mb, lane, sh);
    float ss = 0.f;
#pragma unroll
    for (int i = 0; i < 4; ++i)
#pragma unroll
      for (int e = 0; e < 4; ++e) ss += xv[i][e] * xv[i][e];
    const float rstd = 1.0f / sqrtf(wave_sum(ss) * (1.0f / D) + 1e-6f);
#pragma unroll
    for (int i = 0; i < 4; ++i) {
      f32x4 o;
#pragma unroll
      for (int e = 0; e < 4; ++e) o[e] = xv[i][e] * rstd * gv[i][e] * (1.f + sc[i][e]) + sh[i][e];
      st_bf16x4(p.H + (size_t)r * D + 256 * i + 4 * lane, o);
    }
  }
}
DI void ph_resid_mix(const Params& p, int layer, const float* xl_in, const float* xc_in, int rows, int bid, int nblk) {
  const int lane = TIDX & 63, wid = TIDX >> 6;
  const float* wr = p.w_router + (size_t)layer * D * 16;
  for (int r = bid * 4 + wid; r < rows; r += nblk * 4) {
    const int w = r < RL ? r / TL : 2;
    const float* mb = p.mods + (size_t)(layer * 3 + w) * 6144;
    const float* xin = r < RL ? xl_in + (size_t)r * D : xc_in + (size_t)(r - RL) * D;
    float* xo = r < RL ? p.out + (size_t)r * D : p.xc + (size_t)(r - RL) * D;
    f32x4 yv[4], xv[4], a[4], c[4];
    ld_row16_bf(p.YO + (size_t)r * D, lane, yv); ld_row16(xin, lane, xv);
    float ss = 0.f;
#pragma unroll
    for (int i = 0; i < 4; ++i)
#pragma unroll
      for (int e = 0; e < 4; ++e) ss += yv[i][e] * yv[i][e];
    const float rstd = 1.0f / sqrtf(wave_sum(ss) * (1.0f / D) + 1e-6f);
    ld_row16(mb + 2 * 1024, lane, a); ld_row16(p.g_mix_post + layer * 1024, lane, c);
    float s2 = 0.f;
#pragma unroll
    for (int i = 0; i < 4; ++i) {
#pragma unroll
      for (int e = 0; e < 4; ++e) { xv[i][e] += a[i][e] * yv[i][e] * rstd * c[i][e]; s2 += xv[i][e] * xv[i][e]; }
      *(f32x4*)(xo + 256 * i + 4 * lane) = xv[i];
    }
    const float rstd2 = 1.0f / sqrtf(wave_sum(s2) * (1.0f / D) + 1e-6f);
    ld_row16(p.g_ffn_pre + layer * 1024, lane, a); ld_row16(mb + 4 * 1024, lane, c); ld_row16(mb + 3 * 1024, lane, yv);
    float lg[16];
#pragma unroll
    for (int e = 0; e < 16; ++e) lg[e] = 0.f;
#pragma unroll
    for (int i = 0; i < 4; ++i) {
      f32x4 h2;
#pragma unroll
      for (int e = 0; e < 4; ++e) h2[e] = xv[i][e] * rstd2 * a[i][e] * (1.f + c[i][e]) + yv[i][e];
      st_bf16x4(p.H + (size_t)r * D + 256 * i + 4 * lane, h2);
#pragma unroll
      for (int e = 0; e < 4; ++e) {
        const float* wk = wr + (size_t)(256 * i + 4 * lane + e) * 16;
#pragma unroll
        for (int q = 0; q < 4; ++q) { const f32x4 wv = *(const f32x4*)(wk + 4 * q); lg[4 * q] += h2[e] * wv[0]; lg[4 * q + 1] += h2[e] * wv[1]; lg[4 * q + 2] += h2[e] * wv[2]; lg[4 * q + 3] += h2[e] * wv[3]; }
      }
    }
#pragma unroll
    for (int e = 0; e < 16; ++e) lg[e] = wave_sum(lg[e]);
    float mx = lg[0];
#pragma unroll
    for (int e = 1; e < 16; ++e) mx = fmaxf(mx, lg[e]);
    float sm = 0.f;
#pragma unroll
    for (int e = 0; e < 16; ++e) { lg[e] = expf(lg[e] - mx); sm += lg[e]; }
    int b, s; bs_of(r, b, s);
    float mine = 0.f;
#pragma unroll
    for (int e = 0; e < 16; ++e) mine = (lane == e) ? lg[e] / sm : mine;
    if (lane < 16) p.AFF[((size_t)b * NE + lane) * TK + s] = mine;
  }
}
DI void ph_resid_ffn(const Params& p, int layer, int rows, int bid, int nblk) {
  const int lane = TIDX & 63, wid = TIDX >> 6;
  for (int r = bid * 4 + wid; r < rows; r += nblk * 4) {
    const int w = r < RL ? r / TL : 2;
    const float* mb = p.mods + (size_t)(layer * 3 + w) * 6144;
    float* xo = r < RL ? p.out + (size_t)r * D : p.xc + (size_t)(r - RL) * D;
    const int myinv = lane < NE ? p.INV[(size_t)r * NE + lane] : -1;
    f32x4 f[4];
#pragma unroll
    for (int i = 0; i < 4; ++i) f[i] = (f32x4){0.f, 0.f, 0.f, 0.f};
    for (int e = 0; e < NE; ++e) {
      const int sl = lane_bcast(myinv, e);
      if (sl >= 0) { f32x4 yv[4]; ld_row16_bf(p.YE + ((size_t)e * NSLOT + sl) * D, lane, yv);
#pragma unroll
        for (int i = 0; i < 4; ++i) f[i] += yv[i]; }
    }
    float ss = 0.f;
#pragma unroll
    for (int i = 0; i < 4; ++i)
#pragma unroll
      for (int e = 0; e < 4; ++e) ss += f[i][e] * f[i][e];
    const float rstd = 1.0f / sqrtf(wave_sum(ss) * (1.0f / D) + 1e-6f);
    f32x4 a[4], c[4], xv[4];
    ld_row16(mb + 5 * 1024, lane, a); ld_row16(p.g_ffn_post + layer * 1024, lane, c); ld_row16(xo, lane, xv);
#pragma unroll
    for (int i = 0; i < 4; ++i) {
#pragma unroll
      for (int e = 0; e < 4; ++e) xv[i][e] += a[i][e] * f[i][e] * rstd * c[i][e];
      *(f32x4*)(xo + 256 * i + 4 * lane) = xv[i];
    }
  }
}
DI void ph_mods(const Params& p, char* lds, int bid, int nblk) {
  float* sc = (float*)lds;
  const int t = TIDX;
  for (int i = t; i < 3 * 1024; i += NTHR) { const float v = i < 2048 ? p.c[i] : p.c_ctx[i - 2048]; sc[i] = v / (1.0f + expf(-v)); }
  __syncthreads();
#pragma unroll 1
  for (long gi = (long)bid * NTHR + t; gi < 2 * 3 * 6144; gi += (long)nblk * NTHR) {
    const int col = (int)(gi % 6144), w = (int)((gi / 6144) % 3), l = (int)(gi / (3 * 6144));
    const float* W = p.w_ada + (size_t)l * 1024 * 6144 + col; const float* s = sc + w * 1024;
    float acc[8];
#pragma unroll
    for (int q = 0; q < 8; ++q) acc[q] = 0.f;
#pragma unroll 1
    for (int k = 0; k < 1024; k += 8) {
#pragma unroll
      for (int q = 0; q < 8; ++q) acc[q] += s[k + q] * W[(size_t)(k + q) * 6144];
    }
    p.mods[gi] = ((acc[0] + acc[1]) + (acc[2] + acc[3])) + ((acc[4] + acc[5]) + (acc[6] + acc[7])) + p.b_ada[l * 6144 + col];
  }
  __syncthreads();
}
constexpr int TOPK_LDS = TL * 4 + 2048;
DI int block_sum_i(int v, int* red) {
  const int lane = TIDX & 63, wid = TIDX >> 6;
  v = xor_sum_i<1>(v); v = xor_sum_i<2>(v); v = xor_sum_i<4>(v); v = xor_sum_i<8>(v); v = xor_sum_i<16>(v); v = xor_sum_i<32>(v);
  __syncthreads();
  if (lane == 0) red[wid] = v;
  __syncthreads();
  return red[0] + red[1] + red[2] + red[3];
}
DI int block_excl_scan(int v, int* red) {
  const int lane = TIDX & 63, wid = TIDX >> 6;
  int inc = v;
#pragma unroll
  for (int d = 1; d < 64; d <<= 1) { const int o = lane_up(inc, d, lane); if (lane >= d) inc += o; }
  __syncthreads();
  if (lane == 63) red[wid] = inc;
  __syncthreads();
  int base = 0;
  for (int q = 0; q < wid; ++q) base += red[q];
  return base + inc - v;
}
DI void ph_topk(const Params& p, int need_ctx, char* lds, int bid, int nblk) {
  unsigned* vals = (unsigned*)lds; int* red = (int*)(lds + TL * 4 + 1024);
  const int t = TIDX;
  for (int u = bid; u < NB * NE * 2; u += nblk) {
    const int seg = u & 1, e = (u >> 1) % NE, b = u / (2 * NE);
    const int s0 = seg ? TC : 0, n = seg ? TL : TC, cap = seg ? CAPL : CAPC, slot0 = seg ? b * CAPL : NB * CAPL + b * CAPC;
    if (seg == 0 && !need_ctx) { for (int q = t; q < cap; q += NTHR) p.SEL[(size_t)e * NSLOT + slot0 + q] = -1; continue; }
    const float* a = p.AFF + ((size_t)b * NE + e) * TK + s0;
    const int vpt = (n + NTHR - 1) / NTHR, i0 = t * vpt, i1 = (i0 + vpt < n) ? i0 + vpt : n;
    for (int i = t; i < n; i += NTHR) vals[i + i / vpt] = f2u(a[i]);
    __syncthreads();
    unsigned thr = 0;
    for (int bit = 31; bit >= 0; --bit) {
      const unsigned cand = thr | (1u << bit);
      int cnt = 0;
      for (int i = i0; i < i1; ++i) cnt += (vals[i + t] >= cand);
      if (block_sum_i(cnt, red) >= cap) thr = cand;
    }
    int cgt = 0, ceq = 0;
    for (int i = i0; i < i1; ++i) { cgt += (vals[i + t] > thr); ceq += (vals[i + t] == thr); }
    const int ngt = block_sum_i(cgt, red);
    const int neq = cap - ngt;
    int eqoff = block_excl_scan(ceq, red);
    int csel = 0;
    { int er = eqoff; for (int i = i0; i < i1; ++i) { if (vals[i + t] > thr) ++csel; else if (vals[i + t] == thr) { if (er < neq) ++csel; ++er; } } }
    int q = block_excl_scan(csel, red);
    for (int i = i0; i < i1; ++i) {
      const unsigned v = vals[i + t]; int sel = -1;
      if (v > thr) sel = q++; else if (v == thr) { if (eqoff < neq) sel = q++; ++eqoff; }
      const int r = row_of(b, s0 + i);
      if (sel >= 0) { p.SEL[(size_t)e * NSLOT + slot0 + sel] = r; p.SELV[(size_t)e * NSLOT + slot0 + sel] = u2f(v); }
      p.INV[(size_t)r * NE + e] = sel >= 0 ? slot0 + sel : -1;
    }
    __syncthreads();
  }
}
DI void ph_wt(const float* in, bf16_t* out, int K, int N, int NP, int nbatch, long in_bs, long out_bs, const float* gain, char* lds, int bid, int nblk) {
  float* tile = (float*)lds;
  const int t = TIDX, tk = K / 64, tn = NP / 64, ntile = nbatch * tk * tn;
  f32x4 v[4];
  auto gload = [&](int u) {
    const int bt = u / (tk * tn), rem = u % (tk * tn), k0 = (rem / tn) * 64, n0 = (rem % tn) * 64;
    const float* I = in + (size_t)bt * in_bs;
#pragma unroll
    for (int i = 0; i < 4; ++i) {
      const int idx = t + i * NTHR, kk = idx >> 4, n4 = (idx & 15) * 4;
      v[i] = (f32x4){0.f, 0.f, 0.f, 0.f};
      if (n0 + n4 < N) v[i] = *(const f32x4*)(I + (size_t)(k0 + kk) * N + n0 + n4);
      if (gain) { const float g = gain[k0 + kk]; v[i][0] *= g; v[i][1] *= g; v[i][2] *= g; v[i][3] *= g; }
    }
  };
  if (bid < ntile) gload(bid);
#pragma unroll 1
  for (int u = bid; u < ntile; u += nblk) {
    const int bt = u / (tk * tn), rem = u % (tk * tn), k0 = (rem / tn) * 64, n0 = (rem % tn) * 64;
    bf16_t* O = out + (size_t)bt * out_bs;
#pragma unroll
    for (int i = 0; i < 4; ++i) { const int idx = t + i * NTHR, kk = idx >> 4, n4 = (idx & 15) * 4; float* d = tile + kk * 65 + n4; d[0] = v[i][0]; d[1] = v[i][1]; d[2] = v[i][2]; d[3] = v[i][3]; }
    __syncthreads();
    if (u + nblk < ntile) gload(u + nblk);
#pragma unroll
    for (int i = 0; i < 2; ++i) {
      const int idx = t + i * NTHR, kg = idx & 7, nn = idx >> 3;
      float a[8];
#pragma unroll
      for (int e = 0; e < 8; ++e) a[e] = tile[(kg * 8 + e) * 65 + nn];
      u32x4 o; o.x = pack2bf(a[0], a[1]); o.y = pack2bf(a[2], a[3]); o.z = pack2bf(a[4], a[5]); o.w = pack2bf(a[6], a[7]);
      *(u32x4*)(O + (size_t)(n0 + nn) * K + k0 + kg * 8) = o;
    }
    __syncthreads();
  }
}
DI float wave_max(float v) {
  v = xor_max<1>(v); v = xor_max<2>(v); v = xor_max<4>(v); v = xor_max<8>(v); v = xor_max<16>(v); v = xor_max<32>(v);
  return v;
}
DI bf16x8 cvt8(const float* f) {
  const f32x4 a = *(const f32x4*)f, b = *(const f32x4*)(f + 4);
  u32x4 pk; pk.x = pack2bf(a[0], a[1]); pk.y = pack2bf(a[2], a[3]); pk.z = pack2bf(b[0], b[1]); pk.w = pack2bf(b[2], b[3]);
  return __builtin_bit_cast(bf16x8, pk);
}
constexpr int SCAN_UNITS = NB * NCK * 4, SCAN_LAT_UNITS = NB * NCL * 4;
DI void scan_unit(int u, int& b, int& c, int& h) {
  h = u & 3;
  if (u < SCAN_LAT_UNITS) { c = NCC + (u >> 2) % NCL; b = u / (4 * NCL); } else { const int v = u - SCAN_LAT_UNITS; c = (v >> 2) % NCC; b = v / (4 * NCC); }
}

DI void ph_ml_local(const Params& p, char* lds, int bid, int nblk) {
  bf16_t* sK = (bf16_t*)lds;
  float* sW = (float*)(lds + 64 * 132);
  const int t = TIDX, lane = t & 63, wid = t >> 6, l31 = lane & 31, hh = lane >> 5;
  const int d = wid & 1, vt = wid >> 1;
#pragma unroll 1
  for (int u = bid; u < SCAN_UNITS; u += nblk) {
    int b, c, h; scan_unit(u, b, c, h);
    {
      const int row = t >> 2, seg = (t & 3) * 16;
      const bf16_t* src = p.MK + ((size_t)b * TK + 64 * c + row) * 256 + h * 64 + seg;
      const u32x4 a = ldg16(src), bb = ldg16(src + 8);
      unsigned* dst = (unsigned*)((char*)sK + row * 132 + seg * 2);
      dst[0] = a.x; dst[1] = a.y; dst[2] = a.z; dst[3] = a.w; dst[4] = bb.x; dst[5] = bb.y; dst[6] = bb.z; dst[7] = bb.w;
    }
    if (t < 128) {
      const int dd = t >> 6, l = t & 63, j = step_of(dd, c), pos = dd ? 63 - l : l;
      const size_t o = (((size_t)b * 2 + dd) * TK + 64 * j) * 4 + h;
      const float bend = p.BC[o + 63 * 4], wl = bend - p.BC[o + pos * 4] + p.IGS[o + pos * 4];
      const float ml = wave_max(wl);
      sW[dd * 64 + l] = expf(wl - ml);
      if (l == 0) { const size_t uu = (((size_t)b * 2 + dd) * NCK + j) * 4 + h; p.MM[uu * 4] = ml; p.MM[uu * 4 + 1] = bend; }
    }
    __syncthreads();
    const int j = step_of(d, c);
    const size_t uu = (((size_t)b * 2 + d) * NCK + j) * 4 + h;
    f32x16 acc[2]; acc[0] = (f32x16)(0.f); acc[1] = (f32x16)(0.f);
    const bf16_t* vsrc = p.MVt + (((size_t)b * 4 + h) * 64 + vt * 32 + l31) * TK + 64 * c;
#pragma unroll
    for (int ks = 0; ks < 4; ++ks) {
      const bf16x8 a = *(const bf16x8*)(vsrc + ks * 16 + 8 * hh);
      const float* w = sW + d * 64 + ks * 16 + 8 * hh;
      u32x4 pk;
      pk.x = pack2bf(bf2f((bf16_t)a[0]) * w[0], bf2f((bf16_t)a[1]) * w[1]); pk.y = pack2bf(bf2f((bf16_t)a[2]) * w[2], bf2f((bf16_t)a[3]) * w[3]);
      pk.z = pack2bf(bf2f((bf16_t)a[4]) * w[4], bf2f((bf16_t)a[5]) * w[5]); pk.w = pack2bf(bf2f((bf16_t)a[6]) * w[6], bf2f((bf16_t)a[7]) * w[7]);
      const bf16x8 af = __builtin_bit_cast(bf16x8, pk);
#pragma unroll
      for (int kt = 0; kt < 2; ++kt) {
        bf16x8 bfr;
#pragma unroll
        for (int q = 0; q < 8; ++q) bfr[q] = (short)sK[(ks * 16 + 8 * hh + q) * 66 + kt * 32 + l31];
        acc[kt] = MFMA32(af, bfr, acc[kt]);
      }
    }
#pragma unroll
    for (int kt = 0; kt < 2; ++kt)
#pragma unroll
      for (int i = 0; i < 16; ++i) p.MC[uu * 4096 + (size_t)(vt * 32 + (i & 3) + 8 * (i >> 2) + 4 * hh) * 64 + kt * 32 + l31] = acc[kt][i];
    float nl = 0.f;
    for (int q = 0; q < 32; ++q) { const int l = hh * 32 + q; nl += sW[d * 64 + l] * bf2f(sK[l * 66 + vt * 32 + l31]); }
    nl = xor_sum<32>(nl);
    if (hh == 0) p.MN[uu * 64 + vt * 32 + l31] = nl;
    __syncthreads();
  }
}
DI void ph_ml_scan(const Params& p, int bid, int nblk) {
  for (long gi = (long)bid * NTHR + TIDX; gi < (long)NB * 2 * 4 * 4160; gi += (long)nblk * NTHR) {
    const int e = (int)(gi % 4160), ch = (int)(gi / 4160), h = ch & 3, bd = ch >> 2;
    float* base = e < 4096 ? p.MC + (((size_t)bd * NCK) * 4 + h) * 4096 + e : p.MN + (((size_t)bd * NCK) * 4 + h) * 64 + (e - 4096);
    const size_t stride = e < 4096 ? 4 * 4096 : 4 * 64;
    float* mm = p.MM + (((size_t)bd * NCK) * 4 + h) * 4;
    float st = 0.f, m = -1e30f;
    float cl[8], cm[8], cb[8], nl[8], nm[8], nb[8];
#pragma unroll
    for (int q = 0; q < 8; ++q) { cl[q] = base[(size_t)q * stride]; cm[q] = mm[q * 16]; cb[q] = mm[q * 16 + 1]; }
#pragma unroll 1
    for (int jb = 0; jb < NCK; jb += 8) {
#pragma unroll
      for (int q = 0; q < 8; ++q) { const int j = jb + 8 + q; if (j < NCK) { nl[q] = base[(size_t)j * stride]; nm[q] = mm[j * 16]; nb[q] = mm[j * 16 + 1]; } }
#pragma unroll
      for (int q = 0; q < 8; ++q) {
        const int j = jb + q;
        if (j < NCK) {
          const float mn = fmaxf(cb[q] + m, cm[q]), a = expf(cb[q] + m - mn), g = expf(cm[q] - mn);
          base[(size_t)j * stride] = st;
          st = a * st + g * cl[q];
          if (e == 0) mm[j * 16 + 2] = m;
          m = mn;
        }
      }
#pragma unroll
      for (int q = 0; q < 8; ++q) { cl[q] = nl[q]; cm[q] = nm[q]; cb[q] = nb[q]; }
    }
  }
}
DI void ph_gla_scan(const Params& p, int bid, int nblk) {
  for (long gi = (long)bid * NTHR + TIDX; gi < (long)NB * 2 * 4 * 2048; gi += (long)nblk * NTHR) {
    const int e = (int)(gi % 2048), ch = (int)(gi / 2048), h = ch & 3, bd = ch >> 2, k = e & 31;
    float* base = p.GS + (((size_t)bd * NCK) * 4 + h) * 2048 + e;
    const float* ge = p.GC + ((size_t)bd * TK + 63) * 128 + h * 32 + k;
    float st = 0.f;
    float cl[8], cg[8], nl[8], ng[8];
#pragma unroll
    for (int q = 0; q < 8; ++q) { cl[q] = base[(size_t)q * 4 * 2048]; cg[q] = ge[(size_t)q * 64 * 128]; }
#pragma unroll 1
    for (int jb = 0; jb < NCK; jb += 8) {
#pragma unroll
      for (int q = 0; q < 8; ++q) { const int j = jb + 8 + q; if (j < NCK) { nl[q] = base[(size_t)j * 4 * 2048]; ng[q] = ge[(size_t)j * 64 * 128]; } }
#pragma unroll
      for (int q = 0; q < 8; ++q) {
        const int j = jb + q;
        if (j < NCK) { base[(size_t)j * 4 * 2048] = st; st = expf(cg[q]) * st + cl[q]; }
      }
#pragma unroll
      for (int q = 0; q < 8; ++q) { cl[q] = nl[q]; cg[q] = ng[q]; }
    }
  }
}
constexpr int MO_K = 0, MO_V = 64 * 144, MO_A = MO_V + 64 * VROW, MO_PM = MO_A + 512, MO_N0 = MO_PM + 512, MO_X = MO_N0 + 512, MO_LDS = MO_X + 16384;
DI void ph_ml_out(const Params& p, int layer, int need_ctx, char* lds, int bid, int nblk) {
  float* sA = (float*)(lds + MO_A); float* sPM = (float*)(lds + MO_PM); float* sN0 = (float*)(lds + MO_N0); float* sX = (float*)(lds + MO_X);
  const int t = TIDX, lane = t & 63, wid = t >> 6, l31 = lane & 31, hh = lane >> 5;
  const int lt = wid & 1, d = wid >> 1;
#pragma unroll 1
  for (int u = bid; u < (need_ctx ? SCAN_UNITS : SCAN_LAT_UNITS); u += nblk) {
    int b, c, h; scan_unit(u, b, c, h);
    {
      const int row = t >> 2, seg = (t & 3) * 16;
      const bf16_t* ks = p.MK + ((size_t)b * TK + 64 * c + row) * 256 + h * 64 + seg;
      sts16(lds + MO_K + row * 144 + seg * 2, ldg16(ks)); sts16(lds + MO_K + row * 144 + seg * 2 + 16, ldg16(ks + 8));
      const bf16_t* vs = p.MVt + (((size_t)b * 4 + h) * 64 + row) * TK + 64 * c + seg;
      const u32x4 v0 = ldg16(vs), v1 = ldg16(vs + 8);
      u32x2* dv = (u32x2*)(lds + MO_V + row * VROW + seg * 2);
      u32x2 q; q.x = v0.x; q.y = v0.y; dv[0] = q; q.x = v0.z; q.y = v0.w; dv[1] = q; q.x = v1.x; q.y = v1.y; dv[2] = q; q.x = v1.z; q.y = v1.w; dv[3] = q;
    }
    if (t < 128) {
      const int dd = t >> 6, s = t & 63, j = step_of(dd, c), pos = dd ? 63 - s : s;
      const size_t o = (((size_t)b * 2 + dd) * TK + 64 * j) * 4 + h;
      sA[dd * 64 + s] = p.IGS[o + pos * 4] - p.BC[o + pos * 4];
      const size_t uu = (((size_t)b * 2 + dd) * NCK + j) * 4 + h;
      sN0[dd * 64 + s] = p.MN[uu * 64 + s];
    }
    __syncthreads();
    if (t < 2) {
      float m = -1e30f;
      if (t == 0) { for (int s = 0; s < 64; ++s) { m = fmaxf(m, sA[s]); sPM[s] = m; } }
      else { for (int s = 63; s >= 0; --s) { m = fmaxf(m, sA[64 + s]); sPM[64 + s] = m; } }
    }
    __syncthreads();
    const int j = step_of(d, c);
    const size_t uu = (((size_t)b * 2 + d) * NCK + j) * 4 + h;
    const int l = lt * 32 + l31, pos = d ? 63 - l : l;
    const float bl = p.BC[(((size_t)b * 2 + d) * TK + 64 * j + pos) * 4 + h];
    const float inter = bl + p.MM[uu * 4 + 2];
    const float mt = fmaxf(inter, bl + sPM[d * 64 + l]);
    const float aint = expf(inter - mt);
    bf16x8 qf[4];
#pragma unroll
    for (int ks = 0; ks < 4; ++ks) qf[ks] = *(const bf16x8*)(p.MQ + ((size_t)b * TK + 64 * c + l) * 256 + h * 64 + ks * 16 + 8 * hh);
    f32x16 num[2]; num[0] = (f32x16)(0.f); num[1] = (f32x16)(0.f);
    float den = 0.f;
#pragma unroll
    for (int st = 0; st < 2; ++st) {
      if (d == 0 ? st <= lt : st >= lt) {
        f32x16 S = (f32x16)(0.f);
#pragma unroll
        for (int ks = 0; ks < 4; ++ks) S = MFMA32(lds_frag(lds + MO_K + (st * 32 + l31) * 144 + (ks * 16 + 8 * hh) * 2), qf[ks], S);
#pragma unroll
        for (int i = 0; i < 16; ++i) {
          const int s = st * 32 + (i & 3) + 8 * (i >> 2) + 4 * hh;
          const bool ok = d == 0 ? s <= l : s >= l;
          const float e = ok ? fast_exp2((bl + sA[d * 64 + s] - mt) * LOG2E) * S[i] : 0.f;
          S[i] = e; den += e;
        }
#pragma unroll
        for (int kst = 0; kst < 2; ++kst) {
          const bf16x8 pf = pack8(S, kst);
#pragma unroll
          for (int vt = 0; vt < 2; ++vt) {
            const char* vp = lds + MO_V + (vt * 32 + l31) * VROW + (st * 32 + kst * 16 + 4 * hh) * 2;
            const s16x4 lo = *(const s16x4*)vp, hi = *(const s16x4*)(vp + 16);
            num[vt] = MFMA32(__builtin_shufflevector(lo, hi, 0, 1, 2, 3, 4, 5, 6, 7), pf, num[vt]);
          }
        }
      }
    }
    f32x16 accI[2]; accI[0] = (f32x16)(0.f); accI[1] = (f32x16)(0.f);
#pragma unroll
    for (int vt = 0; vt < 2; ++vt)
#pragma unroll
      for (int ks = 0; ks < 4; ++ks) accI[vt] = MFMA32(cvt8(p.MC + uu * 4096 + (size_t)(vt * 32 + l31) * 64 + ks * 16 + 8 * hh), qf[ks], accI[vt]);
    float qn = 0.f;
#pragma unroll
    for (int ks = 0; ks < 4; ++ks)
#pragma unroll
      for (int q = 0; q < 8; ++q) qn += bf2f((bf16_t)qf[ks][q]) * sN0[d * 64 + ks * 16 + 8 * hh + q];
    den = xor_sum<32>(den + aint * qn);
    const float inv = 1.0f / fmaxf(fabsf(den), expf(-mt));
#pragma unroll
    for (int vt = 0; vt < 2; ++vt)
#pragma unroll
      for (int i = 0; i < 16; ++i) num[vt][i] = (num[vt][i] + aint * accI[vt][i]) * inv;
    if (d == 1) {
#pragma unroll
      for (int vt = 0; vt < 2; ++vt)
#pragma unroll
        for (int i = 0; i < 16; ++i) sX[(lt * 32 + vt * 16 + i) * 64 + lane] = num[vt][i];
    }
    __syncthreads();
    if (d == 0) {
      float ss = 0.f;
#pragma unroll
      for (int vt = 0; vt < 2; ++vt)
#pragma unroll
        for (int i = 0; i < 16; ++i) { num[vt][i] += sX[(lt * 32 + vt * 16 + i) * 64 + lane]; ss += num[vt][i] * num[vt][i]; }
      ss = xor_sum<32>(ss);
      const float rstd = 1.0f / sqrtf(ss * (1.0f / 64) + 1e-6f);
      const int r = row_of(b, 64 * c + l);
#pragma unroll
      for (int vt = 0; vt < 2; ++vt)
#pragma unroll
        for (int g = 0; g < 4; ++g) {
          const int v0 = vt * 32 + 8 * g + 4 * hh;
          const u32x2 ou = *(const u32x2*)(p.Z + (size_t)r * NZP + ZC_MLO + h * 64 + v0);
          const f32x4 gv = *(const f32x4*)(p.g_mlstm_out + layer * 256 + h * 64 + v0);
          const float o0 = u2f(ou.x << 16), o1 = u2f(ou.x & 0xffff0000u), o2 = u2f(ou.y << 16), o3 = u2f(ou.y & 0xffff0000u);
          f32x4 y = {sigmoidf_(o0) * num[vt][4 * g] * rstd * gv[0], sigmoidf_(o1) * num[vt][4 * g + 1] * rstd * gv[1],
                     sigmoidf_(o2) * num[vt][4 * g + 2] * rstd * gv[2], sigmoidf_(o3) * num[vt][4 * g + 3] * rstd * gv[3]};
          st_bf16x4(p.Y + (size_t)r * D + 256 + h * 64 + v0, y);
        }
    }
    __syncthreads();
  }
}
DI void ph_gla_local(const Params& p, char* lds, int bid, int nblk) {
  bf16_t* sKd = (bf16_t*)lds;
  const int t = TIDX, lane = t & 63, wid = t >> 6, l31 = lane & 31, hh = lane >> 5;
  const int d = wid & 1, vt = wid >> 1;
#pragma unroll 1
  for (int u = bid; u < SCAN_UNITS; u += nblk) {
    int b, c, h; scan_unit(u, b, c, h);
    {
      const int dd = t >> 7, l = (t >> 1) & 63, k0 = (t & 1) * 16, j = step_of(dd, c), pos = dd ? 63 - l : l;
      const float* gcr = p.GC + (((size_t)b * 2 + dd) * TK + 64 * j + pos) * 128 + h * 32 + k0;
      const float* ger = p.GC + (((size_t)b * 2 + dd) * TK + 64 * j + 63) * 128 + h * 32 + k0;
      const bf16_t* kr = p.Z + (size_t)row_of(b, 64 * c + l) * NZP + ZC_GK + h * 32 + k0;
#pragma unroll
      for (int q = 0; q < 16; ++q) sKd[(dd * 64 + l) * 33 + k0 + q] = f2bf(bf2f(kr[q]) * fast_exp2((ger[q] - gcr[q]) * LOG2E));
    }
    __syncthreads();
    const int j = step_of(d, c);
    const size_t uu = (((size_t)b * 2 + d) * NCK + j) * 4 + h;
    f32x16 acc = (f32x16)(0.f);
    const bf16_t* vsrc = p.GVt + (((size_t)b * 4 + h) * 64 + vt * 32 + l31) * TK + 64 * c;
#pragma unroll
    for (int ks = 0; ks < 4; ++ks) {
      const bf16x8 af = *(const bf16x8*)(vsrc + ks * 16 + 8 * hh);
      bf16x8 bfr;
#pragma unroll
      for (int q = 0; q < 8; ++q) bfr[q] = (short)sKd[(d * 64 + ks * 16 + 8 * hh + q) * 33 + l31];
      acc = MFMA32(af, bfr, acc);
    }
#pragma unroll
    for (int i = 0; i < 16; ++i) p.GS[uu * 2048 + (size_t)(vt * 32 + (i & 3) + 8 * (i >> 2) + 4 * hh) * 32 + l31] = acc[i];
    __syncthreads();
  }
}
constexpr int GO_Q = 0, GO_K = 2 * 64 * 80, GO_V = 2 * GO_K, GO_X = GO_V + 64 * VROW, GO_LDS = GO_X + 16384;
DI void ph_gla_out(const Params& p, int layer, int need_ctx, char* lds, int bid, int nblk) {
  float* sX = (float*)(lds + GO_X);
  const int t = TIDX, lane = t & 63, wid = t >> 6, l31 = lane & 31, hh = lane >> 5;
  const int lt = wid & 1, d = wid >> 1;
#pragma unroll 1
  for (int u = bid; u < (need_ctx ? SCAN_UNITS : SCAN_LAT_UNITS); u += nblk) {
    int b, c, h; scan_unit(u, b, c, h);
    {
      const int dd = t >> 7, l = (t >> 1) & 63, k0 = (t & 1) * 16, j = step_of(dd, c), pos = dd ? 63 - l : l;
      const float* gcr = p.GC + (((size_t)b * 2 + dd) * TK + 64 * j + pos) * 128 + h * 32 + k0;
      const bf16_t* zr = p.Z + (size_t)row_of(b, 64 * c + l) * NZP;
      bf16_t* qd = (bf16_t*)(lds + GO_Q + (dd * 64 + l) * 80) + k0; bf16_t* kd = (bf16_t*)(lds + GO_K + (dd * 64 + l) * 80) + k0;
#pragma unroll
      for (int q = 0; q < 16; ++q) {
        const float g = gcr[q];
        qd[q] = f2bf(bf2f(zr[ZC_GQ + h * 32 + k0 + q]) * 0.17677669529663687f * fast_exp2(g * LOG2E));
        kd[q] = f2bf(bf2f(zr[ZC_GK + h * 32 + k0 + q]) * fast_exp2(-g * LOG2E));
      }
      const int row = t >> 2, seg = (t & 3) * 16;
      const bf16_t* vs = p.GVt + (((size_t)b * 4 + h) * 64 + row) * TK + 64 * c + seg;
      const u32x4 v0 = ldg16(vs), v1 = ldg16(vs + 8);
      u32x2* dv = (u32x2*)(lds + GO_V + row * VROW + seg * 2);
      u32x2 q2; q2.x = v0.x; q2.y = v0.y; dv[0] = q2; q2.x = v0.z; q2.y = v0.w; dv[1] = q2; q2.x = v1.x; q2.y = v1.y; dv[2] = q2; q2.x = v1.z; q2.y = v1.w; dv[3] = q2;
    }
    __syncthreads();
    const int j = step_of(d, c);
    const size_t uu = (((size_t)b * 2 + d) * NCK + j) * 4 + h;
    const int l = lt * 32 + l31;
    bf16x8 qf[2];
#pragma unroll
    for (int ks = 0; ks < 2; ++ks) qf[ks] = lds_frag(lds + GO_Q + (d * 64 + l) * 80 + (ks * 16 + 8 * hh) * 2);
    f32x16 O[2]; O[0] = (f32x16)(0.f); O[1] = (f32x16)(0.f);
#pragma unroll
    for (int st = 0; st < 2; ++st) {
      if (d == 0 ? st <= lt : st >= lt) {
        f32x16 S = (f32x16)(0.f);
#pragma unroll
        for (int ks = 0; ks < 2; ++ks) S = MFMA32(lds_frag(lds + GO_K + (d * 64 + st * 32 + l31) * 80 + (ks * 16 + 8 * hh) * 2), qf[ks], S);
#pragma unroll
        for (int i = 0; i < 16; ++i) {
          const int s = st * 32 + (i & 3) + 8 * (i >> 2) + 4 * hh;
          const bool ok = d == 0 ? s <= l : s >= l;
          S[i] = ok ? S[i] : 0.f;
        }
#pragma unroll
        for (int kst = 0; kst < 2; ++kst) {
          const bf16x8 pf = pack8(S, kst);
#pragma unroll
          for (int vt = 0; vt < 2; ++vt) {
            const char* vp = lds + GO_V + (vt * 32 + l31) * VROW + (st * 32 + kst * 16 + 4 * hh) * 2;
            const s16x4 lo = *(const s16x4*)vp, hi = *(const s16x4*)(vp + 16);
            O[vt] = MFMA32(__builtin_shufflevector(lo, hi, 0, 1, 2, 3, 4, 5, 6, 7), pf, O[vt]);
          }
        }
      }
    }
#pragma unroll
    for (int vt = 0; vt < 2; ++vt)
#pragma unroll
      for (int ks = 0; ks < 2; ++ks) O[vt] = MFMA32(cvt8(p.GS + uu * 2048 + (size_t)(vt * 32 + l31) * 32 + ks * 16 + 8 * hh), qf[ks], O[vt]);
    if (d == 1) {
#pragma unroll
      for (int vt = 0; vt < 2; ++vt)
#pragma unroll
        for (int i = 0; i < 16; ++i) sX[(lt * 32 + vt * 16 + i) * 64 + lane] = O[vt][i];
    }
    __syncthreads();
    if (d == 0) {
      float ss = 0.f;
#pragma unroll
      for (int vt = 0; vt < 2; ++vt)
#pragma unroll
        for (int i = 0; i < 16; ++i) { O[vt][i] += sX[(lt * 32 + vt * 16 + i) * 64 + lane]; ss += O[vt][i] * O[vt][i]; }
      ss = xor_sum<32>(ss);
      const float rstd = 1.0f / sqrtf(ss * (1.0f / 64) + 1e-6f);
      const int r = row_of(b, 64 * c + l);
#pragma unroll
      for (int vt = 0; vt < 2; ++vt)
#pragma unroll
        for (int g = 0; g < 4; ++g) {
          const int v0 = vt * 32 + 8 * g + 4 * hh;
          const u32x2 ru = *(const u32x2*)(p.Z + (size_t)r * NZP + ZC_GR + h * 64 + v0);
          const f32x4 gv = *(const f32x4*)(p.g_gla_out + layer * 256 + h * 64 + v0);
          const float r0 = u2f(ru.x << 16), r1 = u2f(ru.x & 0xffff0000u), r2 = u2f(ru.y << 16), r3 = u2f(ru.y & 0xffff0000u);
          f32x4 y = {siluf_(r0) * O[vt][4 * g] * rstd * gv[0], siluf_(r1) * O[vt][4 * g + 1] * rstd * gv[1],
                     siluf_(r2) * O[vt][4 * g + 2] * rstd * gv[2], siluf_(r3) * O[vt][4 * g + 3] * rstd * gv[3]};
          st_bf16x4(p.Y + (size_t)r * D + 512 + h * 64 + v0, y);
        }
    }
    __syncthreads();
  }
}

DI float fast_logsigmoid(float x) {
  const float e = fast_exp2(-fabsf(x) * LOG2E);
#ifdef CPU_EMU
  return fminf(x, 0.f) - log1pf(e);
#else
  return fminf(x, 0.f) - 0.6931471805599453f * __builtin_amdgcn_logf(1.0f + e);
#endif
}
DI float wave_incl_scan(float v, int lane) {
#pragma unroll
  for (int dd = 1; dd < 64; dd <<= 1) { const float o = u2f((unsigned)lane_up((int)f2u(v), dd, lane)); if (lane >= dd) v += o; }
  return v;
}
constexpr int GCUM_LDS = 4 * 64 * 33 * 4;
DI void ph_gates_cum(const Params& p, int layer, char* lds, int bid, int nblk) {
  const int t = TIDX, lane = t & 63, wid = t >> 6;
  float* stg = (float*)lds + wid * 64 * 33;
  const float* wal = p.w_alpha2 + (size_t)layer * 2 * 16 * 128;
#pragma unroll 1
  for (int u = bid * 4 + wid; u < NB * 2 * NCK; u += nblk * 4) {
    const int j = u % NCK, d = (u / NCK) & 1, b = u / (2 * NCK);
    const int pp = 64 * j + lane, s = seq_of(d, pp);
    const bf16_t* z = p.Z + (size_t)row_of(b, s) * NZP;
    const size_t ob = ((size_t)b * 2 + d) * TK + pp;
    {
      const u32x2 iu = *(const u32x2*)(z + ZC_MLIG + d * 4), fu = *(const u32x2*)(z + ZC_MLFG + d * 4);
      const float ig[4] = {u2f(iu.x << 16), u2f(iu.x & 0xffff0000u), u2f(iu.y << 16), u2f(iu.y & 0xffff0000u)};
      const float fg[4] = {u2f(fu.x << 16), u2f(fu.x & 0xffff0000u), u2f(fu.y << 16), u2f(fu.y & 0xffff0000u)};
      f32x4 oc, oi;
#pragma unroll
      for (int h = 0; h < 4; ++h) {
        oi[h] = ig[h] + p.b_igate[layer * 8 + d * 4 + h];
        oc[h] = wave_incl_scan(fast_logsigmoid(fg[h] + p.b_fgate[layer * 8 + d * 4 + h]), lane);
      }
      *(f32x4*)(p.BC + ob * 4) = oc; *(f32x4*)(p.IGS + ob * 4) = oi;
    }
    float a[16];
    { float f0[8], f1[8]; unpack8(ldg16(z + ZC_GA + d * 16), f0); unpack8(ldg16(z + ZC_GA + d * 16 + 8), f1);
#pragma unroll
      for (int q = 0; q < 8; ++q) { a[q] = f0[q]; a[8 + q] = f1[q]; } }
    const float* W = wal + (size_t)d * 16 * 128;
#pragma unroll 1
    for (int cg = 0; cg < 4; ++cg) {
#pragma unroll 4
      for (int c = 0; c < 32; ++c) {
        const int ch = cg * 32 + c;
        float zg = p.b_alpha[layer * 256 + d * 128 + ch];
#pragma unroll
        for (int q = 0; q < 16; ++q) zg += a[q] * W[q * 128 + ch];
        stg[lane * 33 + c] = wave_incl_scan(fast_logsigmoid(zg) * (1.0f / 16.0f), lane);
      }
      WAVE_SYNC();
#pragma unroll
      for (int k = 0; k < 32; ++k) { const int pos = k * 2 + (lane >> 5), c = lane & 31; p.GC[(((size_t)b * 2 + d) * TK + 64 * j + pos) * 128 + cg * 32 + c] = stg[pos * 33 + c]; }
      WAVE_SYNC();
    }
  }
}
#define XB_TMO      128
#define XB_XCNT(j)  (256  + 64 * (j))
#define XB_XSUB(j)  (1280 + 64 * (j))
#define XB_XGEN(j)  (2304 + 64 * (j))
#define XB_TOP      3328
#define XB_TOPGEN   3392
#define XCD_BAR_WORDS 3456
#define XB_SPIN_CAP (1u << 28)
#define LAS __attribute__((address_space(3)))

__device__ __forceinline__ unsigned xb_ld(unsigned* p)              { return __hip_atomic_load(p, __ATOMIC_RELAXED, __HIP_MEMORY_SCOPE_AGENT); }
__device__ __forceinline__ unsigned xb_add(unsigned* p, unsigned v) { return __hip_atomic_fetch_add(p, v, __ATOMIC_RELAXED, __HIP_MEMORY_SCOPE_AGENT); }
__device__ __forceinline__ unsigned xb_xcc_id() { return (unsigned)__builtin_amdgcn_s_getreg((3 << 11) | 20) & 0xFu; }
#define XB_SPIN(cond, bar) do { unsigned _sp = 0; while (cond) { __builtin_amdgcn_s_sleep(1); \
    if ((++_sp & 255u) == 0u) { if (xb_ld(&(bar)[XB_TMO])) break; if (_sp > XB_SPIN_CAP) { atomicAdd(&(bar)[XB_TMO], 1u); break; } } } } while (0)

struct XcdBarrier {
    unsigned* bar; unsigned x;
    volatile LAS unsigned* st;
};

__device__ __forceinline__ XcdBarrier xcd_barrier_post(unsigned* bar, volatile LAS unsigned* st) {
    XcdBarrier b; b.bar = bar; b.x = xb_xcc_id(); b.st = st;
    if (threadIdx.x == 0) (void)xb_add(&bar[XB_XCNT(b.x)], 1u);
    return b;
}
__device__ __forceinline__ void xcd_barrier_complete(unsigned* bar, unsigned x, unsigned& nloc, unsigned& nx) {
    const unsigned G = gridDim.x * gridDim.y * gridDim.z;
    unsigned sum, cnt, mine, sp = 0u;
    for (;;) {
        sum = 0u; cnt = 0u; mine = 0u;
#pragma unroll
        for (unsigned j = 0; j < 16; ++j) { const unsigned c = xb_ld(&bar[XB_XCNT(j)]); sum += c; cnt += (c > 0u) ? 1u : 0u; mine = (j == x) ? c : mine; }
        if (sum == G) break;
        __builtin_amdgcn_s_sleep(1);
        if ((++sp & 255u) == 0u) { if (xb_ld(&bar[XB_TMO])) break; if (sp > XB_SPIN_CAP) { atomicAdd(&bar[XB_TMO], 1u); break; } }
    }
    nloc = mine > 0u ? mine : 1u; nx = cnt > 0u ? cnt : 1u;
}

__device__ __forceinline__ void xcd_barrier(const XcdBarrier& b) {
    asm volatile("s_waitcnt vmcnt(0)" ::: "memory");
    __syncthreads();
    if (threadIdx.x == 0) {
        unsigned* bar = b.bar;
        __builtin_amdgcn_s_waitcnt(0);
        unsigned nloc = b.st[0], nx = b.st[1];
        if (nloc == 0u) { xcd_barrier_complete(bar, b.x, nloc, nx); b.st[0] = nloc; b.st[1] = nx; }
        const unsigned old = xb_add(&bar[XB_XSUB(b.x)], 1u);
        const unsigned gen = old / nloc;
        if (old + 1u == (gen + 1u) * nloc) {
            __builtin_amdgcn_fence(__ATOMIC_RELEASE, "agent");
            asm volatile("s_waitcnt vmcnt(0)" ::: "memory");
            const unsigned og = xb_add(&bar[XB_TOP], 1u);
            const unsigned tg = og / nx;
            if (og + 1u == (tg + 1u) * nx) xb_add(&bar[XB_TOPGEN], 1u);
            else XB_SPIN(xb_ld(&bar[XB_TOPGEN]) == tg, bar);
            __builtin_amdgcn_fence(__ATOMIC_ACQUIRE, "agent");
            xb_add(&bar[XB_XGEN(b.x)], 1u);
            asm volatile("s_waitcnt vmcnt(0)" ::: "memory");
        } else {
            XB_SPIN(xb_ld(&bar[XB_XGEN(b.x)]) == gen, bar);
            __builtin_amdgcn_fence(__ATOMIC_ACQUIRE, "agent");
            asm volatile("s_waitcnt vmcnt(0)" ::: "memory");
        }
    }
    __syncthreads();
}

#define GS_LOOP(N, CALL) for (long gi = (long)bid * NTHR + TIDX; gi < (long)(N); gi += (long)nblk * NTHR) { CALL; }
#ifndef PROBE
#define PROBE 0
#endif
#ifndef FAST_SCAN
#define FAST_SCAN 1
#endif
constexpr int N_PHASES = 16;
constexpr int MEGA_LDS = GEMM_LDS > TOPK_LDS ? GEMM_LDS : TOPK_LDS;

template <int PH>
DI void run_phase(const Params& p, int l, char* lds, int bid, int nblk) {
  const int need_ctx = (l == 0);
  const int rows = need_ctx ? R : RL;
  const float* xl_in = l == 0 ? p.x : p.out;
  const float* xc_in = l == 0 ? p.ctx : p.xc;
  bf16_t* QRAW = p.YO; bf16_t* KVRAW = p.YO + (size_t)R * 384;
  if constexpr (PH == 0) {
    ph_mods(p, lds, bid, nblk);
#pragma unroll 1
    for (int ll = 0; ll < 2; ++ll) {
      ph_wt(p.w_in + (size_t)ll * D * NZ, p.Wt_in + ll * WSZ_IN, D, NZ, NZP, 1, 0L, 0L, nullptr, lds, bid, nblk);
      ph_wt(p.w_gate + (size_t)ll * D * 4096, p.Wt_gate + ll * WSZ_GATE, D, 4096, 4096, 1, 0L, 0L, nullptr, lds, bid, nblk);
      ph_wt(p.w_branch + (size_t)ll * 4 * 256 * D, p.Wt_branch + ll * WSZ_BR, 256, D, D, 4, (long)256 * D, (long)D * 256, nullptr, lds, bid, nblk);
      ph_wt(p.w_out + (size_t)ll * D * D, p.Wt_out + ll * WSZ_OUT, D, D, D, 1, 0L, 0L, nullptr, lds, bid, nblk);
      ph_wt(p.w_uq + (size_t)ll * 256 * 384, p.Wt_uq + ll * WSZ_UQ, 256, 384, 384, 1, 0L, 0L, p.g_q_lat + ll * 256, lds, bid, nblk);
      ph_wt(p.w_ukv + (size_t)ll * 128 * 512, p.Wt_ukv + ll * WSZ_UKV, 128, 512, 512, 1, 0L, 0L, p.g_kv_lat + ll * 128, lds, bid, nblk);
    }
  } else if constexpr (PH == 1) {
    ph_modulate(p, l, xl_in, xc_in, bid, nblk);
  } else if constexpr (PH == 2) {
    ph_gemm_plain(p.H, D, p.Wt_in + l * WSZ_IN, D, R, NZP, D, p.Z, NZP, lds, bid, nblk);
#if PROBE == 63
    ph_gemm_probe<3>(p.H, D, p.Wt_in + l * WSZ_IN, D, R, NZP, D, p.mods + 40000, lds, bid, nblk);
#elif PROBE == 66
    ph_gemm_probe<6>(p.H, D, p.Wt_in + l * WSZ_IN, D, R, NZP, D, p.mods + 40000, lds, bid, nblk);
#elif PROBE == 67
    ph_gemm_plain<1>(p.H, D, p.Wt_in + l * WSZ_IN, D, R, NZP, D, p.Z, NZP, lds, bid, nblk);
#elif PROBE == 5
    ph_gemm_plain(p.H, D, p.Wt_in + l * WSZ_IN, D, R, NZP, D, p.Z, NZP, lds, bid, nblk);
#endif
  } else if constexpr (PH == 3) {
    ph_mla_up(p, l, QRAW, KVRAW, lds, bid, nblk);
  } else if constexpr (PH == 4) {
    ph_prep(p, l, QRAW, KVRAW, lds, bid, nblk);
#if PROBE == 41
    ph_prep(p, l, QRAW, KVRAW, lds, bid, nblk);
#elif PROBE == 43
    ph_prep<1>(p, l, QRAW, KVRAW, lds, bid, nblk);
#elif PROBE == 44
    ph_prep<2>(p, l, QRAW, KVRAW, lds, bid, nblk);
#endif
    __syncthreads();
    ph_gates_cum(p, l, lds, bid, nblk);
#if PROBE == 42
    ph_gates_cum(p, l, lds, bid, nblk);
#endif
  } else if constexpr (PH == 5) {
#if FAST_SCAN
    ph_ml_local(p, lds, bid, nblk);
    ph_gla_local(p, lds, bid, nblk);
#else
    GS_LOOP((long)NUNIT * 4160, nvb_ml_local(gi, p));
    GS_LOOP((long)NUNIT * 2048, nvb_gla_local(gi, p));
#endif
  } else if constexpr (PH == 6) {
#if FAST_SCAN
    ph_ml_scan(p, bid, nblk);
    ph_gla_scan(p, (bid + nblk - 260 % nblk) % nblk, nblk);
#else
    GS_LOOP((long)NB * 2 * 4 * 4160, nvb_ml_scan(gi, p));
    GS_LOOP((long)NB * 2 * 4 * 2048, nvb_gla_scan(gi, p));
#endif
    ph_attn(p, l, need_ctx, lds, bid, nblk);
#if PROBE >= 10 && PROBE < 20
    if (l == 0) ph_attn_mla_probe<PROBE - 10>(p, lds, bid, nblk);
#elif PROBE == 1
    ph_attn_diff(p, l, need_ctx, lds, bid, nblk);
#elif PROBE == 2
    ph_attn_mla(p, need_ctx, lds, bid, nblk);
#endif
  } else if constexpr (PH == 7) {
#if FAST_SCAN
    ph_ml_out(p, l, need_ctx, lds, bid, nblk);
    ph_gla_out(p, l, need_ctx, lds, bid, nblk);
#else
    GS_LOOP((long)NUNIT * 4096, nvb_ml_out(gi, p, need_ctx));
    GS_LOOP((long)NUNIT * 4096, nvb_gla_out(gi, p, need_ctx));
#endif
  } else if constexpr (PH == 8) {
#if !FAST_SCAN
    GS_LOOP((long)R * 4, nvb_ml_finish(gi, p, l, need_ctx));
    GS_LOOP((long)R * 4, nvb_gla_finish(gi, p, l, need_ctx));
#endif
  } else if constexpr (PH == 9) {
    ph_merge(p, l, rows, lds, bid, nblk);
#if PROBE == 3
    ph_merge(p, l, rows, lds, bid, nblk);
#endif
  } else if constexpr (PH == 10) {
    ph_gemm_plain(p.MG, D, p.Wt_out + l * WSZ_OUT, D, rows, D, D, p.YO, D, lds, bid, nblk);
  } else if constexpr (PH == 11) {
    ph_resid_mix(p, l, xl_in, xc_in, rows, bid, nblk);
  } else if constexpr (PH == 12) {
    ph_topk(p, need_ctx, lds, bid, nblk);
    ph_wt(p.w_e_gate + (size_t)l * NE * D * FF, p.Wt_eg, D, FF, FF, NE, (long)D * FF, (long)FF * D, nullptr, lds, bid, nblk);
    ph_wt(p.w_e_up + (size_t)l * NE * D * FF, p.Wt_eu, D, FF, FF, NE, (long)D * FF, (long)FF * D, nullptr, lds, bid, nblk);
    ph_wt(p.w_e_down + (size_t)l * NE * FF * D, p.Wt_ed, FF, D, D, NE, (long)FF * D, (long)D * FF, nullptr, lds, bid, nblk);
  } else if constexpr (PH == 13) {
    ph_moe1(p, need_ctx, lds, bid, nblk);
#if PROBE == 4
    ph_moe1(p, need_ctx, lds, bid, nblk);
#endif
  } else if constexpr (PH == 14) {
    ph_moe2(p, need_ctx, lds, bid, nblk);
#if PROBE == 4
    ph_moe2(p, need_ctx, lds, bid, nblk);
#endif
  } else if constexpr (PH == 15) {
    ph_resid_ffn(p, l, rows, bid, nblk);
  }
}

template <int PH> __global__ void __launch_bounds__(256, 2) k_phase(Params p, int l) {
  DYN_LDS(lds);
  run_phase<PH>(p, l, lds, blockIdx.x, gridDim.x);
}

#if !defined(CPU_EMU) && !MK_MULTI
typedef const Params __attribute__((address_space(4)))* KParams;
DI KParams kp_fresh() { KParams k = (KParams)__builtin_amdgcn_kernarg_segment_ptr(); asm volatile("" : "+s"(k)); return k; }
#define PHASE(PH, L) do { asm volatile("; PHASE_MARK " #PH); KParams k_ = kp_fresh(); run_phase<PH>(*(const Params*)k_, (L), lds, bid, nblk); if (PROBE == 20 + PH || (PROBE == 99 && (PH == 4 || PH == 5))) { __syncthreads(); run_phase<PH>(*(const Params*)k_, (L), lds, bid, nblk); } XcdBarrier b_ = bar; asm volatile("" : "+s"(b_.bar), "+s"(b_.x)); xcd_barrier(b_); if (PROBE == 50) xcd_barrier(b_); } while (0)
__global__ void __launch_bounds__(256, 2) k_mega(Params pv) {
  DYN_LDS(lds_all);
  if (threadIdx.x == 0) *(uint4*)lds_all = make_uint4(0u, 0u, 0u, 0u);
  __syncthreads();
  XcdBarrier bar = xcd_barrier_post(pv.bar, (volatile LAS unsigned*)lds_all);
  char* lds = lds_all + 256;
  const int bid = blockIdx.x, nblk = gridDim.x;
  PHASE(0, 0);
#pragma unroll 1
  for (int l = 0; l < 2; ++l) {
    PHASE(1, l); PHASE(2, l); PHASE(3, l); PHASE(4, l); PHASE(5, l); PHASE(6, l); PHASE(7, l);
#if !FAST_SCAN
    PHASE(8, l);
#endif

    PHASE(9, l); PHASE(10, l); PHASE(11, l); PHASE(12, l); PHASE(13, l); PHASE(14, l); PHASE(15, l);
  }
}
#endif
#ifdef CPU_EMU
void emu_check(const Params& p, int layer, int stage);
#define EMU_CHECK(stg) emu_check(p, l, stg)
static int g_nlayers = getenv("NLAYERS") ? atoi(getenv("NLAYERS")) : 2;
#else
#define EMU_CHECK(stg)
#endif
static void fill_params(Params& p, void* const* d_in, void* d_out, void* d_ws) {
  const float** f = (const float**)&p;
  for (int i = 0; i < 33; ++i) f[i] = (const float*)d_in[i];
  p.out = (float*)d_out;
  map_workspace(p, (char*)d_ws);
}
#define LAUNCH_PHASE(PH, L) LAUNCH((k_phase<PH>), grid, 256, MEGA_LDS, stream, p, L)

extern "C" void kernel_launch(void* const* d_in, const int* in_sizes, int n_in, void* d_out, int out_size, void* d_ws,
                              size_t ws_size, hipStream_t stream) {
  Params p{};
  fill_params(p, d_in, d_out, d_ws);
  if (p.ws_need > ws_size) return;
#ifdef CPU_EMU
  const int grid = 16;
  LAUNCH_PHASE(0, 0);
  for (int l = 0; l < g_nlayers; ++l) {
    LAUNCH_PHASE(1, l); LAUNCH_PHASE(2, l); LAUNCH_PHASE(3, l); LAUNCH_PHASE(4, l); LAUNCH_PHASE(5, l); LAUNCH_PHASE(6, l); LAUNCH_PHASE(7, l); LAUNCH_PHASE(8, l);
    EMU_CHECK(1);
    LAUNCH_PHASE(9, l); LAUNCH_PHASE(10, l); LAUNCH_PHASE(11, l);
    EMU_CHECK(2);
    LAUNCH_PHASE(12, l); LAUNCH_PHASE(13, l); LAUNCH_PHASE(14, l); LAUNCH_PHASE(15, l);
    EMU_CHECK(3);
  }
#else
  static int grid = 0;
  if (grid == 0) {
    int dev = 0, cus = 0, per_cu = 0;
    (void)hipGetDevice(&dev);
    (void)hipDeviceGetAttribute(&cus, hipDeviceAttributeMultiprocessorCount, dev);
#if MK_MULTI
    (void)hipFuncSetAttribute((const void*)k_phase<0>, hipFuncAttributeMaxDynamicSharedMemorySize, MEGA_LDS);
    (void)hipFuncSetAttribute((const void*)k_phase<1>, hipFuncAttributeMaxDynamicSharedMemorySize, MEGA_LDS);
    (void)hipFuncSetAttribute((const void*)k_phase<2>, hipFuncAttributeMaxDynamicSharedMemorySize, MEGA_LDS);
    (void)hipFuncSetAttribute((const void*)k_phase<3>, hipFuncAttributeMaxDynamicSharedMemorySize, MEGA_LDS);
    (void)hipFuncSetAttribute((const void*)k_phase<4>, hipFuncAttributeMaxDynamicSharedMemorySize, MEGA_LDS);
    (void)hipFuncSetAttribute((const void*)k_phase<5>, hipFuncAttributeMaxDynamicSharedMemorySize, MEGA_LDS);
    (void)hipFuncSetAttribute((const void*)k_phase<6>, hipFuncAttributeMaxDynamicSharedMemorySize, MEGA_LDS);
    (void)hipFuncSetAttribute((const void*)k_phase<7>, hipFuncAttributeMaxDynamicSharedMemorySize, MEGA_LDS);
    (void)hipFuncSetAttribute((const void*)k_phase<8>, hipFuncAttributeMaxDynamicSharedMemorySize, MEGA_LDS);
    (void)hipFuncSetAttribute((const void*)k_phase<9>, hipFuncAttributeMaxDynamicSharedMemorySize, MEGA_LDS);
    (void)hipFuncSetAttribute((const void*)k_phase<10>, hipFuncAttributeMaxDynamicSharedMemorySize, MEGA_LDS);
    (void)hipFuncSetAttribute((const void*)k_phase<11>, hipFuncAttributeMaxDynamicSharedMemorySize, MEGA_LDS);
    (void)hipFuncSetAttribute((const void*)k_phase<12>, hipFuncAttributeMaxDynamicSharedMemorySize, MEGA_LDS);
    (void)hipFuncSetAttribute((const void*)k_phase<13>, hipFuncAttributeMaxDynamicSharedMemorySize, MEGA_LDS);
    (void)hipFuncSetAttribute((const void*)k_phase<14>, hipFuncAttributeMaxDynamicSharedMemorySize, MEGA_LDS);
    (void)hipFuncSetAttribute((const void*)k_phase<15>, hipFuncAttributeMaxDynamicSharedMemorySize, MEGA_LDS);
    grid = (cus > 0 ? cus : 256) * 2;
#else
    if (hipFuncSetAttribute((const void*)k_mega, hipFuncAttributeMaxDynamicSharedMemorySize, MEGA_LDS + 256) != hipSuccess) { grid = -1; return; }
    if (hipOccupancyMaxActiveBlocksPerMultiprocessor(&per_cu, (const void*)k_mega, 256, MEGA_LDS + 256) != hipSuccess) per_cu = 0;
    (void)hipGetLastError();
    if (per_cu < 1) { grid = -1; return; }
    grid = (cus > 0 ? cus : 256) * (per_cu < 2 ? per_cu : 2);
#endif
  }
  if (grid < 0) return;
#if MK_MULTI
  LAUNCH_PHASE(0, 0);
  for (int l = 0; l < 2; ++l) {
    LAUNCH_PHASE(1, l); LAUNCH_PHASE(2, l); LAUNCH_PHASE(3, l); LAUNCH_PHASE(4, l); LAUNCH_PHASE(5, l); LAUNCH_PHASE(6, l); LAUNCH_PHASE(7, l); LAUNCH_PHASE(8, l);
    LAUNCH_PHASE(9, l); LAUNCH_PHASE(10, l); LAUNCH_PHASE(11, l); LAUNCH_PHASE(12, l); LAUNCH_PHASE(13, l); LAUNCH_PHASE(14, l); LAUNCH_PHASE(15, l);
  }
#else
  (void)hipMemsetAsync(p.bar, 0, XCD_BAR_WORDS * sizeof(unsigned), stream);
  k_mega<<<dim3(grid), dim3(256), MEGA_LDS + 256, stream>>>(p);
#endif
#endif
}
```

```cpp
#ifndef CPU_EMU
#include <hip/hip_runtime.h>
#endif
#include <stdint.h>
#include <stddef.h>

#ifndef T_LAT
#define T_LAT 16384
#endif
#ifndef T_CTX
#define T_CTX 256
#endif

#ifndef MK_MULTI
#define MK_MULTI 0
#endif
#define DI __device__ __forceinline__
typedef unsigned short bf16_t;
typedef short bf16x8 __attribute__((ext_vector_type(8)));
typedef short s16x4 __attribute__((ext_vector_type(4)));
typedef float f32x4 __attribute__((ext_vector_type(4)));
typedef float f32x16 __attribute__((ext_vector_type(16)));
typedef unsigned u32x4 __attribute__((ext_vector_type(4)));
typedef unsigned u32x2 __attribute__((ext_vector_type(2)));
typedef float f32x2 __attribute__((ext_vector_type(2)));

#ifdef CPU_EMU
static inline float u2f(unsigned u) { float f; memcpy(&f, &u, 4); return f; }
static inline unsigned f2u(float f) { unsigned u; memcpy(&u, &f, 4); return u; }
#define MFMA32(a, b, c) emu_mfma_32x32x16((a), (b), (c))
#define MFMA16(a, b, c) emu_mfma_16x16x32((a), (b), (c))
static inline float fast_exp2(float x) { return exp2f(x); }
static inline float fast_rcp(float x) { return 1.0f / x; }
static inline float fast_rsq(float x) { return 1.0f / sqrtf(x); }
static inline float hw_sin_rev(float x) { return sinf(6.283185307179586f * x); }
static inline float hw_cos_rev(float x) { return cosf(6.283185307179586f * x); }
#define LAUNCH(kern, grid, block, lds, stream, ...) emu::launch(dim3(grid), dim3(block), (size_t)(lds), [=]() { kern(__VA_ARGS__); })
#define DYN_LDS(name) char* name = emu_dynlds()
#define SCHED_BARRIER()
#define TIDX ((int)threadIdx.x)
#define WAVE_SYNC() emu::wave_barrier()
#define SETPRIO(x)
#define IGLP_OPT()
template <int M> static inline float xor_sum(float v) { return v + __shfl_xor(v, M); }
template <int M> static inline float xor_max(float v) { return fmaxf(v, __shfl_xor(v, M)); }
template <int M> static inline int xor_sum_i(int v) { return v + __shfl_xor(v, M); }
static inline int lane_bcast(int v, int src) { return __shfl(v, src); }
static inline int lane_up(int v, int d, int lane) { (void)lane; return __shfl_up(v, d); }
#else
DI float u2f(unsigned u) { return __uint_as_float(u); }
DI unsigned f2u(float f) { return __float_as_uint(f); }
#define MFMA32(a, b, c) __builtin_amdgcn_mfma_f32_32x32x16_bf16((a), (b), (c), 0, 0, 0)
#define MFMA16(a, b, c) __builtin_amdgcn_mfma_f32_16x16x32_bf16((a), (b), (c), 0, 0, 0)
DI float fast_exp2(float x) { return __builtin_amdgcn_exp2f(x); }
DI float fast_rcp(float x) { return __builtin_amdgcn_rcpf(x); }
DI float fast_rsq(float x) { return __builtin_amdgcn_rsqf(x); }
DI float hw_sin_rev(float x) { return __builtin_amdgcn_sinf(x); }
DI float hw_cos_rev(float x) { return __builtin_amdgcn_cosf(x); }
#define LAUNCH(kern, grid, block, lds, stream, ...) kern<<<dim3(grid), dim3(block), (lds), (stream)>>>(__VA_ARGS__)
#define DYN_LDS(name) extern __shared__ __attribute__((aligned(16))) char name[]
#define SCHED_BARRIER() __builtin_amdgcn_sched_barrier(0)
DI int tid_fresh() { int t = (int)threadIdx.x; asm volatile("" : "+v"(t)); return t; }
#define TIDX tid_fresh()
#define WAVE_SYNC() __builtin_amdgcn_wave_barrier()
#define SETPRIO(x) __builtin_amdgcn_s_setprio(x)
#define IGLP_OPT() __builtin_amdgcn_iglp_opt(0)
#ifdef USE_SHFL
template <int M> DI float xor_sum(float v) { return v + __shfl_xor(v, M); }
template <int M> DI float xor_max(float v) { return fmaxf(v, __shfl_xor(v, M)); }
template <int M> DI int xor_sum_i(int v) { return v + __shfl_xor(v, M); }
DI int lane_bcast(int v, int src) { return __shfl(v, src); }
DI int lane_up(int v, int d, int lane) { (void)lane; return __shfl_up(v, d); }
#else
template <int M> DI int xor_partner_bits(int bits) { return __builtin_amdgcn_ds_swizzle(bits, (M << 10) | 0x1f); }
DI void half_swap(unsigned& a, unsigned& b) { asm volatile("s_nop 1\n\tv_permlane32_swap_b32 %0, %1\n\ts_nop 1" : "+v"(a), "+v"(b)); }
template <int M> DI float xor_sum(float v) {
  if constexpr (M < 32) return v + __builtin_bit_cast(float, xor_partner_bits<M>(__builtin_bit_cast(int, v)));
  else { unsigned a = __builtin_bit_cast(unsigned, v), b = a; half_swap(a, b); return __builtin_bit_cast(float, a) + __builtin_bit_cast(float, b); }
}
template <int M> DI float xor_max(float v) {
  if constexpr (M < 32) return fmaxf(v, __builtin_bit_cast(float, xor_partner_bits<M>(__builtin_bit_cast(int, v))));
  else { unsigned a = __builtin_bit_cast(unsigned, v), b = a; half_swap(a, b); return fmaxf(__builtin_bit_cast(float, a), __builtin_bit_cast(float, b)); }
}
template <int M> DI int xor_sum_i(int v) {
  if constexpr (M < 32) return v + xor_partner_bits<M>(v);
  else { unsigned a = (unsigned)v, b = a; half_swap(a, b); return (int)(a + b); }
}
DI int lane_bcast(int v, int src) { return __builtin_amdgcn_readlane(v, src); }
DI int lane_up(int v, int d, int lane) { return __builtin_amdgcn_ds_bpermute(((lane - d) & 63) << 2, v); }
#endif
#endif

DI float bf2f(bf16_t v) { return u2f(((unsigned)v) << 16); }
#ifdef CPU_EMU
DI bf16_t f2bf(float f) { unsigned u = f2u(f); u += 0x7fffu + ((u >> 16) & 1u); return (bf16_t)(u >> 16); }
DI unsigned pack2bf(float lo, float hi) { return (unsigned)f2bf(lo) | ((unsigned)f2bf(hi) << 16); }
static inline bool wave_any(bool pr) { int v = pr ? 1 : 0; v |= __shfl_xor(v, 1); v |= __shfl_xor(v, 2); v |= __shfl_xor(v, 4); v |= __shfl_xor(v, 8); v |= __shfl_xor(v, 16); v |= __shfl_xor(v, 32); return v != 0; }
#else
typedef float f32x2_ __attribute__((ext_vector_type(2)));
typedef __bf16 bf16x2_hw __attribute__((ext_vector_type(2)));
DI unsigned pack2bf(float lo, float hi) { const f32x2_ v = {lo, hi}; return __builtin_bit_cast(unsigned, __builtin_convertvector(v, bf16x2_hw)); }
DI bf16_t f2bf(float f) { return (bf16_t)(pack2bf(f, f) & 0xffffu); }
DI bool wave_any(bool pr) { return __builtin_amdgcn_ballot_w64(pr) != 0ull; }
#endif
DI float sigmoidf_(float x) { return 1.0f / (1.0f + expf(-x)); }
DI float siluf_(float x) { return x / (1.0f + expf(-x)); }
DI float logsigmoidf_(float x) { return fminf(x, 0.0f) - log1pf(expf(-fabsf(x))); }

constexpr int D = 1024, NB = 2, TL = T_LAT, TC = T_CTX, TK = TL + TC;
constexpr int RL = NB * TL, RC = NB * TC, R = RL + RC;
constexpr int NZ = 3024, NZP = 3072;
constexpr int ZC_QLAT = 0, ZC_KVLAT = 256, ZC_KROPE = 384, ZC_MLQK = 416, ZC_MLV = 928, ZC_MLO = 1184, ZC_MLIG = 1440,
              ZC_MLFG = 1448, ZC_GQ = 1456, ZC_GK = 1584, ZC_GV = 1712, ZC_GR = 1968, ZC_GA = 2224, ZC_DQ = 2256,
              ZC_DK = 2512, ZC_DV = 2768;
constexpr int NCK = TK / 64, NCC = TC / 64, NCL = TL / 64;
constexpr int NE = 16, FF = 1408, CAPL = 2 * TL / 16, CAPC = 2 * TC / 16, CAPT = CAPL + CAPC, NSLOT = NB * CAPT;
constexpr size_t WSZ_IN = (size_t)NZP * D, WSZ_UQ = 384 * 256, WSZ_UKV = 512 * 128, WSZ_GATE = (size_t)4096 * D, WSZ_BR = (size_t)4 * D * 256, WSZ_OUT = (size_t)D * D;
constexpr int NUNIT = NB * 2 * NCK * 4;
constexpr float LOG2E = 1.4426950408889634f;
constexpr float QS_MLA = 0.10206207261596577f * LOG2E;
constexpr float QS_DIFF = 0.17677669529663687f * LOG2E;

DI int row_of(int b, int s) { return s < TC ? RL + b * TC + s : b * TL + (s - TC); }
DI void bs_of(int r, int& b, int& s) { if (r < RL) { b = r / TL; s = TC + (r % TL); } else { int q = r - RL; b = q / TC; s = q % TC; } }
DI int seq_of(int d, int p) { return d == 0 ? p : (p < TC ? TC - 1 - p : TK - 1 - (p - TC)); }
DI int step_of(int d, int c) { return d == 0 ? c : (c < NCC ? NCC - 1 - c : NCC + (NCK - 1 - c)); }

struct Params {
  const float *x, *c, *ctx, *c_ctx, *w_ada, *b_ada, *g_mix_pre, *g_mix_post, *g_ffn_pre, *g_ffn_post, *w_in, *g_q_lat, *w_uq,
      *g_kv_lat, *w_ukv, *w_conv, *b_conv, *b_igate, *b_fgate, *g_mlstm_out, *w_alpha2, *b_alpha, *g_gla_out, *diff_lambda,
      *g_diff_out, *w_branch, *w_gate, *b_gate, *w_out, *w_router, *w_e_gate, *w_e_up, *w_e_down;
  float* out;
  float *mods, *xc;
  bf16_t *H, *Z, *Qm, *Km, *Vtm, *Qd, *Kd, *Vtd, *MQ, *MK, *Y, *MG, *YO, *HID, *YE, *MVt, *GVt;
  float *BC, *IGS, *GC, *MC, *MN, *MM, *GS, *HD, *OD, *AFF, *SELV;
  int *SEL, *INV;
  bf16_t *Wt_in, *Wt_uq, *Wt_ukv, *Wt_gate, *Wt_branch, *Wt_out, *Wt_eg, *Wt_eu, *Wt_ed;
  unsigned* bar;
  size_t ws_need;
};

static inline size_t al256(size_t x) { return (x + 255) & ~(size_t)255; }
static inline void map_workspace(Params& p, char* ws) {
  size_t o = 0;
  auto take = [&](size_t bytes) { size_t r = o; o += al256(bytes); return ws + r; };
  p.bar = (unsigned*)take(16384);
  p.mods = (float*)take((size_t)2 * 3 * 6144 * 4);
  p.xc = (float*)take((size_t)RC * D * 4);
  p.BC = (float*)take((size_t)NB * 2 * TK * 4 * 4);
  p.IGS = (float*)take((size_t)NB * 2 * TK * 4 * 4);
  p.AFF = (float*)take((size_t)NB * NE * TK * 4);
  p.SEL = (int*)take((size_t)NE * NSLOT * 4);
  p.SELV = (float*)take((size_t)NE * NSLOT * 4);
  p.INV = (int*)take((size_t)R * NE * 4);
  p.MM = (float*)take((size_t)NUNIT * 4 * 4);
  p.MN = (float*)take((size_t)NUNIT * 64 * 4);
  p.Wt_in = (bf16_t*)take((size_t)2 * WSZ_IN * 2);
  p.Wt_uq = (bf16_t*)take((size_t)2 * WSZ_UQ * 2);
  p.Wt_ukv = (bf16_t*)take((size_t)2 * WSZ_UKV * 2);
  p.Wt_gate = (bf16_t*)take((size_t)2 * WSZ_GATE * 2);
  p.Wt_branch = (bf16_t*)take((size_t)2 * WSZ_BR * 2);
  p.Wt_out = (bf16_t*)take((size_t)2 * WSZ_OUT * 2);
  p.H = (bf16_t*)take((size_t)R * D * 2);
  size_t szA = (size_t)R * NZP * 2, szHID = (size_t)NE * NSLOT * FF * 2;
  char* A = take(szA > szHID ? szA : szHID);
  p.Z = (bf16_t*)A; p.HID = (bf16_t*)A;
  size_t szQm = al256((size_t)NB * 4 * TK * 96 * 2), szVt = al256((size_t)NB * 4 * 64 * TK * 2), szQd = al256((size_t)NB * 8 * TK * 32 * 2);
  size_t szB1 = 2 * szQm + 2 * szVt + 2 * szQd;
  size_t szHD = al256((size_t)2 * NB * TK * 256 * 4);
  size_t szYE = (size_t)NE * NSLOT * D * 2;
  size_t szB = szB1; if (2 * szHD > szB) szB = 2 * szHD; if (szYE > szB) szB = szYE;
  char* Bq = take(szB);
  p.Qm = (bf16_t*)Bq; p.Km = (bf16_t*)(Bq + szQm); p.Vtm = (bf16_t*)(Bq + 2 * szQm);
  p.Qd = (bf16_t*)(Bq + 2 * szQm + szVt); p.Kd = (bf16_t*)(Bq + 2 * szQm + szVt + szQd); p.Vtd = (bf16_t*)(Bq + 2 * szQm + szVt + 2 * szQd);
  p.YE = (bf16_t*)Bq;
  p.GC = (float*)take((size_t)NB * 2 * TK * 128 * 4);
  p.MVt = (bf16_t*)take((size_t)NB * 4 * 64 * TK * 2);
  p.GVt = (bf16_t*)take((size_t)NB * 4 * 64 * TK * 2);
  size_t szW = (size_t)NE * FF * D * 2;
  size_t szMC = (size_t)NUNIT * 4096 * 4, szRD = (size_t)R * D * 2;
  size_t szC = szMC; if (szRD > szC) szC = szRD; if (szW > szC) szC = szW;
  char* C = take(szC);
  p.MC = (float*)C; p.MG = (bf16_t*)C; p.Wt_eg = (bf16_t*)C;
  size_t szMQ = al256((size_t)NB * TK * 256 * 2), szGS = (size_t)NUNIT * 2048 * 4;
  size_t szD = 2 * szMQ + szGS; if (szW > szD) szD = szW;
  char* Dq = take(szD);
  p.MQ = (bf16_t*)Dq; p.MK = (bf16_t*)(Dq + szMQ); p.GS = (float*)(Dq + 2 * szMQ); p.Wt_eu = (bf16_t*)Dq;
  size_t szF = 2 * szRD > szW ? 2 * szRD : szW;
  char* F = take(szF);
  p.Y = (bf16_t*)F; p.YO = (bf16_t*)(F + szRD); p.Wt_ed = (bf16_t*)F;
  p.HD = (float*)Bq; p.OD = (float*)(Bq + szHD);
  p.ws_need = o;
}
#define GTID ((long)blockIdx.x * blockDim.x + threadIdx.x)

DI float lam_of(const Params& p, int layer, float& lam_init) {
  const float* lv = p.diff_lambda + layer * 128;
  float s1 = 0.f, s2 = 0.f;
  for (int i = 0; i < 32; ++i) { s1 += lv[i] * lv[32 + i]; s2 += lv[64 + i] * lv[96 + i]; }
  lam_init = layer == 0 ? 0.2f : 0.35550906759096f;
  return expf(s1) - expf(s2) + lam_init;
}
DI void rope_cs(int s, int jj, float& cs, float& sn) {
  int t = s - TC;
  int pos = (jj < 16) ? (t / 64) : (t % 64);
  float ang = (float)pos * exp2f(-1.6609640474436813f * (float)(jj & 7));
  double rev = (double)ang * 0.15915494309189535;
  rev -= floor(rev + 0.5);
  float rf = (float)rev;
  cs = hw_cos_rev(rf); sn = hw_sin_rev(rf);
}
template <class G> DI float rope_elem(G get, int s, int jj) {
  if (s < TC) return get(jj);
  float cs, sn; rope_cs(s, jj, cs, sn);
  float a = get(jj), b = get(jj ^ 8);
  return (jj & 8) ? (a * cs + b * sn) : (a * cs - b * sn);
}

DI void nvb_mods(long GI, const Params& p) {
  long i = GI; if (i >= 2 * 3 * 6144) return;
  int col = (int)(i % 6144), w = (int)((i / 6144) % 3), l = (int)(i / (3 * 6144));
  const float* cv = w < 2 ? p.c + w * 1024 : p.c_ctx;
  const float* W = p.w_ada + (size_t)l * 1024 * 6144;
  float acc = 0.f;
  for (int k = 0; k < 1024; ++k) acc += siluf_(cv[k]) * W[(size_t)k * 6144 + col];
  p.mods[i] = acc + p.b_ada[l * 6144 + col];
}
__global__ void __launch_bounds__(256) nv_wt(const float* in, bf16_t* out, int K, int N, int NP, long in_bs, long out_bs, const float* gain) {
  long i = GTID; if (i >= (long)NP * K) return;
  int k = (int)(i % K), n = (int)(i / K);
  const float* I = in + (size_t)blockIdx.y * in_bs; bf16_t* O = out + (size_t)blockIdx.y * out_bs;
  O[(size_t)n * K + k] = n < N ? f2bf(I[(size_t)k * N + n] * (gain ? gain[k] : 1.0f)) : (bf16_t)0;
}
__global__ void __launch_bounds__(256) nv_modulate(Params p, int layer, int which, const float* xl, const float* xcx, int nrows) {
  long r = GTID; if (r >= nrows) return;
  int w = r < RL ? (int)(r / TL) : 2;
  const float* mb = p.mods + (size_t)(layer * 3 + w) * 6144;
  const float* shift = mb + (which ? 3 : 0) * 1024; const float* scale = mb + (which ? 4 : 1) * 1024;
  const float* g = (which ? p.g_ffn_pre : p.g_mix_pre) + layer * 1024;
  const float* x = r < RL ? xl + (size_t)r * D : xcx + (size_t)(r - RL) * D;
  float ss = 0.f; for (int k = 0; k < D; ++k) ss += x[k] * x[k];
  float rstd = 1.0f / sqrtf(ss / D + 1e-6f);
  for (int k = 0; k < D; ++k) p.H[(size_t)r * D + k] = f2bf(x[k] * rstd * g[k] * (1.f + scale[k]) + shift[k]);
}
__global__ void __launch_bounds__(256) nv_gemm(const bf16_t* A, int lda, const bf16_t* Bt, int ldb, int M, int N, int K, bf16_t* C, int ldc) {
  long i = GTID; if (i >= (long)M * N) return;
  int n = (int)(i % N), m = (int)(i / N);
  const bf16_t* a = A + (size_t)m * lda; const bf16_t* b = Bt + (size_t)n * ldb;
  float acc = 0.f;
  for (int k = 0; k < K; ++k) acc += bf2f(a[k]) * bf2f(b[k]);
  C[(size_t)m * ldc + n] = f2bf(acc);
}
__global__ void __launch_bounds__(256) nv_mla_q(Params p, int layer) {
  long i = GTID; if (i >= (long)R * 4 * 96) return;
  int j = (int)(i % 96), h = (int)((i / 96) % 4), r = (int)(i / 384);
  int b, s; bs_of(r, b, s);
  const bf16_t* z = p.Z + (size_t)r * NZP + ZC_QLAT;
  const float* g = p.g_q_lat + layer * 256; const float* W = p.w_uq + (size_t)layer * 256 * 384;
  float ss = 0.f; for (int k = 0; k < 256; ++k) { float v = bf2f(z[k]); ss += v * v; }
  float rstd = 1.0f / sqrtf(ss / 256 + 1e-6f);
  auto dot = [&](int col) { float a = 0.f; for (int k = 0; k < 256; ++k) a += bf2f(z[k]) * rstd * g[k] * W[(size_t)k * 384 + col]; return a; };
  float v;
  if (j < 64) v = dot(h * 96 + j);
  else v = rope_elem([&](int jj) { return dot(h * 96 + 64 + jj); }, s, j - 64);
  p.Qm[(((size_t)b * 4 + h) * TK + s) * 96 + j] = f2bf(v * QS_MLA);
}
__global__ void __launch_bounds__(256) nv_mla_kv(Params p, int layer) {
  long i = GTID; if (i >= (long)R * 4 * 160) return;
  int j = (int)(i % 160), h = (int)((i / 160) % 4), r = (int)(i / 640);
  int b, s; bs_of(r, b, s);
  const bf16_t* z = p.Z + (size_t)r * NZP;
  if (j < 128) {
    const bf16_t* zl = z + ZC_KVLAT; const float* g = p.g_kv_lat + layer * 128; const float* W = p.w_ukv + (size_t)layer * 128 * 512;
    float ss = 0.f; for (int k = 0; k < 128; ++k) { float v = bf2f(zl[k]); ss += v * v; }
    float rstd = 1.0f / sqrtf(ss / 128 + 1e-6f);
    float a = 0.f; for (int k = 0; k < 128; ++k) a += bf2f(zl[k]) * rstd * g[k] * W[(size_t)k * 512 + h * 128 + j];
    if (j < 64) p.Km[(((size_t)b * 4 + h) * TK + s) * 96 + j] = f2bf(a);
    else p.Vtm[(((size_t)b * 4 + h) * 64 + (j - 64)) * TK + s] = f2bf(a);
  } else {
    int jj = j - 128;
    float v = rope_elem([&](int q) { return bf2f(z[ZC_KROPE + q]); }, s, jj);
    p.Km[(((size_t)b * 4 + h) * TK + s) * 96 + 64 + jj] = f2bf(v);
  }
}
__global__ void __launch_bounds__(256) nv_diff_prep(Params p) {
  long i = GTID; if (i >= (long)R * 768) return;
  int c = (int)(i % 768), r = (int)(i / 768);
  int b, s; bs_of(r, b, s);
  const bf16_t* z = p.Z + (size_t)r * NZP;
  if (c < 512) {
    int qk = c / 256, cc = c % 256, hm = cc / 32, jj = cc % 32;
    const bf16_t* src = z + (qk ? ZC_DK : ZC_DQ) + hm * 32;
    float v = rope_elem([&](int q) { return bf2f(src[q]); }, s, jj);
    if (qk == 0) p.Qd[(((size_t)b * 8 + hm) * TK + s) * 32 + jj] = f2bf(v * QS_DIFF);
    else p.Kd[(((size_t)b * 8 + hm) * TK + s) * 32 + jj] = f2bf(v);
  } else {
    int cc = c - 512, h = cc / 64, dv = cc % 64;
    p.Vtd[(((size_t)b * 4 + h) * 64 + dv) * TK + s] = z[ZC_DV + cc];
  }
}
__global__ void __launch_bounds__(256) nv_ml_prep(Params p, int layer) {
  long i = GTID; if (i >= (long)R * 512) return;
  int ch = (int)(i % 512), r = (int)(i / 512);
  int b, s; bs_of(r, b, s);
  bool first = (s == 0) || (s == TC), last = (s == TC - 1) || (s == TK - 1);
  const float* w = p.w_conv + (size_t)layer * 3 * 512;
  float acc = p.b_conv[layer * 512 + ch];
  acc += bf2f(p.Z[(size_t)r * NZP + ZC_MLQK + ch]) * w[512 + ch];
  if (!first) acc += bf2f(p.Z[(size_t)row_of(b, s - 1) * NZP + ZC_MLQK + ch]) * w[ch];
  if (!last) acc += bf2f(p.Z[(size_t)row_of(b, s + 1) * NZP + ZC_MLQK + ch]) * w[1024 + ch];
  float v = siluf_(acc);
  if (ch < 256) p.MQ[((size_t)b * TK + s) * 256 + ch] = f2bf(v);
  else p.MK[((size_t)b * TK + s) * 256 + ch - 256] = f2bf(v * 0.125f);
}
DI void nvb_ml_gates(long GI, const Params& p, int layer) {
  long i = GI; if (i >= (long)NB * 2 * NCK * 4) return;
  int h = (int)(i % 4), j = (int)((i / 4) % NCK), d = (int)((i / (4 * NCK)) % 2), b = (int)(i / (8 * NCK));
  float bi = p.b_igate[layer * 8 + d * 4 + h], bfg = p.b_fgate[layer * 8 + d * 4 + h];
  float cum = 0.f;
  for (int l = 0; l < 64; ++l) {
    int pp = 64 * j + l, s = seq_of(d, pp); const bf16_t* z = p.Z + (size_t)row_of(b, s) * NZP;
    float ig = bf2f(z[ZC_MLIG + d * 4 + h]) + bi;
    float lf = logsigmoidf_(bf2f(z[ZC_MLFG + d * 4 + h]) + bfg);
    cum += lf;
    size_t o = (((size_t)b * 2 + d) * TK + pp) * 4 + h;
    p.BC[o] = cum; p.IGS[o] = ig;
  }
}
DI void nvb_gla_cum(long GI, const Params& p, int layer) {
  long i = GI; if (i >= (long)NB * 2 * NCK * 128) return;
  int ch = (int)(i % 128), j = (int)((i / 128) % NCK), d = (int)((i / (128 * NCK)) % 2), b = (int)(i / (256 * NCK));
  const float* W = p.w_alpha2 + (size_t)layer * 2 * 16 * 128 + (size_t)d * 16 * 128;
  float ba = p.b_alpha[layer * 256 + d * 128 + ch];
  float cum = 0.f;
  for (int l = 0; l < 64; ++l) {
    int pp = 64 * j + l, s = seq_of(d, pp); const bf16_t* z = p.Z + (size_t)row_of(b, s) * NZP + ZC_GA + d * 16;
    float zg = ba; for (int q = 0; q < 16; ++q) zg += bf2f(z[q]) * W[q * 128 + ch];
    cum += logsigmoidf_(zg) * (1.0f / 16.0f);
    p.GC[(((size_t)b * 2 + d) * TK + pp) * 128 + ch] = cum;
  }
}
__global__ void __launch_bounds__(256) nv_attn_mla(Params p, int need_ctx) {
  long i = GTID; if (i >= (long)NB * 4 * TK) return;
  int s = (int)(i % TK), h = (int)((i / TK) % 4), b = (int)(i / (4 * TK));
  if (s < TC && !need_ctx) return;
  int nk = s < TC ? TC : TK;
  const bf16_t* q = p.Qm + (((size_t)b * 4 + h) * TK + s) * 96;
  const bf16_t* K = p.Km + ((size_t)b * 4 + h) * TK * 96;
  const bf16_t* Vt = p.Vtm + ((size_t)b * 4 + h) * 64 * TK;
  float qf[96], o[64];
  _Pragma("unroll") for (int k = 0; k < 96; ++k) qf[k] = bf2f(q[k]);
  _Pragma("unroll") for (int k = 0; k < 64; ++k) o[k] = 0.f;
  float m = -1e30f, l = 0.f;
  for (int t = 0; t < nk; ++t) {
    float sc = 0.f; _Pragma("unroll") for (int k = 0; k < 96; ++k) sc += qf[k] * bf2f(K[(size_t)t * 96 + k]);
    float mn = fmaxf(m, sc), a = exp2f(m - mn), pr = exp2f(sc - mn);
    l = l * a + pr;
    _Pragma("unroll") for (int k = 0; k < 64; ++k) o[k] = o[k] * a + pr * bf2f(Vt[(size_t)k * TK + t]);
    m = mn;
  }
  int r = row_of(b, s);
  _Pragma("unroll") for (int k = 0; k < 64; ++k) p.Y[(size_t)r * D + h * 64 + k] = f2bf(o[k] / l);
}
__global__ void __launch_bounds__(256) nv_attn_diff(Params p, int layer, int need_ctx) {
  long i = GTID; if (i >= (long)NB * 4 * TK) return;
  int s = (int)(i % TK), h = (int)((i / TK) % 4), b = (int)(i / (4 * TK));
  if (s < TC && !need_ctx) return;
  int nk = s < TC ? TC : TK;
  float lam_init; float lam = lam_of(p, layer, lam_init);
  const bf16_t* Vt = p.Vtd + ((size_t)b * 4 + h) * 64 * TK;
  float res[64];
  _Pragma("unroll") for (int k = 0; k < 64; ++k) res[k] = 0.f;
  _Pragma("unroll") for (int mp = 0; mp < 2; ++mp) {
    const bf16_t* q = p.Qd + (((size_t)b * 8 + h * 2 + mp) * TK + s) * 32;
    const bf16_t* K = p.Kd + ((size_t)b * 8 + h * 2 + mp) * TK * 32;
    float qf[32], o[64];
    _Pragma("unroll") for (int k = 0; k < 32; ++k) qf[k] = bf2f(q[k]);
    _Pragma("unroll") for (int k = 0; k < 64; ++k) o[k] = 0.f;
    float m = -1e30f, l = 0.f;
    for (int t = 0; t < nk; ++t) {
      float sc = 0.f; _Pragma("unroll") for (int k = 0; k < 32; ++k) sc += qf[k] * bf2f(K[(size_t)t * 32 + k]);
      float mn = fmaxf(m, sc), a = exp2f(m - mn), pr = exp2f(sc - mn);
      l = l * a + pr;
      _Pragma("unroll") for (int k = 0; k < 64; ++k) o[k] = o[k] * a + pr * bf2f(Vt[(size_t)k * TK + t]);
      m = mn;
    }
    float wgt = mp == 0 ? 1.f : -lam;
    _Pragma("unroll") for (int k = 0; k < 64; ++k) res[k] += wgt * o[k] / l;
  }
  float ss = 0.f; _Pragma("unroll") for (int k = 0; k < 64; ++k) ss += res[k] * res[k];
  float rstd = 1.0f / sqrtf(ss / 64 + 1e-6f);
  int r = row_of(b, s);
  _Pragma("unroll") for (int k = 0; k < 64; ++k) p.Y[(size_t)r * D + 768 + h * 64 + k] = f2bf(res[k] * rstd * p.g_diff_out[layer * 256 + h * 64 + k] * (1.f - lam_init));
}
DI void nvb_ml_local(long GI, const Params& p) {
  long i = GI; if (i >= (long)NUNIT * 4160) return;
  int e = (int)(i % 4160); long u = i / 4160;
  int h = (int)(u % 4), j = (int)((u / 4) % NCK), d = (int)((u / (4 * NCK)) % 2), b = (int)(u / (8 * NCK));
  const float* bc = p.BC + (((size_t)b * 2 + d) * TK + 64 * j) * 4 + h; const float* ig = p.IGS + (((size_t)b * 2 + d) * TK + 64 * j) * 4 + h;
  float bend = bc[63 * 4], ml = -1e30f;
  for (int l = 0; l < 64; ++l) ml = fmaxf(ml, bend - bc[l * 4] + ig[l * 4]);
  if (e == 4096 + 0) { p.MM[u * 4 + 0] = ml; p.MM[u * 4 + 1] = bend; }
  float acc = 0.f;
  if (e < 4096) {
    int v = e / 64, k = e % 64;
    for (int l = 0; l < 64; ++l) {
      int s = seq_of(d, 64 * j + l); float w = expf(bend - bc[l * 4] + ig[l * 4] - ml);
      acc += w * bf2f(p.Z[(size_t)row_of(b, s) * NZP + ZC_MLV + h * 64 + v]) * bf2f(p.MK[((size_t)b * TK + s) * 256 + h * 64 + k]);
    }
    p.MC[(size_t)u * 4096 + e] = acc;
  } else {
    int k = e - 4096;
    for (int l = 0; l < 64; ++l) {
      int s = seq_of(d, 64 * j + l); float w = expf(bend - bc[l * 4] + ig[l * 4] - ml);
      acc += w * bf2f(p.MK[((size_t)b * TK + s) * 256 + h * 64 + k]);
    }
    p.MN[(size_t)u * 64 + k] = acc;
  }
}
DI void nvb_ml_scan(long GI, const Params& p) {
  long i = GI; if (i >= (long)NB * 2 * 4 * 4160) return;
  int e = (int)(i % 4160); int ch = (int)(i / 4160); int h = ch % 4, bd = ch / 4;
  float st = 0.f, m = -1e30f;
  for (int j = 0; j < NCK; ++j) {
    size_t u = ((size_t)bd * NCK + j) * 4 + h;
    float ml = p.MM[u * 4 + 0], be = p.MM[u * 4 + 1];
    float mn = fmaxf(be + m, ml), a = expf(be + m - mn), g = expf(ml - mn);
    float* slot = e < 4096 ? &p.MC[u * 4096 + e] : &p.MN[u * 64 + (e - 4096)];
    float loc = *slot; *slot = st; st = a * st + g * loc;
    if (e == 0) p.MM[u * 4 + 2] = m;
    m = mn;
  }
}
DI void nvb_ml_out(long GI, const Params& p, int need_ctx) {
  long i = GI; if (i >= (long)NUNIT * 4096) return;
  int v = (int)(i % 64), l = (int)((i / 64) % 64); long u = i / 4096;
  int h = (int)(u % 4), j = (int)((u / 4) % NCK), d = (int)((u / (4 * NCK)) % 2), b = (int)(u / (8 * NCK));
  if (j < NCC && !need_ctx) return;
  const float* bc = p.BC + (((size_t)b * 2 + d) * TK + 64 * j) * 4 + h; const float* ig = p.IGS + (((size_t)b * 2 + d) * TK + 64 * j) * 4 + h;
  float m0 = p.MM[u * 4 + 2];
  int sl = seq_of(d, 64 * j + l);
  const bf16_t* q = p.MQ + ((size_t)b * TK + sl) * 256 + h * 64;
  float bl = bc[l * 4];
  float inter = bl + m0, mt = inter;
  for (int t = 0; t <= l; ++t) mt = fmaxf(mt, bl - bc[t * 4] + ig[t * 4]);
  float num = 0.f, den = 0.f;
  for (int t = 0; t <= l; ++t) {
    int st = seq_of(d, 64 * j + t);
    const bf16_t* k = p.MK + ((size_t)b * TK + st) * 256 + h * 64;
    float qk = 0.f; for (int c = 0; c < 64; ++c) qk += bf2f(q[c]) * bf2f(k[c]);
    float sv = expf(bl - bc[t * 4] + ig[t * 4] - mt) * qk;
    num += sv * bf2f(p.Z[(size_t)row_of(b, st) * NZP + ZC_MLV + h * 64 + v]); den += sv;
  }
  float ai = expf(inter - mt);
  float qc = 0.f, qn = 0.f;
  for (int c = 0; c < 64; ++c) { qc += bf2f(q[c]) * p.MC[(size_t)u * 4096 + v * 64 + c]; qn += bf2f(q[c]) * p.MN[(size_t)u * 64 + c]; }
  num += ai * qc; den += ai * qn;
  p.HD[(((size_t)d * NB + b) * TK + sl) * 256 + h * 64 + v] = num / fmaxf(fabsf(den), expf(-mt));
}
DI void nvb_ml_finish(long GI, const Params& p, int layer, int need_ctx) {
  long i = GI; if (i >= (long)R * 4) return;
  int h = (int)(i % 4), r = (int)(i / 4); int b, s; bs_of(r, b, s);
  if (s < TC && !need_ctx) return;
  const float* h0 = p.HD + (((size_t)0 * NB + b) * TK + s) * 256 + h * 64; const float* h1 = p.HD + (((size_t)1 * NB + b) * TK + s) * 256 + h * 64;
  float ss = 0.f; for (int v = 0; v < 64; ++v) { float t = h0[v] + h1[v]; ss += t * t; }
  float rstd = 1.0f / sqrtf(ss / 64 + 1e-6f);
  for (int v = 0; v < 64; ++v) {
    float o = bf2f(p.Z[(size_t)r * NZP + ZC_MLO + h * 64 + v]);
    p.Y[(size_t)r * D + 256 + h * 64 + v] = f2bf(sigmoidf_(o) * (h0[v] + h1[v]) * rstd * p.g_mlstm_out[layer * 256 + h * 64 + v]);
  }
}
DI void nvb_gla_local(long GI, const Params& p) {
  long i = GI; if (i >= (long)NUNIT * 2048) return;
  int v = (int)(i % 64), k = (int)((i / 64) % 32); long u = i / 2048;
  int h = (int)(u % 4), j = (int)((u / 4) % NCK), d = (int)((u / (4 * NCK)) % 2), b = (int)(u / (8 * NCK));
  const float* gc = p.GC + (((size_t)b * 2 + d) * TK + 64 * j) * 128 + h * 32 + k;
  float ge = gc[63 * 128], acc = 0.f;
  for (int l = 0; l < 64; ++l) {
    int s = seq_of(d, 64 * j + l); const bf16_t* z = p.Z + (size_t)row_of(b, s) * NZP;
    acc += bf2f(z[ZC_GK + h * 32 + k]) * expf(ge - gc[l * 128]) * bf2f(z[ZC_GV + h * 64 + v]);
  }
  p.GS[(size_t)u * 2048 + v * 32 + k] = acc;
}
DI void nvb_gla_scan(long GI, const Params& p) {
  long i = GI; if (i >= (long)NB * 2 * 4 * 2048) return;
  int e = (int)(i % 2048); int ch = (int)(i / 2048); int h = ch % 4, bd = ch / 4; int k = e % 32;
  float st = 0.f;
  for (int j = 0; j < NCK; ++j) {
    size_t u = ((size_t)bd * NCK + j) * 4 + h;
    float ge = p.GC[((size_t)bd * TK + 64 * j + 63) * 128 + h * 32 + k];
    float loc = p.GS[u * 2048 + e]; p.GS[u * 2048 + e] = st; st = expf(ge) * st + loc;
  }
}
DI void nvb_gla_out(long GI, const Params& p, int need_ctx) {
  long i = GI; if (i >= (long)NUNIT * 4096) return;
  int v = (int)(i % 64), l = (int)((i / 64) % 64); long u = i / 4096;
  int h = (int)(u % 4), j = (int)((u / 4) % NCK), d = (int)((u / (4 * NCK)) % 2), b = (int)(u / (8 * NCK));
  if (j < NCC && !need_ctx) return;
  const float* gc = p.GC + (((size_t)b * 2 + d) * TK + 64 * j) * 128 + h * 32;
  int sl = seq_of(d, 64 * j + l);
  const bf16_t* q = p.Z + (size_t)row_of(b, sl) * NZP + ZC_GQ + h * 32;
  const float qs = 0.17677669529663687f;
  float acc = 0.f;
  for (int t = 0; t <= l; ++t) {
    int st = seq_of(d, 64 * j + t); const bf16_t* z = p.Z + (size_t)row_of(b, st) * NZP;
    float att = 0.f; for (int k = 0; k < 32; ++k) att += bf2f(q[k]) * qs * expf(gc[l * 128 + k] - gc[t * 128 + k]) * bf2f(z[ZC_GK + h * 32 + k]);
    acc += att * bf2f(z[ZC_GV + h * 64 + v]);
  }
  for (int k = 0; k < 32; ++k) acc += bf2f(q[k]) * qs * expf(gc[l * 128 + k]) * p.GS[(size_t)u * 2048 + v * 32 + k];
  p.OD[(((size_t)d * NB + b) * TK + sl) * 256 + h * 64 + v] = acc;
}
DI void nvb_gla_finish(long GI, const Params& p, int layer, int need_ctx) {
  long i = GI; if (i >= (long)R * 4) return;
  int h = (int)(i % 4), r = (int)(i / 4); int b, s; bs_of(r, b, s);
  if (s < TC && !need_ctx) return;
  const float* h0 = p.OD + (((size_t)0 * NB + b) * TK + s) * 256 + h * 64; const float* h1 = p.OD + (((size_t)1 * NB + b) * TK + s) * 256 + h * 64;
  float ss = 0.f; for (int v = 0; v < 64; ++v) { float t = h0[v] + h1[v]; ss += t * t; }
  float rstd = 1.0f / sqrtf(ss / 64 + 1e-6f);
  for (int v = 0; v < 64; ++v) {
    float rr = bf2f(p.Z[(size_t)r * NZP + ZC_GR + h * 64 + v]);
    p.Y[(size_t)r * D + 512 + h * 64 + v] = f2bf(siluf_(rr) * (h0[v] + h1[v]) * rstd * p.g_gla_out[layer * 256 + h * 64 + v]);
  }
}
__global__ void __launch_bounds__(256) nv_merge(Params p, int layer, int nrows) {
  long i = GTID; if (i >= (long)nrows * D) return;
  int j = (int)(i % D), r = (int)(i / D);
  float acc = 0.f;
  for (int n = 0; n < 4; ++n) {
    const bf16_t* wg = p.Wt_gate + (size_t)(n * 1024 + j) * D; const bf16_t* wb = p.Wt_branch + ((size_t)n * D + j) * 256;
    float g = p.b_gate[layer * 4096 + n * 1024 + j], pr = 0.f;
    for (int k = 0; k < D; ++k) g += bf2f(p.H[(size_t)r * D + k]) * bf2f(wg[k]);
    for (int k = 0; k < 256; ++k) pr += bf2f(p.Y[(size_t)r * D + n * 256 + k]) * bf2f(wb[k]);
    acc += sigmoidf_(g) * pr;
  }
  p.MG[(size_t)r * D + j] = f2bf(acc);
}
__global__ void __launch_bounds__(256) nv_resid_mix(Params p, int layer, const float* xl_in, const float* xc_in, int nrows) {
  long r = GTID; if (r >= nrows) return;
  int w = r < RL ? (int)(r / TL) : 2;
  const float* mb = p.mods + (size_t)(layer * 3 + w) * 6144;
  const float* xin = r < RL ? xl_in + (size_t)r * D : xc_in + (size_t)(r - RL) * D;
  float* xo = r < RL ? p.out + (size_t)r * D : p.xc + (size_t)(r - RL) * D;
  const bf16_t* yo = p.YO + (size_t)r * D;
  float ss = 0.f; for (int k = 0; k < D; ++k) { float v = bf2f(yo[k]); ss += v * v; }
  float rstd = 1.0f / sqrtf(ss / D + 1e-6f);
  float s2 = 0.f;
  for (int k = 0; k < D; ++k) { float xn = xin[k] + mb[2 * 1024 + k] * bf2f(yo[k]) * rstd * p.g_mix_post[layer * 1024 + k]; xo[k] = xn; s2 += xn * xn; }
  float rstd2 = 1.0f / sqrtf(s2 / D + 1e-6f);
  float lg[16]; _Pragma("unroll") for (int e = 0; e < 16; ++e) lg[e] = 0.f;
  const float* wr = p.w_router + (size_t)layer * D * 16;
  for (int k = 0; k < D; ++k) {
    float h2 = xo[k] * rstd2 * p.g_ffn_pre[layer * 1024 + k] * (1.f + mb[4 * 1024 + k]) + mb[3 * 1024 + k];
    p.H[(size_t)r * D + k] = f2bf(h2);
    _Pragma("unroll") for (int e = 0; e < 16; ++e) lg[e] += h2 * wr[k * 16 + e];
  }
  float mx = lg[0]; _Pragma("unroll") for (int e = 1; e < 16; ++e) mx = fmaxf(mx, lg[e]);
  float sm = 0.f; _Pragma("unroll") for (int e = 0; e < 16; ++e) { lg[e] = expf(lg[e] - mx); sm += lg[e]; }
  int b, s; bs_of((int)r, b, s);
  _Pragma("unroll") for (int e = 0; e < 16; ++e) p.AFF[((size_t)b * NE + e) * TK + s] = lg[e] / sm;
}
__global__ void __launch_bounds__(256) nv_topk(Params p, int need_ctx) {
  long i = GTID; if (i >= NB * NE * 2) return;
  int seg = (int)(i % 2), e = (int)((i / 2) % NE), b = (int)(i / (2 * NE));
  int s0 = seg ? TC : 0, n = seg ? TL : TC, cap = seg ? CAPL : CAPC, slot0 = seg ? b * CAPL : NB * CAPL + b * CAPC;
  if (seg == 0 && !need_ctx) { for (int q = 0; q < cap; ++q) p.SEL[(size_t)e * NSLOT + slot0 + q] = -1; return; }
  const float* a = p.AFF + ((size_t)b * NE + e) * TK + s0;
  unsigned thr = 0;
  for (int bit = 31; bit >= 0; --bit) {
    unsigned cand = thr | (1u << bit); int cnt = 0;
    for (int t = 0; t < n; ++t) cnt += (f2u(a[t]) >= cand);
    if (cnt >= cap) thr = cand;
  }
  int ngt = 0; for (int t = 0; t < n; ++t) ngt += (f2u(a[t]) > thr);
  int neq = cap - ngt, q = 0;
  for (int t = 0; t < n; ++t) {
    unsigned u = f2u(a[t]); int r = row_of(b, s0 + t); int sel = -1;
    if (u > thr) sel = q++; else if (u == thr && neq > 0) { sel = q++; --neq; }
    if (sel >= 0) { p.SEL[(size_t)e * NSLOT + slot0 + sel] = r; p.SELV[(size_t)e * NSLOT + slot0 + sel] = a[t]; }
    p.INV[(size_t)r * NE + e] = sel >= 0 ? slot0 + sel : -1;
  }
}
__global__ void __launch_bounds__(256) nv_moe1(Params p) {
  long i = GTID; if (i >= (long)NE * NSLOT * FF) return;
  int f = (int)(i % FF), slot = (int)((i / FF) % NSLOT), e = (int)(i / ((long)FF * NSLOT));
  int r = p.SEL[(size_t)e * NSLOT + slot];
  float out = 0.f;
  if (r >= 0) {
    const bf16_t* wg = p.Wt_eg + ((size_t)e * FF + f) * D; const bf16_t* wu = p.Wt_eu + ((size_t)e * FF + f) * D; const bf16_t* h = p.H + (size_t)r * D;
    float g = 0.f, u = 0.f; for (int k = 0; k < D; ++k) { float hv = bf2f(h[k]); g += hv * bf2f(wg[k]); u += hv * bf2f(wu[k]); }
    out = siluf_(g) * u;
  }
  p.HID[((size_t)e * NSLOT + slot) * FF + f] = f2bf(out);
}
__global__ void __launch_bounds__(256) nv_moe2(Params p) {
  long i = GTID; if (i >= (long)NE * NSLOT * D) return;
  int j = (int)(i % D), slot = (int)((i / D) % NSLOT), e = (int)(i / ((long)D * NSLOT));
  int r = p.SEL[(size_t)e * NSLOT + slot];
  float out = 0.f;
  if (r >= 0) {
    const bf16_t* wd = p.Wt_ed + ((size_t)e * D + j) * FF; const bf16_t* h = p.HID + ((size_t)e * NSLOT + slot) * FF;
    float a = 0.f; for (int k = 0; k < FF; ++k) a += bf2f(h[k]) * bf2f(wd[k]);
    out = a * p.SELV[(size_t)e * NSLOT + slot];
  }
  p.YE[((size_t)e * NSLOT + slot) * D + j] = f2bf(out);
}
__global__ void __launch_bounds__(256) nv_resid_ffn(Params p, int layer, int nrows) {
  long r = GTID; if (r >= nrows) return;
  int w = r < RL ? (int)(r / TL) : 2;
  const float* mb = p.mods + (size_t)(layer * 3 + w) * 6144;
  float* xo = r < RL ? p.out + (size_t)r * D : p.xc + (size_t)(r - RL) * D;
  float ss = 0.f;
  for (int k = 0; k < D; ++k) {
    float f = 0.f;
    for (int e = 0; e < NE; ++e) { int sl = p.INV[(size_t)r * NE + e]; if (sl >= 0) f += bf2f(p.YE[((size_t)e * NSLOT + sl) * D + k]); }
    ss += f * f;
  }
  float rstd = 1.0f / sqrtf(ss / D + 1e-6f);
  for (int k = 0; k < D; ++k) {
    float f = 0.f;
    for (int e = 0; e < NE; ++e) { int sl = p.INV[(size_t)r * NE + e]; if (sl >= 0) f += bf2f(p.YE[((size_t)e * NSLOT + sl) * D + k]); }
    xo[k] += mb[5 * 1024 + k] * f * rstd * p.g_ffn_post[layer * 1024 + k];
  }
}

__global__ void __launch_bounds__(256) nv_mods(Params p) { nvb_mods(GTID, p); }
__global__ void __launch_bounds__(256) nv_ml_gates(Params p, int layer) { nvb_ml_gates(GTID, p, layer); }
__global__ void __launch_bounds__(256) nv_gla_cum(Params p, int layer) { nvb_gla_cum(GTID, p, layer); }
__global__ void __launch_bounds__(256) nv_ml_local(Params p) { nvb_ml_local(GTID, p); }
__global__ void __launch_bounds__(256) nv_ml_scan(Params p) { nvb_ml_scan(GTID, p); }
__global__ void __launch_bounds__(256) nv_ml_out(Params p, int need_ctx) { nvb_ml_out(GTID, p, need_ctx); }
__global__ void __launch_bounds__(256) nv_ml_finish(Params p, int layer, int need_ctx) { nvb_ml_finish(GTID, p, layer, need_ctx); }
__global__ void __launch_bounds__(256) nv_gla_local(Params p) { nvb_gla_local(GTID, p); }
__global__ void __launch_bounds__(256) nv_gla_scan(Params p) { nvb_gla_scan(GTID, p); }
__global__ void __launch_bounds__(256) nv_gla_out(Params p, int need_ctx) { nvb_gla_out(GTID, p, need_ctx); }
__global__ void __launch_bounds__(256) nv_gla_finish(Params p, int layer, int need_ctx) { nvb_gla_finish(GTID, p, layer, need_ctx); }
constexpr int LROW = 144;
constexpr int A_BYTES = 128 * LROW;
constexpr int NTHR = 256;
#ifndef ATT_THR
#define ATT_THR 16.0f
#endif

DI int xcd_swz(int u, int nt) { return (nt & 7) ? u : (u & 7) * (nt >> 3) + (u >> 3); }
DI u32x4 ldg16(const void* p) { return *(const u32x4*)p; }
DI void sts16(char* p, u32x4 v) { *(u32x4*)p = v; }
DI bf16x8 lds_frag(const char* p) { return *(const bf16x8*)p; }

template <int WN>
DI void gemm_kloop(f32x4 (&acc)[4][WN], const bf16_t* const (&ap)[4], const bf16_t* const (&bp)[WN], int nk, char* lds) {
  constexpr int STAGE = A_BYTES + 32 * WN * LROW;
  const int t = TIDX, lane = t & 63, wid = t >> 6, wr = wid >> 1, wc = wid & 1;
  const int lr = t >> 3, lcb = (t & 7) * 16;
  const int fr = lane & 15, fq = lane >> 4;
  const int aoff = (wr * 64 + fr) * LROW + fq * 16, boff = A_BYTES + (wc * WN * 16 + fr) * LROW + fq * 16, soff = lr * LROW + lcb;
  u32x4 ra0[4], rb0[WN], ra1[4], rb1[WN];
  auto gload = [&](u32x4 (&ra)[4], u32x4 (&rb)[WN], int kt) {
#pragma unroll
    for (int i = 0; i < 4; ++i) ra[i] = ldg16(ap[i] + kt * 64);
#pragma unroll
    for (int i = 0; i < WN; ++i) rb[i] = ldg16(bp[i] + kt * 64);
  };
  auto sstore = [&](const u32x4 (&ra)[4], const u32x4 (&rb)[WN], char* st) {
#pragma unroll
    for (int i = 0; i < 4; ++i) sts16(st + soff + 32 * i * LROW, ra[i]);
#pragma unroll
    for (int i = 0; i < WN; ++i) sts16(st + A_BYTES + soff + 32 * i * LROW, rb[i]);
  };
  auto compute = [&](const char* cur) {
#pragma unroll
    for (int ks = 0; ks < 2; ++ks) {
      bf16x8 af[4], bfr[WN];
#pragma unroll
      for (int m = 0; m < 4; ++m) af[m] = lds_frag(cur + aoff + m * 16 * LROW + ks * 64);
#pragma unroll
      for (int n = 0; n < WN; ++n) bfr[n] = lds_frag(cur + boff + n * 16 * LROW + ks * 64);
#pragma unroll
      for (int m = 0; m < 4; ++m)
#pragma unroll
        for (int n = 0; n < WN; ++n) acc[m][n] = MFMA16(bfr[n], af[m], acc[m][n]);
    }
    IGLP_OPT();
  };
  gload(ra0, rb0, 0);
  gload(ra1, rb1, 1);
  sstore(ra0, rb0, lds);
  __syncthreads();
#pragma unroll 1
  for (int kt = 0; kt < nk; kt += 2) {
    if (kt + 2 < nk) gload(ra0, rb0, kt + 2);
    compute(lds);
    sstore(ra1, rb1, lds + STAGE);
    __syncthreads();
    if (kt + 3 < nk) gload(ra1, rb1, kt + 3);
    compute(lds + STAGE);
    if (kt + 2 < nk) sstore(ra0, rb0, lds);
    __syncthreads();
  }
}
template <int WN> DI void acc_zero(f32x4 (&acc)[4][WN]) {
#pragma unroll
  for (int m = 0; m < 4; ++m)
#pragma unroll
    for (int n = 0; n < WN; ++n) acc[m][n] = (f32x4){0.f, 0.f, 0.f, 0.f};
}
DI void st_bf16x4(bf16_t* p, f32x4 v) { u32x2 o; o.x = pack2bf(v.x, v.y); o.y = pack2bf(v.z, v.w); *(u32x2*)p = o; }

template <int WN, class RowOk>
DI void store_wave_tile(const f32x4 (&acc)[4][WN], bf16_t* C, size_t ldc, char* ldsw, int lane, RowOk row_ok) {
  constexpr int PITCH = WN * 32 + 16, CPR = WN * 2;
  const int fr = lane & 15, fq = lane >> 4;
#pragma unroll
  for (int m = 0; m < 4; ++m)
#pragma unroll
    for (int n = 0; n < WN; ++n) { u32x2 o; o.x = pack2bf(acc[m][n][0], acc[m][n][1]); o.y = pack2bf(acc[m][n][2], acc[m][n][3]); *(u32x2*)(ldsw + (m * 16 + fr) * PITCH + n * 32 + fq * 8) = o; }
  WAVE_SYNC();
  constexpr int RPP = 64 / CPR;
#pragma unroll
  for (int ps = 0; ps < 64 / RPP; ++ps) {
    const int r = ps * RPP + lane / CPR, c = lane % CPR;
    const u32x4 v = *(const u32x4*)(ldsw + r * PITCH + c * 16);
    if (row_ok(r)) *(u32x4*)(C + (size_t)r * ldc + c * 8) = v;
  }
  WAVE_SYNC();
}
template <int NOSTORE = 0>
DI void gemm_plain_tile(const bf16_t* A, int lda, const bf16_t* Bt, int ldb, int K, bf16_t* C, int ldc, int tm, int tn, char* lds) {
  const int t = TIDX, lane = t & 63, wid = t >> 6, wr = wid >> 1, wc = wid & 1, lr = t >> 3, lc = (t & 7) * 8, fr = lane & 15, fq = lane >> 4;
  const bf16_t* ap[4]; const bf16_t* bp[4];
#pragma unroll
  for (int i = 0; i < 4; ++i) { ap[i] = A + (size_t)(tm * 128 + lr + 32 * i) * lda + lc; bp[i] = Bt + (size_t)(tn * 128 + lr + 32 * i) * ldb + lc; }
  f32x4 acc[4][4]; acc_zero<4>(acc);
  gemm_kloop<4>(acc, ap, bp, K / 64, lds);
  if (NOSTORE) { float s = 0.f;
#pragma unroll
    for (int m = 0; m < 4; ++m)
#pragma unroll
      for (int n = 0; n < 4; ++n) s += acc[m][n][0] + acc[m][n][3];
    if (s == 123456.789f) C[0] = 1; return; }
  store_wave_tile<4>(acc, C + (size_t)(tm * 128 + wr * 64) * ldc + tn * 128 + wc * 64, (size_t)ldc, lds + wid * (64 * 144), lane, [](int) { return true; });
  __syncthreads();
}
template <int NOSTORE = 0>
DI void ph_gemm_plain(const bf16_t* A, int lda, const bf16_t* Bt, int ldb, int M, int N, int K, bf16_t* C, int ldc, char* lds, int bid, int nblk) {
  const int ntn = N / 128, nt = (M / 128) * ntn;
  for (int u = bid; u < nt; u += nblk) { const int tile = xcd_swz(u, nt); gemm_plain_tile<NOSTORE>(A, lda, Bt, ldb, K, C, ldc, tile / ntn, tile % ntn, lds); }
}
DI void ph_mla_up(const Params& p, int layer, bf16_t* QRAW, bf16_t* KVRAW, char* lds, int bid, int nblk) {
  const int ntq = (R / 128) * 3, ntkv = (R / 128) * 4;
  for (int tile = bid; tile < ntq + ntkv; tile += nblk) {
    if (tile < ntq) gemm_plain_tile(p.Z + ZC_QLAT, NZP, p.Wt_uq + layer * WSZ_UQ, 256, 256, QRAW, 384, tile / 3, tile % 3, lds);
    else { int u = tile - ntq; gemm_plain_tile(p.Z + ZC_KVLAT, NZP, p.Wt_ukv + layer * WSZ_UKV, 128, 128, KVRAW, 512, u / 4, u % 4, lds); }
  }
}
constexpr int LROW32 = 80;
template <int WM, int WN, bool DEEP>
DI void gemm_kloop_g(f32x4 (&acc)[WM][WN], const bf16_t* const (&ap)[WM / 2], const bf16_t* const (&bp)[WN / 2], int nk, char* lds) {
  constexpr int NA = WM / 2, NBB = WN / 2, A_B = 32 * WM * LROW32, STAGE = (32 * WM + 32 * WN) * LROW32;
  const int t = TIDX, lane = t & 63, wid = t >> 6, wr = wid >> 1, wc = wid & 1, fr = lane & 15, fq = lane >> 4;
  const int aoff = (wr * 16 * WM + fr) * LROW32 + fq * 16, boff = A_B + (wc * 16 * WN + fr) * LROW32 + fq * 16, soff = (t >> 2) * LROW32 + (t & 3) * 16;
  u32x4 ra0[NA], rb0[NBB], ra1[NA], rb1[NBB];
  auto gload = [&](u32x4 (&ra)[NA], u32x4 (&rb)[NBB], int kt) {
#pragma unroll
    for (int i = 0; i < NA; ++i) ra[i] = ldg16(ap[i] + kt * 32);
#pragma unroll
    for (int i = 0; i < NBB; ++i) rb[i] = ldg16(bp[i] + kt * 32);
  };
  auto sstore = [&](const u32x4 (&ra)[NA], const u32x4 (&rb)[NBB], char* st) {
#pragma unroll
    for (int i = 0; i < NA; ++i) sts16(st + soff + 64 * i * LROW32, ra[i]);
#pragma unroll
    for (int i = 0; i < NBB; ++i) sts16(st + A_B + soff + 64 * i * LROW32, rb[i]);
  };
  auto compute = [&](const char* cur) {
    bf16x8 af[WM];
#pragma unroll
    for (int m = 0; m < WM; ++m) af[m] = lds_frag(cur + aoff + m * 16 * LROW32);
#pragma unroll
    for (int n = 0; n < WN; ++n) {
      const bf16x8 bfr = lds_frag(cur + boff + n * 16 * LROW32);
#pragma unroll
      for (int m = 0; m < WM; ++m) acc[m][n] = MFMA16(bfr, af[m], acc[m][n]);
    }
    IGLP_OPT();
  };
  gload(ra0, rb0, 0);
  if (DEEP) gload(ra1, rb1, 1);
  sstore(ra0, rb0, lds);
  __syncthreads();
#pragma unroll 1
  for (int kt = 0; kt < nk; kt += 2) {
    if (DEEP) { if (kt + 2 < nk) gload(ra0, rb0, kt + 2); } else gload(ra1, rb1, kt + 1);
    compute(lds);
    sstore(ra1, rb1, lds + STAGE);
    __syncthreads();
    if (DEEP) { if (kt + 3 < nk) gload(ra1, rb1, kt + 3); } else if (kt + 2 < nk) gload(ra0, rb0, kt + 2);
    compute(lds + STAGE);
    if (kt + 2 < nk) sstore(ra0, rb0, lds);
    __syncthreads();
  }
}
template <int WM, int WN> DI void acc_zero_g(f32x4 (&acc)[WM][WN]) {
#pragma unroll
  for (int m = 0; m < WM; ++m)
#pragma unroll
    for (int n = 0; n < WN; ++n) acc[m][n] = (f32x4){0.f, 0.f, 0.f, 0.f};
}
DI void ph_merge(const Params& p, int layer, int rows, char* lds, int bid, int nblk) {
  const int t = TIDX, lane = t & 63, wid = t >> 6, wr = wid >> 1, wc = wid & 1, fr = lane & 15, fq = lane >> 4;
  const int lr = t >> 2, lc = (t & 3) * 8;
  const int ntn = D / 64, nt = (rows / 128) * ntn;
#pragma unroll 1
  for (int u = bid; u < nt; u += nblk) {
    const int tile = xcd_swz(u, nt), tm = tile / ntn, tn = tile % ntn;
    f32x4 accS[4][2]; acc_zero_g<4, 2>(accS);
#pragma unroll 1
    for (int np = 0; np < 2; ++np) {
      f32x4 accG[4][4]; acc_zero_g<4, 4>(accG);
      {
        const bf16_t* ap[2]; const bf16_t* bp[2];
#pragma unroll
        for (int i = 0; i < 2; ++i) ap[i] = p.H + (size_t)(tm * 128 + lr + 64 * i) * D + lc;
#pragma unroll
        for (int i = 0; i < 2; ++i) { const int rho = lr + 64 * i, wci = rho >> 6, n = 2 * np + ((rho >> 5) & 1), c = rho & 31;
          bp[i] = p.Wt_gate + layer * WSZ_GATE + ((size_t)n * 1024 + tn * 64 + wci * 32 + c) * D + lc; }
        gemm_kloop_g<4, 4, true>(accG, ap, bp, D / 32, lds);
      }
#pragma unroll 1
      for (int q = 0; q < 2; ++q) {
        const int n = 2 * np + q;
        f32x4 accP[4][2]; acc_zero_g<4, 2>(accP);
        const bf16_t* ap[2]; const bf16_t* bp[1];
#pragma unroll
        for (int i = 0; i < 2; ++i) ap[i] = p.Y + (size_t)(tm * 128 + lr + 64 * i) * D + n * 256 + lc;
        bp[0] = p.Wt_branch + layer * WSZ_BR + ((size_t)n * D + tn * 64 + lr) * 256 + lc;
        gemm_kloop_g<4, 2, false>(accP, ap, bp, 8, lds);
#pragma unroll
        for (int nn = 0; nn < 2; ++nn) {
          const f32x4 bv = *(const f32x4*)(p.b_gate + layer * 4096 + n * 1024 + tn * 64 + wc * 32 + nn * 16 + 4 * fq);
#pragma unroll
          for (int m = 0; m < 4; ++m)
#pragma unroll
            for (int j = 0; j < 4; ++j) { const float g = q ? accG[m][2 + nn][j] : accG[m][nn][j]; accS[m][nn][j] += accP[m][nn][j] * fast_rcp(1.0f + fast_exp2(-LOG2E * (g + bv[j]))); }
        }
      }
    }
    store_wave_tile<2>(accS, p.MG + (size_t)(tm * 128 + wr * 64) * D + tn * 64 + wc * 32, (size_t)D, lds + wid * (64 * 80), lane, [](int) { return true; });
    __syncthreads();
  }
}
template <int WM>
DI void gemm_plain_tile_g(const bf16_t* A, int lda, const bf16_t* Bt, int ldb, int K, bf16_t* C, int ldc, int row0, int col0, char* lds) {
  const int t = TIDX, lane = t & 63, wid = t >> 6, wr = wid >> 1, wc = wid & 1, fr = lane & 15, fq = lane >> 4, lr = t >> 2, lc = (t & 3) * 8;
  const bf16_t* ap[WM / 2]; const bf16_t* bp[2];
#pragma unroll
  for (int i = 0; i < WM / 2; ++i) ap[i] = A + (size_t)(row0 + lr + 64 * i) * lda + lc;
#pragma unroll
  for (int i = 0; i < 2; ++i) bp[i] = Bt + (size_t)(col0 + lr + 64 * i) * ldb + lc;
  f32x4 acc[WM][4]; acc_zero_g<WM, 4>(acc);
  gemm_kloop_g<WM, 4, true>(acc, ap, bp, K / 32, lds);
#pragma unroll
  for (int m = 0; m < WM; ++m)
#pragma unroll
    for (int n = 0; n < 4; ++n)
      st_bf16x4(C + (size_t)(row0 + wr * 16 * WM + m * 16 + fr) * ldc + col0 + wc * 64 + n * 16 + 4 * fq, acc[m][n]);
}
DI void ph_gemm_plain2(const bf16_t* A, int lda, const bf16_t* Bt, int ldb, int M, int N, int K, bf16_t* C, int ldc, char* lds, int bid, int nblk) {
  const int ntn = N / 128, nt = (M / 256) * ntn, nfull = (nt / nblk) * nblk;
#pragma unroll 1
  for (int tile = bid; tile < nfull; tile += nblk) gemm_plain_tile_g<8>(A, lda, Bt, ldb, K, C, ldc, (tile / ntn) * 256, (tile % ntn) * 128, lds);
#pragma unroll 1
  for (int h = bid; h < 2 * (nt - nfull); h += nblk) { const int tile = nfull + (h >> 1); gemm_plain_tile_g<4>(A, lda, Bt, ldb, K, C, ldc, (tile / ntn) * 256 + (h & 1) * 128, (tile % ntn) * 128, lds); }
}
DI void gemm_kloop32(f32x16 (&acc)[2][2], const bf16_t* const (&ap)[4], const bf16_t* const (&bp)[4], int nk, char* lds) {
  constexpr int STAGE = A_BYTES + 128 * LROW;
  const int t = TIDX, lane = t & 63, wid = t >> 6, wr = wid >> 1, wc = wid & 1, l31 = lane & 31, hh = lane >> 5;
  const int aoff = (wr * 64 + l31) * LROW + hh * 16, boff = A_BYTES + (wc * 64 + l31) * LROW + hh * 16, soff = (t >> 3) * LROW + (t & 7) * 16;
  u32x4 ra0[4], rb0[4], ra1[4], rb1[4];
  auto gload = [&](u32x4 (&ra)[4], u32x4 (&rb)[4], int kt) {
#pragma unroll
    for (int i = 0; i < 4; ++i) { ra[i] = ldg16(ap[i] + kt * 64); rb[i] = ldg16(bp[i] + kt * 64); }
  };
  auto sstore = [&](const u32x4 (&ra)[4], const u32x4 (&rb)[4], char* st) {
#pragma unroll
    for (int i = 0; i < 4; ++i) { sts16(st + soff + 32 * i * LROW, ra[i]); sts16(st + A_BYTES + soff + 32 * i * LROW, rb[i]); }
  };
  auto compute = [&](const char* cur) {
#pragma unroll
    for (int ks = 0; ks < 4; ++ks) {
      bf16x8 af[2], bfr[2];
#pragma unroll
      for (int m = 0; m < 2; ++m) af[m] = lds_frag(cur + aoff + m * 32 * LROW + ks * 32);
#pragma unroll
      for (int n = 0; n < 2; ++n) bfr[n] = lds_frag(cur + boff + n * 32 * LROW + ks * 32);
#pragma unroll
      for (int m = 0; m < 2; ++m)
#pragma unroll
        for (int n = 0; n < 2; ++n) acc[m][n] = MFMA32(bfr[n], af[m], acc[m][n]);
    }
  };
  gload(ra0, rb0, 0); gload(ra1, rb1, 1);
  sstore(ra0, rb0, lds);
  __syncthreads();
#pragma unroll 1
  for (int kt = 0; kt < nk; kt += 2) {
    if (kt + 2 < nk) gload(ra0, rb0, kt + 2);
    compute(lds);
    sstore(ra1, rb1, lds + STAGE);
    __syncthreads();
    if (kt + 3 < nk) gload(ra1, rb1, kt + 3);
    compute(lds + STAGE);
    if (kt + 2 < nk) sstore(ra0, rb0, lds);
    __syncthreads();
  }
}
DI void ph_gemm_plain32(const bf16_t* A, int lda, const bf16_t* Bt, int ldb, int M, int N, int K, bf16_t* C, int ldc, char* lds, int bid, int nblk) {
  const int t = TIDX, lane = t & 63, wid = t >> 6, wr = wid >> 1, wc = wid & 1, lr = t >> 3, lc = (t & 7) * 8, l31 = lane & 31, hh = lane >> 5;
  const int ntn = N / 128, nt = (M / 128) * ntn;
#pragma unroll 1
  for (int tile = bid; tile < nt; tile += nblk) {
    const int tm = tile / ntn, tn = tile % ntn;
    const bf16_t* ap[4]; const bf16_t* bp[4];
#pragma unroll
    for (int i = 0; i < 4; ++i) { ap[i] = A + (size_t)(tm * 128 + lr + 32 * i) * lda + lc; bp[i] = Bt + (size_t)(tn * 128 + lr + 32 * i) * ldb + lc; }
    f32x16 acc[2][2];
#pragma unroll
    for (int m = 0; m < 2; ++m)
#pragma unroll
      for (int n = 0; n < 2; ++n) acc[m][n] = (f32x16)(0.f);
    gemm_kloop32(acc, ap, bp, K / 64, lds);
#pragma unroll
    for (int m = 0; m < 2; ++m)
#pragma unroll
      for (int n = 0; n < 2; ++n)
#pragma unroll
        for (int g = 0; g < 4; ++g) {
          f32x4 o = {acc[m][n][4 * g], acc[m][n][4 * g + 1], acc[m][n][4 * g + 2], acc[m][n][4 * g + 3]};
          st_bf16x4(C + (size_t)(tm * 128 + wr * 64 + m * 32 + l31) * ldc + tn * 128 + wc * 64 + n * 32 + 8 * g + 4 * hh, o);
        }
  }
}
template <int MODE>
DI void ph_gemm_probe(const bf16_t* A, int lda, const bf16_t* Bt, int ldb, int M, int N, int K, float* sink, char* lds, int bid, int nblk) {
  const int t = TIDX, lane = t & 63, wid = t >> 6, wr = wid >> 1, wc = wid & 1, lr = t >> 3, lc = (t & 7) * 8, fr = lane & 15, fq = lane >> 4;
  const int ntn = N / 128, nt = (M / 128) * ntn, nk = K / 64;
  constexpr int STAGE = A_BYTES + 128 * LROW;
  const int aoff = (wr * 64 + fr) * LROW + fq * 16, boff = A_BYTES + (wc * 64 + fr) * LROW + fq * 16;
#pragma unroll 1
  for (int tile = bid; tile < nt; tile += nblk) {
    f32x4 acc[4][4]; acc_zero<4>(acc);
    bf16x8 af[4], bfr[4];
    const int tm = tile / ntn, tn = tile % ntn;
    const bf16_t* ap[4]; const bf16_t* bp[4];
#pragma unroll
    for (int i = 0; i < 4; ++i) { ap[i] = A + (size_t)(tm * 128 + lr + 32 * i) * lda + lc; bp[i] = Bt + (size_t)(tn * 128 + lr + 32 * i) * ldb + lc; }
    u32x4 ra[4], rb[4], junk = {0u, 0u, 0u, 0u};
#pragma unroll
    for (int i = 0; i < 4; ++i) { ra[i] = junk; rb[i] = junk; }
#pragma unroll 1
    for (int kt = 0; kt < nk; ++kt) {
      const char* cur = lds + (kt & 1) * STAGE;
#pragma unroll
      for (int i = 0; i < 4; ++i) { ra[i] = ldg16(ap[i] + kt * 64); if (MODE == 3) rb[i] = ldg16(bp[i] + kt * 64); }
#pragma unroll
      for (int ks = 0; ks < 2; ++ks) {
#pragma unroll
        for (int m = 0; m < 4; ++m) { af[m] = lds_frag(cur + aoff + m * 16 * LROW + ks * 64); bfr[m] = lds_frag(cur + boff + m * 16 * LROW + ks * 64); }
#pragma unroll
        for (int m = 0; m < 4; ++m)
#pragma unroll
          for (int n = 0; n < 4; ++n) acc[m][n] = MFMA16(bfr[n], af[m], acc[m][n]);
      }
      junk.x ^= ra[0].x ^ ra[1].y ^ ra[2].z ^ ra[3].w ^ rb[0].x ^ rb[1].y ^ rb[2].z ^ rb[3].w;
      __syncthreads();
    }
    float s = (float)(junk.x & 1u);
#pragma unroll
    for (int m = 0; m < 4; ++m)
#pragma unroll
      for (int n = 0; n < 4; ++n) s += acc[m][n][0] + acc[m][n][3];
    if (s == 123456.789f) sink[0] = s;
  }
}
DI void ph_moe1(const Params& p, int need_ctx, char* lds, int bid, int nblk) {
  const int t = TIDX, lane = t & 63, wid = t >> 6, wr = wid >> 1, wc = wid & 1, lr = t >> 3, lc = (t & 7) * 8, fr = lane & 15, fq = lane >> 4;
  constexpr int NTN = FF / 64;
  const int NTM = need_ctx ? (NSLOT + 127) / 128 : (NB * CAPL) / 128;
  for (int u = bid; u < NE * NTM * NTN; u += nblk) {
    const int tile = xcd_swz(u, NE * NTM * NTN), e = tile / (NTM * NTN), rem = tile % (NTM * NTN), tm = rem / NTN, tn = rem % NTN;
    const bf16_t* ap[4]; const bf16_t* bp[4];
#pragma unroll
    for (int i = 0; i < 4; ++i) {
      const int slot = tm * 128 + lr + 32 * i;
      int r = slot < NSLOT ? p.SEL[(size_t)e * NSLOT + slot] : -1;
      ap[i] = p.H + (size_t)(r < 0 ? 0 : r) * D + lc;
      const int rho = lr + 32 * i, wci = rho >> 6, gu = (rho >> 5) & 1, col = wci * 32 + (rho & 31);
      bp[i] = (gu ? p.Wt_eu : p.Wt_eg) + ((size_t)e * FF + tn * 64 + col) * D + lc;
    }
    f32x4 acc[4][4]; acc_zero<4>(acc);
    gemm_kloop<4>(acc, ap, bp, D / 64, lds);
    f32x4 hid[4][2];
#pragma unroll
    for (int m = 0; m < 4; ++m) {
      const int slot = tm * 128 + wr * 64 + m * 16 + fr;
      const bool valid = slot < NSLOT && p.SEL[(size_t)e * NSLOT + (slot < NSLOT ? slot : 0)] >= 0;
#pragma unroll
      for (int n = 0; n < 2; ++n)
#pragma unroll
        for (int j = 0; j < 4; ++j) { const float g = acc[m][n][j], u = acc[m][n + 2][j]; hid[m][n][j] = valid ? g * u * fast_rcp(1.0f + fast_exp2(-LOG2E * g)) : 0.f; }
    }
    const int slot0 = tm * 128 + wr * 64;
    store_wave_tile<2>(hid, p.HID + ((size_t)e * NSLOT + slot0) * FF + tn * 64 + wc * 32, (size_t)FF, lds + wid * (64 * 80), lane, [&](int r) { return slot0 + r < NSLOT; });
    __syncthreads();
  }
}
DI void ph_moe2(const Params& p, int need_ctx, char* lds, int bid, int nblk) {
  const int t = TIDX, lane = t & 63, wid = t >> 6, wr = wid >> 1, wc = wid & 1, lr = t >> 3, lc = (t & 7) * 8, fr = lane & 15, fq = lane >> 4;
  constexpr int NTN = D / 128;
  const int NTM = need_ctx ? (NSLOT + 127) / 128 : (NB * CAPL) / 128;
  for (int u = bid; u < NE * NTM * NTN; u += nblk) {
    const int tile = xcd_swz(u, NE * NTM * NTN), e = tile / (NTM * NTN), rem = tile % (NTM * NTN), tm = rem / NTN, tn = rem % NTN;
    const bf16_t* ap[4]; const bf16_t* bp[4];
#pragma unroll
    for (int i = 0; i < 4; ++i) {
      int slot = tm * 128 + lr + 32 * i; if (slot >= NSLOT) slot = NSLOT - 1;
      ap[i] = p.HID + ((size_t)e * NSLOT + slot) * FF + lc;
      bp[i] = p.Wt_ed + ((size_t)e * D + tn * 128 + lr + 32 * i) * FF + lc;
    }
    f32x4 acc[4][4]; acc_zero<4>(acc);
    gemm_kloop<4>(acc, ap, bp, FF / 64, lds);
#pragma unroll
    for (int m = 0; m < 4; ++m) {
      const int slot = tm * 128 + wr * 64 + m * 16 + fr;
      const float val = (slot < NSLOT && p.SEL[(size_t)e * NSLOT + (slot < NSLOT ? slot : 0)] >= 0) ? p.SELV[(size_t)e * NSLOT + slot] : 0.f;
#pragma unroll
      for (int n = 0; n < 4; ++n) { acc[m][n].x *= val; acc[m][n].y *= val; acc[m][n].z *= val; acc[m][n].w *= val; }
    }
    const int slot0 = tm * 128 + wr * 64;
    store_wave_tile<4>(acc, p.YE + ((size_t)e * NSLOT + slot0) * D + tn * 128 + wc * 64, (size_t)D, lds + wid * (64 * 144), lane, [&](int r) { return slot0 + r < NSLOT; });
    __syncthreads();
  }
}
constexpr int GEMM_LDS = 2 * (A_BYTES + 128 * LROW);

DI void unpack8(u32x4 v, float (&f)[8]) {
  f[0] = u2f(v.x << 16); f[1] = u2f(v.x & 0xffff0000u); f[2] = u2f(v.y << 16); f[3] = u2f(v.y & 0xffff0000u);
  f[4] = u2f(v.z << 16); f[5] = u2f(v.z & 0xffff0000u); f[6] = u2f(v.w << 16); f[7] = u2f(v.w & 0xffff0000u);
}
DI u32x4 pack8f(const float (&f)[8]) { u32x4 v; v.x = pack2bf(f[0], f[1]); v.y = pack2bf(f[2], f[3]); v.z = pack2bf(f[4], f[5]); v.w = pack2bf(f[6], f[7]); return v; }
DI void rope8(float (&a)[8], const float (&pr)[8], int cc, const float* cs, const float* sn) {
  const int ax = (cc >> 1) * 8; const bool second = cc & 1;
#pragma unroll
  for (int i = 0; i < 8; ++i) a[i] = second ? a[i] * cs[ax + i] + pr[i] * sn[ax + i] : a[i] * cs[ax + i] - pr[i] * sn[ax + i];
}
constexpr int PREP_LDS = 64 * 4 + 2 * 512 * 4 + 32 * 528;
template <int PARTS = 3>
DI void ph_prep(const Params& p, int layer, const bf16_t* QRAW, const bf16_t* KVRAW, char* lds, int bid, int nblk) {
  float* s_rstd = (float*)lds;
  float* s_cs = s_rstd + 64;
  float* s_sn = s_cs + 512;
  bf16_t* s_t = (bf16_t*)(s_sn + 512);
  const int t = TIDX;
  constexpr int UPB = TK / 32, NU = NB * UPB;
  const float* wcv = p.w_conv + (size_t)layer * 3 * 512;
#pragma unroll 1
  for (int u = bid; u < NU; u += nblk) {
    int b, s0;
    if (u < NB * (TL / 32)) { b = u / (TL / 32); s0 = TC + (u % (TL / 32)) * 32; } else { const int v = u - NB * (TL / 32); b = v / (TC / 32); s0 = (v % (TC / 32)) * 32; }
    const int r0 = row_of(b, s0);
    {
      const int tok = t >> 3, part = t & 7;
      const bf16_t* z = p.Z + (size_t)(r0 + tok) * NZP;
      float sq = 0.f, sk = 0.f, f[8];
#pragma unroll
      for (int k = 0; k < 4; ++k) { unpack8(ldg16(z + ZC_QLAT + part * 32 + k * 8), f);
#pragma unroll
        for (int i = 0; i < 8; ++i) sq += f[i] * f[i]; }
#pragma unroll
      for (int k = 0; k < 2; ++k) { unpack8(ldg16(z + ZC_KVLAT + part * 16 + k * 8), f);
#pragma unroll
        for (int i = 0; i < 8; ++i) sk += f[i] * f[i]; }
      sq = xor_sum<1>(sq); sk = xor_sum<1>(sk);
      sq = xor_sum<2>(sq); sk = xor_sum<2>(sk);
      sq = xor_sum<4>(sq); sk = xor_sum<4>(sk);
      if (part == 0) { s_rstd[tok * 2] = 1.0f / sqrtf(sq * (1.0f / 256) + 1e-6f); s_rstd[tok * 2 + 1] = 1.0f / sqrtf(sk * (1.0f / 128) + 1e-6f); }
    }
    for (int i = t; i < 512; i += NTHR) {
      const int tok = i >> 4, af = i & 15, s = s0 + tok;
      float cs = 1.f, sn = 0.f;
      if (s >= TC) rope_cs(s, (af >> 3) * 16 + (af & 7), cs, sn);
      s_cs[i] = cs; s_sn[i] = sn;
    }
    __syncthreads();
    if (PARTS & 1) {
#pragma unroll 2
    for (int i = t; i < 32 * 48; i += NTHR) {
      const int tok = i / 48, c = i % 48, h = c / 12, ch = c % 12;
      const float rq = s_rstd[tok * 2] * QS_MLA, rkv = s_rstd[tok * 2 + 1];
      const bf16_t* q = QRAW + (size_t)(r0 + tok) * 384 + h * 96;
      float a[8], pr[8];
      unpack8(ldg16(q + ch * 8), a);
      if (ch >= 8) { unpack8(ldg16(q + 64 + ((ch - 8) ^ 1) * 8), pr); rope8(a, pr, ch - 8, s_cs + tok * 16, s_sn + tok * 16); }
#pragma unroll
      for (int e = 0; e < 8; ++e) a[e] *= rq;
      *(u32x4*)(p.Qm + (((size_t)b * 4 + h) * TK + s0 + tok) * 96 + ch * 8) = pack8f(a);
      if (ch < 8) {
        unpack8(ldg16(KVRAW + (size_t)(r0 + tok) * 512 + h * 128 + ch * 8), a);
#pragma unroll
        for (int e = 0; e < 8; ++e) a[e] *= rkv;
      } else {
        const bf16_t* z = p.Z + (size_t)(r0 + tok) * NZP + ZC_KROPE;
        unpack8(ldg16(z + (ch - 8) * 8), a); unpack8(ldg16(z + ((ch - 8) ^ 1) * 8), pr);
        rope8(a, pr, ch - 8, s_cs + tok * 16, s_sn + tok * 16);
      }
      *(u32x4*)(p.Km + (((size_t)b * 4 + h) * TK + s0 + tok) * 96 + ch * 8) = pack8f(a);
    }
#pragma unroll 2
    for (int i = t; i < 32 * 64; i += NTHR) {
      const int tok = i >> 6, c = i & 63, qk = c >> 5, hm = (c >> 2) & 7, cc = c & 3;
      const bf16_t* src = p.Z + (size_t)(r0 + tok) * NZP + (qk ? ZC_DK : ZC_DQ) + hm * 32;
      float a[8], pr[8];
      unpack8(ldg16(src + cc * 8), a); unpack8(ldg16(src + (cc ^ 1) * 8), pr);
      rope8(a, pr, cc, s_cs + tok * 16, s_sn + tok * 16);
      if (qk == 0) {
#pragma unroll
        for (int e = 0; e < 8; ++e) a[e] *= QS_DIFF;
        *(u32x4*)(p.Qd + (((size_t)b * 8 + hm) * TK + s0 + tok) * 32 + cc * 8) = pack8f(a);
      } else *(u32x4*)(p.Kd + (((size_t)b * 8 + hm) * TK + s0 + tok) * 32 + cc * 8) = pack8f(a);
    }
#pragma unroll 2
    for (int i = t; i < 32 * 64; i += NTHR) {
      const int tok = i >> 6, c8 = (i & 63) * 8, s = s0 + tok;
      const bool first = (s == 0) || (s == TC), last = (s == TC - 1) || (s == TK - 1);
      const bf16_t* z = p.Z + (size_t)(r0 + tok) * NZP + ZC_MLQK + c8;
      float x0[8], xm[8], xp[8], o[8];
      unpack8(ldg16(z), x0);
      if (!first) unpack8(ldg16(z - NZP), xm);
      if (!last) unpack8(ldg16(z + NZP), xp);
      float bc8[8], w0[8], w1[8], w2[8];
      *(f32x4*)bc8 = *(const f32x4*)(p.b_conv + layer * 512 + c8); *(f32x4*)(bc8 + 4) = *(const f32x4*)(p.b_conv + layer * 512 + c8 + 4);
      *(f32x4*)w0 = *(const f32x4*)(wcv + c8); *(f32x4*)(w0 + 4) = *(const f32x4*)(wcv + c8 + 4);
      *(f32x4*)w1 = *(const f32x4*)(wcv + 512 + c8); *(f32x4*)(w1 + 4) = *(const f32x4*)(wcv + 512 + c8 + 4);
      *(f32x4*)w2 = *(const f32x4*)(wcv + 1024 + c8); *(f32x4*)(w2 + 4) = *(const f32x4*)(wcv + 1024 + c8 + 4);
#pragma unroll
      for (int e = 0; e < 8; ++e) {
        float acc = bc8[e] + x0[e] * w1[e];
        if (!first) acc += xm[e] * w0[e];
        if (!last) acc += xp[e] * w2[e];
        o[e] = acc * fast_rcp(1.0f + fast_exp2(-LOG2E * acc));
      }
      if (c8 < 256) *(u32x4*)(p.MQ + ((size_t)b * TK + s) * 256 + c8) = pack8f(o);
      else {
#pragma unroll
        for (int e = 0; e < 8; ++e) o[e] *= 0.125f;
        *(u32x4*)(p.MK + ((size_t)b * TK + s) * 256 + c8 - 256) = pack8f(o);
      }
    }
    }
#pragma unroll 1
    for (int w = 0; w < ((PARTS & 2) ? 4 : 0); ++w) {
      __syncthreads();
#pragma unroll
      for (int k = 0; k < 4; ++k) {
        const int i = t + k * NTHR, tok = i >> 5, c8 = (i & 31) * 8;
        u32x4 v;
        if (w == 0) { float a[8]; const int h = c8 >> 6; unpack8(ldg16(KVRAW + (size_t)(r0 + tok) * 512 + h * 128 + 64 + (c8 & 63)), a); const float rkv = s_rstd[tok * 2 + 1];
#pragma unroll
          for (int e = 0; e < 8; ++e) a[e] *= rkv;
          v = pack8f(a); }
        else v = ldg16(p.Z + (size_t)(r0 + tok) * NZP + (w == 1 ? ZC_DV : (w == 2 ? ZC_MLV : ZC_GV)) + c8);
        *(u32x4*)(s_t + tok * 264 + c8) = v;
      }
      __syncthreads();
      bf16_t* dst = w == 0 ? p.Vtm : (w == 1 ? p.Vtd : (w == 2 ? p.MVt : p.GVt));
#pragma unroll
      for (int k = 0; k < 4; ++k) {
        const int i = t + k * NTHR, tg = i & 3, ch = i >> 2;
        u32x4 v;
        v.x = (unsigned)s_t[(tg * 8 + 0) * 264 + ch] | ((unsigned)s_t[(tg * 8 + 1) * 264 + ch] << 16);
        v.y = (unsigned)s_t[(tg * 8 + 2) * 264 + ch] | ((unsigned)s_t[(tg * 8 + 3) * 264 + ch] << 16);
        v.z = (unsigned)s_t[(tg * 8 + 4) * 264 + ch] | ((unsigned)s_t[(tg * 8 + 5) * 264 + ch] << 16);
        v.w = (unsigned)s_t[(tg * 8 + 6) * 264 + ch] | ((unsigned)s_t[(tg * 8 + 7) * 264 + ch] << 16);
        *(u32x4*)(dst + (((size_t)b * 4 + (ch >> 6)) * 64 + (ch & 63)) * TK + s0 + tg * 8) = v;
      }
    }
    __syncthreads();
  }
}
constexpr int VROW = 136;
constexpr int VROW_A = 144;
template <int DQK> struct AttnCfg {
  static constexpr int KROW = DQK * 2 + 16;
  static constexpr int KBYTES = 64 * KROW, VBYTES = 64 * VROW_A, STAGE = KBYTES + VBYTES;
  static constexpr int KCH = 64 * DQK * 2 / 16 / NTHR;
};
DI bf16x8 pack8(const f32x16& x, int s) {
  u32x4 pk; pk.x = pack2bf(x[8 * s], x[8 * s + 1]); pk.y = pack2bf(x[8 * s + 2], x[8 * s + 3]); pk.z = pack2bf(x[8 * s + 4], x[8 * s + 5]); pk.w = pack2bf(x[8 * s + 6], x[8 * s + 7]);
  return __builtin_bit_cast(bf16x8, pk);
}
template <int DQK, int NMAP, int VAR = 0>
DI void attn_unit(const bf16_t* __restrict__ Qb, const bf16_t* __restrict__ Kb, size_t mstride, const bf16_t* __restrict__ Vt, int q0, int nkeys,
                  f32x16 (&O)[NMAP][2], float (&lsum)[NMAP], char* lds) {
  constexpr int DM = DQK / NMAP;
  constexpr int KS = DM / 16;
  using C = AttnCfg<DQK>;
  constexpr int CPM = 64 * DM * 2 / 16;
  constexpr int CPR = DM * 2 / 16;
  const int t = TIDX, lane = t & 63, wid = t >> 6, l31 = lane & 31, hh = lane >> 5;
  bf16x8 qf[NMAP][KS];
#pragma unroll
  for (int m = 0; m < NMAP; ++m)
#pragma unroll
    for (int ks = 0; ks < KS; ++ks) qf[m][ks] = *(const bf16x8*)(Qb + m * mstride + (size_t)(q0 + wid * 32 + l31) * DM + ks * 16 + 8 * hh);
  float mref[NMAP];
#pragma unroll
  for (int m = 0; m < NMAP; ++m) { mref[m] = 0.f; lsum[m] = 0.f; O[m][0] = (f32x16)(0.f); O[m][1] = (f32x16)(0.f); }
  u32x4 rk[C::KCH], rv[2];
  const bf16_t* kg[C::KCH]; int klds[C::KCH];
#pragma unroll
  for (int i = 0; i < C::KCH; ++i) { const int c = t + i * NTHR, m = c / CPM, cc = c % CPM; kg[i] = Kb + m * mstride + cc * 8; klds[i] = (cc / CPR) * C::KROW + m * DM * 2 + (cc % CPR) * 16; }
  const bf16_t* vg = Vt + (size_t)(t >> 3) * TK + (t & 7) * 8;
  const int vlds = C::KBYTES + (t >> 3) * VROW_A + ((t & 7) >> 1) * 32 + ((t & 1) ? 8 : 0);
  const int kfoff = l31 * C::KROW + 16 * hh, vfoff = C::KBYTES + l31 * VROW_A + 16 * hh;
  const int nt = nkeys / 64;
#pragma unroll
  for (int i = 0; i < C::KCH; ++i) rk[i] = ldg16(kg[i]);
  rv[0] = ldg16(vg); rv[1] = ldg16(vg + (size_t)32 * TK);
#pragma unroll 1
  for (int kt = 0; kt < nt; ++kt) {
    char* cur = lds + (kt & 1) * C::STAGE;
    if (VAR != 2) {
#pragma unroll
    for (int i = 0; i < C::KCH; ++i) sts16(cur + klds[i], rk[i]);
#pragma unroll
    for (int i = 0; i < 2; ++i) { char* d = cur + vlds + i * 32 * VROW_A; u32x2 lo, hi; lo.x = rv[i].x; lo.y = rv[i].y; hi.x = rv[i].z; hi.y = rv[i].w; *(u32x2*)d = lo; *(u32x2*)(d + 16) = hi; }
    __syncthreads();
    }
    if (VAR != 2 && kt + 1 < nt) {
#pragma unroll
      for (int i = 0; i < C::KCH; ++i) rk[i] = ldg16(kg[i] + (size_t)(kt + 1) * 64 * DM);
      rv[0] = ldg16(vg + (kt + 1) * 64); rv[1] = ldg16(vg + (size_t)32 * TK + (kt + 1) * 64);
    }
    bf16x8 kf[NMAP][2][KS];
#pragma unroll
    for (int k2 = 0; k2 < 2; ++k2)
#pragma unroll
      for (int ks = 0; ks < KS; ++ks) kf[0][k2][ks] = lds_frag(cur + kfoff + k2 * 32 * C::KROW + ks * 32);
    f32x16 S[NMAP][2];
    S[0][0] = (f32x16)(0.f); S[0][1] = (f32x16)(0.f);
#pragma unroll
    for (int ks = 0; ks < KS; ++ks)
#pragma unroll
      for (int k2 = 0; k2 < 2; ++k2) S[0][k2] = MFMA32(kf[0][k2][ks], qf[0][ks], S[0][k2]);
    bf16x8 vf[4][2];
#pragma unroll
    for (int kst = 0; kst < 4; ++kst)
#pragma unroll
      for (int dvt = 0; dvt < 2; ++dvt) vf[kst][dvt] = lds_frag(cur + vfoff + dvt * 32 * VROW_A + kst * 32);
#pragma unroll
    for (int m = 1; m < NMAP; ++m)
#pragma unroll
      for (int k2 = 0; k2 < 2; ++k2)
#pragma unroll
        for (int ks = 0; ks < KS; ++ks) kf[m][k2][ks] = lds_frag(cur + kfoff + k2 * 32 * C::KROW + m * DM * 2 + ks * 32);
#pragma unroll
    for (int m = 0; m < NMAP; ++m) {
      if (m > 0) {
        S[m][0] = (f32x16)(0.f); S[m][1] = (f32x16)(0.f);
#pragma unroll
        for (int ks = 0; ks < KS; ++ks)
#pragma unroll
          for (int k2 = 0; k2 < 2; ++k2) S[m][k2] = MFMA32(kf[m][k2][ks], qf[m][ks], S[m][k2]);
      }
      if (VAR != 1) {
      if ((kt & 7) == 0) {
        float mx = fmaxf(S[m][0][0], S[m][1][0]);
#pragma unroll
        for (int i = 1; i < 16; ++i) mx = fmaxf(mx, fmaxf(S[m][0][i], S[m][1][i]));
        mx = xor_max<32>(mx);
        const float rel = mx - mref[m];
        const float delta = (kt == 0) ? ((mx > ATT_THR || mx < -ATT_THR) ? mx : 0.0f) : (rel > ATT_THR ? rel : 0.0f);
        if (wave_any(delta != 0.0f)) {
          const float alpha = fast_exp2(-delta);
          mref[m] += delta; lsum[m] *= alpha;
#pragma unroll
          for (int dvt = 0; dvt < 2; ++dvt)
#pragma unroll
            for (int i = 0; i < 16; ++i) O[m][dvt][i] *= alpha;
        }
      }
      if (wave_any(mref[m] != 0.0f)) {
        const f32x2 nm = {-mref[m], -mref[m]};
#pragma unroll
        for (int k2 = 0; k2 < 2; ++k2)
#pragma unroll
          for (int i = 0; i < 16; i += 2) { const f32x2 x = (f32x2){S[m][k2][i], S[m][k2][i + 1]} + nm; S[m][k2][i] = x.x; S[m][k2][i + 1] = x.y; }
      }
      f32x2 ps2 = {0.f, 0.f};
#pragma unroll
      for (int k2 = 0; k2 < 2; ++k2)
#pragma unroll
        for (int i = 0; i < 16; i += 2) {
          const float e0 = fast_exp2(S[m][k2][i]), e1 = fast_exp2(S[m][k2][i + 1]);
          S[m][k2][i] = e0; S[m][k2][i + 1] = e1; ps2 += (f32x2){e0, e1};
        }
      lsum[m] += ps2.x + ps2.y;
      } else lsum[m] += 1.0f;
#pragma unroll
      for (int kst = 0; kst < 4; ++kst) {
        const bf16x8 pf = pack8(S[m][kst >> 1], kst & 1);
#pragma unroll
        for (int dvt = 0; dvt < 2; ++dvt) O[m][dvt] = MFMA32(vf[kst][dvt], pf, O[m][dvt]);
      }
    }
  }
  __syncthreads();
#pragma unroll
  for (int m = 0; m < NMAP; ++m) lsum[m] = xor_sum<32>(lsum[m]);
}
constexpr int ATT_QB = TK / 128;
constexpr int ATT_LDS = 2 * AttnCfg<96>::STAGE;
constexpr int ATT_QBL = TL / 128, ATT_QBC = TC / 128, ATT_LAT_UNITS = NB * 4 * ATT_QBL, ATT_UNITS = ATT_LAT_UNITS + NB * 4 * ATT_QBC;
DI void att_unit(int u, int& bh, int& qb) {
  if (u < ATT_LAT_UNITS) { bh = u & 7; qb = ATT_QBC + (u >> 3); } else { const int v = u - ATT_LAT_UNITS; bh = v & 7; qb = v >> 3; }
}
DI void ph_attn_diff(const Params& p, int layer, int need_ctx, char* lds, int bid, int nblk) {
  const int lane = TIDX & 63, wid = TIDX >> 6, l31 = lane & 31, hh = lane >> 5;
  float lam_init; const float lam = lam_of(p, layer, lam_init);
#pragma unroll 1
  for (int u = bid; u < (need_ctx ? ATT_UNITS : ATT_LAT_UNITS); u += nblk) {
    int bh, qb; att_unit(u, bh, qb);
    const int b = bh >> 2, h = bh & 3, q0 = qb * 128;
    const int r = row_of(b, q0 + wid * 32 + l31);
    f32x16 O[2][2]; float ls[2];
    attn_unit<64, 2>(p.Qd + ((size_t)b * 8 + h * 2) * TK * 32, p.Kd + ((size_t)b * 8 + h * 2) * TK * 32, (size_t)TK * 32, p.Vtd + ((size_t)b * 4 + h) * 64 * TK, q0,
                     q0 < TC ? TC : TK, O, ls, lds);
    const float i0 = 1.0f / ls[0], i1 = lam / ls[1];
    float ss = 0.f;
#pragma unroll
    for (int dvt = 0; dvt < 2; ++dvt)
#pragma unroll
      for (int i = 0; i < 16; ++i) { const float o = O[0][dvt][i] * i0 - O[1][dvt][i] * i1; O[0][dvt][i] = o; ss += o * o; }
    ss = xor_sum<32>(ss);
    const float rstd = (1.0f - lam_init) / sqrtf(ss * (1.0f / 64) + 1e-6f);
    const float* gd = p.g_diff_out + layer * 256 + h * 64;
#pragma unroll
    for (int dvt = 0; dvt < 2; ++dvt)
#pragma unroll
      for (int g = 0; g < 4; ++g) {
        const int dv = dvt * 32 + 8 * g + 4 * hh;
        const f32x4 gv = *(const f32x4*)(gd + dv);
        f32x4 o = {O[0][dvt][4 * g] * rstd * gv[0], O[0][dvt][4 * g + 1] * rstd * gv[1], O[0][dvt][4 * g + 2] * rstd * gv[2], O[0][dvt][4 * g + 3] * rstd * gv[3]};
        st_bf16x4(p.Y + (size_t)r * D + 768 + h * 64 + dv, o);
      }
  }
}
DI void ph_attn_mla(const Params& p, int need_ctx, char* lds, int bid, int nblk) {
  const int lane = TIDX & 63, wid = TIDX >> 6, l31 = lane & 31, hh = lane >> 5;
#pragma unroll 1
  for (int u = bid; u < (need_ctx ? ATT_UNITS : ATT_LAT_UNITS); u += nblk) {
    int bh, qb; att_unit(u, bh, qb);
    const int b = bh >> 2, h = bh & 3, q0 = qb * 128;
    const int r = row_of(b, q0 + wid * 32 + l31);
    f32x16 O[1][2]; float ls[1];
    attn_unit<96, 1>(p.Qm + ((size_t)b * 4 + h) * TK * 96, p.Km + ((size_t)b * 4 + h) * TK * 96, 0, p.Vtm + ((size_t)b * 4 + h) * 64 * TK, q0, q0 < TC ? TC : TK, O, ls, lds);
    const float inv = 1.0f / ls[0];
#pragma unroll
    for (int dvt = 0; dvt < 2; ++dvt)
#pragma unroll
      for (int g = 0; g < 4; ++g) {
        f32x4 o = {O[0][dvt][4 * g] * inv, O[0][dvt][4 * g + 1] * inv, O[0][dvt][4 * g + 2] * inv, O[0][dvt][4 * g + 3] * inv};
        st_bf16x4(p.Y + (size_t)r * D + h * 64 + dvt * 32 + 8 * g + 4 * hh, o);
      }
  }
}
template <int VAR> DI void ph_attn_mla_probe(const Params& p, char* lds, int bid, int nblk) {
  const int lane = TIDX & 63, wid = TIDX >> 6, l31 = lane & 31, hh = lane >> 5;
#pragma unroll 1
  for (int u = bid; u < ATT_LAT_UNITS; u += nblk) {
    int bh, qb; att_unit(u, bh, qb);
    const int b = bh >> 2, h = bh & 3, q0 = qb * 128;
    const int r = row_of(b, q0 + wid * 32 + l31);
    f32x16 O[1][2]; float ls[1];
    attn_unit<96, 1, VAR>(p.Qm + ((size_t)b * 4 + h) * TK * 96, p.Km + ((size_t)b * 4 + h) * TK * 96, 0, p.Vtm + ((size_t)b * 4 + h) * 64 * TK, q0, TK, O, ls, lds);
    const float inv = 1.0f / ls[0];
#pragma unroll
    for (int dvt = 0; dvt < 2; ++dvt)
#pragma unroll
      for (int g = 0; g < 4; ++g) {
        f32x4 o = {O[0][dvt][4 * g] * inv, O[0][dvt][4 * g + 1] * inv, O[0][dvt][4 * g + 2] * inv, O[0][dvt][4 * g + 3] * inv};
        *(f32x4*)(p.out + (size_t)r * D + h * 64 + dvt * 32 + 8 * g + 4 * hh) = o;
      }
  }
}
DI void ph_attn(const Params& p, int layer, int need_ctx, char* lds, int bid, int nblk) {
  ph_attn_diff(p, layer, need_ctx, lds, bid, nblk);
  ph_attn_mla(p, need_ctx, lds, bid, nblk);
}

DI float wave_sum(float v) {
  v = xor_sum<1>(v); v = xor_sum<2>(v); v = xor_sum<4>(v); v = xor_sum<8>(v); v = xor_sum<16>(v); v = xor_sum<32>(v);
  return v;
}
DI void ld_row16(const float* row, int lane, f32x4 (&v)[4]) {
#pragma unroll
  for (int i = 0; i < 4; ++i) v[i] = *(const f32x4*)(row + 256 * i + 4 * lane);
}
DI void ld_row16_bf(const bf16_t* row, int lane, f32x4 (&v)[4]) {
#pragma unroll
  for (int i = 0; i < 4; ++i) { const u32x2 u = *(const u32x2*)(row + 256 * i + 4 * lane); v[i] = (f32x4){u2f(u.x << 16), u2f(u.x & 0xffff0000u), u2f(u.y << 16), u2f(u.y & 0xffff0000u)}; }
}
DI void ph_modulate(const Params& p, int layer, const float* xl, const float* xcx, int bid, int nblk) {
  const int lane = TIDX & 63, wid = TIDX >> 6;
  const float* g = p.g_mix_pre + layer * 1024;
  for (int r = bid * 4 + wid; r < R; r += nblk * 4) {
    const int w = r < RL ? r / TL : 2;
    const float* mb = p.mods + (size_t)(layer * 3 + w) * 6144;
    const float* x = r < RL ? xl + (size_t)r * D : xcx + (size_t)(r - RL) * D;
    f32x4 xv[4], gv[4], sc[4], sh[4];
    ld_row16(x, lane, xv); ld_row16(g, lane, gv); ld_row16(mb + 1024, lane, sc); ld_row16(mb, lane, sh);
    float ss = 0.f;
#pragma unroll
    for (int i = 0; i < 4; ++i)
#pragma unroll
      for (int e = 0; e < 4; ++e) ss += xv[i][e] * xv[i][e];
    const float rstd = 1.0f / sqrtf(wave_sum(ss) * (1.0f / D) + 1e-6f);
#pragma unroll
    for (int i = 0; i < 4; ++i) {
      f32x4 o;
#pragma unroll
      for (int e = 0; e < 4; ++e) o[e] = xv[i][e] * rstd * gv[i][e] * (1.f + sc[i][e]) + sh[i][e];
      st_bf16x4(p.H + (size_t)r * D + 256 * i + 4 * lane, o);
    }
  }
}
DI void ph_resid_mix(const Params& p, int layer, const float* xl_in, const float* xc_in, int rows, int bid, int nblk) {
  const int lane = TIDX & 63, wid = TIDX >> 6;
  const float* wr = p.w_router + (size_t)layer * D * 16;
  for (int r = bid * 4 + wid; r < rows; r += nblk * 4) {
    const int w = r < RL ? r / TL : 2;
    const float* mb = p.mods + (size_t)(layer * 3 + w) * 6144;
    const float* xin = r < RL ? xl_in + (size_t)r * D : xc_in + (size_t)(r - RL) * D;
    float* xo = r < RL ? p.out + (size_t)r * D : p.xc + (size_t)(r - RL) * D;
    f32x4 yv[4], xv[4], a[4], c[4];
    ld_row16_bf(p.YO + (size_t)r * D, lane, yv); ld_row16(xin, lane, xv);
    float ss = 0.f;
#pragma unroll
    for (int i = 0; i < 4; ++i)
#pragma unroll
      for (int e = 0; e < 4; ++e) ss += yv[i][e] * yv[i][e];
    const float rstd = 1.0f / sqrtf(wave_sum(ss) * (1.0f / D) + 1e-6f);
    ld_row16(mb + 2 * 1024, lane, a); ld_row16(p.g_mix_post + layer * 1024, lane, c);
    float s2 = 0.f;
#pragma unroll
    for (int i = 0; i < 4; ++i) {
#pragma unroll
      for (int e = 0; e < 4; ++e) { xv[i][e] += a[i][e] * yv[i][e] * rstd * c[i][e]; s2 += xv[i][e] * xv[i][e]; }
      *(f32x4*)(xo + 256 * i + 4 * lane) = xv[i];
    }
    const float rstd2 = 1.0f / sqrtf(wave_sum(s2) * (1.0f / D) + 1e-6f);
    ld_row16(p.g_ffn_pre + layer * 1024, lane, a); ld_row16(mb + 4 * 1024, lane, c); ld_row16(mb + 3 * 1024, lane, yv);
    float lg[16];
#pragma unroll
    for (int e = 0; e < 16; ++e) lg[e] = 0.f;
#pragma unroll
    for (int i = 0; i < 4; ++i) {
      f32x4 h2;
#pragma unroll
      for (int e = 0; e < 4; ++e) h2[e] = xv[i][e] * rstd2 * a[i][e] * (1.f + c[i][e]) + yv[i][e];
      st_bf16x4(p.H + (size_t)r * D + 256 * i + 4 * lane, h2);
#pragma unroll
      for (int e = 0; e < 4; ++e) {
        const float* wk = wr + (size_t)(256 * i + 4 * lane + e) * 16;
#pragma unroll
        for (int q = 0; q < 4; ++q) { const f32x4 wv = *(const f32x4*)(wk + 4 * q); lg[4 * q] += h2[e] * wv[0]; lg[4 * q + 1] += h2[e] * wv[1]; lg[4 * q + 2] += h2[e] * wv[2]; lg[4 * q + 3] += h2[e] * wv[3]; }
      }
    }
#pragma unroll
    for (int e = 0; e < 16; ++e) lg[e] = wave_sum(lg[e]);
    float mx = lg[0];
#pragma unroll
    for (int e = 1; e < 16; ++e) mx = fmaxf(mx, lg[e]);
    float sm = 0.f;
#pragma unroll
    for (int e = 0; e < 16; ++e) { lg[e] = expf(lg[e] - mx); sm += lg[e]; }
    int b, s; bs_of(r, b, s);
    float mine = 0.f;
#pragma unroll
    for (int e = 0; e < 16; ++e) mine = (lane == e) ? lg[e] / sm : mine;
    if (lane < 16) p.AFF[((size_t)b * NE + lane) * TK + s] = mine;
  }
}
DI void ph_resid_ffn(const Params& p, int layer, int rows, int bid, int nblk) {
  const int lane = TIDX & 63, wid = TIDX >> 6;
  for (int r = bid * 4 + wid; r < rows; r += nblk * 4) {
    const int w = r < RL ? r / TL : 2;
    const float* mb = p.mods + (size_t)(layer * 3 + w) * 6144;
    float* xo = r < RL ? p.out + (size_t)r * D : p.xc + (size_t)(r - RL) * D;
    const int myinv = lane < NE ? p.INV[(size_t)r * NE + lane] : -1;
    f32x4 f[4];
#pragma unroll
    for (int i = 0; i < 4; ++i) f[i] = (f32x4){0.f, 0.f, 0.f, 0.f};
    for (int e = 0; e < NE; ++e) {
      const int sl = lane_bcast(myinv, e);
      if (sl >= 0) { f32x4 yv[4]; ld_row16_bf(p.YE + ((size_t)e * NSLOT + sl) * D, lane, yv);
#pragma unroll
        for (int i = 0; i < 4; ++i) f[i] += yv[i]; }
    }
    float ss = 0.f;
#pragma unroll
    for (int i = 0; i < 4; ++i)
#pragma unroll
      for (int e = 0; e < 4; ++e) ss += f[i][e] * f[i][e];
    const float rstd = 1.0f / sqrtf(wave_sum(ss) * (1.0f / D) + 1e-6f);
    f32x4 a[4], c[4], xv[4];
    ld_row16(mb + 5 * 1024, lane, a); ld_row16(p.g_ffn_post + layer * 1024, lane, c); ld_row16(xo, lane, xv);
#pragma unroll
    for (int i = 0; i < 4; ++i) {
#pragma unroll
      for (int e = 0; e < 4; ++e) xv[i][e] += a[i][e] * f[i][e] * rstd * c[i][e];
      *(f32x4*)(xo + 256 * i + 4 * lane) = xv[i];
    }
  }
}
DI void ph_mods(const Params& p, char* lds, int bid, int nblk) {
  float* sc = (float*)lds;
  const int t = TIDX;
  for (int i = t; i < 3 * 1024; i += NTHR) { const float v = i < 2048 ? p.c[i] : p.c_ctx[i - 2048]; sc[i] = v / (1.0f + expf(-v)); }
  __syncthreads();
#pragma unroll 1
  for (long gi = (long)bid * NTHR + t; gi < 2 * 3 * 6144; gi += (long)nblk * NTHR) {
    const int col = (int)(gi % 6144), w = (int)((gi / 6144) % 3), l = (int)(gi / (3 * 6144));
    const float* W = p.w_ada + (size_t)l * 1024 * 6144 + col; const float* s = sc + w * 1024;
    float acc[8];
#pragma unroll
    for (int q = 0; q < 8; ++q) acc[q] = 0.f;
#pragma unroll 1
    for (int k = 0; k < 1024; k += 8) {
#pragma unroll
      for (int q = 0; q < 8; ++q) acc[q] += s[k + q] * W[(size_t)(k + q) * 6144];
    }
    p.mods[gi] = ((acc[0] + acc[1]) + (acc[2] + acc[3])) + ((acc[4] + acc[5]) + (acc[6] + acc[7])) + p.b_ada[l * 6144 + col];
  }
  __syncthreads();
}
constexpr int TOPK_LDS = TL * 4 + 2048;
DI int block_sum_i(int v, int* red) {
  const int lane = TIDX & 63, wid = TIDX >> 6;
  v = xor_sum_i<1>(v); v = xor_sum_i<2>(v); v = xor_sum_i<4>(v); v = xor_sum_i<8>(v); v = xor_sum_i<16>(v); v = xor_sum_i<32>(v);
  __syncthreads();
  if (lane == 0) red[wid] = v;
  __syncthreads();
  return red[0] + red[1] + red[2] + red[3];
}
DI int block_excl_scan(int v, int* red) {
  const int lane = TIDX & 63, wid = TIDX >> 6;
  int inc = v;
#pragma unroll
  for (int d = 1; d < 64; d <<= 1) { const int o = lane_up(inc, d, lane); if (lane >= d) inc += o; }
  __syncthreads();
  if (lane == 63) red[wid] = inc;
  __syncthreads();
  int base = 0;
  for (int q = 0; q < wid; ++q) base += red[q];
  return base + inc - v;
}
DI void ph_topk(const Params& p, int need_ctx, char* lds, int bid, int nblk) {
  unsigned* vals = (unsigned*)lds; int* red = (int*)(lds + TL * 4 + 1024);
  const int t = TIDX;
  for (int u = bid; u < NB * NE * 2; u += nblk) {
    const int seg = u & 1, e = (u >> 1) % NE, b = u / (2 * NE);
    const int s0 = seg ? TC : 0, n = seg ? TL : TC, cap = seg ? CAPL : CAPC, slot0 = seg ? b * CAPL : NB * CAPL + b * CAPC;
    if (seg == 0 && !need_ctx) { for (int q = t; q < cap; q += NTHR) p.SEL[(size_t)e * NSLOT + slot0 + q] = -1; continue; }
    const float* a = p.AFF + ((size_t)b * NE + e) * TK + s0;
    const int vpt = (n + NTHR - 1) / NTHR, i0 = t * vpt, i1 = (i0 + vpt < n) ? i0 + vpt : n;
    for (int i = t; i < n; i += NTHR) vals[i + i / vpt] = f2u(a[i]);
    __syncthreads();
    unsigned thr = 0;
    for (int bit = 31; bit >= 0; --bit) {
      const unsigned cand = thr | (1u << bit);
      int cnt = 0;
      for (int i = i0; i < i1; ++i) cnt += (vals[i + t] >= cand);
      if (block_sum_i(cnt, red) >= cap) thr = cand;
    }
    int cgt = 0, ceq = 0;
    for (int i = i0; i < i1; ++i) { cgt += (vals[i + t] > thr); ceq += (vals[i + t] == thr); }
    const int ngt = block_sum_i(cgt, red);
    const int neq = cap - ngt;
    int eqoff = block_excl_scan(ceq, red);
    int csel = 0;
    { int er = eqoff; for (int i = i0; i < i1; ++i) { if (vals[i + t] > thr) ++csel; else if (vals[i + t] == thr) { if (er < neq) ++csel; ++er; } } }
    int q = block_excl_scan(csel, red);
    for (int i = i0; i < i1; ++i) {
      const unsigned v = vals[i + t]; int sel = -1;
      if (v > thr) sel = q++; else if (v == thr) { if (eqoff < neq) sel = q++; ++eqoff; }
      const int r = row_of(b, s0 + i);
      if (sel >= 0) { p.SEL[(size_t)e * NSLOT + slot0 + sel] = r; p.SELV[(size_t)e * NSLOT + slot0 + sel] = u2f(v); }
      p.INV[(size_t)r * NE + e] = sel >= 0 ? slot0 + sel : -1;
    }
    __syncthreads();
  }
}
DI void ph_wt(const float* in, bf16_t* out, int K, int N, int NP, int nbatch, long in_bs, long out_bs, const float* gain, char* lds, int bid, int nblk) {
  float* tile = (float*)lds;
  const int t = TIDX, tk = K / 64, tn = NP / 64, ntile = nbatch * tk * tn;
  f32x4 v[4];
  auto gload = [&](int u) {
    const int bt = u / (tk * tn), rem = u % (tk * tn), k0 = (rem / tn) * 64, n0 = (rem % tn) * 64;
    const float* I = in + (size_t)bt * in_bs;
#pragma unroll
    for (int i = 0; i < 4; ++i) {
      const int idx = t + i * NTHR, kk = idx >> 4, n4 = (idx & 15) * 4;
      v[i] = (f32x4){0.f, 0.f, 0.f, 0.f};
      if (n0 + n4 < N) v[i] = *(const f32x4*)(I + (size_t)(k0 + kk) * N + n0 + n4);
      if (gain) { const float g = gain[k0 + kk]; v[i][0] *= g; v[i][1] *= g; v[i][2] *= g; v[i][3] *= g; }
    }
  };
  if (bid < ntile) gload(bid);
#pragma unroll 1
  for (int u = bid; u < ntile; u += nblk) {
    const int bt = u / (tk * tn), rem = u % (tk * tn), k0 = (rem / tn) * 64, n0 = (rem % tn) * 64;
    bf16_t* O = out + (size_t)bt * out_bs;
#pragma unroll
    for (int i = 0; i < 4; ++i) { const int idx = t + i * NTHR, kk = idx >> 4, n4 = (idx & 15) * 4; float* d = tile + kk * 65 + n4; d[0] = v[i][0]; d[1] = v[i][1]; d[2] = v[i][2]; d[3] = v[i][3]; }
    __syncthreads();
    if (u + nblk < ntile) gload(u + nblk);
#pragma unroll
    for (int i = 0; i < 2; ++i) {
      const int idx = t + i * NTHR, kg = idx & 7, nn = idx >> 3;
      float a[8];
#pragma unroll
      for (int e = 0; e < 8; ++e) a[e] = tile[(kg * 8 + e) * 65 + nn];
      u32x4 o; o.x = pack2bf(a[0], a[1]); o.y = pack2bf(a[2], a[3]); o.z = pack2bf(a[4], a[5]); o.w = pack2bf(a[6], a[7]);
      *(u32x4*)(O + (size_t)(n0 + nn) * K + k0 + kg * 8) = o;
    }
    __syncthreads();
  }
}
DI float wave_max(float v) {
  v = xor_max<1>(v); v = xor_max<2>(v); v = xor_max<4>(v); v = xor_max<8>(v); v = xor_max<16>(v); v = xor_max<32>(v);
  return v;
}
DI bf16x8 cvt8(const float* f) {
  const f32x4 a = *(const f32x4*)f, b = *(const f32x4*)(f + 4);
  u32x4 pk; pk.x = pack2bf(a[0], a[1]); pk.y = pack2bf(a[2], a[3]); pk.z = pack2bf(b[0], b[1]); pk.w = pack2bf(b[2], b[3]);
  return __builtin_bit_cast(bf16x8, pk);
}
constexpr int SCAN_UNITS = NB * NCK * 4, SCAN_LAT_UNITS = NB * NCL * 4;
DI void scan_unit(int u, int& b, int& c, int& h) {
  h = u & 3;
  if (u < SCAN_LAT_UNITS) { c = NCC + (u >> 2) % NCL; b = u / (4 * NCL); } else { const int v = u - SCAN_LAT_UNITS; c = (v >> 2) % NCC; b = v / (4 * NCC); }
}

DI void ph_ml_local(const Params& p, char* lds, int bid, int nblk) {
  bf16_t* sK = (bf16_t*)lds;
  float* sW = (float*)(lds + 64 * 132);
  const int t = TIDX, lane = t & 63, wid = t >> 6, l31 = lane & 31, hh = lane >> 5;
  const int d = wid & 1, vt = wid >> 1;
#pragma unroll 1
  for (int u = bid; u < SCAN_UNITS; u += nblk) {
    int b, c, h; scan_unit(u, b, c, h);
    {
      const int row = t >> 2, seg = (t & 3) * 16;
      const bf16_t* src = p.MK + ((size_t)b * TK + 64 * c + row) * 256 + h * 64 + seg;
      const u32x4 a = ldg16(src), bb = ldg16(src + 8);
      unsigned* dst = (unsigned*)((char*)sK + row * 132 + seg * 2);
      dst[0] = a.x; dst[1] = a.y; dst[2] = a.z; dst[3] = a.w; dst[4] = bb.x; dst[5] = bb.y; dst[6] = bb.z; dst[7] = bb.w;
    }
    if (t < 128) {
      const int dd = t >> 6, l = t & 63, j = step_of(dd, c), pos = dd ? 63 - l : l;
      const size_t o = (((size_t)b * 2 + dd) * TK + 64 * j) * 4 + h;
      const float bend = p.BC[o + 63 * 4], wl = bend - p.BC[o + pos * 4] + p.IGS[o + pos * 4];
      const float ml = wave_max(wl);
      sW[dd * 64 + l] = expf(wl - ml);
      if (l == 0) { const size_t uu = (((size_t)b * 2 + dd) * NCK + j) * 4 + h; p.MM[uu * 4] = ml; p.MM[uu * 4 + 1] = bend; }
    }
    __syncthreads();
    const int j = step_of(d, c);
    const size_t uu = (((size_t)b * 2 + d) * NCK + j) * 4 + h;
    f32x16 acc[2]; acc[0] = (f32x16)(0.f); acc[1] = (f32x16)(0.f);
    const bf16_t* vsrc = p.MVt + (((size_t)b * 4 + h) * 64 + vt * 32 + l31) * TK + 64 * c;
#pragma unroll
    for (int ks = 0; ks < 4; ++ks) {
      const bf16x8 a = *(const bf16x8*)(vsrc + ks * 16 + 8 * hh);
      const float* w = sW + d * 64 + ks * 16 + 8 * hh;
      u32x4 pk;
      pk.x = pack2bf(bf2f((bf16_t)a[0]) * w[0], bf2f((bf16_t)a[1]) * w[1]); pk.y = pack2bf(bf2f((bf16_t)a[2]) * w[2], bf2f((bf16_t)a[3]) * w[3]);
      pk.z = pack2bf(bf2f((bf16_t)a[4]) * w[4], bf2f((bf16_t)a[5]) * w[5]); pk.w = pack2bf(bf2f((bf16_t)a[6]) * w[6], bf2f((bf16_t)a[7]) * w[7]);
      const bf16x8 af = __builtin_bit_cast(bf16x8, pk);
#pragma unroll
      for (int kt = 0; kt < 2; ++kt) {
        bf16x8 bfr;
#pragma unroll
        for (int q = 0; q < 8; ++q) bfr[q] = (short)sK[(ks * 16 + 8 * hh + q) * 66 + kt * 32 + l31];
        acc[kt] = MFMA32(af, bfr, acc[kt]);
      }
    }
#pragma unroll
    for (int kt = 0; kt < 2; ++kt)
#pragma unroll
      for (int i = 0; i < 16; ++i) p.MC[uu * 4096 + (size_t)(vt * 32 + (i & 3) + 8 * (i >> 2) + 4 * hh) * 64 + kt * 32 + l31] = acc[kt][i];
    float nl = 0.f;
    for (int q = 0; q < 32; ++q) { const int l = hh * 32 + q; nl += sW[d * 64 + l] * bf2f(sK[l * 66 + vt * 32 + l31]); }
    nl = xor_sum<32>(nl);
    if (hh == 0) p.MN[uu * 64 + vt * 32 + l31] = nl;
    __syncthreads();
  }
}
DI void ph_ml_scan(const Params& p, int bid, int nblk) {
  for (long gi = (long)bid * NTHR + TIDX; gi < (long)NB * 2 * 4 * 4160; gi += (long)nblk * NTHR) {
    const int e = (int)(gi % 4160), ch = (int)(gi / 4160), h = ch & 3, bd = ch >> 2;
    float* base = e < 4096 ? p.MC + (((size_t)bd * NCK) * 4 + h) * 4096 + e : p.MN + (((size_t)bd * NCK) * 4 + h) * 64 + (e - 4096);
    const size_t stride = e < 4096 ? 4 * 4096 : 4 * 64;
    float* mm = p.MM + (((size_t)bd * NCK) * 4 + h) * 4;
    float st = 0.f, m = -1e30f;
    float cl[8], cm[8], cb[8], nl[8], nm[8], nb[8];
#pragma unroll
    for (int q = 0; q < 8; ++q) { cl[q] = base[(size_t)q * stride]; cm[q] = mm[q * 16]; cb[q] = mm[q * 16 + 1]; }
#pragma unroll 1
    for (int jb = 0; jb < NCK; jb += 8) {
#pragma unroll
      for (int q = 0; q < 8; ++q) { const int j = jb + 8 + q; if (j < NCK) { nl[q] = base[(size_t)j * stride]; nm[q] = mm[j * 16]; nb[q] = mm[j * 16 + 1]; } }
#pragma unroll
      for (int q = 0; q < 8; ++q) {
        const int j = jb + q;
        if (j < NCK) {
          const float mn = fmaxf(cb[q] + m, cm[q]), a = expf(cb[q] + m - mn), g = expf(cm[q] - mn);
          base[(size_t)j * stride] = st;
          st = a * st + g * cl[q];
          if (e == 0) mm[j * 16 + 2] = m;
          m = mn;
        }
      }
#pragma unroll
      for (int q = 0; q < 8; ++q) { cl[q] = nl[q]; cm[q] = nm[q]; cb[q] = nb[q]; }
    }
  }
}
DI void ph_gla_scan(const Params& p, int bid, int nblk) {
  for (long gi = (long)bid * NTHR + TIDX; gi < (long)NB * 2 * 4 * 2048; gi += (long)nblk * NTHR) {
    const int e = (int)(gi % 2048), ch = (int)(gi / 2048), h = ch & 3, bd = ch >> 2, k = e & 31;
    float* base = p.GS + (((size_t)bd * NCK) * 4 + h) * 2048 + e;
    const float* ge = p.GC + ((size_t)bd * TK + 63) * 128 + h * 32 + k;
    float st = 0.f;
    float cl[8], cg[8], nl[8], ng[8];
#pragma unroll
    for (int q = 0; q < 8; ++q) { cl[q] = base[(size_t)q * 4 * 2048]; cg[q] = ge[(size_t)q * 64 * 128]; }
#pragma unroll 1
    for (int jb = 0; jb < NCK; jb += 8) {
#pragma unroll
      for (int q = 0; q < 8; ++q) { const int j = jb + 8 + q; if (j < NCK) { nl[q] = base[(size_t)j * 4 * 2048]; ng[q] = ge[(size_t)j * 64 * 128]; } }
#pragma unroll
      for (int q = 0; q < 8; ++q) {
        const int j = jb + q;
        if (j < NCK) { base[(size_t)j * 4 * 2048] = st; st = expf(cg[q]) * st + cl[q]; }
      }
#pragma unroll
      for (int q = 0; q < 8; ++q) { cl[q] = nl[q]; cg[q] = ng[q]; }
    }
  }
}
constexpr int MO_K = 0, MO_V = 64 * 144, MO_A = MO_V + 64 * VROW, MO_PM = MO_A + 512, MO_N0 = MO_PM + 512, MO_X = MO_N0 + 512, MO_LDS = MO_X + 16384;
DI void ph_ml_out(const Params& p, int layer, int need_ctx, char* lds, int bid, int nblk) {
  float* sA = (float*)(lds + MO_A); float* sPM = (float*)(lds + MO_PM); float* sN0 = (float*)(lds + MO_N0); float* sX = (float*)(lds + MO_X);
  const int t = TIDX, lane = t & 63, wid = t >> 6, l31 = lane & 31, hh = lane >> 5;
  const int lt = wid & 1, d = wid >> 1;
#pragma unroll 1
  for (int u = bid; u < (need_ctx ? SCAN_UNITS : SCAN_LAT_UNITS); u += nblk) {
    int b, c, h; scan_unit(u, b, c, h);
    {
      const int row = t >> 2, seg = (t & 3) * 16;
      const bf16_t* ks = p.MK + ((size_t)b * TK + 64 * c + row) * 256 + h * 64 + seg;
      sts16(lds + MO_K + row * 144 + seg * 2, ldg16(ks)); sts16(lds + MO_K + row * 144 + seg * 2 + 16, ldg16(ks + 8));
      const bf16_t* vs = p.MVt + (((size_t)b * 4 + h) * 64 + row) * TK + 64 * c + seg;
      const u32x4 v0 = ldg16(vs), v1 = ldg16(vs + 8);
      u32x2* dv = (u32x2*)(lds + MO_V + row * VROW + seg * 2);
      u32x2 q; q.x = v0.x; q.y = v0.y; dv[0] = q; q.x = v0.z; q.y = v0.w; dv[1] = q; q.x = v1.x; q.y = v1.y; dv[2] = q; q.x = v1.z; q.y = v1.w; dv[3] = q;
    }
    if (t < 128) {
      const int dd = t >> 6, s = t & 63, j = step_of(dd, c), pos = dd ? 63 - s : s;
      const size_t o = (((size_t)b * 2 + dd) * TK + 64 * j) * 4 + h;
      sA[dd * 64 + s] = p.IGS[o + pos * 4] - p.BC[o + pos * 4];
      const size_t uu = (((size_t)b * 2 + dd) * NCK + j) * 4 + h;
      sN0[dd * 64 + s] = p.MN[uu * 64 + s];
    }
    __syncthreads();
    if (t < 2) {
      float m = -1e30f;
      if (t == 0) { for (int s = 0; s < 64; ++s) { m = fmaxf(m, sA[s]); sPM[s] = m; } }
      else { for (int s = 63; s >= 0; --s) { m = fmaxf(m, sA[64 + s]); sPM[64 + s] = m; } }
    }
    __syncthreads();
    const int j = step_of(d, c);
    const size_t uu = (((size_t)b * 2 + d) * NCK + j) * 4 + h;
    const int l = lt * 32 + l31, pos = d ? 63 - l : l;
    const float bl = p.BC[(((size_t)b * 2 + d) * TK + 64 * j + pos) * 4 + h];
    const float inter = bl + p.MM[uu * 4 + 2];
    const float mt = fmaxf(inter, bl + sPM[d * 64 + l]);
    const float aint = expf(inter - mt);
    bf16x8 qf[4];
#pragma unroll
    for (int ks = 0; ks < 4; ++ks) qf[ks] = *(const bf16x8*)(p.MQ + ((size_t)b * TK + 64 * c + l) * 256 + h * 64 + ks * 16 + 8 * hh);
    f32x16 num[2]; num[0] = (f32x16)(0.f); num[1] = (f32x16)(0.f);
    float den = 0.f;
#pragma unroll
    for (int st = 0; st < 2; ++st) {
      if (d == 0 ? st <= lt : st >= lt) {
        f32x16 S = (f32x16)(0.f);
#pragma unroll
        for (int ks = 0; ks < 4; ++ks) S = MFMA32(lds_frag(lds + MO_K + (st * 32 + l31) * 144 + (ks * 16 + 8 * hh) * 2), qf[ks], S);
#pragma unroll
        for (int i = 0; i < 16; ++i) {
          const int s = st * 32 + (i & 3) + 8 * (i >> 2) + 4 * hh;
          const bool ok = d == 0 ? s <= l : s >= l;
          const float e = ok ? fast_exp2((bl + sA[d * 64 + s] - mt) * LOG2E) * S[i] : 0.f;
          S[i] = e; den += e;
        }
#pragma unroll
        for (int kst = 0; kst < 2; ++kst) {
          const bf16x8 pf = pack8(S, kst);
#pragma unroll
          for (int vt = 0; vt < 2; ++vt) {
            const char* vp = lds + MO_V + (vt * 32 + l31) * VROW + (st * 32 + kst * 16 + 4 * hh) * 2;
            const s16x4 lo = *(const s16x4*)vp, hi = *(const s16x4*)(vp + 16);
            num[vt] = MFMA32(__builtin_shufflevector(lo, hi, 0, 1, 2, 3, 4, 5, 6, 7), pf, num[vt]);
          }
        }
      }
    }
    f32x16 accI[2]; accI[0] = (f32x16)(0.f); accI[1] = (f32x16)(0.f);
#pragma unroll
    for (int vt = 0; vt < 2; ++vt)
#pragma unroll
      for (int ks = 0; ks < 4; ++ks) accI[vt] = MFMA32(cvt8(p.MC + uu * 4096 + (size_t)(vt * 32 + l31) * 64 + ks * 16 + 8 * hh), qf[ks], accI[vt]);
    float qn = 0.f;
#pragma unroll
    for (int ks = 0; ks < 4; ++ks)
#pragma unroll
      for (int q = 0; q < 8; ++q) qn += bf2f((bf16_t)qf[ks][q]) * sN0[d * 64 + ks * 16 + 8 * hh + q];
    den = xor_sum<32>(den + aint * qn);
    const float inv = 1.0f / fmaxf(fabsf(den), expf(-mt));
#pragma unroll
    for (int vt = 0; vt < 2; ++vt)
#pragma unroll
      for (int i = 0; i < 16; ++i) num[vt][i] = (num[vt][i] + aint * accI[vt][i]) * inv;
    if (d == 1) {
#pragma unroll
      for (int vt = 0; vt < 2; ++vt)
#pragma unroll
        for (int i = 0; i < 16; ++i) sX[(lt * 32 + vt * 16 + i) * 64 + lane] = num[vt][i];
    }
    __syncthreads();
    if (d == 0) {
      float ss = 0.f;
#pragma unroll
      for (int vt = 0; vt < 2; ++vt)
#pragma unroll
        for (int i = 0; i < 16; ++i) { num[vt][i] += sX[(lt * 32 + vt * 16 + i) * 64 + lane]; ss += num[vt][i] * num[vt][i]; }
      ss = xor_sum<32>(ss);
      const float rstd = 1.0f / sqrtf(ss * (1.0f / 64) + 1e-6f);
      const int r = row_of(b, 64 * c + l);
#pragma unroll
      for (int vt = 0; vt < 2; ++vt)
#pragma unroll
        for (int g = 0; g < 4; ++g) {
          const int v0 = vt * 32 + 8 * g + 4 * hh;
          const u32x2 ou = *(const u32x2*)(p.Z + (size_t)r * NZP + ZC_MLO + h * 64 + v0);
          const f32x4 gv = *(const f32x4*)(p.g_mlstm_out + layer * 256 + h * 64 + v0);
          const float o0 = u2f(ou.x << 16), o1 = u2f(ou.x & 0xffff0000u), o2 = u2f(ou.y << 16), o3 = u2f(ou.y & 0xffff0000u);
          f32x4 y = {sigmoidf_(o0) * num[vt][4 * g] * rstd * gv[0], sigmoidf_(o1) * num[vt][4 * g + 1] * rstd * gv[1],
                     sigmoidf_(o2) * num[vt][4 * g + 2] * rstd * gv[2], sigmoidf_(o3) * num[vt][4 * g + 3] * rstd * gv[3]};
          st_bf16x4(p.Y + (size_t)r * D + 256 + h * 64 + v0, y);
        }
    }
    __syncthreads();
  }
}
DI void ph_gla_local(const Params& p, char* lds, int bid, int nblk) {
  bf16_t* sKd = (bf16_t*)lds;
  const int t = TIDX, lane = t & 63, wid = t >> 6, l31 = lane & 31, hh = lane >> 5;
  const int d = wid & 1, vt = wid >> 1;
#pragma unroll 1
  for (int u = bid; u < SCAN_UNITS; u += nblk) {
    int b, c, h; scan_unit(u, b, c, h);
    {
      const int dd = t >> 7, l = (t >> 1) & 63, k0 = (t & 1) * 16, j = step_of(dd, c), pos = dd ? 63 - l : l;
      const float* gcr = p.GC + (((size_t)b * 2 + dd) * TK + 64 * j + pos) * 128 + h * 32 + k0;
      const float* ger = p.GC + (((size_t)b * 2 + dd) * TK + 64 * j + 63) * 128 + h * 32 + k0;
      const bf16_t* kr = p.Z + (size_t)row_of(b, 64 * c + l) * NZP + ZC_GK + h * 32 + k0;
#pragma unroll
      for (int q = 0; q < 16; ++q) sKd[(dd * 64 + l) * 33 + k0 + q] = f2bf(bf2f(kr[q]) * fast_exp2((ger[q] - gcr[q]) * LOG2E));
    }
    __syncthreads();
    const int j = step_of(d, c);
    const size_t uu = (((size_t)b * 2 + d) * NCK + j) * 4 + h;
    f32x16 acc = (f32x16)(0.f);
    const bf16_t* vsrc = p.GVt + (((size_t)b * 4 + h) * 64 + vt * 32 + l31) * TK + 64 * c;
#pragma unroll
    for (int ks = 0; ks < 4; ++ks) {
      const bf16x8 af = *(const bf16x8*)(vsrc + ks * 16 + 8 * hh);
      bf16x8 bfr;
#pragma unroll
      for (int q = 0; q < 8; ++q) bfr[q] = (short)sKd[(d * 64 + ks * 16 + 8 * hh + q) * 33 + l31];
      acc = MFMA32(af, bfr, acc);
    }
#pragma unroll
    for (int i = 0; i < 16; ++i) p.GS[uu * 2048 + (size_t)(vt * 32 + (i & 3) + 8 * (i >> 2) + 4 * hh) * 32 + l31] = acc[i];
    __syncthreads();
  }
}
constexpr int GO_Q = 0, GO_K = 2 * 64 * 80, GO_V = 2 * GO_K, GO_X = GO_V + 64 * VROW, GO_LDS = GO_X + 16384;
DI void ph_gla_out(const Params& p, int layer, int need_ctx, char* lds, int bid, int nblk) {
  float* sX = (float*)(lds + GO_X);
  const int t = TIDX, lane = t & 63, wid = t >> 6, l31 = lane & 31, hh = lane >> 5;
  const int lt = wid & 1, d = wid >> 1;
#pragma unroll 1
  for (int u = bid; u < (need_ctx ? SCAN_UNITS : SCAN_LAT_UNITS); u += nblk) {
    int b, c, h; scan_unit(u, b, c, h);
    {
      const int dd = t >> 7, l = (t >> 1) & 63, k0 = (t & 1) * 16, j = step_of(dd, c), pos = dd ? 63 - l : l;
      const float* gcr = p.GC + (((size_t)b * 2 + dd) * TK + 64 * j + pos) * 128 + h * 32 + k0;
      const bf16_t* zr = p.Z + (size_t)row_of(b, 64 * c + l) * NZP;
      bf16_t* qd = (bf16_t*)(lds + GO_Q + (dd * 64 + l) * 80) + k0; bf16_t* kd = (bf16_t*)(lds + GO_K + (dd * 64 + l) * 80) + k0;
#pragma unroll
      for (int q = 0; q < 16; ++q) {
        const float g = gcr[q];
        qd[q] = f2bf(bf2f(zr[ZC_GQ + h * 32 + k0 + q]) * 0.17677669529663687f * fast_exp2(g * LOG2E));
        kd[q] = f2bf(bf2f(zr[ZC_GK + h * 32 + k0 + q]) * fast_exp2(-g * LOG2E));
      }
      const int row = t >> 2, seg = (t & 3) * 16;
      const bf16_t* vs = p.GVt + (((size_t)b * 4 + h) * 64 + row) * TK + 64 * c + seg;
      const u32x4 v0 = ldg16(vs), v1 = ldg16(vs + 8);
      u32x2* dv = (u32x2*)(lds + GO_V + row * VROW + seg * 2);
      u32x2 q2; q2.x = v0.x; q2.y = v0.y; dv[0] = q2; q2.x = v0.z; q2.y = v0.w; dv[1] = q2; q2.x = v1.x; q2.y = v1.y; dv[2] = q2; q2.x = v1.z; q2.y = v1.w; dv[3] = q2;
    }
    __syncthreads();
    const int j = step_of(d, c);
    const size_t uu = (((size_t)b * 2 + d) * NCK + j) * 4 + h;
    const int l = lt * 32 + l31;
    bf16x8 qf[2];
#pragma unroll
    for (int ks = 0; ks < 2; ++ks) qf[ks] = lds_frag(lds + GO_Q + (d * 64 + l) * 80 + (ks * 16 + 8 * hh) * 2);
    f32x16 O[2]; O[0] = (f32x16)(0.f); O[1] = (f32x16)(0.f);
#pragma unroll
    for (int st = 0; st < 2; ++st) {
      if (d == 0 ? st <= lt : st >= lt) {
        f32x16 S = (f32x16)(0.f);
#pragma unroll
        for (int ks = 0; ks < 2; ++ks) S = MFMA32(lds_frag(lds + GO_K + (d * 64 + st * 32 + l31) * 80 + (ks * 16 + 8 * hh) * 2), qf[ks], S);
#pragma unroll
        for (int i = 0; i < 16; ++i) {
          const int s = st * 32 + (i & 3) + 8 * (i >> 2) + 4 * hh;
          const bool ok = d == 0 ? s <= l : s >= l;
          S[i] = ok ? S[i] : 0.f;
        }
#pragma unroll
        for (int kst = 0; kst < 2; ++kst) {
          const bf16x8 pf = pack8(S, kst);
#pragma unroll
          for (int vt = 0; vt < 2; ++vt) {
            const char* vp = lds + GO_V + (vt * 32 + l31) * VROW + (st * 32 + kst * 16 + 4 * hh) * 2;
            const s16x4 lo = *(const s16x4*)vp, hi = *(const s16x4*)(vp + 16);
            O[vt] = MFMA32(__builtin_shufflevector(lo, hi, 0, 1, 2, 3, 4, 5, 6, 7), pf, O[vt]);
          }
        }
      }
    }
#pragma unroll
    for (int vt = 0; vt < 2; ++vt)
#pragma unroll
      for (int ks = 0; ks < 2; ++ks) O[vt] = MFMA32(cvt8(p.GS + uu * 2048 + (size_t)(vt * 32 + l31) * 32 + ks * 16 + 8 * hh), qf[ks], O[vt]);
    if (d == 1) {
#pragma unroll
      for (int vt = 0; vt < 2; ++vt)
#pragma unroll
        for (int i = 0; i < 16; ++i) sX[(lt * 32 + vt * 16 + i) * 64 + lane] = O[vt][i];
    }
    __syncthreads();
    if (d == 0) {
      float ss = 0.f;
#pragma unroll
      for (int vt = 0; vt < 2; ++vt)
#pragma unroll
        for (int i = 0; i < 16; ++i) { O[vt][i] += sX[(lt * 32 + vt * 16 + i) * 64 + lane]; ss += O[vt][i] * O[vt][i]; }
      ss = xor_sum<32>(ss);
      const float rstd = 1.0f / sqrtf(ss * (1.0f / 64) + 1e-6f);
      const int r = row_of(b, 64 * c + l);
#pragma unroll
      for (int vt = 0; vt < 2; ++vt)
#pragma unroll
        for (int g = 0; g < 4; ++g) {
          const int v0 = vt * 32 + 8 * g + 4 * hh;
          const u32x2 ru = *(const u32x2*)(p.Z + (size_t)r * NZP + ZC_GR + h * 64 + v0);
          const f32x4 gv = *(const f32x4*)(p.g_gla_out + layer * 256 + h * 64 + v0);
          const float r0 = u2f(ru.x << 16), r1 = u2f(ru.x & 0xffff0000u), r2 = u2f(ru.y << 16), r3 = u2f(ru.y & 0xffff0000u);
          f32x4 y = {siluf_(r0) * O[vt][4 * g] * rstd * gv[0], siluf_(r1) * O[vt][4 * g + 1] * rstd * gv[1],
                     siluf_(r2) * O[vt][4 * g + 2] * rstd * gv[2], siluf_(r3) * O[vt][4 * g + 3] * rstd * gv[3]};
          st_bf16x4(p.Y + (size_t)r * D + 512 + h * 64 + v0, y);
        }
    }
    __syncthreads();
  }
}

DI float fast_logsigmoid(float x) {
  const float e = fast_exp2(-fabsf(x) * LOG2E);
#ifdef CPU_EMU
  return fminf(x, 0.f) - log1pf(e);
#else
  return fminf(x, 0.f) - 0.6931471805599453f * __builtin_amdgcn_logf(1.0f + e);
#endif
}
DI float wave_incl_scan(float v, int lane) {
#pragma unroll
  for (int dd = 1; dd < 64; dd <<= 1) { const float o = u2f((unsigned)lane_up((int)f2u(v), dd, lane)); if (lane >= dd) v += o; }
  return v;
}
constexpr int GCUM_LDS = 4 * 64 * 33 * 4;
DI void ph_gates_cum(const Params& p, int layer, char* lds, int bid, int nblk) {
  const int t = TIDX, lane = t & 63, wid = t >> 6;
  float* stg = (float*)lds + wid * 64 * 33;
  const float* wal = p.w_alpha2 + (size_t)layer * 2 * 16 * 128;
#pragma unroll 1
  for (int u = bid * 4 + wid; u < NB * 2 * NCK; u += nblk * 4) {
    const int j = u % NCK, d = (u / NCK) & 1, b = u / (2 * NCK);
    const int pp = 64 * j + lane, s = seq_of(d, pp);
    const bf16_t* z = p.Z + (size_t)row_of(b, s) * NZP;
    const size_t ob = ((size_t)b * 2 + d) * TK + pp;
    {
      const u32x2 iu = *(const u32x2*)(z + ZC_MLIG + d * 4), fu = *(const u32x2*)(z + ZC_MLFG + d * 4);
      const float ig[4] = {u2f(iu.x << 16), u2f(iu.x & 0xffff0000u), u2f(iu.y << 16), u2f(iu.y & 0xffff0000u)};
      const float fg[4] = {u2f(fu.x << 16), u2f(fu.x & 0xffff0000u), u2f(fu.y << 16), u2f(fu.y & 0xffff0000u)};
      f32x4 oc, oi;
#pragma unroll
      for (int h = 0; h < 4; ++h) {
        oi[h] = ig[h] + p.b_igate[layer * 8 + d * 4 + h];
        oc[h] = wave_incl_scan(fast_logsigmoid(fg[h] + p.b_fgate[layer * 8 + d * 4 + h]), lane);
      }
      *(f32x4*)(p.BC + ob * 4) = oc; *(f32x4*)(p.IGS + ob * 4) = oi;
    }
    float a[16];
    { float f0[8], f1[8]; unpack8(ldg16(z + ZC_GA + d * 16), f0); unpack8(ldg16(z + ZC_GA + d * 16 + 8), f1);
#pragma unroll
      for (int q = 0; q < 8; ++q) { a[q] = f0[q]; a[8 + q] = f1[q]; } }
    const float* W = wal + (size_t)d * 16 * 128;
#pragma unroll 1
    for (int cg = 0; cg < 4; ++cg) {
#pragma unroll 4
      for (int c = 0; c < 32; ++c) {
        const int ch = cg * 32 + c;
        float zg = p.b_alpha[layer * 256 + d * 128 + ch];
#pragma unroll
        for (int q = 0; q < 16; ++q) zg += a[q] * W[q * 128 + ch];
        stg[lane * 33 + c] = wave_incl_scan(fast_logsigmoid(zg) * (1.0f / 16.0f), lane);
      }
      WAVE_SYNC();
#pragma unroll
      for (int k = 0; k < 32; ++k) { const int pos = k * 2 + (lane >> 5), c = lane & 31; p.GC[(((size_t)b * 2 + d) * TK + 64 * j + pos) * 128 + cg * 32 + c] = stg[pos * 33 + c]; }
      WAVE_SYNC();
    }
  }
}
#define XB_TMO      128
#define XB_XCNT(j)  (256  + 64 * (j))
#define XB_XSUB(j)  (1280 + 64 * (j))
#define XB_XGEN(j)  (2304 + 64 * (j))
#define XB_TOP      3328
#define XB_TOPGEN   3392
#define XCD_BAR_WORDS 3456
#define XB_SPIN_CAP (1u << 28)
#define LAS __attribute__((address_space(3)))

__device__ __forceinline__ unsigned xb_ld(unsigned* p)              { return __hip_atomic_load(p, __ATOMIC_RELAXED, __HIP_MEMORY_SCOPE_AGENT); }
__device__ __forceinline__ unsigned xb_add(unsigned* p, unsigned v) { return __hip_atomic_fetch_add(p, v, __ATOMIC_RELAXED, __HIP_MEMORY_SCOPE_AGENT); }
__device__ __forceinline__ unsigned xb_xcc_id() { return (unsigned)__builtin_amdgcn_s_getreg((3 << 11) | 20) & 0xFu; }
#define XB_SPIN(cond, bar) do { unsigned _sp = 0; while (cond) { __builtin_amdgcn_s_sleep(1); \
    if ((++_sp & 255u) == 0u) { if (xb_ld(&(bar)[XB_TMO])) break; if (_sp > XB_SPIN_CAP) { atomicAdd(&(bar)[XB_TMO], 1u); break; } } } } while (0)

struct XcdBarrier {
    unsigned* bar; unsigned x;
    volatile LAS unsigned* st;
};

__device__ __forceinline__ XcdBarrier xcd_barrier_post(unsigned* bar, volatile LAS unsigned* st) {
    XcdBarrier b; b.bar = bar; b.x = xb_xcc_id(); b.st = st;
    if (threadIdx.x == 0) (void)xb_add(&bar[XB_XCNT(b.x)], 1u);
    return b;
}
__device__ __forceinline__ void xcd_barrier_complete(unsigned* bar, unsigned x, unsigned& nloc, unsigned& nx) {
    const unsigned G = gridDim.x * gridDim.y * gridDim.z;
    unsigned sum, cnt, mine, sp = 0u;
    for (;;) {
        sum = 0u; cnt = 0u; mine = 0u;
#pragma unroll
        for (unsigned j = 0; j < 16; ++j) { const unsigned c = xb_ld(&bar[XB_XCNT(j)]); sum += c; cnt += (c > 0u) ? 1u : 0u; mine = (j == x) ? c : mine; }
        if (sum == G) break;
        __builtin_amdgcn_s_sleep(1);
        if ((++sp & 255u) == 0u) { if (xb_ld(&bar[XB_TMO])) break; if (sp > XB_SPIN_CAP) { atomicAdd(&bar[XB_TMO], 1u); break; } }
    }
    nloc = mine > 0u ? mine : 1u; nx = cnt > 0u ? cnt : 1u;
}

__device__ __forceinline__ void xcd_barrier(const XcdBarrier& b) {
    asm volatile("s_waitcnt vmcnt(0)" ::: "memory");
    __syncthreads();
    if (threadIdx.x == 0) {
        unsigned* bar = b.bar;
        __builtin_amdgcn_s_waitcnt(0);
        unsigned nloc = b.st[0], nx = b.st[1];
        if (nloc == 0u) { xcd_barrier_complete(bar, b.x, nloc, nx); b.st[0] = nloc; b.st[1] = nx; }
        const unsigned old = xb_add(&bar[XB_XSUB(b.x)], 1u);
        const unsigned gen = old / nloc;
        if (old + 1u == (gen + 1u) * nloc) {
            __builtin_amdgcn_fence(__ATOMIC_RELEASE, "agent");
            asm volatile("s_waitcnt vmcnt(0)" ::: "memory");
            const unsigned og = xb_add(&bar[XB_TOP], 1u);
            const unsigned tg = og / nx;
            if (og + 1u == (tg + 1u) * nx) xb_add(&bar[XB_TOPGEN], 1u);
            else XB_SPIN(xb_ld(&bar[XB_TOPGEN]) == tg, bar);
            __builtin_amdgcn_fence(__ATOMIC_ACQUIRE, "agent");
            xb_add(&bar[XB_XGEN(b.x)], 1u);
            asm volatile("s_waitcnt vmcnt(0)" ::: "memory");
        } else {
            XB_SPIN(xb_ld(&bar[XB_XGEN(b.x)]) == gen, bar);
            __builtin_amdgcn_fence(__ATOMIC_ACQUIRE, "agent");
            asm volatile("s_waitcnt vmcnt(0)" ::: "memory");
        }
    }
    __syncthreads();
}

#define GS_LOOP(N, CALL) for (long gi = (long)bid * NTHR + TIDX; gi < (long)(N); gi += (long)nblk * NTHR) { CALL; }
#ifndef PROBE
#define PROBE 0
#endif
#ifndef FAST_SCAN
#define FAST_SCAN 1
#endif
constexpr int N_PHASES = 16;
constexpr int MEGA_LDS = GEMM_LDS > TOPK_LDS ? GEMM_LDS : TOPK_LDS;

template <int PH>
DI void run_phase(const Params& p, int l, char* lds, int bid, int nblk) {
  const int need_ctx = (l == 0);
  const int rows = need_ctx ? R : RL;
  const float* xl_in = l == 0 ? p.x : p.out;
  const float* xc_in = l == 0 ? p.ctx : p.xc;
  bf16_t* QRAW = p.YO; bf16_t* KVRAW = p.YO + (size_t)R * 384;
  if constexpr (PH == 0) {
    ph_mods(p, lds, bid, nblk);
#pragma unroll 1
    for (int ll = 0; ll < 2; ++ll) {
      ph_wt(p.w_in + (size_t)ll * D * NZ, p.Wt_in + ll * WSZ_IN, D, NZ, NZP, 1, 0L, 0L, nullptr, lds, bid, nblk);
      ph_wt(p.w_gate + (size_t)ll * D * 4096, p.Wt_gate + ll * WSZ_GATE, D, 4096, 4096, 1, 0L, 0L, nullptr, lds, bid, nblk);
      ph_wt(p.w_branch + (size_t)ll * 4 * 256 * D, p.Wt_branch + ll * WSZ_BR, 256, D, D, 4, (long)256 * D, (long)D * 256, nullptr, lds, bid, nblk);
      ph_wt(p.w_out + (size_t)ll * D * D, p.Wt_out + ll * WSZ_OUT, D, D, D, 1, 0L, 0L, nullptr, lds, bid, nblk);
      ph_wt(p.w_uq + (size_t)ll * 256 * 384, p.Wt_uq + ll * WSZ_UQ, 256, 384, 384, 1, 0L, 0L, p.g_q_lat + ll * 256, lds, bid, nblk);
      ph_wt(p.w_ukv + (size_t)ll * 128 * 512, p.Wt_ukv + ll * WSZ_UKV, 128, 512, 512, 1, 0L, 0L, p.g_kv_lat + ll * 128, lds, bid, nblk);
    }
  } else if constexpr (PH == 1) {
    ph_modulate(p, l, xl_in, xc_in, bid, nblk);
  } else if constexpr (PH == 2) {
    ph_gemm_plain(p.H, D, p.Wt_in + l * WSZ_IN, D, R, NZP, D, p.Z, NZP, lds, bid, nblk);
#if PROBE == 63
    ph_gemm_probe<3>(p.H, D, p.Wt_in + l * WSZ_IN, D, R, NZP, D, p.mods + 40000, lds, bid, nblk);
#elif PROBE == 66
    ph_gemm_probe<6>(p.H, D, p.Wt_in + l * WSZ_IN, D, R, NZP, D, p.mods + 40000, lds, bid, nblk);
#elif PROBE == 67
    ph_gemm_plain<1>(p.H, D, p.Wt_in + l * WSZ_IN, D, R, NZP, D, p.Z, NZP, lds, bid, nblk);
#elif PROBE == 5
    ph_gemm_plain(p.H, D, p.Wt_in + l * WSZ_IN, D, R, NZP, D, p.Z, NZP, lds, bid, nblk);
#endif
  } else if constexpr (PH == 3) {
    ph_mla_up(p, l, QRAW, KVRAW, lds, bid, nblk);
  } else if constexpr (PH == 4) {
    ph_prep(p, l, QRAW, KVRAW, lds, bid, nblk);
#if PROBE == 41
    ph_prep(p, l, QRAW, KVRAW, lds, bid, nblk);
#elif PROBE == 43
    ph_prep<1>(p, l, QRAW, KVRAW, lds, bid, nblk);
#elif PROBE == 44
    ph_prep<2>(p, l, QRAW, KVRAW, lds, bid, nblk);
#endif
    __syncthreads();
    ph_gates_cum(p, l, lds, bid, nblk);
#if PROBE == 42
    ph_gates_cum(p, l, lds, bid, nblk);
#endif
  } else if constexpr (PH == 5) {
#if FAST_SCAN
    ph_ml_local(p, lds, bid, nblk);
    ph_gla_local(p, lds, bid, nblk);
#else
    GS_LOOP((long)NUNIT * 4160, nvb_ml_local(gi, p));
    GS_LOOP((long)NUNIT * 2048, nvb_gla_local(gi, p));
#endif
  } else if constexpr (PH == 6) {
#if FAST_SCAN
    ph_ml_scan(p, bid, nblk);
    ph_gla_scan(p, (bid + nblk - 260 % nblk) % nblk, nblk);
#else
    GS_LOOP((long)NB * 2 * 4 * 4160, nvb_ml_scan(gi, p));
    GS_LOOP((long)NB * 2 * 4 * 2048, nvb_gla_scan(gi, p));
#endif
    ph_attn(p, l, need_ctx, lds, bid, nblk);
#if PROBE >= 10 && PROBE < 20
    if (l == 0) ph_attn_mla_probe<PROBE - 10>(p, lds, bid, nblk);
#elif PROBE == 1
    ph_attn_diff(p, l, need_ctx, lds, bid, nblk);
#elif PROBE == 2
    ph_attn_mla(p, need_ctx, lds, bid, nblk);
#endif
  } else if constexpr (PH == 7) {
#if FAST_SCAN
    ph_ml_out(p, l, need_ctx, lds, bid, nblk);
    ph_gla_out(p, l, need_ctx, lds, bid, nblk);
#else
    GS_LOOP((long)NUNIT * 4096, nvb_ml_out(gi, p, need_ctx));
    GS_LOOP((long)NUNIT * 4096, nvb_gla_out(gi, p, need_ctx));
#endif
  } else if constexpr (PH == 8) {
#if !FAST_SCAN
    GS_LOOP((long)R * 4, nvb_ml_finish(gi, p, l, need_ctx));
    GS_LOOP((long)R * 4, nvb_gla_finish(gi, p, l, need_ctx));
#endif
  } else if constexpr (PH == 9) {
    ph_merge(p, l, rows, lds, bid, nblk);
#if PROBE == 3
    ph_merge(p, l, rows, lds, bid, nblk);
#endif
  } else if constexpr (PH == 10) {
    ph_gemm_plain(p.MG, D, p.Wt_out + l * WSZ_OUT, D, rows, D, D, p.YO, D, lds, bid, nblk);
  } else if constexpr (PH == 11) {
    ph_resid_mix(p, l, xl_in, xc_in, rows, bid, nblk);
  } else if constexpr (PH == 12) {
    ph_topk(p, need_ctx, lds, bid, nblk);
    ph_wt(p.w_e_gate + (size_t)l * NE * D * FF, p.Wt_eg, D, FF, FF, NE, (long)D * FF, (long)FF * D, nullptr, lds, bid, nblk);
    ph_wt(p.w_e_up + (size_t)l * NE * D * FF, p.Wt_eu, D, FF, FF, NE, (long)D * FF, (long)FF * D, nullptr, lds, bid, nblk);
    ph_wt(p.w_e_down + (size_t)l * NE * FF * D, p.Wt_ed, FF, D, D, NE, (long)FF * D, (long)D * FF, nullptr, lds, bid, nblk);
  } else if constexpr (PH == 13) {
    ph_moe1(p, need_ctx, lds, bid, nblk);
#if PROBE == 4
    ph_moe1(p, need_ctx, lds, bid, nblk);
#endif
  } else if constexpr (PH == 14) {
    ph_moe2(p, need_ctx, lds, bid, nblk);
#if PROBE == 4
    ph_moe2(p, need_ctx, lds, bid, nblk);
#endif
  } else if constexpr (PH == 15) {
    ph_resid_ffn(p, l, rows, bid, nblk);
  }
}

template <int PH> __global__ void __launch_bounds__(256, 2) k_phase(Params p, int l) {
  DYN_LDS(lds);
  run_phase<PH>(p, l, lds, blockIdx.x, gridDim.x);
}

#if !defined(CPU_EMU) && !MK_MULTI
typedef const Params __attribute__((address_space(4)))* KParams;
DI KParams kp_fresh() { KParams k = (KParams)__builtin_amdgcn_kernarg_segment_ptr(); asm volatile("" : "+s"(k)); return k; }
#define PHASE(PH, L) do { asm volatile("; PHASE_MARK " #PH); KParams k_ = kp_fresh(); run_phase<PH>(*(const Params*)k_, (L), lds, bid, nblk); if (PROBE == 20 + PH || (PROBE == 99 && (PH == 4 || PH == 5))) { __syncthreads(); run_phase<PH>(*(const Params*)k_, (L), lds, bid, nblk); } XcdBarrier b_ = bar; asm volatile("" : "+s"(b_.bar), "+s"(b_.x)); xcd_barrier(b_); if (PROBE == 50) xcd_barrier(b_); } while (0)
__global__ void __launch_bounds__(256, 2) k_mega(Params pv) {
  DYN_LDS(lds_all);
  if (threadIdx.x == 0) *(uint4*)lds_all = make_uint4(0u, 0u, 0u, 0u);
  __syncthreads();
  XcdBarrier bar = xcd_barrier_post(pv.bar, (volatile LAS unsigned*)lds_all);
  char* lds = lds_all + 256;
  const int bid = blockIdx.x, nblk = gridDim.x;
  PHASE(0, 0);
#pragma unroll 1
  for (int l = 0; l < 2; ++l) {
    PHASE(1, l); PHASE(2, l); PHASE(3, l); PHASE(4, l); PHASE(5, l); PHASE(6, l); PHASE(7, l);
#if !FAST_SCAN
    PHASE(8, l);
#endif

    PHASE(9, l); PHASE(10, l); PHASE(11, l); PHASE(12, l); PHASE(13, l); PHASE(14, l); PHASE(15, l);
  }
}
#endif
#ifdef CPU_EMU
void emu_check(const Params& p, int layer, int stage);
#define EMU_CHECK(stg) emu_check(p, l, stg)
static int g_nlayers = getenv("NLAYERS") ? atoi(getenv("NLAYERS")) : 2;
#else
#define EMU_CHECK(stg)
#endif
static void fill_params(Params& p, void* const* d_in, void* d_out, void* d_ws) {
  const float** f = (const float**)&p;
  for (int i = 0; i < 33; ++i) f[i] = (const float*)d_in[i];
  p.out = (float*)d_out;
  map_workspace(p, (char*)d_ws);
}
#define LAUNCH_PHASE(PH, L) LAUNCH((k_phase<PH>), grid, 256, MEGA_LDS, stream, p, L)

extern "C" void kernel_launch(void* const* d_in, const int* in_sizes, int n_in, void* d_out, int out_size, void* d_ws,
                              size_t ws_size, hipStream_t stream) {
  Params p{};
  fill_params(p, d_in, d_out, d_ws);
  if (p.ws_need > ws_size) return;
#ifdef CPU_EMU
  const int grid = 16;
  LAUNCH_PHASE(0, 0);
  for (int l = 0; l < g_nlayers; ++l) {
    LAUNCH_PHASE(1, l); LAUNCH_PHASE(2, l); LAUNCH_PHASE(3, l); LAUNCH_PHASE(4, l); LAUNCH_PHASE(5, l); LAUNCH_PHASE(6, l); LAUNCH_PHASE(7, l); LAUNCH_PHASE(8, l);
    EMU_CHECK(1);
    LAUNCH_PHASE(9, l); LAUNCH_PHASE(10, l); LAUNCH_PHASE(11, l);
    EMU_CHECK(2);
    LAUNCH_PHASE(12, l); LAUNCH_PHASE(13, l); LAUNCH_PHASE(14, l); LAUNCH_PHASE(15, l);
    EMU_CHECK(3);
  }
#else
  static int grid = 0;
  if (grid == 0) {
    int dev = 0, cus = 0, per_cu = 0;
    (void)hipGetDevice(&dev);
    (void)hipDeviceGetAttribute(&cus, hipDeviceAttributeMultiprocessorCount, dev);
#if MK_MULTI
    (void)hipFuncSetAttribute((const void*)k_phase<0>, hipFuncAttributeMaxDynamicSharedMemorySize, MEGA_LDS);
    (void)hipFuncSetAttribute((const void*)k_phase<1>, hipFuncAttributeMaxDynamicSharedMemorySize, MEGA_LDS);
    (void)hipFuncSetAttribute((const void*)k_phase<2>, hipFuncAttributeMaxDynamicSharedMemorySize, MEGA_LDS);
    (void)hipFuncSetAttribute((const void*)k_phase<3>, hipFuncAttributeMaxDynamicSharedMemorySize, MEGA_LDS);
    (void)hipFuncSetAttribute((const void*)k_phase<4>, hipFuncAttributeMaxDynamicSharedMemorySize, MEGA_LDS);
    (void)hipFuncSetAttribute((const void*)k_phase<5>, hipFuncAttributeMaxDynamicSharedMemorySize, MEGA_LDS);
    (void)hipFuncSetAttribute((const void*)k_phase<6>, hipFuncAttributeMaxDynamicSharedMemorySize, MEGA_LDS);
    (void)hipFuncSetAttribute((const void*)k_phase<7>, hipFuncAttributeMaxDynamicSharedMemorySize, MEGA_LDS);
    (void)hipFuncSetAttribute((const void*)k_phase<8>, hipFuncAttributeMaxDynamicSharedMemorySize, MEGA_LDS);
    (void)hipFuncSetAttribute((const void*)k_phase<9>, hipFuncAttributeMaxDynamicSharedMemorySize, MEGA_LDS);
    (void)hipFuncSetAttribute((const void*)k_phase<10>, hipFuncAttributeMaxDynamicSharedMemorySize, MEGA_LDS);
    (void)hipFuncSetAttribute((const void*)k_phase<11>, hipFuncAttributeMaxDynamicSharedMemorySize, MEGA_LDS);
    (void)hipFuncSetAttribute((const void*)k_phase<12>, hipFuncAttributeMaxDynamicSharedMemorySize, MEGA_LDS);
    (void)hipFuncSetAttribute((const void*)k_phase<13>, hipFuncAttributeMaxDynamicSharedMemorySize, MEGA_LDS);
    (void)hipFuncSetAttribute((const void*)k_phase<14>, hipFuncAttributeMaxDynamicSharedMemorySize, MEGA_LDS);
    (void)hipFuncSetAttribute((const void*)k_phase<15>, hipFuncAttributeMaxDynamicSharedMemorySize, MEGA_LDS);
    grid = (cus > 0 ? cus : 256) * 2;
#else
    if (hipFuncSetAttribute((const void*)k_mega, hipFuncAttributeMaxDynamicSharedMemorySize, MEGA_LDS + 256) != hipSuccess) { grid = -1; return; }
    if (hipOccupancyMaxActiveBlocksPerMultiprocessor(&per_cu, (const void*)k_mega, 256, MEGA_LDS + 256) != hipSuccess) per_cu = 0;
    (void)hipGetLastError();
    if (per_cu < 1) { grid = -1; return; }
    grid = (cus > 0 ? cus : 256) * (per_cu < 2 ? per_cu : 2);
#endif
  }
  if (grid < 0) return;
#if MK_MULTI
  LAUNCH_PHASE(0, 0);
  for (int l = 0; l < 2; ++l) {
    LAUNCH_PHASE(1, l); LAUNCH_PHASE(2, l); LAUNCH_PHASE(3, l); LAUNCH_PHASE(4, l); LAUNCH_PHASE(5, l); LAUNCH_PHASE(6, l); LAUNCH_PHASE(7, l); LAUNCH_PHASE(8, l);
    LAUNCH_PHASE(9, l); LAUNCH_PHASE(10, l); LAUNCH_PHASE(11, l); LAUNCH_PHASE(12, l); LAUNCH_PHASE(13, l); LAUNCH_PHASE(14, l); LAUNCH_PHASE(15, l);
  }
#else
  (void)hipMemsetAsync(p.bar, 0, XCD_BAR_WORDS * sizeof(unsigned), stream);
  k_mega<<<dim3(grid), dim3(256), MEGA_LDS + 256, stream>>>(p);
#endif
#endif
}
```

```cpp
#ifndef CPU_EMU
#include <hip/hip_runtime.h>
#endif
#include <stdint.h>
#include <stddef.h>

#ifndef T_LAT
#define T_LAT 16384
#endif
#ifndef T_CTX
#define T_CTX 256
#endif

#ifndef MK_MULTI
#define MK_MULTI 0
#endif
#define DI __device__ __forceinline__
typedef unsigned short bf16_t;
typedef short bf16x8 __attribute__((ext_vector_type(8)));
typedef short s16x4 __attribute__((ext_vector_type(4)));
typedef float f32x4 __attribute__((ext_vector_type(4)));
typedef float f32x16 __attribute__((ext_vector_type(16)));
typedef unsigned u32x4 __attribute__((ext_vector_type(4)));
typedef unsigned u32x2 __attribute__((ext_vector_type(2)));
typedef float f32x2 __attribute__((ext_vector_type(2)));

#ifdef CPU_EMU
static inline float u2f(unsigned u) { float f; memcpy(&f, &u, 4); return f; }
static inline unsigned f2u(float f) { unsigned u; memcpy(&u, &f, 4); return u; }
#define MFMA32(a, b, c) emu_mfma_32x32x16((a), (b), (c))
#define MFMA16(a, b, c) emu_mfma_16x16x32((a), (b), (c))
static inline float fast_exp2(float x) { return exp2f(x); }
static inline float fast_rcp(float x) { return 1.0f / x; }
static inline float fast_rsq(float x) { return 1.0f / sqrtf(x); }
static inline float hw_sin_rev(float x) { return sinf(6.283185307179586f * x); }
static inline float hw_cos_rev(float x) { return cosf(6.283185307179586f * x); }
#define LAUNCH(kern, grid, block, lds, stream, ...) emu::launch(dim3(grid), dim3(block), (size_t)(lds), [=]() { kern(__VA_ARGS__); })
#define DYN_LDS(name) char* name = emu_dynlds()
#define SCHED_BARRIER()
#define TIDX ((int)threadIdx.x)
#define WAVE_SYNC() emu::wave_barrier()
#define SETPRIO(x)
#define IGLP_OPT()
template <int M> static inline float xor_sum(float v) { return v + __shfl_xor(v, M); }
template <int M> static inline float xor_max(float v) { return fmaxf(v, __shfl_xor(v, M)); }
template <int M> static inline int xor_sum_i(int v) { return v + __shfl_xor(v, M); }
static inline int lane_bcast(int v, int src) { return __shfl(v, src); }
static inline int lane_up(int v, int d, int lane) { (void)lane; return __shfl_up(v, d); }
#else
DI float u2f(unsigned u) { return __uint_as_float(u); }
DI unsigned f2u(float f) { return __float_as_uint(f); }
#define MFMA32(a, b, c) __builtin_amdgcn_mfma_f32_32x32x16_bf16((a), (b), (c), 0, 0, 0)
#define MFMA16(a, b, c) __builtin_amdgcn_mfma_f32_16x16x32_bf16((a), (b), (c), 0, 0, 0)
DI float fast_exp2(float x) { return __builtin_amdgcn_exp2f(x); }
DI float fast_rcp(float x) { return __builtin_amdgcn_rcpf(x); }
DI float fast_rsq(float x) { return __builtin_amdgcn_rsqf(x); }
DI float hw_sin_rev(float x) { return __builtin_amdgcn_sinf(x); }
DI float hw_cos_rev(float x) { return __builtin_amdgcn_cosf(x); }
#define LAUNCH(kern, grid, block, lds, stream, ...) kern<<<dim3(grid), dim3(block), (lds), (stream)>>>(__VA_ARGS__)
#define DYN_LDS(name) extern __shared__ __attribute__((aligned(16))) char name[]
#define SCHED_BARRIER() __builtin_amdgcn_sched_barrier(0)
DI int tid_fresh() { int t = (int)threadIdx.x; asm volatile("" : "+v"(t)); return t; }
#define TIDX tid_fresh()
#define WAVE_SYNC() __builtin_amdgcn_wave_barrier()
#define SETPRIO(x) __builtin_amdgcn_s_setprio(x)
#define IGLP_OPT() __builtin_amdgcn_iglp_opt(0)
#ifdef USE_SHFL
template <int M> DI float xor_sum(float v) { return v + __shfl_xor(v, M); }
template <int M> DI float xor_max(float v) { return fmaxf(v, __shfl_xor(v, M)); }
template <int M> DI int xor_sum_i(int v) { return v + __shfl_xor(v, M); }
DI int lane_bcast(int v, int src) { return __shfl(v, src); }
DI int lane_up(int v, int d, int lane) { (void)lane; return __shfl_up(v, d); }
#else
template <int M> DI int xor_partner_bits(int bits) { return __builtin_amdgcn_ds_swizzle(bits, (M << 10) | 0x1f); }
DI void half_swap(unsigned& a, unsigned& b) { asm volatile("s_nop 1\n\tv_permlane32_swap_b32 %0, %1\n\ts_nop 1" : "+v"(a), "+v"(b)); }
template <int M> DI float xor_sum(float v) {
  if constexpr (M < 32) return v + __builtin_bit_cast(float, xor_partner_bits<M>(__builtin_bit_cast(int, v)));
  else { unsigned a = __builtin_bit_cast(unsigned, v), b = a; half_swap(a, b); return __builtin_bit_cast(float, a) + __builtin_bit_cast(float, b); }
}
template <int M> DI float xor_max(float v) {
  if constexpr (M < 32) return fmaxf(v, __builtin_bit_cast(float, xor_partner_bits<M>(__builtin_bit_cast(int, v))));
  else { unsigned a = __builtin_bit_cast(unsigned, v), b = a; half_swap(a, b); return fmaxf(__builtin_bit_cast(float, a), __builtin_bit_cast(float, b)); }
}
template <int M> DI int xor_sum_i(int v) {
  if constexpr (M < 32) return v + xor_partner_bits<M>(v);
  else { unsigned a = (unsigned)v, b = a; half_swap(a, b); return (int)(a + b); }
}
DI int lane_bcast(int v, int src) { return __builtin_amdgcn_readlane(v, src); }
DI int lane_up(int v, int d, int lane) { return __builtin_amdgcn_ds_bpermute(((lane - d) & 63) << 2, v); }
#endif
#endif

DI float bf2f(bf16_t v) { return u2f(((unsigned)v) << 16); }
#ifdef CPU_EMU
DI bf16_t f2bf(float f) { unsigned u = f2u(f); u += 0x7fffu + ((u >> 16) & 1u); return (bf16_t)(u >> 16); }
DI unsigned pack2bf(float lo, float hi) { return (unsigned)f2bf(lo) | ((unsigned)f2bf(hi) << 16); }
static inline bool wave_any(bool pr) { int v = pr ? 1 : 0; v |= __shfl_xor(v, 1); v |= __shfl_xor(v, 2); v |= __shfl_xor(v, 4); v |= __shfl_xor(v, 8); v |= __shfl_xor(v, 16); v |= __shfl_xor(v, 32); return v != 0; }
#else
typedef float f32x2_ __attribute__((ext_vector_type(2)));
typedef __bf16 bf16x2_hw __attribute__((ext_vector_type(2)));
DI unsigned pack2bf(float lo, float hi) { const f32x2_ v = {lo, hi}; return __builtin_bit_cast(unsigned, __builtin_convertvector(v, bf16x2_hw)); }
DI bf16_t f2bf(float f) { return (bf16_t)(pack2bf(f, f) & 0xffffu); }
DI bool wave_any(bool pr) { return __builtin_amdgcn_ballot_w64(pr) != 0ull; }
#endif
DI float sigmoidf_(float x) { return 1.0f / (1.0f + expf(-x)); }
DI float siluf_(float x) { return x / (1.0f + expf(-x)); }
DI float logsigmoidf_(float x) { return fminf(x, 0.0f) - log1pf(expf(-fabsf(x))); }

constexpr int D = 1024, NB = 2, TL = T_LAT, TC = T_CTX, TK = TL + TC;
constexpr int RL = NB * TL, RC = NB * TC, R = RL + RC;
constexpr int NZ = 3024, NZP = 3072;
constexpr int ZC_QLAT = 0, ZC_KVLAT = 256, ZC_KROPE = 384, ZC_MLQK = 416, ZC_MLV = 928, ZC_MLO = 1184, ZC_MLIG = 1440,
              ZC_MLFG = 1448, ZC_GQ = 1456, ZC_GK = 1584, ZC_GV = 1712, ZC_GR = 1968, ZC_GA = 2224, ZC_DQ = 2256,
              ZC_DK = 2512, ZC_DV = 2768;
constexpr int NCK = TK / 64, NCC = TC / 64, NCL = TL / 64;
constexpr int NE = 16, FF = 1408, CAPL = 2 * TL / 16, CAPC = 2 * TC / 16, CAPT = CAPL + CAPC, NSLOT = NB * CAPT;
constexpr size_t WSZ_IN = (size_t)NZP * D, WSZ_UQ = 384 * 256, WSZ_UKV = 512 * 128, WSZ_GATE = (size_t)4096 * D, WSZ_BR = (size_t)4 * D * 256, WSZ_OUT = (size_t)D * D;
constexpr int NUNIT = NB * 2 * NCK * 4;
constexpr float LOG2E = 1.4426950408889634f;
constexpr float QS_MLA = 0.10206207261596577f * LOG2E;
constexpr float QS_DIFF = 0.17677669529663687f * LOG2E;

DI int row_of(int b, int s) { return s < TC ? RL + b * TC + s : b * TL + (s - TC); }
DI void bs_of(int r, int& b, int& s) { if (r < RL) { b = r / TL; s = TC + (r % TL); } else { int q = r - RL; b = q / TC; s = q % TC; } }
DI int seq_of(int d, int p) { return d == 0 ? p : (p < TC ? TC - 1 - p : TK - 1 - (p - TC)); }
DI int step_of(int d, int c) { return d == 0 ? c : (c < NCC ? NCC - 1 - c : NCC + (NCK - 1 - c)); }

struct Params {
  const float *x, *c, *ctx, *c_ctx, *w_ada, *b_ada, *g_mix_pre, *g_mix_post, *g_ffn_pre, *g_ffn_post, *w_in, *g_q_lat, *w_uq,
      *g_kv_lat, *w_ukv, *w_conv, *b_conv, *b_igate, *b_fgate, *g_mlstm_out, *w_alpha2, *b_alpha, *g_gla_out, *diff_lambda,
      *g_diff_out, *w_branch, *w_gate, *b_gate, *w_out, *w_router, *w_e_gate, *w_e_up, *w_e_down;
  float* out;
  float *mods, *xc;
  bf16_t *H, *Z, *Qm, *Km, *Vtm, *Qd, *Kd, *Vtd, *MQ, *MK, *Y, *MG, *YO, *HID, *YE, *MVt, *GVt;
  float *BC, *IGS, *GC, *MC, *MN, *MM, *GS, *HD, *OD, *AFF, *SELV;
  int *SEL, *INV;
  bf16_t *Wt_in, *Wt_uq, *Wt_ukv, *Wt_gate, *Wt_branch, *Wt_out, *Wt_eg, *Wt_eu, *Wt_ed;
  unsigned* bar;
  size_t ws_need;
};

static inline size_t al256(size_t x) { return (x + 255) & ~(size_t)255; }
static inline void map_workspace(Params& p, char* ws) {
  size_t o = 0;
  auto take = [&](size_t bytes) { size_t r = o; o += al256(bytes); return ws + r; };
  p.bar = (unsigned*)take(16384);
  p.mods = (float*)take((size_t)2 * 3 * 6144 * 4);
  p.xc = (float*)take((size_t)RC * D * 4);
  p.BC = (float*)take((size_t)NB * 2 * TK * 4 * 4);
  p.IGS = (float*)take((size_t)NB * 2 * TK * 4 * 4);
  p.AFF = (float*)take((size_t)NB * NE * TK * 4);
  p.SEL = (int*)take((size_t)NE * NSLOT * 4);
  p.SELV = (float*)take((size_t)NE * NSLOT * 4);
  p.INV = (int*)take((size_t)R * NE * 4);
  p.MM = (float*)take((size_t)NUNIT * 4 * 4);
  p.MN = (float*)take((size_t)NUNIT * 64 * 4);
  p.Wt_in = (bf16_t*)take((size_t)2 * WSZ_IN * 2);
  p.Wt_uq = (bf16_t*)take((size_t)2 * WSZ_UQ * 2);
  p.Wt_ukv = (bf16_t*)take((size_t)2 * WSZ_UKV * 2);
  p.Wt_gate = (bf16_t*)take((size_t)2 * WSZ_GATE * 2);
  p.Wt_branch = (bf16_t*)take((size_t)2 * WSZ_BR * 2);
  p.Wt_out = (bf16_t*)take((size_t)2 * WSZ_OUT * 2);
  p.H = (bf16_t*)take((size_t)R * D * 2);
  size_t szA = (size_t)R * NZP * 2, szHID = (size_t)NE * NSLOT * FF * 2;
  char* A = take(szA > szHID ? szA : szHID);
  p.Z = (bf16_t*)A; p.HID = (bf16_t*)A;
  size_t szQm = al256((size_t)NB * 4 * TK * 96 * 2), szVt = al256((size_t)NB * 4 * 64 * TK * 2), szQd = al256((size_t)NB * 8 * TK * 32 * 2);
  size_t szB1 = 2 * szQm + 2 * szVt + 2 * szQd;
  size_t szHD = al256((size_t)2 * NB * TK * 256 * 4);
  size_t szYE = (size_t)NE * NSLOT * D * 2;
  size_t szB = szB1; if (2 * szHD > szB) szB = 2 * szHD; if (szYE > szB) szB = szYE;
  char* Bq = take(szB);
  p.Qm = (bf16_t*)Bq; p.Km = (bf16_t*)(Bq + szQm); p.Vtm = (bf16_t*)(Bq + 2 * szQm);
  p.Qd = (bf16_t*)(Bq + 2 * szQm + szVt); p.Kd = (bf16_t*)(Bq + 2 * szQm + szVt + szQd); p.Vtd = (bf16_t*)(Bq + 2 * szQm + szVt + 2 * szQd);
  p.YE = (bf16_t*)Bq;
  p.GC = (float*)take((size_t)NB * 2 * TK * 128 * 4);
  p.MVt = (bf16_t*)take((size_t)NB * 4 * 64 * TK * 2);
  p.GVt = (bf16_t*)take((size_t)NB * 4 * 64 * TK * 2);
  size_t szW = (size_t)NE * FF * D * 2;
  size_t szMC = (size_t)NUNIT * 4096 * 4, szRD = (size_t)R * D * 2;
  size_t szC = szMC; if (szRD > szC) szC = szRD; if (szW > szC) szC = szW;
  char* C = take(szC);
  p.MC = (float*)C; p.MG = (bf16_t*)C; p.Wt_eg = (bf16_t*)C;
  size_t szMQ = al256((size_t)NB * TK * 256 * 2), szGS = (size_t)NUNIT * 2048 * 4;
  size_t szD = 2 * szMQ + szGS; if (szW > szD) szD = szW;
  char* Dq = take(szD);
  p.MQ = (bf16_t*)Dq; p.MK = (bf16_t*)(Dq + szMQ); p.GS = (float*)(Dq + 2 * szMQ); p.Wt_eu = (bf16_t*)Dq;
  size_t szF = 2 * szRD > szW ? 2 * szRD : szW;
  char* F = take(szF);
  p.Y = (bf16_t*)F; p.YO = (bf16_t*)(F + szRD); p.Wt_ed = (bf16_t*)F;
  p.HD = (float*)Bq; p.OD = (float*)(Bq + szHD);
  p.ws_need = o;
}
#define GTID ((long)blockIdx.x * blockDim.x + threadIdx.x)

DI float lam_of(const Params& p, int layer, float& lam_init) {
  const float* lv = p.diff_lambda + layer * 128;
  float s1 = 0.f, s2 = 0.f;
  for (int i = 0; i < 32; ++i) { s1 += lv[i] * lv[32 + i]; s2 += lv[64 + i] * lv[96 + i]; }
  lam_init = layer == 0 ? 0.2f : 0.35550906759096f;
  return expf(s1) - expf(s2) + lam_init;
}
DI void rope_cs(int s, int jj, float& cs, float& sn) {
  int t = s - TC;
  int pos = (jj < 16) ? (t / 64) : (t % 64);
  float ang = (float)pos * exp2f(-1.6609640474436813f * (float)(jj & 7));
  double rev = (double)ang * 0.15915494309189535;
  rev -= floor(rev + 0.5);
  float rf = (float)rev;
  cs = hw_cos_rev(rf); sn = hw_sin_rev(rf);
}
template <class G> DI float rope_elem(G get, int s, int jj) {
  if (s < TC) return get(jj);
  float cs, sn; rope_cs(s, jj, cs, sn);
  float a = get(jj), b = get(jj ^ 8);
  return (jj & 8) ? (a * cs + b * sn) : (a * cs - b * sn);
}

DI void nvb_mods(long GI, const Params& p) {
  long i = GI; if (i >= 2 * 3 * 6144) return;
  int col = (int)(i % 6144), w = (int)((i / 6144) % 3), l = (int)(i / (3 * 6144));
  const float* cv = w < 2 ? p.c + w * 1024 : p.c_ctx;
  const float* W = p.w_ada + (size_t)l * 1024 * 6144;
  float acc = 0.f;
  for (int k = 0; k < 1024; ++k) acc += siluf_(cv[k]) * W[(size_t)k * 6144 + col];
  p.mods[i] = acc + p.b_ada[l * 6144 + col];
}
__global__ void __launch_bounds__(256) nv_wt(const float* in, bf16_t* out, int K, int N, int NP, long in_bs, long out_bs, const float* gain) {
  long i = GTID; if (i >= (long)NP * K) return;
  int k = (int)(i % K), n = (int)(i / K);
  const float* I = in + (size_t)blockIdx.y * in_bs; bf16_t* O = out + (size_t)blockIdx.y * out_bs;
  O[(size_t)n * K + k] = n < N ? f2bf(I[(size_t)k * N + n] * (gain ? gain[k] : 1.0f)) : (bf16_t)0;
}
__global__ void __launch_bounds__(256) nv_modulate(Params p, int layer, int which, const float* xl, const float* xcx, int nrows) {
  long r = GTID; if (r >= nrows) return;
  int w = r < RL ? (int)(r / TL) : 2;
  const float* mb = p.mods + (size_t)(layer * 3 + w) * 6144;
  const float* shift = mb + (which ? 3 : 0) * 1024; const float* scale = mb + (which ? 4 : 1) * 1024;
  const float* g = (which ? p.g_ffn_pre : p.g_mix_pre) + layer * 1024;
  const float* x = r < RL ? xl + (size_t)r * D : xcx + (size_t)(r - RL) * D;
  float ss = 0.f; for (int k = 0; k < D; ++k) ss += x[k] * x[k];
  float rstd = 1.0f / sqrtf(ss / D + 1e-6f);
  for (int k = 0; k < D; ++k) p.H[(size_t)r * D + k] = f2bf(x[k] * rstd * g[k] * (1.f + scale[k]) + shift[k]);
}
__global__ void __launch_bounds__(256) nv_gemm(const bf16_t* A, int lda, const bf16_t* Bt, int ldb, int M, int N, int K, bf16_t* C, int ldc) {
  long i = GTID; if (i >= (long)M * N) return;
  int n = (int)(i % N), m = (int)(i / N);
  const bf16_t* a = A + (size_t)m * lda; const bf16_t* b = Bt + (size_t)n * ldb;
  float acc = 0.f;
  for (int k = 0; k < K; ++k) acc += bf2f(a[k]) * bf2f(b[k]);
  C[(size_t)m * ldc + n] = f2bf(acc);
}
__global__ void __launch_bounds__(256) nv_mla_q(Params p, int layer) {
  long i = GTID; if (i >= (long)R * 4 * 96) return;
  int j = (int)(i % 96), h = (int)((i / 96) % 4), r = (int)(i / 384);
  int b, s; bs_of(r, b, s);
  const bf16_t* z = p.Z + (size_t)r * NZP + ZC_QLAT;
  const float* g = p.g_q_lat + layer * 256; const float* W = p.w_uq + (size_t)layer * 256 * 384;
  float ss = 0.f; for (int k = 0; k < 256; ++k) { float v = bf2f(z[k]); ss += v * v; }
  float rstd = 1.0f / sqrtf(ss / 256 + 1e-6f);
  auto dot = [&](int col) { float a = 0.f; for (int k = 0; k < 256; ++k) a += bf2f(z[k]) * rstd * g[k] * W[(size_t)k * 384 + col]; return a; };
  float v;
  if (j < 64) v = dot(h * 96 + j);
  else v = rope_elem([&](int jj) { return dot(h * 96 + 64 + jj); }, s, j - 64);
  p.Qm[(((size_t)b * 4 + h) * TK + s) * 96 + j] = f2bf(v * QS_MLA);
}
__global__ void __launch_bounds__(256) nv_mla_kv(Params p, int layer) {
  long i = GTID; if (i >= (long)R * 4 * 160) return;
  int j = (int)(i % 160), h = (int)((i / 160) % 4), r = (int)(i / 640);
  int b, s; bs_of(r, b, s);
  const bf16_t* z = p.Z + (size_t)r * NZP;
  if (j < 128) {
    const bf16_t* zl = z + ZC_KVLAT; const float* g = p.g_kv_lat + layer * 128; const float* W = p.w_ukv + (size_t)layer * 128 * 512;
    float ss = 0.f; for (int k = 0; k < 128; ++k) { float v = bf2f(zl[k]); ss += v * v; }
    float rstd = 1.0f / sqrtf(ss / 128 + 1e-6f);
    float a = 0.f; for (int k = 0; k < 128; ++k) a += bf2f(zl[k]) * rstd * g[k] * W[(size_t)k * 512 + h * 128 + j];
    if (j < 64) p.Km[(((size_t)b * 4 + h) * TK + s) * 96 + j] = f2bf(a);
    else p.Vtm[(((size_t)b * 4 + h) * 64 + (j - 64)) * TK + s] = f2bf(a);
  } else {
    int jj = j - 128;
    float v = rope_elem([&](int q) { return bf2f(z[ZC_KROPE + q]); }, s, jj);
    p.Km[(((size_t)b * 4 + h) * TK + s) * 96 + 64 + jj] = f2bf(v);
  }
}
__global__ void __launch_bounds__(256) nv_diff_prep(Params p) {
  long i = GTID; if (i >= (long)R * 768) return;
  int c = (int)(i % 768), r = (int)(i / 768);
  int b, s; bs_of(r, b, s);
  const bf16_t* z = p.Z + (size_t)r * NZP;
  if (c < 512) {
    int qk = c / 256, cc = c % 256, hm = cc / 32, jj = cc % 32;
    const bf16_t* src = z + (qk ? ZC_DK : ZC_DQ) + hm * 32;
    float v = rope_elem([&](int q) { return bf2f(src[q]); }, s, jj);
    if (qk == 0) p.Qd[(((size_t)b * 8 + hm) * TK + s) * 32 + jj] = f2bf(v * QS_DIFF);
    else p.Kd[(((size_t)b * 8 + hm) * TK + s) * 32 + jj] = f2bf(v);
  } else {
    int cc = c - 512, h = cc / 64, dv = cc % 64;
    p.Vtd[(((size_t)b * 4 + h) * 64 + dv) * TK + s] = z[ZC_DV + cc];
  }
}
__global__ void __launch_bounds__(256) nv_ml_prep(Params p, int layer) {
  long i = GTID; if (i >= (long)R * 512) return;
  int ch = (int)(i % 512), r = (int)(i / 512);
  int b, s; bs_of(r, b, s);
  bool first = (s == 0) || (s == TC), last = (s == TC - 1) || (s == TK - 1);
  const float* w = p.w_conv + (size_t)layer * 3 * 512;
  float acc = p.b_conv[layer * 512 + ch];
  acc += bf2f(p.Z[(size_t)r * NZP + ZC_MLQK + ch]) * w[512 + ch];
  if (!first) acc += bf2f(p.Z[(size_t)row_of(b, s - 1) * NZP + ZC_MLQK + ch]) * w[ch];
  if (!last) acc += bf2f(p.Z[(size_t)row_of(b, s + 1) * NZP + ZC_MLQK + ch]) * w[1024 + ch];
  float v = siluf_(acc);
  if (ch < 256) p.MQ[((size_t)b * TK + s) * 256 + ch] = f2bf(v);
  else p.MK[((size_t)b * TK + s) * 256 + ch - 256] = f2bf(v * 0.125f);
}
DI void nvb_ml_gates(long GI, const Params& p, int layer) {
  long i = GI; if (i >= (long)NB * 2 * NCK * 4) return;
  int h = (int)(i % 4), j = (int)((i / 4) % NCK), d = (int)((i / (4 * NCK)) % 2), b = (int)(i / (8 * NCK));
  float bi = p.b_igate[layer * 8 + d * 4 + h], bfg = p.b_fgate[layer * 8 + d * 4 + h];
  float cum = 0.f;
  for (int l = 0; l < 64; ++l) {
    int pp = 64 * j + l, s = seq_of(d, pp); const bf16_t* z = p.Z + (size_t)row_of(b, s) * NZP;
    float ig = bf2f(z[ZC_MLIG + d * 4 + h]) + bi;
    float lf = logsigmoidf_(bf2f(z[ZC_MLFG + d * 4 + h]) + bfg);
    cum += lf;
    size_t o = (((size_t)b * 2 + d) * TK + pp) * 4 + h;
    p.BC[o] = cum; p.IGS[o] = ig;
  }
}
DI void nvb_gla_cum(long GI, const Params& p, int layer) {
  long i = GI; if (i >= (long)NB * 2 * NCK * 128) return;
  int ch = (int)(i % 128), j = (int)((i / 128) % NCK), d = (int)((i / (128 * NCK)) % 2), b = (int)(i / (256 * NCK));
  const float* W = p.w_alpha2 + (size_t)layer * 2 * 16 * 128 + (size_t)d * 16 * 128;
  float ba = p.b_alpha[layer * 256 + d * 128 + ch];
  float cum = 0.f;
  for (int l = 0; l < 64; ++l) {
    int pp = 64 * j + l, s = seq_of(d, pp); const bf16_t* z = p.Z + (size_t)row_of(b, s) * NZP + ZC_GA + d * 16;
    float zg = ba; for (int q = 0; q < 16; ++q) zg += bf2f(z[q]) * W[q * 128 + ch];
    cum += logsigmoidf_(zg) * (1.0f / 16.0f);
    p.GC[(((size_t)b * 2 + d) * TK + pp) * 128 + ch] = cum;
  }
}
__global__ void __launch_bounds__(256) nv_attn_mla(Params p, int need_ctx) {
  long i = GTID; if (i >= (long)NB * 4 * TK) return;
  int s = (int)(i % TK), h = (int)((i / TK) % 4), b = (int)(i / (4 * TK));
  if (s < TC && !need_ctx) return;
  int nk = s < TC ? TC : TK;
  const bf16_t* q = p.Qm + (((size_t)b * 4 + h) * TK + s) * 96;
  const bf16_t* K = p.Km + ((size_t)b * 4 + h) * TK * 96;
  const bf16_t* Vt = p.Vtm + ((size_t)b * 4 + h) * 64 * TK;
  float qf[96], o[64];
  _Pragma("unroll") for (int k = 0; k < 96; ++k) qf[k] = bf2f(q[k]);
  _Pragma("unroll") for (int k = 0; k < 64; ++k) o[k] = 0.f;
  float m = -1e30f, l = 0.f;
  for (int t = 0; t < nk; ++t) {
    float sc = 0.f; _Pragma("unroll") for (int k = 0; k < 96; ++k) sc += qf[k] * bf2f(K[(size_t)t * 96 + k]);
    float mn = fmaxf(m, sc), a = exp2f(m - mn), pr = exp2f(sc - mn);
    l = l * a + pr;
    _Pragma("unroll") for (int k = 0; k < 64; ++k) o[k] = o[k] * a + pr * bf2f(Vt[(size_t)k * TK + t]);
    m = mn;
  }
  int r = row_of(b, s);
  _Pragma("unroll") for (int k = 0; k < 64; ++k) p.Y[(size_t)r * D + h * 64 + k] = f2bf(o[k] / l);
}
__global__ void __launch_bounds__(256) nv_attn_diff(Params p, int layer, int need_ctx) {
  long i = GTID; if (i >= (long)NB * 4 * TK) return;
  int s = (int)(i % TK), h = (int)((i / TK) % 4), b = (int)(i / (4 * TK));
  if (s < TC && !need_ctx) return;
  int nk = s < TC ? TC : TK;
  float lam_init; float lam = lam_of(p, layer, lam_init);
  const bf16_t* Vt = p.Vtd + ((size_t)b * 4 + h) * 64 * TK;
  float res[64];
  _Pragma("unroll") for (int k = 0; k < 64; ++k) res[k] = 0.f;
  _Pragma("unroll") for (int mp = 0; mp < 2; ++mp) {
    const bf16_t* q = p.Qd + (((size_t)b * 8 + h * 2 + mp) * TK + s) * 32;
    const bf16_t* K = p.Kd + ((size_t)b * 8 + h * 2 + mp) * TK * 32;
    float qf[32], o[64];
    _Pragma("unroll") for (int k = 0; k < 32; ++k) qf[k] = bf2f(q[k]);
    _Pragma("unroll") for (int k = 0; k < 64; ++k) o[k] = 0.f;
    float m = -1e30f, l = 0.f;
    for (int t = 0; t < nk; ++t) {
      float sc = 0.f; _Pragma("unroll") for (int k = 0; k < 32; ++k) sc += qf[k] * bf2f(K[(size_t)t * 32 + k]);
      float mn = fmaxf(m, sc), a = exp2f(m - mn), pr = exp2f(sc - mn);
      l = l * a + pr;
      _Pragma("unroll") for (int k = 0; k < 64; ++k) o[k] = o[k] * a + pr * bf2f(Vt[(size_t)k * TK + t]);
      m = mn;
    }
    float wgt = mp == 0 ? 1.f : -lam;
    _Pragma("unroll") for (int k = 0; k < 64; ++k) res[k] += wgt * o[k] / l;
  }
  float ss = 0.f; _Pragma("unroll") for (int k = 0; k < 64; ++k) ss += res[k] * res[k];
  float rstd = 1.0f / sqrtf(ss / 64 + 1e-6f);
  int r = row_of(b, s);
  _Pragma("unroll") for (int k = 0; k < 64; ++k) p.Y[(size_t)r * D + 768 + h * 64 + k] = f2bf(res[k] * rstd * p.g_diff_out[layer * 256 + h * 64 + k] * (1.f - lam_init));
}
DI void nvb_ml_local(long GI, const Params& p) {
  long i = GI; if (i >= (long)NUNIT * 4160) return;
  int e = (int)(i % 4160); long u = i / 4160;
  int h = (int)(u % 4), j = (int)((u / 4) % NCK), d = (int)((u / (4 * NCK)) % 2), b = (int)(u / (8 * NCK));
  const float* bc = p.BC + (((size_t)b * 2 + d) * TK + 64 * j) * 4 + h; const float* ig = p.IGS + (((size_t)b * 2 + d) * TK + 64 * j) * 4 + h;
  float bend = bc[63 * 4], ml = -1e30f;
  for (int l = 0; l < 64; ++l) ml = fmaxf(ml, bend - bc[l * 4] + ig[l * 4]);
  if (e == 4096 + 0) { p.MM[u * 4 + 0] = ml; p.MM[u * 4 + 1] = bend; }
  float acc = 0.f;
  if (e < 4096) {
    int v = e / 64, k = e % 64;
    for (int l = 0; l < 64; ++l) {
      int s = seq_of(d, 64 * j + l); float w = expf(bend - bc[l * 4] + ig[l * 4] - ml);
      acc += w * bf2f(p.Z[(size_t)row_of(b, s) * NZP + ZC_MLV + h * 64 + v]) * bf2f(p.MK[((size_t)b * TK + s) * 256 + h * 64 + k]);
    }
    p.MC[(size_t)u * 4096 + e] = acc;
  } else {
    int k = e - 4096;
    for (int l = 0; l < 64; ++l) {
      int s = seq_of(d, 64 * j + l); float w = expf(bend - bc[l * 4] + ig[l * 4] - ml);
      acc += w * bf2f(p.MK[((size_t)b * TK + s) * 256 + h * 64 + k]);
    }
    p.MN[(size_t)u * 64 + k] = acc;
  }
}
DI void nvb_ml_scan(long GI, const Params& p) {
  long i = GI; if (i >= (long)NB * 2 * 4 * 4160) return;
  int e = (int)(i % 4160); int ch = (int)(i / 4160); int h = ch % 4, bd = ch / 4;
  float st = 0.f, m = -1e30f;
  for (int j = 0; j < NCK; ++j) {
    size_t u = ((size_t)bd * NCK + j) * 4 + h;
    float ml = p.MM[u * 4 + 0], be = p.MM[u * 4 + 1];
    float mn = fmaxf(be + m, ml), a = expf(be + m - mn), g = expf(ml - mn);
    float* slot = e < 4096 ? &p.MC[u * 4096 + e] : &p.MN[u * 64 + (e - 4096)];
    float loc = *slot; *slot = st; st = a * st + g * loc;
    if (e == 0) p.MM[u * 4 + 2] = m;
    m = mn;
  }
}
DI void nvb_ml_out(long GI, const Params& p, int need_ctx) {
  long i = GI; if (i >= (long)NUNIT * 4096) return;
  int v = (int)(i % 64), l = (int)((i / 64) % 64); long u = i / 4096;
  int h = (int)(u % 4), j = (int)((u / 4) % NCK), d = (int)((u / (4 * NCK)) % 2), b = (int)(u / (8 * NCK));
  if (j < NCC && !need_ctx) return;
  const float* bc = p.BC + (((size_t)b * 2 + d) * TK + 64 * j) * 4 + h; const float* ig = p.IGS + (((size_t)b * 2 + d) * TK + 64 * j) * 4 + h;
  float m0 = p.MM[u * 4 + 2];
  int sl = seq_of(d, 64 * j + l);
  const bf16_t* q = p.MQ + ((size_t)b * TK + sl) * 256 + h * 64;
  float bl = bc[l * 4];
  float inter = bl + m0, mt = inter;
  for (int t = 0; t <= l; ++t) mt = fmaxf(mt, bl - bc[t * 4] + ig[t * 4]);
  float num = 0.f, den = 0.f;
  for (int t = 0; t <= l; ++t) {
    int st = seq_of(d, 64 * j + t);
    const bf16_t* k = p.MK + ((size_t)b * TK + st) * 256 + h * 64;
    float qk = 0.f; for (int c = 0; c < 64; ++c) qk += bf2f(q[c]) * bf2f(k[c]);
    float sv = expf(bl - bc[t * 4] + ig[t * 4] - mt) * qk;
    num += sv * bf2f(p.Z[(size_t)row_of(b, st) * NZP + ZC_MLV + h * 64 + v]); den += sv;
  }
  float ai = expf(inter - mt);
  float qc = 0.f, qn = 0.f;
  for (int c = 0; c < 64; ++c) { qc += bf2f(q[c]) * p.MC[(size_t)u * 4096 + v * 64 + c]; qn += bf2f(q[c]) * p.MN[(size_t)u * 64 + c]; }
  num += ai * qc; den += ai * qn;
  p.HD[(((size_t)d * NB + b) * TK + sl) * 256 + h * 64 + v] = num / fmaxf(fabsf(den), expf(-mt));
}
DI void nvb_ml_finish(long GI, const Params& p, int layer, int need_ctx) {
  long i = GI; if (i >= (long)R * 4) return;
  int h = (int)(i % 4), r = (int)(i / 4); int b, s; bs_of(r, b, s);
  if (s < TC && !need_ctx) return;
  const float* h0 = p.HD + (((size_t)0 * NB + b) * TK + s) * 256 + h * 64; const float* h1 = p.HD + (((size_t)1 * NB + b) * TK + s) * 256 + h * 64;
  float ss = 0.f; for (int v = 0; v < 64; ++v) { float t = h0[v] + h1[v]; ss += t * t; }
  float rstd = 1.0f / sqrtf(ss / 64 + 1e-6f);
  for (int v = 0; v < 64; ++v) {
    float o = bf2f(p.Z[(size_t)r * NZP + ZC_MLO + h * 64 + v]);
    p.Y[(size_t)r * D + 256 + h * 64 + v] = f2bf(sigmoidf_(o) * (h0[v] + h1[v]) * rstd * p.g_mlstm_out[layer * 256 + h * 64 + v]);
  }
}
DI void nvb_gla_local(long GI, const Params& p) {
  long i = GI; if (i >= (long)NUNIT * 2048) return;
  int v = (int)(i % 64), k = (int)((i / 64) % 32); long u = i / 2048;
  int h = (int)(u % 4), j = (int)((u / 4) % NCK), d = (int)((u / (4 * NCK)) % 2), b = (int)(u / (8 * NCK));
  const float* gc = p.GC + (((size_t)b * 2 + d) * TK + 64 * j) * 128 + h * 32 + k;
  float ge = gc[63 * 128], acc = 0.f;
  for (int l = 0; l < 64; ++l) {
    int s = seq_of(d, 64 * j + l); const bf16_t* z = p.Z + (size_t)row_of(b, s) * NZP;
    acc += bf2f(z[ZC_GK + h * 32 + k]) * expf(ge - gc[l * 128]) * bf2f(z[ZC_GV + h * 64 + v]);
  }
  p.GS[(size_t)u * 2048 + v * 32 + k] = acc;
}
DI void nvb_gla_scan(long GI, const Params& p) {
  long i = GI; if (i >= (long)NB * 2 * 4 * 2048) return;
  int e = (int)(i % 2048); int ch = (int)(i / 2048); int h = ch % 4, bd = ch / 4; int k = e % 32;
  float st = 0.f;
  for (int j = 0; j < NCK; ++j) {
    size_t u = ((size_t)bd * NCK + j) * 4 + h;
    float ge = p.GC[((size_t)bd * TK + 64 * j + 63) * 128 + h * 32 + k];
    float loc = p.GS[u * 2048 + e]; p.GS[u * 2048 + e] = st; st = expf(ge) * st + loc;
  }
}
DI void nvb_gla_out(long GI, const Params& p, int need_ctx) {
  long i = GI; if (i >= (long)NUNIT * 4096) return;
  int v = (int)(i % 64), l = (int)((i / 64) % 64); long u = i / 4096;
  int h = (int)(u % 4), j = (int)((u / 4) % NCK), d = (int)((u / (4 * NCK)) % 2), b = (int)(u / (8 * NCK));
  if (j < NCC && !need_ctx) return;
  const float* gc = p.GC + (((size_t)b * 2 + d) * TK + 64 * j) * 128 + h * 32;
  int sl = seq_of(d, 64 * j + l);
  const bf16_t* q = p.Z + (size_t)row_of(b, sl) * NZP + ZC_GQ + h * 32;
  const float qs = 0.17677669529663687f;
  float acc = 0.f;
  for (int t = 0; t <= l; ++t) {
    int st = seq_of(d, 64 * j + t); const bf16_t* z = p.Z + (size_t)row_of(b, st) * NZP;
    float att = 0.f; for (int k = 0; k < 32; ++k) att += bf2f(q[k]) * qs * expf(gc[l * 128 + k] - gc[t * 128 + k]) * bf2f(z[ZC_GK + h * 32 + k]);
    acc += att * bf2f(z[ZC_GV + h * 64 + v]);
  }
  for (int k = 0; k < 32; ++k) acc += bf2f(q[k]) * qs * expf(gc[l * 128 + k]) * p.GS[(size_t)u * 2048 + v * 32 + k];
  p.OD[(((size_t)d * NB + b) * TK + sl) * 256 + h * 64 + v] = acc;
}
DI void nvb_gla_finish(long GI, const Params& p, int layer, int need_ctx) {
  long i = GI; if (i >= (long)R * 4) return;
  int h = (int)(i % 4), r = (int)(i / 4); int b, s; bs_of(r, b, s);
  if (s < TC && !need_ctx) return;
  const float* h0 = p.OD + (((size_t)0 * NB + b) * TK + s) * 256 + h * 64; const float* h1 = p.OD + (((size_t)1 * NB + b) * TK + s) * 256 + h * 64;
  float ss = 0.f; for (int v = 0; v < 64; ++v) { float t = h0[v] + h1[v]; ss += t * t; }
  float rstd = 1.0f / sqrtf(ss / 64 + 1e-6f);
  for (int v = 0; v < 64; ++v) {
    float rr = bf2f(p.Z[(size_t)r * NZP + ZC_GR + h * 64 + v]);
    p.Y[(size_t)r * D + 512 + h * 64 + v] = f2bf(siluf_(rr) * (h0[v] + h1[v]) * rstd * p.g_gla_out[layer * 256 + h * 64 + v]);
  }
}
__global__ void __launch_bounds__(256) nv_merge(Params p, int layer, int nrows) {
  long i = GTID; if (i >= (long)nrows * D) return;
  int j = (int)(i % D), r = (int)(i / D);
  float acc = 0.f;
  for (int n = 0; n < 4; ++n) {
    const bf16_t* wg = p.Wt_gate + (size_t)(n * 1024 + j) * D; const bf16_t* wb = p.Wt_branch + ((size_t)n * D + j) * 256;
    float g = p.b_gate[layer * 4096 + n * 1024 + j], pr = 0.f;
    for (int k = 0; k < D; ++k) g += bf2f(p.H[(size_t)r * D + k]) * bf2f(wg[k]);
    for (int k = 0; k < 256; ++k) pr += bf2f(p.Y[(size_t)r * D + n * 256 + k]) * bf2f(wb[k]);
    acc += sigmoidf_(g) * pr;
  }
  p.MG[(size_t)r * D + j] = f2bf(acc);
}
__global__ void __launch_bounds__(256) nv_resid_mix(Params p, int layer, const float* xl_in, const float* xc_in, int nrows) {
  long r = GTID; if (r >= nrows) return;
  int w = r < RL ? (int)(r / TL) : 2;
  const float* mb = p.mods + (size_t)(layer * 3 + w) * 6144;
  const float* xin = r < RL ? xl_in + (size_t)r * D : xc_in + (size_t)(r - RL) * D;
  float* xo = r < RL ? p.out + (size_t)r * D : p.xc + (size_t)(r - RL) * D;
  const bf16_t* yo = p.YO + (size_t)r * D;
  float ss = 0.f; for (int k = 0; k < D; ++k) { float v = bf2f(yo[k]); ss += v * v; }
  float rstd = 1.0f / sqrtf(ss / D + 1e-6f);
  float s2 = 0.f;
  for (int k = 0; k < D; ++k) { float xn = xin[k] + mb[2 * 1024 + k] * bf2f(yo[k]) * rstd * p.g_mix_post[layer * 1024 + k]; xo[k] = xn; s2 += xn * xn; }
  float rstd2 = 1.0f / sqrtf(s2 / D + 1e-6f);
  float lg[16]; _Pragma("unroll") for (int e = 0; e < 16; ++e) lg[e] = 0.f;
  const float* wr = p.w_router + (size_t)layer * D * 16;
  for (int k = 0; k < D; ++k) {
    float h2 = xo[k] * rstd2 * p.g_ffn_pre[layer * 1024 + k] * (1.f + mb[4 * 1024 + k]) + mb[3 * 1024 + k];
    p.H[(size_t)r * D + k] = f2bf(h2);
    _Pragma("unroll") for (int e = 0; e < 16; ++e) lg[e] += h2 * wr[k * 16 + e];
  }
  float mx = lg[0]; _Pragma("unroll") for (int e = 1; e < 16; ++e) mx = fmaxf(mx, lg[e]);
  float sm = 0.f; _Pragma("unroll") for (int e = 0; e < 16; ++e) { lg[e] = expf(lg[e] - mx); sm += lg[e]; }
  int b, s; bs_of((int)r, b, s);
  _Pragma("unroll") for (int e = 0; e < 16; ++e) p.AFF[((size_t)b * NE + e) * TK + s] = lg[e] / sm;
}
__global__ void __launch_bounds__(256) nv_topk(Params p, int need_ctx) {
  long i = GTID; if (i >= NB * NE * 2) return;
  int seg = (int)(i % 2), e = (int)((i / 2) % NE), b = (int)(i / (2 * NE));
  int s0 = seg ? TC : 0, n = seg ? TL : TC, cap = seg ? CAPL : CAPC, slot0 = seg ? b * CAPL : NB * CAPL + b * CAPC;
  if (seg == 0 && !need_ctx) { for (int q = 0; q < cap; ++q) p.SEL[(size_t)e * NSLOT + slot0 + q] = -1; return; }
  const float* a = p.AFF + ((size_t)b * NE + e) * TK + s0;
  unsigned thr = 0;
  for (int bit = 31; bit >= 0; --bit) {
    unsigned cand = thr | (1u << bit); int cnt = 0;
    for (int t = 0; t < n; ++t) cnt += (f2u(a[t]) >= cand);
    if (cnt >= cap) thr = cand;
  }
  int ngt = 0; for (int t = 0; t < n; ++t) ngt += (f2u(a[t]) > thr);
  int neq = cap - ngt, q = 0;
  for (int t = 0; t < n; ++t) {
    unsigned u = f2u(a[t]); int r = row_of(b, s0 + t); int sel = -1;
    if (u > thr) sel = q++; else if (u == thr && neq > 0) { sel = q++; --neq; }
    if (sel >= 0) { p.SEL[(size_t)e * NSLOT + slot0 + sel] = r; p.SELV[(size_t)e * NSLOT + slot0 + sel] = a[t]; }
    p.INV[(size_t)r * NE + e] = sel >= 0 ? slot0 + sel : -1;
  }
}
__global__ void __launch_bounds__(256) nv_moe1(Params p) {
  long i = GTID; if (i >= (long)NE * NSLOT * FF) return;
  int f = (int)(i % FF), slot = (int)((i / FF) % NSLOT), e = (int)(i / ((long)FF * NSLOT));
  int r = p.SEL[(size_t)e * NSLOT + slot];
  float out = 0.f;
  if (r >= 0) {
    const bf16_t* wg = p.Wt_eg + ((size_t)e * FF + f) * D; const bf16_t* wu = p.Wt_eu + ((size_t)e * FF + f) * D; const bf16_t* h = p.H + (size_t)r * D;
    float g = 0.f, u = 0.f; for (int k = 0; k < D; ++k) { float hv = bf2f(h[k]); g += hv * bf2f(wg[k]); u += hv * bf2f(wu[k]); }
    out = siluf_(g) * u;
  }
  p.HID[((size_t)e * NSLOT + slot) * FF + f] = f2bf(out);
}
__global__ void __launch_bounds__(256) nv_moe2(Params p) {
  long i = GTID; if (i >= (long)NE * NSLOT * D) return;
  int j = (int)(i % D), slot = (int)((i / D) % NSLOT), e = (int)(i / ((long)D * NSLOT));
  int r = p.SEL[(size_t)e * NSLOT + slot];
  float out = 0.f;
  if (r >= 0) {
    const bf16_t* wd = p.Wt_ed + ((size_t)e * D + j) * FF; const bf16_t* h = p.HID + ((size_t)e * NSLOT + slot) * FF;
    float a = 0.f; for (int k = 0; k < FF; ++k) a += bf2f(h[k]) * bf2f(wd[k]);
    out = a * p.SELV[(size_t)e * NSLOT + slot];
  }
  p.YE[((size_t)e * NSLOT + slot) * D + j] = f2bf(out);
}
__global__ void __launch_bounds__(256) nv_resid_ffn(Params p, int layer, int nrows) {
  long r = GTID; if (r >= nrows) return;
  int w = r < RL ? (int)(r / TL) : 2;
  const float* mb = p.mods + (size_t)(layer * 3 + w) * 6144;
  float* xo = r < RL ? p.out + (size_t)r * D : p.xc + (size_t)(r - RL) * D;
  float ss = 0.f;
  for (int k = 0; k < D; ++k) {
    float f = 0.f;
    for (int e = 0; e < NE; ++e) { int sl = p.INV[(size_t)r * NE + e]; if (sl >= 0) f += bf2f(p.YE[((size_t)e * NSLOT + sl) * D + k]); }
    ss += f * f;
  }
  float rstd = 1.0f / sqrtf(ss / D + 1e-6f);
  for (int k = 0; k < D; ++k) {
    float f = 0.f;
    for (int e = 0; e < NE; ++e) { int sl = p.INV[(size_t)r * NE + e]; if (sl >= 0) f += bf2f(p.YE[((size_t)e * NSLOT + sl) * D + k]); }
    xo[k] += mb[5 * 1024 + k] * f * rstd * p.g_ffn_post[layer * 1024 + k];
  }
}

__global__ void __launch_bounds__(256) nv_mods(Params p) { nvb_mods(GTID, p); }
__global__ void __launch_bounds__(256) nv_ml_gates(Params p, int layer) { nvb_ml_gates(GTID, p, layer); }
__global__ void __launch_bounds__(256) nv_gla_cum(Params p, int layer) { nvb_gla_cum(GTID, p, layer); }
__global__ void __launch_bounds__(256) nv_ml_local(Params p) { nvb_ml_local(GTID, p); }
__global__ void __launch_bounds__(256) nv_ml_scan(Params p) { nvb_ml_scan(GTID, p); }
__global__ void __launch_bounds__(256) nv_ml_out(Params p, int need_ctx) { nvb_ml_out(GTID, p, need_ctx); }
__global__ void __launch_bounds__(256) nv_ml_finish(Params p, int layer, int need_ctx) { nvb_ml_finish(GTID, p, layer, need_ctx); }
__global__ void __launch_bounds__(256) nv_gla_local(Params p) { nvb_gla_local(GTID, p); }
__global__ void __launch_bounds__(256) nv_gla_scan(Params p) { nvb_gla_scan(GTID, p); }
__global__ void __launch_bounds__(256) nv_gla_out(Params p, int need_ctx) { nvb_gla_out(GTID, p, need_ctx); }
__global__ void __launch_bounds__(256) nv_gla_finish(Params p, int layer, int need_ctx) { nvb_gla_finish(GTID, p, layer, need_ctx); }
constexpr int LROW = 144;
constexpr int A_BYTES = 128 * LROW;
constexpr int NTHR = 256;
#ifndef ATT_THR
#define ATT_THR 16.0f
#endif

DI int xcd_swz(int u, int nt) { return (nt & 7) ? u : (u & 7) * (nt >> 3) + (u >> 3); }
DI u32x4 ldg16(const void* p) { return *(const u32x4*)p; }
DI void sts16(char* p, u32x4 v) { *(u32x4*)p = v; }
DI bf16x8 lds_frag(const char* p) { return *(const bf16x8*)p; }

template <int WN>
DI void gemm_kloop(f32x4 (&acc)[4][WN], const bf16_t* const (&ap)[4], const bf16_t* const (&bp)[WN], int nk, char* lds) {
  constexpr int STAGE = A_BYTES + 32 * WN * LROW;
  const int t = TIDX, lane = t & 63, wid = t >> 6, wr = wid >> 1, wc = wid & 1;
  const int lr = t >> 3, lcb = (t & 7) * 16;
  const int fr = lane & 15, fq = lane >> 4;
  const int aoff = (wr * 64 + fr) * LROW + fq * 16, boff = A_BYTES + (wc * WN * 16 + fr) * LROW + fq * 16, soff = lr * LROW + lcb;
  u32x4 ra0[4], rb0[WN], ra1[4], rb1[WN];
  auto gload = [&](u32x4 (&ra)[4], u32x4 (&rb)[WN], int kt) {
#pragma unroll
    for (int i = 0; i < 4; ++i) ra[i] = ldg16(ap[i] + kt * 64);
#pragma unroll
    for (int i = 0; i < WN; ++i) rb[i] = ldg16(bp[i] + kt * 64);
  };
  auto sstore = [&](const u32x4 (&ra)[4], const u32x4 (&rb)[WN], char* st) {
#pragma unroll
    for (int i = 0; i < 4; ++i) sts16(st + soff + 32 * i * LROW, ra[i]);
#pragma unroll
    for (int i = 0; i < WN; ++i) sts16(st + A_BYTES + soff + 32 * i * LROW, rb[i]);
  };
  auto compute = [&](const char* cur) {
#pragma unroll
    for (int ks = 0; ks < 2; ++ks) {
      bf16x8 af[4], bfr[WN];
#pragma unroll
      for (int m = 0; m < 4; ++m) af[m] = lds_frag(cur + aoff + m * 16 * LROW + ks * 64);
#pragma unroll
      for (int n = 0; n < WN; ++n) bfr[n] = lds_frag(cur + boff + n * 16 * LROW + ks * 64);
#pragma unroll
      for (int m = 0; m < 4; ++m)
#pragma unroll
        for (int n = 0; n < WN; ++n) acc[m][n] = MFMA16(bfr[n], af[m], acc[m][n]);
    }
    IGLP_OPT();
  };
  gload(ra0, rb0, 0);
  gload(ra1, rb1, 1);
  sstore(ra0, rb0, lds);
  __syncthreads();
#pragma unroll 1
  for (int kt = 0; kt < nk; kt += 2) {
    if (kt + 2 < nk) gload(ra0, rb0, kt + 2);
    compute(lds);
    sstore(ra1, rb1, lds + STAGE);
    __syncthreads();
    if (kt + 3 < nk) gload(ra1, rb1, kt + 3);
    compute(lds + STAGE);
    if (kt + 2 < nk) sstore(ra0, rb0, lds);
    __syncthreads();
  }
}
template <int WN> DI void acc_zero(f32x4 (&acc)[4][WN]) {
#pragma unroll
  for (int m = 0; m < 4; ++m)
#pragma unroll
    for (int n = 0; n < WN; ++n) acc[m][n] = (f32x4){0.f, 0.f, 0.f, 0.f};
}
DI void st_bf16x4(bf16_t* p, f32x4 v) { u32x2 o; o.x = pack2bf(v.x, v.y); o.y = pack2bf(v.z, v.w); *(u32x2*)p = o; }

template <int WN, class RowOk>
DI void store_wave_tile(const f32x4 (&acc)[4][WN], bf16_t* C, size_t ldc, char* ldsw, int lane, RowOk row_ok) {
  constexpr int PITCH = WN * 32 + 16, CPR = WN * 2;
  const int fr = lane & 15, fq = lane >> 4;
#pragma unroll
  for (int m = 0; m < 4; ++m)
#pragma unroll
    for (int n = 0; n < WN; ++n) { u32x2 o; o.x = pack2bf(acc[m][n][0], acc[m][n][1]); o.y = pack2bf(acc[m][n][2], acc[m][n][3]); *(u32x2*)(ldsw + (m * 16 + fr) * PITCH + n * 32 + fq * 8) = o; }
  WAVE_SYNC();
  constexpr int RPP = 64 / CPR;
#pragma unroll
  for (int ps = 0; ps < 64 / RPP; ++ps) {
    const int r = ps * RPP + lane / CPR, c = lane % CPR;
    const u32x4 v = *(const u32x4*)(ldsw + r * PITCH + c * 16);
    if (row_ok(r)) *(u32x4*)(C + (size_t)r * ldc + c * 8) = v;
  }
  WAVE_SYNC();
}
template <int NOSTORE = 0>
DI void gemm_plain_tile(const bf16_t* A, int lda, const bf16_t* Bt, int ldb, int K, bf16_t* C, int ldc, int tm, int tn, char* lds) {
  const int t = TIDX, lane = t & 63, wid = t >> 6, wr = wid >> 1, wc = wid & 1, lr = t >> 3, lc = (t & 7) * 8, fr = lane & 15, fq = lane >> 4;
  const bf16_t* ap[4]; const bf16_t* bp[4];
#pragma unroll
  for (int i = 0; i < 4; ++i) { ap[i] = A + (size_t)(tm * 128 + lr + 32 * i) * lda + lc; bp[i] = Bt + (size_t)(tn * 128 + lr + 32 * i) * ldb + lc; }
  f32x4 acc[4][4]; acc_zero<4>(acc);
  gemm_kloop<4>(acc, ap, bp, K / 64, lds);
  if (NOSTORE) { float s = 0.f;
#pragma unroll
    for (int m = 0; m < 4; ++m)
#pragma unroll
      for (int n = 0; n < 4; ++n) s += acc[m][n][0] + acc[m][n][3];
    if (s == 123456.789f) C[0] = 1; return; }
  store_wave_tile<4>(acc, C + (size_t)(tm * 128 + wr * 64) * ldc + tn * 128 + wc * 64, (size_t)ldc, lds + wid * (64 * 144), lane, [](int) { return true; });
  __syncthreads();
}
template <int NOSTORE = 0>
DI void ph_gemm_plain(const bf16_t* A, int lda, const bf16_t* Bt, int ldb, int M, int N, int K, bf16_t* C, int ldc, char* lds, int bid, int nblk) {
  const int ntn = N / 128, nt = (M / 128) * ntn;
  for (int u = bid; u < nt; u += nblk) { const int tile = xcd_swz(u, nt); gemm_plain_tile<NOSTORE>(A, lda, Bt, ldb, K, C, ldc, tile / ntn, tile % ntn, lds); }
}
DI void ph_mla_up(const Params& p, int layer, bf16_t* QRAW, bf16_t* KVRAW, char* lds, int bid, int nblk) {
  const int ntq = (R / 128) * 3, ntkv = (R / 128) * 4;
  for (int tile = bid; tile < ntq + ntkv; tile += nblk) {
    if (tile < ntq) gemm_plain_tile(p.Z + ZC_QLAT, NZP, p.Wt_uq + layer * WSZ_UQ, 256, 256, QRAW, 384, tile / 3, tile % 3, lds);
    else { int u = tile - ntq; gemm_plain_tile(p.Z + ZC_KVLAT, NZP, p.Wt_ukv + layer * WSZ_UKV, 128, 128, KVRAW, 512, u / 4, u % 4, lds); }
  }
}
constexpr int LROW32 = 80;
template <int WM, int WN, bool DEEP>
DI void gemm_kloop_g(f32x4 (&acc)[WM][WN], const bf16_t* const (&ap)[WM / 2], const bf16_t* const (&bp)[WN / 2], int nk, char* lds) {
  constexpr int NA = WM / 2, NBB = WN / 2, A_B = 32 * WM * LROW32, STAGE = (32 * WM + 32 * WN) * LROW32;
  const int t = TIDX, lane = t & 63, wid = t >> 6, wr = wid >> 1, wc = wid & 1, fr = lane & 15, fq = lane >> 4;
  const int aoff = (wr * 16 * WM + fr) * LROW32 + fq * 16, boff = A_B + (wc * 16 * WN + fr) * LROW32 + fq * 16, soff = (t >> 2) * LROW32 + (t & 3) * 16;
  u32x4 ra0[NA], rb0[NBB], ra1[NA], rb1[NBB];
  auto gload = [&](u32x4 (&ra)[NA], u32x4 (&rb)[NBB], int kt) {
#pragma unroll
    for (int i = 0; i < NA; ++i) ra[i] = ldg16(ap[i] + kt * 32);
#pragma unroll
    for (int i = 0; i < NBB; ++i) rb[i] = ldg16(bp[i] + kt * 32);
  };
  auto sstore = [&](const u32x4 (&ra)[NA], const u32x4 (&rb)[NBB], char* st) {
#pragma unroll
    for (int i = 0; i < NA; ++i) sts16(st + soff + 64 * i * LROW32, ra[i]);
#pragma unroll
    for (int i = 0; i < NBB; ++i) sts16(st + A_B + soff + 64 * i * LROW32, rb[i]);
  };
  auto compute = [&](const char* cur) {
    bf16x8 af[WM];
#pragma unroll
    for (int m = 0; m < WM; ++m) af[m] = lds_frag(cur + aoff + m * 16 * LROW32);
#pragma unroll
    for (int n = 0; n < WN; ++n) {
      const bf16x8 bfr = lds_frag(cur + boff + n * 16 * LROW32);
#pragma unroll
      for (int m = 0; m < WM; ++m) acc[m][n] = MFMA16(bfr, af[m], acc[m][n]);
    }
    IGLP_OPT();
  };
  gload(ra0, rb0, 0);
  if (DEEP) gload(ra1, rb1, 1);
  sstore(ra0, rb0, lds);
  __syncthreads();
#pragma unroll 1
  for (int kt = 0; kt < nk; kt += 2) {
    if (DEEP) { if (kt + 2 < nk) gload(ra0, rb0, kt + 2); } else gload(ra1, rb1, kt + 1);
    compute(lds);
    sstore(ra1, rb1, lds + STAGE);
    __syncthreads();
    if (DEEP) { if (kt + 3 < nk) gload(ra1, rb1, kt + 3); } else if (kt + 2 < nk) gload(ra0, rb0, kt + 2);
    compute(lds + STAGE);
    if (kt + 2 < nk) sstore(ra0, rb0, lds);
    __syncthreads();
  }
}
template <int WM, int WN> DI void acc_zero_g(f32x4 (&acc)[WM][WN]) {
#pragma unroll
  for (int m = 0; m < WM; ++m)
#pragma unroll
    for (int n = 0; n < WN; ++n) acc[m][n] = (f32x4){0.f, 0.f, 0.f, 0.f};
}
DI void ph_merge(const Params& p, int layer, int rows, char* lds, int bid, int nblk) {
  const int t = TIDX, lane = t & 63, wid = t >> 6, wr = wid >> 1, wc = wid & 1, fr = lane & 15, fq = lane >> 4;
  const int lr = t >> 2, lc = (t & 3) * 8;
  const int ntn = D / 64, nt = (rows / 128) * ntn;
#pragma unroll 1
  for (int u = bid; u < nt; u += nblk) {
    const int tile = xcd_swz(u, nt), tm = tile / ntn, tn = tile % ntn;
    f32x4 accS[4][2]; acc_zero_g<4, 2>(accS);
#pragma unroll 1
    for (int np = 0; np < 2; ++np) {
      f32x4 accG[4][4]; acc_zero_g<4, 4>(accG);
      {
        const bf16_t* ap[2]; const bf16_t* bp[2];
#pragma unroll
        for (int i = 0; i < 2; ++i) ap[i] = p.H + (size_t)(tm * 128 + lr + 64 * i) * D + lc;
#pragma unroll
        for (int i = 0; i < 2; ++i) { const int rho = lr + 64 * i, wci = rho >> 6, n = 2 * np + ((rho >> 5) & 1), c = rho & 31;
          bp[i] = p.Wt_gate + layer * WSZ_GATE + ((size_t)n * 1024 + tn * 64 + wci * 32 + c) * D + lc; }
        gemm_kloop_g<4, 4, true>(accG, ap, bp, D / 32, lds);
      }
#pragma unroll 1
      for (int q = 0; q < 2; ++q) {
        const int n = 2 * np + q;
        f32x4 accP[4][2]; acc_zero_g<4, 2>(accP);
        const bf16_t* ap[2]; const bf16_t* bp[1];
#pragma unroll
        for (int i = 0; i < 2; ++i) ap[i] = p.Y + (size_t)(tm * 128 + lr + 64 * i) * D + n * 256 + lc;
        bp[0] = p.Wt_branch + layer * WSZ_BR + ((size_t)n * D + tn * 64 + lr) * 256 + lc;
        gemm_kloop_g<4, 2, false>(accP, ap, bp, 8, lds);
#pragma unroll
        for (int nn = 0; nn < 2; ++nn) {
          const f32x4 bv = *(const f32x4*)(p.b_gate + layer * 4096 + n * 1024 + tn * 64 + wc * 32 + nn * 16 + 4 * fq);
#pragma unroll
          for (int m = 0; m < 4; ++m)
#pragma unroll
            for (int j = 0; j < 4; ++j) { const float g = q ? accG[m][2 + nn][j] : accG[m][nn][j]; accS[m][nn][j] += accP[m][nn][j] * fast_rcp(1.0f + fast_exp2(-LOG2E * (g + bv[j]))); }
        }
      }
    }
    store_wave_tile<2>(accS, p.MG + (size_t)(tm * 128 + wr * 64) * D + tn * 64 + wc * 32, (size_t)D, lds + wid * (64 * 80), lane, [](int) { return true; });
    __syncthreads();
  }
}
template <int WM>
DI void gemm_plain_tile_g(const bf16_t* A, int lda, const bf16_t* Bt, int ldb, int K, bf16_t* C, int ldc, int row0, int col0, char* lds) {
  const int t = TIDX, lane = t & 63, wid = t >> 6, wr = wid >> 1, wc = wid & 1, fr = lane & 15, fq = lane >> 4, lr = t >> 2, lc = (t & 3) * 8;
  const bf16_t* ap[WM / 2]; const bf16_t* bp[2];
#pragma unroll
  for (int i = 0; i < WM / 2; ++i) ap[i] = A + (size_t)(row0 + lr + 64 * i) * lda + lc;
#pragma unroll
  for (int i = 0; i < 2; ++i) bp[i] = Bt + (size_t)(col0 + lr + 64 * i) * ldb + lc;
  f32x4 acc[WM][4]; acc_zero_g<WM, 4>(acc);
  gemm_kloop_g<WM, 4, true>(acc, ap, bp, K / 32, lds);
#pragma unroll
  for (int m = 0; m < WM; ++m)
#pragma unroll
    for (int n = 0; n < 4; ++n)
      st_bf16x4(C + (size_t)(row0 + wr * 16 * WM + m * 16 + fr) * ldc + col0 + wc * 64 + n * 16 + 4 * fq, acc[m][n]);
}
DI void ph_gemm_plain2(const bf16_t* A, int lda, const bf16_t* Bt, int ldb, int M, int N, int K, bf16_t* C, int ldc, char* lds, int bid, int nblk) {
  const int ntn = N / 128, nt = (M / 256) * ntn, nfull = (nt / nblk) * nblk;
#pragma unroll 1
  for (int tile = bid; tile < nfull; tile += nblk) gemm_plain_tile_g<8>(A, lda, Bt, ldb, K, C, ldc, (tile / ntn) * 256, (tile % ntn) * 128, lds);
#pragma unroll 1
  for (int h = bid; h < 2 * (nt - nfull); h += nblk) { const int tile = nfull + (h >> 1); gemm_plain_tile_g<4>(A, lda, Bt, ldb, K, C, ldc, (tile / ntn) * 256 + (h & 1) * 128, (tile % ntn) * 128, lds); }
}
DI void gemm_kloop32(f32x16 (&acc)[2][2], const bf16_t* const (&ap)[4], const bf16_t* const (&bp)[4], int nk, char* lds) {
  constexpr int STAGE = A_BYTES + 128 * LROW;
  const int t = TIDX, lane = t & 63, wid = t >> 6, wr = wid >> 1, wc = wid & 1, l31 = lane & 31, hh = lane >> 5;
  const int aoff = (wr * 64 + l31) * LROW + hh * 16, boff = A_BYTES + (wc * 64 + l31) * LROW + hh * 16, soff = (t >> 3) * LROW + (t & 7) * 16;
  u32x4 ra0[4], rb0[4], ra1[4], rb1[4];
  auto gload = [&](u32x4 (&ra)[4], u32x4 (&rb)[4], int kt) {
#pragma unroll
    for (int i = 0; i < 4; ++i) { ra[i] = ldg16(ap[i] + kt * 64); rb[i] = ldg16(bp[i] + kt * 64); }
  };
  auto sstore = [&](const u32x4 (&ra)[4], const u32x4 (&rb)[4], char* st) {
#pragma unroll
    for (int i = 0; i < 4; ++i) { sts16(st + soff + 32 * i * LROW, ra[i]); sts16(st + A_BYTES + soff + 32 * i * LROW, rb[i]); }
  };
  auto compute = [&](const char* cur) {
#pragma unroll
    for (int ks = 0; ks < 4; ++ks) {
      bf16x8 af[2], bfr[2];
#pragma unroll
      for (int m = 0; m < 2; ++m) af[m] = lds_frag(cur + aoff + m * 32 * LROW + ks * 32);
#pragma unroll
      for (int n = 0; n < 2; ++n) bfr[n] = lds_frag(cur + boff + n * 32 * LROW + ks * 32);
#pragma unroll
      for (int m = 0; m < 2; ++m)
#pragma unroll
        for (int n = 0; n < 2; ++n) acc[m][n] = MFMA32(bfr[n], af[m], acc[m][n]);
    }
  };
  gload(ra0, rb0, 0); gload(ra1, rb1, 1);
  sstore(ra0, rb0, lds);
  __syncthreads();
#pragma unroll 1
  for (int kt = 0; kt < nk; kt += 2) {
    if (kt + 2 < nk) gload(ra0, rb0, kt + 2);
    compute(lds);
    sstore(ra1, rb1, lds + STAGE);
    __syncthreads();
    if (kt + 3 < nk) gload(ra1, rb1, kt + 3);
    compute(lds + STAGE);
    if (kt + 2 < nk) sstore(ra0, rb0, lds);
    __syncthreads();
  }
}
DI void ph_gemm_plain32(const bf16_t* A, int lda, const bf16_t* Bt, int ldb, int M, int N, int K, bf16_t* C, int ldc, char* lds, int bid, int nblk) {
  const int t = TIDX, lane = t & 63, wid = t >> 6, wr = wid >> 1, wc = wid & 1, lr = t >> 3, lc = (t & 7) * 8, l31 = lane & 31, hh = lane >> 5;
  const int ntn = N / 128, nt = (M / 128) * ntn;
#pragma unroll 1
  for (int tile = bid; tile < nt; tile += nblk) {
    const int tm = tile / ntn, tn = tile % ntn;
    const bf16_t* ap[4]; const bf16_t* bp[4];
#pragma unroll
    for (int i = 0; i < 4; ++i) { ap[i] = A + (size_t)(tm * 128 + lr + 32 * i) * lda + lc; bp[i] = Bt + (size_t)(tn * 128 + lr + 32 * i) * ldb + lc; }
    f32x16 acc[2][2];
#pragma unroll
    for (int m = 0; m < 2; ++m)
#pragma unroll
      for (int n = 0; n < 2; ++n) acc[m][n] = (f32x16)(0.f);
    gemm_kloop32(acc, ap, bp, K / 64, lds);
#pragma unroll
    for (int m = 0; m < 2; ++m)
#pragma unroll
      for (int n = 0; n < 2; ++n)
#pragma unroll
        for (int g = 0; g < 4; ++g) {
          f32x4 o = {acc[m][n][4 * g], acc[m][n][4 * g + 1], acc[m][n][4 * g + 2], acc[m][n][4 * g + 3]};
          st_bf16x4(C + (size_t)(tm * 128 + wr * 64 + m * 32 + l31) * ldc + tn * 128 + wc * 64 + n * 32 + 8 * g + 4 * hh, o);
        }
  }
}
template <int MODE>
DI void ph_gemm_probe(const bf16_t* A, int lda, const bf16_t* Bt, int ldb, int M, int N, int K, float* sink, char* lds, int bid, int nblk) {
  const int t = TIDX, lane = t & 63, wid = t >> 6, wr = wid >> 1, wc = wid & 1, lr = t >> 3, lc = (t & 7) * 8, fr = lane & 15, fq = lane >> 4;
  const int ntn = N / 128, nt = (M / 128) * ntn, nk = K / 64;
  constexpr int STAGE = A_BYTES + 128 * LROW;
  const int aoff = (wr * 64 + fr) * LROW + fq * 16, boff = A_BYTES + (wc * 64 + fr) * LROW + fq * 16;
#pragma unroll 1
  for (int tile = bid; tile < nt; tile += nblk) {
    f32x4 acc[4][4]; acc_zero<4>(acc);
    bf16x8 af[4], bfr[4];
    const int tm = tile / ntn, tn = tile % ntn;
    const bf16_t* ap[4]; const bf16_t* bp[4];
#pragma unroll
    for (int i = 0; i < 4; ++i) { ap[i] = A + (size_t)(tm * 128 + lr + 32 * i) * lda + lc; bp[i] = Bt + (size_t)(tn * 128 + lr + 32 * i) * ldb + lc; }
    u32x4 ra[4], rb[4], junk = {0u, 0u, 0u, 0u};
#pragma unroll
    for (int i = 0; i < 4; ++i) { ra[i] = junk; rb[i] = junk; }
#pragma unroll 1
    for (int kt = 0; kt < nk; ++kt) {
      const char* cur = lds + (kt & 1) * STAGE;
#pragma unroll
      for (int i = 0; i < 4; ++i) { ra[i] = ldg16(ap[i] + kt * 64); if (MODE == 3) rb[i] = ldg16(bp[i] + kt * 64); }
#pragma unroll
      for (int ks = 0; ks < 2; ++ks) {
#pragma unroll
        for (int m = 0; m < 4; ++m) { af[m] = lds_frag(cur + aoff + m * 16 * LROW + ks * 64); bfr[m] = lds_frag(cur + boff + m * 16 * LROW + ks * 64); }
#pragma unroll
        for (int m = 0; m < 4; ++m)
#pragma unroll
          for (int n = 0; n < 4; ++n) acc[m][n] = MFMA16(bfr[n], af[m], acc[m][n]);
      }
      junk.x ^= ra[0].x ^ ra[1].y ^ ra[2].z ^ ra[3].w ^ rb[0].x ^ rb[1].y ^ rb[2].z ^ rb[3].w;
      __syncthreads();
    }
    float s = (float)(junk.x & 1u);
#pragma unroll
    for (int m = 0; m < 4; ++m)
#pragma unroll
      for (int n = 0; n < 4; ++n) s += acc[m][n][0] + acc[m][n][3];
    if (s == 123456.789f) sink[0] = s;
  }
}
DI void ph_moe1(const Params& p, int need_ctx, char* lds, int bid, int nblk) {
  const int t = TIDX, lane = t & 63, wid = t >> 6, wr = wid >> 1, wc = wid & 1, lr = t >> 3, lc = (t & 7) * 8, fr = lane & 15, fq = lane >> 4;
  constexpr int NTN = FF / 64;
  const int NTM = need_ctx ? (NSLOT + 127) / 128 : (NB * CAPL) / 128;
  for (int u = bid; u < NE * NTM * NTN; u += nblk) {
    const int tile = xcd_swz(u, NE * NTM * NTN), e = tile / (NTM * NTN), rem = tile % (NTM * NTN), tm = rem / NTN, tn = rem % NTN;
    const bf16_t* ap[4]; const bf16_t* bp[4];
#pragma unroll
    for (int i = 0; i < 4; ++i) {
      const int slot = tm * 128 + lr + 32 * i;
      int r = slot < NSLOT ? p.SEL[(size_t)e * NSLOT + slot] : -1;
      ap[i] = p.H + (size_t)(r < 0 ? 0 : r) * D + lc;
      const int rho = lr + 32 * i, wci = rho >> 6, gu = (rho >> 5) & 1, col = wci * 32 + (rho & 31);
      bp[i] = (gu ? p.Wt_eu : p.Wt_eg) + ((size_t)e * FF + tn * 64 + col) * D + lc;
    }
    f32x4 acc[4][4]; acc_zero<4>(acc);
    gemm_kloop<4>(acc, ap, bp, D / 64, lds);
    f32x4 hid[4][2];
#pragma unroll
    for (int m = 0; m < 4; ++m) {
      const int slot = tm * 128 + wr * 64 + m * 16 + fr;
      const bool valid = slot < NSLOT && p.SEL[(size_t)e * NSLOT + (slot < NSLOT ? slot : 0)] >= 0;
#pragma unroll
      for (int n = 0; n < 2; ++n)
#pragma unroll
        for (int j = 0; j < 4; ++j) { const float g = acc[m][n][j], u = acc[m][n + 2][j]; hid[m][n][j] = valid ? g * u * fast_rcp(1.0f + fast_exp2(-LOG2E * g)) : 0.f; }
    }
    const int slot0 = tm * 128 + wr * 64;
    store_wave_tile<2>(hid, p.HID + ((size_t)e * NSLOT + slot0) * FF + tn * 64 + wc * 32, (size_t)FF, lds + wid * (64 * 80), lane, [&](int r) { return slot0 + r < NSLOT; });
    __syncthreads();
  }
}
DI void ph_moe2(const Params& p, int need_ctx, char* lds, int bid, int nblk) {
  const int t = TIDX, lane = t & 63, wid = t >> 6, wr = wid >> 1, wc = wid & 1, lr = t >> 3, lc = (t & 7) * 8, fr = lane & 15, fq = lane >> 4;
  constexpr int NTN = D / 128;
  const int NTM = need_ctx ? (NSLOT + 127) / 128 : (NB * CAPL) / 128;
  for (int u = bid; u < NE * NTM * NTN; u += nblk) {
    const int tile = xcd_swz(u, NE * NTM * NTN), e = tile / (NTM * NTN), rem = tile % (NTM * NTN), tm = rem / NTN, tn = rem % NTN;
    const bf16_t* ap[4]; const bf16_t* bp[4];
#pragma unroll
    for (int i = 0; i < 4; ++i) {
      int slot = tm * 128 + lr + 32 * i; if (slot >= NSLOT) slot = NSLOT - 1;
      ap[i] = p.HID + ((size_t)e * NSLOT + slot) * FF + lc;
      bp[i] = p.Wt_ed + ((size_t)e * D + tn * 128 + lr + 32 * i) * FF + lc;
    }
    f32x4 acc[4][4]; acc_zero<4>(acc);
    gemm_kloop<4>(acc, ap, bp, FF / 64, lds);
#pragma unroll
    for (int m = 0; m < 4; ++m) {
      const int slot = tm * 128 + wr * 64 + m * 16 + fr;
      const float val = (slot < NSLOT && p.SEL[(size_t)e * NSLOT + (slot < NSLOT ? slot : 0)] >= 0) ? p.SELV[(size_t)e * NSLOT + slot] : 0.f;
#pragma unroll
      for (int n = 0; n < 4; ++n) { acc[m][n].x *= val; acc[m][n].y *= val; acc[m][n].z *= val; acc[m][n].w *= val; }
    }
    const int slot0 = tm * 128 + wr * 64;
    store_wave_tile<4>(acc, p.YE + ((size_t)e * NSLOT + slot0) * D + tn * 128 + wc * 64, (size_t)D, lds + wid * (64 * 144), lane, [&](int r) { return slot0 + r < NSLOT; });
    __syncthreads();
  }
}
constexpr int GEMM_LDS = 2 * (A_BYTES + 128 * LROW);

DI void unpack8(u32x4 v, float (&f)[8]) {
  f[0] = u2f(v.x << 16); f[1] = u2f(v.x & 0xffff0000u); f[2] = u2f(v.y << 16); f[3] = u2f(v.y & 0xffff0000u);
  f[4] = u2f(v.z << 16); f[5] = u2f(v.z & 0xffff0000u); f[6] = u2f(v.w << 16); f[7] = u2f(v.w & 0xffff0000u);
}
DI u32x4 pack8f(const float (&f)[8]) { u32x4 v; v.x = pack2bf(f[0], f[1]); v.y = pack2bf(f[2], f[3]); v.z = pack2bf(f[4], f[5]); v.w = pack2bf(f[6], f[7]); return v; }
DI void rope8(float (&a)[8], const float (&pr)[8], int cc, const float* cs, const float* sn) {
  const int ax = (cc >> 1) * 8; const bool second = cc & 1;
#pragma unroll
  for (int i = 0; i < 8; ++i) a[i] = second ? a[i] * cs[ax + i] + pr[i] * sn[ax + i] : a[i] * cs[ax + i] - pr[i] * sn[ax + i];
}
constexpr int PREP_LDS = 64 * 4 + 2 * 512 * 4 + 32 * 528;
template <int PARTS = 3>
DI void ph_prep(const Params& p, int layer, const bf16_t* QRAW, const bf16_t* KVRAW, char* lds, int bid, int nblk) {
  float* s_rstd = (float*)lds;
  float* s_cs = s_rstd + 64;
  float* s_sn = s_cs + 512;
  bf16_t* s_t = (bf16_t*)(s_sn + 512);
  const int t = TIDX;
  constexpr int UPB = TK / 32, NU = NB * UPB;
  const float* wcv = p.w_conv + (size_t)layer * 3 * 512;
#pragma unroll 1
  for (int u = bid; u < NU; u += nblk) {
    int b, s0;
    if (u < NB * (TL / 32)) { b = u / (TL / 32); s0 = TC + (u % (TL / 32)) * 32; } else { const int v = u - NB * (TL / 32); b = v / (TC / 32); s0 = (v % (TC / 32)) * 32; }
    const int r0 = row_of(b, s0);
    {
      const int tok = t >> 3, part = t & 7;
      const bf16_t* z = p.Z + (size_t)(r0 + tok) * NZP;
      float sq = 0.f, sk = 0.f, f[8];
#pragma unroll
      for (int k = 0; k < 4; ++k) { unpack8(ldg16(z + ZC_QLAT + part * 32 + k * 8), f);
#pragma unroll
        for (int i = 0; i < 8; ++i) sq += f[i] * f[i]; }
#pragma unroll
      for (int k = 0; k < 2; ++k) { unpack8(ldg16(z + ZC_KVLAT + part * 16 + k * 8), f);
#pragma unroll
        for (int i = 0; i < 8; ++i) sk += f[i] * f[i]; }
      sq = xor_sum<1>(sq); sk = xor_sum<1>(sk);
      sq = xor_sum<2>(sq); sk = xor_sum<2>(sk);
      sq = xor_sum<4>(sq); sk = xor_sum<4>(sk);
      if (part == 0) { s_rstd[tok * 2] = 1.0f / sqrtf(sq * (1.0f / 256) + 1e-6f); s_rstd[tok * 2 + 1] = 1.0f / sqrtf(sk * (1.0f / 128) + 1e-6f); }
    }
    for (int i = t; i < 512; i += NTHR) {
      const int tok = i >> 4, af = i & 15, s = s0 + tok;
      float cs = 1.f, sn = 0.f;
      if (s >= TC) rope_cs(s, (af >> 3) * 16 + (af & 7), cs, sn);
      s_cs[i] = cs; s_sn[i] = sn;
    }
    __syncthreads();
    if (PARTS & 1) {
#pragma unroll 2
    for (int i = t; i < 32 * 48; i += NTHR) {
      const int tok = i / 48, c = i % 48, h = c / 12, ch = c % 12;
      const float rq = s_rstd[tok * 2] * QS_MLA, rkv = s_rstd[tok * 2 + 1];
      const bf16_t* q = QRAW + (size_t)(r0 + tok) * 384 + h * 96;
      float a[8], pr[8];
      unpack8(ldg16(q + ch * 8), a);
      if (ch >= 8) { unpack8(ldg16(q + 64 + ((ch - 8) ^ 1) * 8), pr); rope8(a, pr, ch - 8, s_cs + tok * 16, s_sn + tok * 16); }
#pragma unroll
      for (int e = 0; e < 8; ++e) a[e] *= rq;
      *(u32x4*)(p.Qm + (((size_t)b * 4 + h) * TK + s0 + tok) * 96 + ch * 8) = pack8f(a);
      if (ch < 8) {
        unpack8(ldg16(KVRAW + (size_t)(r0 + tok) * 512 + h * 128 + ch * 8), a);
#pragma unroll
        for (int e = 0; e < 8; ++e) a[e] *= rkv;
      } else {
        const bf16_t* z = p.Z + (size_t)(r0 + tok) * NZP + ZC_KROPE;
        unpack8(ldg16(z + (ch - 8) * 8), a); unpack8(ldg16(z + ((ch - 8) ^ 1) * 8), pr);
        rope8(a, pr, ch - 8, s_cs + tok * 16, s_sn + tok * 16);
      }
      *(u32x4*)(p.Km + (((size_t)b * 4 + h) * TK + s0 + tok) * 96 + ch * 8) = pack8f(a);
    }
#pragma unroll 2
    for (int i = t; i < 32 * 64; i += NTHR) {
      const int tok = i >> 6, c = i & 63, qk = c >> 5, hm = (c >> 2) & 7, cc = c & 3;
      const bf16_t* src = p.Z + (size_t)(r0 + tok) * NZP + (qk ? ZC_DK : ZC_DQ) + hm * 32;
      float a[8], pr[8];
      unpack8(ldg16(src + cc * 8), a); unpack8(ldg16(src + (cc ^ 1) * 8), pr);
      rope8(a, pr, cc, s_cs + tok * 16, s_sn + tok * 16);
      if (qk == 0) {
#pragma unroll
        for (int e = 0; e < 8; ++e) a[e] *= QS_DIFF;
        *(u32x4*)(p.Qd + (((size_t)b * 8 + hm) * TK + s0 + tok) * 32 + cc * 8) = pack8f(a);
      } else *(u32x4*)(p.Kd + (((size_t)b * 8 + hm) * TK + s0 + tok) * 32 + cc * 8) = pack8f(a);
    }
#pragma unroll 2
    for (int i = t; i < 32 * 64; i += NTHR) {
      const int tok = i >> 6, c8 = (i & 63) * 8, s = s0 + tok;
      const bool first = (s == 0) || (s == TC), last = (s == TC - 1) || (s == TK - 1);
      const bf16_t* z = p.Z + (size_t)(r0 + tok) * NZP + ZC_MLQK + c8;
      float x0[8], xm[8], xp[8], o[8];
      unpack8(ldg16(z), x0);
      if (!first) unpack8(ldg16(z - NZP), xm);
      if (!last) unpack8(ldg16(z + NZP), xp);
      float bc8[8], w0[8], w1[8], w2[8];
      *(f32x4*)bc8 = *(const f32x4*)(p.b_conv + layer * 512 + c8); *(f32x4*)(bc8 + 4) = *(const f32x4*)(p.b_conv + layer * 512 + c8 + 4);
      *(f32x4*)w0 = *(const f32x4*)(wcv + c8); *(f32x4*)(w0 + 4) = *(const f32x4*)(wcv + c8 + 4);
      *(f32x4*)w1 = *(const f32x4*)(wcv + 512 + c8); *(f32x4*)(w1 + 4) = *(const f32x4*)(wcv + 512 + c8 + 4);
      *(f32x4*)w2 = *(const f32x4*)(wcv + 1024 + c8); *(f32x4*)(w2 + 4) = *(const f32x4*)(wcv + 1024 + c8 + 4);
#pragma unroll
      for (int e = 0; e < 8; ++e) {
        float acc = bc8[e] + x0[e] * w1[e];
        if (!first) acc += xm[e] * w0[e];
        if (!last) acc += xp[e] * w2[e];
        o[e] = acc * fast_rcp(1.0f + fast_exp2(-LOG2E * acc));
      }
      if (c8 < 256) *(u32x4*)(p.MQ + ((size_t)b * TK + s) * 256 + c8) = pack8f(o);
      else {
#pragma unroll
        for (int e = 0; e < 8; ++e) o[e] *= 0.125f;
        *(u32x4*)(p.MK + ((size_t)b * TK + s) * 256 + c8 - 256) = pack8f(o);
      }
    }
    }
#pragma unroll 1
    for (int w = 0; w < ((PARTS & 2) ? 4 : 0); ++w) {
      __syncthreads();
#pragma unroll
      for (int k = 0; k < 4; ++k) {
        const int i = t + k * NTHR, tok = i >> 5, c8 = (i & 31) * 8;
        u32x4 v;
        if (w == 0) { float a[8]; const int h = c8 >> 6; unpack8(ldg16(KVRAW + (size_t)(r0 + tok) * 512 + h * 128 + 64 + (c8 & 63)), a); const float rkv = s_rstd[tok * 2 + 1];
#pragma unroll
          for (int e = 0; e < 8; ++e) a[e] *= rkv;
          v = pack8f(a); }
        else v = ldg16(p.Z + (size_t)(r0 + tok) * NZP + (w == 1 ? ZC_DV : (w == 2 ? ZC_MLV : ZC_GV)) + c8);
        *(u32x4*)(s_t + tok * 264 + c8) = v;
      }
      __syncthreads();
      bf16_t* dst = w == 0 ? p.Vtm : (w == 1 ? p.Vtd : (w == 2 ? p.MVt : p.GVt));
#pragma unroll
      for (int k = 0; k < 4; ++k) {
        const int i = t + k * NTHR, tg = i & 3, ch = i >> 2;
        u32x4 v;
        v.x = (unsigned)s_t[(tg * 8 + 0) * 264 + ch] | ((unsigned)s_t[(tg * 8 + 1) * 264 + ch] << 16);
        v.y = (unsigned)s_t[(tg * 8 + 2) * 264 + ch] | ((unsigned)s_t[(tg * 8 + 3) * 264 + ch] << 16);
        v.z = (unsigned)s_t[(tg * 8 + 4) * 264 + ch] | ((unsigned)s_t[(tg * 8 + 5) * 264 + ch] << 16);
        v.w = (unsigned)s_t[(tg * 8 + 6) * 264 + ch] | ((unsigned)s_t[(tg * 8 + 7) * 264 + ch] << 16);
        *(u32x4*)(dst + (((size_t)b * 4 + (ch >> 6)) * 64 + (ch & 63)) * TK + s0 + tg * 8) = v;
      }
    }
    __syncthreads();
  }
}
constexpr int VROW = 136;
constexpr int VROW_A = 144;
template <int DQK> struct AttnCfg {
  static constexpr int KROW = DQK * 2 + 16;
  static constexpr int KBYTES = 64 * KROW, VBYTES = 64 * VROW_A, STAGE = KBYTES + VBYTES;
  static constexpr int KCH = 64 * DQK * 2 / 16 / NTHR;
};
DI bf16x8 pack8(const f32x16& x, int s) {
  u32x4 pk; pk.x = pack2bf(x[8 * s], x[8 * s + 1]); pk.y = pack2bf(x[8 * s + 2], x[8 * s + 3]); pk.z = pack2bf(x[8 * s + 4], x[8 * s + 5]); pk.w = pack2bf(x[8 * s + 6], x[8 * s + 7]);
  return __builtin_bit_cast(bf16x8, pk);
}
struct TrueC { static constexpr bool value = true; };
struct FalseC { static constexpr bool value = false; };
template <int DQK, int NMAP, int VAR = 0>
DI void attn_unit(const bf16_t* __restrict__ Qb, const bf16_t* __restrict__ Kb, size_t mstride, const bf16_t* __restrict__ Vt, int q0, int nkeys,
                  f32x16 (&O)[NMAP][2], float (&lsum)[NMAP], char* lds) {
  constexpr int DM = DQK / NMAP;
  constexpr int KS = DM / 16;
  using C = AttnCfg<DQK>;
  constexpr int CPM = 64 * DM * 2 / 16;
  constexpr int CPR = DM * 2 / 16;
  const int t = TIDX, lane = t & 63, wid = t >> 6, l31 = lane & 31, hh = lane >> 5;
  bf16x8 qf[NMAP][KS];
#pragma unroll
  for (int m = 0; m < NMAP; ++m)
#pragma unroll
    for (int ks = 0; ks < KS; ++ks) qf[m][ks] = *(const bf16x8*)(Qb + m * mstride + (size_t)(q0 + wid * 32 + l31) * DM + ks * 16 + 8 * hh);
  float mref[NMAP];
#pragma unroll
  for (int m = 0; m < NMAP; ++m) { mref[m] = 0.f; lsum[m] = 0.f; O[m][0] = (f32x16)(0.f); O[m][1] = (f32x16)(0.f); }
  u32x4 rk[C::KCH], rv[2];
  const bf16_t* kg[C::KCH]; int klds[C::KCH];
#pragma unroll
  for (int i = 0; i < C::KCH; ++i) { const int c = t + i * NTHR, m = c / CPM, cc = c % CPM; kg[i] = Kb + m * mstride + cc * 8; klds[i] = (cc / CPR) * C::KROW + m * DM * 2 + (cc % CPR) * 16; }
  const bf16_t* vg = Vt + (size_t)(t >> 3) * TK + (t & 7) * 8;
  const int vlds = C::KBYTES + (t >> 3) * VROW_A + ((t & 7) >> 1) * 32 + ((t & 1) ? 8 : 0);
  const int kfoff = l31 * C::KROW + 16 * hh, vfoff = C::KBYTES + l31 * VROW_A + 16 * hh;
  const int nt = nkeys / 64;
#pragma unroll
  for (int i = 0; i < C::KCH; ++i) rk[i] = ldg16(kg[i]);
  rv[0] = ldg16(vg); rv[1] = ldg16(vg + (size_t)32 * TK);
  auto tile = [&](const int kt, auto chk_c, auto ref_c) __attribute__((always_inline)) {
    constexpr bool CHK = decltype(chk_c)::value, REF = decltype(ref_c)::value;
    char* cur = lds + (kt & 1) * C::STAGE;
    if (VAR != 2) {
#pragma unroll
    for (int i = 0; i < C::KCH; ++i) sts16(cur + klds[i], rk[i]);
#pragma unroll
    for (int i = 0; i < 2; ++i) { char* d = cur + vlds + i * 32 * VROW_A; u32x2 lo, hi; lo.x = rv[i].x; lo.y = rv[i].y; hi.x = rv[i].z; hi.y = rv[i].w; *(u32x2*)d = lo; *(u32x2*)(d + 16) = hi; }
    __syncthreads();
    }
    if (VAR != 2 && kt + 1 < nt) {
#pragma unroll
      for (int i = 0; i < C::KCH; ++i) rk[i] = ldg16(kg[i] + (size_t)(kt + 1) * 64 * DM);
      rv[0] = ldg16(vg + (kt + 1) * 64); rv[1] = ldg16(vg + (size_t)32 * TK + (kt + 1) * 64);
    }
    bf16x8 kf[NMAP][2][KS];
#pragma unroll
    for (int k2 = 0; k2 < 2; ++k2)
#pragma unroll
      for (int ks = 0; ks < KS; ++ks) kf[0][k2][ks] = lds_frag(cur + kfoff + k2 * 32 * C::KROW + ks * 32);
    f32x16 S[NMAP][2];
    S[0][0] = (f32x16)(0.f); S[0][1] = (f32x16)(0.f);
#pragma unroll
    for (int ks = 0; ks < KS; ++ks)
#pragma unroll
      for (int k2 = 0; k2 < 2; ++k2) S[0][k2] = MFMA32(kf[0][k2][ks], qf[0][ks], S[0][k2]);
    bf16x8 vf[4][2];
#pragma unroll
    for (int kst = 0; kst < 4; ++kst)
#pragma unroll
      for (int dvt = 0; dvt < 2; ++dvt) vf[kst][dvt] = lds_frag(cur + vfoff + dvt * 32 * VROW_A + kst * 32);
#pragma unroll
    for (int m = 1; m < NMAP; ++m)
#pragma unroll
      for (int k2 = 0; k2 < 2; ++k2)
#pragma unroll
        for (int ks = 0; ks < KS; ++ks) kf[m][k2][ks] = lds_frag(cur + kfoff + k2 * 32 * C::KROW + m * DM * 2 + ks * 32);
#pragma unroll
    for (int m = 0; m < NMAP; ++m) {
      if (m > 0) {
        SCHED_BARRIER();
        S[m][0] = (f32x16)(0.f); S[m][1] = (f32x16)(0.f);
#pragma unroll
        for (int ks = 0; ks < KS; ++ks)
#pragma unroll
          for (int k2 = 0; k2 < 2; ++k2) S[m][k2] = MFMA32(kf[m][k2][ks], qf[m][ks], S[m][k2]);
      }
      if (VAR != 1) {
      if (CHK && (kt & 7) == 0) {
        float mx = fmaxf(S[m][0][0], S[m][1][0]);
#pragma unroll
        for (int i = 1; i < 16; ++i) mx = fmaxf(mx, fmaxf(S[m][0][i], S[m][1][i]));
        mx = xor_max<32>(mx);
        const float rel = mx - mref[m];
        const float delta = (kt == 0) ? ((mx > ATT_THR || mx < -ATT_THR) ? mx : 0.0f) : (rel > ATT_THR ? rel : 0.0f);
        if (wave_any(delta != 0.0f)) {
          const float alpha = fast_exp2(-delta);
          mref[m] += delta; lsum[m] *= alpha;
#pragma unroll
          for (int dvt = 0; dvt < 2; ++dvt)
#pragma unroll
            for (int i = 0; i < 16; ++i) O[m][dvt][i] *= alpha;
        }
      }
      if constexpr (REF) {
        if (wave_any(mref[m] != 0.0f)) {
          const f32x2 nm = {-mref[m], -mref[m]};
#pragma unroll
          for (int k2 = 0; k2 < 2; ++k2)
#pragma unroll
            for (int i = 0; i < 16; i += 2) { const f32x2 x = (f32x2){S[m][k2][i], S[m][k2][i + 1]} + nm; S[m][k2][i] = x.x; S[m][k2][i + 1] = x.y; }
        }
      }
      f32x2 ps2 = {0.f, 0.f};
#pragma unroll
      for (int k2 = 0; k2 < 2; ++k2)
#pragma unroll
        for (int i = 0; i < 16; i += 2) {
          const float e0 = fast_exp2(S[m][k2][i]), e1 = fast_exp2(S[m][k2][i + 1]);
          S[m][k2][i] = e0; S[m][k2][i + 1] = e1; ps2 += (f32x2){e0, e1};
        }
      lsum[m] += ps2.x + ps2.y;
      } else lsum[m] += 1.0f;
#pragma unroll
      for (int kst = 0; kst < 4; ++kst) {
        const bf16x8 pf = pack8(S[m][kst >> 1], kst & 1);
#pragma unroll
        for (int dvt = 0; dvt < 2; ++dvt) O[m][dvt] = MFMA32(vf[kst][dvt], pf, O[m][dvt]);
      }
    }
  };
  int kt = 0;
#pragma unroll 1
  while (kt < nt) {
    tile(kt, TrueC{}, TrueC{});
    ++kt;
    bool nz = false;
#pragma unroll
    for (int m = 0; m < NMAP; ++m) nz = nz || (mref[m] != 0.0f);
    if (!wave_any(nz)) {
      const int k8 = (kt + 7) & ~7, kend = k8 < nt ? k8 : nt;
#pragma unroll 1
      for (; kt < kend; ++kt) tile(kt, FalseC{}, FalseC{});
    }
  }
  __syncthreads();
#pragma unroll
  for (int m = 0; m < NMAP; ++m) lsum[m] = xor_sum<32>(lsum[m]);
}
constexpr int ATT_QB = TK / 128;
constexpr int ATT_LDS = 2 * AttnCfg<96>::STAGE;
constexpr int ATT_QBL = TL / 128, ATT_QBC = TC / 128, ATT_LAT_UNITS = NB * 4 * ATT_QBL, ATT_UNITS = ATT_LAT_UNITS + NB * 4 * ATT_QBC;
DI void att_unit(int u, int& bh, int& qb) {
  if (u < ATT_LAT_UNITS) { bh = u & 7; qb = ATT_QBC + (u >> 3); } else { const int v = u - ATT_LAT_UNITS; bh = v & 7; qb = v >> 3; }
}
DI void ph_attn_diff(const Params& p, int layer, int need_ctx, char* lds, int bid, int nblk) {
  const int lane = TIDX & 63, wid = TIDX >> 6, l31 = lane & 31, hh = lane >> 5;
  float lam_init; const float lam = lam_of(p, layer, lam_init);
#pragma unroll 1
  for (int u = bid; u < (need_ctx ? ATT_UNITS : ATT_LAT_UNITS); u += nblk) {
    int bh, qb; att_unit(u, bh, qb);
    const int b = bh >> 2, h = bh & 3, q0 = qb * 128;
    const int r = row_of(b, q0 + wid * 32 + l31);
    f32x16 O[2][2]; float ls[2];
    attn_unit<64, 2>(p.Qd + ((size_t)b * 8 + h * 2) * TK * 32, p.Kd + ((size_t)b * 8 + h * 2) * TK * 32, (size_t)TK * 32, p.Vtd + ((size_t)b * 4 + h) * 64 * TK, q0,
                     q0 < TC ? TC : TK, O, ls, lds);
    const float i0 = 1.0f / ls[0], i1 = lam / ls[1];
    float ss = 0.f;
#pragma unroll
    for (int dvt = 0; dvt < 2; ++dvt)
#pragma unroll
      for (int i = 0; i < 16; ++i) { const float o = O[0][dvt][i] * i0 - O[1][dvt][i] * i1; O[0][dvt][i] = o; ss += o * o; }
    ss = xor_sum<32>(ss);
    const float rstd = (1.0f - lam_init) / sqrtf(ss * (1.0f / 64) + 1e-6f);
    const float* gd = p.g_diff_out + layer * 256 + h * 64;
#pragma unroll
    for (int dvt = 0; dvt < 2; ++dvt)
#pragma unroll
      for (int g = 0; g < 4; ++g) {
        const int dv = dvt * 32 + 8 * g + 4 * hh;
        const f32x4 gv = *(const f32x4*)(gd + dv);
        f32x4 o = {O[0][dvt][4 * g] * rstd * gv[0], O[0][dvt][4 * g + 1] * rstd * gv[1], O[0][dvt][4 * g + 2] * rstd * gv[2], O[0][dvt][4 * g + 3] * rstd * gv[3]};
        st_bf16x4(p.Y + (size_t)r * D + 768 + h * 64 + dv, o);
      }
  }
}
DI void ph_attn_mla(const Params& p, int need_ctx, char* lds, int bid, int nblk) {
  const int lane = TIDX & 63, wid = TIDX >> 6, l31 = lane & 31, hh = lane >> 5;
#pragma unroll 1
  for (int u = bid; u < (need_ctx ? ATT_UNITS : ATT_LAT_UNITS); u += nblk) {
    int bh, qb; att_unit(u, bh, qb);
    const int b = bh >> 2, h = bh & 3, q0 = qb * 128;
    const int r = row_of(b, q0 + wid * 32 + l31);
    f32x16 O[1][2]; float ls[1];
    attn_unit<96, 1>(p.Qm + ((size_t)b * 4 + h) * TK * 96, p.Km + ((size_t)b * 4 + h) * TK * 96, 0, p.Vtm + ((size_t)b * 4 + h) * 64 * TK, q0, q0 < TC ? TC : TK, O, ls, lds);
    const float inv = 1.0f / ls[0];
#pragma unroll
    for (int dvt = 0; dvt < 2; ++dvt)
#pragma unroll
      for (int g = 0; g < 4; ++g) {
        f32x4 o = {O[0][dvt][4 * g] * inv, O[0][dvt][4 * g + 1] * inv, O[0][dvt][4 * g + 2] * inv, O[0][dvt][4 * g + 3] * inv};
        st_bf16x4(p.Y + (size_t)r * D + h * 64 + dvt * 32 + 8 * g + 4 * hh, o);
      }
  }
}
template <int VAR> DI void ph_attn_mla_probe(const Params& p, char* lds, int bid, int nblk) {
  const int lane = TIDX & 63, wid = TIDX >> 6, l31 = lane & 31, hh = lane >> 5;
#pragma unroll 1
  for (int u = bid; u < ATT_LAT_UNITS; u += nblk) {
    int bh, qb; att_unit(u, bh, qb);
    const int b = bh >> 2, h = bh & 3, q0 = qb * 128;
    const int r = row_of(b, q0 + wid * 32 + l31);
    f32x16 O[1][2]; float ls[1];
    attn_unit<96, 1, VAR>(p.Qm + ((size_t)b * 4 + h) * TK * 96, p.Km + ((size_t)b * 4 + h) * TK * 96, 0, p.Vtm + ((size_t)b * 4 + h) * 64 * TK, q0, TK, O, ls, lds);
    const float inv = 1.0f / ls[0];
#pragma unroll
    for (int dvt = 0; dvt < 2; ++dvt)
#pragma unroll
      for (int g = 0; g < 4; ++g) {
        f32x4 o = {O[0][dvt][4 * g] * inv, O[0][dvt][4 * g + 1] * inv, O[0][dvt][4 * g + 2] * inv, O[0][dvt][4 * g + 3] * inv};
        *(f32x4*)(p.out + (size_t)r * D + h * 64 + dvt * 32 + 8 * g + 4 * hh) = o;
      }
  }
}
DI void ph_attn(const Params& p, int layer, int need_ctx, char* lds, int bid, int nblk) {
  ph_attn_diff(p, layer, need_ctx, lds, bid, nblk);
  ph_attn_mla(p, need_ctx, lds, bid, nblk);
}

DI float wave_sum(float v) {
  v = xor_sum<1>(v); v = xor_sum<2>(v); v = xor_sum<4>(v); v = xor_sum<8>(v); v = xor_sum<16>(v); v = xor_sum<32>(v);
  return v;
}
DI void ld_row16(const float* row, int lane, f32x4 (&v)[4]) {
#pragma unroll
  for (int i = 0; i < 4; ++i) v[i] = *(const f32x4*)(row + 256 * i + 4 * lane);
}
DI void ld_row16_bf(const bf16_t* row, int lane, f32x4 (&v)[4]) {
#pragma unroll
  for (int i = 0; i < 4; ++i) { const u32x2 u = *(const u32x2*)(row + 256 * i + 4 * lane); v[i] = (f32x4){u2f(u.x << 16), u2f(u.x & 0xffff0000u), u2f(u.y << 16), u2f(u.y & 0xffff0000u)}; }
}
DI void ph_modulate(const Params& p, int layer, const float* xl, const float* xcx, int bid, int nblk) {
  const int lane = TIDX & 63, wid = TIDX >> 6;
  const float* g = p.g_mix_pre + layer * 1024;
  for (int r = bid * 4 + wid; r < R; r += nblk * 4) {
    const int w = r < RL ? r / TL : 2;
    const float* mb = p.mods + (size_t)(layer * 3 + w) * 6144;
    const float* x = r < RL ? xl + (size_t)r * D : xcx + (size_t)(r - RL) * D;
    f32x4 xv[4], gv[4], sc[4], sh[4];
    ld_row16(x, lane, xv); ld_row16(g, lane, gv); ld_row16(mb + 1024, lane, sc); ld_row16(mb, lane, sh);
    float ss = 0.f;
#pragma unroll
    for (int i = 0; i < 4; ++i)
#pragma unroll
      for (int e = 0; e < 4; ++e) ss += xv[i][e] * xv[i][e];
    const float rstd = 1.0f / sqrtf(wave_sum(ss) * (1.0f / D) + 1e-6f);
#pragma unroll
    for (int i = 0; i < 4; ++i) {
      f32x4 o;
#pragma unroll
      for (int e = 0; e < 4; ++e) o[e] = xv[i][e] * rstd * gv[i][e] * (1.f + sc[i][e]) + sh[i][e];
      st_bf16x4(p.H + (size_t)r * D + 256 * i + 4 * lane, o);
    }
  }
}
DI void ph_resid_mix(const Params& p, int layer, const float* xl_in, const float* xc_in, int rows, int bid, int nblk) {
  const int lane = TIDX & 63, wid = TIDX >> 6;
  const float* wr = p.w_router + (size_t)layer * D * 16;
  for (int r = bid * 4 + wid; r < rows; r += nblk * 4) {
    const int w = r < RL ? r / TL : 2;
    const float* mb = p.mods + (size_t)(layer * 3 + w) * 6144;
    const float* xin = r < RL ? xl_in + (size_t)r * D : xc_in + (size_t)(r - RL) * D;
    float* xo = r < RL ? p.out + (size_t)r * D : p.xc + (size_t)(r - RL) * D;
    f32x4 yv[4], xv[4], a[4], c[4];
    ld_row16_bf(p.YO + (size_t)r * D, lane, yv); ld_row16(xin, lane, xv);
    float ss = 0.f;
#pragma unroll
    for (int i = 0; i < 4; ++i)
#pragma unroll
      for (int e = 0; e < 4; ++e) ss += yv[i][e] * yv[i][e];
    const float rstd = 1.0f / sqrtf(wave_sum(ss) * (1.0f / D) + 1e-6f);
    ld_row16(mb + 2 * 1024, lane, a); ld_row16(p.g_mix_post + layer * 1024, lane, c);
    float s2 = 0.f;
#pragma unroll
    for (int i = 0; i < 4; ++i) {
#pragma unroll
      for (int e = 0; e < 4; ++e) { xv[i][e] += a[i][e] * yv[i][e] * rstd * c[i][e]; s2 += xv[i][e] * xv[i][e]; }
      *(f32x4*)(xo + 256 * i + 4 * lane) = xv[i];
    }
    const float rstd2 = 1.0f / sqrtf(wave_sum(s2) * (1.0f / D) + 1e-6f);
    ld_row16(p.g_ffn_pre + layer * 1024, lane, a); ld_row16(mb + 4 * 1024, lane, c); ld_row16(mb + 3 * 1024, lane, yv);
    float lg[16];
#pragma unroll
    for (int e = 0; e < 16; ++e) lg[e] = 0.f;
#pragma unroll
    for (int i = 0; i < 4; ++i) {
      f32x4 h2;
#pragma unroll
      for (int e = 0; e < 4; ++e) h2[e] = xv[i][e] * rstd2 * a[i][e] * (1.f + c[i][e]) + yv[i][e];
      st_bf16x4(p.H + (size_t)r * D + 256 * i + 4 * lane, h2);
#pragma unroll
      for (int e = 0; e < 4; ++e) {
        const float* wk = wr + (size_t)(256 * i + 4 * lane + e) * 16;
#pragma unroll
        for (int q = 0; q < 4; ++q) { const f32x4 wv = *(const f32x4*)(wk + 4 * q); lg[4 * q] += h2[e] * wv[0]; lg[4 * q + 1] += h2[e] * wv[1]; lg[4 * q + 2] += h2[e] * wv[2]; lg[4 * q + 3] += h2[e] * wv[3]; }
      }
    }
#pragma unroll
    for (int e = 0; e < 16; ++e) lg[e] = wave_sum(lg[e]);
    float mx = lg[0];
#pragma unroll
    for (int e = 1; e < 16; ++e) mx = fmaxf(mx, lg[e]);
    float sm = 0.f;
#pragma unroll
    for (int e = 0; e < 16; ++e) { lg[e] = expf(lg[e] - mx); sm += lg[e]; }
    int b, s; bs_of(r, b, s);
    float mine = 0.f;
#pragma unroll
    for (int e = 0; e < 16; ++e) mine = (lane == e) ? lg[e] / sm : mine;
    if (lane < 16) p.AFF[((size_t)b * NE + lane) * TK + s] = mine;
  }
}
DI void ph_resid_ffn(const Params& p, int layer, int rows, int bid, int nblk) {
  const int lane = TIDX & 63, wid = TIDX >> 6;
  for (int r = bid * 4 + wid; r < rows; r += nblk * 4) {
    const int w = r < RL ? r / TL : 2;
    const float* mb = p.mods + (size_t)(layer * 3 + w) * 6144;
    float* xo = r < RL ? p.out + (size_t)r * D : p.xc + (size_t)(r - RL) * D;
    const int myinv = lane < NE ? p.INV[(size_t)r * NE + lane] : -1;
    f32x4 f[4];
#pragma unroll
    for (int i = 0; i < 4; ++i) f[i] = (f32x4){0.f, 0.f, 0.f, 0.f};
    for (int e = 0; e < NE; ++e) {
      const int sl = lane_bcast(myinv, e);
      if (sl >= 0) { f32x4 yv[4]; ld_row16_bf(p.YE + ((size_t)e * NSLOT + sl) * D, lane, yv);
#pragma unroll
        for (int i = 0; i < 4; ++i) f[i] += yv[i]; }
    }
    float ss = 0.f;
#pragma unroll
    for (int i = 0; i < 4; ++i)
#pragma unroll
      for (int e = 0; e < 4; ++e) ss += f[i][e] * f[i][e];
    const float rstd = 1.0f / sqrtf(wave_sum(ss) * (1.0f / D) + 1e-6f);
    f32x4 a[4], c[4], xv[4];
    ld_row16(mb + 5 * 1024, lane, a); ld_row16(p.g_ffn_post + layer * 1024, lane, c); ld_row16(xo, lane, xv);
#pragma unroll
    for (int i = 0; i < 4; ++i) {
#pragma unroll
      for (int e = 0; e < 4; ++e) xv[i][e] += a[i][e] * f[i][e] * rstd * c[i][e];
      *(f32x4*)(xo + 256 * i + 4 * lane) = xv[i];
    }
  }
}
DI void ph_mods(const Params& p, char* lds, int bid, int nblk) {
  float* sc = (float*)lds;
  const int t = TIDX;
  for (int i = t; i < 3 * 1024; i += NTHR) { const float v = i < 2048 ? p.c[i] : p.c_ctx[i - 2048]; sc[i] = v / (1.0f + expf(-v)); }
  __syncthreads();
#pragma unroll 1
  for (long gi = (long)bid * NTHR + t; gi < 2 * 3 * 6144; gi += (long)nblk * NTHR) {
    const int col = (int)(gi % 6144), w = (int)((gi / 6144) % 3), l = (int)(gi / (3 * 6144));
    const float* W = p.w_ada + (size_t)l * 1024 * 6144 + col; const float* s = sc + w * 1024;
    float acc[8];
#pragma unroll
    for (int q = 0; q < 8; ++q) acc[q] = 0.f;
#pragma unroll 1
    for (int k = 0; k < 1024; k += 8) {
#pragma unroll
      for (int q = 0; q < 8; ++q) acc[q] += s[k + q] * W[(size_t)(k + q) * 6144];
    }
    p.mods[gi] = ((acc[0] + acc[1]) + (acc[2] + acc[3])) + ((acc[4] + acc[5]) + (acc[6] + acc[7])) + p.b_ada[l * 6144 + col];
  }
  __syncthreads();
}
constexpr int TOPK_LDS = TL * 4 + 2048;
DI int block_sum_i(int v, int* red) {
  const int lane = TIDX & 63, wid = TIDX >> 6;
  v = xor_sum_i<1>(v); v = xor_sum_i<2>(v); v = xor_sum_i<4>(v); v = xor_sum_i<8>(v); v = xor_sum_i<16>(v); v = xor_sum_i<32>(v);
  __syncthreads();
  if (lane == 0) red[wid] = v;
  __syncthreads();
  return red[0] + red[1] + red[2] + red[3];
}
DI int block_excl_scan(int v, int* red) {
  const int lane = TIDX & 63, wid = TIDX >> 6;
  int inc = v;
#pragma unroll
  for (int d = 1; d < 64; d <<= 1) { const int o = lane_up(inc, d, lane); if (lane >= d) inc += o; }
  __syncthreads();
  if (lane == 63) red[wid] = inc;
  __syncthreads();
  int base = 0;
  for (int q = 0; q < wid; ++q) base += red[q];
  return base + inc - v;
}
DI void ph_topk(const Params& p, int need_ctx, char* lds, int bid, int nblk) {
  unsigned* vals = (unsigned*)lds; int* red = (int*)(lds + TL * 4 + 1024);
  const int t = TIDX;
  for (int u = bid; u < NB * NE * 2; u += nblk) {
    const int seg = u & 1, e = (u >> 1) % NE, b = u / (2 * NE);
    const int s0 = seg ? TC : 0, n = seg ? TL : TC, cap = seg ? CAPL : CAPC, slot0 = seg ? b * CAPL : NB * CAPL + b * CAPC;
    if (seg == 0 && !need_ctx) { for (int q = t; q < cap; q += NTHR) p.SEL[(size_t)e * NSLOT + slot0 + q] = -1; continue; }
    const float* a = p.AFF + ((size_t)b * NE + e) * TK + s0;
    const int vpt = (n + NTHR - 1) / NTHR, i0 = t * vpt, i1 = (i0 + vpt < n) ? i0 + vpt : n;
    for (int i = t; i < n; i += NTHR) vals[i + i / vpt] = f2u(a[i]);
    __syncthreads();
    unsigned thr = 0;
    for (int bit = 31; bit >= 0; --bit) {
      const unsigned cand = thr | (1u << bit);
      int cnt = 0;
      for (int i = i0; i < i1; ++i) cnt += (vals[i + t] >= cand);
      if (block_sum_i(cnt, red) >= cap) thr = cand;
    }
    int cgt = 0, ceq = 0;
    for (int i = i0; i < i1; ++i) { cgt += (vals[i + t] > thr); ceq += (vals[i + t] == thr); }
    const int ngt = block_sum_i(cgt, red);
    const int neq = cap - ngt;
    int eqoff = block_excl_scan(ceq, red);
    int csel = 0;
    { int er = eqoff; for (int i = i0; i < i1; ++i) { if (vals[i + t] > thr) ++csel; else if (vals[i + t] == thr) { if (er < neq) ++csel; ++er; } } }
    int q = block_excl_scan(csel, red);
    for (int i = i0; i < i1; ++i) {
      const unsigned v = vals[i + t]; int sel = -1;
      if (v > thr) sel = q++; else if (v == thr) { if (eqoff < neq) sel = q++; ++eqoff; }
      const int r = row_of(b, s0 + i);
      if (sel >= 0) { p.SEL[(size_t)e * NSLOT + slot0 + sel] = r; p.SELV[(size_t)e * NSLOT + slot0 + sel] = u2f(v); }
      p.INV[(size_t)r * NE + e] = sel >= 0 ? slot0 + sel : -1;
    }
    __syncthreads();
  }
}
DI void ph_wt(const float* in, bf16_t* out, int K, int N, int NP, int nbatch, long in_bs, long out_bs, const float* gain, char* lds, int bid, int nblk) {
  float* tile = (float*)lds;
  const int t = TIDX, tk = K / 64, tn = NP / 64, ntile = nbatch * tk * tn;
  f32x4 v[4];
  auto gload = [&](int u) {
    const int bt = u / (tk * tn), rem = u % (tk * tn), k0 = (rem / tn) * 64, n0 = (rem % tn) * 64;
    const float* I = in + (size_t)bt * in_bs;
#pragma unroll
    for (int i = 0; i < 4; ++i) {
      const int idx = t + i * NTHR, kk = idx >> 4, n4 = (idx & 15) * 4;
      v[i] = (f32x4){0.f, 0.f, 0.f, 0.f};
      if (n0 + n4 < N) v[i] = *(const f32x4*)(I + (size_t)(k0 + kk) * N + n0 + n4);
      if (gain) { const float g = gain[k0 + kk]; v[i][0] *= g; v[i][1] *= g; v[i][2] *= g; v[i][3] *= g; }
    }
  };
  if (bid < ntile) gload(bid);
#pragma unroll 1
  for (int u = bid; u < ntile; u += nblk) {
    const int bt = u / (tk * tn), rem = u % (tk * tn), k0 = (rem / tn) * 64, n0 = (rem % tn) * 64;
    bf16_t* O = out + (size_t)bt * out_bs;
#pragma unroll
    for (int i = 0; i < 4; ++i) { const int idx = t + i * NTHR, kk = idx >> 4, n4 = (idx & 15) * 4; float* d = tile + kk * 65 + n4; d[0] = v[i][0]; d[1] = v[i][1]; d[2] = v[i][2]; d[3] = v[i][3]; }
    __syncthreads();
    if (u + nblk < ntile) gload(u + nblk);
#pragma unroll
    for (int i = 0; i < 2; ++i) {
      const int idx = t + i * NTHR, kg = idx & 7, nn = idx >> 3;
      float a[8];
#pragma unroll
      for (int e = 0; e < 8; ++e) a[e] = tile[(kg * 8 + e) * 65 + nn];
      u32x4 o; o.x = pack2bf(a[0], a[1]); o.y = pack2bf(a[2], a[3]); o.z = pack2bf(a[4], a[5]); o.w = pack2bf(a[6], a[7]);
      *(u32x4*)(O + (size_t)(n0 + nn) * K + k0 + kg * 8) = o;
    }
    __syncthreads();
  }
}
DI float wave_max(float v) {
  v = xor_max<1>(v); v = xor_max<2>(v); v = xor_max<4>(v); v = xor_max<8>(v); v = xor_max<16>(v); v = xor_max<32>(v);
  return v;
}
DI bf16x8 cvt8(const float* f) {
  const f32x4 a = *(const f32x4*)f, b = *(const f32x4*)(f + 4);
  u32x4 pk; pk.x = pack2bf(a[0], a[1]); pk.y = pack2bf(a[2], a[3]); pk.z = pack2bf(b[0], b[1]); pk.w = pack2bf(b[2], b[3]);
  return __builtin_bit_cast(bf16x8, pk);
}
constexpr int SCAN_UNITS = NB * NCK * 4, SCAN_LAT_UNITS = NB * NCL * 4;
DI void scan_unit(int u, int& b, int& c, int& h) {
  h = u & 3;
  if (u < SCAN_LAT_UNITS) { c = NCC + (u >> 2) % NCL; b = u / (4 * NCL); } else { const int v = u - SCAN_LAT_UNITS; c = (v >> 2) % NCC; b = v / (4 * NCC); }
}

DI void ph_ml_local(const Params& p, char* lds, int bid, int nblk) {
  bf16_t* sK = (bf16_t*)lds;
  float* sW = (float*)(lds + 64 * 132);
  const int t = TIDX, lane = t & 63, wid = t >> 6, l31 = lane & 31, hh = lane >> 5;
  const int d = wid & 1, vt = wid >> 1;
#pragma unroll 1
  for (int u = bid; u < SCAN_UNITS; u += nblk) {
    int b, c, h; scan_unit(u, b, c, h);
    {
      const int row = t >> 2, seg = (t & 3) * 16;
      const bf16_t* src = p.MK + ((size_t)b * TK + 64 * c + row) * 256 + h * 64 + seg;
      const u32x4 a = ldg16(src), bb = ldg16(src + 8);
      unsigned* dst = (unsigned*)((char*)sK + row * 132 + seg * 2);
      dst[0] = a.x; dst[1] = a.y; dst[2] = a.z; dst[3] = a.w; dst[4] = bb.x; dst[5] = bb.y; dst[6] = bb.z; dst[7] = bb.w;
    }
    if (t < 128) {
      const int dd = t >> 6, l = t & 63, j = step_of(dd, c), pos = dd ? 63 - l : l;
      const size_t o = (((size_t)b * 2 + dd) * TK + 64 * j) * 4 + h;
      const float bend = p.BC[o + 63 * 4], wl = bend - p.BC[o + pos * 4] + p.IGS[o + pos * 4];
      const float ml = wave_max(wl);
      sW[dd * 64 + l] = expf(wl - ml);
      if (l == 0) { const size_t uu = (((size_t)b * 2 + dd) * NCK + j) * 4 + h; p.MM[uu * 4] = ml; p.MM[uu * 4 + 1] = bend; }
    }
    __syncthreads();
    const int j = step_of(d, c);
    const size_t uu = (((size_t)b * 2 + d) * NCK + j) * 4 + h;
    f32x16 acc[2]; acc[0] = (f32x16)(0.f); acc[1] = (f32x16)(0.f);
    const bf16_t* vsrc = p.MVt + (((size_t)b * 4 + h) * 64 + vt * 32 + l31) * TK + 64 * c;
#pragma unroll
    for (int ks = 0; ks < 4; ++ks) {
      const bf16x8 a = *(const bf16x8*)(vsrc + ks * 16 + 8 * hh);
      const float* w = sW + d * 64 + ks * 16 + 8 * hh;
      u32x4 pk;
      pk.x = pack2bf(bf2f((bf16_t)a[0]) * w[0], bf2f((bf16_t)a[1]) * w[1]); pk.y = pack2bf(bf2f((bf16_t)a[2]) * w[2], bf2f((bf16_t)a[3]) * w[3]);
      pk.z = pack2bf(bf2f((bf16_t)a[4]) * w[4], bf2f((bf16_t)a[5]) * w[5]); pk.w = pack2bf(bf2f((bf16_t)a[6]) * w[6], bf2f((bf16_t)a[7]) * w[7]);
      const bf16x8 af = __builtin_bit_cast(bf16x8, pk);
#pragma unroll
      for (int kt = 0; kt < 2; ++kt) {
        bf16x8 bfr;
#pragma unroll
        for (int q = 0; q < 8; ++q) bfr[q] = (short)sK[(ks * 16 + 8 * hh + q) * 66 + kt * 32 + l31];
        acc[kt] = MFMA32(af, bfr, acc[kt]);
      }
    }
#pragma unroll
    for (int kt = 0; kt < 2; ++kt)
#pragma unroll
      for (int i = 0; i < 16; ++i) p.MC[uu * 4096 + (size_t)(vt * 32 + (i & 3) + 8 * (i >> 2) + 4 * hh) * 64 + kt * 32 + l31] = acc[kt][i];
    float nl = 0.f;
    for (int q = 0; q < 32; ++q) { const int l = hh * 32 + q; nl += sW[d * 64 + l] * bf2f(sK[l * 66 + vt * 32 + l31]); }
    nl = xor_sum<32>(nl);
    if (hh == 0) p.MN[uu * 64 + vt * 32 + l31] = nl;
    __syncthreads();
  }
}
DI void ph_ml_scan(const Params& p, int bid, int nblk) {
  for (long gi = (long)bid * NTHR + TIDX; gi < (long)NB * 2 * 4 * 4160; gi += (long)nblk * NTHR) {
    const int e = (int)(gi % 4160), ch = (int)(gi / 4160), h = ch & 3, bd = ch >> 2;
    float* base = e < 4096 ? p.MC + (((size_t)bd * NCK) * 4 + h) * 4096 + e : p.MN + (((size_t)bd * NCK) * 4 + h) * 64 + (e - 4096);
    const size_t stride = e < 4096 ? 4 * 4096 : 4 * 64;
    float* mm = p.MM + (((size_t)bd * NCK) * 4 + h) * 4;
    float st = 0.f, m = -1e30f;
    float cl[8], cm[8], cb[8], nl[8], nm[8], nb[8];
#pragma unroll
    for (int q = 0; q < 8; ++q) { cl[q] = base[(size_t)q * stride]; cm[q] = mm[q * 16]; cb[q] = mm[q * 16 + 1]; }
#pragma unroll 1
    for (int jb = 0; jb < NCK; jb += 8) {
#pragma unroll
      for (int q = 0; q < 8; ++q) { const int j = jb + 8 + q; if (j < NCK) { nl[q] = base[(size_t)j * stride]; nm[q] = mm[j * 16]; nb[q] = mm[j * 16 + 1]; } }
#pragma unroll
      for (int q = 0; q < 8; ++q) {
        const int j = jb + q;
        if (j < NCK) {
          const float mn = fmaxf(cb[q] + m, cm[q]), a = expf(cb[q] + m - mn), g = expf(cm[q] - mn);
          base[(size_t)j * stride] = st;
          st = a * st + g * cl[q];
          if (e == 0) mm[j * 16 + 2] = m;
          m = mn;
        }
      }
#pragma unroll
      for (int q = 0; q < 8; ++q) { cl[q] = nl[q]; cm[q] = nm[q]; cb[q] = nb[q]; }
    }
  }
}
DI void ph_gla_scan(const Params& p, int bid, int nblk) {
  for (long gi = (long)bid * NTHR + TIDX; gi < (long)NB * 2 * 4 * 2048; gi += (long)nblk * NTHR) {
    const int e = (int)(gi % 2048), ch = (int)(gi / 2048), h = ch & 3, bd = ch >> 2, k = e & 31;
    float* base = p.GS + (((size_t)bd * NCK) * 4 + h) * 2048 + e;
    const float* ge = p.GC + ((size_t)bd * TK + 63) * 128 + h * 32 + k;
    float st = 0.f;
    float cl[8], cg[8], nl[8], ng[8];
#pragma unroll
    for (int q = 0; q < 8; ++q) { cl[q] = base[(size_t)q * 4 * 2048]; cg[q] = ge[(size_t)q * 64 * 128]; }
#pragma unroll 1
    for (int jb = 0; jb < NCK; jb += 8) {
#pragma unroll
      for (int q = 0; q < 8; ++q) { const int j = jb + 8 + q; if (j < NCK) { nl[q] = base[(size_t)j * 4 * 2048]; ng[q] = ge[(size_t)j * 64 * 128]; } }
#pragma unroll
      for (int q = 0; q < 8; ++q) {
        const int j = jb + q;
        if (j < NCK) { base[(size_t)j * 4 * 2048] = st; st = expf(cg[q]) * st + cl[q]; }
      }
#pragma unroll
      for (int q = 0; q < 8; ++q) { cl[q] = nl[q]; cg[q] = ng[q]; }
    }
  }
}
constexpr int MO_K = 0, MO_V = 64 * 144, MO_A = MO_V + 64 * VROW, MO_PM = MO_A + 512, MO_N0 = MO_PM + 512, MO_X = MO_N0 + 512, MO_LDS = MO_X + 16384;
DI void ph_ml_out(const Params& p, int layer, int need_ctx, char* lds, int bid, int nblk) {
  float* sA = (float*)(lds + MO_A); float* sPM = (float*)(lds + MO_PM); float* sN0 = (float*)(lds + MO_N0); float* sX = (float*)(lds + MO_X);
  const int t = TIDX, lane = t & 63, wid = t >> 6, l31 = lane & 31, hh = lane >> 5;
  const int lt = wid & 1, d = wid >> 1;
#pragma unroll 1
  for (int u = bid; u < (need_ctx ? SCAN_UNITS : SCAN_LAT_UNITS); u += nblk) {
    int b, c, h; scan_unit(u, b, c, h);
    {
      const int row = t >> 2, seg = (t & 3) * 16;
      const bf16_t* ks = p.MK + ((size_t)b * TK + 64 * c + row) * 256 + h * 64 + seg;
      sts16(lds + MO_K + row * 144 + seg * 2, ldg16(ks)); sts16(lds + MO_K + row * 144 + seg * 2 + 16, ldg16(ks + 8));
      const bf16_t* vs = p.MVt + (((size_t)b * 4 + h) * 64 + row) * TK + 64 * c + seg;
      const u32x4 v0 = ldg16(vs), v1 = ldg16(vs + 8);
      u32x2* dv = (u32x2*)(lds + MO_V + row * VROW + seg * 2);
      u32x2 q; q.x = v0.x; q.y = v0.y; dv[0] = q; q.x = v0.z; q.y = v0.w; dv[1] = q; q.x = v1.x; q.y = v1.y; dv[2] = q; q.x = v1.z; q.y = v1.w; dv[3] = q;
    }
    if (t < 128) {
      const int dd = t >> 6, s = t & 63, j = step_of(dd, c), pos = dd ? 63 - s : s;
      const size_t o = (((size_t)b * 2 + dd) * TK + 64 * j) * 4 + h;
      sA[dd * 64 + s] = p.IGS[o + pos * 4] - p.BC[o + pos * 4];
      const size_t uu = (((size_t)b * 2 + dd) * NCK + j) * 4 + h;
      sN0[dd * 64 + s] = p.MN[uu * 64 + s];
    }
    __syncthreads();
    if (t < 2) {
      float m = -1e30f;
      if (t == 0) { for (int s = 0; s < 64; ++s) { m = fmaxf(m, sA[s]); sPM[s] = m; } }
      else { for (int s = 63; s >= 0; --s) { m = fmaxf(m, sA[64 + s]); sPM[64 + s] = m; } }
    }
    __syncthreads();
    const int j = step_of(d, c);
    const size_t uu = (((size_t)b * 2 + d) * NCK + j) * 4 + h;
    const int l = lt * 32 + l31, pos = d ? 63 - l : l;
    const float bl = p.BC[(((size_t)b * 2 + d) * TK + 64 * j + pos) * 4 + h];
    const float inter = bl + p.MM[uu * 4 + 2];
    const float mt = fmaxf(inter, bl + sPM[d * 64 + l]);
    const float aint = expf(inter - mt);
    bf16x8 qf[4];
#pragma unroll
    for (int ks = 0; ks < 4; ++ks) qf[ks] = *(const bf16x8*)(p.MQ + ((size_t)b * TK + 64 * c + l) * 256 + h * 64 + ks * 16 + 8 * hh);
    f32x16 num[2]; num[0] = (f32x16)(0.f); num[1] = (f32x16)(0.f);
    float den = 0.f;
#pragma unroll
    for (int st = 0; st < 2; ++st) {
      if (d == 0 ? st <= lt : st >= lt) {
        f32x16 S = (f32x16)(0.f);
#pragma unroll
        for (int ks = 0; ks < 4; ++ks) S = MFMA32(lds_frag(lds + MO_K + (st * 32 + l31) * 144 + (ks * 16 + 8 * hh) * 2), qf[ks], S);
#pragma unroll
        for (int i = 0; i < 16; ++i) {
          const int s = st * 32 + (i & 3) + 8 * (i >> 2) + 4 * hh;
          const bool ok = d == 0 ? s <= l : s >= l;
          const float e = ok ? fast_exp2((bl + sA[d * 64 + s] - mt) * LOG2E) * S[i] : 0.f;
          S[i] = e; den += e;
        }
#pragma unroll
        for (int kst = 0; kst < 2; ++kst) {
          const bf16x8 pf = pack8(S, kst);
#pragma unroll
          for (int vt = 0; vt < 2; ++vt) {
            const char* vp = lds + MO_V + (vt * 32 + l31) * VROW + (st * 32 + kst * 16 + 4 * hh) * 2;
            const s16x4 lo = *(const s16x4*)vp, hi = *(const s16x4*)(vp + 16);
            num[vt] = MFMA32(__builtin_shufflevector(lo, hi, 0, 1, 2, 3, 4, 5, 6, 7), pf, num[vt]);
          }
        }
      }
    }
    f32x16 accI[2]; accI[0] = (f32x16)(0.f); accI[1] = (f32x16)(0.f);
#pragma unroll
    for (int vt = 0; vt < 2; ++vt)
#pragma unroll
      for (int ks = 0; ks < 4; ++ks) accI[vt] = MFMA32(cvt8(p.MC + uu * 4096 + (size_t)(vt * 32 + l31) * 64 + ks * 16 + 8 * hh), qf[ks], accI[vt]);
    float qn = 0.f;
#pragma unroll
    for (int ks = 0; ks < 4; ++ks)
#pragma unroll
      for (int q = 0; q < 8; ++q) qn += bf2f((bf16_t)qf[ks][q]) * sN0[d * 64 + ks * 16 + 8 * hh + q];
    den = xor_sum<32>(den + aint * qn);
    const float inv = 1.0f / fmaxf(fabsf(den), expf(-mt));
#pragma unroll
    for (int vt = 0; vt < 2; ++vt)
#pragma unroll
      for (int i = 0; i < 16; ++i) num[vt][i] = (num[vt][i] + aint * accI[vt][i]) * inv;
    if (d == 1) {
#pragma unroll
      for (int vt = 0; vt < 2; ++vt)
#pragma unroll
        for (int i = 0; i < 16; ++i) sX[(lt * 32 + vt * 16 + i) * 64 + lane] = num[vt][i];
    }
    __syncthreads();
    if (d == 0) {
      float ss = 0.f;
#pragma unroll
      for (int vt = 0; vt < 2; ++vt)
#pragma unroll
        for (int i = 0; i < 16; ++i) { num[vt][i] += sX[(lt * 32 + vt * 16 + i) * 64 + lane]; ss += num[vt][i] * num[vt][i]; }
      ss = xor_sum<32>(ss);
      const float rstd = 1.0f / sqrtf(ss * (1.0f / 64) + 1e-6f);
      const int r = row_of(b, 64 * c + l);
#pragma unroll
      for (int vt = 0; vt < 2; ++vt)
#pragma unroll
        for (int g = 0; g < 4; ++g) {
          const int v0 = vt * 32 + 8 * g + 4 * hh;
          const u32x2 ou = *(const u32x2*)(p.Z + (size_t)r * NZP + ZC_MLO + h * 64 + v0);
          const f32x4 gv = *(const f32x4*)(p.g_mlstm_out + layer * 256 + h * 64 + v0);
          const float o0 = u2f(ou.x << 16), o1 = u2f(ou.x & 0xffff0000u), o2 = u2f(ou.y << 16), o3 = u2f(ou.y & 0xffff0000u);
          f32x4 y = {sigmoidf_(o0) * num[vt][4 * g] * rstd * gv[0], sigmoidf_(o1) * num[vt][4 * g + 1] * rstd * gv[1],
                     sigmoidf_(o2) * num[vt][4 * g + 2] * rstd * gv[2], sigmoidf_(o3) * num[vt][4 * g + 3] * rstd * gv[3]};
          st_bf16x4(p.Y + (size_t)r * D + 256 + h * 64 + v0, y);
        }
    }
    __syncthreads();
  }
}
DI void ph_gla_local(const Params& p, char* lds, int bid, int nblk) {
  bf16_t* sKd = (bf16_t*)lds;
  const int t = TIDX, lane = t & 63, wid = t >> 6, l31 = lane & 31, hh = lane >> 5;
  const int d = wid & 1, vt = wid >> 1;
#pragma unroll 1
  for (int u = bid; u < SCAN_UNITS; u += nblk) {
    int b, c, h; scan_unit(u, b, c, h);
    {
      const int dd = t >> 7, l = (t >> 1) & 63, k0 = (t & 1) * 16, j = step_of(dd, c), pos = dd ? 63 - l : l;
      const float* gcr = p.GC + (((size_t)b * 2 + dd) * TK + 64 * j + pos) * 128 + h * 32 + k0;
      const float* ger = p.GC + (((size_t)b * 2 + dd) * TK + 64 * j + 63) * 128 + h * 32 + k0;
      const bf16_t* kr = p.Z + (size_t)row_of(b, 64 * c + l) * NZP + ZC_GK + h * 32 + k0;
#pragma unroll
      for (int q = 0; q < 16; ++q) sKd[(dd * 64 + l) * 33 + k0 + q] = f2bf(bf2f(kr[q]) * fast_exp2((ger[q] - gcr[q]) * LOG2E));
    }
    __syncthreads();
    const int j = step_of(d, c);
    const size_t uu = (((size_t)b * 2 + d) * NCK + j) * 4 + h;
    f32x16 acc = (f32x16)(0.f);
    const bf16_t* vsrc = p.GVt + (((size_t)b * 4 + h) * 64 + vt * 32 + l31) * TK + 64 * c;
#pragma unroll
    for (int ks = 0; ks < 4; ++ks) {
      const bf16x8 af = *(const bf16x8*)(vsrc + ks * 16 + 8 * hh);
      bf16x8 bfr;
#pragma unroll
      for (int q = 0; q < 8; ++q) bfr[q] = (short)sKd[(d * 64 + ks * 16 + 8 * hh + q) * 33 + l31];
      acc = MFMA32(af, bfr, acc);
    }
#pragma unroll
    for (int i = 0; i < 16; ++i) p.GS[uu * 2048 + (size_t)(vt * 32 + (i & 3) + 8 * (i >> 2) + 4 * hh) * 32 + l31] = acc[i];
    __syncthreads();
  }
}
constexpr int GO_Q = 0, GO_K = 2 * 64 * 80, GO_V = 2 * GO_K, GO_X = GO_V + 64 * VROW, GO_LDS = GO_X + 16384;
DI void ph_gla_out(const Params& p, int layer, int need_ctx, char* lds, int bid, int nblk) {
  float* sX = (float*)(lds + GO_X);
  const int t = TIDX, lane = t & 63, wid = t >> 6, l31 = lane & 31, hh = lane >> 5;
  const int lt = wid & 1, d = wid >> 1;
#pragma unroll 1
  for (int u = bid; u < (need_ctx ? SCAN_UNITS : SCAN_LAT_UNITS); u += nblk) {
    int b, c, h; scan_unit(u, b, c, h);
    {
      const int dd = t >> 7, l = (t >> 1) & 63, k0 = (t & 1) * 16, j = step_of(dd, c), pos = dd ? 63 - l : l;
      const float* gcr = p.GC + (((size_t)b * 2 + dd) * TK + 64 * j + pos) * 128 + h * 32 + k0;
      const bf16_t* zr = p.Z + (size_t)row_of(b, 64 * c + l) * NZP;
      bf16_t* qd = (bf16_t*)(lds + GO_Q + (dd * 64 + l) * 80) + k0; bf16_t* kd = (bf16_t*)(lds + GO_K + (dd * 64 + l) * 80) + k0;
#pragma unroll
      for (int q = 0; q < 16; ++q) {
        const float g = gcr[q];
        qd[q] = f2bf(bf2f(zr[ZC_GQ + h * 32 + k0 + q]) * 0.17677669529663687f * fast_exp2(g * LOG2E));
        kd[q] = f2bf(bf2f(zr[ZC_GK + h * 32 + k0 + q]) * fast_exp2(-g * LOG2E));
      }
      const int row = t >> 2, seg = (t & 3) * 16;
      const bf16_t* vs = p.GVt + (((size_t)b * 4 + h) * 64 + row) * TK + 64 * c + seg;
      const u32x4 v0 = ldg16(vs), v1 = ldg16(vs + 8);
      u32x2* dv = (u32x2*)(lds + GO_V + row * VROW + seg * 2);
      u32x2 q2; q2.x = v0.x; q2.y = v0.y; dv[0] = q2; q2.x = v0.z; q2.y = v0.w; dv[1] = q2; q2.x = v1.x; q2.y = v1.y; dv[2] = q2; q2.x = v1.z; q2.y = v1.w; dv[3] = q2;
    }
    __syncthreads();
    const int j = step_of(d, c);
    const size_t uu = (((size_t)b * 2 + d) * NCK + j) * 4 + h;
    const int l = lt * 32 + l31;
    bf16x8 qf[2];
#pragma unroll
    for (int ks = 0; ks < 2; ++ks) qf[ks] = lds_frag(lds + GO_Q + (d * 64 + l) * 80 + (ks * 16 + 8 * hh) * 2);
    f32x16 O[2]; O[0] = (f32x16)(0.f); O[1] = (f32x16)(0.f);
#pragma unroll
    for (int st = 0; st < 2; ++st) {
      if (d == 0 ? st <= lt : st >= lt) {
        f32x16 S = (f32x16)(0.f);
#pragma unroll
        for (int ks = 0; ks < 2; ++ks) S = MFMA32(lds_frag(lds + GO_K + (d * 64 + st * 32 + l31) * 80 + (ks * 16 + 8 * hh) * 2), qf[ks], S);
#pragma unroll
        for (int i = 0; i < 16; ++i) {
          const int s = st * 32 + (i & 3) + 8 * (i >> 2) + 4 * hh;
          const bool ok = d == 0 ? s <= l : s >= l;
          S[i] = ok ? S[i] : 0.f;
        }
#pragma unroll
        for (int kst = 0; kst < 2; ++kst) {
          const bf16x8 pf = pack8(S, kst);
#pragma unroll
          for (int vt = 0; vt < 2; ++vt) {
            const char* vp = lds + GO_V + (vt * 32 + l31) * VROW + (st * 32 + kst * 16 + 4 * hh) * 2;
            const s16x4 lo = *(const s16x4*)vp, hi = *(const s16x4*)(vp + 16);
            O[vt] = MFMA32(__builtin_shufflevector(lo, hi, 0, 1, 2, 3, 4, 5, 6, 7), pf, O[vt]);
          }
        }
      }
    }
#pragma unroll
    for (int vt = 0; vt < 2; ++vt)
#pragma unroll
      for (int ks = 0; ks < 2; ++ks) O[vt] = MFMA32(cvt8(p.GS + uu * 2048 + (size_t)(vt * 32 + l31) * 32 + ks * 16 + 8 * hh), qf[ks], O[vt]);
    if (d == 1) {
#pragma unroll
      for (int vt = 0; vt < 2; ++vt)
#pragma unroll
        for (int i = 0; i < 16; ++i) sX[(lt * 32 + vt * 16 + i) * 64 + lane] = O[vt][i];
    }
    __syncthreads();
    if (d == 0) {
      float ss = 0.f;
#pragma unroll
      for (int vt = 0; vt < 2; ++vt)
#pragma unroll
        for (int i = 0; i < 16; ++i) { O[vt][i] += sX[(lt * 32 + vt * 16 + i) * 64 + lane]; ss += O[vt][i] * O[vt][i]; }
      ss = xor_sum<32>(ss);
      const float rstd = 1.0f / sqrtf(ss * (1.0f / 64) + 1e-6f);
      const int r = row_of(b, 64 * c + l);
#pragma unroll
      for (int vt = 0; vt < 2; ++vt)
#pragma unroll
        for (int g = 0; g < 4; ++g) {
          const int v0 = vt * 32 + 8 * g + 4 * hh;
          const u32x2 ru = *(const u32x2*)(p.Z + (size_t)r * NZP + ZC_GR + h * 64 + v0);
          const f32x4 gv = *(const f32x4*)(p.g_gla_out + layer * 256 + h * 64 + v0);
          const float r0 = u2f(ru.x << 16), r1 = u2f(ru.x & 0xffff0000u), r2 = u2f(ru.y << 16), r3 = u2f(ru.y & 0xffff0000u);
          f32x4 y = {siluf_(r0) * O[vt][4 * g] * rstd * gv[0], siluf_(r1) * O[vt][4 * g + 1] * rstd * gv[1],
                     siluf_(r2) * O[vt][4 * g + 2] * rstd * gv[2], siluf_(r3) * O[vt][4 * g + 3] * rstd * gv[3]};
          st_bf16x4(p.Y + (size_t)r * D + 512 + h * 64 + v0, y);
        }
    }
    __syncthreads();
  }
}

DI float fast_logsigmoid(float x) {
  const float e = fast_exp2(-fabsf(x) * LOG2E);
#ifdef CPU_EMU
  return fminf(x, 0.f) - log1pf(e);
#else
  return fminf(x, 0.f) - 0.6931471805599453f * __builtin_amdgcn_logf(1.0f + e);
#endif
}
DI float wave_incl_scan(float v, int lane) {
#pragma unroll
  for (int dd = 1; dd < 64; dd <<= 1) { const float o = u2f((unsigned)lane_up((int)f2u(v), dd, lane)); if (lane >= dd) v += o; }
  return v;
}
constexpr int GCUM_LDS = 4 * 64 * 33 * 4;
DI void ph_gates_cum(const Params& p, int layer, char* lds, int bid, int nblk) {
  const int t = TIDX, lane = t & 63, wid = t >> 6;
  float* stg = (float*)lds + wid * 64 * 33;
  const float* wal = p.w_alpha2 + (size_t)layer * 2 * 16 * 128;
#pragma unroll 1
  for (int u = bid * 4 + wid; u < NB * 2 * NCK; u += nblk * 4) {
    const int j = u % NCK, d = (u / NCK) & 1, b = u / (2 * NCK);
    const int pp = 64 * j + lane, s = seq_of(d, pp);
    const bf16_t* z = p.Z + (size_t)row_of(b, s) * NZP;
    const size_t ob = ((size_t)b * 2 + d) * TK + pp;
    {
      const u32x2 iu = *(const u32x2*)(z + ZC_MLIG + d * 4), fu = *(const u32x2*)(z + ZC_MLFG + d * 4);
      const float ig[4] = {u2f(iu.x << 16), u2f(iu.x & 0xffff0000u), u2f(iu.y << 16), u2f(iu.y & 0xffff0000u)};
      const float fg[4] = {u2f(fu.x << 16), u2f(fu.x & 0xffff0000u), u2f(fu.y << 16), u2f(fu.y & 0xffff0000u)};
      f32x4 oc, oi;
#pragma unroll
      for (int h = 0; h < 4; ++h) {
        oi[h] = ig[h] + p.b_igate[layer * 8 + d * 4 + h];
        oc[h] = wave_incl_scan(fast_logsigmoid(fg[h] + p.b_fgate[layer * 8 + d * 4 + h]), lane);
      }
      *(f32x4*)(p.BC + ob * 4) = oc; *(f32x4*)(p.IGS + ob * 4) = oi;
    }
    float a[16];
    { float f0[8], f1[8]; unpack8(ldg16(z + ZC_GA + d * 16), f0); unpack8(ldg16(z + ZC_GA + d * 16 + 8), f1);
#pragma unroll
      for (int q = 0; q < 8; ++q) { a[q] = f0[q]; a[8 + q] = f1[q]; } }
    const float* W = wal + (size_t)d * 16 * 128;
#pragma unroll 1
    for (int cg = 0; cg < 4; ++cg) {
#pragma unroll 4
      for (int c = 0; c < 32; ++c) {
        const int ch = cg * 32 + c;
        float zg = p.b_alpha[layer * 256 + d * 128 + ch];
#pragma unroll
        for (int q = 0; q < 16; ++q) zg += a[q] * W[q * 128 + ch];
        stg[lane * 33 + c] = wave_incl_scan(fast_logsigmoid(zg) * (1.0f / 16.0f), lane);
      }
      WAVE_SYNC();
#pragma unroll
      for (int k = 0; k < 32; ++k) { const int pos = k * 2 + (lane >> 5), c = lane & 31; p.GC[(((size_t)b * 2 + d) * TK + 64 * j + pos) * 128 + cg * 32 + c] = stg[pos * 33 + c]; }
      WAVE_SYNC();
    }
  }
}
#define XB_TMO      128
#define XB_XCNT(j)  (256  + 64 * (j))
#define XB_XSUB(j)  (1280 + 64 * (j))
#define XB_XGEN(j)  (2304 + 64 * (j))
#define XB_TOP      3328
#define XB_TOPGEN   3392
#define XCD_BAR_WORDS 3456
#define XB_SPIN_CAP (1u << 28)
#define LAS __attribute__((address_space(3)))

__device__ __forceinline__ unsigned xb_ld(unsigned* p)              { return __hip_atomic_load(p, __ATOMIC_RELAXED, __HIP_MEMORY_SCOPE_AGENT); }
__device__ __forceinline__ unsigned xb_add(unsigned* p, unsigned v) { return __hip_atomic_fetch_add(p, v, __ATOMIC_RELAXED, __HIP_MEMORY_SCOPE_AGENT); }
__device__ __forceinline__ unsigned xb_xcc_id() { return (unsigned)__builtin_amdgcn_s_getreg((3 << 11) | 20) & 0xFu; }
#define XB_SPIN(cond, bar) do { unsigned _sp = 0; while (cond) { __builtin_amdgcn_s_sleep(1); \
    if ((++_sp & 255u) == 0u) { if (xb_ld(&(bar)[XB_TMO])) break; if (_sp > XB_SPIN_CAP) { atomicAdd(&(bar)[XB_TMO], 1u); break; } } } } while (0)

struct XcdBarrier {
    unsigned* bar; unsigned x;
    volatile LAS unsigned* st;
};

__device__ __forceinline__ XcdBarrier xcd_barrier_post(unsigned* bar, volatile LAS unsigned* st) {
    XcdBarrier b; b.bar = bar; b.x = xb_xcc_id(); b.st = st;
    if (threadIdx.x == 0) (void)xb_add(&bar[XB_XCNT(b.x)], 1u);
    return b;
}
__device__ __forceinline__ void xcd_barrier_complete(unsigned* bar, unsigned x, unsigned& nloc, unsigned& nx) {
    const unsigned G = gridDim.x * gridDim.y * gridDim.z;
    unsigned sum, cnt, mine, sp = 0u;
    for (;;) {
        sum = 0u; cnt = 0u; mine = 0u;
#pragma unroll
        for (unsigned j = 0; j < 16; ++j) { const unsigned c = xb_ld(&bar[XB_XCNT(j)]); sum += c; cnt += (c > 0u) ? 1u : 0u; mine = (j == x) ? c : mine; }
        if (sum == G) break;
        __builtin_amdgcn_s_sleep(1);
        if ((++sp & 255u) == 0u) { if (xb_ld(&bar[XB_TMO])) break; if (sp > XB_SPIN_CAP) { atomicAdd(&bar[XB_TMO], 1u); break; } }
    }
    nloc = mine > 0u ? mine : 1u; nx = cnt > 0u ? cnt : 1u;
}

__device__ __forceinline__ void xcd_barrier(const XcdBarrier& b) {
    asm volatile("s_waitcnt vmcnt(0)" ::: "memory");
    __syncthreads();
    if (threadIdx.x == 0) {
        unsigned* bar = b.bar;
        __builtin_amdgcn_s_waitcnt(0);
        unsigned nloc = b.st[0], nx = b.st[1];
        if (nloc == 0u) { xcd_barrier_complete(bar, b.x, nloc, nx); b.st[0] = nloc; b.st[1] = nx; }
        const unsigned old = xb_add(&bar[XB_XSUB(b.x)], 1u);
        const unsigned gen = old / nloc;
        if (old + 1u == (gen + 1u) * nloc) {
            __builtin_amdgcn_fence(__ATOMIC_RELEASE, "agent");
            asm volatile("s_waitcnt vmcnt(0)" ::: "memory");
            const unsigned og = xb_add(&bar[XB_TOP], 1u);
            const unsigned tg = og / nx;
            if (og + 1u == (tg + 1u) * nx) xb_add(&bar[XB_TOPGEN], 1u);
            else XB_SPIN(xb_ld(&bar[XB_TOPGEN]) == tg, bar);
            __builtin_amdgcn_fence(__ATOMIC_ACQUIRE, "agent");
            xb_add(&bar[XB_XGEN(b.x)], 1u);
            asm volatile("s_waitcnt vmcnt(0)" ::: "memory");
        } else {
            XB_SPIN(xb_ld(&bar[XB_XGEN(b.x)]) == gen, bar);
            __builtin_amdgcn_fence(__ATOMIC_ACQUIRE, "agent");
            asm volatile("s_waitcnt vmcnt(0)" ::: "memory");
        }
    }
    __syncthreads();
}

#define GS_LOOP(N, CALL) for (long gi = (long)bid * NTHR + TIDX; gi < (long)(N); gi += (long)nblk * NTHR) { CALL; }
#ifndef PROBE
#define PROBE 0
#endif
#ifndef FAST_SCAN
#define FAST_SCAN 1
#endif
constexpr int N_PHASES = 16;
constexpr int MEGA_LDS = GEMM_LDS > TOPK_LDS ? GEMM_LDS : TOPK_LDS;

template <int PH>
DI void run_phase(const Params& p, int l, char* lds, int bid, int nblk) {
  const int need_ctx = (l == 0);
  const int rows = need_ctx ? R : RL;
  const float* xl_in = l == 0 ? p.x : p.out;
  const float* xc_in = l == 0 ? p.ctx : p.xc;
  bf16_t* QRAW = p.YO; bf16_t* KVRAW = p.YO + (size_t)R * 384;
  if constexpr (PH == 0) {
    ph_mods(p, lds, bid, nblk);
#pragma unroll 1
    for (int ll = 0; ll < 2; ++ll) {
      ph_wt(p.w_in + (size_t)ll * D * NZ, p.Wt_in + ll * WSZ_IN, D, NZ, NZP, 1, 0L, 0L, nullptr, lds, bid, nblk);
      ph_wt(p.w_gate + (size_t)ll * D * 4096, p.Wt_gate + ll * WSZ_GATE, D, 4096, 4096, 1, 0L, 0L, nullptr, lds, bid, nblk);
      ph_wt(p.w_branch + (size_t)ll * 4 * 256 * D, p.Wt_branch + ll * WSZ_BR, 256, D, D, 4, (long)256 * D, (long)D * 256, nullptr, lds, bid, nblk);
      ph_wt(p.w_out + (size_t)ll * D * D, p.Wt_out + ll * WSZ_OUT, D, D, D, 1, 0L, 0L, nullptr, lds, bid, nblk);
      ph_wt(p.w_uq + (size_t)ll * 256 * 384, p.Wt_uq + ll * WSZ_UQ, 256, 384, 384, 1, 0L, 0L, p.g_q_lat + ll * 256, lds, bid, nblk);
      ph_wt(p.w_ukv + (size_t)ll * 128 * 512, p.Wt_ukv + ll * WSZ_UKV, 128, 512, 512, 1, 0L, 0L, p.g_kv_lat + ll * 128, lds, bid, nblk);
    }
  } else if constexpr (PH == 1) {
    ph_modulate(p, l, xl_in, xc_in, bid, nblk);
  } else if constexpr (PH == 2) {
    ph_gemm_plain(p.H, D, p.Wt_in + l * WSZ_IN, D, R, NZP, D, p.Z, NZP, lds, bid, nblk);
#if PROBE == 63
    ph_gemm_probe<3>(p.H, D, p.Wt_in + l * WSZ_IN, D, R, NZP, D, p.mods + 40000, lds, bid, nblk);
#elif PROBE == 66
    ph_gemm_probe<6>(p.H, D, p.Wt_in + l * WSZ_IN, D, R, NZP, D, p.mods + 40000, lds, bid, nblk);
#elif PROBE == 67
    ph_gemm_plain<1>(p.H, D, p.Wt_in + l * WSZ_IN, D, R, NZP, D, p.Z, NZP, lds, bid, nblk);
#elif PROBE == 5
    ph_gemm_plain(p.H, D, p.Wt_in + l * WSZ_IN, D, R, NZP, D, p.Z, NZP, lds, bid, nblk);
#endif
  } else if constexpr (PH == 3) {
    ph_mla_up(p, l, QRAW, KVRAW, lds, bid, nblk);
  } else if constexpr (PH == 4) {
    ph_prep(p, l, QRAW, KVRAW, lds, bid, nblk);
#if PROBE == 41
    ph_prep(p, l, QRAW, KVRAW, lds, bid, nblk);
#elif PROBE == 43
    ph_prep<1>(p, l, QRAW, KVRAW, lds, bid, nblk);
#elif PROBE == 44
    ph_prep<2>(p, l, QRAW, KVRAW, lds, bid, nblk);
#endif
    __syncthreads();
    ph_gates_cum(p, l, lds, bid, nblk);
#if PROBE == 42
    ph_gates_cum(p, l, lds, bid, nblk);
#endif
  } else if constexpr (PH == 5) {
#if FAST_SCAN
    ph_ml_local(p, lds, bid, nblk);
    ph_gla_local(p, lds, bid, nblk);
#else
    GS_LOOP((long)NUNIT * 4160, nvb_ml_local(gi, p));
    GS_LOOP((long)NUNIT * 2048, nvb_gla_local(gi, p));
#endif
  } else if constexpr (PH == 6) {
#if FAST_SCAN
    ph_ml_scan(p, bid, nblk);
    ph_gla_scan(p, (bid + nblk - 260 % nblk) % nblk, nblk);
#else
    GS_LOOP((long)NB * 2 * 4 * 4160, nvb_ml_scan(gi, p));
    GS_LOOP((long)NB * 2 * 4 * 2048, nvb_gla_scan(gi, p));
#endif
    ph_attn(p, l, need_ctx, lds, bid, nblk);
#if PROBE >= 10 && PROBE < 20
    if (l == 0) ph_attn_mla_probe<PROBE - 10>(p, lds, bid, nblk);
#elif PROBE == 1
    ph_attn_diff(p, l, need_ctx, lds, bid, nblk);
#elif PROBE == 2
    ph_attn_mla(p, need_ctx, lds, bid, nblk);
#endif
  } else if constexpr (PH == 7) {
#if FAST_SCAN
    ph_ml_out(p, l, need_ctx, lds, bid, nblk);
    ph_gla_out(p, l, need_ctx, lds, bid, nblk);
#else
    GS_LOOP((long)NUNIT * 4096, nvb_ml_out(gi, p, need_ctx));
    GS_LOOP((long)NUNIT * 4096, nvb_gla_out(gi, p, need_ctx));
#endif
  } else if constexpr (PH == 8) {
#if !FAST_SCAN
    GS_LOOP((long)R * 4, nvb_ml_finish(gi, p, l, need_ctx));
    GS_LOOP((long)R * 4, nvb_gla_finish(gi, p, l, need_ctx));
#endif
  } else if constexpr (PH == 9) {
    ph_merge(p, l, rows, lds, bid, nblk);
#if PROBE == 3
    ph_merge(p, l, rows, lds, bid, nblk);
#endif
  } else if constexpr (PH == 10) {
    ph_gemm_plain(p.MG, D, p.Wt_out + l * WSZ_OUT, D, rows, D, D, p.YO, D, lds, bid, nblk);
  } else if constexpr (PH == 11) {
    ph_resid_mix(p, l, xl_in, xc_in, rows, bid, nblk);
  } else if constexpr (PH == 12) {
    ph_topk(p, need_ctx, lds, bid, nblk);
    ph_wt(p.w_e_gate + (size_t)l * NE * D * FF, p.Wt_eg, D, FF, FF, NE, (long)D * FF, (long)FF * D, nullptr, lds, bid, nblk);
    ph_wt(p.w_e_up + (size_t)l * NE * D * FF, p.Wt_eu, D, FF, FF, NE, (long)D * FF, (long)FF * D, nullptr, lds, bid, nblk);
    ph_wt(p.w_e_down + (size_t)l * NE * FF * D, p.Wt_ed, FF, D, D, NE, (long)FF * D, (long)D * FF, nullptr, lds, bid, nblk);
  } else if constexpr (PH == 13) {
    ph_moe1(p, need_ctx, lds, bid, nblk);
#if PROBE == 4
    ph_moe1(p, need_ctx, lds, bid, nblk);
#endif
  } else if constexpr (PH == 14) {
    ph_moe2(p, need_ctx, lds, bid, nblk);
#if PROBE == 4
    ph_moe2(p, need_ctx, lds, bid, nblk);
#endif
  } else if constexpr (PH == 15) {
    ph_resid_ffn(p, l, rows, bid, nblk);
  }
}

template <int PH> __global__ void __launch_bounds__(256, 2) k_phase(Params p, int l) {
  DYN_LDS(lds);
  run_phase<PH>(p, l, lds, blockIdx.x, gridDim.x);
}

#if !defined(CPU_EMU) && !MK_MULTI
typedef const Params __attribute__((address_space(4)))* KParams;
DI KParams kp_fresh() { KParams k = (KParams)__builtin_amdgcn_kernarg_segment_ptr(); asm volatile("" : "+s"(k)); return k; }
#define PHASE(PH, L) do { asm volatile("; PHASE_MARK " #PH); KParams k_ = kp_fresh(); run_phase<PH>(*(const Params*)k_, (L), lds, bid, nblk); if (PROBE == 20 + PH || (PROBE == 99 && (PH == 4 || PH == 5))) { __syncthreads(); run_phase<PH>(*(const Params*)k_, (L), lds, bid, nblk); } XcdBarrier b_ = bar; asm volatile("" : "+s"(b_.bar), "+s"(b_.x)); xcd_barrier(b_); if (PROBE == 50) xcd_barrier(b_); } while (0)
__global__ void __launch_bounds__(256, 2) k_mega(Params pv) {
  DYN_LDS(lds_all);
  if (threadIdx.x == 0) *(uint4*)lds_all = make_uint4(0u, 0u, 0u, 0u);
  __syncthreads();
  XcdBarrier bar = xcd_barrier_post(pv.bar, (volatile LAS unsigned*)lds_all);
  char* lds = lds_all + 256;
  const int bid = blockIdx.x, nblk = gridDim.x;
  PHASE(0, 0);
#pragma unroll 1
  for (int l = 0; l < 2; ++l) {
    PHASE(1, l); PHASE(2, l); PHASE(3, l); PHASE(4, l); PHASE(5, l); PHASE(6, l); PHASE(7, l);
#if !FAST_SCAN
    PHASE(8, l);
#endif

    PHASE(9, l); PHASE(10, l); PHASE(11, l); PHASE(12, l); PHASE(13, l); PHASE(14, l); PHASE(15, l);
  }
}
#endif
#ifdef CPU_EMU
void emu_check(const Params& p, int layer, int stage);
#define EMU_CHECK(stg) emu_check(p, l, stg)
static int g_nlayers = getenv("NLAYERS") ? atoi(getenv("NLAYERS")) : 2;
#else
#define EMU_CHECK(stg)
#endif
static void fill_params(Params& p, void* const* d_in, void* d_out, void* d_ws) {
  const float** f = (const float**)&p;
  for (int i = 0; i < 33; ++i) f[i] = (const float*)d_in[i];
  p.out = (float*)d_out;
  map_workspace(p, (char*)d_ws);
}
#define LAUNCH_PHASE(PH, L) LAUNCH((k_phase<PH>), grid, 256, MEGA_LDS, stream, p, L)

extern "C" void kernel_launch(void* const* d_in, const int* in_sizes, int n_in, void* d_out, int out_size, void* d_ws,
                              size_t ws_size, hipStream_t stream) {
  Params p{};
  fill_params(p, d_in, d_out, d_ws);
  if (p.ws_need > ws_size) return;
#ifdef CPU_EMU
  const int grid = 16;
  LAUNCH_PHASE(0, 0);
  for (int l = 0; l < g_nlayers; ++l) {
    LAUNCH_PHASE(1, l); LAUNCH_PHASE(2, l); LAUNCH_PHASE(3, l); LAUNCH_PHASE(4, l); LAUNCH_PHASE(5, l); LAUNCH_PHASE(6, l); LAUNCH_PHASE(7, l); LAUNCH_PHASE(8, l);
    EMU_CHECK(1);
    LAUNCH_PHASE(9, l); LAUNCH_PHASE(10, l); LAUNCH_PHASE(11, l);
    EMU_CHECK(2);
    LAUNCH_PHASE(12, l); LAUNCH_PHASE(13, l); LAUNCH_PHASE(14, l); LAUNCH_PHASE(15, l);
    EMU_CHECK(3);
  }
#else
  static int grid = 0;
  if (grid == 0) {
    int dev = 0, cus = 0, per_cu = 0;
    (void)hipGetDevice(&dev);
    (void)hipDeviceGetAttribute(&cus, hipDeviceAttributeMultiprocessorCount, dev);
#if MK_MULTI
    (void)hipFuncSetAttribute((const void*)k_phase<0>, hipFuncAttributeMaxDynamicSharedMemorySize, MEGA_LDS);
    (void)hipFuncSetAttribute((const void*)k_phase<1>, hipFuncAttributeMaxDynamicSharedMemorySize, MEGA_LDS);
    (void)hipFuncSetAttribute((const void*)k_phase<2>, hipFuncAttributeMaxDynamicSharedMemorySize, MEGA_LDS);
    (void)hipFuncSetAttribute((const void*)k_phase<3>, hipFuncAttributeMaxDynamicSharedMemorySize, MEGA_LDS);
    (void)hipFuncSetAttribute((const void*)k_phase<4>, hipFuncAttributeMaxDynamicSharedMemorySize, MEGA_LDS);
    (void)hipFuncSetAttribute((const void*)k_phase<5>, hipFuncAttributeMaxDynamicSharedMemorySize, MEGA_LDS);
    (void)hipFuncSetAttribute((const void*)k_phase<6>, hipFuncAttributeMaxDynamicSharedMemorySize, MEGA_LDS);
    (void)hipFuncSetAttribute((const void*)k_phase<7>, hipFuncAttributeMaxDynamicSharedMemorySize, MEGA_LDS);
    (void)hipFuncSetAttribute((const void*)k_phase<8>, hipFuncAttributeMaxDynamicSharedMemorySize, MEGA_LDS);
    (void)hipFuncSetAttribute((const void*)k_phase<9>, hipFuncAttributeMaxDynamicSharedMemorySize, MEGA_LDS);
    (void)hipFuncSetAttribute((const void*)k_phase<10>, hipFuncAttributeMaxDynamicSharedMemorySize, MEGA_LDS);
    (void)hipFuncSetAttribute((const void*)k_phase<11>, hipFuncAttributeMaxDynamicSharedMemorySize, MEGA_LDS);
    (void)hipFuncSetAttribute((const void*)k_phase<12>, hipFuncAttributeMaxDynamicSharedMemorySize, MEGA_LDS);
    (void)hipFuncSetAttribute((const void*)k_phase<13>, hipFuncAttributeMaxDynamicSharedMemorySize, MEGA_LDS);
    (void)hipFuncSetAttribute((const void*)k_phase<14>, hipFuncAttributeMaxDynamicSharedMemorySize, MEGA_LDS);
    (void)hipFuncSetAttribute((const void*)k_phase<15>, hipFuncAttributeMaxDynamicSharedMemorySize, MEGA_LDS);
    grid = (cus > 0 ? cus : 256) * 2;
#else
    if (hipFuncSetAttribute((const void*)k_mega, hipFuncAttributeMaxDynamicSharedMemorySize, MEGA_LDS + 256) != hipSuccess) { grid = -1; return; }
    if (hipOccupancyMaxActiveBlocksPerMultiprocessor(&per_cu, (const void*)k_mega, 256, MEGA_LDS + 256) != hipSuccess) per_cu = 0;
    (void)hipGetLastError();
    if (per_cu < 1) { grid = -1; return; }
    grid = (cus > 0 ? cus : 256) * (per_cu < 2 ? per_cu : 2);
#endif
  }
  if (grid < 0) return;
#if MK_MULTI
  LAUNCH_PHASE(0, 0);
  for (int l = 0; l < 2; ++l) {
    LAUNCH_PHASE(1, l); LAUNCH_PHASE(2, l); LAUNCH_PHASE(3, l); LAUNCH_PHASE(4, l); LAUNCH_PHASE(5, l); LAUNCH_PHASE(6, l); LAUNCH_PHASE(7, l); LAUNCH_PHASE(8, l);
    LAUNCH_PHASE(9, l); LAUNCH_PHASE(10, l); LAUNCH_PHASE(11, l); LAUNCH_PHASE(12, l); LAUNCH_PHASE(13, l); LAUNCH_PHASE(14, l); LAUNCH_PHASE(15, l);
  }
#else
  (void)hipMemsetAsync(p.bar, 0, XCD_BAR_WORDS * sizeof(unsigned), stream);
  k_mega<<<dim3(grid), dim3(256), MEGA_LDS + 256, stream>>>(p);
#endif
#endif
}
```

```cpp
#ifndef CPU_EMU
#include <hip/hip_runtime.h>
#endif
#include <stdint.h>
#include <stddef.h>

#ifndef T_LAT
#define T_LAT 16384
#endif
#ifndef T_CTX
#define T_CTX 256
#endif

#ifndef MK_MULTI
#define MK_MULTI 0
#endif
#define DI __device__ __forceinline__
typedef unsigned short bf16_t;
typedef short bf16x8 __attribute__((ext_vector_type(8)));
typedef short s16x4 __attribute__((ext_vector_type(4)));
typedef float f32x4 __attribute__((ext_vector_type(4)));
typedef float f32x16 __attribute__((ext_vector_type(16)));
typedef unsigned u32x4 __attribute__((ext_vector_type(4)));
typedef unsigned u32x2 __attribute__((ext_vector_type(2)));
typedef float f32x2 __attribute__((ext_vector_type(2)));

#ifdef CPU_EMU
static inline float u2f(unsigned u) { float f; memcpy(&f, &u, 4); return f; }
static inline unsigned f2u(float f) { unsigned u; memcpy(&u, &f, 4); return u; }
#define MFMA32(a, b, c) emu_mfma_32x32x16((a), (b), (c))
#define MFMA16(a, b, c) emu_mfma_16x16x32((a), (b), (c))
static inline float fast_exp2(float x) { return exp2f(x); }
static inline float fast_rcp(float x) { return 1.0f / x; }
static inline float fast_rsq(float x) { return 1.0f / sqrtf(x); }
static inline float hw_sin_rev(float x) { return sinf(6.283185307179586f * x); }
static inline float hw_cos_rev(float x) { return cosf(6.283185307179586f * x); }
#define LAUNCH(kern, grid, block, lds, stream, ...) emu::launch(dim3(grid), dim3(block), (size_t)(lds), [=]() { kern(__VA_ARGS__); })
#define DYN_LDS(name) char* name = emu_dynlds()
#define SCHED_BARRIER()
#define TIDX ((int)threadIdx.x)
#define WAVE_SYNC() emu::wave_barrier()
#define SETPRIO(x)
#define IGLP_OPT()
template <int M> static inline float xor_sum(float v) { return v + __shfl_xor(v, M); }
template <int M> static inline float xor_max(float v) { return fmaxf(v, __shfl_xor(v, M)); }
template <int M> static inline int xor_sum_i(int v) { return v + __shfl_xor(v, M); }
static inline int lane_bcast(int v, int src) { return __shfl(v, src); }
static inline int lane_up(int v, int d, int lane) { (void)lane; return __shfl_up(v, d); }
#else
DI float u2f(unsigned u) { return __uint_as_float(u); }
DI unsigned f2u(float f) { return __float_as_uint(f); }
#define MFMA32(a, b, c) __builtin_amdgcn_mfma_f32_32x32x16_bf16((a), (b), (c), 0, 0, 0)
#define MFMA16(a, b, c) __builtin_amdgcn_mfma_f32_16x16x32_bf16((a), (b), (c), 0, 0, 0)
DI float fast_exp2(float x) { return __builtin_amdgcn_exp2f(x); }
DI float fast_rcp(float x) { return __builtin_amdgcn_rcpf(x); }
DI float fast_rsq(float x) { return __builtin_amdgcn_rsqf(x); }
DI float hw_sin_rev(float x) { return __builtin_amdgcn_sinf(x); }
DI float hw_cos_rev(float x) { return __builtin_amdgcn_cosf(x); }
#define LAUNCH(kern, grid, block, lds, stream, ...) kern<<<dim3(grid), dim3(block), (lds), (stream)>>>(__VA_ARGS__)
#define DYN_LDS(name) extern __shared__ __attribute__((aligned(16))) char name[]
#define SCHED_BARRIER() __builtin_amdgcn_sched_barrier(0)
DI int tid_fresh() { int t = (int)threadIdx.x; asm volatile("" : "+v"(t)); return t; }
#define TIDX tid_fresh()
#define WAVE_SYNC() __builtin_amdgcn_wave_barrier()
#define SETPRIO(x) __builtin_amdgcn_s_setprio(x)
#define IGLP_OPT() __builtin_amdgcn_iglp_opt(0)
#ifdef USE_SHFL
template <int M> DI float xor_sum(float v) { return v + __shfl_xor(v, M); }
template <int M> DI float xor_max(float v) { return fmaxf(v, __shfl_xor(v, M)); }
template <int M> DI int xor_sum_i(int v) { return v + __shfl_xor(v, M); }
DI int lane_bcast(int v, int src) { return __shfl(v, src); }
DI int lane_up(int v, int d, int lane) { (void)lane; return __shfl_up(v, d); }
#else
template <int M> DI int xor_partner_bits(int bits) { return __builtin_amdgcn_ds_swizzle(bits, (M << 10) | 0x1f); }
DI void half_swap(unsigned& a, unsigned& b) { asm volatile("s_nop 1\n\tv_permlane32_swap_b32 %0, %1\n\ts_nop 1" : "+v"(a), "+v"(b)); }
template <int M> DI float xor_sum(float v) {
  if constexpr (M < 32) return v + __builtin_bit_cast(float, xor_partner_bits<M>(__builtin_bit_cast(int, v)));
  else { unsigned a = __builtin_bit_cast(unsigned, v), b = a; half_swap(a, b); return __builtin_bit_cast(float, a) + __builtin_bit_cast(float, b); }
}
template <int M> DI float xor_max(float v) {
  if constexpr (M < 32) return fmaxf(v, __builtin_bit_cast(float, xor_partner_bits<M>(__builtin_bit_cast(int, v))));
  else { unsigned a = __builtin_bit_cast(unsigned, v), b = a; half_swap(a, b); return fmaxf(__builtin_bit_cast(float, a), __builtin_bit_cast(float, b)); }
}
template <int M> DI int xor_sum_i(int v) {
  if constexpr (M < 32) return v + xor_partner_bits<M>(v);
  else { unsigned a = (unsigned)v, b = a; half_swap(a, b); return (int)(a + b); }
}
DI int lane_bcast(int v, int src) { return __builtin_amdgcn_readlane(v, src); }
DI int lane_up(int v, int d, int lane) { return __builtin_amdgcn_ds_bpermute(((lane - d) & 63) << 2, v); }
#endif
#endif

DI float bf2f(bf16_t v) { return u2f(((unsigned)v) << 16); }
#ifdef CPU_EMU
DI bf16_t f2bf(float f) { unsigned u = f2u(f); u += 0x7fffu + ((u >> 16) & 1u); return (bf16_t)(u >> 16); }
DI unsigned pack2bf(float lo, float hi) { return (unsigned)f2bf(lo) | ((unsigned)f2bf(hi) << 16); }
static inline bool wave_any(bool pr) { int v = pr ? 1 : 0; v |= __shfl_xor(v, 1); v |= __shfl_xor(v, 2); v |= __shfl_xor(v, 4); v |= __shfl_xor(v, 8); v |= __shfl_xor(v, 16); v |= __shfl_xor(v, 32); return v != 0; }
#else
typedef float f32x2_ __attribute__((ext_vector_type(2)));
typedef __bf16 bf16x2_hw __attribute__((ext_vector_type(2)));
DI unsigned pack2bf(float lo, float hi) { const f32x2_ v = {lo, hi}; return __builtin_bit_cast(unsigned, __builtin_convertvector(v, bf16x2_hw)); }
DI bf16_t f2bf(float f) { return (bf16_t)(pack2bf(f, f) & 0xffffu); }
DI bool wave_any(bool pr) { return __builtin_amdgcn_ballot_w64(pr) != 0ull; }
#endif
DI float sigmoidf_(float x) { return 1.0f / (1.0f + expf(-x)); }
DI float siluf_(float x) { return x / (1.0f + expf(-x)); }
DI float logsigmoidf_(float x) { return fminf(x, 0.0f) - log1pf(expf(-fabsf(x))); }

constexpr int D = 1024, NB = 2, TL = T_LAT, TC = T_CTX, TK = TL + TC;
constexpr int RL = NB * TL, RC = NB * TC, R = RL + RC;
constexpr int NZ = 3024, NZP = 3072;
constexpr int ZC_QLAT = 0, ZC_KVLAT = 256, ZC_KROPE = 384, ZC_MLQK = 416, ZC_MLV = 928, ZC_MLO = 1184, ZC_MLIG = 1440,
              ZC_MLFG = 1448, ZC_GQ = 1456, ZC_GK = 1584, ZC_GV = 1712, ZC_GR = 1968, ZC_GA = 2224, ZC_DQ = 2256,
              ZC_DK = 2512, ZC_DV = 2768;
constexpr int NCK = TK / 64, NCC = TC / 64, NCL = TL / 64;
constexpr int NE = 16, FF = 1408, CAPL = 2 * TL / 16, CAPC = 2 * TC / 16, CAPT = CAPL + CAPC, NSLOT = NB * CAPT;
constexpr size_t WSZ_IN = (size_t)NZP * D, WSZ_UQ = 384 * 256, WSZ_UKV = 512 * 128, WSZ_GATE = (size_t)4096 * D, WSZ_BR = (size_t)4 * D * 256, WSZ_OUT = (size_t)D * D;
constexpr int NUNIT = NB * 2 * NCK * 4;
constexpr float LOG2E = 1.4426950408889634f;
constexpr float QS_MLA = 0.10206207261596577f * LOG2E;
constexpr float QS_DIFF = 0.17677669529663687f * LOG2E;

DI int row_of(int b, int s) { return s < TC ? RL + b * TC + s : b * TL + (s - TC); }
DI void bs_of(int r, int& b, int& s) { if (r < RL) { b = r / TL; s = TC + (r % TL); } else { int q = r - RL; b = q / TC; s = q % TC; } }
DI int seq_of(int d, int p) { return d == 0 ? p : (p < TC ? TC - 1 - p : TK - 1 - (p - TC)); }
DI int step_of(int d, int c) { return d == 0 ? c : (c < NCC ? NCC - 1 - c : NCC + (NCK - 1 - c)); }

struct Params {
  const float *x, *c, *ctx, *c_ctx, *w_ada, *b_ada, *g_mix_pre, *g_mix_post, *g_ffn_pre, *g_ffn_post, *w_in, *g_q_lat, *w_uq,
      *g_kv_lat, *w_ukv, *w_conv, *b_conv, *b_igate, *b_fgate, *g_mlstm_out, *w_alpha2, *b_alpha, *g_gla_out, *diff_lambda,
      *g_diff_out, *w_branch, *w_gate, *b_gate, *w_out, *w_router, *w_e_gate, *w_e_up, *w_e_down;
  float* out;
  float *mods, *xc;
  bf16_t *H, *Z, *Qm, *Km, *Vtm, *Qd, *Kd, *Vtd, *MQ, *MK, *Y, *MG, *YO, *HID, *YE, *MVt, *GVt;
  float *BC, *IGS, *GC, *MC, *MN, *MM, *GS, *HD, *OD, *AFF, *SELV;
  int *SEL, *INV;
  bf16_t *Wt_in, *Wt_uq, *Wt_ukv, *Wt_gate, *Wt_branch, *Wt_out, *Wt_eg, *Wt_eu, *Wt_ed;
  unsigned* bar;
  size_t ws_need;
};

static inline size_t al256(size_t x) { return (x + 255) & ~(size_t)255; }
static inline void map_workspace(Params& p, char* ws) {
  size_t o = 0;
  auto take = [&](size_t bytes) { size_t r = o; o += al256(bytes); return ws + r; };
  p.bar = (unsigned*)take(16384);
  p.mods = (float*)take((size_t)2 * 3 * 6144 * 4);
  p.xc = (float*)take((size_t)RC * D * 4);
  p.BC = (float*)take((size_t)NB * 2 * TK * 4 * 4);
  p.IGS = (float*)take((size_t)NB * 2 * TK * 4 * 4);
  p.AFF = (float*)take((size_t)NB * NE * TK * 4);
  p.SEL = (int*)take((size_t)NE * NSLOT * 4);
  p.SELV = (float*)take((size_t)NE * NSLOT * 4);
  p.INV = (int*)take((size_t)R * NE * 4);
  p.MM = (float*)take((size_t)NUNIT * 4 * 4);
  p.MN = (float*)take((size_t)NUNIT * 64 * 4);
  p.Wt_in = (bf16_t*)take((size_t)2 * WSZ_IN * 2);
  p.Wt_uq = (bf16_t*)take((size_t)2 * WSZ_UQ * 2);
  p.Wt_ukv = (bf16_t*)take((size_t)2 * WSZ_UKV * 2);
  p.Wt_gate = (bf16_t*)take((size_t)2 * WSZ_GATE * 2);
  p.Wt_branch = (bf16_t*)take((size_t)2 * WSZ_BR * 2);
  p.Wt_out = (bf16_t*)take((size_t)2 * WSZ_OUT * 2);
  p.H = (bf16_t*)take((size_t)R * D * 2);
  size_t szA = (size_t)R * NZP * 2, szHID = (size_t)NE * NSLOT * FF * 2;
  char* A = take(szA > szHID ? szA : szHID);
  p.Z = (bf16_t*)A; p.HID = (bf16_t*)A;
  size_t szQm = al256((size_t)NB * 4 * TK * 96 * 2), szVt = al256((size_t)NB * 4 * 64 * TK * 2), szQd = al256((size_t)NB * 8 * TK * 32 * 2);
  size_t szB1 = 2 * szQm + 2 * szVt + 2 * szQd;
  size_t szHD = al256((size_t)2 * NB * TK * 256 * 4);
  size_t szYE = (size_t)NE * NSLOT * D * 2;
  size_t szB = szB1; if (2 * szHD > szB) szB = 2 * szHD; if (szYE > szB) szB = szYE;
  char* Bq = take(szB);
  p.Qm = (bf16_t*)Bq; p.Km = (bf16_t*)(Bq + szQm); p.Vtm = (bf16_t*)(Bq + 2 * szQm);
  p.Qd = (bf16_t*)(Bq + 2 * szQm + szVt); p.Kd = (bf16_t*)(Bq + 2 * szQm + szVt + szQd); p.Vtd = (bf16_t*)(Bq + 2 * szQm + szVt + 2 * szQd);
  p.YE = (bf16_t*)Bq;
  p.GC = (float*)take((size_t)NB * 2 * TK * 128 * 4);
  p.MVt = (bf16_t*)take((size_t)NB * 4 * 64 * TK * 2);
  p.GVt = (bf16_t*)take((size_t)NB * 4 * 64 * TK * 2);
  size_t szW = (size_t)NE * FF * D * 2;
  size_t szMC = (size_t)NUNIT * 4096 * 4, szRD = (size_t)R * D * 2;
  size_t szC = szMC; if (szRD > szC) szC = szRD; if (szW > szC) szC = szW;
  char* C = take(szC);
  p.MC = (float*)C; p.MG = (bf16_t*)C; p.Wt_eg = (bf16_t*)C;
  size_t szMQ = al256((size_t)NB * TK * 256 * 2), szGS = (size_t)NUNIT * 2048 * 4;
  size_t szD = 2 * szMQ + szGS; if (szW > szD) szD = szW;
  char* Dq = take(szD);
  p.MQ = (bf16_t*)Dq; p.MK = (bf16_t*)(Dq + szMQ); p.GS = (float*)(Dq + 2 * szMQ); p.Wt_eu = (bf16_t*)Dq;
  size_t szF = 2 * szRD > szW ? 2 * szRD : szW;
  char* F = take(szF);
  p.Y = (bf16_t*)F; p.YO = (bf16_t*)(F + szRD); p.Wt_ed = (bf16_t*)F;
  p.HD = (float*)Bq; p.OD = (float*)(Bq + szHD);
  p.ws_need = o;
}
#define GTID ((long)blockIdx.x * blockDim.x + threadIdx.x)

DI float lam_of(const Params& p, int layer, float& lam_init) {
  const float* lv = p.diff_lambda + layer * 128;
  float s1 = 0.f, s2 = 0.f;
  for (int i = 0; i < 32; ++i) { s1 += lv[i] * lv[32 + i]; s2 += lv[64 + i] * lv[96 + i]; }
  lam_init = layer == 0 ? 0.2f : 0.35550906759096f;
  return expf(s1) - expf(s2) + lam_init;
}
DI void rope_cs(int s, int jj, float& cs, float& sn) {
  int t = s - TC;
  int pos = (jj < 16) ? (t / 64) : (t % 64);
  float ang = (float)pos * exp2f(-1.6609640474436813f * (float)(jj & 7));
  double rev = (double)ang * 0.15915494309189535;
  rev -= floor(rev + 0.5);
  float rf = (float)rev;
  cs = hw_cos_rev(rf); sn = hw_sin_rev(rf);
}
template <class G> DI float rope_elem(G get, int s, int jj) {
  if (s < TC) return get(jj);
  float cs, sn; rope_cs(s, jj, cs, sn);
  float a = get(jj), b = get(jj ^ 8);
  return (jj & 8) ? (a * cs + b * sn) : (a * cs - b * sn);
}

DI void nvb_mods(long GI, const Params& p) {
  long i = GI; if (i >= 2 * 3 * 6144) return;
  int col = (int)(i % 6144), w = (int)((i / 6144) % 3), l = (int)(i / (3 * 6144));
  const float* cv = w < 2 ? p.c + w * 1024 : p.c_ctx;
  const float* W = p.w_ada + (size_t)l * 1024 * 6144;
  float acc = 0.f;
  for (int k = 0; k < 1024; ++k) acc += siluf_(cv[k]) * W[(size_t)k * 6144 + col];
  p.mods[i] = acc + p.b_ada[l * 6144 + col];
}
__global__ void __launch_bounds__(256) nv_wt(const float* in, bf16_t* out, int K, int N, int NP, long in_bs, long out_bs, const float* gain) {
  long i = GTID; if (i >= (long)NP * K) return;
  int k = (int)(i % K), n = (int)(i / K);
  const float* I = in + (size_t)blockIdx.y * in_bs; bf16_t* O = out + (size_t)blockIdx.y * out_bs;
  O[(size_t)n * K + k] = n < N ? f2bf(I[(size_t)k * N + n] * (gain ? gain[k] : 1.0f)) : (bf16_t)0;
}
__global__ void __launch_bounds__(256) nv_modulate(Params p, int layer, int which, const float* xl, const float* xcx, int nrows) {
  long r = GTID; if (r >= nrows) return;
  int w = r < RL ? (int)(r / TL) : 2;
  const float* mb = p.mods + (size_t)(layer * 3 + w) * 6144;
  const float* shift = mb + (which ? 3 : 0) * 1024; const float* scale = mb + (which ? 4 : 1) * 1024;
  const float* g = (which ? p.g_ffn_pre : p.g_mix_pre) + layer * 1024;
  const float* x = r < RL ? xl + (size_t)r * D : xcx + (size_t)(r - RL) * D;
  float ss = 0.f; for (int k = 0; k < D; ++k) ss += x[k] * x[k];
  float rstd = 1.0f / sqrtf(ss / D + 1e-6f);
  for (int k = 0; k < D; ++k) p.H[(size_t)r * D + k] = f2bf(x[k] * rstd * g[k] * (1.f + scale[k]) + shift[k]);
}
__global__ void __launch_bounds__(256) nv_gemm(const bf16_t* A, int lda, const bf16_t* Bt, int ldb, int M, int N, int K, bf16_t* C, int ldc) {
  long i = GTID; if (i >= (long)M * N) return;
  int n = (int)(i % N), m = (int)(i / N);
  const bf16_t* a = A + (size_t)m * lda; const bf16_t* b = Bt + (size_t)n * ldb;
  float acc = 0.f;
  for (int k = 0; k < K; ++k) acc += bf2f(a[k]) * bf2f(b[k]);
  C[(size_t)m * ldc + n] = f2bf(acc);
}
__global__ void __launch_bounds__(256) nv_mla_q(Params p, int layer) {
  long i = GTID; if (i >= (long)R * 4 * 96) return;
  int j = (int)(i % 96), h = (int)((i / 96) % 4), r = (int)(i / 384);
  int b, s; bs_of(r, b, s);
  const bf16_t* z = p.Z + (size_t)r * NZP + ZC_QLAT;
  const float* g = p.g_q_lat + layer * 256; const float* W = p.w_uq + (size_t)layer * 256 * 384;
  float ss = 0.f; for (int k = 0; k < 256; ++k) { float v = bf2f(z[k]); ss += v * v; }
  float rstd = 1.0f / sqrtf(ss / 256 + 1e-6f);
  auto dot = [&](int col) { float a = 0.f; for (int k = 0; k < 256; ++k) a += bf2f(z[k]) * rstd * g[k] * W[(size_t)k * 384 + col]; return a; };
  float v;
  if (j < 64) v = dot(h * 96 + j);
  else v = rope_elem([&](int jj) { return dot(h * 96 + 64 + jj); }, s, j - 64);
  p.Qm[(((size_t)b * 4 + h) * TK + s) * 96 + j] = f2bf(v * QS_MLA);
}
__global__ void __launch_bounds__(256) nv_mla_kv(Params p, int layer) {
  long i = GTID; if (i >= (long)R * 4 * 160) return;
  int j = (int)(i % 160), h = (int)((i / 160) % 4), r = (int)(i / 640);
  int b, s; bs_of(r, b, s);
  const bf16_t* z = p.Z + (size_t)r * NZP;
  if (j < 128) {
    const bf16_t* zl = z + ZC_KVLAT; const float* g = p.g_kv_lat + layer * 128; const float* W = p.w_ukv + (size_t)layer * 128 * 512;
    float ss = 0.f; for (int k = 0; k < 128; ++k) { float v = bf2f(zl[k]); ss += v * v; }
    float rstd = 1.0f / sqrtf(ss / 128 + 1e-6f);
    float a = 0.f; for (int k = 0; k < 128; ++k) a += bf2f(zl[k]) * rstd * g[k] * W[(size_t)k * 512 + h * 128 + j];
    if (j < 64) p.Km[(((size_t)b * 4 + h) * TK + s) * 96 + j] = f2bf(a);
    else p.Vtm[(((size_t)b * 4 + h) * 64 + (j - 64)) * TK + s] = f2bf(a);
  } else {
    int jj = j - 128;
    float v = rope_elem([&](int q) { return bf2f(z[ZC_KROPE + q]); }, s, jj);
    p.Km[(((size_t)b * 4 + h) * TK + s) * 96 + 64 + jj] = f2bf(v);
  }
}
__global__ void __launch_bounds__(256) nv_diff_prep(Params p) {
  long i = GTID; if (i >= (long)R * 768) return;
  int c = (int)(i % 768), r = (int)(i / 768);
  int b, s; bs_of(r, b, s);
  const bf16_t* z = p.Z + (size_t)r * NZP;
  if (c < 512) {
    int qk = c / 256, cc = c % 256, hm = cc / 32, jj = cc % 32;
    const bf16_t* src = z + (qk ? ZC_DK : ZC_DQ) + hm * 32;
    float v = rope_elem([&](int q) { return bf2f(src[q]); }, s, jj);
    if (qk == 0) p.Qd[(((size_t)b * 8 + hm) * TK + s) * 32 + jj] = f2bf(v * QS_DIFF);
    else p.Kd[(((size_t)b * 8 + hm) * TK + s) * 32 + jj] = f2bf(v);
  } else {
    int cc = c - 512, h = cc / 64, dv = cc % 64;
    p.Vtd[(((size_t)b * 4 + h) * 64 + dv) * TK + s] = z[ZC_DV + cc];
  }
}
__global__ void __launch_bounds__(256) nv_ml_prep(Params p, int layer) {
  long i = GTID; if (i >= (long)R * 512) return;
  int ch = (int)(i % 512), r = (int)(i / 512);
  int b, s; bs_of(r, b, s);
  bool first = (s == 0) || (s == TC), last = (s == TC - 1) || (s == TK - 1);
  const float* w = p.w_conv + (size_t)layer * 3 * 512;
  float acc = p.b_conv[layer * 512 + ch];
  acc += bf2f(p.Z[(size_t)r * NZP + ZC_MLQK + ch]) * w[512 + ch];
  if (!first) acc += bf2f(p.Z[(size_t)row_of(b, s - 1) * NZP + ZC_MLQK + ch]) * w[ch];
  if (!last) acc += bf2f(p.Z[(size_t)row_of(b, s + 1) * NZP + ZC_MLQK + ch]) * w[1024 + ch];
  float v = siluf_(acc);
  if (ch < 256) p.MQ[((size_t)b * TK + s) * 256 + ch] = f2bf(v);
  else p.MK[((size_t)b * TK + s) * 256 + ch - 256] = f2bf(v * 0.125f);
}
DI void nvb_ml_gates(long GI, const Params& p, int layer) {
  long i = GI; if (i >= (long)NB * 2 * NCK * 4) return;
  int h = (int)(i % 4), j = (int)((i / 4) % NCK), d = (int)((i / (4 * NCK)) % 2), b = (int)(i / (8 * NCK));
  float bi = p.b_igate[layer * 8 + d * 4 + h], bfg = p.b_fgate[layer * 8 + d * 4 + h];
  float cum = 0.f;
  for (int l = 0; l < 64; ++l) {
    int pp = 64 * j + l, s = seq_of(d, pp); const bf16_t* z = p.Z + (size_t)row_of(b, s) * NZP;
    float ig = bf2f(z[ZC_MLIG + d * 4 + h]) + bi;
    float lf = logsigmoidf_(bf2f(z[ZC_MLFG + d * 4 + h]) + bfg);
    cum += lf;
    size_t o = (((size_t)b * 2 + d) * TK + pp) * 4 + h;
    p.BC[o] = cum; p.IGS[o] = ig;
  }
}
DI void nvb_gla_cum(long GI, const Params& p, int layer) {
  long i = GI; if (i >= (long)NB * 2 * NCK * 128) return;
  int ch = (int)(i % 128), j = (int)((i / 128) % NCK), d = (int)((i / (128 * NCK)) % 2), b = (int)(i / (256 * NCK));
  const float* W = p.w_alpha2 + (size_t)layer * 2 * 16 * 128 + (size_t)d * 16 * 128;
  float ba = p.b_alpha[layer * 256 + d * 128 + ch];
  float cum = 0.f;
  for (int l = 0; l < 64; ++l) {
    int pp = 64 * j + l, s = seq_of(d, pp); const bf16_t* z = p.Z + (size_t)row_of(b, s) * NZP + ZC_GA + d * 16;
    float zg = ba; for (int q = 0; q < 16; ++q) zg += bf2f(z[q]) * W[q * 128 + ch];
    cum += logsigmoidf_(zg) * (1.0f / 16.0f);
    p.GC[(((size_t)b * 2 + d) * TK + pp) * 128 + ch] = cum;
  }
}
__global__ void __launch_bounds__(256) nv_attn_mla(Params p, int need_ctx) {
  long i = GTID; if (i >= (long)NB * 4 * TK) return;
  int s = (int)(i % TK), h = (int)((i / TK) % 4), b = (int)(i / (4 * TK));
  if (s < TC && !need_ctx) return;
  int nk = s < TC ? TC : TK;
  const bf16_t* q = p.Qm + (((size_t)b * 4 + h) * TK + s) * 96;
  const bf16_t* K = p.Km + ((size_t)b * 4 + h) * TK * 96;
  const bf16_t* Vt = p.Vtm + ((size_t)b * 4 + h) * 64 * TK;
  float qf[96], o[64];
  _Pragma("unroll") for (int k = 0; k < 96; ++k) qf[k] = bf2f(q[k]);
  _Pragma("unroll") for (int k = 0; k < 64; ++k) o[k] = 0.f;
  float m = -1e30f, l = 0.f;
  for (int t = 0; t < nk; ++t) {
    float sc = 0.f; _Pragma("unroll") for (int k = 0; k < 96; ++k) sc += qf[k] * bf2f(K[(size_t)t * 96 + k]);
    float mn = fmaxf(m, sc), a = exp2f(m - mn), pr = exp2f(sc - mn);
    l = l * a + pr;
    _Pragma("unroll") for (int k = 0; k < 64; ++k) o[k] = o[k] * a + pr * bf2f(Vt[(size_t)k * TK + t]);
    m = mn;
  }
  int r = row_of(b, s);
  _Pragma("unroll") for (int k = 0; k < 64; ++k) p.Y[(size_t)r * D + h * 64 + k] = f2bf(o[k] / l);
}
__global__ void __launch_bounds__(256) nv_attn_diff(Params p, int layer, int need_ctx) {
  long i = GTID; if (i >= (long)NB * 4 * TK) return;
  int s = (int)(i % TK), h = (int)((i / TK) % 4), b = (int)(i / (4 * TK));
  if (s < TC && !need_ctx) return;
  int nk = s < TC ? TC : TK;
  float lam_init; float lam = lam_of(p, layer, lam_init);
  const bf16_t* Vt = p.Vtd + ((size_t)b * 4 + h) * 64 * TK;
  float res[64];
  _Pragma("unroll") for (int k = 0; k < 64; ++k) res[k] = 0.f;
  _Pragma("unroll") for (int mp = 0; mp < 2; ++mp) {
    const bf16_t* q = p.Qd + (((size_t)b * 8 + h * 2 + mp) * TK + s) * 32;
    const bf16_t* K = p.Kd + ((size_t)b * 8 + h * 2 + mp) * TK * 32;
    float qf[32], o[64];
    _Pragma("unroll") for (int k = 0; k < 32; ++k) qf[k] = bf2f(q[k]);
    _Pragma("unroll") for (int k = 0; k < 64; ++k) o[k] = 0.f;
    float m = -1e30f, l = 0.f;
    for (int t = 0; t < nk; ++t) {
      float sc = 0.f; _Pragma("unroll") for (int k = 0; k < 32; ++k) sc += qf[k] * bf2f(K[(size_t)t * 32 + k]);
      float mn = fmaxf(m, sc), a = exp2f(m - mn), pr = exp2f(sc - mn);
      l = l * a + pr;
      _Pragma("unroll") for (int k = 0; k < 64; ++k) o[k] = o[k] * a + pr * bf2f(Vt[(size_t)k * TK + t]);
      m = mn;
    }
    float wgt = mp == 0 ? 1.f : -lam;
    _Pragma("unroll") for (int k = 0; k < 64; ++k) res[k] += wgt * o[k] / l;
  }
  float ss = 0.f; _Pragma("unroll") for (int k = 0; k < 64; ++k) ss += res[k] * res[k];
  float rstd = 1.0f / sqrtf(ss / 64 + 1e-6f);
  int r = row_of(b, s);
  _Pragma("unroll") for (int k = 0; k < 64; ++k) p.Y[(size_t)r * D + 768 + h * 64 + k] = f2bf(res[k] * rstd * p.g_diff_out[layer * 256 + h * 64 + k] * (1.f - lam_init));
}
DI void nvb_ml_local(long GI, const Params& p) {
  long i = GI; if (i >= (long)NUNIT * 4160) return;
  int e = (int)(i % 4160); long u = i / 4160;
  int h = (int)(u % 4), j = (int)((u / 4) % NCK), d = (int)((u / (4 * NCK)) % 2), b = (int)(u / (8 * NCK));
  const float* bc = p.BC + (((size_t)b * 2 + d) * TK + 64 * j) * 4 + h; const float* ig = p.IGS + (((size_t)b * 2 + d) * TK + 64 * j) * 4 + h;
  float bend = bc[63 * 4], ml = -1e30f;
  for (int l = 0; l < 64; ++l) ml = fmaxf(ml, bend - bc[l * 4] + ig[l * 4]);
  if (e == 4096 + 0) { p.MM[u * 4 + 0] = ml; p.MM[u * 4 + 1] = bend; }
  float acc = 0.f;
  if (e < 4096) {
    int v = e / 64, k = e % 64;
    for (int l = 0; l < 64; ++l) {
      int s = seq_of(d, 64 * j + l); float w = expf(bend - bc[l * 4] + ig[l * 4] - ml);
      acc += w * bf2f(p.Z[(size_t)row_of(b, s) * NZP + ZC_MLV + h * 64 + v]) * bf2f(p.MK[((size_t)b * TK + s) * 256 + h * 64 + k]);
    }
    p.MC[(size_t)u * 4096 + e] = acc;
  } else {
    int k = e - 4096;
    for (int l = 0; l < 64; ++l) {
      int s = seq_of(d, 64 * j + l); float w = expf(bend - bc[l * 4] + ig[l * 4] - ml);
      acc += w * bf2f(p.MK[((size_t)b * TK + s) * 256 + h * 64 + k]);
    }
    p.MN[(size_t)u * 64 + k] = acc;
  }
}
DI void nvb_ml_scan(long GI, const Params& p) {
  long i = GI; if (i >= (long)NB * 2 * 4 * 4160) return;
  int e = (int)(i % 4160); int ch = (int)(i / 4160); int h = ch % 4, bd = ch / 4;
  float st = 0.f, m = -1e30f;
  for (int j = 0; j < NCK; ++j) {
    size_t u = ((size_t)bd * NCK + j) * 4 + h;
    float ml = p.MM[u * 4 + 0], be = p.MM[u * 4 + 1];
    float mn = fmaxf(be + m, ml), a = expf(be + m - mn), g = expf(ml - mn);
    float* slot = e < 4096 ? &p.MC[u * 4096 + e] : &p.MN[u * 64 + (e - 4096)];
    float loc = *slot; *slot = st; st = a * st + g * loc;
    if (e == 0) p.MM[u * 4 + 2] = m;
    m = mn;
  }
}
DI void nvb_ml_out(long GI, const Params& p, int need_ctx) {
  long i = GI; if (i >= (long)NUNIT * 4096) return;
  int v = (int)(i % 64), l = (int)((i / 64) % 64); long u = i / 4096;
  int h = (int)(u % 4), j = (int)((u / 4) % NCK), d = (int)((u / (4 * NCK)) % 2), b = (int)(u / (8 * NCK));
  if (j < NCC && !need_ctx) return;
  const float* bc = p.BC + (((size_t)b * 2 + d) * TK + 64 * j) * 4 + h; const float* ig = p.IGS + (((size_t)b * 2 + d) * TK + 64 * j) * 4 + h;
  float m0 = p.MM[u * 4 + 2];
  int sl = seq_of(d, 64 * j + l);
  const bf16_t* q = p.MQ + ((size_t)b * TK + sl) * 256 + h * 64;
  float bl = bc[l * 4];
  float inter = bl + m0, mt = inter;
  for (int t = 0; t <= l; ++t) mt = fmaxf(mt, bl - bc[t * 4] + ig[t * 4]);
  float num = 0.f, den = 0.f;
  for (int t = 0; t <= l; ++t) {
    int st = seq_of(d, 64 * j + t);
    const bf16_t* k = p.MK + ((size_t)b * TK + st) * 256 + h * 64;
    float qk = 0.f; for (int c = 0; c < 64; ++c) qk += bf2f(q[c]) * bf2f(k[c]);
    float sv = expf(bl - bc[t * 4] + ig[t * 4] - mt) * qk;
    num += sv * bf2f(p.Z[(size_t)row_of(b, st) * NZP + ZC_MLV + h * 64 + v]); den += sv;
  }
  float ai = expf(inter - mt);
  float qc = 0.f, qn = 0.f;
  for (int c = 0; c < 64; ++c) { qc += bf2f(q[c]) * p.MC[(size_t)u * 4096 + v * 64 + c]; qn += bf2f(q[c]) * p.MN[(size_t)u * 64 + c]; }
  num += ai * qc; den += ai * qn;
  p.HD[(((size_t)d * NB + b) * TK + sl) * 256 + h * 64 + v] = num / fmaxf(fabsf(den), expf(-mt));
}
DI void nvb_ml_finish(long GI, const Params& p, int layer, int need_ctx) {
  long i = GI; if (i >= (long)R * 4) return;
  int h = (int)(i % 4), r = (int)(i / 4); int b, s; bs_of(r, b, s);
  if (s < TC && !need_ctx) return;
  const float* h0 = p.HD + (((size_t)0 * NB + b) * TK + s) * 256 + h * 64; const float* h1 = p.HD + (((size_t)1 * NB + b) * TK + s) * 256 + h * 64;
  float ss = 0.f; for (int v = 0; v < 64; ++v) { float t = h0[v] + h1[v]; ss += t * t; }
  float rstd = 1.0f / sqrtf(ss / 64 + 1e-6f);
  for (int v = 0; v < 64; ++v) {
    float o = bf2f(p.Z[(size_t)r * NZP + ZC_MLO + h * 64 + v]);
    p.Y[(size_t)r * D + 256 + h * 64 + v] = f2bf(sigmoidf_(o) * (h0[v] + h1[v]) * rstd * p.g_mlstm_out[layer * 256 + h * 64 + v]);
  }
}
DI void nvb_gla_local(long GI, const Params& p) {
  long i = GI; if (i >= (long)NUNIT * 2048) return;
  int v = (int)(i % 64), k = (int)((i / 64) % 32); long u = i / 2048;
  int h = (int)(u % 4), j = (int)((u / 4) % NCK), d = (int)((u / (4 * NCK)) % 2), b = (int)(u / (8 * NCK));
  const float* gc = p.GC + (((size_t)b * 2 + d) * TK + 64 * j) * 128 + h * 32 + k;
  float ge = gc[63 * 128], acc = 0.f;
  for (int l = 0; l < 64; ++l) {
    int s = seq_of(d, 64 * j + l); const bf16_t* z = p.Z + (size_t)row_of(b, s) * NZP;
    acc += bf2f(z[ZC_GK + h * 32 + k]) * expf(ge - gc[l * 128]) * bf2f(z[ZC_GV + h * 64 + v]);
  }
  p.GS[(size_t)u * 2048 + v * 32 + k] = acc;
}
DI void nvb_gla_scan(long GI, const Params& p) {
  long i = GI; if (i >= (long)NB * 2 * 4 * 2048) return;
  int e = (int)(i % 2048); int ch = (int)(i / 2048); int h = ch % 4, bd = ch / 4; int k = e % 32;
  float st = 0.f;
  for (int j = 0; j < NCK; ++j) {
    size_t u = ((size_t)bd * NCK + j) * 4 + h;
    float ge = p.GC[((size_t)bd * TK + 64 * j + 63) * 128 + h * 32 + k];
    float loc = p.GS[u * 2048 + e]; p.GS[u * 2048 + e] = st; st = expf(ge) * st + loc;
  }
}
DI void nvb_gla_out(long GI, const Params& p, int need_ctx) {
  long i = GI; if (i >= (long)NUNIT * 4096) return;
  int v = (int)(i % 64), l = (int)((i / 64) % 64); long u = i / 4096;
  int h = (int)(u % 4), j = (int)((u / 4) % NCK), d = (int)((u / (4 * NCK)) % 2), b = (int)(u / (8 * NCK));
  if (j < NCC && !need_ctx) return;
  const float* gc = p.GC + (((size_t)b * 2 + d) * TK + 64 * j) * 128 + h * 32;
  int sl = seq_of(d, 64 * j + l);
  const bf16_t* q = p.Z + (size_t)row_of(b, sl) * NZP + ZC_GQ + h * 32;
  const float qs = 0.17677669529663687f;
  float acc = 0.f;
  for (int t = 0; t <= l; ++t) {
    int st = seq_of(d, 64 * j + t); const bf16_t* z = p.Z + (size_t)row_of(b, st) * NZP;
    float att = 0.f; for (int k = 0; k < 32; ++k) att += bf2f(q[k]) * qs * expf(gc[l * 128 + k] - gc[t * 128 + k]) * bf2f(z[ZC_GK + h * 32 + k]);
    acc += att * bf2f(z[ZC_GV + h * 64 + v]);
  }
  for (int k = 0; k < 32; ++k) acc += bf2f(q[k]) * qs * expf(gc[l * 128 + k]) * p.GS[(size_t)u * 2048 + v * 32 + k];
  p.OD[(((size_t)d * NB + b) * TK + sl) * 256 + h * 64 + v] = acc;
}
DI void nvb_gla_finish(long GI, const Params& p, int layer, int need_ctx) {
  long i = GI; if (i >= (long)R * 4) return;
  int h = (int)(i % 4), r = (int)(i / 4); int b, s; bs_of(r, b, s);
  if (s < TC && !need_ctx) return;
  const float* h0 = p.OD + (((size_t)0 * NB + b) * TK + s) * 256 + h * 64; const float* h1 = p.OD + (((size_t)1 * NB + b) * TK + s) * 256 + h * 64;
  float ss = 0.f; for (int v = 0; v < 64; ++v) { float t = h0[v] + h1[v]; ss += t * t; }
  float rstd = 1.0f / sqrtf(ss / 64 + 1e-6f);
  for (int v = 0; v < 64; ++v) {
    float rr = bf2f(p.Z[(size_t)r * NZP + ZC_GR + h * 64 + v]);
    p.Y[(size_t)r * D + 512 + h * 64 + v] = f2bf(siluf_(rr) * (h0[v] + h1[v]) * rstd * p.g_gla_out[layer * 256 + h * 64 + v]);
  }
}
__global__ void __launch_bounds__(256) nv_merge(Params p, int layer, int nrows) {
  long i = GTID; if (i >= (long)nrows * D) return;
  int j = (int)(i % D), r = (int)(i / D);
  float acc = 0.f;
  for (int n = 0; n < 4; ++n) {
    const bf16_t* wg = p.Wt_gate + (size_t)(n * 1024 + j) * D; const bf16_t* wb = p.Wt_branch + ((size_t)n * D + j) * 256;
    float g = p.b_gate[layer * 4096 + n * 1024 + j], pr = 0.f;
    for (int k = 0; k < D; ++k) g += bf2f(p.H[(size_t)r * D + k]) * bf2f(wg[k]);
    for (int k = 0; k < 256; ++k) pr += bf2f(p.Y[(size_t)r * D + n * 256 + k]) * bf2f(wb[k]);
    acc += sigmoidf_(g) * pr;
  }
  p.MG[(size_t)r * D + j] = f2bf(acc);
}
__global__ void __launch_bounds__(256) nv_resid_mix(Params p, int layer, const float* xl_in, const float* xc_in, int nrows) {
  long r = GTID; if (r >= nrows) return;
  int w = r < RL ? (int)(r / TL) : 2;
  const float* mb = p.mods + (size_t)(layer * 3 + w) * 6144;
  const float* xin = r < RL ? xl_in + (size_t)r * D : xc_in + (size_t)(r - RL) * D;
  float* xo = r < RL ? p.out + (size_t)r * D : p.xc + (size_t)(r - RL) * D;
  const bf16_t* yo = p.YO + (size_t)r * D;
  float ss = 0.f; for (int k = 0; k < D; ++k) { float v = bf2f(yo[k]); ss += v * v; }
  float rstd = 1.0f / sqrtf(ss / D + 1e-6f);
  float s2 = 0.f;
  for (int k = 0; k < D; ++k) { float xn = xin[k] + mb[2 * 1024 + k] * bf2f(yo[k]) * rstd * p.g_mix_post[layer * 1024 + k]; xo[k] = xn; s2 += xn * xn; }
  float rstd2 = 1.0f / sqrtf(s2 / D + 1e-6f);
  float lg[16]; _Pragma("unroll") for (int e = 0; e < 16; ++e) lg[e] = 0.f;
  const float* wr = p.w_router + (size_t)layer * D * 16;
  for (int k = 0; k < D; ++k) {
    float h2 = xo[k] * rstd2 * p.g_ffn_pre[layer * 1024 + k] * (1.f + mb[4 * 1024 + k]) + mb[3 * 1024 + k];
    p.H[(size_t)r * D + k] = f2bf(h2);
    _Pragma("unroll") for (int e = 0; e < 16; ++e) lg[e] += h2 * wr[k * 16 + e];
  }
  float mx = lg[0]; _Pragma("unroll") for (int e = 1; e < 16; ++e) mx = fmaxf(mx, lg[e]);
  float sm = 0.f; _Pragma("unroll") for (int e = 0; e < 16; ++e) { lg[e] = expf(lg[e] - mx); sm += lg[e]; }
  int b, s; bs_of((int)r, b, s);
  _Pragma("unroll") for (int e = 0; e < 16; ++e) p.AFF[((size_t)b * NE + e) * TK + s] = lg[e] / sm;
}
__global__ void __launch_bounds__(256) nv_topk(Params p, int need_ctx) {
  long i = GTID; if (i >= NB * NE * 2) return;
  int seg = (int)(i % 2), e = (int)((i / 2) % NE), b = (int)(i / (2 * NE));
  int s0 = seg ? TC : 0, n = seg ? TL : TC, cap = seg ? CAPL : CAPC, slot0 = seg ? b * CAPL : NB * CAPL + b * CAPC;
  if (seg == 0 && !need_ctx) { for (int q = 0; q < cap; ++q) p.SEL[(size_t)e * NSLOT + slot0 + q] = -1; return; }
  const float* a = p.AFF + ((size_t)b * NE + e) * TK + s0;
  unsigned thr = 0;
  for (int bit = 31; bit >= 0; --bit) {
    unsigned cand = thr | (1u << bit); int cnt = 0;
    for (int t = 0; t < n; ++t) cnt += (f2u(a[t]) >= cand);
    if (cnt >= cap) thr = cand;
  }
  int ngt = 0; for (int t = 0; t < n; ++t) ngt += (f2u(a[t]) > thr);
  int neq = cap - ngt, q = 0;
  for (int t = 0; t < n; ++t) {
    unsigned u = f2u(a[t]); int r = row_of(b, s0 + t); int sel = -1;
    if (u > thr) sel = q++; else if (u == thr && neq > 0) { sel = q++; --neq; }
    if (sel >= 0) { p.SEL[(size_t)e * NSLOT + slot0 + sel] = r; p.SELV[(size_t)e * NSLOT + slot0 + sel] = a[t]; }
    p.INV[(size_t)r * NE + e] = sel >= 0 ? slot0 + sel : -1;
  }
}
__global__ void __launch_bounds__(256) nv_moe1(Params p) {
  long i = GTID; if (i >= (long)NE * NSLOT * FF) return;
  int f = (int)(i % FF), slot = (int)((i / FF) % NSLOT), e = (int)(i / ((long)FF * NSLOT));
  int r = p.SEL[(size_t)e * NSLOT + slot];
  float out = 0.f;
  if (r >= 0) {
    const bf16_t* wg = p.Wt_eg + ((size_t)e * FF + f) * D; const bf16_t* wu = p.Wt_eu + ((size_t)e * FF + f) * D; const bf16_t* h = p.H + (size_t)r * D;
    float g = 0.f, u = 0.f; for (int k = 0; k < D; ++k) { float hv = bf2f(h[k]); g += hv * bf2f(wg[k]); u += hv * bf2f(wu[k]); }
    out = siluf_(g) * u;
  }
  p.HID[((size_t)e * NSLOT + slot) * FF + f] = f2bf(out);
}
__global__ void __launch_bounds__(256) nv_moe2(Params p) {
  long i = GTID; if (i >= (long)NE * NSLOT * D) return;
  int j = (int)(i % D), slot = (int)((i / D) % NSLOT), e = (int)(i / ((long)D * NSLOT));
  int r = p.SEL[(size_t)e * NSLOT + slot];
  float out = 0.f;
  if (r >= 0) {
    const bf16_t* wd = p.Wt_ed + ((size_t)e * D + j) * FF; const bf16_t* h = p.HID + ((size_t)e * NSLOT + slot) * FF;
    float a = 0.f; for (int k = 0; k < FF; ++k) a += bf2f(h[k]) * bf2f(wd[k]);
    out = a * p.SELV[(size_t)e * NSLOT + slot];
  }
  p.YE[((size_t)e * NSLOT + slot) * D + j] = f2bf(out);
}
__global__ void __launch_bounds__(256) nv_resid_ffn(Params p, int layer, int nrows) {
  long r = GTID; if (r >= nrows) return;
  int w = r < RL ? (int)(r / TL) : 2;
  const float* mb = p.mods + (size_t)(layer * 3 + w) * 6144;
  float* xo = r < RL ? p.out + (size_t)r * D : p.xc + (size_t)(r - RL) * D;
  float ss = 0.f;
  for (int k = 0; k < D; ++k) {
    float f = 0.f;
    for (int e = 0; e < NE; ++e) { int sl = p.INV[(size_t)r * NE + e]; if (sl >= 0) f += bf2f(p.YE[((size_t)e * NSLOT + sl) * D + k]); }
    ss += f * f;
  }
  float rstd = 1.0f / sqrtf(ss / D + 1e-6f);
  for (int k = 0; k < D; ++k) {
    float f = 0.f;
    for (int e = 0; e < NE; ++e) { int sl = p.INV[(size_t)r * NE + e]; if (sl >= 0) f += bf2f(p.YE[((size_t)e * NSLOT + sl) * D + k]); }
    xo[k] += mb[5 * 1024 + k] * f * rstd * p.g_ffn_post[layer * 1024 + k];
  }
}

__global__ void __launch_bounds__(256) nv_mods(Params p) { nvb_mods(GTID, p); }
__global__ void __launch_bounds__(256) nv_ml_gates(Params p, int layer) { nvb_ml_gates(GTID, p, layer); }
__global__ void __launch_bounds__(256) nv_gla_cum(Params p, int layer) { nvb_gla_cum(GTID, p, layer); }
__global__ void __launch_bounds__(256) nv_ml_local(Params p) { nvb_ml_local(GTID, p); }
__global__ void __launch_bounds__(256) nv_ml_scan(Params p) { nvb_ml_scan(GTID, p); }
__global__ void __launch_bounds__(256) nv_ml_out(Params p, int need_ctx) { nvb_ml_out(GTID, p, need_ctx); }
__global__ void __launch_bounds__(256) nv_ml_finish(Params p, int layer, int need_ctx) { nvb_ml_finish(GTID, p, layer, need_ctx); }
__global__ void __launch_bounds__(256) nv_gla_local(Params p) { nvb_gla_local(GTID, p); }
__global__ void __launch_bounds__(256) nv_gla_scan(Params p) { nvb_gla_scan(GTID, p); }
__global__ void __launch_bounds__(256) nv_gla_out(Params p, int need_ctx) { nvb_gla_out(GTID, p, need_ctx); }
__global__ void __launch_bounds__(256) nv_gla_finish(Params p, int layer, int need_ctx) { nvb_gla_finish(GTID, p, layer, need_ctx); }
constexpr int LROW = 144;
constexpr int A_BYTES = 128 * LROW;
constexpr int NTHR = 256;
#ifndef ATT_THR
#define ATT_THR 16.0f
#endif

DI int xcd_swz(int u, int nt) { return (nt & 7) ? u : (u & 7) * (nt >> 3) + (u >> 3); }
template <int GW> DI void grp_tile(int L, int ntm, int ntn, int& tm, int& tn) {
  const int gsz = ntm * GW; int g = 0;
  while (L >= gsz) { L -= gsz; ++g; }
  tm = L / GW; tn = g * GW + (L & (GW - 1)); (void)ntn;
}
DI u32x4 ldg16(const void* p) { return *(const u32x4*)p; }
DI void sts16(char* p, u32x4 v) { *(u32x4*)p = v; }
DI bf16x8 lds_frag(const char* p) { return *(const bf16x8*)p; }

template <int WN>
DI void gemm_kloop(f32x4 (&acc)[4][WN], const bf16_t* const (&ap)[4], const bf16_t* const (&bp)[WN], int nk, char* lds) {
  constexpr int STAGE = A_BYTES + 32 * WN * LROW;
  const int t = TIDX, lane = t & 63, wid = t >> 6, wr = wid >> 1, wc = wid & 1;
  const int lr = t >> 3, lcb = (t & 7) * 16;
  const int fr = lane & 15, fq = lane >> 4;
  const int aoff = (wr * 64 + fr) * LROW + fq * 16, boff = A_BYTES + (wc * WN * 16 + fr) * LROW + fq * 16, soff = lr * LROW + lcb;
  u32x4 ra0[4], rb0[WN], ra1[4], rb1[WN];
  auto gload = [&](u32x4 (&ra)[4], u32x4 (&rb)[WN], int kt) {
#pragma unroll
    for (int i = 0; i < 4; ++i) ra[i] = ldg16(ap[i] + kt * 64);
#pragma unroll
    for (int i = 0; i < WN; ++i) rb[i] = ldg16(bp[i] + kt * 64);
  };
  auto sstore = [&](const u32x4 (&ra)[4], const u32x4 (&rb)[WN], char* st) {
#pragma unroll
    for (int i = 0; i < 4; ++i) sts16(st + soff + 32 * i * LROW, ra[i]);
#pragma unroll
    for (int i = 0; i < WN; ++i) sts16(st + A_BYTES + soff + 32 * i * LROW, rb[i]);
  };
  auto compute = [&](const char* cur) {
#pragma unroll
    for (int ks = 0; ks < 2; ++ks) {
      bf16x8 af[4], bfr[WN];
#pragma unroll
      for (int m = 0; m < 4; ++m) af[m] = lds_frag(cur + aoff + m * 16 * LROW + ks * 64);
#pragma unroll
      for (int n = 0; n < WN; ++n) bfr[n] = lds_frag(cur + boff + n * 16 * LROW + ks * 64);
#pragma unroll
      for (int m = 0; m < 4; ++m)
#pragma unroll
        for (int n = 0; n < WN; ++n) acc[m][n] = MFMA16(bfr[n], af[m], acc[m][n]);
    }
    IGLP_OPT();
  };
  gload(ra0, rb0, 0);
  gload(ra1, rb1, 1);
  sstore(ra0, rb0, lds);
  __syncthreads();
#pragma unroll 1
  for (int kt = 0; kt < nk; kt += 2) {
    if (kt + 2 < nk) gload(ra0, rb0, kt + 2);
    compute(lds);
    sstore(ra1, rb1, lds + STAGE);
    __syncthreads();
    if (kt + 3 < nk) gload(ra1, rb1, kt + 3);
    compute(lds + STAGE);
    if (kt + 2 < nk) sstore(ra0, rb0, lds);
    __syncthreads();
  }
}
template <int WN> DI void acc_zero(f32x4 (&acc)[4][WN]) {
#pragma unroll
  for (int m = 0; m < 4; ++m)
#pragma unroll
    for (int n = 0; n < WN; ++n) acc[m][n] = (f32x4){0.f, 0.f, 0.f, 0.f};
}
DI void st_bf16x4(bf16_t* p, f32x4 v) { u32x2 o; o.x = pack2bf(v.x, v.y); o.y = pack2bf(v.z, v.w); *(u32x2*)p = o; }

template <int WN, class RowOk>
DI void store_wave_tile(const f32x4 (&acc)[4][WN], bf16_t* C, size_t ldc, char* ldsw, int lane, RowOk row_ok) {
  constexpr int PITCH = WN * 32 + 16, CPR = WN * 2;
  const int fr = lane & 15, fq = lane >> 4;
#pragma unroll
  for (int m = 0; m < 4; ++m)
#pragma unroll
    for (int n = 0; n < WN; ++n) { u32x2 o; o.x = pack2bf(acc[m][n][0], acc[m][n][1]); o.y = pack2bf(acc[m][n][2], acc[m][n][3]); *(u32x2*)(ldsw + (m * 16 + fr) * PITCH + n * 32 + fq * 8) = o; }
  WAVE_SYNC();
  constexpr int RPP = 64 / CPR;
#pragma unroll
  for (int ps = 0; ps < 64 / RPP; ++ps) {
    const int r = ps * RPP + lane / CPR, c = lane % CPR;
    const u32x4 v = *(const u32x4*)(ldsw + r * PITCH + c * 16);
    if (row_ok(r)) *(u32x4*)(C + (size_t)r * ldc + c * 8) = v;
  }
  WAVE_SYNC();
}
template <int NOSTORE = 0>
DI void gemm_plain_tile(const bf16_t* A, int lda, const bf16_t* Bt, int ldb, int K, bf16_t* C, int ldc, int tm, int tn, char* lds) {
  const int t = TIDX, lane = t & 63, wid = t >> 6, wr = wid >> 1, wc = wid & 1, lr = t >> 3, lc = (t & 7) * 8, fr = lane & 15, fq = lane >> 4;
  const bf16_t* ap[4]; const bf16_t* bp[4];
#pragma unroll
  for (int i = 0; i < 4; ++i) { ap[i] = A + (size_t)(tm * 128 + lr + 32 * i) * lda + lc; bp[i] = Bt + (size_t)(tn * 128 + lr + 32 * i) * ldb + lc; }
  f32x4 acc[4][4]; acc_zero<4>(acc);
  gemm_kloop<4>(acc, ap, bp, K / 64, lds);
  if (NOSTORE) { float s = 0.f;
#pragma unroll
    for (int m = 0; m < 4; ++m)
#pragma unroll
      for (int n = 0; n < 4; ++n) s += acc[m][n][0] + acc[m][n][3];
    if (s == 123456.789f) C[0] = 1; return; }
  store_wave_tile<4>(acc, C + (size_t)(tm * 128 + wr * 64) * ldc + tn * 128 + wc * 64, (size_t)ldc, lds + wid * (64 * 144), lane, [](int) { return true; });
  __syncthreads();
}
template <int NOSTORE = 0>
DI void ph_gemm_plain(const bf16_t* A, int lda, const bf16_t* Bt, int ldb, int M, int N, int K, bf16_t* C, int ldc, char* lds, int bid, int nblk) {
  const int ntn = N / 128, nt = (M / 128) * ntn;
  for (int u = bid; u < nt; u += nblk) { int tm, tn; grp_tile<8>(xcd_swz(u, nt), M / 128, ntn, tm, tn); gemm_plain_tile<NOSTORE>(A, lda, Bt, ldb, K, C, ldc, tm, tn, lds); }
}
DI void ph_mla_up(const Params& p, int layer, bf16_t* QRAW, bf16_t* KVRAW, char* lds, int bid, int nblk) {
  const int ntq = (R / 128) * 3, ntkv = (R / 128) * 4;
  for (int tile = bid; tile < ntq + ntkv; tile += nblk) {
    if (tile < ntq) gemm_plain_tile(p.Z + ZC_QLAT, NZP, p.Wt_uq + layer * WSZ_UQ, 256, 256, QRAW, 384, tile / 3, tile % 3, lds);
    else { int u = tile - ntq; gemm_plain_tile(p.Z + ZC_KVLAT, NZP, p.Wt_ukv + layer * WSZ_UKV, 128, 128, KVRAW, 512, u / 4, u % 4, lds); }
  }
}
constexpr int LROW32 = 80;
template <int WM, int WN, bool DEEP>
DI void gemm_kloop_g(f32x4 (&acc)[WM][WN], const bf16_t* const (&ap)[WM / 2], const bf16_t* const (&bp)[WN / 2], int nk, char* lds) {
  constexpr int NA = WM / 2, NBB = WN / 2, A_B = 32 * WM * LROW32, STAGE = (32 * WM + 32 * WN) * LROW32;
  const int t = TIDX, lane = t & 63, wid = t >> 6, wr = wid >> 1, wc = wid & 1, fr = lane & 15, fq = lane >> 4;
  const int aoff = (wr * 16 * WM + fr) * LROW32 + fq * 16, boff = A_B + (wc * 16 * WN + fr) * LROW32 + fq * 16, soff = (t >> 2) * LROW32 + (t & 3) * 16;
  u32x4 ra0[NA], rb0[NBB], ra1[NA], rb1[NBB];
  auto gload = [&](u32x4 (&ra)[NA], u32x4 (&rb)[NBB], int kt) {
#pragma unroll
    for (int i = 0; i < NA; ++i) ra[i] = ldg16(ap[i] + kt * 32);
#pragma unroll
    for (int i = 0; i < NBB; ++i) rb[i] = ldg16(bp[i] + kt * 32);
  };
  auto sstore = [&](const u32x4 (&ra)[NA], const u32x4 (&rb)[NBB], char* st) {
#pragma unroll
    for (int i = 0; i < NA; ++i) sts16(st + soff + 64 * i * LROW32, ra[i]);
#pragma unroll
    for (int i = 0; i < NBB; ++i) sts16(st + A_B + soff + 64 * i * LROW32, rb[i]);
  };
  auto compute = [&](const char* cur) {
    bf16x8 af[WM];
#pragma unroll
    for (int m = 0; m < WM; ++m) af[m] = lds_frag(cur + aoff + m * 16 * LROW32);
#pragma unroll
    for (int n = 0; n < WN; ++n) {
      const bf16x8 bfr = lds_frag(cur + boff + n * 16 * LROW32);
#pragma unroll
      for (int m = 0; m < WM; ++m) acc[m][n] = MFMA16(bfr, af[m], acc[m][n]);
    }
    IGLP_OPT();
  };
  gload(ra0, rb0, 0);
  if (DEEP) gload(ra1, rb1, 1);
  sstore(ra0, rb0, lds);
  __syncthreads();
#pragma unroll 1
  for (int kt = 0; kt < nk; kt += 2) {
    if (DEEP) { if (kt + 2 < nk) gload(ra0, rb0, kt + 2); } else gload(ra1, rb1, kt + 1);
    compute(lds);
    sstore(ra1, rb1, lds + STAGE);
    __syncthreads();
    if (DEEP) { if (kt + 3 < nk) gload(ra1, rb1, kt + 3); } else if (kt + 2 < nk) gload(ra0, rb0, kt + 2);
    compute(lds + STAGE);
    if (kt + 2 < nk) sstore(ra0, rb0, lds);
    __syncthreads();
  }
}
template <int WM, int WN> DI void acc_zero_g(f32x4 (&acc)[WM][WN]) {
#pragma unroll
  for (int m = 0; m < WM; ++m)
#pragma unroll
    for (int n = 0; n < WN; ++n) acc[m][n] = (f32x4){0.f, 0.f, 0.f, 0.f};
}
DI void ph_merge(const Params& p, int layer, int rows, char* lds, int bid, int nblk) {
  const int t = TIDX, lane = t & 63, wid = t >> 6, wr = wid >> 1, wc = wid & 1, fr = lane & 15, fq = lane >> 4;
  const int lr = t >> 2, lc = (t & 3) * 8;
  const int ntn = D / 64, nt = (rows / 128) * ntn;
#pragma unroll 1
  for (int u = bid; u < nt; u += nblk) {
    int tm, tn; grp_tile<4>(xcd_swz(u, nt), rows / 128, ntn, tm, tn);
    f32x4 accS[4][2]; acc_zero_g<4, 2>(accS);
#pragma unroll 1
    for (int np = 0; np < 2; ++np) {
      f32x4 accG[4][4]; acc_zero_g<4, 4>(accG);
      {
        const bf16_t* ap[2]; const bf16_t* bp[2];
#pragma unroll
        for (int i = 0; i < 2; ++i) ap[i] = p.H + (size_t)(tm * 128 + lr + 64 * i) * D + lc;
#pragma unroll
        for (int i = 0; i < 2; ++i) { const int rho = lr + 64 * i, wci = rho >> 6, n = 2 * np + ((rho >> 5) & 1), c = rho & 31;
          bp[i] = p.Wt_gate + layer * WSZ_GATE + ((size_t)n * 1024 + tn * 64 + wci * 32 + c) * D + lc; }
        gemm_kloop_g<4, 4, true>(accG, ap, bp, D / 32, lds);
      }
#pragma unroll 1
      for (int q = 0; q < 2; ++q) {
        const int n = 2 * np + q;
        f32x4 accP[4][2]; acc_zero_g<4, 2>(accP);
        const bf16_t* ap[2]; const bf16_t* bp[1];
#pragma unroll
        for (int i = 0; i < 2; ++i) ap[i] = p.Y + (size_t)(tm * 128 + lr + 64 * i) * D + n * 256 + lc;
        bp[0] = p.Wt_branch + layer * WSZ_BR + ((size_t)n * D + tn * 64 + lr) * 256 + lc;
        gemm_kloop_g<4, 2, false>(accP, ap, bp, 8, lds);
#pragma unroll
        for (int nn = 0; nn < 2; ++nn) {
          const f32x4 bv = *(const f32x4*)(p.b_gate + layer * 4096 + n * 1024 + tn * 64 + wc * 32 + nn * 16 + 4 * fq);
#pragma unroll
          for (int m = 0; m < 4; ++m)
#pragma unroll
            for (int j = 0; j < 4; ++j) { const float g = q ? accG[m][2 + nn][j] : accG[m][nn][j]; accS[m][nn][j] += accP[m][nn][j] * fast_rcp(1.0f + fast_exp2(-LOG2E * (g + bv[j]))); }
        }
      }
    }
    store_wave_tile<2>(accS, p.MG + (size_t)(tm * 128 + wr * 64) * D + tn * 64 + wc * 32, (size_t)D, lds + wid * (64 * 80), lane, [](int) { return true; });
    __syncthreads();
  }
}
template <int WM>
DI void gemm_plain_tile_g(const bf16_t* A, int lda, const bf16_t* Bt, int ldb, int K, bf16_t* C, int ldc, int row0, int col0, char* lds) {
  const int t = TIDX, lane = t & 63, wid = t >> 6, wr = wid >> 1, wc = wid & 1, fr = lane & 15, fq = lane >> 4, lr = t >> 2, lc = (t & 3) * 8;
  const bf16_t* ap[WM / 2]; const bf16_t* bp[2];
#pragma unroll
  for (int i = 0; i < WM / 2; ++i) ap[i] = A + (size_t)(row0 + lr + 64 * i) * lda + lc;
#pragma unroll
  for (int i = 0; i < 2; ++i) bp[i] = Bt + (size_t)(col0 + lr + 64 * i) * ldb + lc;
  f32x4 acc[WM][4]; acc_zero_g<WM, 4>(acc);
  gemm_kloop_g<WM, 4, true>(acc, ap, bp, K / 32, lds);
#pragma unroll
  for (int m = 0; m < WM; ++m)
#pragma unroll
    for (int n = 0; n < 4; ++n)
      st_bf16x4(C + (size_t)(row0 + wr * 16 * WM + m * 16 + fr) * ldc + col0 + wc * 64 + n * 16 + 4 * fq, acc[m][n]);
}
DI void ph_gemm_plain2(const bf16_t* A, int lda, const bf16_t* Bt, int ldb, int M, int N, int K, bf16_t* C, int ldc, char* lds, int bid, int nblk) {
  const int ntn = N / 128, nt = (M / 256) * ntn, nfull = (nt / nblk) * nblk;
#pragma unroll 1
  for (int tile = bid; tile < nfull; tile += nblk) gemm_plain_tile_g<8>(A, lda, Bt, ldb, K, C, ldc, (tile / ntn) * 256, (tile % ntn) * 128, lds);
#pragma unroll 1
  for (int h = bid; h < 2 * (nt - nfull); h += nblk) { const int tile = nfull + (h >> 1); gemm_plain_tile_g<4>(A, lda, Bt, ldb, K, C, ldc, (tile / ntn) * 256 + (h & 1) * 128, (tile % ntn) * 128, lds); }
}
DI void gemm_kloop32(f32x16 (&acc)[2][2], const bf16_t* const (&ap)[4], const bf16_t* const (&bp)[4], int nk, char* lds) {
  constexpr int STAGE = A_BYTES + 128 * LROW;
  const int t = TIDX, lane = t & 63, wid = t >> 6, wr = wid >> 1, wc = wid & 1, l31 = lane & 31, hh = lane >> 5;
  const int aoff = (wr * 64 + l31) * LROW + hh * 16, boff = A_BYTES + (wc * 64 + l31) * LROW + hh * 16, soff = (t >> 3) * LROW + (t & 7) * 16;
  u32x4 ra0[4], rb0[4], ra1[4], rb1[4];
  auto gload = [&](u32x4 (&ra)[4], u32x4 (&rb)[4], int kt) {
#pragma unroll
    for (int i = 0; i < 4; ++i) { ra[i] = ldg16(ap[i] + kt * 64); rb[i] = ldg16(bp[i] + kt * 64); }
  };
  auto sstore = [&](const u32x4 (&ra)[4], const u32x4 (&rb)[4], char* st) {
#pragma unroll
    for (int i = 0; i < 4; ++i) { sts16(st + soff + 32 * i * LROW, ra[i]); sts16(st + A_BYTES + soff + 32 * i * LROW, rb[i]); }
  };
  auto compute = [&](const char* cur) {
#pragma unroll
    for (int ks = 0; ks < 4; ++ks) {
      bf16x8 af[2], bfr[2];
#pragma unroll
      for (int m = 0; m < 2; ++m) af[m] = lds_frag(cur + aoff + m * 32 * LROW + ks * 32);
#pragma unroll
      for (int n = 0; n < 2; ++n) bfr[n] = lds_frag(cur + boff + n * 32 * LROW + ks * 32);
#pragma unroll
      for (int m = 0; m < 2; ++m)
#pragma unroll
        for (int n = 0; n < 2; ++n) acc[m][n] = MFMA32(bfr[n], af[m], acc[m][n]);
    }
  };
  gload(ra0, rb0, 0); gload(ra1, rb1, 1);
  sstore(ra0, rb0, lds);
  __syncthreads();
#pragma unroll 1
  for (int kt = 0; kt < nk; kt += 2) {
    if (kt + 2 < nk) gload(ra0, rb0, kt + 2);
    compute(lds);
    sstore(ra1, rb1, lds + STAGE);
    __syncthreads();
    if (kt + 3 < nk) gload(ra1, rb1, kt + 3);
    compute(lds + STAGE);
    if (kt + 2 < nk) sstore(ra0, rb0, lds);
    __syncthreads();
  }
}
DI void ph_gemm_plain32(const bf16_t* A, int lda, const bf16_t* Bt, int ldb, int M, int N, int K, bf16_t* C, int ldc, char* lds, int bid, int nblk) {
  const int t = TIDX, lane = t & 63, wid = t >> 6, wr = wid >> 1, wc = wid & 1, lr = t >> 3, lc = (t & 7) * 8, l31 = lane & 31, hh = lane >> 5;
  const int ntn = N / 128, nt = (M / 128) * ntn;
#pragma unroll 1
  for (int tile = bid; tile < nt; tile += nblk) {
    const int tm = tile / ntn, tn = tile % ntn;
    const bf16_t* ap[4]; const bf16_t* bp[4];
#pragma unroll
    for (int i = 0; i < 4; ++i) { ap[i] = A + (size_t)(tm * 128 + lr + 32 * i) * lda + lc; bp[i] = Bt + (size_t)(tn * 128 + lr + 32 * i) * ldb + lc; }
    f32x16 acc[2][2];
#pragma unroll
    for (int m = 0; m < 2; ++m)
#pragma unroll
      for (int n = 0; n < 2; ++n) acc[m][n] = (f32x16)(0.f);
    gemm_kloop32(acc, ap, bp, K / 64, lds);
#pragma unroll
    for (int m = 0; m < 2; ++m)
#pragma unroll
      for (int n = 0; n < 2; ++n)
#pragma unroll
        for (int g = 0; g < 4; ++g) {
          f32x4 o = {acc[m][n][4 * g], acc[m][n][4 * g + 1], acc[m][n][4 * g + 2], acc[m][n][4 * g + 3]};
          st_bf16x4(C + (size_t)(tm * 128 + wr * 64 + m * 32 + l31) * ldc + tn * 128 + wc * 64 + n * 32 + 8 * g + 4 * hh, o);
        }
  }
}
template <int MODE>
DI void ph_gemm_probe(const bf16_t* A, int lda, const bf16_t* Bt, int ldb, int M, int N, int K, float* sink, char* lds, int bid, int nblk) {
  const int t = TIDX, lane = t & 63, wid = t >> 6, wr = wid >> 1, wc = wid & 1, lr = t >> 3, lc = (t & 7) * 8, fr = lane & 15, fq = lane >> 4;
  const int ntn = N / 128, nt = (M / 128) * ntn, nk = K / 64;
  constexpr int STAGE = A_BYTES + 128 * LROW;
  const int aoff = (wr * 64 + fr) * LROW + fq * 16, boff = A_BYTES + (wc * 64 + fr) * LROW + fq * 16;
#pragma unroll 1
  for (int tile = bid; tile < nt; tile += nblk) {
    f32x4 acc[4][4]; acc_zero<4>(acc);
    bf16x8 af[4], bfr[4];
    const int tm = tile / ntn, tn = tile % ntn;
    const bf16_t* ap[4]; const bf16_t* bp[4];
#pragma unroll
    for (int i = 0; i < 4; ++i) { ap[i] = A + (size_t)(tm * 128 + lr + 32 * i) * lda + lc; bp[i] = Bt + (size_t)(tn * 128 + lr + 32 * i) * ldb + lc; }
    u32x4 ra[4], rb[4], junk = {0u, 0u, 0u, 0u};
#pragma unroll
    for (int i = 0; i < 4; ++i) { ra[i] = junk; rb[i] = junk; }
#pragma unroll 1
    for (int kt = 0; kt < nk; ++kt) {
      const char* cur = lds + (kt & 1) * STAGE;
#pragma unroll
      for (int i = 0; i < 4; ++i) { ra[i] = ldg16(ap[i] + kt * 64); if (MODE == 3) rb[i] = ldg16(bp[i] + kt * 64); }
#pragma unroll
      for (int ks = 0; ks < 2; ++ks) {
#pragma unroll
        for (int m = 0; m < 4; ++m) { af[m] = lds_frag(cur + aoff + m * 16 * LROW + ks * 64); bfr[m] = lds_frag(cur + boff + m * 16 * LROW + ks * 64); }
#pragma unroll
        for (int m = 0; m < 4; ++m)
#pragma unroll
          for (int n = 0; n < 4; ++n) acc[m][n] = MFMA16(bfr[n], af[m], acc[m][n]);
      }
      junk.x ^= ra[0].x ^ ra[1].y ^ ra[2].z ^ ra[3].w ^ rb[0].x ^ rb[1].y ^ rb[2].z ^ rb[3].w;
      __syncthreads();
    }
    float s = (float)(junk.x & 1u);
#pragma unroll
    for (int m = 0; m < 4; ++m)
#pragma unroll
      for (int n = 0; n < 4; ++n) s += acc[m][n][0] + acc[m][n][3];
    if (s == 123456.789f) sink[0] = s;
  }
}
DI void ph_moe1(const Params& p, int need_ctx, char* lds, int bid, int nblk) {
  const int t = TIDX, lane = t & 63, wid = t >> 6, wr = wid >> 1, wc = wid & 1, lr = t >> 3, lc = (t & 7) * 8, fr = lane & 15, fq = lane >> 4;
  constexpr int NTN = FF / 64;
  const int NTM = need_ctx ? (NSLOT + 127) / 128 : (NB * CAPL) / 128;
  for (int u = bid; u < NE * NTM * NTN; u += nblk) {
    const int tile = xcd_swz(u, NE * NTM * NTN), e = tile / (NTM * NTN), rem = tile % (NTM * NTN);
    int tm, tn, rr = rem, g = 0;
    if (rr >= NTM * 8) { rr -= NTM * 8; g = 1; }
    if (rr >= NTM * 8) { rr -= NTM * 8; g = 2; }
    if (g < 2) { tm = rr >> 3; tn = g * 8 + (rr & 7); } else { tm = rr / (NTN - 16); tn = 16 + rr - tm * (NTN - 16); }
    const bf16_t* ap[4]; const bf16_t* bp[4];
#pragma unroll
    for (int i = 0; i < 4; ++i) {
      const int slot = tm * 128 + lr + 32 * i;
      int r = slot < NSLOT ? p.SEL[(size_t)e * NSLOT + slot] : -1;
      ap[i] = p.H + (size_t)(r < 0 ? 0 : r) * D + lc;
      const int rho = lr + 32 * i, wci = rho >> 6, gu = (rho >> 5) & 1, col = wci * 32 + (rho & 31);
      bp[i] = (gu ? p.Wt_eu : p.Wt_eg) + ((size_t)e * FF + tn * 64 + col) * D + lc;
    }
    f32x4 acc[4][4]; acc_zero<4>(acc);
    gemm_kloop<4>(acc, ap, bp, D / 64, lds);
    f32x4 hid[4][2];
#pragma unroll
    for (int m = 0; m < 4; ++m) {
      const int slot = tm * 128 + wr * 64 + m * 16 + fr;
      const bool valid = slot < NSLOT && p.SEL[(size_t)e * NSLOT + (slot < NSLOT ? slot : 0)] >= 0;
#pragma unroll
      for (int n = 0; n < 2; ++n)
#pragma unroll
        for (int j = 0; j < 4; ++j) { const float g = acc[m][n][j], u = acc[m][n + 2][j]; hid[m][n][j] = valid ? g * u * fast_rcp(1.0f + fast_exp2(-LOG2E * g)) : 0.f; }
    }
    const int slot0 = tm * 128 + wr * 64;
    store_wave_tile<2>(hid, p.HID + ((size_t)e * NSLOT + slot0) * FF + tn * 64 + wc * 32, (size_t)FF, lds + wid * (64 * 80), lane, [&](int r) { return slot0 + r < NSLOT; });
    __syncthreads();
  }
}
DI void ph_moe2(const Params& p, int need_ctx, char* lds, int bid, int nblk) {
  const int t = TIDX, lane = t & 63, wid = t >> 6, wr = wid >> 1, wc = wid & 1, lr = t >> 3, lc = (t & 7) * 8, fr = lane & 15, fq = lane >> 4;
  constexpr int NTN = D / 128;
  const int NTM = need_ctx ? (NSLOT + 127) / 128 : (NB * CAPL) / 128;
  for (int u = bid; u < NE * NTM * NTN; u += nblk) {
    const int tile = xcd_swz(u, NE * NTM * NTN), e = tile / (NTM * NTN), rem = tile % (NTM * NTN), tm = rem / NTN, tn = rem % NTN;
    const bf16_t* ap[4]; const bf16_t* bp[4];
#pragma unroll
    for (int i = 0; i < 4; ++i) {
      int slot = tm * 128 + lr + 32 * i; if (slot >= NSLOT) slot = NSLOT - 1;
      ap[i] = p.HID + ((size_t)e * NSLOT + slot) * FF + lc;
      bp[i] = p.Wt_ed + ((size_t)e * D + tn * 128 + lr + 32 * i) * FF + lc;
    }
    f32x4 acc[4][4]; acc_zero<4>(acc);
    gemm_kloop<4>(acc, ap, bp, FF / 64, lds);
#pragma unroll
    for (int m = 0; m < 4; ++m) {
      const int slot = tm * 128 + wr * 64 + m * 16 + fr;
      const float val = (slot < NSLOT && p.SEL[(size_t)e * NSLOT + (slot < NSLOT ? slot : 0)] >= 0) ? p.SELV[(size_t)e * NSLOT + slot] : 0.f;
#pragma unroll
      for (int n = 0; n < 4; ++n) { acc[m][n].x *= val; acc[m][n].y *= val; acc[m][n].z *= val; acc[m][n].w *= val; }
    }
    const int slot0 = tm * 128 + wr * 64;
    store_wave_tile<4>(acc, p.YE + ((size_t)e * NSLOT + slot0) * D + tn * 128 + wc * 64, (size_t)D, lds + wid * (64 * 144), lane, [&](int r) { return slot0 + r < NSLOT; });
    __syncthreads();
  }
}
constexpr int GEMM_LDS = 2 * (A_BYTES + 128 * LROW);

DI void unpack8(u32x4 v, float (&f)[8]) {
  f[0] = u2f(v.x << 16); f[1] = u2f(v.x & 0xffff0000u); f[2] = u2f(v.y << 16); f[3] = u2f(v.y & 0xffff0000u);
  f[4] = u2f(v.z << 16); f[5] = u2f(v.z & 0xffff0000u); f[6] = u2f(v.w << 16); f[7] = u2f(v.w & 0xffff0000u);
}
DI u32x4 pack8f(const float (&f)[8]) { u32x4 v; v.x = pack2bf(f[0], f[1]); v.y = pack2bf(f[2], f[3]); v.z = pack2bf(f[4], f[5]); v.w = pack2bf(f[6], f[7]); return v; }
DI void rope8(float (&a)[8], const float (&pr)[8], int cc, const float* cs, const float* sn) {
  const int ax = (cc >> 1) * 8; const bool second = cc & 1;
#pragma unroll
  for (int i = 0; i < 8; ++i) a[i] = second ? a[i] * cs[ax + i] + pr[i] * sn[ax + i] : a[i] * cs[ax + i] - pr[i] * sn[ax + i];
}
constexpr int PREP_LDS = 64 * 4 + 2 * 512 * 4 + 32 * 528;
template <int PARTS = 3>
DI void ph_prep(const Params& p, int layer, const bf16_t* QRAW, const bf16_t* KVRAW, char* lds, int bid, int nblk) {
  float* s_rstd = (float*)lds;
  float* s_cs = s_rstd + 64;
  float* s_sn = s_cs + 512;
  bf16_t* s_t = (bf16_t*)(s_sn + 512);
  const int t = TIDX;
  constexpr int UPB = TK / 32, NU = NB * UPB;
  const float* wcv = p.w_conv + (size_t)layer * 3 * 512;
#pragma unroll 1
  for (int u = bid; u < NU; u += nblk) {
    int b, s0;
    if (u < NB * (TL / 32)) { b = u / (TL / 32); s0 = TC + (u % (TL / 32)) * 32; } else { const int v = u - NB * (TL / 32); b = v / (TC / 32); s0 = (v % (TC / 32)) * 32; }
    const int r0 = row_of(b, s0);
    {
      const int tok = t >> 3, part = t & 7;
      const bf16_t* z = p.Z + (size_t)(r0 + tok) * NZP;
      float sq = 0.f, sk = 0.f, f[8];
#pragma unroll
      for (int k = 0; k < 4; ++k) { unpack8(ldg16(z + ZC_QLAT + part * 32 + k * 8), f);
#pragma unroll
        for (int i = 0; i < 8; ++i) sq += f[i] * f[i]; }
#pragma unroll
      for (int k = 0; k < 2; ++k) { unpack8(ldg16(z + ZC_KVLAT + part * 16 + k * 8), f);
#pragma unroll
        for (int i = 0; i < 8; ++i) sk += f[i] * f[i]; }
      sq = xor_sum<1>(sq); sk = xor_sum<1>(sk);
      sq = xor_sum<2>(sq); sk = xor_sum<2>(sk);
      sq = xor_sum<4>(sq); sk = xor_sum<4>(sk);
      if (part == 0) { s_rstd[tok * 2] = 1.0f / sqrtf(sq * (1.0f / 256) + 1e-6f); s_rstd[tok * 2 + 1] = 1.0f / sqrtf(sk * (1.0f / 128) + 1e-6f); }
    }
    for (int i = t; i < 512; i += NTHR) {
      const int tok = i >> 4, af = i & 15, s = s0 + tok;
      float cs = 1.f, sn = 0.f;
      if (s >= TC) rope_cs(s, (af >> 3) * 16 + (af & 7), cs, sn);
      s_cs[i] = cs; s_sn[i] = sn;
    }
    __syncthreads();
    if (PARTS & 1) {
#pragma unroll 2
    for (int i = t; i < 32 * 48; i += NTHR) {
      const int tok = i / 48, c = i % 48, h = c / 12, ch = c % 12;
      const float rq = s_rstd[tok * 2] * QS_MLA, rkv = s_rstd[tok * 2 + 1];
      const bf16_t* q = QRAW + (size_t)(r0 + tok) * 384 + h * 96;
      float a[8], pr[8];
      unpack8(ldg16(q + ch * 8), a);
      if (ch >= 8) { unpack8(ldg16(q + 64 + ((ch - 8) ^ 1) * 8), pr); rope8(a, pr, ch - 8, s_cs + tok * 16, s_sn + tok * 16); }
#pragma unroll
      for (int e = 0; e < 8; ++e) a[e] *= rq;
      *(u32x4*)(p.Qm + (((size_t)b * 4 + h) * TK + s0 + tok) * 96 + ch * 8) = pack8f(a);
      if (ch < 8) {
        unpack8(ldg16(KVRAW + (size_t)(r0 + tok) * 512 + h * 128 + ch * 8), a);
#pragma unroll
        for (int e = 0; e < 8; ++e) a[e] *= rkv;
      } else {
        const bf16_t* z = p.Z + (size_t)(r0 + tok) * NZP + ZC_KROPE;
        unpack8(ldg16(z + (ch - 8) * 8), a); unpack8(ldg16(z + ((ch - 8) ^ 1) * 8), pr);
        rope8(a, pr, ch - 8, s_cs + tok * 16, s_sn + tok * 16);
      }
      *(u32x4*)(p.Km + (((size_t)b * 4 + h) * TK + s0 + tok) * 96 + ch * 8) = pack8f(a);
    }
#pragma unroll 2
    for (int i = t; i < 32 * 64; i += NTHR) {
      const int tok = i >> 6, c = i & 63, qk = c >> 5, hm = (c >> 2) & 7, cc = c & 3;
      const bf16_t* src = p.Z + (size_t)(r0 + tok) * NZP + (qk ? ZC_DK : ZC_DQ) + hm * 32;
      float a[8], pr[8];
      unpack8(ldg16(src + cc * 8), a); unpack8(ldg16(src + (cc ^ 1) * 8), pr);
      rope8(a, pr, cc, s_cs + tok * 16, s_sn + tok * 16);
      if (qk == 0) {
#pragma unroll
        for (int e = 0; e < 8; ++e) a[e] *= QS_DIFF;
        *(u32x4*)(p.Qd + (((size_t)b * 8 + hm) * TK + s0 + tok) * 32 + cc * 8) = pack8f(a);
      } else *(u32x4*)(p.Kd + (((size_t)b * 8 + hm) * TK + s0 + tok) * 32 + cc * 8) = pack8f(a);
    }
#pragma unroll 2
    for (int i = t; i < 32 * 64; i += NTHR) {
      const int tok = i >> 6, c8 = (i & 63) * 8, s = s0 + tok;
      const bool first = (s == 0) || (s == TC), last = (s == TC - 1) || (s == TK - 1);
      const bf16_t* z = p.Z + (size_t)(r0 + tok) * NZP + ZC_MLQK + c8;
      float x0[8], xm[8], xp[8], o[8];
      unpack8(ldg16(z), x0);
      if (!first) unpack8(ldg16(z - NZP), xm);
      if (!last) unpack8(ldg16(z + NZP), xp);
      float bc8[8], w0[8], w1[8], w2[8];
      *(f32x4*)bc8 = *(const f32x4*)(p.b_conv + layer * 512 + c8); *(f32x4*)(bc8 + 4) = *(const f32x4*)(p.b_conv + layer * 512 + c8 + 4);
      *(f32x4*)w0 = *(const f32x4*)(wcv + c8); *(f32x4*)(w0 + 4) = *(const f32x4*)(wcv + c8 + 4);
      *(f32x4*)w1 = *(const f32x4*)(wcv + 512 + c8); *(f32x4*)(w1 + 4) = *(const f32x4*)(wcv + 512 + c8 + 4);
      *(f32x4*)w2 = *(const f32x4*)(wcv + 1024 + c8); *(f32x4*)(w2 + 4) = *(const f32x4*)(wcv + 1024 + c8 + 4);
#pragma unroll
      for (int e = 0; e < 8; ++e) {
        float acc = bc8[e] + x0[e] * w1[e];
        if (!first) acc += xm[e] * w0[e];
        if (!last) acc += xp[e] * w2[e];
        o[e] = acc * fast_rcp(1.0f + fast_exp2(-LOG2E * acc));
      }
      if (c8 < 256) *(u32x4*)(p.MQ + ((size_t)b * TK + s) * 256 + c8) = pack8f(o);
      else {
#pragma unroll
        for (int e = 0; e < 8; ++e) o[e] *= 0.125f;
        *(u32x4*)(p.MK + ((size_t)b * TK + s) * 256 + c8 - 256) = pack8f(o);
      }
    }
    }
#pragma unroll 1
    for (int w = 0; w < ((PARTS & 2) ? 4 : 0); ++w) {
      __syncthreads();
#pragma unroll
      for (int k = 0; k < 4; ++k) {
        const int i = t + k * NTHR, tok = i >> 5, c8 = (i & 31) * 8;
        u32x4 v;
        if (w == 0) { float a[8]; const int h = c8 >> 6; unpack8(ldg16(KVRAW + (size_t)(r0 + tok) * 512 + h * 128 + 64 + (c8 & 63)), a); const float rkv = s_rstd[tok * 2 + 1];
#pragma unroll
          for (int e = 0; e < 8; ++e) a[e] *= rkv;
          v = pack8f(a); }
        else v = ldg16(p.Z + (size_t)(r0 + tok) * NZP + (w == 1 ? ZC_DV : (w == 2 ? ZC_MLV : ZC_GV)) + c8);
        *(u32x4*)(s_t + tok * 264 + c8) = v;
      }
      __syncthreads();
      bf16_t* dst = w == 0 ? p.Vtm : (w == 1 ? p.Vtd : (w == 2 ? p.MVt : p.GVt));
#pragma unroll
      for (int k = 0; k < 4; ++k) {
        const int i = t + k * NTHR, tg = i & 3, ch = i >> 2;
        u32x4 v;
        v.x = (unsigned)s_t[(tg * 8 + 0) * 264 + ch] | ((unsigned)s_t[(tg * 8 + 1) * 264 + ch] << 16);
        v.y = (unsigned)s_t[(tg * 8 + 2) * 264 + ch] | ((unsigned)s_t[(tg * 8 + 3) * 264 + ch] << 16);
        v.z = (unsigned)s_t[(tg * 8 + 4) * 264 + ch] | ((unsigned)s_t[(tg * 8 + 5) * 264 + ch] << 16);
        v.w = (unsigned)s_t[(tg * 8 + 6) * 264 + ch] | ((unsigned)s_t[(tg * 8 + 7) * 264 + ch] << 16);
        *(u32x4*)(dst + (((size_t)b * 4 + (ch >> 6)) * 64 + (ch & 63)) * TK + s0 + tg * 8) = v;
      }
    }
    __syncthreads();
  }
}
constexpr int VROW = 136;
constexpr int VROW_A = 144;
template <int DQK> struct AttnCfg {
  static constexpr int KROW = DQK * 2 + 16;
  static constexpr int KBYTES = 64 * KROW, VBYTES = 64 * VROW_A, STAGE = KBYTES + VBYTES;
  static constexpr int KCH = 64 * DQK * 2 / 16 / NTHR;
};
DI bf16x8 pack8(const f32x16& x, int s) {
  u32x4 pk; pk.x = pack2bf(x[8 * s], x[8 * s + 1]); pk.y = pack2bf(x[8 * s + 2], x[8 * s + 3]); pk.z = pack2bf(x[8 * s + 4], x[8 * s + 5]); pk.w = pack2bf(x[8 * s + 6], x[8 * s + 7]);
  return __builtin_bit_cast(bf16x8, pk);
}
struct TrueC { static constexpr bool value = true; };
struct FalseC { static constexpr bool value = false; };
template <int DQK, int NMAP, int VAR = 0>
DI void attn_unit(const bf16_t* __restrict__ Qb, const bf16_t* __restrict__ Kb, size_t mstride, const bf16_t* __restrict__ Vt, int q0, int nkeys,
                  f32x16 (&O)[NMAP][2], float (&lsum)[NMAP], char* lds) {
  constexpr int DM = DQK / NMAP;
  constexpr int KS = DM / 16;
  using C = AttnCfg<DQK>;
  constexpr int CPM = 64 * DM * 2 / 16;
  constexpr int CPR = DM * 2 / 16;
  const int t = TIDX, lane = t & 63, wid = t >> 6, l31 = lane & 31, hh = lane >> 5;
  bf16x8 qf[NMAP][KS];
#pragma unroll
  for (int m = 0; m < NMAP; ++m)
#pragma unroll
    for (int ks = 0; ks < KS; ++ks) qf[m][ks] = *(const bf16x8*)(Qb + m * mstride + (size_t)(q0 + wid * 32 + l31) * DM + ks * 16 + 8 * hh);
  float mref[NMAP];
#pragma unroll
  for (int m = 0; m < NMAP; ++m) { mref[m] = 0.f; lsum[m] = 0.f; O[m][0] = (f32x16)(0.f); O[m][1] = (f32x16)(0.f); }
  u32x4 rk[C::KCH], rv[2];
  const bf16_t* kg[C::KCH]; int klds[C::KCH];
#pragma unroll
  for (int i = 0; i < C::KCH; ++i) { const int c = t + i * NTHR, m = c / CPM, cc = c % CPM; kg[i] = Kb + m * mstride + cc * 8; klds[i] = (cc / CPR) * C::KROW + m * DM * 2 + (cc % CPR) * 16; }
  const bf16_t* vg = Vt + (size_t)(t >> 3) * TK + (t & 7) * 8;
  const int vlds = C::KBYTES + (t >> 3) * VROW_A + ((t & 7) >> 1) * 32 + ((t & 1) ? 8 : 0);
  const int kfoff = l31 * C::KROW + 16 * hh, vfoff = C::KBYTES + l31 * VROW_A + 16 * hh;
  const int nt = nkeys / 64;
#pragma unroll
  for (int i = 0; i < C::KCH; ++i) rk[i] = ldg16(kg[i]);
  rv[0] = ldg16(vg); rv[1] = ldg16(vg + (size_t)32 * TK);
  auto tile = [&](const int kt, auto chk_c, auto ref_c) __attribute__((always_inline)) {
    constexpr bool CHK = decltype(chk_c)::value, REF = decltype(ref_c)::value;
    char* cur = lds + (kt & 1) * C::STAGE;
    if (VAR != 2) {
#pragma unroll
    for (int i = 0; i < C::KCH; ++i) sts16(cur + klds[i], rk[i]);
#pragma unroll
    for (int i = 0; i < 2; ++i) { char* d = cur + vlds + i * 32 * VROW_A; u32x2 lo, hi; lo.x = rv[i].x; lo.y = rv[i].y; hi.x = rv[i].z; hi.y = rv[i].w; *(u32x2*)d = lo; *(u32x2*)(d + 16) = hi; }
    __syncthreads();
    }
    if (VAR != 2 && kt + 1 < nt) {
#pragma unroll
      for (int i = 0; i < C::KCH; ++i) rk[i] = ldg16(kg[i] + (size_t)(kt + 1) * 64 * DM);
      rv[0] = ldg16(vg + (kt + 1) * 64); rv[1] = ldg16(vg + (size_t)32 * TK + (kt + 1) * 64);
    }
    bf16x8 kf[NMAP][2][KS];
#pragma unroll
    for (int k2 = 0; k2 < 2; ++k2)
#pragma unroll
      for (int ks = 0; ks < KS; ++ks) kf[0][k2][ks] = lds_frag(cur + kfoff + k2 * 32 * C::KROW + ks * 32);
    f32x16 S[NMAP][2];
    S[0][0] = (f32x16)(0.f); S[0][1] = (f32x16)(0.f);
#pragma unroll
    for (int ks = 0; ks < KS; ++ks)
#pragma unroll
      for (int k2 = 0; k2 < 2; ++k2) S[0][k2] = MFMA32(kf[0][k2][ks], qf[0][ks], S[0][k2]);
    bf16x8 vf[4][2];
#pragma unroll
    for (int kst = 0; kst < 4; ++kst)
#pragma unroll
      for (int dvt = 0; dvt < 2; ++dvt) vf[kst][dvt] = lds_frag(cur + vfoff + dvt * 32 * VROW_A + kst * 32);
#pragma unroll
    for (int m = 1; m < NMAP; ++m)
#pragma unroll
      for (int k2 = 0; k2 < 2; ++k2)
#pragma unroll
        for (int ks = 0; ks < KS; ++ks) kf[m][k2][ks] = lds_frag(cur + kfoff + k2 * 32 * C::KROW + m * DM * 2 + ks * 32);
#pragma unroll
    for (int m = 0; m < NMAP; ++m) {
      if (m > 0) {
        SCHED_BARRIER();
        S[m][0] = (f32x16)(0.f); S[m][1] = (f32x16)(0.f);
#pragma unroll
        for (int ks = 0; ks < KS; ++ks)
#pragma unroll
          for (int k2 = 0; k2 < 2; ++k2) S[m][k2] = MFMA32(kf[m][k2][ks], qf[m][ks], S[m][k2]);
      }
      if (VAR != 1) {
      if (CHK && (kt & 7) == 0) {
        float mx = fmaxf(S[m][0][0], S[m][1][0]);
#pragma unroll
        for (int i = 1; i < 16; ++i) mx = fmaxf(mx, fmaxf(S[m][0][i], S[m][1][i]));
        mx = xor_max<32>(mx);
        const float rel = mx - mref[m];
        const float delta = (kt == 0) ? ((mx > ATT_THR || mx < -ATT_THR) ? mx : 0.0f) : (rel > ATT_THR ? rel : 0.0f);
        if (wave_any(delta != 0.0f)) {
          const float alpha = fast_exp2(-delta);
          mref[m] += delta; lsum[m] *= alpha;
#pragma unroll
          for (int dvt = 0; dvt < 2; ++dvt)
#pragma unroll
            for (int i = 0; i < 16; ++i) O[m][dvt][i] *= alpha;
        }
      }
      if constexpr (REF) {
        if (wave_any(mref[m] != 0.0f)) {
          const f32x2 nm = {-mref[m], -mref[m]};
#pragma unroll
          for (int k2 = 0; k2 < 2; ++k2)
#pragma unroll
            for (int i = 0; i < 16; i += 2) { const f32x2 x = (f32x2){S[m][k2][i], S[m][k2][i + 1]} + nm; S[m][k2][i] = x.x; S[m][k2][i + 1] = x.y; }
        }
      }
      f32x2 ps2 = {0.f, 0.f};
#pragma unroll
      for (int k2 = 0; k2 < 2; ++k2)
#pragma unroll
        for (int i = 0; i < 16; i += 2) {
          const float e0 = fast_exp2(S[m][k2][i]), e1 = fast_exp2(S[m][k2][i + 1]);
          S[m][k2][i] = e0; S[m][k2][i + 1] = e1; ps2 += (f32x2){e0, e1};
        }
      lsum[m] += ps2.x + ps2.y;
      } else lsum[m] += 1.0f;
#pragma unroll
      for (int kst = 0; kst < 4; ++kst) {
        const bf16x8 pf = pack8(S[m][kst >> 1], kst & 1);
#pragma unroll
        for (int dvt = 0; dvt < 2; ++dvt) O[m][dvt] = MFMA32(vf[kst][dvt], pf, O[m][dvt]);
      }
    }
  };
  int kt = 0;
#pragma unroll 1
  while (kt < nt) {
    tile(kt, TrueC{}, TrueC{});
    ++kt;
    bool nz = false;
#pragma unroll
    for (int m = 0; m < NMAP; ++m) nz = nz || (mref[m] != 0.0f);
    if (!wave_any(nz)) {
      const int k8 = (kt + 7) & ~7, kend = k8 < nt ? k8 : nt;
#pragma unroll 1
      for (; kt < kend; ++kt) tile(kt, FalseC{}, FalseC{});
    }
  }
  __syncthreads();
#pragma unroll
  for (int m = 0; m < NMAP; ++m) lsum[m] = xor_sum<32>(lsum[m]);
}
constexpr int ATT_QB = TK / 128;
constexpr int ATT_LDS = 2 * AttnCfg<96>::STAGE;
constexpr int ATT_QBL = TL / 128, ATT_QBC = TC / 128, ATT_LAT_UNITS = NB * 4 * ATT_QBL, ATT_UNITS = ATT_LAT_UNITS + NB * 4 * ATT_QBC;
DI void att_unit(int u, int& bh, int& qb) {
  if (u < ATT_LAT_UNITS) { bh = u & 7; qb = ATT_QBC + (u >> 3); } else { const int v = u - ATT_LAT_UNITS; bh = v & 7; qb = v >> 3; }
}
DI void ph_attn_diff(const Params& p, int layer, int need_ctx, char* lds, int bid, int nblk) {
  const int lane = TIDX & 63, wid = TIDX >> 6, l31 = lane & 31, hh = lane >> 5;
  float lam_init; const float lam = lam_of(p, layer, lam_init);
#pragma unroll 1
  for (int u = bid; u < (need_ctx ? ATT_UNITS : ATT_LAT_UNITS); u += nblk) {
    int bh, qb; att_unit(u, bh, qb);
    const int b = bh >> 2, h = bh & 3, q0 = qb * 128;
    const int r = row_of(b, q0 + wid * 32 + l31);
    f32x16 O[2][2]; float ls[2];
    attn_unit<64, 2>(p.Qd + ((size_t)b * 8 + h * 2) * TK * 32, p.Kd + ((size_t)b * 8 + h * 2) * TK * 32, (size_t)TK * 32, p.Vtd + ((size_t)b * 4 + h) * 64 * TK, q0,
                     q0 < TC ? TC : TK, O, ls, lds);
    const float i0 = 1.0f / ls[0], i1 = lam / ls[1];
    float ss = 0.f;
#pragma unroll
    for (int dvt = 0; dvt < 2; ++dvt)
#pragma unroll
      for (int i = 0; i < 16; ++i) { const float o = O[0][dvt][i] * i0 - O[1][dvt][i] * i1; O[0][dvt][i] = o; ss += o * o; }
    ss = xor_sum<32>(ss);
    const float rstd = (1.0f - lam_init) / sqrtf(ss * (1.0f / 64) + 1e-6f);
    const float* gd = p.g_diff_out + layer * 256 + h * 64;
#pragma unroll
    for (int dvt = 0; dvt < 2; ++dvt)
#pragma unroll
      for (int g = 0; g < 4; ++g) {
        const int dv = dvt * 32 + 8 * g + 4 * hh;
        const f32x4 gv = *(const f32x4*)(gd + dv);
        f32x4 o = {O[0][dvt][4 * g] * rstd * gv[0], O[0][dvt][4 * g + 1] * rstd * gv[1], O[0][dvt][4 * g + 2] * rstd * gv[2], O[0][dvt][4 * g + 3] * rstd * gv[3]};
        st_bf16x4(p.Y + (size_t)r * D + 768 + h * 64 + dv, o);
      }
  }
}
DI void ph_attn_mla(const Params& p, int need_ctx, char* lds, int bid, int nblk) {
  const int lane = TIDX & 63, wid = TIDX >> 6, l31 = lane & 31, hh = lane >> 5;
#pragma unroll 1
  for (int u = bid; u < (need_ctx ? ATT_UNITS : ATT_LAT_UNITS); u += nblk) {
    int bh, qb; att_unit(u, bh, qb);
    const int b = bh >> 2, h = bh & 3, q0 = qb * 128;
    const int r = row_of(b, q0 + wid * 32 + l31);
    f32x16 O[1][2]; float ls[1];
    attn_unit<96, 1>(p.Qm + ((size_t)b * 4 + h) * TK * 96, p.Km + ((size_t)b * 4 + h) * TK * 96, 0, p.Vtm + ((size_t)b * 4 + h) * 64 * TK, q0, q0 < TC ? TC : TK, O, ls, lds);
    const float inv = 1.0f / ls[0];
#pragma unroll
    for (int dvt = 0; dvt < 2; ++dvt)
#pragma unroll
      for (int g = 0; g < 4; ++g) {
        f32x4 o = {O[0][dvt][4 * g] * inv, O[0][dvt][4 * g + 1] * inv, O[0][dvt][4 * g + 2] * inv, O[0][dvt][4 * g + 3] * inv};
        st_bf16x4(p.Y + (size_t)r * D + h * 64 + dvt * 32 + 8 * g + 4 * hh, o);
      }
  }
}
template <int VAR> DI void ph_attn_mla_probe(const Params& p, char* lds, int bid, int nblk) {
  const int lane = TIDX & 63, wid = TIDX >> 6, l31 = lane & 31, hh = lane >> 5;
#pragma unroll 1
  for (int u = bid; u < ATT_LAT_UNITS; u += nblk) {
    int bh, qb; att_unit(u, bh, qb);
    const int b = bh >> 2, h = bh & 3, q0 = qb * 128;
    const int r = row_of(b, q0 + wid * 32 + l31);
    f32x16 O[1][2]; float ls[1];
    attn_unit<96, 1, VAR>(p.Qm + ((size_t)b * 4 + h) * TK * 96, p.Km + ((size_t)b * 4 + h) * TK * 96, 0, p.Vtm + ((size_t)b * 4 + h) * 64 * TK, q0, TK, O, ls, lds);
    const float inv = 1.0f / ls[0];
#pragma unroll
    for (int dvt = 0; dvt < 2; ++dvt)
#pragma unroll
      for (int g = 0; g < 4; ++g) {
        f32x4 o = {O[0][dvt][4 * g] * inv, O[0][dvt][4 * g + 1] * inv, O[0][dvt][4 * g + 2] * inv, O[0][dvt][4 * g + 3] * inv};
        *(f32x4*)(p.out + (size_t)r * D + h * 64 + dvt * 32 + 8 * g + 4 * hh) = o;
      }
  }
}
DI void ph_attn(const Params& p, int layer, int need_ctx, char* lds, int bid, int nblk) {
  ph_attn_diff(p, layer, need_ctx, lds, bid, nblk);
  ph_attn_mla(p, need_ctx, lds, bid, nblk);
}

DI float wave_sum(float v) {
  v = xor_sum<1>(v); v = xor_sum<2>(v); v = xor_sum<4>(v); v = xor_sum<8>(v); v = xor_sum<16>(v); v = xor_sum<32>(v);
  return v;
}
DI void ld_row16(const float* row, int lane, f32x4 (&v)[4]) {
#pragma unroll
  for (int i = 0; i < 4; ++i) v[i] = *(const f32x4*)(row + 256 * i + 4 * lane);
}
DI void ld_row16_bf(const bf16_t* row, int lane, f32x4 (&v)[4]) {
#pragma unroll
  for (int i = 0; i < 4; ++i) { const u32x2 u = *(const u32x2*)(row + 256 * i + 4 * lane); v[i] = (f32x4){u2f(u.x << 16), u2f(u.x & 0xffff0000u), u2f(u.y << 16), u2f(u.y & 0xffff0000u)}; }
}
DI void ph_modulate(const Params& p, int layer, const float* xl, const float* xcx, int bid, int nblk) {
  const int lane = TIDX & 63, wid = TIDX >> 6;
  const float* g = p.g_mix_pre + layer * 1024;
  for (int r = bid * 4 + wid; r < R; r += nblk * 4) {
    const int w = r < RL ? r / TL : 2;
    const float* mb = p.mods + (size_t)(layer * 3 + w) * 6144;
    const float* x = r < RL ? xl + (size_t)r * D : xcx + (size_t)(r - RL) * D;
    f32x4 xv[4], gv[4], sc[4], sh[4];
    ld_row16(x, lane, xv); ld_row16(g, lane, gv); ld_row16(mb + 1024, lane, sc); ld_row16(mb, lane, sh);
    float ss = 0.f;
#pragma unroll
    for (int i = 0; i < 4; ++i)
#pragma unroll
      for (int e = 0; e < 4; ++e) ss += xv[i][e] * xv[i][e];
    const float rstd = 1.0f / sqrtf(wave_sum(ss) * (1.0f / D) + 1e-6f);
#pragma unroll
    for (int i = 0; i < 4; ++i) {
      f32x4 o;
#pragma unroll
      for (int e = 0; e < 4; ++e) o[e] = xv[i][e] * rstd * gv[i][e] * (1.f + sc[i][e]) + sh[i][e];
      st_bf16x4(p.H + (size_t)r * D + 256 * i + 4 * lane, o);
    }
  }
}
DI void ph_resid_mix(const Params& p, int layer, const float* xl_in, const float* xc_in, int rows, int bid, int nblk) {
  const int lane = TIDX & 63, wid = TIDX >> 6;
  const float* wr = p.w_router + (size_t)layer * D * 16;
  for (int r = bid * 4 + wid; r < rows; r += nblk * 4) {
    const int w = r < RL ? r / TL : 2;
    const float* mb = p.mods + (size_t)(layer * 3 + w) * 6144;
    const float* xin = r < RL ? xl_in + (size_t)r * D : xc_in + (size_t)(r - RL) * D;
    float* xo = r < RL ? p.out + (size_t)r * D : p.xc + (size_t)(r - RL) * D;
    f32x4 yv[4], xv[4], a[4], c[4];
    ld_row16_bf(p.YO + (size_t)r * D, lane, yv); ld_row16(xin, lane, xv);
    float ss = 0.f;
#pragma unroll
    for (int i = 0; i < 4; ++i)
#pragma unroll
      for (int e = 0; e < 4; ++e) ss += yv[i][e] * yv[i][e];
    const float rstd = 1.0f / sqrtf(wave_sum(ss) * (1.0f / D) + 1e-6f);
    ld_row16(mb + 2 * 1024, lane, a); ld_row16(p.g_mix_post + layer * 1024, lane, c);
    float s2 = 0.f;
#pragma unroll
    for (int i = 0; i < 4; ++i) {
#pragma unroll
      for (int e = 0; e < 4; ++e) { xv[i][e] += a[i][e] * yv[i][e] * rstd * c[i][e]; s2 += xv[i][e] * xv[i][e]; }
      *(f32x4*)(xo + 256 * i + 4 * lane) = xv[i];
    }
    const float rstd2 = 1.0f / sqrtf(wave_sum(s2) * (1.0f / D) + 1e-6f);
    ld_row16(p.g_ffn_pre + layer * 1024, lane, a); ld_row16(mb + 4 * 1024, lane, c); ld_row16(mb + 3 * 1024, lane, yv);
    float lg[16];
#pragma unroll
    for (int e = 0; e < 16; ++e) lg[e] = 0.f;
#pragma unroll
    for (int i = 0; i < 4; ++i) {
      f32x4 h2;
#pragma unroll
      for (int e = 0; e < 4; ++e) h2[e] = xv[i][e] * rstd2 * a[i][e] * (1.f + c[i][e]) + yv[i][e];
      st_bf16x4(p.H + (size_t)r * D + 256 * i + 4 * lane, h2);
#pragma unroll
      for (int e = 0; e < 4; ++e) {
        const float* wk = wr + (size_t)(256 * i + 4 * lane + e) * 16;
#pragma unroll
        for (int q = 0; q < 4; ++q) { const f32x4 wv = *(const f32x4*)(wk + 4 * q); lg[4 * q] += h2[e] * wv[0]; lg[4 * q + 1] += h2[e] * wv[1]; lg[4 * q + 2] += h2[e] * wv[2]; lg[4 * q + 3] += h2[e] * wv[3]; }
      }
    }
#pragma unroll
    for (int e = 0; e < 16; ++e) lg[e] = wave_sum(lg[e]);
    float mx = lg[0];
#pragma unroll
    for (int e = 1; e < 16; ++e) mx = fmaxf(mx, lg[e]);
    float sm = 0.f;
#pragma unroll
    for (int e = 0; e < 16; ++e) { lg[e] = expf(lg[e] - mx); sm += lg[e]; }
    int b, s; bs_of(r, b, s);
    float mine = 0.f;
#pragma unroll
    for (int e = 0; e < 16; ++e) mine = (lane == e) ? lg[e] / sm : mine;
    if (lane < 16) p.AFF[((size_t)b * NE + lane) * TK + s] = mine;
  }
}
DI void ph_resid_ffn(const Params& p, int layer, int rows, int bid, int nblk) {
  const int lane = TIDX & 63, wid = TIDX >> 6;
  for (int r = bid * 4 + wid; r < rows; r += nblk * 4) {
    const int w = r < RL ? r / TL : 2;
    const float* mb = p.mods + (size_t)(layer * 3 + w) * 6144;
    float* xo = r < RL ? p.out + (size_t)r * D : p.xc + (size_t)(r - RL) * D;
    const int myinv = lane < NE ? p.INV[(size_t)r * NE + lane] : -1;
    f32x4 f[4];
#pragma unroll
    for (int i = 0; i < 4; ++i) f[i] = (f32x4){0.f, 0.f, 0.f, 0.f};
    for (int e = 0; e < NE; ++e) {
      const int sl = lane_bcast(myinv, e);
      if (sl >= 0) { f32x4 yv[4]; ld_row16_bf(p.YE + ((size_t)e * NSLOT + sl) * D, lane, yv);
#pragma unroll
        for (int i = 0; i < 4; ++i) f[i] += yv[i]; }
    }
    float ss = 0.f;
#pragma unroll
    for (int i = 0; i < 4; ++i)
#pragma unroll
      for (int e = 0; e < 4; ++e) ss += f[i][e] * f[i][e];
    const float rstd = 1.0f / sqrtf(wave_sum(ss) * (1.0f / D) + 1e-6f);
    f32x4 a[4], c[4], xv[4];
    ld_row16(mb + 5 * 1024, lane, a); ld_row16(p.g_ffn_post + layer * 1024, lane, c); ld_row16(xo, lane, xv);
#pragma unroll
    for (int i = 0; i < 4; ++i) {
#pragma unroll
      for (int e = 0; e < 4; ++e) xv[i][e] += a[i][e] * f[i][e] * rstd * c[i][e];
      *(f32x4*)(xo + 256 * i + 4 * lane) = xv[i];
    }
  }
}
DI void ph_mods(const Params& p, char* lds, int bid, int nblk) {
  float* sc = (float*)lds;
  const int t = TIDX;
  for (int i = t; i < 3 * 1024; i += NTHR) { const float v = i < 2048 ? p.c[i] : p.c_ctx[i - 2048]; sc[i] = v / (1.0f + expf(-v)); }
  __syncthreads();
#pragma unroll 1
  for (long gi = (long)bid * NTHR + t; gi < 2 * 3 * 6144; gi += (long)nblk * NTHR) {
    const int col = (int)(gi % 6144), w = (int)((gi / 6144) % 3), l = (int)(gi / (3 * 6144));
    const float* W = p.w_ada + (size_t)l * 1024 * 6144 + col; const float* s = sc + w * 1024;
    float acc[8];
#pragma unroll
    for (int q = 0; q < 8; ++q) acc[q] = 0.f;
#pragma unroll 1
    for (int k = 0; k < 1024; k += 8) {
#pragma unroll
      for (int q = 0; q < 8; ++q) acc[q] += s[k + q] * W[(size_t)(k + q) * 6144];
    }
    p.mods[gi] = ((acc[0] + acc[1]) + (acc[2] + acc[3])) + ((acc[4] + acc[5]) + (acc[6] + acc[7])) + p.b_ada[l * 6144 + col];
  }
  __syncthreads();
}
constexpr int TOPK_LDS = TL * 4 + 2048;
DI int block_sum_i(int v, int* red) {
  const int lane = TIDX & 63, wid = TIDX >> 6;
  v = xor_sum_i<1>(v); v = xor_sum_i<2>(v); v = xor_sum_i<4>(v); v = xor_sum_i<8>(v); v = xor_sum_i<16>(v); v = xor_sum_i<32>(v);
  __syncthreads();
  if (lane == 0) red[wid] = v;
  __syncthreads();
  return red[0] + red[1] + red[2] + red[3];
}
DI int block_excl_scan(int v, int* red) {
  const int lane = TIDX & 63, wid = TIDX >> 6;
  int inc = v;
#pragma unroll
  for (int d = 1; d < 64; d <<= 1) { const int o = lane_up(inc, d, lane); if (lane >= d) inc += o; }
  __syncthreads();
  if (lane == 63) red[wid] = inc;
  __syncthreads();
  int base = 0;
  for (int q = 0; q < wid; ++q) base += red[q];
  return base + inc - v;
}
DI void ph_topk(const Params& p, int need_ctx, char* lds, int bid, int nblk) {
  unsigned* vals = (unsigned*)lds; int* red = (int*)(lds + TL * 4 + 1024);
  const int t = TIDX;
  for (int u = bid; u < NB * NE * 2; u += nblk) {
    const int seg = u & 1, e = (u >> 1) % NE, b = u / (2 * NE);
    const int s0 = seg ? TC : 0, n = seg ? TL : TC, cap = seg ? CAPL : CAPC, slot0 = seg ? b * CAPL : NB * CAPL + b * CAPC;
    if (seg == 0 && !need_ctx) { for (int q = t; q < cap; q += NTHR) p.SEL[(size_t)e * NSLOT + slot0 + q] = -1; continue; }
    const float* a = p.AFF + ((size_t)b * NE + e) * TK + s0;
    const int vpt = (n + NTHR - 1) / NTHR, i0 = t * vpt, i1 = (i0 + vpt < n) ? i0 + vpt : n;
    for (int i = t; i < n; i += NTHR) vals[i + i / vpt] = f2u(a[i]);
    __syncthreads();
    unsigned thr = 0;
    for (int bit = 31; bit >= 0; --bit) {
      const unsigned cand = thr | (1u << bit);
      int cnt = 0;
      for (int i = i0; i < i1; ++i) cnt += (vals[i + t] >= cand);
      if (block_sum_i(cnt, red) >= cap) thr = cand;
    }
    int cgt = 0, ceq = 0;
    for (int i = i0; i < i1; ++i) { cgt += (vals[i + t] > thr); ceq += (vals[i + t] == thr); }
    const int ngt = block_sum_i(cgt, red);
    const int neq = cap - ngt;
    int eqoff = block_excl_scan(ceq, red);
    int csel = 0;
    { int er = eqoff; for (int i = i0; i < i1; ++i) { if (vals[i + t] > thr) ++csel; else if (vals[i + t] == thr) { if (er < neq) ++csel; ++er; } } }
    int q = block_excl_scan(csel, red);
    for (int i = i0; i < i1; ++i) {
      const unsigned v = vals[i + t]; int sel = -1;
      if (v > thr) sel = q++; else if (v == thr) { if (eqoff < neq) sel = q++; ++eqoff; }
      const int r = row_of(b, s0 + i);
      if (sel >= 0) { p.SEL[(size_t)e * NSLOT + slot0 + sel] = r; p.SELV[(size_t)e * NSLOT + slot0 + sel] = u2f(v); }
      p.INV[(size_t)r * NE + e] = sel >= 0 ? slot0 + sel : -1;
    }
    __syncthreads();
  }
}
DI void ph_wt(const float* in, bf16_t* out, int K, int N, int NP, int nbatch, long in_bs, long out_bs, const float* gain, char* lds, int bid, int nblk) {
  float* tile = (float*)lds;
  const int t = TIDX, tk = K / 64, tn = NP / 64, ntile = nbatch * tk * tn;
  f32x4 v[4];
  auto gload = [&](int u) {
    const int bt = u / (tk * tn), rem = u % (tk * tn), k0 = (rem / tn) * 64, n0 = (rem % tn) * 64;
    const float* I = in + (size_t)bt * in_bs;
#pragma unroll
    for (int i = 0; i < 4; ++i) {
      const int idx = t + i * NTHR, kk = idx >> 4, n4 = (idx & 15) * 4;
      v[i] = (f32x4){0.f, 0.f, 0.f, 0.f};
      if (n0 + n4 < N) v[i] = *(const f32x4*)(I + (size_t)(k0 + kk) * N + n0 + n4);
      if (gain) { const float g = gain[k0 + kk]; v[i][0] *= g; v[i][1] *= g; v[i][2] *= g; v[i][3] *= g; }
    }
  };
  if (bid < ntile) gload(bid);
#pragma unroll 1
  for (int u = bid; u < ntile; u += nblk) {
    const int bt = u / (tk * tn), rem = u % (tk * tn), k0 = (rem / tn) * 64, n0 = (rem % tn) * 64;
    bf16_t* O = out + (size_t)bt * out_bs;
#pragma unroll
    for (int i = 0; i < 4; ++i) { const int idx = t + i * NTHR, kk = idx >> 4, n4 = (idx & 15) * 4; float* d = tile + kk * 65 + n4; d[0] = v[i][0]; d[1] = v[i][1]; d[2] = v[i][2]; d[3] = v[i][3]; }
    __syncthreads();
    if (u + nblk < ntile) gload(u + nblk);
#pragma unroll
    for (int i = 0; i < 2; ++i) {
      const int idx = t + i * NTHR, kg = idx & 7, nn = idx >> 3;
      float a[8];
#pragma unroll
      for (int e = 0; e < 8; ++e) a[e] = tile[(kg * 8 + e) * 65 + nn];
      u32x4 o; o.x = pack2bf(a[0], a[1]); o.y = pack2bf(a[2], a[3]); o.z = pack2bf(a[4], a[5]); o.w = pack2bf(a[6], a[7]);
      *(u32x4*)(O + (size_t)(n0 + nn) * K + k0 + kg * 8) = o;
    }
    __syncthreads();
  }
}
DI float wave_max(float v) {
  v = xor_max<1>(v); v = xor_max<2>(v); v = xor_max<4>(v); v = xor_max<8>(v); v = xor_max<16>(v); v = xor_max<32>(v);
  return v;
}
DI bf16x8 cvt8(const float* f) {
  const f32x4 a = *(const f32x4*)f, b = *(const f32x4*)(f + 4);
  u32x4 pk; pk.x = pack2bf(a[0], a[1]); pk.y = pack2bf(a[2], a[3]); pk.z = pack2bf(b[0], b[1]); pk.w = pack2bf(b[2], b[3]);
  return __builtin_bit_cast(bf16x8, pk);
}
constexpr int SCAN_UNITS = NB * NCK * 4, SCAN_LAT_UNITS = NB * NCL * 4;
DI void scan_unit(int u, int& b, int& c, int& h) {
  h = u & 3;
  if (u < SCAN_LAT_UNITS) { c = NCC + (u >> 2) % NCL; b = u / (4 * NCL); } else { const int v = u - SCAN_LAT_UNITS; c = (v >> 2) % NCC; b = v / (4 * NCC); }
}

DI void ph_ml_local(const Params& p, char* lds, int bid, int nblk) {
  bf16_t* sK = (bf16_t*)lds;
  float* sW = (float*)(lds + 64 * 132);
  const int t = TIDX, lane = t & 63, wid = t >> 6, l31 = lane & 31, hh = lane >> 5;
  const int d = wid & 1, vt = wid >> 1;
#pragma unroll 1
  for (int u = bid; u < SCAN_UNITS; u += nblk) {
    int b, c, h; scan_unit(u, b, c, h);
    {
      const int row = t >> 2, seg = (t & 3) * 16;
      const bf16_t* src = p.MK + ((size_t)b * TK + 64 * c + row) * 256 + h * 64 + seg;
      const u32x4 a = ldg16(src), bb = ldg16(src + 8);
      unsigned* dst = (unsigned*)((char*)sK + row * 132 + seg * 2);
      dst[0] = a.x; dst[1] = a.y; dst[2] = a.z; dst[3] = a.w; dst[4] = bb.x; dst[5] = bb.y; dst[6] = bb.z; dst[7] = bb.w;
    }
    if (t < 128) {
      const int dd = t >> 6, l = t & 63, j = step_of(dd, c), pos = dd ? 63 - l : l;
      const size_t o = (((size_t)b * 2 + dd) * TK + 64 * j) * 4 + h;
      const float bend = p.BC[o + 63 * 4], wl = bend - p.BC[o + pos * 4] + p.IGS[o + pos * 4];
      const float ml = wave_max(wl);
      sW[dd * 64 + l] = expf(wl - ml);
      if (l == 0) { const size_t uu = (((size_t)b * 2 + dd) * NCK + j) * 4 + h; p.MM[uu * 4] = ml; p.MM[uu * 4 + 1] = bend; }
    }
    __syncthreads();
    const int j = step_of(d, c);
    const size_t uu = (((size_t)b * 2 + d) * NCK + j) * 4 + h;
    f32x16 acc[2]; acc[0] = (f32x16)(0.f); acc[1] = (f32x16)(0.f);
    const bf16_t* vsrc = p.MVt + (((size_t)b * 4 + h) * 64 + vt * 32 + l31) * TK + 64 * c;
#pragma unroll
    for (int ks = 0; ks < 4; ++ks) {
      const bf16x8 a = *(const bf16x8*)(vsrc + ks * 16 + 8 * hh);
      const float* w = sW + d * 64 + ks * 16 + 8 * hh;
      u32x4 pk;
      pk.x = pack2bf(bf2f((bf16_t)a[0]) * w[0], bf2f((bf16_t)a[1]) * w[1]); pk.y = pack2bf(bf2f((bf16_t)a[2]) * w[2], bf2f((bf16_t)a[3]) * w[3]);
      pk.z = pack2bf(bf2f((bf16_t)a[4]) * w[4], bf2f((bf16_t)a[5]) * w[5]); pk.w = pack2bf(bf2f((bf16_t)a[6]) * w[6], bf2f((bf16_t)a[7]) * w[7]);
      const bf16x8 af = __builtin_bit_cast(bf16x8, pk);
#pragma unroll
      for (int kt = 0; kt < 2; ++kt) {
        bf16x8 bfr;
#pragma unroll
        for (int q = 0; q < 8; ++q) bfr[q] = (short)sK[(ks * 16 + 8 * hh + q) * 66 + kt * 32 + l31];
        acc[kt] = MFMA32(af, bfr, acc[kt]);
      }
    }
#pragma unroll
    for (int kt = 0; kt < 2; ++kt)
#pragma unroll
      for (int i = 0; i < 16; ++i) p.MC[uu * 4096 + (size_t)(vt * 32 + (i & 3) + 8 * (i >> 2) + 4 * hh) * 64 + kt * 32 + l31] = acc[kt][i];
    float nl = 0.f;
    for (int q = 0; q < 32; ++q) { const int l = hh * 32 + q; nl += sW[d * 64 + l] * bf2f(sK[l * 66 + vt * 32 + l31]); }
    nl = xor_sum<32>(nl);
    if (hh == 0) p.MN[uu * 64 + vt * 32 + l31] = nl;
    __syncthreads();
  }
}
DI void ph_ml_scan(const Params& p, int bid, int nblk) {
  for (long gi = (long)bid * NTHR + TIDX; gi < (long)NB * 2 * 4 * 4160; gi += (long)nblk * NTHR) {
    const int e = (int)(gi % 4160), ch = (int)(gi / 4160), h = ch & 3, bd = ch >> 2;
    float* base = e < 4096 ? p.MC + (((size_t)bd * NCK) * 4 + h) * 4096 + e : p.MN + (((size_t)bd * NCK) * 4 + h) * 64 + (e - 4096);
    const size_t stride = e < 4096 ? 4 * 4096 : 4 * 64;
    float* mm = p.MM + (((size_t)bd * NCK) * 4 + h) * 4;
    float st = 0.f, m = -1e30f;
    float cl[8], cm[8], cb[8], nl[8], nm[8], nb[8];
#pragma unroll
    for (int q = 0; q < 8; ++q) { cl[q] = base[(size_t)q * stride]; cm[q] = mm[q * 16]; cb[q] = mm[q * 16 + 1]; }
#pragma unroll 1
    for (int jb = 0; jb < NCK; jb += 8) {
#pragma unroll
      for (int q = 0; q < 8; ++q) { const int j = jb + 8 + q; if (j < NCK) { nl[q] = base[(size_t)j * stride]; nm[q] = mm[j * 16]; nb[q] = mm[j * 16 + 1]; } }
#pragma unroll
      for (int q = 0; q < 8; ++q) {
        const int j = jb + q;
        if (j < NCK) {
          const float mn = fmaxf(cb[q] + m, cm[q]), a = expf(cb[q] + m - mn), g = expf(cm[q] - mn);
          base[(size_t)j * stride] = st;
          st = a * st + g * cl[q];
          if (e == 0) mm[j * 16 + 2] = m;
          m = mn;
        }
      }
#pragma unroll
      for (int q = 0; q < 8; ++q) { cl[q] = nl[q]; cm[q] = nm[q]; cb[q] = nb[q]; }
    }
  }
}
DI void ph_gla_scan(const Params& p, int bid, int nblk) {
  for (long gi = (long)bid * NTHR + TIDX; gi < (long)NB * 2 * 4 * 2048; gi += (long)nblk * NTHR) {
    const int e = (int)(gi % 2048), ch = (int)(gi / 2048), h = ch & 3, bd = ch >> 2, k = e & 31;
    float* base = p.GS + (((size_t)bd * NCK) * 4 + h) * 2048 + e;
    const float* ge = p.GC + ((size_t)bd * TK + 63) * 128 + h * 32 + k;
    float st = 0.f;
    float cl[8], cg[8], nl[8], ng[8];
#pragma unroll
    for (int q = 0; q < 8; ++q) { cl[q] = base[(size_t)q * 4 * 2048]; cg[q] = ge[(size_t)q * 64 * 128]; }
#pragma unroll 1
    for (int jb = 0; jb < NCK; jb += 8) {
#pragma unroll
      for (int q = 0; q < 8; ++q) { const int j = jb + 8 + q; if (j < NCK) { nl[q] = base[(size_t)j * 4 * 2048]; ng[q] = ge[(size_t)j * 64 * 128]; } }
#pragma unroll
      for (int q = 0; q < 8; ++q) {
        const int j = jb + q;
        if (j < NCK) { base[(size_t)j * 4 * 2048] = st; st = expf(cg[q]) * st + cl[q]; }
      }
#pragma unroll
      for (int q = 0; q < 8; ++q) { cl[q] = nl[q]; cg[q] = ng[q]; }
    }
  }
}
constexpr int MO_K = 0, MO_V = 64 * 144, MO_A = MO_V + 64 * VROW, MO_PM = MO_A + 512, MO_N0 = MO_PM + 512, MO_X = MO_N0 + 512, MO_LDS = MO_X + 16384;
DI void ph_ml_out(const Params& p, int layer, int need_ctx, char* lds, int bid, int nblk) {
  float* sA = (float*)(lds + MO_A); float* sPM = (float*)(lds + MO_PM); float* sN0 = (float*)(lds + MO_N0); float* sX = (float*)(lds + MO_X);
  const int t = TIDX, lane = t & 63, wid = t >> 6, l31 = lane & 31, hh = lane >> 5;
  const int lt = wid & 1, d = wid >> 1;
#pragma unroll 1
  for (int u = bid; u < (need_ctx ? SCAN_UNITS : SCAN_LAT_UNITS); u += nblk) {
    int b, c, h; scan_unit(u, b, c, h);
    {
      const int row = t >> 2, seg = (t & 3) * 16;
      const bf16_t* ks = p.MK + ((size_t)b * TK + 64 * c + row) * 256 + h * 64 + seg;
      sts16(lds + MO_K + row * 144 + seg * 2, ldg16(ks)); sts16(lds + MO_K + row * 144 + seg * 2 + 16, ldg16(ks + 8));
      const bf16_t* vs = p.MVt + (((size_t)b * 4 + h) * 64 + row) * TK + 64 * c + seg;
      const u32x4 v0 = ldg16(vs), v1 = ldg16(vs + 8);
      u32x2* dv = (u32x2*)(lds + MO_V + row * VROW + seg * 2);
      u32x2 q; q.x = v0.x; q.y = v0.y; dv[0] = q; q.x = v0.z; q.y = v0.w; dv[1] = q; q.x = v1.x; q.y = v1.y; dv[2] = q; q.x = v1.z; q.y = v1.w; dv[3] = q;
    }
    if (t < 128) {
      const int dd = t >> 6, s = t & 63, j = step_of(dd, c), pos = dd ? 63 - s : s;
      const size_t o = (((size_t)b * 2 + dd) * TK + 64 * j) * 4 + h;
      sA[dd * 64 + s] = p.IGS[o + pos * 4] - p.BC[o + pos * 4];
      const size_t uu = (((size_t)b * 2 + dd) * NCK + j) * 4 + h;
      sN0[dd * 64 + s] = p.MN[uu * 64 + s];
    }
    __syncthreads();
    if (t < 2) {
      float m = -1e30f;
      if (t == 0) { for (int s = 0; s < 64; ++s) { m = fmaxf(m, sA[s]); sPM[s] = m; } }
      else { for (int s = 63; s >= 0; --s) { m = fmaxf(m, sA[64 + s]); sPM[64 + s] = m; } }
    }
    __syncthreads();
    const int j = step_of(d, c);
    const size_t uu = (((size_t)b * 2 + d) * NCK + j) * 4 + h;
    const int l = lt * 32 + l31, pos = d ? 63 - l : l;
    const float bl = p.BC[(((size_t)b * 2 + d) * TK + 64 * j + pos) * 4 + h];
    const float inter = bl + p.MM[uu * 4 + 2];
    const float mt = fmaxf(inter, bl + sPM[d * 64 + l]);
    const float aint = expf(inter - mt);
    bf16x8 qf[4];
#pragma unroll
    for (int ks = 0; ks < 4; ++ks) qf[ks] = *(const bf16x8*)(p.MQ + ((size_t)b * TK + 64 * c + l) * 256 + h * 64 + ks * 16 + 8 * hh);
    f32x16 num[2]; num[0] = (f32x16)(0.f); num[1] = (f32x16)(0.f);
    float den = 0.f;
#pragma unroll
    for (int st = 0; st < 2; ++st) {
      if (d == 0 ? st <= lt : st >= lt) {
        f32x16 S = (f32x16)(0.f);
#pragma unroll
        for (int ks = 0; ks < 4; ++ks) S = MFMA32(lds_frag(lds + MO_K + (st * 32 + l31) * 144 + (ks * 16 + 8 * hh) * 2), qf[ks], S);
#pragma unroll
        for (int i = 0; i < 16; ++i) {
          const int s = st * 32 + (i & 3) + 8 * (i >> 2) + 4 * hh;
          const bool ok = d == 0 ? s <= l : s >= l;
          const float e = ok ? fast_exp2((bl + sA[d * 64 + s] - mt) * LOG2E) * S[i] : 0.f;
          S[i] = e; den += e;
        }
#pragma unroll
        for (int kst = 0; kst < 2; ++kst) {
          const bf16x8 pf = pack8(S, kst);
#pragma unroll
          for (int vt = 0; vt < 2; ++vt) {
            const char* vp = lds + MO_V + (vt * 32 + l31) * VROW + (st * 32 + kst * 16 + 4 * hh) * 2;
            const s16x4 lo = *(const s16x4*)vp, hi = *(const s16x4*)(vp + 16);
            num[vt] = MFMA32(__builtin_shufflevector(lo, hi, 0, 1, 2, 3, 4, 5, 6, 7), pf, num[vt]);
          }
        }
      }
    }
    f32x16 accI[2]; accI[0] = (f32x16)(0.f); accI[1] = (f32x16)(0.f);
#pragma unroll
    for (int vt = 0; vt < 2; ++vt)
#pragma unroll
      for (int ks = 0; ks < 4; ++ks) accI[vt] = MFMA32(cvt8(p.MC + uu * 4096 + (size_t)(vt * 32 + l31) * 64 + ks * 16 + 8 * hh), qf[ks], accI[vt]);
    float qn = 0.f;
#pragma unroll
    for (int ks = 0; ks < 4; ++ks)
#pragma unroll
      for (int q = 0; q < 8; ++q) qn += bf2f((bf16_t)qf[ks][q]) * sN0[d * 64 + ks * 16 + 8 * hh + q];
    den = xor_sum<32>(den + aint * qn);
    const float inv = 1.0f / fmaxf(fabsf(den), expf(-mt));
#pragma unroll
    for (int vt = 0; vt < 2; ++vt)
#pragma unroll
      for (int i = 0; i < 16; ++i) num[vt][i] = (num[vt][i] + aint * accI[vt][i]) * inv;
    if (d == 1) {
#pragma unroll
      for (int vt = 0; vt < 2; ++vt)
#pragma unroll
        for (int i = 0; i < 16; ++i) sX[(lt * 32 + vt * 16 + i) * 64 + lane] = num[vt][i];
    }
    __syncthreads();
    if (d == 0) {
      float ss = 0.f;
#pragma unroll
      for (int vt = 0; vt < 2; ++vt)
#pragma unroll
        for (int i = 0; i < 16; ++i) { num[vt][i] += sX[(lt * 32 + vt * 16 + i) * 64 + lane]; ss += num[vt][i] * num[vt][i]; }
      ss = xor_sum<32>(ss);
      const float rstd = 1.0f / sqrtf(ss * (1.0f / 64) + 1e-6f);
      const int r = row_of(b, 64 * c + l);
#pragma unroll
      for (int vt = 0; vt < 2; ++vt)
#pragma unroll
        for (int g = 0; g < 4; ++g) {
          const int v0 = vt * 32 + 8 * g + 4 * hh;
          const u32x2 ou = *(const u32x2*)(p.Z + (size_t)r * NZP + ZC_MLO + h * 64 + v0);
          const f32x4 gv = *(const f32x4*)(p.g_mlstm_out + layer * 256 + h * 64 + v0);
          const float o0 = u2f(ou.x << 16), o1 = u2f(ou.x & 0xffff0000u), o2 = u2f(ou.y << 16), o3 = u2f(ou.y & 0xffff0000u);
          f32x4 y = {sigmoidf_(o0) * num[vt][4 * g] * rstd * gv[0], sigmoidf_(o1) * num[vt][4 * g + 1] * rstd * gv[1],
                     sigmoidf_(o2) * num[vt][4 * g + 2] * rstd * gv[2], sigmoidf_(o3) * num[vt][4 * g + 3] * rstd * gv[3]};
          st_bf16x4(p.Y + (size_t)r * D + 256 + h * 64 + v0, y);
        }
    }
    __syncthreads();
  }
}
DI void ph_gla_local(const Params& p, char* lds, int bid, int nblk) {
  bf16_t* sKd = (bf16_t*)lds;
  const int t = TIDX, lane = t & 63, wid = t >> 6, l31 = lane & 31, hh = lane >> 5;
  const int d = wid & 1, vt = wid >> 1;
#pragma unroll 1
  for (int u = bid; u < SCAN_UNITS; u += nblk) {
    int b, c, h; scan_unit(u, b, c, h);
    {
      const int dd = t >> 7, l = (t >> 1) & 63, k0 = (t & 1) * 16, j = step_of(dd, c), pos = dd ? 63 - l : l;
      const float* gcr = p.GC + (((size_t)b * 2 + dd) * TK + 64 * j + pos) * 128 + h * 32 + k0;
      const float* ger = p.GC + (((size_t)b * 2 + dd) * TK + 64 * j + 63) * 128 + h * 32 + k0;
      const bf16_t* kr = p.Z + (size_t)row_of(b, 64 * c + l) * NZP + ZC_GK + h * 32 + k0;
#pragma unroll
      for (int q = 0; q < 16; ++q) sKd[(dd * 64 + l) * 33 + k0 + q] = f2bf(bf2f(kr[q]) * fast_exp2((ger[q] - gcr[q]) * LOG2E));
    }
    __syncthreads();
    const int j = step_of(d, c);
    const size_t uu = (((size_t)b * 2 + d) * NCK + j) * 4 + h;
    f32x16 acc = (f32x16)(0.f);
    const bf16_t* vsrc = p.GVt + (((size_t)b * 4 + h) * 64 + vt * 32 + l31) * TK + 64 * c;
#pragma unroll
    for (int ks = 0; ks < 4; ++ks) {
      const bf16x8 af = *(const bf16x8*)(vsrc + ks * 16 + 8 * hh);
      bf16x8 bfr;
#pragma unroll
      for (int q = 0; q < 8; ++q) bfr[q] = (short)sKd[(d * 64 + ks * 16 + 8 * hh + q) * 33 + l31];
      acc = MFMA32(af, bfr, acc);
    }
#pragma unroll
    for (int i = 0; i < 16; ++i) p.GS[uu * 2048 + (size_t)(vt * 32 + (i & 3) + 8 * (i >> 2) + 4 * hh) * 32 + l31] = acc[i];
    __syncthreads();
  }
}
constexpr int GO_Q = 0, GO_K = 2 * 64 * 80, GO_V = 2 * GO_K, GO_X = GO_V + 64 * VROW, GO_LDS = GO_X + 16384;
DI void ph_gla_out(const Params& p, int layer, int need_ctx, char* lds, int bid, int nblk) {
  float* sX = (float*)(lds + GO_X);
  const int t = TIDX, lane = t & 63, wid = t >> 6, l31 = lane & 31, hh = lane >> 5;
  const int lt = wid & 1, d = wid >> 1;
#pragma unroll 1
  for (int u = bid; u < (need_ctx ? SCAN_UNITS : SCAN_LAT_UNITS); u += nblk) {
    int b, c, h; scan_unit(u, b, c, h);
    {
      const int dd = t >> 7, l = (t >> 1) & 63, k0 = (t & 1) * 16, j = step_of(dd, c), pos = dd ? 63 - l : l;
      const float* gcr = p.GC + (((size_t)b * 2 + dd) * TK + 64 * j + pos) * 128 + h * 32 + k0;
      const bf16_t* zr = p.Z + (size_t)row_of(b, 64 * c + l) * NZP;
      bf16_t* qd = (bf16_t*)(lds + GO_Q + (dd * 64 + l) * 80) + k0; bf16_t* kd = (bf16_t*)(lds + GO_K + (dd * 64 + l) * 80) + k0;
#pragma unroll
      for (int q = 0; q < 16; ++q) {
        const float g = gcr[q];
        qd[q] = f2bf(bf2f(zr[ZC_GQ + h * 32 + k0 + q]) * 0.17677669529663687f * fast_exp2(g * LOG2E));
        kd[q] = f2bf(bf2f(zr[ZC_GK + h * 32 + k0 + q]) * fast_exp2(-g * LOG2E));
      }
      const int row = t >> 2, seg = (t & 3) * 16;
      const bf16_t* vs = p.GVt + (((size_t)b * 4 + h) * 64 + row) * TK + 64 * c + seg;
      const u32x4 v0 = ldg16(vs), v1 = ldg16(vs + 8);
      u32x2* dv = (u32x2*)(lds + GO_V + row * VROW + seg * 2);
      u32x2 q2; q2.x = v0.x; q2.y = v0.y; dv[0] = q2; q2.x = v0.z; q2.y = v0.w; dv[1] = q2; q2.x = v1.x; q2.y = v1.y; dv[2] = q2; q2.x = v1.z; q2.y = v1.w; dv[3] = q2;
    }
    __syncthreads();
    const int j = step_of(d, c);
    const size_t uu = (((size_t)b * 2 + d) * NCK + j) * 4 + h;
    const int l = lt * 32 + l31;
    bf16x8 qf[2];
#pragma unroll
    for (int ks = 0; ks < 2; ++ks) qf[ks] = lds_frag(lds + GO_Q + (d * 64 + l) * 80 + (ks * 16 + 8 * hh) * 2);
    f32x16 O[2]; O[0] = (f32x16)(0.f); O[1] = (f32x16)(0.f);
#pragma unroll
    for (int st = 0; st < 2; ++st) {
      if (d == 0 ? st <= lt : st >= lt) {
        f32x16 S = (f32x16)(0.f);
#pragma unroll
        for (int ks = 0; ks < 2; ++ks) S = MFMA32(lds_frag(lds + GO_K + (d * 64 + st * 32 + l31) * 80 + (ks * 16 + 8 * hh) * 2), qf[ks], S);
#pragma unroll
        for (int i = 0; i < 16; ++i) {
          const int s = st * 32 + (i & 3) + 8 * (i >> 2) + 4 * hh;
          const bool ok = d == 0 ? s <= l : s >= l;
          S[i] = ok ? S[i] : 0.f;
        }
#pragma unroll
        for (int kst = 0; kst < 2; ++kst) {
          const bf16x8 pf = pack8(S, kst);
#pragma unroll
          for (int vt = 0; vt < 2; ++vt) {
            const char* vp = lds + GO_V + (vt * 32 + l31) * VROW + (st * 32 + kst * 16 + 4 * hh) * 2;
            const s16x4 lo = *(const s16x4*)vp, hi = *(const s16x4*)(vp + 16);
            O[vt] = MFMA32(__builtin_shufflevector(lo, hi, 0, 1, 2, 3, 4, 5, 6, 7), pf, O[vt]);
          }
        }
      }
    }
#pragma unroll
    for (int vt = 0; vt < 2; ++vt)
#pragma unroll
      for (int ks = 0; ks < 2; ++ks) O[vt] = MFMA32(cvt8(p.GS + uu * 2048 + (size_t)(vt * 32 + l31) * 32 + ks * 16 + 8 * hh), qf[ks], O[vt]);
    if (d == 1) {
#pragma unroll
      for (int vt = 0; vt < 2; ++vt)
#pragma unroll
        for (int i = 0; i < 16; ++i) sX[(lt * 32 + vt * 16 + i) * 64 + lane] = O[vt][i];
    }
    __syncthreads();
    if (d == 0) {
      float ss = 0.f;
#pragma unroll
      for (int vt = 0; vt < 2; ++vt)
#pragma unroll
        for (int i = 0; i < 16; ++i) { O[vt][i] += sX[(lt * 32 + vt * 16 + i) * 64 + lane]; ss += O[vt][i] * O[vt][i]; }
      ss = xor_sum<32>(ss);
      const float rstd = 1.0f / sqrtf(ss * (1.0f / 64) + 1e-6f);
      const int r = row_of(b, 64 * c + l);
#pragma unroll
      for (int vt = 0; vt < 2; ++vt)
#pragma unroll
        for (int g = 0; g < 4; ++g) {
          const int v0 = vt * 32 + 8 * g + 4 * hh;
          const u32x2 ru = *(const u32x2*)(p.Z + (size_t)r * NZP + ZC_GR + h * 64 + v0);
          const f32x4 gv = *(const f32x4*)(p.g_gla_out + layer * 256 + h * 64 + v0);
          const float r0 = u2f(ru.x << 16), r1 = u2f(ru.x & 0xffff0000u), r2 = u2f(ru.y << 16), r3 = u2f(ru.y & 0xffff0000u);
          f32x4 y = {siluf_(r0) * O[vt][4 * g] * rstd * gv[0], siluf_(r1) * O[vt][4 * g + 1] * rstd * gv[1],
                     siluf_(r2) * O[vt][4 * g + 2] * rstd * gv[2], siluf_(r3) * O[vt][4 * g + 3] * rstd * gv[3]};
          st_bf16x4(p.Y + (size_t)r * D + 512 + h * 64 + v0, y);
        }
    }
    __syncthreads();
  }
}

DI float fast_logsigmoid(float x) {
  const float e = fast_exp2(-fabsf(x) * LOG2E);
#ifdef CPU_EMU
  return fminf(x, 0.f) - log1pf(e);
#else
  return fminf(x, 0.f) - 0.6931471805599453f * __builtin_amdgcn_logf(1.0f + e);
#endif
}
DI float wave_incl_scan(float v, int lane) {
#pragma unroll
  for (int dd = 1; dd < 64; dd <<= 1) { const float o = u2f((unsigned)lane_up((int)f2u(v), dd, lane)); if (lane >= dd) v += o; }
  return v;
}
constexpr int GCUM_LDS = 4 * 64 * 33 * 4;
DI void ph_gates_cum(const Params& p, int layer, char* lds, int bid, int nblk) {
  const int t = TIDX, lane = t & 63, wid = t >> 6;
  float* stg = (float*)lds + wid * 64 * 33;
  const float* wal = p.w_alpha2 + (size_t)layer * 2 * 16 * 128;
#pragma unroll 1
  for (int u = bid * 4 + wid; u < NB * 2 * NCK; u += nblk * 4) {
    const int j = u % NCK, d = (u / NCK) & 1, b = u / (2 * NCK);
    const int pp = 64 * j + lane, s = seq_of(d, pp);
    const bf16_t* z = p.Z + (size_t)row_of(b, s) * NZP;
    const size_t ob = ((size_t)b * 2 + d) * TK + pp;
    {
      const u32x2 iu = *(const u32x2*)(z + ZC_MLIG + d * 4), fu = *(const u32x2*)(z + ZC_MLFG + d * 4);
      const float ig[4] = {u2f(iu.x << 16), u2f(iu.x & 0xffff0000u), u2f(iu.y << 16), u2f(iu.y & 0xffff0000u)};
      const float fg[4] = {u2f(fu.x << 16), u2f(fu.x & 0xffff0000u), u2f(fu.y << 16), u2f(fu.y & 0xffff0000u)};
      f32x4 oc, oi;
#pragma unroll
      for (int h = 0; h < 4; ++h) {
        oi[h] = ig[h] + p.b_igate[layer * 8 + d * 4 + h];
        oc[h] = wave_incl_scan(fast_logsigmoid(fg[h] + p.b_fgate[layer * 8 + d * 4 + h]), lane);
      }
      *(f32x4*)(p.BC + ob * 4) = oc; *(f32x4*)(p.IGS + ob * 4) = oi;
    }
    float a[16];
    { float f0[8], f1[8]; unpack8(ldg16(z + ZC_GA + d * 16), f0); unpack8(ldg16(z + ZC_GA + d * 16 + 8), f1);
#pragma unroll
      for (int q = 0; q < 8; ++q) { a[q] = f0[q]; a[8 + q] = f1[q]; } }
    const float* W = wal + (size_t)d * 16 * 128;
#pragma unroll 1
    for (int cg = 0; cg < 4; ++cg) {
#pragma unroll 4
      for (int c = 0; c < 32; ++c) {
        const int ch = cg * 32 + c;
        float zg = p.b_alpha[layer * 256 + d * 128 + ch];
#pragma unroll
        for (int q = 0; q < 16; ++q) zg += a[q] * W[q * 128 + ch];
        stg[lane * 33 + c] = wave_incl_scan(fast_logsigmoid(zg) * (1.0f / 16.0f), lane);
      }
      WAVE_SYNC();
#pragma unroll
      for (int k = 0; k < 32; ++k) { const int pos = k * 2 + (lane >> 5), c = lane & 31; p.GC[(((size_t)b * 2 + d) * TK + 64 * j + pos) * 128 + cg * 32 + c] = stg[pos * 33 + c]; }
      WAVE_SYNC();
    }
  }
}
#define XB_TMO      128
#define XB_XCNT(j)  (256  + 64 * (j))
#define XB_XSUB(j)  (1280 + 64 * (j))
#define XB_XGEN(j)  (2304 + 64 * (j))
#define XB_TOP      3328
#define XB_TOPGEN   3392
#define XCD_BAR_WORDS 3456
#define XB_SPIN_CAP (1u << 28)
#define LAS __attribute__((address_space(3)))

__device__ __forceinline__ unsigned xb_ld(unsigned* p)              { return __hip_atomic_load(p, __ATOMIC_RELAXED, __HIP_MEMORY_SCOPE_AGENT); }
__device__ __forceinline__ unsigned xb_add(unsigned* p, unsigned v) { return __hip_atomic_fetch_add(p, v, __ATOMIC_RELAXED, __HIP_MEMORY_SCOPE_AGENT); }
__device__ __forceinline__ unsigned xb_xcc_id() { return (unsigned)__builtin_amdgcn_s_getreg((3 << 11) | 20) & 0xFu; }
#define XB_SPIN(cond, bar) do { unsigned _sp = 0; while (cond) { __builtin_amdgcn_s_sleep(1); \
    if ((++_sp & 255u) == 0u) { if (xb_ld(&(bar)[XB_TMO])) break; if (_sp > XB_SPIN_CAP) { atomicAdd(&(bar)[XB_TMO], 1u); break; } } } } while (0)

struct XcdBarrier {
    unsigned* bar; unsigned x;
    volatile LAS unsigned* st;
};

__device__ __forceinline__ XcdBarrier xcd_barrier_post(unsigned* bar, volatile LAS unsigned* st) {
    XcdBarrier b; b.bar = bar; b.x = xb_xcc_id(); b.st = st;
    if (threadIdx.x == 0) (void)xb_add(&bar[XB_XCNT(b.x)], 1u);
    return b;
}
__device__ __forceinline__ void xcd_barrier_complete(unsigned* bar, unsigned x, unsigned& nloc, unsigned& nx) {
    const unsigned G = gridDim.x * gridDim.y * gridDim.z;
    unsigned sum, cnt, mine, sp = 0u;
    for (;;) {
        sum = 0u; cnt = 0u; mine = 0u;
#pragma unroll
        for (unsigned j = 0; j < 16; ++j) { const unsigned c = xb_ld(&bar[XB_XCNT(j)]); sum += c; cnt += (c > 0u) ? 1u : 0u; mine = (j == x) ? c : mine; }
        if (sum == G) break;
        __builtin_amdgcn_s_sleep(1);
        if ((++sp & 255u) == 0u) { if (xb_ld(&bar[XB_TMO])) break; if (sp > XB_SPIN_CAP) { atomicAdd(&bar[XB_TMO], 1u); break; } }
    }
    nloc = mine > 0u ? mine : 1u; nx = cnt > 0u ? cnt : 1u;
}

__device__ __forceinline__ void xcd_barrier(const XcdBarrier& b) {
    asm volatile("s_waitcnt vmcnt(0)" ::: "memory");
    __syncthreads();
    if (threadIdx.x == 0) {
        unsigned* bar = b.bar;
        __builtin_amdgcn_s_waitcnt(0);
        unsigned nloc = b.st[0], nx = b.st[1];
        if (nloc == 0u) { xcd_barrier_complete(bar, b.x, nloc, nx); b.st[0] = nloc; b.st[1] = nx; }
        const unsigned old = xb_add(&bar[XB_XSUB(b.x)], 1u);
        const unsigned gen = old / nloc;
        if (old + 1u == (gen + 1u) * nloc) {
            __builtin_amdgcn_fence(__ATOMIC_RELEASE, "agent");
            asm volatile("s_waitcnt vmcnt(0)" ::: "memory");
            const unsigned og = xb_add(&bar[XB_TOP], 1u);
            const unsigned tg = og / nx;
            if (og + 1u == (tg + 1u) * nx) xb_add(&bar[XB_TOPGEN], 1u);
            else XB_SPIN(xb_ld(&bar[XB_TOPGEN]) == tg, bar);
            __builtin_amdgcn_fence(__ATOMIC_ACQUIRE, "agent");
            xb_add(&bar[XB_XGEN(b.x)], 1u);
            asm volatile("s_waitcnt vmcnt(0)" ::: "memory");
        } else {
            XB_SPIN(xb_ld(&bar[XB_XGEN(b.x)]) == gen, bar);
            __builtin_amdgcn_fence(__ATOMIC_ACQUIRE, "agent");
            asm volatile("s_waitcnt vmcnt(0)" ::: "memory");
        }
    }
    __syncthreads();
}

#define GS_LOOP(N, CALL) for (long gi = (long)bid * NTHR + TIDX; gi < (long)(N); gi += (long)nblk * NTHR) { CALL; }
#ifndef PROBE
#define PROBE 0
#endif
#ifndef FAST_SCAN
#define FAST_SCAN 1
#endif
constexpr int N_PHASES = 16;
constexpr int MEGA_LDS = GEMM_LDS > TOPK_LDS ? GEMM_LDS : TOPK_LDS;

template <int PH>
DI void run_phase(const Params& p, int l, char* lds, int bid, int nblk) {
  const int need_ctx = (l == 0);
  const int rows = need_ctx ? R : RL;
  const float* xl_in = l == 0 ? p.x : p.out;
  const float* xc_in = l == 0 ? p.ctx : p.xc;
  bf16_t* QRAW = p.YO; bf16_t* KVRAW = p.YO + (size_t)R * 384;
  if constexpr (PH == 0) {
    ph_mods(p, lds, bid, nblk);
#pragma unroll 1
    for (int ll = 0; ll < 2; ++ll) {
      ph_wt(p.w_in + (size_t)ll * D * NZ, p.Wt_in + ll * WSZ_IN, D, NZ, NZP, 1, 0L, 0L, nullptr, lds, bid, nblk);
      ph_wt(p.w_gate + (size_t)ll * D * 4096, p.Wt_gate + ll * WSZ_GATE, D, 4096, 4096, 1, 0L, 0L, nullptr, lds, bid, nblk);
      ph_wt(p.w_branch + (size_t)ll * 4 * 256 * D, p.Wt_branch + ll * WSZ_BR, 256, D, D, 4, (long)256 * D, (long)D * 256, nullptr, lds, bid, nblk);
      ph_wt(p.w_out + (size_t)ll * D * D, p.Wt_out + ll * WSZ_OUT, D, D, D, 1, 0L, 0L, nullptr, lds, bid, nblk);
      ph_wt(p.w_uq + (size_t)ll * 256 * 384, p.Wt_uq + ll * WSZ_UQ, 256, 384, 384, 1, 0L, 0L, p.g_q_lat + ll * 256, lds, bid, nblk);
      ph_wt(p.w_ukv + (size_t)ll * 128 * 512, p.Wt_ukv + ll * WSZ_UKV, 128, 512, 512, 1, 0L, 0L, p.g_kv_lat + ll * 128, lds, bid, nblk);
    }
  } else if constexpr (PH == 1) {
    ph_modulate(p, l, xl_in, xc_in, bid, nblk);
  } else if constexpr (PH == 2) {
    ph_gemm_plain(p.H, D, p.Wt_in + l * WSZ_IN, D, R, NZP, D, p.Z, NZP, lds, bid, nblk);
#if PROBE == 63
    ph_gemm_probe<3>(p.H, D, p.Wt_in + l * WSZ_IN, D, R, NZP, D, p.mods + 40000, lds, bid, nblk);
#elif PROBE == 66
    ph_gemm_probe<6>(p.H, D, p.Wt_in + l * WSZ_IN, D, R, NZP, D, p.mods + 40000, lds, bid, nblk);
#elif PROBE == 67
    ph_gemm_plain<1>(p.H, D, p.Wt_in + l * WSZ_IN, D, R, NZP, D, p.Z, NZP, lds, bid, nblk);
#elif PROBE == 5
    ph_gemm_plain(p.H, D, p.Wt_in + l * WSZ_IN, D, R, NZP, D, p.Z, NZP, lds, bid, nblk);
#endif
  } else if constexpr (PH == 3) {
    ph_mla_up(p, l, QRAW, KVRAW, lds, bid, nblk);
  } else if constexpr (PH == 4) {
    ph_prep(p, l, QRAW, KVRAW, lds, bid, nblk);
#if PROBE == 41
    ph_prep(p, l, QRAW, KVRAW, lds, bid, nblk);
#elif PROBE == 43
    ph_prep<1>(p, l, QRAW, KVRAW, lds, bid, nblk);
#elif PROBE == 44
    ph_prep<2>(p, l, QRAW, KVRAW, lds, bid, nblk);
#endif
    __syncthreads();
    ph_gates_cum(p, l, lds, bid, nblk);
#if PROBE == 42
    ph_gates_cum(p, l, lds, bid, nblk);
#endif
  } else if constexpr (PH == 5) {
#if FAST_SCAN
    ph_ml_local(p, lds, bid, nblk);
    ph_gla_local(p, lds, bid, nblk);
#else
    GS_LOOP((long)NUNIT * 4160, nvb_ml_local(gi, p));
    GS_LOOP((long)NUNIT * 2048, nvb_gla_local(gi, p));
#endif
  } else if constexpr (PH == 6) {
#if FAST_SCAN
    ph_ml_scan(p, bid, nblk);
    ph_gla_scan(p, (bid + nblk - 260 % nblk) % nblk, nblk);
#else
    GS_LOOP((long)NB * 2 * 4 * 4160, nvb_ml_scan(gi, p));
    GS_LOOP((long)NB * 2 * 4 * 2048, nvb_gla_scan(gi, p));
#endif
    ph_attn(p, l, need_ctx, lds, bid, nblk);
#if PROBE >= 10 && PROBE < 20
    if (l == 0) ph_attn_mla_probe<PROBE - 10>(p, lds, bid, nblk);
#elif PROBE == 1
    ph_attn_diff(p, l, need_ctx, lds, bid, nblk);
#elif PROBE == 2
    ph_attn_mla(p, need_ctx, lds, bid, nblk);
#endif
  } else if constexpr (PH == 7) {
#if FAST_SCAN
    ph_ml_out(p, l, need_ctx, lds, bid, nblk);
    ph_gla_out(p, l, need_ctx, lds, bid, nblk);
#else
    GS_LOOP((long)NUNIT * 4096, nvb_ml_out(gi, p, need_ctx));
    GS_LOOP((long)NUNIT * 4096, nvb_gla_out(gi, p, need_ctx));
#endif
  } else if constexpr (PH == 8) {
#if !FAST_SCAN
    GS_LOOP((long)R * 4, nvb_ml_finish(gi, p, l, need_ctx));
    GS_LOOP((long)R * 4, nvb_gla_finish(gi, p, l, need_ctx));
#endif
  } else if constexpr (PH == 9) {
    ph_merge(p, l, rows, lds, bid, nblk);
#if PROBE == 3
    ph_merge(p, l, rows, lds, bid, nblk);
#endif
  } else if constexpr (PH == 10) {
    ph_gemm_plain(p.MG, D, p.Wt_out + l * WSZ_OUT, D, rows, D, D, p.YO, D, lds, bid, nblk);
  } else if constexpr (PH == 11) {
    ph_resid_mix(p, l, xl_in, xc_in, rows, bid, nblk);
  } else if constexpr (PH == 12) {
    ph_topk(p, need_ctx, lds, bid, nblk);
    ph_wt(p.w_e_gate + (size_t)l * NE * D * FF, p.Wt_eg, D, FF, FF, NE, (long)D * FF, (long)FF * D, nullptr, lds, bid, nblk);
    ph_wt(p.w_e_up + (size_t)l * NE * D * FF, p.Wt_eu, D, FF, FF, NE, (long)D * FF, (long)FF * D, nullptr, lds, bid, nblk);
    ph_wt(p.w_e_down + (size_t)l * NE * FF * D, p.Wt_ed, FF, D, D, NE, (long)FF * D, (long)D * FF, nullptr, lds, bid, nblk);
  } else if constexpr (PH == 13) {
    ph_moe1(p, need_ctx, lds, bid, nblk);
#if PROBE == 4
    ph_moe1(p, need_ctx, lds, bid, nblk);
#endif
  } else if constexpr (PH == 14) {
    ph_moe2(p, need_ctx, lds, bid, nblk);
#if PROBE == 4
    ph_moe2(p, need_ctx, lds, bid, nblk);
#endif
  } else if constexpr (PH == 15) {
    ph_resid_ffn(p, l, rows, bid, nblk);
  }
}

template <int PH> __global__ void __launch_bounds__(256, 2) k_phase(Params p, int l) {
  DYN_LDS(lds);
  run_phase<PH>(p, l, lds, blockIdx.x, gridDim.x);
}

#if !defined(CPU_EMU) && !MK_MULTI
typedef const Params __attribute__((address_space(4)))* KParams;
DI KParams kp_fresh() { KParams k = (KParams)__builtin_amdgcn_kernarg_segment_ptr(); asm volatile("" : "+s"(k)); return k; }
#define PHASE(PH, L) do { asm volatile("; PHASE_MARK " #PH); KParams k_ = kp_fresh(); run_phase<PH>(*(const Params*)k_, (L), lds, bid, nblk); if (PROBE == 20 + PH || (PROBE == 99 && (PH == 4 || PH == 5))) { __syncthreads(); run_phase<PH>(*(const Params*)k_, (L), lds, bid, nblk); } XcdBarrier b_ = bar; asm volatile("" : "+s"(b_.bar), "+s"(b_.x)); xcd_barrier(b_); if (PROBE == 50) xcd_barrier(b_); } while (0)
__global__ void __launch_bounds__(256, 2) k_mega(Params pv) {
  DYN_LDS(lds_all);
  if (threadIdx.x == 0) *(uint4*)lds_all = make_uint4(0u, 0u, 0u, 0u);
  __syncthreads();
  XcdBarrier bar = xcd_barrier_post(pv.bar, (volatile LAS unsigned*)lds_all);
  char* lds = lds_all + 256;
  const int bid = blockIdx.x, nblk = gridDim.x;
  PHASE(0, 0);
#pragma unroll 1
  for (int l = 0; l < 2; ++l) {
    PHASE(1, l); PHASE(2, l); PHASE(3, l); PHASE(4, l); PHASE(5, l); PHASE(6, l); PHASE(7, l);
#if !FAST_SCAN
    PHASE(8, l);
#endif

    PHASE(9, l); PHASE(10, l); PHASE(11, l); PHASE(12, l); PHASE(13, l); PHASE(14, l); PHASE(15, l);
  }
}
#endif
#ifdef CPU_EMU
void emu_check(const Params& p, int layer, int stage);
#define EMU_CHECK(stg) emu_check(p, l, stg)
static int g_nlayers = getenv("NLAYERS") ? atoi(getenv("NLAYERS")) : 2;
#else
#define EMU_CHECK(stg)
#endif
static void fill_params(Params& p, void* const* d_in, void* d_out, void* d_ws) {
  const float** f = (const float**)&p;
  for (int i = 0; i < 33; ++i) f[i] = (const float*)d_in[i];
  p.out = (float*)d_out;
  map_workspace(p, (char*)d_ws);
}
#define LAUNCH_PHASE(PH, L) LAUNCH((k_phase<PH>), grid, 256, MEGA_LDS, stream, p, L)

extern "C" void kernel_launch(void* const* d_in, const int* in_sizes, int n_in, void* d_out, int out_size, void* d_ws,
                              size_t ws_size, hipStream_t stream) {
  Params p{};
  fill_params(p, d_in, d_out, d_ws);
  if (p.ws_need > ws_size) return;
#ifdef CPU_EMU
  const int grid = 16;
  LAUNCH_PHASE(0, 0);
  for (int l = 0; l < g_nlayers; ++l) {
    LAUNCH_PHASE(1, l); LAUNCH_PHASE(2, l); LAUNCH_PHASE(3, l); LAUNCH_PHASE(4, l); LAUNCH_PHASE(5, l); LAUNCH_PHASE(6, l); LAUNCH_PHASE(7, l); LAUNCH_PHASE(8, l);
    EMU_CHECK(1);
    LAUNCH_PHASE(9, l); LAUNCH_PHASE(10, l); LAUNCH_PHASE(11, l);
    EMU_CHECK(2);
    LAUNCH_PHASE(12, l); LAUNCH_PHASE(13, l); LAUNCH_PHASE(14, l); LAUNCH_PHASE(15, l);
    EMU_CHECK(3);
  }
#else
  static int grid = 0;
  if (grid == 0) {
    int dev = 0, cus = 0, per_cu = 0;
    (void)hipGetDevice(&dev);
    (void)hipDeviceGetAttribute(&cus, hipDeviceAttributeMultiprocessorCount, dev);
#if MK_MULTI
    (void)hipFuncSetAttribute((const void*)k_phase<0>, hipFuncAttributeMaxDynamicSharedMemorySize, MEGA_LDS);
    (void)hipFuncSetAttribute((const void*)k_phase<1>, hipFuncAttributeMaxDynamicSharedMemorySize, MEGA_LDS);
    (void)hipFuncSetAttribute((const void*)k_phase<2>, hipFuncAttributeMaxDynamicSharedMemorySize, MEGA_LDS);
    (void)hipFuncSetAttribute((const void*)k_phase<3>, hipFuncAttributeMaxDynamicSharedMemorySize, MEGA_LDS);
    (void)hipFuncSetAttribute((const void*)k_phase<4>, hipFuncAttributeMaxDynamicSharedMemorySize, MEGA_LDS);
    (void)hipFuncSetAttribute((const void*)k_phase<5>, hipFuncAttributeMaxDynamicSharedMemorySize, MEGA_LDS);
    (void)hipFuncSetAttribute((const void*)k_phase<6>, hipFuncAttributeMaxDynamicSharedMemorySize, MEGA_LDS);
    (void)hipFuncSetAttribute((const void*)k_phase<7>, hipFuncAttributeMaxDynamicSharedMemorySize, MEGA_LDS);
    (void)hipFuncSetAttribute((const void*)k_phase<8>, hipFuncAttributeMaxDynamicSharedMemorySize, MEGA_LDS);
    (void)hipFuncSetAttribute((const void*)k_phase<9>, hipFuncAttributeMaxDynamicSharedMemorySize, MEGA_LDS);
    (void)hipFuncSetAttribute((const void*)k_phase<10>, hipFuncAttributeMaxDynamicSharedMemorySize, MEGA_LDS);
    (void)hipFuncSetAttribute((const void*)k_phase<11>, hipFuncAttributeMaxDynamicSharedMemorySize, MEGA_LDS);
    (void)hipFuncSetAttribute((const void*)k_phase<12>, hipFuncAttributeMaxDynamicSharedMemorySize, MEGA_LDS);
    (void)hipFuncSetAttribute((const void*)k_phase<13>, hipFuncAttributeMaxDynamicSharedMemorySize, MEGA_LDS);
    (void)hipFuncSetAttribute((const void*)k_phase<14>, hipFuncAttributeMaxDynamicSharedMemorySize, MEGA_LDS);
    (void)hipFuncSetAttribute((const void*)k_phase<15>, hipFuncAttributeMaxDynamicSharedMemorySize, MEGA_LDS);
    grid = (cus > 0 ? cus : 256) * 2;
#else
    if (hipFuncSetAttribute((const void*)k_mega, hipFuncAttributeMaxDynamicSharedMemorySize, MEGA_LDS + 256) != hipSuccess) { grid = -1; return; }
    if (hipOccupancyMaxActiveBlocksPerMultiprocessor(&per_cu, (const void*)k_mega, 256, MEGA_LDS + 256) != hipSuccess) per_cu = 0;
    (void)hipGetLastError();
    if (per_cu < 1) { grid = -1; return; }
    grid = (cus > 0 ? cus : 256) * (per_cu < 2 ? per_cu : 2);
#endif
  }
  if (grid < 0) return;
#if MK_MULTI
  LAUNCH_PHASE(0, 0);
  for (int l = 0; l < 2; ++l) {
    LAUNCH_PHASE(1, l); LAUNCH_PHASE(2, l); LAUNCH_PHASE(3, l); LAUNCH_PHASE(4, l); LAUNCH_PHASE(5, l); LAUNCH_PHASE(6, l); LAUNCH_PHASE(7, l); LAUNCH_PHASE(8, l);
    LAUNCH_PHASE(9, l); LAUNCH_PHASE(10, l); LAUNCH_PHASE(11, l); LAUNCH_PHASE(12, l); LAUNCH_PHASE(13, l); LAUNCH_PHASE(14, l); LAUNCH_PHASE(15, l);
  }
#else
  (void)hipMemsetAsync(p.bar, 0, XCD_BAR_WORDS * sizeof(unsigned), stream);
  k_mega<<<dim3(grid), dim3(256), MEGA_LDS + 256, stream>>>(p);
#endif
#endif
}
```

```cpp
#ifndef CPU_EMU
#include <hip/hip_runtime.h>
#endif
#include <stdint.h>
#include <stddef.h>

#ifndef T_LAT
#define T_LAT 16384
#endif
#ifndef T_CTX
#define T_CTX 256
#endif

#ifndef MK_MULTI
#define MK_MULTI 0
#endif
#define DI __device__ __forceinline__
typedef unsigned short bf16_t;
typedef short bf16x8 __attribute__((ext_vector_type(8)));
typedef short s16x4 __attribute__((ext_vector_type(4)));
typedef float f32x4 __attribute__((ext_vector_type(4)));
typedef float f32x16 __attribute__((ext_vector_type(16)));
typedef unsigned u32x4 __attribute__((ext_vector_type(4)));
typedef unsigned u32x2 __attribute__((ext_vector_type(2)));
typedef float f32x2 __attribute__((ext_vector_type(2)));

#ifdef CPU_EMU
static inline float u2f(unsigned u) { float f; memcpy(&f, &u, 4); return f; }
static inline unsigned f2u(float f) { unsigned u; memcpy(&u, &f, 4); return u; }
#define MFMA32(a, b, c) emu_mfma_32x32x16((a), (b), (c))
#define MFMA16(a, b, c) emu_mfma_16x16x32((a), (b), (c))
static inline float fast_exp2(float x) { return exp2f(x); }
static inline float fast_rcp(float x) { return 1.0f / x; }
static inline float fast_rsq(float x) { return 1.0f / sqrtf(x); }
static inline float hw_sin_rev(float x) { return sinf(6.283185307179586f * x); }
static inline float hw_cos_rev(float x) { return cosf(6.283185307179586f * x); }
#define LAUNCH(kern, grid, block, lds, stream, ...) emu::launch(dim3(grid), dim3(block), (size_t)(lds), [=]() { kern(__VA_ARGS__); })
#define DYN_LDS(name) char* name = emu_dynlds()
#define SCHED_BARRIER()
#define TIDX ((int)threadIdx.x)
#define WAVE_SYNC() emu::wave_barrier()
#define SETPRIO(x)
#define IGLP_OPT()
template <int M> static inline float xor_sum(float v) { return v + __shfl_xor(v, M); }
template <int M> static inline float xor_max(float v) { return fmaxf(v, __shfl_xor(v, M)); }
template <int M> static inline int xor_sum_i(int v) { return v + __shfl_xor(v, M); }
static inline int lane_bcast(int v, int src) { return __shfl(v, src); }
static inline int lane_up(int v, int d, int lane) { (void)lane; return __shfl_up(v, d); }
#else
DI float u2f(unsigned u) { return __uint_as_float(u); }
DI unsigned f2u(float f) { return __float_as_uint(f); }
#define MFMA32(a, b, c) __builtin_amdgcn_mfma_f32_32x32x16_bf16((a), (b), (c), 0, 0, 0)
#define MFMA16(a, b, c) __builtin_amdgcn_mfma_f32_16x16x32_bf16((a), (b), (c), 0, 0, 0)
DI float fast_exp2(float x) { return __builtin_amdgcn_exp2f(x); }
DI float fast_rcp(float x) { return __builtin_amdgcn_rcpf(x); }
DI float fast_rsq(float x) { return __builtin_amdgcn_rsqf(x); }
DI float hw_sin_rev(float x) { return __builtin_amdgcn_sinf(x); }
DI float hw_cos_rev(float x) { return __builtin_amdgcn_cosf(x); }
#define LAUNCH(kern, grid, block, lds, stream, ...) kern<<<dim3(grid), dim3(block), (lds), (stream)>>>(__VA_ARGS__)
#define DYN_LDS(name) extern __shared__ __attribute__((aligned(16))) char name[]
#define SCHED_BARRIER() __builtin_amdgcn_sched_barrier(0)
DI int tid_fresh() { int t = (int)threadIdx.x; asm volatile("" : "+v"(t)); return t; }
#define TIDX tid_fresh()
#define WAVE_SYNC() __builtin_amdgcn_wave_barrier()
#define SETPRIO(x) __builtin_amdgcn_s_setprio(x)
#define IGLP_OPT() __builtin_amdgcn_iglp_opt(0)
#ifdef USE_SHFL
template <int M> DI float xor_sum(float v) { return v + __shfl_xor(v, M); }
template <int M> DI float xor_max(float v) { return fmaxf(v, __shfl_xor(v, M)); }
template <int M> DI int xor_sum_i(int v) { return v + __shfl_xor(v, M); }
DI int lane_bcast(int v, int src) { return __shfl(v, src); }
DI int lane_up(int v, int d, int lane) { (void)lane; return __shfl_up(v, d); }
#else
template <int M> DI int xor_partner_bits(int bits) { return __builtin_amdgcn_ds_swizzle(bits, (M << 10) | 0x1f); }
DI void half_swap(unsigned& a, unsigned& b) { asm volatile("s_nop 1\n\tv_permlane32_swap_b32 %0, %1\n\ts_nop 1" : "+v"(a), "+v"(b)); }
template <int M> DI float xor_sum(float v) {
  if constexpr (M < 32) return v + __builtin_bit_cast(float, xor_partner_bits<M>(__builtin_bit_cast(int, v)));
  else { unsigned a = __builtin_bit_cast(unsigned, v), b = a; half_swap(a, b); return __builtin_bit_cast(float, a) + __builtin_bit_cast(float, b); }
}
template <int M> DI float xor_max(float v) {
  if constexpr (M < 32) return fmaxf(v, __builtin_bit_cast(float, xor_partner_bits<M>(__builtin_bit_cast(int, v))));
  else { unsigned a = __builtin_bit_cast(unsigned, v), b = a; half_swap(a, b); return fmaxf(__builtin_bit_cast(float, a), __builtin_bit_cast(float, b)); }
}
template <int M> DI int xor_sum_i(int v) {
  if constexpr (M < 32) return v + xor_partner_bits<M>(v);
  else { unsigned a = (unsigned)v, b = a; half_swap(a, b); return (int)(a + b); }
}
DI int lane_bcast(int v, int src) { return __builtin_amdgcn_readlane(v, src); }
DI int lane_up(int v, int d, int lane) { return __builtin_amdgcn_ds_bpermute(((lane - d) & 63) << 2, v); }
#endif
#endif

DI float bf2f(bf16_t v) { return u2f(((unsigned)v) << 16); }
#ifdef CPU_EMU
DI bf16_t f2bf(float f) { unsigned u = f2u(f); u += 0x7fffu + ((u >> 16) & 1u); return (bf16_t)(u >> 16); }
DI unsigned pack2bf(float lo, float hi) { return (unsigned)f2bf(lo) | ((unsigned)f2bf(hi) << 16); }
static inline bool wave_any(bool pr) { int v = pr ? 1 : 0; v |= __shfl_xor(v, 1); v |= __shfl_xor(v, 2); v |= __shfl_xor(v, 4); v |= __shfl_xor(v, 8); v |= __shfl_xor(v, 16); v |= __shfl_xor(v, 32); return v != 0; }
#else
typedef float f32x2_ __attribute__((ext_vector_type(2)));
typedef __bf16 bf16x2_hw __attribute__((ext_vector_type(2)));
DI unsigned pack2bf(float lo, float hi) { const f32x2_ v = {lo, hi}; return __builtin_bit_cast(unsigned, __builtin_convertvector(v, bf16x2_hw)); }
DI bf16_t f2bf(float f) { return (bf16_t)(pack2bf(f, f) & 0xffffu); }
DI bool wave_any(bool pr) { return __builtin_amdgcn_ballot_w64(pr) != 0ull; }
#endif
DI float sigmoidf_(float x) { return 1.0f / (1.0f + expf(-x)); }
DI float siluf_(float x) { return x / (1.0f + expf(-x)); }
DI float logsigmoidf_(float x) { return fminf(x, 0.0f) - log1pf(expf(-fabsf(x))); }

constexpr int D = 1024, NB = 2, TL = T_LAT, TC = T_CTX, TK = TL + TC;
constexpr int RL = NB * TL, RC = NB * TC, R = RL + RC;
constexpr int NZ = 3024, NZP = 3072;
constexpr int ZC_QLAT = 0, ZC_KVLAT = 256, ZC_KROPE = 384, ZC_MLQK = 416, ZC_MLV = 928, ZC_MLO = 1184, ZC_MLIG = 1440,
              ZC_MLFG = 1448, ZC_GQ = 1456, ZC_GK = 1584, ZC_GV = 1712, ZC_GR = 1968, ZC_GA = 2224, ZC_DQ = 2256,
              ZC_DK = 2512, ZC_DV = 2768;
constexpr int NCK = TK / 64, NCC = TC / 64, NCL = TL / 64;
constexpr int NE = 16, FF = 1408, CAPL = 2 * TL / 16, CAPC = 2 * TC / 16, CAPT = CAPL + CAPC, NSLOT = NB * CAPT;
constexpr size_t WSZ_IN = (size_t)NZP * D, WSZ_UQ = 384 * 256, WSZ_UKV = 512 * 128, WSZ_GATE = (size_t)4096 * D, WSZ_BR = (size_t)4 * D * 256, WSZ_OUT = (size_t)D * D;
constexpr int NUNIT = NB * 2 * NCK * 4;
constexpr float LOG2E = 1.4426950408889634f;
constexpr float QS_MLA = 0.10206207261596577f * LOG2E;
constexpr float QS_DIFF = 0.17677669529663687f * LOG2E;

DI int row_of(int b, int s) { return s < TC ? RL + b * TC + s : b * TL + (s - TC); }
DI void bs_of(int r, int& b, int& s) { if (r < RL) { b = r / TL; s = TC + (r % TL); } else { int q = r - RL; b = q / TC; s = q % TC; } }
DI int seq_of(int d, int p) { return d == 0 ? p : (p < TC ? TC - 1 - p : TK - 1 - (p - TC)); }
DI int step_of(int d, int c) { return d == 0 ? c : (c < NCC ? NCC - 1 - c : NCC + (NCK - 1 - c)); }

struct Params {
  const float *x, *c, *ctx, *c_ctx, *w_ada, *b_ada, *g_mix_pre, *g_mix_post, *g_ffn_pre, *g_ffn_post, *w_in, *g_q_lat, *w_uq,
      *g_kv_lat, *w_ukv, *w_conv, *b_conv, *b_igate, *b_fgate, *g_mlstm_out, *w_alpha2, *b_alpha, *g_gla_out, *diff_lambda,
      *g_diff_out, *w_branch, *w_gate, *b_gate, *w_out, *w_router, *w_e_gate, *w_e_up, *w_e_down;
  float* out;
  float *mods, *xc;
  bf16_t *H, *Z, *Qm, *Km, *Vtm, *Qd, *Kd, *Vtd, *MQ, *MK, *Y, *MG, *YO, *HID, *YE, *MVt, *GVt;
  float *BC, *IGS, *GC, *MC, *MN, *MM, *GS, *HD, *OD, *AFF, *SELV;
  int *SEL, *INV;
  bf16_t *Wt_in, *Wt_uq, *Wt_ukv, *Wt_gate, *Wt_branch, *Wt_out, *Wt_eg, *Wt_eu, *Wt_ed;
  unsigned* bar;
  size_t ws_need;
};

static inline size_t al256(size_t x) { return (x + 255) & ~(size_t)255; }
static inline void map_workspace(Params& p, char* ws) {
  size_t o = 0;
  auto take = [&](size_t bytes) { size_t r = o; o += al256(bytes); return ws + r; };
  p.bar = (unsigned*)take(16384);
  p.mods = (float*)take((size_t)2 * 3 * 6144 * 4);
  p.xc = (float*)take((size_t)RC * D * 4);
  p.BC = (float*)take((size_t)NB * 2 * TK * 4 * 4);
  p.IGS = (float*)take((size_t)NB * 2 * TK * 4 * 4);
  p.AFF = (float*)take((size_t)NB * NE * TK * 4);
  p.SEL = (int*)take((size_t)NE * NSLOT * 4);
  p.SELV = (float*)take((size_t)NE * NSLOT * 4);
  p.INV = (int*)take((size_t)R * NE * 4);
  p.MM = (float*)take((size_t)NUNIT * 4 * 4);
  p.MN = (float*)take((size_t)NUNIT * 64 * 4);
  p.Wt_in = (bf16_t*)take((size_t)2 * WSZ_IN * 2);
  p.Wt_uq = (bf16_t*)take((size_t)2 * WSZ_UQ * 2);
  p.Wt_ukv = (bf16_t*)take((size_t)2 * WSZ_UKV * 2);
  p.Wt_gate = (bf16_t*)take((size_t)2 * WSZ_GATE * 2);
  p.Wt_branch = (bf16_t*)take((size_t)2 * WSZ_BR * 2);
  p.Wt_out = (bf16_t*)take((size_t)2 * WSZ_OUT * 2);
  p.H = (bf16_t*)take((size_t)R * D * 2);
  size_t szA = (size_t)R * NZP * 2, szHID = (size_t)NE * NSLOT * FF * 2;
  char* A = take(szA > szHID ? szA : szHID);
  p.Z = (bf16_t*)A; p.HID = (bf16_t*)A;
  size_t szQm = al256((size_t)NB * 4 * TK * 96 * 2), szVt = al256((size_t)NB * 4 * 64 * TK * 2), szQd = al256((size_t)NB * 8 * TK * 32 * 2);
  size_t szB1 = 2 * szQm + 2 * szVt + 2 * szQd;
  size_t szHD = al256((size_t)2 * NB * TK * 256 * 4);
  size_t szYE = (size_t)NE * NSLOT * D * 2;
  size_t szB = szB1; if (2 * szHD > szB) szB = 2 * szHD; if (szYE > szB) szB = szYE;
  char* Bq = take(szB);
  p.Qm = (bf16_t*)Bq; p.Km = (bf16_t*)(Bq + szQm); p.Vtm = (bf16_t*)(Bq + 2 * szQm);
  p.Qd = (bf16_t*)(Bq + 2 * szQm + szVt); p.Kd = (bf16_t*)(Bq + 2 * szQm + szVt + szQd); p.Vtd = (bf16_t*)(Bq + 2 * szQm + szVt + 2 * szQd);
  p.YE = (bf16_t*)Bq;
  p.GC = (float*)take((size_t)NB * 2 * TK * 128 * 4);
  p.MVt = (bf16_t*)take((size_t)NB * 4 * 64 * TK * 2);
  p.GVt = (bf16_t*)take((size_t)NB * 4 * 64 * TK * 2);
  size_t szW = (size_t)NE * FF * D * 2;
  size_t szMC = (size_t)NUNIT * 4096 * 4, szRD = (size_t)R * D * 2;
  size_t szC = szMC; if (szRD > szC) szC = szRD; if (szW > szC) szC = szW;
  char* C = take(szC);
  p.MC = (float*)C; p.MG = (bf16_t*)C; p.Wt_eg = (bf16_t*)C;
  size_t szMQ = al256((size_t)NB * TK * 256 * 2), szGS = (size_t)NUNIT * 2048 * 4;
  size_t szD = 2 * szMQ + szGS; if (szW > szD) szD = szW;
  char* Dq = take(szD);
  p.MQ = (bf16_t*)Dq; p.MK = (bf16_t*)(Dq + szMQ); p.GS = (float*)(Dq + 2 * szMQ); p.Wt_eu = (bf16_t*)Dq;
  size_t szF = 2 * szRD > szW ? 2 * szRD : szW;
  char* F = take(szF);
  p.Y = (bf16_t*)F; p.YO = (bf16_t*)(F + szRD); p.Wt_ed = (bf16_t*)F;
  p.HD = (float*)Bq; p.OD = (float*)(Bq + szHD);
  p.ws_need = o;
}
#define GTID ((long)blockIdx.x * blockDim.x + threadIdx.x)

DI float lam_of(const Params& p, int layer, float& lam_init) {
  const float* lv = p.diff_lambda + layer * 128;
  float s1 = 0.f, s2 = 0.f;
  for (int i = 0; i < 32; ++i) { s1 += lv[i] * lv[32 + i]; s2 += lv[64 + i] * lv[96 + i]; }
  lam_init = layer == 0 ? 0.2f : 0.35550906759096f;
  return expf(s1) - expf(s2) + lam_init;
}
DI void rope_cs(int s, int jj, float& cs, float& sn) {
  int t = s - TC;
  int pos = (jj < 16) ? (t / 64) : (t % 64);
  float ang = (float)pos * exp2f(-1.6609640474436813f * (float)(jj & 7));
  double rev = (double)ang * 0.15915494309189535;
  rev -= floor(rev + 0.5);
  float rf = (float)rev;
  cs = hw_cos_rev(rf); sn = hw_sin_rev(rf);
}
template <class G> DI float rope_elem(G get, int s, int jj) {
  if (s < TC) return get(jj);
  float cs, sn; rope_cs(s, jj, cs, sn);
  float a = get(jj), b = get(jj ^ 8);
  return (jj & 8) ? (a * cs + b * sn) : (a * cs - b * sn);
}

DI void nvb_mods(long GI, const Params& p) {
  long i = GI; if (i >= 2 * 3 * 6144) return;
  int col = (int)(i % 6144), w = (int)((i / 6144) % 3), l = (int)(i / (3 * 6144));
  const float* cv = w < 2 ? p.c + w * 1024 : p.c_ctx;
  const float* W = p.w_ada + (size_t)l * 1024 * 6144;
  float acc = 0.f;
  for (int k = 0; k < 1024; ++k) acc += siluf_(cv[k]) * W[(size_t)k * 6144 + col];
  p.mods[i] = acc + p.b_ada[l * 6144 + col];
}
__global__ void __launch_bounds__(256) nv_wt(const float* in, bf16_t* out, int K, int N, int NP, long in_bs, long out_bs, const float* gain) {
  long i = GTID; if (i >= (long)NP * K) return;
  int k = (int)(i % K), n = (int)(i / K);
  const float* I = in + (size_t)blockIdx.y * in_bs; bf16_t* O = out + (size_t)blockIdx.y * out_bs;
  O[(size_t)n * K + k] = n < N ? f2bf(I[(size_t)k * N + n] * (gain ? gain[k] : 1.0f)) : (bf16_t)0;
}
__global__ void __launch_bounds__(256) nv_modulate(Params p, int layer, int which, const float* xl, const float* xcx, int nrows) {
  long r = GTID; if (r >= nrows) return;
  int w = r < RL ? (int)(r / TL) : 2;
  const float* mb = p.mods + (size_t)(layer * 3 + w) * 6144;
  const float* shift = mb + (which ? 3 : 0) * 1024; const float* scale = mb + (which ? 4 : 1) * 1024;
  const float* g = (which ? p.g_ffn_pre : p.g_mix_pre) + layer * 1024;
  const float* x = r < RL ? xl + (size_t)r * D : xcx + (size_t)(r - RL) * D;
  float ss = 0.f; for (int k = 0; k < D; ++k) ss += x[k] * x[k];
  float rstd = 1.0f / sqrtf(ss / D + 1e-6f);
  for (int k = 0; k < D; ++k) p.H[(size_t)r * D + k] = f2bf(x[k] * rstd * g[k] * (1.f + scale[k]) + shift[k]);
}
__global__ void __launch_bounds__(256) nv_gemm(const bf16_t* A, int lda, const bf16_t* Bt, int ldb, int M, int N, int K, bf16_t* C, int ldc) {
  long i = GTID; if (i >= (long)M * N) return;
  int n = (int)(i % N), m = (int)(i / N);
  const bf16_t* a = A + (size_t)m * lda; const bf16_t* b = Bt + (size_t)n * ldb;
  float acc = 0.f;
  for (int k = 0; k < K; ++k) acc += bf2f(a[k]) * bf2f(b[k]);
  C[(size_t)m * ldc + n] = f2bf(acc);
}
__global__ void __launch_bounds__(256) nv_mla_q(Params p, int layer) {
  long i = GTID; if (i >= (long)R * 4 * 96) return;
  int j = (int)(i % 96), h = (int)((i / 96) % 4), r = (int)(i / 384);
  int b, s; bs_of(r, b, s);
  const bf16_t* z = p.Z + (size_t)r * NZP + ZC_QLAT;
  const float* g = p.g_q_lat + layer * 256; const float* W = p.w_uq + (size_t)layer * 256 * 384;
  float ss = 0.f; for (int k = 0; k < 256; ++k) { float v = bf2f(z[k]); ss += v * v; }
  float rstd = 1.0f / sqrtf(ss / 256 + 1e-6f);
  auto dot = [&](int col) { float a = 0.f; for (int k = 0; k < 256; ++k) a += bf2f(z[k]) * rstd * g[k] * W[(size_t)k * 384 + col]; return a; };
  float v;
  if (j < 64) v = dot(h * 96 + j);
  else v = rope_elem([&](int jj) { return dot(h * 96 + 64 + jj); }, s, j - 64);
  p.Qm[(((size_t)b * 4 + h) * TK + s) * 96 + j] = f2bf(v * QS_MLA);
}
__global__ void __launch_bounds__(256) nv_mla_kv(Params p, int layer) {
  long i = GTID; if (i >= (long)R * 4 * 160) return;
  int j = (int)(i % 160), h = (int)((i / 160) % 4), r = (int)(i / 640);
  int b, s; bs_of(r, b, s);
  const bf16_t* z = p.Z + (size_t)r * NZP;
  if (j < 128) {
    const bf16_t* zl = z + ZC_KVLAT; const float* g = p.g_kv_lat + layer * 128; const float* W = p.w_ukv + (size_t)layer * 128 * 512;
    float ss = 0.f; for (int k = 0; k < 128; ++k) { float v = bf2f(zl[k]); ss += v * v; }
    float rstd = 1.0f / sqrtf(ss / 128 + 1e-6f);
    float a = 0.f; for (int k = 0; k < 128; ++k) a += bf2f(zl[k]) * rstd * g[k] * W[(size_t)k * 512 + h * 128 + j];
    if (j < 64) p.Km[(((size_t)b * 4 + h) * TK + s) * 96 + j] = f2bf(a);
    else p.Vtm[(((size_t)b * 4 + h) * 64 + (j - 64)) * TK + s] = f2bf(a);
  } else {
    int jj = j - 128;
    float v = rope_elem([&](int q) { return bf2f(z[ZC_KROPE + q]); }, s, jj);
    p.Km[(((size_t)b * 4 + h) * TK + s) * 96 + 64 + jj] = f2bf(v);
  }
}
__global__ void __launch_bounds__(256) nv_diff_prep(Params p) {
  long i = GTID; if (i >= (long)R * 768) return;
  int c = (int)(i % 768), r = (int)(i / 768);
  int b, s; bs_of(r, b, s);
  const bf16_t* z = p.Z + (size_t)r * NZP;
  if (c < 512) {
    int qk = c / 256, cc = c % 256, hm = cc / 32, jj = cc % 32;
    const bf16_t* src = z + (qk ? ZC_DK : ZC_DQ) + hm * 32;
    float v = rope_elem([&](int q) { return bf2f(src[q]); }, s, jj);
    if (qk == 0) p.Qd[(((size_t)b * 8 + hm) * TK + s) * 32 + jj] = f2bf(v * QS_DIFF);
    else p.Kd[(((size_t)b * 8 + hm) * TK + s) * 32 + jj] = f2bf(v);
  } else {
    int cc = c - 512, h = cc / 64, dv = cc % 64;
    p.Vtd[(((size_t)b * 4 + h) * 64 + dv) * TK + s] = z[ZC_DV + cc];
  }
}
__global__ void __launch_bounds__(256) nv_ml_prep(Params p, int layer) {
  long i = GTID; if (i >= (long)R * 512) return;
  int ch = (int)(i % 512), r = (int)(i / 512);
  int b, s; bs_of(r, b, s);
  bool first = (s == 0) || (s == TC), last = (s == TC - 1) || (s == TK - 1);
  const float* w = p.w_conv + (size_t)layer * 3 * 512;
  float acc = p.b_conv[layer * 512 + ch];
  acc += bf2f(p.Z[(size_t)r * NZP + ZC_MLQK + ch]) * w[512 + ch];
  if (!first) acc += bf2f(p.Z[(size_t)row_of(b, s - 1) * NZP + ZC_MLQK + ch]) * w[ch];
  if (!last) acc += bf2f(p.Z[(size_t)row_of(b, s + 1) * NZP + ZC_MLQK + ch]) * w[1024 + ch];
  float v = siluf_(acc);
  if (ch < 256) p.MQ[((size_t)b * TK + s) * 256 + ch] = f2bf(v);
  else p.MK[((size_t)b * TK + s) * 256 + ch - 256] = f2bf(v * 0.125f);
}
DI void nvb_ml_gates(long GI, const Params& p, int layer) {
  long i = GI; if (i >= (long)NB * 2 * NCK * 4) return;
  int h = (int)(i % 4), j = (int)((i / 4) % NCK), d = (int)((i / (4 * NCK)) % 2), b = (int)(i / (8 * NCK));
  float bi = p.b_igate[layer * 8 + d * 4 + h], bfg = p.b_fgate[layer * 8 + d * 4 + h];
  float cum = 0.f;
  for (int l = 0; l < 64; ++l) {
    int pp = 64 * j + l, s = seq_of(d, pp); const bf16_t* z = p.Z + (size_t)row_of(b, s) * NZP;
    float ig = bf2f(z[ZC_MLIG + d * 4 + h]) + bi;
    float lf = logsigmoidf_(bf2f(z[ZC_MLFG + d * 4 + h]) + bfg);
    cum += lf;
    size_t o = (((size_t)b * 2 + d) * TK + pp) * 4 + h;
    p.BC[o] = cum; p.IGS[o] = ig;
  }
}
DI void nvb_gla_cum(long GI, const Params& p, int layer) {
  long i = GI; if (i >= (long)NB * 2 * NCK * 128) return;
  int ch = (int)(i % 128), j = (int)((i / 128) % NCK), d = (int)((i / (128 * NCK)) % 2), b = (int)(i / (256 * NCK));
  const float* W = p.w_alpha2 + (size_t)layer * 2 * 16 * 128 + (size_t)d * 16 * 128;
  float ba = p.b_alpha[layer * 256 + d * 128 + ch];
  float cum = 0.f;
  for (int l = 0; l < 64; ++l) {
    int pp = 64 * j + l, s = seq_of(d, pp); const bf16_t* z = p.Z + (size_t)row_of(b, s) * NZP + ZC_GA + d * 16;
    float zg = ba; for (int q = 0; q < 16; ++q) zg += bf2f(z[q]) * W[q * 128 + ch];
    cum += logsigmoidf_(zg) * (1.0f / 16.0f);
    p.GC[(((size_t)b * 2 + d) * TK + pp) * 128 + ch] = cum;
  }
}
__global__ void __launch_bounds__(256) nv_attn_mla(Params p, int need_ctx) {
  long i = GTID; if (i >= (long)NB * 4 * TK) return;
  int s = (int)(i % TK), h = (int)((i / TK) % 4), b = (int)(i / (4 * TK));
  if (s < TC && !need_ctx) return;
  int nk = s < TC ? TC : TK;
  const bf16_t* q = p.Qm + (((size_t)b * 4 + h) * TK + s) * 96;
  const bf16_t* K = p.Km + ((size_t)b * 4 + h) * TK * 96;
  const bf16_t* Vt = p.Vtm + ((size_t)b * 4 + h) * 64 * TK;
  float qf[96], o[64];
  _Pragma("unroll") for (int k = 0; k < 96; ++k) qf[k] = bf2f(q[k]);
  _Pragma("unroll") for (int k = 0; k < 64; ++k) o[k] = 0.f;
  float m = -1e30f, l = 0.f;
  for (int t = 0; t < nk; ++t) {
    float sc = 0.f; _Pragma("unroll") for (int k = 0; k < 96; ++k) sc += qf[k] * bf2f(K[(size_t)t * 96 + k]);
    float mn = fmaxf(m, sc), a = exp2f(m - mn), pr = exp2f(sc - mn);
    l = l * a + pr;
    _Pragma("unroll") for (int k = 0; k < 64; ++k) o[k] = o[k] * a + pr * bf2f(Vt[(size_t)k * TK + t]);
    m = mn;
  }
  int r = row_of(b, s);
  _Pragma("unroll") for (int k = 0; k < 64; ++k) p.Y[(size_t)r * D + h * 64 + k] = f2bf(o[k] / l);
}
__global__ void __launch_bounds__(256) nv_attn_diff(Params p, int layer, int need_ctx) {
  long i = GTID; if (i >= (long)NB * 4 * TK) return;
  int s = (int)(i % TK), h = (int)((i / TK) % 4), b = (int)(i / (4 * TK));
  if (s < TC && !need_ctx) return;
  int nk = s < TC ? TC : TK;
  float lam_init; float lam = lam_of(p, layer, lam_init);
  const bf16_t* Vt = p.Vtd + ((size_t)b * 4 + h) * 64 * TK;
  float res[64];
  _Pragma("unroll") for (int k = 0; k < 64; ++k) res[k] = 0.f;
  _Pragma("unroll") for (int mp = 0; mp < 2; ++mp) {
    const bf16_t* q = p.Qd + (((size_t)b * 8 + h * 2 + mp) * TK + s) * 32;
    const bf16_t* K = p.Kd + ((size_t)b * 8 + h * 2 + mp) * TK * 32;
    float qf[32], o[64];
    _Pragma("unroll") for (int k = 0; k < 32; ++k) qf[k] = bf2f(q[k]);
    _Pragma("unroll") for (int k = 0; k < 64; ++k) o[k] = 0.f;
    float m = -1e30f, l = 0.f;
    for (int t = 0; t < nk; ++t) {
      float sc = 0.f; _Pragma("unroll") for (int k = 0; k < 32; ++k) sc += qf[k] * bf2f(K[(size_t)t * 32 + k]);
      float mn = fmaxf(m, sc), a = exp2f(m - mn), pr = exp2f(sc - mn);
      l = l * a + pr;
      _Pragma("unroll") for (int k = 0; k < 64; ++k) o[k] = o[k] * a + pr * bf2f(Vt[(size_t)k * TK + t]);
      m = mn;
    }
    float wgt = mp == 0 ? 1.f : -lam;
    _Pragma("unroll") for (int k = 0; k < 64; ++k) res[k] += wgt * o[k] / l;
  }
  float ss = 0.f; _Pragma("unroll") for (int k = 0; k < 64; ++k) ss += res[k] * res[k];
  float rstd = 1.0f / sqrtf(ss / 64 + 1e-6f);
  int r = row_of(b, s);
  _Pragma("unroll") for (int k = 0; k < 64; ++k) p.Y[(size_t)r * D + 768 + h * 64 + k] = f2bf(res[k] * rstd * p.g_diff_out[layer * 256 + h * 64 + k] * (1.f - lam_init));
}
DI void nvb_ml_local(long GI, const Params& p) {
  long i = GI; if (i >= (long)NUNIT * 4160) return;
  int e = (int)(i % 4160); long u = i / 4160;
  int h = (int)(u % 4), j = (int)((u / 4) % NCK), d = (int)((u / (4 * NCK)) % 2), b = (int)(u / (8 * NCK));
  const float* bc = p.BC + (((size_t)b * 2 + d) * TK + 64 * j) * 4 + h; const float* ig = p.IGS + (((size_t)b * 2 + d) * TK + 64 * j) * 4 + h;
  float bend = bc[63 * 4], ml = -1e30f;
  for (int l = 0; l < 64; ++l) ml = fmaxf(ml, bend - bc[l * 4] + ig[l * 4]);
  if (e == 4096 + 0) { p.MM[u * 4 + 0] = ml; p.MM[u * 4 + 1] = bend; }
  float acc = 0.f;
  if (e < 4096) {
    int v = e / 64, k = e % 64;
    for (int l = 0; l < 64; ++l) {
      int s = seq_of(d, 64 * j + l); float w = expf(bend - bc[l * 4] + ig[l * 4] - ml);
      acc += w * bf2f(p.Z[(size_t)row_of(b, s) * NZP + ZC_MLV + h * 64 + v]) * bf2f(p.MK[((size_t)b * TK + s) * 256 + h * 64 + k]);
    }
    p.MC[(size_t)u * 4096 + e] = acc;
  } else {
    int k = e - 4096;
    for (int l = 0; l < 64; ++l) {
      int s = seq_of(d, 64 * j + l); float w = expf(bend - bc[l * 4] + ig[l * 4] - ml);
      acc += w * bf2f(p.MK[((size_t)b * TK + s) * 256 + h * 64 + k]);
    }
    p.MN[(size_t)u * 64 + k] = acc;
  }
}
DI void nvb_ml_scan(long GI, const Params& p) {
  long i = GI; if (i >= (long)NB * 2 * 4 * 4160) return;
  int e = (int)(i % 4160); int ch = (int)(i / 4160); int h = ch % 4, bd = ch / 4;
  float st = 0.f, m = -1e30f;
  for (int j = 0; j < NCK; ++j) {
    size_t u = ((size_t)bd * NCK + j) * 4 + h;
    float ml = p.MM[u * 4 + 0], be = p.MM[u * 4 + 1];
    float mn = fmaxf(be + m, ml), a = expf(be + m - mn), g = expf(ml - mn);
    float* slot = e < 4096 ? &p.MC[u * 4096 + e] : &p.MN[u * 64 + (e - 4096)];
    float loc = *slot; *slot = st; st = a * st + g * loc;
    if (e == 0) p.MM[u * 4 + 2] = m;
    m = mn;
  }
}
DI void nvb_ml_out(long GI, const Params& p, int need_ctx) {
  long i = GI; if (i >= (long)NUNIT * 4096) return;
  int v = (int)(i % 64), l = (int)((i / 64) % 64); long u = i / 4096;
  int h = (int)(u % 4), j = (int)((u / 4) % NCK), d = (int)((u / (4 * NCK)) % 2), b = (int)(u / (8 * NCK));
  if (j < NCC && !need_ctx) return;
  const float* bc = p.BC + (((size_t)b * 2 + d) * TK + 64 * j) * 4 + h; const float* ig = p.IGS + (((size_t)b * 2 + d) * TK + 64 * j) * 4 + h;
  float m0 = p.MM[u * 4 + 2];
  int sl = seq_of(d, 64 * j + l);
  const bf16_t* q = p.MQ + ((size_t)b * TK + sl) * 256 + h * 64;
  float bl = bc[l * 4];
  float inter = bl + m0, mt = inter;
  for (int t = 0; t <= l; ++t) mt = fmaxf(mt, bl - bc[t * 4] + ig[t * 4]);
  float num = 0.f, den = 0.f;
  for (int t = 0; t <= l; ++t) {
    int st = seq_of(d, 64 * j + t);
    const bf16_t* k = p.MK + ((size_t)b * TK + st) * 256 + h * 64;
    float qk = 0.f; for (int c = 0; c < 64; ++c) qk += bf2f(q[c]) * bf2f(k[c]);
    float sv = expf(bl - bc[t * 4] + ig[t * 4] - mt) * qk;
    num += sv * bf2f(p.Z[(size_t)row_of(b, st) * NZP + ZC_MLV + h * 64 + v]); den += sv;
  }
  float ai = expf(inter - mt);
  float qc = 0.f, qn = 0.f;
  for (int c = 0; c < 64; ++c) { qc += bf2f(q[c]) * p.MC[(size_t)u * 4096 + v * 64 + c]; qn += bf2f(q[c]) * p.MN[(size_t)u * 64 + c]; }
  num += ai * qc; den += ai * qn;
  p.HD[(((size_t)d * NB + b) * TK + sl) * 256 + h * 64 + v] = num / fmaxf(fabsf(den), expf(-mt));
}
DI void nvb_ml_finish(long GI, const Params& p, int layer, int need_ctx) {
  long i = GI; if (i >= (long)R * 4) return;
  int h = (int)(i % 4), r = (int)(i / 4); int b, s; bs_of(r, b, s);
  if (s < TC && !need_ctx) return;
  const float* h0 = p.HD + (((size_t)0 * NB + b) * TK + s) * 256 + h * 64; const float* h1 = p.HD + (((size_t)1 * NB + b) * TK + s) * 256 + h * 64;
  float ss = 0.f; for (int v = 0; v < 64; ++v) { float t = h0[v] + h1[v]; ss += t * t; }
  float rstd = 1.0f / sqrtf(ss / 64 + 1e-6f);
  for (int v = 0; v < 64; ++v) {
    float o = bf2f(p.Z[(size_t)r * NZP + ZC_MLO + h * 64 + v]);
    p.Y[(size_t)r * D + 256 + h * 64 + v] = f2bf(sigmoidf_(o) * (h0[v] + h1[v]) * rstd * p.g_mlstm_out[layer * 256 + h * 64 + v]);
  }
}
DI void nvb_gla_local(long GI, const Params& p) {
  long i = GI; if (i >= (long)NUNIT * 2048) return;
  int v = (int)(i % 64), k = (int)((i / 64) % 32); long u = i / 2048;
  int h = (int)(u % 4), j = (int)((u / 4) % NCK), d = (int)((u / (4 * NCK)) % 2), b = (int)(u / (8 * NCK));
  const float* gc = p.GC + (((size_t)b * 2 + d) * TK + 64 * j) * 128 + h * 32 + k;
  float ge = gc[63 * 128], acc = 0.f;
  for (int l = 0; l < 64; ++l) {
    int s = seq_of(d, 64 * j + l); const bf16_t* z = p.Z + (size_t)row_of(b, s) * NZP;
    acc += bf2f(z[ZC_GK + h * 32 + k]) * expf(ge - gc[l * 128]) * bf2f(z[ZC_GV + h * 64 + v]);
  }
  p.GS[(size_t)u * 2048 + v * 32 + k] = acc;
}
DI void nvb_gla_scan(long GI, const Params& p) {
  long i = GI; if (i >= (long)NB * 2 * 4 * 2048) return;
  int e = (int)(i % 2048); int ch = (int)(i / 2048); int h = ch % 4, bd = ch / 4; int k = e % 32;
  float st = 0.f;
  for (int j = 0; j < NCK; ++j) {
    size_t u = ((size_t)bd * NCK + j) * 4 + h;
    float ge = p.GC[((size_t)bd * TK + 64 * j + 63) * 128 + h * 32 + k];
    float loc = p.GS[u * 2048 + e]; p.GS[u * 2048 + e] = st; st = expf(ge) * st + loc;
  }
}
DI void nvb_gla_out(long GI, const Params& p, int need_ctx) {
  long i = GI; if (i >= (long)NUNIT * 4096) return;
  int v = (int)(i % 64), l = (int)((i / 64) % 64); long u = i / 4096;
  int h = (int)(u % 4), j = (int)((u / 4) % NCK), d = (int)((u / (4 * NCK)) % 2), b = (int)(u / (8 * NCK));
  if (j < NCC && !need_ctx) return;
  const float* gc = p.GC + (((size_t)b * 2 + d) * TK + 64 * j) * 128 + h * 32;
  int sl = seq_of(d, 64 * j + l);
  const bf16_t* q = p.Z + (size_t)row_of(b, sl) * NZP + ZC_GQ + h * 32;
  const float qs = 0.17677669529663687f;
  float acc = 0.f;
  for (int t = 0; t <= l; ++t) {
    int st = seq_of(d, 64 * j + t); const bf16_t* z = p.Z + (size_t)row_of(b, st) * NZP;
    float att = 0.f; for (int k = 0; k < 32; ++k) att += bf2f(q[k]) * qs * expf(gc[l * 128 + k] - gc[t * 128 + k]) * bf2f(z[ZC_GK + h * 32 + k]);
    acc += att * bf2f(z[ZC_GV + h * 64 + v]);
  }
  for (int k = 0; k < 32; ++k) acc += bf2f(q[k]) * qs * expf(gc[l * 128 + k]) * p.GS[(size_t)u * 2048 + v * 32 + k];
  p.OD[(((size_t)d * NB + b) * TK + sl) * 256 + h * 64 + v] = acc;
}
DI void nvb_gla_finish(long GI, const Params& p, int layer, int need_ctx) {
  long i = GI; if (i >= (long)R * 4) return;
  int h = (int)(i % 4), r = (int)(i / 4); int b, s; bs_of(r, b, s);
  if (s < TC && !need_ctx) return;
  const float* h0 = p.OD + (((size_t)0 * NB + b) * TK + s) * 256 + h * 64; const float* h1 = p.OD + (((size_t)1 * NB + b) * TK + s) * 256 + h * 64;
  float ss = 0.f; for (int v = 0; v < 64; ++v) { float t = h0[v] + h1[v]; ss += t * t; }
  float rstd = 1.0f / sqrtf(ss / 64 + 1e-6f);
  for (int v = 0; v < 64; ++v) {
    float rr = bf2f(p.Z[(size_t)r * NZP + ZC_GR + h * 64 + v]);
    p.Y[(size_t)r * D + 512 + h * 64 + v] = f2bf(siluf_(rr) * (h0[v] + h1[v]) * rstd * p.g_gla_out[layer * 256 + h * 64 + v]);
  }
}
__global__ void __launch_bounds__(256) nv_merge(Params p, int layer, int nrows) {
  long i = GTID; if (i >= (long)nrows * D) return;
  int j = (int)(i % D), r = (int)(i / D);
  float acc = 0.f;
  for (int n = 0; n < 4; ++n) {
    const bf16_t* wg = p.Wt_gate + (size_t)(n * 1024 + j) * D; const bf16_t* wb = p.Wt_branch + ((size_t)n * D + j) * 256;
    float g = p.b_gate[layer * 4096 + n * 1024 + j], pr = 0.f;
    for (int k = 0; k < D; ++k) g += bf2f(p.H[(size_t)r * D + k]) * bf2f(wg[k]);
    for (int k = 0; k < 256; ++k) pr += bf2f(p.Y[(size_t)r * D + n * 256 + k]) * bf2f(wb[k]);
    acc += sigmoidf_(g) * pr;
  }
  p.MG[(size_t)r * D + j] = f2bf(acc);
}
__global__ void __launch_bounds__(256) nv_resid_mix(Params p, int layer, const float* xl_in, const float* xc_in, int nrows) {
  long r = GTID; if (r >= nrows) return;
  int w = r < RL ? (int)(r / TL) : 2;
  const float* mb = p.mods + (size_t)(layer * 3 + w) * 6144;
  const float* xin = r < RL ? xl_in + (size_t)r * D : xc_in + (size_t)(r - RL) * D;
  float* xo = r < RL ? p.out + (size_t)r * D : p.xc + (size_t)(r - RL) * D;
  const bf16_t* yo = p.YO + (size_t)r * D;
  float ss = 0.f; for (int k = 0; k < D; ++k) { float v = bf2f(yo[k]); ss += v * v; }
  float rstd = 1.0f / sqrtf(ss / D + 1e-6f);
  float s2 = 0.f;
  for (int k = 0; k < D; ++k) { float xn = xin[k] + mb[2 * 1024 + k] * bf2f(yo[k]) * rstd * p.g_mix_post[layer * 1024 + k]; xo[k] = xn; s2 += xn * xn; }
  float rstd2 = 1.0f / sqrtf(s2 / D + 1e-6f);
  float lg[16]; _Pragma("unroll") for (int e = 0; e < 16; ++e) lg[e] = 0.f;
  const float* wr = p.w_router + (size_t)layer * D * 16;
  for (int k = 0; k < D; ++k) {
    float h2 = xo[k] * rstd2 * p.g_ffn_pre[layer * 1024 + k] * (1.f + mb[4 * 1024 + k]) + mb[3 * 1024 + k];
    p.H[(size_t)r * D + k] = f2bf(h2);
    _Pragma("unroll") for (int e = 0; e < 16; ++e) lg[e] += h2 * wr[k * 16 + e];
  }
  float mx = lg[0]; _Pragma("unroll") for (int e = 1; e < 16; ++e) mx = fmaxf(mx, lg[e]);
  float sm = 0.f; _Pragma("unroll") for (int e = 0; e < 16; ++e) { lg[e] = expf(lg[e] - mx); sm += lg[e]; }
  int b, s; bs_of((int)r, b, s);
  _Pragma("unroll") for (int e = 0; e < 16; ++e) p.AFF[((size_t)b * NE + e) * TK + s] = lg[e] / sm;
}
__global__ void __launch_bounds__(256) nv_topk(Params p, int need_ctx) {
  long i = GTID; if (i >= NB * NE * 2) return;
  int seg = (int)(i % 2), e = (int)((i / 2) % NE), b = (int)(i / (2 * NE));
  int s0 = seg ? TC : 0, n = seg ? TL : TC, cap = seg ? CAPL : CAPC, slot0 = seg ? b * CAPL : NB * CAPL + b * CAPC;
  if (seg == 0 && !need_ctx) { for (int q = 0; q < cap; ++q) p.SEL[(size_t)e * NSLOT + slot0 + q] = -1; return; }
  const float* a = p.AFF + ((size_t)b * NE + e) * TK + s0;
  unsigned thr = 0;
  for (int bit = 31; bit >= 0; --bit) {
    unsigned cand = thr | (1u << bit); int cnt = 0;
    for (int t = 0; t < n; ++t) cnt += (f2u(a[t]) >= cand);
    if (cnt >= cap) thr = cand;
  }
  int ngt = 0; for (int t = 0; t < n; ++t) ngt += (f2u(a[t]) > thr);
  int neq = cap - ngt, q = 0;
  for (int t = 0; t < n; ++t) {
    unsigned u = f2u(a[t]); int r = row_of(b, s0 + t); int sel = -1;
    if (u > thr) sel = q++; else if (u == thr && neq > 0) { sel = q++; --neq; }
    if (sel >= 0) { p.SEL[(size_t)e * NSLOT + slot0 + sel] = r; p.SELV[(size_t)e * NSLOT + slot0 + sel] = a[t]; }
    p.INV[(size_t)r * NE + e] = sel >= 0 ? slot0 + sel : -1;
  }
}
__global__ void __launch_bounds__(256) nv_moe1(Params p) {
  long i = GTID; if (i >= (long)NE * NSLOT * FF) return;
  int f = (int)(i % FF), slot = (int)((i / FF) % NSLOT), e = (int)(i / ((long)FF * NSLOT));
  int r = p.SEL[(size_t)e * NSLOT + slot];
  float out = 0.f;
  if (r >= 0) {
    const bf16_t* wg = p.Wt_eg + ((size_t)e * FF + f) * D; const bf16_t* wu = p.Wt_eu + ((size_t)e * FF + f) * D; const bf16_t* h = p.H + (size_t)r * D;
    float g = 0.f, u = 0.f; for (int k = 0; k < D; ++k) { float hv = bf2f(h[k]); g += hv * bf2f(wg[k]); u += hv * bf2f(wu[k]); }
    out = siluf_(g) * u;
  }
  p.HID[((size_t)e * NSLOT + slot) * FF + f] = f2bf(out);
}
__global__ void __launch_bounds__(256) nv_moe2(Params p) {
  long i = GTID; if (i >= (long)NE * NSLOT * D) return;
  int j = (int)(i % D), slot = (int)((i / D) % NSLOT), e = (int)(i / ((long)D * NSLOT));
  int r = p.SEL[(size_t)e * NSLOT + slot];
  float out = 0.f;
  if (r >= 0) {
    const bf16_t* wd = p.Wt_ed + ((size_t)e * D + j) * FF; const bf16_t* h = p.HID + ((size_t)e * NSLOT + slot) * FF;
    float a = 0.f; for (int k = 0; k < FF; ++k) a += bf2f(h[k]) * bf2f(wd[k]);
    out = a * p.SELV[(size_t)e * NSLOT + slot];
  }
  p.YE[((size_t)e * NSLOT + slot) * D + j] = f2bf(out);
}
__global__ void __launch_bounds__(256) nv_resid_ffn(Params p, int layer, int nrows) {
  long r = GTID; if (r >= nrows) return;
  int w = r < RL ? (int)(r / TL) : 2;
  const float* mb = p.mods + (size_t)(layer * 3 + w) * 6144;
  float* xo = r < RL ? p.out + (size_t)r * D : p.xc + (size_t)(r - RL) * D;
  float ss = 0.f;
  for (int k = 0; k < D; ++k) {
    float f = 0.f;
    for (int e = 0; e < NE; ++e) { int sl = p.INV[(size_t)r * NE + e]; if (sl >= 0) f += bf2f(p.YE[((size_t)e * NSLOT + sl) * D + k]); }
    ss += f * f;
  }
  float rstd = 1.0f / sqrtf(ss / D + 1e-6f);
  for (int k = 0; k < D; ++k) {
    float f = 0.f;
    for (int e = 0; e < NE; ++e) { int sl = p.INV[(size_t)r * NE + e]; if (sl >= 0) f += bf2f(p.YE[((size_t)e * NSLOT + sl) * D + k]); }
    xo[k] += mb[5 * 1024 + k] * f * rstd * p.g_ffn_post[layer * 1024 + k];
  }
}

__global__ void __launch_bounds__(256) nv_mods(Params p) { nvb_mods(GTID, p); }
__global__ void __launch_bounds__(256) nv_ml_gates(Params p, int layer) { nvb_ml_gates(GTID, p, layer); }
__global__ void __launch_bounds__(256) nv_gla_cum(Params p, int layer) { nvb_gla_cum(GTID, p, layer); }
__global__ void __launch_bounds__(256) nv_ml_local(Params p) { nvb_ml_local(GTID, p); }
__global__ void __launch_bounds__(256) nv_ml_scan(Params p) { nvb_ml_scan(GTID, p); }
__global__ void __launch_bounds__(256) nv_ml_out(Params p, int need_ctx) { nvb_ml_out(GTID, p, need_ctx); }
__global__ void __launch_bounds__(256) nv_ml_finish(Params p, int layer, int need_ctx) { nvb_ml_finish(GTID, p, layer, need_ctx); }
__global__ void __launch_bounds__(256) nv_gla_local(Params p) { nvb_gla_local(GTID, p); }
__global__ void __launch_bounds__(256) nv_gla_scan(Params p) { nvb_gla_scan(GTID, p); }
__global__ void __launch_bounds__(256) nv_gla_out(Params p, int need_ctx) { nvb_gla_out(GTID, p, need_ctx); }
__global__ void __launch_bounds__(256) nv_gla_finish(Params p, int layer, int need_ctx) { nvb_gla_finish(GTID, p, layer, need_ctx); }
constexpr int LROW = 144;
constexpr int A_BYTES = 128 * LROW;
constexpr int NTHR = 256;
#ifndef ATT_THR
#define ATT_THR 16.0f
#endif

DI int xcd_swz(int u, int nt) { return (nt & 7) ? u : (u & 7) * (nt >> 3) + (u >> 3); }
template <int GW> DI void grp_tile(int L, int ntm, int ntn, int& tm, int& tn) {
  const int gsz = ntm * GW; int g = 0;
  while (L >= gsz) { L -= gsz; ++g; }
  tm = L / GW; tn = g * GW + (L & (GW - 1)); (void)ntn;
}
DI u32x4 ldg16(const void* p) { return *(const u32x4*)p; }
DI void sts16(char* p, u32x4 v) { *(u32x4*)p = v; }
DI bf16x8 lds_frag(const char* p) { return *(const bf16x8*)p; }

template <int WN>
DI void gemm_kloop(f32x4 (&acc)[4][WN], const bf16_t* const (&ap)[4], const bf16_t* const (&bp)[WN], int nk, char* lds) {
  constexpr int STAGE = A_BYTES + 32 * WN * LROW;
  const int t = TIDX, lane = t & 63, wid = t >> 6, wr = wid >> 1, wc = wid & 1;
  const int lr = t >> 3, lcb = (t & 7) * 16;
  const int fr = lane & 15, fq = lane >> 4;
  const int aoff = (wr * 64 + fr) * LROW + fq * 16, boff = A_BYTES + (wc * WN * 16 + fr) * LROW + fq * 16, soff = lr * LROW + lcb;
  u32x4 ra0[4], rb0[WN], ra1[4], rb1[WN];
  auto gload = [&](u32x4 (&ra)[4], u32x4 (&rb)[WN], int kt) {
#pragma unroll
    for (int i = 0; i < 4; ++i) ra[i] = ldg16(ap[i] + kt * 64);
#pragma unroll
    for (int i = 0; i < WN; ++i) rb[i] = ldg16(bp[i] + kt * 64);
  };
  auto sstore = [&](const u32x4 (&ra)[4], const u32x4 (&rb)[WN], char* st) {
#pragma unroll
    for (int i = 0; i < 4; ++i) sts16(st + soff + 32 * i * LROW, ra[i]);
#pragma unroll
    for (int i = 0; i < WN; ++i) sts16(st + A_BYTES + soff + 32 * i * LROW, rb[i]);
  };
  auto compute = [&](const char* cur) {
#pragma unroll
    for (int ks = 0; ks < 2; ++ks) {
      bf16x8 af[4], bfr[WN];
#pragma unroll
      for (int m = 0; m < 4; ++m) af[m] = lds_frag(cur + aoff + m * 16 * LROW + ks * 64);
#pragma unroll
      for (int n = 0; n < WN; ++n) bfr[n] = lds_frag(cur + boff + n * 16 * LROW + ks * 64);
#pragma unroll
      for (int m = 0; m < 4; ++m)
#pragma unroll
        for (int n = 0; n < WN; ++n) acc[m][n] = MFMA16(bfr[n], af[m], acc[m][n]);
    }
    IGLP_OPT();
  };
  gload(ra0, rb0, 0);
  gload(ra1, rb1, 1);
  sstore(ra0, rb0, lds);
  __syncthreads();
#pragma unroll 1
  for (int kt = 0; kt < nk; kt += 2) {
    if (kt + 2 < nk) gload(ra0, rb0, kt + 2);
    compute(lds);
    sstore(ra1, rb1, lds + STAGE);
    __syncthreads();
    if (kt + 3 < nk) gload(ra1, rb1, kt + 3);
    compute(lds + STAGE);
    if (kt + 2 < nk) sstore(ra0, rb0, lds);
    __syncthreads();
  }
}
template <int WN> DI void acc_zero(f32x4 (&acc)[4][WN]) {
#pragma unroll
  for (int m = 0; m < 4; ++m)
#pragma unroll
    for (int n = 0; n < WN; ++n) acc[m][n] = (f32x4){0.f, 0.f, 0.f, 0.f};
}
DI void st_bf16x4(bf16_t* p, f32x4 v) { u32x2 o; o.x = pack2bf(v.x, v.y); o.y = pack2bf(v.z, v.w); *(u32x2*)p = o; }

template <int WN, class RowOk>
DI void store_wave_tile(const f32x4 (&acc)[4][WN], bf16_t* C, size_t ldc, char* ldsw, int lane, RowOk row_ok) {
  constexpr int PITCH = WN * 32 + 16, CPR = WN * 2;
  const int fr = lane & 15, fq = lane >> 4;
#pragma unroll
  for (int m = 0; m < 4; ++m)
#pragma unroll
    for (int n = 0; n < WN; ++n) { u32x2 o; o.x = pack2bf(acc[m][n][0], acc[m][n][1]); o.y = pack2bf(acc[m][n][2], acc[m][n][3]); *(u32x2*)(ldsw + (m * 16 + fr) * PITCH + n * 32 + fq * 8) = o; }
  WAVE_SYNC();
  constexpr int RPP = 64 / CPR;
#pragma unroll
  for (int ps = 0; ps < 64 / RPP; ++ps) {
    const int r = ps * RPP + lane / CPR, c = lane % CPR;
    const u32x4 v = *(const u32x4*)(ldsw + r * PITCH + c * 16);
    if (row_ok(r)) *(u32x4*)(C + (size_t)r * ldc + c * 8) = v;
  }
  WAVE_SYNC();
}
template <int NOSTORE = 0>
DI void gemm_plain_tile(const bf16_t* A, int lda, const bf16_t* Bt, int ldb, int K, bf16_t* C, int ldc, int tm, int tn, char* lds) {
  const int t = TIDX, lane = t & 63, wid = t >> 6, wr = wid >> 1, wc = wid & 1, lr = t >> 3, lc = (t & 7) * 8, fr = lane & 15, fq = lane >> 4;
  const bf16_t* ap[4]; const bf16_t* bp[4];
#pragma unroll
  for (int i = 0; i < 4; ++i) { ap[i] = A + (size_t)(tm * 128 + lr + 32 * i) * lda + lc; bp[i] = Bt + (size_t)(tn * 128 + lr + 32 * i) * ldb + lc; }
  f32x4 acc[4][4]; acc_zero<4>(acc);
  gemm_kloop<4>(acc, ap, bp, K / 64, lds);
  if (NOSTORE) { float s = 0.f;
#pragma unroll
    for (int m = 0; m < 4; ++m)
#pragma unroll
      for (int n = 0; n < 4; ++n) s += acc[m][n][0] + acc[m][n][3];
    if (s == 123456.789f) C[0] = 1; return; }
  store_wave_tile<4>(acc, C + (size_t)(tm * 128 + wr * 64) * ldc + tn * 128 + wc * 64, (size_t)ldc, lds + wid * (64 * 144), lane, [](int) { return true; });
  __syncthreads();
}
template <int NOSTORE = 0>
DI void ph_gemm_plain(const bf16_t* A, int lda, const bf16_t* Bt, int ldb, int M, int N, int K, bf16_t* C, int ldc, char* lds, int bid, int nblk) {
  const int ntn = N / 128, nt = (M / 128) * ntn;
  for (int u = bid; u < nt; u += nblk) { int tm, tn; grp_tile<8>(xcd_swz(u, nt), M / 128, ntn, tm, tn); gemm_plain_tile<NOSTORE>(A, lda, Bt, ldb, K, C, ldc, tm, tn, lds); }
}
DI void ph_mla_up(const Params& p, int layer, bf16_t* QRAW, bf16_t* KVRAW, char* lds, int bid, int nblk) {
  const int ntq = (R / 128) * 3, ntkv = (R / 128) * 4;
  for (int tile = bid; tile < ntq + ntkv; tile += nblk) {
    if (tile < ntq) gemm_plain_tile(p.Z + ZC_QLAT, NZP, p.Wt_uq + layer * WSZ_UQ, 256, 256, QRAW, 384, tile / 3, tile % 3, lds);
    else { int u = tile - ntq; gemm_plain_tile(p.Z + ZC_KVLAT, NZP, p.Wt_ukv + layer * WSZ_UKV, 128, 128, KVRAW, 512, u / 4, u % 4, lds); }
  }
}
constexpr int LROW32 = 80;
template <int WM, int WN, bool DEEP>
DI void gemm_kloop_g(f32x4 (&acc)[WM][WN], const bf16_t* const (&ap)[WM / 2], const bf16_t* const (&bp)[WN / 2], int nk, char* lds) {
  constexpr int NA = WM / 2, NBB = WN / 2, A_B = 32 * WM * LROW32, STAGE = (32 * WM + 32 * WN) * LROW32;
  const int t = TIDX, lane = t & 63, wid = t >> 6, wr = wid >> 1, wc = wid & 1, fr = lane & 15, fq = lane >> 4;
  const int aoff = (wr * 16 * WM + fr) * LROW32 + fq * 16, boff = A_B + (wc * 16 * WN + fr) * LROW32 + fq * 16, soff = (t >> 2) * LROW32 + (t & 3) * 16;
  u32x4 ra0[NA], rb0[NBB], ra1[NA], rb1[NBB];
  auto gload = [&](u32x4 (&ra)[NA], u32x4 (&rb)[NBB], int kt) {
#pragma unroll
    for (int i = 0; i < NA; ++i) ra[i] = ldg16(ap[i] + kt * 32);
#pragma unroll
    for (int i = 0; i < NBB; ++i) rb[i] = ldg16(bp[i] + kt * 32);
  };
  auto sstore = [&](const u32x4 (&ra)[NA], const u32x4 (&rb)[NBB], char* st) {
#pragma unroll
    for (int i = 0; i < NA; ++i) sts16(st + soff + 64 * i * LROW32, ra[i]);
#pragma unroll
    for (int i = 0; i < NBB; ++i) sts16(st + A_B + soff + 64 * i * LROW32, rb[i]);
  };
  auto compute = [&](const char* cur) {
    bf16x8 af[WM];
#pragma unroll
    for (int m = 0; m < WM; ++m) af[m] = lds_frag(cur + aoff + m * 16 * LROW32);
#pragma unroll
    for (int n = 0; n < WN; ++n) {
      const bf16x8 bfr = lds_frag(cur + boff + n * 16 * LROW32);
#pragma unroll
      for (int m = 0; m < WM; ++m) acc[m][n] = MFMA16(bfr, af[m], acc[m][n]);
    }
    IGLP_OPT();
  };
  gload(ra0, rb0, 0);
  if (DEEP) gload(ra1, rb1, 1);
  sstore(ra0, rb0, lds);
  __syncthreads();
#pragma unroll 1
  for (int kt = 0; kt < nk; kt += 2) {
    if (DEEP) { if (kt + 2 < nk) gload(ra0, rb0, kt + 2); } else gload(ra1, rb1, kt + 1);
    compute(lds);
    sstore(ra1, rb1, lds + STAGE);
    __syncthreads();
    if (DEEP) { if (kt + 3 < nk) gload(ra1, rb1, kt + 3); } else if (kt + 2 < nk) gload(ra0, rb0, kt + 2);
    compute(lds + STAGE);
    if (kt + 2 < nk) sstore(ra0, rb0, lds);
    __syncthreads();
  }
}
template <int WM, int WN> DI void acc_zero_g(f32x4 (&acc)[WM][WN]) {
#pragma unroll
  for (int m = 0; m < WM; ++m)
#pragma unroll
    for (int n = 0; n < WN; ++n) acc[m][n] = (f32x4){0.f, 0.f, 0.f, 0.f};
}
DI void ph_merge(const Params& p, int layer, int rows, char* lds, int bid, int nblk) {
  const int t = TIDX, lane = t & 63, wid = t >> 6, wr = wid >> 1, wc = wid & 1, fr = lane & 15, fq = lane >> 4;
  const int lr = t >> 2, lc = (t & 3) * 8;
  const int ntn = D / 64, nt = (rows / 128) * ntn;
#pragma unroll 1
  for (int u = bid; u < nt; u += nblk) {
    int tm, tn; grp_tile<4>(xcd_swz(u, nt), rows / 128, ntn, tm, tn);
    f32x4 accS[4][2]; acc_zero_g<4, 2>(accS);
#pragma unroll 1
    for (int np = 0; np < 2; ++np) {
      f32x4 accG[4][4]; acc_zero_g<4, 4>(accG);
      {
        const bf16_t* ap[2]; const bf16_t* bp[2];
#pragma unroll
        for (int i = 0; i < 2; ++i) ap[i] = p.H + (size_t)(tm * 128 + lr + 64 * i) * D + lc;
#pragma unroll
        for (int i = 0; i < 2; ++i) { const int rho = lr + 64 * i, wci = rho >> 6, n = 2 * np + ((rho >> 5) & 1), c = rho & 31;
          bp[i] = p.Wt_gate + layer * WSZ_GATE + ((size_t)n * 1024 + tn * 64 + wci * 32 + c) * D + lc; }
        gemm_kloop_g<4, 4, true>(accG, ap, bp, D / 32, lds);
      }
#pragma unroll 1
      for (int q = 0; q < 2; ++q) {
        const int n = 2 * np + q;
        f32x4 accP[4][2]; acc_zero_g<4, 2>(accP);
        const bf16_t* ap[2]; const bf16_t* bp[1];
#pragma unroll
        for (int i = 0; i < 2; ++i) ap[i] = p.Y + (size_t)(tm * 128 + lr + 64 * i) * D + n * 256 + lc;
        bp[0] = p.Wt_branch + layer * WSZ_BR + ((size_t)n * D + tn * 64 + lr) * 256 + lc;
        gemm_kloop_g<4, 2, false>(accP, ap, bp, 8, lds);
#pragma unroll
        for (int nn = 0; nn < 2; ++nn) {
          const f32x4 bv = *(const f32x4*)(p.b_gate + layer * 4096 + n * 1024 + tn * 64 + wc * 32 + nn * 16 + 4 * fq);
#pragma unroll
          for (int m = 0; m < 4; ++m)
#pragma unroll
            for (int j = 0; j < 4; ++j) { const float g = q ? accG[m][2 + nn][j] : accG[m][nn][j]; accS[m][nn][j] += accP[m][nn][j] * fast_rcp(1.0f + fast_exp2(-LOG2E * (g + bv[j]))); }
        }
      }
    }
    store_wave_tile<2>(accS, p.MG + (size_t)(tm * 128 + wr * 64) * D + tn * 64 + wc * 32, (size_t)D, lds + wid * (64 * 80), lane, [](int) { return true; });
    __syncthreads();
  }
}
template <int WM>
DI void gemm_plain_tile_g(const bf16_t* A, int lda, const bf16_t* Bt, int ldb, int K, bf16_t* C, int ldc, int row0, int col0, char* lds) {
  const int t = TIDX, lane = t & 63, wid = t >> 6, wr = wid >> 1, wc = wid & 1, fr = lane & 15, fq = lane >> 4, lr = t >> 2, lc = (t & 3) * 8;
  const bf16_t* ap[WM / 2]; const bf16_t* bp[2];
#pragma unroll
  for (int i = 0; i < WM / 2; ++i) ap[i] = A + (size_t)(row0 + lr + 64 * i) * lda + lc;
#pragma unroll
  for (int i = 0; i < 2; ++i) bp[i] = Bt + (size_t)(col0 + lr + 64 * i) * ldb + lc;
  f32x4 acc[WM][4]; acc_zero_g<WM, 4>(acc);
  gemm_kloop_g<WM, 4, true>(acc, ap, bp, K / 32, lds);
#pragma unroll
  for (int m = 0; m < WM; ++m)
#pragma unroll
    for (int n = 0; n < 4; ++n)
      st_bf16x4(C + (size_t)(row0 + wr * 16 * WM + m * 16 + fr) * ldc + col0 + wc * 64 + n * 16 + 4 * fq, acc[m][n]);
}
DI void ph_gemm_plain2(const bf16_t* A, int lda, const bf16_t* Bt, int ldb, int M, int N, int K, bf16_t* C, int ldc, char* lds, int bid, int nblk) {
  const int ntn = N / 128, nt = (M / 256) * ntn, nfull = (nt / nblk) * nblk;
#pragma unroll 1
  for (int tile = bid; tile < nfull; tile += nblk) gemm_plain_tile_g<8>(A, lda, Bt, ldb, K, C, ldc, (tile / ntn) * 256, (tile % ntn) * 128, lds);
#pragma unroll 1
  for (int h = bid; h < 2 * (nt - nfull); h += nblk) { const int tile = nfull + (h >> 1); gemm_plain_tile_g<4>(A, lda, Bt, ldb, K, C, ldc, (tile / ntn) * 256 + (h & 1) * 128, (tile % ntn) * 128, lds); }
}
DI void gemm_kloop32(f32x16 (&acc)[2][2], const bf16_t* const (&ap)[4], const bf16_t* const (&bp)[4], int nk, char* lds) {
  constexpr int STAGE = A_BYTES + 128 * LROW;
  const int t = TIDX, lane = t & 63, wid = t >> 6, wr = wid >> 1, wc = wid & 1, l31 = lane & 31, hh = lane >> 5;
  const int aoff = (wr * 64 + l31) * LROW + hh * 16, boff = A_BYTES + (wc * 64 + l31) * LROW + hh * 16, soff = (t >> 3) * LROW + (t & 7) * 16;
  u32x4 ra0[4], rb0[4], ra1[4], rb1[4];
  auto gload = [&](u32x4 (&ra)[4], u32x4 (&rb)[4], int kt) {
#pragma unroll
    for (int i = 0; i < 4; ++i) { ra[i] = ldg16(ap[i] + kt * 64); rb[i] = ldg16(bp[i] + kt * 64); }
  };
  auto sstore = [&](const u32x4 (&ra)[4], const u32x4 (&rb)[4], char* st) {
#pragma unroll
    for (int i = 0; i < 4; ++i) { sts16(st + soff + 32 * i * LROW, ra[i]); sts16(st + A_BYTES + soff + 32 * i * LROW, rb[i]); }
  };
  auto compute = [&](const char* cur) {
#pragma unroll
    for (int ks = 0; ks < 4; ++ks) {
      bf16x8 af[2], bfr[2];
#pragma unroll
      for (int m = 0; m < 2; ++m) af[m] = lds_frag(cur + aoff + m * 32 * LROW + ks * 32);
#pragma unroll
      for (int n = 0; n < 2; ++n) bfr[n] = lds_frag(cur + boff + n * 32 * LROW + ks * 32);
#pragma unroll
      for (int m = 0; m < 2; ++m)
#pragma unroll
        for (int n = 0; n < 2; ++n) acc[m][n] = MFMA32(bfr[n], af[m], acc[m][n]);
    }
  };
  gload(ra0, rb0, 0); gload(ra1, rb1, 1);
  sstore(ra0, rb0, lds);
  __syncthreads();
#pragma unroll 1
  for (int kt = 0; kt < nk; kt += 2) {
    if (kt + 2 < nk) gload(ra0, rb0, kt + 2);
    compute(lds);
    sstore(ra1, rb1, lds + STAGE);
    __syncthreads();
    if (kt + 3 < nk) gload(ra1, rb1, kt + 3);
    compute(lds + STAGE);
    if (kt + 2 < nk) sstore(ra0, rb0, lds);
    __syncthreads();
  }
}
DI void ph_gemm_plain32(const bf16_t* A, int lda, const bf16_t* Bt, int ldb, int M, int N, int K, bf16_t* C, int ldc, char* lds, int bid, int nblk) {
  const int t = TIDX, lane = t & 63, wid = t >> 6, wr = wid >> 1, wc = wid & 1, lr = t >> 3, lc = (t & 7) * 8, l31 = lane & 31, hh = lane >> 5;
  const int ntn = N / 128, nt = (M / 128) * ntn;
#pragma unroll 1
  for (int tile = bid; tile < nt; tile += nblk) {
    const int tm = tile / ntn, tn = tile % ntn;
    const bf16_t* ap[4]; const bf16_t* bp[4];
#pragma unroll
    for (int i = 0; i < 4; ++i) { ap[i] = A + (size_t)(tm * 128 + lr + 32 * i) * lda + lc; bp[i] = Bt + (size_t)(tn * 128 + lr + 32 * i) * ldb + lc; }
    f32x16 acc[2][2];
#pragma unroll
    for (int m = 0; m < 2; ++m)
#pragma unroll
      for (int n = 0; n < 2; ++n) acc[m][n] = (f32x16)(0.f);
    gemm_kloop32(acc, ap, bp, K / 64, lds);
#pragma unroll
    for (int m = 0; m < 2; ++m)
#pragma unroll
      for (int n = 0; n < 2; ++n)
#pragma unroll
        for (int g = 0; g < 4; ++g) {
          f32x4 o = {acc[m][n][4 * g], acc[m][n][4 * g + 1], acc[m][n][4 * g + 2], acc[m][n][4 * g + 3]};
          st_bf16x4(C + (size_t)(tm * 128 + wr * 64 + m * 32 + l31) * ldc + tn * 128 + wc * 64 + n * 32 + 8 * g + 4 * hh, o);
        }
  }
}
template <int MODE>
DI void ph_gemm_probe(const bf16_t* A, int lda, const bf16_t* Bt, int ldb, int M, int N, int K, float* sink, char* lds, int bid, int nblk) {
  const int t = TIDX, lane = t & 63, wid = t >> 6, wr = wid >> 1, wc = wid & 1, lr = t >> 3, lc = (t & 7) * 8, fr = lane & 15, fq = lane >> 4;
  const int ntn = N / 128, nt = (M / 128) * ntn, nk = K / 64;
  constexpr int STAGE = A_BYTES + 128 * LROW;
  const int aoff = (wr * 64 + fr) * LROW + fq * 16, boff = A_BYTES + (wc * 64 + fr) * LROW + fq * 16;
#pragma unroll 1
  for (int tile = bid; tile < nt; tile += nblk) {
    f32x4 acc[4][4]; acc_zero<4>(acc);
    bf16x8 af[4], bfr[4];
    const int tm = tile / ntn, tn = tile % ntn;
    const bf16_t* ap[4]; const bf16_t* bp[4];
#pragma unroll
    for (int i = 0; i < 4; ++i) { ap[i] = A + (size_t)(tm * 128 + lr + 32 * i) * lda + lc; bp[i] = Bt + (size_t)(tn * 128 + lr + 32 * i) * ldb + lc; }
    u32x4 ra[4], rb[4], junk = {0u, 0u, 0u, 0u};
#pragma unroll
    for (int i = 0; i < 4; ++i) { ra[i] = junk; rb[i] = junk; }
#pragma unroll 1
    for (int kt = 0; kt < nk; ++kt) {
      const char* cur = lds + (kt & 1) * STAGE;
#pragma unroll
      for (int i = 0; i < 4; ++i) { ra[i] = ldg16(ap[i] + kt * 64); if (MODE == 3) rb[i] = ldg16(bp[i] + kt * 64); }
#pragma unroll
      for (int ks = 0; ks < 2; ++ks) {
#pragma unroll
        for (int m = 0; m < 4; ++m) { af[m] = lds_frag(cur + aoff + m * 16 * LROW + ks * 64); bfr[m] = lds_frag(cur + boff + m * 16 * LROW + ks * 64); }
#pragma unroll
        for (int m = 0; m < 4; ++m)
#pragma unroll
          for (int n = 0; n < 4; ++n) acc[m][n] = MFMA16(bfr[n], af[m], acc[m][n]);
      }
      junk.x ^= ra[0].x ^ ra[1].y ^ ra[2].z ^ ra[3].w ^ rb[0].x ^ rb[1].y ^ rb[2].z ^ rb[3].w;
      __syncthreads();
    }
    float s = (float)(junk.x & 1u);
#pragma unroll
    for (int m = 0; m < 4; ++m)
#pragma unroll
      for (int n = 0; n < 4; ++n) s += acc[m][n][0] + acc[m][n][3];
    if (s == 123456.789f) sink[0] = s;
  }
}
DI void ph_moe1(const Params& p, int need_ctx, char* lds, int bid, int nblk) {
  const int t = TIDX, lane = t & 63, wid = t >> 6, wr = wid >> 1, wc = wid & 1, lr = t >> 3, lc = (t & 7) * 8, fr = lane & 15, fq = lane >> 4;
  constexpr int NTN = FF / 64;
  const int NTM = need_ctx ? (NSLOT + 127) / 128 : (NB * CAPL) / 128;
  for (int u = bid; u < NE * NTM * NTN; u += nblk) {
    const int tile = xcd_swz(u, NE * NTM * NTN), e = tile / (NTM * NTN), rem = tile % (NTM * NTN);
    int tm, tn, rr = rem, g = 0;
    if (rr >= NTM * 8) { rr -= NTM * 8; g = 1; }
    if (rr >= NTM * 8) { rr -= NTM * 8; g = 2; }
    if (g < 2) { tm = rr >> 3; tn = g * 8 + (rr & 7); } else { tm = rr / (NTN - 16); tn = 16 + rr - tm * (NTN - 16); }
    const bf16_t* ap[4]; const bf16_t* bp[4];
#pragma unroll
    for (int i = 0; i < 4; ++i) {
      const int slot = tm * 128 + lr + 32 * i;
      int r = slot < NSLOT ? p.SEL[(size_t)e * NSLOT + slot] : -1;
      ap[i] = p.H + (size_t)(r < 0 ? 0 : r) * D + lc;
      const int rho = lr + 32 * i, wci = rho >> 6, gu = (rho >> 5) & 1, col = wci * 32 + (rho & 31);
      bp[i] = (gu ? p.Wt_eu : p.Wt_eg) + ((size_t)e * FF + tn * 64 + col) * D + lc;
    }
    f32x4 acc[4][4]; acc_zero<4>(acc);
    gemm_kloop<4>(acc, ap, bp, D / 64, lds);
    f32x4 hid[4][2];
#pragma unroll
    for (int m = 0; m < 4; ++m) {
      const int slot = tm * 128 + wr * 64 + m * 16 + fr;
      const bool valid = slot < NSLOT && p.SEL[(size_t)e * NSLOT + (slot < NSLOT ? slot : 0)] >= 0;
#pragma unroll
      for (int n = 0; n < 2; ++n)
#pragma unroll
        for (int j = 0; j < 4; ++j) { const float g = acc[m][n][j], u = acc[m][n + 2][j]; hid[m][n][j] = valid ? g * u * fast_rcp(1.0f + fast_exp2(-LOG2E * g)) : 0.f; }
    }
    const int slot0 = tm * 128 + wr * 64;
    store_wave_tile<2>(hid, p.HID + ((size_t)e * NSLOT + slot0) * FF + tn * 64 + wc * 32, (size_t)FF, lds + wid * (64 * 80), lane, [&](int r) { return slot0 + r < NSLOT; });
    __syncthreads();
  }
}
DI void ph_moe2(const Params& p, int need_ctx, char* lds, int bid, int nblk) {
  const int t = TIDX, lane = t & 63, wid = t >> 6, wr = wid >> 1, wc = wid & 1, lr = t >> 3, lc = (t & 7) * 8, fr = lane & 15, fq = lane >> 4;
  constexpr int NTN = D / 128;
  const int NTM = need_ctx ? (NSLOT + 127) / 128 : (NB * CAPL) / 128;
  for (int u = bid; u < NE * NTM * NTN; u += nblk) {
    const int tile = xcd_swz(u, NE * NTM * NTN), e = tile / (NTM * NTN), rem = tile % (NTM * NTN), tm = rem / NTN, tn = rem % NTN;
    const bf16_t* ap[4]; const bf16_t* bp[4];
#pragma unroll
    for (int i = 0; i < 4; ++i) {
      int slot = tm * 128 + lr + 32 * i; if (slot >= NSLOT) slot = NSLOT - 1;
      ap[i] = p.HID + ((size_t)e * NSLOT + slot) * FF + lc;
      bp[i] = p.Wt_ed + ((size_t)e * D + tn * 128 + lr + 32 * i) * FF + lc;
    }
    f32x4 acc[4][4]; acc_zero<4>(acc);
    gemm_kloop<4>(acc, ap, bp, FF / 64, lds);
#pragma unroll
    for (int m = 0; m < 4; ++m) {
      const int slot = tm * 128 + wr * 64 + m * 16 + fr;
      const float val = (slot < NSLOT && p.SEL[(size_t)e * NSLOT + (slot < NSLOT ? slot : 0)] >= 0) ? p.SELV[(size_t)e * NSLOT + slot] : 0.f;
#pragma unroll
      for (int n = 0; n < 4; ++n) { acc[m][n].x *= val; acc[m][n].y *= val; acc[m][n].z *= val; acc[m][n].w *= val; }
    }
    const int slot0 = tm * 128 + wr * 64;
    store_wave_tile<4>(acc, p.YE + ((size_t)e * NSLOT + slot0) * D + tn * 128 + wc * 64, (size_t)D, lds + wid * (64 * 144), lane, [&](int r) { return slot0 + r < NSLOT; });
    __syncthreads();
  }
}
constexpr int GEMM_LDS = 2 * (A_BYTES + 128 * LROW);

DI void unpack8(u32x4 v, float (&f)[8]) {
  f[0] = u2f(v.x << 16); f[1] = u2f(v.x & 0xffff0000u); f[2] = u2f(v.y << 16); f[3] = u2f(v.y & 0xffff0000u);
  f[4] = u2f(v.z << 16); f[5] = u2f(v.z & 0xffff0000u); f[6] = u2f(v.w << 16); f[7] = u2f(v.w & 0xffff0000u);
}
DI u32x4 pack8f(const float (&f)[8]) { u32x4 v; v.x = pack2bf(f[0], f[1]); v.y = pack2bf(f[2], f[3]); v.z = pack2bf(f[4], f[5]); v.w = pack2bf(f[6], f[7]); return v; }
DI void rope8(float (&a)[8], const float (&pr)[8], int cc, const float* cs, const float* sn) {
  const int ax = (cc >> 1) * 8; const bool second = cc & 1;
#pragma unroll
  for (int i = 0; i < 8; ++i) a[i] = second ? a[i] * cs[ax + i] + pr[i] * sn[ax + i] : a[i] * cs[ax + i] - pr[i] * sn[ax + i];
}
constexpr int PREP_LDS = 64 * 4 + 2 * 512 * 4 + 32 * 528;
template <int PARTS = 3>
DI void ph_prep(const Params& p, int layer, const bf16_t* QRAW, const bf16_t* KVRAW, char* lds, int bid, int nblk) {
  float* s_rstd = (float*)lds;
  float* s_cs = s_rstd + 64;
  float* s_sn = s_cs + 512;
  bf16_t* s_t = (bf16_t*)(s_sn + 512);
  const int t = TIDX;
  constexpr int UPB = TK / 32, NU = NB * UPB;
  const float* wcv = p.w_conv + (size_t)layer * 3 * 512;
#pragma unroll 1
  for (int u = bid; u < NU; u += nblk) {
    int b, s0;
    if (u < NB * (TL / 32)) { b = u / (TL / 32); s0 = TC + (u % (TL / 32)) * 32; } else { const int v = u - NB * (TL / 32); b = v / (TC / 32); s0 = (v % (TC / 32)) * 32; }
    const int r0 = row_of(b, s0);
    {
      const int tok = t >> 3, part = t & 7;
      const bf16_t* z = p.Z + (size_t)(r0 + tok) * NZP;
      float sq = 0.f, sk = 0.f, f[8];
#pragma unroll
      for (int k = 0; k < 4; ++k) { unpack8(ldg16(z + ZC_QLAT + part * 32 + k * 8), f);
#pragma unroll
        for (int i = 0; i < 8; ++i) sq += f[i] * f[i]; }
#pragma unroll
      for (int k = 0; k < 2; ++k) { unpack8(ldg16(z + ZC_KVLAT + part * 16 + k * 8), f);
#pragma unroll
        for (int i = 0; i < 8; ++i) sk += f[i] * f[i]; }
      sq = xor_sum<1>(sq); sk = xor_sum<1>(sk);
      sq = xor_sum<2>(sq); sk = xor_sum<2>(sk);
      sq = xor_sum<4>(sq); sk = xor_sum<4>(sk);
      if (part == 0) { s_rstd[tok * 2] = 1.0f / sqrtf(sq * (1.0f / 256) + 1e-6f); s_rstd[tok * 2 + 1] = 1.0f / sqrtf(sk * (1.0f / 128) + 1e-6f); }
    }
    for (int i = t; i < 512; i += NTHR) {
      const int tok = i >> 4, af = i & 15, s = s0 + tok;
      float cs = 1.f, sn = 0.f;
      if (s >= TC) rope_cs(s, (af >> 3) * 16 + (af & 7), cs, sn);
      s_cs[i] = cs; s_sn[i] = sn;
    }
    __syncthreads();
    if (PARTS & 1) {
#pragma unroll 2
    for (int i = t; i < 32 * 48; i += NTHR) {
      const int tok = i / 48, c = i % 48, h = c / 12, ch = c % 12;
      const float rq = s_rstd[tok * 2] * QS_MLA, rkv = s_rstd[tok * 2 + 1];
      const bf16_t* q = QRAW + (size_t)(r0 + tok) * 384 + h * 96;
      float a[8], pr[8];
      unpack8(ldg16(q + ch * 8), a);
      if (ch >= 8) { unpack8(ldg16(q + 64 + ((ch - 8) ^ 1) * 8), pr); rope8(a, pr, ch - 8, s_cs + tok * 16, s_sn + tok * 16); }
#pragma unroll
      for (int e = 0; e < 8; ++e) a[e] *= rq;
      *(u32x4*)(p.Qm + (((size_t)b * 4 + h) * TK + s0 + tok) * 96 + ch * 8) = pack8f(a);
      if (ch < 8) {
        unpack8(ldg16(KVRAW + (size_t)(r0 + tok) * 512 + h * 128 + ch * 8), a);
#pragma unroll
        for (int e = 0; e < 8; ++e) a[e] *= rkv;
      } else {
        const bf16_t* z = p.Z + (size_t)(r0 + tok) * NZP + ZC_KROPE;
        unpack8(ldg16(z + (ch - 8) * 8), a); unpack8(ldg16(z + ((ch - 8) ^ 1) * 8), pr);
        rope8(a, pr, ch - 8, s_cs + tok * 16, s_sn + tok * 16);
      }
      *(u32x4*)(p.Km + (((size_t)b * 4 + h) * TK + s0 + tok) * 96 + ch * 8) = pack8f(a);
    }
#pragma unroll 2
    for (int i = t; i < 32 * 64; i += NTHR) {
      const int tok = i >> 6, c = i & 63, qk = c >> 5, hm = (c >> 2) & 7, cc = c & 3;
      const bf16_t* src = p.Z + (size_t)(r0 + tok) * NZP + (qk ? ZC_DK : ZC_DQ) + hm * 32;
      float a[8], pr[8];
      unpack8(ldg16(src + cc * 8), a); unpack8(ldg16(src + (cc ^ 1) * 8), pr);
      rope8(a, pr, cc, s_cs + tok * 16, s_sn + tok * 16);
      if (qk == 0) {
#pragma unroll
        for (int e = 0; e < 8; ++e) a[e] *= QS_DIFF;
        *(u32x4*)(p.Qd + (((size_t)b * 8 + hm) * TK + s0 + tok) * 32 + cc * 8) = pack8f(a);
      } else *(u32x4*)(p.Kd + (((size_t)b * 8 + hm) * TK + s0 + tok) * 32 + cc * 8) = pack8f(a);
    }
#pragma unroll 2
    for (int i = t; i < 32 * 64; i += NTHR) {
      const int tok = i >> 6, c8 = (i & 63) * 8, s = s0 + tok;
      const bool first = (s == 0) || (s == TC), last = (s == TC - 1) || (s == TK - 1);
      const bf16_t* z = p.Z + (size_t)(r0 + tok) * NZP + ZC_MLQK + c8;
      float x0[8], xm[8], xp[8], o[8];
      unpack8(ldg16(z), x0);
      if (!first) unpack8(ldg16(z - NZP), xm);
      if (!last) unpack8(ldg16(z + NZP), xp);
      float bc8[8], w0[8], w1[8], w2[8];
      *(f32x4*)bc8 = *(const f32x4*)(p.b_conv + layer * 512 + c8); *(f32x4*)(bc8 + 4) = *(const f32x4*)(p.b_conv + layer * 512 + c8 + 4);
      *(f32x4*)w0 = *(const f32x4*)(wcv + c8); *(f32x4*)(w0 + 4) = *(const f32x4*)(wcv + c8 + 4);
      *(f32x4*)w1 = *(const f32x4*)(wcv + 512 + c8); *(f32x4*)(w1 + 4) = *(const f32x4*)(wcv + 512 + c8 + 4);
      *(f32x4*)w2 = *(const f32x4*)(wcv + 1024 + c8); *(f32x4*)(w2 + 4) = *(const f32x4*)(wcv + 1024 + c8 + 4);
#pragma unroll
      for (int e = 0; e < 8; ++e) {
        float acc = bc8[e] + x0[e] * w1[e];
        if (!first) acc += xm[e] * w0[e];
        if (!last) acc += xp[e] * w2[e];
        o[e] = acc * fast_rcp(1.0f + fast_exp2(-LOG2E * acc));
      }
      if (c8 < 256) *(u32x4*)(p.MQ + ((size_t)b * TK + s) * 256 + c8) = pack8f(o);
      else {
#pragma unroll
        for (int e = 0; e < 8; ++e) o[e] *= 0.125f;
        *(u32x4*)(p.MK + ((size_t)b * TK + s) * 256 + c8 - 256) = pack8f(o);
      }
    }
    }
#pragma unroll 1
    for (int w = 0; w < ((PARTS & 2) ? 4 : 0); ++w) {
      __syncthreads();
#pragma unroll
      for (int k = 0; k < 4; ++k) {
        const int i = t + k * NTHR, tok = i >> 5, c8 = (i & 31) * 8;
        u32x4 v;
        if (w == 0) { float a[8]; const int h = c8 >> 6; unpack8(ldg16(KVRAW + (size_t)(r0 + tok) * 512 + h * 128 + 64 + (c8 & 63)), a); const float rkv = s_rstd[tok * 2 + 1];
#pragma unroll
          for (int e = 0; e < 8; ++e) a[e] *= rkv;
          v = pack8f(a); }
        else v = ldg16(p.Z + (size_t)(r0 + tok) * NZP + (w == 1 ? ZC_DV : (w == 2 ? ZC_MLV : ZC_GV)) + c8);
        *(u32x4*)(s_t + tok * 264 + c8) = v;
      }
      __syncthreads();
      bf16_t* dst = w == 0 ? p.Vtm : (w == 1 ? p.Vtd : (w == 2 ? p.MVt : p.GVt));
#pragma unroll
      for (int k = 0; k < 4; ++k) {
        const int i = t + k * NTHR, tg = i & 3, ch = i >> 2;
        u32x4 v;
        v.x = (unsigned)s_t[(tg * 8 + 0) * 264 + ch] | ((unsigned)s_t[(tg * 8 + 1) * 264 + ch] << 16);
        v.y = (unsigned)s_t[(tg * 8 + 2) * 264 + ch] | ((unsigned)s_t[(tg * 8 + 3) * 264 + ch] << 16);
        v.z = (unsigned)s_t[(tg * 8 + 4) * 264 + ch] | ((unsigned)s_t[(tg * 8 + 5) * 264 + ch] << 16);
        v.w = (unsigned)s_t[(tg * 8 + 6) * 264 + ch] | ((unsigned)s_t[(tg * 8 + 7) * 264 + ch] << 16);
        *(u32x4*)(dst + (((size_t)b * 4 + (ch >> 6)) * 64 + (ch & 63)) * TK + s0 + tg * 8) = v;
      }
    }
    __syncthreads();
  }
}
constexpr int VROW = 136;
constexpr int VROW_A = 144;
template <int DQK> struct AttnCfg {
  static constexpr int KROW = DQK * 2 + 16;
  static constexpr int KBYTES = 64 * KROW, VBYTES = 64 * VROW_A, STAGE = KBYTES + VBYTES;
  static constexpr int KCH = 64 * DQK * 2 / 16 / NTHR;
};
DI bf16x8 pack8(const f32x16& x, int s) {
  u32x4 pk; pk.x = pack2bf(x[8 * s], x[8 * s + 1]); pk.y = pack2bf(x[8 * s + 2], x[8 * s + 3]); pk.z = pack2bf(x[8 * s + 4], x[8 * s + 5]); pk.w = pack2bf(x[8 * s + 6], x[8 * s + 7]);
  return __builtin_bit_cast(bf16x8, pk);
}
struct TrueC { static constexpr bool value = true; };
struct FalseC { static constexpr bool value = false; };
template <int DQK, int NMAP, int VAR = 0>
DI void attn_unit(const bf16_t* __restrict__ Qb, const bf16_t* __restrict__ Kb, size_t mstride, const bf16_t* __restrict__ Vt, int q0, int nkeys,
                  f32x16 (&O)[NMAP][2], float (&lsum)[NMAP], char* lds) {
  constexpr int DM = DQK / NMAP;
  constexpr int KS = DM / 16;
  using C = AttnCfg<DQK>;
  constexpr int CPM = 64 * DM * 2 / 16;
  constexpr int CPR = DM * 2 / 16;
  const int t = TIDX, lane = t & 63, wid = t >> 6, l31 = lane & 31, hh = lane >> 5;
  bf16x8 qf[NMAP][KS];
#pragma unroll
  for (int m = 0; m < NMAP; ++m)
#pragma unroll
    for (int ks = 0; ks < KS; ++ks) qf[m][ks] = *(const bf16x8*)(Qb + m * mstride + (size_t)(q0 + wid * 32 + l31) * DM + ks * 16 + 8 * hh);
  float mref[NMAP];
#pragma unroll
  for (int m = 0; m < NMAP; ++m) { mref[m] = 0.f; lsum[m] = 0.f; O[m][0] = (f32x16)(0.f); O[m][1] = (f32x16)(0.f); }
  u32x4 rk[C::KCH], rv[2];
  const bf16_t* kg[C::KCH]; int klds[C::KCH];
#pragma unroll
  for (int i = 0; i < C::KCH; ++i) { const int c = t + i * NTHR, m = c / CPM, cc = c % CPM; kg[i] = Kb + m * mstride + cc * 8; klds[i] = (cc / CPR) * C::KROW + m * DM * 2 + (cc % CPR) * 16; }
  const bf16_t* vg = Vt + (size_t)(t >> 3) * TK + (t & 7) * 8;
  const int vlds = C::KBYTES + (t >> 3) * VROW_A + ((t & 7) >> 1) * 32 + ((t & 1) ? 8 : 0);
  const int kfoff = l31 * C::KROW + 16 * hh, vfoff = C::KBYTES + l31 * VROW_A + 16 * hh;
  const int nt = nkeys / 64;
#pragma unroll
  for (int i = 0; i < C::KCH; ++i) rk[i] = ldg16(kg[i]);
  rv[0] = ldg16(vg); rv[1] = ldg16(vg + (size_t)32 * TK);
  auto tile = [&](const int kt, auto chk_c, auto ref_c) __attribute__((always_inline)) {
    constexpr bool CHK = decltype(chk_c)::value, REF = decltype(ref_c)::value;
    char* cur = lds + (kt & 1) * C::STAGE;
    if (VAR != 2) {
#pragma unroll
    for (int i = 0; i < C::KCH; ++i) sts16(cur + klds[i], rk[i]);
#pragma unroll
    for (int i = 0; i < 2; ++i) { char* d = cur + vlds + i * 32 * VROW_A; u32x2 lo, hi; lo.x = rv[i].x; lo.y = rv[i].y; hi.x = rv[i].z; hi.y = rv[i].w; *(u32x2*)d = lo; *(u32x2*)(d + 16) = hi; }
    __syncthreads();
    }
    if (VAR != 2 && kt + 1 < nt) {
#pragma unroll
      for (int i = 0; i < C::KCH; ++i) rk[i] = ldg16(kg[i] + (size_t)(kt + 1) * 64 * DM);
      rv[0] = ldg16(vg + (kt + 1) * 64); rv[1] = ldg16(vg + (size_t)32 * TK + (kt + 1) * 64);
    }
    bf16x8 kf[NMAP][2][KS];
#pragma unroll
    for (int k2 = 0; k2 < 2; ++k2)
#pragma unroll
      for (int ks = 0; ks < KS; ++ks) kf[0][k2][ks] = lds_frag(cur + kfoff + k2 * 32 * C::KROW + ks * 32);
    f32x16 S[NMAP][2];
    S[0][0] = (f32x16)(0.f); S[0][1] = (f32x16)(0.f);
#pragma unroll
    for (int ks = 0; ks < KS; ++ks)
#pragma unroll
      for (int k2 = 0; k2 < 2; ++k2) S[0][k2] = MFMA32(kf[0][k2][ks], qf[0][ks], S[0][k2]);
    bf16x8 vf[4][2];
#pragma unroll
    for (int kst = 0; kst < 4; ++kst)
#pragma unroll
      for (int dvt = 0; dvt < 2; ++dvt) vf[kst][dvt] = lds_frag(cur + vfoff + dvt * 32 * VROW_A + kst * 32);
#pragma unroll
    for (int m = 1; m < NMAP; ++m)
#pragma unroll
      for (int k2 = 0; k2 < 2; ++k2)
#pragma unroll
        for (int ks = 0; ks < KS; ++ks) kf[m][k2][ks] = lds_frag(cur + kfoff + k2 * 32 * C::KROW + m * DM * 2 + ks * 32);
#pragma unroll
    for (int m = 0; m < NMAP; ++m) {
      if (m > 0) {
        SCHED_BARRIER();
        S[m][0] = (f32x16)(0.f); S[m][1] = (f32x16)(0.f);
#pragma unroll
        for (int ks = 0; ks < KS; ++ks)
#pragma unroll
          for (int k2 = 0; k2 < 2; ++k2) S[m][k2] = MFMA32(kf[m][k2][ks], qf[m][ks], S[m][k2]);
      }
      if (VAR != 1) {
      if (CHK && (kt & 7) == 0) {
        float mx = fmaxf(S[m][0][0], S[m][1][0]);
#pragma unroll
        for (int i = 1; i < 16; ++i) mx = fmaxf(mx, fmaxf(S[m][0][i], S[m][1][i]));
        mx = xor_max<32>(mx);
        const float rel = mx - mref[m];
        const float delta = (kt == 0) ? ((mx > ATT_THR || mx < -ATT_THR) ? mx : 0.0f) : (rel > ATT_THR ? rel : 0.0f);
        if (wave_any(delta != 0.0f)) {
          const float alpha = fast_exp2(-delta);
          mref[m] += delta; lsum[m] *= alpha;
#pragma unroll
          for (int dvt = 0; dvt < 2; ++dvt)
#pragma unroll
            for (int i = 0; i < 16; ++i) O[m][dvt][i] *= alpha;
        }
      }
      if constexpr (REF) {
        if (wave_any(mref[m] != 0.0f)) {
          const f32x2 nm = {-mref[m], -mref[m]};
#pragma unroll
          for (int k2 = 0; k2 < 2; ++k2)
#pragma unroll
            for (int i = 0; i < 16; i += 2) { const f32x2 x = (f32x2){S[m][k2][i], S[m][k2][i + 1]} + nm; S[m][k2][i] = x.x; S[m][k2][i + 1] = x.y; }
        }
      }
      f32x2 ps2 = {0.f, 0.f};
#pragma unroll
      for (int k2 = 0; k2 < 2; ++k2)
#pragma unroll
        for (int i = 0; i < 16; i += 2) {
          const float e0 = fast_exp2(S[m][k2][i]), e1 = fast_exp2(S[m][k2][i + 1]);
          S[m][k2][i] = e0; S[m][k2][i + 1] = e1; ps2 += (f32x2){e0, e1};
        }
      lsum[m] += ps2.x + ps2.y;
      } else lsum[m] += 1.0f;
#pragma unroll
      for (int kst = 0; kst < 4; ++kst) {
        const bf16x8 pf = pack8(S[m][kst >> 1], kst & 1);
#pragma unroll
        for (int dvt = 0; dvt < 2; ++dvt) O[m][dvt] = MFMA32(vf[kst][dvt], pf, O[m][dvt]);
      }
    }
  };
  int kt = 0;
#pragma unroll 1
  while (kt < nt) {
    tile(kt, TrueC{}, TrueC{});
    ++kt;
    bool nz = false;
#pragma unroll
    for (int m = 0; m < NMAP; ++m) nz = nz || (mref[m] != 0.0f);
    if (!wave_any(nz)) {
      const int k8 = (kt + 7) & ~7, kend = k8 < nt ? k8 : nt;
#pragma unroll 1
      for (; kt < kend; ++kt) tile(kt, FalseC{}, FalseC{});
    }
  }
  __syncthreads();
#pragma unroll
  for (int m = 0; m < NMAP; ++m) lsum[m] = xor_sum<32>(lsum[m]);
}
constexpr int ATT_QB = TK / 128;
constexpr int ATT_LDS = 2 * AttnCfg<96>::STAGE;
constexpr int ATT_QBL = TL / 128, ATT_QBC = TC / 128, ATT_LAT_UNITS = NB * 4 * ATT_QBL, ATT_UNITS = ATT_LAT_UNITS + NB * 4 * ATT_QBC;
DI void att_unit(int u, int& bh, int& qb) {
  if (u < ATT_LAT_UNITS) { bh = u & 7; qb = ATT_QBC + (u >> 3); } else { const int v = u - ATT_LAT_UNITS; bh = v & 7; qb = v >> 3; }
}
DI void ph_attn_diff(const Params& p, int layer, int need_ctx, char* lds, int bid, int nblk) {
  const int lane = TIDX & 63, wid = TIDX >> 6, l31 = lane & 31, hh = lane >> 5;
  float lam_init; const float lam = lam_of(p, layer, lam_init);
#pragma unroll 1
  for (int u = bid; u < (need_ctx ? ATT_UNITS : ATT_LAT_UNITS); u += nblk) {
    int bh, qb; att_unit(u, bh, qb);
    const int b = bh >> 2, h = bh & 3, q0 = qb * 128;
    const int r = row_of(b, q0 + wid * 32 + l31);
    f32x16 O[2][2]; float ls[2];
    attn_unit<64, 2>(p.Qd + ((size_t)b * 8 + h * 2) * TK * 32, p.Kd + ((size_t)b * 8 + h * 2) * TK * 32, (size_t)TK * 32, p.Vtd + ((size_t)b * 4 + h) * 64 * TK, q0,
                     q0 < TC ? TC : TK, O, ls, lds);
    const float i0 = 1.0f / ls[0], i1 = lam / ls[1];
    float ss = 0.f;
#pragma unroll
    for (int dvt = 0; dvt < 2; ++dvt)
#pragma unroll
      for (int i = 0; i < 16; ++i) { const float o = O[0][dvt][i] * i0 - O[1][dvt][i] * i1; O[0][dvt][i] = o; ss += o * o; }
    ss = xor_sum<32>(ss);
    const float rstd = (1.0f - lam_init) / sqrtf(ss * (1.0f / 64) + 1e-6f);
    const float* gd = p.g_diff_out + layer * 256 + h * 64;
#pragma unroll
    for (int dvt = 0; dvt < 2; ++dvt)
#pragma unroll
      for (int g = 0; g < 4; ++g) {
        const int dv = dvt * 32 + 8 * g + 4 * hh;
        const f32x4 gv = *(const f32x4*)(gd + dv);
        f32x4 o = {O[0][dvt][4 * g] * rstd * gv[0], O[0][dvt][4 * g + 1] * rstd * gv[1], O[0][dvt][4 * g + 2] * rstd * gv[2], O[0][dvt][4 * g + 3] * rstd * gv[3]};
        st_bf16x4(p.Y + (size_t)r * D + 768 + h * 64 + dv, o);
      }
  }
}
DI void ph_attn_mla(const Params& p, int need_ctx, char* lds, int bid, int nblk) {
  const int lane = TIDX & 63, wid = TIDX >> 6, l31 = lane & 31, hh = lane >> 5;
#pragma unroll 1
  for (int u = bid; u < (need_ctx ? ATT_UNITS : ATT_LAT_UNITS); u += nblk) {
    int bh, qb; att_unit(u, bh, qb);
    const int b = bh >> 2, h = bh & 3, q0 = qb * 128;
    const int r = row_of(b, q0 + wid * 32 + l31);
    f32x16 O[1][2]; float ls[1];
    attn_unit<96, 1>(p.Qm + ((size_t)b * 4 + h) * TK * 96, p.Km + ((size_t)b * 4 + h) * TK * 96, 0, p.Vtm + ((size_t)b * 4 + h) * 64 * TK, q0, q0 < TC ? TC : TK, O, ls, lds);
    const float inv = 1.0f / ls[0];
#pragma unroll
    for (int dvt = 0; dvt < 2; ++dvt)
#pragma unroll
      for (int g = 0; g < 4; ++g) {
        f32x4 o = {O[0][dvt][4 * g] * inv, O[0][dvt][4 * g + 1] * inv, O[0][dvt][4 * g + 2] * inv, O[0][dvt][4 * g + 3] * inv};
        st_bf16x4(p.Y + (size_t)r * D + h * 64 + dvt * 32 + 8 * g + 4 * hh, o);
      }
  }
}
template <int VAR> DI void ph_attn_mla_probe(const Params& p, char* lds, int bid, int nblk) {
  const int lane = TIDX & 63, wid = TIDX >> 6, l31 = lane & 31, hh = lane >> 5;
#pragma unroll 1
  for (int u = bid; u < ATT_LAT_UNITS; u += nblk) {
    int bh, qb; att_unit(u, bh, qb);
    const int b = bh >> 2, h = bh & 3, q0 = qb * 128;
    const int r = row_of(b, q0 + wid * 32 + l31);
    f32x16 O[1][2]; float ls[1];
    attn_unit<96, 1, VAR>(p.Qm + ((size_t)b * 4 + h) * TK * 96, p.Km + ((size_t)b * 4 + h) * TK * 96, 0, p.Vtm + ((size_t)b * 4 + h) * 64 * TK, q0, TK, O, ls, lds);
    const float inv = 1.0f / ls[0];
#pragma unroll
    for (int dvt = 0; dvt < 2; ++dvt)
#pragma unroll
      for (int g = 0; g < 4; ++g) {
        f32x4 o = {O[0][dvt][4 * g] * inv, O[0][dvt][4 * g + 1] * inv, O[0][dvt][4 * g + 2] * inv, O[0][dvt][4 * g + 3] * inv};
        *(f32x4*)(p.out + (size_t)r * D + h * 64 + dvt * 32 + 8 * g + 4 * hh) = o;
      }
  }
}
DI void ph_attn(const Params& p, int layer, int need_ctx, char* lds, int bid, int nblk) {
  ph_attn_diff(p, layer, need_ctx, lds, bid, nblk);
  ph_attn_mla(p, need_ctx, lds, bid, nblk);
}

DI float wave_sum(float v) {
  v = xor_sum<1>(v); v = xor_sum<2>(v); v = xor_sum<4>(v); v = xor_sum<8>(v); v = xor_sum<16>(v); v = xor_sum<32>(v);
  return v;
}
DI void ld_row16(const float* row, int lane, f32x4 (&v)[4]) {
#pragma unroll
  for (int i = 0; i < 4; ++i) v[i] = *(const f32x4*)(row + 256 * i + 4 * lane);
}
DI void ld_row16_bf(const bf16_t* row, int lane, f32x4 (&v)[4]) {
#pragma unroll
  for (int i = 0; i < 4; ++i) { const u32x2 u = *(const u32x2*)(row + 256 * i + 4 * lane); v[i] = (f32x4){u2f(u.x << 16), u2f(u.x & 0xffff0000u), u2f(u.y << 16), u2f(u.y & 0xffff0000u)}; }
}
DI void ph_modulate(const Params& p, int layer, const float* xl, const float* xcx, int bid, int nblk) {
  const int lane = TIDX & 63, wid = TIDX >> 6;
  const float* g = p.g_mix_pre + layer * 1024;
  for (int r = bid * 4 + wid; r < R; r += nblk * 4) {
    const int w = r < RL ? r / TL : 2;
    const float* mb = p.mods + (size_t)(layer * 3 + w) * 6144;
    const float* x = r < RL ? xl + (size_t)r * D : xcx + (size_t)(r - RL) * D;
    f32x4 xv[4], gv[4], sc[4], sh[4];
    ld_row16(x, lane, xv); ld_row16(g, lane, gv); ld_row16(mb + 1024, lane, sc); ld_row16(mb, lane, sh);
    float ss = 0.f;
#pragma unroll
    for (int i = 0; i < 4; ++i)
#pragma unroll
      for (int e = 0; e < 4; ++e) ss += xv[i][e] * xv[i][e];
    const float rstd = 1.0f / sqrtf(wave_sum(ss) * (1.0f / D) + 1e-6f);
#pragma unroll
    for (int i = 0; i < 4; ++i) {
      f32x4 o;
#pragma unroll
      for (int e = 0; e < 4; ++e) o[e] = xv[i][e] * rstd * gv[i][e] * (1.f + sc[i][e]) + sh[i][e];
      st_bf16x4(p.H + (size_t)r * D + 256 * i + 4 * lane, o);
    }
  }
}
DI void ph_resid_mix(const Params& p, int layer, const float* xl_in, const float* xc_in, int rows, char* lds, int bid, int nblk) {
  const int lane = TIDX & 63, wid = TIDX >> 6;
  const float* wr = p.w_router + (size_t)layer * D * 16;
  for (int i = TIDX; i < D * 4; i += NTHR) { const int k = i >> 2, q = i & 3; *(f32x4*)(lds + k * 64 + (k >> 2) * 16 + q * 16) = *(const f32x4*)(wr + k * 16 + q * 4); }
  __syncthreads();
  for (int r = bid * 4 + wid; r < rows; r += nblk * 4) {
    const int w = r < RL ? r / TL : 2;
    const float* mb = p.mods + (size_t)(layer * 3 + w) * 6144;
    const float* xin = r < RL ? xl_in + (size_t)r * D : xc_in + (size_t)(r - RL) * D;
    float* xo = r < RL ? p.out + (size_t)r * D : p.xc + (size_t)(r - RL) * D;
    f32x4 yv[4], xv[4], a[4], c[4];
    ld_row16_bf(p.YO + (size_t)r * D, lane, yv); ld_row16(xin, lane, xv);
    float ss = 0.f;
#pragma unroll
    for (int i = 0; i < 4; ++i)
#pragma unroll
      for (int e = 0; e < 4; ++e) ss += yv[i][e] * yv[i][e];
    const float rstd = 1.0f / sqrtf(wave_sum(ss) * (1.0f / D) + 1e-6f);
    ld_row16(mb + 2 * 1024, lane, a); ld_row16(p.g_mix_post + layer * 1024, lane, c);
    float s2 = 0.f;
#pragma unroll
    for (int i = 0; i < 4; ++i) {
#pragma unroll
      for (int e = 0; e < 4; ++e) { xv[i][e] += a[i][e] * yv[i][e] * rstd * c[i][e]; s2 += xv[i][e] * xv[i][e]; }
      *(f32x4*)(xo + 256 * i + 4 * lane) = xv[i];
    }
    const float rstd2 = 1.0f / sqrtf(wave_sum(s2) * (1.0f / D) + 1e-6f);
    ld_row16(p.g_ffn_pre + layer * 1024, lane, a); ld_row16(mb + 4 * 1024, lane, c); ld_row16(mb + 3 * 1024, lane, yv);
    float lg[16];
#pragma unroll
    for (int e = 0; e < 16; ++e) lg[e] = 0.f;
#pragma unroll
    for (int i = 0; i < 4; ++i) {
      f32x4 h2;
#pragma unroll
      for (int e = 0; e < 4; ++e) h2[e] = xv[i][e] * rstd2 * a[i][e] * (1.f + c[i][e]) + yv[i][e];
      st_bf16x4(p.H + (size_t)r * D + 256 * i + 4 * lane, h2);
#pragma unroll
      for (int e = 0; e < 4; ++e) {
        const char* wk = lds + (256 * i + 4 * lane + e) * 64 + (64 * i + lane) * 16;
#pragma unroll
        for (int q = 0; q < 4; ++q) { const f32x4 wv = *(const f32x4*)(wk + 16 * q); lg[4 * q] += h2[e] * wv[0]; lg[4 * q + 1] += h2[e] * wv[1]; lg[4 * q + 2] += h2[e] * wv[2]; lg[4 * q + 3] += h2[e] * wv[3]; }
      }
    }
#pragma unroll
    for (int e = 0; e < 16; ++e) lg[e] = wave_sum(lg[e]);
    float mx = lg[0];
#pragma unroll
    for (int e = 1; e < 16; ++e) mx = fmaxf(mx, lg[e]);
    float sm = 0.f;
#pragma unroll
    for (int e = 0; e < 16; ++e) { lg[e] = expf(lg[e] - mx); sm += lg[e]; }
    int b, s; bs_of(r, b, s);
    float mine = 0.f;
#pragma unroll
    for (int e = 0; e < 16; ++e) mine = (lane == e) ? lg[e] / sm : mine;
    if (lane < 16) p.AFF[((size_t)b * NE + lane) * TK + s] = mine;
  }
}
DI void ph_resid_ffn(const Params& p, int layer, int rows, int bid, int nblk) {
  const int lane = TIDX & 63, wid = TIDX >> 6;
  for (int r = bid * 4 + wid; r < rows; r += nblk * 4) {
    const int w = r < RL ? r / TL : 2;
    const float* mb = p.mods + (size_t)(layer * 3 + w) * 6144;
    float* xo = r < RL ? p.out + (size_t)r * D : p.xc + (size_t)(r - RL) * D;
    const int myinv = lane < NE ? p.INV[(size_t)r * NE + lane] : -1;
    f32x4 f[4];
#pragma unroll
    for (int i = 0; i < 4; ++i) f[i] = (f32x4){0.f, 0.f, 0.f, 0.f};
    for (int e = 0; e < NE; ++e) {
      const int sl = lane_bcast(myinv, e);
      if (sl >= 0) { f32x4 yv[4]; ld_row16_bf(p.YE + ((size_t)e * NSLOT + sl) * D, lane, yv);
#pragma unroll
        for (int i = 0; i < 4; ++i) f[i] += yv[i]; }
    }
    float ss = 0.f;
#pragma unroll
    for (int i = 0; i < 4; ++i)
#pragma unroll
      for (int e = 0; e < 4; ++e) ss += f[i][e] * f[i][e];
    const float rstd = 1.0f / sqrtf(wave_sum(ss) * (1.0f / D) + 1e-6f);
    f32x4 a[4], c[4], xv[4];
    ld_row16(mb + 5 * 1024, lane, a); ld_row16(p.g_ffn_post + layer * 1024, lane, c); ld_row16(xo, lane, xv);
#pragma unroll
    for (int i = 0; i < 4; ++i) {
#pragma unroll
      for (int e = 0; e < 4; ++e) xv[i][e] += a[i][e] * f[i][e] * rstd * c[i][e];
      *(f32x4*)(xo + 256 * i + 4 * lane) = xv[i];
    }
  }
}
DI void ph_mods(const Params& p, char* lds, int bid, int nblk) {
  float* sc = (float*)lds;
  const int t = TIDX;
  for (int i = t; i < 3 * 1024; i += NTHR) { const float v = i < 2048 ? p.c[i] : p.c_ctx[i - 2048]; sc[i] = v / (1.0f + expf(-v)); }
  __syncthreads();
#pragma unroll 1
  for (long gi = (long)bid * NTHR + t; gi < 2 * 3 * 6144; gi += (long)nblk * NTHR) {
    const int col = (int)(gi % 6144), w = (int)((gi / 6144) % 3), l = (int)(gi / (3 * 6144));
    const float* W = p.w_ada + (size_t)l * 1024 * 6144 + col; const float* s = sc + w * 1024;
    float acc[8];
#pragma unroll
    for (int q = 0; q < 8; ++q) acc[q] = 0.f;
#pragma unroll 1
    for (int k = 0; k < 1024; k += 8) {
#pragma unroll
      for (int q = 0; q < 8; ++q) acc[q] += s[k + q] * W[(size_t)(k + q) * 6144];
    }
    p.mods[gi] = ((acc[0] + acc[1]) + (acc[2] + acc[3])) + ((acc[4] + acc[5]) + (acc[6] + acc[7])) + p.b_ada[l * 6144 + col];
  }
  __syncthreads();
}
constexpr int TOPK_LDS = TL * 4 + 2048;
DI int block_sum_i(int v, int* red) {
  const int lane = TIDX & 63, wid = TIDX >> 6;
  v = xor_sum_i<1>(v); v = xor_sum_i<2>(v); v = xor_sum_i<4>(v); v = xor_sum_i<8>(v); v = xor_sum_i<16>(v); v = xor_sum_i<32>(v);
  __syncthreads();
  if (lane == 0) red[wid] = v;
  __syncthreads();
  return red[0] + red[1] + red[2] + red[3];
}
DI int block_excl_scan(int v, int* red) {
  const int lane = TIDX & 63, wid = TIDX >> 6;
  int inc = v;
#pragma unroll
  for (int d = 1; d < 64; d <<= 1) { const int o = lane_up(inc, d, lane); if (lane >= d) inc += o; }
  __syncthreads();
  if (lane == 63) red[wid] = inc;
  __syncthreads();
  int base = 0;
  for (int q = 0; q < wid; ++q) base += red[q];
  return base + inc - v;
}
DI void ph_topk(const Params& p, int need_ctx, char* lds, int bid, int nblk) {
  unsigned* vals = (unsigned*)lds; int* red = (int*)(lds + TL * 4 + 1024);
  const int t = TIDX;
  for (int u = bid; u < NB * NE * 2; u += nblk) {
    const int seg = u & 1, e = (u >> 1) % NE, b = u / (2 * NE);
    const int s0 = seg ? TC : 0, n = seg ? TL : TC, cap = seg ? CAPL : CAPC, slot0 = seg ? b * CAPL : NB * CAPL + b * CAPC;
    if (seg == 0 && !need_ctx) { for (int q = t; q < cap; q += NTHR) p.SEL[(size_t)e * NSLOT + slot0 + q] = -1; continue; }
    const float* a = p.AFF + ((size_t)b * NE + e) * TK + s0;
    const int vpt = (n + NTHR - 1) / NTHR, i0 = t * vpt, i1 = (i0 + vpt < n) ? i0 + vpt : n;
    for (int i = t; i < n; i += NTHR) vals[i + i / vpt] = f2u(a[i]);
    __syncthreads();
    unsigned thr = 0;
    for (int bit = 31; bit >= 0; --bit) {
      const unsigned cand = thr | (1u << bit);
      int cnt = 0;
      for (int i = i0; i < i1; ++i) cnt += (vals[i + t] >= cand);
      if (block_sum_i(cnt, red) >= cap) thr = cand;
    }
    int cgt = 0, ceq = 0;
    for (int i = i0; i < i1; ++i) { cgt += (vals[i + t] > thr); ceq += (vals[i + t] == thr); }
    const int ngt = block_sum_i(cgt, red);
    const int neq = cap - ngt;
    int eqoff = block_excl_scan(ceq, red);
    int csel = 0;
    { int er = eqoff; for (int i = i0; i < i1; ++i) { if (vals[i + t] > thr) ++csel; else if (vals[i + t] == thr) { if (er < neq) ++csel; ++er; } } }
    int q = block_excl_scan(csel, red);
    for (int i = i0; i < i1; ++i) {
      const unsigned v = vals[i + t]; int sel = -1;
      if (v > thr) sel = q++; else if (v == thr) { if (eqoff < neq) sel = q++; ++eqoff; }
      const int r = row_of(b, s0 + i);
      if (sel >= 0) { p.SEL[(size_t)e * NSLOT + slot0 + sel] = r; p.SELV[(size_t)e * NSLOT + slot0 + sel] = u2f(v); }
      p.INV[(size_t)r * NE + e] = sel >= 0 ? slot0 + sel : -1;
    }
    __syncthreads();
  }
}
DI void ph_wt(const float* in, bf16_t* out, int K, int N, int NP, int nbatch, long in_bs, long out_bs, const float* gain, char* lds, int bid, int nblk) {
  float* tile = (float*)lds;
  const int t = TIDX, tk = K / 64, tn = NP / 64, ntile = nbatch * tk * tn;
  f32x4 v[4];
  auto gload = [&](int u) {
    const int bt = u / (tk * tn), rem = u % (tk * tn), k0 = (rem / tn) * 64, n0 = (rem % tn) * 64;
    const float* I = in + (size_t)bt * in_bs;
#pragma unroll
    for (int i = 0; i < 4; ++i) {
      const int idx = t + i * NTHR, kk = idx >> 4, n4 = (idx & 15) * 4;
      v[i] = (f32x4){0.f, 0.f, 0.f, 0.f};
      if (n0 + n4 < N) v[i] = *(const f32x4*)(I + (size_t)(k0 + kk) * N + n0 + n4);
      if (gain) { const float g = gain[k0 + kk]; v[i][0] *= g; v[i][1] *= g; v[i][2] *= g; v[i][3] *= g; }
    }
  };
  if (bid < ntile) gload(bid);
#pragma unroll 1
  for (int u = bid; u < ntile; u += nblk) {
    const int bt = u / (tk * tn), rem = u % (tk * tn), k0 = (rem / tn) * 64, n0 = (rem % tn) * 64;
    bf16_t* O = out + (size_t)bt * out_bs;
#pragma unroll
    for (int i = 0; i < 4; ++i) { const int idx = t + i * NTHR, kk = idx >> 4, n4 = (idx & 15) * 4; float* d = tile + kk * 65 + n4; d[0] = v[i][0]; d[1] = v[i][1]; d[2] = v[i][2]; d[3] = v[i][3]; }
    __syncthreads();
    if (u + nblk < ntile) gload(u + nblk);
#pragma unroll
    for (int i = 0; i < 2; ++i) {
      const int idx = t + i * NTHR, kg = idx & 7, nn = idx >> 3;
      float a[8];
#pragma unroll
      for (int e = 0; e < 8; ++e) a[e] = tile[(kg * 8 + e) * 65 + nn];
      u32x4 o; o.x = pack2bf(a[0], a[1]); o.y = pack2bf(a[2], a[3]); o.z = pack2bf(a[4], a[5]); o.w = pack2bf(a[6], a[7]);
      *(u32x4*)(O + (size_t)(n0 + nn) * K + k0 + kg * 8) = o;
    }
    __syncthreads();
  }
}
DI float wave_max(float v) {
  v = xor_max<1>(v); v = xor_max<2>(v); v = xor_max<4>(v); v = xor_max<8>(v); v = xor_max<16>(v); v = xor_max<32>(v);
  return v;
}
DI bf16x8 cvt8(const float* f) {
  const f32x4 a = *(const f32x4*)f, b = *(const f32x4*)(f + 4);
  u32x4 pk; pk.x = pack2bf(a[0], a[1]); pk.y = pack2bf(a[2], a[3]); pk.z = pack2bf(b[0], b[1]); pk.w = pack2bf(b[2], b[3]);
  return __builtin_bit_cast(bf16x8, pk);
}
constexpr int SCAN_UNITS = NB * NCK * 4, SCAN_LAT_UNITS = NB * NCL * 4;
DI void scan_unit(int u, int& b, int& c, int& h) {
  h = u & 3;
  if (u < SCAN_LAT_UNITS) { c = NCC + (u >> 2) % NCL; b = u / (4 * NCL); } else { const int v = u - SCAN_LAT_UNITS; c = (v >> 2) % NCC; b = v / (4 * NCC); }
}

DI void ph_ml_local(const Params& p, char* lds, int bid, int nblk) {
  bf16_t* sK = (bf16_t*)lds;
  float* sW = (float*)(lds + 64 * 132);
  const int t = TIDX, lane = t & 63, wid = t >> 6, l31 = lane & 31, hh = lane >> 5;
  const int d = wid & 1, vt = wid >> 1;
#pragma unroll 1
  for (int u = bid; u < SCAN_UNITS; u += nblk) {
    int b, c, h; scan_unit(u, b, c, h);
    {
      const int row = t >> 2, seg = (t & 3) * 16;
      const bf16_t* src = p.MK + ((size_t)b * TK + 64 * c + row) * 256 + h * 64 + seg;
      const u32x4 a = ldg16(src), bb = ldg16(src + 8);
      unsigned* dst = (unsigned*)((char*)sK + row * 132 + seg * 2);
      dst[0] = a.x; dst[1] = a.y; dst[2] = a.z; dst[3] = a.w; dst[4] = bb.x; dst[5] = bb.y; dst[6] = bb.z; dst[7] = bb.w;
    }
    if (t < 128) {
      const int dd = t >> 6, l = t & 63, j = step_of(dd, c), pos = dd ? 63 - l : l;
      const size_t o = (((size_t)b * 2 + dd) * TK + 64 * j) * 4 + h;
      const float bend = p.BC[o + 63 * 4], wl = bend - p.BC[o + pos * 4] + p.IGS[o + pos * 4];
      const float ml = wave_max(wl);
      sW[dd * 64 + l] = expf(wl - ml);
      if (l == 0) { const size_t uu = (((size_t)b * 2 + dd) * NCK + j) * 4 + h; p.MM[uu * 4] = ml; p.MM[uu * 4 + 1] = bend; }
    }
    __syncthreads();
    const int j = step_of(d, c);
    const size_t uu = (((size_t)b * 2 + d) * NCK + j) * 4 + h;
    f32x16 acc[2]; acc[0] = (f32x16)(0.f); acc[1] = (f32x16)(0.f);
    const bf16_t* vsrc = p.MVt + (((size_t)b * 4 + h) * 64 + vt * 32 + l31) * TK + 64 * c;
#pragma unroll
    for (int ks = 0; ks < 4; ++ks) {
      const bf16x8 a = *(const bf16x8*)(vsrc + ks * 16 + 8 * hh);
      const float* w = sW + d * 64 + ks * 16 + 8 * hh;
      u32x4 pk;
      pk.x = pack2bf(bf2f((bf16_t)a[0]) * w[0], bf2f((bf16_t)a[1]) * w[1]); pk.y = pack2bf(bf2f((bf16_t)a[2]) * w[2], bf2f((bf16_t)a[3]) * w[3]);
      pk.z = pack2bf(bf2f((bf16_t)a[4]) * w[4], bf2f((bf16_t)a[5]) * w[5]); pk.w = pack2bf(bf2f((bf16_t)a[6]) * w[6], bf2f((bf16_t)a[7]) * w[7]);
      const bf16x8 af = __builtin_bit_cast(bf16x8, pk);
#pragma unroll
      for (int kt = 0; kt < 2; ++kt) {
        bf16x8 bfr;
#pragma unroll
        for (int q = 0; q < 8; ++q) bfr[q] = (short)sK[(ks * 16 + 8 * hh + q) * 66 + kt * 32 + l31];
        acc[kt] = MFMA32(af, bfr, acc[kt]);
      }
    }
#pragma unroll
    for (int kt = 0; kt < 2; ++kt)
#pragma unroll
      for (int i = 0; i < 16; ++i) p.MC[uu * 4096 + (size_t)(vt * 32 + (i & 3) + 8 * (i >> 2) + 4 * hh) * 64 + kt * 32 + l31] = acc[kt][i];
    float nl = 0.f;
    for (int q = 0; q < 32; ++q) { const int l = hh * 32 + q; nl += sW[d * 64 + l] * bf2f(sK[l * 66 + vt * 32 + l31]); }
    nl = xor_sum<32>(nl);
    if (hh == 0) p.MN[uu * 64 + vt * 32 + l31] = nl;
    __syncthreads();
  }
}
DI void ph_ml_scan(const Params& p, int bid, int nblk) {
  for (long gi = (long)bid * NTHR + TIDX; gi < (long)NB * 2 * 4 * 4160; gi += (long)nblk * NTHR) {
    const int e = (int)(gi % 4160), ch = (int)(gi / 4160), h = ch & 3, bd = ch >> 2;
    float* base = e < 4096 ? p.MC + (((size_t)bd * NCK) * 4 + h) * 4096 + e : p.MN + (((size_t)bd * NCK) * 4 + h) * 64 + (e - 4096);
    const size_t stride = e < 4096 ? 4 * 4096 : 4 * 64;
    float* mm = p.MM + (((size_t)bd * NCK) * 4 + h) * 4;
    float st = 0.f, m = -1e30f;
    float cl[8], cm[8], cb[8], nl[8], nm[8], nb[8];
#pragma unroll
    for (int q = 0; q < 8; ++q) { cl[q] = base[(size_t)q * stride]; cm[q] = mm[q * 16]; cb[q] = mm[q * 16 + 1]; }
#pragma unroll 1
    for (int jb = 0; jb < NCK; jb += 8) {
#pragma unroll
      for (int q = 0; q < 8; ++q) { const int j = jb + 8 + q; if (j < NCK) { nl[q] = base[(size_t)j * stride]; nm[q] = mm[j * 16]; nb[q] = mm[j * 16 + 1]; } }
#pragma unroll
      for (int q = 0; q < 8; ++q) {
        const int j = jb + q;
        if (j < NCK) {
          const float mn = fmaxf(cb[q] + m, cm[q]), a = expf(cb[q] + m - mn), g = expf(cm[q] - mn);
          base[(size_t)j * stride] = st;
          st = a * st + g * cl[q];
          if (e == 0) mm[j * 16 + 2] = m;
          m = mn;
        }
      }
#pragma unroll
      for (int q = 0; q < 8; ++q) { cl[q] = nl[q]; cm[q] = nm[q]; cb[q] = nb[q]; }
    }
  }
}
DI void ph_gla_scan(const Params& p, int bid, int nblk) {
  for (long gi = (long)bid * NTHR + TIDX; gi < (long)NB * 2 * 4 * 2048; gi += (long)nblk * NTHR) {
    const int e = (int)(gi % 2048), ch = (int)(gi / 2048), h = ch & 3, bd = ch >> 2, k = e & 31;
    float* base = p.GS + (((size_t)bd * NCK) * 4 + h) * 2048 + e;
    const float* ge = p.GC + ((size_t)bd * TK + 63) * 128 + h * 32 + k;
    float st = 0.f;
    float cl[8], cg[8], nl[8], ng[8];
#pragma unroll
    for (int q = 0; q < 8; ++q) { cl[q] = base[(size_t)q * 4 * 2048]; cg[q] = ge[(size_t)q * 64 * 128]; }
#pragma unroll 1
    for (int jb = 0; jb < NCK; jb += 8) {
#pragma unroll
      for (int q = 0; q < 8; ++q) { const int j = jb + 8 + q; if (j < NCK) { nl[q] = base[(size_t)j * 4 * 2048]; ng[q] = ge[(size_t)j * 64 * 128]; } }
#pragma unroll
      for (int q = 0; q < 8; ++q) {
        const int j = jb + q;
        if (j < NCK) { base[(size_t)j * 4 * 2048] = st; st = expf(cg[q]) * st + cl[q]; }
      }
#pragma unroll
      for (int q = 0; q < 8; ++q) { cl[q] = nl[q]; cg[q] = ng[q]; }
    }
  }
}
constexpr int MO_K = 0, MO_V = 64 * 144, MO_A = MO_V + 64 * VROW, MO_PM = MO_A + 512, MO_N0 = MO_PM + 512, MO_X = MO_N0 + 512, MO_LDS = MO_X + 16384;
DI void ph_ml_out(const Params& p, int layer, int need_ctx, char* lds, int bid, int nblk) {
  float* sA = (float*)(lds + MO_A); float* sPM = (float*)(lds + MO_PM); float* sN0 = (float*)(lds + MO_N0); float* sX = (float*)(lds + MO_X);
  const int t = TIDX, lane = t & 63, wid = t >> 6, l31 = lane & 31, hh = lane >> 5;
  const int lt = wid & 1, d = wid >> 1;
#pragma unroll 1
  for (int u = bid; u < (need_ctx ? SCAN_UNITS : SCAN_LAT_UNITS); u += nblk) {
    int b, c, h; scan_unit(u, b, c, h);
    {
      const int row = t >> 2, seg = (t & 3) * 16;
      const bf16_t* ks = p.MK + ((size_t)b * TK + 64 * c + row) * 256 + h * 64 + seg;
      sts16(lds + MO_K + row * 144 + seg * 2, ldg16(ks)); sts16(lds + MO_K + row * 144 + seg * 2 + 16, ldg16(ks + 8));
      const bf16_t* vs = p.MVt + (((size_t)b * 4 + h) * 64 + row) * TK + 64 * c + seg;
      const u32x4 v0 = ldg16(vs), v1 = ldg16(vs + 8);
      u32x2* dv = (u32x2*)(lds + MO_V + row * VROW + seg * 2);
      u32x2 q; q.x = v0.x; q.y = v0.y; dv[0] = q; q.x = v0.z; q.y = v0.w; dv[1] = q; q.x = v1.x; q.y = v1.y; dv[2] = q; q.x = v1.z; q.y = v1.w; dv[3] = q;
    }
    if (t < 128) {
      const int dd = t >> 6, s = t & 63, j = step_of(dd, c), pos = dd ? 63 - s : s;
      const size_t o = (((size_t)b * 2 + dd) * TK + 64 * j) * 4 + h;
      sA[dd * 64 + s] = p.IGS[o + pos * 4] - p.BC[o + pos * 4];
      const size_t uu = (((size_t)b * 2 + dd) * NCK + j) * 4 + h;
      sN0[dd * 64 + s] = p.MN[uu * 64 + s];
    }
    __syncthreads();
    if (t < 2) {
      float m = -1e30f;
      if (t == 0) { for (int s = 0; s < 64; ++s) { m = fmaxf(m, sA[s]); sPM[s] = m; } }
      else { for (int s = 63; s >= 0; --s) { m = fmaxf(m, sA[64 + s]); sPM[64 + s] = m; } }
    }
    __syncthreads();
    const int j = step_of(d, c);
    const size_t uu = (((size_t)b * 2 + d) * NCK + j) * 4 + h;
    const int l = lt * 32 + l31, pos = d ? 63 - l : l;
    const float bl = p.BC[(((size_t)b * 2 + d) * TK + 64 * j + pos) * 4 + h];
    const float inter = bl + p.MM[uu * 4 + 2];
    const float mt = fmaxf(inter, bl + sPM[d * 64 + l]);
    const float aint = expf(inter - mt);
    bf16x8 qf[4];
#pragma unroll
    for (int ks = 0; ks < 4; ++ks) qf[ks] = *(const bf16x8*)(p.MQ + ((size_t)b * TK + 64 * c + l) * 256 + h * 64 + ks * 16 + 8 * hh);
    f32x16 num[2]; num[0] = (f32x16)(0.f); num[1] = (f32x16)(0.f);
    float den = 0.f;
#pragma unroll
    for (int st = 0; st < 2; ++st) {
      if (d == 0 ? st <= lt : st >= lt) {
        f32x16 S = (f32x16)(0.f);
#pragma unroll
        for (int ks = 0; ks < 4; ++ks) S = MFMA32(lds_frag(lds + MO_K + (st * 32 + l31) * 144 + (ks * 16 + 8 * hh) * 2), qf[ks], S);
#pragma unroll
        for (int i = 0; i < 16; ++i) {
          const int s = st * 32 + (i & 3) + 8 * (i >> 2) + 4 * hh;
          const bool ok = d == 0 ? s <= l : s >= l;
          const float e = ok ? fast_exp2((bl + sA[d * 64 + s] - mt) * LOG2E) * S[i] : 0.f;
          S[i] = e; den += e;
        }
#pragma unroll
        for (int kst = 0; kst < 2; ++kst) {
          const bf16x8 pf = pack8(S, kst);
#pragma unroll
          for (int vt = 0; vt < 2; ++vt) {
            const char* vp = lds + MO_V + (vt * 32 + l31) * VROW + (st * 32 + kst * 16 + 4 * hh) * 2;
            const s16x4 lo = *(const s16x4*)vp, hi = *(const s16x4*)(vp + 16);
            num[vt] = MFMA32(__builtin_shufflevector(lo, hi, 0, 1, 2, 3, 4, 5, 6, 7), pf, num[vt]);
          }
        }
      }
    }
    f32x16 accI[2]; accI[0] = (f32x16)(0.f); accI[1] = (f32x16)(0.f);
#pragma unroll
    for (int vt = 0; vt < 2; ++vt)
#pragma unroll
      for (int ks = 0; ks < 4; ++ks) accI[vt] = MFMA32(cvt8(p.MC + uu * 4096 + (size_t)(vt * 32 + l31) * 64 + ks * 16 + 8 * hh), qf[ks], accI[vt]);
    float qn = 0.f;
#pragma unroll
    for (int ks = 0; ks < 4; ++ks)
#pragma unroll
      for (int q = 0; q < 8; ++q) qn += bf2f((bf16_t)qf[ks][q]) * sN0[d * 64 + ks * 16 + 8 * hh + q];
    den = xor_sum<32>(den + aint * qn);
    const float inv = 1.0f / fmaxf(fabsf(den), expf(-mt));
#pragma unroll
    for (int vt = 0; vt < 2; ++vt)
#pragma unroll
      for (int i = 0; i < 16; ++i) num[vt][i] = (num[vt][i] + aint * accI[vt][i]) * inv;
    if (d == 1) {
#pragma unroll
      for (int vt = 0; vt < 2; ++vt)
#pragma unroll
        for (int i = 0; i < 16; ++i) sX[(lt * 32 + vt * 16 + i) * 64 + lane] = num[vt][i];
    }
    __syncthreads();
    if (d == 0) {
      float ss = 0.f;
#pragma unroll
      for (int vt = 0; vt < 2; ++vt)
#pragma unroll
        for (int i = 0; i < 16; ++i) { num[vt][i] += sX[(lt * 32 + vt * 16 + i) * 64 + lane]; ss += num[vt][i] * num[vt][i]; }
      ss = xor_sum<32>(ss);
      const float rstd = 1.0f / sqrtf(ss * (1.0f / 64) + 1e-6f);
      const int r = row_of(b, 64 * c + l);
#pragma unroll
      for (int vt = 0; vt < 2; ++vt)
#pragma unroll
        for (int g = 0; g < 4; ++g) {
          const int v0 = vt * 32 + 8 * g + 4 * hh;
          const u32x2 ou = *(const u32x2*)(p.Z + (size_t)r * NZP + ZC_MLO + h * 64 + v0);
          const f32x4 gv = *(const f32x4*)(p.g_mlstm_out + layer * 256 + h * 64 + v0);
          const float o0 = u2f(ou.x << 16), o1 = u2f(ou.x & 0xffff0000u), o2 = u2f(ou.y << 16), o3 = u2f(ou.y & 0xffff0000u);
          f32x4 y = {sigmoidf_(o0) * num[vt][4 * g] * rstd * gv[0], sigmoidf_(o1) * num[vt][4 * g + 1] * rstd * gv[1],
                     sigmoidf_(o2) * num[vt][4 * g + 2] * rstd * gv[2], sigmoidf_(o3) * num[vt][4 * g + 3] * rstd * gv[3]};
          st_bf16x4(p.Y + (size_t)r * D + 256 + h * 64 + v0, y);
        }
    }
    __syncthreads();
  }
}
DI void ph_gla_local(const Params& p, char* lds, int bid, int nblk) {
  bf16_t* sKd = (bf16_t*)lds;
  const int t = TIDX, lane = t & 63, wid = t >> 6, l31 = lane & 31, hh = lane >> 5;
  const int d = wid & 1, vt = wid >> 1;
#pragma unroll 1
  for (int u = bid; u < SCAN_UNITS; u += nblk) {
    int b, c, h; scan_unit(u, b, c, h);
    {
      const int dd = t >> 7, l = (t >> 1) & 63, k0 = (t & 1) * 16, j = step_of(dd, c), pos = dd ? 63 - l : l;
      const float* gcr = p.GC + (((size_t)b * 2 + dd) * TK + 64 * j + pos) * 128 + h * 32 + k0;
      const float* ger = p.GC + (((size_t)b * 2 + dd) * TK + 64 * j + 63) * 128 + h * 32 + k0;
      const bf16_t* kr = p.Z + (size_t)row_of(b, 64 * c + l) * NZP + ZC_GK + h * 32 + k0;
#pragma unroll
      for (int q = 0; q < 16; ++q) sKd[(dd * 64 + l) * 33 + k0 + q] = f2bf(bf2f(kr[q]) * fast_exp2((ger[q] - gcr[q]) * LOG2E));
    }
    __syncthreads();
    const int j = step_of(d, c);
    const size_t uu = (((size_t)b * 2 + d) * NCK + j) * 4 + h;
    f32x16 acc = (f32x16)(0.f);
    const bf16_t* vsrc = p.GVt + (((size_t)b * 4 + h) * 64 + vt * 32 + l31) * TK + 64 * c;
#pragma unroll
    for (int ks = 0; ks < 4; ++ks) {
      const bf16x8 af = *(const bf16x8*)(vsrc + ks * 16 + 8 * hh);
      bf16x8 bfr;
#pragma unroll
      for (int q = 0; q < 8; ++q) bfr[q] = (short)sKd[(d * 64 + ks * 16 + 8 * hh + q) * 33 + l31];
      acc = MFMA32(af, bfr, acc);
    }
#pragma unroll
    for (int i = 0; i < 16; ++i) p.GS[uu * 2048 + (size_t)(vt * 32 + (i & 3) + 8 * (i >> 2) + 4 * hh) * 32 + l31] = acc[i];
    __syncthreads();
  }
}
constexpr int GO_Q = 0, GO_K = 2 * 64 * 80, GO_V = 2 * GO_K, GO_X = GO_V + 64 * VROW, GO_LDS = GO_X + 16384;
DI void ph_gla_out(const Params& p, int layer, int need_ctx, char* lds, int bid, int nblk) {
  float* sX = (float*)(lds + GO_X);
  const int t = TIDX, lane = t & 63, wid = t >> 6, l31 = lane & 31, hh = lane >> 5;
  const int lt = wid & 1, d = wid >> 1;
#pragma unroll 1
  for (int u = bid; u < (need_ctx ? SCAN_UNITS : SCAN_LAT_UNITS); u += nblk) {
    int b, c, h; scan_unit(u, b, c, h);
    {
      const int dd = t >> 7, l = (t >> 1) & 63, k0 = (t & 1) * 16, j = step_of(dd, c), pos = dd ? 63 - l : l;
      const float* gcr = p.GC + (((size_t)b * 2 + dd) * TK + 64 * j + pos) * 128 + h * 32 + k0;
      const bf16_t* zr = p.Z + (size_t)row_of(b, 64 * c + l) * NZP;
      bf16_t* qd = (bf16_t*)(lds + GO_Q + (dd * 64 + l) * 80) + k0; bf16_t* kd = (bf16_t*)(lds + GO_K + (dd * 64 + l) * 80) + k0;
#pragma unroll
      for (int q = 0; q < 16; ++q) {
        const float g = gcr[q];
        qd[q] = f2bf(bf2f(zr[ZC_GQ + h * 32 + k0 + q]) * 0.17677669529663687f * fast_exp2(g * LOG2E));
        kd[q] = f2bf(bf2f(zr[ZC_GK + h * 32 + k0 + q]) * fast_exp2(-g * LOG2E));
      }
      const int row = t >> 2, seg = (t & 3) * 16;
      const bf16_t* vs = p.GVt + (((size_t)b * 4 + h) * 64 + row) * TK + 64 * c + seg;
      const u32x4 v0 = ldg16(vs), v1 = ldg16(vs + 8);
      u32x2* dv = (u32x2*)(lds + GO_V + row * VROW + seg * 2);
      u32x2 q2; q2.x = v0.x; q2.y = v0.y; dv[0] = q2; q2.x = v0.z; q2.y = v0.w; dv[1] = q2; q2.x = v1.x; q2.y = v1.y; dv[2] = q2; q2.x = v1.z; q2.y = v1.w; dv[3] = q2;
    }
    __syncthreads();
    const int j = step_of(d, c);
    const size_t uu = (((size_t)b * 2 + d) * NCK + j) * 4 + h;
    const int l = lt * 32 + l31;
    bf16x8 qf[2];
#pragma unroll
    for (int ks = 0; ks < 2; ++ks) qf[ks] = lds_frag(lds + GO_Q + (d * 64 + l) * 80 + (ks * 16 + 8 * hh) * 2);
    f32x16 O[2]; O[0] = (f32x16)(0.f); O[1] = (f32x16)(0.f);
#pragma unroll
    for (int st = 0; st < 2; ++st) {
      if (d == 0 ? st <= lt : st >= lt) {
        f32x16 S = (f32x16)(0.f);
#pragma unroll
        for (int ks = 0; ks < 2; ++ks) S = MFMA32(lds_frag(lds + GO_K + (d * 64 + st * 32 + l31) * 80 + (ks * 16 + 8 * hh) * 2), qf[ks], S);
#pragma unroll
        for (int i = 0; i < 16; ++i) {
          const int s = st * 32 + (i & 3) + 8 * (i >> 2) + 4 * hh;
          const bool ok = d == 0 ? s <= l : s >= l;
          S[i] = ok ? S[i] : 0.f;
        }
#pragma unroll
        for (int kst = 0; kst < 2; ++kst) {
          const bf16x8 pf = pack8(S, kst);
#pragma unroll
          for (int vt = 0; vt < 2; ++vt) {
            const char* vp = lds + GO_V + (vt * 32 + l31) * VROW + (st * 32 + kst * 16 + 4 * hh) * 2;
            const s16x4 lo = *(const s16x4*)vp, hi = *(const s16x4*)(vp + 16);
            O[vt] = MFMA32(__builtin_shufflevector(lo, hi, 0, 1, 2, 3, 4, 5, 6, 7), pf, O[vt]);
          }
        }
      }
    }
#pragma unroll
    for (int vt = 0; vt < 2; ++vt)
#pragma unroll
      for (int ks = 0; ks < 2; ++ks) O[vt] = MFMA32(cvt8(p.GS + uu * 2048 + (size_t)(vt * 32 + l31) * 32 + ks * 16 + 8 * hh), qf[ks], O[vt]);
    if (d == 1) {
#pragma unroll
      for (int vt = 0; vt < 2; ++vt)
#pragma unroll
        for (int i = 0; i < 16; ++i) sX[(lt * 32 + vt * 16 + i) * 64 + lane] = O[vt][i];
    }
    __syncthreads();
    if (d == 0) {
      float ss = 0.f;
#pragma unroll
      for (int vt = 0; vt < 2; ++vt)
#pragma unroll
        for (int i = 0; i < 16; ++i) { O[vt][i] += sX[(lt * 32 + vt * 16 + i) * 64 + lane]; ss += O[vt][i] * O[vt][i]; }
      ss = xor_sum<32>(ss);
      const float rstd = 1.0f / sqrtf(ss * (1.0f / 64) + 1e-6f);
      const int r = row_of(b, 64 * c + l);
#pragma unroll
      for (int vt = 0; vt < 2; ++vt)
#pragma unroll
        for (int g = 0; g < 4; ++g) {
          const int v0 = vt * 32 + 8 * g + 4 * hh;
          const u32x2 ru = *(const u32x2*)(p.Z + (size_t)r * NZP + ZC_GR + h * 64 + v0);
          const f32x4 gv = *(const f32x4*)(p.g_gla_out + layer * 256 + h * 64 + v0);
          const float r0 = u2f(ru.x << 16), r1 = u2f(ru.x & 0xffff0000u), r2 = u2f(ru.y << 16), r3 = u2f(ru.y & 0xffff0000u);
          f32x4 y = {siluf_(r0) * O[vt][4 * g] * rstd * gv[0], siluf_(r1) * O[vt][4 * g + 1] * rstd * gv[1],
                     siluf_(r2) * O[vt][4 * g + 2] * rstd * gv[2], siluf_(r3) * O[vt][4 * g + 3] * rstd * gv[3]};
          st_bf16x4(p.Y + (size_t)r * D + 512 + h * 64 + v0, y);
        }
    }
    __syncthreads();
  }
}

DI float fast_logsigmoid(float x) {
  const float e = fast_exp2(-fabsf(x) * LOG2E);
#ifdef CPU_EMU
  return fminf(x, 0.f) - log1pf(e);
#else
  return fminf(x, 0.f) - 0.6931471805599453f * __builtin_amdgcn_logf(1.0f + e);
#endif
}
DI float wave_incl_scan(float v, int lane) {
#pragma unroll
  for (int dd = 1; dd < 64; dd <<= 1) { const float o = u2f((unsigned)lane_up((int)f2u(v), dd, lane)); if (lane >= dd) v += o; }
  return v;
}
constexpr int GCUM_LDS = 4 * 64 * 33 * 4;
DI void ph_gates_cum(const Params& p, int layer, char* lds, int bid, int nblk) {
  const int t = TIDX, lane = t & 63, wid = t >> 6;
  float* stg = (float*)lds + wid * 64 * 33;
  const float* wal = p.w_alpha2 + (size_t)layer * 2 * 16 * 128;
#pragma unroll 1
  for (int u = bid * 4 + wid; u < NB * 2 * NCK; u += nblk * 4) {
    const int j = u % NCK, d = (u / NCK) & 1, b = u / (2 * NCK);
    const int pp = 64 * j + lane, s = seq_of(d, pp);
    const bf16_t* z = p.Z + (size_t)row_of(b, s) * NZP;
    const size_t ob = ((size_t)b * 2 + d) * TK + pp;
    {
      const u32x2 iu = *(const u32x2*)(z + ZC_MLIG + d * 4), fu = *(const u32x2*)(z + ZC_MLFG + d * 4);
      const float ig[4] = {u2f(iu.x << 16), u2f(iu.x & 0xffff0000u), u2f(iu.y << 16), u2f(iu.y & 0xffff0000u)};
      const float fg[4] = {u2f(fu.x << 16), u2f(fu.x & 0xffff0000u), u2f(fu.y << 16), u2f(fu.y & 0xffff0000u)};
      f32x4 oc, oi;
#pragma unroll
      for (int h = 0; h < 4; ++h) {
        oi[h] = ig[h] + p.b_igate[layer * 8 + d * 4 + h];
        oc[h] = wave_incl_scan(fast_logsigmoid(fg[h] + p.b_fgate[layer * 8 + d * 4 + h]), lane);
      }
      *(f32x4*)(p.BC + ob * 4) = oc; *(f32x4*)(p.IGS + ob * 4) = oi;
    }
    float a[16];
    { float f0[8], f1[8]; unpack8(ldg16(z + ZC_GA + d * 16), f0); unpack8(ldg16(z + ZC_GA + d * 16 + 8), f1);
#pragma unroll
      for (int q = 0; q < 8; ++q) { a[q] = f0[q]; a[8 + q] = f1[q]; } }
    const float* W = wal + (size_t)d * 16 * 128;
#pragma unroll 1
    for (int cg = 0; cg < 4; ++cg) {
#pragma unroll 4
      for (int c = 0; c < 32; ++c) {
        const int ch = cg * 32 + c;
        float zg = p.b_alpha[layer * 256 + d * 128 + ch];
#pragma unroll
        for (int q = 0; q < 16; ++q) zg += a[q] * W[q * 128 + ch];
        stg[lane * 33 + c] = wave_incl_scan(fast_logsigmoid(zg) * (1.0f / 16.0f), lane);
      }
      WAVE_SYNC();
#pragma unroll
      for (int k = 0; k < 32; ++k) { const int pos = k * 2 + (lane >> 5), c = lane & 31; p.GC[(((size_t)b * 2 + d) * TK + 64 * j + pos) * 128 + cg * 32 + c] = stg[pos * 33 + c]; }
      WAVE_SYNC();
    }
  }
}
#define XB_TMO      128
#define XB_XCNT(j)  (256  + 64 * (j))
#define XB_XSUB(j)  (1280 + 64 * (j))
#define XB_XGEN(j)  (2304 + 64 * (j))
#define XB_TOP      3328
#define XB_TOPGEN   3392
#define XCD_BAR_WORDS 3456
#define XB_SPIN_CAP (1u << 28)
#define LAS __attribute__((address_space(3)))

__device__ __forceinline__ unsigned xb_ld(unsigned* p)              { return __hip_atomic_load(p, __ATOMIC_RELAXED, __HIP_MEMORY_SCOPE_AGENT); }
__device__ __forceinline__ unsigned xb_add(unsigned* p, unsigned v) { return __hip_atomic_fetch_add(p, v, __ATOMIC_RELAXED, __HIP_MEMORY_SCOPE_AGENT); }
__device__ __forceinline__ unsigned xb_xcc_id() { return (unsigned)__builtin_amdgcn_s_getreg((3 << 11) | 20) & 0xFu; }
#define XB_SPIN(cond, bar) do { unsigned _sp = 0; while (cond) { __builtin_amdgcn_s_sleep(1); \
    if ((++_sp & 255u) == 0u) { if (xb_ld(&(bar)[XB_TMO])) break; if (_sp > XB_SPIN_CAP) { atomicAdd(&(bar)[XB_TMO], 1u); break; } } } } while (0)

struct XcdBarrier {
    unsigned* bar; unsigned x;
    volatile LAS unsigned* st;
};

__device__ __forceinline__ XcdBarrier xcd_barrier_post(unsigned* bar, volatile LAS unsigned* st) {
    XcdBarrier b; b.bar = bar; b.x = xb_xcc_id(); b.st = st;
    if (threadIdx.x == 0) (void)xb_add(&bar[XB_XCNT(b.x)], 1u);
    return b;
}
__device__ __forceinline__ void xcd_barrier_complete(unsigned* bar, unsigned x, unsigned& nloc, unsigned& nx) {
    const unsigned G = gridDim.x * gridDim.y * gridDim.z;
    unsigned sum, cnt, mine, sp = 0u;
    for (;;) {
        sum = 0u; cnt = 0u; mine = 0u;
#pragma unroll
        for (unsigned j = 0; j < 16; ++j) { const unsigned c = xb_ld(&bar[XB_XCNT(j)]); sum += c; cnt += (c > 0u) ? 1u : 0u; mine = (j == x) ? c : mine; }
        if (sum == G) break;
        __builtin_amdgcn_s_sleep(1);
        if ((++sp & 255u) == 0u) { if (xb_ld(&bar[XB_TMO])) break; if (sp > XB_SPIN_CAP) { atomicAdd(&bar[XB_TMO], 1u); break; } }
    }
    nloc = mine > 0u ? mine : 1u; nx = cnt > 0u ? cnt : 1u;
}

__device__ __forceinline__ void xcd_barrier(const XcdBarrier& b) {
    asm volatile("s_waitcnt vmcnt(0)" ::: "memory");
    __syncthreads();
    if (threadIdx.x == 0) {
        unsigned* bar = b.bar;
        __builtin_amdgcn_s_waitcnt(0);
        unsigned nloc = b.st[0], nx = b.st[1];
        if (nloc == 0u) { xcd_barrier_complete(bar, b.x, nloc, nx); b.st[0] = nloc; b.st[1] = nx; }
        const unsigned old = xb_add(&bar[XB_XSUB(b.x)], 1u);
        const unsigned gen = old / nloc;
        if (old + 1u == (gen + 1u) * nloc) {
            __builtin_amdgcn_fence(__ATOMIC_RELEASE, "agent");
            asm volatile("s_waitcnt vmcnt(0)" ::: "memory");
            const unsigned og = xb_add(&bar[XB_TOP], 1u);
            const unsigned tg = og / nx;
            if (og + 1u == (tg + 1u) * nx) xb_add(&bar[XB_TOPGEN], 1u);
            else XB_SPIN(xb_ld(&bar[XB_TOPGEN]) == tg, bar);
            __builtin_amdgcn_fence(__ATOMIC_ACQUIRE, "agent");
            xb_add(&bar[XB_XGEN(b.x)], 1u);
            asm volatile("s_waitcnt vmcnt(0)" ::: "memory");
        } else {
            XB_SPIN(xb_ld(&bar[XB_XGEN(b.x)]) == gen, bar);
            __builtin_amdgcn_fence(__ATOMIC_ACQUIRE, "agent");
            asm volatile("s_waitcnt vmcnt(0)" ::: "memory");
        }
    }
    __syncthreads();
}

#define GS_LOOP(N, CALL) for (long gi = (long)bid * NTHR + TIDX; gi < (long)(N); gi += (long)nblk * NTHR) { CALL; }
#ifndef PROBE
#define PROBE 0
#endif
#ifndef PROBE_MASK
#define PROBE_MASK 0
#endif
#ifndef FAST_SCAN
#define FAST_SCAN 1
#endif
constexpr int N_PHASES = 16;
constexpr int MEGA_LDS = GEMM_LDS > TOPK_LDS ? GEMM_LDS : TOPK_LDS;

template <int PH>
DI void run_phase(const Params& p, int l, char* lds, int bid, int nblk) {
  const int need_ctx = (l == 0);
  const int rows = need_ctx ? R : RL;
  const float* xl_in = l == 0 ? p.x : p.out;
  const float* xc_in = l == 0 ? p.ctx : p.xc;
  bf16_t* QRAW = p.YO; bf16_t* KVRAW = p.YO + (size_t)R * 384;
  if constexpr (PH == 0) {
    ph_mods(p, lds, bid, nblk);
#pragma unroll 1
    for (int ll = 0; ll < 2; ++ll) {
      ph_wt(p.w_in + (size_t)ll * D * NZ, p.Wt_in + ll * WSZ_IN, D, NZ, NZP, 1, 0L, 0L, nullptr, lds, bid, nblk);
      ph_wt(p.w_gate + (size_t)ll * D * 4096, p.Wt_gate + ll * WSZ_GATE, D, 4096, 4096, 1, 0L, 0L, nullptr, lds, bid, nblk);
      ph_wt(p.w_branch + (size_t)ll * 4 * 256 * D, p.Wt_branch + ll * WSZ_BR, 256, D, D, 4, (long)256 * D, (long)D * 256, nullptr, lds, bid, nblk);
      ph_wt(p.w_out + (size_t)ll * D * D, p.Wt_out + ll * WSZ_OUT, D, D, D, 1, 0L, 0L, nullptr, lds, bid, nblk);
      ph_wt(p.w_uq + (size_t)ll * 256 * 384, p.Wt_uq + ll * WSZ_UQ, 256, 384, 384, 1, 0L, 0L, p.g_q_lat + ll * 256, lds, bid, nblk);
      ph_wt(p.w_ukv + (size_t)ll * 128 * 512, p.Wt_ukv + ll * WSZ_UKV, 128, 512, 512, 1, 0L, 0L, p.g_kv_lat + ll * 128, lds, bid, nblk);
    }
  } else if constexpr (PH == 1) {
    ph_modulate(p, l, xl_in, xc_in, bid, nblk);
  } else if constexpr (PH == 2) {
    ph_gemm_plain(p.H, D, p.Wt_in + l * WSZ_IN, D, R, NZP, D, p.Z, NZP, lds, bid, nblk);
#if PROBE == 63
    ph_gemm_probe<3>(p.H, D, p.Wt_in + l * WSZ_IN, D, R, NZP, D, p.mods + 40000, lds, bid, nblk);
#elif PROBE == 66
    ph_gemm_probe<6>(p.H, D, p.Wt_in + l * WSZ_IN, D, R, NZP, D, p.mods + 40000, lds, bid, nblk);
#elif PROBE == 67
    ph_gemm_plain<1>(p.H, D, p.Wt_in + l * WSZ_IN, D, R, NZP, D, p.Z, NZP, lds, bid, nblk);
#elif PROBE == 5
    ph_gemm_plain(p.H, D, p.Wt_in + l * WSZ_IN, D, R, NZP, D, p.Z, NZP, lds, bid, nblk);
#endif
  } else if constexpr (PH == 3) {
    ph_mla_up(p, l, QRAW, KVRAW, lds, bid, nblk);
  } else if constexpr (PH == 4) {
    ph_prep(p, l, QRAW, KVRAW, lds, bid, nblk);
#if PROBE == 41
    ph_prep(p, l, QRAW, KVRAW, lds, bid, nblk);
#elif PROBE == 43
    ph_prep<1>(p, l, QRAW, KVRAW, lds, bid, nblk);
#elif PROBE == 44
    ph_prep<2>(p, l, QRAW, KVRAW, lds, bid, nblk);
#endif
    __syncthreads();
    ph_gates_cum(p, l, lds, bid, nblk);
#if PROBE == 42
    ph_gates_cum(p, l, lds, bid, nblk);
#endif
  } else if constexpr (PH == 5) {
#if FAST_SCAN
    ph_ml_local(p, lds, bid, nblk);
    ph_gla_local(p, lds, bid, nblk);
#else
    GS_LOOP((long)NUNIT * 4160, nvb_ml_local(gi, p));
    GS_LOOP((long)NUNIT * 2048, nvb_gla_local(gi, p));
#endif
  } else if constexpr (PH == 6) {
#if FAST_SCAN
    ph_ml_scan(p, bid, nblk);
    ph_gla_scan(p, (bid + nblk - 260 % nblk) % nblk, nblk);
#else
    GS_LOOP((long)NB * 2 * 4 * 4160, nvb_ml_scan(gi, p));
    GS_LOOP((long)NB * 2 * 4 * 2048, nvb_gla_scan(gi, p));
#endif
    ph_attn(p, l, need_ctx, lds, bid, nblk);
#if PROBE >= 10 && PROBE < 20
    if (l == 0) ph_attn_mla_probe<PROBE - 10>(p, lds, bid, nblk);
#elif PROBE == 1
    ph_attn_diff(p, l, need_ctx, lds, bid, nblk);
#elif PROBE == 2
    ph_attn_mla(p, need_ctx, lds, bid, nblk);
#endif
  } else if constexpr (PH == 7) {
#if FAST_SCAN
    ph_ml_out(p, l, need_ctx, lds, bid, nblk);
    ph_gla_out(p, l, need_ctx, lds, bid, nblk);
#else
    GS_LOOP((long)NUNIT * 4096, nvb_ml_out(gi, p, need_ctx));
    GS_LOOP((long)NUNIT * 4096, nvb_gla_out(gi, p, need_ctx));
#endif
  } else if constexpr (PH == 8) {
#if !FAST_SCAN
    GS_LOOP((long)R * 4, nvb_ml_finish(gi, p, l, need_ctx));
    GS_LOOP((long)R * 4, nvb_gla_finish(gi, p, l, need_ctx));
#endif
  } else if constexpr (PH == 9) {
    ph_merge(p, l, rows, lds, bid, nblk);
#if PROBE == 3
    ph_merge(p, l, rows, lds, bid, nblk);
#endif
  } else if constexpr (PH == 10) {
    ph_gemm_plain(p.MG, D, p.Wt_out + l * WSZ_OUT, D, rows, D, D, p.YO, D, lds, bid, nblk);
  } else if constexpr (PH == 11) {
    ph_resid_mix(p, l, xl_in, xc_in, rows, lds, bid, nblk);
  } else if constexpr (PH == 12) {
    ph_topk(p, need_ctx, lds, bid, nblk);
    ph_wt(p.w_e_gate + (size_t)l * NE * D * FF, p.Wt_eg, D, FF, FF, NE, (long)D * FF, (long)FF * D, nullptr, lds, bid, nblk);
    ph_wt(p.w_e_up + (size_t)l * NE * D * FF, p.Wt_eu, D, FF, FF, NE, (long)D * FF, (long)FF * D, nullptr, lds, bid, nblk);
    ph_wt(p.w_e_down + (size_t)l * NE * FF * D, p.Wt_ed, FF, D, D, NE, (long)FF * D, (long)D * FF, nullptr, lds, bid, nblk);
  } else if constexpr (PH == 13) {
    ph_moe1(p, need_ctx, lds, bid, nblk);
#if PROBE == 4
    ph_moe1(p, need_ctx, lds, bid, nblk);
#endif
  } else if constexpr (PH == 14) {
    ph_moe2(p, need_ctx, lds, bid, nblk);
#if PROBE == 4
    ph_moe2(p, need_ctx, lds, bid, nblk);
#endif
  } else if constexpr (PH == 15) {
    ph_resid_ffn(p, l, rows, bid, nblk);
  }
}

template <int PH> __global__ void __launch_bounds__(256, 2) k_phase(Params p, int l) {
  DYN_LDS(lds);
  run_phase<PH>(p, l, lds, blockIdx.x, gridDim.x);
}

#if !defined(CPU_EMU) && !MK_MULTI
typedef const Params __attribute__((address_space(4)))* KParams;
DI KParams kp_fresh() { KParams k = (KParams)__builtin_amdgcn_kernarg_segment_ptr(); asm volatile("" : "+s"(k)); return k; }
#define PHASE(PH, L) do { asm volatile("; PHASE_MARK " #PH); KParams k_ = kp_fresh(); run_phase<PH>(*(const Params*)k_, (L), lds, bid, nblk); if (PROBE == 20 + PH || ((PROBE_MASK >> PH) & 1) || (PROBE == 100 + PH && (L) == 0) || (PROBE == 99 && (PH == 4 || PH == 5))) { __syncthreads(); run_phase<PH>(*(const Params*)k_, (L), lds, bid, nblk); } XcdBarrier b_ = bar; asm volatile("" : "+s"(b_.bar), "+s"(b_.x)); xcd_barrier(b_); if (PROBE == 50) xcd_barrier(b_); } while (0)
__global__ void __launch_bounds__(256, 2) k_mega(Params pv) {
  DYN_LDS(lds_all);
  if (threadIdx.x == 0) *(uint4*)lds_all = make_uint4(0u, 0u, 0u, 0u);
  __syncthreads();
  XcdBarrier bar = xcd_barrier_post(pv.bar, (volatile LAS unsigned*)lds_all);
  char* lds = lds_all + 256;
  const int bid = blockIdx.x, nblk = gridDim.x;
  PHASE(0, 0);
#pragma unroll 1
  for (int l = 0; l < 2; ++l) {
    PHASE(1, l); PHASE(2, l); PHASE(3, l); PHASE(4, l); PHASE(5, l); PHASE(6, l); PHASE(7, l);
#if !FAST_SCAN
    PHASE(8, l);
#endif

    PHASE(9, l); PHASE(10, l); PHASE(11, l); PHASE(12, l); PHASE(13, l); PHASE(14, l); PHASE(15, l);
  }
}
#endif
#ifdef CPU_EMU
void emu_check(const Params& p, int layer, int stage);
#define EMU_CHECK(stg) emu_check(p, l, stg)
static int g_nlayers = getenv("NLAYERS") ? atoi(getenv("NLAYERS")) : 2;
#else
#define EMU_CHECK(stg)
#endif
static void fill_params(Params& p, void* const* d_in, void* d_out, void* d_ws) {
  const float** f = (const float**)&p;
  for (int i = 0; i < 33; ++i) f[i] = (const float*)d_in[i];
  p.out = (float*)d_out;
  map_workspace(p, (char*)d_ws);
}
#define LAUNCH_PHASE(PH, L) LAUNCH((k_phase<PH>), grid, 256, MEGA_LDS, stream, p, L)

extern "C" void kernel_launch(void* const* d_in, const int* in_sizes, int n_in, void* d_out, int out_size, void* d_ws,
                              size_t ws_size, hipStream_t stream) {
  Params p{};
  fill_params(p, d_in, d_out, d_ws);
  if (p.ws_need > ws_size) return;
#ifdef CPU_EMU
  const int grid = 16;
  LAUNCH_PHASE(0, 0);
  for (int l = 0; l < g_nlayers; ++l) {
    LAUNCH_PHASE(1, l); LAUNCH_PHASE(2, l); LAUNCH_PHASE(3, l); LAUNCH_PHASE(4, l); LAUNCH_PHASE(5, l); LAUNCH_PHASE(6, l); LAUNCH_PHASE(7, l); LAUNCH_PHASE(8, l);
    EMU_CHECK(1);
    LAUNCH_PHASE(9, l); LAUNCH_PHASE(10, l); LAUNCH_PHASE(11, l);
    EMU_CHECK(2);
    LAUNCH_PHASE(12, l); LAUNCH_PHASE(13, l); LAUNCH_PHASE(14, l); LAUNCH_PHASE(15, l);
    EMU_CHECK(3);
  }
#else
  static int grid = 0;
  if (grid == 0) {
    int dev = 0, cus = 0, per_cu = 0;
    (void)hipGetDevice(&dev);
    (void)hipDeviceGetAttribute(&cus, hipDeviceAttributeMultiprocessorCount, dev);
#if MK_MULTI
    (void)hipFuncSetAttribute((const void*)k_phase<0>, hipFuncAttributeMaxDynamicSharedMemorySize, MEGA_LDS);
    (void)hipFuncSetAttribute((const void*)k_phase<1>, hipFuncAttributeMaxDynamicSharedMemorySize, MEGA_LDS);
    (void)hipFuncSetAttribute((const void*)k_phase<2>, hipFuncAttributeMaxDynamicSharedMemorySize, MEGA_LDS);
    (void)hipFuncSetAttribute((const void*)k_phase<3>, hipFuncAttributeMaxDynamicSharedMemorySize, MEGA_LDS);
    (void)hipFuncSetAttribute((const void*)k_phase<4>, hipFuncAttributeMaxDynamicSharedMemorySize, MEGA_LDS);
    (void)hipFuncSetAttribute((const void*)k_phase<5>, hipFuncAttributeMaxDynamicSharedMemorySize, MEGA_LDS);
    (void)hipFuncSetAttribute((const void*)k_phase<6>, hipFuncAttributeMaxDynamicSharedMemorySize, MEGA_LDS);
    (void)hipFuncSetAttribute((const void*)k_phase<7>, hipFuncAttributeMaxDynamicSharedMemorySize, MEGA_LDS);
    (void)hipFuncSetAttribute((const void*)k_phase<8>, hipFuncAttributeMaxDynamicSharedMemorySize, MEGA_LDS);
    (void)hipFuncSetAttribute((const void*)k_phase<9>, hipFuncAttributeMaxDynamicSharedMemorySize, MEGA_LDS);
    (void)hipFuncSetAttribute((const void*)k_phase<10>, hipFuncAttributeMaxDynamicSharedMemorySize, MEGA_LDS);
    (void)hipFuncSetAttribute((const void*)k_phase<11>, hipFuncAttributeMaxDynamicSharedMemorySize, MEGA_LDS);
    (void)hipFuncSetAttribute((const void*)k_phase<12>, hipFuncAttributeMaxDynamicSharedMemorySize, MEGA_LDS);
    (void)hipFuncSetAttribute((const void*)k_phase<13>, hipFuncAttributeMaxDynamicSharedMemorySize, MEGA_LDS);
    (void)hipFuncSetAttribute((const void*)k_phase<14>, hipFuncAttributeMaxDynamicSharedMemorySize, MEGA_LDS);
    (void)hipFuncSetAttribute((const void*)k_phase<15>, hipFuncAttributeMaxDynamicSharedMemorySize, MEGA_LDS);
    grid = (cus > 0 ? cus : 256) * 2;
#else
    if (hipFuncSetAttribute((const void*)k_mega, hipFuncAttributeMaxDynamicSharedMemorySize, MEGA_LDS + 256) != hipSuccess) { grid = -1; return; }
    if (hipOccupancyMaxActiveBlocksPerMultiprocessor(&per_cu, (const void*)k_mega, 256, MEGA_LDS + 256) != hipSuccess) per_cu = 0;
    (void)hipGetLastError();
    if (per_cu < 1) { grid = -1; return; }
    grid = (cus > 0 ? cus : 256) * (per_cu < 2 ? per_cu : 2);
#endif
  }
  if (grid < 0) return;
#if MK_MULTI
  LAUNCH_PHASE(0, 0);
  for (int l = 0; l < 2; ++l) {
    LAUNCH_PHASE(1, l); LAUNCH_PHASE(2, l); LAUNCH_PHASE(3, l); LAUNCH_PHASE(4, l); LAUNCH_PHASE(5, l); LAUNCH_PHASE(6, l); LAUNCH_PHASE(7, l); LAUNCH_PHASE(8, l);
    LAUNCH_PHASE(9, l); LAUNCH_PHASE(10, l); LAUNCH_PHASE(11, l); LAUNCH_PHASE(12, l); LAUNCH_PHASE(13, l); LAUNCH_PHASE(14, l); LAUNCH_PHASE(15, l);
  }
#else
  (void)hipMemsetAsync(p.bar, 0, XCD_BAR_WORDS * sizeof(unsigned), stream);
  k_mega<<<dim3(grid), dim3(256), MEGA_LDS + 256, stream>>>(p);
#endif
#endif
}
```

```cpp
#ifndef CPU_EMU
#include <hip/hip_runtime.h>
#endif
#include <stdint.h>
#include <stddef.h>

#ifndef T_LAT
#define T_LAT 16384
#endif
#ifndef T_CTX
#define T_CTX 256
#endif

#ifndef MK_MULTI
#define MK_MULTI 0
#endif
#define DI __device__ __forceinline__
typedef unsigned short bf16_t;
typedef short bf16x8 __attribute__((ext_vector_type(8)));
typedef short s16x4 __attribute__((ext_vector_type(4)));
typedef float f32x4 __attribute__((ext_vector_type(4)));
typedef float f32x16 __attribute__((ext_vector_type(16)));
typedef unsigned u32x4 __attribute__((ext_vector_type(4)));
typedef unsigned u32x2 __attribute__((ext_vector_type(2)));
typedef float f32x2 __attribute__((ext_vector_type(2)));

#ifdef CPU_EMU
static inline float u2f(unsigned u) { float f; memcpy(&f, &u, 4); return f; }
static inline unsigned f2u(float f) { unsigned u; memcpy(&u, &f, 4); return u; }
#define MFMA32(a, b, c) emu_mfma_32x32x16((a), (b), (c))
#define MFMA16(a, b, c) emu_mfma_16x16x32((a), (b), (c))
static inline float fast_exp2(float x) { return exp2f(x); }
static inline float fast_rcp(float x) { return 1.0f / x; }
static inline float fast_rsq(float x) { return 1.0f / sqrtf(x); }
static inline float hw_sin_rev(float x) { return sinf(6.283185307179586f * x); }
static inline float hw_cos_rev(float x) { return cosf(6.283185307179586f * x); }
#define LAUNCH(kern, grid, block, lds, stream, ...) emu::launch(dim3(grid), dim3(block), (size_t)(lds), [=]() { kern(__VA_ARGS__); })
#define DYN_LDS(name) char* name = emu_dynlds()
#define SCHED_BARRIER()
#define TIDX ((int)threadIdx.x)
#define WAVE_SYNC() emu::wave_barrier()
#define SETPRIO(x)
#define IGLP_OPT()
template <int M> static inline float xor_sum(float v) { return v + __shfl_xor(v, M); }
template <int M> static inline float xor_max(float v) { return fmaxf(v, __shfl_xor(v, M)); }
template <int M> static inline int xor_sum_i(int v) { return v + __shfl_xor(v, M); }
static inline int lane_bcast(int v, int src) { return __shfl(v, src); }
static inline float lane_get(float v, int src) { return __shfl(v, src); }
static inline int lane_up(int v, int d, int lane) { (void)lane; return __shfl_up(v, d); }
#else
DI float u2f(unsigned u) { return __uint_as_float(u); }
DI unsigned f2u(float f) { return __float_as_uint(f); }
#define MFMA32(a, b, c) __builtin_amdgcn_mfma_f32_32x32x16_bf16((a), (b), (c), 0, 0, 0)
#define MFMA16(a, b, c) __builtin_amdgcn_mfma_f32_16x16x32_bf16((a), (b), (c), 0, 0, 0)
DI float fast_exp2(float x) { return __builtin_amdgcn_exp2f(x); }
DI float fast_rcp(float x) { return __builtin_amdgcn_rcpf(x); }
DI float fast_rsq(float x) { return __builtin_amdgcn_rsqf(x); }
DI float hw_sin_rev(float x) { return __builtin_amdgcn_sinf(x); }
DI float hw_cos_rev(float x) { return __builtin_amdgcn_cosf(x); }
#define LAUNCH(kern, grid, block, lds, stream, ...) kern<<<dim3(grid), dim3(block), (lds), (stream)>>>(__VA_ARGS__)
#define DYN_LDS(name) extern __shared__ __attribute__((aligned(16))) char name[]
#define SCHED_BARRIER() __builtin_amdgcn_sched_barrier(0)
DI int tid_fresh() { int t = (int)threadIdx.x; asm volatile("" : "+v"(t)); return t; }
#define TIDX tid_fresh()
#define WAVE_SYNC() __builtin_amdgcn_wave_barrier()
#define SETPRIO(x) __builtin_amdgcn_s_setprio(x)
#define IGLP_OPT() __builtin_amdgcn_iglp_opt(0)
#ifdef USE_SHFL
template <int M> DI float xor_sum(float v) { return v + __shfl_xor(v, M); }
template <int M> DI float xor_max(float v) { return fmaxf(v, __shfl_xor(v, M)); }
template <int M> DI int xor_sum_i(int v) { return v + __shfl_xor(v, M); }
DI int lane_bcast(int v, int src) { return __shfl(v, src); }
DI int lane_up(int v, int d, int lane) { (void)lane; return __shfl_up(v, d); }
#else
template <int M> DI int xor_partner_bits(int bits) { return __builtin_amdgcn_ds_swizzle(bits, (M << 10) | 0x1f); }
DI void half_swap(unsigned& a, unsigned& b) { asm volatile("s_nop 1\n\tv_permlane32_swap_b32 %0, %1\n\ts_nop 1" : "+v"(a), "+v"(b)); }
template <int M> DI float xor_sum(float v) {
  if constexpr (M < 32) return v + __builtin_bit_cast(float, xor_partner_bits<M>(__builtin_bit_cast(int, v)));
  else { unsigned a = __builtin_bit_cast(unsigned, v), b = a; half_swap(a, b); return __builtin_bit_cast(float, a) + __builtin_bit_cast(float, b); }
}
template <int M> DI float xor_max(float v) {
  if constexpr (M < 32) return fmaxf(v, __builtin_bit_cast(float, xor_partner_bits<M>(__builtin_bit_cast(int, v))));
  else { unsigned a = __builtin_bit_cast(unsigned, v), b = a; half_swap(a, b); return fmaxf(__builtin_bit_cast(float, a), __builtin_bit_cast(float, b)); }
}
template <int M> DI int xor_sum_i(int v) {
  if constexpr (M < 32) return v + xor_partner_bits<M>(v);
  else { unsigned a = (unsigned)v, b = a; half_swap(a, b); return (int)(a + b); }
}
DI int lane_bcast(int v, int src) { return __builtin_amdgcn_readlane(v, src); }
DI float lane_get(float v, int src) { return __builtin_bit_cast(float, __builtin_amdgcn_ds_bpermute(src << 2, __builtin_bit_cast(int, v))); }
DI int lane_up(int v, int d, int lane) { return __builtin_amdgcn_ds_bpermute(((lane - d) & 63) << 2, v); }
#endif
#endif

DI float bf2f(bf16_t v) { return u2f(((unsigned)v) << 16); }
#ifdef CPU_EMU
DI bf16_t f2bf(float f) { unsigned u = f2u(f); u += 0x7fffu + ((u >> 16) & 1u); return (bf16_t)(u >> 16); }
DI unsigned pack2bf(float lo, float hi) { return (unsigned)f2bf(lo) | ((unsigned)f2bf(hi) << 16); }
static inline bool wave_any(bool pr) { int v = pr ? 1 : 0; v |= __shfl_xor(v, 1); v |= __shfl_xor(v, 2); v |= __shfl_xor(v, 4); v |= __shfl_xor(v, 8); v |= __shfl_xor(v, 16); v |= __shfl_xor(v, 32); return v != 0; }
#else
typedef float f32x2_ __attribute__((ext_vector_type(2)));
typedef __bf16 bf16x2_hw __attribute__((ext_vector_type(2)));
DI unsigned pack2bf(float lo, float hi) { const f32x2_ v = {lo, hi}; return __builtin_bit_cast(unsigned, __builtin_convertvector(v, bf16x2_hw)); }
DI bf16_t f2bf(float f) { return (bf16_t)(pack2bf(f, f) & 0xffffu); }
DI bool wave_any(bool pr) { return __builtin_amdgcn_ballot_w64(pr) != 0ull; }
#endif
DI float sigmoidf_(float x) { return 1.0f / (1.0f + expf(-x)); }
DI float siluf_(float x) { return x / (1.0f + expf(-x)); }
DI float logsigmoidf_(float x) { return fminf(x, 0.0f) - log1pf(expf(-fabsf(x))); }

constexpr int D = 1024, NB = 2, TL = T_LAT, TC = T_CTX, TK = TL + TC;
constexpr int RL = NB * TL, RC = NB * TC, R = RL + RC;
constexpr int NZ = 3024, NZP = 3072;
constexpr int ZC_QLAT = 0, ZC_KVLAT = 256, ZC_KROPE = 384, ZC_MLQK = 416, ZC_MLV = 928, ZC_MLO = 1184, ZC_MLIG = 1440,
              ZC_MLFG = 1448, ZC_GQ = 1456, ZC_GK = 1584, ZC_GV = 1712, ZC_GR = 1968, ZC_GA = 2224, ZC_DQ = 2256,
              ZC_DK = 2512, ZC_DV = 2768;
constexpr int NCK = TK / 64, NCC = TC / 64, NCL = TL / 64;
constexpr int NE = 16, FF = 1408, CAPL = 2 * TL / 16, CAPC = 2 * TC / 16, CAPT = CAPL + CAPC, NSLOT = NB * CAPT;
constexpr size_t WSZ_IN = (size_t)NZP * D, WSZ_UQ = 384 * 256, WSZ_UKV = 512 * 128, WSZ_GATE = (size_t)4096 * D, WSZ_BR = (size_t)4 * D * 256, WSZ_OUT = (size_t)D * D;
constexpr int NUNIT = NB * 2 * NCK * 4;
constexpr float LOG2E = 1.4426950408889634f;
constexpr float QS_MLA = 0.10206207261596577f * LOG2E;
constexpr float QS_DIFF = 0.17677669529663687f * LOG2E;

DI int row_of(int b, int s) { return s < TC ? RL + b * TC + s : b * TL + (s - TC); }
DI void bs_of(int r, int& b, int& s) { if (r < RL) { b = r / TL; s = TC + (r % TL); } else { int q = r - RL; b = q / TC; s = q % TC; } }
DI int seq_of(int d, int p) { return d == 0 ? p : (p < TC ? TC - 1 - p : TK - 1 - (p - TC)); }
DI int step_of(int d, int c) { return d == 0 ? c : (c < NCC ? NCC - 1 - c : NCC + (NCK - 1 - c)); }

struct Params {
  const float *x, *c, *ctx, *c_ctx, *w_ada, *b_ada, *g_mix_pre, *g_mix_post, *g_ffn_pre, *g_ffn_post, *w_in, *g_q_lat, *w_uq,
      *g_kv_lat, *w_ukv, *w_conv, *b_conv, *b_igate, *b_fgate, *g_mlstm_out, *w_alpha2, *b_alpha, *g_gla_out, *diff_lambda,
      *g_diff_out, *w_branch, *w_gate, *b_gate, *w_out, *w_router, *w_e_gate, *w_e_up, *w_e_down;
  float* out;
  float *mods, *xc;
  bf16_t *H, *Z, *Qm, *Km, *Vtm, *Qd, *Kd, *Vtd, *MQ, *MK, *Y, *MG, *YO, *HID, *YE, *MVt, *GVt;
  float *BC, *IGS, *GC, *MC, *MN, *MM, *GS, *HD, *OD, *AFF, *SELV;
  int *SEL, *INV;
  bf16_t *Wt_in, *Wt_uq, *Wt_ukv, *Wt_gate, *Wt_branch, *Wt_out, *Wt_eg, *Wt_eu, *Wt_ed;
  unsigned* bar;
  size_t ws_need;
};

static inline size_t al256(size_t x) { return (x + 255) & ~(size_t)255; }
static inline void map_workspace(Params& p, char* ws) {
  size_t o = 0;
  auto take = [&](size_t bytes) { size_t r = o; o += al256(bytes); return ws + r; };
  p.bar = (unsigned*)take(16384);
  p.mods = (float*)take((size_t)2 * 3 * 6144 * 4);
  p.xc = (float*)take((size_t)RC * D * 4);
  p.BC = (float*)take((size_t)NB * 2 * TK * 4 * 4);
  p.IGS = (float*)take((size_t)NB * 2 * TK * 4 * 4);
  p.AFF = (float*)take((size_t)NB * NE * TK * 4);
  p.SEL = (int*)take((size_t)NE * NSLOT * 4);
  p.SELV = (float*)take((size_t)NE * NSLOT * 4);
  p.INV = (int*)take((size_t)R * NE * 4);
  p.MM = (float*)take((size_t)NUNIT * 4 * 4);
  p.MN = (float*)take((size_t)NUNIT * 64 * 4);
  p.Wt_in = (bf16_t*)take((size_t)2 * WSZ_IN * 2);
  p.Wt_uq = (bf16_t*)take((size_t)2 * WSZ_UQ * 2);
  p.Wt_ukv = (bf16_t*)take((size_t)2 * WSZ_UKV * 2);
  p.Wt_gate = (bf16_t*)take((size_t)2 * WSZ_GATE * 2);
  p.Wt_branch = (bf16_t*)take((size_t)2 * WSZ_BR * 2);
  p.Wt_out = (bf16_t*)take((size_t)2 * WSZ_OUT * 2);
  p.H = (bf16_t*)take((size_t)R * D * 2);
  size_t szA = (size_t)R * NZP * 2, szHID = (size_t)NE * NSLOT * FF * 2;
  char* A = take(szA > szHID ? szA : szHID);
  p.Z = (bf16_t*)A; p.HID = (bf16_t*)A;
  size_t szQm = al256((size_t)NB * 4 * TK * 96 * 2), szVt = al256((size_t)NB * 4 * 64 * TK * 2), szQd = al256((size_t)NB * 8 * TK * 32 * 2);
  size_t szB1 = 2 * szQm + 2 * szVt + 2 * szQd;
  size_t szHD = al256((size_t)2 * NB * TK * 256 * 4);
  size_t szYE = (size_t)NE * NSLOT * D * 2;
  size_t szB = szB1; if (2 * szHD > szB) szB = 2 * szHD; if (szYE > szB) szB = szYE;
  char* Bq = take(szB);
  p.Qm = (bf16_t*)Bq; p.Km = (bf16_t*)(Bq + szQm); p.Vtm = (bf16_t*)(Bq + 2 * szQm);
  p.Qd = (bf16_t*)(Bq + 2 * szQm + szVt); p.Kd = (bf16_t*)(Bq + 2 * szQm + szVt + szQd); p.Vtd = (bf16_t*)(Bq + 2 * szQm + szVt + 2 * szQd);
  p.YE = (bf16_t*)Bq;
  p.GC = (float*)take((size_t)NB * 2 * TK * 128 * 4);
  p.MVt = (bf16_t*)take((size_t)NB * 4 * 64 * TK * 2);
  p.GVt = (bf16_t*)take((size_t)NB * 4 * 64 * TK * 2);
  size_t szW = (size_t)NE * FF * D * 2;
  size_t szMC = (size_t)NUNIT * 4096 * 4, szRD = (size_t)R * D * 2;
  size_t szC = szMC; if (szRD > szC) szC = szRD; if (szW > szC) szC = szW;
  char* C = take(szC);
  p.MC = (float*)C; p.MG = (bf16_t*)C; p.Wt_eg = (bf16_t*)C;
  size_t szMQ = al256((size_t)NB * TK * 256 * 2), szGS = (size_t)NUNIT * 2048 * 4;
  size_t szD = 2 * szMQ + szGS; if (szW > szD) szD = szW;
  char* Dq = take(szD);
  p.MQ = (bf16_t*)Dq; p.MK = (bf16_t*)(Dq + szMQ); p.GS = (float*)(Dq + 2 * szMQ); p.Wt_eu = (bf16_t*)Dq;
  size_t szF = 2 * szRD > szW ? 2 * szRD : szW;
  char* F = take(szF);
  p.Y = (bf16_t*)F; p.YO = (bf16_t*)(F + szRD); p.Wt_ed = (bf16_t*)F;
  p.HD = (float*)Bq; p.OD = (float*)(Bq + szHD);
  p.ws_need = o;
}
#define GTID ((long)blockIdx.x * blockDim.x + threadIdx.x)

DI float lam_of(const Params& p, int layer, float& lam_init) {
  const float* lv = p.diff_lambda + layer * 128;
  float s1 = 0.f, s2 = 0.f;
  for (int i = 0; i < 32; ++i) { s1 += lv[i] * lv[32 + i]; s2 += lv[64 + i] * lv[96 + i]; }
  lam_init = layer == 0 ? 0.2f : 0.35550906759096f;
  return expf(s1) - expf(s2) + lam_init;
}
DI void rope_cs(int s, int jj, float& cs, float& sn) {
  int t = s - TC;
  int pos = (jj < 16) ? (t / 64) : (t % 64);
  float ang = (float)pos * exp2f(-1.6609640474436813f * (float)(jj & 7));
  double rev = (double)ang * 0.15915494309189535;
  rev -= floor(rev + 0.5);
  float rf = (float)rev;
  cs = hw_cos_rev(rf); sn = hw_sin_rev(rf);
}
template <class G> DI float rope_elem(G get, int s, int jj) {
  if (s < TC) return get(jj);
  float cs, sn; rope_cs(s, jj, cs, sn);
  float a = get(jj), b = get(jj ^ 8);
  return (jj & 8) ? (a * cs + b * sn) : (a * cs - b * sn);
}

DI void nvb_mods(long GI, const Params& p) {
  long i = GI; if (i >= 2 * 3 * 6144) return;
  int col = (int)(i % 6144), w = (int)((i / 6144) % 3), l = (int)(i / (3 * 6144));
  const float* cv = w < 2 ? p.c + w * 1024 : p.c_ctx;
  const float* W = p.w_ada + (size_t)l * 1024 * 6144;
  float acc = 0.f;
  for (int k = 0; k < 1024; ++k) acc += siluf_(cv[k]) * W[(size_t)k * 6144 + col];
  p.mods[i] = acc + p.b_ada[l * 6144 + col];
}
__global__ void __launch_bounds__(256) nv_wt(const float* in, bf16_t* out, int K, int N, int NP, long in_bs, long out_bs, const float* gain) {
  long i = GTID; if (i >= (long)NP * K) return;
  int k = (int)(i % K), n = (int)(i / K);
  const float* I = in + (size_t)blockIdx.y * in_bs; bf16_t* O = out + (size_t)blockIdx.y * out_bs;
  O[(size_t)n * K + k] = n < N ? f2bf(I[(size_t)k * N + n] * (gain ? gain[k] : 1.0f)) : (bf16_t)0;
}
__global__ void __launch_bounds__(256) nv_modulate(Params p, int layer, int which, const float* xl, const float* xcx, int nrows) {
  long r = GTID; if (r >= nrows) return;
  int w = r < RL ? (int)(r / TL) : 2;
  const float* mb = p.mods + (size_t)(layer * 3 + w) * 6144;
  const float* shift = mb + (which ? 3 : 0) * 1024; const float* scale = mb + (which ? 4 : 1) * 1024;
  const float* g = (which ? p.g_ffn_pre : p.g_mix_pre) + layer * 1024;
  const float* x = r < RL ? xl + (size_t)r * D : xcx + (size_t)(r - RL) * D;
  float ss = 0.f; for (int k = 0; k < D; ++k) ss += x[k] * x[k];
  float rstd = 1.0f / sqrtf(ss / D + 1e-6f);
  for (int k = 0; k < D; ++k) p.H[(size_t)r * D + k] = f2bf(x[k] * rstd * g[k] * (1.f + scale[k]) + shift[k]);
}
__global__ void __launch_bounds__(256) nv_gemm(const bf16_t* A, int lda, const bf16_t* Bt, int ldb, int M, int N, int K, bf16_t* C, int ldc) {
  long i = GTID; if (i >= (long)M * N) return;
  int n = (int)(i % N), m = (int)(i / N);
  const bf16_t* a = A + (size_t)m * lda; const bf16_t* b = Bt + (size_t)n * ldb;
  float acc = 0.f;
  for (int k = 0; k < K; ++k) acc += bf2f(a[k]) * bf2f(b[k]);
  C[(size_t)m * ldc + n] = f2bf(acc);
}
__global__ void __launch_bounds__(256) nv_mla_q(Params p, int layer) {
  long i = GTID; if (i >= (long)R * 4 * 96) return;
  int j = (int)(i % 96), h = (int)((i / 96) % 4), r = (int)(i / 384);
  int b, s; bs_of(r, b, s);
  const bf16_t* z = p.Z + (size_t)r * NZP + ZC_QLAT;
  const float* g = p.g_q_lat + layer * 256; const float* W = p.w_uq + (size_t)layer * 256 * 384;
  float ss = 0.f; for (int k = 0; k < 256; ++k) { float v = bf2f(z[k]); ss += v * v; }
  float rstd = 1.0f / sqrtf(ss / 256 + 1e-6f);
  auto dot = [&](int col) { float a = 0.f; for (int k = 0; k < 256; ++k) a += bf2f(z[k]) * rstd * g[k] * W[(size_t)k * 384 + col]; return a; };
  float v;
  if (j < 64) v = dot(h * 96 + j);
  else v = rope_elem([&](int jj) { return dot(h * 96 + 64 + jj); }, s, j - 64);
  p.Qm[(((size_t)b * 4 + h) * TK + s) * 96 + j] = f2bf(v * QS_MLA);
}
__global__ void __launch_bounds__(256) nv_mla_kv(Params p, int layer) {
  long i = GTID; if (i >= (long)R * 4 * 160) return;
  int j = (int)(i % 160), h = (int)((i / 160) % 4), r = (int)(i / 640);
  int b, s; bs_of(r, b, s);
  const bf16_t* z = p.Z + (size_t)r * NZP;
  if (j < 128) {
    const bf16_t* zl = z + ZC_KVLAT; const float* g = p.g_kv_lat + layer * 128; const float* W = p.w_ukv + (size_t)layer * 128 * 512;
    float ss = 0.f; for (int k = 0; k < 128; ++k) { float v = bf2f(zl[k]); ss += v * v; }
    float rstd = 1.0f / sqrtf(ss / 128 + 1e-6f);
    float a = 0.f; for (int k = 0; k < 128; ++k) a += bf2f(zl[k]) * rstd * g[k] * W[(size_t)k * 512 + h * 128 + j];
    if (j < 64) p.Km[(((size_t)b * 4 + h) * TK + s) * 96 + j] = f2bf(a);
    else p.Vtm[(((size_t)b * 4 + h) * 64 + (j - 64)) * TK + s] = f2bf(a);
  } else {
    int jj = j - 128;
    float v = rope_elem([&](int q) { return bf2f(z[ZC_KROPE + q]); }, s, jj);
    p.Km[(((size_t)b * 4 + h) * TK + s) * 96 + 64 + jj] = f2bf(v);
  }
}
__global__ void __launch_bounds__(256) nv_diff_prep(Params p) {
  long i = GTID; if (i >= (long)R * 768) return;
  int c = (int)(i % 768), r = (int)(i / 768);
  int b, s; bs_of(r, b, s);
  const bf16_t* z = p.Z + (size_t)r * NZP;
  if (c < 512) {
    int qk = c / 256, cc = c % 256, hm = cc / 32, jj = cc % 32;
    const bf16_t* src = z + (qk ? ZC_DK : ZC_DQ) + hm * 32;
    float v = rope_elem([&](int q) { return bf2f(src[q]); }, s, jj);
    if (qk == 0) p.Qd[(((size_t)b * 8 + hm) * TK + s) * 32 + jj] = f2bf(v * QS_DIFF);
    else p.Kd[(((size_t)b * 8 + hm) * TK + s) * 32 + jj] = f2bf(v);
  } else {
    int cc = c - 512, h = cc / 64, dv = cc % 64;
    p.Vtd[(((size_t)b * 4 + h) * 64 + dv) * TK + s] = z[ZC_DV + cc];
  }
}
__global__ void __launch_bounds__(256) nv_ml_prep(Params p, int layer) {
  long i = GTID; if (i >= (long)R * 512) return;
  int ch = (int)(i % 512), r = (int)(i / 512);
  int b, s; bs_of(r, b, s);
  bool first = (s == 0) || (s == TC), last = (s == TC - 1) || (s == TK - 1);
  const float* w = p.w_conv + (size_t)layer * 3 * 512;
  float acc = p.b_conv[layer * 512 + ch];
  acc += bf2f(p.Z[(size_t)r * NZP + ZC_MLQK + ch]) * w[512 + ch];
  if (!first) acc += bf2f(p.Z[(size_t)row_of(b, s - 1) * NZP + ZC_MLQK + ch]) * w[ch];
  if (!last) acc += bf2f(p.Z[(size_t)row_of(b, s + 1) * NZP + ZC_MLQK + ch]) * w[1024 + ch];
  float v = siluf_(acc);
  if (ch < 256) p.MQ[((size_t)b * TK + s) * 256 + ch] = f2bf(v);
  else p.MK[((size_t)b * TK + s) * 256 + ch - 256] = f2bf(v * 0.125f);
}
DI void nvb_ml_gates(long GI, const Params& p, int layer) {
  long i = GI; if (i >= (long)NB * 2 * NCK * 4) return;
  int h = (int)(i % 4), j = (int)((i / 4) % NCK), d = (int)((i / (4 * NCK)) % 2), b = (int)(i / (8 * NCK));
  float bi = p.b_igate[layer * 8 + d * 4 + h], bfg = p.b_fgate[layer * 8 + d * 4 + h];
  float cum = 0.f;
  for (int l = 0; l < 64; ++l) {
    int pp = 64 * j + l, s = seq_of(d, pp); const bf16_t* z = p.Z + (size_t)row_of(b, s) * NZP;
    float ig = bf2f(z[ZC_MLIG + d * 4 + h]) + bi;
    float lf = logsigmoidf_(bf2f(z[ZC_MLFG + d * 4 + h]) + bfg);
    cum += lf;
    size_t o = (((size_t)b * 2 + d) * TK + pp) * 4 + h;
    p.BC[o] = cum; p.IGS[o] = ig;
  }
}
DI void nvb_gla_cum(long GI, const Params& p, int layer) {
  long i = GI; if (i >= (long)NB * 2 * NCK * 128) return;
  int ch = (int)(i % 128), j = (int)((i / 128) % NCK), d = (int)((i / (128 * NCK)) % 2), b = (int)(i / (256 * NCK));
  const float* W = p.w_alpha2 + (size_t)layer * 2 * 16 * 128 + (size_t)d * 16 * 128;
  float ba = p.b_alpha[layer * 256 + d * 128 + ch];
  float cum = 0.f;
  for (int l = 0; l < 64; ++l) {
    int pp = 64 * j + l, s = seq_of(d, pp); const bf16_t* z = p.Z + (size_t)row_of(b, s) * NZP + ZC_GA + d * 16;
    float zg = ba; for (int q = 0; q < 16; ++q) zg += bf2f(z[q]) * W[q * 128 + ch];
    cum += logsigmoidf_(zg) * (1.0f / 16.0f);
    p.GC[(((size_t)b * 2 + d) * TK + pp) * 128 + ch] = cum;
  }
}
__global__ void __launch_bounds__(256) nv_attn_mla(Params p, int need_ctx) {
  long i = GTID; if (i >= (long)NB * 4 * TK) return;
  int s = (int)(i % TK), h = (int)((i / TK) % 4), b = (int)(i / (4 * TK));
  if (s < TC && !need_ctx) return;
  int nk = s < TC ? TC : TK;
  const bf16_t* q = p.Qm + (((size_t)b * 4 + h) * TK + s) * 96;
  const bf16_t* K = p.Km + ((size_t)b * 4 + h) * TK * 96;
  const bf16_t* Vt = p.Vtm + ((size_t)b * 4 + h) * 64 * TK;
  float qf[96], o[64];
  _Pragma("unroll") for (int k = 0; k < 96; ++k) qf[k] = bf2f(q[k]);
  _Pragma("unroll") for (int k = 0; k < 64; ++k) o[k] = 0.f;
  float m = -1e30f, l = 0.f;
  for (int t = 0; t < nk; ++t) {
    float sc = 0.f; _Pragma("unroll") for (int k = 0; k < 96; ++k) sc += qf[k] * bf2f(K[(size_t)t * 96 + k]);
    float mn = fmaxf(m, sc), a = exp2f(m - mn), pr = exp2f(sc - mn);
    l = l * a + pr;
    _Pragma("unroll") for (int k = 0; k < 64; ++k) o[k] = o[k] * a + pr * bf2f(Vt[(size_t)k * TK + t]);
    m = mn;
  }
  int r = row_of(b, s);
  _Pragma("unroll") for (int k = 0; k < 64; ++k) p.Y[(size_t)r * D + h * 64 + k] = f2bf(o[k] / l);
}
__global__ void __launch_bounds__(256) nv_attn_diff(Params p, int layer, int need_ctx) {
  long i = GTID; if (i >= (long)NB * 4 * TK) return;
  int s = (int)(i % TK), h = (int)((i / TK) % 4), b = (int)(i / (4 * TK));
  if (s < TC && !need_ctx) return;
  int nk = s < TC ? TC : TK;
  float lam_init; float lam = lam_of(p, layer, lam_init);
  const bf16_t* Vt = p.Vtd + ((size_t)b * 4 + h) * 64 * TK;
  float res[64];
  _Pragma("unroll") for (int k = 0; k < 64; ++k) res[k] = 0.f;
  _Pragma("unroll") for (int mp = 0; mp < 2; ++mp) {
    const bf16_t* q = p.Qd + (((size_t)b * 8 + h * 2 + mp) * TK + s) * 32;
    const bf16_t* K = p.Kd + ((size_t)b * 8 + h * 2 + mp) * TK * 32;
    float qf[32], o[64];
    _Pragma("unroll") for (int k = 0; k < 32; ++k) qf[k] = bf2f(q[k]);
    _Pragma("unroll") for (int k = 0; k < 64; ++k) o[k] = 0.f;
    float m = -1e30f, l = 0.f;
    for (int t = 0; t < nk; ++t) {
      float sc = 0.f; _Pragma("unroll") for (int k = 0; k < 32; ++k) sc += qf[k] * bf2f(K[(size_t)t * 32 + k]);
      float mn = fmaxf(m, sc), a = exp2f(m - mn), pr = exp2f(sc - mn);
      l = l * a + pr;
      _Pragma("unroll") for (int k = 0; k < 64; ++k) o[k] = o[k] * a + pr * bf2f(Vt[(size_t)k * TK + t]);
      m = mn;
    }
    float wgt = mp == 0 ? 1.f : -lam;
    _Pragma("unroll") for (int k = 0; k < 64; ++k) res[k] += wgt * o[k] / l;
  }
  float ss = 0.f; _Pragma("unroll") for (int k = 0; k < 64; ++k) ss += res[k] * res[k];
  float rstd = 1.0f / sqrtf(ss / 64 + 1e-6f);
  int r = row_of(b, s);
  _Pragma("unroll") for (int k = 0; k < 64; ++k) p.Y[(size_t)r * D + 768 + h * 64 + k] = f2bf(res[k] * rstd * p.g_diff_out[layer * 256 + h * 64 + k] * (1.f - lam_init));
}
DI void nvb_ml_local(long GI, const Params& p) {
  long i = GI; if (i >= (long)NUNIT * 4160) return;
  int e = (int)(i % 4160); long u = i / 4160;
  int h = (int)(u % 4), j = (int)((u / 4) % NCK), d = (int)((u / (4 * NCK)) % 2), b = (int)(u / (8 * NCK));
  const float* bc = p.BC + (((size_t)b * 2 + d) * TK + 64 * j) * 4 + h; const float* ig = p.IGS + (((size_t)b * 2 + d) * TK + 64 * j) * 4 + h;
  float bend = bc[63 * 4], ml = -1e30f;
  for (int l = 0; l < 64; ++l) ml = fmaxf(ml, bend - bc[l * 4] + ig[l * 4]);
  if (e == 4096 + 0) { p.MM[u * 4 + 0] = ml; p.MM[u * 4 + 1] = bend; }
  float acc = 0.f;
  if (e < 4096) {
    int v = e / 64, k = e % 64;
    for (int l = 0; l < 64; ++l) {
      int s = seq_of(d, 64 * j + l); float w = expf(bend - bc[l * 4] + ig[l * 4] - ml);
      acc += w * bf2f(p.Z[(size_t)row_of(b, s) * NZP + ZC_MLV + h * 64 + v]) * bf2f(p.MK[((size_t)b * TK + s) * 256 + h * 64 + k]);
    }
    p.MC[(size_t)u * 4096 + e] = acc;
  } else {
    int k = e - 4096;
    for (int l = 0; l < 64; ++l) {
      int s = seq_of(d, 64 * j + l); float w = expf(bend - bc[l * 4] + ig[l * 4] - ml);
      acc += w * bf2f(p.MK[((size_t)b * TK + s) * 256 + h * 64 + k]);
    }
    p.MN[(size_t)u * 64 + k] = acc;
  }
}
DI void nvb_ml_scan(long GI, const Params& p) {
  long i = GI; if (i >= (long)NB * 2 * 4 * 4160) return;
  int e = (int)(i % 4160); int ch = (int)(i / 4160); int h = ch % 4, bd = ch / 4;
  float st = 0.f, m = -1e30f;
  for (int j = 0; j < NCK; ++j) {
    size_t u = ((size_t)bd * NCK + j) * 4 + h;
    float ml = p.MM[u * 4 + 0], be = p.MM[u * 4 + 1];
    float mn = fmaxf(be + m, ml), a = expf(be + m - mn), g = expf(ml - mn);
    float* slot = e < 4096 ? &p.MC[u * 4096 + e] : &p.MN[u * 64 + (e - 4096)];
    float loc = *slot; *slot = st; st = a * st + g * loc;
    if (e == 0) p.MM[u * 4 + 2] = m;
    m = mn;
  }
}
DI void nvb_ml_out(long GI, const Params& p, int need_ctx) {
  long i = GI; if (i >= (long)NUNIT * 4096) return;
  int v = (int)(i % 64), l = (int)((i / 64) % 64); long u = i / 4096;
  int h = (int)(u % 4), j = (int)((u / 4) % NCK), d = (int)((u / (4 * NCK)) % 2), b = (int)(u / (8 * NCK));
  if (j < NCC && !need_ctx) return;
  const float* bc = p.BC + (((size_t)b * 2 + d) * TK + 64 * j) * 4 + h; const float* ig = p.IGS + (((size_t)b * 2 + d) * TK + 64 * j) * 4 + h;
  float m0 = p.MM[u * 4 + 2];
  int sl = seq_of(d, 64 * j + l);
  const bf16_t* q = p.MQ + ((size_t)b * TK + sl) * 256 + h * 64;
  float bl = bc[l * 4];
  float inter = bl + m0, mt = inter;
  for (int t = 0; t <= l; ++t) mt = fmaxf(mt, bl - bc[t * 4] + ig[t * 4]);
  float num = 0.f, den = 0.f;
  for (int t = 0; t <= l; ++t) {
    int st = seq_of(d, 64 * j + t);
    const bf16_t* k = p.MK + ((size_t)b * TK + st) * 256 + h * 64;
    float qk = 0.f; for (int c = 0; c < 64; ++c) qk += bf2f(q[c]) * bf2f(k[c]);
    float sv = expf(bl - bc[t * 4] + ig[t * 4] - mt) * qk;
    num += sv * bf2f(p.Z[(size_t)row_of(b, st) * NZP + ZC_MLV + h * 64 + v]); den += sv;
  }
  float ai = expf(inter - mt);
  float qc = 0.f, qn = 0.f;
  for (int c = 0; c < 64; ++c) { qc += bf2f(q[c]) * p.MC[(size_t)u * 4096 + v * 64 + c]; qn += bf2f(q[c]) * p.MN[(size_t)u * 64 + c]; }
  num += ai * qc; den += ai * qn;
  p.HD[(((size_t)d * NB + b) * TK + sl) * 256 + h * 64 + v] = num / fmaxf(fabsf(den), expf(-mt));
}
DI void nvb_ml_finish(long GI, const Params& p, int layer, int need_ctx) {
  long i = GI; if (i >= (long)R * 4) return;
  int h = (int)(i % 4), r = (int)(i / 4); int b, s; bs_of(r, b, s);
  if (s < TC && !need_ctx) return;
  const float* h0 = p.HD + (((size_t)0 * NB + b) * TK + s) * 256 + h * 64; const float* h1 = p.HD + (((size_t)1 * NB + b) * TK + s) * 256 + h * 64;
  float ss = 0.f; for (int v = 0; v < 64; ++v) { float t = h0[v] + h1[v]; ss += t * t; }
  float rstd = 1.0f / sqrtf(ss / 64 + 1e-6f);
  for (int v = 0; v < 64; ++v) {
    float o = bf2f(p.Z[(size_t)r * NZP + ZC_MLO + h * 64 + v]);
    p.Y[(size_t)r * D + 256 + h * 64 + v] = f2bf(sigmoidf_(o) * (h0[v] + h1[v]) * rstd * p.g_mlstm_out[layer * 256 + h * 64 + v]);
  }
}
DI void nvb_gla_local(long GI, const Params& p) {
  long i = GI; if (i >= (long)NUNIT * 2048) return;
  int v = (int)(i % 64), k = (int)((i / 64) % 32); long u = i / 2048;
  int h = (int)(u % 4), j = (int)((u / 4) % NCK), d = (int)((u / (4 * NCK)) % 2), b = (int)(u / (8 * NCK));
  const float* gc = p.GC + (((size_t)b * 2 + d) * TK + 64 * j) * 128 + h * 32 + k;
  float ge = gc[63 * 128], acc = 0.f;
  for (int l = 0; l < 64; ++l) {
    int s = seq_of(d, 64 * j + l); const bf16_t* z = p.Z + (size_t)row_of(b, s) * NZP;
    acc += bf2f(z[ZC_GK + h * 32 + k]) * expf(ge - gc[l * 128]) * bf2f(z[ZC_GV + h * 64 + v]);
  }
  p.GS[(size_t)u * 2048 + v * 32 + k] = acc;
}
DI void nvb_gla_scan(long GI, const Params& p) {
  long i = GI; if (i >= (long)NB * 2 * 4 * 2048) return;
  int e = (int)(i % 2048); int ch = (int)(i / 2048); int h = ch % 4, bd = ch / 4; int k = e % 32;
  float st = 0.f;
  for (int j = 0; j < NCK; ++j) {
    size_t u = ((size_t)bd * NCK + j) * 4 + h;
    float ge = p.GC[((size_t)bd * TK + 64 * j + 63) * 128 + h * 32 + k];
    float loc = p.GS[u * 2048 + e]; p.GS[u * 2048 + e] = st; st = expf(ge) * st + loc;
  }
}
DI void nvb_gla_out(long GI, const Params& p, int need_ctx) {
  long i = GI; if (i >= (long)NUNIT * 4096) return;
  int v = (int)(i % 64), l = (int)((i / 64) % 64); long u = i / 4096;
  int h = (int)(u % 4), j = (int)((u / 4) % NCK), d = (int)((u / (4 * NCK)) % 2), b = (int)(u / (8 * NCK));
  if (j < NCC && !need_ctx) return;
  const float* gc = p.GC + (((size_t)b * 2 + d) * TK + 64 * j) * 128 + h * 32;
  int sl = seq_of(d, 64 * j + l);
  const bf16_t* q = p.Z + (size_t)row_of(b, sl) * NZP + ZC_GQ + h * 32;
  const float qs = 0.17677669529663687f;
  float acc = 0.f;
  for (int t = 0; t <= l; ++t) {
    int st = seq_of(d, 64 * j + t); const bf16_t* z = p.Z + (size_t)row_of(b, st) * NZP;
    float att = 0.f; for (int k = 0; k < 32; ++k) att += bf2f(q[k]) * qs * expf(gc[l * 128 + k] - gc[t * 128 + k]) * bf2f(z[ZC_GK + h * 32 + k]);
    acc += att * bf2f(z[ZC_GV + h * 64 + v]);
  }
  for (int k = 0; k < 32; ++k) acc += bf2f(q[k]) * qs * expf(gc[l * 128 + k]) * p.GS[(size_t)u * 2048 + v * 32 + k];
  p.OD[(((size_t)d * NB + b) * TK + sl) * 256 + h * 64 + v] = acc;
}
DI void nvb_gla_finish(long GI, const Params& p, int layer, int need_ctx) {
  long i = GI; if (i >= (long)R * 4) return;
  int h = (int)(i % 4), r = (int)(i / 4); int b, s; bs_of(r, b, s);
  if (s < TC && !need_ctx) return;
  const float* h0 = p.OD + (((size_t)0 * NB + b) * TK + s) * 256 + h * 64; const float* h1 = p.OD + (((size_t)1 * NB + b) * TK + s) * 256 + h * 64;
  float ss = 0.f; for (int v = 0; v < 64; ++v) { float t = h0[v] + h1[v]; ss += t * t; }
  float rstd = 1.0f / sqrtf(ss / 64 + 1e-6f);
  for (int v = 0; v < 64; ++v) {
    float rr = bf2f(p.Z[(size_t)r * NZP + ZC_GR + h * 64 + v]);
    p.Y[(size_t)r * D + 512 + h * 64 + v] = f2bf(siluf_(rr) * (h0[v] + h1[v]) * rstd * p.g_gla_out[layer * 256 + h * 64 + v]);
  }
}
__global__ void __launch_bounds__(256) nv_merge(Params p, int layer, int nrows) {
  long i = GTID; if (i >= (long)nrows * D) return;
  int j = (int)(i % D), r = (int)(i / D);
  float acc = 0.f;
  for (int n = 0; n < 4; ++n) {
    const bf16_t* wg = p.Wt_gate + (size_t)(n * 1024 + j) * D; const bf16_t* wb = p.Wt_branch + ((size_t)n * D + j) * 256;
    float g = p.b_gate[layer * 4096 + n * 1024 + j], pr = 0.f;
    for (int k = 0; k < D; ++k) g += bf2f(p.H[(size_t)r * D + k]) * bf2f(wg[k]);
    for (int k = 0; k < 256; ++k) pr += bf2f(p.Y[(size_t)r * D + n * 256 + k]) * bf2f(wb[k]);
    acc += sigmoidf_(g) * pr;
  }
  p.MG[(size_t)r * D + j] = f2bf(acc);
}
__global__ void __launch_bounds__(256) nv_resid_mix(Params p, int layer, const float* xl_in, const float* xc_in, int nrows) {
  long r = GTID; if (r >= nrows) return;
  int w = r < RL ? (int)(r / TL) : 2;
  const float* mb = p.mods + (size_t)(layer * 3 + w) * 6144;
  const float* xin = r < RL ? xl_in + (size_t)r * D : xc_in + (size_t)(r - RL) * D;
  float* xo = r < RL ? p.out + (size_t)r * D : p.xc + (size_t)(r - RL) * D;
  const bf16_t* yo = p.YO + (size_t)r * D;
  float ss = 0.f; for (int k = 0; k < D; ++k) { float v = bf2f(yo[k]); ss += v * v; }
  float rstd = 1.0f / sqrtf(ss / D + 1e-6f);
  float s2 = 0.f;
  for (int k = 0; k < D; ++k) { float xn = xin[k] + mb[2 * 1024 + k] * bf2f(yo[k]) * rstd * p.g_mix_post[layer * 1024 + k]; xo[k] = xn; s2 += xn * xn; }
  float rstd2 = 1.0f / sqrtf(s2 / D + 1e-6f);
  float lg[16]; _Pragma("unroll") for (int e = 0; e < 16; ++e) lg[e] = 0.f;
  const float* wr = p.w_router + (size_t)layer * D * 16;
  for (int k = 0; k < D; ++k) {
    float h2 = xo[k] * rstd2 * p.g_ffn_pre[layer * 1024 + k] * (1.f + mb[4 * 1024 + k]) + mb[3 * 1024 + k];
    p.H[(size_t)r * D + k] = f2bf(h2);
    _Pragma("unroll") for (int e = 0; e < 16; ++e) lg[e] += h2 * wr[k * 16 + e];
  }
  float mx = lg[0]; _Pragma("unroll") for (int e = 1; e < 16; ++e) mx = fmaxf(mx, lg[e]);
  float sm = 0.f; _Pragma("unroll") for (int e = 0; e < 16; ++e) { lg[e] = expf(lg[e] - mx); sm += lg[e]; }
  int b, s; bs_of((int)r, b, s);
  _Pragma("unroll") for (int e = 0; e < 16; ++e) p.AFF[((size_t)b * NE + e) * TK + s] = lg[e] / sm;
}
__global__ void __launch_bounds__(256) nv_topk(Params p, int need_ctx) {
  long i = GTID; if (i >= NB * NE * 2) return;
  int seg = (int)(i % 2), e = (int)((i / 2) % NE), b = (int)(i / (2 * NE));
  int s0 = seg ? TC : 0, n = seg ? TL : TC, cap = seg ? CAPL : CAPC, slot0 = seg ? b * CAPL : NB * CAPL + b * CAPC;
  if (seg == 0 && !need_ctx) { for (int q = 0; q < cap; ++q) p.SEL[(size_t)e * NSLOT + slot0 + q] = -1; return; }
  const float* a = p.AFF + ((size_t)b * NE + e) * TK + s0;
  unsigned thr = 0;
  for (int bit = 31; bit >= 0; --bit) {
    unsigned cand = thr | (1u << bit); int cnt = 0;
    for (int t = 0; t < n; ++t) cnt += (f2u(a[t]) >= cand);
    if (cnt >= cap) thr = cand;
  }
  int ngt = 0; for (int t = 0; t < n; ++t) ngt += (f2u(a[t]) > thr);
  int neq = cap - ngt, q = 0;
  for (int t = 0; t < n; ++t) {
    unsigned u = f2u(a[t]); int r = row_of(b, s0 + t); int sel = -1;
    if (u > thr) sel = q++; else if (u == thr && neq > 0) { sel = q++; --neq; }
    if (sel >= 0) { p.SEL[(size_t)e * NSLOT + slot0 + sel] = r; p.SELV[(size_t)e * NSLOT + slot0 + sel] = a[t]; }
    p.INV[(size_t)r * NE + e] = sel >= 0 ? slot0 + sel : -1;
  }
}
__global__ void __launch_bounds__(256) nv_moe1(Params p) {
  long i = GTID; if (i >= (long)NE * NSLOT * FF) return;
  int f = (int)(i % FF), slot = (int)((i / FF) % NSLOT), e = (int)(i / ((long)FF * NSLOT));
  int r = p.SEL[(size_t)e * NSLOT + slot];
  float out = 0.f;
  if (r >= 0) {
    const bf16_t* wg = p.Wt_eg + ((size_t)e * FF + f) * D; const bf16_t* wu = p.Wt_eu + ((size_t)e * FF + f) * D; const bf16_t* h = p.H + (size_t)r * D;
    float g = 0.f, u = 0.f; for (int k = 0; k < D; ++k) { float hv = bf2f(h[k]); g += hv * bf2f(wg[k]); u += hv * bf2f(wu[k]); }
    out = siluf_(g) * u;
  }
  p.HID[((size_t)e * NSLOT + slot) * FF + f] = f2bf(out);
}
__global__ void __launch_bounds__(256) nv_moe2(Params p) {
  long i = GTID; if (i >= (long)NE * NSLOT * D) return;
  int j = (int)(i % D), slot = (int)((i / D) % NSLOT), e = (int)(i / ((long)D * NSLOT));
  int r = p.SEL[(size_t)e * NSLOT + slot];
  float out = 0.f;
  if (r >= 0) {
    const bf16_t* wd = p.Wt_ed + ((size_t)e * D + j) * FF; const bf16_t* h = p.HID + ((size_t)e * NSLOT + slot) * FF;
    float a = 0.f; for (int k = 0; k < FF; ++k) a += bf2f(h[k]) * bf2f(wd[k]);
    out = a * p.SELV[(size_t)e * NSLOT + slot];
  }
  p.YE[((size_t)e * NSLOT + slot) * D + j] = f2bf(out);
}
__global__ void __launch_bounds__(256) nv_resid_ffn(Params p, int layer, int nrows) {
  long r = GTID; if (r >= nrows) return;
  int w = r < RL ? (int)(r / TL) : 2;
  const float* mb = p.mods + (size_t)(layer * 3 + w) * 6144;
  float* xo = r < RL ? p.out + (size_t)r * D : p.xc + (size_t)(r - RL) * D;
  float ss = 0.f;
  for (int k = 0; k < D; ++k) {
    float f = 0.f;
    for (int e = 0; e < NE; ++e) { int sl = p.INV[(size_t)r * NE + e]; if (sl >= 0) f += bf2f(p.YE[((size_t)e * NSLOT + sl) * D + k]); }
    ss += f * f;
  }
  float rstd = 1.0f / sqrtf(ss / D + 1e-6f);
  for (int k = 0; k < D; ++k) {
    float f = 0.f;
    for (int e = 0; e < NE; ++e) { int sl = p.INV[(size_t)r * NE + e]; if (sl >= 0) f += bf2f(p.YE[((size_t)e * NSLOT + sl) * D + k]); }
    xo[k] += mb[5 * 1024 + k] * f * rstd * p.g_ffn_post[layer * 1024 + k];
  }
}

__global__ void __launch_bounds__(256) nv_mods(Params p) { nvb_mods(GTID, p); }
__global__ void __launch_bounds__(256) nv_ml_gates(Params p, int layer) { nvb_ml_gates(GTID, p, layer); }
__global__ void __launch_bounds__(256) nv_gla_cum(Params p, int layer) { nvb_gla_cum(GTID, p, layer); }
__global__ void __launch_bounds__(256) nv_ml_local(Params p) { nvb_ml_local(GTID, p); }
__global__ void __launch_bounds__(256) nv_ml_scan(Params p) { nvb_ml_scan(GTID, p); }
__global__ void __launch_bounds__(256) nv_ml_out(Params p, int need_ctx) { nvb_ml_out(GTID, p, need_ctx); }
__global__ void __launch_bounds__(256) nv_ml_finish(Params p, int layer, int need_ctx) { nvb_ml_finish(GTID, p, layer, need_ctx); }
__global__ void __launch_bounds__(256) nv_gla_local(Params p) { nvb_gla_local(GTID, p); }
__global__ void __launch_bounds__(256) nv_gla_scan(Params p) { nvb_gla_scan(GTID, p); }
__global__ void __launch_bounds__(256) nv_gla_out(Params p, int need_ctx) { nvb_gla_out(GTID, p, need_ctx); }
__global__ void __launch_bounds__(256) nv_gla_finish(Params p, int layer, int need_ctx) { nvb_gla_finish(GTID, p, layer, need_ctx); }
constexpr int LROW = 144;
constexpr int A_BYTES = 128 * LROW;
constexpr int NTHR = 256;
#ifndef ATT_THR
#define ATT_THR 16.0f
#endif

DI int xcd_swz(int u, int nt) { return (nt & 7) ? u : (u & 7) * (nt >> 3) + (u >> 3); }
template <int GW> DI void grp_tile(int L, int ntm, int ntn, int& tm, int& tn) {
  const int gsz = ntm * GW; int g = 0;
  while (L >= gsz) { L -= gsz; ++g; }
  tm = L / GW; tn = g * GW + (L & (GW - 1)); (void)ntn;
}
DI u32x4 ldg16(const void* p) { return *(const u32x4*)p; }
DI void sts16(char* p, u32x4 v) { *(u32x4*)p = v; }
DI bf16x8 lds_frag(const char* p) { return *(const bf16x8*)p; }

template <int WN>
DI void gemm_kloop(f32x4 (&acc)[4][WN], const bf16_t* const (&ap)[4], const bf16_t* const (&bp)[WN], int nk, char* lds) {
  constexpr int STAGE = A_BYTES + 32 * WN * LROW;
  const int t = TIDX, lane = t & 63, wid = t >> 6, wr = wid >> 1, wc = wid & 1;
  const int lr = t >> 3, lcb = (t & 7) * 16;
  const int fr = lane & 15, fq = lane >> 4;
  const int aoff = (wr * 64 + fr) * LROW + fq * 16, boff = A_BYTES + (wc * WN * 16 + fr) * LROW + fq * 16, soff = lr * LROW + lcb;
  u32x4 ra0[4], rb0[WN], ra1[4], rb1[WN];
  auto gload = [&](u32x4 (&ra)[4], u32x4 (&rb)[WN], int kt) {
#pragma unroll
    for (int i = 0; i < 4; ++i) ra[i] = ldg16(ap[i] + kt * 64);
#pragma unroll
    for (int i = 0; i < WN; ++i) rb[i] = ldg16(bp[i] + kt * 64);
  };
  auto sstore = [&](const u32x4 (&ra)[4], const u32x4 (&rb)[WN], char* st) {
#pragma unroll
    for (int i = 0; i < 4; ++i) sts16(st + soff + 32 * i * LROW, ra[i]);
#pragma unroll
    for (int i = 0; i < WN; ++i) sts16(st + A_BYTES + soff + 32 * i * LROW, rb[i]);
  };
  auto compute = [&](const char* cur) {
#pragma unroll
    for (int ks = 0; ks < 2; ++ks) {
      bf16x8 af[4], bfr[WN];
#pragma unroll
      for (int m = 0; m < 4; ++m) af[m] = lds_frag(cur + aoff + m * 16 * LROW + ks * 64);
#pragma unroll
      for (int n = 0; n < WN; ++n) bfr[n] = lds_frag(cur + boff + n * 16 * LROW + ks * 64);
#pragma unroll
      for (int m = 0; m < 4; ++m)
#pragma unroll
        for (int n = 0; n < WN; ++n) acc[m][n] = MFMA16(bfr[n], af[m], acc[m][n]);
    }
    IGLP_OPT();
  };
  gload(ra0, rb0, 0);
  gload(ra1, rb1, 1);
  sstore(ra0, rb0, lds);
  __syncthreads();
#pragma unroll 1
  for (int kt = 0; kt < nk; kt += 2) {
    if (kt + 2 < nk) gload(ra0, rb0, kt + 2);
    compute(lds);
    sstore(ra1, rb1, lds + STAGE);
    __syncthreads();
    if (kt + 3 < nk) gload(ra1, rb1, kt + 3);
    compute(lds + STAGE);
    if (kt + 2 < nk) sstore(ra0, rb0, lds);
    __syncthreads();
  }
}
template <int WN> DI void acc_zero(f32x4 (&acc)[4][WN]) {
#pragma unroll
  for (int m = 0; m < 4; ++m)
#pragma unroll
    for (int n = 0; n < WN; ++n) acc[m][n] = (f32x4){0.f, 0.f, 0.f, 0.f};
}
DI void st_bf16x4(bf16_t* p, f32x4 v) { u32x2 o; o.x = pack2bf(v.x, v.y); o.y = pack2bf(v.z, v.w); *(u32x2*)p = o; }

template <int WN, class RowOk>
DI void store_wave_tile(const f32x4 (&acc)[4][WN], bf16_t* C, size_t ldc, char* ldsw, int lane, RowOk row_ok) {
  constexpr int PITCH = WN * 32 + 16, CPR = WN * 2;
  const int fr = lane & 15, fq = lane >> 4;
#pragma unroll
  for (int m = 0; m < 4; ++m)
#pragma unroll
    for (int n = 0; n < WN; ++n) { u32x2 o; o.x = pack2bf(acc[m][n][0], acc[m][n][1]); o.y = pack2bf(acc[m][n][2], acc[m][n][3]); *(u32x2*)(ldsw + (m * 16 + fr) * PITCH + n * 32 + fq * 8) = o; }
  WAVE_SYNC();
  constexpr int RPP = 64 / CPR;
#pragma unroll
  for (int ps = 0; ps < 64 / RPP; ++ps) {
    const int r = ps * RPP + lane / CPR, c = lane % CPR;
    const u32x4 v = *(const u32x4*)(ldsw + r * PITCH + c * 16);
    if (row_ok(r)) *(u32x4*)(C + (size_t)r * ldc + c * 8) = v;
  }
  WAVE_SYNC();
}
template <int NOSTORE = 0>
DI void gemm_plain_tile(const bf16_t* A, int lda, const bf16_t* Bt, int ldb, int K, bf16_t* C, int ldc, int tm, int tn, char* lds) {
  const int t = TIDX, lane = t & 63, wid = t >> 6, wr = wid >> 1, wc = wid & 1, lr = t >> 3, lc = (t & 7) * 8, fr = lane & 15, fq = lane >> 4;
  const bf16_t* ap[4]; const bf16_t* bp[4];
#pragma unroll
  for (int i = 0; i < 4; ++i) { ap[i] = A + (size_t)(tm * 128 + lr + 32 * i) * lda + lc; bp[i] = Bt + (size_t)(tn * 128 + lr + 32 * i) * ldb + lc; }
  f32x4 acc[4][4]; acc_zero<4>(acc);
  gemm_kloop<4>(acc, ap, bp, K / 64, lds);
  if (NOSTORE) { float s = 0.f;
#pragma unroll
    for (int m = 0; m < 4; ++m)
#pragma unroll
      for (int n = 0; n < 4; ++n) s += acc[m][n][0] + acc[m][n][3];
    if (s == 123456.789f) C[0] = 1; return; }
  store_wave_tile<4>(acc, C + (size_t)(tm * 128 + wr * 64) * ldc + tn * 128 + wc * 64, (size_t)ldc, lds + wid * (64 * 144), lane, [](int) { return true; });
  __syncthreads();
}
template <int NOSTORE = 0>
DI void ph_gemm_plain(const bf16_t* A, int lda, const bf16_t* Bt, int ldb, int M, int N, int K, bf16_t* C, int ldc, char* lds, int bid, int nblk) {
  const int ntn = N / 128, nt = (M / 128) * ntn;
  for (int u = bid; u < nt; u += nblk) { int tm, tn; grp_tile<8>(xcd_swz(u, nt), M / 128, ntn, tm, tn); gemm_plain_tile<NOSTORE>(A, lda, Bt, ldb, K, C, ldc, tm, tn, lds); }
}
DI void ph_mla_up(const Params& p, int layer, bf16_t* QRAW, bf16_t* KVRAW, char* lds, int bid, int nblk) {
  const int ntq = (R / 128) * 3, ntkv = (R / 128) * 4;
  for (int tile = bid; tile < ntq + ntkv; tile += nblk) {
    if (tile < ntq) gemm_plain_tile(p.Z + ZC_QLAT, NZP, p.Wt_uq + layer * WSZ_UQ, 256, 256, QRAW, 384, tile / 3, tile % 3, lds);
    else { int u = tile - ntq; gemm_plain_tile(p.Z + ZC_KVLAT, NZP, p.Wt_ukv + layer * WSZ_UKV, 128, 128, KVRAW, 512, u / 4, u % 4, lds); }
  }
}
constexpr int LROW32 = 80;
template <int WM, int WN, bool DEEP>
DI void gemm_kloop_g(f32x4 (&acc)[WM][WN], const bf16_t* const (&ap)[WM / 2], const bf16_t* const (&bp)[WN / 2], int nk, char* lds) {
  constexpr int NA = WM / 2, NBB = WN / 2, A_B = 32 * WM * LROW32, STAGE = (32 * WM + 32 * WN) * LROW32;
  const int t = TIDX, lane = t & 63, wid = t >> 6, wr = wid >> 1, wc = wid & 1, fr = lane & 15, fq = lane >> 4;
  const int aoff = (wr * 16 * WM + fr) * LROW32 + fq * 16, boff = A_B + (wc * 16 * WN + fr) * LROW32 + fq * 16, soff = (t >> 2) * LROW32 + (t & 3) * 16;
  u32x4 ra0[NA], rb0[NBB], ra1[NA], rb1[NBB];
  auto gload = [&](u32x4 (&ra)[NA], u32x4 (&rb)[NBB], int kt) {
#pragma unroll
    for (int i = 0; i < NA; ++i) ra[i] = ldg16(ap[i] + kt * 32);
#pragma unroll
    for (int i = 0; i < NBB; ++i) rb[i] = ldg16(bp[i] + kt * 32);
  };
  auto sstore = [&](const u32x4 (&ra)[NA], const u32x4 (&rb)[NBB], char* st) {
#pragma unroll
    for (int i = 0; i < NA; ++i) sts16(st + soff + 64 * i * LROW32, ra[i]);
#pragma unroll
    for (int i = 0; i < NBB; ++i) sts16(st + A_B + soff + 64 * i * LROW32, rb[i]);
  };
  auto compute = [&](const char* cur) {
    bf16x8 af[WM];
#pragma unroll
    for (int m = 0; m < WM; ++m) af[m] = lds_frag(cur + aoff + m * 16 * LROW32);
#pragma unroll
    for (int n = 0; n < WN; ++n) {
      const bf16x8 bfr = lds_frag(cur + boff + n * 16 * LROW32);
#pragma unroll
      for (int m = 0; m < WM; ++m) acc[m][n] = MFMA16(bfr, af[m], acc[m][n]);
    }
    IGLP_OPT();
  };
  gload(ra0, rb0, 0);
  if (DEEP) gload(ra1, rb1, 1);
  sstore(ra0, rb0, lds);
  __syncthreads();
#pragma unroll 1
  for (int kt = 0; kt < nk; kt += 2) {
    if (DEEP) { if (kt + 2 < nk) gload(ra0, rb0, kt + 2); } else gload(ra1, rb1, kt + 1);
    compute(lds);
    sstore(ra1, rb1, lds + STAGE);
    __syncthreads();
    if (DEEP) { if (kt + 3 < nk) gload(ra1, rb1, kt + 3); } else if (kt + 2 < nk) gload(ra0, rb0, kt + 2);
    compute(lds + STAGE);
    if (kt + 2 < nk) sstore(ra0, rb0, lds);
    __syncthreads();
  }
}
template <int WM, int WN> DI void acc_zero_g(f32x4 (&acc)[WM][WN]) {
#pragma unroll
  for (int m = 0; m < WM; ++m)
#pragma unroll
    for (int n = 0; n < WN; ++n) acc[m][n] = (f32x4){0.f, 0.f, 0.f, 0.f};
}
DI void ph_merge(const Params& p, int layer, int rows, char* lds, int bid, int nblk) {
  const int t = TIDX, lane = t & 63, wid = t >> 6, wr = wid >> 1, wc = wid & 1, fr = lane & 15, fq = lane >> 4;
  const int lr = t >> 2, lc = (t & 3) * 8;
  const int ntn = D / 64, nt = (rows / 128) * ntn;
#pragma unroll 1
  for (int u = bid; u < nt; u += nblk) {
    int tm, tn; grp_tile<4>(xcd_swz(u, nt), rows / 128, ntn, tm, tn);
    f32x4 accS[4][2]; acc_zero_g<4, 2>(accS);
#pragma unroll 1
    for (int np = 0; np < 2; ++np) {
      f32x4 accG[4][4]; acc_zero_g<4, 4>(accG);
      {
        const bf16_t* ap[2]; const bf16_t* bp[2];
#pragma unroll
        for (int i = 0; i < 2; ++i) ap[i] = p.H + (size_t)(tm * 128 + lr + 64 * i) * D + lc;
#pragma unroll
        for (int i = 0; i < 2; ++i) { const int rho = lr + 64 * i, wci = rho >> 6, n = 2 * np + ((rho >> 5) & 1), c = rho & 31;
          bp[i] = p.Wt_gate + layer * WSZ_GATE + ((size_t)n * 1024 + tn * 64 + wci * 32 + c) * D + lc; }
        gemm_kloop_g<4, 4, true>(accG, ap, bp, D / 32, lds);
      }
#pragma unroll 1
      for (int q = 0; q < 2; ++q) {
        const int n = 2 * np + q;
        f32x4 accP[4][2]; acc_zero_g<4, 2>(accP);
        const bf16_t* ap[2]; const bf16_t* bp[1];
#pragma unroll
        for (int i = 0; i < 2; ++i) ap[i] = p.Y + (size_t)(tm * 128 + lr + 64 * i) * D + n * 256 + lc;
        bp[0] = p.Wt_branch + layer * WSZ_BR + ((size_t)n * D + tn * 64 + lr) * 256 + lc;
        gemm_kloop_g<4, 2, false>(accP, ap, bp, 8, lds);
#pragma unroll
        for (int nn = 0; nn < 2; ++nn) {
          const f32x4 bv = *(const f32x4*)(p.b_gate + layer * 4096 + n * 1024 + tn * 64 + wc * 32 + nn * 16 + 4 * fq);
#pragma unroll
          for (int m = 0; m < 4; ++m)
#pragma unroll
            for (int j = 0; j < 4; ++j) { const float g = q ? accG[m][2 + nn][j] : accG[m][nn][j]; accS[m][nn][j] += accP[m][nn][j] * fast_rcp(1.0f + fast_exp2(-LOG2E * (g + bv[j]))); }
        }
      }
    }
    store_wave_tile<2>(accS, p.MG + (size_t)(tm * 128 + wr * 64) * D + tn * 64 + wc * 32, (size_t)D, lds + wid * (64 * 80), lane, [](int) { return true; });
    __syncthreads();
  }
}
template <int WM>
DI void gemm_plain_tile_g(const bf16_t* A, int lda, const bf16_t* Bt, int ldb, int K, bf16_t* C, int ldc, int row0, int col0, char* lds) {
  const int t = TIDX, lane = t & 63, wid = t >> 6, wr = wid >> 1, wc = wid & 1, fr = lane & 15, fq = lane >> 4, lr = t >> 2, lc = (t & 3) * 8;
  const bf16_t* ap[WM / 2]; const bf16_t* bp[2];
#pragma unroll
  for (int i = 0; i < WM / 2; ++i) ap[i] = A + (size_t)(row0 + lr + 64 * i) * lda + lc;
#pragma unroll
  for (int i = 0; i < 2; ++i) bp[i] = Bt + (size_t)(col0 + lr + 64 * i) * ldb + lc;
  f32x4 acc[WM][4]; acc_zero_g<WM, 4>(acc);
  gemm_kloop_g<WM, 4, true>(acc, ap, bp, K / 32, lds);
#pragma unroll
  for (int m = 0; m < WM; ++m)
#pragma unroll
    for (int n = 0; n < 4; ++n)
      st_bf16x4(C + (size_t)(row0 + wr * 16 * WM + m * 16 + fr) * ldc + col0 + wc * 64 + n * 16 + 4 * fq, acc[m][n]);
}
DI void ph_gemm_plain2(const bf16_t* A, int lda, const bf16_t* Bt, int ldb, int M, int N, int K, bf16_t* C, int ldc, char* lds, int bid, int nblk) {
  const int ntn = N / 128, nt = (M / 256) * ntn, nfull = (nt / nblk) * nblk;
#pragma unroll 1
  for (int tile = bid; tile < nfull; tile += nblk) gemm_plain_tile_g<8>(A, lda, Bt, ldb, K, C, ldc, (tile / ntn) * 256, (tile % ntn) * 128, lds);
#pragma unroll 1
  for (int h = bid; h < 2 * (nt - nfull); h += nblk) { const int tile = nfull + (h >> 1); gemm_plain_tile_g<4>(A, lda, Bt, ldb, K, C, ldc, (tile / ntn) * 256 + (h & 1) * 128, (tile % ntn) * 128, lds); }
}
DI void gemm_kloop32(f32x16 (&acc)[2][2], const bf16_t* const (&ap)[4], const bf16_t* const (&bp)[4], int nk, char* lds) {
  constexpr int STAGE = A_BYTES + 128 * LROW;
  const int t = TIDX, lane = t & 63, wid = t >> 6, wr = wid >> 1, wc = wid & 1, l31 = lane & 31, hh = lane >> 5;
  const int aoff = (wr * 64 + l31) * LROW + hh * 16, boff = A_BYTES + (wc * 64 + l31) * LROW + hh * 16, soff = (t >> 3) * LROW + (t & 7) * 16;
  u32x4 ra0[4], rb0[4], ra1[4], rb1[4];
  auto gload = [&](u32x4 (&ra)[4], u32x4 (&rb)[4], int kt) {
#pragma unroll
    for (int i = 0; i < 4; ++i) { ra[i] = ldg16(ap[i] + kt * 64); rb[i] = ldg16(bp[i] + kt * 64); }
  };
  auto sstore = [&](const u32x4 (&ra)[4], const u32x4 (&rb)[4], char* st) {
#pragma unroll
    for (int i = 0; i < 4; ++i) { sts16(st + soff + 32 * i * LROW, ra[i]); sts16(st + A_BYTES + soff + 32 * i * LROW, rb[i]); }
  };
  auto compute = [&](const char* cur) {
#pragma unroll
    for (int ks = 0; ks < 4; ++ks) {
      bf16x8 af[2], bfr[2];
#pragma unroll
      for (int m = 0; m < 2; ++m) af[m] = lds_frag(cur + aoff + m * 32 * LROW + ks * 32);
#pragma unroll
      for (int n = 0; n < 2; ++n) bfr[n] = lds_frag(cur + boff + n * 32 * LROW + ks * 32);
#pragma unroll
      for (int m = 0; m < 2; ++m)
#pragma unroll
        for (int n = 0; n < 2; ++n) acc[m][n] = MFMA32(bfr[n], af[m], acc[m][n]);
    }
  };
  gload(ra0, rb0, 0); gload(ra1, rb1, 1);
  sstore(ra0, rb0, lds);
  __syncthreads();
#pragma unroll 1
  for (int kt = 0; kt < nk; kt += 2) {
    if (kt + 2 < nk) gload(ra0, rb0, kt + 2);
    compute(lds);
    sstore(ra1, rb1, lds + STAGE);
    __syncthreads();
    if (kt + 3 < nk) gload(ra1, rb1, kt + 3);
    compute(lds + STAGE);
    if (kt + 2 < nk) sstore(ra0, rb0, lds);
    __syncthreads();
  }
}
DI void ph_gemm_plain32(const bf16_t* A, int lda, const bf16_t* Bt, int ldb, int M, int N, int K, bf16_t* C, int ldc, char* lds, int bid, int nblk) {
  const int t = TIDX, lane = t & 63, wid = t >> 6, wr = wid >> 1, wc = wid & 1, lr = t >> 3, lc = (t & 7) * 8, l31 = lane & 31, hh = lane >> 5;
  const int ntn = N / 128, nt = (M / 128) * ntn;
#pragma unroll 1
  for (int tile = bid; tile < nt; tile += nblk) {
    const int tm = tile / ntn, tn = tile % ntn;
    const bf16_t* ap[4]; const bf16_t* bp[4];
#pragma unroll
    for (int i = 0; i < 4; ++i) { ap[i] = A + (size_t)(tm * 128 + lr + 32 * i) * lda + lc; bp[i] = Bt + (size_t)(tn * 128 + lr + 32 * i) * ldb + lc; }
    f32x16 acc[2][2];
#pragma unroll
    for (int m = 0; m < 2; ++m)
#pragma unroll
      for (int n = 0; n < 2; ++n) acc[m][n] = (f32x16)(0.f);
    gemm_kloop32(acc, ap, bp, K / 64, lds);
#pragma unroll
    for (int m = 0; m < 2; ++m)
#pragma unroll
      for (int n = 0; n < 2; ++n)
#pragma unroll
        for (int g = 0; g < 4; ++g) {
          f32x4 o = {acc[m][n][4 * g], acc[m][n][4 * g + 1], acc[m][n][4 * g + 2], acc[m][n][4 * g + 3]};
          st_bf16x4(C + (size_t)(tm * 128 + wr * 64 + m * 32 + l31) * ldc + tn * 128 + wc * 64 + n * 32 + 8 * g + 4 * hh, o);
        }
  }
}
template <int MODE>
DI void ph_gemm_probe(const bf16_t* A, int lda, const bf16_t* Bt, int ldb, int M, int N, int K, float* sink, char* lds, int bid, int nblk) {
  const int t = TIDX, lane = t & 63, wid = t >> 6, wr = wid >> 1, wc = wid & 1, lr = t >> 3, lc = (t & 7) * 8, fr = lane & 15, fq = lane >> 4;
  const int ntn = N / 128, nt = (M / 128) * ntn, nk = K / 64;
  constexpr int STAGE = A_BYTES + 128 * LROW;
  const int aoff = (wr * 64 + fr) * LROW + fq * 16, boff = A_BYTES + (wc * 64 + fr) * LROW + fq * 16;
#pragma unroll 1
  for (int tile = bid; tile < nt; tile += nblk) {
    f32x4 acc[4][4]; acc_zero<4>(acc);
    bf16x8 af[4], bfr[4];
    const int tm = tile / ntn, tn = tile % ntn;
    const bf16_t* ap[4]; const bf16_t* bp[4];
#pragma unroll
    for (int i = 0; i < 4; ++i) { ap[i] = A + (size_t)(tm * 128 + lr + 32 * i) * lda + lc; bp[i] = Bt + (size_t)(tn * 128 + lr + 32 * i) * ldb + lc; }
    u32x4 ra[4], rb[4], junk = {0u, 0u, 0u, 0u};
#pragma unroll
    for (int i = 0; i < 4; ++i) { ra[i] = junk; rb[i] = junk; }
#pragma unroll 1
    for (int kt = 0; kt < nk; ++kt) {
      const char* cur = lds + (kt & 1) * STAGE;
#pragma unroll
      for (int i = 0; i < 4; ++i) { ra[i] = ldg16(ap[i] + kt * 64); if (MODE == 3) rb[i] = ldg16(bp[i] + kt * 64); }
#pragma unroll
      for (int ks = 0; ks < 2; ++ks) {
#pragma unroll
        for (int m = 0; m < 4; ++m) { af[m] = lds_frag(cur + aoff + m * 16 * LROW + ks * 64); bfr[m] = lds_frag(cur + boff + m * 16 * LROW + ks * 64); }
#pragma unroll
        for (int m = 0; m < 4; ++m)
#pragma unroll
          for (int n = 0; n < 4; ++n) acc[m][n] = MFMA16(bfr[n], af[m], acc[m][n]);
      }
      junk.x ^= ra[0].x ^ ra[1].y ^ ra[2].z ^ ra[3].w ^ rb[0].x ^ rb[1].y ^ rb[2].z ^ rb[3].w;
      __syncthreads();
    }
    float s = (float)(junk.x & 1u);
#pragma unroll
    for (int m = 0; m < 4; ++m)
#pragma unroll
      for (int n = 0; n < 4; ++n) s += acc[m][n][0] + acc[m][n][3];
    if (s == 123456.789f) sink[0] = s;
  }
}
DI void ph_moe1(const Params& p, int need_ctx, char* lds, int bid, int nblk) {
  const int t = TIDX, lane = t & 63, wid = t >> 6, wr = wid >> 1, wc = wid & 1, lr = t >> 3, lc = (t & 7) * 8, fr = lane & 15, fq = lane >> 4;
  constexpr int NTN = FF / 64;
  const int NTM = need_ctx ? (NSLOT + 127) / 128 : (NB * CAPL) / 128;
  for (int u = bid; u < NE * NTM * NTN; u += nblk) {
    const int tile = xcd_swz(u, NE * NTM * NTN), e = tile / (NTM * NTN), rem = tile % (NTM * NTN);
    int tm, tn, rr = rem, g = 0;
    if (rr >= NTM * 8) { rr -= NTM * 8; g = 1; }
    if (rr >= NTM * 8) { rr -= NTM * 8; g = 2; }
    if (g < 2) { tm = rr >> 3; tn = g * 8 + (rr & 7); } else { tm = rr / (NTN - 16); tn = 16 + rr - tm * (NTN - 16); }
    const bf16_t* ap[4]; const bf16_t* bp[4];
#pragma unroll
    for (int i = 0; i < 4; ++i) {
      const int slot = tm * 128 + lr + 32 * i;
      int r = slot < NSLOT ? p.SEL[(size_t)e * NSLOT + slot] : -1;
      ap[i] = p.H + (size_t)(r < 0 ? 0 : r) * D + lc;
      const int rho = lr + 32 * i, wci = rho >> 6, gu = (rho >> 5) & 1, col = wci * 32 + (rho & 31);
      bp[i] = (gu ? p.Wt_eu : p.Wt_eg) + ((size_t)e * FF + tn * 64 + col) * D + lc;
    }
    f32x4 acc[4][4]; acc_zero<4>(acc);
    gemm_kloop<4>(acc, ap, bp, D / 64, lds);
    f32x4 hid[4][2];
#pragma unroll
    for (int m = 0; m < 4; ++m) {
      const int slot = tm * 128 + wr * 64 + m * 16 + fr;
      const bool valid = slot < NSLOT && p.SEL[(size_t)e * NSLOT + (slot < NSLOT ? slot : 0)] >= 0;
#pragma unroll
      for (int n = 0; n < 2; ++n)
#pragma unroll
        for (int j = 0; j < 4; ++j) { const float g = acc[m][n][j], u = acc[m][n + 2][j]; hid[m][n][j] = valid ? g * u * fast_rcp(1.0f + fast_exp2(-LOG2E * g)) : 0.f; }
    }
    const int slot0 = tm * 128 + wr * 64;
    store_wave_tile<2>(hid, p.HID + ((size_t)e * NSLOT + slot0) * FF + tn * 64 + wc * 32, (size_t)FF, lds + wid * (64 * 80), lane, [&](int r) { return slot0 + r < NSLOT; });
    __syncthreads();
  }
}
DI void ph_moe2(const Params& p, int need_ctx, char* lds, int bid, int nblk) {
  const int t = TIDX, lane = t & 63, wid = t >> 6, wr = wid >> 1, wc = wid & 1, lr = t >> 3, lc = (t & 7) * 8, fr = lane & 15, fq = lane >> 4;
  constexpr int NTN = D / 128;
  const int NTM = need_ctx ? (NSLOT + 127) / 128 : (NB * CAPL) / 128;
  for (int u = bid; u < NE * NTM * NTN; u += nblk) {
    const int tile = xcd_swz(u, NE * NTM * NTN), e = tile / (NTM * NTN), rem = tile % (NTM * NTN), tm = rem / NTN, tn = rem % NTN;
    const bf16_t* ap[4]; const bf16_t* bp[4];
#pragma unroll
    for (int i = 0; i < 4; ++i) {
      int slot = tm * 128 + lr + 32 * i; if (slot >= NSLOT) slot = NSLOT - 1;
      ap[i] = p.HID + ((size_t)e * NSLOT + slot) * FF + lc;
      bp[i] = p.Wt_ed + ((size_t)e * D + tn * 128 + lr + 32 * i) * FF + lc;
    }
    f32x4 acc[4][4]; acc_zero<4>(acc);
    gemm_kloop<4>(acc, ap, bp, FF / 64, lds);
#pragma unroll
    for (int m = 0; m < 4; ++m) {
      const int slot = tm * 128 + wr * 64 + m * 16 + fr;
      const float val = (slot < NSLOT && p.SEL[(size_t)e * NSLOT + (slot < NSLOT ? slot : 0)] >= 0) ? p.SELV[(size_t)e * NSLOT + slot] : 0.f;
#pragma unroll
      for (int n = 0; n < 4; ++n) { acc[m][n].x *= val; acc[m][n].y *= val; acc[m][n].z *= val; acc[m][n].w *= val; }
    }
    const int slot0 = tm * 128 + wr * 64;
    store_wave_tile<4>(acc, p.YE + ((size_t)e * NSLOT + slot0) * D + tn * 128 + wc * 64, (size_t)D, lds + wid * (64 * 144), lane, [&](int r) { return slot0 + r < NSLOT; });
    __syncthreads();
  }
}
constexpr int GEMM_LDS = 2 * (A_BYTES + 128 * LROW);

DI void unpack8(u32x4 v, float (&f)[8]) {
  f[0] = u2f(v.x << 16); f[1] = u2f(v.x & 0xffff0000u); f[2] = u2f(v.y << 16); f[3] = u2f(v.y & 0xffff0000u);
  f[4] = u2f(v.z << 16); f[5] = u2f(v.z & 0xffff0000u); f[6] = u2f(v.w << 16); f[7] = u2f(v.w & 0xffff0000u);
}
DI u32x4 pack8f(const float (&f)[8]) { u32x4 v; v.x = pack2bf(f[0], f[1]); v.y = pack2bf(f[2], f[3]); v.z = pack2bf(f[4], f[5]); v.w = pack2bf(f[6], f[7]); return v; }
DI void rope8(float (&a)[8], const float (&pr)[8], int cc, const float* cs, const float* sn) {
  const int ax = (cc >> 1) * 8; const bool second = cc & 1;
#pragma unroll
  for (int i = 0; i < 8; ++i) a[i] = second ? a[i] * cs[ax + i] + pr[i] * sn[ax + i] : a[i] * cs[ax + i] - pr[i] * sn[ax + i];
}
constexpr int PREP_LDS = 64 * 4 + 2 * 512 * 4 + 32 * 528;
template <int PARTS = 3>
DI void ph_prep(const Params& p, int layer, const bf16_t* QRAW, const bf16_t* KVRAW, char* lds, int bid, int nblk) {
  float* s_rstd = (float*)lds;
  float* s_cs = s_rstd + 64;
  float* s_sn = s_cs + 512;
  bf16_t* s_t = (bf16_t*)(s_sn + 512);
  const int t = TIDX;
  constexpr int UPB = TK / 32, NU = NB * UPB;
  const float* wcv = p.w_conv + (size_t)layer * 3 * 512;
#pragma unroll 1
  for (int u = bid; u < NU; u += nblk) {
    int b, s0;
    if (u < NB * (TL / 32)) { b = u / (TL / 32); s0 = TC + (u % (TL / 32)) * 32; } else { const int v = u - NB * (TL / 32); b = v / (TC / 32); s0 = (v % (TC / 32)) * 32; }
    const int r0 = row_of(b, s0);
    {
      const int tok = t >> 3, part = t & 7;
      const bf16_t* z = p.Z + (size_t)(r0 + tok) * NZP;
      float sq = 0.f, sk = 0.f, f[8];
#pragma unroll
      for (int k = 0; k < 4; ++k) { unpack8(ldg16(z + ZC_QLAT + part * 32 + k * 8), f);
#pragma unroll
        for (int i = 0; i < 8; ++i) sq += f[i] * f[i]; }
#pragma unroll
      for (int k = 0; k < 2; ++k) { unpack8(ldg16(z + ZC_KVLAT + part * 16 + k * 8), f);
#pragma unroll
        for (int i = 0; i < 8; ++i) sk += f[i] * f[i]; }
      sq = xor_sum<1>(sq); sk = xor_sum<1>(sk);
      sq = xor_sum<2>(sq); sk = xor_sum<2>(sk);
      sq = xor_sum<4>(sq); sk = xor_sum<4>(sk);
      if (part == 0) { s_rstd[tok * 2] = 1.0f / sqrtf(sq * (1.0f / 256) + 1e-6f); s_rstd[tok * 2 + 1] = 1.0f / sqrtf(sk * (1.0f / 128) + 1e-6f); }
    }
    for (int i = t; i < 512; i += NTHR) {
      const int tok = i >> 4, af = i & 15, s = s0 + tok;
      float cs = 1.f, sn = 0.f;
      if (s >= TC) rope_cs(s, (af >> 3) * 16 + (af & 7), cs, sn);
      s_cs[i] = cs; s_sn[i] = sn;
    }
    __syncthreads();
    if (PARTS & 1) {
#pragma unroll 2
    for (int i = t; i < 32 * 48; i += NTHR) {
      const int tok = i / 48, c = i % 48, h = c / 12, ch = c % 12;
      const float rq = s_rstd[tok * 2] * QS_MLA, rkv = s_rstd[tok * 2 + 1];
      const bf16_t* q = QRAW + (size_t)(r0 + tok) * 384 + h * 96;
      float a[8], pr[8];
      unpack8(ldg16(q + ch * 8), a);
      if (ch >= 8) { unpack8(ldg16(q + 64 + ((ch - 8) ^ 1) * 8), pr); rope8(a, pr, ch - 8, s_cs + tok * 16, s_sn + tok * 16); }
#pragma unroll
      for (int e = 0; e < 8; ++e) a[e] *= rq;
      *(u32x4*)(p.Qm + (((size_t)b * 4 + h) * TK + s0 + tok) * 96 + ch * 8) = pack8f(a);
      if (ch < 8) {
        unpack8(ldg16(KVRAW + (size_t)(r0 + tok) * 512 + h * 128 + ch * 8), a);
#pragma unroll
        for (int e = 0; e < 8; ++e) a[e] *= rkv;
      } else {
        const bf16_t* z = p.Z + (size_t)(r0 + tok) * NZP + ZC_KROPE;
        unpack8(ldg16(z + (ch - 8) * 8), a); unpack8(ldg16(z + ((ch - 8) ^ 1) * 8), pr);
        rope8(a, pr, ch - 8, s_cs + tok * 16, s_sn + tok * 16);
      }
      *(u32x4*)(p.Km + (((size_t)b * 4 + h) * TK + s0 + tok) * 96 + ch * 8) = pack8f(a);
    }
#pragma unroll 2
    for (int i = t; i < 32 * 64; i += NTHR) {
      const int tok = i >> 6, c = i & 63, qk = c >> 5, hm = (c >> 2) & 7, cc = c & 3;
      const bf16_t* src = p.Z + (size_t)(r0 + tok) * NZP + (qk ? ZC_DK : ZC_DQ) + hm * 32;
      float a[8], pr[8];
      unpack8(ldg16(src + cc * 8), a); unpack8(ldg16(src + (cc ^ 1) * 8), pr);
      rope8(a, pr, cc, s_cs + tok * 16, s_sn + tok * 16);
      if (qk == 0) {
#pragma unroll
        for (int e = 0; e < 8; ++e) a[e] *= QS_DIFF;
        *(u32x4*)(p.Qd + (((size_t)b * 8 + hm) * TK + s0 + tok) * 32 + cc * 8) = pack8f(a);
      } else *(u32x4*)(p.Kd + (((size_t)b * 8 + hm) * TK + s0 + tok) * 32 + cc * 8) = pack8f(a);
    }
#pragma unroll 2
    for (int i = t; i < 32 * 64; i += NTHR) {
      const int tok = i >> 6, c8 = (i & 63) * 8, s = s0 + tok;
      const bool first = (s == 0) || (s == TC), last = (s == TC - 1) || (s == TK - 1);
      const bf16_t* z = p.Z + (size_t)(r0 + tok) * NZP + ZC_MLQK + c8;
      float x0[8], xm[8], xp[8], o[8];
      unpack8(ldg16(z), x0);
      if (!first) unpack8(ldg16(z - NZP), xm);
      if (!last) unpack8(ldg16(z + NZP), xp);
      float bc8[8], w0[8], w1[8], w2[8];
      *(f32x4*)bc8 = *(const f32x4*)(p.b_conv + layer * 512 + c8); *(f32x4*)(bc8 + 4) = *(const f32x4*)(p.b_conv + layer * 512 + c8 + 4);
      *(f32x4*)w0 = *(const f32x4*)(wcv + c8); *(f32x4*)(w0 + 4) = *(const f32x4*)(wcv + c8 + 4);
      *(f32x4*)w1 = *(const f32x4*)(wcv + 512 + c8); *(f32x4*)(w1 + 4) = *(const f32x4*)(wcv + 512 + c8 + 4);
      *(f32x4*)w2 = *(const f32x4*)(wcv + 1024 + c8); *(f32x4*)(w2 + 4) = *(const f32x4*)(wcv + 1024 + c8 + 4);
#pragma unroll
      for (int e = 0; e < 8; ++e) {
        float acc = bc8[e] + x0[e] * w1[e];
        if (!first) acc += xm[e] * w0[e];
        if (!last) acc += xp[e] * w2[e];
        o[e] = acc * fast_rcp(1.0f + fast_exp2(-LOG2E * acc));
      }
      if (c8 < 256) *(u32x4*)(p.MQ + ((size_t)b * TK + s) * 256 + c8) = pack8f(o);
      else {
#pragma unroll
        for (int e = 0; e < 8; ++e) o[e] *= 0.125f;
        *(u32x4*)(p.MK + ((size_t)b * TK + s) * 256 + c8 - 256) = pack8f(o);
      }
    }
    }
#pragma unroll 1
    for (int w = 0; w < ((PARTS & 2) ? 4 : 0); ++w) {
      __syncthreads();
#pragma unroll
      for (int k = 0; k < 4; ++k) {
        const int i = t + k * NTHR, tok = i >> 5, c8 = (i & 31) * 8;
        u32x4 v;
        if (w == 0) { float a[8]; const int h = c8 >> 6; unpack8(ldg16(KVRAW + (size_t)(r0 + tok) * 512 + h * 128 + 64 + (c8 & 63)), a); const float rkv = s_rstd[tok * 2 + 1];
#pragma unroll
          for (int e = 0; e < 8; ++e) a[e] *= rkv;
          v = pack8f(a); }
        else v = ldg16(p.Z + (size_t)(r0 + tok) * NZP + (w == 1 ? ZC_DV : (w == 2 ? ZC_MLV : ZC_GV)) + c8);
        *(u32x4*)(s_t + tok * 264 + c8) = v;
      }
      __syncthreads();
      bf16_t* dst = w == 0 ? p.Vtm : (w == 1 ? p.Vtd : (w == 2 ? p.MVt : p.GVt));
#pragma unroll
      for (int k = 0; k < 4; ++k) {
        const int i = t + k * NTHR, tg = i & 3, ch = i >> 2;
        u32x4 v;
        v.x = (unsigned)s_t[(tg * 8 + 0) * 264 + ch] | ((unsigned)s_t[(tg * 8 + 1) * 264 + ch] << 16);
        v.y = (unsigned)s_t[(tg * 8 + 2) * 264 + ch] | ((unsigned)s_t[(tg * 8 + 3) * 264 + ch] << 16);
        v.z = (unsigned)s_t[(tg * 8 + 4) * 264 + ch] | ((unsigned)s_t[(tg * 8 + 5) * 264 + ch] << 16);
        v.w = (unsigned)s_t[(tg * 8 + 6) * 264 + ch] | ((unsigned)s_t[(tg * 8 + 7) * 264 + ch] << 16);
        *(u32x4*)(dst + (((size_t)b * 4 + (ch >> 6)) * 64 + (ch & 63)) * TK + s0 + tg * 8) = v;
      }
    }
    __syncthreads();
  }
}
constexpr int VROW = 136;
constexpr int VROW_A = 144;
template <int DQK> struct AttnCfg {
  static constexpr int KROW = DQK * 2 + 16;
  static constexpr int KBYTES = 64 * KROW, VBYTES = 64 * VROW_A, STAGE = KBYTES + VBYTES;
  static constexpr int KCH = 64 * DQK * 2 / 16 / NTHR;
};
DI bf16x8 pack8(const f32x16& x, int s) {
  u32x4 pk; pk.x = pack2bf(x[8 * s], x[8 * s + 1]); pk.y = pack2bf(x[8 * s + 2], x[8 * s + 3]); pk.z = pack2bf(x[8 * s + 4], x[8 * s + 5]); pk.w = pack2bf(x[8 * s + 6], x[8 * s + 7]);
  return __builtin_bit_cast(bf16x8, pk);
}
struct TrueC { static constexpr bool value = true; };
struct FalseC { static constexpr bool value = false; };
template <int DQK, int NMAP, int VAR = 0>
DI void attn_unit(const bf16_t* __restrict__ Qb, const bf16_t* __restrict__ Kb, size_t mstride, const bf16_t* __restrict__ Vt, int q0, int nkeys,
                  f32x16 (&O)[NMAP][2], float (&lsum)[NMAP], char* lds) {
  constexpr int DM = DQK / NMAP;
  constexpr int KS = DM / 16;
  using C = AttnCfg<DQK>;
  constexpr int CPM = 64 * DM * 2 / 16;
  constexpr int CPR = DM * 2 / 16;
  const int t = TIDX, lane = t & 63, wid = t >> 6, l31 = lane & 31, hh = lane >> 5;
  bf16x8 qf[NMAP][KS];
#pragma unroll
  for (int m = 0; m < NMAP; ++m)
#pragma unroll
    for (int ks = 0; ks < KS; ++ks) qf[m][ks] = *(const bf16x8*)(Qb + m * mstride + (size_t)(q0 + wid * 32 + l31) * DM + ks * 16 + 8 * hh);
  float mref[NMAP];
  f32x4 lacc[NMAP];
  const short onev = ((lane & 15) < 2 && ((lane >> 4) & 1) == (lane & 15)) ? (short)0x3F80 : (short)0;
  const bf16x8 ones_a = {onev, onev, onev, onev, onev, onev, onev, onev};
#pragma unroll
  for (int m = 0; m < NMAP; ++m) { mref[m] = 0.f; lacc[m] = (f32x4){0.f, 0.f, 0.f, 0.f}; O[m][0] = (f32x16)(0.f); O[m][1] = (f32x16)(0.f); }
  u32x4 rk[C::KCH], rv[2];
  const bf16_t* kg[C::KCH]; int klds[C::KCH];
#pragma unroll
  for (int i = 0; i < C::KCH; ++i) { const int c = t + i * NTHR, m = c / CPM, cc = c % CPM; kg[i] = Kb + m * mstride + cc * 8; klds[i] = (cc / CPR) * C::KROW + m * DM * 2 + (cc % CPR) * 16; }
  const bf16_t* vg = Vt + (size_t)(t >> 3) * TK + (t & 7) * 8;
  const int vlds = C::KBYTES + (t >> 3) * VROW_A + ((t & 7) >> 1) * 32 + ((t & 1) ? 8 : 0);
  const int kfoff = l31 * C::KROW + 16 * hh, vfoff = C::KBYTES + l31 * VROW_A + 16 * hh;
  const int nt = nkeys / 64;
#pragma unroll
  for (int i = 0; i < C::KCH; ++i) rk[i] = ldg16(kg[i]);
  rv[0] = ldg16(vg); rv[1] = ldg16(vg + (size_t)32 * TK);
  auto tile = [&](const int kt, auto chk_c, auto ref_c) __attribute__((always_inline)) {
    constexpr bool CHK = decltype(chk_c)::value, REF = decltype(ref_c)::value;
    char* cur = lds + (kt & 1) * C::STAGE;
    if (VAR != 2) {
#pragma unroll
    for (int i = 0; i < C::KCH; ++i) sts16(cur + klds[i], rk[i]);
#pragma unroll
    for (int i = 0; i < 2; ++i) { char* d = cur + vlds + i * 32 * VROW_A; u32x2 lo, hi; lo.x = rv[i].x; lo.y = rv[i].y; hi.x = rv[i].z; hi.y = rv[i].w; *(u32x2*)d = lo; *(u32x2*)(d + 16) = hi; }
    __syncthreads();
    }
    if (VAR != 2 && kt + 1 < nt) {
#pragma unroll
      for (int i = 0; i < C::KCH; ++i) rk[i] = ldg16(kg[i] + (size_t)(kt + 1) * 64 * DM);
      rv[0] = ldg16(vg + (kt + 1) * 64); rv[1] = ldg16(vg + (size_t)32 * TK + (kt + 1) * 64);
    }
    bf16x8 kf[NMAP][2][KS];
#pragma unroll
    for (int k2 = 0; k2 < 2; ++k2)
#pragma unroll
      for (int ks = 0; ks < KS; ++ks) kf[0][k2][ks] = lds_frag(cur + kfoff + k2 * 32 * C::KROW + ks * 32);
    f32x16 S[NMAP][2];
    S[0][0] = (f32x16)(0.f); S[0][1] = (f32x16)(0.f);
#pragma unroll
    for (int ks = 0; ks < KS; ++ks)
#pragma unroll
      for (int k2 = 0; k2 < 2; ++k2) S[0][k2] = MFMA32(kf[0][k2][ks], qf[0][ks], S[0][k2]);
    bf16x8 vf[4][2];
#pragma unroll
    for (int kst = 0; kst < 4; ++kst)
#pragma unroll
      for (int dvt = 0; dvt < 2; ++dvt) vf[kst][dvt] = lds_frag(cur + vfoff + dvt * 32 * VROW_A + kst * 32);
#pragma unroll
    for (int m = 1; m < NMAP; ++m)
#pragma unroll
      for (int k2 = 0; k2 < 2; ++k2)
#pragma unroll
        for (int ks = 0; ks < KS; ++ks) kf[m][k2][ks] = lds_frag(cur + kfoff + k2 * 32 * C::KROW + m * DM * 2 + ks * 32);
#pragma unroll
    for (int m = 0; m < NMAP; ++m) {
      if (m > 0) {
        SCHED_BARRIER();
        S[m][0] = (f32x16)(0.f); S[m][1] = (f32x16)(0.f);
#pragma unroll
        for (int ks = 0; ks < KS; ++ks)
#pragma unroll
          for (int k2 = 0; k2 < 2; ++k2) S[m][k2] = MFMA32(kf[m][k2][ks], qf[m][ks], S[m][k2]);
      }
      if (VAR != 1) {
      if (CHK && (kt & 7) == 0) {
        float mx = fmaxf(S[m][0][0], S[m][1][0]);
#pragma unroll
        for (int i = 1; i < 16; ++i) mx = fmaxf(mx, fmaxf(S[m][0][i], S[m][1][i]));
        mx = xor_max<32>(mx);
        const float rel = mx - mref[m];
        const float delta = (kt == 0) ? ((mx > ATT_THR || mx < -ATT_THR) ? mx : 0.0f) : (rel > ATT_THR ? rel : 0.0f);
        if (wave_any(delta != 0.0f)) {
          const float alpha = fast_exp2(-delta);
          mref[m] += delta; lacc[m][0] *= alpha; lacc[m][1] *= lane_get(alpha, (lane & 15) + 16);
#pragma unroll
          for (int dvt = 0; dvt < 2; ++dvt)
#pragma unroll
            for (int i = 0; i < 16; ++i) O[m][dvt][i] *= alpha;
        }
      }
      if constexpr (REF) {
        if (wave_any(mref[m] != 0.0f)) {
          const f32x2 nm = {-mref[m], -mref[m]};
#pragma unroll
          for (int k2 = 0; k2 < 2; ++k2)
#pragma unroll
            for (int i = 0; i < 16; i += 2) { const f32x2 x = (f32x2){S[m][k2][i], S[m][k2][i + 1]} + nm; S[m][k2][i] = x.x; S[m][k2][i + 1] = x.y; }
        }
      }
#pragma unroll
      for (int k2 = 0; k2 < 2; ++k2)
#pragma unroll
        for (int i = 0; i < 16; ++i) S[m][k2][i] = fast_exp2(S[m][k2][i]);
      }
#pragma unroll
      for (int kst = 0; kst < 4; ++kst) {
        const bf16x8 pf = pack8(S[m][kst >> 1], kst & 1);
#pragma unroll
        for (int dvt = 0; dvt < 2; ++dvt) O[m][dvt] = MFMA32(vf[kst][dvt], pf, O[m][dvt]);
        lacc[m] = MFMA16(ones_a, pf, lacc[m]);
      }
    }
  };
  int kt = 0;
#pragma unroll 1
  while (kt < nt) {
    tile(kt, TrueC{}, TrueC{});
    ++kt;
    bool nz = false;
#pragma unroll
    for (int m = 0; m < NMAP; ++m) nz = nz || (mref[m] != 0.0f);
    if (!wave_any(nz)) {
      const int k8 = (kt + 7) & ~7, kend = k8 < nt ? k8 : nt;
#pragma unroll 1
      for (; kt < kend; ++kt) tile(kt, FalseC{}, FalseC{});
    }
  }
  __syncthreads();
#pragma unroll
  for (int m = 0; m < NMAP; ++m) { const float a0 = lane_get(lacc[m][0], lane & 15), a1 = lane_get(lacc[m][1], lane & 15); lsum[m] = l31 < 16 ? a0 : a1; }
}
constexpr int ATT_QB = TK / 128;
constexpr int ATT_LDS = 2 * AttnCfg<96>::STAGE;
constexpr int ATT_QBL = TL / 128, ATT_QBC = TC / 128, ATT_LAT_UNITS = NB * 4 * ATT_QBL, ATT_UNITS = ATT_LAT_UNITS + NB * 4 * ATT_QBC;
DI void att_unit(int u, int& bh, int& qb) {
  if (u < ATT_LAT_UNITS) { bh = u & 7; qb = ATT_QBC + (u >> 3); } else { const int v = u - ATT_LAT_UNITS; bh = v & 7; qb = v >> 3; }
}
DI void ph_attn_diff(const Params& p, int layer, int need_ctx, char* lds, int bid, int nblk) {
  const int lane = TIDX & 63, wid = TIDX >> 6, l31 = lane & 31, hh = lane >> 5;
  float lam_init; const float lam = lam_of(p, layer, lam_init);
#pragma unroll 1
  for (int u = bid; u < (need_ctx ? ATT_UNITS : ATT_LAT_UNITS); u += nblk) {
    int bh, qb; att_unit(u, bh, qb);
    const int b = bh >> 2, h = bh & 3, q0 = qb * 128;
    const int r = row_of(b, q0 + wid * 32 + l31);
    f32x16 O[2][2]; float ls[2];
    attn_unit<64, 2>(p.Qd + ((size_t)b * 8 + h * 2) * TK * 32, p.Kd + ((size_t)b * 8 + h * 2) * TK * 32, (size_t)TK * 32, p.Vtd + ((size_t)b * 4 + h) * 64 * TK, q0,
                     q0 < TC ? TC : TK, O, ls, lds);
    const float i0 = 1.0f / ls[0], i1 = lam / ls[1];
    float ss = 0.f;
#pragma unroll
    for (int dvt = 0; dvt < 2; ++dvt)
#pragma unroll
      for (int i = 0; i < 16; ++i) { const float o = O[0][dvt][i] * i0 - O[1][dvt][i] * i1; O[0][dvt][i] = o; ss += o * o; }
    ss = xor_sum<32>(ss);
    const float rstd = (1.0f - lam_init) / sqrtf(ss * (1.0f / 64) + 1e-6f);
    const float* gd = p.g_diff_out + layer * 256 + h * 64;
#pragma unroll
    for (int dvt = 0; dvt < 2; ++dvt)
#pragma unroll
      for (int g = 0; g < 4; ++g) {
        const int dv = dvt * 32 + 8 * g + 4 * hh;
        const f32x4 gv = *(const f32x4*)(gd + dv);
        f32x4 o = {O[0][dvt][4 * g] * rstd * gv[0], O[0][dvt][4 * g + 1] * rstd * gv[1], O[0][dvt][4 * g + 2] * rstd * gv[2], O[0][dvt][4 * g + 3] * rstd * gv[3]};
        st_bf16x4(p.Y + (size_t)r * D + 768 + h * 64 + dv, o);
      }
  }
}
DI void ph_attn_mla(const Params& p, int need_ctx, char* lds, int bid, int nblk) {
  const int lane = TIDX & 63, wid = TIDX >> 6, l31 = lane & 31, hh = lane >> 5;
#pragma unroll 1
  for (int u = bid; u < (need_ctx ? ATT_UNITS : ATT_LAT_UNITS); u += nblk) {
    int bh, qb; att_unit(u, bh, qb);
    const int b = bh >> 2, h = bh & 3, q0 = qb * 128;
    const int r = row_of(b, q0 + wid * 32 + l31);
    f32x16 O[1][2]; float ls[1];
    attn_unit<96, 1>(p.Qm + ((size_t)b * 4 + h) * TK * 96, p.Km + ((size_t)b * 4 + h) * TK * 96, 0, p.Vtm + ((size_t)b * 4 + h) * 64 * TK, q0, q0 < TC ? TC : TK, O, ls, lds);
    const float inv = 1.0f / ls[0];
#pragma unroll
    for (int dvt = 0; dvt < 2; ++dvt)
#pragma unroll
      for (int g = 0; g < 4; ++g) {
        f32x4 o = {O[0][dvt][4 * g] * inv, O[0][dvt][4 * g + 1] * inv, O[0][dvt][4 * g + 2] * inv, O[0][dvt][4 * g + 3] * inv};
        st_bf16x4(p.Y + (size_t)r * D + h * 64 + dvt * 32 + 8 * g + 4 * hh, o);
      }
  }
}
template <int VAR> DI void ph_attn_mla_probe(const Params& p, char* lds, int bid, int nblk) {
  const int lane = TIDX & 63, wid = TIDX >> 6, l31 = lane & 31, hh = lane >> 5;
#pragma unroll 1
  for (int u = bid; u < ATT_LAT_UNITS; u += nblk) {
    int bh, qb; att_unit(u, bh, qb);
    const int b = bh >> 2, h = bh & 3, q0 = qb * 128;
    const int r = row_of(b, q0 + wid * 32 + l31);
    f32x16 O[1][2]; float ls[1];
    attn_unit<96, 1, VAR>(p.Qm + ((size_t)b * 4 + h) * TK * 96, p.Km + ((size_t)b * 4 + h) * TK * 96, 0, p.Vtm + ((size_t)b * 4 + h) * 64 * TK, q0, TK, O, ls, lds);
    const float inv = 1.0f / ls[0];
#pragma unroll
    for (int dvt = 0; dvt < 2; ++dvt)
#pragma unroll
      for (int g = 0; g < 4; ++g) {
        f32x4 o = {O[0][dvt][4 * g] * inv, O[0][dvt][4 * g + 1] * inv, O[0][dvt][4 * g + 2] * inv, O[0][dvt][4 * g + 3] * inv};
        *(f32x4*)(p.out + (size_t)r * D + h * 64 + dvt * 32 + 8 * g + 4 * hh) = o;
      }
  }
}
DI void ph_attn(const Params& p, int layer, int need_ctx, char* lds, int bid, int nblk) {
  ph_attn_diff(p, layer, need_ctx, lds, bid, nblk);
  ph_attn_mla(p, need_ctx, lds, bid, nblk);
}

DI float wave_sum(float v) {
  v = xor_sum<1>(v); v = xor_sum<2>(v); v = xor_sum<4>(v); v = xor_sum<8>(v); v = xor_sum<16>(v); v = xor_sum<32>(v);
  return v;
}
DI void ld_row16(const float* row, int lane, f32x4 (&v)[4]) {
#pragma unroll
  for (int i = 0; i < 4; ++i) v[i] = *(const f32x4*)(row + 256 * i + 4 * lane);
}
DI void ld_row16_bf(const bf16_t* row, int lane, f32x4 (&v)[4]) {
#pragma unroll
  for (int i = 0; i < 4; ++i) { const u32x2 u = *(const u32x2*)(row + 256 * i + 4 * lane); v[i] = (f32x4){u2f(u.x << 16), u2f(u.x & 0xffff0000u), u2f(u.y << 16), u2f(u.y & 0xffff0000u)}; }
}
DI void ph_modulate(const Params& p, int layer, const float* xl, const float* xcx, int bid, int nblk) {
  const int lane = TIDX & 63, wid = TIDX >> 6;
  const float* g = p.g_mix_pre + layer * 1024;
  for (int r = bid * 4 + wid; r < R; r += nblk * 4) {
    const int w = r < RL ? r / TL : 2;
    const float* mb = p.mods + (size_t)(layer * 3 + w) * 6144;
    const float* x = r < RL ? xl + (size_t)r * D : xcx + (size_t)(r - RL) * D;
    f32x4 xv[4], gv[4], sc[4], sh[4];
    ld_row16(x, lane, xv); ld_row16(g, lane, gv); ld_row16(mb + 1024, lane, sc); ld_row16(mb, lane, sh);
    float ss = 0.f;
#pragma unroll
    for (int i = 0; i < 4; ++i)
#pragma unroll
      for (int e = 0; e < 4; ++e) ss += xv[i][e] * xv[i][e];
    const float rstd = 1.0f / sqrtf(wave_sum(ss) * (1.0f / D) + 1e-6f);
#pragma unroll
    for (int i = 0; i < 4; ++i) {
      f32x4 o;
#pragma unroll
      for (int e = 0; e < 4; ++e) o[e] = xv[i][e] * rstd * gv[i][e] * (1.f + sc[i][e]) + sh[i][e];
      st_bf16x4(p.H + (size_t)r * D + 256 * i + 4 * lane, o);
    }
  }
}
DI void ph_resid_mix(const Params& p, int layer, const float* xl_in, const float* xc_in, int rows, char* lds, int bid, int nblk) {
  const int lane = TIDX & 63, wid = TIDX >> 6;
  const float* wr = p.w_router + (size_t)layer * D * 16;
  for (int i = TIDX; i < D * 4; i += NTHR) { const int k = i >> 2, q = i & 3; *(f32x4*)(lds + k * 64 + (k >> 2) * 16 + q * 16) = *(const f32x4*)(wr + k * 16 + q * 4); }
  __syncthreads();
  for (int r = bid * 4 + wid; r < rows; r += nblk * 4) {
    const int w = r < RL ? r / TL : 2;
    const float* mb = p.mods + (size_t)(layer * 3 + w) * 6144;
    const float* xin = r < RL ? xl_in + (size_t)r * D : xc_in + (size_t)(r - RL) * D;
    float* xo = r < RL ? p.out + (size_t)r * D : p.xc + (size_t)(r - RL) * D;
    f32x4 yv[4], xv[4], a[4], c[4];
    ld_row16_bf(p.YO + (size_t)r * D, lane, yv); ld_row16(xin, lane, xv);
    float ss = 0.f;
#pragma unroll
    for (int i = 0; i < 4; ++i)
#pragma unroll
      for (int e = 0; e < 4; ++e) ss += yv[i][e] * yv[i][e];
    const float rstd = 1.0f / sqrtf(wave_sum(ss) * (1.0f / D) + 1e-6f);
    ld_row16(mb + 2 * 1024, lane, a); ld_row16(p.g_mix_post + layer * 1024, lane, c);
    float s2 = 0.f;
#pragma unroll
    for (int i = 0; i < 4; ++i) {
#pragma unroll
      for (int e = 0; e < 4; ++e) { xv[i][e] += a[i][e] * yv[i][e] * rstd * c[i][e]; s2 += xv[i][e] * xv[i][e]; }
      *(f32x4*)(xo + 256 * i + 4 * lane) = xv[i];
    }
    const float rstd2 = 1.0f / sqrtf(wave_sum(s2) * (1.0f / D) + 1e-6f);
    ld_row16(p.g_ffn_pre + layer * 1024, lane, a); ld_row16(mb + 4 * 1024, lane, c); ld_row16(mb + 3 * 1024, lane, yv);
    float lg[16];
#pragma unroll
    for (int e = 0; e < 16; ++e) lg[e] = 0.f;
#pragma unroll
    for (int i = 0; i < 4; ++i) {
      f32x4 h2;
#pragma unroll
      for (int e = 0; e < 4; ++e) h2[e] = xv[i][e] * rstd2 * a[i][e] * (1.f + c[i][e]) + yv[i][e];
      st_bf16x4(p.H + (size_t)r * D + 256 * i + 4 * lane, h2);
#pragma unroll
      for (int e = 0; e < 4; ++e) {
        const char* wk = lds + (256 * i + 4 * lane + e) * 64 + (64 * i + lane) * 16;
#pragma unroll
        for (int q = 0; q < 4; ++q) { const f32x4 wv = *(const f32x4*)(wk + 16 * q); lg[4 * q] += h2[e] * wv[0]; lg[4 * q + 1] += h2[e] * wv[1]; lg[4 * q + 2] += h2[e] * wv[2]; lg[4 * q + 3] += h2[e] * wv[3]; }
      }
    }
#pragma unroll
    for (int e = 0; e < 16; ++e) lg[e] = wave_sum(lg[e]);
    float mx = lg[0];
#pragma unroll
    for (int e = 1; e < 16; ++e) mx = fmaxf(mx, lg[e]);
    float sm = 0.f;
#pragma unroll
    for (int e = 0; e < 16; ++e) { lg[e] = expf(lg[e] - mx); sm += lg[e]; }
    int b, s; bs_of(r, b, s);
    float mine = 0.f;
#pragma unroll
    for (int e = 0; e < 16; ++e) mine = (lane == e) ? lg[e] / sm : mine;
    if (lane < 16) p.AFF[((size_t)b * NE + lane) * TK + s] = mine;
  }
}
DI void ph_resid_ffn(const Params& p, int layer, int rows, int bid, int nblk) {
  const int lane = TIDX & 63, wid = TIDX >> 6;
  for (int r = bid * 4 + wid; r < rows; r += nblk * 4) {
    const int w = r < RL ? r / TL : 2;
    const float* mb = p.mods + (size_t)(layer * 3 + w) * 6144;
    float* xo = r < RL ? p.out + (size_t)r * D : p.xc + (size_t)(r - RL) * D;
    const int myinv = lane < NE ? p.INV[(size_t)r * NE + lane] : -1;
    f32x4 f[4];
#pragma unroll
    for (int i = 0; i < 4; ++i) f[i] = (f32x4){0.f, 0.f, 0.f, 0.f};
    for (int e = 0; e < NE; ++e) {
      const int sl = lane_bcast(myinv, e);
      if (sl >= 0) { f32x4 yv[4]; ld_row16_bf(p.YE + ((size_t)e * NSLOT + sl) * D, lane, yv);
#pragma unroll
        for (int i = 0; i < 4; ++i) f[i] += yv[i]; }
    }
    float ss = 0.f;
#pragma unroll
    for (int i = 0; i < 4; ++i)
#pragma unroll
      for (int e = 0; e < 4; ++e) ss += f[i][e] * f[i][e];
    const float rstd = 1.0f / sqrtf(wave_sum(ss) * (1.0f / D) + 1e-6f);
    f32x4 a[4], c[4], xv[4];
    ld_row16(mb + 5 * 1024, lane, a); ld_row16(p.g_ffn_post + layer * 1024, lane, c); ld_row16(xo, lane, xv);
#pragma unroll
    for (int i = 0; i < 4; ++i) {
#pragma unroll
      for (int e = 0; e < 4; ++e) xv[i][e] += a[i][e] * f[i][e] * rstd * c[i][e];
      *(f32x4*)(xo + 256 * i + 4 * lane) = xv[i];
    }
  }
}
DI void ph_mods(const Params& p, char* lds, int bid, int nblk) {
  float* sc = (float*)lds;
  const int t = TIDX;
  for (int i = t; i < 3 * 1024; i += NTHR) { const float v = i < 2048 ? p.c[i] : p.c_ctx[i - 2048]; sc[i] = v / (1.0f + expf(-v)); }
  __syncthreads();
#pragma unroll 1
  for (long gi = (long)bid * NTHR + t; gi < 2 * 3 * 6144; gi += (long)nblk * NTHR) {
    const int col = (int)(gi % 6144), w = (int)((gi / 6144) % 3), l = (int)(gi / (3 * 6144));
    const float* W = p.w_ada + (size_t)l * 1024 * 6144 + col; const float* s = sc + w * 1024;
    float acc[8];
#pragma unroll
    for (int q = 0; q < 8; ++q) acc[q] = 0.f;
#pragma unroll 1
    for (int k = 0; k < 1024; k += 8) {
#pragma unroll
      for (int q = 0; q < 8; ++q) acc[q] += s[k + q] * W[(size_t)(k + q) * 6144];
    }
    p.mods[gi] = ((acc[0] + acc[1]) + (acc[2] + acc[3])) + ((acc[4] + acc[5]) + (acc[6] + acc[7])) + p.b_ada[l * 6144 + col];
  }
  __syncthreads();
}
constexpr int TOPK_LDS = TL * 4 + 2048;
DI int block_sum_i(int v, int* red) {
  const int lane = TIDX & 63, wid = TIDX >> 6;
  v = xor_sum_i<1>(v); v = xor_sum_i<2>(v); v = xor_sum_i<4>(v); v = xor_sum_i<8>(v); v = xor_sum_i<16>(v); v = xor_sum_i<32>(v);
  __syncthreads();
  if (lane == 0) red[wid] = v;
  __syncthreads();
  return red[0] + red[1] + red[2] + red[3];
}
DI int block_excl_scan(int v, int* red) {
  const int lane = TIDX & 63, wid = TIDX >> 6;
  int inc = v;
#pragma unroll
  for (int d = 1; d < 64; d <<= 1) { const int o = lane_up(inc, d, lane); if (lane >= d) inc += o; }
  __syncthreads();
  if (lane == 63) red[wid] = inc;
  __syncthreads();
  int base = 0;
  for (int q = 0; q < wid; ++q) base += red[q];
  return base + inc - v;
}
DI void ph_topk(const Params& p, int need_ctx, char* lds, int bid, int nblk) {
  unsigned* vals = (unsigned*)lds; int* red = (int*)(lds + TL * 4 + 1024);
  const int t = TIDX;
  for (int u = bid; u < NB * NE * 2; u += nblk) {
    const int seg = u & 1, e = (u >> 1) % NE, b = u / (2 * NE);
    const int s0 = seg ? TC : 0, n = seg ? TL : TC, cap = seg ? CAPL : CAPC, slot0 = seg ? b * CAPL : NB * CAPL + b * CAPC;
    if (seg == 0 && !need_ctx) { for (int q = t; q < cap; q += NTHR) p.SEL[(size_t)e * NSLOT + slot0 + q] = -1; continue; }
    const float* a = p.AFF + ((size_t)b * NE + e) * TK + s0;
    const int vpt = (n + NTHR - 1) / NTHR, i0 = t * vpt, i1 = (i0 + vpt < n) ? i0 + vpt : n;
    for (int i = t; i < n; i += NTHR) vals[i + i / vpt] = f2u(a[i]);
    __syncthreads();
    unsigned thr = 0;
    for (int bit = 31; bit >= 0; --bit) {
      const unsigned cand = thr | (1u << bit);
      int cnt = 0;
      for (int i = i0; i < i1; ++i) cnt += (vals[i + t] >= cand);
      if (block_sum_i(cnt, red) >= cap) thr = cand;
    }
    int cgt = 0, ceq = 0;
    for (int i = i0; i < i1; ++i) { cgt += (vals[i + t] > thr); ceq += (vals[i + t] == thr); }
    const int ngt = block_sum_i(cgt, red);
    const int neq = cap - ngt;
    int eqoff = block_excl_scan(ceq, red);
    int csel = 0;
    { int er = eqoff; for (int i = i0; i < i1; ++i) { if (vals[i + t] > thr) ++csel; else if (vals[i + t] == thr) { if (er < neq) ++csel; ++er; } } }
    int q = block_excl_scan(csel, red);
    for (int i = i0; i < i1; ++i) {
      const unsigned v = vals[i + t]; int sel = -1;
      if (v > thr) sel = q++; else if (v == thr) { if (eqoff < neq) sel = q++; ++eqoff; }
      const int r = row_of(b, s0 + i);
      if (sel >= 0) { p.SEL[(size_t)e * NSLOT + slot0 + sel] = r; p.SELV[(size_t)e * NSLOT + slot0 + sel] = u2f(v); }
      p.INV[(size_t)r * NE + e] = sel >= 0 ? slot0 + sel : -1;
    }
    __syncthreads();
  }
}
DI void ph_wt(const float* in, bf16_t* out, int K, int N, int NP, int nbatch, long in_bs, long out_bs, const float* gain, char* lds, int bid, int nblk) {
  float* tile = (float*)lds;
  const int t = TIDX, tk = K / 64, tn = NP / 64, ntile = nbatch * tk * tn;
  f32x4 v[4];
  auto gload = [&](int u) {
    const int bt = u / (tk * tn), rem = u % (tk * tn), k0 = (rem / tn) * 64, n0 = (rem % tn) * 64;
    const float* I = in + (size_t)bt * in_bs;
#pragma unroll
    for (int i = 0; i < 4; ++i) {
      const int idx = t + i * NTHR, kk = idx >> 4, n4 = (idx & 15) * 4;
      v[i] = (f32x4){0.f, 0.f, 0.f, 0.f};
      if (n0 + n4 < N) v[i] = *(const f32x4*)(I + (size_t)(k0 + kk) * N + n0 + n4);
      if (gain) { const float g = gain[k0 + kk]; v[i][0] *= g; v[i][1] *= g; v[i][2] *= g; v[i][3] *= g; }
    }
  };
  if (bid < ntile) gload(bid);
#pragma unroll 1
  for (int u = bid; u < ntile; u += nblk) {
    const int bt = u / (tk * tn), rem = u % (tk * tn), k0 = (rem / tn) * 64, n0 = (rem % tn) * 64;
    bf16_t* O = out + (size_t)bt * out_bs;
#pragma unroll
    for (int i = 0; i < 4; ++i) { const int idx = t + i * NTHR, kk = idx >> 4, n4 = (idx & 15) * 4; float* d = tile + kk * 65 + n4; d[0] = v[i][0]; d[1] = v[i][1]; d[2] = v[i][2]; d[3] = v[i][3]; }
    __syncthreads();
    if (u + nblk < ntile) gload(u + nblk);
#pragma unroll
    for (int i = 0; i < 2; ++i) {
      const int idx = t + i * NTHR, kg = idx & 7, nn = idx >> 3;
      float a[8];
#pragma unroll
      for (int e = 0; e < 8; ++e) a[e] = tile[(kg * 8 + e) * 65 + nn];
      u32x4 o; o.x = pack2bf(a[0], a[1]); o.y = pack2bf(a[2], a[3]); o.z = pack2bf(a[4], a[5]); o.w = pack2bf(a[6], a[7]);
      *(u32x4*)(O + (size_t)(n0 + nn) * K + k0 + kg * 8) = o;
    }
    __syncthreads();
  }
}
DI float wave_max(float v) {
  v = xor_max<1>(v); v = xor_max<2>(v); v = xor_max<4>(v); v = xor_max<8>(v); v = xor_max<16>(v); v = xor_max<32>(v);
  return v;
}
DI bf16x8 cvt8(const float* f) {
  const f32x4 a = *(const f32x4*)f, b = *(const f32x4*)(f + 4);
  u32x4 pk; pk.x = pack2bf(a[0], a[1]); pk.y = pack2bf(a[2], a[3]); pk.z = pack2bf(b[0], b[1]); pk.w = pack2bf(b[2], b[3]);
  return __builtin_bit_cast(bf16x8, pk);
}
constexpr int SCAN_UNITS = NB * NCK * 4, SCAN_LAT_UNITS = NB * NCL * 4;
DI void scan_unit(int u, int& b, int& c, int& h) {
  h = u & 3;
  if (u < SCAN_LAT_UNITS) { c = NCC + (u >> 2) % NCL; b = u / (4 * NCL); } else { const int v = u - SCAN_LAT_UNITS; c = (v >> 2) % NCC; b = v / (4 * NCC); }
}

DI void ph_ml_local(const Params& p, char* lds, int bid, int nblk) {
  bf16_t* sK = (bf16_t*)lds;
  float* sW = (float*)(lds + 64 * 132);
  const int t = TIDX, lane = t & 63, wid = t >> 6, l31 = lane & 31, hh = lane >> 5;
  const int d = wid & 1, vt = wid >> 1;
#pragma unroll 1
  for (int u = bid; u < SCAN_UNITS; u += nblk) {
    int b, c, h; scan_unit(u, b, c, h);
    {
      const int row = t >> 2, seg = (t & 3) * 16;
      const bf16_t* src = p.MK + ((size_t)b * TK + 64 * c + row) * 256 + h * 64 + seg;
      const u32x4 a = ldg16(src), bb = ldg16(src + 8);
      unsigned* dst = (unsigned*)((char*)sK + row * 132 + seg * 2);
      dst[0] = a.x; dst[1] = a.y; dst[2] = a.z; dst[3] = a.w; dst[4] = bb.x; dst[5] = bb.y; dst[6] = bb.z; dst[7] = bb.w;
    }
    if (t < 128) {
      const int dd = t >> 6, l = t & 63, j = step_of(dd, c), pos = dd ? 63 - l : l;
      const size_t o = (((size_t)b * 2 + dd) * TK + 64 * j) * 4 + h;
      const float bend = p.BC[o + 63 * 4], wl = bend - p.BC[o + pos * 4] + p.IGS[o + pos * 4];
      const float ml = wave_max(wl);
      sW[dd * 64 + l] = expf(wl - ml);
      if (l == 0) { const size_t uu = (((size_t)b * 2 + dd) * NCK + j) * 4 + h; p.MM[uu * 4] = ml; p.MM[uu * 4 + 1] = bend; }
    }
    __syncthreads();
    const int j = step_of(d, c);
    const size_t uu = (((size_t)b * 2 + d) * NCK + j) * 4 + h;
    f32x16 acc[2]; acc[0] = (f32x16)(0.f); acc[1] = (f32x16)(0.f);
    const bf16_t* vsrc = p.MVt + (((size_t)b * 4 + h) * 64 + vt * 32 + l31) * TK + 64 * c;
#pragma unroll
    for (int ks = 0; ks < 4; ++ks) {
      const bf16x8 a = *(const bf16x8*)(vsrc + ks * 16 + 8 * hh);
      const float* w = sW + d * 64 + ks * 16 + 8 * hh;
      u32x4 pk;
      pk.x = pack2bf(bf2f((bf16_t)a[0]) * w[0], bf2f((bf16_t)a[1]) * w[1]); pk.y = pack2bf(bf2f((bf16_t)a[2]) * w[2], bf2f((bf16_t)a[3]) * w[3]);
      pk.z = pack2bf(bf2f((bf16_t)a[4]) * w[4], bf2f((bf16_t)a[5]) * w[5]); pk.w = pack2bf(bf2f((bf16_t)a[6]) * w[6], bf2f((bf16_t)a[7]) * w[7]);
      const bf16x8 af = __builtin_bit_cast(bf16x8, pk);
#pragma unroll
      for (int kt = 0; kt < 2; ++kt) {
        bf16x8 bfr;
#pragma unroll
        for (int q = 0; q < 8; ++q) bfr[q] = (short)sK[(ks * 16 + 8 * hh + q) * 66 + kt * 32 + l31];
        acc[kt] = MFMA32(af, bfr, acc[kt]);
      }
    }
#pragma unroll
    for (int kt = 0; kt < 2; ++kt)
#pragma unroll
      for (int i = 0; i < 16; ++i) p.MC[uu * 4096 + (size_t)(vt * 32 + (i & 3) + 8 * (i >> 2) + 4 * hh) * 64 + kt * 32 + l31] = acc[kt][i];
    float nl = 0.f;
    for (int q = 0; q < 32; ++q) { const int l = hh * 32 + q; nl += sW[d * 64 + l] * bf2f(sK[l * 66 + vt * 32 + l31]); }
    nl = xor_sum<32>(nl);
    if (hh == 0) p.MN[uu * 64 + vt * 32 + l31] = nl;
    __syncthreads();
  }
}
DI void ph_ml_scan(const Params& p, int bid, int nblk) {
  for (long gi = (long)bid * NTHR + TIDX; gi < (long)NB * 2 * 4 * 4160; gi += (long)nblk * NTHR) {
    const int e = (int)(gi % 4160), ch = (int)(gi / 4160), h = ch & 3, bd = ch >> 2;
    float* base = e < 4096 ? p.MC + (((size_t)bd * NCK) * 4 + h) * 4096 + e : p.MN + (((size_t)bd * NCK) * 4 + h) * 64 + (e - 4096);
    const size_t stride = e < 4096 ? 4 * 4096 : 4 * 64;
    float* mm = p.MM + (((size_t)bd * NCK) * 4 + h) * 4;
    float st = 0.f, m = -1e30f;
    float cl[8], cm[8], cb[8], nl[8], nm[8], nb[8];
#pragma unroll
    for (int q = 0; q < 8; ++q) { cl[q] = base[(size_t)q * stride]; cm[q] = mm[q * 16]; cb[q] = mm[q * 16 + 1]; }
#pragma unroll 1
    for (int jb = 0; jb < NCK; jb += 8) {
#pragma unroll
      for (int q = 0; q < 8; ++q) { const int j = jb + 8 + q; if (j < NCK) { nl[q] = base[(size_t)j * stride]; nm[q] = mm[j * 16]; nb[q] = mm[j * 16 + 1]; } }
#pragma unroll
      for (int q = 0; q < 8; ++q) {
        const int j = jb + q;
        if (j < NCK) {
          const float mn = fmaxf(cb[q] + m, cm[q]), a = expf(cb[q] + m - mn), g = expf(cm[q] - mn);
          base[(size_t)j * stride] = st;
          st = a * st + g * cl[q];
          if (e == 0) mm[j * 16 + 2] = m;
          m = mn;
        }
      }
#pragma unroll
      for (int q = 0; q < 8; ++q) { cl[q] = nl[q]; cm[q] = nm[q]; cb[q] = nb[q]; }
    }
  }
}
DI void ph_gla_scan(const Params& p, int bid, int nblk) {
  for (long gi = (long)bid * NTHR + TIDX; gi < (long)NB * 2 * 4 * 2048; gi += (long)nblk * NTHR) {
    const int e = (int)(gi % 2048), ch = (int)(gi / 2048), h = ch & 3, bd = ch >> 2, k = e & 31;
    float* base = p.GS + (((size_t)bd * NCK) * 4 + h) * 2048 + e;
    const float* ge = p.GC + ((size_t)bd * TK + 63) * 128 + h * 32 + k;
    float st = 0.f;
    float cl[8], cg[8], nl[8], ng[8];
#pragma unroll
    for (int q = 0; q < 8; ++q) { cl[q] = base[(size_t)q * 4 * 2048]; cg[q] = ge[(size_t)q * 64 * 128]; }
#pragma unroll 1
    for (int jb = 0; jb < NCK; jb += 8) {
#pragma unroll
      for (int q = 0; q < 8; ++q) { const int j = jb + 8 + q; if (j < NCK) { nl[q] = base[(size_t)j * 4 * 2048]; ng[q] = ge[(size_t)j * 64 * 128]; } }
#pragma unroll
      for (int q = 0; q < 8; ++q) {
        const int j = jb + q;
        if (j < NCK) { base[(size_t)j * 4 * 2048] = st; st = expf(cg[q]) * st + cl[q]; }
      }
#pragma unroll
      for (int q = 0; q < 8; ++q) { cl[q] = nl[q]; cg[q] = ng[q]; }
    }
  }
}
constexpr int MO_K = 0, MO_V = 64 * 144, MO_A = MO_V + 64 * VROW, MO_PM = MO_A + 512, MO_N0 = MO_PM + 512, MO_X = MO_N0 + 512, MO_LDS = MO_X + 16384;
DI void ph_ml_out(const Params& p, int layer, int need_ctx, char* lds, int bid, int nblk) {
  float* sA = (float*)(lds + MO_A); float* sPM = (float*)(lds + MO_PM); float* sN0 = (float*)(lds + MO_N0); float* sX = (float*)(lds + MO_X);
  const int t = TIDX, lane = t & 63, wid = t >> 6, l31 = lane & 31, hh = lane >> 5;
  const int lt = wid & 1, d = wid >> 1;
#pragma unroll 1
  for (int u = bid; u < (need_ctx ? SCAN_UNITS : SCAN_LAT_UNITS); u += nblk) {
    int b, c, h; scan_unit(u, b, c, h);
    {
      const int row = t >> 2, seg = (t & 3) * 16;
      const bf16_t* ks = p.MK + ((size_t)b * TK + 64 * c + row) * 256 + h * 64 + seg;
      sts16(lds + MO_K + row * 144 + seg * 2, ldg16(ks)); sts16(lds + MO_K + row * 144 + seg * 2 + 16, ldg16(ks + 8));
      const bf16_t* vs = p.MVt + (((size_t)b * 4 + h) * 64 + row) * TK + 64 * c + seg;
      const u32x4 v0 = ldg16(vs), v1 = ldg16(vs + 8);
      u32x2* dv = (u32x2*)(lds + MO_V + row * VROW + seg * 2);
      u32x2 q; q.x = v0.x; q.y = v0.y; dv[0] = q; q.x = v0.z; q.y = v0.w; dv[1] = q; q.x = v1.x; q.y = v1.y; dv[2] = q; q.x = v1.z; q.y = v1.w; dv[3] = q;
    }
    if (t < 128) {
      const int dd = t >> 6, s = t & 63, j = step_of(dd, c), pos = dd ? 63 - s : s;
      const size_t o = (((size_t)b * 2 + dd) * TK + 64 * j) * 4 + h;
      sA[dd * 64 + s] = p.IGS[o + pos * 4] - p.BC[o + pos * 4];
      const size_t uu = (((size_t)b * 2 + dd) * NCK + j) * 4 + h;
      sN0[dd * 64 + s] = p.MN[uu * 64 + s];
    }
    __syncthreads();
    if (t < 2) {
      float m = -1e30f;
      if (t == 0) { for (int s = 0; s < 64; ++s) { m = fmaxf(m, sA[s]); sPM[s] = m; } }
      else { for (int s = 63; s >= 0; --s) { m = fmaxf(m, sA[64 + s]); sPM[64 + s] = m; } }
    }
    __syncthreads();
    const int j = step_of(d, c);
    const size_t uu = (((size_t)b * 2 + d) * NCK + j) * 4 + h;
    const int l = lt * 32 + l31, pos = d ? 63 - l : l;
    const float bl = p.BC[(((size_t)b * 2 + d) * TK + 64 * j + pos) * 4 + h];
    const float inter = bl + p.MM[uu * 4 + 2];
    const float mt = fmaxf(inter, bl + sPM[d * 64 + l]);
    const float aint = expf(inter - mt);
    bf16x8 qf[4];
#pragma unroll
    for (int ks = 0; ks < 4; ++ks) qf[ks] = *(const bf16x8*)(p.MQ + ((size_t)b * TK + 64 * c + l) * 256 + h * 64 + ks * 16 + 8 * hh);
    f32x16 num[2]; num[0] = (f32x16)(0.f); num[1] = (f32x16)(0.f);
    float den = 0.f;
#pragma unroll
    for (int st = 0; st < 2; ++st) {
      if (d == 0 ? st <= lt : st >= lt) {
        f32x16 S = (f32x16)(0.f);
#pragma unroll
        for (int ks = 0; ks < 4; ++ks) S = MFMA32(lds_frag(lds + MO_K + (st * 32 + l31) * 144 + (ks * 16 + 8 * hh) * 2), qf[ks], S);
#pragma unroll
        for (int i = 0; i < 16; ++i) {
          const int s = st * 32 + (i & 3) + 8 * (i >> 2) + 4 * hh;
          const bool ok = d == 0 ? s <= l : s >= l;
          const float e = ok ? fast_exp2((bl + sA[d * 64 + s] - mt) * LOG2E) * S[i] : 0.f;
          S[i] = e; den += e;
        }
#pragma unroll
        for (int kst = 0; kst < 2; ++kst) {
          const bf16x8 pf = pack8(S, kst);
#pragma unroll
          for (int vt = 0; vt < 2; ++vt) {
            const char* vp = lds + MO_V + (vt * 32 + l31) * VROW + (st * 32 + kst * 16 + 4 * hh) * 2;
            const s16x4 lo = *(const s16x4*)vp, hi = *(const s16x4*)(vp + 16);
            num[vt] = MFMA32(__builtin_shufflevector(lo, hi, 0, 1, 2, 3, 4, 5, 6, 7), pf, num[vt]);
          }
        }
      }
    }
    f32x16 accI[2]; accI[0] = (f32x16)(0.f); accI[1] = (f32x16)(0.f);
#pragma unroll
    for (int vt = 0; vt < 2; ++vt)
#pragma unroll
      for (int ks = 0; ks < 4; ++ks) accI[vt] = MFMA32(cvt8(p.MC + uu * 4096 + (size_t)(vt * 32 + l31) * 64 + ks * 16 + 8 * hh), qf[ks], accI[vt]);
    float qn = 0.f;
#pragma unroll
    for (int ks = 0; ks < 4; ++ks)
#pragma unroll
      for (int q = 0; q < 8; ++q) qn += bf2f((bf16_t)qf[ks][q]) * sN0[d * 64 + ks * 16 + 8 * hh + q];
    den = xor_sum<32>(den + aint * qn);
    const float inv = 1.0f / fmaxf(fabsf(den), expf(-mt));
#pragma unroll
    for (int vt = 0; vt < 2; ++vt)
#pragma unroll
      for (int i = 0; i < 16; ++i) num[vt][i] = (num[vt][i] + aint * accI[vt][i]) * inv;
    if (d == 1) {
#pragma unroll
      for (int vt = 0; vt < 2; ++vt)
#pragma unroll
        for (int i = 0; i < 16; ++i) sX[(lt * 32 + vt * 16 + i) * 64 + lane] = num[vt][i];
    }
    __syncthreads();
    if (d == 0) {
      float ss = 0.f;
#pragma unroll
      for (int vt = 0; vt < 2; ++vt)
#pragma unroll
        for (int i = 0; i < 16; ++i) { num[vt][i] += sX[(lt * 32 + vt * 16 + i) * 64 + lane]; ss += num[vt][i] * num[vt][i]; }
      ss = xor_sum<32>(ss);
      const float rstd = 1.0f / sqrtf(ss * (1.0f / 64) + 1e-6f);
      const int r = row_of(b, 64 * c + l);
#pragma unroll
      for (int vt = 0; vt < 2; ++vt)
#pragma unroll
        for (int g = 0; g < 4; ++g) {
          const int v0 = vt * 32 + 8 * g + 4 * hh;
          const u32x2 ou = *(const u32x2*)(p.Z + (size_t)r * NZP + ZC_MLO + h * 64 + v0);
          const f32x4 gv = *(const f32x4*)(p.g_mlstm_out + layer * 256 + h * 64 + v0);
          const float o0 = u2f(ou.x << 16), o1 = u2f(ou.x & 0xffff0000u), o2 = u2f(ou.y << 16), o3 = u2f(ou.y & 0xffff0000u);
          f32x4 y = {sigmoidf_(o0) * num[vt][4 * g] * rstd * gv[0], sigmoidf_(o1) * num[vt][4 * g + 1] * rstd * gv[1],
                     sigmoidf_(o2) * num[vt][4 * g + 2] * rstd * gv[2], sigmoidf_(o3) * num[vt][4 * g + 3] * rstd * gv[3]};
          st_bf16x4(p.Y + (size_t)r * D + 256 + h * 64 + v0, y);
        }
    }
    __syncthreads();
  }
}
DI void ph_gla_local(const Params& p, char* lds, int bid, int nblk) {
  bf16_t* sKd = (bf16_t*)lds;
  const int t = TIDX, lane = t & 63, wid = t >> 6, l31 = lane & 31, hh = lane >> 5;
  const int d = wid & 1, vt = wid >> 1;
#pragma unroll 1
  for (int u = bid; u < SCAN_UNITS; u += nblk) {
    int b, c, h; scan_unit(u, b, c, h);
    {
      const int dd = t >> 7, l = (t >> 1) & 63, k0 = (t & 1) * 16, j = step_of(dd, c), pos = dd ? 63 - l : l;
      const float* gcr = p.GC + (((size_t)b * 2 + dd) * TK + 64 * j + pos) * 128 + h * 32 + k0;
      const float* ger = p.GC + (((size_t)b * 2 + dd) * TK + 64 * j + 63) * 128 + h * 32 + k0;
      const bf16_t* kr = p.Z + (size_t)row_of(b, 64 * c + l) * NZP + ZC_GK + h * 32 + k0;
#pragma unroll
      for (int q = 0; q < 16; ++q) sKd[(dd * 64 + l) * 33 + k0 + q] = f2bf(bf2f(kr[q]) * fast_exp2((ger[q] - gcr[q]) * LOG2E));
    }
    __syncthreads();
    const int j = step_of(d, c);
    const size_t uu = (((size_t)b * 2 + d) * NCK + j) * 4 + h;
    f32x16 acc = (f32x16)(0.f);
    const bf16_t* vsrc = p.GVt + (((size_t)b * 4 + h) * 64 + vt * 32 + l31) * TK + 64 * c;
#pragma unroll
    for (int ks = 0; ks < 4; ++ks) {
      const bf16x8 af = *(const bf16x8*)(vsrc + ks * 16 + 8 * hh);
      bf16x8 bfr;
#pragma unroll
      for (int q = 0; q < 8; ++q) bfr[q] = (short)sKd[(d * 64 + ks * 16 + 8 * hh + q) * 33 + l31];
      acc = MFMA32(af, bfr, acc);
    }
#pragma unroll
    for (int i = 0; i < 16; ++i) p.GS[uu * 2048 + (size_t)(vt * 32 + (i & 3) + 8 * (i >> 2) + 4 * hh) * 32 + l31] = acc[i];
    __syncthreads();
  }
}
constexpr int GO_Q = 0, GO_K = 2 * 64 * 80, GO_V = 2 * GO_K, GO_X = GO_V + 64 * VROW, GO_LDS = GO_X + 16384;
DI void ph_gla_out(const Params& p, int layer, int need_ctx, char* lds, int bid, int nblk) {
  float* sX = (float*)(lds + GO_X);
  const int t = TIDX, lane = t & 63, wid = t >> 6, l31 = lane & 31, hh = lane >> 5;
  const int lt = wid & 1, d = wid >> 1;
#pragma unroll 1
  for (int u = bid; u < (need_ctx ? SCAN_UNITS : SCAN_LAT_UNITS); u += nblk) {
    int b, c, h; scan_unit(u, b, c, h);
    {
      const int dd = t >> 7, l = (t >> 1) & 63, k0 = (t & 1) * 16, j = step_of(dd, c), pos = dd ? 63 - l : l;
      const float* gcr = p.GC + (((size_t)b * 2 + dd) * TK + 64 * j + pos) * 128 + h * 32 + k0;
      const bf16_t* zr = p.Z + (size_t)row_of(b, 64 * c + l) * NZP;
      bf16_t* qd = (bf16_t*)(lds + GO_Q + (dd * 64 + l) * 80) + k0; bf16_t* kd = (bf16_t*)(lds + GO_K + (dd * 64 + l) * 80) + k0;
#pragma unroll
      for (int q = 0; q < 16; ++q) {
        const float g = gcr[q];
        qd[q] = f2bf(bf2f(zr[ZC_GQ + h * 32 + k0 + q]) * 0.17677669529663687f * fast_exp2(g * LOG2E));
        kd[q] = f2bf(bf2f(zr[ZC_GK + h * 32 + k0 + q]) * fast_exp2(-g * LOG2E));
      }
      const int row = t >> 2, seg = (t & 3) * 16;
      const bf16_t* vs = p.GVt + (((size_t)b * 4 + h) * 64 + row) * TK + 64 * c + seg;
      const u32x4 v0 = ldg16(vs), v1 = ldg16(vs + 8);
      u32x2* dv = (u32x2*)(lds + GO_V + row * VROW + seg * 2);
      u32x2 q2; q2.x = v0.x; q2.y = v0.y; dv[0] = q2; q2.x = v0.z; q2.y = v0.w; dv[1] = q2; q2.x = v1.x; q2.y = v1.y; dv[2] = q2; q2.x = v1.z; q2.y = v1.w; dv[3] = q2;
    }
    __syncthreads();
    const int j = step_of(d, c);
    const size_t uu = (((size_t)b * 2 + d) * NCK + j) * 4 + h;
    const int l = lt * 32 + l31;
    bf16x8 qf[2];
#pragma unroll
    for (int ks = 0; ks < 2; ++ks) qf[ks] = lds_frag(lds + GO_Q + (d * 64 + l) * 80 + (ks * 16 + 8 * hh) * 2);
    f32x16 O[2]; O[0] = (f32x16)(0.f); O[1] = (f32x16)(0.f);
#pragma unroll
    for (int st = 0; st < 2; ++st) {
      if (d == 0 ? st <= lt : st >= lt) {
        f32x16 S = (f32x16)(0.f);
#pragma unroll
        for (int ks = 0; ks < 2; ++ks) S = MFMA32(lds_frag(lds + GO_K + (d * 64 + st * 32 + l31) * 80 + (ks * 16 + 8 * hh) * 2), qf[ks], S);
#pragma unroll
        for (int i = 0; i < 16; ++i) {
          const int s = st * 32 + (i & 3) + 8 * (i >> 2) + 4 * hh;
          const bool ok = d == 0 ? s <= l : s >= l;
          S[i] = ok ? S[i] : 0.f;
        }
#pragma unroll
        for (int kst = 0; kst < 2; ++kst) {
          const bf16x8 pf = pack8(S, kst);
#pragma unroll
          for (int vt = 0; vt < 2; ++vt) {
            const char* vp = lds + GO_V + (vt * 32 + l31) * VROW + (st * 32 + kst * 16 + 4 * hh) * 2;
            const s16x4 lo = *(const s16x4*)vp, hi = *(const s16x4*)(vp + 16);
            O[vt] = MFMA32(__builtin_shufflevector(lo, hi, 0, 1, 2, 3, 4, 5, 6, 7), pf, O[vt]);
          }
        }
      }
    }
#pragma unroll
    for (int vt = 0; vt < 2; ++vt)
#pragma unroll
      for (int ks = 0; ks < 2; ++ks) O[vt] = MFMA32(cvt8(p.GS + uu * 2048 + (size_t)(vt * 32 + l31) * 32 + ks * 16 + 8 * hh), qf[ks], O[vt]);
    if (d == 1) {
#pragma unroll
      for (int vt = 0; vt < 2; ++vt)
#pragma unroll
        for (int i = 0; i < 16; ++i) sX[(lt * 32 + vt * 16 + i) * 64 + lane] = O[vt][i];
    }
    __syncthreads();
    if (d == 0) {
      float ss = 0.f;
#pragma unroll
      for (int vt = 0; vt < 2; ++vt)
#pragma unroll
        for (int i = 0; i < 16; ++i) { O[vt][i] += sX[(lt * 32 + vt * 16 + i) * 64 + lane]; ss += O[vt][i] * O[vt][i]; }
      ss = xor_sum<32>(ss);
      const float rstd = 1.0f / sqrtf(ss * (1.0f / 64) + 1e-6f);
      const int r = row_of(b, 64 * c + l);
#pragma unroll
      for (int vt = 0; vt < 2; ++vt)
#pragma unroll
        for (int g = 0; g < 4; ++g) {
          const int v0 = vt * 32 + 8 * g + 4 * hh;
          const u32x2 ru = *(const u32x2*)(p.Z + (size_t)r * NZP + ZC_GR + h * 64 + v0);
          const f32x4 gv = *(const f32x4*)(p.g_gla_out + layer * 256 + h * 64 + v0);
          const float r0 = u2f(ru.x << 16), r1 = u2f(ru.x & 0xffff0000u), r2 = u2f(ru.y << 16), r3 = u2f(ru.y & 0xffff0000u);
          f32x4 y = {siluf_(r0) * O[vt][4 * g] * rstd * gv[0], siluf_(r1) * O[vt][4 * g + 1] * rstd * gv[1],
                     siluf_(r2) * O[vt][4 * g + 2] * rstd * gv[2], siluf_(r3) * O[vt][4 * g + 3] * rstd * gv[3]};
          st_bf16x4(p.Y + (size_t)r * D + 512 + h * 64 + v0, y);
        }
    }
    __syncthreads();
  }
}

DI float fast_logsigmoid(float x) {
  const float e = fast_exp2(-fabsf(x) * LOG2E);
#ifdef CPU_EMU
  return fminf(x, 0.f) - log1pf(e);
#else
  return fminf(x, 0.f) - 0.6931471805599453f * __builtin_amdgcn_logf(1.0f + e);
#endif
}
DI float wave_incl_scan(float v, int lane) {
#pragma unroll
  for (int dd = 1; dd < 64; dd <<= 1) { const float o = u2f((unsigned)lane_up((int)f2u(v), dd, lane)); if (lane >= dd) v += o; }
  return v;
}
constexpr int GCUM_LDS = 4 * 64 * 33 * 4;
DI void ph_gates_cum(const Params& p, int layer, char* lds, int bid, int nblk) {
  const int t = TIDX, lane = t & 63, wid = t >> 6;
  float* stg = (float*)lds + wid * 64 * 33;
  const float* wal = p.w_alpha2 + (size_t)layer * 2 * 16 * 128;
#pragma unroll 1
  for (int u = bid * 4 + wid; u < NB * 2 * NCK; u += nblk * 4) {
    const int j = u % NCK, d = (u / NCK) & 1, b = u / (2 * NCK);
    const int pp = 64 * j + lane, s = seq_of(d, pp);
    const bf16_t* z = p.Z + (size_t)row_of(b, s) * NZP;
    const size_t ob = ((size_t)b * 2 + d) * TK + pp;
    {
      const u32x2 iu = *(const u32x2*)(z + ZC_MLIG + d * 4), fu = *(const u32x2*)(z + ZC_MLFG + d * 4);
      const float ig[4] = {u2f(iu.x << 16), u2f(iu.x & 0xffff0000u), u2f(iu.y << 16), u2f(iu.y & 0xffff0000u)};
      const float fg[4] = {u2f(fu.x << 16), u2f(fu.x & 0xffff0000u), u2f(fu.y << 16), u2f(fu.y & 0xffff0000u)};
      f32x4 oc, oi;
#pragma unroll
      for (int h = 0; h < 4; ++h) {
        oi[h] = ig[h] + p.b_igate[layer * 8 + d * 4 + h];
        oc[h] = wave_incl_scan(fast_logsigmoid(fg[h] + p.b_fgate[layer * 8 + d * 4 + h]), lane);
      }
      *(f32x4*)(p.BC + ob * 4) = oc; *(f32x4*)(p.IGS + ob * 4) = oi;
    }
    float a[16];
    { float f0[8], f1[8]; unpack8(ldg16(z + ZC_GA + d * 16), f0); unpack8(ldg16(z + ZC_GA + d * 16 + 8), f1);
#pragma unroll
      for (int q = 0; q < 8; ++q) { a[q] = f0[q]; a[8 + q] = f1[q]; } }
    const float* W = wal + (size_t)d * 16 * 128;
#pragma unroll 1
    for (int cg = 0; cg < 4; ++cg) {
#pragma unroll 4
      for (int c = 0; c < 32; ++c) {
        const int ch = cg * 32 + c;
        float zg = p.b_alpha[layer * 256 + d * 128 + ch];
#pragma unroll
        for (int q = 0; q < 16; ++q) zg += a[q] * W[q * 128 + ch];
        stg[lane * 33 + c] = wave_incl_scan(fast_logsigmoid(zg) * (1.0f / 16.0f), lane);
      }
      WAVE_SYNC();
#pragma unroll
      for (int k = 0; k < 32; ++k) { const int pos = k * 2 + (lane >> 5), c = lane & 31; p.GC[(((size_t)b * 2 + d) * TK + 64 * j + pos) * 128 + cg * 32 + c] = stg[pos * 33 + c]; }
      WAVE_SYNC();
    }
  }
}
#define XB_TMO      128
#define XB_XCNT(j)  (256  + 64 * (j))
#define XB_XSUB(j)  (1280 + 64 * (j))
#define XB_XGEN(j)  (2304 + 64 * (j))
#define XB_TOP      3328
#define XB_TOPGEN   3392
#define XCD_BAR_WORDS 3456
#define XB_SPIN_CAP (1u << 28)
#define LAS __attribute__((address_space(3)))

__device__ __forceinline__ unsigned xb_ld(unsigned* p)              { return __hip_atomic_load(p, __ATOMIC_RELAXED, __HIP_MEMORY_SCOPE_AGENT); }
__device__ __forceinline__ unsigned xb_add(unsigned* p, unsigned v) { return __hip_atomic_fetch_add(p, v, __ATOMIC_RELAXED, __HIP_MEMORY_SCOPE_AGENT); }
__device__ __forceinline__ unsigned xb_xcc_id() { return (unsigned)__builtin_amdgcn_s_getreg((3 << 11) | 20) & 0xFu; }
#define XB_SPIN(cond, bar) do { unsigned _sp = 0; while (cond) { __builtin_amdgcn_s_sleep(1); \
    if ((++_sp & 255u) == 0u) { if (xb_ld(&(bar)[XB_TMO])) break; if (_sp > XB_SPIN_CAP) { atomicAdd(&(bar)[XB_TMO], 1u); break; } } } } while (0)

struct XcdBarrier {
    unsigned* bar; unsigned x;
    volatile LAS unsigned* st;
};

__device__ __forceinline__ XcdBarrier xcd_barrier_post(unsigned* bar, volatile LAS unsigned* st) {
    XcdBarrier b; b.bar = bar; b.x = xb_xcc_id(); b.st = st;
    if (threadIdx.x == 0) (void)xb_add(&bar[XB_XCNT(b.x)], 1u);
    return b;
}
__device__ __forceinline__ void xcd_barrier_complete(unsigned* bar, unsigned x, unsigned& nloc, unsigned& nx) {
    const unsigned G = gridDim.x * gridDim.y * gridDim.z;
    unsigned sum, cnt, mine, sp = 0u;
    for (;;) {
        sum = 0u; cnt = 0u; mine = 0u;
#pragma unroll
        for (unsigned j = 0; j < 16; ++j) { const unsigned c = xb_ld(&bar[XB_XCNT(j)]); sum += c; cnt += (c > 0u) ? 1u : 0u; mine = (j == x) ? c : mine; }
        if (sum == G) break;
        __builtin_amdgcn_s_sleep(1);
        if ((++sp & 255u) == 0u) { if (xb_ld(&bar[XB_TMO])) break; if (sp > XB_SPIN_CAP) { atomicAdd(&bar[XB_TMO], 1u); break; } }
    }
    nloc = mine > 0u ? mine : 1u; nx = cnt > 0u ? cnt : 1u;
}

__device__ __forceinline__ void xcd_barrier(const XcdBarrier& b) {
    asm volatile("s_waitcnt vmcnt(0)" ::: "memory");
    __syncthreads();
    if (threadIdx.x == 0) {
        unsigned* bar = b.bar;
        __builtin_amdgcn_s_waitcnt(0);
        unsigned nloc = b.st[0], nx = b.st[1];
        if (nloc == 0u) { xcd_barrier_complete(bar, b.x, nloc, nx); b.st[0] = nloc; b.st[1] = nx; }
        const unsigned old = xb_add(&bar[XB_XSUB(b.x)], 1u);
        const unsigned gen = old / nloc;
        if (old + 1u == (gen + 1u) * nloc) {
            __builtin_amdgcn_fence(__ATOMIC_RELEASE, "agent");
            asm volatile("s_waitcnt vmcnt(0)" ::: "memory");
            const unsigned og = xb_add(&bar[XB_TOP], 1u);
            const unsigned tg = og / nx;
            if (og + 1u == (tg + 1u) * nx) xb_add(&bar[XB_TOPGEN], 1u);
            else XB_SPIN(xb_ld(&bar[XB_TOPGEN]) == tg, bar);
            __builtin_amdgcn_fence(__ATOMIC_ACQUIRE, "agent");
            xb_add(&bar[XB_XGEN(b.x)], 1u);
            asm volatile("s_waitcnt vmcnt(0)" ::: "memory");
        } else {
            XB_SPIN(xb_ld(&bar[XB_XGEN(b.x)]) == gen, bar);
            __builtin_amdgcn_fence(__ATOMIC_ACQUIRE, "agent");
            asm volatile("s_waitcnt vmcnt(0)" ::: "memory");
        }
    }
    __syncthreads();
}

#define GS_LOOP(N, CALL) for (long gi = (long)bid * NTHR + TIDX; gi < (long)(N); gi += (long)nblk * NTHR) { CALL; }
#ifndef PROBE
#define PROBE 0
#endif
#ifndef PROBE_MASK
#define PROBE_MASK 0
#endif
#ifndef FAST_SCAN
#define FAST_SCAN 1
#endif
constexpr int N_PHASES = 16;
constexpr int MEGA_LDS = GEMM_LDS > TOPK_LDS ? GEMM_LDS : TOPK_LDS;

template <int PH>
DI void run_phase(const Params& p, int l, char* lds, int bid, int nblk) {
  const int need_ctx = (l == 0);
  const int rows = need_ctx ? R : RL;
  const float* xl_in = l == 0 ? p.x : p.out;
  const float* xc_in = l == 0 ? p.ctx : p.xc;
  bf16_t* QRAW = p.YO; bf16_t* KVRAW = p.YO + (size_t)R * 384;
  if constexpr (PH == 0) {
    ph_mods(p, lds, bid, nblk);
#pragma unroll 1
    for (int ll = 0; ll < 2; ++ll) {
      ph_wt(p.w_in + (size_t)ll * D * NZ, p.Wt_in + ll * WSZ_IN, D, NZ, NZP, 1, 0L, 0L, nullptr, lds, bid, nblk);
      ph_wt(p.w_gate + (size_t)ll * D * 4096, p.Wt_gate + ll * WSZ_GATE, D, 4096, 4096, 1, 0L, 0L, nullptr, lds, bid, nblk);
      ph_wt(p.w_branch + (size_t)ll * 4 * 256 * D, p.Wt_branch + ll * WSZ_BR, 256, D, D, 4, (long)256 * D, (long)D * 256, nullptr, lds, bid, nblk);
      ph_wt(p.w_out + (size_t)ll * D * D, p.Wt_out + ll * WSZ_OUT, D, D, D, 1, 0L, 0L, nullptr, lds, bid, nblk);
      ph_wt(p.w_uq + (size_t)ll * 256 * 384, p.Wt_uq + ll * WSZ_UQ, 256, 384, 384, 1, 0L, 0L, p.g_q_lat + ll * 256, lds, bid, nblk);
      ph_wt(p.w_ukv + (size_t)ll * 128 * 512, p.Wt_ukv + ll * WSZ_UKV, 128, 512, 512, 1, 0L, 0L, p.g_kv_lat + ll * 128, lds, bid, nblk);
    }
  } else if constexpr (PH == 1) {
    ph_modulate(p, l, xl_in, xc_in, bid, nblk);
  } else if constexpr (PH == 2) {
    ph_gemm_plain(p.H, D, p.Wt_in + l * WSZ_IN, D, R, NZP, D, p.Z, NZP, lds, bid, nblk);
#if PROBE == 63
    ph_gemm_probe<3>(p.H, D, p.Wt_in + l * WSZ_IN, D, R, NZP, D, p.mods + 40000, lds, bid, nblk);
#elif PROBE == 66
    ph_gemm_probe<6>(p.H, D, p.Wt_in + l * WSZ_IN, D, R, NZP, D, p.mods + 40000, lds, bid, nblk);
#elif PROBE == 67
    ph_gemm_plain<1>(p.H, D, p.Wt_in + l * WSZ_IN, D, R, NZP, D, p.Z, NZP, lds, bid, nblk);
#elif PROBE == 5
    ph_gemm_plain(p.H, D, p.Wt_in + l * WSZ_IN, D, R, NZP, D, p.Z, NZP, lds, bid, nblk);
#endif
  } else if constexpr (PH == 3) {
    ph_mla_up(p, l, QRAW, KVRAW, lds, bid, nblk);
  } else if constexpr (PH == 4) {
    ph_prep(p, l, QRAW, KVRAW, lds, bid, nblk);
#if PROBE == 41
    ph_prep(p, l, QRAW, KVRAW, lds, bid, nblk);
#elif PROBE == 43
    ph_prep<1>(p, l, QRAW, KVRAW, lds, bid, nblk);
#elif PROBE == 44
    ph_prep<2>(p, l, QRAW, KVRAW, lds, bid, nblk);
#endif
    __syncthreads();
    ph_gates_cum(p, l, lds, bid, nblk);
#if PROBE == 42
    ph_gates_cum(p, l, lds, bid, nblk);
#endif
  } else if constexpr (PH == 5) {
#if FAST_SCAN
    ph_ml_local(p, lds, bid, nblk);
    ph_gla_local(p, lds, bid, nblk);
#else
    GS_LOOP((long)NUNIT * 4160, nvb_ml_local(gi, p));
    GS_LOOP((long)NUNIT * 2048, nvb_gla_local(gi, p));
#endif
  } else if constexpr (PH == 6) {
#if FAST_SCAN
    ph_ml_scan(p, bid, nblk);
    ph_gla_scan(p, (bid + nblk - 260 % nblk) % nblk, nblk);
#else
    GS_LOOP((long)NB * 2 * 4 * 4160, nvb_ml_scan(gi, p));
    GS_LOOP((long)NB * 2 * 4 * 2048, nvb_gla_scan(gi, p));
#endif
    ph_attn(p, l, need_ctx, lds, bid, nblk);
#if PROBE >= 10 && PROBE < 20
    if (l == 0) ph_attn_mla_probe<PROBE - 10>(p, lds, bid, nblk);
#elif PROBE == 1
    ph_attn_diff(p, l, need_ctx, lds, bid, nblk);
#elif PROBE == 2
    ph_attn_mla(p, need_ctx, lds, bid, nblk);
#endif
  } else if constexpr (PH == 7) {
#if FAST_SCAN
    ph_ml_out(p, l, need_ctx, lds, bid, nblk);
    ph_gla_out(p, l, need_ctx, lds, bid, nblk);
#else
    GS_LOOP((long)NUNIT * 4096, nvb_ml_out(gi, p, need_ctx));
    GS_LOOP((long)NUNIT * 4096, nvb_gla_out(gi, p, need_ctx));
#endif
  } else if constexpr (PH == 8) {
#if !FAST_SCAN
    GS_LOOP((long)R * 4, nvb_ml_finish(gi, p, l, need_ctx));
    GS_LOOP((long)R * 4, nvb_gla_finish(gi, p, l, need_ctx));
#endif
  } else if constexpr (PH == 9) {
    ph_merge(p, l, rows, lds, bid, nblk);
#if PROBE == 3
    ph_merge(p, l, rows, lds, bid, nblk);
#endif
  } else if constexpr (PH == 10) {
    ph_gemm_plain(p.MG, D, p.Wt_out + l * WSZ_OUT, D, rows, D, D, p.YO, D, lds, bid, nblk);
  } else if constexpr (PH == 11) {
    ph_resid_mix(p, l, xl_in, xc_in, rows, lds, bid, nblk);
  } else if constexpr (PH == 12) {
    ph_topk(p, need_ctx, lds, bid, nblk);
    ph_wt(p.w_e_gate + (size_t)l * NE * D * FF, p.Wt_eg, D, FF, FF, NE, (long)D * FF, (long)FF * D, nullptr, lds, bid, nblk);
    ph_wt(p.w_e_up + (size_t)l * NE * D * FF, p.Wt_eu, D, FF, FF, NE, (long)D * FF, (long)FF * D, nullptr, lds, bid, nblk);
    ph_wt(p.w_e_down + (size_t)l * NE * FF * D, p.Wt_ed, FF, D, D, NE, (long)FF * D, (long)D * FF, nullptr, lds, bid, nblk);
  } else if constexpr (PH == 13) {
    ph_moe1(p, need_ctx, lds, bid, nblk);
#if PROBE == 4
    ph_moe1(p, need_ctx, lds, bid, nblk);
#endif
  } else if constexpr (PH == 14) {
    ph_moe2(p, need_ctx, lds, bid, nblk);
#if PROBE == 4
    ph_moe2(p, need_ctx, lds, bid, nblk);
#endif
  } else if constexpr (PH == 15) {
    ph_resid_ffn(p, l, rows, bid, nblk);
  }
}

template <int PH> __global__ void __launch_bounds__(256, 2) k_phase(Params p, int l) {
  DYN_LDS(lds);
  run_phase<PH>(p, l, lds, blockIdx.x, gridDim.x);
}

#if !defined(CPU_EMU) && !MK_MULTI
typedef const Params __attribute__((address_space(4)))* KParams;
DI KParams kp_fresh() { KParams k = (KParams)__builtin_amdgcn_kernarg_segment_ptr(); asm volatile("" : "+s"(k)); return k; }
#define PHASE(PH, L) do { asm volatile("; PHASE_MARK " #PH); KParams k_ = kp_fresh(); run_phase<PH>(*(const Params*)k_, (L), lds, bid, nblk); if (PROBE == 20 + PH || ((PROBE_MASK >> PH) & 1) || (PROBE == 100 + PH && (L) == 0) || (PROBE == 99 && (PH == 4 || PH == 5))) { __syncthreads(); run_phase<PH>(*(const Params*)k_, (L), lds, bid, nblk); } XcdBarrier b_ = bar; asm volatile("" : "+s"(b_.bar), "+s"(b_.x)); xcd_barrier(b_); if (PROBE == 50) xcd_barrier(b_); } while (0)
__global__ void __launch_bounds__(256, 2) k_mega(Params pv) {
  DYN_LDS(lds_all);
  if (threadIdx.x == 0) *(uint4*)lds_all = make_uint4(0u, 0u, 0u, 0u);
  __syncthreads();
  XcdBarrier bar = xcd_barrier_post(pv.bar, (volatile LAS unsigned*)lds_all);
  char* lds = lds_all + 256;
  const int bid = blockIdx.x, nblk = gridDim.x;
  PHASE(0, 0);
#pragma unroll 1
  for (int l = 0; l < 2; ++l) {
    PHASE(1, l); PHASE(2, l); PHASE(3, l); PHASE(4, l); PHASE(5, l); PHASE(6, l); PHASE(7, l);
#if !FAST_SCAN
    PHASE(8, l);
#endif

    PHASE(9, l); PHASE(10, l); PHASE(11, l); PHASE(12, l); PHASE(13, l); PHASE(14, l); PHASE(15, l);
  }
}
#endif
#ifdef CPU_EMU
void emu_check(const Params& p, int layer, int stage);
#define EMU_CHECK(stg) emu_check(p, l, stg)
static int g_nlayers = getenv("NLAYERS") ? atoi(getenv("NLAYERS")) : 2;
#else
#define EMU_CHECK(stg)
#endif
static void fill_params(Params& p, void* const* d_in, void* d_out, void* d_ws) {
  const float** f = (const float**)&p;
  for (int i = 0; i < 33; ++i) f[i] = (const float*)d_in[i];
  p.out = (float*)d_out;
  map_workspace(p, (char*)d_ws);
}
#define LAUNCH_PHASE(PH, L) LAUNCH((k_phase<PH>), grid, 256, MEGA_LDS, stream, p, L)

extern "C" void kernel_launch(void* const* d_in, const int* in_sizes, int n_in, void* d_out, int out_size, void* d_ws,
                              size_t ws_size, hipStream_t stream) {
  Params p{};
  fill_params(p, d_in, d_out, d_ws);
  if (p.ws_need > ws_size) return;
#ifdef CPU_EMU
  const int grid = 16;
  LAUNCH_PHASE(0, 0);
  for (int l = 0; l < g_nlayers; ++l) {
    LAUNCH_PHASE(1, l); LAUNCH_PHASE(2, l); LAUNCH_PHASE(3, l); LAUNCH_PHASE(4, l); LAUNCH_PHASE(5, l); LAUNCH_PHASE(6, l); LAUNCH_PHASE(7, l); LAUNCH_PHASE(8, l);
    EMU_CHECK(1);
    LAUNCH_PHASE(9, l); LAUNCH_PHASE(10, l); LAUNCH_PHASE(11, l);
    EMU_CHECK(2);
    LAUNCH_PHASE(12, l); LAUNCH_PHASE(13, l); LAUNCH_PHASE(14, l); LAUNCH_PHASE(15, l);
    EMU_CHECK(3);
  }
#else
  static int grid = 0;
  if (grid == 0) {
    int dev = 0, cus = 0, per_cu = 0;
    (void)hipGetDevice(&dev);
    (void)hipDeviceGetAttribute(&cus, hipDeviceAttributeMultiprocessorCount, dev);
#if MK_MULTI
    (void)hipFuncSetAttribute((const void*)k_phase<0>, hipFuncAttributeMaxDynamicSharedMemorySize, MEGA_LDS);
    (void)hipFuncSetAttribute((const void*)k_phase<1>, hipFuncAttributeMaxDynamicSharedMemorySize, MEGA_LDS);
    (void)hipFuncSetAttribute((const void*)k_phase<2>, hipFuncAttributeMaxDynamicSharedMemorySize, MEGA_LDS);
    (void)hipFuncSetAttribute((const void*)k_phase<3>, hipFuncAttributeMaxDynamicSharedMemorySize, MEGA_LDS);
    (void)hipFuncSetAttribute((const void*)k_phase<4>, hipFuncAttributeMaxDynamicSharedMemorySize, MEGA_LDS);
    (void)hipFuncSetAttribute((const void*)k_phase<5>, hipFuncAttributeMaxDynamicSharedMemorySize, MEGA_LDS);
    (void)hipFuncSetAttribute((const void*)k_phase<6>, hipFuncAttributeMaxDynamicSharedMemorySize, MEGA_LDS);
    (void)hipFuncSetAttribute((const void*)k_phase<7>, hipFuncAttributeMaxDynamicSharedMemorySize, MEGA_LDS);
    (void)hipFuncSetAttribute((const void*)k_phase<8>, hipFuncAttributeMaxDynamicSharedMemorySize, MEGA_LDS);
    (void)hipFuncSetAttribute((const void*)k_phase<9>, hipFuncAttributeMaxDynamicSharedMemorySize, MEGA_LDS);
    (void)hipFuncSetAttribute((const void*)k_phase<10>, hipFuncAttributeMaxDynamicSharedMemorySize, MEGA_LDS);
    (void)hipFuncSetAttribute((const void*)k_phase<11>, hipFuncAttributeMaxDynamicSharedMemorySize, MEGA_LDS);
    (void)hipFuncSetAttribute((const void*)k_phase<12>, hipFuncAttributeMaxDynamicSharedMemorySize, MEGA_LDS);
    (void)hipFuncSetAttribute((const void*)k_phase<13>, hipFuncAttributeMaxDynamicSharedMemorySize, MEGA_LDS);
    (void)hipFuncSetAttribute((const void*)k_phase<14>, hipFuncAttributeMaxDynamicSharedMemorySize, MEGA_LDS);
    (void)hipFuncSetAttribute((const void*)k_phase<15>, hipFuncAttributeMaxDynamicSharedMemorySize, MEGA_LDS);
    grid = (cus > 0 ? cus : 256) * 2;
#else
    if (hipFuncSetAttribute((const void*)k_mega, hipFuncAttributeMaxDynamicSharedMemorySize, MEGA_LDS + 256) != hipSuccess) { grid = -1; return; }
    if (hipOccupancyMaxActiveBlocksPerMultiprocessor(&per_cu, (const void*)k_mega, 256, MEGA_LDS + 256) != hipSuccess) per_cu = 0;
    (void)hipGetLastError();
    if (per_cu < 1) { grid = -1; return; }
    grid = (cus > 0 ? cus : 256) * (per_cu < 2 ? per_cu : 2);
#endif
  }
  if (grid < 0) return;
#if MK_MULTI
  LAUNCH_PHASE(0, 0);
  for (int l = 0; l < 2; ++l) {
    LAUNCH_PHASE(1, l); LAUNCH_PHASE(2, l); LAUNCH_PHASE(3, l); LAUNCH_PHASE(4, l); LAUNCH_PHASE(5, l); LAUNCH_PHASE(6, l); LAUNCH_PHASE(7, l); LAUNCH_PHASE(8, l);
    LAUNCH_PHASE(9, l); LAUNCH_PHASE(10, l); LAUNCH_PHASE(11, l); LAUNCH_PHASE(12, l); LAUNCH_PHASE(13, l); LAUNCH_PHASE(14, l); LAUNCH_PHASE(15, l);
  }
#else
  (void)hipMemsetAsync(p.bar, 0, XCD_BAR_WORDS * sizeof(unsigned), stream);
  k_mega<<<dim3(grid), dim3(256), MEGA_LDS + 256, stream>>>(p);
#endif
#endif
}
```

```cpp
#ifndef CPU_EMU
#include <hip/hip_runtime.h>
#endif
#include <stdint.h>
#include <stddef.h>

#ifndef T_LAT
#define T_LAT 16384
#endif
#ifndef T_CTX
#define T_CTX 256
#endif

#ifndef MK_MULTI
#define MK_MULTI 0
#endif
#define DI __device__ __forceinline__
typedef unsigned short bf16_t;
typedef short bf16x8 __attribute__((ext_vector_type(8)));
typedef short s16x4 __attribute__((ext_vector_type(4)));
typedef float f32x4 __attribute__((ext_vector_type(4)));
typedef float f32x16 __attribute__((ext_vector_type(16)));
typedef unsigned u32x4 __attribute__((ext_vector_type(4)));
typedef unsigned u32x2 __attribute__((ext_vector_type(2)));
typedef float f32x2 __attribute__((ext_vector_type(2)));

#ifdef CPU_EMU
static inline float u2f(unsigned u) { float f; memcpy(&f, &u, 4); return f; }
static inline unsigned f2u(float f) { unsigned u; memcpy(&u, &f, 4); return u; }
#define MFMA32(a, b, c) emu_mfma_32x32x16((a), (b), (c))
#define MFMA16(a, b, c) emu_mfma_16x16x32((a), (b), (c))
static inline float fast_exp2(float x) { return exp2f(x); }
static inline float fast_rcp(float x) { return 1.0f / x; }
static inline float fast_rsq(float x) { return 1.0f / sqrtf(x); }
static inline float hw_sin_rev(float x) { return sinf(6.283185307179586f * x); }
static inline float hw_cos_rev(float x) { return cosf(6.283185307179586f * x); }
#define LAUNCH(kern, grid, block, lds, stream, ...) emu::launch(dim3(grid), dim3(block), (size_t)(lds), [=]() { kern(__VA_ARGS__); })
#define DYN_LDS(name) char* name = emu_dynlds()
#define SCHED_BARRIER()
#define TIDX ((int)threadIdx.x)
#define WAVE_SYNC() emu::wave_barrier()
#define SETPRIO(x)
#define IGLP_OPT()
template <int M> static inline float xor_sum(float v) { return v + __shfl_xor(v, M); }
template <int M> static inline float xor_max(float v) { return fmaxf(v, __shfl_xor(v, M)); }
template <int M> static inline int xor_sum_i(int v) { return v + __shfl_xor(v, M); }
static inline int lane_bcast(int v, int src) { return __shfl(v, src); }
static inline float lane_get(float v, int src) { return __shfl(v, src); }
static inline int lane_up(int v, int d, int lane) { (void)lane; return __shfl_up(v, d); }
#else
DI float u2f(unsigned u) { return __uint_as_float(u); }
DI unsigned f2u(float f) { return __float_as_uint(f); }
#define MFMA32(a, b, c) __builtin_amdgcn_mfma_f32_32x32x16_bf16((a), (b), (c), 0, 0, 0)
#define MFMA16(a, b, c) __builtin_amdgcn_mfma_f32_16x16x32_bf16((a), (b), (c), 0, 0, 0)
DI float fast_exp2(float x) { return __builtin_amdgcn_exp2f(x); }
DI float fast_rcp(float x) { return __builtin_amdgcn_rcpf(x); }
DI float fast_rsq(float x) { return __builtin_amdgcn_rsqf(x); }
DI float hw_sin_rev(float x) { return __builtin_amdgcn_sinf(x); }
DI float hw_cos_rev(float x) { return __builtin_amdgcn_cosf(x); }
#define LAUNCH(kern, grid, block, lds, stream, ...) kern<<<dim3(grid), dim3(block), (lds), (stream)>>>(__VA_ARGS__)
#define DYN_LDS(name) extern __shared__ __attribute__((aligned(16))) char name[]
#define SCHED_BARRIER() __builtin_amdgcn_sched_barrier(0)
DI int tid_fresh() { int t = (int)threadIdx.x; asm volatile("" : "+v"(t)); return t; }
#define TIDX tid_fresh()
#define WAVE_SYNC() __builtin_amdgcn_wave_barrier()
#define SETPRIO(x) __builtin_amdgcn_s_setprio(x)
#define IGLP_OPT() __builtin_amdgcn_iglp_opt(0)
#ifdef USE_SHFL
template <int M> DI float xor_sum(float v) { return v + __shfl_xor(v, M); }
template <int M> DI float xor_max(float v) { return fmaxf(v, __shfl_xor(v, M)); }
template <int M> DI int xor_sum_i(int v) { return v + __shfl_xor(v, M); }
DI int lane_bcast(int v, int src) { return __shfl(v, src); }
DI int lane_up(int v, int d, int lane) { (void)lane; return __shfl_up(v, d); }
#else
template <int M> DI int xor_partner_bits(int bits) { return __builtin_amdgcn_ds_swizzle(bits, (M << 10) | 0x1f); }
DI void half_swap(unsigned& a, unsigned& b) { asm volatile("s_nop 1\n\tv_permlane32_swap_b32 %0, %1\n\ts_nop 1" : "+v"(a), "+v"(b)); }
template <int M> DI float xor_sum(float v) {
  if constexpr (M < 32) return v + __builtin_bit_cast(float, xor_partner_bits<M>(__builtin_bit_cast(int, v)));
  else { unsigned a = __builtin_bit_cast(unsigned, v), b = a; half_swap(a, b); return __builtin_bit_cast(float, a) + __builtin_bit_cast(float, b); }
}
template <int M> DI float xor_max(float v) {
  if constexpr (M < 32) return fmaxf(v, __builtin_bit_cast(float, xor_partner_bits<M>(__builtin_bit_cast(int, v))));
  else { unsigned a = __builtin_bit_cast(unsigned, v), b = a; half_swap(a, b); return fmaxf(__builtin_bit_cast(float, a), __builtin_bit_cast(float, b)); }
}
template <int M> DI int xor_sum_i(int v) {
  if constexpr (M < 32) return v + xor_partner_bits<M>(v);
  else { unsigned a = (unsigned)v, b = a; half_swap(a, b); return (int)(a + b); }
}
DI int lane_bcast(int v, int src) { return __builtin_amdgcn_readlane(v, src); }
DI float lane_get(float v, int src) { return __builtin_bit_cast(float, __builtin_amdgcn_ds_bpermute(src << 2, __builtin_bit_cast(int, v))); }
DI int lane_up(int v, int d, int lane) { return __builtin_amdgcn_ds_bpermute(((lane - d) & 63) << 2, v); }
#endif
#endif

DI float bf2f(bf16_t v) { return u2f(((unsigned)v) << 16); }
#ifdef CPU_EMU
DI bf16_t f2bf(float f) { unsigned u = f2u(f); u += 0x7fffu + ((u >> 16) & 1u); return (bf16_t)(u >> 16); }
DI unsigned pack2bf(float lo, float hi) { return (unsigned)f2bf(lo) | ((unsigned)f2bf(hi) << 16); }
static inline unsigned wave_ballot16(bool pr) { unsigned m = 0; for (int e = 0; e < 16; ++e) m |= (__shfl(pr ? 1 : 0, e) ? 1u : 0u) << e; return m; }
static inline bool wave_any(bool pr) { int v = pr ? 1 : 0; v |= __shfl_xor(v, 1); v |= __shfl_xor(v, 2); v |= __shfl_xor(v, 4); v |= __shfl_xor(v, 8); v |= __shfl_xor(v, 16); v |= __shfl_xor(v, 32); return v != 0; }
#else
typedef float f32x2_ __attribute__((ext_vector_type(2)));
typedef __bf16 bf16x2_hw __attribute__((ext_vector_type(2)));
DI unsigned pack2bf(float lo, float hi) { const f32x2_ v = {lo, hi}; return __builtin_bit_cast(unsigned, __builtin_convertvector(v, bf16x2_hw)); }
DI bf16_t f2bf(float f) { return (bf16_t)(pack2bf(f, f) & 0xffffu); }
DI bool wave_any(bool pr) { return __builtin_amdgcn_ballot_w64(pr) != 0ull; }
DI unsigned wave_ballot16(bool pr) { return (unsigned)__builtin_amdgcn_ballot_w64(pr) & 0xffffu; }
#endif
DI float sigmoidf_(float x) { return 1.0f / (1.0f + expf(-x)); }
DI float siluf_(float x) { return x / (1.0f + expf(-x)); }
DI float logsigmoidf_(float x) { return fminf(x, 0.0f) - log1pf(expf(-fabsf(x))); }

constexpr int D = 1024, NB = 2, TL = T_LAT, TC = T_CTX, TK = TL + TC;
constexpr int RL = NB * TL, RC = NB * TC, R = RL + RC;
constexpr int NZ = 3024, NZP = 3072;
constexpr int ZC_QLAT = 0, ZC_KVLAT = 256, ZC_KROPE = 384, ZC_MLQK = 416, ZC_MLV = 928, ZC_MLO = 1184, ZC_MLIG = 1440,
              ZC_MLFG = 1448, ZC_GQ = 1456, ZC_GK = 1584, ZC_GV = 1712, ZC_GR = 1968, ZC_GA = 2224, ZC_DQ = 2256,
              ZC_DK = 2512, ZC_DV = 2768;
constexpr int NCK = TK / 64, NCC = TC / 64, NCL = TL / 64;
constexpr int NE = 16, FF = 1408, CAPL = 2 * TL / 16, CAPC = 2 * TC / 16, CAPT = CAPL + CAPC, NSLOT = NB * CAPT;
constexpr size_t WSZ_IN = (size_t)NZP * D, WSZ_UQ = 384 * 256, WSZ_UKV = 512 * 128, WSZ_GATE = (size_t)4096 * D, WSZ_BR = (size_t)4 * D * 256, WSZ_OUT = (size_t)D * D;
constexpr int NUNIT = NB * 2 * NCK * 4;
constexpr float LOG2E = 1.4426950408889634f;
constexpr float QS_MLA = 0.10206207261596577f * LOG2E;
constexpr float QS_DIFF = 0.17677669529663687f * LOG2E;

DI int row_of(int b, int s) { return s < TC ? RL + b * TC + s : b * TL + (s - TC); }
DI void bs_of(int r, int& b, int& s) { if (r < RL) { b = r / TL; s = TC + (r % TL); } else { int q = r - RL; b = q / TC; s = q % TC; } }
DI int seq_of(int d, int p) { return d == 0 ? p : (p < TC ? TC - 1 - p : TK - 1 - (p - TC)); }
DI int step_of(int d, int c) { return d == 0 ? c : (c < NCC ? NCC - 1 - c : NCC + (NCK - 1 - c)); }

struct Params {
  const float *x, *c, *ctx, *c_ctx, *w_ada, *b_ada, *g_mix_pre, *g_mix_post, *g_ffn_pre, *g_ffn_post, *w_in, *g_q_lat, *w_uq,
      *g_kv_lat, *w_ukv, *w_conv, *b_conv, *b_igate, *b_fgate, *g_mlstm_out, *w_alpha2, *b_alpha, *g_gla_out, *diff_lambda,
      *g_diff_out, *w_branch, *w_gate, *b_gate, *w_out, *w_router, *w_e_gate, *w_e_up, *w_e_down;
  float* out;
  float *mods, *xc;
  bf16_t *H, *Z, *Qm, *Km, *Vtm, *Qd, *Kd, *Vtd, *MQ, *MK, *Y, *MG, *YO, *HID, *YE, *MVt, *GVt;
  float *BC, *IGS, *GC, *MC, *MN, *MM, *GS, *HD, *OD, *AFF, *SELV;
  int *SEL, *INV;
  bf16_t *Wt_in, *Wt_uq, *Wt_ukv, *Wt_gate, *Wt_branch, *Wt_out, *Wt_eg, *Wt_eu, *Wt_ed;
  unsigned* bar;
  size_t ws_need;
};

static inline size_t al256(size_t x) { return (x + 255) & ~(size_t)255; }
static inline void map_workspace(Params& p, char* ws) {
  size_t o = 0;
  auto take = [&](size_t bytes) { size_t r = o; o += al256(bytes); return ws + r; };
  p.bar = (unsigned*)take(16384);
  p.mods = (float*)take((size_t)2 * 3 * 6144 * 4);
  p.xc = (float*)take((size_t)RC * D * 4);
  p.BC = (float*)take((size_t)NB * 2 * TK * 4 * 4);
  p.IGS = (float*)take((size_t)NB * 2 * TK * 4 * 4);
  p.AFF = (float*)take((size_t)NB * NE * TK * 4);
  p.SEL = (int*)take((size_t)NE * NSLOT * 4);
  p.SELV = (float*)take((size_t)NE * NSLOT * 4);
  p.INV = (int*)take((size_t)R * NE * 4);
  p.MM = (float*)take((size_t)NUNIT * 4 * 4);
  p.MN = (float*)take((size_t)NUNIT * 64 * 4);
  p.Wt_in = (bf16_t*)take((size_t)2 * WSZ_IN * 2);
  p.Wt_uq = (bf16_t*)take((size_t)2 * WSZ_UQ * 2);
  p.Wt_ukv = (bf16_t*)take((size_t)2 * WSZ_UKV * 2);
  p.Wt_gate = (bf16_t*)take((size_t)2 * WSZ_GATE * 2);
  p.Wt_branch = (bf16_t*)take((size_t)2 * WSZ_BR * 2);
  p.Wt_out = (bf16_t*)take((size_t)2 * WSZ_OUT * 2);
  p.H = (bf16_t*)take((size_t)R * D * 2);
  size_t szA = (size_t)R * NZP * 2, szHID = (size_t)NE * NSLOT * FF * 2;
  char* A = take(szA > szHID ? szA : szHID);
  p.Z = (bf16_t*)A; p.HID = (bf16_t*)A;
  size_t szQm = al256((size_t)NB * 4 * TK * 96 * 2), szVt = al256((size_t)NB * 4 * 64 * TK * 2), szQd = al256((size_t)NB * 8 * TK * 32 * 2);
  size_t szB1 = 2 * szQm + 2 * szVt + 2 * szQd;
  size_t szHD = al256((size_t)2 * NB * TK * 256 * 4);
  size_t szYE = (size_t)NE * NSLOT * D * 2;
  size_t szB = szB1; if (2 * szHD > szB) szB = 2 * szHD; if (szYE > szB) szB = szYE;
  char* Bq = take(szB);
  p.Qm = (bf16_t*)Bq; p.Km = (bf16_t*)(Bq + szQm); p.Vtm = (bf16_t*)(Bq + 2 * szQm);
  p.Qd = (bf16_t*)(Bq + 2 * szQm + szVt); p.Kd = (bf16_t*)(Bq + 2 * szQm + szVt + szQd); p.Vtd = (bf16_t*)(Bq + 2 * szQm + szVt + 2 * szQd);
  p.YE = (bf16_t*)Bq;
  p.GC = (float*)take((size_t)NB * 2 * TK * 128 * 4);
  p.MVt = (bf16_t*)take((size_t)NB * 4 * 64 * TK * 2);
  p.GVt = (bf16_t*)take((size_t)NB * 4 * 64 * TK * 2);
  size_t szW = (size_t)NE * FF * D * 2;
  size_t szMC = (size_t)NUNIT * 4096 * 4, szRD = (size_t)R * D * 2;
  size_t szC = szMC; if (szRD > szC) szC = szRD; if (szW > szC) szC = szW;
  char* C = take(szC);
  p.MC = (float*)C; p.MG = (bf16_t*)C; p.Wt_eg = (bf16_t*)C;
  size_t szMQ = al256((size_t)NB * TK * 256 * 2), szGS = (size_t)NUNIT * 2048 * 4;
  size_t szD = 2 * szMQ + szGS; if (szW > szD) szD = szW;
  char* Dq = take(szD);
  p.MQ = (bf16_t*)Dq; p.MK = (bf16_t*)(Dq + szMQ); p.GS = (float*)(Dq + 2 * szMQ); p.Wt_eu = (bf16_t*)Dq;
  size_t szF = 2 * szRD > szW ? 2 * szRD : szW;
  char* F = take(szF);
  p.Y = (bf16_t*)F; p.YO = (bf16_t*)(F + szRD); p.Wt_ed = (bf16_t*)F;
  p.HD = (float*)Bq; p.OD = (float*)(Bq + szHD);
  p.ws_need = o;
}
#define GTID ((long)blockIdx.x * blockDim.x + threadIdx.x)

DI float lam_of(const Params& p, int layer, float& lam_init) {
  const float* lv = p.diff_lambda + layer * 128;
  float s1 = 0.f, s2 = 0.f;
  for (int i = 0; i < 32; ++i) { s1 += lv[i] * lv[32 + i]; s2 += lv[64 + i] * lv[96 + i]; }
  lam_init = layer == 0 ? 0.2f : 0.35550906759096f;
  return expf(s1) - expf(s2) + lam_init;
}
DI void rope_cs(int s, int jj, float& cs, float& sn) {
  int t = s - TC;
  int pos = (jj < 16) ? (t / 64) : (t % 64);
  float ang = (float)pos * exp2f(-1.6609640474436813f * (float)(jj & 7));
  double rev = (double)ang * 0.15915494309189535;
  rev -= floor(rev + 0.5);
  float rf = (float)rev;
  cs = hw_cos_rev(rf); sn = hw_sin_rev(rf);
}
template <class G> DI float rope_elem(G get, int s, int jj) {
  if (s < TC) return get(jj);
  float cs, sn; rope_cs(s, jj, cs, sn);
  float a = get(jj), b = get(jj ^ 8);
  return (jj & 8) ? (a * cs + b * sn) : (a * cs - b * sn);
}

DI void nvb_mods(long GI, const Params& p) {
  long i = GI; if (i >= 2 * 3 * 6144) return;
  int col = (int)(i % 6144), w = (int)((i / 6144) % 3), l = (int)(i / (3 * 6144));
  const float* cv = w < 2 ? p.c + w * 1024 : p.c_ctx;
  const float* W = p.w_ada + (size_t)l * 1024 * 6144;
  float acc = 0.f;
  for (int k = 0; k < 1024; ++k) acc += siluf_(cv[k]) * W[(size_t)k * 6144 + col];
  p.mods[i] = acc + p.b_ada[l * 6144 + col];
}
__global__ void __launch_bounds__(256) nv_wt(const float* in, bf16_t* out, int K, int N, int NP, long in_bs, long out_bs, const float* gain) {
  long i = GTID; if (i >= (long)NP * K) return;
  int k = (int)(i % K), n = (int)(i / K);
  const float* I = in + (size_t)blockIdx.y * in_bs; bf16_t* O = out + (size_t)blockIdx.y * out_bs;
  O[(size_t)n * K + k] = n < N ? f2bf(I[(size_t)k * N + n] * (gain ? gain[k] : 1.0f)) : (bf16_t)0;
}
__global__ void __launch_bounds__(256) nv_modulate(Params p, int layer, int which, const float* xl, const float* xcx, int nrows) {
  long r = GTID; if (r >= nrows) return;
  int w = r < RL ? (int)(r / TL) : 2;
  const float* mb = p.mods + (size_t)(layer * 3 + w) * 6144;
  const float* shift = mb + (which ? 3 : 0) * 1024; const float* scale = mb + (which ? 4 : 1) * 1024;
  const float* g = (which ? p.g_ffn_pre : p.g_mix_pre) + layer * 1024;
  const float* x = r < RL ? xl + (size_t)r * D : xcx + (size_t)(r - RL) * D;
  float ss = 0.f; for (int k = 0; k < D; ++k) ss += x[k] * x[k];
  float rstd = 1.0f / sqrtf(ss / D + 1e-6f);
  for (int k = 0; k < D; ++k) p.H[(size_t)r * D + k] = f2bf(x[k] * rstd * g[k] * (1.f + scale[k]) + shift[k]);
}
__global__ void __launch_bounds__(256) nv_gemm(const bf16_t* A, int lda, const bf16_t* Bt, int ldb, int M, int N, int K, bf16_t* C, int ldc) {
  long i = GTID; if (i >= (long)M * N) return;
  int n = (int)(i % N), m = (int)(i / N);
  const bf16_t* a = A + (size_t)m * lda; const bf16_t* b = Bt + (size_t)n * ldb;
  float acc = 0.f;
  for (int k = 0; k < K; ++k) acc += bf2f(a[k]) * bf2f(b[k]);
  C[(size_t)m * ldc + n] = f2bf(acc);
}
__global__ void __launch_bounds__(256) nv_mla_q(Params p, int layer) {
  long i = GTID; if (i >= (long)R * 4 * 96) return;
  int j = (int)(i % 96), h = (int)((i / 96) % 4), r = (int)(i / 384);
  int b, s; bs_of(r, b, s);
  const bf16_t* z = p.Z + (size_t)r * NZP + ZC_QLAT;
  const float* g = p.g_q_lat + layer * 256; const float* W = p.w_uq + (size_t)layer * 256 * 384;
  float ss = 0.f; for (int k = 0; k < 256; ++k) { float v = bf2f(z[k]); ss += v * v; }
  float rstd = 1.0f / sqrtf(ss / 256 + 1e-6f);
  auto dot = [&](int col) { float a = 0.f; for (int k = 0; k < 256; ++k) a += bf2f(z[k]) * rstd * g[k] * W[(size_t)k * 384 + col]; return a; };
  float v;
  if (j < 64) v = dot(h * 96 + j);
  else v = rope_elem([&](int jj) { return dot(h * 96 + 64 + jj); }, s, j - 64);
  p.Qm[(((size_t)b * 4 + h) * TK + s) * 96 + j] = f2bf(v * QS_MLA);
}
__global__ void __launch_bounds__(256) nv_mla_kv(Params p, int layer) {
  long i = GTID; if (i >= (long)R * 4 * 160) return;
  int j = (int)(i % 160), h = (int)((i / 160) % 4), r = (int)(i / 640);
  int b, s; bs_of(r, b, s);
  const bf16_t* z = p.Z + (size_t)r * NZP;
  if (j < 128) {
    const bf16_t* zl = z + ZC_KVLAT; const float* g = p.g_kv_lat + layer * 128; const float* W = p.w_ukv + (size_t)layer * 128 * 512;
    float ss = 0.f; for (int k = 0; k < 128; ++k) { float v = bf2f(zl[k]); ss += v * v; }
    float rstd = 1.0f / sqrtf(ss / 128 + 1e-6f);
    float a = 0.f; for (int k = 0; k < 128; ++k) a += bf2f(zl[k]) * rstd * g[k] * W[(size_t)k * 512 + h * 128 + j];
    if (j < 64) p.Km[(((size_t)b * 4 + h) * TK + s) * 96 + j] = f2bf(a);
    else p.Vtm[(((size_t)b * 4 + h) * 64 + (j - 64)) * TK + s] = f2bf(a);
  } else {
    int jj = j - 128;
    float v = rope_elem([&](int q) { return bf2f(z[ZC_KROPE + q]); }, s, jj);
    p.Km[(((size_t)b * 4 + h) * TK + s) * 96 + 64 + jj] = f2bf(v);
  }
}
__global__ void __launch_bounds__(256) nv_diff_prep(Params p) {
  long i = GTID; if (i >= (long)R * 768) return;
  int c = (int)(i % 768), r = (int)(i / 768);
  int b, s; bs_of(r, b, s);
  const bf16_t* z = p.Z + (size_t)r * NZP;
  if (c < 512) {
    int qk = c / 256, cc = c % 256, hm = cc / 32, jj = cc % 32;
    const bf16_t* src = z + (qk ? ZC_DK : ZC_DQ) + hm * 32;
    float v = rope_elem([&](int q) { return bf2f(src[q]); }, s, jj);
    if (qk == 0) p.Qd[(((size_t)b * 8 + hm) * TK + s) * 32 + jj] = f2bf(v * QS_DIFF);
    else p.Kd[(((size_t)b * 8 + hm) * TK + s) * 32 + jj] = f2bf(v);
  } else {
    int cc = c - 512, h = cc / 64, dv = cc % 64;
    p.Vtd[(((size_t)b * 4 + h) * 64 + dv) * TK + s] = z[ZC_DV + cc];
  }
}
__global__ void __launch_bounds__(256) nv_ml_prep(Params p, int layer) {
  long i = GTID; if (i >= (long)R * 512) return;
  int ch = (int)(i % 512), r = (int)(i / 512);
  int b, s; bs_of(r, b, s);
  bool first = (s == 0) || (s == TC), last = (s == TC - 1) || (s == TK - 1);
  const float* w = p.w_conv + (size_t)layer * 3 * 512;
  float acc = p.b_conv[layer * 512 + ch];
  acc += bf2f(p.Z[(size_t)r * NZP + ZC_MLQK + ch]) * w[512 + ch];
  if (!first) acc += bf2f(p.Z[(size_t)row_of(b, s - 1) * NZP + ZC_MLQK + ch]) * w[ch];
  if (!last) acc += bf2f(p.Z[(size_t)row_of(b, s + 1) * NZP + ZC_MLQK + ch]) * w[1024 + ch];
  float v = siluf_(acc);
  if (ch < 256) p.MQ[((size_t)b * TK + s) * 256 + ch] = f2bf(v);
  else p.MK[((size_t)b * TK + s) * 256 + ch - 256] = f2bf(v * 0.125f);
}
DI void nvb_ml_gates(long GI, const Params& p, int layer) {
  long i = GI; if (i >= (long)NB * 2 * NCK * 4) return;
  int h = (int)(i % 4), j = (int)((i / 4) % NCK), d = (int)((i / (4 * NCK)) % 2), b = (int)(i / (8 * NCK));
  float bi = p.b_igate[layer * 8 + d * 4 + h], bfg = p.b_fgate[layer * 8 + d * 4 + h];
  float cum = 0.f;
  for (int l = 0; l < 64; ++l) {
    int pp = 64 * j + l, s = seq_of(d, pp); const bf16_t* z = p.Z + (size_t)row_of(b, s) * NZP;
    float ig = bf2f(z[ZC_MLIG + d * 4 + h]) + bi;
    float lf = logsigmoidf_(bf2f(z[ZC_MLFG + d * 4 + h]) + bfg);
    cum += lf;
    size_t o = (((size_t)b * 2 + d) * TK + pp) * 4 + h;
    p.BC[o] = cum; p.IGS[o] = ig;
  }
}
DI void nvb_gla_cum(long GI, const Params& p, int layer) {
  long i = GI; if (i >= (long)NB * 2 * NCK * 128) return;
  int ch = (int)(i % 128), j = (int)((i / 128) % NCK), d = (int)((i / (128 * NCK)) % 2), b = (int)(i / (256 * NCK));
  const float* W = p.w_alpha2 + (size_t)layer * 2 * 16 * 128 + (size_t)d * 16 * 128;
  float ba = p.b_alpha[layer * 256 + d * 128 + ch];
  float cum = 0.f;
  for (int l = 0; l < 64; ++l) {
    int pp = 64 * j + l, s = seq_of(d, pp); const bf16_t* z = p.Z + (size_t)row_of(b, s) * NZP + ZC_GA + d * 16;
    float zg = ba; for (int q = 0; q < 16; ++q) zg += bf2f(z[q]) * W[q * 128 + ch];
    cum += logsigmoidf_(zg) * (1.0f / 16.0f);
    p.GC[(((size_t)b * 2 + d) * TK + pp) * 128 + ch] = cum;
  }
}
__global__ void __launch_bounds__(256) nv_attn_mla(Params p, int need_ctx) {
  long i = GTID; if (i >= (long)NB * 4 * TK) return;
  int s = (int)(i % TK), h = (int)((i / TK) % 4), b = (int)(i / (4 * TK));
  if (s < TC && !need_ctx) return;
  int nk = s < TC ? TC : TK;
  const bf16_t* q = p.Qm + (((size_t)b * 4 + h) * TK + s) * 96;
  const bf16_t* K = p.Km + ((size_t)b * 4 + h) * TK * 96;
  const bf16_t* Vt = p.Vtm + ((size_t)b * 4 + h) * 64 * TK;
  float qf[96], o[64];
  _Pragma("unroll") for (int k = 0; k < 96; ++k) qf[k] = bf2f(q[k]);
  _Pragma("unroll") for (int k = 0; k < 64; ++k) o[k] = 0.f;
  float m = -1e30f, l = 0.f;
  for (int t = 0; t < nk; ++t) {
    float sc = 0.f; _Pragma("unroll") for (int k = 0; k < 96; ++k) sc += qf[k] * bf2f(K[(size_t)t * 96 + k]);
    float mn = fmaxf(m, sc), a = exp2f(m - mn), pr = exp2f(sc - mn);
    l = l * a + pr;
    _Pragma("unroll") for (int k = 0; k < 64; ++k) o[k] = o[k] * a + pr * bf2f(Vt[(size_t)k * TK + t]);
    m = mn;
  }
  int r = row_of(b, s);
  _Pragma("unroll") for (int k = 0; k < 64; ++k) p.Y[(size_t)r * D + h * 64 + k] = f2bf(o[k] / l);
}
__global__ void __launch_bounds__(256) nv_attn_diff(Params p, int layer, int need_ctx) {
  long i = GTID; if (i >= (long)NB * 4 * TK) return;
  int s = (int)(i % TK), h = (int)((i / TK) % 4), b = (int)(i / (4 * TK));
  if (s < TC && !need_ctx) return;
  int nk = s < TC ? TC : TK;
  float lam_init; float lam = lam_of(p, layer, lam_init);
  const bf16_t* Vt = p.Vtd + ((size_t)b * 4 + h) * 64 * TK;
  float res[64];
  _Pragma("unroll") for (int k = 0; k < 64; ++k) res[k] = 0.f;
  _Pragma("unroll") for (int mp = 0; mp < 2; ++mp) {
    const bf16_t* q = p.Qd + (((size_t)b * 8 + h * 2 + mp) * TK + s) * 32;
    const bf16_t* K = p.Kd + ((size_t)b * 8 + h * 2 + mp) * TK * 32;
    float qf[32], o[64];
    _Pragma("unroll") for (int k = 0; k < 32; ++k) qf[k] = bf2f(q[k]);
    _Pragma("unroll") for (int k = 0; k < 64; ++k) o[k] = 0.f;
    float m = -1e30f, l = 0.f;
    for (int t = 0; t < nk; ++t) {
      float sc = 0.f; _Pragma("unroll") for (int k = 0; k < 32; ++k) sc += qf[k] * bf2f(K[(size_t)t * 32 + k]);
      float mn = fmaxf(m, sc), a = exp2f(m - mn), pr = exp2f(sc - mn);
      l = l * a + pr;
      _Pragma("unroll") for (int k = 0; k < 64; ++k) o[k] = o[k] * a + pr * bf2f(Vt[(size_t)k * TK + t]);
      m = mn;
    }
    float wgt = mp == 0 ? 1.f : -lam;
    _Pragma("unroll") for (int k = 0; k < 64; ++k) res[k] += wgt * o[k] / l;
  }
  float ss = 0.f; _Pragma("unroll") for (int k = 0; k < 64; ++k) ss += res[k] * res[k];
  float rstd = 1.0f / sqrtf(ss / 64 + 1e-6f);
  int r = row_of(b, s);
  _Pragma("unroll") for (int k = 0; k < 64; ++k) p.Y[(size_t)r * D + 768 + h * 64 + k] = f2bf(res[k] * rstd * p.g_diff_out[layer * 256 + h * 64 + k] * (1.f - lam_init));
}
DI void nvb_ml_local(long GI, const Params& p) {
  long i = GI; if (i >= (long)NUNIT * 4160) return;
  int e = (int)(i % 4160); long u = i / 4160;
  int h = (int)(u % 4), j = (int)((u / 4) % NCK), d = (int)((u / (4 * NCK)) % 2), b = (int)(u / (8 * NCK));
  const float* bc = p.BC + (((size_t)b * 2 + d) * TK + 64 * j) * 4 + h; const float* ig = p.IGS + (((size_t)b * 2 + d) * TK + 64 * j) * 4 + h;
  float bend = bc[63 * 4], ml = -1e30f;
  for (int l = 0; l < 64; ++l) ml = fmaxf(ml, bend - bc[l * 4] + ig[l * 4]);
  if (e == 4096 + 0) { p.MM[u * 4 + 0] = ml; p.MM[u * 4 + 1] = bend; }
  float acc = 0.f;
  if (e < 4096) {
    int v = e / 64, k = e % 64;
    for (int l = 0; l < 64; ++l) {
      int s = seq_of(d, 64 * j + l); float w = expf(bend - bc[l * 4] + ig[l * 4] - ml);
      acc += w * bf2f(p.Z[(size_t)row_of(b, s) * NZP + ZC_MLV + h * 64 + v]) * bf2f(p.MK[((size_t)b * TK + s) * 256 + h * 64 + k]);
    }
    p.MC[(size_t)u * 4096 + e] = acc;
  } else {
    int k = e - 4096;
    for (int l = 0; l < 64; ++l) {
      int s = seq_of(d, 64 * j + l); float w = expf(bend - bc[l * 4] + ig[l * 4] - ml);
      acc += w * bf2f(p.MK[((size_t)b * TK + s) * 256 + h * 64 + k]);
    }
    p.MN[(size_t)u * 64 + k] = acc;
  }
}
DI void nvb_ml_scan(long GI, const Params& p) {
  long i = GI; if (i >= (long)NB * 2 * 4 * 4160) return;
  int e = (int)(i % 4160); int ch = (int)(i / 4160); int h = ch % 4, bd = ch / 4;
  float st = 0.f, m = -1e30f;
  for (int j = 0; j < NCK; ++j) {
    size_t u = ((size_t)bd * NCK + j) * 4 + h;
    float ml = p.MM[u * 4 + 0], be = p.MM[u * 4 + 1];
    float mn = fmaxf(be + m, ml), a = expf(be + m - mn), g = expf(ml - mn);
    float* slot = e < 4096 ? &p.MC[u * 4096 + e] : &p.MN[u * 64 + (e - 4096)];
    float loc = *slot; *slot = st; st = a * st + g * loc;
    if (e == 0) p.MM[u * 4 + 2] = m;
    m = mn;
  }
}
DI void nvb_ml_out(long GI, const Params& p, int need_ctx) {
  long i = GI; if (i >= (long)NUNIT * 4096) return;
  int v = (int)(i % 64), l = (int)((i / 64) % 64); long u = i / 4096;
  int h = (int)(u % 4), j = (int)((u / 4) % NCK), d = (int)((u / (4 * NCK)) % 2), b = (int)(u / (8 * NCK));
  if (j < NCC && !need_ctx) return;
  const float* bc = p.BC + (((size_t)b * 2 + d) * TK + 64 * j) * 4 + h; const float* ig = p.IGS + (((size_t)b * 2 + d) * TK + 64 * j) * 4 + h;
  float m0 = p.MM[u * 4 + 2];
  int sl = seq_of(d, 64 * j + l);
  const bf16_t* q = p.MQ + ((size_t)b * TK + sl) * 256 + h * 64;
  float bl = bc[l * 4];
  float inter = bl + m0, mt = inter;
  for (int t = 0; t <= l; ++t) mt = fmaxf(mt, bl - bc[t * 4] + ig[t * 4]);
  float num = 0.f, den = 0.f;
  for (int t = 0; t <= l; ++t) {
    int st = seq_of(d, 64 * j + t);
    const bf16_t* k = p.MK + ((size_t)b * TK + st) * 256 + h * 64;
    float qk = 0.f; for (int c = 0; c < 64; ++c) qk += bf2f(q[c]) * bf2f(k[c]);
    float sv = expf(bl - bc[t * 4] + ig[t * 4] - mt) * qk;
    num += sv * bf2f(p.Z[(size_t)row_of(b, st) * NZP + ZC_MLV + h * 64 + v]); den += sv;
  }
  float ai = expf(inter - mt);
  float qc = 0.f, qn = 0.f;
  for (int c = 0; c < 64; ++c) { qc += bf2f(q[c]) * p.MC[(size_t)u * 4096 + v * 64 + c]; qn += bf2f(q[c]) * p.MN[(size_t)u * 64 + c]; }
  num += ai * qc; den += ai * qn;
  p.HD[(((size_t)d * NB + b) * TK + sl) * 256 + h * 64 + v] = num / fmaxf(fabsf(den), expf(-mt));
}
DI void nvb_ml_finish(long GI, const Params& p, int layer, int need_ctx) {
  long i = GI; if (i >= (long)R * 4) return;
  int h = (int)(i % 4), r = (int)(i / 4); int b, s; bs_of(r, b, s);
  if (s < TC && !need_ctx) return;
  const float* h0 = p.HD + (((size_t)0 * NB + b) * TK + s) * 256 + h * 64; const float* h1 = p.HD + (((size_t)1 * NB + b) * TK + s) * 256 + h * 64;
  float ss = 0.f; for (int v = 0; v < 64; ++v) { float t = h0[v] + h1[v]; ss += t * t; }
  float rstd = 1.0f / sqrtf(ss / 64 + 1e-6f);
  for (int v = 0; v < 64; ++v) {
    float o = bf2f(p.Z[(size_t)r * NZP + ZC_MLO + h * 64 + v]);
    p.Y[(size_t)r * D + 256 + h * 64 + v] = f2bf(sigmoidf_(o) * (h0[v] + h1[v]) * rstd * p.g_mlstm_out[layer * 256 + h * 64 + v]);
  }
}
DI void nvb_gla_local(long GI, const Params& p) {
  long i = GI; if (i >= (long)NUNIT * 2048) return;
  int v = (int)(i % 64), k = (int)((i / 64) % 32); long u = i / 2048;
  int h = (int)(u % 4), j = (int)((u / 4) % NCK), d = (int)((u / (4 * NCK)) % 2), b = (int)(u / (8 * NCK));
  const float* gc = p.GC + (((size_t)b * 2 + d) * TK + 64 * j) * 128 + h * 32 + k;
  float ge = gc[63 * 128], acc = 0.f;
  for (int l = 0; l < 64; ++l) {
    int s = seq_of(d, 64 * j + l); const bf16_t* z = p.Z + (size_t)row_of(b, s) * NZP;
    acc += bf2f(z[ZC_GK + h * 32 + k]) * expf(ge - gc[l * 128]) * bf2f(z[ZC_GV + h * 64 + v]);
  }
  p.GS[(size_t)u * 2048 + v * 32 + k] = acc;
}
DI void nvb_gla_scan(long GI, const Params& p) {
  long i = GI; if (i >= (long)NB * 2 * 4 * 2048) return;
  int e = (int)(i % 2048); int ch = (int)(i / 2048); int h = ch % 4, bd = ch / 4; int k = e % 32;
  float st = 0.f;
  for (int j = 0; j < NCK; ++j) {
    size_t u = ((size_t)bd * NCK + j) * 4 + h;
    float ge = p.GC[((size_t)bd * TK + 64 * j + 63) * 128 + h * 32 + k];
    float loc = p.GS[u * 2048 + e]; p.GS[u * 2048 + e] = st; st = expf(ge) * st + loc;
  }
}
DI void nvb_gla_out(long GI, const Params& p, int need_ctx) {
  long i = GI; if (i >= (long)NUNIT * 4096) return;
  int v = (int)(i % 64), l = (int)((i / 64) % 64); long u = i / 4096;
  int h = (int)(u % 4), j = (int)((u / 4) % NCK), d = (int)((u / (4 * NCK)) % 2), b = (int)(u / (8 * NCK));
  if (j < NCC && !need_ctx) return;
  const float* gc = p.GC + (((size_t)b * 2 + d) * TK + 64 * j) * 128 + h * 32;
  int sl = seq_of(d, 64 * j + l);
  const bf16_t* q = p.Z + (size_t)row_of(b, sl) * NZP + ZC_GQ + h * 32;
  const float qs = 0.17677669529663687f;
  float acc = 0.f;
  for (int t = 0; t <= l; ++t) {
    int st = seq_of(d, 64 * j + t); const bf16_t* z = p.Z + (size_t)row_of(b, st) * NZP;
    float att = 0.f; for (int k = 0; k < 32; ++k) att += bf2f(q[k]) * qs * expf(gc[l * 128 + k] - gc[t * 128 + k]) * bf2f(z[ZC_GK + h * 32 + k]);
    acc += att * bf2f(z[ZC_GV + h * 64 + v]);
  }
  for (int k = 0; k < 32; ++k) acc += bf2f(q[k]) * qs * expf(gc[l * 128 + k]) * p.GS[(size_t)u * 2048 + v * 32 + k];
  p.OD[(((size_t)d * NB + b) * TK + sl) * 256 + h * 64 + v] = acc;
}
DI void nvb_gla_finish(long GI, const Params& p, int layer, int need_ctx) {
  long i = GI; if (i >= (long)R * 4) return;
  int h = (int)(i % 4), r = (int)(i / 4); int b, s; bs_of(r, b, s);
  if (s < TC && !need_ctx) return;
  const float* h0 = p.OD + (((size_t)0 * NB + b) * TK + s) * 256 + h * 64; const float* h1 = p.OD + (((size_t)1 * NB + b) * TK + s) * 256 + h * 64;
  float ss = 0.f; for (int v = 0; v < 64; ++v) { float t = h0[v] + h1[v]; ss += t * t; }
  float rstd = 1.0f / sqrtf(ss / 64 + 1e-6f);
  for (int v = 0; v < 64; ++v) {
    float rr = bf2f(p.Z[(size_t)r * NZP + ZC_GR + h * 64 + v]);
    p.Y[(size_t)r * D + 512 + h * 64 + v] = f2bf(siluf_(rr) * (h0[v] + h1[v]) * rstd * p.g_gla_out[layer * 256 + h * 64 + v]);
  }
}
__global__ void __launch_bounds__(256) nv_merge(Params p, int layer, int nrows) {
  long i = GTID; if (i >= (long)nrows * D) return;
  int j = (int)(i % D), r = (int)(i / D);
  float acc = 0.f;
  for (int n = 0; n < 4; ++n) {
    const bf16_t* wg = p.Wt_gate + (size_t)(n * 1024 + j) * D; const bf16_t* wb = p.Wt_branch + ((size_t)n * D + j) * 256;
    float g = p.b_gate[layer * 4096 + n * 1024 + j], pr = 0.f;
    for (int k = 0; k < D; ++k) g += bf2f(p.H[(size_t)r * D + k]) * bf2f(wg[k]);
    for (int k = 0; k < 256; ++k) pr += bf2f(p.Y[(size_t)r * D + n * 256 + k]) * bf2f(wb[k]);
    acc += sigmoidf_(g) * pr;
  }
  p.MG[(size_t)r * D + j] = f2bf(acc);
}
__global__ void __launch_bounds__(256) nv_resid_mix(Params p, int layer, const float* xl_in, const float* xc_in, int nrows) {
  long r = GTID; if (r >= nrows) return;
  int w = r < RL ? (int)(r / TL) : 2;
  const float* mb = p.mods + (size_t)(layer * 3 + w) * 6144;
  const float* xin = r < RL ? xl_in + (size_t)r * D : xc_in + (size_t)(r - RL) * D;
  float* xo = r < RL ? p.out + (size_t)r * D : p.xc + (size_t)(r - RL) * D;
  const bf16_t* yo = p.YO + (size_t)r * D;
  float ss = 0.f; for (int k = 0; k < D; ++k) { float v = bf2f(yo[k]); ss += v * v; }
  float rstd = 1.0f / sqrtf(ss / D + 1e-6f);
  float s2 = 0.f;
  for (int k = 0; k < D; ++k) { float xn = xin[k] + mb[2 * 1024 + k] * bf2f(yo[k]) * rstd * p.g_mix_post[layer * 1024 + k]; xo[k] = xn; s2 += xn * xn; }
  float rstd2 = 1.0f / sqrtf(s2 / D + 1e-6f);
  float lg[16]; _Pragma("unroll") for (int e = 0; e < 16; ++e) lg[e] = 0.f;
  const float* wr = p.w_router + (size_t)layer * D * 16;
  for (int k = 0; k < D; ++k) {
    float h2 = xo[k] * rstd2 * p.g_ffn_pre[layer * 1024 + k] * (1.f + mb[4 * 1024 + k]) + mb[3 * 1024 + k];
    p.H[(size_t)r * D + k] = f2bf(h2);
    _Pragma("unroll") for (int e = 0; e < 16; ++e) lg[e] += h2 * wr[k * 16 + e];
  }
  float mx = lg[0]; _Pragma("unroll") for (int e = 1; e < 16; ++e) mx = fmaxf(mx, lg[e]);
  float sm = 0.f; _Pragma("unroll") for (int e = 0; e < 16; ++e) { lg[e] = expf(lg[e] - mx); sm += lg[e]; }
  int b, s; bs_of((int)r, b, s);
  _Pragma("unroll") for (int e = 0; e < 16; ++e) p.AFF[((size_t)b * NE + e) * TK + s] = lg[e] / sm;
}
__global__ void __launch_bounds__(256) nv_topk(Params p, int need_ctx) {
  long i = GTID; if (i >= NB * NE * 2) return;
  int seg = (int)(i % 2), e = (int)((i / 2) % NE), b = (int)(i / (2 * NE));
  int s0 = seg ? TC : 0, n = seg ? TL : TC, cap = seg ? CAPL : CAPC, slot0 = seg ? b * CAPL : NB * CAPL + b * CAPC;
  if (seg == 0 && !need_ctx) { for (int q = 0; q < cap; ++q) p.SEL[(size_t)e * NSLOT + slot0 + q] = -1; return; }
  const float* a = p.AFF + ((size_t)b * NE + e) * TK + s0;
  unsigned thr = 0;
  for (int bit = 31; bit >= 0; --bit) {
    unsigned cand = thr | (1u << bit); int cnt = 0;
    for (int t = 0; t < n; ++t) cnt += (f2u(a[t]) >= cand);
    if (cnt >= cap) thr = cand;
  }
  int ngt = 0; for (int t = 0; t < n; ++t) ngt += (f2u(a[t]) > thr);
  int neq = cap - ngt, q = 0;
  for (int t = 0; t < n; ++t) {
    unsigned u = f2u(a[t]); int r = row_of(b, s0 + t); int sel = -1;
    if (u > thr) sel = q++; else if (u == thr && neq > 0) { sel = q++; --neq; }
    if (sel >= 0) { p.SEL[(size_t)e * NSLOT + slot0 + sel] = r; p.SELV[(size_t)e * NSLOT + slot0 + sel] = a[t]; }
    p.INV[(size_t)r * NE + e] = sel >= 0 ? slot0 + sel : -1;
  }
}
__global__ void __launch_bounds__(256) nv_moe1(Params p) {
  long i = GTID; if (i >= (long)NE * NSLOT * FF) return;
  int f = (int)(i % FF), slot = (int)((i / FF) % NSLOT), e = (int)(i / ((long)FF * NSLOT));
  int r = p.SEL[(size_t)e * NSLOT + slot];
  float out = 0.f;
  if (r >= 0) {
    const bf16_t* wg = p.Wt_eg + ((size_t)e * FF + f) * D; const bf16_t* wu = p.Wt_eu + ((size_t)e * FF + f) * D; const bf16_t* h = p.H + (size_t)r * D;
    float g = 0.f, u = 0.f; for (int k = 0; k < D; ++k) { float hv = bf2f(h[k]); g += hv * bf2f(wg[k]); u += hv * bf2f(wu[k]); }
    out = siluf_(g) * u;
  }
  p.HID[((size_t)e * NSLOT + slot) * FF + f] = f2bf(out);
}
__global__ void __launch_bounds__(256) nv_moe2(Params p) {
  long i = GTID; if (i >= (long)NE * NSLOT * D) return;
  int j = (int)(i % D), slot = (int)((i / D) % NSLOT), e = (int)(i / ((long)D * NSLOT));
  int r = p.SEL[(size_t)e * NSLOT + slot];
  float out = 0.f;
  if (r >= 0) {
    const bf16_t* wd = p.Wt_ed + ((size_t)e * D + j) * FF; const bf16_t* h = p.HID + ((size_t)e * NSLOT + slot) * FF;
    float a = 0.f; for (int k = 0; k < FF; ++k) a += bf2f(h[k]) * bf2f(wd[k]);
    out = a * p.SELV[(size_t)e * NSLOT + slot];
  }
  p.YE[((size_t)e * NSLOT + slot) * D + j] = f2bf(out);
}
__global__ void __launch_bounds__(256) nv_resid_ffn(Params p, int layer, int nrows) {
  long r = GTID; if (r >= nrows) return;
  int w = r < RL ? (int)(r / TL) : 2;
  const float* mb = p.mods + (size_t)(layer * 3 + w) * 6144;
  float* xo = r < RL ? p.out + (size_t)r * D : p.xc + (size_t)(r - RL) * D;
  float ss = 0.f;
  for (int k = 0; k < D; ++k) {
    float f = 0.f;
    for (int e = 0; e < NE; ++e) { int sl = p.INV[(size_t)r * NE + e]; if (sl >= 0) f += bf2f(p.YE[((size_t)e * NSLOT + sl) * D + k]); }
    ss += f * f;
  }
  float rstd = 1.0f / sqrtf(ss / D + 1e-6f);
  for (int k = 0; k < D; ++k) {
    float f = 0.f;
    for (int e = 0; e < NE; ++e) { int sl = p.INV[(size_t)r * NE + e]; if (sl >= 0) f += bf2f(p.YE[((size_t)e * NSLOT + sl) * D + k]); }
    xo[k] += mb[5 * 1024 + k] * f * rstd * p.g_ffn_post[layer * 1024 + k];
  }
}

__global__ void __launch_bounds__(256) nv_mods(Params p) { nvb_mods(GTID, p); }
__global__ void __launch_bounds__(256) nv_ml_gates(Params p, int layer) { nvb_ml_gates(GTID, p, layer); }
__global__ void __launch_bounds__(256) nv_gla_cum(Params p, int layer) { nvb_gla_cum(GTID, p, layer); }
__global__ void __launch_bounds__(256) nv_ml_local(Params p) { nvb_ml_local(GTID, p); }
__global__ void __launch_bounds__(256) nv_ml_scan(Params p) { nvb_ml_scan(GTID, p); }
__global__ void __launch_bounds__(256) nv_ml_out(Params p, int need_ctx) { nvb_ml_out(GTID, p, need_ctx); }
__global__ void __launch_bounds__(256) nv_ml_finish(Params p, int layer, int need_ctx) { nvb_ml_finish(GTID, p, layer, need_ctx); }
__global__ void __launch_bounds__(256) nv_gla_local(Params p) { nvb_gla_local(GTID, p); }
__global__ void __launch_bounds__(256) nv_gla_scan(Params p) { nvb_gla_scan(GTID, p); }
__global__ void __launch_bounds__(256) nv_gla_out(Params p, int need_ctx) { nvb_gla_out(GTID, p, need_ctx); }
__global__ void __launch_bounds__(256) nv_gla_finish(Params p, int layer, int need_ctx) { nvb_gla_finish(GTID, p, layer, need_ctx); }
constexpr int LROW = 144;
constexpr int A_BYTES = 128 * LROW;
constexpr int NTHR = 256;
#ifndef ATT_THR
#define ATT_THR 16.0f
#endif

DI int xcd_swz(int u, int nt) { return (nt & 7) ? u : (u & 7) * (nt >> 3) + (u >> 3); }
template <int GW> DI void grp_tile(int L, int ntm, int ntn, int& tm, int& tn) {
  const int gsz = ntm * GW; int g = 0;
  while (L >= gsz) { L -= gsz; ++g; }
  tm = L / GW; tn = g * GW + (L & (GW - 1)); (void)ntn;
}
DI u32x4 ldg16(const void* p) { return *(const u32x4*)p; }
DI void sts16(char* p, u32x4 v) { *(u32x4*)p = v; }
DI bf16x8 lds_frag(const char* p) { return *(const bf16x8*)p; }

template <int WN, int KFIX = 0>
DI void gemm_kloop(f32x4 (&acc)[4][WN], const bf16_t* const (&ap)[4], const bf16_t* const (&bp)[WN], int nk, char* lds) {
  constexpr int STAGE = A_BYTES + 32 * WN * LROW;
  const int t = TIDX, lane = t & 63, wid = t >> 6, wr = wid >> 1, wc = wid & 1;
  const int lr = t >> 3, lcb = (t & 7) * 16;
  const int fr = lane & 15, fq = lane >> 4;
  const int aoff = (wr * 64 + fr) * LROW + fq * 16, boff = A_BYTES + (wc * WN * 16 + fr) * LROW + fq * 16, soff = lr * LROW + lcb;
  u32x4 ra0[4], rb0[WN], ra1[4], rb1[WN];
  auto gload = [&](u32x4 (&ra)[4], u32x4 (&rb)[WN], int kt) {
#pragma unroll
    for (int i = 0; i < 4; ++i) ra[i] = ldg16(ap[i] + (KFIX ? (kt & 1) : kt) * 64);
#pragma unroll
    for (int i = 0; i < WN; ++i) rb[i] = ldg16(bp[i] + (KFIX ? (kt & 1) : kt) * 64);
  };
  auto sstore = [&](const u32x4 (&ra)[4], const u32x4 (&rb)[WN], char* st) {
#pragma unroll
    for (int i = 0; i < 4; ++i) sts16(st + soff + 32 * i * LROW, ra[i]);
#pragma unroll
    for (int i = 0; i < WN; ++i) sts16(st + A_BYTES + soff + 32 * i * LROW, rb[i]);
  };
  auto compute = [&](const char* cur) {
#pragma unroll
    for (int ks = 0; ks < 2; ++ks) {
      bf16x8 af[4], bfr[WN];
#pragma unroll
      for (int m = 0; m < 4; ++m) af[m] = lds_frag(cur + aoff + m * 16 * LROW + ks * 64);
#pragma unroll
      for (int n = 0; n < WN; ++n) bfr[n] = lds_frag(cur + boff + n * 16 * LROW + ks * 64);
#pragma unroll
      for (int m = 0; m < 4; ++m)
#pragma unroll
        for (int n = 0; n < WN; ++n) acc[m][n] = MFMA16(bfr[n], af[m], acc[m][n]);
    }
    IGLP_OPT();
  };
  gload(ra0, rb0, 0);
  gload(ra1, rb1, 1);
  sstore(ra0, rb0, lds);
  __syncthreads();
#pragma unroll 1
  for (int kt = 0; kt < nk; kt += 2) {
    if (kt + 2 < nk) gload(ra0, rb0, kt + 2);
    compute(lds);
    sstore(ra1, rb1, lds + STAGE);
    __syncthreads();
    if (kt + 3 < nk) gload(ra1, rb1, kt + 3);
    compute(lds + STAGE);
    if (kt + 2 < nk) sstore(ra0, rb0, lds);
    __syncthreads();
  }
}
template <int WN> DI void acc_zero(f32x4 (&acc)[4][WN]) {
#pragma unroll
  for (int m = 0; m < 4; ++m)
#pragma unroll
    for (int n = 0; n < WN; ++n) acc[m][n] = (f32x4){0.f, 0.f, 0.f, 0.f};
}
DI void st_bf16x4(bf16_t* p, f32x4 v) { u32x2 o; o.x = pack2bf(v.x, v.y); o.y = pack2bf(v.z, v.w); *(u32x2*)p = o; }

template <int WN, class RowOk>
DI void store_wave_tile(const f32x4 (&acc)[4][WN], bf16_t* C, size_t ldc, char* ldsw, int lane, RowOk row_ok) {
  constexpr int PITCH = WN * 32 + 16, CPR = WN * 2;
  const int fr = lane & 15, fq = lane >> 4;
#pragma unroll
  for (int m = 0; m < 4; ++m)
#pragma unroll
    for (int n = 0; n < WN; ++n) { u32x2 o; o.x = pack2bf(acc[m][n][0], acc[m][n][1]); o.y = pack2bf(acc[m][n][2], acc[m][n][3]); *(u32x2*)(ldsw + (m * 16 + fr) * PITCH + n * 32 + fq * 8) = o; }
  WAVE_SYNC();
  constexpr int RPP = 64 / CPR;
#pragma unroll
  for (int ps = 0; ps < 64 / RPP; ++ps) {
    const int r = ps * RPP + lane / CPR, c = lane % CPR;
    const u32x4 v = *(const u32x4*)(ldsw + r * PITCH + c * 16);
    if (row_ok(r)) *(u32x4*)(C + (size_t)r * ldc + c * 8) = v;
  }
  WAVE_SYNC();
}
template <int NOSTORE = 0>
DI void gemm_plain_tile(const bf16_t* A, int lda, const bf16_t* Bt, int ldb, int K, bf16_t* C, int ldc, int tm, int tn, char* lds) {
  const int t = TIDX, lane = t & 63, wid = t >> 6, wr = wid >> 1, wc = wid & 1, lr = t >> 3, lc = (t & 7) * 8, fr = lane & 15, fq = lane >> 4;
  const bf16_t* ap[4]; const bf16_t* bp[4];
#pragma unroll
  for (int i = 0; i < 4; ++i) { ap[i] = A + (size_t)(tm * 128 + lr + 32 * i) * lda + lc; bp[i] = Bt + (size_t)(tn * 128 + lr + 32 * i) * ldb + lc; }
  f32x4 acc[4][4]; acc_zero<4>(acc);
  gemm_kloop<4, NOSTORE == 2>(acc, ap, bp, K / 64, lds);
  if (NOSTORE) { float s = 0.f;
#pragma unroll
    for (int m = 0; m < 4; ++m)
#pragma unroll
      for (int n = 0; n < 4; ++n) s += acc[m][n][0] + acc[m][n][3];
    if (s == 123456.789f) C[0] = 1; return; }
  store_wave_tile<4>(acc, C + (size_t)(tm * 128 + wr * 64) * ldc + tn * 128 + wc * 64, (size_t)ldc, lds + wid * (64 * 144), lane, [](int) { return true; });
  __syncthreads();
}
template <int NOSTORE = 0>
DI void ph_gemm_plain(const bf16_t* A, int lda, const bf16_t* Bt, int ldb, int M, int N, int K, bf16_t* C, int ldc, char* lds, int bid, int nblk) {
  const int ntn = N / 128, nt = (M / 128) * ntn;
  for (int u = bid; u < nt; u += nblk) { int tm, tn; grp_tile<8>(xcd_swz(u, nt), M / 128, ntn, tm, tn); gemm_plain_tile<NOSTORE>(A, lda, Bt, ldb, K, C, ldc, tm, tn, lds); }
}
DI void ph_mla_up(const Params& p, int layer, bf16_t* QRAW, bf16_t* KVRAW, char* lds, int bid, int nblk) {
  const int ntq = (R / 128) * 3, ntkv = (R / 128) * 4;
  for (int tile = bid; tile < ntq + ntkv; tile += nblk) {
    if (tile < ntq) gemm_plain_tile(p.Z + ZC_QLAT, NZP, p.Wt_uq + layer * WSZ_UQ, 256, 256, QRAW, 384, tile / 3, tile % 3, lds);
    else { int u = tile - ntq; gemm_plain_tile(p.Z + ZC_KVLAT, NZP, p.Wt_ukv + layer * WSZ_UKV, 128, 128, KVRAW, 512, u / 4, u % 4, lds); }
  }
}
constexpr int LROW32 = 80;
template <int WM, int WN, bool DEEP>
DI void gemm_kloop_g(f32x4 (&acc)[WM][WN], const bf16_t* const (&ap)[WM / 2], const bf16_t* const (&bp)[WN / 2], int nk, char* lds) {
  constexpr int NA = WM / 2, NBB = WN / 2, A_B = 32 * WM * LROW32, STAGE = (32 * WM + 32 * WN) * LROW32;
  const int t = TIDX, lane = t & 63, wid = t >> 6, wr = wid >> 1, wc = wid & 1, fr = lane & 15, fq = lane >> 4;
  const int aoff = (wr * 16 * WM + fr) * LROW32 + fq * 16, boff = A_B + (wc * 16 * WN + fr) * LROW32 + fq * 16, soff = (t >> 2) * LROW32 + (t & 3) * 16;
  u32x4 ra0[NA], rb0[NBB], ra1[NA], rb1[NBB];
  auto gload = [&](u32x4 (&ra)[NA], u32x4 (&rb)[NBB], int kt) {
#pragma unroll
    for (int i = 0; i < NA; ++i) ra[i] = ldg16(ap[i] + kt * 32);
#pragma unroll
    for (int i = 0; i < NBB; ++i) rb[i] = ldg16(bp[i] + kt * 32);
  };
  auto sstore = [&](const u32x4 (&ra)[NA], const u32x4 (&rb)[NBB], char* st) {
#pragma unroll
    for (int i = 0; i < NA; ++i) sts16(st + soff + 64 * i * LROW32, ra[i]);
#pragma unroll
    for (int i = 0; i < NBB; ++i) sts16(st + A_B + soff + 64 * i * LROW32, rb[i]);
  };
  auto compute = [&](const char* cur) {
    bf16x8 af[WM];
#pragma unroll
    for (int m = 0; m < WM; ++m) af[m] = lds_frag(cur + aoff + m * 16 * LROW32);
#pragma unroll
    for (int n = 0; n < WN; ++n) {
      const bf16x8 bfr = lds_frag(cur + boff + n * 16 * LROW32);
#pragma unroll
      for (int m = 0; m < WM; ++m) acc[m][n] = MFMA16(bfr, af[m], acc[m][n]);
    }
    IGLP_OPT();
  };
  gload(ra0, rb0, 0);
  if (DEEP) gload(ra1, rb1, 1);
  sstore(ra0, rb0, lds);
  __syncthreads();
#pragma unroll 1
  for (int kt = 0; kt < nk; kt += 2) {
    if (DEEP) { if (kt + 2 < nk) gload(ra0, rb0, kt + 2); } else gload(ra1, rb1, kt + 1);
    compute(lds);
    sstore(ra1, rb1, lds + STAGE);
    __syncthreads();
    if (DEEP) { if (kt + 3 < nk) gload(ra1, rb1, kt + 3); } else if (kt + 2 < nk) gload(ra0, rb0, kt + 2);
    compute(lds + STAGE);
    if (kt + 2 < nk) sstore(ra0, rb0, lds);
    __syncthreads();
  }
}
template <int WM, int WN> DI void acc_zero_g(f32x4 (&acc)[WM][WN]) {
#pragma unroll
  for (int m = 0; m < WM; ++m)
#pragma unroll
    for (int n = 0; n < WN; ++n) acc[m][n] = (f32x4){0.f, 0.f, 0.f, 0.f};
}
DI void ph_merge(const Params& p, int layer, int rows, char* lds, int bid, int nblk) {
  const int t = TIDX, lane = t & 63, wid = t >> 6, wr = wid >> 1, wc = wid & 1, fr = lane & 15, fq = lane >> 4;
  const int lr = t >> 2, lc = (t & 3) * 8;
  const int ntn = D / 64, nt = (rows / 128) * ntn;
#pragma unroll 1
  for (int u = bid; u < nt; u += nblk) {
    int tm, tn; grp_tile<4>(xcd_swz(u, nt), rows / 128, ntn, tm, tn);
    f32x4 accS[4][2]; acc_zero_g<4, 2>(accS);
#pragma unroll 1
    for (int np = 0; np < 2; ++np) {
      f32x4 accG[4][4]; acc_zero_g<4, 4>(accG);
      {
        const bf16_t* ap[2]; const bf16_t* bp[2];
#pragma unroll
        for (int i = 0; i < 2; ++i) ap[i] = p.H + (size_t)(tm * 128 + lr + 64 * i) * D + lc;
#pragma unroll
        for (int i = 0; i < 2; ++i) { const int rho = lr + 64 * i, wci = rho >> 6, n = 2 * np + ((rho >> 5) & 1), c = rho & 31;
          bp[i] = p.Wt_gate + layer * WSZ_GATE + ((size_t)n * 1024 + tn * 64 + wci * 32 + c) * D + lc; }
        gemm_kloop_g<4, 4, true>(accG, ap, bp, D / 32, lds);
      }
#pragma unroll 1
      for (int q = 0; q < 2; ++q) {
        const int n = 2 * np + q;
        f32x4 accP[4][2]; acc_zero_g<4, 2>(accP);
        const bf16_t* ap[2]; const bf16_t* bp[1];
#pragma unroll
        for (int i = 0; i < 2; ++i) ap[i] = p.Y + (size_t)(tm * 128 + lr + 64 * i) * D + n * 256 + lc;
        bp[0] = p.Wt_branch + layer * WSZ_BR + ((size_t)n * D + tn * 64 + lr) * 256 + lc;
        gemm_kloop_g<4, 2, false>(accP, ap, bp, 8, lds);
#pragma unroll
        for (int nn = 0; nn < 2; ++nn) {
          const f32x4 bv = *(const f32x4*)(p.b_gate + layer * 4096 + n * 1024 + tn * 64 + wc * 32 + nn * 16 + 4 * fq);
#pragma unroll
          for (int m = 0; m < 4; ++m)
#pragma unroll
            for (int j = 0; j < 4; ++j) { const float g = q ? accG[m][2 + nn][j] : accG[m][nn][j]; accS[m][nn][j] += accP[m][nn][j] * fast_rcp(1.0f + fast_exp2(-LOG2E * (g + bv[j]))); }
        }
      }
    }
    store_wave_tile<2>(accS, p.MG + (size_t)(tm * 128 + wr * 64) * D + tn * 64 + wc * 32, (size_t)D, lds + wid * (64 * 80), lane, [](int) { return true; });
    __syncthreads();
  }
}
template <int WM>
DI void gemm_plain_tile_g(const bf16_t* A, int lda, const bf16_t* Bt, int ldb, int K, bf16_t* C, int ldc, int row0, int col0, char* lds) {
  const int t = TIDX, lane = t & 63, wid = t >> 6, wr = wid >> 1, wc = wid & 1, fr = lane & 15, fq = lane >> 4, lr = t >> 2, lc = (t & 3) * 8;
  const bf16_t* ap[WM / 2]; const bf16_t* bp[2];
#pragma unroll
  for (int i = 0; i < WM / 2; ++i) ap[i] = A + (size_t)(row0 + lr + 64 * i) * lda + lc;
#pragma unroll
  for (int i = 0; i < 2; ++i) bp[i] = Bt + (size_t)(col0 + lr + 64 * i) * ldb + lc;
  f32x4 acc[WM][4]; acc_zero_g<WM, 4>(acc);
  gemm_kloop_g<WM, 4, true>(acc, ap, bp, K / 32, lds);
#pragma unroll
  for (int m = 0; m < WM; ++m)
#pragma unroll
    for (int n = 0; n < 4; ++n)
      st_bf16x4(C + (size_t)(row0 + wr * 16 * WM + m * 16 + fr) * ldc + col0 + wc * 64 + n * 16 + 4 * fq, acc[m][n]);
}
DI void ph_gemm_plain2(const bf16_t* A, int lda, const bf16_t* Bt, int ldb, int M, int N, int K, bf16_t* C, int ldc, char* lds, int bid, int nblk) {
  const int ntn = N / 128, nt = (M / 256) * ntn, nfull = (nt / nblk) * nblk;
#pragma unroll 1
  for (int tile = bid; tile < nfull; tile += nblk) gemm_plain_tile_g<8>(A, lda, Bt, ldb, K, C, ldc, (tile / ntn) * 256, (tile % ntn) * 128, lds);
#pragma unroll 1
  for (int h = bid; h < 2 * (nt - nfull); h += nblk) { const int tile = nfull + (h >> 1); gemm_plain_tile_g<4>(A, lda, Bt, ldb, K, C, ldc, (tile / ntn) * 256 + (h & 1) * 128, (tile % ntn) * 128, lds); }
}
DI void gemm_kloop32(f32x16 (&acc)[2][2], const bf16_t* const (&ap)[4], const bf16_t* const (&bp)[4], int nk, char* lds) {
  constexpr int STAGE = A_BYTES + 128 * LROW;
  const int t = TIDX, lane = t & 63, wid = t >> 6, wr = wid >> 1, wc = wid & 1, l31 = lane & 31, hh = lane >> 5;
  const int aoff = (wr * 64 + l31) * LROW + hh * 16, boff = A_BYTES + (wc * 64 + l31) * LROW + hh * 16, soff = (t >> 3) * LROW + (t & 7) * 16;
  u32x4 ra0[4], rb0[4], ra1[4], rb1[4];
  auto gload = [&](u32x4 (&ra)[4], u32x4 (&rb)[4], int kt) {
#pragma unroll
    for (int i = 0; i < 4; ++i) { ra[i] = ldg16(ap[i] + kt * 64); rb[i] = ldg16(bp[i] + kt * 64); }
  };
  auto sstore = [&](const u32x4 (&ra)[4], const u32x4 (&rb)[4], char* st) {
#pragma unroll
    for (int i = 0; i < 4; ++i) { sts16(st + soff + 32 * i * LROW, ra[i]); sts16(st + A_BYTES + soff + 32 * i * LROW, rb[i]); }
  };
  auto compute = [&](const char* cur) {
#pragma unroll
    for (int ks = 0; ks < 4; ++ks) {
      bf16x8 af[2], bfr[2];
#pragma unroll
      for (int m = 0; m < 2; ++m) af[m] = lds_frag(cur + aoff + m * 32 * LROW + ks * 32);
#pragma unroll
      for (int n = 0; n < 2; ++n) bfr[n] = lds_frag(cur + boff + n * 32 * LROW + ks * 32);
#pragma unroll
      for (int m = 0; m < 2; ++m)
#pragma unroll
        for (int n = 0; n < 2; ++n) acc[m][n] = MFMA32(bfr[n], af[m], acc[m][n]);
    }
  };
  gload(ra0, rb0, 0); gload(ra1, rb1, 1);
  sstore(ra0, rb0, lds);
  __syncthreads();
#pragma unroll 1
  for (int kt = 0; kt < nk; kt += 2) {
    if (kt + 2 < nk) gload(ra0, rb0, kt + 2);
    compute(lds);
    sstore(ra1, rb1, lds + STAGE);
    __syncthreads();
    if (kt + 3 < nk) gload(ra1, rb1, kt + 3);
    compute(lds + STAGE);
    if (kt + 2 < nk) sstore(ra0, rb0, lds);
    __syncthreads();
  }
}
DI void ph_gemm_plain32(const bf16_t* A, int lda, const bf16_t* Bt, int ldb, int M, int N, int K, bf16_t* C, int ldc, char* lds, int bid, int nblk) {
  const int t = TIDX, lane = t & 63, wid = t >> 6, wr = wid >> 1, wc = wid & 1, lr = t >> 3, lc = (t & 7) * 8, l31 = lane & 31, hh = lane >> 5;
  const int ntn = N / 128, nt = (M / 128) * ntn;
#pragma unroll 1
  for (int tile = bid; tile < nt; tile += nblk) {
    const int tm = tile / ntn, tn = tile % ntn;
    const bf16_t* ap[4]; const bf16_t* bp[4];
#pragma unroll
    for (int i = 0; i < 4; ++i) { ap[i] = A + (size_t)(tm * 128 + lr + 32 * i) * lda + lc; bp[i] = Bt + (size_t)(tn * 128 + lr + 32 * i) * ldb + lc; }
    f32x16 acc[2][2];
#pragma unroll
    for (int m = 0; m < 2; ++m)
#pragma unroll
      for (int n = 0; n < 2; ++n) acc[m][n] = (f32x16)(0.f);
    gemm_kloop32(acc, ap, bp, K / 64, lds);
#pragma unroll
    for (int m = 0; m < 2; ++m)
#pragma unroll
      for (int n = 0; n < 2; ++n)
#pragma unroll
        for (int g = 0; g < 4; ++g) {
          f32x4 o = {acc[m][n][4 * g], acc[m][n][4 * g + 1], acc[m][n][4 * g + 2], acc[m][n][4 * g + 3]};
          st_bf16x4(C + (size_t)(tm * 128 + wr * 64 + m * 32 + l31) * ldc + tn * 128 + wc * 64 + n * 32 + 8 * g + 4 * hh, o);
        }
  }
}
template <int MODE>
DI void ph_gemm_probe(const bf16_t* A, int lda, const bf16_t* Bt, int ldb, int M, int N, int K, float* sink, char* lds, int bid, int nblk) {
  const int t = TIDX, lane = t & 63, wid = t >> 6, wr = wid >> 1, wc = wid & 1, lr = t >> 3, lc = (t & 7) * 8, fr = lane & 15, fq = lane >> 4;
  const int ntn = N / 128, nt = (M / 128) * ntn, nk = K / 64;
  constexpr int STAGE = A_BYTES + 128 * LROW;
  const int aoff = (wr * 64 + fr) * LROW + fq * 16, boff = A_BYTES + (wc * 64 + fr) * LROW + fq * 16;
#pragma unroll 1
  for (int tile = bid; tile < nt; tile += nblk) {
    f32x4 acc[4][4]; acc_zero<4>(acc);
    bf16x8 af[4], bfr[4];
    const int tm = tile / ntn, tn = tile % ntn;
    const bf16_t* ap[4]; const bf16_t* bp[4];
#pragma unroll
    for (int i = 0; i < 4; ++i) { ap[i] = A + (size_t)(tm * 128 + lr + 32 * i) * lda + lc; bp[i] = Bt + (size_t)(tn * 128 + lr + 32 * i) * ldb + lc; }
    u32x4 ra[4], rb[4], junk = {0u, 0u, 0u, 0u};
#pragma unroll
    for (int i = 0; i < 4; ++i) { ra[i] = junk; rb[i] = junk; }
#pragma unroll 1
    for (int kt = 0; kt < nk; ++kt) {
      const char* cur = lds + (kt & 1) * STAGE;
#pragma unroll
      for (int i = 0; i < 4; ++i) { ra[i] = ldg16(ap[i] + kt * 64); if (MODE == 3) rb[i] = ldg16(bp[i] + kt * 64); }
#pragma unroll
      for (int ks = 0; ks < 2; ++ks) {
#pragma unroll
        for (int m = 0; m < 4; ++m) { af[m] = lds_frag(cur + aoff + m * 16 * LROW + ks * 64); bfr[m] = lds_frag(cur + boff + m * 16 * LROW + ks * 64); }
#pragma unroll
        for (int m = 0; m < 4; ++m)
#pragma unroll
          for (int n = 0; n < 4; ++n) acc[m][n] = MFMA16(bfr[n], af[m], acc[m][n]);
      }
      junk.x ^= ra[0].x ^ ra[1].y ^ ra[2].z ^ ra[3].w ^ rb[0].x ^ rb[1].y ^ rb[2].z ^ rb[3].w;
      __syncthreads();
    }
    float s = (float)(junk.x & 1u);
#pragma unroll
    for (int m = 0; m < 4; ++m)
#pragma unroll
      for (int n = 0; n < 4; ++n) s += acc[m][n][0] + acc[m][n][3];
    if (s == 123456.789f) sink[0] = s;
  }
}
DI void ph_moe1(const Params& p, int need_ctx, char* lds, int bid, int nblk) {
  const int t = TIDX, lane = t & 63, wid = t >> 6, wr = wid >> 1, wc = wid & 1, lr = t >> 3, lc = (t & 7) * 8, fr = lane & 15, fq = lane >> 4;
  constexpr int NTN = FF / 64;
  const int NTM = need_ctx ? (NSLOT + 127) / 128 : (NB * CAPL) / 128;
  for (int u = bid; u < NE * NTM * NTN; u += nblk) {
    const int tile = xcd_swz(u, NE * NTM * NTN), e = tile / (NTM * NTN), rem = tile % (NTM * NTN);
    int tm, tn, rr = rem, g = 0;
    if (rr >= NTM * 8) { rr -= NTM * 8; g = 1; }
    if (rr >= NTM * 8) { rr -= NTM * 8; g = 2; }
    if (g < 2) { tm = rr >> 3; tn = g * 8 + (rr & 7); } else { tm = rr / (NTN - 16); tn = 16 + rr - tm * (NTN - 16); }
    const bf16_t* ap[4]; const bf16_t* bp[4];
#pragma unroll
    for (int i = 0; i < 4; ++i) {
      const int slot = tm * 128 + lr + 32 * i;
      int r = slot < NSLOT ? p.SEL[(size_t)e * NSLOT + slot] : -1;
      ap[i] = p.H + (size_t)(r < 0 ? 0 : r) * D + lc;
      const int rho = lr + 32 * i, wci = rho >> 6, gu = (rho >> 5) & 1, col = wci * 32 + (rho & 31);
      bp[i] = (gu ? p.Wt_eu : p.Wt_eg) + ((size_t)e * FF + tn * 64 + col) * D + lc;
    }
    f32x4 acc[4][4]; acc_zero<4>(acc);
    gemm_kloop<4>(acc, ap, bp, D / 64, lds);
    f32x4 hid[4][2];
#pragma unroll
    for (int m = 0; m < 4; ++m) {
      const int slot = tm * 128 + wr * 64 + m * 16 + fr;
      const bool valid = slot < NSLOT && p.SEL[(size_t)e * NSLOT + (slot < NSLOT ? slot : 0)] >= 0;
#pragma unroll
      for (int n = 0; n < 2; ++n)
#pragma unroll
        for (int j = 0; j < 4; ++j) { const float g = acc[m][n][j], u = acc[m][n + 2][j]; hid[m][n][j] = valid ? g * u * fast_rcp(1.0f + fast_exp2(-LOG2E * g)) : 0.f; }
    }
    const int slot0 = tm * 128 + wr * 64;
    store_wave_tile<2>(hid, p.HID + ((size_t)e * NSLOT + slot0) * FF + tn * 64 + wc * 32, (size_t)FF, lds + wid * (64 * 80), lane, [&](int r) { return slot0 + r < NSLOT; });
    __syncthreads();
  }
}
DI void ph_moe2(const Params& p, int need_ctx, char* lds, int bid, int nblk) {
  const int t = TIDX, lane = t & 63, wid = t >> 6, wr = wid >> 1, wc = wid & 1, lr = t >> 3, lc = (t & 7) * 8, fr = lane & 15, fq = lane >> 4;
  constexpr int NTN = D / 128;
  const int NTM = need_ctx ? (NSLOT + 127) / 128 : (NB * CAPL) / 128;
  for (int u = bid; u < NE * NTM * NTN; u += nblk) {
    const int tile = xcd_swz(u, NE * NTM * NTN), e = tile / (NTM * NTN), rem = tile % (NTM * NTN), tm = rem / NTN, tn = rem % NTN;
    const bf16_t* ap[4]; const bf16_t* bp[4];
#pragma unroll
    for (int i = 0; i < 4; ++i) {
      int slot = tm * 128 + lr + 32 * i; if (slot >= NSLOT) slot = NSLOT - 1;
      ap[i] = p.HID + ((size_t)e * NSLOT + slot) * FF + lc;
      bp[i] = p.Wt_ed + ((size_t)e * D + tn * 128 + lr + 32 * i) * FF + lc;
    }
    f32x4 acc[4][4]; acc_zero<4>(acc);
    gemm_kloop<4>(acc, ap, bp, FF / 64, lds);
#pragma unroll
    for (int m = 0; m < 4; ++m) {
      const int slot = tm * 128 + wr * 64 + m * 16 + fr;
      const float val = (slot < NSLOT && p.SEL[(size_t)e * NSLOT + (slot < NSLOT ? slot : 0)] >= 0) ? p.SELV[(size_t)e * NSLOT + slot] : 0.f;
#pragma unroll
      for (int n = 0; n < 4; ++n) { acc[m][n].x *= val; acc[m][n].y *= val; acc[m][n].z *= val; acc[m][n].w *= val; }
    }
    const int slot0 = tm * 128 + wr * 64;
    store_wave_tile<4>(acc, p.YE + ((size_t)e * NSLOT + slot0) * D + tn * 128 + wc * 64, (size_t)D, lds + wid * (64 * 144), lane, [&](int r) { return slot0 + r < NSLOT; });
    __syncthreads();
  }
}
constexpr int GEMM_LDS = 2 * (A_BYTES + 128 * LROW);

DI void unpack8(u32x4 v, float (&f)[8]) {
  f[0] = u2f(v.x << 16); f[1] = u2f(v.x & 0xffff0000u); f[2] = u2f(v.y << 16); f[3] = u2f(v.y & 0xffff0000u);
  f[4] = u2f(v.z << 16); f[5] = u2f(v.z & 0xffff0000u); f[6] = u2f(v.w << 16); f[7] = u2f(v.w & 0xffff0000u);
}
DI u32x4 pack8f(const float (&f)[8]) { u32x4 v; v.x = pack2bf(f[0], f[1]); v.y = pack2bf(f[2], f[3]); v.z = pack2bf(f[4], f[5]); v.w = pack2bf(f[6], f[7]); return v; }
DI void rope8(float (&a)[8], const float (&pr)[8], int cc, const float* cs, const float* sn) {
  const int ax = (cc >> 1) * 8; const bool second = cc & 1;
#pragma unroll
  for (int i = 0; i < 8; ++i) a[i] = second ? a[i] * cs[ax + i] + pr[i] * sn[ax + i] : a[i] * cs[ax + i] - pr[i] * sn[ax + i];
}
constexpr int PREP_LDS = 64 * 4 + 2 * 512 * 4 + 32 * 528;
template <int PARTS = 3>
DI void ph_prep(const Params& p, int layer, const bf16_t* QRAW, const bf16_t* KVRAW, char* lds, int bid, int nblk) {
  float* s_rstd = (float*)lds;
  float* s_cs = s_rstd + 64;
  float* s_sn = s_cs + 512;
  bf16_t* s_t = (bf16_t*)(s_sn + 512);
  const int t = TIDX;
  constexpr int UPB = TK / 32, NU = NB * UPB;
  const float* wcv = p.w_conv + (size_t)layer * 3 * 512;
#pragma unroll 1
  for (int u = bid; u < NU; u += nblk) {
    int b, s0;
    if (u < NB * (TL / 32)) { b = u / (TL / 32); s0 = TC + (u % (TL / 32)) * 32; } else { const int v = u - NB * (TL / 32); b = v / (TC / 32); s0 = (v % (TC / 32)) * 32; }
    const int r0 = row_of(b, s0);
    {
      const int tok = t >> 3, part = t & 7;
      const bf16_t* z = p.Z + (size_t)(r0 + tok) * NZP;
      float sq = 0.f, sk = 0.f, f[8];
#pragma unroll
      for (int k = 0; k < 4; ++k) { unpack8(ldg16(z + ZC_QLAT + part * 32 + k * 8), f);
#pragma unroll
        for (int i = 0; i < 8; ++i) sq += f[i] * f[i]; }
#pragma unroll
      for (int k = 0; k < 2; ++k) { unpack8(ldg16(z + ZC_KVLAT + part * 16 + k * 8), f);
#pragma unroll
        for (int i = 0; i < 8; ++i) sk += f[i] * f[i]; }
      sq = xor_sum<1>(sq); sk = xor_sum<1>(sk);
      sq = xor_sum<2>(sq); sk = xor_sum<2>(sk);
      sq = xor_sum<4>(sq); sk = xor_sum<4>(sk);
      if (part == 0) { s_rstd[tok * 2] = 1.0f / sqrtf(sq * (1.0f / 256) + 1e-6f); s_rstd[tok * 2 + 1] = 1.0f / sqrtf(sk * (1.0f / 128) + 1e-6f); }
    }
    for (int i = t; i < 512; i += NTHR) {
      const int tok = i >> 4, af = i & 15, s = s0 + tok;
      float cs = 1.f, sn = 0.f;
      if (s >= TC) rope_cs(s, (af >> 3) * 16 + (af & 7), cs, sn);
      s_cs[i] = cs; s_sn[i] = sn;
    }
    __syncthreads();
    if (PARTS & 1) {
#pragma unroll 2
    for (int i = t; i < 32 * 48; i += NTHR) {
      const int tok = i / 48, c = i % 48, h = c / 12, ch = c % 12;
      const float rq = s_rstd[tok * 2] * QS_MLA, rkv = s_rstd[tok * 2 + 1];
      const bf16_t* q = QRAW + (size_t)(r0 + tok) * 384 + h * 96;
      float a[8], pr[8];
      unpack8(ldg16(q + ch * 8), a);
      if (ch >= 8) { unpack8(ldg16(q + 64 + ((ch - 8) ^ 1) * 8), pr); rope8(a, pr, ch - 8, s_cs + tok * 16, s_sn + tok * 16); }
#pragma unroll
      for (int e = 0; e < 8; ++e) a[e] *= rq;
      *(u32x4*)(p.Qm + (((size_t)b * 4 + h) * TK + s0 + tok) * 96 + ch * 8) = pack8f(a);
      if (ch < 8) {
        unpack8(ldg16(KVRAW + (size_t)(r0 + tok) * 512 + h * 128 + ch * 8), a);
#pragma unroll
        for (int e = 0; e < 8; ++e) a[e] *= rkv;
      } else {
        const bf16_t* z = p.Z + (size_t)(r0 + tok) * NZP + ZC_KROPE;
        unpack8(ldg16(z + (ch - 8) * 8), a); unpack8(ldg16(z + ((ch - 8) ^ 1) * 8), pr);
        rope8(a, pr, ch - 8, s_cs + tok * 16, s_sn + tok * 16);
      }
      *(u32x4*)(p.Km + (((size_t)b * 4 + h) * TK + s0 + tok) * 96 + ch * 8) = pack8f(a);
    }
#pragma unroll 2
    for (int i = t; i < 32 * 64; i += NTHR) {
      const int tok = i >> 6, c = i & 63, qk = c >> 5, hm = (c >> 2) & 7, cc = c & 3;
      const bf16_t* src = p.Z + (size_t)(r0 + tok) * NZP + (qk ? ZC_DK : ZC_DQ) + hm * 32;
      float a[8], pr[8];
      unpack8(ldg16(src + cc * 8), a); unpack8(ldg16(src + (cc ^ 1) * 8), pr);
      rope8(a, pr, cc, s_cs + tok * 16, s_sn + tok * 16);
      if (qk == 0) {
#pragma unroll
        for (int e = 0; e < 8; ++e) a[e] *= QS_DIFF;
        *(u32x4*)(p.Qd + (((size_t)b * 8 + hm) * TK + s0 + tok) * 32 + cc * 8) = pack8f(a);
      } else *(u32x4*)(p.Kd + (((size_t)b * 8 + hm) * TK + s0 + tok) * 32 + cc * 8) = pack8f(a);
    }
#pragma unroll 2
    for (int i = t; i < 32 * 64; i += NTHR) {
      const int tok = i >> 6, c8 = (i & 63) * 8, s = s0 + tok;
      const bool first = (s == 0) || (s == TC), last = (s == TC - 1) || (s == TK - 1);
      const bf16_t* z = p.Z + (size_t)(r0 + tok) * NZP + ZC_MLQK + c8;
      float x0[8], xm[8], xp[8], o[8];
      unpack8(ldg16(z), x0);
      if (!first) unpack8(ldg16(z - NZP), xm);
      if (!last) unpack8(ldg16(z + NZP), xp);
      float bc8[8], w0[8], w1[8], w2[8];
      *(f32x4*)bc8 = *(const f32x4*)(p.b_conv + layer * 512 + c8); *(f32x4*)(bc8 + 4) = *(const f32x4*)(p.b_conv + layer * 512 + c8 + 4);
      *(f32x4*)w0 = *(const f32x4*)(wcv + c8); *(f32x4*)(w0 + 4) = *(const f32x4*)(wcv + c8 + 4);
      *(f32x4*)w1 = *(const f32x4*)(wcv + 512 + c8); *(f32x4*)(w1 + 4) = *(const f32x4*)(wcv + 512 + c8 + 4);
      *(f32x4*)w2 = *(const f32x4*)(wcv + 1024 + c8); *(f32x4*)(w2 + 4) = *(const f32x4*)(wcv + 1024 + c8 + 4);
#pragma unroll
      for (int e = 0; e < 8; ++e) {
        float acc = bc8[e] + x0[e] * w1[e];
        if (!first) acc += xm[e] * w0[e];
        if (!last) acc += xp[e] * w2[e];
        o[e] = acc * fast_rcp(1.0f + fast_exp2(-LOG2E * acc));
      }
      if (c8 < 256) *(u32x4*)(p.MQ + ((size_t)b * TK + s) * 256 + c8) = pack8f(o);
      else {
#pragma unroll
        for (int e = 0; e < 8; ++e) o[e] *= 0.125f;
        *(u32x4*)(p.MK + ((size_t)b * TK + s) * 256 + c8 - 256) = pack8f(o);
      }
    }
    }
#pragma unroll 1
    for (int w = 0; w < ((PARTS & 2) ? 4 : 0); ++w) {
      __syncthreads();
#pragma unroll
      for (int k = 0; k < 4; ++k) {
        const int i = t + k * NTHR, tok = i >> 5, c8 = (i & 31) * 8;
        u32x4 v;
        if (w == 0) { float a[8]; const int h = c8 >> 6; unpack8(ldg16(KVRAW + (size_t)(r0 + tok) * 512 + h * 128 + 64 + (c8 & 63)), a); const float rkv = s_rstd[tok * 2 + 1];
#pragma unroll
          for (int e = 0; e < 8; ++e) a[e] *= rkv;
          v = pack8f(a); }
        else v = ldg16(p.Z + (size_t)(r0 + tok) * NZP + (w == 1 ? ZC_DV : (w == 2 ? ZC_MLV : ZC_GV)) + c8);
        *(u32x4*)(s_t + tok * 264 + c8) = v;
      }
      __syncthreads();
      bf16_t* dst = w == 0 ? p.Vtm : (w == 1 ? p.Vtd : (w == 2 ? p.MVt : p.GVt));
#pragma unroll
      for (int k = 0; k < 4; ++k) {
        const int i = t + k * NTHR, tg = i & 3, ch = i >> 2;
        u32x4 v;
        v.x = (unsigned)s_t[(tg * 8 + 0) * 264 + ch] | ((unsigned)s_t[(tg * 8 + 1) * 264 + ch] << 16);
        v.y = (unsigned)s_t[(tg * 8 + 2) * 264 + ch] | ((unsigned)s_t[(tg * 8 + 3) * 264 + ch] << 16);
        v.z = (unsigned)s_t[(tg * 8 + 4) * 264 + ch] | ((unsigned)s_t[(tg * 8 + 5) * 264 + ch] << 16);
        v.w = (unsigned)s_t[(tg * 8 + 6) * 264 + ch] | ((unsigned)s_t[(tg * 8 + 7) * 264 + ch] << 16);
        *(u32x4*)(dst + (((size_t)b * 4 + (ch >> 6)) * 64 + (ch & 63)) * TK + s0 + tg * 8) = v;
      }
    }
    __syncthreads();
  }
}
constexpr int VROW = 136;
constexpr int VROW_A = 144;
template <int DQK> struct AttnCfg {
  static constexpr int KROW = DQK * 2 + 16;
  static constexpr int KBYTES = 64 * KROW, VBYTES = 64 * VROW_A, STAGE = KBYTES + VBYTES;
  static constexpr int KCH = 64 * DQK * 2 / 16 / NTHR;
};
DI bf16x8 pack8(const f32x16& x, int s) {
  u32x4 pk; pk.x = pack2bf(x[8 * s], x[8 * s + 1]); pk.y = pack2bf(x[8 * s + 2], x[8 * s + 3]); pk.z = pack2bf(x[8 * s + 4], x[8 * s + 5]); pk.w = pack2bf(x[8 * s + 6], x[8 * s + 7]);
  return __builtin_bit_cast(bf16x8, pk);
}
struct TrueC { static constexpr bool value = true; };
struct FalseC { static constexpr bool value = false; };
template <int DQK, int NMAP, int VAR = 0>
DI void attn_unit(const bf16_t* __restrict__ Qb, const bf16_t* __restrict__ Kb, size_t mstride, const bf16_t* __restrict__ Vt, int q0, int nkeys,
                  f32x16 (&O)[NMAP][2], float (&lsum)[NMAP], char* lds) {
  constexpr int DM = DQK / NMAP;
  constexpr int KS = DM / 16;
  using C = AttnCfg<DQK>;
  constexpr int CPM = 64 * DM * 2 / 16;
  constexpr int CPR = DM * 2 / 16;
  const int t = TIDX, lane = t & 63, wid = t >> 6, l31 = lane & 31, hh = lane >> 5;
  bf16x8 qf[NMAP][KS];
#pragma unroll
  for (int m = 0; m < NMAP; ++m)
#pragma unroll
    for (int ks = 0; ks < KS; ++ks) qf[m][ks] = *(const bf16x8*)(Qb + m * mstride + (size_t)(q0 + wid * 32 + l31) * DM + ks * 16 + 8 * hh);
  float mref[NMAP];
  f32x4 lacc[NMAP];
  const short onev = ((lane & 15) < 2 && ((lane >> 4) & 1) == (lane & 15)) ? (short)0x3F80 : (short)0;
  const bf16x8 ones_a = {onev, onev, onev, onev, onev, onev, onev, onev};
#pragma unroll
  for (int m = 0; m < NMAP; ++m) { mref[m] = 0.f; lacc[m] = (f32x4){0.f, 0.f, 0.f, 0.f}; O[m][0] = (f32x16)(0.f); O[m][1] = (f32x16)(0.f); }
  u32x4 rk[C::KCH], rv[2];
  const bf16_t* kg[C::KCH]; int klds[C::KCH];
#pragma unroll
  for (int i = 0; i < C::KCH; ++i) { const int c = t + i * NTHR, m = c / CPM, cc = c % CPM; kg[i] = Kb + m * mstride + cc * 8; klds[i] = (cc / CPR) * C::KROW + m * DM * 2 + (cc % CPR) * 16; }
  const bf16_t* vg = Vt + (size_t)(t >> 3) * TK + (t & 7) * 8;
  const int vlds = C::KBYTES + (t >> 3) * VROW_A + ((t & 7) >> 1) * 32 + ((t & 1) ? 8 : 0);
  const int kfoff = l31 * C::KROW + 16 * hh, vfoff = C::KBYTES + l31 * VROW_A + 16 * hh;
  const int nt = nkeys / 64;
#pragma unroll
  for (int i = 0; i < C::KCH; ++i) rk[i] = ldg16(kg[i]);
  rv[0] = ldg16(vg); rv[1] = ldg16(vg + (size_t)32 * TK);
  auto tile = [&](const int kt, auto chk_c, auto ref_c) __attribute__((always_inline)) {
    constexpr bool CHK = decltype(chk_c)::value, REF = decltype(ref_c)::value;
    char* cur = lds + (kt & 1) * C::STAGE;
    if (VAR != 2) {
#pragma unroll
    for (int i = 0; i < C::KCH; ++i) sts16(cur + klds[i], rk[i]);
#pragma unroll
    for (int i = 0; i < 2; ++i) { char* d = cur + vlds + i * 32 * VROW_A; u32x2 lo, hi; lo.x = rv[i].x; lo.y = rv[i].y; hi.x = rv[i].z; hi.y = rv[i].w; *(u32x2*)d = lo; *(u32x2*)(d + 16) = hi; }
    __syncthreads();
    }
    if (VAR != 2 && kt + 1 < nt) {
#pragma unroll
      for (int i = 0; i < C::KCH; ++i) rk[i] = ldg16(kg[i] + (size_t)(kt + 1) * 64 * DM);
      rv[0] = ldg16(vg + (kt + 1) * 64); rv[1] = ldg16(vg + (size_t)32 * TK + (kt + 1) * 64);
    }
    bf16x8 kf[NMAP][2][KS];
#pragma unroll
    for (int k2 = 0; k2 < 2; ++k2)
#pragma unroll
      for (int ks = 0; ks < KS; ++ks) kf[0][k2][ks] = lds_frag(cur + kfoff + k2 * 32 * C::KROW + ks * 32);
    f32x16 S[NMAP][2];
    S[0][0] = (f32x16)(0.f); S[0][1] = (f32x16)(0.f);
#pragma unroll
    for (int ks = 0; ks < KS; ++ks)
#pragma unroll
      for (int k2 = 0; k2 < 2; ++k2) S[0][k2] = MFMA32(kf[0][k2][ks], qf[0][ks], S[0][k2]);
    bf16x8 vf[4][2];
#pragma unroll
    for (int kst = 0; kst < 4; ++kst)
#pragma unroll
      for (int dvt = 0; dvt < 2; ++dvt) vf[kst][dvt] = lds_frag(cur + vfoff + dvt * 32 * VROW_A + kst * 32);
#pragma unroll
    for (int m = 1; m < NMAP; ++m)
#pragma unroll
      for (int k2 = 0; k2 < 2; ++k2)
#pragma unroll
        for (int ks = 0; ks < KS; ++ks) kf[m][k2][ks] = lds_frag(cur + kfoff + k2 * 32 * C::KROW + m * DM * 2 + ks * 32);
#pragma unroll
    for (int m = 0; m < NMAP; ++m) {
      if (m > 0) {
        SCHED_BARRIER();
        S[m][0] = (f32x16)(0.f); S[m][1] = (f32x16)(0.f);
#pragma unroll
        for (int ks = 0; ks < KS; ++ks)
#pragma unroll
          for (int k2 = 0; k2 < 2; ++k2) S[m][k2] = MFMA32(kf[m][k2][ks], qf[m][ks], S[m][k2]);
      }
      if (VAR != 1) {
      if (CHK && (kt & 7) == 0) {
        float mx = fmaxf(S[m][0][0], S[m][1][0]);
#pragma unroll
        for (int i = 1; i < 16; ++i) mx = fmaxf(mx, fmaxf(S[m][0][i], S[m][1][i]));
        mx = xor_max<32>(mx);
        const float rel = mx - mref[m];
        const float delta = (kt == 0) ? ((mx > ATT_THR || mx < -ATT_THR) ? mx : 0.0f) : (rel > ATT_THR ? rel : 0.0f);
        if (wave_any(delta != 0.0f)) {
          const float alpha = fast_exp2(-delta);
          mref[m] += delta; lacc[m][0] *= alpha; lacc[m][1] *= lane_get(alpha, (lane & 15) + 16);
#pragma unroll
          for (int dvt = 0; dvt < 2; ++dvt)
#pragma unroll
            for (int i = 0; i < 16; ++i) O[m][dvt][i] *= alpha;
        }
      }
      if constexpr (REF) {
        if (wave_any(mref[m] != 0.0f)) {
          const f32x2 nm = {-mref[m], -mref[m]};
#pragma unroll
          for (int k2 = 0; k2 < 2; ++k2)
#pragma unroll
            for (int i = 0; i < 16; i += 2) { const f32x2 x = (f32x2){S[m][k2][i], S[m][k2][i + 1]} + nm; S[m][k2][i] = x.x; S[m][k2][i + 1] = x.y; }
        }
      }
#pragma unroll
      for (int k2 = 0; k2 < 2; ++k2)
#pragma unroll
        for (int i = 0; i < 16; ++i) S[m][k2][i] = fast_exp2(S[m][k2][i]);
      }
#pragma unroll
      for (int kst = 0; kst < 4; ++kst) {
        const bf16x8 pf = pack8(S[m][kst >> 1], kst & 1);
#pragma unroll
        for (int dvt = 0; dvt < 2; ++dvt) O[m][dvt] = MFMA32(vf[kst][dvt], pf, O[m][dvt]);
        lacc[m] = MFMA16(ones_a, pf, lacc[m]);
      }
    }
  };
  int kt = 0;
#pragma unroll 1
  while (kt < nt) {
    tile(kt, TrueC{}, TrueC{});
    ++kt;
    bool nz = false;
#pragma unroll
    for (int m = 0; m < NMAP; ++m) nz = nz || (mref[m] != 0.0f);
    if (!wave_any(nz)) {
      const int k8 = (kt + 7) & ~7, kend = k8 < nt ? k8 : nt;
#pragma unroll 1
      for (; kt < kend; ++kt) tile(kt, FalseC{}, FalseC{});
    }
  }
  __syncthreads();
#pragma unroll
  for (int m = 0; m < NMAP; ++m) { const float a0 = lane_get(lacc[m][0], lane & 15), a1 = lane_get(lacc[m][1], lane & 15); lsum[m] = l31 < 16 ? a0 : a1; }
}
constexpr int ATT_QB = TK / 128;
constexpr int ATT_LDS = 2 * AttnCfg<96>::STAGE;
constexpr int ATT_QBL = TL / 128, ATT_QBC = TC / 128, ATT_LAT_UNITS = NB * 4 * ATT_QBL, ATT_UNITS = ATT_LAT_UNITS + NB * 4 * ATT_QBC;
DI void att_unit(int u, int& bh, int& qb) {
  if (u < ATT_LAT_UNITS) { bh = u & 7; qb = ATT_QBC + (u >> 3); } else { const int v = u - ATT_LAT_UNITS; bh = v & 7; qb = v >> 3; }
}
DI void ph_attn_diff(const Params& p, int layer, int need_ctx, char* lds, int bid, int nblk) {
  const int lane = TIDX & 63, wid = TIDX >> 6, l31 = lane & 31, hh = lane >> 5;
  float lam_init; const float lam = lam_of(p, layer, lam_init);
#pragma unroll 1
  for (int u = bid; u < (need_ctx ? ATT_UNITS : ATT_LAT_UNITS); u += nblk) {
    int bh, qb; att_unit(u, bh, qb);
    const int b = bh >> 2, h = bh & 3, q0 = qb * 128;
    const int r = row_of(b, q0 + wid * 32 + l31);
    f32x16 O[2][2]; float ls[2];
    attn_unit<64, 2>(p.Qd + ((size_t)b * 8 + h * 2) * TK * 32, p.Kd + ((size_t)b * 8 + h * 2) * TK * 32, (size_t)TK * 32, p.Vtd + ((size_t)b * 4 + h) * 64 * TK, q0,
                     q0 < TC ? TC : TK, O, ls, lds);
    const float i0 = 1.0f / ls[0], i1 = lam / ls[1];
    float ss = 0.f;
#pragma unroll
    for (int dvt = 0; dvt < 2; ++dvt)
#pragma unroll
      for (int i = 0; i < 16; ++i) { const float o = O[0][dvt][i] * i0 - O[1][dvt][i] * i1; O[0][dvt][i] = o; ss += o * o; }
    ss = xor_sum<32>(ss);
    const float rstd = (1.0f - lam_init) / sqrtf(ss * (1.0f / 64) + 1e-6f);
    const float* gd = p.g_diff_out + layer * 256 + h * 64;
#pragma unroll
    for (int dvt = 0; dvt < 2; ++dvt)
#pragma unroll
      for (int g = 0; g < 4; ++g) {
        const int dv = dvt * 32 + 8 * g + 4 * hh;
        const f32x4 gv = *(const f32x4*)(gd + dv);
        f32x4 o = {O[0][dvt][4 * g] * rstd * gv[0], O[0][dvt][4 * g + 1] * rstd * gv[1], O[0][dvt][4 * g + 2] * rstd * gv[2], O[0][dvt][4 * g + 3] * rstd * gv[3]};
        st_bf16x4(p.Y + (size_t)r * D + 768 + h * 64 + dv, o);
      }
  }
}
DI void ph_attn_mla(const Params& p, int need_ctx, char* lds, int bid, int nblk) {
  const int lane = TIDX & 63, wid = TIDX >> 6, l31 = lane & 31, hh = lane >> 5;
#pragma unroll 1
  for (int u = bid; u < (need_ctx ? ATT_UNITS : ATT_LAT_UNITS); u += nblk) {
    int bh, qb; att_unit(u, bh, qb);
    const int b = bh >> 2, h = bh & 3, q0 = qb * 128;
    const int r = row_of(b, q0 + wid * 32 + l31);
    f32x16 O[1][2]; float ls[1];
    attn_unit<96, 1>(p.Qm + ((size_t)b * 4 + h) * TK * 96, p.Km + ((size_t)b * 4 + h) * TK * 96, 0, p.Vtm + ((size_t)b * 4 + h) * 64 * TK, q0, q0 < TC ? TC : TK, O, ls, lds);
    const float inv = 1.0f / ls[0];
#pragma unroll
    for (int dvt = 0; dvt < 2; ++dvt)
#pragma unroll
      for (int g = 0; g < 4; ++g) {
        f32x4 o = {O[0][dvt][4 * g] * inv, O[0][dvt][4 * g + 1] * inv, O[0][dvt][4 * g + 2] * inv, O[0][dvt][4 * g + 3] * inv};
        st_bf16x4(p.Y + (size_t)r * D + h * 64 + dvt * 32 + 8 * g + 4 * hh, o);
      }
  }
}
template <int VAR> DI void ph_attn_mla_probe(const Params& p, char* lds, int bid, int nblk) {
  const int lane = TIDX & 63, wid = TIDX >> 6, l31 = lane & 31, hh = lane >> 5;
#pragma unroll 1
  for (int u = bid; u < ATT_LAT_UNITS; u += nblk) {
    int bh, qb; att_unit(u, bh, qb);
    const int b = bh >> 2, h = bh & 3, q0 = qb * 128;
    const int r = row_of(b, q0 + wid * 32 + l31);
    f32x16 O[1][2]; float ls[1];
    attn_unit<96, 1, VAR>(p.Qm + ((size_t)b * 4 + h) * TK * 96, p.Km + ((size_t)b * 4 + h) * TK * 96, 0, p.Vtm + ((size_t)b * 4 + h) * 64 * TK, q0, TK, O, ls, lds);
    const float inv = 1.0f / ls[0];
#pragma unroll
    for (int dvt = 0; dvt < 2; ++dvt)
#pragma unroll
      for (int g = 0; g < 4; ++g) {
        f32x4 o = {O[0][dvt][4 * g] * inv, O[0][dvt][4 * g + 1] * inv, O[0][dvt][4 * g + 2] * inv, O[0][dvt][4 * g + 3] * inv};
        *(f32x4*)(p.out + (size_t)r * D + h * 64 + dvt * 32 + 8 * g + 4 * hh) = o;
      }
  }
}
DI void ph_attn(const Params& p, int layer, int need_ctx, char* lds, int bid, int nblk) {
  ph_attn_diff(p, layer, need_ctx, lds, bid, nblk);
  ph_attn_mla(p, need_ctx, lds, bid, nblk);
}

DI float wave_sum(float v) {
  v = xor_sum<1>(v); v = xor_sum<2>(v); v = xor_sum<4>(v); v = xor_sum<8>(v); v = xor_sum<16>(v); v = xor_sum<32>(v);
  return v;
}
DI void ld_row16(const float* row, int lane, f32x4 (&v)[4]) {
#pragma unroll
  for (int i = 0; i < 4; ++i) v[i] = *(const f32x4*)(row + 256 * i + 4 * lane);
}
DI void ld_row16_bf(const bf16_t* row, int lane, f32x4 (&v)[4]) {
#pragma unroll
  for (int i = 0; i < 4; ++i) { const u32x2 u = *(const u32x2*)(row + 256 * i + 4 * lane); v[i] = (f32x4){u2f(u.x << 16), u2f(u.x & 0xffff0000u), u2f(u.y << 16), u2f(u.y & 0xffff0000u)}; }
}
DI void ph_modulate(const Params& p, int layer, const float* xl, const float* xcx, int bid, int nblk) {
  const int lane = TIDX & 63, wid = TIDX >> 6;
  const float* g = p.g_mix_pre + layer * 1024;
  for (int r = bid * 4 + wid; r < R; r += nblk * 4) {
    const int w = r < RL ? r / TL : 2;
    const float* mb = p.mods + (size_t)(layer * 3 + w) * 6144;
    const float* x = r < RL ? xl + (size_t)r * D : xcx + (size_t)(r - RL) * D;
    f32x4 xv[4], gv[4], sc[4], sh[4];
    ld_row16(x, lane, xv); ld_row16(g, lane, gv); ld_row16(mb + 1024, lane, sc); ld_row16(mb, lane, sh);
    float ss = 0.f;
#pragma unroll
    for (int i = 0; i < 4; ++i)
#pragma unroll
      for (int e = 0; e < 4; ++e) ss += xv[i][e] * xv[i][e];
    const float rstd = 1.0f / sqrtf(wave_sum(ss) * (1.0f / D) + 1e-6f);
#pragma unroll
    for (int i = 0; i < 4; ++i) {
      f32x4 o;
#pragma unroll
      for (int e = 0; e < 4; ++e) o[e] = xv[i][e] * rstd * gv[i][e] * (1.f + sc[i][e]) + sh[i][e];
      st_bf16x4(p.H + (size_t)r * D + 256 * i + 4 * lane, o);
    }
  }
}
DI void ph_resid_mix(const Params& p, int layer, const float* xl_in, const float* xc_in, int rows, char* lds, int bid, int nblk) {
  const int lane = TIDX & 63, wid = TIDX >> 6;
  const float* wr = p.w_router + (size_t)layer * D * 16;
  for (int i = TIDX; i < D * 4; i += NTHR) { const int k = i >> 2, q = i & 3; *(f32x4*)(lds + k * 64 + (k >> 2) * 16 + q * 16) = *(const f32x4*)(wr + k * 16 + q * 4); }
  __syncthreads();
  for (int r = bid * 4 + wid; r < rows; r += nblk * 4) {
    const int w = r < RL ? r / TL : 2;
    const float* mb = p.mods + (size_t)(layer * 3 + w) * 6144;
    const float* xin = r < RL ? xl_in + (size_t)r * D : xc_in + (size_t)(r - RL) * D;
    float* xo = r < RL ? p.out + (size_t)r * D : p.xc + (size_t)(r - RL) * D;
    f32x4 yv[4], xv[4], a[4], c[4];
    ld_row16_bf(p.YO + (size_t)r * D, lane, yv); ld_row16(xin, lane, xv);
    float ss = 0.f;
#pragma unroll
    for (int i = 0; i < 4; ++i)
#pragma unroll
      for (int e = 0; e < 4; ++e) ss += yv[i][e] * yv[i][e];
    const float rstd = 1.0f / sqrtf(wave_sum(ss) * (1.0f / D) + 1e-6f);
    ld_row16(mb + 2 * 1024, lane, a); ld_row16(p.g_mix_post + layer * 1024, lane, c);
    float s2 = 0.f;
#pragma unroll
    for (int i = 0; i < 4; ++i) {
#pragma unroll
      for (int e = 0; e < 4; ++e) { xv[i][e] += a[i][e] * yv[i][e] * rstd * c[i][e]; s2 += xv[i][e] * xv[i][e]; }
      *(f32x4*)(xo + 256 * i + 4 * lane) = xv[i];
    }
    const float rstd2 = 1.0f / sqrtf(wave_sum(s2) * (1.0f / D) + 1e-6f);
    ld_row16(p.g_ffn_pre + layer * 1024, lane, a); ld_row16(mb + 4 * 1024, lane, c); ld_row16(mb + 3 * 1024, lane, yv);
    float lg[16];
#pragma unroll
    for (int e = 0; e < 16; ++e) lg[e] = 0.f;
#pragma unroll
    for (int i = 0; i < 4; ++i) {
      f32x4 h2;
#pragma unroll
      for (int e = 0; e < 4; ++e) h2[e] = xv[i][e] * rstd2 * a[i][e] * (1.f + c[i][e]) + yv[i][e];
      st_bf16x4(p.H + (size_t)r * D + 256 * i + 4 * lane, h2);
#pragma unroll
      for (int e = 0; e < 4; ++e) {
        const char* wk = lds + (256 * i + 4 * lane + e) * 64 + (64 * i + lane) * 16;
#pragma unroll
        for (int q = 0; q < 4; ++q) { const f32x4 wv = *(const f32x4*)(wk + 16 * q); lg[4 * q] += h2[e] * wv[0]; lg[4 * q + 1] += h2[e] * wv[1]; lg[4 * q + 2] += h2[e] * wv[2]; lg[4 * q + 3] += h2[e] * wv[3]; }
      }
    }
#pragma unroll
    for (int e = 0; e < 16; ++e) lg[e] = wave_sum(lg[e]);
    float mx = lg[0];
#pragma unroll
    for (int e = 1; e < 16; ++e) mx = fmaxf(mx, lg[e]);
    float sm = 0.f;
#pragma unroll
    for (int e = 0; e < 16; ++e) { lg[e] = expf(lg[e] - mx); sm += lg[e]; }
    int b, s; bs_of(r, b, s);
    float mine = 0.f;
#pragma unroll
    for (int e = 0; e < 16; ++e) mine = (lane == e) ? lg[e] / sm : mine;
    if (lane < 16) p.AFF[((size_t)b * NE + lane) * TK + s] = mine;
  }
}
DI void ph_resid_ffn(const Params& p, int layer, int rows, int bid, int nblk) {
  const int lane = TIDX & 63, wid = TIDX >> 6;
  int r = bid * 4 + wid;
  int inv_n = (r < rows && lane < NE) ? p.INV[(size_t)r * NE + lane] : -1;
#pragma unroll 1
  for (; r < rows; r += nblk * 4) {
    const int w = r < RL ? r / TL : 2;
    const float* mb = p.mods + (size_t)(layer * 3 + w) * 6144;
    float* xo = r < RL ? p.out + (size_t)r * D : p.xc + (size_t)(r - RL) * D;
    const int myinv = inv_n;
    { const int rn = r + nblk * 4; inv_n = (rn < rows && lane < NE) ? p.INV[(size_t)rn * NE + lane] : -1; }
    f32x4 f[4], xv[4];
    ld_row16(xo, lane, xv);
#pragma unroll
    for (int i = 0; i < 4; ++i) f[i] = (f32x4){0.f, 0.f, 0.f, 0.f};
    unsigned mask = wave_ballot16(myinv >= 0);
#pragma unroll 1
    while (mask) {
      const int e0 = __builtin_ctz(mask); mask &= mask - 1;
      const bool two = mask != 0u;
      const int e1 = two ? __builtin_ctz(mask) : e0; if (two) mask &= mask - 1;
      const int s0 = lane_bcast(myinv, e0), s1 = lane_bcast(myinv, e1);
      f32x4 y0[4], y1[4];
      ld_row16_bf(p.YE + ((size_t)e0 * NSLOT + s0) * D, lane, y0); ld_row16_bf(p.YE + ((size_t)e1 * NSLOT + s1) * D, lane, y1);
      const float w1 = two ? 1.0f : 0.0f;
#pragma unroll
      for (int i = 0; i < 4; ++i) f[i] += y0[i] + y1[i] * w1;
    }
    float ss = 0.f;
#pragma unroll
    for (int i = 0; i < 4; ++i)
#pragma unroll
      for (int e = 0; e < 4; ++e) ss += f[i][e] * f[i][e];
    const float rstd = 1.0f / sqrtf(wave_sum(ss) * (1.0f / D) + 1e-6f);
    f32x4 a[4], c[4];
    ld_row16(mb + 5 * 1024, lane, a); ld_row16(p.g_ffn_post + layer * 1024, lane, c);
    float s2 = 0.f;
#pragma unroll
    for (int i = 0; i < 4; ++i) {
#pragma unroll
      for (int e = 0; e < 4; ++e) { xv[i][e] += a[i][e] * f[i][e] * rstd * c[i][e]; s2 += xv[i][e] * xv[i][e]; }
      *(f32x4*)(xo + 256 * i + 4 * lane) = xv[i];
    }
    if (layer == 0) {
      const float rstd2 = 1.0f / sqrtf(wave_sum(s2) * (1.0f / D) + 1e-6f);
      const float* mb1 = p.mods + (size_t)(3 + w) * 6144;
      f32x4 sh[4];
      ld_row16(p.g_mix_pre + 1024, lane, a); ld_row16(mb1 + 1024, lane, c); ld_row16(mb1, lane, sh);
#pragma unroll
      for (int i = 0; i < 4; ++i) {
        f32x4 o;
#pragma unroll
        for (int e = 0; e < 4; ++e) o[e] = xv[i][e] * rstd2 * a[i][e] * (1.f + c[i][e]) + sh[i][e];
        st_bf16x4(p.H + (size_t)r * D + 256 * i + 4 * lane, o);
      }
    }
  }
}
DI void ph_mods(const Params& p, char* lds, int bid, int nblk) {
  float* sc = (float*)lds;
  const int t = TIDX;
  for (int i = t; i < 3 * 1024; i += NTHR) { const float v = i < 2048 ? p.c[i] : p.c_ctx[i - 2048]; sc[i] = v / (1.0f + expf(-v)); }
  __syncthreads();
#pragma unroll 1
  for (long gi = (long)bid * NTHR + t; gi < 2 * 3 * 6144; gi += (long)nblk * NTHR) {
    const int col = (int)(gi % 6144), w = (int)((gi / 6144) % 3), l = (int)(gi / (3 * 6144));
    const float* W = p.w_ada + (size_t)l * 1024 * 6144 + col; const float* s = sc + w * 1024;
    float acc[8];
#pragma unroll
    for (int q = 0; q < 8; ++q) acc[q] = 0.f;
#pragma unroll 1
    for (int k = 0; k < 1024; k += 8) {
#pragma unroll
      for (int q = 0; q < 8; ++q) acc[q] += s[k + q] * W[(size_t)(k + q) * 6144];
    }
    p.mods[gi] = ((acc[0] + acc[1]) + (acc[2] + acc[3])) + ((acc[4] + acc[5]) + (acc[6] + acc[7])) + p.b_ada[l * 6144 + col];
  }
  __syncthreads();
}
constexpr int TOPK_LDS = TL * 4 + 2048;
DI int block_sum_i(int v, int* red) {
  const int lane = TIDX & 63, wid = TIDX >> 6;
  v = xor_sum_i<1>(v); v = xor_sum_i<2>(v); v = xor_sum_i<4>(v); v = xor_sum_i<8>(v); v = xor_sum_i<16>(v); v = xor_sum_i<32>(v);
  __syncthreads();
  if (lane == 0) red[wid] = v;
  __syncthreads();
  return red[0] + red[1] + red[2] + red[3];
}
DI int block_excl_scan(int v, int* red) {
  const int lane = TIDX & 63, wid = TIDX >> 6;
  int inc = v;
#pragma unroll
  for (int d = 1; d < 64; d <<= 1) { const int o = lane_up(inc, d, lane); if (lane >= d) inc += o; }
  __syncthreads();
  if (lane == 63) red[wid] = inc;
  __syncthreads();
  int base = 0;
  for (int q = 0; q < wid; ++q) base += red[q];
  return base + inc - v;
}
DI void ph_topk(const Params& p, int need_ctx, char* lds, int bid, int nblk) {
  unsigned* vals = (unsigned*)lds; int* red = (int*)(lds + TL * 4 + 1024);
  const int t = TIDX;
  for (int u = bid; u < NB * NE * 2; u += nblk) {
    const int seg = u & 1, e = (u >> 1) % NE, b = u / (2 * NE);
    const int s0 = seg ? TC : 0, n = seg ? TL : TC, cap = seg ? CAPL : CAPC, slot0 = seg ? b * CAPL : NB * CAPL + b * CAPC;
    if (seg == 0 && !need_ctx) { for (int q = t; q < cap; q += NTHR) p.SEL[(size_t)e * NSLOT + slot0 + q] = -1; continue; }
    const float* a = p.AFF + ((size_t)b * NE + e) * TK + s0;
    const int vpt = (n + NTHR - 1) / NTHR, i0 = t * vpt, i1 = (i0 + vpt < n) ? i0 + vpt : n;
    for (int i = t; i < n; i += NTHR) vals[i + i / vpt] = f2u(a[i]);
    __syncthreads();
    unsigned thr = 0;
    for (int bit = 31; bit >= 0; --bit) {
      const unsigned cand = thr | (1u << bit);
      int cnt = 0;
      for (int i = i0; i < i1; ++i) cnt += (vals[i + t] >= cand);
      if (block_sum_i(cnt, red) >= cap) thr = cand;
    }
    int cgt = 0, ceq = 0;
    for (int i = i0; i < i1; ++i) { cgt += (vals[i + t] > thr); ceq += (vals[i + t] == thr); }
    const int ngt = block_sum_i(cgt, red);
    const int neq = cap - ngt;
    int eqoff = block_excl_scan(ceq, red);
    int csel = 0;
    { int er = eqoff; for (int i = i0; i < i1; ++i) { if (vals[i + t] > thr) ++csel; else if (vals[i + t] == thr) { if (er < neq) ++csel; ++er; } } }
    int q = block_excl_scan(csel, red);
    for (int i = i0; i < i1; ++i) {
      const unsigned v = vals[i + t]; int sel = -1;
      if (v > thr) sel = q++; else if (v == thr) { if (eqoff < neq) sel = q++; ++eqoff; }
      const int r = row_of(b, s0 + i);
      if (sel >= 0) { p.SEL[(size_t)e * NSLOT + slot0 + sel] = r; p.SELV[(size_t)e * NSLOT + slot0 + sel] = u2f(v); }
      p.INV[(size_t)r * NE + e] = sel >= 0 ? slot0 + sel : -1;
    }
    __syncthreads();
  }
}
DI void ph_wt(const float* in, bf16_t* out, int K, int N, int NP, int nbatch, long in_bs, long out_bs, const float* gain, char* lds, int bid, int nblk) {
  float* tile = (float*)lds;
  const int t = TIDX, tk = K / 64, tn = NP / 64, ntile = nbatch * tk * tn;
  f32x4 v[4];
  auto gload = [&](int u) {
    const int bt = u / (tk * tn), rem = u % (tk * tn), k0 = (rem / tn) * 64, n0 = (rem % tn) * 64;
    const float* I = in + (size_t)bt * in_bs;
#pragma unroll
    for (int i = 0; i < 4; ++i) {
      const int idx = t + i * NTHR, kk = idx >> 4, n4 = (idx & 15) * 4;
      v[i] = (f32x4){0.f, 0.f, 0.f, 0.f};
      if (n0 + n4 < N) v[i] = *(const f32x4*)(I + (size_t)(k0 + kk) * N + n0 + n4);
      if (gain) { const float g = gain[k0 + kk]; v[i][0] *= g; v[i][1] *= g; v[i][2] *= g; v[i][3] *= g; }
    }
  };
  if (bid < ntile) gload(bid);
#pragma unroll 1
  for (int u = bid; u < ntile; u += nblk) {
    const int bt = u / (tk * tn), rem = u % (tk * tn), k0 = (rem / tn) * 64, n0 = (rem % tn) * 64;
    bf16_t* O = out + (size_t)bt * out_bs;
#pragma unroll
    for (int i = 0; i < 4; ++i) { const int idx = t + i * NTHR, kk = idx >> 4, n4 = (idx & 15) * 4; float* d = tile + kk * 65 + n4; d[0] = v[i][0]; d[1] = v[i][1]; d[2] = v[i][2]; d[3] = v[i][3]; }
    __syncthreads();
    if (u + nblk < ntile) gload(u + nblk);
#pragma unroll
    for (int i = 0; i < 2; ++i) {
      const int idx = t + i * NTHR, kg = idx & 7, nn = idx >> 3;
      float a[8];
#pragma unroll
      for (int e = 0; e < 8; ++e) a[e] = tile[(kg * 8 + e) * 65 + nn];
      u32x4 o; o.x = pack2bf(a[0], a[1]); o.y = pack2bf(a[2], a[3]); o.z = pack2bf(a[4], a[5]); o.w = pack2bf(a[6], a[7]);
      *(u32x4*)(O + (size_t)(n0 + nn) * K + k0 + kg * 8) = o;
    }
    __syncthreads();
  }
}
DI float wave_max(float v) {
  v = xor_max<1>(v); v = xor_max<2>(v); v = xor_max<4>(v); v = xor_max<8>(v); v = xor_max<16>(v); v = xor_max<32>(v);
  return v;
}
DI bf16x8 cvt8(const float* f) {
  const f32x4 a = *(const f32x4*)f, b = *(const f32x4*)(f + 4);
  u32x4 pk; pk.x = pack2bf(a[0], a[1]); pk.y = pack2bf(a[2], a[3]); pk.z = pack2bf(b[0], b[1]); pk.w = pack2bf(b[2], b[3]);
  return __builtin_bit_cast(bf16x8, pk);
}
constexpr int SCAN_UNITS = NB * NCK * 4, SCAN_LAT_UNITS = NB * NCL * 4;
DI void scan_unit(int u, int& b, int& c, int& h) {
  h = u & 3;
  if (u < SCAN_LAT_UNITS) { c = NCC + (u >> 2) % NCL; b = u / (4 * NCL); } else { const int v = u - SCAN_LAT_UNITS; c = (v >> 2) % NCC; b = v / (4 * NCC); }
}

DI void ph_ml_local(const Params& p, char* lds, int bid, int nblk) {
  bf16_t* sK = (bf16_t*)lds;
  float* sW = (float*)(lds + 64 * 132);
  const int t = TIDX, lane = t & 63, wid = t >> 6, l31 = lane & 31, hh = lane >> 5;
  const int d = wid & 1, vt = wid >> 1;
#pragma unroll 1
  for (int u = bid; u < SCAN_UNITS; u += nblk) {
    int b, c, h; scan_unit(u, b, c, h);
    {
      const int row = t >> 2, seg = (t & 3) * 16;
      const bf16_t* src = p.MK + ((size_t)b * TK + 64 * c + row) * 256 + h * 64 + seg;
      const u32x4 a = ldg16(src), bb = ldg16(src + 8);
      unsigned* dst = (unsigned*)((char*)sK + row * 132 + seg * 2);
      dst[0] = a.x; dst[1] = a.y; dst[2] = a.z; dst[3] = a.w; dst[4] = bb.x; dst[5] = bb.y; dst[6] = bb.z; dst[7] = bb.w;
    }
    if (t < 128) {
      const int dd = t >> 6, l = t & 63, j = step_of(dd, c), pos = dd ? 63 - l : l;
      const size_t o = (((size_t)b * 2 + dd) * TK + 64 * j) * 4 + h;
      const float bend = p.BC[o + 63 * 4], wl = bend - p.BC[o + pos * 4] + p.IGS[o + pos * 4];
      const float ml = wave_max(wl);
      sW[dd * 64 + l] = expf(wl - ml);
      if (l == 0) { const size_t uu = (((size_t)b * 2 + dd) * NCK + j) * 4 + h; p.MM[uu * 4] = ml; p.MM[uu * 4 + 1] = bend; }
    }
    __syncthreads();
    const int j = step_of(d, c);
    const size_t uu = (((size_t)b * 2 + d) * NCK + j) * 4 + h;
    f32x16 acc[2]; acc[0] = (f32x16)(0.f); acc[1] = (f32x16)(0.f);
    const bf16_t* vsrc = p.MVt + (((size_t)b * 4 + h) * 64 + vt * 32 + l31) * TK + 64 * c;
#pragma unroll
    for (int ks = 0; ks < 4; ++ks) {
      const bf16x8 a = *(const bf16x8*)(vsrc + ks * 16 + 8 * hh);
      const float* w = sW + d * 64 + ks * 16 + 8 * hh;
      u32x4 pk;
      pk.x = pack2bf(bf2f((bf16_t)a[0]) * w[0], bf2f((bf16_t)a[1]) * w[1]); pk.y = pack2bf(bf2f((bf16_t)a[2]) * w[2], bf2f((bf16_t)a[3]) * w[3]);
      pk.z = pack2bf(bf2f((bf16_t)a[4]) * w[4], bf2f((bf16_t)a[5]) * w[5]); pk.w = pack2bf(bf2f((bf16_t)a[6]) * w[6], bf2f((bf16_t)a[7]) * w[7]);
      const bf16x8 af = __builtin_bit_cast(bf16x8, pk);
#pragma unroll
      for (int kt = 0; kt < 2; ++kt) {
        bf16x8 bfr;
#pragma unroll
        for (int q = 0; q < 8; ++q) bfr[q] = (short)sK[(ks * 16 + 8 * hh + q) * 66 + kt * 32 + l31];
        acc[kt] = MFMA32(af, bfr, acc[kt]);
      }
    }
#pragma unroll
    for (int kt = 0; kt < 2; ++kt)
#pragma unroll
      for (int i = 0; i < 16; ++i) p.MC[uu * 4096 + (size_t)(vt * 32 + (i & 3) + 8 * (i >> 2) + 4 * hh) * 64 + kt * 32 + l31] = acc[kt][i];
    float nl = 0.f;
    for (int q = 0; q < 32; ++q) { const int l = hh * 32 + q; nl += sW[d * 64 + l] * bf2f(sK[l * 66 + vt * 32 + l31]); }
    nl = xor_sum<32>(nl);
    if (hh == 0) p.MN[uu * 64 + vt * 32 + l31] = nl;
    __syncthreads();
  }
}
constexpr int SCAN_PF = 8;
DI void ph_ml_scan(const Params& p, int bid, int nblk) {
  for (long gi = (long)bid * NTHR + TIDX; gi < (long)NB * 2 * 4 * 4160; gi += (long)nblk * NTHR) {
    const int e = (int)(gi % 4160), ch = (int)(gi / 4160), h = ch & 3, bd = ch >> 2;
    float* base = e < 4096 ? p.MC + (((size_t)bd * NCK) * 4 + h) * 4096 + e : p.MN + (((size_t)bd * NCK) * 4 + h) * 64 + (e - 4096);
    const size_t stride = e < 4096 ? 4 * 4096 : 4 * 64;
    float* mm = p.MM + (((size_t)bd * NCK) * 4 + h) * 4;
    float st = 0.f, m = -1e30f;
    float cl[SCAN_PF], cm[SCAN_PF], cb[SCAN_PF], nl[SCAN_PF], nm[SCAN_PF], nb[SCAN_PF];
#pragma unroll
    for (int q = 0; q < SCAN_PF; ++q) if (q < NCK) { cl[q] = base[(size_t)q * stride]; cm[q] = mm[q * 16]; cb[q] = mm[q * 16 + 1]; }
#pragma unroll 1
    for (int jb = 0; jb < NCK; jb += SCAN_PF) {
#pragma unroll
      for (int q = 0; q < SCAN_PF; ++q) { const int j = jb + SCAN_PF + q; if (j < NCK) { nl[q] = base[(size_t)j * stride]; nm[q] = mm[j * 16]; nb[q] = mm[j * 16 + 1]; } }
#pragma unroll
      for (int q = 0; q < SCAN_PF; ++q) {
        const int j = jb + q;
        if (j < NCK) {
          const float mn = fmaxf(cb[q] + m, cm[q]), a = expf(cb[q] + m - mn), g = expf(cm[q] - mn);
          base[(size_t)j * stride] = st;
          st = a * st + g * cl[q];
          if (e == 0) mm[j * 16 + 2] = m;
          m = mn;
        }
      }
#pragma unroll
      for (int q = 0; q < SCAN_PF; ++q) { cl[q] = nl[q]; cm[q] = nm[q]; cb[q] = nb[q]; }
    }
  }
}
DI void ph_gla_scan(const Params& p, int bid, int nblk) {
  for (long gi = (long)bid * NTHR + TIDX; gi < (long)NB * 2 * 4 * 2048; gi += (long)nblk * NTHR) {
    const int e = (int)(gi % 2048), ch = (int)(gi / 2048), h = ch & 3, bd = ch >> 2, k = e & 31;
    float* base = p.GS + (((size_t)bd * NCK) * 4 + h) * 2048 + e;
    const float* ge = p.GC + ((size_t)bd * TK + 63) * 128 + h * 32 + k;
    float st = 0.f;
    float cl[SCAN_PF], cg[SCAN_PF], nl[SCAN_PF], ng[SCAN_PF];
#pragma unroll
    for (int q = 0; q < SCAN_PF; ++q) if (q < NCK) { cl[q] = base[(size_t)q * 4 * 2048]; cg[q] = ge[(size_t)q * 64 * 128]; }
#pragma unroll 1
    for (int jb = 0; jb < NCK; jb += SCAN_PF) {
#pragma unroll
      for (int q = 0; q < SCAN_PF; ++q) { const int j = jb + SCAN_PF + q; if (j < NCK) { nl[q] = base[(size_t)j * 4 * 2048]; ng[q] = ge[(size_t)j * 64 * 128]; } }
#pragma unroll
      for (int q = 0; q < SCAN_PF; ++q) {
        const int j = jb + q;
        if (j < NCK) { base[(size_t)j * 4 * 2048] = st; st = expf(cg[q]) * st + cl[q]; }
      }
#pragma unroll
      for (int q = 0; q < SCAN_PF; ++q) { cl[q] = nl[q]; cg[q] = ng[q]; }
    }
  }
}
constexpr int MO_K = 0, MO_V = 64 * 144, MO_A = MO_V + 64 * VROW, MO_PM = MO_A + 512, MO_N0 = MO_PM + 512, MO_X = MO_N0 + 512, MO_LDS = MO_X + 16384;
DI void ph_ml_out(const Params& p, int layer, int need_ctx, char* lds, int bid, int nblk) {
  float* sA = (float*)(lds + MO_A); float* sPM = (float*)(lds + MO_PM); float* sN0 = (float*)(lds + MO_N0); float* sX = (float*)(lds + MO_X);
  const int t = TIDX, lane = t & 63, wid = t >> 6, l31 = lane & 31, hh = lane >> 5;
  const int lt = wid & 1, d = wid >> 1;
#pragma unroll 1
  for (int u = bid; u < (need_ctx ? SCAN_UNITS : SCAN_LAT_UNITS); u += nblk) {
    int b, c, h; scan_unit(u, b, c, h);
    {
      const int row = t >> 2, seg = (t & 3) * 16;
      const bf16_t* ks = p.MK + ((size_t)b * TK + 64 * c + row) * 256 + h * 64 + seg;
      sts16(lds + MO_K + row * 144 + seg * 2, ldg16(ks)); sts16(lds + MO_K + row * 144 + seg * 2 + 16, ldg16(ks + 8));
      const bf16_t* vs = p.MVt + (((size_t)b * 4 + h) * 64 + row) * TK + 64 * c + seg;
      const u32x4 v0 = ldg16(vs), v1 = ldg16(vs + 8);
      u32x2* dv = (u32x2*)(lds + MO_V + row * VROW + seg * 2);
      u32x2 q; q.x = v0.x; q.y = v0.y; dv[0] = q; q.x = v0.z; q.y = v0.w; dv[1] = q; q.x = v1.x; q.y = v1.y; dv[2] = q; q.x = v1.z; q.y = v1.w; dv[3] = q;
    }
    if (t < 128) {
      const int dd = t >> 6, s = t & 63, j = step_of(dd, c), pos = dd ? 63 - s : s;
      const size_t o = (((size_t)b * 2 + dd) * TK + 64 * j) * 4 + h;
      sA[dd * 64 + s] = p.IGS[o + pos * 4] - p.BC[o + pos * 4];
      const size_t uu = (((size_t)b * 2 + dd) * NCK + j) * 4 + h;
      sN0[dd * 64 + s] = p.MN[uu * 64 + s];
    }
    __syncthreads();
    if (t < 2) {
      float m = -1e30f;
      if (t == 0) { for (int s = 0; s < 64; ++s) { m = fmaxf(m, sA[s]); sPM[s] = m; } }
      else { for (int s = 63; s >= 0; --s) { m = fmaxf(m, sA[64 + s]); sPM[64 + s] = m; } }
    }
    __syncthreads();
    const int j = step_of(d, c);
    const size_t uu = (((size_t)b * 2 + d) * NCK + j) * 4 + h;
    const int l = lt * 32 + l31, pos = d ? 63 - l : l;
    const float bl = p.BC[(((size_t)b * 2 + d) * TK + 64 * j + pos) * 4 + h];
    const float inter = bl + p.MM[uu * 4 + 2];
    const float mt = fmaxf(inter, bl + sPM[d * 64 + l]);
    const float aint = expf(inter - mt);
    bf16x8 qf[4];
#pragma unroll
    for (int ks = 0; ks < 4; ++ks) qf[ks] = *(const bf16x8*)(p.MQ + ((size_t)b * TK + 64 * c + l) * 256 + h * 64 + ks * 16 + 8 * hh);
    f32x16 num[2]; num[0] = (f32x16)(0.f); num[1] = (f32x16)(0.f);
    float den = 0.f;
#pragma unroll
    for (int st = 0; st < 2; ++st) {
      if (d == 0 ? st <= lt : st >= lt) {
        f32x16 S = (f32x16)(0.f);
#pragma unroll
        for (int ks = 0; ks < 4; ++ks) S = MFMA32(lds_frag(lds + MO_K + (st * 32 + l31) * 144 + (ks * 16 + 8 * hh) * 2), qf[ks], S);
#pragma unroll
        for (int i = 0; i < 16; ++i) {
          const int s = st * 32 + (i & 3) + 8 * (i >> 2) + 4 * hh;
          const bool ok = d == 0 ? s <= l : s >= l;
          const float e = ok ? fast_exp2((bl + sA[d * 64 + s] - mt) * LOG2E) * S[i] : 0.f;
          S[i] = e; den += e;
        }
#pragma unroll
        for (int kst = 0; kst < 2; ++kst) {
          const bf16x8 pf = pack8(S, kst);
#pragma unroll
          for (int vt = 0; vt < 2; ++vt) {
            const char* vp = lds + MO_V + (vt * 32 + l31) * VROW + (st * 32 + kst * 16 + 4 * hh) * 2;
            const s16x4 lo = *(const s16x4*)vp, hi = *(const s16x4*)(vp + 16);
            num[vt] = MFMA32(__builtin_shufflevector(lo, hi, 0, 1, 2, 3, 4, 5, 6, 7), pf, num[vt]);
          }
        }
      }
    }
    f32x16 accI[2]; accI[0] = (f32x16)(0.f); accI[1] = (f32x16)(0.f);
#pragma unroll
    for (int vt = 0; vt < 2; ++vt)
#pragma unroll
      for (int ks = 0; ks < 4; ++ks) accI[vt] = MFMA32(cvt8(p.MC + uu * 4096 + (size_t)(vt * 32 + l31) * 64 + ks * 16 + 8 * hh), qf[ks], accI[vt]);
    float qn = 0.f;
#pragma unroll
    for (int ks = 0; ks < 4; ++ks)
#pragma unroll
      for (int q = 0; q < 8; ++q) qn += bf2f((bf16_t)qf[ks][q]) * sN0[d * 64 + ks * 16 + 8 * hh + q];
    den = xor_sum<32>(den + aint * qn);
    const float inv = 1.0f / fmaxf(fabsf(den), expf(-mt));
#pragma unroll
    for (int vt = 0; vt < 2; ++vt)
#pragma unroll
      for (int i = 0; i < 16; ++i) num[vt][i] = (num[vt][i] + aint * accI[vt][i]) * inv;
    if (d == 1) {
#pragma unroll
      for (int vt = 0; vt < 2; ++vt)
#pragma unroll
        for (int i = 0; i < 16; ++i) sX[(lt * 32 + vt * 16 + i) * 64 + lane] = num[vt][i];
    }
    __syncthreads();
    if (d == 0) {
      float ss = 0.f;
#pragma unroll
      for (int vt = 0; vt < 2; ++vt)
#pragma unroll
        for (int i = 0; i < 16; ++i) { num[vt][i] += sX[(lt * 32 + vt * 16 + i) * 64 + lane]; ss += num[vt][i] * num[vt][i]; }
      ss = xor_sum<32>(ss);
      const float rstd = 1.0f / sqrtf(ss * (1.0f / 64) + 1e-6f);
      const int r = row_of(b, 64 * c + l);
#pragma unroll
      for (int vt = 0; vt < 2; ++vt)
#pragma unroll
        for (int g = 0; g < 4; ++g) {
          const int v0 = vt * 32 + 8 * g + 4 * hh;
          const u32x2 ou = *(const u32x2*)(p.Z + (size_t)r * NZP + ZC_MLO + h * 64 + v0);
          const f32x4 gv = *(const f32x4*)(p.g_mlstm_out + layer * 256 + h * 64 + v0);
          const float o0 = u2f(ou.x << 16), o1 = u2f(ou.x & 0xffff0000u), o2 = u2f(ou.y << 16), o3 = u2f(ou.y & 0xffff0000u);
          f32x4 y = {sigmoidf_(o0) * num[vt][4 * g] * rstd * gv[0], sigmoidf_(o1) * num[vt][4 * g + 1] * rstd * gv[1],
                     sigmoidf_(o2) * num[vt][4 * g + 2] * rstd * gv[2], sigmoidf_(o3) * num[vt][4 * g + 3] * rstd * gv[3]};
          st_bf16x4(p.Y + (size_t)r * D + 256 + h * 64 + v0, y);
        }
    }
    __syncthreads();
  }
}
DI void ph_gla_local(const Params& p, char* lds, int bid, int nblk) {
  bf16_t* sKd = (bf16_t*)lds;
  const int t = TIDX, lane = t & 63, wid = t >> 6, l31 = lane & 31, hh = lane >> 5;
  const int d = wid & 1, vt = wid >> 1;
#pragma unroll 1
  for (int u = bid; u < SCAN_UNITS; u += nblk) {
    int b, c, h; scan_unit(u, b, c, h);
    {
      const int dd = t >> 7, l = (t >> 1) & 63, k0 = (t & 1) * 16, j = step_of(dd, c), pos = dd ? 63 - l : l;
      const float* gcr = p.GC + (((size_t)b * 2 + dd) * TK + 64 * j + pos) * 128 + h * 32 + k0;
      const float* ger = p.GC + (((size_t)b * 2 + dd) * TK + 64 * j + 63) * 128 + h * 32 + k0;
      const bf16_t* kr = p.Z + (size_t)row_of(b, 64 * c + l) * NZP + ZC_GK + h * 32 + k0;
#pragma unroll
      for (int q = 0; q < 16; ++q) sKd[(dd * 64 + l) * 33 + k0 + q] = f2bf(bf2f(kr[q]) * fast_exp2((ger[q] - gcr[q]) * LOG2E));
    }
    __syncthreads();
    const int j = step_of(d, c);
    const size_t uu = (((size_t)b * 2 + d) * NCK + j) * 4 + h;
    f32x16 acc = (f32x16)(0.f);
    const bf16_t* vsrc = p.GVt + (((size_t)b * 4 + h) * 64 + vt * 32 + l31) * TK + 64 * c;
#pragma unroll
    for (int ks = 0; ks < 4; ++ks) {
      const bf16x8 af = *(const bf16x8*)(vsrc + ks * 16 + 8 * hh);
      bf16x8 bfr;
#pragma unroll
      for (int q = 0; q < 8; ++q) bfr[q] = (short)sKd[(d * 64 + ks * 16 + 8 * hh + q) * 33 + l31];
      acc = MFMA32(af, bfr, acc);
    }
#pragma unroll
    for (int i = 0; i < 16; ++i) p.GS[uu * 2048 + (size_t)(vt * 32 + (i & 3) + 8 * (i >> 2) + 4 * hh) * 32 + l31] = acc[i];
    __syncthreads();
  }
}
constexpr int GO_Q = 0, GO_K = 2 * 64 * 80, GO_V = 2 * GO_K, GO_X = GO_V + 64 * VROW, GO_LDS = GO_X + 16384;
DI void ph_gla_out(const Params& p, int layer, int need_ctx, char* lds, int bid, int nblk) {
  float* sX = (float*)(lds + GO_X);
  const int t = TIDX, lane = t & 63, wid = t >> 6, l31 = lane & 31, hh = lane >> 5;
  const int lt = wid & 1, d = wid >> 1;
#pragma unroll 1
  for (int u = bid; u < (need_ctx ? SCAN_UNITS : SCAN_LAT_UNITS); u += nblk) {
    int b, c, h; scan_unit(u, b, c, h);
    {
      const int dd = t >> 7, l = (t >> 1) & 63, k0 = (t & 1) * 16, j = step_of(dd, c), pos = dd ? 63 - l : l;
      const float* gcr = p.GC + (((size_t)b * 2 + dd) * TK + 64 * j + pos) * 128 + h * 32 + k0;
      const bf16_t* zr = p.Z + (size_t)row_of(b, 64 * c + l) * NZP;
      bf16_t* qd = (bf16_t*)(lds + GO_Q + (dd * 64 + l) * 80) + k0; bf16_t* kd = (bf16_t*)(lds + GO_K + (dd * 64 + l) * 80) + k0;
#pragma unroll
      for (int q = 0; q < 16; ++q) {
        const float g = gcr[q];
        qd[q] = f2bf(bf2f(zr[ZC_GQ + h * 32 + k0 + q]) * 0.17677669529663687f * fast_exp2(g * LOG2E));
        kd[q] = f2bf(bf2f(zr[ZC_GK + h * 32 + k0 + q]) * fast_exp2(-g * LOG2E));
      }
      const int row = t >> 2, seg = (t & 3) * 16;
      const bf16_t* vs = p.GVt + (((size_t)b * 4 + h) * 64 + row) * TK + 64 * c + seg;
      const u32x4 v0 = ldg16(vs), v1 = ldg16(vs + 8);
      u32x2* dv = (u32x2*)(lds + GO_V + row * VROW + seg * 2);
      u32x2 q2; q2.x = v0.x; q2.y = v0.y; dv[0] = q2; q2.x = v0.z; q2.y = v0.w; dv[1] = q2; q2.x = v1.x; q2.y = v1.y; dv[2] = q2; q2.x = v1.z; q2.y = v1.w; dv[3] = q2;
    }
    __syncthreads();
    const int j = step_of(d, c);
    const size_t uu = (((size_t)b * 2 + d) * NCK + j) * 4 + h;
    const int l = lt * 32 + l31;
    bf16x8 qf[2];
#pragma unroll
    for (int ks = 0; ks < 2; ++ks) qf[ks] = lds_frag(lds + GO_Q + (d * 64 + l) * 80 + (ks * 16 + 8 * hh) * 2);
    f32x16 O[2]; O[0] = (f32x16)(0.f); O[1] = (f32x16)(0.f);
#pragma unroll
    for (int st = 0; st < 2; ++st) {
      if (d == 0 ? st <= lt : st >= lt) {
        f32x16 S = (f32x16)(0.f);
#pragma unroll
        for (int ks = 0; ks < 2; ++ks) S = MFMA32(lds_frag(lds + GO_K + (d * 64 + st * 32 + l31) * 80 + (ks * 16 + 8 * hh) * 2), qf[ks], S);
#pragma unroll
        for (int i = 0; i < 16; ++i) {
          const int s = st * 32 + (i & 3) + 8 * (i >> 2) + 4 * hh;
          const bool ok = d == 0 ? s <= l : s >= l;
          S[i] = ok ? S[i] : 0.f;
        }
#pragma unroll
        for (int kst = 0; kst < 2; ++kst) {
          const bf16x8 pf = pack8(S, kst);
#pragma unroll
          for (int vt = 0; vt < 2; ++vt) {
            const char* vp = lds + GO_V + (vt * 32 + l31) * VROW + (st * 32 + kst * 16 + 4 * hh) * 2;
            const s16x4 lo = *(const s16x4*)vp, hi = *(const s16x4*)(vp + 16);
            O[vt] = MFMA32(__builtin_shufflevector(lo, hi, 0, 1, 2, 3, 4, 5, 6, 7), pf, O[vt]);
          }
        }
      }
    }
#pragma unroll
    for (int vt = 0; vt < 2; ++vt)
#pragma unroll
      for (int ks = 0; ks < 2; ++ks) O[vt] = MFMA32(cvt8(p.GS + uu * 2048 + (size_t)(vt * 32 + l31) * 32 + ks * 16 + 8 * hh), qf[ks], O[vt]);
    if (d == 1) {
#pragma unroll
      for (int vt = 0; vt < 2; ++vt)
#pragma unroll
        for (int i = 0; i < 16; ++i) sX[(lt * 32 + vt * 16 + i) * 64 + lane] = O[vt][i];
    }
    __syncthreads();
    if (d == 0) {
      float ss = 0.f;
#pragma unroll
      for (int vt = 0; vt < 2; ++vt)
#pragma unroll
        for (int i = 0; i < 16; ++i) { O[vt][i] += sX[(lt * 32 + vt * 16 + i) * 64 + lane]; ss += O[vt][i] * O[vt][i]; }
      ss = xor_sum<32>(ss);
      const float rstd = 1.0f / sqrtf(ss * (1.0f / 64) + 1e-6f);
      const int r = row_of(b, 64 * c + l);
#pragma unroll
      for (int vt = 0; vt < 2; ++vt)
#pragma unroll
        for (int g = 0; g < 4; ++g) {
          const int v0 = vt * 32 + 8 * g + 4 * hh;
          const u32x2 ru = *(const u32x2*)(p.Z + (size_t)r * NZP + ZC_GR + h * 64 + v0);
          const f32x4 gv = *(const f32x4*)(p.g_gla_out + layer * 256 + h * 64 + v0);
          const float r0 = u2f(ru.x << 16), r1 = u2f(ru.x & 0xffff0000u), r2 = u2f(ru.y << 16), r3 = u2f(ru.y & 0xffff0000u);
          f32x4 y = {siluf_(r0) * O[vt][4 * g] * rstd * gv[0], siluf_(r1) * O[vt][4 * g + 1] * rstd * gv[1],
                     siluf_(r2) * O[vt][4 * g + 2] * rstd * gv[2], siluf_(r3) * O[vt][4 * g + 3] * rstd * gv[3]};
          st_bf16x4(p.Y + (size_t)r * D + 512 + h * 64 + v0, y);
        }
    }
    __syncthreads();
  }
}

DI float fast_logsigmoid(float x) {
  const float e = fast_exp2(-fabsf(x) * LOG2E);
#ifdef CPU_EMU
  return fminf(x, 0.f) - log1pf(e);
#else
  return fminf(x, 0.f) - 0.6931471805599453f * __builtin_amdgcn_logf(1.0f + e);
#endif
}
DI float wave_incl_scan(float v, int lane) {
#pragma unroll
  for (int dd = 1; dd < 64; dd <<= 1) { const float o = u2f((unsigned)lane_up((int)f2u(v), dd, lane)); if (lane >= dd) v += o; }
  return v;
}
constexpr int GCUM_LDS = 4 * 64 * 33 * 4;
DI void ph_gates_cum(const Params& p, int layer, char* lds, int bid, int nblk) {
  const int t = TIDX, lane = t & 63, wid = t >> 6;
  float* stg = (float*)lds + wid * 64 * 33;
  const float* wal = p.w_alpha2 + (size_t)layer * 2 * 16 * 128;
#pragma unroll 1
  for (int u = bid * 4 + wid; u < NB * 2 * NCK; u += nblk * 4) {
    const int j = u % NCK, d = (u / NCK) & 1, b = u / (2 * NCK);
    const int pp = 64 * j + lane, s = seq_of(d, pp);
    const bf16_t* z = p.Z + (size_t)row_of(b, s) * NZP;
    const size_t ob = ((size_t)b * 2 + d) * TK + pp;
    {
      const u32x2 iu = *(const u32x2*)(z + ZC_MLIG + d * 4), fu = *(const u32x2*)(z + ZC_MLFG + d * 4);
      const float ig[4] = {u2f(iu.x << 16), u2f(iu.x & 0xffff0000u), u2f(iu.y << 16), u2f(iu.y & 0xffff0000u)};
      const float fg[4] = {u2f(fu.x << 16), u2f(fu.x & 0xffff0000u), u2f(fu.y << 16), u2f(fu.y & 0xffff0000u)};
      f32x4 oc, oi;
#pragma unroll
      for (int h = 0; h < 4; ++h) {
        oi[h] = ig[h] + p.b_igate[layer * 8 + d * 4 + h];
        oc[h] = wave_incl_scan(fast_logsigmoid(fg[h] + p.b_fgate[layer * 8 + d * 4 + h]), lane);
      }
      *(f32x4*)(p.BC + ob * 4) = oc; *(f32x4*)(p.IGS + ob * 4) = oi;
    }
    float a[16];
    { float f0[8], f1[8]; unpack8(ldg16(z + ZC_GA + d * 16), f0); unpack8(ldg16(z + ZC_GA + d * 16 + 8), f1);
#pragma unroll
      for (int q = 0; q < 8; ++q) { a[q] = f0[q]; a[8 + q] = f1[q]; } }
    const float* W = wal + (size_t)d * 16 * 128;
#pragma unroll 1
    for (int cg = 0; cg < 4; ++cg) {
#pragma unroll 4
      for (int c = 0; c < 32; ++c) {
        const int ch = cg * 32 + c;
        float zg = p.b_alpha[layer * 256 + d * 128 + ch];
#pragma unroll
        for (int q = 0; q < 16; ++q) zg += a[q] * W[q * 128 + ch];
        stg[lane * 33 + c] = wave_incl_scan(fast_logsigmoid(zg) * (1.0f / 16.0f), lane);
      }
      WAVE_SYNC();
#pragma unroll
      for (int k = 0; k < 32; ++k) { const int pos = k * 2 + (lane >> 5), c = lane & 31; p.GC[(((size_t)b * 2 + d) * TK + 64 * j + pos) * 128 + cg * 32 + c] = stg[pos * 33 + c]; }
      WAVE_SYNC();
    }
  }
}
#define XB_TMO      128
#define XB_XCNT(j)  (256  + 64 * (j))
#define XB_XSUB(j)  (1280 + 64 * (j))
#define XB_XGEN(j)  (2304 + 64 * (j))
#define XB_TOP      3328
#define XB_TOPGEN   3392
#define XCD_BAR_WORDS 3456
#define XB_SPIN_CAP (1u << 28)
#define LAS __attribute__((address_space(3)))

__device__ __forceinline__ unsigned xb_ld(unsigned* p)              { return __hip_atomic_load(p, __ATOMIC_RELAXED, __HIP_MEMORY_SCOPE_AGENT); }
__device__ __forceinline__ unsigned xb_add(unsigned* p, unsigned v) { return __hip_atomic_fetch_add(p, v, __ATOMIC_RELAXED, __HIP_MEMORY_SCOPE_AGENT); }
__device__ __forceinline__ unsigned xb_xcc_id() { return (unsigned)__builtin_amdgcn_s_getreg((3 << 11) | 20) & 0xFu; }
#define XB_SPIN(cond, bar) do { unsigned _sp = 0; while (cond) { __builtin_amdgcn_s_sleep(1); \
    if ((++_sp & 255u) == 0u) { if (xb_ld(&(bar)[XB_TMO])) break; if (_sp > XB_SPIN_CAP) { atomicAdd(&(bar)[XB_TMO], 1u); break; } } } } while (0)

struct XcdBarrier {
    unsigned* bar; unsigned x;
    volatile LAS unsigned* st;
};

__device__ __forceinline__ XcdBarrier xcd_barrier_post(unsigned* bar, volatile LAS unsigned* st) {
    XcdBarrier b; b.bar = bar; b.x = xb_xcc_id(); b.st = st;
    if (threadIdx.x == 0) (void)xb_add(&bar[XB_XCNT(b.x)], 1u);
    return b;
}
__device__ __forceinline__ void xcd_barrier_complete(unsigned* bar, unsigned x, unsigned& nloc, unsigned& nx) {
    const unsigned G = gridDim.x * gridDim.y * gridDim.z;
    unsigned sum, cnt, mine, sp = 0u;
    for (;;) {
        sum = 0u; cnt = 0u; mine = 0u;
#pragma unroll
        for (unsigned j = 0; j < 16; ++j) { const unsigned c = xb_ld(&bar[XB_XCNT(j)]); sum += c; cnt += (c > 0u) ? 1u : 0u; mine = (j == x) ? c : mine; }
        if (sum == G) break;
        __builtin_amdgcn_s_sleep(1);
        if ((++sp & 255u) == 0u) { if (xb_ld(&bar[XB_TMO])) break; if (sp > XB_SPIN_CAP) { atomicAdd(&bar[XB_TMO], 1u); break; } }
    }
    nloc = mine > 0u ? mine : 1u; nx = cnt > 0u ? cnt : 1u;
}

__device__ __forceinline__ void xcd_barrier(const XcdBarrier& b) {
    asm volatile("s_waitcnt vmcnt(0)" ::: "memory");
    __syncthreads();
    if (threadIdx.x == 0) {
        unsigned* bar = b.bar;
        __builtin_amdgcn_s_waitcnt(0);
        unsigned nloc = b.st[0], nx = b.st[1];
        if (nloc == 0u) { xcd_barrier_complete(bar, b.x, nloc, nx); b.st[0] = nloc; b.st[1] = nx; }
        const unsigned old = xb_add(&bar[XB_XSUB(b.x)], 1u);
        const unsigned gen = old / nloc;
        if (old + 1u == (gen + 1u) * nloc) {
            __builtin_amdgcn_fence(__ATOMIC_RELEASE, "agent");
            asm volatile("s_waitcnt vmcnt(0)" ::: "memory");
            const unsigned og = xb_add(&bar[XB_TOP], 1u);
            const unsigned tg = og / nx;
            if (og + 1u == (tg + 1u) * nx) xb_add(&bar[XB_TOPGEN], 1u);
            else XB_SPIN(xb_ld(&bar[XB_TOPGEN]) == tg, bar);
            __builtin_amdgcn_fence(__ATOMIC_ACQUIRE, "agent");
            xb_add(&bar[XB_XGEN(b.x)], 1u);
            asm volatile("s_waitcnt vmcnt(0)" ::: "memory");
        } else {
            XB_SPIN(xb_ld(&bar[XB_XGEN(b.x)]) == gen, bar);
            __builtin_amdgcn_fence(__ATOMIC_ACQUIRE, "agent");
            asm volatile("s_waitcnt vmcnt(0)" ::: "memory");
        }
    }
    __syncthreads();
}

#define GS_LOOP(N, CALL) for (long gi = (long)bid * NTHR + TIDX; gi < (long)(N); gi += (long)nblk * NTHR) { CALL; }
#ifndef PROBE
#define PROBE 0
#endif
#ifndef PROBE_MASK
#define PROBE_MASK 0
#endif
#ifndef FAST_SCAN
#define FAST_SCAN 1
#endif
constexpr int N_PHASES = 16;
constexpr int MEGA_LDS = GEMM_LDS > TOPK_LDS ? GEMM_LDS : TOPK_LDS;

template <int PH>
DI void run_phase(const Params& p, int l, char* lds, int bid, int nblk) {
  const int need_ctx = (l == 0);
  const int rows = need_ctx ? R : RL;
  const float* xl_in = l == 0 ? p.x : p.out;
  const float* xc_in = l == 0 ? p.ctx : p.xc;
  bf16_t* QRAW = p.YO; bf16_t* KVRAW = p.YO + (size_t)R * 384;
  if constexpr (PH == 0) {
    ph_mods(p, lds, bid, nblk);
#pragma unroll 1
    for (int ll = 0; ll < 2; ++ll) {
      ph_wt(p.w_in + (size_t)ll * D * NZ, p.Wt_in + ll * WSZ_IN, D, NZ, NZP, 1, 0L, 0L, nullptr, lds, bid, nblk);
      ph_wt(p.w_gate + (size_t)ll * D * 4096, p.Wt_gate + ll * WSZ_GATE, D, 4096, 4096, 1, 0L, 0L, nullptr, lds, bid, nblk);
      ph_wt(p.w_branch + (size_t)ll * 4 * 256 * D, p.Wt_branch + ll * WSZ_BR, 256, D, D, 4, (long)256 * D, (long)D * 256, nullptr, lds, bid, nblk);
      ph_wt(p.w_out + (size_t)ll * D * D, p.Wt_out + ll * WSZ_OUT, D, D, D, 1, 0L, 0L, nullptr, lds, bid, nblk);
      ph_wt(p.w_uq + (size_t)ll * 256 * 384, p.Wt_uq + ll * WSZ_UQ, 256, 384, 384, 1, 0L, 0L, p.g_q_lat + ll * 256, lds, bid, nblk);
      ph_wt(p.w_ukv + (size_t)ll * 128 * 512, p.Wt_ukv + ll * WSZ_UKV, 128, 512, 512, 1, 0L, 0L, p.g_kv_lat + ll * 128, lds, bid, nblk);
    }
  } else if constexpr (PH == 1) {
    ph_modulate(p, l, xl_in, xc_in, bid, nblk);
  } else if constexpr (PH == 2) {
    ph_gemm_plain(p.H, D, p.Wt_in + l * WSZ_IN, D, R, NZP, D, p.Z, NZP, lds, bid, nblk);
#if PROBE == 63
    ph_gemm_probe<3>(p.H, D, p.Wt_in + l * WSZ_IN, D, R, NZP, D, p.mods + 40000, lds, bid, nblk);
#elif PROBE == 66
    ph_gemm_probe<6>(p.H, D, p.Wt_in + l * WSZ_IN, D, R, NZP, D, p.mods + 40000, lds, bid, nblk);
#elif PROBE == 67
    ph_gemm_plain<1>(p.H, D, p.Wt_in + l * WSZ_IN, D, R, NZP, D, p.Z, NZP, lds, bid, nblk);
#elif PROBE == 68
    ph_gemm_plain<2>(p.H, D, p.Wt_in + l * WSZ_IN, D, R, NZP, D, p.Z, NZP, lds, bid, nblk);
#elif PROBE == 5
    ph_gemm_plain(p.H, D, p.Wt_in + l * WSZ_IN, D, R, NZP, D, p.Z, NZP, lds, bid, nblk);
#endif
  } else if constexpr (PH == 3) {
    ph_mla_up(p, l, QRAW, KVRAW, lds, bid, nblk);
  } else if constexpr (PH == 4) {
    ph_prep(p, l, QRAW, KVRAW, lds, bid, nblk);
#if PROBE == 41
    ph_prep(p, l, QRAW, KVRAW, lds, bid, nblk);
#elif PROBE == 43
    ph_prep<1>(p, l, QRAW, KVRAW, lds, bid, nblk);
#elif PROBE == 44
    ph_prep<2>(p, l, QRAW, KVRAW, lds, bid, nblk);
#endif
    __syncthreads();
    ph_gates_cum(p, l, lds, bid, nblk);
#if PROBE == 42
    ph_gates_cum(p, l, lds, bid, nblk);
#endif
  } else if constexpr (PH == 5) {
#if FAST_SCAN
    ph_ml_local(p, lds, bid, nblk);
    ph_gla_local(p, lds, bid, nblk);
#else
    GS_LOOP((long)NUNIT * 4160, nvb_ml_local(gi, p));
    GS_LOOP((long)NUNIT * 2048, nvb_gla_local(gi, p));
#endif
  } else if constexpr (PH == 6) {
#if FAST_SCAN
    ph_ml_scan(p, bid, nblk);
    ph_gla_scan(p, (bid + nblk - 260 % nblk) % nblk, nblk);
#else
    GS_LOOP((long)NB * 2 * 4 * 4160, nvb_ml_scan(gi, p));
    GS_LOOP((long)NB * 2 * 4 * 2048, nvb_gla_scan(gi, p));
#endif
    ph_attn(p, l, need_ctx, lds, bid, nblk);
#if PROBE >= 10 && PROBE < 20
    if (l == 0) ph_attn_mla_probe<PROBE - 10>(p, lds, bid, nblk);
#elif PROBE == 1
    ph_attn_diff(p, l, need_ctx, lds, bid, nblk);
#elif PROBE == 2
    ph_attn_mla(p, need_ctx, lds, bid, nblk);
#endif
  } else if constexpr (PH == 7) {
#if FAST_SCAN
    ph_ml_out(p, l, need_ctx, lds, bid, nblk);
    ph_gla_out(p, l, need_ctx, lds, bid, nblk);
#else
    GS_LOOP((long)NUNIT * 4096, nvb_ml_out(gi, p, need_ctx));
    GS_LOOP((long)NUNIT * 4096, nvb_gla_out(gi, p, need_ctx));
#endif
  } else if constexpr (PH == 8) {
#if !FAST_SCAN
    GS_LOOP((long)R * 4, nvb_ml_finish(gi, p, l, need_ctx));
    GS_LOOP((long)R * 4, nvb_gla_finish(gi, p, l, need_ctx));
#endif
  } else if constexpr (PH == 9) {
    ph_merge(p, l, rows, lds, bid, nblk);
#if PROBE == 3
    ph_merge(p, l, rows, lds, bid, nblk);
#endif
  } else if constexpr (PH == 10) {
    ph_gemm_plain(p.MG, D, p.Wt_out + l * WSZ_OUT, D, rows, D, D, p.YO, D, lds, bid, nblk);
  } else if constexpr (PH == 11) {
    ph_resid_mix(p, l, xl_in, xc_in, rows, lds, bid, nblk);
  } else if constexpr (PH == 12) {
    ph_topk(p, need_ctx, lds, bid, nblk);
    ph_wt(p.w_e_gate + (size_t)l * NE * D * FF, p.Wt_eg, D, FF, FF, NE, (long)D * FF, (long)FF * D, nullptr, lds, bid, nblk);
    ph_wt(p.w_e_up + (size_t)l * NE * D * FF, p.Wt_eu, D, FF, FF, NE, (long)D * FF, (long)FF * D, nullptr, lds, bid, nblk);
    ph_wt(p.w_e_down + (size_t)l * NE * FF * D, p.Wt_ed, FF, D, D, NE, (long)FF * D, (long)D * FF, nullptr, lds, bid, nblk);
  } else if constexpr (PH == 13) {
    ph_moe1(p, need_ctx, lds, bid, nblk);
#if PROBE == 4
    ph_moe1(p, need_ctx, lds, bid, nblk);
#endif
  } else if constexpr (PH == 14) {
    ph_moe2(p, need_ctx, lds, bid, nblk);
#if PROBE == 4
    ph_moe2(p, need_ctx, lds, bid, nblk);
#endif
  } else if constexpr (PH == 15) {
    ph_resid_ffn(p, l, rows, bid, nblk);
  }
}

template <int PH> __global__ void __launch_bounds__(256, 2) k_phase(Params p, int l) {
  DYN_LDS(lds);
  run_phase<PH>(p, l, lds, blockIdx.x, gridDim.x);
}

#if !defined(CPU_EMU) && !MK_MULTI
typedef const Params __attribute__((address_space(4)))* KParams;
DI KParams kp_fresh() { KParams k = (KParams)__builtin_amdgcn_kernarg_segment_ptr(); asm volatile("" : "+s"(k)); return k; }
#define PHASE(PH, L) do { asm volatile("; PHASE_MARK " #PH); KParams k_ = kp_fresh(); run_phase<PH>(*(const Params*)k_, (L), lds, bid, nblk); if (PROBE == 20 + PH || ((PROBE_MASK >> PH) & 1) || (PROBE == 100 + PH && (L) == 0) || (PROBE == 99 && (PH == 4 || PH == 5))) { __syncthreads(); run_phase<PH>(*(const Params*)k_, (L), lds, bid, nblk); } XcdBarrier b_ = bar; asm volatile("" : "+s"(b_.bar), "+s"(b_.x)); xcd_barrier(b_); if (PROBE == 50) xcd_barrier(b_); } while (0)
__global__ void __launch_bounds__(256, 2) k_mega(Params pv) {
  DYN_LDS(lds_all);
  if (threadIdx.x == 0) *(uint4*)lds_all = make_uint4(0u, 0u, 0u, 0u);
  __syncthreads();
  XcdBarrier bar = xcd_barrier_post(pv.bar, (volatile LAS unsigned*)lds_all);
  char* lds = lds_all + 256;
  const int bid = blockIdx.x, nblk = gridDim.x;
  PHASE(0, 0);
#pragma unroll 1
  for (int l = 0; l < 2; ++l) {
    if (l == 0) PHASE(1, l);
    PHASE(2, l); PHASE(3, l); PHASE(4, l); PHASE(5, l); PHASE(6, l); PHASE(7, l);
#if !FAST_SCAN
    PHASE(8, l);
#endif

    PHASE(9, l); PHASE(10, l); PHASE(11, l); PHASE(12, l); PHASE(13, l); PHASE(14, l); PHASE(15, l);
  }
}
#endif
#ifdef CPU_EMU
void emu_check(const Params& p, int layer, int stage);
#define EMU_CHECK(stg) emu_check(p, l, stg)
static int g_nlayers = getenv("NLAYERS") ? atoi(getenv("NLAYERS")) : 2;
#else
#define EMU_CHECK(stg)
#endif
static void fill_params(Params& p, void* const* d_in, void* d_out, void* d_ws) {
  const float** f = (const float**)&p;
  for (int i = 0; i < 33; ++i) f[i] = (const float*)d_in[i];
  p.out = (float*)d_out;
  map_workspace(p, (char*)d_ws);
}
#define LAUNCH_PHASE(PH, L) LAUNCH((k_phase<PH>), grid, 256, MEGA_LDS, stream, p, L)

extern "C" void kernel_launch(void* const* d_in, const int* in_sizes, int n_in, void* d_out, int out_size, void* d_ws,
                              size_t ws_size, hipStream_t stream) {
  Params p{};
  fill_params(p, d_in, d_out, d_ws);
  if (p.ws_need > ws_size) return;
#ifdef CPU_EMU
  const int grid = 16;
  LAUNCH_PHASE(0, 0);
  for (int l = 0; l < g_nlayers; ++l) {
    if (l == 0) LAUNCH_PHASE(1, l);
    LAUNCH_PHASE(2, l); LAUNCH_PHASE(3, l); LAUNCH_PHASE(4, l); LAUNCH_PHASE(5, l); LAUNCH_PHASE(6, l); LAUNCH_PHASE(7, l); LAUNCH_PHASE(8, l);
    EMU_CHECK(1);
    LAUNCH_PHASE(9, l); LAUNCH_PHASE(10, l); LAUNCH_PHASE(11, l);
    EMU_CHECK(2);
    LAUNCH_PHASE(12, l); LAUNCH_PHASE(13, l); LAUNCH_PHASE(14, l); LAUNCH_PHASE(15, l);
    EMU_CHECK(3);
  }
#else
  static int grid = 0;
  if (grid == 0) {
    int dev = 0, cus = 0, per_cu = 0;
    (void)hipGetDevice(&dev);
    (void)hipDeviceGetAttribute(&cus, hipDeviceAttributeMultiprocessorCount, dev);
#if MK_MULTI
    (void)hipFuncSetAttribute((const void*)k_phase<0>, hipFuncAttributeMaxDynamicSharedMemorySize, MEGA_LDS);
    (void)hipFuncSetAttribute((const void*)k_phase<1>, hipFuncAttributeMaxDynamicSharedMemorySize, MEGA_LDS);
    (void)hipFuncSetAttribute((const void*)k_phase<2>, hipFuncAttributeMaxDynamicSharedMemorySize, MEGA_LDS);
    (void)hipFuncSetAttribute((const void*)k_phase<3>, hipFuncAttributeMaxDynamicSharedMemorySize, MEGA_LDS);
    (void)hipFuncSetAttribute((const void*)k_phase<4>, hipFuncAttributeMaxDynamicSharedMemorySize, MEGA_LDS);
    (void)hipFuncSetAttribute((const void*)k_phase<5>, hipFuncAttributeMaxDynamicSharedMemorySize, MEGA_LDS);
    (void)hipFuncSetAttribute((const void*)k_phase<6>, hipFuncAttributeMaxDynamicSharedMemorySize, MEGA_LDS);
    (void)hipFuncSetAttribute((const void*)k_phase<7>, hipFuncAttributeMaxDynamicSharedMemorySize, MEGA_LDS);
    (void)hipFuncSetAttribute((const void*)k_phase<8>, hipFuncAttributeMaxDynamicSharedMemorySize, MEGA_LDS);
    (void)hipFuncSetAttribute((const void*)k_phase<9>, hipFuncAttributeMaxDynamicSharedMemorySize, MEGA_LDS);
    (void)hipFuncSetAttribute((const void*)k_phase<10>, hipFuncAttributeMaxDynamicSharedMemorySize, MEGA_LDS);
    (void)hipFuncSetAttribute((const void*)k_phase<11>, hipFuncAttributeMaxDynamicSharedMemorySize, MEGA_LDS);
    (void)hipFuncSetAttribute((const void*)k_phase<12>, hipFuncAttributeMaxDynamicSharedMemorySize, MEGA_LDS);
    (void)hipFuncSetAttribute((const void*)k_phase<13>, hipFuncAttributeMaxDynamicSharedMemorySize, MEGA_LDS);
    (void)hipFuncSetAttribute((const void*)k_phase<14>, hipFuncAttributeMaxDynamicSharedMemorySize, MEGA_LDS);
    (void)hipFuncSetAttribute((const void*)k_phase<15>, hipFuncAttributeMaxDynamicSharedMemorySize, MEGA_LDS);
    grid = (cus > 0 ? cus : 256) * 2;
#else
    if (hipFuncSetAttribute((const void*)k_mega, hipFuncAttributeMaxDynamicSharedMemorySize, MEGA_LDS + 256) != hipSuccess) { grid = -1; return; }
    if (hipOccupancyMaxActiveBlocksPerMultiprocessor(&per_cu, (const void*)k_mega, 256, MEGA_LDS + 256) != hipSuccess) per_cu = 0;
    (void)hipGetLastError();
    if (per_cu < 1) { grid = -1; return; }
    grid = (cus > 0 ? cus : 256) * (per_cu < 2 ? per_cu : 2);
#endif
  }
  if (grid < 0) return;
#if MK_MULTI
  LAUNCH_PHASE(0, 0);
  for (int l = 0; l < 2; ++l) {
    if (l == 0) LAUNCH_PHASE(1, l);
    LAUNCH_PHASE(2, l); LAUNCH_PHASE(3, l); LAUNCH_PHASE(4, l); LAUNCH_PHASE(5, l); LAUNCH_PHASE(6, l); LAUNCH_PHASE(7, l); LAUNCH_PHASE(8, l);
    LAUNCH_PHASE(9, l); LAUNCH_PHASE(10, l); LAUNCH_PHASE(11, l); LAUNCH_PHASE(12, l); LAUNCH_PHASE(13, l); LAUNCH_PHASE(14, l); LAUNCH_PHASE(15, l);
  }
#else
  (void)hipMemsetAsync(p.bar, 0, XCD_BAR_WORDS * sizeof(unsigned), stream);
  k_mega<<<dim3(grid), dim3(256), MEGA_LDS + 256, stream>>>(p);
#endif
#endif
}
```

```cpp
#ifndef CPU_EMU
#include <hip/hip_runtime.h>
#endif
#include <stdint.h>
#include <stddef.h>

#ifndef T_LAT
#define T_LAT 16384
#endif
#ifndef T_CTX
#define T_CTX 256
#endif

#ifndef MK_MULTI
#define MK_MULTI 0
#endif
#define DI __device__ __forceinline__
typedef unsigned short bf16_t;
typedef short bf16x8 __attribute__((ext_vector_type(8)));
typedef short s16x4 __attribute__((ext_vector_type(4)));
typedef float f32x4 __attribute__((ext_vector_type(4)));
typedef float f32x16 __attribute__((ext_vector_type(16)));
typedef unsigned u32x4 __attribute__((ext_vector_type(4)));
typedef unsigned u32x2 __attribute__((ext_vector_type(2)));
typedef float f32x2 __attribute__((ext_vector_type(2)));

#ifdef CPU_EMU
static inline float u2f(unsigned u) { float f; memcpy(&f, &u, 4); return f; }
static inline unsigned f2u(float f) { unsigned u; memcpy(&u, &f, 4); return u; }
#define MFMA32(a, b, c) emu_mfma_32x32x16((a), (b), (c))
#define MFMA16(a, b, c) emu_mfma_16x16x32((a), (b), (c))
static inline float fast_exp2(float x) { return exp2f(x); }
static inline float fast_rcp(float x) { return 1.0f / x; }
static inline float fast_rsq(float x) { return 1.0f / sqrtf(x); }
static inline float hw_sin_rev(float x) { return sinf(6.283185307179586f * x); }
static inline float hw_cos_rev(float x) { return cosf(6.283185307179586f * x); }
#define LAUNCH(kern, grid, block, lds, stream, ...) emu::launch(dim3(grid), dim3(block), (size_t)(lds), [=]() { kern(__VA_ARGS__); })
#define DYN_LDS(name) char* name = emu_dynlds()
#define SCHED_BARRIER()
#define TIDX ((int)threadIdx.x)
#define WAVE_SYNC() emu::wave_barrier()
#define SETPRIO(x)
#define IGLP_OPT()
template <int M> static inline float xor_sum(float v) { return v + __shfl_xor(v, M); }
template <int M> static inline float xor_max(float v) { return fmaxf(v, __shfl_xor(v, M)); }
template <int M> static inline int xor_sum_i(int v) { return v + __shfl_xor(v, M); }
static inline int lane_bcast(int v, int src) { return __shfl(v, src); }
static inline float lane_get(float v, int src) { return __shfl(v, src); }
static inline int lane_up(int v, int d, int lane) { (void)lane; return __shfl_up(v, d); }
#else
DI float u2f(unsigned u) { return __uint_as_float(u); }
DI unsigned f2u(float f) { return __float_as_uint(f); }
#define MFMA32(a, b, c) __builtin_amdgcn_mfma_f32_32x32x16_bf16((a), (b), (c), 0, 0, 0)
#define MFMA16(a, b, c) __builtin_amdgcn_mfma_f32_16x16x32_bf16((a), (b), (c), 0, 0, 0)
DI float fast_exp2(float x) { return __builtin_amdgcn_exp2f(x); }
DI float fast_rcp(float x) { return __builtin_amdgcn_rcpf(x); }
DI float fast_rsq(float x) { return __builtin_amdgcn_rsqf(x); }
DI float hw_sin_rev(float x) { return __builtin_amdgcn_sinf(x); }
DI float hw_cos_rev(float x) { return __builtin_amdgcn_cosf(x); }
#define LAUNCH(kern, grid, block, lds, stream, ...) kern<<<dim3(grid), dim3(block), (lds), (stream)>>>(__VA_ARGS__)
#define DYN_LDS(name) extern __shared__ __attribute__((aligned(16))) char name[]
#define SCHED_BARRIER() __builtin_amdgcn_sched_barrier(0)
DI int tid_fresh() { int t = (int)threadIdx.x; asm volatile("" : "+v"(t)); return t; }
#define TIDX tid_fresh()
#define WAVE_SYNC() __builtin_amdgcn_wave_barrier()
#define SETPRIO(x) __builtin_amdgcn_s_setprio(x)
#define IGLP_OPT() __builtin_amdgcn_iglp_opt(0)
#ifdef USE_SHFL
template <int M> DI float xor_sum(float v) { return v + __shfl_xor(v, M); }
template <int M> DI float xor_max(float v) { return fmaxf(v, __shfl_xor(v, M)); }
template <int M> DI int xor_sum_i(int v) { return v + __shfl_xor(v, M); }
DI int lane_bcast(int v, int src) { return __shfl(v, src); }
DI int lane_up(int v, int d, int lane) { (void)lane; return __shfl_up(v, d); }
#else
template <int M> DI int xor_partner_bits(int bits) { return __builtin_amdgcn_ds_swizzle(bits, (M << 10) | 0x1f); }
DI void half_swap(unsigned& a, unsigned& b) { asm volatile("s_nop 1\n\tv_permlane32_swap_b32 %0, %1\n\ts_nop 1" : "+v"(a), "+v"(b)); }
template <int M> DI float xor_sum(float v) {
  if constexpr (M < 32) return v + __builtin_bit_cast(float, xor_partner_bits<M>(__builtin_bit_cast(int, v)));
  else { unsigned a = __builtin_bit_cast(unsigned, v), b = a; half_swap(a, b); return __builtin_bit_cast(float, a) + __builtin_bit_cast(float, b); }
}
template <int M> DI float xor_max(float v) {
  if constexpr (M < 32) return fmaxf(v, __builtin_bit_cast(float, xor_partner_bits<M>(__builtin_bit_cast(int, v))));
  else { unsigned a = __builtin_bit_cast(unsigned, v), b = a; half_swap(a, b); return fmaxf(__builtin_bit_cast(float, a), __builtin_bit_cast(float, b)); }
}
template <int M> DI int xor_sum_i(int v) {
  if constexpr (M < 32) return v + xor_partner_bits<M>(v);
  else { unsigned a = (unsigned)v, b = a; half_swap(a, b); return (int)(a + b); }
}
DI int lane_bcast(int v, int src) { return __builtin_amdgcn_readlane(v, src); }
DI float lane_get(float v, int src) { return __builtin_bit_cast(float, __builtin_amdgcn_ds_bpermute(src << 2, __builtin_bit_cast(int, v))); }
DI int lane_up(int v, int d, int lane) { return __builtin_amdgcn_ds_bpermute(((lane - d) & 63) << 2, v); }
#endif
#endif

DI float bf2f(bf16_t v) { return u2f(((unsigned)v) << 16); }
#ifdef CPU_EMU
DI bf16_t f2bf(float f) { unsigned u = f2u(f); u += 0x7fffu + ((u >> 16) & 1u); return (bf16_t)(u >> 16); }
DI unsigned pack2bf(float lo, float hi) { return (unsigned)f2bf(lo) | ((unsigned)f2bf(hi) << 16); }
static inline unsigned wave_ballot16(bool pr) { unsigned m = 0; for (int e = 0; e < 16; ++e) m |= (__shfl(pr ? 1 : 0, e) ? 1u : 0u) << e; return m; }
static inline bool wave_any(bool pr) { int v = pr ? 1 : 0; v |= __shfl_xor(v, 1); v |= __shfl_xor(v, 2); v |= __shfl_xor(v, 4); v |= __shfl_xor(v, 8); v |= __shfl_xor(v, 16); v |= __shfl_xor(v, 32); return v != 0; }
#else
typedef float f32x2_ __attribute__((ext_vector_type(2)));
typedef __bf16 bf16x2_hw __attribute__((ext_vector_type(2)));
DI unsigned pack2bf(float lo, float hi) { const f32x2_ v = {lo, hi}; return __builtin_bit_cast(unsigned, __builtin_convertvector(v, bf16x2_hw)); }
DI bf16_t f2bf(float f) { return (bf16_t)(pack2bf(f, f) & 0xffffu); }
DI bool wave_any(bool pr) { return __builtin_amdgcn_ballot_w64(pr) != 0ull; }
DI unsigned wave_ballot16(bool pr) { return (unsigned)__builtin_amdgcn_ballot_w64(pr) & 0xffffu; }
#endif
DI float sigmoidf_(float x) { return 1.0f / (1.0f + expf(-x)); }
DI float siluf_(float x) { return x / (1.0f + expf(-x)); }
DI float logsigmoidf_(float x) { return fminf(x, 0.0f) - log1pf(expf(-fabsf(x))); }

constexpr int D = 1024, NB = 2, TL = T_LAT, TC = T_CTX, TK = TL + TC;
constexpr int RL = NB * TL, RC = NB * TC, R = RL + RC;
constexpr int NZ = 3024, NZP = 3072;
constexpr int ZC_QLAT = 0, ZC_KVLAT = 256, ZC_KROPE = 384, ZC_MLQK = 416, ZC_MLV = 928, ZC_MLO = 1184, ZC_MLIG = 1440,
              ZC_MLFG = 1448, ZC_GQ = 1456, ZC_GK = 1584, ZC_GV = 1712, ZC_GR = 1968, ZC_GA = 2224, ZC_DQ = 2256,
              ZC_DK = 2512, ZC_DV = 2768;
constexpr int NCK = TK / 64, NCC = TC / 64, NCL = TL / 64;
constexpr int NE = 16, FF = 1408, CAPL = 2 * TL / 16, CAPC = 2 * TC / 16, CAPT = CAPL + CAPC, NSLOT = NB * CAPT;
constexpr size_t WSZ_IN = (size_t)NZP * D, WSZ_UQ = 384 * 256, WSZ_UKV = 512 * 128, WSZ_GATE = (size_t)4096 * D, WSZ_BR = (size_t)4 * D * 256, WSZ_OUT = (size_t)D * D;
constexpr int NUNIT = NB * 2 * NCK * 4;
constexpr float LOG2E = 1.4426950408889634f;
constexpr float QS_MLA = 0.10206207261596577f * LOG2E;
constexpr float QS_DIFF = 0.17677669529663687f * LOG2E;

DI int row_of(int b, int s) { return s < TC ? RL + b * TC + s : b * TL + (s - TC); }
DI void bs_of(int r, int& b, int& s) { if (r < RL) { b = r / TL; s = TC + (r % TL); } else { int q = r - RL; b = q / TC; s = q % TC; } }
DI int seq_of(int d, int p) { return d == 0 ? p : (p < TC ? TC - 1 - p : TK - 1 - (p - TC)); }
DI int step_of(int d, int c) { return d == 0 ? c : (c < NCC ? NCC - 1 - c : NCC + (NCK - 1 - c)); }

struct Params {
  const float *x, *c, *ctx, *c_ctx, *w_ada, *b_ada, *g_mix_pre, *g_mix_post, *g_ffn_pre, *g_ffn_post, *w_in, *g_q_lat, *w_uq,
      *g_kv_lat, *w_ukv, *w_conv, *b_conv, *b_igate, *b_fgate, *g_mlstm_out, *w_alpha2, *b_alpha, *g_gla_out, *diff_lambda,
      *g_diff_out, *w_branch, *w_gate, *b_gate, *w_out, *w_router, *w_e_gate, *w_e_up, *w_e_down;
  float* out;
  float *mods, *xc;
  bf16_t *H, *Z, *Qm, *Km, *Vtm, *Qd, *Kd, *Vtd, *MQ, *MK, *Y, *MG, *YO, *HID, *YE, *MVt, *GVt;
  float *BC, *IGS, *GC, *MC, *MN, *MM, *GS, *HD, *OD, *AFF, *SELV;
  int *SEL, *INV;
  bf16_t *Wt_in, *Wt_uq, *Wt_ukv, *Wt_gate, *Wt_branch, *Wt_out, *Wt_eg, *Wt_eu, *Wt_ed;
  unsigned* bar;
  size_t ws_need;
};

static inline size_t al256(size_t x) { return (x + 255) & ~(size_t)255; }
static inline void map_workspace(Params& p, char* ws) {
  size_t o = 0;
  auto take = [&](size_t bytes) { size_t r = o; o += al256(bytes); return ws + r; };
  p.bar = (unsigned*)take(16384);
  p.mods = (float*)take((size_t)2 * 3 * 6144 * 4);
  p.xc = (float*)take((size_t)RC * D * 4);
  p.BC = (float*)take((size_t)NB * 2 * TK * 4 * 4);
  p.IGS = (float*)take((size_t)NB * 2 * TK * 4 * 4);
  p.AFF = (float*)take((size_t)NB * NE * TK * 4);
  p.SEL = (int*)take((size_t)NE * NSLOT * 4);
  p.SELV = (float*)take((size_t)NE * NSLOT * 4);
  p.INV = (int*)take((size_t)R * NE * 4);
  p.MM = (float*)take((size_t)NUNIT * 4 * 4);
  p.MN = (float*)take((size_t)NUNIT * 64 * 4);
  p.Wt_in = (bf16_t*)take((size_t)2 * WSZ_IN * 2);
  p.Wt_uq = (bf16_t*)take((size_t)2 * WSZ_UQ * 2);
  p.Wt_ukv = (bf16_t*)take((size_t)2 * WSZ_UKV * 2);
  p.Wt_gate = (bf16_t*)take((size_t)2 * WSZ_GATE * 2);
  p.Wt_branch = (bf16_t*)take((size_t)2 * WSZ_BR * 2);
  p.Wt_out = (bf16_t*)take((size_t)2 * WSZ_OUT * 2);
  p.H = (bf16_t*)take((size_t)R * D * 2);
  size_t szA = (size_t)R * NZP * 2, szHID = (size_t)NE * NSLOT * FF * 2;
  char* A = take(szA > szHID ? szA : szHID);
  p.Z = (bf16_t*)A; p.HID = (bf16_t*)A;
  size_t szQm = al256((size_t)NB * 4 * TK * 96 * 2), szVt = al256((size_t)NB * 4 * 64 * TK * 2), szQd = al256((size_t)NB * 8 * TK * 32 * 2);
  size_t szB1 = 2 * szQm + 2 * szVt + 2 * szQd;
  size_t szHD = al256((size_t)2 * NB * TK * 256 * 4);
  size_t szYE = (size_t)NE * NSLOT * D * 2;
  size_t szB = szB1; if (2 * szHD > szB) szB = 2 * szHD; if (szYE > szB) szB = szYE;
  char* Bq = take(szB);
  p.Qm = (bf16_t*)Bq; p.Km = (bf16_t*)(Bq + szQm); p.Vtm = (bf16_t*)(Bq + 2 * szQm);
  p.Qd = (bf16_t*)(Bq + 2 * szQm + szVt); p.Kd = (bf16_t*)(Bq + 2 * szQm + szVt + szQd); p.Vtd = (bf16_t*)(Bq + 2 * szQm + szVt + 2 * szQd);
  p.YE = (bf16_t*)Bq;
  p.GC = (float*)take((size_t)NB * 2 * TK * 128 * 4);
  p.MVt = (bf16_t*)take((size_t)NB * 4 * 64 * TK * 2);
  p.GVt = (bf16_t*)take((size_t)NB * 4 * 64 * TK * 2);
  size_t szW = (size_t)NE * FF * D * 2;
  size_t szMC = (size_t)NUNIT * 4096 * 4, szRD = (size_t)R * D * 2;
  size_t szC = szMC; if (szRD > szC) szC = szRD; if (szW > szC) szC = szW;
  char* C = take(szC);
  p.MC = (float*)C; p.MG = (bf16_t*)C; p.Wt_eg = (bf16_t*)C;
  size_t szMQ = al256((size_t)NB * TK * 256 * 2), szGS = (size_t)NUNIT * 2048 * 4;
  size_t szD = 2 * szMQ + szGS; if (szW > szD) szD = szW;
  char* Dq = take(szD);
  p.MQ = (bf16_t*)Dq; p.MK = (bf16_t*)(Dq + szMQ); p.GS = (float*)(Dq + 2 * szMQ); p.Wt_eu = (bf16_t*)Dq;
  size_t szF = 2 * szRD > szW ? 2 * szRD : szW;
  char* F = take(szF);
  p.Y = (bf16_t*)F; p.YO = (bf16_t*)(F + szRD); p.Wt_ed = (bf16_t*)F;
  p.HD = (float*)Bq; p.OD = (float*)(Bq + szHD);
  p.ws_need = o;
}
#define GTID ((long)blockIdx.x * blockDim.x + threadIdx.x)

DI float lam_of(const Params& p, int layer, float& lam_init) {
  const float* lv = p.diff_lambda + layer * 128;
  float s1 = 0.f, s2 = 0.f;
  for (int i = 0; i < 32; ++i) { s1 += lv[i] * lv[32 + i]; s2 += lv[64 + i] * lv[96 + i]; }
  lam_init = layer == 0 ? 0.2f : 0.35550906759096f;
  return expf(s1) - expf(s2) + lam_init;
}
DI void rope_cs(int s, int jj, float& cs, float& sn) {
  int t = s - TC;
  int pos = (jj < 16) ? (t / 64) : (t % 64);
  float ang = (float)pos * exp2f(-1.6609640474436813f * (float)(jj & 7));
  double rev = (double)ang * 0.15915494309189535;
  rev -= floor(rev + 0.5);
  float rf = (float)rev;
  cs = hw_cos_rev(rf); sn = hw_sin_rev(rf);
}
template <class G> DI float rope_elem(G get, int s, int jj) {
  if (s < TC) return get(jj);
  float cs, sn; rope_cs(s, jj, cs, sn);
  float a = get(jj), b = get(jj ^ 8);
  return (jj & 8) ? (a * cs + b * sn) : (a * cs - b * sn);
}

DI void nvb_mods(long GI, const Params& p) {
  long i = GI; if (i >= 2 * 3 * 6144) return;
  int col = (int)(i % 6144), w = (int)((i / 6144) % 3), l = (int)(i / (3 * 6144));
  const float* cv = w < 2 ? p.c + w * 1024 : p.c_ctx;
  const float* W = p.w_ada + (size_t)l * 1024 * 6144;
  float acc = 0.f;
  for (int k = 0; k < 1024; ++k) acc += siluf_(cv[k]) * W[(size_t)k * 6144 + col];
  p.mods[i] = acc + p.b_ada[l * 6144 + col];
}
__global__ void __launch_bounds__(256) nv_wt(const float* in, bf16_t* out, int K, int N, int NP, long in_bs, long out_bs, const float* gain) {
  long i = GTID; if (i >= (long)NP * K) return;
  int k = (int)(i % K), n = (int)(i / K);
  const float* I = in + (size_t)blockIdx.y * in_bs; bf16_t* O = out + (size_t)blockIdx.y * out_bs;
  O[(size_t)n * K + k] = n < N ? f2bf(I[(size_t)k * N + n] * (gain ? gain[k] : 1.0f)) : (bf16_t)0;
}
__global__ void __launch_bounds__(256) nv_modulate(Params p, int layer, int which, const float* xl, const float* xcx, int nrows) {
  long r = GTID; if (r >= nrows) return;
  int w = r < RL ? (int)(r / TL) : 2;
  const float* mb = p.mods + (size_t)(layer * 3 + w) * 6144;
  const float* shift = mb + (which ? 3 : 0) * 1024; const float* scale = mb + (which ? 4 : 1) * 1024;
  const float* g = (which ? p.g_ffn_pre : p.g_mix_pre) + layer * 1024;
  const float* x = r < RL ? xl + (size_t)r * D : xcx + (size_t)(r - RL) * D;
  float ss = 0.f; for (int k = 0; k < D; ++k) ss += x[k] * x[k];
  float rstd = 1.0f / sqrtf(ss / D + 1e-6f);
  for (int k = 0; k < D; ++k) p.H[(size_t)r * D + k] = f2bf(x[k] * rstd * g[k] * (1.f + scale[k]) + shift[k]);
}
__global__ void __launch_bounds__(256) nv_gemm(const bf16_t* A, int lda, const bf16_t* Bt, int ldb, int M, int N, int K, bf16_t* C, int ldc) {
  long i = GTID; if (i >= (long)M * N) return;
  int n = (int)(i % N), m = (int)(i / N);
  const bf16_t* a = A + (size_t)m * lda; const bf16_t* b = Bt + (size_t)n * ldb;
  float acc = 0.f;
  for (int k = 0; k < K; ++k) acc += bf2f(a[k]) * bf2f(b[k]);
  C[(size_t)m * ldc + n] = f2bf(acc);
}
__global__ void __launch_bounds__(256) nv_mla_q(Params p, int layer) {
  long i = GTID; if (i >= (long)R * 4 * 96) return;
  int j = (int)(i % 96), h = (int)((i / 96) % 4), r = (int)(i / 384);
  int b, s; bs_of(r, b, s);
  const bf16_t* z = p.Z + (size_t)r * NZP + ZC_QLAT;
  const float* g = p.g_q_lat + layer * 256; const float* W = p.w_uq + (size_t)layer * 256 * 384;
  float ss = 0.f; for (int k = 0; k < 256; ++k) { float v = bf2f(z[k]); ss += v * v; }
  float rstd = 1.0f / sqrtf(ss / 256 + 1e-6f);
  auto dot = [&](int col) { float a = 0.f; for (int k = 0; k < 256; ++k) a += bf2f(z[k]) * rstd * g[k] * W[(size_t)k * 384 + col]; return a; };
  float v;
  if (j < 64) v = dot(h * 96 + j);
  else v = rope_elem([&](int jj) { return dot(h * 96 + 64 + jj); }, s, j - 64);
  p.Qm[(((size_t)b * 4 + h) * TK + s) * 96 + j] = f2bf(v * QS_MLA);
}
__global__ void __launch_bounds__(256) nv_mla_kv(Params p, int layer) {
  long i = GTID; if (i >= (long)R * 4 * 160) return;
  int j = (int)(i % 160), h = (int)((i / 160) % 4), r = (int)(i / 640);
  int b, s; bs_of(r, b, s);
  const bf16_t* z = p.Z + (size_t)r * NZP;
  if (j < 128) {
    const bf16_t* zl = z + ZC_KVLAT; const float* g = p.g_kv_lat + layer * 128; const float* W = p.w_ukv + (size_t)layer * 128 * 512;
    float ss = 0.f; for (int k = 0; k < 128; ++k) { float v = bf2f(zl[k]); ss += v * v; }
    float rstd = 1.0f / sqrtf(ss / 128 + 1e-6f);
    float a = 0.f; for (int k = 0; k < 128; ++k) a += bf2f(zl[k]) * rstd * g[k] * W[(size_t)k * 512 + h * 128 + j];
    if (j < 64) p.Km[(((size_t)b * 4 + h) * TK + s) * 96 + j] = f2bf(a);
    else p.Vtm[(((size_t)b * 4 + h) * 64 + (j - 64)) * TK + s] = f2bf(a);
  } else {
    int jj = j - 128;
    float v = rope_elem([&](int q) { return bf2f(z[ZC_KROPE + q]); }, s, jj);
    p.Km[(((size_t)b * 4 + h) * TK + s) * 96 + 64 + jj] = f2bf(v);
  }
}
__global__ void __launch_bounds__(256) nv_diff_prep(Params p) {
  long i = GTID; if (i >= (long)R * 768) return;
  int c = (int)(i % 768), r = (int)(i / 768);
  int b, s; bs_of(r, b, s);
  const bf16_t* z = p.Z + (size_t)r * NZP;
  if (c < 512) {
    int qk = c / 256, cc = c % 256, hm = cc / 32, jj = cc % 32;
    const bf16_t* src = z + (qk ? ZC_DK : ZC_DQ) + hm * 32;
    float v = rope_elem([&](int q) { return bf2f(src[q]); }, s, jj);
    if (qk == 0) p.Qd[(((size_t)b * 8 + hm) * TK + s) * 32 + jj] = f2bf(v * QS_DIFF);
    else p.Kd[(((size_t)b * 8 + hm) * TK + s) * 32 + jj] = f2bf(v);
  } else {
    int cc = c - 512, h = cc / 64, dv = cc % 64;
    p.Vtd[(((size_t)b * 4 + h) * 64 + dv) * TK + s] = z[ZC_DV + cc];
  }
}
__global__ void __launch_bounds__(256) nv_ml_prep(Params p, int layer) {
  long i = GTID; if (i >= (long)R * 512) return;
  int ch = (int)(i % 512), r = (int)(i / 512);
  int b, s; bs_of(r, b, s);
  bool first = (s == 0) || (s == TC), last = (s == TC - 1) || (s == TK - 1);
  const float* w = p.w_conv + (size_t)layer * 3 * 512;
  float acc = p.b_conv[layer * 512 + ch];
  acc += bf2f(p.Z[(size_t)r * NZP + ZC_MLQK + ch]) * w[512 + ch];
  if (!first) acc += bf2f(p.Z[(size_t)row_of(b, s - 1) * NZP + ZC_MLQK + ch]) * w[ch];
  if (!last) acc += bf2f(p.Z[(size_t)row_of(b, s + 1) * NZP + ZC_MLQK + ch]) * w[1024 + ch];
  float v = siluf_(acc);
  if (ch < 256) p.MQ[((size_t)b * TK + s) * 256 + ch] = f2bf(v);
  else p.MK[((size_t)b * TK + s) * 256 + ch - 256] = f2bf(v * 0.125f);
}
DI void nvb_ml_gates(long GI, const Params& p, int layer) {
  long i = GI; if (i >= (long)NB * 2 * NCK * 4) return;
  int h = (int)(i % 4), j = (int)((i / 4) % NCK), d = (int)((i / (4 * NCK)) % 2), b = (int)(i / (8 * NCK));
  float bi = p.b_igate[layer * 8 + d * 4 + h], bfg = p.b_fgate[layer * 8 + d * 4 + h];
  float cum = 0.f;
  for (int l = 0; l < 64; ++l) {
    int pp = 64 * j + l, s = seq_of(d, pp); const bf16_t* z = p.Z + (size_t)row_of(b, s) * NZP;
    float ig = bf2f(z[ZC_MLIG + d * 4 + h]) + bi;
    float lf = logsigmoidf_(bf2f(z[ZC_MLFG + d * 4 + h]) + bfg);
    cum += lf;
    size_t o = (((size_t)b * 2 + d) * TK + pp) * 4 + h;
    p.BC[o] = cum; p.IGS[o] = ig;
  }
}
DI void nvb_gla_cum(long GI, const Params& p, int layer) {
  long i = GI; if (i >= (long)NB * 2 * NCK * 128) return;
  int ch = (int)(i % 128), j = (int)((i / 128) % NCK), d = (int)((i / (128 * NCK)) % 2), b = (int)(i / (256 * NCK));
  const float* W = p.w_alpha2 + (size_t)layer * 2 * 16 * 128 + (size_t)d * 16 * 128;
  float ba = p.b_alpha[layer * 256 + d * 128 + ch];
  float cum = 0.f;
  for (int l = 0; l < 64; ++l) {
    int pp = 64 * j + l, s = seq_of(d, pp); const bf16_t* z = p.Z + (size_t)row_of(b, s) * NZP + ZC_GA + d * 16;
    float zg = ba; for (int q = 0; q < 16; ++q) zg += bf2f(z[q]) * W[q * 128 + ch];
    cum += logsigmoidf_(zg) * (1.0f / 16.0f);
    p.GC[(((size_t)b * 2 + d) * TK + pp) * 128 + ch] = cum;
  }
}
__global__ void __launch_bounds__(256) nv_attn_mla(Params p, int need_ctx) {
  long i = GTID; if (i >= (long)NB * 4 * TK) return;
  int s = (int)(i % TK), h = (int)((i / TK) % 4), b = (int)(i / (4 * TK));
  if (s < TC && !need_ctx) return;
  int nk = s < TC ? TC : TK;
  const bf16_t* q = p.Qm + (((size_t)b * 4 + h) * TK + s) * 96;
  const bf16_t* K = p.Km + ((size_t)b * 4 + h) * TK * 96;
  const bf16_t* Vt = p.Vtm + ((size_t)b * 4 + h) * 64 * TK;
  float qf[96], o[64];
  _Pragma("unroll") for (int k = 0; k < 96; ++k) qf[k] = bf2f(q[k]);
  _Pragma("unroll") for (int k = 0; k < 64; ++k) o[k] = 0.f;
  float m = -1e30f, l = 0.f;
  for (int t = 0; t < nk; ++t) {
    float sc = 0.f; _Pragma("unroll") for (int k = 0; k < 96; ++k) sc += qf[k] * bf2f(K[(size_t)t * 96 + k]);
    float mn = fmaxf(m, sc), a = exp2f(m - mn), pr = exp2f(sc - mn);
    l = l * a + pr;
    _Pragma("unroll") for (int k = 0; k < 64; ++k) o[k] = o[k] * a + pr * bf2f(Vt[(size_t)k * TK + t]);
    m = mn;
  }
  int r = row_of(b, s);
  _Pragma("unroll") for (int k = 0; k < 64; ++k) p.Y[(size_t)r * D + h * 64 + k] = f2bf(o[k] / l);
}
__global__ void __launch_bounds__(256) nv_attn_diff(Params p, int layer, int need_ctx) {
  long i = GTID; if (i >= (long)NB * 4 * TK) return;
  int s = (int)(i % TK), h = (int)((i / TK) % 4), b = (int)(i / (4 * TK));
  if (s < TC && !need_ctx) return;
  int nk = s < TC ? TC : TK;
  float lam_init; float lam = lam_of(p, layer, lam_init);
  const bf16_t* Vt = p.Vtd + ((size_t)b * 4 + h) * 64 * TK;
  float res[64];
  _Pragma("unroll") for (int k = 0; k < 64; ++k) res[k] = 0.f;
  _Pragma("unroll") for (int mp = 0; mp < 2; ++mp) {
    const bf16_t* q = p.Qd + (((size_t)b * 8 + h * 2 + mp) * TK + s) * 32;
    const bf16_t* K = p.Kd + ((size_t)b * 8 + h * 2 + mp) * TK * 32;
    float qf[32], o[64];
    _Pragma("unroll") for (int k = 0; k < 32; ++k) qf[k] = bf2f(q[k]);
    _Pragma("unroll") for (int k = 0; k < 64; ++k) o[k] = 0.f;
    float m = -1e30f, l = 0.f;
    for (int t = 0; t < nk; ++t) {
      float sc = 0.f; _Pragma("unroll") for (int k = 0; k < 32; ++k) sc += qf[k] * bf2f(K[(size_t)t * 32 + k]);
      float mn = fmaxf(m, sc), a = exp2f(m - mn), pr = exp2f(sc - mn);
      l = l * a + pr;
      _Pragma("unroll") for (int k = 0; k < 64; ++k) o[k] = o[k] * a + pr * bf2f(Vt[(size_t)k * TK + t]);
      m = mn;
    }
    float wgt = mp == 0 ? 1.f : -lam;
    _Pragma("unroll") for (int k = 0; k < 64; ++k) res[k] += wgt * o[k] / l;
  }
  float ss = 0.f; _Pragma("unroll") for (int k = 0; k < 64; ++k) ss += res[k] * res[k];
  float rstd = 1.0f / sqrtf(ss / 64 + 1e-6f);
  int r = row_of(b, s);
  _Pragma("unroll") for (int k = 0; k < 64; ++k) p.Y[(size_t)r * D + 768 + h * 64 + k] = f2bf(res[k] * rstd * p.g_diff_out[layer * 256 + h * 64 + k] * (1.f - lam_init));
}
DI void nvb_ml_local(long GI, const Params& p) {
  long i = GI; if (i >= (long)NUNIT * 4160) return;
  int e = (int)(i % 4160); long u = i / 4160;
  int h = (int)(u % 4), j = (int)((u / 4) % NCK), d = (int)((u / (4 * NCK)) % 2), b = (int)(u / (8 * NCK));
  const float* bc = p.BC + (((size_t)b * 2 + d) * TK + 64 * j) * 4 + h; const float* ig = p.IGS + (((size_t)b * 2 + d) * TK + 64 * j) * 4 + h;
  float bend = bc[63 * 4], ml = -1e30f;
  for (int l = 0; l < 64; ++l) ml = fmaxf(ml, bend - bc[l * 4] + ig[l * 4]);
  if (e == 4096 + 0) { p.MM[u * 4 + 0] = ml; p.MM[u * 4 + 1] = bend; }
  float acc = 0.f;
  if (e < 4096) {
    int v = e / 64, k = e % 64;
    for (int l = 0; l < 64; ++l) {
      int s = seq_of(d, 64 * j + l); float w = expf(bend - bc[l * 4] + ig[l * 4] - ml);
      acc += w * bf2f(p.Z[(size_t)row_of(b, s) * NZP + ZC_MLV + h * 64 + v]) * bf2f(p.MK[((size_t)b * TK + s) * 256 + h * 64 + k]);
    }
    p.MC[(size_t)u * 4096 + e] = acc;
  } else {
    int k = e - 4096;
    for (int l = 0; l < 64; ++l) {
      int s = seq_of(d, 64 * j + l); float w = expf(bend - bc[l * 4] + ig[l * 4] - ml);
      acc += w * bf2f(p.MK[((size_t)b * TK + s) * 256 + h * 64 + k]);
    }
    p.MN[(size_t)u * 64 + k] = acc;
  }
}
DI void nvb_ml_scan(long GI, const Params& p) {
  long i = GI; if (i >= (long)NB * 2 * 4 * 4160) return;
  int e = (int)(i % 4160); int ch = (int)(i / 4160); int h = ch % 4, bd = ch / 4;
  float st = 0.f, m = -1e30f;
  for (int j = 0; j < NCK; ++j) {
    size_t u = ((size_t)bd * NCK + j) * 4 + h;
    float ml = p.MM[u * 4 + 0], be = p.MM[u * 4 + 1];
    float mn = fmaxf(be + m, ml), a = expf(be + m - mn), g = expf(ml - mn);
    float* slot = e < 4096 ? &p.MC[u * 4096 + e] : &p.MN[u * 64 + (e - 4096)];
    float loc = *slot; *slot = st; st = a * st + g * loc;
    if (e == 0) p.MM[u * 4 + 2] = m;
    m = mn;
  }
}
DI void nvb_ml_out(long GI, const Params& p, int need_ctx) {
  long i = GI; if (i >= (long)NUNIT * 4096) return;
  int v = (int)(i % 64), l = (int)((i / 64) % 64); long u = i / 4096;
  int h = (int)(u % 4), j = (int)((u / 4) % NCK), d = (int)((u / (4 * NCK)) % 2), b = (int)(u / (8 * NCK));
  if (j < NCC && !need_ctx) return;
  const float* bc = p.BC + (((size_t)b * 2 + d) * TK + 64 * j) * 4 + h; const float* ig = p.IGS + (((size_t)b * 2 + d) * TK + 64 * j) * 4 + h;
  float m0 = p.MM[u * 4 + 2];
  int sl = seq_of(d, 64 * j + l);
  const bf16_t* q = p.MQ + ((size_t)b * TK + sl) * 256 + h * 64;
  float bl = bc[l * 4];
  float inter = bl + m0, mt = inter;
  for (int t = 0; t <= l; ++t) mt = fmaxf(mt, bl - bc[t * 4] + ig[t * 4]);
  float num = 0.f, den = 0.f;
  for (int t = 0; t <= l; ++t) {
    int st = seq_of(d, 64 * j + t);
    const bf16_t* k = p.MK + ((size_t)b * TK + st) * 256 + h * 64;
    float qk = 0.f; for (int c = 0; c < 64; ++c) qk += bf2f(q[c]) * bf2f(k[c]);
    float sv = expf(bl - bc[t * 4] + ig[t * 4] - mt) * qk;
    num += sv * bf2f(p.Z[(size_t)row_of(b, st) * NZP + ZC_MLV + h * 64 + v]); den += sv;
  }
  float ai = expf(inter - mt);
  float qc = 0.f, qn = 0.f;
  for (int c = 0; c < 64; ++c) { qc += bf2f(q[c]) * p.MC[(size_t)u * 4096 + v * 64 + c]; qn += bf2f(q[c]) * p.MN[(size_t)u * 64 + c]; }
  num += ai * qc; den += ai * qn;
  p.HD[(((size_t)d * NB + b) * TK + sl) * 256 + h * 64 + v] = num / fmaxf(fabsf(den), expf(-mt));
}
DI void nvb_ml_finish(long GI, const Params& p, int layer, int need_ctx) {
  long i = GI; if (i >= (long)R * 4) return;
  int h = (int)(i % 4), r = (int)(i / 4); int b, s; bs_of(r, b, s);
  if (s < TC && !need_ctx) return;
  const float* h0 = p.HD + (((size_t)0 * NB + b) * TK + s) * 256 + h * 64; const float* h1 = p.HD + (((size_t)1 * NB + b) * TK + s) * 256 + h * 64;
  float ss = 0.f; for (int v = 0; v < 64; ++v) { float t = h0[v] + h1[v]; ss += t * t; }
  float rstd = 1.0f / sqrtf(ss / 64 + 1e-6f);
  for (int v = 0; v < 64; ++v) {
    float o = bf2f(p.Z[(size_t)r * NZP + ZC_MLO + h * 64 + v]);
    p.Y[(size_t)r * D + 256 + h * 64 + v] = f2bf(sigmoidf_(o) * (h0[v] + h1[v]) * rstd * p.g_mlstm_out[layer * 256 + h * 64 + v]);
  }
}
DI void nvb_gla_local(long GI, const Params& p) {
  long i = GI; if (i >= (long)NUNIT * 2048) return;
  int v = (int)(i % 64), k = (int)((i / 64) % 32); long u = i / 2048;
  int h = (int)(u % 4), j = (int)((u / 4) % NCK), d = (int)((u / (4 * NCK)) % 2), b = (int)(u / (8 * NCK));
  const float* gc = p.GC + (((size_t)b * 2 + d) * TK + 64 * j) * 128 + h * 32 + k;
  float ge = gc[63 * 128], acc = 0.f;
  for (int l = 0; l < 64; ++l) {
    int s = seq_of(d, 64 * j + l); const bf16_t* z = p.Z + (size_t)row_of(b, s) * NZP;
    acc += bf2f(z[ZC_GK + h * 32 + k]) * expf(ge - gc[l * 128]) * bf2f(z[ZC_GV + h * 64 + v]);
  }
  p.GS[(size_t)u * 2048 + v * 32 + k] = acc;
}
DI void nvb_gla_scan(long GI, const Params& p) {
  long i = GI; if (i >= (long)NB * 2 * 4 * 2048) return;
  int e = (int)(i % 2048); int ch = (int)(i / 2048); int h = ch % 4, bd = ch / 4; int k = e % 32;
  float st = 0.f;
  for (int j = 0; j < NCK; ++j) {
    size_t u = ((size_t)bd * NCK + j) * 4 + h;
    float ge = p.GC[((size_t)bd * TK + 64 * j + 63) * 128 + h * 32 + k];
    float loc = p.GS[u * 2048 + e]; p.GS[u * 2048 + e] = st; st = expf(ge) * st + loc;
  }
}
DI void nvb_gla_out(long GI, const Params& p, int need_ctx) {
  long i = GI; if (i >= (long)NUNIT * 4096) return;
  int v = (int)(i % 64), l = (int)((i / 64) % 64); long u = i / 4096;
  int h = (int)(u % 4), j = (int)((u / 4) % NCK), d = (int)((u / (4 * NCK)) % 2), b = (int)(u / (8 * NCK));
  if (j < NCC && !need_ctx) return;
  const float* gc = p.GC + (((size_t)b * 2 + d) * TK + 64 * j) * 128 + h * 32;
  int sl = seq_of(d, 64 * j + l);
  const bf16_t* q = p.Z + (size_t)row_of(b, sl) * NZP + ZC_GQ + h * 32;
  const float qs = 0.17677669529663687f;
  float acc = 0.f;
  for (int t = 0; t <= l; ++t) {
    int st = seq_of(d, 64 * j + t); const bf16_t* z = p.Z + (size_t)row_of(b, st) * NZP;
    float att = 0.f; for (int k = 0; k < 32; ++k) att += bf2f(q[k]) * qs * expf(gc[l * 128 + k] - gc[t * 128 + k]) * bf2f(z[ZC_GK + h * 32 + k]);
    acc += att * bf2f(z[ZC_GV + h * 64 + v]);
  }
  for (int k = 0; k < 32; ++k) acc += bf2f(q[k]) * qs * expf(gc[l * 128 + k]) * p.GS[(size_t)u * 2048 + v * 32 + k];
  p.OD[(((size_t)d * NB + b) * TK + sl) * 256 + h * 64 + v] = acc;
}
DI void nvb_gla_finish(long GI, const Params& p, int layer, int need_ctx) {
  long i = GI; if (i >= (long)R * 4) return;
  int h = (int)(i % 4), r = (int)(i / 4); int b, s; bs_of(r, b, s);
  if (s < TC && !need_ctx) return;
  const float* h0 = p.OD + (((size_t)0 * NB + b) * TK + s) * 256 + h * 64; const float* h1 = p.OD + (((size_t)1 * NB + b) * TK + s) * 256 + h * 64;
  float ss = 0.f; for (int v = 0; v < 64; ++v) { float t = h0[v] + h1[v]; ss += t * t; }
  float rstd = 1.0f / sqrtf(ss / 64 + 1e-6f);
  for (int v = 0; v < 64; ++v) {
    float rr = bf2f(p.Z[(size_t)r * NZP + ZC_GR + h * 64 + v]);
    p.Y[(size_t)r * D + 512 + h * 64 + v] = f2bf(siluf_(rr) * (h0[v] + h1[v]) * rstd * p.g_gla_out[layer * 256 + h * 64 + v]);
  }
}
__global__ void __launch_bounds__(256) nv_merge(Params p, int layer, int nrows) {
  long i = GTID; if (i >= (long)nrows * D) return;
  int j = (int)(i % D), r = (int)(i / D);
  float acc = 0.f;
  for (int n = 0; n < 4; ++n) {
    const bf16_t* wg = p.Wt_gate + (size_t)(n * 1024 + j) * D; const bf16_t* wb = p.Wt_branch + ((size_t)n * D + j) * 256;
    float g = p.b_gate[layer * 4096 + n * 1024 + j], pr = 0.f;
    for (int k = 0; k < D; ++k) g += bf2f(p.H[(size_t)r * D + k]) * bf2f(wg[k]);
    for (int k = 0; k < 256; ++k) pr += bf2f(p.Y[(size_t)r * D + n * 256 + k]) * bf2f(wb[k]);
    acc += sigmoidf_(g) * pr;
  }
  p.MG[(size_t)r * D + j] = f2bf(acc);
}
__global__ void __launch_bounds__(256) nv_resid_mix(Params p, int layer, const float* xl_in, const float* xc_in, int nrows) {
  long r = GTID; if (r >= nrows) return;
  int w = r < RL ? (int)(r / TL) : 2;
  const float* mb = p.mods + (size_t)(layer * 3 + w) * 6144;
  const float* xin = r < RL ? xl_in + (size_t)r * D : xc_in + (size_t)(r - RL) * D;
  float* xo = r < RL ? p.out + (size_t)r * D : p.xc + (size_t)(r - RL) * D;
  const bf16_t* yo = p.YO + (size_t)r * D;
  float ss = 0.f; for (int k = 0; k < D; ++k) { float v = bf2f(yo[k]); ss += v * v; }
  float rstd = 1.0f / sqrtf(ss / D + 1e-6f);
  float s2 = 0.f;
  for (int k = 0; k < D; ++k) { float xn = xin[k] + mb[2 * 1024 + k] * bf2f(yo[k]) * rstd * p.g_mix_post[layer * 1024 + k]; xo[k] = xn; s2 += xn * xn; }
  float rstd2 = 1.0f / sqrtf(s2 / D + 1e-6f);
  float lg[16]; _Pragma("unroll") for (int e = 0; e < 16; ++e) lg[e] = 0.f;
  const float* wr = p.w_router + (size_t)layer * D * 16;
  for (int k = 0; k < D; ++k) {
    float h2 = xo[k] * rstd2 * p.g_ffn_pre[layer * 1024 + k] * (1.f + mb[4 * 1024 + k]) + mb[3 * 1024 + k];
    p.H[(size_t)r * D + k] = f2bf(h2);
    _Pragma("unroll") for (int e = 0; e < 16; ++e) lg[e] += h2 * wr[k * 16 + e];
  }
  float mx = lg[0]; _Pragma("unroll") for (int e = 1; e < 16; ++e) mx = fmaxf(mx, lg[e]);
  float sm = 0.f; _Pragma("unroll") for (int e = 0; e < 16; ++e) { lg[e] = expf(lg[e] - mx); sm += lg[e]; }
  int b, s; bs_of((int)r, b, s);
  _Pragma("unroll") for (int e = 0; e < 16; ++e) p.AFF[((size_t)b * NE + e) * TK + s] = lg[e] / sm;
}
__global__ void __launch_bounds__(256) nv_topk(Params p, int need_ctx) {
  long i = GTID; if (i >= NB * NE * 2) return;
  int seg = (int)(i % 2), e = (int)((i / 2) % NE), b = (int)(i / (2 * NE));
  int s0 = seg ? TC : 0, n = seg ? TL : TC, cap = seg ? CAPL : CAPC, slot0 = seg ? b * CAPL : NB * CAPL + b * CAPC;
  if (seg == 0 && !need_ctx) { for (int q = 0; q < cap; ++q) p.SEL[(size_t)e * NSLOT + slot0 + q] = -1; return; }
  const float* a = p.AFF + ((size_t)b * NE + e) * TK + s0;
  unsigned thr = 0;
  for (int bit = 31; bit >= 0; --bit) {
    unsigned cand = thr | (1u << bit); int cnt = 0;
    for (int t = 0; t < n; ++t) cnt += (f2u(a[t]) >= cand);
    if (cnt >= cap) thr = cand;
  }
  int ngt = 0; for (int t = 0; t < n; ++t) ngt += (f2u(a[t]) > thr);
  int neq = cap - ngt, q = 0;
  for (int t = 0; t < n; ++t) {
    unsigned u = f2u(a[t]); int r = row_of(b, s0 + t); int sel = -1;
    if (u > thr) sel = q++; else if (u == thr && neq > 0) { sel = q++; --neq; }
    if (sel >= 0) { p.SEL[(size_t)e * NSLOT + slot0 + sel] = r; p.SELV[(size_t)e * NSLOT + slot0 + sel] = a[t]; }
    p.INV[(size_t)r * NE + e] = sel >= 0 ? slot0 + sel : -1;
  }
}
__global__ void __launch_bounds__(256) nv_moe1(Params p) {
  long i = GTID; if (i >= (long)NE * NSLOT * FF) return;
  int f = (int)(i % FF), slot = (int)((i / FF) % NSLOT), e = (int)(i / ((long)FF * NSLOT));
  int r = p.SEL[(size_t)e * NSLOT + slot];
  float out = 0.f;
  if (r >= 0) {
    const bf16_t* wg = p.Wt_eg + ((size_t)e * FF + f) * D; const bf16_t* wu = p.Wt_eu + ((size_t)e * FF + f) * D; const bf16_t* h = p.H + (size_t)r * D;
    float g = 0.f, u = 0.f; for (int k = 0; k < D; ++k) { float hv = bf2f(h[k]); g += hv * bf2f(wg[k]); u += hv * bf2f(wu[k]); }
    out = siluf_(g) * u;
  }
  p.HID[((size_t)e * NSLOT + slot) * FF + f] = f2bf(out);
}
__global__ void __launch_bounds__(256) nv_moe2(Params p) {
  long i = GTID; if (i >= (long)NE * NSLOT * D) return;
  int j = (int)(i % D), slot = (int)((i / D) % NSLOT), e = (int)(i / ((long)D * NSLOT));
  int r = p.SEL[(size_t)e * NSLOT + slot];
  float out = 0.f;
  if (r >= 0) {
    const bf16_t* wd = p.Wt_ed + ((size_t)e * D + j) * FF; const bf16_t* h = p.HID + ((size_t)e * NSLOT + slot) * FF;
    float a = 0.f; for (int k = 0; k < FF; ++k) a += bf2f(h[k]) * bf2f(wd[k]);
    out = a * p.SELV[(size_t)e * NSLOT + slot];
  }
  p.YE[((size_t)e * NSLOT + slot) * D + j] = f2bf(out);
}
__global__ void __launch_bounds__(256) nv_resid_ffn(Params p, int layer, int nrows) {
  long r = GTID; if (r >= nrows) return;
  int w = r < RL ? (int)(r / TL) : 2;
  const float* mb = p.mods + (size_t)(layer * 3 + w) * 6144;
  float* xo = r < RL ? p.out + (size_t)r * D : p.xc + (size_t)(r - RL) * D;
  float ss = 0.f;
  for (int k = 0; k < D; ++k) {
    float f = 0.f;
    for (int e = 0; e < NE; ++e) { int sl = p.INV[(size_t)r * NE + e]; if (sl >= 0) f += bf2f(p.YE[((size_t)e * NSLOT + sl) * D + k]); }
    ss += f * f;
  }
  float rstd = 1.0f / sqrtf(ss / D + 1e-6f);
  for (int k = 0; k < D; ++k) {
    float f = 0.f;
    for (int e = 0; e < NE; ++e) { int sl = p.INV[(size_t)r * NE + e]; if (sl >= 0) f += bf2f(p.YE[((size_t)e * NSLOT + sl) * D + k]); }
    xo[k] += mb[5 * 1024 + k] * f * rstd * p.g_ffn_post[layer * 1024 + k];
  }
}

__global__ void __launch_bounds__(256) nv_mods(Params p) { nvb_mods(GTID, p); }
__global__ void __launch_bounds__(256) nv_ml_gates(Params p, int layer) { nvb_ml_gates(GTID, p, layer); }
__global__ void __launch_bounds__(256) nv_gla_cum(Params p, int layer) { nvb_gla_cum(GTID, p, layer); }
__global__ void __launch_bounds__(256) nv_ml_local(Params p) { nvb_ml_local(GTID, p); }
__global__ void __launch_bounds__(256) nv_ml_scan(Params p) { nvb_ml_scan(GTID, p); }
__global__ void __launch_bounds__(256) nv_ml_out(Params p, int need_ctx) { nvb_ml_out(GTID, p, need_ctx); }
__global__ void __launch_bounds__(256) nv_ml_finish(Params p, int layer, int need_ctx) { nvb_ml_finish(GTID, p, layer, need_ctx); }
__global__ void __launch_bounds__(256) nv_gla_local(Params p) { nvb_gla_local(GTID, p); }
__global__ void __launch_bounds__(256) nv_gla_scan(Params p) { nvb_gla_scan(GTID, p); }
__global__ void __launch_bounds__(256) nv_gla_out(Params p, int need_ctx) { nvb_gla_out(GTID, p, need_ctx); }
__global__ void __launch_bounds__(256) nv_gla_finish(Params p, int layer, int need_ctx) { nvb_gla_finish(GTID, p, layer, need_ctx); }
constexpr int LROW = 144;
constexpr int A_BYTES = 128 * LROW;
constexpr int NTHR = 256;
#ifndef ATT_THR
#define ATT_THR 16.0f
#endif

DI int xcd_swz(int u, int nt) { return (nt & 7) ? u : (u & 7) * (nt >> 3) + (u >> 3); }
template <int GW> DI void grp_tile(int L, int ntm, int ntn, int& tm, int& tn) {
  const int gsz = ntm * GW; int g = 0;
  while (L >= gsz) { L -= gsz; ++g; }
  tm = L / GW; tn = g * GW + (L & (GW - 1)); (void)ntn;
}
DI u32x4 ldg16(const void* p) { return *(const u32x4*)p; }
DI void sts16(char* p, u32x4 v) { *(u32x4*)p = v; }
DI bf16x8 lds_frag(const char* p) { return *(const bf16x8*)p; }

template <int WN, int KFIX = 0>
DI void gemm_kloop(f32x4 (&acc)[4][WN], const bf16_t* const (&ap)[4], const bf16_t* const (&bp)[WN], int nk, char* lds) {
  constexpr int STAGE = A_BYTES + 32 * WN * LROW;
  const int t = TIDX, lane = t & 63, wid = t >> 6, wr = wid >> 1, wc = wid & 1;
  const int lr = t >> 3, lcb = (t & 7) * 16;
  const int fr = lane & 15, fq = lane >> 4;
  const int aoff = (wr * 64 + fr) * LROW + fq * 16, boff = A_BYTES + (wc * WN * 16 + fr) * LROW + fq * 16, soff = lr * LROW + lcb;
  u32x4 ra0[4], rb0[WN], ra1[4], rb1[WN];
  auto gload = [&](u32x4 (&ra)[4], u32x4 (&rb)[WN], int kt) {
#pragma unroll
    for (int i = 0; i < 4; ++i) ra[i] = ldg16(ap[i] + (KFIX ? (kt & 1) : kt) * 64);
#pragma unroll
    for (int i = 0; i < WN; ++i) rb[i] = ldg16(bp[i] + (KFIX ? (kt & 1) : kt) * 64);
  };
  auto sstore = [&](const u32x4 (&ra)[4], const u32x4 (&rb)[WN], char* st) {
#pragma unroll
    for (int i = 0; i < 4; ++i) sts16(st + soff + 32 * i * LROW, ra[i]);
#pragma unroll
    for (int i = 0; i < WN; ++i) sts16(st + A_BYTES + soff + 32 * i * LROW, rb[i]);
  };
  auto compute = [&](const char* cur) {
#pragma unroll
    for (int ks = 0; ks < 2; ++ks) {
      bf16x8 af[4], bfr[WN];
#pragma unroll
      for (int m = 0; m < 4; ++m) af[m] = lds_frag(cur + aoff + m * 16 * LROW + ks * 64);
#pragma unroll
      for (int n = 0; n < WN; ++n) bfr[n] = lds_frag(cur + boff + n * 16 * LROW + ks * 64);
#pragma unroll
      for (int m = 0; m < 4; ++m)
#pragma unroll
        for (int n = 0; n < WN; ++n) acc[m][n] = MFMA16(bfr[n], af[m], acc[m][n]);
    }
    IGLP_OPT();
  };
  gload(ra0, rb0, 0);
  gload(ra1, rb1, 1);
  sstore(ra0, rb0, lds);
  __syncthreads();
#pragma unroll 1
  for (int kt = 0; kt < nk; kt += 2) {
    if (kt + 2 < nk) gload(ra0, rb0, kt + 2);
    compute(lds);
    sstore(ra1, rb1, lds + STAGE);
    __syncthreads();
    if (kt + 3 < nk) gload(ra1, rb1, kt + 3);
    compute(lds + STAGE);
    if (kt + 2 < nk) sstore(ra0, rb0, lds);
    __syncthreads();
  }
}
template <int WN> DI void acc_zero(f32x4 (&acc)[4][WN]) {
#pragma unroll
  for (int m = 0; m < 4; ++m)
#pragma unroll
    for (int n = 0; n < WN; ++n) acc[m][n] = (f32x4){0.f, 0.f, 0.f, 0.f};
}
DI void st_bf16x4(bf16_t* p, f32x4 v) { u32x2 o; o.x = pack2bf(v.x, v.y); o.y = pack2bf(v.z, v.w); *(u32x2*)p = o; }

template <int WN, class RowOk>
DI void store_wave_tile(const f32x4 (&acc)[4][WN], bf16_t* C, size_t ldc, char* ldsw, int lane, RowOk row_ok) {
  constexpr int PITCH = WN * 32 + 16, CPR = WN * 2;
  const int fr = lane & 15, fq = lane >> 4;
#pragma unroll
  for (int m = 0; m < 4; ++m)
#pragma unroll
    for (int n = 0; n < WN; ++n) { u32x2 o; o.x = pack2bf(acc[m][n][0], acc[m][n][1]); o.y = pack2bf(acc[m][n][2], acc[m][n][3]); *(u32x2*)(ldsw + (m * 16 + fr) * PITCH + n * 32 + fq * 8) = o; }
  WAVE_SYNC();
  constexpr int RPP = 64 / CPR;
#pragma unroll
  for (int ps = 0; ps < 64 / RPP; ++ps) {
    const int r = ps * RPP + lane / CPR, c = lane % CPR;
    const u32x4 v = *(const u32x4*)(ldsw + r * PITCH + c * 16);
    if (row_ok(r)) *(u32x4*)(C + (size_t)r * ldc + c * 8) = v;
  }
  WAVE_SYNC();
}
template <int NOSTORE = 0>
DI void gemm_plain_tile(const bf16_t* A, int lda, const bf16_t* Bt, int ldb, int K, bf16_t* C, int ldc, int tm, int tn, char* lds) {
  const int t = TIDX, lane = t & 63, wid = t >> 6, wr = wid >> 1, wc = wid & 1, lr = t >> 3, lc = (t & 7) * 8, fr = lane & 15, fq = lane >> 4;
  const bf16_t* ap[4]; const bf16_t* bp[4];
#pragma unroll
  for (int i = 0; i < 4; ++i) { ap[i] = A + (size_t)(tm * 128 + lr + 32 * i) * lda + lc; bp[i] = Bt + (size_t)(tn * 128 + lr + 32 * i) * ldb + lc; }
  f32x4 acc[4][4]; acc_zero<4>(acc);
  gemm_kloop<4, NOSTORE == 2>(acc, ap, bp, K / 64, lds);
  if (NOSTORE) { float s = 0.f;
#pragma unroll
    for (int m = 0; m < 4; ++m)
#pragma unroll
      for (int n = 0; n < 4; ++n) s += acc[m][n][0] + acc[m][n][3];
    if (s == 123456.789f) C[0] = 1; return; }
  store_wave_tile<4>(acc, C + (size_t)(tm * 128 + wr * 64) * ldc + tn * 128 + wc * 64, (size_t)ldc, lds + wid * (64 * 144), lane, [](int) { return true; });
  __syncthreads();
}
template <int NOSTORE = 0>
DI void ph_gemm_plain(const bf16_t* A, int lda, const bf16_t* Bt, int ldb, int M, int N, int K, bf16_t* C, int ldc, char* lds, int bid, int nblk) {
  const int ntn = N / 128, nt = (M / 128) * ntn;
  for (int u = bid; u < nt; u += nblk) { int tm, tn; grp_tile<8>(xcd_swz(u, nt), M / 128, ntn, tm, tn); gemm_plain_tile<NOSTORE>(A, lda, Bt, ldb, K, C, ldc, tm, tn, lds); }
}
DI void ph_mla_up(const Params& p, int layer, bf16_t* QRAW, bf16_t* KVRAW, char* lds, int bid, int nblk) {
  const int ntq = (R / 128) * 3, ntkv = (R / 128) * 4;
  for (int tile = bid; tile < ntq + ntkv; tile += nblk) {
    if (tile < ntq) gemm_plain_tile(p.Z + ZC_QLAT, NZP, p.Wt_uq + layer * WSZ_UQ, 256, 256, QRAW, 384, tile / 3, tile % 3, lds);
    else { int u = tile - ntq; gemm_plain_tile(p.Z + ZC_KVLAT, NZP, p.Wt_ukv + layer * WSZ_UKV, 128, 128, KVRAW, 512, u / 4, u % 4, lds); }
  }
}
constexpr int LROW32 = 80;
template <int WM, int WN, bool DEEP>
DI void gemm_kloop_g(f32x4 (&acc)[WM][WN], const bf16_t* const (&ap)[WM / 2], const bf16_t* const (&bp)[WN / 2], int nk, char* lds) {
  constexpr int NA = WM / 2, NBB = WN / 2, A_B = 32 * WM * LROW32, STAGE = (32 * WM + 32 * WN) * LROW32;
  const int t = TIDX, lane = t & 63, wid = t >> 6, wr = wid >> 1, wc = wid & 1, fr = lane & 15, fq = lane >> 4;
  const int aoff = (wr * 16 * WM + fr) * LROW32 + fq * 16, boff = A_B + (wc * 16 * WN + fr) * LROW32 + fq * 16, soff = (t >> 2) * LROW32 + (t & 3) * 16;
  u32x4 ra0[NA], rb0[NBB], ra1[NA], rb1[NBB];
  auto gload = [&](u32x4 (&ra)[NA], u32x4 (&rb)[NBB], int kt) {
#pragma unroll
    for (int i = 0; i < NA; ++i) ra[i] = ldg16(ap[i] + kt * 32);
#pragma unroll
    for (int i = 0; i < NBB; ++i) rb[i] = ldg16(bp[i] + kt * 32);
  };
  auto sstore = [&](const u32x4 (&ra)[NA], const u32x4 (&rb)[NBB], char* st) {
#pragma unroll
    for (int i = 0; i < NA; ++i) sts16(st + soff + 64 * i * LROW32, ra[i]);
#pragma unroll
    for (int i = 0; i < NBB; ++i) sts16(st + A_B + soff + 64 * i * LROW32, rb[i]);
  };
  auto compute = [&](const char* cur) {
    bf16x8 af[WM];
#pragma unroll
    for (int m = 0; m < WM; ++m) af[m] = lds_frag(cur + aoff + m * 16 * LROW32);
#pragma unroll
    for (int n = 0; n < WN; ++n) {
      const bf16x8 bfr = lds_frag(cur + boff + n * 16 * LROW32);
#pragma unroll
      for (int m = 0; m < WM; ++m) acc[m][n] = MFMA16(bfr, af[m], acc[m][n]);
    }
    IGLP_OPT();
  };
  gload(ra0, rb0, 0);
  if (DEEP) gload(ra1, rb1, 1);
  sstore(ra0, rb0, lds);
  __syncthreads();
#pragma unroll 1
  for (int kt = 0; kt < nk; kt += 2) {
    if (DEEP) { if (kt + 2 < nk) gload(ra0, rb0, kt + 2); } else gload(ra1, rb1, kt + 1);
    compute(lds);
    sstore(ra1, rb1, lds + STAGE);
    __syncthreads();
    if (DEEP) { if (kt + 3 < nk) gload(ra1, rb1, kt + 3); } else if (kt + 2 < nk) gload(ra0, rb0, kt + 2);
    compute(lds + STAGE);
    if (kt + 2 < nk) sstore(ra0, rb0, lds);
    __syncthreads();
  }
}
template <int WM, int WN> DI void acc_zero_g(f32x4 (&acc)[WM][WN]) {
#pragma unroll
  for (int m = 0; m < WM; ++m)
#pragma unroll
    for (int n = 0; n < WN; ++n) acc[m][n] = (f32x4){0.f, 0.f, 0.f, 0.f};
}
DI void ph_merge(const Params& p, int layer, int rows, char* lds, int bid, int nblk) {
  const int t = TIDX, lane = t & 63, wid = t >> 6, wr = wid >> 1, wc = wid & 1, fr = lane & 15, fq = lane >> 4;
  const int lr = t >> 2, lc = (t & 3) * 8;
  const int ntn = D / 64, nt = (rows / 128) * ntn;
#pragma unroll 1
  for (int u = bid; u < nt; u += nblk) {
    int tm, tn; grp_tile<4>(xcd_swz(u, nt), rows / 128, ntn, tm, tn);
    f32x4 accS[4][2]; acc_zero_g<4, 2>(accS);
#pragma unroll 1
    for (int np = 0; np < 2; ++np) {
      f32x4 accG[4][4]; acc_zero_g<4, 4>(accG);
      {
        const bf16_t* ap[2]; const bf16_t* bp[2];
#pragma unroll
        for (int i = 0; i < 2; ++i) ap[i] = p.H + (size_t)(tm * 128 + lr + 64 * i) * D + lc;
#pragma unroll
        for (int i = 0; i < 2; ++i) { const int rho = lr + 64 * i, wci = rho >> 6, n = 2 * np + ((rho >> 5) & 1), c = rho & 31;
          bp[i] = p.Wt_gate + layer * WSZ_GATE + ((size_t)n * 1024 + tn * 64 + wci * 32 + c) * D + lc; }
        gemm_kloop_g<4, 4, true>(accG, ap, bp, D / 32, lds);
      }
#pragma unroll 1
      for (int q = 0; q < 2; ++q) {
        const int n = 2 * np + q;
        f32x4 accP[4][2]; acc_zero_g<4, 2>(accP);
        const bf16_t* ap[2]; const bf16_t* bp[1];
#pragma unroll
        for (int i = 0; i < 2; ++i) ap[i] = p.Y + (size_t)(tm * 128 + lr + 64 * i) * D + n * 256 + lc;
        bp[0] = p.Wt_branch + layer * WSZ_BR + ((size_t)n * D + tn * 64 + lr) * 256 + lc;
        gemm_kloop_g<4, 2, false>(accP, ap, bp, 8, lds);
#pragma unroll
        for (int nn = 0; nn < 2; ++nn) {
          const f32x4 bv = *(const f32x4*)(p.b_gate + layer * 4096 + n * 1024 + tn * 64 + wc * 32 + nn * 16 + 4 * fq);
#pragma unroll
          for (int m = 0; m < 4; ++m)
#pragma unroll
            for (int j = 0; j < 4; ++j) { const float g = q ? accG[m][2 + nn][j] : accG[m][nn][j]; accS[m][nn][j] += accP[m][nn][j] * fast_rcp(1.0f + fast_exp2(-LOG2E * (g + bv[j]))); }
        }
      }
    }
    store_wave_tile<2>(accS, p.MG + (size_t)(tm * 128 + wr * 64) * D + tn * 64 + wc * 32, (size_t)D, lds + wid * (64 * 80), lane, [](int) { return true; });
    __syncthreads();
  }
}
template <int WM>
DI void gemm_plain_tile_g(const bf16_t* A, int lda, const bf16_t* Bt, int ldb, int K, bf16_t* C, int ldc, int row0, int col0, char* lds) {
  const int t = TIDX, lane = t & 63, wid = t >> 6, wr = wid >> 1, wc = wid & 1, fr = lane & 15, fq = lane >> 4, lr = t >> 2, lc = (t & 3) * 8;
  const bf16_t* ap[WM / 2]; const bf16_t* bp[2];
#pragma unroll
  for (int i = 0; i < WM / 2; ++i) ap[i] = A + (size_t)(row0 + lr + 64 * i) * lda + lc;
#pragma unroll
  for (int i = 0; i < 2; ++i) bp[i] = Bt + (size_t)(col0 + lr + 64 * i) * ldb + lc;
  f32x4 acc[WM][4]; acc_zero_g<WM, 4>(acc);
  gemm_kloop_g<WM, 4, true>(acc, ap, bp, K / 32, lds);
#pragma unroll
  for (int m = 0; m < WM; ++m)
#pragma unroll
    for (int n = 0; n < 4; ++n)
      st_bf16x4(C + (size_t)(row0 + wr * 16 * WM + m * 16 + fr) * ldc + col0 + wc * 64 + n * 16 + 4 * fq, acc[m][n]);
}
DI void ph_gemm_plain2(const bf16_t* A, int lda, const bf16_t* Bt, int ldb, int M, int N, int K, bf16_t* C, int ldc, char* lds, int bid, int nblk) {
  const int ntn = N / 128, nt = (M / 256) * ntn, nfull = (nt / nblk) * nblk;
#pragma unroll 1
  for (int tile = bid; tile < nfull; tile += nblk) gemm_plain_tile_g<8>(A, lda, Bt, ldb, K, C, ldc, (tile / ntn) * 256, (tile % ntn) * 128, lds);
#pragma unroll 1
  for (int h = bid; h < 2 * (nt - nfull); h += nblk) { const int tile = nfull + (h >> 1); gemm_plain_tile_g<4>(A, lda, Bt, ldb, K, C, ldc, (tile / ntn) * 256 + (h & 1) * 128, (tile % ntn) * 128, lds); }
}
DI void gemm_kloop32(f32x16 (&acc)[2][2], const bf16_t* const (&ap)[4], const bf16_t* const (&bp)[4], int nk, char* lds) {
  constexpr int STAGE = A_BYTES + 128 * LROW;
  const int t = TIDX, lane = t & 63, wid = t >> 6, wr = wid >> 1, wc = wid & 1, l31 = lane & 31, hh = lane >> 5;
  const int aoff = (wr * 64 + l31) * LROW + hh * 16, boff = A_BYTES + (wc * 64 + l31) * LROW + hh * 16, soff = (t >> 3) * LROW + (t & 7) * 16;
  u32x4 ra0[4], rb0[4], ra1[4], rb1[4];
  auto gload = [&](u32x4 (&ra)[4], u32x4 (&rb)[4], int kt) {
#pragma unroll
    for (int i = 0; i < 4; ++i) { ra[i] = ldg16(ap[i] + kt * 64); rb[i] = ldg16(bp[i] + kt * 64); }
  };
  auto sstore = [&](const u32x4 (&ra)[4], const u32x4 (&rb)[4], char* st) {
#pragma unroll
    for (int i = 0; i < 4; ++i) { sts16(st + soff + 32 * i * LROW, ra[i]); sts16(st + A_BYTES + soff + 32 * i * LROW, rb[i]); }
  };
  auto compute = [&](const char* cur) {
#pragma unroll
    for (int ks = 0; ks < 4; ++ks) {
      bf16x8 af[2], bfr[2];
#pragma unroll
      for (int m = 0; m < 2; ++m) af[m] = lds_frag(cur + aoff + m * 32 * LROW + ks * 32);
#pragma unroll
      for (int n = 0; n < 2; ++n) bfr[n] = lds_frag(cur + boff + n * 32 * LROW + ks * 32);
#pragma unroll
      for (int m = 0; m < 2; ++m)
#pragma unroll
        for (int n = 0; n < 2; ++n) acc[m][n] = MFMA32(bfr[n], af[m], acc[m][n]);
    }
  };
  gload(ra0, rb0, 0); gload(ra1, rb1, 1);
  sstore(ra0, rb0, lds);
  __syncthreads();
#pragma unroll 1
  for (int kt = 0; kt < nk; kt += 2) {
    if (kt + 2 < nk) gload(ra0, rb0, kt + 2);
    compute(lds);
    sstore(ra1, rb1, lds + STAGE);
    __syncthreads();
    if (kt + 3 < nk) gload(ra1, rb1, kt + 3);
    compute(lds + STAGE);
    if (kt + 2 < nk) sstore(ra0, rb0, lds);
    __syncthreads();
  }
}
DI void ph_gemm_plain32(const bf16_t* A, int lda, const bf16_t* Bt, int ldb, int M, int N, int K, bf16_t* C, int ldc, char* lds, int bid, int nblk) {
  const int t = TIDX, lane = t & 63, wid = t >> 6, wr = wid >> 1, wc = wid & 1, lr = t >> 3, lc = (t & 7) * 8, l31 = lane & 31, hh = lane >> 5;
  const int ntn = N / 128, nt = (M / 128) * ntn;
#pragma unroll 1
  for (int tile = bid; tile < nt; tile += nblk) {
    const int tm = tile / ntn, tn = tile % ntn;
    const bf16_t* ap[4]; const bf16_t* bp[4];
#pragma unroll
    for (int i = 0; i < 4; ++i) { ap[i] = A + (size_t)(tm * 128 + lr + 32 * i) * lda + lc; bp[i] = Bt + (size_t)(tn * 128 + lr + 32 * i) * ldb + lc; }
    f32x16 acc[2][2];
#pragma unroll
    for (int m = 0; m < 2; ++m)
#pragma unroll
      for (int n = 0; n < 2; ++n) acc[m][n] = (f32x16)(0.f);
    gemm_kloop32(acc, ap, bp, K / 64, lds);
#pragma unroll
    for (int m = 0; m < 2; ++m)
#pragma unroll
      for (int n = 0; n < 2; ++n)
#pragma unroll
        for (int g = 0; g < 4; ++g) {
          f32x4 o = {acc[m][n][4 * g], acc[m][n][4 * g + 1], acc[m][n][4 * g + 2], acc[m][n][4 * g + 3]};
          st_bf16x4(C + (size_t)(tm * 128 + wr * 64 + m * 32 + l31) * ldc + tn * 128 + wc * 64 + n * 32 + 8 * g + 4 * hh, o);
        }
  }
}
template <int MODE>
DI void ph_gemm_probe(const bf16_t* A, int lda, const bf16_t* Bt, int ldb, int M, int N, int K, float* sink, char* lds, int bid, int nblk) {
  const int t = TIDX, lane = t & 63, wid = t >> 6, wr = wid >> 1, wc = wid & 1, lr = t >> 3, lc = (t & 7) * 8, fr = lane & 15, fq = lane >> 4;
  const int ntn = N / 128, nt = (M / 128) * ntn, nk = K / 64;
  constexpr int STAGE = A_BYTES + 128 * LROW;
  const int aoff = (wr * 64 + fr) * LROW + fq * 16, boff = A_BYTES + (wc * 64 + fr) * LROW + fq * 16;
#pragma unroll 1
  for (int tile = bid; tile < nt; tile += nblk) {
    f32x4 acc[4][4]; acc_zero<4>(acc);
    bf16x8 af[4], bfr[4];
    const int tm = tile / ntn, tn = tile % ntn;
    const bf16_t* ap[4]; const bf16_t* bp[4];
#pragma unroll
    for (int i = 0; i < 4; ++i) { ap[i] = A + (size_t)(tm * 128 + lr + 32 * i) * lda + lc; bp[i] = Bt + (size_t)(tn * 128 + lr + 32 * i) * ldb + lc; }
    u32x4 ra[4], rb[4], junk = {0u, 0u, 0u, 0u};
#pragma unroll
    for (int i = 0; i < 4; ++i) { ra[i] = junk; rb[i] = junk; }
#pragma unroll 1
    for (int kt = 0; kt < nk; ++kt) {
      const char* cur = lds + (kt & 1) * STAGE;
#pragma unroll
      for (int i = 0; i < 4; ++i) { ra[i] = ldg16(ap[i] + kt * 64); if (MODE == 3) rb[i] = ldg16(bp[i] + kt * 64); }
#pragma unroll
      for (int ks = 0; ks < 2; ++ks) {
#pragma unroll
        for (int m = 0; m < 4; ++m) { af[m] = lds_frag(cur + aoff + m * 16 * LROW + ks * 64); bfr[m] = lds_frag(cur + boff + m * 16 * LROW + ks * 64); }
#pragma unroll
        for (int m = 0; m < 4; ++m)
#pragma unroll
          for (int n = 0; n < 4; ++n) acc[m][n] = MFMA16(bfr[n], af[m], acc[m][n]);
      }
      junk.x ^= ra[0].x ^ ra[1].y ^ ra[2].z ^ ra[3].w ^ rb[0].x ^ rb[1].y ^ rb[2].z ^ rb[3].w;
      __syncthreads();
    }
    float s = (float)(junk.x & 1u);
#pragma unroll
    for (int m = 0; m < 4; ++m)
#pragma unroll
      for (int n = 0; n < 4; ++n) s += acc[m][n][0] + acc[m][n][3];
    if (s == 123456.789f) sink[0] = s;
  }
}
DI void ph_moe1(const Params& p, int need_ctx, char* lds, int bid, int nblk) {
  const int t = TIDX, lane = t & 63, wid = t >> 6, wr = wid >> 1, wc = wid & 1, lr = t >> 3, lc = (t & 7) * 8, fr = lane & 15, fq = lane >> 4;
  constexpr int NTN = FF / 64;
  const int NTM = need_ctx ? (NSLOT + 127) / 128 : (NB * CAPL) / 128;
  for (int u = bid; u < NE * NTM * NTN; u += nblk) {
    const int tile = xcd_swz(u, NE * NTM * NTN), e = tile / (NTM * NTN), rem = tile % (NTM * NTN);
    int tm, tn, rr = rem, g = 0;
    if (rr >= NTM * 8) { rr -= NTM * 8; g = 1; }
    if (rr >= NTM * 8) { rr -= NTM * 8; g = 2; }
    if (g < 2) { tm = rr >> 3; tn = g * 8 + (rr & 7); } else { tm = rr / (NTN - 16); tn = 16 + rr - tm * (NTN - 16); }
    const bf16_t* ap[4]; const bf16_t* bp[4];
#pragma unroll
    for (int i = 0; i < 4; ++i) {
      const int slot = tm * 128 + lr + 32 * i;
      int r = slot < NSLOT ? p.SEL[(size_t)e * NSLOT + slot] : -1;
      ap[i] = p.H + (size_t)(r < 0 ? 0 : r) * D + lc;
      const int rho = lr + 32 * i, wci = rho >> 6, gu = (rho >> 5) & 1, col = wci * 32 + (rho & 31);
      bp[i] = (gu ? p.Wt_eu : p.Wt_eg) + ((size_t)e * FF + tn * 64 + col) * D + lc;
    }
    f32x4 acc[4][4]; acc_zero<4>(acc);
    gemm_kloop<4>(acc, ap, bp, D / 64, lds);
    f32x4 hid[4][2];
#pragma unroll
    for (int m = 0; m < 4; ++m) {
      const int slot = tm * 128 + wr * 64 + m * 16 + fr;
      const bool valid = slot < NSLOT && p.SEL[(size_t)e * NSLOT + (slot < NSLOT ? slot : 0)] >= 0;
#pragma unroll
      for (int n = 0; n < 2; ++n)
#pragma unroll
        for (int j = 0; j < 4; ++j) { const float g = acc[m][n][j], u = acc[m][n + 2][j]; hid[m][n][j] = valid ? g * u * fast_rcp(1.0f + fast_exp2(-LOG2E * g)) : 0.f; }
    }
    const int slot0 = tm * 128 + wr * 64;
    store_wave_tile<2>(hid, p.HID + ((size_t)e * NSLOT + slot0) * FF + tn * 64 + wc * 32, (size_t)FF, lds + wid * (64 * 80), lane, [&](int r) { return slot0 + r < NSLOT; });
    __syncthreads();
  }
}
DI void ph_moe2(const Params& p, int need_ctx, char* lds, int bid, int nblk) {
  const int t = TIDX, lane = t & 63, wid = t >> 6, wr = wid >> 1, wc = wid & 1, lr = t >> 3, lc = (t & 7) * 8, fr = lane & 15, fq = lane >> 4;
  constexpr int NTN = D / 128;
  const int NTM = need_ctx ? (NSLOT + 127) / 128 : (NB * CAPL) / 128;
  for (int u = bid; u < NE * NTM * NTN; u += nblk) {
    const int tile = xcd_swz(u, NE * NTM * NTN), e = tile / (NTM * NTN), rem = tile % (NTM * NTN), tm = rem / NTN, tn = rem % NTN;
    const bf16_t* ap[4]; const bf16_t* bp[4];
#pragma unroll
    for (int i = 0; i < 4; ++i) {
      int slot = tm * 128 + lr + 32 * i; if (slot >= NSLOT) slot = NSLOT - 1;
      ap[i] = p.HID + ((size_t)e * NSLOT + slot) * FF + lc;
      bp[i] = p.Wt_ed + ((size_t)e * D + tn * 128 + lr + 32 * i) * FF + lc;
    }
    f32x4 acc[4][4]; acc_zero<4>(acc);
    gemm_kloop<4>(acc, ap, bp, FF / 64, lds);
#pragma unroll
    for (int m = 0; m < 4; ++m) {
      const int slot = tm * 128 + wr * 64 + m * 16 + fr;
      const float val = (slot < NSLOT && p.SEL[(size_t)e * NSLOT + (slot < NSLOT ? slot : 0)] >= 0) ? p.SELV[(size_t)e * NSLOT + slot] : 0.f;
#pragma unroll
      for (int n = 0; n < 4; ++n) { acc[m][n].x *= val; acc[m][n].y *= val; acc[m][n].z *= val; acc[m][n].w *= val; }
    }
    const int slot0 = tm * 128 + wr * 64;
    store_wave_tile<4>(acc, p.YE + ((size_t)e * NSLOT + slot0) * D + tn * 128 + wc * 64, (size_t)D, lds + wid * (64 * 144), lane, [&](int r) { return slot0 + r < NSLOT; });
    __syncthreads();
  }
}
constexpr int GEMM_LDS = 2 * (A_BYTES + 128 * LROW);

DI void unpack8(u32x4 v, float (&f)[8]) {
  f[0] = u2f(v.x << 16); f[1] = u2f(v.x & 0xffff0000u); f[2] = u2f(v.y << 16); f[3] = u2f(v.y & 0xffff0000u);
  f[4] = u2f(v.z << 16); f[5] = u2f(v.z & 0xffff0000u); f[6] = u2f(v.w << 16); f[7] = u2f(v.w & 0xffff0000u);
}
DI u32x4 pack8f(const float (&f)[8]) { u32x4 v; v.x = pack2bf(f[0], f[1]); v.y = pack2bf(f[2], f[3]); v.z = pack2bf(f[4], f[5]); v.w = pack2bf(f[6], f[7]); return v; }
DI void rope8(float (&a)[8], const float (&pr)[8], int cc, const float* cs, const float* sn) {
  const int ax = (cc >> 1) * 8; const bool second = cc & 1;
#pragma unroll
  for (int i = 0; i < 8; ++i) a[i] = second ? a[i] * cs[ax + i] + pr[i] * sn[ax + i] : a[i] * cs[ax + i] - pr[i] * sn[ax + i];
}
constexpr int PREP_LDS = 64 * 4 + 2 * 512 * 4 + 32 * 528;
template <int PARTS = 3>
DI void ph_prep(const Params& p, int layer, const bf16_t* QRAW, const bf16_t* KVRAW, char* lds, int bid, int nblk) {
  float* s_rstd = (float*)lds;
  float* s_cs = s_rstd + 64;
  float* s_sn = s_cs + 512;
  bf16_t* s_t = (bf16_t*)(s_sn + 512);
  const int t = TIDX;
  constexpr int UPB = TK / 32, NU = NB * UPB;
  const float* wcv = p.w_conv + (size_t)layer * 3 * 512;
#pragma unroll 1
  for (int u = bid; u < NU; u += nblk) {
    int b, s0;
    if (u < NB * (TL / 32)) { b = u / (TL / 32); s0 = TC + (u % (TL / 32)) * 32; } else { const int v = u - NB * (TL / 32); b = v / (TC / 32); s0 = (v % (TC / 32)) * 32; }
    const int r0 = row_of(b, s0);
    {
      const int tok = t >> 3, part = t & 7;
      const bf16_t* z = p.Z + (size_t)(r0 + tok) * NZP;
      float sq = 0.f, sk = 0.f, f[8];
#pragma unroll
      for (int k = 0; k < 4; ++k) { unpack8(ldg16(z + ZC_QLAT + part * 32 + k * 8), f);
#pragma unroll
        for (int i = 0; i < 8; ++i) sq += f[i] * f[i]; }
#pragma unroll
      for (int k = 0; k < 2; ++k) { unpack8(ldg16(z + ZC_KVLAT + part * 16 + k * 8), f);
#pragma unroll
        for (int i = 0; i < 8; ++i) sk += f[i] * f[i]; }
      sq = xor_sum<1>(sq); sk = xor_sum<1>(sk);
      sq = xor_sum<2>(sq); sk = xor_sum<2>(sk);
      sq = xor_sum<4>(sq); sk = xor_sum<4>(sk);
      if (part == 0) { s_rstd[tok * 2] = 1.0f / sqrtf(sq * (1.0f / 256) + 1e-6f); s_rstd[tok * 2 + 1] = 1.0f / sqrtf(sk * (1.0f / 128) + 1e-6f); }
    }
    for (int i = t; i < 512; i += NTHR) {
      const int tok = i >> 4, af = i & 15, s = s0 + tok;
      float cs = 1.f, sn = 0.f;
      if (s >= TC) rope_cs(s, (af >> 3) * 16 + (af & 7), cs, sn);
      s_cs[i] = cs; s_sn[i] = sn;
    }
    __syncthreads();
    if (PARTS & 1) {
#pragma unroll 2
    for (int i = t; i < 32 * 48; i += NTHR) {
      const int tok = i / 48, c = i % 48, h = c / 12, ch = c % 12;
      const float rq = s_rstd[tok * 2] * QS_MLA, rkv = s_rstd[tok * 2 + 1];
      const bf16_t* q = QRAW + (size_t)(r0 + tok) * 384 + h * 96;
      float a[8], pr[8];
      unpack8(ldg16(q + ch * 8), a);
      if (ch >= 8) { unpack8(ldg16(q + 64 + ((ch - 8) ^ 1) * 8), pr); rope8(a, pr, ch - 8, s_cs + tok * 16, s_sn + tok * 16); }
#pragma unroll
      for (int e = 0; e < 8; ++e) a[e] *= rq;
      *(u32x4*)(p.Qm + (((size_t)b * 4 + h) * TK + s0 + tok) * 96 + ch * 8) = pack8f(a);
      if (ch < 8) {
        unpack8(ldg16(KVRAW + (size_t)(r0 + tok) * 512 + h * 128 + ch * 8), a);
#pragma unroll
        for (int e = 0; e < 8; ++e) a[e] *= rkv;
      } else {
        const bf16_t* z = p.Z + (size_t)(r0 + tok) * NZP + ZC_KROPE;
        unpack8(ldg16(z + (ch - 8) * 8), a); unpack8(ldg16(z + ((ch - 8) ^ 1) * 8), pr);
        rope8(a, pr, ch - 8, s_cs + tok * 16, s_sn + tok * 16);
      }
      *(u32x4*)(p.Km + (((size_t)b * 4 + h) * TK + s0 + tok) * 96 + ch * 8) = pack8f(a);
    }
#pragma unroll 2
    for (int i = t; i < 32 * 64; i += NTHR) {
      const int tok = i >> 6, c = i & 63, qk = c >> 5, hm = (c >> 2) & 7, cc = c & 3;
      const bf16_t* src = p.Z + (size_t)(r0 + tok) * NZP + (qk ? ZC_DK : ZC_DQ) + hm * 32;
      float a[8], pr[8];
      unpack8(ldg16(src + cc * 8), a); unpack8(ldg16(src + (cc ^ 1) * 8), pr);
      rope8(a, pr, cc, s_cs + tok * 16, s_sn + tok * 16);
      if (qk == 0) {
#pragma unroll
        for (int e = 0; e < 8; ++e) a[e] *= QS_DIFF;
        *(u32x4*)(p.Qd + (((size_t)b * 8 + hm) * TK + s0 + tok) * 32 + cc * 8) = pack8f(a);
      } else *(u32x4*)(p.Kd + (((size_t)b * 8 + hm) * TK + s0 + tok) * 32 + cc * 8) = pack8f(a);
    }
#pragma unroll 2
    for (int i = t; i < 32 * 64; i += NTHR) {
      const int tok = i >> 6, c8 = (i & 63) * 8, s = s0 + tok;
      const bool first = (s == 0) || (s == TC), last = (s == TC - 1) || (s == TK - 1);
      const bf16_t* z = p.Z + (size_t)(r0 + tok) * NZP + ZC_MLQK + c8;
      float x0[8], xm[8], xp[8], o[8];
      unpack8(ldg16(z), x0);
      if (!first) unpack8(ldg16(z - NZP), xm);
      if (!last) unpack8(ldg16(z + NZP), xp);
      float bc8[8], w0[8], w1[8], w2[8];
      *(f32x4*)bc8 = *(const f32x4*)(p.b_conv + layer * 512 + c8); *(f32x4*)(bc8 + 4) = *(const f32x4*)(p.b_conv + layer * 512 + c8 + 4);
      *(f32x4*)w0 = *(const f32x4*)(wcv + c8); *(f32x4*)(w0 + 4) = *(const f32x4*)(wcv + c8 + 4);
      *(f32x4*)w1 = *(const f32x4*)(wcv + 512 + c8); *(f32x4*)(w1 + 4) = *(const f32x4*)(wcv + 512 + c8 + 4);
      *(f32x4*)w2 = *(const f32x4*)(wcv + 1024 + c8); *(f32x4*)(w2 + 4) = *(const f32x4*)(wcv + 1024 + c8 + 4);
#pragma unroll
      for (int e = 0; e < 8; ++e) {
        float acc = bc8[e] + x0[e] * w1[e];
        if (!first) acc += xm[e] * w0[e];
        if (!last) acc += xp[e] * w2[e];
        o[e] = acc * fast_rcp(1.0f + fast_exp2(-LOG2E * acc));
      }
      if (c8 < 256) *(u32x4*)(p.MQ + ((size_t)b * TK + s) * 256 + c8) = pack8f(o);
      else {
#pragma unroll
        for (int e = 0; e < 8; ++e) o[e] *= 0.125f;
        *(u32x4*)(p.MK + ((size_t)b * TK + s) * 256 + c8 - 256) = pack8f(o);
      }
    }
    }
#pragma unroll 1
    for (int w = 0; w < ((PARTS & 2) ? 4 : 0); ++w) {
      __syncthreads();
#pragma unroll
      for (int k = 0; k < 4; ++k) {
        const int i = t + k * NTHR, tok = i >> 5, c8 = (i & 31) * 8;
        u32x4 v;
        if (w == 0) { float a[8]; const int h = c8 >> 6; unpack8(ldg16(KVRAW + (size_t)(r0 + tok) * 512 + h * 128 + 64 + (c8 & 63)), a); const float rkv = s_rstd[tok * 2 + 1];
#pragma unroll
          for (int e = 0; e < 8; ++e) a[e] *= rkv;
          v = pack8f(a); }
        else v = ldg16(p.Z + (size_t)(r0 + tok) * NZP + (w == 1 ? ZC_DV : (w == 2 ? ZC_MLV : ZC_GV)) + c8);
        *(u32x4*)(s_t + tok * 264 + c8) = v;
      }
      __syncthreads();
      bf16_t* dst = w == 0 ? p.Vtm : (w == 1 ? p.Vtd : (w == 2 ? p.MVt : p.GVt));
#pragma unroll
      for (int k = 0; k < 4; ++k) {
        const int i = t + k * NTHR, tg = i & 3, ch = i >> 2;
        u32x4 v;
        v.x = (unsigned)s_t[(tg * 8 + 0) * 264 + ch] | ((unsigned)s_t[(tg * 8 + 1) * 264 + ch] << 16);
        v.y = (unsigned)s_t[(tg * 8 + 2) * 264 + ch] | ((unsigned)s_t[(tg * 8 + 3) * 264 + ch] << 16);
        v.z = (unsigned)s_t[(tg * 8 + 4) * 264 + ch] | ((unsigned)s_t[(tg * 8 + 5) * 264 + ch] << 16);
        v.w = (unsigned)s_t[(tg * 8 + 6) * 264 + ch] | ((unsigned)s_t[(tg * 8 + 7) * 264 + ch] << 16);
        *(u32x4*)(dst + (((size_t)b * 4 + (ch >> 6)) * 64 + (ch & 63)) * TK + s0 + tg * 8) = v;
      }
    }
    __syncthreads();
  }
}
constexpr int VROW = 136;
constexpr int VROW_A = 144;
template <int DQK> struct AttnCfg {
  static constexpr int KROW = DQK * 2 + 16;
  static constexpr int KBYTES = 64 * KROW, VBYTES = 64 * VROW_A, STAGE = KBYTES + VBYTES;
  static constexpr int KCH = 64 * DQK * 2 / 16 / NTHR;
};
DI bf16x8 pack8(const f32x16& x, int s) {
  u32x4 pk; pk.x = pack2bf(x[8 * s], x[8 * s + 1]); pk.y = pack2bf(x[8 * s + 2], x[8 * s + 3]); pk.z = pack2bf(x[8 * s + 4], x[8 * s + 5]); pk.w = pack2bf(x[8 * s + 6], x[8 * s + 7]);
  return __builtin_bit_cast(bf16x8, pk);
}
struct TrueC { static constexpr bool value = true; };
struct FalseC { static constexpr bool value = false; };
template <int DQK, int NMAP, int VAR = 0>
DI void attn_unit(const bf16_t* __restrict__ Qb, const bf16_t* __restrict__ Kb, size_t mstride, const bf16_t* __restrict__ Vt, int q0, int nkeys,
                  f32x16 (&O)[NMAP][2], float (&lsum)[NMAP], char* lds) {
  constexpr int DM = DQK / NMAP;
  constexpr int KS = DM / 16;
  using C = AttnCfg<DQK>;
  constexpr int CPM = 64 * DM * 2 / 16;
  constexpr int CPR = DM * 2 / 16;
  const int t = TIDX, lane = t & 63, wid = t >> 6, l31 = lane & 31, hh = lane >> 5;
  bf16x8 qf[NMAP][KS];
#pragma unroll
  for (int m = 0; m < NMAP; ++m)
#pragma unroll
    for (int ks = 0; ks < KS; ++ks) qf[m][ks] = *(const bf16x8*)(Qb + m * mstride + (size_t)(q0 + wid * 32 + l31) * DM + ks * 16 + 8 * hh);
  float mref[NMAP];
  f32x4 lacc[NMAP];
  const short onev = ((lane & 15) < 2 && ((lane >> 4) & 1) == (lane & 15)) ? (short)0x3F80 : (short)0;
  const bf16x8 ones_a = {onev, onev, onev, onev, onev, onev, onev, onev};
#pragma unroll
  for (int m = 0; m < NMAP; ++m) { mref[m] = 0.f; lacc[m] = (f32x4){0.f, 0.f, 0.f, 0.f}; O[m][0] = (f32x16)(0.f); O[m][1] = (f32x16)(0.f); }
  u32x4 rk[C::KCH], rv[2];
  const bf16_t* kg[C::KCH]; int klds[C::KCH];
#pragma unroll
  for (int i = 0; i < C::KCH; ++i) { const int c = t + i * NTHR, m = c / CPM, cc = c % CPM; kg[i] = Kb + m * mstride + cc * 8; klds[i] = (cc / CPR) * C::KROW + m * DM * 2 + (cc % CPR) * 16; }
  const bf16_t* vg = Vt + (size_t)(t >> 3) * TK + (t & 7) * 8;
  const int vlds = C::KBYTES + (t >> 3) * VROW_A + ((t & 7) >> 1) * 32 + ((t & 1) ? 8 : 0);
  const int kfoff = l31 * C::KROW + 16 * hh, vfoff = C::KBYTES + l31 * VROW_A + 16 * hh;
  const int nt = nkeys / 64;
#pragma unroll
  for (int i = 0; i < C::KCH; ++i) rk[i] = ldg16(kg[i]);
  rv[0] = ldg16(vg); rv[1] = ldg16(vg + (size_t)32 * TK);
  auto tile = [&](const int kt, auto chk_c, auto ref_c) __attribute__((always_inline)) {
    constexpr bool CHK = decltype(chk_c)::value, REF = decltype(ref_c)::value;
    char* cur = lds + (kt & 1) * C::STAGE;
    if (VAR != 2) {
#pragma unroll
    for (int i = 0; i < C::KCH; ++i) sts16(cur + klds[i], rk[i]);
#pragma unroll
    for (int i = 0; i < 2; ++i) { char* d = cur + vlds + i * 32 * VROW_A; u32x2 lo, hi; lo.x = rv[i].x; lo.y = rv[i].y; hi.x = rv[i].z; hi.y = rv[i].w; *(u32x2*)d = lo; *(u32x2*)(d + 16) = hi; }
    __syncthreads();
    }
    if (VAR != 2 && kt + 1 < nt) {
      const int kn = VAR == 3 ? ((kt + 1) & 1) : kt + 1;
#pragma unroll
      for (int i = 0; i < C::KCH; ++i) rk[i] = ldg16(kg[i] + (size_t)kn * 64 * DM);
      rv[0] = ldg16(vg + kn * 64); rv[1] = ldg16(vg + (size_t)32 * TK + kn * 64);
    }
    bf16x8 kf[NMAP][2][KS];
#pragma unroll
    for (int k2 = 0; k2 < 2; ++k2)
#pragma unroll
      for (int ks = 0; ks < KS; ++ks) kf[0][k2][ks] = lds_frag(cur + kfoff + k2 * 32 * C::KROW + ks * 32);
    f32x16 S[NMAP][2];
    S[0][0] = (f32x16)(0.f); S[0][1] = (f32x16)(0.f);
#pragma unroll
    for (int ks = 0; ks < KS; ++ks)
#pragma unroll
      for (int k2 = 0; k2 < 2; ++k2) S[0][k2] = MFMA32(kf[0][k2][ks], qf[0][ks], S[0][k2]);
    bf16x8 vf[4][2];
#pragma unroll
    for (int kst = 0; kst < 4; ++kst)
#pragma unroll
      for (int dvt = 0; dvt < 2; ++dvt) vf[kst][dvt] = lds_frag(cur + vfoff + dvt * 32 * VROW_A + kst * 32);
#pragma unroll
    for (int m = 1; m < NMAP; ++m)
#pragma unroll
      for (int k2 = 0; k2 < 2; ++k2)
#pragma unroll
        for (int ks = 0; ks < KS; ++ks) kf[m][k2][ks] = lds_frag(cur + kfoff + k2 * 32 * C::KROW + m * DM * 2 + ks * 32);
#pragma unroll
    for (int m = 0; m < NMAP; ++m) {
      if (m > 0) {
        SCHED_BARRIER();
        S[m][0] = (f32x16)(0.f); S[m][1] = (f32x16)(0.f);
#pragma unroll
        for (int ks = 0; ks < KS; ++ks)
#pragma unroll
          for (int k2 = 0; k2 < 2; ++k2) S[m][k2] = MFMA32(kf[m][k2][ks], qf[m][ks], S[m][k2]);
      }
      if (VAR != 1) {
      if (CHK && (kt & 7) == 0) {
        float mx = fmaxf(S[m][0][0], S[m][1][0]);
#pragma unroll
        for (int i = 1; i < 16; ++i) mx = fmaxf(mx, fmaxf(S[m][0][i], S[m][1][i]));
        mx = xor_max<32>(mx);
        const float rel = mx - mref[m];
        const float delta = (kt == 0) ? ((mx > ATT_THR || mx < -ATT_THR) ? mx : 0.0f) : (rel > ATT_THR ? rel : 0.0f);
        if (wave_any(delta != 0.0f)) {
          const float alpha = fast_exp2(-delta);
          mref[m] += delta; lacc[m][0] *= alpha; lacc[m][1] *= lane_get(alpha, (lane & 15) + 16);
#pragma unroll
          for (int dvt = 0; dvt < 2; ++dvt)
#pragma unroll
            for (int i = 0; i < 16; ++i) O[m][dvt][i] *= alpha;
        }
      }
      if constexpr (REF) {
        if (wave_any(mref[m] != 0.0f)) {
          const f32x2 nm = {-mref[m], -mref[m]};
#pragma unroll
          for (int k2 = 0; k2 < 2; ++k2)
#pragma unroll
            for (int i = 0; i < 16; i += 2) { const f32x2 x = (f32x2){S[m][k2][i], S[m][k2][i + 1]} + nm; S[m][k2][i] = x.x; S[m][k2][i + 1] = x.y; }
        }
      }
#pragma unroll
      for (int k2 = 0; k2 < 2; ++k2)
#pragma unroll
        for (int i = 0; i < 16; ++i) S[m][k2][i] = fast_exp2(S[m][k2][i]);
      }
#pragma unroll
      for (int kst = 0; kst < 4; ++kst) {
        const bf16x8 pf = pack8(S[m][kst >> 1], kst & 1);
#pragma unroll
        for (int dvt = 0; dvt < 2; ++dvt) O[m][dvt] = MFMA32(vf[kst][dvt], pf, O[m][dvt]);
        lacc[m] = MFMA16(ones_a, pf, lacc[m]);
      }
    }
  };
  int kt = 0;
#pragma unroll 1
  while (kt < nt) {
    tile(kt, TrueC{}, TrueC{});
    ++kt;
    bool nz = false;
#pragma unroll
    for (int m = 0; m < NMAP; ++m) nz = nz || (mref[m] != 0.0f);
    if (!wave_any(nz)) {
      const int k8 = (kt + 7) & ~7, kend = k8 < nt ? k8 : nt;
#pragma unroll 1
      for (; kt < kend; ++kt) tile(kt, FalseC{}, FalseC{});
    }
  }
  __syncthreads();
#pragma unroll
  for (int m = 0; m < NMAP; ++m) { const float a0 = lane_get(lacc[m][0], lane & 15), a1 = lane_get(lacc[m][1], lane & 15); lsum[m] = l31 < 16 ? a0 : a1; }
}
constexpr int ATT_QB = TK / 128;
constexpr int ATT_LDS = 2 * AttnCfg<96>::STAGE;
constexpr int ATT_QBL = TL / 128, ATT_QBC = TC / 128, ATT_LAT_UNITS = NB * 4 * ATT_QBL, ATT_UNITS = ATT_LAT_UNITS + NB * 4 * ATT_QBC;
DI void att_unit(int u, int& bh, int& qb) {
  if (u < ATT_LAT_UNITS) { bh = u & 7; qb = ATT_QBC + (u >> 3); } else { const int v = u - ATT_LAT_UNITS; bh = v & 7; qb = v >> 3; }
}
DI void ph_attn_diff(const Params& p, int layer, int need_ctx, char* lds, int bid, int nblk) {
  const int lane = TIDX & 63, wid = TIDX >> 6, l31 = lane & 31, hh = lane >> 5;
  float lam_init; const float lam = lam_of(p, layer, lam_init);
#pragma unroll 1
  for (int u = bid; u < (need_ctx ? ATT_UNITS : ATT_LAT_UNITS); u += nblk) {
    int bh, qb; att_unit(u, bh, qb);
    const int b = bh >> 2, h = bh & 3, q0 = qb * 128;
    const int r = row_of(b, q0 + wid * 32 + l31);
    f32x16 O[2][2]; float ls[2];
    attn_unit<64, 2>(p.Qd + ((size_t)b * 8 + h * 2) * TK * 32, p.Kd + ((size_t)b * 8 + h * 2) * TK * 32, (size_t)TK * 32, p.Vtd + ((size_t)b * 4 + h) * 64 * TK, q0,
                     q0 < TC ? TC : TK, O, ls, lds);
    const float i0 = 1.0f / ls[0], i1 = lam / ls[1];
    float ss = 0.f;
#pragma unroll
    for (int dvt = 0; dvt < 2; ++dvt)
#pragma unroll
      for (int i = 0; i < 16; ++i) { const float o = O[0][dvt][i] * i0 - O[1][dvt][i] * i1; O[0][dvt][i] = o; ss += o * o; }
    ss = xor_sum<32>(ss);
    const float rstd = (1.0f - lam_init) / sqrtf(ss * (1.0f / 64) + 1e-6f);
    const float* gd = p.g_diff_out + layer * 256 + h * 64;
#pragma unroll
    for (int dvt = 0; dvt < 2; ++dvt)
#pragma unroll
      for (int g = 0; g < 4; ++g) {
        const int dv = dvt * 32 + 8 * g + 4 * hh;
        const f32x4 gv = *(const f32x4*)(gd + dv);
        f32x4 o = {O[0][dvt][4 * g] * rstd * gv[0], O[0][dvt][4 * g + 1] * rstd * gv[1], O[0][dvt][4 * g + 2] * rstd * gv[2], O[0][dvt][4 * g + 3] * rstd * gv[3]};
        st_bf16x4(p.Y + (size_t)r * D + 768 + h * 64 + dv, o);
      }
  }
}
DI void ph_attn_mla(const Params& p, int need_ctx, char* lds, int bid, int nblk) {
  const int lane = TIDX & 63, wid = TIDX >> 6, l31 = lane & 31, hh = lane >> 5;
#pragma unroll 1
  for (int u = bid; u < (need_ctx ? ATT_UNITS : ATT_LAT_UNITS); u += nblk) {
    int bh, qb; att_unit(u, bh, qb);
    const int b = bh >> 2, h = bh & 3, q0 = qb * 128;
    const int r = row_of(b, q0 + wid * 32 + l31);
    f32x16 O[1][2]; float ls[1];
    attn_unit<96, 1>(p.Qm + ((size_t)b * 4 + h) * TK * 96, p.Km + ((size_t)b * 4 + h) * TK * 96, 0, p.Vtm + ((size_t)b * 4 + h) * 64 * TK, q0, q0 < TC ? TC : TK, O, ls, lds);
    const float inv = 1.0f / ls[0];
#pragma unroll
    for (int dvt = 0; dvt < 2; ++dvt)
#pragma unroll
      for (int g = 0; g < 4; ++g) {
        f32x4 o = {O[0][dvt][4 * g] * inv, O[0][dvt][4 * g + 1] * inv, O[0][dvt][4 * g + 2] * inv, O[0][dvt][4 * g + 3] * inv};
        st_bf16x4(p.Y + (size_t)r * D + h * 64 + dvt * 32 + 8 * g + 4 * hh, o);
      }
  }
}
template <int VAR> DI void ph_attn_mla_probe(const Params& p, char* lds, int bid, int nblk) {
  const int lane = TIDX & 63, wid = TIDX >> 6, l31 = lane & 31, hh = lane >> 5;
#pragma unroll 1
  for (int u = bid; u < ATT_LAT_UNITS; u += nblk) {
    int bh, qb; att_unit(u, bh, qb);
    const int b = bh >> 2, h = bh & 3, q0 = qb * 128;
    const int r = row_of(b, q0 + wid * 32 + l31);
    f32x16 O[1][2]; float ls[1];
    attn_unit<96, 1, VAR>(p.Qm + ((size_t)b * 4 + h) * TK * 96, p.Km + ((size_t)b * 4 + h) * TK * 96, 0, p.Vtm + ((size_t)b * 4 + h) * 64 * TK, q0, TK, O, ls, lds);
    const float inv = 1.0f / ls[0];
#pragma unroll
    for (int dvt = 0; dvt < 2; ++dvt)
#pragma unroll
      for (int g = 0; g < 4; ++g) {
        f32x4 o = {O[0][dvt][4 * g] * inv, O[0][dvt][4 * g + 1] * inv, O[0][dvt][4 * g + 2] * inv, O[0][dvt][4 * g + 3] * inv};
        *(f32x4*)(p.out + (size_t)r * D + h * 64 + dvt * 32 + 8 * g + 4 * hh) = o;
      }
  }
}
DI void ph_attn(const Params& p, int layer, int need_ctx, char* lds, int bid, int nblk) {
  ph_attn_diff(p, layer, need_ctx, lds, bid, nblk);
  ph_attn_mla(p, need_ctx, lds, bid, nblk);
}

DI float wave_sum(float v) {
  v = xor_sum<1>(v); v = xor_sum<2>(v); v = xor_sum<4>(v); v = xor_sum<8>(v); v = xor_sum<16>(v); v = xor_sum<32>(v);
  return v;
}
DI void ld_row16(const float* row, int lane, f32x4 (&v)[4]) {
#pragma unroll
  for (int i = 0; i < 4; ++i) v[i] = *(const f32x4*)(row + 256 * i + 4 * lane);
}
DI void ld_row16_bf(const bf16_t* row, int lane, f32x4 (&v)[4]) {
#pragma unroll
  for (int i = 0; i < 4; ++i) { const u32x2 u = *(const u32x2*)(row + 256 * i + 4 * lane); v[i] = (f32x4){u2f(u.x << 16), u2f(u.x & 0xffff0000u), u2f(u.y << 16), u2f(u.y & 0xffff0000u)}; }
}
DI void ph_modulate(const Params& p, int layer, const float* xl, const float* xcx, int bid, int nblk) {
  const int lane = TIDX & 63, wid = TIDX >> 6;
  const float* g = p.g_mix_pre + layer * 1024;
  for (int r = bid * 4 + wid; r < R; r += nblk * 4) {
    const int w = r < RL ? r / TL : 2;
    const float* mb = p.mods + (size_t)(layer * 3 + w) * 6144;
    const float* x = r < RL ? xl + (size_t)r * D : xcx + (size_t)(r - RL) * D;
    f32x4 xv[4], gv[4], sc[4], sh[4];
    ld_row16(x, lane, xv); ld_row16(g, lane, gv); ld_row16(mb + 1024, lane, sc); ld_row16(mb, lane, sh);
    float ss = 0.f;
#pragma unroll
    for (int i = 0; i < 4; ++i)
#pragma unroll
      for (int e = 0; e < 4; ++e) ss += xv[i][e] * xv[i][e];
    const float rstd = 1.0f / sqrtf(wave_sum(ss) * (1.0f / D) + 1e-6f);
#pragma unroll
    for (int i = 0; i < 4; ++i) {
      f32x4 o;
#pragma unroll
      for (int e = 0; e < 4; ++e) o[e] = xv[i][e] * rstd * gv[i][e] * (1.f + sc[i][e]) + sh[i][e];
      st_bf16x4(p.H + (size_t)r * D + 256 * i + 4 * lane, o);
    }
  }
}
DI void ph_resid_mix(const Params& p, int layer, const float* xl_in, const float* xc_in, int rows, char* lds, int bid, int nblk) {
  const int lane = TIDX & 63, wid = TIDX >> 6;
  const float* wr = p.w_router + (size_t)layer * D * 16;
  for (int i = TIDX; i < D * 4; i += NTHR) { const int k = i >> 2, q = i & 3; *(f32x4*)(lds + k * 64 + (k >> 2) * 16 + q * 16) = *(const f32x4*)(wr + k * 16 + q * 4); }
  __syncthreads();
  for (int r = bid * 4 + wid; r < rows; r += nblk * 4) {
    const int w = r < RL ? r / TL : 2;
    const float* mb = p.mods + (size_t)(layer * 3 + w) * 6144;
    const float* xin = r < RL ? xl_in + (size_t)r * D : xc_in + (size_t)(r - RL) * D;
    float* xo = r < RL ? p.out + (size_t)r * D : p.xc + (size_t)(r - RL) * D;
    f32x4 yv[4], xv[4], a[4], c[4];
    ld_row16_bf(p.YO + (size_t)r * D, lane, yv); ld_row16(xin, lane, xv);
    float ss = 0.f;
#pragma unroll
    for (int i = 0; i < 4; ++i)
#pragma unroll
      for (int e = 0; e < 4; ++e) ss += yv[i][e] * yv[i][e];
    const float rstd = 1.0f / sqrtf(wave_sum(ss) * (1.0f / D) + 1e-6f);
    ld_row16(mb + 2 * 1024, lane, a); ld_row16(p.g_mix_post + layer * 1024, lane, c);
    float s2 = 0.f;
#pragma unroll
    for (int i = 0; i < 4; ++i) {
#pragma unroll
      for (int e = 0; e < 4; ++e) { xv[i][e] += a[i][e] * yv[i][e] * rstd * c[i][e]; s2 += xv[i][e] * xv[i][e]; }
      *(f32x4*)(xo + 256 * i + 4 * lane) = xv[i];
    }
    const float rstd2 = 1.0f / sqrtf(wave_sum(s2) * (1.0f / D) + 1e-6f);
    ld_row16(p.g_ffn_pre + layer * 1024, lane, a); ld_row16(mb + 4 * 1024, lane, c); ld_row16(mb + 3 * 1024, lane, yv);
    float lg[16];
#pragma unroll
    for (int e = 0; e < 16; ++e) lg[e] = 0.f;
#pragma unroll
    for (int i = 0; i < 4; ++i) {
      f32x4 h2;
#pragma unroll
      for (int e = 0; e < 4; ++e) h2[e] = xv[i][e] * rstd2 * a[i][e] * (1.f + c[i][e]) + yv[i][e];
      st_bf16x4(p.H + (size_t)r * D + 256 * i + 4 * lane, h2);
#pragma unroll
      for (int e = 0; e < 4; ++e) {
        const char* wk = lds + (256 * i + 4 * lane + e) * 64 + (64 * i + lane) * 16;
#pragma unroll
        for (int q = 0; q < 4; ++q) { const f32x4 wv = *(const f32x4*)(wk + 16 * q); lg[4 * q] += h2[e] * wv[0]; lg[4 * q + 1] += h2[e] * wv[1]; lg[4 * q + 2] += h2[e] * wv[2]; lg[4 * q + 3] += h2[e] * wv[3]; }
      }
    }
#pragma unroll
    for (int e = 0; e < 16; ++e) lg[e] = wave_sum(lg[e]);
    float mx = lg[0];
#pragma unroll
    for (int e = 1; e < 16; ++e) mx = fmaxf(mx, lg[e]);
    float sm = 0.f;
#pragma unroll
    for (int e = 0; e < 16; ++e) { lg[e] = expf(lg[e] - mx); sm += lg[e]; }
    int b, s; bs_of(r, b, s);
    float mine = 0.f;
#pragma unroll
    for (int e = 0; e < 16; ++e) mine = (lane == e) ? lg[e] / sm : mine;
    if (lane < 16) p.AFF[((size_t)b * NE + lane) * TK + s] = mine;
  }
}
DI void ph_resid_ffn(const Params& p, int layer, int rows, int bid, int nblk) {
  const int lane = TIDX & 63, wid = TIDX >> 6;
  int r = bid * 4 + wid;
  int inv_n = (r < rows && lane < NE) ? p.INV[(size_t)r * NE + lane] : -1;
#pragma unroll 1
  for (; r < rows; r += nblk * 4) {
    const int w = r < RL ? r / TL : 2;
    const float* mb = p.mods + (size_t)(layer * 3 + w) * 6144;
    float* xo = r < RL ? p.out + (size_t)r * D : p.xc + (size_t)(r - RL) * D;
    const int myinv = inv_n;
    { const int rn = r + nblk * 4; inv_n = (rn < rows && lane < NE) ? p.INV[(size_t)rn * NE + lane] : -1; }
    f32x4 f[4], xv[4];
    ld_row16(xo, lane, xv);
#pragma unroll
    for (int i = 0; i < 4; ++i) f[i] = (f32x4){0.f, 0.f, 0.f, 0.f};
    unsigned mask = wave_ballot16(myinv >= 0);
#pragma unroll 1
    while (mask) {
      const int e0 = __builtin_ctz(mask); mask &= mask - 1;
      const bool two = mask != 0u;
      const int e1 = two ? __builtin_ctz(mask) : e0; if (two) mask &= mask - 1;
      const int s0 = lane_bcast(myinv, e0), s1 = lane_bcast(myinv, e1);
      f32x4 y0[4], y1[4];
      ld_row16_bf(p.YE + ((size_t)e0 * NSLOT + s0) * D, lane, y0); ld_row16_bf(p.YE + ((size_t)e1 * NSLOT + s1) * D, lane, y1);
      const float w1 = two ? 1.0f : 0.0f;
#pragma unroll
      for (int i = 0; i < 4; ++i) f[i] += y0[i] + y1[i] * w1;
    }
    float ss = 0.f;
#pragma unroll
    for (int i = 0; i < 4; ++i)
#pragma unroll
      for (int e = 0; e < 4; ++e) ss += f[i][e] * f[i][e];
    const float rstd = 1.0f / sqrtf(wave_sum(ss) * (1.0f / D) + 1e-6f);
    f32x4 a[4], c[4];
    ld_row16(mb + 5 * 1024, lane, a); ld_row16(p.g_ffn_post + layer * 1024, lane, c);
    float s2 = 0.f;
#pragma unroll
    for (int i = 0; i < 4; ++i) {
#pragma unroll
      for (int e = 0; e < 4; ++e) { xv[i][e] += a[i][e] * f[i][e] * rstd * c[i][e]; s2 += xv[i][e] * xv[i][e]; }
      *(f32x4*)(xo + 256 * i + 4 * lane) = xv[i];
    }
    if (layer == 0) {
      const float rstd2 = 1.0f / sqrtf(wave_sum(s2) * (1.0f / D) + 1e-6f);
      const float* mb1 = p.mods + (size_t)(3 + w) * 6144;
      f32x4 sh[4];
      ld_row16(p.g_mix_pre + 1024, lane, a); ld_row16(mb1 + 1024, lane, c); ld_row16(mb1, lane, sh);
#pragma unroll
      for (int i = 0; i < 4; ++i) {
        f32x4 o;
#pragma unroll
        for (int e = 0; e < 4; ++e) o[e] = xv[i][e] * rstd2 * a[i][e] * (1.f + c[i][e]) + sh[i][e];
        st_bf16x4(p.H + (size_t)r * D + 256 * i + 4 * lane, o);
      }
    }
  }
}
DI void ph_mods(const Params& p, char* lds, int bid, int nblk) {
  float* sc = (float*)lds;
  const int t = TIDX;
  for (int i = t; i < 3 * 1024; i += NTHR) { const float v = i < 2048 ? p.c[i] : p.c_ctx[i - 2048]; sc[i] = v / (1.0f + expf(-v)); }
  __syncthreads();
#pragma unroll 1
  for (long gi = (long)bid * NTHR + t; gi < 2 * 3 * 6144; gi += (long)nblk * NTHR) {
    const int col = (int)(gi % 6144), w = (int)((gi / 6144) % 3), l = (int)(gi / (3 * 6144));
    const float* W = p.w_ada + (size_t)l * 1024 * 6144 + col; const float* s = sc + w * 1024;
    float acc[8];
#pragma unroll
    for (int q = 0; q < 8; ++q) acc[q] = 0.f;
#pragma unroll 1
    for (int k = 0; k < 1024; k += 8) {
#pragma unroll
      for (int q = 0; q < 8; ++q) acc[q] += s[k + q] * W[(size_t)(k + q) * 6144];
    }
    p.mods[gi] = ((acc[0] + acc[1]) + (acc[2] + acc[3])) + ((acc[4] + acc[5]) + (acc[6] + acc[7])) + p.b_ada[l * 6144 + col];
  }
  __syncthreads();
}
constexpr int TOPK_LDS = TL * 4 + 2048;
DI int block_sum_i(int v, int* red) {
  const int lane = TIDX & 63, wid = TIDX >> 6;
  v = xor_sum_i<1>(v); v = xor_sum_i<2>(v); v = xor_sum_i<4>(v); v = xor_sum_i<8>(v); v = xor_sum_i<16>(v); v = xor_sum_i<32>(v);
  __syncthreads();
  if (lane == 0) red[wid] = v;
  __syncthreads();
  return red[0] + red[1] + red[2] + red[3];
}
DI int block_excl_scan(int v, int* red) {
  const int lane = TIDX & 63, wid = TIDX >> 6;
  int inc = v;
#pragma unroll
  for (int d = 1; d < 64; d <<= 1) { const int o = lane_up(inc, d, lane); if (lane >= d) inc += o; }
  __syncthreads();
  if (lane == 63) red[wid] = inc;
  __syncthreads();
  int base = 0;
  for (int q = 0; q < wid; ++q) base += red[q];
  return base + inc - v;
}
DI void ph_topk(const Params& p, int need_ctx, char* lds, int bid, int nblk) {
  unsigned* vals = (unsigned*)lds; int* red = (int*)(lds + TL * 4 + 1024);
  const int t = TIDX;
  for (int u = bid; u < NB * NE * 2; u += nblk) {
    const int seg = u & 1, e = (u >> 1) % NE, b = u / (2 * NE);
    const int s0 = seg ? TC : 0, n = seg ? TL : TC, cap = seg ? CAPL : CAPC, slot0 = seg ? b * CAPL : NB * CAPL + b * CAPC;
    if (seg == 0 && !need_ctx) { for (int q = t; q < cap; q += NTHR) p.SEL[(size_t)e * NSLOT + slot0 + q] = -1; continue; }
    const float* a = p.AFF + ((size_t)b * NE + e) * TK + s0;
    const int vpt = (n + NTHR - 1) / NTHR, i0 = t * vpt, i1 = (i0 + vpt < n) ? i0 + vpt : n;
    for (int i = t; i < n; i += NTHR) vals[i + i / vpt] = f2u(a[i]);
    __syncthreads();
    unsigned thr = 0;
    for (int bit = 31; bit >= 0; --bit) {
      const unsigned cand = thr | (1u << bit);
      int cnt = 0;
      for (int i = i0; i < i1; ++i) cnt += (vals[i + t] >= cand);
      if (block_sum_i(cnt, red) >= cap) thr = cand;
    }
    int cgt = 0, ceq = 0;
    for (int i = i0; i < i1; ++i) { cgt += (vals[i + t] > thr); ceq += (vals[i + t] == thr); }
    const int ngt = block_sum_i(cgt, red);
    const int neq = cap - ngt;
    int eqoff = block_excl_scan(ceq, red);
    int csel = 0;
    { int er = eqoff; for (int i = i0; i < i1; ++i) { if (vals[i + t] > thr) ++csel; else if (vals[i + t] == thr) { if (er < neq) ++csel; ++er; } } }
    int q = block_excl_scan(csel, red);
    for (int i = i0; i < i1; ++i) {
      const unsigned v = vals[i + t]; int sel = -1;
      if (v > thr) sel = q++; else if (v == thr) { if (eqoff < neq) sel = q++; ++eqoff; }
      const int r = row_of(b, s0 + i);
      if (sel >= 0) { p.SEL[(size_t)e * NSLOT + slot0 + sel] = r; p.SELV[(size_t)e * NSLOT + slot0 + sel] = u2f(v); }
      p.INV[(size_t)r * NE + e] = sel >= 0 ? slot0 + sel : -1;
    }
    __syncthreads();
  }
}
DI void ph_wt(const float* in, bf16_t* out, int K, int N, int NP, int nbatch, long in_bs, long out_bs, const float* gain, char* lds, int bid, int nblk) {
  float* tile = (float*)lds;
  const int t = TIDX, tk = K / 64, tn = NP / 64, ntile = nbatch * tk * tn;
  f32x4 v[4];
  auto gload = [&](int u) {
    const int bt = u / (tk * tn), rem = u % (tk * tn), k0 = (rem / tn) * 64, n0 = (rem % tn) * 64;
    const float* I = in + (size_t)bt * in_bs;
#pragma unroll
    for (int i = 0; i < 4; ++i) {
      const int idx = t + i * NTHR, kk = idx >> 4, n4 = (idx & 15) * 4;
      v[i] = (f32x4){0.f, 0.f, 0.f, 0.f};
      if (n0 + n4 < N) v[i] = *(const f32x4*)(I + (size_t)(k0 + kk) * N + n0 + n4);
      if (gain) { const float g = gain[k0 + kk]; v[i][0] *= g; v[i][1] *= g; v[i][2] *= g; v[i][3] *= g; }
    }
  };
  if (bid < ntile) gload(bid);
#pragma unroll 1
  for (int u = bid; u < ntile; u += nblk) {
    const int bt = u / (tk * tn), rem = u % (tk * tn), k0 = (rem / tn) * 64, n0 = (rem % tn) * 64;
    bf16_t* O = out + (size_t)bt * out_bs;
#pragma unroll
    for (int i = 0; i < 4; ++i) { const int idx = t + i * NTHR, kk = idx >> 4, n4 = (idx & 15) * 4; float* d = tile + kk * 65 + n4; d[0] = v[i][0]; d[1] = v[i][1]; d[2] = v[i][2]; d[3] = v[i][3]; }
    __syncthreads();
    if (u + nblk < ntile) gload(u + nblk);
#pragma unroll
    for (int i = 0; i < 2; ++i) {
      const int idx = t + i * NTHR, kg = idx & 7, nn = idx >> 3;
      float a[8];
#pragma unroll
      for (int e = 0; e < 8; ++e) a[e] = tile[(kg * 8 + e) * 65 + nn];
      u32x4 o; o.x = pack2bf(a[0], a[1]); o.y = pack2bf(a[2], a[3]); o.z = pack2bf(a[4], a[5]); o.w = pack2bf(a[6], a[7]);
      *(u32x4*)(O + (size_t)(n0 + nn) * K + k0 + kg * 8) = o;
    }
    __syncthreads();
  }
}
DI float wave_max(float v) {
  v = xor_max<1>(v); v = xor_max<2>(v); v = xor_max<4>(v); v = xor_max<8>(v); v = xor_max<16>(v); v = xor_max<32>(v);
  return v;
}
DI bf16x8 cvt8(const float* f) {
  const f32x4 a = *(const f32x4*)f, b = *(const f32x4*)(f + 4);
  u32x4 pk; pk.x = pack2bf(a[0], a[1]); pk.y = pack2bf(a[2], a[3]); pk.z = pack2bf(b[0], b[1]); pk.w = pack2bf(b[2], b[3]);
  return __builtin_bit_cast(bf16x8, pk);
}
constexpr int SCAN_UNITS = NB * NCK * 4, SCAN_LAT_UNITS = NB * NCL * 4;
DI void scan_unit(int u, int& b, int& c, int& h) {
  h = u & 3;
  if (u < SCAN_LAT_UNITS) { c = NCC + (u >> 2) % NCL; b = u / (4 * NCL); } else { const int v = u - SCAN_LAT_UNITS; c = (v >> 2) % NCC; b = v / (4 * NCC); }
}

DI void ph_ml_local(const Params& p, char* lds, int bid, int nblk) {
  bf16_t* sK = (bf16_t*)lds;
  float* sW = (float*)(lds + 64 * 132);
  const int t = TIDX, lane = t & 63, wid = t >> 6, l31 = lane & 31, hh = lane >> 5;
  const int d = wid & 1, vt = wid >> 1;
#pragma unroll 1
  for (int u = bid; u < SCAN_UNITS; u += nblk) {
    int b, c, h; scan_unit(u, b, c, h);
    {
      const int row = t >> 2, seg = (t & 3) * 16;
      const bf16_t* src = p.MK + ((size_t)b * TK + 64 * c + row) * 256 + h * 64 + seg;
      const u32x4 a = ldg16(src), bb = ldg16(src + 8);
      unsigned* dst = (unsigned*)((char*)sK + row * 132 + seg * 2);
      dst[0] = a.x; dst[1] = a.y; dst[2] = a.z; dst[3] = a.w; dst[4] = bb.x; dst[5] = bb.y; dst[6] = bb.z; dst[7] = bb.w;
    }
    if (t < 128) {
      const int dd = t >> 6, l = t & 63, j = step_of(dd, c), pos = dd ? 63 - l : l;
      const size_t o = (((size_t)b * 2 + dd) * TK + 64 * j) * 4 + h;
      const float bend = p.BC[o + 63 * 4], wl = bend - p.BC[o + pos * 4] + p.IGS[o + pos * 4];
      const float ml = wave_max(wl);
      sW[dd * 64 + l] = expf(wl - ml);
      if (l == 0) { const size_t uu = (((size_t)b * 2 + dd) * NCK + j) * 4 + h; p.MM[uu * 4] = ml; p.MM[uu * 4 + 1] = bend; }
    }
    __syncthreads();
    const int j = step_of(d, c);
    const size_t uu = (((size_t)b * 2 + d) * NCK + j) * 4 + h;
    f32x16 acc[2]; acc[0] = (f32x16)(0.f); acc[1] = (f32x16)(0.f);
    const bf16_t* vsrc = p.MVt + (((size_t)b * 4 + h) * 64 + vt * 32 + l31) * TK + 64 * c;
#pragma unroll
    for (int ks = 0; ks < 4; ++ks) {
      const bf16x8 a = *(const bf16x8*)(vsrc + ks * 16 + 8 * hh);
      const float* w = sW + d * 64 + ks * 16 + 8 * hh;
      u32x4 pk;
      pk.x = pack2bf(bf2f((bf16_t)a[0]) * w[0], bf2f((bf16_t)a[1]) * w[1]); pk.y = pack2bf(bf2f((bf16_t)a[2]) * w[2], bf2f((bf16_t)a[3]) * w[3]);
      pk.z = pack2bf(bf2f((bf16_t)a[4]) * w[4], bf2f((bf16_t)a[5]) * w[5]); pk.w = pack2bf(bf2f((bf16_t)a[6]) * w[6], bf2f((bf16_t)a[7]) * w[7]);
      const bf16x8 af = __builtin_bit_cast(bf16x8, pk);
#pragma unroll
      for (int kt = 0; kt < 2; ++kt) {
        bf16x8 bfr;
#pragma unroll
        for (int q = 0; q < 8; ++q) bfr[q] = (short)sK[(ks * 16 + 8 * hh + q) * 66 + kt * 32 + l31];
        acc[kt] = MFMA32(af, bfr, acc[kt]);
      }
    }
#pragma unroll
    for (int kt = 0; kt < 2; ++kt)
#pragma unroll
      for (int i = 0; i < 16; ++i) p.MC[uu * 4096 + (size_t)(vt * 32 + (i & 3) + 8 * (i >> 2) + 4 * hh) * 64 + kt * 32 + l31] = acc[kt][i];
    float nl = 0.f;
    for (int q = 0; q < 32; ++q) { const int l = hh * 32 + q; nl += sW[d * 64 + l] * bf2f(sK[l * 66 + vt * 32 + l31]); }
    nl = xor_sum<32>(nl);
    if (hh == 0) p.MN[uu * 64 + vt * 32 + l31] = nl;
    __syncthreads();
  }
}
constexpr int SCAN_PF = 8;
DI void ph_ml_scan(const Params& p, int bid, int nblk) {
  for (long gi = (long)bid * NTHR + TIDX; gi < (long)NB * 2 * 4 * 4160; gi += (long)nblk * NTHR) {
    const int e = (int)(gi % 4160), ch = (int)(gi / 4160), h = ch & 3, bd = ch >> 2;
    float* base = e < 4096 ? p.MC + (((size_t)bd * NCK) * 4 + h) * 4096 + e : p.MN + (((size_t)bd * NCK) * 4 + h) * 64 + (e - 4096);
    const size_t stride = e < 4096 ? 4 * 4096 : 4 * 64;
    float* mm = p.MM + (((size_t)bd * NCK) * 4 + h) * 4;
    float st = 0.f, m = -1e30f;
    float cl[SCAN_PF], cm[SCAN_PF], cb[SCAN_PF], nl[SCAN_PF], nm[SCAN_PF], nb[SCAN_PF];
#pragma unroll
    for (int q = 0; q < SCAN_PF; ++q) if (q < NCK) { cl[q] = base[(size_t)q * stride]; cm[q] = mm[q * 16]; cb[q] = mm[q * 16 + 1]; }
#pragma unroll 1
    for (int jb = 0; jb < NCK; jb += SCAN_PF) {
#pragma unroll
      for (int q = 0; q < SCAN_PF; ++q) { const int j = jb + SCAN_PF + q; if (j < NCK) { nl[q] = base[(size_t)j * stride]; nm[q] = mm[j * 16]; nb[q] = mm[j * 16 + 1]; } }
#pragma unroll
      for (int q = 0; q < SCAN_PF; ++q) {
        const int j = jb + q;
        if (j < NCK) {
          const float mn = fmaxf(cb[q] + m, cm[q]), a = expf(cb[q] + m - mn), g = expf(cm[q] - mn);
          base[(size_t)j * stride] = st;
          st = a * st + g * cl[q];
          if (e == 0) mm[j * 16 + 2] = m;
          m = mn;
        }
      }
#pragma unroll
      for (int q = 0; q < SCAN_PF; ++q) { cl[q] = nl[q]; cm[q] = nm[q]; cb[q] = nb[q]; }
    }
  }
}
DI void ph_gla_scan(const Params& p, int bid, int nblk) {
  for (long gi = (long)bid * NTHR + TIDX; gi < (long)NB * 2 * 4 * 2048; gi += (long)nblk * NTHR) {
    const int e = (int)(gi % 2048), ch = (int)(gi / 2048), h = ch & 3, bd = ch >> 2, k = e & 31;
    float* base = p.GS + (((size_t)bd * NCK) * 4 + h) * 2048 + e;
    const float* ge = p.GC + ((size_t)bd * TK + 63) * 128 + h * 32 + k;
    float st = 0.f;
    float cl[SCAN_PF], cg[SCAN_PF], nl[SCAN_PF], ng[SCAN_PF];
#pragma unroll
    for (int q = 0; q < SCAN_PF; ++q) if (q < NCK) { cl[q] = base[(size_t)q * 4 * 2048]; cg[q] = ge[(size_t)q * 64 * 128]; }
#pragma unroll 1
    for (int jb = 0; jb < NCK; jb += SCAN_PF) {
#pragma unroll
      for (int q = 0; q < SCAN_PF; ++q) { const int j = jb + SCAN_PF + q; if (j < NCK) { nl[q] = base[(size_t)j * 4 * 2048]; ng[q] = ge[(size_t)j * 64 * 128]; } }
#pragma unroll
      for (int q = 0; q < SCAN_PF; ++q) {
        const int j = jb + q;
        if (j < NCK) { base[(size_t)j * 4 * 2048] = st; st = expf(cg[q]) * st + cl[q]; }
      }
#pragma unroll
      for (int q = 0; q < SCAN_PF; ++q) { cl[q] = nl[q]; cg[q] = ng[q]; }
    }
  }
}
constexpr int MO_K = 0, MO_V = 64 * 144, MO_A = MO_V + 64 * VROW, MO_PM = MO_A + 512, MO_N0 = MO_PM + 512, MO_X = MO_N0 + 512, MO_LDS = MO_X + 16384;
DI void ph_ml_out(const Params& p, int layer, int need_ctx, char* lds, int bid, int nblk) {
  float* sA = (float*)(lds + MO_A); float* sPM = (float*)(lds + MO_PM); float* sN0 = (float*)(lds + MO_N0); float* sX = (float*)(lds + MO_X);
  const int t = TIDX, lane = t & 63, wid = t >> 6, l31 = lane & 31, hh = lane >> 5;
  const int lt = wid & 1, d = wid >> 1;
#pragma unroll 1
  for (int u = bid; u < (need_ctx ? SCAN_UNITS : SCAN_LAT_UNITS); u += nblk) {
    int b, c, h; scan_unit(u, b, c, h);
    {
      const int row = t >> 2, seg = (t & 3) * 16;
      const bf16_t* ks = p.MK + ((size_t)b * TK + 64 * c + row) * 256 + h * 64 + seg;
      sts16(lds + MO_K + row * 144 + seg * 2, ldg16(ks)); sts16(lds + MO_K + row * 144 + seg * 2 + 16, ldg16(ks + 8));
      const bf16_t* vs = p.MVt + (((size_t)b * 4 + h) * 64 + row) * TK + 64 * c + seg;
      const u32x4 v0 = ldg16(vs), v1 = ldg16(vs + 8);
      u32x2* dv = (u32x2*)(lds + MO_V + row * VROW + seg * 2);
      u32x2 q; q.x = v0.x; q.y = v0.y; dv[0] = q; q.x = v0.z; q.y = v0.w; dv[1] = q; q.x = v1.x; q.y = v1.y; dv[2] = q; q.x = v1.z; q.y = v1.w; dv[3] = q;
    }
    if (t < 128) {
      const int dd = t >> 6, s = t & 63, j = step_of(dd, c), pos = dd ? 63 - s : s;
      const size_t o = (((size_t)b * 2 + dd) * TK + 64 * j) * 4 + h;
      sA[dd * 64 + s] = p.IGS[o + pos * 4] - p.BC[o + pos * 4];
      const size_t uu = (((size_t)b * 2 + dd) * NCK + j) * 4 + h;
      sN0[dd * 64 + s] = p.MN[uu * 64 + s];
    }
    __syncthreads();
    if (t < 2) {
      float m = -1e30f;
      if (t == 0) { for (int s = 0; s < 64; ++s) { m = fmaxf(m, sA[s]); sPM[s] = m; } }
      else { for (int s = 63; s >= 0; --s) { m = fmaxf(m, sA[64 + s]); sPM[64 + s] = m; } }
    }
    __syncthreads();
    const int j = step_of(d, c);
    const size_t uu = (((size_t)b * 2 + d) * NCK + j) * 4 + h;
    const int l = lt * 32 + l31, pos = d ? 63 - l : l;
    const float bl = p.BC[(((size_t)b * 2 + d) * TK + 64 * j + pos) * 4 + h];
    const float inter = bl + p.MM[uu * 4 + 2];
    const float mt = fmaxf(inter, bl + sPM[d * 64 + l]);
    const float aint = expf(inter - mt);
    bf16x8 qf[4];
#pragma unroll
    for (int ks = 0; ks < 4; ++ks) qf[ks] = *(const bf16x8*)(p.MQ + ((size_t)b * TK + 64 * c + l) * 256 + h * 64 + ks * 16 + 8 * hh);
    f32x16 num[2]; num[0] = (f32x16)(0.f); num[1] = (f32x16)(0.f);
    float den = 0.f;
#pragma unroll
    for (int st = 0; st < 2; ++st) {
      if (d == 0 ? st <= lt : st >= lt) {
        f32x16 S = (f32x16)(0.f);
#pragma unroll
        for (int ks = 0; ks < 4; ++ks) S = MFMA32(lds_frag(lds + MO_K + (st * 32 + l31) * 144 + (ks * 16 + 8 * hh) * 2), qf[ks], S);
#pragma unroll
        for (int i = 0; i < 16; ++i) {
          const int s = st * 32 + (i & 3) + 8 * (i >> 2) + 4 * hh;
          const bool ok = d == 0 ? s <= l : s >= l;
          const float e = ok ? fast_exp2((bl + sA[d * 64 + s] - mt) * LOG2E) * S[i] : 0.f;
          S[i] = e; den += e;
        }
#pragma unroll
        for (int kst = 0; kst < 2; ++kst) {
          const bf16x8 pf = pack8(S, kst);
#pragma unroll
          for (int vt = 0; vt < 2; ++vt) {
            const char* vp = lds + MO_V + (vt * 32 + l31) * VROW + (st * 32 + kst * 16 + 4 * hh) * 2;
            const s16x4 lo = *(const s16x4*)vp, hi = *(const s16x4*)(vp + 16);
            num[vt] = MFMA32(__builtin_shufflevector(lo, hi, 0, 1, 2, 3, 4, 5, 6, 7), pf, num[vt]);
          }
        }
      }
    }
    f32x16 accI[2]; accI[0] = (f32x16)(0.f); accI[1] = (f32x16)(0.f);
#pragma unroll
    for (int vt = 0; vt < 2; ++vt)
#pragma unroll
      for (int ks = 0; ks < 4; ++ks) accI[vt] = MFMA32(cvt8(p.MC + uu * 4096 + (size_t)(vt * 32 + l31) * 64 + ks * 16 + 8 * hh), qf[ks], accI[vt]);
    float qn = 0.f;
#pragma unroll
    for (int ks = 0; ks < 4; ++ks)
#pragma unroll
      for (int q = 0; q < 8; ++q) qn += bf2f((bf16_t)qf[ks][q]) * sN0[d * 64 + ks * 16 + 8 * hh + q];
    den = xor_sum<32>(den + aint * qn);
    const float inv = 1.0f / fmaxf(fabsf(den), expf(-mt));
#pragma unroll
    for (int vt = 0; vt < 2; ++vt)
#pragma unroll
      for (int i = 0; i < 16; ++i) num[vt][i] = (num[vt][i] + aint * accI[vt][i]) * inv;
    if (d == 1) {
#pragma unroll
      for (int vt = 0; vt < 2; ++vt)
#pragma unroll
        for (int i = 0; i < 16; ++i) sX[(lt * 32 + vt * 16 + i) * 64 + lane] = num[vt][i];
    }
    __syncthreads();
    if (d == 0) {
      float ss = 0.f;
#pragma unroll
      for (int vt = 0; vt < 2; ++vt)
#pragma unroll
        for (int i = 0; i < 16; ++i) { num[vt][i] += sX[(lt * 32 + vt * 16 + i) * 64 + lane]; ss += num[vt][i] * num[vt][i]; }
      ss = xor_sum<32>(ss);
      const float rstd = 1.0f / sqrtf(ss * (1.0f / 64) + 1e-6f);
      const int r = row_of(b, 64 * c + l);
#pragma unroll
      for (int vt = 0; vt < 2; ++vt)
#pragma unroll
        for (int g = 0; g < 4; ++g) {
          const int v0 = vt * 32 + 8 * g + 4 * hh;
          const u32x2 ou = *(const u32x2*)(p.Z + (size_t)r * NZP + ZC_MLO + h * 64 + v0);
          const f32x4 gv = *(const f32x4*)(p.g_mlstm_out + layer * 256 + h * 64 + v0);
          const float o0 = u2f(ou.x << 16), o1 = u2f(ou.x & 0xffff0000u), o2 = u2f(ou.y << 16), o3 = u2f(ou.y & 0xffff0000u);
          f32x4 y = {sigmoidf_(o0) * num[vt][4 * g] * rstd * gv[0], sigmoidf_(o1) * num[vt][4 * g + 1] * rstd * gv[1],
                     sigmoidf_(o2) * num[vt][4 * g + 2] * rstd * gv[2], sigmoidf_(o3) * num[vt][4 * g + 3] * rstd * gv[3]};
          st_bf16x4(p.Y + (size_t)r * D + 256 + h * 64 + v0, y);
        }
    }
    __syncthreads();
  }
}
DI void ph_gla_local(const Params& p, char* lds, int bid, int nblk) {
  bf16_t* sKd = (bf16_t*)lds;
  const int t = TIDX, lane = t & 63, wid = t >> 6, l31 = lane & 31, hh = lane >> 5;
  const int d = wid & 1, vt = wid >> 1;
#pragma unroll 1
  for (int u = bid; u < SCAN_UNITS; u += nblk) {
    int b, c, h; scan_unit(u, b, c, h);
    {
      const int dd = t >> 7, l = (t >> 1) & 63, k0 = (t & 1) * 16, j = step_of(dd, c), pos = dd ? 63 - l : l;
      const float* gcr = p.GC + (((size_t)b * 2 + dd) * TK + 64 * j + pos) * 128 + h * 32 + k0;
      const float* ger = p.GC + (((size_t)b * 2 + dd) * TK + 64 * j + 63) * 128 + h * 32 + k0;
      const bf16_t* kr = p.Z + (size_t)row_of(b, 64 * c + l) * NZP + ZC_GK + h * 32 + k0;
#pragma unroll
      for (int q = 0; q < 16; ++q) sKd[(dd * 64 + l) * 33 + k0 + q] = f2bf(bf2f(kr[q]) * fast_exp2((ger[q] - gcr[q]) * LOG2E));
    }
    __syncthreads();
    const int j = step_of(d, c);
    const size_t uu = (((size_t)b * 2 + d) * NCK + j) * 4 + h;
    f32x16 acc = (f32x16)(0.f);
    const bf16_t* vsrc = p.GVt + (((size_t)b * 4 + h) * 64 + vt * 32 + l31) * TK + 64 * c;
#pragma unroll
    for (int ks = 0; ks < 4; ++ks) {
      const bf16x8 af = *(const bf16x8*)(vsrc + ks * 16 + 8 * hh);
      bf16x8 bfr;
#pragma unroll
      for (int q = 0; q < 8; ++q) bfr[q] = (short)sKd[(d * 64 + ks * 16 + 8 * hh + q) * 33 + l31];
      acc = MFMA32(af, bfr, acc);
    }
#pragma unroll
    for (int i = 0; i < 16; ++i) p.GS[uu * 2048 + (size_t)(vt * 32 + (i & 3) + 8 * (i >> 2) + 4 * hh) * 32 + l31] = acc[i];
    __syncthreads();
  }
}
constexpr int GO_Q = 0, GO_K = 2 * 64 * 80, GO_V = 2 * GO_K, GO_X = GO_V + 64 * VROW, GO_LDS = GO_X + 16384;
DI void ph_gla_out(const Params& p, int layer, int need_ctx, char* lds, int bid, int nblk) {
  float* sX = (float*)(lds + GO_X);
  const int t = TIDX, lane = t & 63, wid = t >> 6, l31 = lane & 31, hh = lane >> 5;
  const int lt = wid & 1, d = wid >> 1;
#pragma unroll 1
  for (int u = bid; u < (need_ctx ? SCAN_UNITS : SCAN_LAT_UNITS); u += nblk) {
    int b, c, h; scan_unit(u, b, c, h);
    {
      const int dd = t >> 7, l = (t >> 1) & 63, k0 = (t & 1) * 16, j = step_of(dd, c), pos = dd ? 63 - l : l;
      const float* gcr = p.GC + (((size_t)b * 2 + dd) * TK + 64 * j + pos) * 128 + h * 32 + k0;
      const bf16_t* zr = p.Z + (size_t)row_of(b, 64 * c + l) * NZP;
      bf16_t* qd = (bf16_t*)(lds + GO_Q + (dd * 64 + l) * 80) + k0; bf16_t* kd = (bf16_t*)(lds + GO_K + (dd * 64 + l) * 80) + k0;
#pragma unroll
      for (int q = 0; q < 16; ++q) {
        const float g = gcr[q];
        qd[q] = f2bf(bf2f(zr[ZC_GQ + h * 32 + k0 + q]) * 0.17677669529663687f * fast_exp2(g * LOG2E));
        kd[q] = f2bf(bf2f(zr[ZC_GK + h * 32 + k0 + q]) * fast_exp2(-g * LOG2E));
      }
      const int row = t >> 2, seg = (t & 3) * 16;
      const bf16_t* vs = p.GVt + (((size_t)b * 4 + h) * 64 + row) * TK + 64 * c + seg;
      const u32x4 v0 = ldg16(vs), v1 = ldg16(vs + 8);
      u32x2* dv = (u32x2*)(lds + GO_V + row * VROW + seg * 2);
      u32x2 q2; q2.x = v0.x; q2.y = v0.y; dv[0] = q2; q2.x = v0.z; q2.y = v0.w; dv[1] = q2; q2.x = v1.x; q2.y = v1.y; dv[2] = q2; q2.x = v1.z; q2.y = v1.w; dv[3] = q2;
    }
    __syncthreads();
    const int j = step_of(d, c);
    const size_t uu = (((size_t)b * 2 + d) * NCK + j) * 4 + h;
    const int l = lt * 32 + l31;
    bf16x8 qf[2];
#pragma unroll
    for (int ks = 0; ks < 2; ++ks) qf[ks] = lds_frag(lds + GO_Q + (d * 64 + l) * 80 + (ks * 16 + 8 * hh) * 2);
    f32x16 O[2]; O[0] = (f32x16)(0.f); O[1] = (f32x16)(0.f);
#pragma unroll
    for (int st = 0; st < 2; ++st) {
      if (d == 0 ? st <= lt : st >= lt) {
        f32x16 S = (f32x16)(0.f);
#pragma unroll
        for (int ks = 0; ks < 2; ++ks) S = MFMA32(lds_frag(lds + GO_K + (d * 64 + st * 32 + l31) * 80 + (ks * 16 + 8 * hh) * 2), qf[ks], S);
#pragma unroll
        for (int i = 0; i < 16; ++i) {
          const int s = st * 32 + (i & 3) + 8 * (i >> 2) + 4 * hh;
          const bool ok = d == 0 ? s <= l : s >= l;
          S[i] = ok ? S[i] : 0.f;
        }
#pragma unroll
        for (int kst = 0; kst < 2; ++kst) {
          const bf16x8 pf = pack8(S, kst);
#pragma unroll
          for (int vt = 0; vt < 2; ++vt) {
            const char* vp = lds + GO_V + (vt * 32 + l31) * VROW + (st * 32 + kst * 16 + 4 * hh) * 2;
            const s16x4 lo = *(const s16x4*)vp, hi = *(const s16x4*)(vp + 16);
            O[vt] = MFMA32(__builtin_shufflevector(lo, hi, 0, 1, 2, 3, 4, 5, 6, 7), pf, O[vt]);
          }
        }
      }
    }
#pragma unroll
    for (int vt = 0; vt < 2; ++vt)
#pragma unroll
      for (int ks = 0; ks < 2; ++ks) O[vt] = MFMA32(cvt8(p.GS + uu * 2048 + (size_t)(vt * 32 + l31) * 32 + ks * 16 + 8 * hh), qf[ks], O[vt]);
    if (d == 1) {
#pragma unroll
      for (int vt = 0; vt < 2; ++vt)
#pragma unroll
        for (int i = 0; i < 16; ++i) sX[(lt * 32 + vt * 16 + i) * 64 + lane] = O[vt][i];
    }
    __syncthreads();
    if (d == 0) {
      float ss = 0.f;
#pragma unroll
      for (int vt = 0; vt < 2; ++vt)
#pragma unroll
        for (int i = 0; i < 16; ++i) { O[vt][i] += sX[(lt * 32 + vt * 16 + i) * 64 + lane]; ss += O[vt][i] * O[vt][i]; }
      ss = xor_sum<32>(ss);
      const float rstd = 1.0f / sqrtf(ss * (1.0f / 64) + 1e-6f);
      const int r = row_of(b, 64 * c + l);
#pragma unroll
      for (int vt = 0; vt < 2; ++vt)
#pragma unroll
        for (int g = 0; g < 4; ++g) {
          const int v0 = vt * 32 + 8 * g + 4 * hh;
          const u32x2 ru = *(const u32x2*)(p.Z + (size_t)r * NZP + ZC_GR + h * 64 + v0);
          const f32x4 gv = *(const f32x4*)(p.g_gla_out + layer * 256 + h * 64 + v0);
          const float r0 = u2f(ru.x << 16), r1 = u2f(ru.x & 0xffff0000u), r2 = u2f(ru.y << 16), r3 = u2f(ru.y & 0xffff0000u);
          f32x4 y = {siluf_(r0) * O[vt][4 * g] * rstd * gv[0], siluf_(r1) * O[vt][4 * g + 1] * rstd * gv[1],
                     siluf_(r2) * O[vt][4 * g + 2] * rstd * gv[2], siluf_(r3) * O[vt][4 * g + 3] * rstd * gv[3]};
          st_bf16x4(p.Y + (size_t)r * D + 512 + h * 64 + v0, y);
        }
    }
    __syncthreads();
  }
}

DI float fast_logsigmoid(float x) {
  const float e = fast_exp2(-fabsf(x) * LOG2E);
#ifdef CPU_EMU
  return fminf(x, 0.f) - log1pf(e);
#else
  return fminf(x, 0.f) - 0.6931471805599453f * __builtin_amdgcn_logf(1.0f + e);
#endif
}
DI float wave_incl_scan(float v, int lane) {
#pragma unroll
  for (int dd = 1; dd < 64; dd <<= 1) { const float o = u2f((unsigned)lane_up((int)f2u(v), dd, lane)); if (lane >= dd) v += o; }
  return v;
}
constexpr int GCUM_LDS = 4 * 64 * 33 * 4;
DI void ph_gates_cum(const Params& p, int layer, char* lds, int bid, int nblk) {
  const int t = TIDX, lane = t & 63, wid = t >> 6;
  float* stg = (float*)lds + wid * 64 * 33;
  const float* wal = p.w_alpha2 + (size_t)layer * 2 * 16 * 128;
#pragma unroll 1
  for (int u = bid * 4 + wid; u < NB * 2 * NCK; u += nblk * 4) {
    const int j = u % NCK, d = (u / NCK) & 1, b = u / (2 * NCK);
    const int pp = 64 * j + lane, s = seq_of(d, pp);
    const bf16_t* z = p.Z + (size_t)row_of(b, s) * NZP;
    const size_t ob = ((size_t)b * 2 + d) * TK + pp;
    {
      const u32x2 iu = *(const u32x2*)(z + ZC_MLIG + d * 4), fu = *(const u32x2*)(z + ZC_MLFG + d * 4);
      const float ig[4] = {u2f(iu.x << 16), u2f(iu.x & 0xffff0000u), u2f(iu.y << 16), u2f(iu.y & 0xffff0000u)};
      const float fg[4] = {u2f(fu.x << 16), u2f(fu.x & 0xffff0000u), u2f(fu.y << 16), u2f(fu.y & 0xffff0000u)};
      f32x4 oc, oi;
#pragma unroll
      for (int h = 0; h < 4; ++h) {
        oi[h] = ig[h] + p.b_igate[layer * 8 + d * 4 + h];
        oc[h] = wave_incl_scan(fast_logsigmoid(fg[h] + p.b_fgate[layer * 8 + d * 4 + h]), lane);
      }
      *(f32x4*)(p.BC + ob * 4) = oc; *(f32x4*)(p.IGS + ob * 4) = oi;
    }
    float a[16];
    { float f0[8], f1[8]; unpack8(ldg16(z + ZC_GA + d * 16), f0); unpack8(ldg16(z + ZC_GA + d * 16 + 8), f1);
#pragma unroll
      for (int q = 0; q < 8; ++q) { a[q] = f0[q]; a[8 + q] = f1[q]; } }
    const float* W = wal + (size_t)d * 16 * 128;
#pragma unroll 1
    for (int cg = 0; cg < 4; ++cg) {
#pragma unroll 4
      for (int c = 0; c < 32; ++c) {
        const int ch = cg * 32 + c;
        float zg = p.b_alpha[layer * 256 + d * 128 + ch];
#pragma unroll
        for (int q = 0; q < 16; ++q) zg += a[q] * W[q * 128 + ch];
        stg[lane * 33 + c] = wave_incl_scan(fast_logsigmoid(zg) * (1.0f / 16.0f), lane);
      }
      WAVE_SYNC();
#pragma unroll
      for (int k = 0; k < 32; ++k) { const int pos = k * 2 + (lane >> 5), c = lane & 31; p.GC[(((size_t)b * 2 + d) * TK + 64 * j + pos) * 128 + cg * 32 + c] = stg[pos * 33 + c]; }
      WAVE_SYNC();
    }
  }
}
#define XB_TMO      128
#define XB_XCNT(j)  (256  + 64 * (j))
#define XB_XSUB(j)  (1280 + 64 * (j))
#define XB_XGEN(j)  (2304 + 64 * (j))
#define XB_TOP      3328
#define XB_TOPGEN   3392
#define XCD_BAR_WORDS 3456
#define XB_SPIN_CAP (1u << 28)
#define LAS __attribute__((address_space(3)))

__device__ __forceinline__ unsigned xb_ld(unsigned* p)              { return __hip_atomic_load(p, __ATOMIC_RELAXED, __HIP_MEMORY_SCOPE_AGENT); }
__device__ __forceinline__ unsigned xb_add(unsigned* p, unsigned v) { return __hip_atomic_fetch_add(p, v, __ATOMIC_RELAXED, __HIP_MEMORY_SCOPE_AGENT); }
__device__ __forceinline__ unsigned xb_xcc_id() { return (unsigned)__builtin_amdgcn_s_getreg((3 << 11) | 20) & 0xFu; }
#define XB_SPIN(cond, bar) do { unsigned _sp = 0; while (cond) { __builtin_amdgcn_s_sleep(1); \
    if ((++_sp & 255u) == 0u) { if (xb_ld(&(bar)[XB_TMO])) break; if (_sp > XB_SPIN_CAP) { atomicAdd(&(bar)[XB_TMO], 1u); break; } } } } while (0)

struct XcdBarrier {
    unsigned* bar; unsigned x;
    volatile LAS unsigned* st;
};

__device__ __forceinline__ XcdBarrier xcd_barrier_post(unsigned* bar, volatile LAS unsigned* st) {
    XcdBarrier b; b.bar = bar; b.x = xb_xcc_id(); b.st = st;
    if (threadIdx.x == 0) (void)xb_add(&bar[XB_XCNT(b.x)], 1u);
    return b;
}
__device__ __forceinline__ void xcd_barrier_complete(unsigned* bar, unsigned x, unsigned& nloc, unsigned& nx) {
    const unsigned G = gridDim.x * gridDim.y * gridDim.z;
    unsigned sum, cnt, mine, sp = 0u;
    for (;;) {
        sum = 0u; cnt = 0u; mine = 0u;
#pragma unroll
        for (unsigned j = 0; j < 16; ++j) { const unsigned c = xb_ld(&bar[XB_XCNT(j)]); sum += c; cnt += (c > 0u) ? 1u : 0u; mine = (j == x) ? c : mine; }
        if (sum == G) break;
        __builtin_amdgcn_s_sleep(1);
        if ((++sp & 255u) == 0u) { if (xb_ld(&bar[XB_TMO])) break; if (sp > XB_SPIN_CAP) { atomicAdd(&bar[XB_TMO], 1u); break; } }
    }
    nloc = mine > 0u ? mine : 1u; nx = cnt > 0u ? cnt : 1u;
}

__device__ __forceinline__ void xcd_barrier(const XcdBarrier& b) {
    asm volatile("s_waitcnt vmcnt(0)" ::: "memory");
    __syncthreads();
    if (threadIdx.x == 0) {
        unsigned* bar = b.bar;
        __builtin_amdgcn_s_waitcnt(0);
        unsigned nloc = b.st[0], nx = b.st[1];
        if (nloc == 0u) { xcd_barrier_complete(bar, b.x, nloc, nx); b.st[0] = nloc; b.st[1] = nx; }
        const unsigned old = xb_add(&bar[XB_XSUB(b.x)], 1u);
        const unsigned gen = old / nloc;
        if (old + 1u == (gen + 1u) * nloc) {
            __builtin_amdgcn_fence(__ATOMIC_RELEASE, "agent");
            asm volatile("s_waitcnt vmcnt(0)" ::: "memory");
            const unsigned og = xb_add(&bar[XB_TOP], 1u);
            const unsigned tg = og / nx;
            if (og + 1u == (tg + 1u) * nx) xb_add(&bar[XB_TOPGEN], 1u);
            else XB_SPIN(xb_ld(&bar[XB_TOPGEN]) == tg, bar);
            __builtin_amdgcn_fence(__ATOMIC_ACQUIRE, "agent");
            xb_add(&bar[XB_XGEN(b.x)], 1u);
            asm volatile("s_waitcnt vmcnt(0)" ::: "memory");
        } else {
            XB_SPIN(xb_ld(&bar[XB_XGEN(b.x)]) == gen, bar);
            __builtin_amdgcn_fence(__ATOMIC_ACQUIRE, "agent");
            asm volatile("s_waitcnt vmcnt(0)" ::: "memory");
        }
    }
    __syncthreads();
}

#define GS_LOOP(N, CALL) for (long gi = (long)bid * NTHR + TIDX; gi < (long)(N); gi += (long)nblk * NTHR) { CALL; }
#ifndef PROBE
#define PROBE 0
#endif
#ifndef PROBE_MASK
#define PROBE_MASK 0
#endif
#ifndef FAST_SCAN
#define FAST_SCAN 1
#endif
constexpr int N_PHASES = 16;
constexpr int MEGA_LDS = GEMM_LDS > TOPK_LDS ? GEMM_LDS : TOPK_LDS;

DI void conv_expert(const Params& p, int which, int layer, char* lds, int bid, int nblk, int busy) {
  __syncthreads();
  if (bid < busy) return;
  if (which == 0) ph_wt(p.w_e_gate + (size_t)layer * NE * D * FF, p.Wt_eg, D, FF, FF, NE, (long)D * FF, (long)FF * D, nullptr, lds, bid - busy, nblk - busy);
  else if (which == 1) ph_wt(p.w_e_up + (size_t)layer * NE * D * FF, p.Wt_eu, D, FF, FF, NE, (long)D * FF, (long)FF * D, nullptr, lds, bid - busy, nblk - busy);
  else ph_wt(p.w_e_down + (size_t)layer * NE * FF * D, p.Wt_ed, FF, D, D, NE, (long)FF * D, (long)D * FF, nullptr, lds, bid - busy, nblk - busy);
}
template <int PH>
DI void run_phase(const Params& p, int l, char* lds, int bid, int nblk) {
  const int need_ctx = (l == 0);
  const int rows = need_ctx ? R : RL;
  const float* xl_in = l == 0 ? p.x : p.out;
  const float* xc_in = l == 0 ? p.ctx : p.xc;
  bf16_t* QRAW = p.YO; bf16_t* KVRAW = p.YO + (size_t)R * 384;
  if constexpr (PH == 0) {
    ph_mods(p, lds, bid, nblk);
#pragma unroll 1
    for (int ll = 0; ll < 2; ++ll) {
      ph_wt(p.w_in + (size_t)ll * D * NZ, p.Wt_in + ll * WSZ_IN, D, NZ, NZP, 1, 0L, 0L, nullptr, lds, bid, nblk);
      ph_wt(p.w_gate + (size_t)ll * D * 4096, p.Wt_gate + ll * WSZ_GATE, D, 4096, 4096, 1, 0L, 0L, nullptr, lds, bid, nblk);
      ph_wt(p.w_branch + (size_t)ll * 4 * 256 * D, p.Wt_branch + ll * WSZ_BR, 256, D, D, 4, (long)256 * D, (long)D * 256, nullptr, lds, bid, nblk);
      ph_wt(p.w_out + (size_t)ll * D * D, p.Wt_out + ll * WSZ_OUT, D, D, D, 1, 0L, 0L, nullptr, lds, bid, nblk);
      ph_wt(p.w_uq + (size_t)ll * 256 * 384, p.Wt_uq + ll * WSZ_UQ, 256, 384, 384, 1, 0L, 0L, p.g_q_lat + ll * 256, lds, bid, nblk);
      ph_wt(p.w_ukv + (size_t)ll * 128 * 512, p.Wt_ukv + ll * WSZ_UKV, 128, 512, 512, 1, 0L, 0L, p.g_kv_lat + ll * 128, lds, bid, nblk);
    }
  } else if constexpr (PH == 1) {
    ph_modulate(p, l, xl_in, xc_in, bid, nblk);
  } else if constexpr (PH == 2) {
    ph_gemm_plain(p.H, D, p.Wt_in + l * WSZ_IN, D, R, NZP, D, p.Z, NZP, lds, bid, nblk);
#if PROBE == 63
    ph_gemm_probe<3>(p.H, D, p.Wt_in + l * WSZ_IN, D, R, NZP, D, p.mods + 40000, lds, bid, nblk);
#elif PROBE == 66
    ph_gemm_probe<6>(p.H, D, p.Wt_in + l * WSZ_IN, D, R, NZP, D, p.mods + 40000, lds, bid, nblk);
#elif PROBE == 67
    ph_gemm_plain<1>(p.H, D, p.Wt_in + l * WSZ_IN, D, R, NZP, D, p.Z, NZP, lds, bid, nblk);
#elif PROBE == 68
    ph_gemm_plain<2>(p.H, D, p.Wt_in + l * WSZ_IN, D, R, NZP, D, p.Z, NZP, lds, bid, nblk);
#elif PROBE == 5
    ph_gemm_plain(p.H, D, p.Wt_in + l * WSZ_IN, D, R, NZP, D, p.Z, NZP, lds, bid, nblk);
#endif
  } else if constexpr (PH == 3) {
    ph_mla_up(p, l, QRAW, KVRAW, lds, bid, nblk);
  } else if constexpr (PH == 4) {
    ph_prep(p, l, QRAW, KVRAW, lds, bid, nblk);
#if PROBE == 41
    ph_prep(p, l, QRAW, KVRAW, lds, bid, nblk);
#elif PROBE == 43
    ph_prep<1>(p, l, QRAW, KVRAW, lds, bid, nblk);
#elif PROBE == 44
    ph_prep<2>(p, l, QRAW, KVRAW, lds, bid, nblk);
#endif
    __syncthreads();
    ph_gates_cum(p, l, lds, bid, nblk);
#if PROBE == 42
    ph_gates_cum(p, l, lds, bid, nblk);
#endif
  } else if constexpr (PH == 5) {
#if FAST_SCAN
    ph_ml_local(p, lds, bid, nblk);
    ph_gla_local(p, lds, bid, nblk);
#else
    GS_LOOP((long)NUNIT * 4160, nvb_ml_local(gi, p));
    GS_LOOP((long)NUNIT * 2048, nvb_gla_local(gi, p));
#endif
  } else if constexpr (PH == 6) {
#if FAST_SCAN
    ph_ml_scan(p, bid, nblk);
    ph_gla_scan(p, (bid + nblk - 260 % nblk) % nblk, nblk);
#else
    GS_LOOP((long)NB * 2 * 4 * 4160, nvb_ml_scan(gi, p));
    GS_LOOP((long)NB * 2 * 4 * 2048, nvb_gla_scan(gi, p));
#endif
    ph_attn(p, l, need_ctx, lds, bid, nblk);
#if PROBE >= 10 && PROBE < 20
    if (l == 0) ph_attn_mla_probe<PROBE - 10>(p, lds, bid, nblk);
#elif PROBE == 1
    ph_attn_diff(p, l, need_ctx, lds, bid, nblk);
#elif PROBE == 2
    ph_attn_mla(p, need_ctx, lds, bid, nblk);
#endif
  } else if constexpr (PH == 7) {
#if FAST_SCAN
    ph_ml_out(p, l, need_ctx, lds, bid, nblk);
    ph_gla_out(p, l, need_ctx, lds, bid, nblk);
#else
    GS_LOOP((long)NUNIT * 4096, nvb_ml_out(gi, p, need_ctx));
    GS_LOOP((long)NUNIT * 4096, nvb_gla_out(gi, p, need_ctx));
#endif
  } else if constexpr (PH == 8) {
#if !FAST_SCAN
    GS_LOOP((long)R * 4, nvb_ml_finish(gi, p, l, need_ctx));
    GS_LOOP((long)R * 4, nvb_gla_finish(gi, p, l, need_ctx));
#endif
  } else if constexpr (PH == 9) {
    ph_merge(p, l, rows, lds, bid, nblk);
#if PROBE == 3
    ph_merge(p, l, rows, lds, bid, nblk);
#endif
    if (l == 0) conv_expert(p, 1, 0, lds, bid, nblk, ((rows / 128) * (D / 64)) % nblk);
  } else if constexpr (PH == 10) {
    ph_gemm_plain(p.MG, D, p.Wt_out + l * WSZ_OUT, D, rows, D, D, p.YO, D, lds, bid, nblk);
    if (l == 0) conv_expert(p, 2, 0, lds, bid, nblk, ((rows / 128) * (D / 128)) % nblk);
  } else if constexpr (PH == 11) {
    ph_resid_mix(p, l, xl_in, xc_in, rows, lds, bid, nblk);
  } else if constexpr (PH == 12) {
    ph_topk(p, need_ctx, lds, bid, nblk);
    conv_expert(p, 0, l, lds, bid, nblk, 0);
    if (l == 1) { conv_expert(p, 1, 1, lds, bid, nblk, 0); conv_expert(p, 2, 1, lds, bid, nblk, 0); }
  } else if constexpr (PH == 13) {
    ph_moe1(p, need_ctx, lds, bid, nblk);
#if PROBE == 4
    ph_moe1(p, need_ctx, lds, bid, nblk);
#endif
  } else if constexpr (PH == 14) {
    ph_moe2(p, need_ctx, lds, bid, nblk);
#if PROBE == 4
    ph_moe2(p, need_ctx, lds, bid, nblk);
#endif
  } else if constexpr (PH == 15) {
    ph_resid_ffn(p, l, rows, bid, nblk);
  }
}

template <int PH> __global__ void __launch_bounds__(256, 2) k_phase(Params p, int l) {
  DYN_LDS(lds);
  run_phase<PH>(p, l, lds, blockIdx.x, gridDim.x);
}

#if !defined(CPU_EMU) && !MK_MULTI
typedef const Params __attribute__((address_space(4)))* KParams;
DI KParams kp_fresh() { KParams k = (KParams)__builtin_amdgcn_kernarg_segment_ptr(); asm volatile("" : "+s"(k)); return k; }
#define PHASE(PH, L) do { asm volatile("; PHASE_MARK " #PH); KParams k_ = kp_fresh(); run_phase<PH>(*(const Params*)k_, (L), lds, bid, nblk); if (PROBE == 20 + PH || ((PROBE_MASK >> PH) & 1) || (PROBE == 100 + PH && (L) == 0) || (PROBE == 99 && (PH == 4 || PH == 5))) { __syncthreads(); run_phase<PH>(*(const Params*)k_, (L), lds, bid, nblk); } XcdBarrier b_ = bar; asm volatile("" : "+s"(b_.bar), "+s"(b_.x)); xcd_barrier(b_); if (PROBE == 50) xcd_barrier(b_); } while (0)
__global__ void __launch_bounds__(256, 2) k_mega(Params pv) {
  DYN_LDS(lds_all);
  if (threadIdx.x == 0) *(uint4*)lds_all = make_uint4(0u, 0u, 0u, 0u);
  __syncthreads();
  XcdBarrier bar = xcd_barrier_post(pv.bar, (volatile LAS unsigned*)lds_all);
  char* lds = lds_all + 256;
  const int bid = blockIdx.x, nblk = gridDim.x;
  PHASE(0, 0);
#pragma unroll 1
  for (int l = 0; l < 2; ++l) {
    if (l == 0) PHASE(1, l);
    PHASE(2, l); PHASE(3, l); PHASE(4, l); PHASE(5, l); PHASE(6, l); PHASE(7, l);
#if !FAST_SCAN
    PHASE(8, l);
#endif

    PHASE(9, l); PHASE(10, l); PHASE(11, l); PHASE(12, l); PHASE(13, l); PHASE(14, l); PHASE(15, l);
  }
}
#endif
#ifdef CPU_EMU
void emu_check(const Params& p, int layer, int stage);
#define EMU_CHECK(stg) emu_check(p, l, stg)
static int g_nlayers = getenv("NLAYERS") ? atoi(getenv("NLAYERS")) : 2;
#else
#define EMU_CHECK(stg)
#endif
static void fill_params(Params& p, void* const* d_in, void* d_out, void* d_ws) {
  const float** f = (const float**)&p;
  for (int i = 0; i < 33; ++i) f[i] = (const float*)d_in[i];
  p.out = (float*)d_out;
  map_workspace(p, (char*)d_ws);
}
#define LAUNCH_PHASE(PH, L) LAUNCH((k_phase<PH>), grid, 256, MEGA_LDS, stream, p, L)

extern "C" void kernel_launch(void* const* d_in, const int* in_sizes, int n_in, void* d_out, int out_size, void* d_ws,
                              size_t ws_size, hipStream_t stream) {
  Params p{};
  fill_params(p, d_in, d_out, d_ws);
  if (p.ws_need > ws_size) return;
#ifdef CPU_EMU
  const int grid = 16;
  LAUNCH_PHASE(0, 0);
  for (int l = 0; l < g_nlayers; ++l) {
    if (l == 0) LAUNCH_PHASE(1, l);
    LAUNCH_PHASE(2, l); LAUNCH_PHASE(3, l); LAUNCH_PHASE(4, l); LAUNCH_PHASE(5, l); LAUNCH_PHASE(6, l); LAUNCH_PHASE(7, l); LAUNCH_PHASE(8, l);
    EMU_CHECK(1);
    LAUNCH_PHASE(9, l); LAUNCH_PHASE(10, l); LAUNCH_PHASE(11, l);
    EMU_CHECK(2);
    LAUNCH_PHASE(12, l); LAUNCH_PHASE(13, l); LAUNCH_PHASE(14, l); LAUNCH_PHASE(15, l);
    EMU_CHECK(3);
  }
#else
  static int grid = 0;
  if (grid == 0) {
    int dev = 0, cus = 0, per_cu = 0;
    (void)hipGetDevice(&dev);
    (void)hipDeviceGetAttribute(&cus, hipDeviceAttributeMultiprocessorCount, dev);
#if MK_MULTI
    (void)hipFuncSetAttribute((const void*)k_phase<0>, hipFuncAttributeMaxDynamicSharedMemorySize, MEGA_LDS);
    (void)hipFuncSetAttribute((const void*)k_phase<1>, hipFuncAttributeMaxDynamicSharedMemorySize, MEGA_LDS);
    (void)hipFuncSetAttribute((const void*)k_phase<2>, hipFuncAttributeMaxDynamicSharedMemorySize, MEGA_LDS);
    (void)hipFuncSetAttribute((const void*)k_phase<3>, hipFuncAttributeMaxDynamicSharedMemorySize, MEGA_LDS);
    (void)hipFuncSetAttribute((const void*)k_phase<4>, hipFuncAttributeMaxDynamicSharedMemorySize, MEGA_LDS);
    (void)hipFuncSetAttribute((const void*)k_phase<5>, hipFuncAttributeMaxDynamicSharedMemorySize, MEGA_LDS);
    (void)hipFuncSetAttribute((const void*)k_phase<6>, hipFuncAttributeMaxDynamicSharedMemorySize, MEGA_LDS);
    (void)hipFuncSetAttribute((const void*)k_phase<7>, hipFuncAttributeMaxDynamicSharedMemorySize, MEGA_LDS);
    (void)hipFuncSetAttribute((const void*)k_phase<8>, hipFuncAttributeMaxDynamicSharedMemorySize, MEGA_LDS);
    (void)hipFuncSetAttribute((const void*)k_phase<9>, hipFuncAttributeMaxDynamicSharedMemorySize, MEGA_LDS);
    (void)hipFuncSetAttribute((const void*)k_phase<10>, hipFuncAttributeMaxDynamicSharedMemorySize, MEGA_LDS);
    (void)hipFuncSetAttribute((const void*)k_phase<11>, hipFuncAttributeMaxDynamicSharedMemorySize, MEGA_LDS);
    (void)hipFuncSetAttribute((const void*)k_phase<12>, hipFuncAttributeMaxDynamicSharedMemorySize, MEGA_LDS);
    (void)hipFuncSetAttribute((const void*)k_phase<13>, hipFuncAttributeMaxDynamicSharedMemorySize, MEGA_LDS);
    (void)hipFuncSetAttribute((const void*)k_phase<14>, hipFuncAttributeMaxDynamicSharedMemorySize, MEGA_LDS);
    (void)hipFuncSetAttribute((const void*)k_phase<15>, hipFuncAttributeMaxDynamicSharedMemorySize, MEGA_LDS);
    grid = (cus > 0 ? cus : 256) * 2;
#else
    if (hipFuncSetAttribute((const void*)k_mega, hipFuncAttributeMaxDynamicSharedMemorySize, MEGA_LDS + 256) != hipSuccess) { grid = -1; return; }
    if (hipOccupancyMaxActiveBlocksPerMultiprocessor(&per_cu, (const void*)k_mega, 256, MEGA_LDS + 256) != hipSuccess) per_cu = 0;
    (void)hipGetLastError();
    if (per_cu < 1) { grid = -1; return; }
    grid = (cus > 0 ? cus : 256) * (per_cu < 2 ? per_cu : 2);
#endif
  }
  if (grid < 0) return;
#if MK_MULTI
  LAUNCH_PHASE(0, 0);
  for (int l = 0; l < 2; ++l) {
    if (l == 0) LAUNCH_PHASE(1, l);
    LAUNCH_PHASE(2, l); LAUNCH_PHASE(3, l); LAUNCH_PHASE(4, l); LAUNCH_PHASE(5, l); LAUNCH_PHASE(6, l); LAUNCH_PHASE(7, l); LAUNCH_PHASE(8, l);
    LAUNCH_PHASE(9, l); LAUNCH_PHASE(10, l); LAUNCH_PHASE(11, l); LAUNCH_PHASE(12, l); LAUNCH_PHASE(13, l); LAUNCH_PHASE(14, l); LAUNCH_PHASE(15, l);
  }
#else
  (void)hipMemsetAsync(p.bar, 0, XCD_BAR_WORDS * sizeof(unsigned), stream);
  k_mega<<<dim3(grid), dim3(256), MEGA_LDS + 256, stream>>>(p);
#endif
#endif
}
```

```cpp
#ifndef CPU_EMU
#include <hip/hip_runtime.h>
#endif
#include <stdint.h>
#include <stddef.h>

#ifndef T_LAT
#define T_LAT 16384
#endif
#ifndef T_CTX
#define T_CTX 256
#endif

#ifndef MK_MULTI
#define MK_MULTI 0
#endif
#define DI __device__ __forceinline__
typedef unsigned short bf16_t;
typedef short bf16x8 __attribute__((ext_vector_type(8)));
typedef short s16x4 __attribute__((ext_vector_type(4)));
typedef float f32x4 __attribute__((ext_vector_type(4)));
typedef float f32x16 __attribute__((ext_vector_type(16)));
typedef unsigned u32x4 __attribute__((ext_vector_type(4)));
typedef unsigned u32x2 __attribute__((ext_vector_type(2)));
typedef float f32x2 __attribute__((ext_vector_type(2)));

#ifdef CPU_EMU
static inline float u2f(unsigned u) { float f; memcpy(&f, &u, 4); return f; }
static inline unsigned f2u(float f) { unsigned u; memcpy(&u, &f, 4); return u; }
#define MFMA32(a, b, c) emu_mfma_32x32x16((a), (b), (c))
#define MFMA16(a, b, c) emu_mfma_16x16x32((a), (b), (c))
static inline float fast_exp2(float x) { return exp2f(x); }
static inline float fast_rcp(float x) { return 1.0f / x; }
static inline float fast_rsq(float x) { return 1.0f / sqrtf(x); }
static inline float hw_sin_rev(float x) { return sinf(6.283185307179586f * x); }
static inline float hw_cos_rev(float x) { return cosf(6.283185307179586f * x); }
#define LAUNCH(kern, grid, block, lds, stream, ...) emu::launch(dim3(grid), dim3(block), (size_t)(lds), [=]() { kern(__VA_ARGS__); })
#define DYN_LDS(name) char* name = emu_dynlds()
#define SCHED_BARRIER()
#define TIDX ((int)threadIdx.x)
#define WAVE_SYNC() emu::wave_barrier()
#define SETPRIO(x)
#define IGLP_OPT()
template <int M> static inline float xor_sum(float v) { return v + __shfl_xor(v, M); }
template <int M> static inline float xor_max(float v) { return fmaxf(v, __shfl_xor(v, M)); }
template <int M> static inline int xor_sum_i(int v) { return v + __shfl_xor(v, M); }
static inline int lane_bcast(int v, int src) { return __shfl(v, src); }
static inline float lane_get(float v, int src) { return __shfl(v, src); }
static inline int lane_up(int v, int d, int lane) { (void)lane; return __shfl_up(v, d); }
#else
DI float u2f(unsigned u) { return __uint_as_float(u); }
DI unsigned f2u(float f) { return __float_as_uint(f); }
#define MFMA32(a, b, c) __builtin_amdgcn_mfma_f32_32x32x16_bf16((a), (b), (c), 0, 0, 0)
#define MFMA16(a, b, c) __builtin_amdgcn_mfma_f32_16x16x32_bf16((a), (b), (c), 0, 0, 0)
DI float fast_exp2(float x) { return __builtin_amdgcn_exp2f(x); }
DI float fast_rcp(float x) { return __builtin_amdgcn_rcpf(x); }
DI float fast_rsq(float x) { return __builtin_amdgcn_rsqf(x); }
DI float hw_sin_rev(float x) { return __builtin_amdgcn_sinf(x); }
DI float hw_cos_rev(float x) { return __builtin_amdgcn_cosf(x); }
#define LAUNCH(kern, grid, block, lds, stream, ...) kern<<<dim3(grid), dim3(block), (lds), (stream)>>>(__VA_ARGS__)
#define DYN_LDS(name) extern __shared__ __attribute__((aligned(16))) char name[]
#define SCHED_BARRIER() __builtin_amdgcn_sched_barrier(0)
DI int tid_fresh() { int t = (int)threadIdx.x; asm volatile("" : "+v"(t)); return t; }
#define TIDX tid_fresh()
#define WAVE_SYNC() __builtin_amdgcn_wave_barrier()
#define SETPRIO(x) __builtin_amdgcn_s_setprio(x)
#define IGLP_OPT() __builtin_amdgcn_iglp_opt(0)
#ifdef USE_SHFL
template <int M> DI float xor_sum(float v) { return v + __shfl_xor(v, M); }
template <int M> DI float xor_max(float v) { return fmaxf(v, __shfl_xor(v, M)); }
template <int M> DI int xor_sum_i(int v) { return v + __shfl_xor(v, M); }
DI int lane_bcast(int v, int src) { return __shfl(v, src); }
DI int lane_up(int v, int d, int lane) { (void)lane; return __shfl_up(v, d); }
#else
template <int M> DI int xor_partner_bits(int bits) { return __builtin_amdgcn_ds_swizzle(bits, (M << 10) | 0x1f); }
DI void half_swap(unsigned& a, unsigned& b) { asm volatile("s_nop 1\n\tv_permlane32_swap_b32 %0, %1\n\ts_nop 1" : "+v"(a), "+v"(b)); }
template <int M> DI float xor_sum(float v) {
  if constexpr (M < 32) return v + __builtin_bit_cast(float, xor_partner_bits<M>(__builtin_bit_cast(int, v)));
  else { unsigned a = __builtin_bit_cast(unsigned, v), b = a; half_swap(a, b); return __builtin_bit_cast(float, a) + __builtin_bit_cast(float, b); }
}
template <int M> DI float xor_max(float v) {
  if constexpr (M < 32) return fmaxf(v, __builtin_bit_cast(float, xor_partner_bits<M>(__builtin_bit_cast(int, v))));
  else { unsigned a = __builtin_bit_cast(unsigned, v), b = a; half_swap(a, b); return fmaxf(__builtin_bit_cast(float, a), __builtin_bit_cast(float, b)); }
}
template <int M> DI int xor_sum_i(int v) {
  if constexpr (M < 32) return v + xor_partner_bits<M>(v);
  else { unsigned a = (unsigned)v, b = a; half_swap(a, b); return (int)(a + b); }
}
DI int lane_bcast(int v, int src) { return __builtin_amdgcn_readlane(v, src); }
DI float lane_get(float v, int src) { return __builtin_bit_cast(float, __builtin_amdgcn_ds_bpermute(src << 2, __builtin_bit_cast(int, v))); }
DI int lane_up(int v, int d, int lane) { return __builtin_amdgcn_ds_bpermute(((lane - d) & 63) << 2, v); }
#endif
#endif

DI float bf2f(bf16_t v) { return u2f(((unsigned)v) << 16); }
#ifdef CPU_EMU
DI bf16_t f2bf(float f) { unsigned u = f2u(f); u += 0x7fffu + ((u >> 16) & 1u); return (bf16_t)(u >> 16); }
DI unsigned pack2bf(float lo, float hi) { return (unsigned)f2bf(lo) | ((unsigned)f2bf(hi) << 16); }
static inline unsigned wave_ballot16(bool pr) { unsigned m = 0; for (int e = 0; e < 16; ++e) m |= (__shfl(pr ? 1 : 0, e) ? 1u : 0u) << e; return m; }
static inline bool wave_any(bool pr) { int v = pr ? 1 : 0; v |= __shfl_xor(v, 1); v |= __shfl_xor(v, 2); v |= __shfl_xor(v, 4); v |= __shfl_xor(v, 8); v |= __shfl_xor(v, 16); v |= __shfl_xor(v, 32); return v != 0; }
#else
typedef float f32x2_ __attribute__((ext_vector_type(2)));
typedef __bf16 bf16x2_hw __attribute__((ext_vector_type(2)));
DI unsigned pack2bf(float lo, float hi) { const f32x2_ v = {lo, hi}; return __builtin_bit_cast(unsigned, __builtin_convertvector(v, bf16x2_hw)); }
DI bf16_t f2bf(float f) { return (bf16_t)(pack2bf(f, f) & 0xffffu); }
DI bool wave_any(bool pr) { return __builtin_amdgcn_ballot_w64(pr) != 0ull; }
DI unsigned wave_ballot16(bool pr) { return (unsigned)__builtin_amdgcn_ballot_w64(pr) & 0xffffu; }
#endif
DI float sigmoidf_(float x) { return 1.0f / (1.0f + expf(-x)); }
DI float siluf_(float x) { return x / (1.0f + expf(-x)); }
DI float logsigmoidf_(float x) { return fminf(x, 0.0f) - log1pf(expf(-fabsf(x))); }

constexpr int D = 1024, NB = 2, TL = T_LAT, TC = T_CTX, TK = TL + TC;
constexpr int RL = NB * TL, RC = NB * TC, R = RL + RC;
constexpr int NZ = 3024, NZP = 3072;
constexpr int ZC_QLAT = 0, ZC_KVLAT = 256, ZC_KROPE = 384, ZC_MLQK = 416, ZC_MLV = 928, ZC_MLO = 1184, ZC_MLIG = 1440,
              ZC_MLFG = 1448, ZC_GQ = 1456, ZC_GK = 1584, ZC_GV = 1712, ZC_GR = 1968, ZC_GA = 2224, ZC_DQ = 2256,
              ZC_DK = 2512, ZC_DV = 2768;
constexpr int NCK = TK / 64, NCC = TC / 64, NCL = TL / 64;
constexpr int NE = 16, FF = 1408, CAPL = 2 * TL / 16, CAPC = 2 * TC / 16, CAPT = CAPL + CAPC, NSLOT = NB * CAPT;
constexpr size_t WSZ_IN = (size_t)NZP * D, WSZ_UQ = 384 * 256, WSZ_UKV = 512 * 128, WSZ_GATE = (size_t)4096 * D, WSZ_BR = (size_t)4 * D * 256, WSZ_OUT = (size_t)D * D;
constexpr int NUNIT = NB * 2 * NCK * 4;
constexpr float LOG2E = 1.4426950408889634f;
constexpr float QS_MLA = 0.10206207261596577f * LOG2E;
constexpr float QS_DIFF = 0.17677669529663687f * LOG2E;

DI int row_of(int b, int s) { return s < TC ? RL + b * TC + s : b * TL + (s - TC); }
DI void bs_of(int r, int& b, int& s) { if (r < RL) { b = r / TL; s = TC + (r % TL); } else { int q = r - RL; b = q / TC; s = q % TC; } }
DI int seq_of(int d, int p) { return d == 0 ? p : (p < TC ? TC - 1 - p : TK - 1 - (p - TC)); }
DI int step_of(int d, int c) { return d == 0 ? c : (c < NCC ? NCC - 1 - c : NCC + (NCK - 1 - c)); }

struct Params {
  const float *x, *c, *ctx, *c_ctx, *w_ada, *b_ada, *g_mix_pre, *g_mix_post, *g_ffn_pre, *g_ffn_post, *w_in, *g_q_lat, *w_uq,
      *g_kv_lat, *w_ukv, *w_conv, *b_conv, *b_igate, *b_fgate, *g_mlstm_out, *w_alpha2, *b_alpha, *g_gla_out, *diff_lambda,
      *g_diff_out, *w_branch, *w_gate, *b_gate, *w_out, *w_router, *w_e_gate, *w_e_up, *w_e_down;
  float* out;
  float *mods, *xc;
  bf16_t *H, *Z, *Qm, *Km, *Vtm, *Qd, *Kd, *Vtd, *MQ, *MK, *Y, *MG, *YO, *HID, *YE, *MVt, *GVt;
  float *BC, *IGS, *GC, *MC, *MN, *MM, *GS, *HD, *OD, *AFF, *SELV;
  int *SEL, *INV;
  bf16_t *Wt_in, *Wt_uq, *Wt_ukv, *Wt_gate, *Wt_branch, *Wt_out, *Wt_eg, *Wt_eu, *Wt_ed;
  unsigned* bar;
  size_t ws_need;
};

static inline size_t al256(size_t x) { return (x + 255) & ~(size_t)255; }
static inline void map_workspace(Params& p, char* ws) {
  size_t o = 0;
  auto take = [&](size_t bytes) { size_t r = o; o += al256(bytes); return ws + r; };
  p.bar = (unsigned*)take(16384);
  p.mods = (float*)take((size_t)2 * 3 * 6144 * 4);
  p.xc = (float*)take((size_t)RC * D * 4);
  p.BC = (float*)take((size_t)NB * 2 * TK * 4 * 4);
  p.IGS = (float*)take((size_t)NB * 2 * TK * 4 * 4);
  p.AFF = (float*)take((size_t)NB * NE * TK * 4);
  p.SEL = (int*)take((size_t)NE * NSLOT * 4);
  p.SELV = (float*)take((size_t)NE * NSLOT * 4);
  p.INV = (int*)take((size_t)R * NE * 4);
  p.MM = (float*)take((size_t)NUNIT * 4 * 4);
  p.MN = (float*)take((size_t)NUNIT * 64 * 4);
  p.Wt_in = (bf16_t*)take((size_t)2 * WSZ_IN * 2);
  p.Wt_uq = (bf16_t*)take((size_t)2 * WSZ_UQ * 2);
  p.Wt_ukv = (bf16_t*)take((size_t)2 * WSZ_UKV * 2);
  p.Wt_gate = (bf16_t*)take((size_t)2 * WSZ_GATE * 2);
  p.Wt_branch = (bf16_t*)take((size_t)2 * WSZ_BR * 2);
  p.Wt_out = (bf16_t*)take((size_t)2 * WSZ_OUT * 2);
  p.H = (bf16_t*)take((size_t)R * D * 2);
  size_t szA = (size_t)R * NZP * 2, szHID = (size_t)NE * NSLOT * FF * 2;
  char* A = take(szA > szHID ? szA : szHID);
  p.Z = (bf16_t*)A; p.HID = (bf16_t*)A;
  size_t szQm = al256((size_t)NB * 4 * TK * 96 * 2), szVt = al256((size_t)NB * 4 * 64 * TK * 2), szQd = al256((size_t)NB * 8 * TK * 32 * 2);
  size_t szB1 = 2 * szQm + 2 * szVt + 2 * szQd;
  size_t szHD = al256((size_t)2 * NB * TK * 256 * 4);
  size_t szYE = (size_t)NE * NSLOT * D * 2;
  size_t szB = szB1; if (2 * szHD > szB) szB = 2 * szHD; if (szYE > szB) szB = szYE;
  char* Bq = take(szB);
  p.Qm = (bf16_t*)Bq; p.Km = (bf16_t*)(Bq + szQm); p.Vtm = (bf16_t*)(Bq + 2 * szQm);
  p.Qd = (bf16_t*)(Bq + 2 * szQm + szVt); p.Kd = (bf16_t*)(Bq + 2 * szQm + szVt + szQd); p.Vtd = (bf16_t*)(Bq + 2 * szQm + szVt + 2 * szQd);
  p.YE = (bf16_t*)Bq;
  p.GC = (float*)take((size_t)NB * 2 * TK * 128 * 4);
  p.MVt = (bf16_t*)take((size_t)NB * 4 * 64 * TK * 2);
  p.GVt = (bf16_t*)take((size_t)NB * 4 * 64 * TK * 2);
  size_t szW = (size_t)NE * FF * D * 2;
  size_t szMC = (size_t)NUNIT * 4096 * 4, szRD = (size_t)R * D * 2;
  size_t szC = szMC; if (szRD > szC) szC = szRD; if (szW > szC) szC = szW;
  char* C = take(szC);
  p.MC = (float*)C; p.MG = (bf16_t*)C; p.Wt_eg = (bf16_t*)C;
  size_t szMQ = al256((size_t)NB * TK * 256 * 2), szGS = (size_t)NUNIT * 2048 * 4;
  size_t szD = 2 * szMQ + szGS; if (szW > szD) szD = szW;
  char* Dq = take(szD);
  p.MQ = (bf16_t*)Dq; p.MK = (bf16_t*)(Dq + szMQ); p.GS = (float*)(Dq + 2 * szMQ); p.Wt_eu = (bf16_t*)Dq;
  size_t szF = 2 * szRD > szW ? 2 * szRD : szW;
  char* F = take(szF);
  p.Y = (bf16_t*)F; p.YO = (bf16_t*)(F + szRD); p.Wt_ed = (bf16_t*)F;
  p.HD = (float*)Bq; p.OD = (float*)(Bq + szHD);
  p.ws_need = o;
}
#define GTID ((long)blockIdx.x * blockDim.x + threadIdx.x)

DI float lam_of(const Params& p, int layer, float& lam_init) {
  const float* lv = p.diff_lambda + layer * 128;
  float s1 = 0.f, s2 = 0.f;
  for (int i = 0; i < 32; ++i) { s1 += lv[i] * lv[32 + i]; s2 += lv[64 + i] * lv[96 + i]; }
  lam_init = layer == 0 ? 0.2f : 0.35550906759096f;
  return expf(s1) - expf(s2) + lam_init;
}
DI void rope_cs(int s, int jj, float& cs, float& sn) {
  int t = s - TC;
  int pos = (jj < 16) ? (t / 64) : (t % 64);
  float ang = (float)pos * exp2f(-1.6609640474436813f * (float)(jj & 7));
  double rev = (double)ang * 0.15915494309189535;
  rev -= floor(rev + 0.5);
  float rf = (float)rev;
  cs = hw_cos_rev(rf); sn = hw_sin_rev(rf);
}
template <class G> DI float rope_elem(G get, int s, int jj) {
  if (s < TC) return get(jj);
  float cs, sn; rope_cs(s, jj, cs, sn);
  float a = get(jj), b = get(jj ^ 8);
  return (jj & 8) ? (a * cs + b * sn) : (a * cs - b * sn);
}

DI void nvb_mods(long GI, const Params& p) {
  long i = GI; if (i >= 2 * 3 * 6144) return;
  int col = (int)(i % 6144), w = (int)((i / 6144) % 3), l = (int)(i / (3 * 6144));
  const float* cv = w < 2 ? p.c + w * 1024 : p.c_ctx;
  const float* W = p.w_ada + (size_t)l * 1024 * 6144;
  float acc = 0.f;
  for (int k = 0; k < 1024; ++k) acc += siluf_(cv[k]) * W[(size_t)k * 6144 + col];
  p.mods[i] = acc + p.b_ada[l * 6144 + col];
}
__global__ void __launch_bounds__(256) nv_wt(const float* in, bf16_t* out, int K, int N, int NP, long in_bs, long out_bs, const float* gain) {
  long i = GTID; if (i >= (long)NP * K) return;
  int k = (int)(i % K), n = (int)(i / K);
  const float* I = in + (size_t)blockIdx.y * in_bs; bf16_t* O = out + (size_t)blockIdx.y * out_bs;
  O[(size_t)n * K + k] = n < N ? f2bf(I[(size_t)k * N + n] * (gain ? gain[k] : 1.0f)) : (bf16_t)0;
}
__global__ void __launch_bounds__(256) nv_modulate(Params p, int layer, int which, const float* xl, const float* xcx, int nrows) {
  long r = GTID; if (r >= nrows) return;
  int w = r < RL ? (int)(r / TL) : 2;
  const float* mb = p.mods + (size_t)(layer * 3 + w) * 6144;
  const float* shift = mb + (which ? 3 : 0) * 1024; const float* scale = mb + (which ? 4 : 1) * 1024;
  const float* g = (which ? p.g_ffn_pre : p.g_mix_pre) + layer * 1024;
  const float* x = r < RL ? xl + (size_t)r * D : xcx + (size_t)(r - RL) * D;
  float ss = 0.f; for (int k = 0; k < D; ++k) ss += x[k] * x[k];
  float rstd = 1.0f / sqrtf(ss / D + 1e-6f);
  for (int k = 0; k < D; ++k) p.H[(size_t)r * D + k] = f2bf(x[k] * rstd * g[k] * (1.f + scale[k]) + shift[k]);
}
__global__ void __launch_bounds__(256) nv_gemm(const bf16_t* A, int lda, const bf16_t* Bt, int ldb, int M, int N, int K, bf16_t* C, int ldc) {
  long i = GTID; if (i >= (long)M * N) return;
  int n = (int)(i % N), m = (int)(i / N);
  const bf16_t* a = A + (size_t)m * lda; const bf16_t* b = Bt + (size_t)n * ldb;
  float acc = 0.f;
  for (int k = 0; k < K; ++k) acc += bf2f(a[k]) * bf2f(b[k]);
  C[(size_t)m * ldc + n] = f2bf(acc);
}
__global__ void __launch_bounds__(256) nv_mla_q(Params p, int layer) {
  long i = GTID; if (i >= (long)R * 4 * 96) return;
  int j = (int)(i % 96), h = (int)((i / 96) % 4), r = (int)(i / 384);
  int b, s; bs_of(r, b, s);
  const bf16_t* z = p.Z + (size_t)r * NZP + ZC_QLAT;
  const float* g = p.g_q_lat + layer * 256; const float* W = p.w_uq + (size_t)layer * 256 * 384;
  float ss = 0.f; for (int k = 0; k < 256; ++k) { float v = bf2f(z[k]); ss += v * v; }
  float rstd = 1.0f / sqrtf(ss / 256 + 1e-6f);
  auto dot = [&](int col) { float a = 0.f; for (int k = 0; k < 256; ++k) a += bf2f(z[k]) * rstd * g[k] * W[(size_t)k * 384 + col]; return a; };
  float v;
  if (j < 64) v = dot(h * 96 + j);
  else v = rope_elem([&](int jj) { return dot(h * 96 + 64 + jj); }, s, j - 64);
  p.Qm[(((size_t)b * 4 + h) * TK + s) * 96 + j] = f2bf(v * QS_MLA);
}
__global__ void __launch_bounds__(256) nv_mla_kv(Params p, int layer) {
  long i = GTID; if (i >= (long)R * 4 * 160) return;
  int j = (int)(i % 160), h = (int)((i / 160) % 4), r = (int)(i / 640);
  int b, s; bs_of(r, b, s);
  const bf16_t* z = p.Z + (size_t)r * NZP;
  if (j < 128) {
    const bf16_t* zl = z + ZC_KVLAT; const float* g = p.g_kv_lat + layer * 128; const float* W = p.w_ukv + (size_t)layer * 128 * 512;
    float ss = 0.f; for (int k = 0; k < 128; ++k) { float v = bf2f(zl[k]); ss += v * v; }
    float rstd = 1.0f / sqrtf(ss / 128 + 1e-6f);
    float a = 0.f; for (int k = 0; k < 128; ++k) a += bf2f(zl[k]) * rstd * g[k] * W[(size_t)k * 512 + h * 128 + j];
    if (j < 64) p.Km[(((size_t)b * 4 + h) * TK + s) * 96 + j] = f2bf(a);
    else p.Vtm[(((size_t)b * 4 + h) * 64 + (j - 64)) * TK + s] = f2bf(a);
  } else {
    int jj = j - 128;
    float v = rope_elem([&](int q) { return bf2f(z[ZC_KROPE + q]); }, s, jj);
    p.Km[(((size_t)b * 4 + h) * TK + s) * 96 + 64 + jj] = f2bf(v);
  }
}
__global__ void __launch_bounds__(256) nv_diff_prep(Params p) {
  long i = GTID; if (i >= (long)R * 768) return;
  int c = (int)(i % 768), r = (int)(i / 768);
  int b, s; bs_of(r, b, s);
  const bf16_t* z = p.Z + (size_t)r * NZP;
  if (c < 512) {
    int qk = c / 256, cc = c % 256, hm = cc / 32, jj = cc % 32;
    const bf16_t* src = z + (qk ? ZC_DK : ZC_DQ) + hm * 32;
    float v = rope_elem([&](int q) { return bf2f(src[q]); }, s, jj);
    if (qk == 0) p.Qd[(((size_t)b * 8 + hm) * TK + s) * 32 + jj] = f2bf(v * QS_DIFF);
    else p.Kd[(((size_t)b * 8 + hm) * TK + s) * 32 + jj] = f2bf(v);
  } else {
    int cc = c - 512, h = cc / 64, dv = cc % 64;
    p.Vtd[(((size_t)b * 4 + h) * 64 + dv) * TK + s] = z[ZC_DV + cc];
  }
}
__global__ void __launch_bounds__(256) nv_ml_prep(Params p, int layer) {
  long i = GTID; if (i >= (long)R * 512) return;
  int ch = (int)(i % 512), r = (int)(i / 512);
  int b, s; bs_of(r, b, s);
  bool first = (s == 0) || (s == TC), last = (s == TC - 1) || (s == TK - 1);
  const float* w = p.w_conv + (size_t)layer * 3 * 512;
  float acc = p.b_conv[layer * 512 + ch];
  acc += bf2f(p.Z[(size_t)r * NZP + ZC_MLQK + ch]) * w[512 + ch];
  if (!first) acc += bf2f(p.Z[(size_t)row_of(b, s - 1) * NZP + ZC_MLQK + ch]) * w[ch];
  if (!last) acc += bf2f(p.Z[(size_t)row_of(b, s + 1) * NZP + ZC_MLQK + ch]) * w[1024 + ch];
  float v = siluf_(acc);
  if (ch < 256) p.MQ[((size_t)b * TK + s) * 256 + ch] = f2bf(v);
  else p.MK[((size_t)b * TK + s) * 256 + ch - 256] = f2bf(v * 0.125f);
}
DI void nvb_ml_gates(long GI, const Params& p, int layer) {
  long i = GI; if (i >= (long)NB * 2 * NCK * 4) return;
  int h = (int)(i % 4), j = (int)((i / 4) % NCK), d = (int)((i / (4 * NCK)) % 2), b = (int)(i / (8 * NCK));
  float bi = p.b_igate[layer * 8 + d * 4 + h], bfg = p.b_fgate[layer * 8 + d * 4 + h];
  float cum = 0.f;
  for (int l = 0; l < 64; ++l) {
    int pp = 64 * j + l, s = seq_of(d, pp); const bf16_t* z = p.Z + (size_t)row_of(b, s) * NZP;
    float ig = bf2f(z[ZC_MLIG + d * 4 + h]) + bi;
    float lf = logsigmoidf_(bf2f(z[ZC_MLFG + d * 4 + h]) + bfg);
    cum += lf;
    size_t o = (((size_t)b * 2 + d) * TK + pp) * 4 + h;
    p.BC[o] = cum; p.IGS[o] = ig;
  }
}
DI void nvb_gla_cum(long GI, const Params& p, int layer) {
  long i = GI; if (i >= (long)NB * 2 * NCK * 128) return;
  int ch = (int)(i % 128), j = (int)((i / 128) % NCK), d = (int)((i / (128 * NCK)) % 2), b = (int)(i / (256 * NCK));
  const float* W = p.w_alpha2 + (size_t)layer * 2 * 16 * 128 + (size_t)d * 16 * 128;
  float ba = p.b_alpha[layer * 256 + d * 128 + ch];
  float cum = 0.f;
  for (int l = 0; l < 64; ++l) {
    int pp = 64 * j + l, s = seq_of(d, pp); const bf16_t* z = p.Z + (size_t)row_of(b, s) * NZP + ZC_GA + d * 16;
    float zg = ba; for (int q = 0; q < 16; ++q) zg += bf2f(z[q]) * W[q * 128 + ch];
    cum += logsigmoidf_(zg) * (1.0f / 16.0f);
    p.GC[(((size_t)b * 2 + d) * TK + pp) * 128 + ch] = cum;
  }
}
__global__ void __launch_bounds__(256) nv_attn_mla(Params p, int need_ctx) {
  long i = GTID; if (i >= (long)NB * 4 * TK) return;
  int s = (int)(i % TK), h = (int)((i / TK) % 4), b = (int)(i / (4 * TK));
  if (s < TC && !need_ctx) return;
  int nk = s < TC ? TC : TK;
  const bf16_t* q = p.Qm + (((size_t)b * 4 + h) * TK + s) * 96;
  const bf16_t* K = p.Km + ((size_t)b * 4 + h) * TK * 96;
  const bf16_t* Vt = p.Vtm + ((size_t)b * 4 + h) * 64 * TK;
  float qf[96], o[64];
  _Pragma("unroll") for (int k = 0; k < 96; ++k) qf[k] = bf2f(q[k]);
  _Pragma("unroll") for (int k = 0; k < 64; ++k) o[k] = 0.f;
  float m = -1e30f, l = 0.f;
  for (int t = 0; t < nk; ++t) {
    float sc = 0.f; _Pragma("unroll") for (int k = 0; k < 96; ++k) sc += qf[k] * bf2f(K[(size_t)t * 96 + k]);
    float mn = fmaxf(m, sc), a = exp2f(m - mn), pr = exp2f(sc - mn);
    l = l * a + pr;
    _Pragma("unroll") for (int k = 0; k < 64; ++k) o[k] = o[k] * a + pr * bf2f(Vt[(size_t)k * TK + t]);
    m = mn;
  }
  int r = row_of(b, s);
  _Pragma("unroll") for (int k = 0; k < 64; ++k) p.Y[(size_t)r * D + h * 64 + k] = f2bf(o[k] / l);
}
__global__ void __launch_bounds__(256) nv_attn_diff(Params p, int layer, int need_ctx) {
  long i = GTID; if (i >= (long)NB * 4 * TK) return;
  int s = (int)(i % TK), h = (int)((i / TK) % 4), b = (int)(i / (4 * TK));
  if (s < TC && !need_ctx) return;
  int nk = s < TC ? TC : TK;
  float lam_init; float lam = lam_of(p, layer, lam_init);
  const bf16_t* Vt = p.Vtd + ((size_t)b * 4 + h) * 64 * TK;
  float res[64];
  _Pragma("unroll") for (int k = 0; k < 64; ++k) res[k] = 0.f;
  _Pragma("unroll") for (int mp = 0; mp < 2; ++mp) {
    const bf16_t* q = p.Qd + (((size_t)b * 8 + h * 2 + mp) * TK + s) * 32;
    const bf16_t* K = p.Kd + ((size_t)b * 8 + h * 2 + mp) * TK * 32;
    float qf[32], o[64];
    _Pragma("unroll") for (int k = 0; k < 32; ++k) qf[k] = bf2f(q[k]);
    _Pragma("unroll") for (int k = 0; k < 64; ++k) o[k] = 0.f;
    float m = -1e30f, l = 0.f;
    for (int t = 0; t < nk; ++t) {
      float sc = 0.f; _Pragma("unroll") for (int k = 0; k < 32; ++k) sc += qf[k] * bf2f(K[(size_t)t * 32 + k]);
      float mn = fmaxf(m, sc), a = exp2f(m - mn), pr = exp2f(sc - mn);
      l = l * a + pr;
      _Pragma("unroll") for (int k = 0; k < 64; ++k) o[k] = o[k] * a + pr * bf2f(Vt[(size_t)k * TK + t]);
      m = mn;
    }
    float wgt = mp == 0 ? 1.f : -lam;
    _Pragma("unroll") for (int k = 0; k < 64; ++k) res[k] += wgt * o[k] / l;
  }
  float ss = 0.f; _Pragma("unroll") for (int k = 0; k < 64; ++k) ss += res[k] * res[k];
  float rstd = 1.0f / sqrtf(ss / 64 + 1e-6f);
  int r = row_of(b, s);
  _Pragma("unroll") for (int k = 0; k < 64; ++k) p.Y[(size_t)r * D + 768 + h * 64 + k] = f2bf(res[k] * rstd * p.g_diff_out[layer * 256 + h * 64 + k] * (1.f - lam_init));
}
DI void nvb_ml_local(long GI, const Params& p) {
  long i = GI; if (i >= (long)NUNIT * 4160) return;
  int e = (int)(i % 4160); long u = i / 4160;
  int h = (int)(u % 4), j = (int)((u / 4) % NCK), d = (int)((u / (4 * NCK)) % 2), b = (int)(u / (8 * NCK));
  const float* bc = p.BC + (((size_t)b * 2 + d) * TK + 64 * j) * 4 + h; const float* ig = p.IGS + (((size_t)b * 2 + d) * TK + 64 * j) * 4 + h;
  float bend = bc[63 * 4], ml = -1e30f;
  for (int l = 0; l < 64; ++l) ml = fmaxf(ml, bend - bc[l * 4] + ig[l * 4]);
  if (e == 4096 + 0) { p.MM[u * 4 + 0] = ml; p.MM[u * 4 + 1] = bend; }
  float acc = 0.f;
  if (e < 4096) {
    int v = e / 64, k = e % 64;
    for (int l = 0; l < 64; ++l) {
      int s = seq_of(d, 64 * j + l); float w = expf(bend - bc[l * 4] + ig[l * 4] - ml);
      acc += w * bf2f(p.Z[(size_t)row_of(b, s) * NZP + ZC_MLV + h * 64 + v]) * bf2f(p.MK[((size_t)b * TK + s) * 256 + h * 64 + k]);
    }
    p.MC[(size_t)u * 4096 + e] = acc;
  } else {
    int k = e - 4096;
    for (int l = 0; l < 64; ++l) {
      int s = seq_of(d, 64 * j + l); float w = expf(bend - bc[l * 4] + ig[l * 4] - ml);
      acc += w * bf2f(p.MK[((size_t)b * TK + s) * 256 + h * 64 + k]);
    }
    p.MN[(size_t)u * 64 + k] = acc;
  }
}
DI void nvb_ml_scan(long GI, const Params& p) {
  long i = GI; if (i >= (long)NB * 2 * 4 * 4160) return;
  int e = (int)(i % 4160); int ch = (int)(i / 4160); int h = ch % 4, bd = ch / 4;
  float st = 0.f, m = -1e30f;
  for (int j = 0; j < NCK; ++j) {
    size_t u = ((size_t)bd * NCK + j) * 4 + h;
    float ml = p.MM[u * 4 + 0], be = p.MM[u * 4 + 1];
    float mn = fmaxf(be + m, ml), a = expf(be + m - mn), g = expf(ml - mn);
    float* slot = e < 4096 ? &p.MC[u * 4096 + e] : &p.MN[u * 64 + (e - 4096)];
    float loc = *slot; *slot = st; st = a * st + g * loc;
    if (e == 0) p.MM[u * 4 + 2] = m;
    m = mn;
  }
}
DI void nvb_ml_out(long GI, const Params& p, int need_ctx) {
  long i = GI; if (i >= (long)NUNIT * 4096) return;
  int v = (int)(i % 64), l = (int)((i / 64) % 64); long u = i / 4096;
  int h = (int)(u % 4), j = (int)((u / 4) % NCK), d = (int)((u / (4 * NCK)) % 2), b = (int)(u / (8 * NCK));
  if (j < NCC && !need_ctx) return;
  const float* bc = p.BC + (((size_t)b * 2 + d) * TK + 64 * j) * 4 + h; const float* ig = p.IGS + (((size_t)b * 2 + d) * TK + 64 * j) * 4 + h;
  float m0 = p.MM[u * 4 + 2];
  int sl = seq_of(d, 64 * j + l);
  const bf16_t* q = p.MQ + ((size_t)b * TK + sl) * 256 + h * 64;
  float bl = bc[l * 4];
  float inter = bl + m0, mt = inter;
  for (int t = 0; t <= l; ++t) mt = fmaxf(mt, bl - bc[t * 4] + ig[t * 4]);
  float num = 0.f, den = 0.f;
  for (int t = 0; t <= l; ++t) {
    int st = seq_of(d, 64 * j + t);
    const bf16_t* k = p.MK + ((size_t)b * TK + st) * 256 + h * 64;
    float qk = 0.f; for (int c = 0; c < 64; ++c) qk += bf2f(q[c]) * bf2f(k[c]);
    float sv = expf(bl - bc[t * 4] + ig[t * 4] - mt) * qk;
    num += sv * bf2f(p.Z[(size_t)row_of(b, st) * NZP + ZC_MLV + h * 64 + v]); den += sv;
  }
  float ai = expf(inter - mt);
  float qc = 0.f, qn = 0.f;
  for (int c = 0; c < 64; ++c) { qc += bf2f(q[c]) * p.MC[(size_t)u * 4096 + v * 64 + c]; qn += bf2f(q[c]) * p.MN[(size_t)u * 64 + c]; }
  num += ai * qc; den += ai * qn;
  p.HD[(((size_t)d * NB + b) * TK + sl) * 256 + h * 64 + v] = num / fmaxf(fabsf(den), expf(-mt));
}
DI void nvb_ml_finish(long GI, const Params& p, int layer, int need_ctx) {
  long i = GI; if (i >= (long)R * 4) return;
  int h = (int)(i % 4), r = (int)(i / 4); int b, s; bs_of(r, b, s);
  if (s < TC && !need_ctx) return;
  const float* h0 = p.HD + (((size_t)0 * NB + b) * TK + s) * 256 + h * 64; const float* h1 = p.HD + (((size_t)1 * NB + b) * TK + s) * 256 + h * 64;
  float ss = 0.f; for (int v = 0; v < 64; ++v) { float t = h0[v] + h1[v]; ss += t * t; }
  float rstd = 1.0f / sqrtf(ss / 64 + 1e-6f);
  for (int v = 0; v < 64; ++v) {
    float o = bf2f(p.Z[(size_t)r * NZP + ZC_MLO + h * 64 + v]);
    p.Y[(size_t)r * D + 256 + h * 64 + v] = f2bf(sigmoidf_(o) * (h0[v] + h1[v]) * rstd * p.g_mlstm_out[layer * 256 + h * 64 + v]);
  }
}
DI void nvb_gla_local(long GI, const Params& p) {
  long i = GI; if (i >= (long)NUNIT * 2048) return;
  int v = (int)(i % 64), k = (int)((i / 64) % 32); long u = i / 2048;
  int h = (int)(u % 4), j = (int)((u / 4) % NCK), d = (int)((u / (4 * NCK)) % 2), b = (int)(u / (8 * NCK));
  const float* gc = p.GC + (((size_t)b * 2 + d) * TK + 64 * j) * 128 + h * 32 + k;
  float ge = gc[63 * 128], acc = 0.f;
  for (int l = 0; l < 64; ++l) {
    int s = seq_of(d, 64 * j + l); const bf16_t* z = p.Z + (size_t)row_of(b, s) * NZP;
    acc += bf2f(z[ZC_GK + h * 32 + k]) * expf(ge - gc[l * 128]) * bf2f(z[ZC_GV + h * 64 + v]);
  }
  p.GS[(size_t)u * 2048 + v * 32 + k] = acc;
}
DI void nvb_gla_scan(long GI, const Params& p) {
  long i = GI; if (i >= (long)NB * 2 * 4 * 2048) return;
  int e = (int)(i % 2048); int ch = (int)(i / 2048); int h = ch % 4, bd = ch / 4; int k = e % 32;
  float st = 0.f;
  for (int j = 0; j < NCK; ++j) {
    size_t u = ((size_t)bd * NCK + j) * 4 + h;
    float ge = p.GC[((size_t)bd * TK + 64 * j + 63) * 128 + h * 32 + k];
    float loc = p.GS[u * 2048 + e]; p.GS[u * 2048 + e] = st; st = expf(ge) * st + loc;
  }
}
DI void nvb_gla_out(long GI, const Params& p, int need_ctx) {
  long i = GI; if (i >= (long)NUNIT * 4096) return;
  int v = (int)(i % 64), l = (int)((i / 64) % 64); long u = i / 4096;
  int h = (int)(u % 4), j = (int)((u / 4) % NCK), d = (int)((u / (4 * NCK)) % 2), b = (int)(u / (8 * NCK));
  if (j < NCC && !need_ctx) return;
  const float* gc = p.GC + (((size_t)b * 2 + d) * TK + 64 * j) * 128 + h * 32;
  int sl = seq_of(d, 64 * j + l);
  const bf16_t* q = p.Z + (size_t)row_of(b, sl) * NZP + ZC_GQ + h * 32;
  const float qs = 0.17677669529663687f;
  float acc = 0.f;
  for (int t = 0; t <= l; ++t) {
    int st = seq_of(d, 64 * j + t); const bf16_t* z = p.Z + (size_t)row_of(b, st) * NZP;
    float att = 0.f; for (int k = 0; k < 32; ++k) att += bf2f(q[k]) * qs * expf(gc[l * 128 + k] - gc[t * 128 + k]) * bf2f(z[ZC_GK + h * 32 + k]);
    acc += att * bf2f(z[ZC_GV + h * 64 + v]);
  }
  for (int k = 0; k < 32; ++k) acc += bf2f(q[k]) * qs * expf(gc[l * 128 + k]) * p.GS[(size_t)u * 2048 + v * 32 + k];
  p.OD[(((size_t)d * NB + b) * TK + sl) * 256 + h * 64 + v] = acc;
}
DI void nvb_gla_finish(long GI, const Params& p, int layer, int need_ctx) {
  long i = GI; if (i >= (long)R * 4) return;
  int h = (int)(i % 4), r = (int)(i / 4); int b, s; bs_of(r, b, s);
  if (s < TC && !need_ctx) return;
  const float* h0 = p.OD + (((size_t)0 * NB + b) * TK + s) * 256 + h * 64; const float* h1 = p.OD + (((size_t)1 * NB + b) * TK + s) * 256 + h * 64;
  float ss = 0.f; for (int v = 0; v < 64; ++v) { float t = h0[v] + h1[v]; ss += t * t; }
  float rstd = 1.0f / sqrtf(ss / 64 + 1e-6f);
  for (int v = 0; v < 64; ++v) {
    float rr = bf2f(p.Z[(size_t)r * NZP + ZC_GR + h * 64 + v]);
    p.Y[(size_t)r * D + 512 + h * 64 + v] = f2bf(siluf_(rr) * (h0[v] + h1[v]) * rstd * p.g_gla_out[layer * 256 + h * 64 + v]);
  }
}
__global__ void __launch_bounds__(256) nv_merge(Params p, int layer, int nrows) {
  long i = GTID; if (i >= (long)nrows * D) return;
  int j = (int)(i % D), r = (int)(i / D);
  float acc = 0.f;
  for (int n = 0; n < 4; ++n) {
    const bf16_t* wg = p.Wt_gate + (size_t)(n * 1024 + j) * D; const bf16_t* wb = p.Wt_branch + ((size_t)n * D + j) * 256;
    float g = p.b_gate[layer * 4096 + n * 1024 + j], pr = 0.f;
    for (int k = 0; k < D; ++k) g += bf2f(p.H[(size_t)r * D + k]) * bf2f(wg[k]);
    for (int k = 0; k < 256; ++k) pr += bf2f(p.Y[(size_t)r * D + n * 256 + k]) * bf2f(wb[k]);
    acc += sigmoidf_(g) * pr;
  }
  p.MG[(size_t)r * D + j] = f2bf(acc);
}
__global__ void __launch_bounds__(256) nv_resid_mix(Params p, int layer, const float* xl_in, const float* xc_in, int nrows) {
  long r = GTID; if (r >= nrows) return;
  int w = r < RL ? (int)(r / TL) : 2;
  const float* mb = p.mods + (size_t)(layer * 3 + w) * 6144;
  const float* xin = r < RL ? xl_in + (size_t)r * D : xc_in + (size_t)(r - RL) * D;
  float* xo = r < RL ? p.out + (size_t)r * D : p.xc + (size_t)(r - RL) * D;
  const bf16_t* yo = p.YO + (size_t)r * D;
  float ss = 0.f; for (int k = 0; k < D; ++k) { float v = bf2f(yo[k]); ss += v * v; }
  float rstd = 1.0f / sqrtf(ss / D + 1e-6f);
  float s2 = 0.f;
  for (int k = 0; k < D; ++k) { float xn = xin[k] + mb[2 * 1024 + k] * bf2f(yo[k]) * rstd * p.g_mix_post[layer * 1024 + k]; xo[k] = xn; s2 += xn * xn; }
  float rstd2 = 1.0f / sqrtf(s2 / D + 1e-6f);
  float lg[16]; _Pragma("unroll") for (int e = 0; e < 16; ++e) lg[e] = 0.f;
  const float* wr = p.w_router + (size_t)layer * D * 16;
  for (int k = 0; k < D; ++k) {
    float h2 = xo[k] * rstd2 * p.g_ffn_pre[layer * 1024 + k] * (1.f + mb[4 * 1024 + k]) + mb[3 * 1024 + k];
    p.H[(size_t)r * D + k] = f2bf(h2);
    _Pragma("unroll") for (int e = 0; e < 16; ++e) lg[e] += h2 * wr[k * 16 + e];
  }
  float mx = lg[0]; _Pragma("unroll") for (int e = 1; e < 16; ++e) mx = fmaxf(mx, lg[e]);
  float sm = 0.f; _Pragma("unroll") for (int e = 0; e < 16; ++e) { lg[e] = expf(lg[e] - mx); sm += lg[e]; }
  int b, s; bs_of((int)r, b, s);
  _Pragma("unroll") for (int e = 0; e < 16; ++e) p.AFF[((size_t)b * NE + e) * TK + s] = lg[e] / sm;
}
__global__ void __launch_bounds__(256) nv_topk(Params p, int need_ctx) {
  long i = GTID; if (i >= NB * NE * 2) return;
  int seg = (int)(i % 2), e = (int)((i / 2) % NE), b = (int)(i / (2 * NE));
  int s0 = seg ? TC : 0, n = seg ? TL : TC, cap = seg ? CAPL : CAPC, slot0 = seg ? b * CAPL : NB * CAPL + b * CAPC;
  if (seg == 0 && !need_ctx) { for (int q = 0; q < cap; ++q) p.SEL[(size_t)e * NSLOT + slot0 + q] = -1; return; }
  const float* a = p.AFF + ((size_t)b * NE + e) * TK + s0;
  unsigned thr = 0;
  for (int bit = 31; bit >= 0; --bit) {
    unsigned cand = thr | (1u << bit); int cnt = 0;
    for (int t = 0; t < n; ++t) cnt += (f2u(a[t]) >= cand);
    if (cnt >= cap) thr = cand;
  }
  int ngt = 0; for (int t = 0; t < n; ++t) ngt += (f2u(a[t]) > thr);
  int neq = cap - ngt, q = 0;
  for (int t = 0; t < n; ++t) {
    unsigned u = f2u(a[t]); int r = row_of(b, s0 + t); int sel = -1;
    if (u > thr) sel = q++; else if (u == thr && neq > 0) { sel = q++; --neq; }
    if (sel >= 0) { p.SEL[(size_t)e * NSLOT + slot0 + sel] = r; p.SELV[(size_t)e * NSLOT + slot0 + sel] = a[t]; }
    p.INV[(size_t)r * NE + e] = sel >= 0 ? slot0 + sel : -1;
  }
}
__global__ void __launch_bounds__(256) nv_moe1(Params p) {
  long i = GTID; if (i >= (long)NE * NSLOT * FF) return;
  int f = (int)(i % FF), slot = (int)((i / FF) % NSLOT), e = (int)(i / ((long)FF * NSLOT));
  int r = p.SEL[(size_t)e * NSLOT + slot];
  float out = 0.f;
  if (r >= 0) {
    const bf16_t* wg = p.Wt_eg + ((size_t)e * FF + f) * D; const bf16_t* wu = p.Wt_eu + ((size_t)e * FF + f) * D; const bf16_t* h = p.H + (size_t)r * D;
    float g = 0.f, u = 0.f; for (int k = 0; k < D; ++k) { float hv = bf2f(h[k]); g += hv * bf2f(wg[k]); u += hv * bf2f(wu[k]); }
    out = siluf_(g) * u;
  }
  p.HID[((size_t)e * NSLOT + slot) * FF + f] = f2bf(out);
}
__global__ void __launch_bounds__(256) nv_moe2(Params p) {
  long i = GTID; if (i >= (long)NE * NSLOT * D) return;
  int j = (int)(i % D), slot = (int)((i / D) % NSLOT), e = (int)(i / ((long)D * NSLOT));
  int r = p.SEL[(size_t)e * NSLOT + slot];
  float out = 0.f;
  if (r >= 0) {
    const bf16_t* wd = p.Wt_ed + ((size_t)e * D + j) * FF; const bf16_t* h = p.HID + ((size_t)e * NSLOT + slot) * FF;
    float a = 0.f; for (int k = 0; k < FF; ++k) a += bf2f(h[k]) * bf2f(wd[k]);
    out = a * p.SELV[(size_t)e * NSLOT + slot];
  }
  p.YE[((size_t)e * NSLOT + slot) * D + j] = f2bf(out);
}
__global__ void __launch_bounds__(256) nv_resid_ffn(Params p, int layer, int nrows) {
  long r = GTID; if (r >= nrows) return;
  int w = r < RL ? (int)(r / TL) : 2;
  const float* mb = p.mods + (size_t)(layer * 3 + w) * 6144;
  float* xo = r < RL ? p.out + (size_t)r * D : p.xc + (size_t)(r - RL) * D;
  float ss = 0.f;
  for (int k = 0; k < D; ++k) {
    float f = 0.f;
    for (int e = 0; e < NE; ++e) { int sl = p.INV[(size_t)r * NE + e]; if (sl >= 0) f += bf2f(p.YE[((size_t)e * NSLOT + sl) * D + k]); }
    ss += f * f;
  }
  float rstd = 1.0f / sqrtf(ss / D + 1e-6f);
  for (int k = 0; k < D; ++k) {
    float f = 0.f;
    for (int e = 0; e < NE; ++e) { int sl = p.INV[(size_t)r * NE + e]; if (sl >= 0) f += bf2f(p.YE[((size_t)e * NSLOT + sl) * D + k]); }
    xo[k] += mb[5 * 1024 + k] * f * rstd * p.g_ffn_post[layer * 1024 + k];
  }
}

__global__ void __launch_bounds__(256) nv_mods(Params p) { nvb_mods(GTID, p); }
__global__ void __launch_bounds__(256) nv_ml_gates(Params p, int layer) { nvb_ml_gates(GTID, p, layer); }
__global__ void __launch_bounds__(256) nv_gla_cum(Params p, int layer) { nvb_gla_cum(GTID, p, layer); }
__global__ void __launch_bounds__(256) nv_ml_local(Params p) { nvb_ml_local(GTID, p); }
__global__ void __launch_bounds__(256) nv_ml_scan(Params p) { nvb_ml_scan(GTID, p); }
__global__ void __launch_bounds__(256) nv_ml_out(Params p, int need_ctx) { nvb_ml_out(GTID, p, need_ctx); }
__global__ void __launch_bounds__(256) nv_ml_finish(Params p, int layer, int need_ctx) { nvb_ml_finish(GTID, p, layer, need_ctx); }
__global__ void __launch_bounds__(256) nv_gla_local(Params p) { nvb_gla_local(GTID, p); }
__global__ void __launch_bounds__(256) nv_gla_scan(Params p) { nvb_gla_scan(GTID, p); }
__global__ void __launch_bounds__(256) nv_gla_out(Params p, int need_ctx) { nvb_gla_out(GTID, p, need_ctx); }
__global__ void __launch_bounds__(256) nv_gla_finish(Params p, int layer, int need_ctx) { nvb_gla_finish(GTID, p, layer, need_ctx); }
constexpr int LROW = 144;
constexpr int A_BYTES = 128 * LROW;
constexpr int NTHR = 256;
#ifndef ATT_THR
#define ATT_THR 16.0f
#endif

DI int xcd_swz(int u, int nt) { return (nt & 7) ? u : (u & 7) * (nt >> 3) + (u >> 3); }
template <int GW> DI void grp_tile(int L, int ntm, int ntn, int& tm, int& tn) {
  const int gsz = ntm * GW; int g = 0;
  while (L >= gsz) { L -= gsz; ++g; }
  tm = L / GW; tn = g * GW + (L & (GW - 1)); (void)ntn;
}
DI u32x4 ldg16(const void* p) { return *(const u32x4*)p; }
DI void sts16(char* p, u32x4 v) { *(u32x4*)p = v; }
DI bf16x8 lds_frag(const char* p) { return *(const bf16x8*)p; }

template <int WN, int KFIX = 0>
DI void gemm_kloop(f32x4 (&acc)[4][WN], const bf16_t* const (&ap)[4], const bf16_t* const (&bp)[WN], int nk, char* lds) {
  constexpr int STAGE = A_BYTES + 32 * WN * LROW;
  const int t = TIDX, lane = t & 63, wid = t >> 6, wr = wid >> 1, wc = wid & 1;
  const int lr = t >> 3, lcb = (t & 7) * 16;
  const int fr = lane & 15, fq = lane >> 4;
  const int aoff = (wr * 64 + fr) * LROW + fq * 16, boff = A_BYTES + (wc * WN * 16 + fr) * LROW + fq * 16, soff = lr * LROW + lcb;
  u32x4 ra0[4], rb0[WN], ra1[4], rb1[WN];
  auto gload = [&](u32x4 (&ra)[4], u32x4 (&rb)[WN], int kt) {
#pragma unroll
    for (int i = 0; i < 4; ++i) ra[i] = ldg16(ap[i] + (KFIX ? (kt & 1) : kt) * 64);
#pragma unroll
    for (int i = 0; i < WN; ++i) rb[i] = ldg16(bp[i] + (KFIX ? (kt & 1) : kt) * 64);
  };
  auto sstore = [&](const u32x4 (&ra)[4], const u32x4 (&rb)[WN], char* st) {
#pragma unroll
    for (int i = 0; i < 4; ++i) sts16(st + soff + 32 * i * LROW, ra[i]);
#pragma unroll
    for (int i = 0; i < WN; ++i) sts16(st + A_BYTES + soff + 32 * i * LROW, rb[i]);
  };
  auto compute = [&](const char* cur) {
#pragma unroll
    for (int ks = 0; ks < 2; ++ks) {
      bf16x8 af[4], bfr[WN];
#pragma unroll
      for (int m = 0; m < 4; ++m) af[m] = lds_frag(cur + aoff + m * 16 * LROW + ks * 64);
#pragma unroll
      for (int n = 0; n < WN; ++n) bfr[n] = lds_frag(cur + boff + n * 16 * LROW + ks * 64);
#pragma unroll
      for (int m = 0; m < 4; ++m)
#pragma unroll
        for (int n = 0; n < WN; ++n) acc[m][n] = MFMA16(bfr[n], af[m], acc[m][n]);
    }
    IGLP_OPT();
  };
  gload(ra0, rb0, 0);
  gload(ra1, rb1, 1);
  sstore(ra0, rb0, lds);
  __syncthreads();
#pragma unroll 1
  for (int kt = 0; kt < nk; kt += 2) {
    if (kt + 2 < nk) gload(ra0, rb0, kt + 2);
    compute(lds);
    sstore(ra1, rb1, lds + STAGE);
    __syncthreads();
    if (kt + 3 < nk) gload(ra1, rb1, kt + 3);
    compute(lds + STAGE);
    if (kt + 2 < nk) sstore(ra0, rb0, lds);
    __syncthreads();
  }
}
template <int WN> DI void acc_zero(f32x4 (&acc)[4][WN]) {
#pragma unroll
  for (int m = 0; m < 4; ++m)
#pragma unroll
    for (int n = 0; n < WN; ++n) acc[m][n] = (f32x4){0.f, 0.f, 0.f, 0.f};
}
DI void st_bf16x4(bf16_t* p, f32x4 v) { u32x2 o; o.x = pack2bf(v.x, v.y); o.y = pack2bf(v.z, v.w); *(u32x2*)p = o; }

template <int WN, class RowOk>
DI void store_wave_tile(const f32x4 (&acc)[4][WN], bf16_t* C, size_t ldc, char* ldsw, int lane, RowOk row_ok) {
  constexpr int PITCH = WN * 32 + 16, CPR = WN * 2;
  const int fr = lane & 15, fq = lane >> 4;
#pragma unroll
  for (int m = 0; m < 4; ++m)
#pragma unroll
    for (int n = 0; n < WN; ++n) { u32x2 o; o.x = pack2bf(acc[m][n][0], acc[m][n][1]); o.y = pack2bf(acc[m][n][2], acc[m][n][3]); *(u32x2*)(ldsw + (m * 16 + fr) * PITCH + n * 32 + fq * 8) = o; }
  WAVE_SYNC();
  constexpr int RPP = 64 / CPR;
#pragma unroll
  for (int ps = 0; ps < 64 / RPP; ++ps) {
    const int r = ps * RPP + lane / CPR, c = lane % CPR;
    const u32x4 v = *(const u32x4*)(ldsw + r * PITCH + c * 16);
    if (row_ok(r)) *(u32x4*)(C + (size_t)r * ldc + c * 8) = v;
  }
  WAVE_SYNC();
}
template <int NOSTORE = 0>
DI void gemm_plain_tile(const bf16_t* A, int lda, const bf16_t* Bt, int ldb, int K, bf16_t* C, int ldc, int tm, int tn, char* lds) {
  const int t = TIDX, lane = t & 63, wid = t >> 6, wr = wid >> 1, wc = wid & 1, lr = t >> 3, lc = (t & 7) * 8, fr = lane & 15, fq = lane >> 4;
  const bf16_t* ap[4]; const bf16_t* bp[4];
#pragma unroll
  for (int i = 0; i < 4; ++i) { ap[i] = A + (size_t)(tm * 128 + lr + 32 * i) * lda + lc; bp[i] = Bt + (size_t)(tn * 128 + lr + 32 * i) * ldb + lc; }
  f32x4 acc[4][4]; acc_zero<4>(acc);
  gemm_kloop<4, NOSTORE == 2>(acc, ap, bp, K / 64, lds);
  if (NOSTORE) { float s = 0.f;
#pragma unroll
    for (int m = 0; m < 4; ++m)
#pragma unroll
      for (int n = 0; n < 4; ++n) s += acc[m][n][0] + acc[m][n][3];
    if (s == 123456.789f) C[0] = 1; return; }
  store_wave_tile<4>(acc, C + (size_t)(tm * 128 + wr * 64) * ldc + tn * 128 + wc * 64, (size_t)ldc, lds + wid * (64 * 144), lane, [](int) { return true; });
  __syncthreads();
}
template <int NOSTORE = 0>
DI void ph_gemm_plain(const bf16_t* A, int lda, const bf16_t* Bt, int ldb, int M, int N, int K, bf16_t* C, int ldc, char* lds, int bid, int nblk) {
  const int ntn = N / 128, nt = (M / 128) * ntn;
  for (int u = bid; u < nt; u += nblk) { int tm, tn; grp_tile<8>(xcd_swz(u, nt), M / 128, ntn, tm, tn); gemm_plain_tile<NOSTORE>(A, lda, Bt, ldb, K, C, ldc, tm, tn, lds); }
}
DI void ph_mla_up(const Params& p, int layer, bf16_t* QRAW, bf16_t* KVRAW, char* lds, int bid, int nblk) {
  const int ntq = (R / 128) * 3, ntkv = (R / 128) * 4;
  for (int tile = bid; tile < ntq + ntkv; tile += nblk) {
    if (tile < ntq) gemm_plain_tile(p.Z + ZC_QLAT, NZP, p.Wt_uq + layer * WSZ_UQ, 256, 256, QRAW, 384, tile / 3, tile % 3, lds);
    else { int u = tile - ntq; gemm_plain_tile(p.Z + ZC_KVLAT, NZP, p.Wt_ukv + layer * WSZ_UKV, 128, 128, KVRAW, 512, u / 4, u % 4, lds); }
  }
}
constexpr int LROW32 = 80;
template <int WM, int WN, bool DEEP>
DI void gemm_kloop_g(f32x4 (&acc)[WM][WN], const bf16_t* const (&ap)[WM / 2], const bf16_t* const (&bp)[WN / 2], int nk, char* lds) {
  constexpr int NA = WM / 2, NBB = WN / 2, A_B = 32 * WM * LROW32, STAGE = (32 * WM + 32 * WN) * LROW32;
  const int t = TIDX, lane = t & 63, wid = t >> 6, wr = wid >> 1, wc = wid & 1, fr = lane & 15, fq = lane >> 4;
  const int aoff = (wr * 16 * WM + fr) * LROW32 + fq * 16, boff = A_B + (wc * 16 * WN + fr) * LROW32 + fq * 16, soff = (t >> 2) * LROW32 + (t & 3) * 16;
  u32x4 ra0[NA], rb0[NBB], ra1[NA], rb1[NBB];
  auto gload = [&](u32x4 (&ra)[NA], u32x4 (&rb)[NBB], int kt) {
#pragma unroll
    for (int i = 0; i < NA; ++i) ra[i] = ldg16(ap[i] + kt * 32);
#pragma unroll
    for (int i = 0; i < NBB; ++i) rb[i] = ldg16(bp[i] + kt * 32);
  };
  auto sstore = [&](const u32x4 (&ra)[NA], const u32x4 (&rb)[NBB], char* st) {
#pragma unroll
    for (int i = 0; i < NA; ++i) sts16(st + soff + 64 * i * LROW32, ra[i]);
#pragma unroll
    for (int i = 0; i < NBB; ++i) sts16(st + A_B + soff + 64 * i * LROW32, rb[i]);
  };
  auto compute = [&](const char* cur) {
    bf16x8 af[WM];
#pragma unroll
    for (int m = 0; m < WM; ++m) af[m] = lds_frag(cur + aoff + m * 16 * LROW32);
#pragma unroll
    for (int n = 0; n < WN; ++n) {
      const bf16x8 bfr = lds_frag(cur + boff + n * 16 * LROW32);
#pragma unroll
      for (int m = 0; m < WM; ++m) acc[m][n] = MFMA16(bfr, af[m], acc[m][n]);
    }
    IGLP_OPT();
  };
  gload(ra0, rb0, 0);
  if (DEEP) gload(ra1, rb1, 1);
  sstore(ra0, rb0, lds);
  __syncthreads();
#pragma unroll 1
  for (int kt = 0; kt < nk; kt += 2) {
    if (DEEP) { if (kt + 2 < nk) gload(ra0, rb0, kt + 2); } else gload(ra1, rb1, kt + 1);
    compute(lds);
    sstore(ra1, rb1, lds + STAGE);
    __syncthreads();
    if (DEEP) { if (kt + 3 < nk) gload(ra1, rb1, kt + 3); } else if (kt + 2 < nk) gload(ra0, rb0, kt + 2);
    compute(lds + STAGE);
    if (kt + 2 < nk) sstore(ra0, rb0, lds);
    __syncthreads();
  }
}
template <int WM, int WN> DI void acc_zero_g(f32x4 (&acc)[WM][WN]) {
#pragma unroll
  for (int m = 0; m < WM; ++m)
#pragma unroll
    for (int n = 0; n < WN; ++n) acc[m][n] = (f32x4){0.f, 0.f, 0.f, 0.f};
}
DI void ph_merge(const Params& p, int layer, int rows, char* lds, int bid, int nblk) {
  const int t = TIDX, lane = t & 63, wid = t >> 6, wr = wid >> 1, wc = wid & 1, fr = lane & 15, fq = lane >> 4;
  const int lr = t >> 2, lc = (t & 3) * 8;
  const int ntn = D / 64, nt = (rows / 128) * ntn;
#pragma unroll 1
  for (int u = bid; u < nt; u += nblk) {
    int tm, tn; grp_tile<4>(xcd_swz(u, nt), rows / 128, ntn, tm, tn);
    f32x4 accS[4][2]; acc_zero_g<4, 2>(accS);
#pragma unroll 1
    for (int np = 0; np < 2; ++np) {
      f32x4 accG[4][4]; acc_zero_g<4, 4>(accG);
      {
        const bf16_t* ap[2]; const bf16_t* bp[2];
#pragma unroll
        for (int i = 0; i < 2; ++i) ap[i] = p.H + (size_t)(tm * 128 + lr + 64 * i) * D + lc;
#pragma unroll
        for (int i = 0; i < 2; ++i) { const int rho = lr + 64 * i, wci = rho >> 6, n = 2 * np + ((rho >> 5) & 1), c = rho & 31;
          bp[i] = p.Wt_gate + layer * WSZ_GATE + ((size_t)n * 1024 + tn * 64 + wci * 32 + c) * D + lc; }
        gemm_kloop_g<4, 4, true>(accG, ap, bp, D / 32, lds);
      }
#pragma unroll 1
      for (int q = 0; q < 2; ++q) {
        const int n = 2 * np + q;
        f32x4 accP[4][2]; acc_zero_g<4, 2>(accP);
        const bf16_t* ap[2]; const bf16_t* bp[1];
#pragma unroll
        for (int i = 0; i < 2; ++i) ap[i] = p.Y + (size_t)(tm * 128 + lr + 64 * i) * D + n * 256 + lc;
        bp[0] = p.Wt_branch + layer * WSZ_BR + ((size_t)n * D + tn * 64 + lr) * 256 + lc;
        gemm_kloop_g<4, 2, false>(accP, ap, bp, 8, lds);
#pragma unroll
        for (int nn = 0; nn < 2; ++nn) {
          const f32x4 bv = *(const f32x4*)(p.b_gate + layer * 4096 + n * 1024 + tn * 64 + wc * 32 + nn * 16 + 4 * fq);
#pragma unroll
          for (int m = 0; m < 4; ++m)
#pragma unroll
            for (int j = 0; j < 4; ++j) { const float g = q ? accG[m][2 + nn][j] : accG[m][nn][j]; accS[m][nn][j] += accP[m][nn][j] * fast_rcp(1.0f + fast_exp2(-LOG2E * (g + bv[j]))); }
        }
      }
    }
    store_wave_tile<2>(accS, p.MG + (size_t)(tm * 128 + wr * 64) * D + tn * 64 + wc * 32, (size_t)D, lds + wid * (64 * 80), lane, [](int) { return true; });
    __syncthreads();
  }
}
template <int WM>
DI void gemm_plain_tile_g(const bf16_t* A, int lda, const bf16_t* Bt, int ldb, int K, bf16_t* C, int ldc, int row0, int col0, char* lds) {
  const int t = TIDX, lane = t & 63, wid = t >> 6, wr = wid >> 1, wc = wid & 1, fr = lane & 15, fq = lane >> 4, lr = t >> 2, lc = (t & 3) * 8;
  const bf16_t* ap[WM / 2]; const bf16_t* bp[2];
#pragma unroll
  for (int i = 0; i < WM / 2; ++i) ap[i] = A + (size_t)(row0 + lr + 64 * i) * lda + lc;
#pragma unroll
  for (int i = 0; i < 2; ++i) bp[i] = Bt + (size_t)(col0 + lr + 64 * i) * ldb + lc;
  f32x4 acc[WM][4]; acc_zero_g<WM, 4>(acc);
  gemm_kloop_g<WM, 4, true>(acc, ap, bp, K / 32, lds);
#pragma unroll
  for (int m = 0; m < WM; ++m)
#pragma unroll
    for (int n = 0; n < 4; ++n)
      st_bf16x4(C + (size_t)(row0 + wr * 16 * WM + m * 16 + fr) * ldc + col0 + wc * 64 + n * 16 + 4 * fq, acc[m][n]);
}
DI void ph_gemm_plain2(const bf16_t* A, int lda, const bf16_t* Bt, int ldb, int M, int N, int K, bf16_t* C, int ldc, char* lds, int bid, int nblk) {
  const int ntn = N / 128, nt = (M / 256) * ntn, nfull = (nt / nblk) * nblk;
#pragma unroll 1
  for (int tile = bid; tile < nfull; tile += nblk) gemm_plain_tile_g<8>(A, lda, Bt, ldb, K, C, ldc, (tile / ntn) * 256, (tile % ntn) * 128, lds);
#pragma unroll 1
  for (int h = bid; h < 2 * (nt - nfull); h += nblk) { const int tile = nfull + (h >> 1); gemm_plain_tile_g<4>(A, lda, Bt, ldb, K, C, ldc, (tile / ntn) * 256 + (h & 1) * 128, (tile % ntn) * 128, lds); }
}
DI void gemm_kloop32(f32x16 (&acc)[2][2], const bf16_t* const (&ap)[4], const bf16_t* const (&bp)[4], int nk, char* lds) {
  constexpr int STAGE = A_BYTES + 128 * LROW;
  const int t = TIDX, lane = t & 63, wid = t >> 6, wr = wid >> 1, wc = wid & 1, l31 = lane & 31, hh = lane >> 5;
  const int aoff = (wr * 64 + l31) * LROW + hh * 16, boff = A_BYTES + (wc * 64 + l31) * LROW + hh * 16, soff = (t >> 3) * LROW + (t & 7) * 16;
  u32x4 ra0[4], rb0[4], ra1[4], rb1[4];
  auto gload = [&](u32x4 (&ra)[4], u32x4 (&rb)[4], int kt) {
#pragma unroll
    for (int i = 0; i < 4; ++i) { ra[i] = ldg16(ap[i] + kt * 64); rb[i] = ldg16(bp[i] + kt * 64); }
  };
  auto sstore = [&](const u32x4 (&ra)[4], const u32x4 (&rb)[4], char* st) {
#pragma unroll
    for (int i = 0; i < 4; ++i) { sts16(st + soff + 32 * i * LROW, ra[i]); sts16(st + A_BYTES + soff + 32 * i * LROW, rb[i]); }
  };
  auto compute = [&](const char* cur) {
#pragma unroll
    for (int ks = 0; ks < 4; ++ks) {
      bf16x8 af[2], bfr[2];
#pragma unroll
      for (int m = 0; m < 2; ++m) af[m] = lds_frag(cur + aoff + m * 32 * LROW + ks * 32);
#pragma unroll
      for (int n = 0; n < 2; ++n) bfr[n] = lds_frag(cur + boff + n * 32 * LROW + ks * 32);
#pragma unroll
      for (int m = 0; m < 2; ++m)
#pragma unroll
        for (int n = 0; n < 2; ++n) acc[m][n] = MFMA32(bfr[n], af[m], acc[m][n]);
    }
  };
  gload(ra0, rb0, 0); gload(ra1, rb1, 1);
  sstore(ra0, rb0, lds);
  __syncthreads();
#pragma unroll 1
  for (int kt = 0; kt < nk; kt += 2) {
    if (kt + 2 < nk) gload(ra0, rb0, kt + 2);
    compute(lds);
    sstore(ra1, rb1, lds + STAGE);
    __syncthreads();
    if (kt + 3 < nk) gload(ra1, rb1, kt + 3);
    compute(lds + STAGE);
    if (kt + 2 < nk) sstore(ra0, rb0, lds);
    __syncthreads();
  }
}
DI void ph_gemm_plain32(const bf16_t* A, int lda, const bf16_t* Bt, int ldb, int M, int N, int K, bf16_t* C, int ldc, char* lds, int bid, int nblk) {
  const int t = TIDX, lane = t & 63, wid = t >> 6, wr = wid >> 1, wc = wid & 1, lr = t >> 3, lc = (t & 7) * 8, l31 = lane & 31, hh = lane >> 5;
  const int ntn = N / 128, nt = (M / 128) * ntn;
#pragma unroll 1
  for (int tile = bid; tile < nt; tile += nblk) {
    const int tm = tile / ntn, tn = tile % ntn;
    const bf16_t* ap[4]; const bf16_t* bp[4];
#pragma unroll
    for (int i = 0; i < 4; ++i) { ap[i] = A + (size_t)(tm * 128 + lr + 32 * i) * lda + lc; bp[i] = Bt + (size_t)(tn * 128 + lr + 32 * i) * ldb + lc; }
    f32x16 acc[2][2];
#pragma unroll
    for (int m = 0; m < 2; ++m)
#pragma unroll
      for (int n = 0; n < 2; ++n) acc[m][n] = (f32x16)(0.f);
    gemm_kloop32(acc, ap, bp, K / 64, lds);
#pragma unroll
    for (int m = 0; m < 2; ++m)
#pragma unroll
      for (int n = 0; n < 2; ++n)
#pragma unroll
        for (int g = 0; g < 4; ++g) {
          f32x4 o = {acc[m][n][4 * g], acc[m][n][4 * g + 1], acc[m][n][4 * g + 2], acc[m][n][4 * g + 3]};
          st_bf16x4(C + (size_t)(tm * 128 + wr * 64 + m * 32 + l31) * ldc + tn * 128 + wc * 64 + n * 32 + 8 * g + 4 * hh, o);
        }
  }
}
template <int MODE>
DI void ph_gemm_probe(const bf16_t* A, int lda, const bf16_t* Bt, int ldb, int M, int N, int K, float* sink, char* lds, int bid, int nblk) {
  const int t = TIDX, lane = t & 63, wid = t >> 6, wr = wid >> 1, wc = wid & 1, lr = t >> 3, lc = (t & 7) * 8, fr = lane & 15, fq = lane >> 4;
  const int ntn = N / 128, nt = (M / 128) * ntn, nk = K / 64;
  constexpr int STAGE = A_BYTES + 128 * LROW;
  const int aoff = (wr * 64 + fr) * LROW + fq * 16, boff = A_BYTES + (wc * 64 + fr) * LROW + fq * 16;
#pragma unroll 1
  for (int tile = bid; tile < nt; tile += nblk) {
    f32x4 acc[4][4]; acc_zero<4>(acc);
    bf16x8 af[4], bfr[4];
    const int tm = tile / ntn, tn = tile % ntn;
    const bf16_t* ap[4]; const bf16_t* bp[4];
#pragma unroll
    for (int i = 0; i < 4; ++i) { ap[i] = A + (size_t)(tm * 128 + lr + 32 * i) * lda + lc; bp[i] = Bt + (size_t)(tn * 128 + lr + 32 * i) * ldb + lc; }
    u32x4 ra[4], rb[4], junk = {0u, 0u, 0u, 0u};
#pragma unroll
    for (int i = 0; i < 4; ++i) { ra[i] = junk; rb[i] = junk; }
#pragma unroll 1
    for (int kt = 0; kt < nk; ++kt) {
      const char* cur = lds + (kt & 1) * STAGE;
#pragma unroll
      for (int i = 0; i < 4; ++i) { ra[i] = ldg16(ap[i] + kt * 64); if (MODE == 3) rb[i] = ldg16(bp[i] + kt * 64); }
#pragma unroll
      for (int ks = 0; ks < 2; ++ks) {
#pragma unroll
        for (int m = 0; m < 4; ++m) { af[m] = lds_frag(cur + aoff + m * 16 * LROW + ks * 64); bfr[m] = lds_frag(cur + boff + m * 16 * LROW + ks * 64); }
#pragma unroll
        for (int m = 0; m < 4; ++m)
#pragma unroll
          for (int n = 0; n < 4; ++n) acc[m][n] = MFMA16(bfr[n], af[m], acc[m][n]);
      }
      junk.x ^= ra[0].x ^ ra[1].y ^ ra[2].z ^ ra[3].w ^ rb[0].x ^ rb[1].y ^ rb[2].z ^ rb[3].w;
      __syncthreads();
    }
    float s = (float)(junk.x & 1u);
#pragma unroll
    for (int m = 0; m < 4; ++m)
#pragma unroll
      for (int n = 0; n < 4; ++n) s += acc[m][n][0] + acc[m][n][3];
    if (s == 123456.789f) sink[0] = s;
  }
}
DI void ph_moe1(const Params& p, int need_ctx, char* lds, int bid, int nblk) {
  const int t = TIDX, lane = t & 63, wid = t >> 6, wr = wid >> 1, wc = wid & 1, lr = t >> 3, lc = (t & 7) * 8, fr = lane & 15, fq = lane >> 4;
  constexpr int NTN = FF / 64;
  const int NTM = need_ctx ? (NSLOT + 127) / 128 : (NB * CAPL) / 128;
  for (int u = bid; u < NE * NTM * NTN; u += nblk) {
    const int tile = xcd_swz(u, NE * NTM * NTN), e = tile / (NTM * NTN), rem = tile % (NTM * NTN);
    int tm, tn, rr = rem, g = 0;
    if (rr >= NTM * 8) { rr -= NTM * 8; g = 1; }
    if (rr >= NTM * 8) { rr -= NTM * 8; g = 2; }
    if (g < 2) { tm = rr >> 3; tn = g * 8 + (rr & 7); } else { tm = rr / (NTN - 16); tn = 16 + rr - tm * (NTN - 16); }
    const bf16_t* ap[4]; const bf16_t* bp[4];
#pragma unroll
    for (int i = 0; i < 4; ++i) {
      const int slot = tm * 128 + lr + 32 * i;
      int r = slot < NSLOT ? p.SEL[(size_t)e * NSLOT + slot] : -1;
      ap[i] = p.H + (size_t)(r < 0 ? 0 : r) * D + lc;
      const int rho = lr + 32 * i, wci = rho >> 6, gu = (rho >> 5) & 1, col = wci * 32 + (rho & 31);
      bp[i] = (gu ? p.Wt_eu : p.Wt_eg) + ((size_t)e * FF + tn * 64 + col) * D + lc;
    }
    f32x4 acc[4][4]; acc_zero<4>(acc);
    gemm_kloop<4>(acc, ap, bp, D / 64, lds);
    f32x4 hid[4][2];
#pragma unroll
    for (int m = 0; m < 4; ++m) {
      const int slot = tm * 128 + wr * 64 + m * 16 + fr;
      const bool valid = slot < NSLOT && p.SEL[(size_t)e * NSLOT + (slot < NSLOT ? slot : 0)] >= 0;
#pragma unroll
      for (int n = 0; n < 2; ++n)
#pragma unroll
        for (int j = 0; j < 4; ++j) { const float g = acc[m][n][j], u = acc[m][n + 2][j]; hid[m][n][j] = valid ? g * u * fast_rcp(1.0f + fast_exp2(-LOG2E * g)) : 0.f; }
    }
    const int slot0 = tm * 128 + wr * 64;
    store_wave_tile<2>(hid, p.HID + ((size_t)e * NSLOT + slot0) * FF + tn * 64 + wc * 32, (size_t)FF, lds + wid * (64 * 80), lane, [&](int r) { return slot0 + r < NSLOT; });
    __syncthreads();
  }
}
DI void ph_moe2(const Params& p, int need_ctx, char* lds, int bid, int nblk) {
  const int t = TIDX, lane = t & 63, wid = t >> 6, wr = wid >> 1, wc = wid & 1, lr = t >> 3, lc = (t & 7) * 8, fr = lane & 15, fq = lane >> 4;
  constexpr int NTN = D / 128;
  const int NTM = need_ctx ? (NSLOT + 127) / 128 : (NB * CAPL) / 128;
  for (int u = bid; u < NE * NTM * NTN; u += nblk) {
    const int tile = xcd_swz(u, NE * NTM * NTN), e = tile / (NTM * NTN), rem = tile % (NTM * NTN), tm = rem / NTN, tn = rem % NTN;
    const bf16_t* ap[4]; const bf16_t* bp[4];
#pragma unroll
    for (int i = 0; i < 4; ++i) {
      int slot = tm * 128 + lr + 32 * i; if (slot >= NSLOT) slot = NSLOT - 1;
      ap[i] = p.HID + ((size_t)e * NSLOT + slot) * FF + lc;
      bp[i] = p.Wt_ed + ((size_t)e * D + tn * 128 + lr + 32 * i) * FF + lc;
    }
    f32x4 acc[4][4]; acc_zero<4>(acc);
    gemm_kloop<4>(acc, ap, bp, FF / 64, lds);
#pragma unroll
    for (int m = 0; m < 4; ++m) {
      const int slot = tm * 128 + wr * 64 + m * 16 + fr;
      const float val = (slot < NSLOT && p.SEL[(size_t)e * NSLOT + (slot < NSLOT ? slot : 0)] >= 0) ? p.SELV[(size_t)e * NSLOT + slot] : 0.f;
#pragma unroll
      for (int n = 0; n < 4; ++n) { acc[m][n].x *= val; acc[m][n].y *= val; acc[m][n].z *= val; acc[m][n].w *= val; }
    }
    const int slot0 = tm * 128 + wr * 64;
    store_wave_tile<4>(acc, p.YE + ((size_t)e * NSLOT + slot0) * D + tn * 128 + wc * 64, (size_t)D, lds + wid * (64 * 144), lane, [&](int r) { return slot0 + r < NSLOT; });
    __syncthreads();
  }
}
constexpr int GEMM_LDS = 2 * (A_BYTES + 128 * LROW);

DI void unpack8(u32x4 v, float (&f)[8]) {
  f[0] = u2f(v.x << 16); f[1] = u2f(v.x & 0xffff0000u); f[2] = u2f(v.y << 16); f[3] = u2f(v.y & 0xffff0000u);
  f[4] = u2f(v.z << 16); f[5] = u2f(v.z & 0xffff0000u); f[6] = u2f(v.w << 16); f[7] = u2f(v.w & 0xffff0000u);
}
DI u32x4 pack8f(const float (&f)[8]) { u32x4 v; v.x = pack2bf(f[0], f[1]); v.y = pack2bf(f[2], f[3]); v.z = pack2bf(f[4], f[5]); v.w = pack2bf(f[6], f[7]); return v; }
DI void rope8(float (&a)[8], const float (&pr)[8], int cc, const float* cs, const float* sn) {
  const int ax = (cc >> 1) * 8; const bool second = cc & 1;
#pragma unroll
  for (int i = 0; i < 8; ++i) a[i] = second ? a[i] * cs[ax + i] + pr[i] * sn[ax + i] : a[i] * cs[ax + i] - pr[i] * sn[ax + i];
}
constexpr int PREP_LDS = 64 * 4 + 2 * 512 * 4 + 32 * 528;
template <int PARTS = 3>
DI void ph_prep(const Params& p, int layer, const bf16_t* QRAW, const bf16_t* KVRAW, char* lds, int bid, int nblk) {
  float* s_rstd = (float*)lds;
  float* s_cs = s_rstd + 64;
  float* s_sn = s_cs + 512;
  bf16_t* s_t = (bf16_t*)(s_sn + 512);
  const int t = TIDX;
  constexpr int UPB = TK / 32, NU = NB * UPB;
  const float* wcv = p.w_conv + (size_t)layer * 3 * 512;
#pragma unroll 1
  for (int u = bid; u < NU; u += nblk) {
    int b, s0;
    if (u < NB * (TL / 32)) { b = u / (TL / 32); s0 = TC + (u % (TL / 32)) * 32; } else { const int v = u - NB * (TL / 32); b = v / (TC / 32); s0 = (v % (TC / 32)) * 32; }
    const int r0 = row_of(b, s0);
    {
      const int tok = t >> 3, part = t & 7;
      const bf16_t* z = p.Z + (size_t)(r0 + tok) * NZP;
      float sq = 0.f, sk = 0.f, f[8];
#pragma unroll
      for (int k = 0; k < 4; ++k) { unpack8(ldg16(z + ZC_QLAT + part * 32 + k * 8), f);
#pragma unroll
        for (int i = 0; i < 8; ++i) sq += f[i] * f[i]; }
#pragma unroll
      for (int k = 0; k < 2; ++k) { unpack8(ldg16(z + ZC_KVLAT + part * 16 + k * 8), f);
#pragma unroll
        for (int i = 0; i < 8; ++i) sk += f[i] * f[i]; }
      sq = xor_sum<1>(sq); sk = xor_sum<1>(sk);
      sq = xor_sum<2>(sq); sk = xor_sum<2>(sk);
      sq = xor_sum<4>(sq); sk = xor_sum<4>(sk);
      if (part == 0) { s_rstd[tok * 2] = 1.0f / sqrtf(sq * (1.0f / 256) + 1e-6f); s_rstd[tok * 2 + 1] = 1.0f / sqrtf(sk * (1.0f / 128) + 1e-6f); }
    }
    for (int i = t; i < 512; i += NTHR) {
      const int tok = i >> 4, af = i & 15, s = s0 + tok;
      float cs = 1.f, sn = 0.f;
      if (s >= TC) rope_cs(s, (af >> 3) * 16 + (af & 7), cs, sn);
      s_cs[i] = cs; s_sn[i] = sn;
    }
    __syncthreads();
    if (PARTS & 1) {
#pragma unroll 2
    for (int i = t; i < 32 * 48; i += NTHR) {
      const int tok = i / 48, c = i % 48, h = c / 12, ch = c % 12;
      const float rq = s_rstd[tok * 2] * QS_MLA, rkv = s_rstd[tok * 2 + 1];
      const bf16_t* q = QRAW + (size_t)(r0 + tok) * 384 + h * 96;
      float a[8], pr[8];
      unpack8(ldg16(q + ch * 8), a);
      if (ch >= 8) { unpack8(ldg16(q + 64 + ((ch - 8) ^ 1) * 8), pr); rope8(a, pr, ch - 8, s_cs + tok * 16, s_sn + tok * 16); }
#pragma unroll
      for (int e = 0; e < 8; ++e) a[e] *= rq;
      *(u32x4*)(p.Qm + (((size_t)b * 4 + h) * TK + s0 + tok) * 96 + ch * 8) = pack8f(a);
      if (ch < 8) {
        unpack8(ldg16(KVRAW + (size_t)(r0 + tok) * 512 + h * 128 + ch * 8), a);
#pragma unroll
        for (int e = 0; e < 8; ++e) a[e] *= rkv;
      } else {
        const bf16_t* z = p.Z + (size_t)(r0 + tok) * NZP + ZC_KROPE;
        unpack8(ldg16(z + (ch - 8) * 8), a); unpack8(ldg16(z + ((ch - 8) ^ 1) * 8), pr);
        rope8(a, pr, ch - 8, s_cs + tok * 16, s_sn + tok * 16);
      }
      *(u32x4*)(p.Km + (((size_t)b * 4 + h) * TK + s0 + tok) * 96 + ch * 8) = pack8f(a);
    }
#pragma unroll 2
    for (int i = t; i < 32 * 64; i += NTHR) {
      const int tok = i >> 6, c = i & 63, qk = c >> 5, hm = (c >> 2) & 7, cc = c & 3;
      const bf16_t* src = p.Z + (size_t)(r0 + tok) * NZP + (qk ? ZC_DK : ZC_DQ) + hm * 32;
      float a[8], pr[8];
      unpack8(ldg16(src + cc * 8), a); unpack8(ldg16(src + (cc ^ 1) * 8), pr);
      rope8(a, pr, cc, s_cs + tok * 16, s_sn + tok * 16);
      if (qk == 0) {
#pragma unroll
        for (int e = 0; e < 8; ++e) a[e] *= QS_DIFF;
        *(u32x4*)(p.Qd + (((size_t)b * 8 + hm) * TK + s0 + tok) * 32 + cc * 8) = pack8f(a);
      } else *(u32x4*)(p.Kd + (((size_t)b * 8 + hm) * TK + s0 + tok) * 32 + cc * 8) = pack8f(a);
    }
#pragma unroll 2
    for (int i = t; i < 32 * 64; i += NTHR) {
      const int tok = i >> 6, c8 = (i & 63) * 8, s = s0 + tok;
      const bool first = (s == 0) || (s == TC), last = (s == TC - 1) || (s == TK - 1);
      const bf16_t* z = p.Z + (size_t)(r0 + tok) * NZP + ZC_MLQK + c8;
      float x0[8], xm[8], xp[8], o[8];
      unpack8(ldg16(z), x0);
      if (!first) unpack8(ldg16(z - NZP), xm);
      if (!last) unpack8(ldg16(z + NZP), xp);
      float bc8[8], w0[8], w1[8], w2[8];
      *(f32x4*)bc8 = *(const f32x4*)(p.b_conv + layer * 512 + c8); *(f32x4*)(bc8 + 4) = *(const f32x4*)(p.b_conv + layer * 512 + c8 + 4);
      *(f32x4*)w0 = *(const f32x4*)(wcv + c8); *(f32x4*)(w0 + 4) = *(const f32x4*)(wcv + c8 + 4);
      *(f32x4*)w1 = *(const f32x4*)(wcv + 512 + c8); *(f32x4*)(w1 + 4) = *(const f32x4*)(wcv + 512 + c8 + 4);
      *(f32x4*)w2 = *(const f32x4*)(wcv + 1024 + c8); *(f32x4*)(w2 + 4) = *(const f32x4*)(wcv + 1024 + c8 + 4);
#pragma unroll
      for (int e = 0; e < 8; ++e) {
        float acc = bc8[e] + x0[e] * w1[e];
        if (!first) acc += xm[e] * w0[e];
        if (!last) acc += xp[e] * w2[e];
        o[e] = acc * fast_rcp(1.0f + fast_exp2(-LOG2E * acc));
      }
      if (c8 < 256) *(u32x4*)(p.MQ + ((size_t)b * TK + s) * 256 + c8) = pack8f(o);
      else {
#pragma unroll
        for (int e = 0; e < 8; ++e) o[e] *= 0.125f;
        *(u32x4*)(p.MK + ((size_t)b * TK + s) * 256 + c8 - 256) = pack8f(o);
      }
    }
    }
#pragma unroll 1
    for (int w = 0; w < ((PARTS & 2) ? 4 : 0); ++w) {
      __syncthreads();
#pragma unroll
      for (int k = 0; k < 4; ++k) {
        const int i = t + k * NTHR, tok = i >> 5, c8 = (i & 31) * 8;
        u32x4 v;
        if (w == 0) { float a[8]; const int h = c8 >> 6; unpack8(ldg16(KVRAW + (size_t)(r0 + tok) * 512 + h * 128 + 64 + (c8 & 63)), a); const float rkv = s_rstd[tok * 2 + 1];
#pragma unroll
          for (int e = 0; e < 8; ++e) a[e] *= rkv;
          v = pack8f(a); }
        else v = ldg16(p.Z + (size_t)(r0 + tok) * NZP + (w == 1 ? ZC_DV : (w == 2 ? ZC_MLV : ZC_GV)) + c8);
        *(u32x4*)(s_t + tok * 264 + c8) = v;
      }
      __syncthreads();
      bf16_t* dst = w == 0 ? p.Vtm : (w == 1 ? p.Vtd : (w == 2 ? p.MVt : p.GVt));
#pragma unroll
      for (int k = 0; k < 4; ++k) {
        const int i = t + k * NTHR, tg = i & 3, ch = i >> 2;
        u32x4 v;
        v.x = (unsigned)s_t[(tg * 8 + 0) * 264 + ch] | ((unsigned)s_t[(tg * 8 + 1) * 264 + ch] << 16);
        v.y = (unsigned)s_t[(tg * 8 + 2) * 264 + ch] | ((unsigned)s_t[(tg * 8 + 3) * 264 + ch] << 16);
        v.z = (unsigned)s_t[(tg * 8 + 4) * 264 + ch] | ((unsigned)s_t[(tg * 8 + 5) * 264 + ch] << 16);
        v.w = (unsigned)s_t[(tg * 8 + 6) * 264 + ch] | ((unsigned)s_t[(tg * 8 + 7) * 264 + ch] << 16);
        *(u32x4*)(dst + (((size_t)b * 4 + (ch >> 6)) * 64 + (ch & 63)) * TK + s0 + tg * 8) = v;
      }
    }
    __syncthreads();
  }
}
constexpr int VROW = 136;
constexpr int VROW_A = 144;
template <int DQK> struct AttnCfg {
  static constexpr int KROW = DQK * 2 + 16;
  static constexpr int KBYTES = 64 * KROW, VBYTES = 64 * VROW_A, STAGE = KBYTES + VBYTES;
  static constexpr int KCH = 64 * DQK * 2 / 16 / NTHR;
};
DI bf16x8 pack8(const f32x16& x, int s) {
  u32x4 pk; pk.x = pack2bf(x[8 * s], x[8 * s + 1]); pk.y = pack2bf(x[8 * s + 2], x[8 * s + 3]); pk.z = pack2bf(x[8 * s + 4], x[8 * s + 5]); pk.w = pack2bf(x[8 * s + 6], x[8 * s + 7]);
  return __builtin_bit_cast(bf16x8, pk);
}
struct TrueC { static constexpr bool value = true; };
struct FalseC { static constexpr bool value = false; };
template <int DQK, int NMAP, int VAR = 0>
DI void attn_unit(const bf16_t* __restrict__ Qb, const bf16_t* __restrict__ Kb, size_t mstride, const bf16_t* __restrict__ Vt, int q0, int nkeys,
                  f32x16 (&O)[NMAP][2], float (&lsum)[NMAP], char* lds) {
  constexpr int DM = DQK / NMAP;
  constexpr int KS = DM / 16;
  using C = AttnCfg<DQK>;
  constexpr int CPM = 64 * DM * 2 / 16;
  constexpr int CPR = DM * 2 / 16;
  const int t = TIDX, lane = t & 63, wid = t >> 6, l31 = lane & 31, hh = lane >> 5;
  bf16x8 qf[NMAP][KS];
#pragma unroll
  for (int m = 0; m < NMAP; ++m)
#pragma unroll
    for (int ks = 0; ks < KS; ++ks) qf[m][ks] = *(const bf16x8*)(Qb + m * mstride + (size_t)(q0 + wid * 32 + l31) * DM + ks * 16 + 8 * hh);
  float mref[NMAP];
  f32x4 lacc[NMAP];
  const short onev = ((lane & 15) < 2 && ((lane >> 4) & 1) == (lane & 15)) ? (short)0x3F80 : (short)0;
  const bf16x8 ones_a = {onev, onev, onev, onev, onev, onev, onev, onev};
#pragma unroll
  for (int m = 0; m < NMAP; ++m) { mref[m] = 0.f; lacc[m] = (f32x4){0.f, 0.f, 0.f, 0.f}; O[m][0] = (f32x16)(0.f); O[m][1] = (f32x16)(0.f); }
  u32x4 rk[C::KCH], rv[2];
  const bf16_t* kg[C::KCH]; int klds[C::KCH];
#pragma unroll
  for (int i = 0; i < C::KCH; ++i) { const int c = t + i * NTHR, m = c / CPM, cc = c % CPM; kg[i] = Kb + m * mstride + cc * 8; klds[i] = (cc / CPR) * C::KROW + m * DM * 2 + (cc % CPR) * 16; }
  const bf16_t* vg = Vt + (size_t)(t >> 3) * TK + (t & 7) * 8;
  const int vlds = C::KBYTES + (t >> 3) * VROW_A + ((t & 7) >> 1) * 32 + ((t & 1) ? 8 : 0);
  const int kfoff = l31 * C::KROW + 16 * hh, vfoff = C::KBYTES + l31 * VROW_A + 16 * hh;
  const int nt = nkeys / 64;
#pragma unroll
  for (int i = 0; i < C::KCH; ++i) rk[i] = ldg16(kg[i]);
  rv[0] = ldg16(vg); rv[1] = ldg16(vg + (size_t)32 * TK);
  auto tile = [&](const int kt, auto chk_c, auto ref_c) __attribute__((always_inline)) {
    constexpr bool CHK = decltype(chk_c)::value, REF = decltype(ref_c)::value;
    char* cur = lds + (kt & 1) * C::STAGE;
    if (VAR != 2) {
#pragma unroll
    for (int i = 0; i < C::KCH; ++i) sts16(cur + klds[i], rk[i]);
#pragma unroll
    for (int i = 0; i < 2; ++i) { char* d = cur + vlds + i * 32 * VROW_A; u32x2 lo, hi; lo.x = rv[i].x; lo.y = rv[i].y; hi.x = rv[i].z; hi.y = rv[i].w; *(u32x2*)d = lo; *(u32x2*)(d + 16) = hi; }
    __syncthreads();
    }
    if (VAR != 2 && kt + 1 < nt) {
      const int kn = VAR == 3 ? ((kt + 1) & 1) : kt + 1;
#pragma unroll
      for (int i = 0; i < C::KCH; ++i) rk[i] = ldg16(kg[i] + (size_t)kn * 64 * DM);
      rv[0] = ldg16(vg + kn * 64); rv[1] = ldg16(vg + (size_t)32 * TK + kn * 64);
    }
    bf16x8 kf[NMAP][2][KS];
#pragma unroll
    for (int k2 = 0; k2 < 2; ++k2)
#pragma unroll
      for (int ks = 0; ks < KS; ++ks) kf[0][k2][ks] = lds_frag(cur + kfoff + k2 * 32 * C::KROW + ks * 32);
    f32x16 S[NMAP][2];
    S[0][0] = (f32x16)(0.f); S[0][1] = (f32x16)(0.f);
#pragma unroll
    for (int ks = 0; ks < KS; ++ks)
#pragma unroll
      for (int k2 = 0; k2 < 2; ++k2) S[0][k2] = MFMA32(kf[0][k2][ks], qf[0][ks], S[0][k2]);
    bf16x8 vf[4][2];
#pragma unroll
    for (int kst = 0; kst < 4; ++kst)
#pragma unroll
      for (int dvt = 0; dvt < 2; ++dvt) vf[kst][dvt] = lds_frag(cur + vfoff + dvt * 32 * VROW_A + kst * 32);
#pragma unroll
    for (int m = 1; m < NMAP; ++m)
#pragma unroll
      for (int k2 = 0; k2 < 2; ++k2)
#pragma unroll
        for (int ks = 0; ks < KS; ++ks) kf[m][k2][ks] = lds_frag(cur + kfoff + k2 * 32 * C::KROW + m * DM * 2 + ks * 32);
#pragma unroll
    for (int m = 0; m < NMAP; ++m) {
      if (m > 0) {
        SCHED_BARRIER();
        S[m][0] = (f32x16)(0.f); S[m][1] = (f32x16)(0.f);
#pragma unroll
        for (int ks = 0; ks < KS; ++ks)
#pragma unroll
          for (int k2 = 0; k2 < 2; ++k2) S[m][k2] = MFMA32(kf[m][k2][ks], qf[m][ks], S[m][k2]);
      }
      if (VAR != 1) {
      if (CHK && (kt & 7) == 0) {
        float mx = fmaxf(S[m][0][0], S[m][1][0]);
#pragma unroll
        for (int i = 1; i < 16; ++i) mx = fmaxf(mx, fmaxf(S[m][0][i], S[m][1][i]));
        mx = xor_max<32>(mx);
        const float rel = mx - mref[m];
        const float delta = (kt == 0) ? ((mx > ATT_THR || mx < -ATT_THR) ? mx : 0.0f) : (rel > ATT_THR ? rel : 0.0f);
        if (wave_any(delta != 0.0f)) {
          const float alpha = fast_exp2(-delta);
          mref[m] += delta; lacc[m][0] *= alpha; lacc[m][1] *= lane_get(alpha, (lane & 15) + 16);
#pragma unroll
          for (int dvt = 0; dvt < 2; ++dvt)
#pragma unroll
            for (int i = 0; i < 16; ++i) O[m][dvt][i] *= alpha;
        }
      }
      if constexpr (REF) {
        if (wave_any(mref[m] != 0.0f)) {
          const f32x2 nm = {-mref[m], -mref[m]};
#pragma unroll
          for (int k2 = 0; k2 < 2; ++k2)
#pragma unroll
            for (int i = 0; i < 16; i += 2) { const f32x2 x = (f32x2){S[m][k2][i], S[m][k2][i + 1]} + nm; S[m][k2][i] = x.x; S[m][k2][i + 1] = x.y; }
        }
      }
#pragma unroll
      for (int k2 = 0; k2 < 2; ++k2)
#pragma unroll
        for (int i = 0; i < 16; ++i) S[m][k2][i] = fast_exp2(S[m][k2][i]);
      }
#pragma unroll
      for (int kst = 0; kst < 4; ++kst) {
        const bf16x8 pf = pack8(S[m][kst >> 1], kst & 1);
#pragma unroll
        for (int dvt = 0; dvt < 2; ++dvt) O[m][dvt] = MFMA32(vf[kst][dvt], pf, O[m][dvt]);
        lacc[m] = MFMA16(ones_a, pf, lacc[m]);
      }
    }
  };
  int kt = 0;
#pragma unroll 1
  while (kt < nt) {
    tile(kt, TrueC{}, TrueC{});
    ++kt;
    bool nz = false;
#pragma unroll
    for (int m = 0; m < NMAP; ++m) nz = nz || (mref[m] != 0.0f);
    if (!wave_any(nz)) {
      const int k8 = (kt + 7) & ~7, kend = k8 < nt ? k8 : nt;
#pragma unroll 1
      for (; kt < kend; ++kt) tile(kt, FalseC{}, FalseC{});
    }
  }
  __syncthreads();
#pragma unroll
  for (int m = 0; m < NMAP; ++m) { const float a0 = lane_get(lacc[m][0], lane & 15), a1 = lane_get(lacc[m][1], lane & 15); lsum[m] = l31 < 16 ? a0 : a1; }
}
constexpr int ATT_QB = TK / 128;
constexpr int ATT_LDS = 2 * AttnCfg<96>::STAGE;
constexpr int ATT_QBL = TL / 128, ATT_QBC = TC / 128, ATT_LAT_UNITS = NB * 4 * ATT_QBL, ATT_UNITS = ATT_LAT_UNITS + NB * 4 * ATT_QBC;
DI void att_unit(int u, int& bh, int& qb) {
  if (u < ATT_LAT_UNITS) { bh = u & 7; qb = ATT_QBC + (u >> 3); } else { const int v = u - ATT_LAT_UNITS; bh = v & 7; qb = v >> 3; }
}
DI void ph_attn_diff(const Params& p, int layer, int need_ctx, char* lds, int bid, int nblk) {
  const int lane = TIDX & 63, wid = TIDX >> 6, l31 = lane & 31, hh = lane >> 5;
  float lam_init; const float lam = lam_of(p, layer, lam_init);
#pragma unroll 1
  for (int u = bid; u < (need_ctx ? ATT_UNITS : ATT_LAT_UNITS); u += nblk) {
    int bh, qb; att_unit(u, bh, qb);
    const int b = bh >> 2, h = bh & 3, q0 = qb * 128;
    const int r = row_of(b, q0 + wid * 32 + l31);
    f32x16 O[2][2]; float ls[2];
    attn_unit<64, 2>(p.Qd + ((size_t)b * 8 + h * 2) * TK * 32, p.Kd + ((size_t)b * 8 + h * 2) * TK * 32, (size_t)TK * 32, p.Vtd + ((size_t)b * 4 + h) * 64 * TK, q0,
                     q0 < TC ? TC : TK, O, ls, lds);
    const float i0 = 1.0f / ls[0], i1 = lam / ls[1];
    float ss = 0.f;
#pragma unroll
    for (int dvt = 0; dvt < 2; ++dvt)
#pragma unroll
      for (int i = 0; i < 16; ++i) { const float o = O[0][dvt][i] * i0 - O[1][dvt][i] * i1; O[0][dvt][i] = o; ss += o * o; }
    ss = xor_sum<32>(ss);
    const float rstd = (1.0f - lam_init) / sqrtf(ss * (1.0f / 64) + 1e-6f);
    const float* gd = p.g_diff_out + layer * 256 + h * 64;
#pragma unroll
    for (int dvt = 0; dvt < 2; ++dvt)
#pragma unroll
      for (int g = 0; g < 4; ++g) {
        const int dv = dvt * 32 + 8 * g + 4 * hh;
        const f32x4 gv = *(const f32x4*)(gd + dv);
        f32x4 o = {O[0][dvt][4 * g] * rstd * gv[0], O[0][dvt][4 * g + 1] * rstd * gv[1], O[0][dvt][4 * g + 2] * rstd * gv[2], O[0][dvt][4 * g + 3] * rstd * gv[3]};
        st_bf16x4(p.Y + (size_t)r * D + 768 + h * 64 + dv, o);
      }
  }
}
DI void ph_attn_mla(const Params& p, int need_ctx, char* lds, int bid, int nblk) {
  const int lane = TIDX & 63, wid = TIDX >> 6, l31 = lane & 31, hh = lane >> 5;
#pragma unroll 1
  for (int u = bid; u < (need_ctx ? ATT_UNITS : ATT_LAT_UNITS); u += nblk) {
    int bh, qb; att_unit(u, bh, qb);
    const int b = bh >> 2, h = bh & 3, q0 = qb * 128;
    const int r = row_of(b, q0 + wid * 32 + l31);
    f32x16 O[1][2]; float ls[1];
    attn_unit<96, 1>(p.Qm + ((size_t)b * 4 + h) * TK * 96, p.Km + ((size_t)b * 4 + h) * TK * 96, 0, p.Vtm + ((size_t)b * 4 + h) * 64 * TK, q0, q0 < TC ? TC : TK, O, ls, lds);
    const float inv = 1.0f / ls[0];
#pragma unroll
    for (int dvt = 0; dvt < 2; ++dvt)
#pragma unroll
      for (int g = 0; g < 4; ++g) {
        f32x4 o = {O[0][dvt][4 * g] * inv, O[0][dvt][4 * g + 1] * inv, O[0][dvt][4 * g + 2] * inv, O[0][dvt][4 * g + 3] * inv};
        st_bf16x4(p.Y + (size_t)r * D + h * 64 + dvt * 32 + 8 * g + 4 * hh, o);
      }
  }
}
template <int VAR> DI void ph_attn_mla_probe(const Params& p, char* lds, int bid, int nblk) {
  const int lane = TIDX & 63, wid = TIDX >> 6, l31 = lane & 31, hh = lane >> 5;
#pragma unroll 1
  for (int u = bid; u < ATT_LAT_UNITS; u += nblk) {
    int bh, qb; att_unit(u, bh, qb);
    const int b = bh >> 2, h = bh & 3, q0 = qb * 128;
    const int r = row_of(b, q0 + wid * 32 + l31);
    f32x16 O[1][2]; float ls[1];
    attn_unit<96, 1, VAR>(p.Qm + ((size_t)b * 4 + h) * TK * 96, p.Km + ((size_t)b * 4 + h) * TK * 96, 0, p.Vtm + ((size_t)b * 4 + h) * 64 * TK, q0, TK, O, ls, lds);
    const float inv = 1.0f / ls[0];
#pragma unroll
    for (int dvt = 0; dvt < 2; ++dvt)
#pragma unroll
      for (int g = 0; g < 4; ++g) {
        f32x4 o = {O[0][dvt][4 * g] * inv, O[0][dvt][4 * g + 1] * inv, O[0][dvt][4 * g + 2] * inv, O[0][dvt][4 * g + 3] * inv};
        *(f32x4*)(p.out + (size_t)r * D + h * 64 + dvt * 32 + 8 * g + 4 * hh) = o;
      }
  }
}
DI void ph_attn(const Params& p, int layer, int need_ctx, char* lds, int bid, int nblk) {
  ph_attn_diff(p, layer, need_ctx, lds, bid, nblk);
  ph_attn_mla(p, need_ctx, lds, bid, nblk);
}

DI float wave_sum(float v) {
  v = xor_sum<1>(v); v = xor_sum<2>(v); v = xor_sum<4>(v); v = xor_sum<8>(v); v = xor_sum<16>(v); v = xor_sum<32>(v);
  return v;
}
DI void ld_row16(const float* row, int lane, f32x4 (&v)[4]) {
#pragma unroll
  for (int i = 0; i < 4; ++i) v[i] = *(const f32x4*)(row + 256 * i + 4 * lane);
}
DI void ld_row16_bf(const bf16_t* row, int lane, f32x4 (&v)[4]) {
#pragma unroll
  for (int i = 0; i < 4; ++i) { const u32x2 u = *(const u32x2*)(row + 256 * i + 4 * lane); v[i] = (f32x4){u2f(u.x << 16), u2f(u.x & 0xffff0000u), u2f(u.y << 16), u2f(u.y & 0xffff0000u)}; }
}
DI void ph_modulate(const Params& p, int layer, const float* xl, const float* xcx, int bid, int nblk) {
  const int lane = TIDX & 63, wid = TIDX >> 6;
  const float* g = p.g_mix_pre + layer * 1024;
  for (int r = bid * 4 + wid; r < R; r += nblk * 4) {
    const int w = r < RL ? r / TL : 2;
    const float* mb = p.mods + (size_t)(layer * 3 + w) * 6144;
    const float* x = r < RL ? xl + (size_t)r * D : xcx + (size_t)(r - RL) * D;
    f32x4 xv[4], gv[4], sc[4], sh[4];
    ld_row16(x, lane, xv); ld_row16(g, lane, gv); ld_row16(mb + 1024, lane, sc); ld_row16(mb, lane, sh);
    float ss = 0.f;
#pragma unroll
    for (int i = 0; i < 4; ++i)
#pragma unroll
      for (int e = 0; e < 4; ++e) ss += xv[i][e] * xv[i][e];
    const float rstd = 1.0f / sqrtf(wave_sum(ss) * (1.0f / D) + 1e-6f);
#pragma unroll
    for (int i = 0; i < 4; ++i) {
      f32x4 o;
#pragma unroll
      for (int e = 0; e < 4; ++e) o[e] = xv[i][e] * rstd * gv[i][e] * (1.f + sc[i][e]) + sh[i][e];
      st_bf16x4(p.H + (size_t)r * D + 256 * i + 4 * lane, o);
    }
  }
}
DI void ph_resid_mix(const Params& p, int layer, const float* xl_in, const float* xc_in, int rows, char* lds, int bid, int nblk) {
  const int lane = TIDX & 63, wid = TIDX >> 6;
  const float* wr = p.w_router + (size_t)layer * D * 16;
  for (int i = TIDX; i < D * 4; i += NTHR) { const int k = i >> 2, q = i & 3; *(f32x4*)(lds + k * 64 + (k >> 2) * 16 + q * 16) = *(const f32x4*)(wr + k * 16 + q * 4); }
  __syncthreads();
  int wprev = -1;
  f32x4 ac[4], gs[4], s3[4];
  for (int r = bid * 4 + wid; r < rows; r += nblk * 4) {
    const int w = r < RL ? r / TL : 2;
    const float* xin = r < RL ? xl_in + (size_t)r * D : xc_in + (size_t)(r - RL) * D;
    float* xo = r < RL ? p.out + (size_t)r * D : p.xc + (size_t)(r - RL) * D;
    f32x4 yv[4], xv[4];
    ld_row16_bf(p.YO + (size_t)r * D, lane, yv); ld_row16(xin, lane, xv);
    if (w != wprev) {
      const float* mb = p.mods + (size_t)(layer * 3 + w) * 6144;
      f32x4 a[4], c[4];
      ld_row16(mb + 2 * 1024, lane, a); ld_row16(p.g_mix_post + layer * 1024, lane, c);
#pragma unroll
      for (int i = 0; i < 4; ++i) ac[i] = a[i] * c[i];
      ld_row16(p.g_ffn_pre + layer * 1024, lane, a); ld_row16(mb + 4 * 1024, lane, c); ld_row16(mb + 3 * 1024, lane, s3);
#pragma unroll
      for (int i = 0; i < 4; ++i) gs[i] = a[i] * (c[i] + 1.0f);
      wprev = w;
    }
    float ss = 0.f;
#pragma unroll
    for (int i = 0; i < 4; ++i)
#pragma unroll
      for (int e = 0; e < 4; ++e) ss += yv[i][e] * yv[i][e];
    const float rstd = 1.0f / sqrtf(wave_sum(ss) * (1.0f / D) + 1e-6f);
    float s2 = 0.f;
#pragma unroll
    for (int i = 0; i < 4; ++i) {
#pragma unroll
      for (int e = 0; e < 4; ++e) { xv[i][e] += ac[i][e] * yv[i][e] * rstd; s2 += xv[i][e] * xv[i][e]; }
      *(f32x4*)(xo + 256 * i + 4 * lane) = xv[i];
    }
    const float rstd2 = 1.0f / sqrtf(wave_sum(s2) * (1.0f / D) + 1e-6f);
    float lg[16];
#pragma unroll
    for (int e = 0; e < 16; ++e) lg[e] = 0.f;
#pragma unroll
    for (int i = 0; i < 4; ++i) {
      f32x4 h2;
#pragma unroll
      for (int e = 0; e < 4; ++e) h2[e] = xv[i][e] * rstd2 * gs[i][e] + s3[i][e];
      st_bf16x4(p.H + (size_t)r * D + 256 * i + 4 * lane, h2);
#pragma unroll
      for (int e = 0; e < 4; ++e) {
        const char* wk = lds + (256 * i + 4 * lane + e) * 64 + (64 * i + lane) * 16;
#pragma unroll
        for (int q = 0; q < 4; ++q) { const f32x4 wv = *(const f32x4*)(wk + 16 * q); lg[4 * q] += h2[e] * wv[0]; lg[4 * q + 1] += h2[e] * wv[1]; lg[4 * q + 2] += h2[e] * wv[2]; lg[4 * q + 3] += h2[e] * wv[3]; }
      }
    }
#pragma unroll
    for (int e = 0; e < 16; ++e) lg[e] = wave_sum(lg[e]);
    float mx = lg[0];
#pragma unroll
    for (int e = 1; e < 16; ++e) mx = fmaxf(mx, lg[e]);
    float sm = 0.f;
#pragma unroll
    for (int e = 0; e < 16; ++e) { lg[e] = expf(lg[e] - mx); sm += lg[e]; }
    int b, s; bs_of(r, b, s);
    float mine = 0.f;
#pragma unroll
    for (int e = 0; e < 16; ++e) mine = (lane == e) ? lg[e] / sm : mine;
    if (lane < 16) p.AFF[((size_t)b * NE + lane) * TK + s] = mine;
  }
}
DI void ph_resid_ffn(const Params& p, int layer, int rows, int bid, int nblk) {
  const int lane = TIDX & 63, wid = TIDX >> 6;
  int r = bid * 4 + wid;
  int inv_n = (r < rows && lane < NE) ? p.INV[(size_t)r * NE + lane] : -1;
  int wprev = -1;
  f32x4 ac[4], gs[4], sh[4];
#pragma unroll 1
  for (; r < rows; r += nblk * 4) {
    const int w = r < RL ? r / TL : 2;
    if (w != wprev) {
      const float* mb = p.mods + (size_t)(layer * 3 + w) * 6144;
      f32x4 a[4], c[4];
      ld_row16(mb + 5 * 1024, lane, a); ld_row16(p.g_ffn_post + layer * 1024, lane, c);
#pragma unroll
      for (int i = 0; i < 4; ++i) ac[i] = a[i] * c[i];
      if (layer == 0) {
        const float* mb1 = p.mods + (size_t)(3 + w) * 6144;
        ld_row16(p.g_mix_pre + 1024, lane, a); ld_row16(mb1 + 1024, lane, c); ld_row16(mb1, lane, sh);
#pragma unroll
        for (int i = 0; i < 4; ++i) gs[i] = a[i] * (c[i] + 1.0f);
      }
      wprev = w;
    }
    float* xo = r < RL ? p.out + (size_t)r * D : p.xc + (size_t)(r - RL) * D;
    const int myinv = inv_n;
    { const int rn = r + nblk * 4; inv_n = (rn < rows && lane < NE) ? p.INV[(size_t)rn * NE + lane] : -1; }
    f32x4 f[4], xv[4];
    ld_row16(xo, lane, xv);
#pragma unroll
    for (int i = 0; i < 4; ++i) f[i] = (f32x4){0.f, 0.f, 0.f, 0.f};
    unsigned mask = wave_ballot16(myinv >= 0);
#pragma unroll 1
    while (mask) {
      const int e0 = __builtin_ctz(mask); mask &= mask - 1;
      const bool two = mask != 0u;
      const int e1 = two ? __builtin_ctz(mask) : e0; if (two) mask &= mask - 1;
      const int s0 = lane_bcast(myinv, e0), s1 = lane_bcast(myinv, e1);
      f32x4 y0[4], y1[4];
      ld_row16_bf(p.YE + ((size_t)e0 * NSLOT + s0) * D, lane, y0); ld_row16_bf(p.YE + ((size_t)e1 * NSLOT + s1) * D, lane, y1);
      const float w1 = two ? 1.0f : 0.0f;
#pragma unroll
      for (int i = 0; i < 4; ++i) f[i] += y0[i] + y1[i] * w1;
    }
    float ss = 0.f;
#pragma unroll
    for (int i = 0; i < 4; ++i)
#pragma unroll
      for (int e = 0; e < 4; ++e) ss += f[i][e] * f[i][e];
    const float rstd = 1.0f / sqrtf(wave_sum(ss) * (1.0f / D) + 1e-6f);
    float s2 = 0.f;
#pragma unroll
    for (int i = 0; i < 4; ++i) {
#pragma unroll
      for (int e = 0; e < 4; ++e) { xv[i][e] += ac[i][e] * f[i][e] * rstd; s2 += xv[i][e] * xv[i][e]; }
      *(f32x4*)(xo + 256 * i + 4 * lane) = xv[i];
    }
    if (layer == 0) {
      const float rstd2 = 1.0f / sqrtf(wave_sum(s2) * (1.0f / D) + 1e-6f);
#pragma unroll
      for (int i = 0; i < 4; ++i) {
        f32x4 o;
#pragma unroll
        for (int e = 0; e < 4; ++e) o[e] = xv[i][e] * rstd2 * gs[i][e] + sh[i][e];
        st_bf16x4(p.H + (size_t)r * D + 256 * i + 4 * lane, o);
      }
    }
  }
}
DI void ph_mods(const Params& p, char* lds, int bid, int nblk) {
  float* sc = (float*)lds;
  const int t = TIDX;
  for (int i = t; i < 3 * 1024; i += NTHR) { const float v = i < 2048 ? p.c[i] : p.c_ctx[i - 2048]; sc[i] = v / (1.0f + expf(-v)); }
  __syncthreads();
#pragma unroll 1
  for (long gi = (long)bid * NTHR + t; gi < 2 * 3 * 6144; gi += (long)nblk * NTHR) {
    const int col = (int)(gi % 6144), w = (int)((gi / 6144) % 3), l = (int)(gi / (3 * 6144));
    const float* W = p.w_ada + (size_t)l * 1024 * 6144 + col; const float* s = sc + w * 1024;
    float acc[8];
#pragma unroll
    for (int q = 0; q < 8; ++q) acc[q] = 0.f;
#pragma unroll 1
    for (int k = 0; k < 1024; k += 8) {
#pragma unroll
      for (int q = 0; q < 8; ++q) acc[q] += s[k + q] * W[(size_t)(k + q) * 6144];
    }
    p.mods[gi] = ((acc[0] + acc[1]) + (acc[2] + acc[3])) + ((acc[4] + acc[5]) + (acc[6] + acc[7])) + p.b_ada[l * 6144 + col];
  }
  __syncthreads();
}
constexpr int TOPK_LDS = TL * 4 + 2048;
DI int block_sum_i(int v, int* red) {
  const int lane = TIDX & 63, wid = TIDX >> 6;
  v = xor_sum_i<1>(v); v = xor_sum_i<2>(v); v = xor_sum_i<4>(v); v = xor_sum_i<8>(v); v = xor_sum_i<16>(v); v = xor_sum_i<32>(v);
  __syncthreads();
  if (lane == 0) red[wid] = v;
  __syncthreads();
  return red[0] + red[1] + red[2] + red[3];
}
DI int block_excl_scan(int v, int* red) {
  const int lane = TIDX & 63, wid = TIDX >> 6;
  int inc = v;
#pragma unroll
  for (int d = 1; d < 64; d <<= 1) { const int o = lane_up(inc, d, lane); if (lane >= d) inc += o; }
  __syncthreads();
  if (lane == 63) red[wid] = inc;
  __syncthreads();
  int base = 0;
  for (int q = 0; q < wid; ++q) base += red[q];
  return base + inc - v;
}
DI void ph_topk(const Params& p, int need_ctx, char* lds, int bid, int nblk) {
  unsigned* vals = (unsigned*)lds; int* red = (int*)(lds + TL * 4 + 1024);
  const int t = TIDX;
  for (int u = bid; u < NB * NE * 2; u += nblk) {
    const int seg = u & 1, e = (u >> 1) % NE, b = u / (2 * NE);
    const int s0 = seg ? TC : 0, n = seg ? TL : TC, cap = seg ? CAPL : CAPC, slot0 = seg ? b * CAPL : NB * CAPL + b * CAPC;
    if (seg == 0 && !need_ctx) { for (int q = t; q < cap; q += NTHR) p.SEL[(size_t)e * NSLOT + slot0 + q] = -1; continue; }
    const float* a = p.AFF + ((size_t)b * NE + e) * TK + s0;
    const int vpt = (n + NTHR - 1) / NTHR, i0 = t * vpt, i1 = (i0 + vpt < n) ? i0 + vpt : n;
    for (int i = t; i < n; i += NTHR) vals[i + i / vpt] = f2u(a[i]);
    __syncthreads();
    unsigned thr = 0;
    for (int bit = 31; bit >= 0; --bit) {
      const unsigned cand = thr | (1u << bit);
      int cnt = 0;
      for (int i = i0; i < i1; ++i) cnt += (vals[i + t] >= cand);
      if (block_sum_i(cnt, red) >= cap) thr = cand;
    }
    int cgt = 0, ceq = 0;
    for (int i = i0; i < i1; ++i) { cgt += (vals[i + t] > thr); ceq += (vals[i + t] == thr); }
    const int ngt = block_sum_i(cgt, red);
    const int neq = cap - ngt;
    int eqoff = block_excl_scan(ceq, red);
    int csel = 0;
    { int er = eqoff; for (int i = i0; i < i1; ++i) { if (vals[i + t] > thr) ++csel; else if (vals[i + t] == thr) { if (er < neq) ++csel; ++er; } } }
    int q = block_excl_scan(csel, red);
    for (int i = i0; i < i1; ++i) {
      const unsigned v = vals[i + t]; int sel = -1;
      if (v > thr) sel = q++; else if (v == thr) { if (eqoff < neq) sel = q++; ++eqoff; }
      const int r = row_of(b, s0 + i);
      if (sel >= 0) { p.SEL[(size_t)e * NSLOT + slot0 + sel] = r; p.SELV[(size_t)e * NSLOT + slot0 + sel] = u2f(v); }
      p.INV[(size_t)r * NE + e] = sel >= 0 ? slot0 + sel : -1;
    }
    __syncthreads();
  }
}
DI void ph_wt(const float* in, bf16_t* out, int K, int N, int NP, int nbatch, long in_bs, long out_bs, const float* gain, char* lds, int bid, int nblk) {
  float* tile = (float*)lds;
  const int t = TIDX, tk = K / 64, tn = NP / 64, ntile = nbatch * tk * tn;
  f32x4 v[4];
  auto gload = [&](int u) {
    const int bt = u / (tk * tn), rem = u % (tk * tn), k0 = (rem / tn) * 64, n0 = (rem % tn) * 64;
    const float* I = in + (size_t)bt * in_bs;
#pragma unroll
    for (int i = 0; i < 4; ++i) {
      const int idx = t + i * NTHR, kk = idx >> 4, n4 = (idx & 15) * 4;
      v[i] = (f32x4){0.f, 0.f, 0.f, 0.f};
      if (n0 + n4 < N) v[i] = *(const f32x4*)(I + (size_t)(k0 + kk) * N + n0 + n4);
      if (gain) { const float g = gain[k0 + kk]; v[i][0] *= g; v[i][1] *= g; v[i][2] *= g; v[i][3] *= g; }
    }
  };
  if (bid < ntile) gload(bid);
#pragma unroll 1
  for (int u = bid; u < ntile; u += nblk) {
    const int bt = u / (tk * tn), rem = u % (tk * tn), k0 = (rem / tn) * 64, n0 = (rem % tn) * 64;
    bf16_t* O = out + (size_t)bt * out_bs;
#pragma unroll
    for (int i = 0; i < 4; ++i) { const int idx = t + i * NTHR, kk = idx >> 4, n4 = (idx & 15) * 4; float* d = tile + kk * 65 + n4; d[0] = v[i][0]; d[1] = v[i][1]; d[2] = v[i][2]; d[3] = v[i][3]; }
    __syncthreads();
    if (u + nblk < ntile) gload(u + nblk);
#pragma unroll
    for (int i = 0; i < 2; ++i) {
      const int idx = t + i * NTHR, kg = idx & 7, nn = idx >> 3;
      float a[8];
#pragma unroll
      for (int e = 0; e < 8; ++e) a[e] = tile[(kg * 8 + e) * 65 + nn];
      u32x4 o; o.x = pack2bf(a[0], a[1]); o.y = pack2bf(a[2], a[3]); o.z = pack2bf(a[4], a[5]); o.w = pack2bf(a[6], a[7]);
      *(u32x4*)(O + (size_t)(n0 + nn) * K + k0 + kg * 8) = o;
    }
    __syncthreads();
  }
}
DI float wave_max(float v) {
  v = xor_max<1>(v); v = xor_max<2>(v); v = xor_max<4>(v); v = xor_max<8>(v); v = xor_max<16>(v); v = xor_max<32>(v);
  return v;
}
DI bf16x8 cvt8(const float* f) {
  const f32x4 a = *(const f32x4*)f, b = *(const f32x4*)(f + 4);
  u32x4 pk; pk.x = pack2bf(a[0], a[1]); pk.y = pack2bf(a[2], a[3]); pk.z = pack2bf(b[0], b[1]); pk.w = pack2bf(b[2], b[3]);
  return __builtin_bit_cast(bf16x8, pk);
}
constexpr int SCAN_UNITS = NB * NCK * 4, SCAN_LAT_UNITS = NB * NCL * 4;
DI void scan_unit(int u, int& b, int& c, int& h) {
  h = u & 3;
  if (u < SCAN_LAT_UNITS) { c = NCC + (u >> 2) % NCL; b = u / (4 * NCL); } else { const int v = u - SCAN_LAT_UNITS; c = (v >> 2) % NCC; b = v / (4 * NCC); }
}

DI void ph_ml_local(const Params& p, char* lds, int bid, int nblk) {
  bf16_t* sK = (bf16_t*)lds;
  float* sW = (float*)(lds + 64 * 132);
  const int t = TIDX, lane = t & 63, wid = t >> 6, l31 = lane & 31, hh = lane >> 5;
  const int d = wid & 1, vt = wid >> 1;
#pragma unroll 1
  for (int u = bid; u < SCAN_UNITS; u += nblk) {
    int b, c, h; scan_unit(u, b, c, h);
    {
      const int row = t >> 2, seg = (t & 3) * 16;
      const bf16_t* src = p.MK + ((size_t)b * TK + 64 * c + row) * 256 + h * 64 + seg;
      const u32x4 a = ldg16(src), bb = ldg16(src + 8);
      unsigned* dst = (unsigned*)((char*)sK + row * 132 + seg * 2);
      dst[0] = a.x; dst[1] = a.y; dst[2] = a.z; dst[3] = a.w; dst[4] = bb.x; dst[5] = bb.y; dst[6] = bb.z; dst[7] = bb.w;
    }
    if (t < 128) {
      const int dd = t >> 6, l = t & 63, j = step_of(dd, c), pos = dd ? 63 - l : l;
      const size_t o = (((size_t)b * 2 + dd) * TK + 64 * j) * 4 + h;
      const float bend = p.BC[o + 63 * 4], wl = bend - p.BC[o + pos * 4] + p.IGS[o + pos * 4];
      const float ml = wave_max(wl);
      sW[dd * 64 + l] = expf(wl - ml);
      if (l == 0) { const size_t uu = (((size_t)b * 2 + dd) * NCK + j) * 4 + h; p.MM[uu * 4] = ml; p.MM[uu * 4 + 1] = bend; }
    }
    __syncthreads();
    const int j = step_of(d, c);
    const size_t uu = (((size_t)b * 2 + d) * NCK + j) * 4 + h;
    f32x16 acc[2]; acc[0] = (f32x16)(0.f); acc[1] = (f32x16)(0.f);
    const bf16_t* vsrc = p.MVt + (((size_t)b * 4 + h) * 64 + vt * 32 + l31) * TK + 64 * c;
#pragma unroll
    for (int ks = 0; ks < 4; ++ks) {
      const bf16x8 a = *(const bf16x8*)(vsrc + ks * 16 + 8 * hh);
      const float* w = sW + d * 64 + ks * 16 + 8 * hh;
      u32x4 pk;
      pk.x = pack2bf(bf2f((bf16_t)a[0]) * w[0], bf2f((bf16_t)a[1]) * w[1]); pk.y = pack2bf(bf2f((bf16_t)a[2]) * w[2], bf2f((bf16_t)a[3]) * w[3]);
      pk.z = pack2bf(bf2f((bf16_t)a[4]) * w[4], bf2f((bf16_t)a[5]) * w[5]); pk.w = pack2bf(bf2f((bf16_t)a[6]) * w[6], bf2f((bf16_t)a[7]) * w[7]);
      const bf16x8 af = __builtin_bit_cast(bf16x8, pk);
#pragma unroll
      for (int kt = 0; kt < 2; ++kt) {
        bf16x8 bfr;
#pragma unroll
        for (int q = 0; q < 8; ++q) bfr[q] = (short)sK[(ks * 16 + 8 * hh + q) * 66 + kt * 32 + l31];
        acc[kt] = MFMA32(af, bfr, acc[kt]);
      }
    }
#pragma unroll
    for (int kt = 0; kt < 2; ++kt)
#pragma unroll
      for (int i = 0; i < 16; ++i) p.MC[uu * 4096 + (size_t)(vt * 32 + (i & 3) + 8 * (i >> 2) + 4 * hh) * 64 + kt * 32 + l31] = acc[kt][i];
    float nl = 0.f;
    for (int q = 0; q < 32; ++q) { const int l = hh * 32 + q; nl += sW[d * 64 + l] * bf2f(sK[l * 66 + vt * 32 + l31]); }
    nl = xor_sum<32>(nl);
    if (hh == 0) p.MN[uu * 64 + vt * 32 + l31] = nl;
    __syncthreads();
  }
}
constexpr int SCAN_PF = 8;
DI void ph_ml_scan(const Params& p, int bid, int nblk) {
  for (long gi = (long)bid * NTHR + TIDX; gi < (long)NB * 2 * 4 * 4160; gi += (long)nblk * NTHR) {
    const int e = (int)(gi % 4160), ch = (int)(gi / 4160), h = ch & 3, bd = ch >> 2;
    float* base = e < 4096 ? p.MC + (((size_t)bd * NCK) * 4 + h) * 4096 + e : p.MN + (((size_t)bd * NCK) * 4 + h) * 64 + (e - 4096);
    const size_t stride = e < 4096 ? 4 * 4096 : 4 * 64;
    float* mm = p.MM + (((size_t)bd * NCK) * 4 + h) * 4;
    float st = 0.f, m = -1e30f;
    float cl[SCAN_PF], cm[SCAN_PF], cb[SCAN_PF], nl[SCAN_PF], nm[SCAN_PF], nb[SCAN_PF];
#pragma unroll
    for (int q = 0; q < SCAN_PF; ++q) if (q < NCK) { cl[q] = base[(size_t)q * stride]; cm[q] = mm[q * 16]; cb[q] = mm[q * 16 + 1]; }
#pragma unroll 1
    for (int jb = 0; jb < NCK; jb += SCAN_PF) {
#pragma unroll
      for (int q = 0; q < SCAN_PF; ++q) { const int j = jb + SCAN_PF + q; if (j < NCK) { nl[q] = base[(size_t)j * stride]; nm[q] = mm[j * 16]; nb[q] = mm[j * 16 + 1]; } }
#pragma unroll
      for (int q = 0; q < SCAN_PF; ++q) {
        const int j = jb + q;
        if (j < NCK) {
          const float mn = fmaxf(cb[q] + m, cm[q]), a = expf(cb[q] + m - mn), g = expf(cm[q] - mn);
          base[(size_t)j * stride] = st;
          st = a * st + g * cl[q];
          if (e == 0) mm[j * 16 + 2] = m;
          m = mn;
        }
      }
#pragma unroll
      for (int q = 0; q < SCAN_PF; ++q) { cl[q] = nl[q]; cm[q] = nm[q]; cb[q] = nb[q]; }
    }
  }
}
DI void ph_gla_scan(const Params& p, int bid, int nblk) {
  for (long gi = (long)bid * NTHR + TIDX; gi < (long)NB * 2 * 4 * 2048; gi += (long)nblk * NTHR) {
    const int e = (int)(gi % 2048), ch = (int)(gi / 2048), h = ch & 3, bd = ch >> 2, k = e & 31;
    float* base = p.GS + (((size_t)bd * NCK) * 4 + h) * 2048 + e;
    const float* ge = p.GC + ((size_t)bd * TK + 63) * 128 + h * 32 + k;
    float st = 0.f;
    float cl[SCAN_PF], cg[SCAN_PF], nl[SCAN_PF], ng[SCAN_PF];
#pragma unroll
    for (int q = 0; q < SCAN_PF; ++q) if (q < NCK) { cl[q] = base[(size_t)q * 4 * 2048]; cg[q] = ge[(size_t)q * 64 * 128]; }
#pragma unroll 1
    for (int jb = 0; jb < NCK; jb += SCAN_PF) {
#pragma unroll
      for (int q = 0; q < SCAN_PF; ++q) { const int j = jb + SCAN_PF + q; if (j < NCK) { nl[q] = base[(size_t)j * 4 * 2048]; ng[q] = ge[(size_t)j * 64 * 128]; } }
#pragma unroll
      for (int q = 0; q < SCAN_PF; ++q) {
        const int j = jb + q;
        if (j < NCK) { base[(size_t)j * 4 * 2048] = st; st = expf(cg[q]) * st + cl[q]; }
      }
#pragma unroll
      for (int q = 0; q < SCAN_PF; ++q) { cl[q] = nl[q]; cg[q] = ng[q]; }
    }
  }
}
constexpr int MO_K = 0, MO_V = 64 * 144, MO_A = MO_V + 64 * VROW, MO_PM = MO_A + 512, MO_N0 = MO_PM + 512, MO_X = MO_N0 + 512, MO_LDS = MO_X + 16384;
DI void ph_ml_out(const Params& p, int layer, int need_ctx, char* lds, int bid, int nblk) {
  float* sA = (float*)(lds + MO_A); float* sPM = (float*)(lds + MO_PM); float* sN0 = (float*)(lds + MO_N0); float* sX = (float*)(lds + MO_X);
  const int t = TIDX, lane = t & 63, wid = t >> 6, l31 = lane & 31, hh = lane >> 5;
  const int lt = wid & 1, d = wid >> 1;
#pragma unroll 1
  for (int u = bid; u < (need_ctx ? SCAN_UNITS : SCAN_LAT_UNITS); u += nblk) {
    int b, c, h; scan_unit(u, b, c, h);
    {
      const int row = t >> 2, seg = (t & 3) * 16;
      const bf16_t* ks = p.MK + ((size_t)b * TK + 64 * c + row) * 256 + h * 64 + seg;
      sts16(lds + MO_K + row * 144 + seg * 2, ldg16(ks)); sts16(lds + MO_K + row * 144 + seg * 2 + 16, ldg16(ks + 8));
      const bf16_t* vs = p.MVt + (((size_t)b * 4 + h) * 64 + row) * TK + 64 * c + seg;
      const u32x4 v0 = ldg16(vs), v1 = ldg16(vs + 8);
      u32x2* dv = (u32x2*)(lds + MO_V + row * VROW + seg * 2);
      u32x2 q; q.x = v0.x; q.y = v0.y; dv[0] = q; q.x = v0.z; q.y = v0.w; dv[1] = q; q.x = v1.x; q.y = v1.y; dv[2] = q; q.x = v1.z; q.y = v1.w; dv[3] = q;
    }
    if (t < 128) {
      const int dd = t >> 6, s = t & 63, j = step_of(dd, c), pos = dd ? 63 - s : s;
      const size_t o = (((size_t)b * 2 + dd) * TK + 64 * j) * 4 + h;
      sA[dd * 64 + s] = p.IGS[o + pos * 4] - p.BC[o + pos * 4];
      const size_t uu = (((size_t)b * 2 + dd) * NCK + j) * 4 + h;
      sN0[dd * 64 + s] = p.MN[uu * 64 + s];
    }
    __syncthreads();
    if (t < 2) {
      float m = -1e30f;
      if (t == 0) { for (int s = 0; s < 64; ++s) { m = fmaxf(m, sA[s]); sPM[s] = m; } }
      else { for (int s = 63; s >= 0; --s) { m = fmaxf(m, sA[64 + s]); sPM[64 + s] = m; } }
    }
    __syncthreads();
    const int j = step_of(d, c);
    const size_t uu = (((size_t)b * 2 + d) * NCK + j) * 4 + h;
    const int l = lt * 32 + l31, pos = d ? 63 - l : l;
    const float bl = p.BC[(((size_t)b * 2 + d) * TK + 64 * j + pos) * 4 + h];
    const float inter = bl + p.MM[uu * 4 + 2];
    const float mt = fmaxf(inter, bl + sPM[d * 64 + l]);
    const float aint = expf(inter - mt);
    bf16x8 qf[4];
#pragma unroll
    for (int ks = 0; ks < 4; ++ks) qf[ks] = *(const bf16x8*)(p.MQ + ((size_t)b * TK + 64 * c + l) * 256 + h * 64 + ks * 16 + 8 * hh);
    f32x16 num[2]; num[0] = (f32x16)(0.f); num[1] = (f32x16)(0.f);
    float den = 0.f;
#pragma unroll
    for (int st = 0; st < 2; ++st) {
      if (d == 0 ? st <= lt : st >= lt) {
        f32x16 S = (f32x16)(0.f);
#pragma unroll
        for (int ks = 0; ks < 4; ++ks) S = MFMA32(lds_frag(lds + MO_K + (st * 32 + l31) * 144 + (ks * 16 + 8 * hh) * 2), qf[ks], S);
#pragma unroll
        for (int i = 0; i < 16; ++i) {
          const int s = st * 32 + (i & 3) + 8 * (i >> 2) + 4 * hh;
          const bool ok = d == 0 ? s <= l : s >= l;
          const float e = ok ? fast_exp2((bl + sA[d * 64 + s] - mt) * LOG2E) * S[i] : 0.f;
          S[i] = e; den += e;
        }
#pragma unroll
        for (int kst = 0; kst < 2; ++kst) {
          const bf16x8 pf = pack8(S, kst);
#pragma unroll
          for (int vt = 0; vt < 2; ++vt) {
            const char* vp = lds + MO_V + (vt * 32 + l31) * VROW + (st * 32 + kst * 16 + 4 * hh) * 2;
            const s16x4 lo = *(const s16x4*)vp, hi = *(const s16x4*)(vp + 16);
            num[vt] = MFMA32(__builtin_shufflevector(lo, hi, 0, 1, 2, 3, 4, 5, 6, 7), pf, num[vt]);
          }
        }
      }
    }
    f32x16 accI[2]; accI[0] = (f32x16)(0.f); accI[1] = (f32x16)(0.f);
#pragma unroll
    for (int vt = 0; vt < 2; ++vt)
#pragma unroll
      for (int ks = 0; ks < 4; ++ks) accI[vt] = MFMA32(cvt8(p.MC + uu * 4096 + (size_t)(vt * 32 + l31) * 64 + ks * 16 + 8 * hh), qf[ks], accI[vt]);
    float qn = 0.f;
#pragma unroll
    for (int ks = 0; ks < 4; ++ks)
#pragma unroll
      for (int q = 0; q < 8; ++q) qn += bf2f((bf16_t)qf[ks][q]) * sN0[d * 64 + ks * 16 + 8 * hh + q];
    den = xor_sum<32>(den + aint * qn);
    const float inv = 1.0f / fmaxf(fabsf(den), expf(-mt));
#pragma unroll
    for (int vt = 0; vt < 2; ++vt)
#pragma unroll
      for (int i = 0; i < 16; ++i) num[vt][i] = (num[vt][i] + aint * accI[vt][i]) * inv;
    if (d == 1) {
#pragma unroll
      for (int vt = 0; vt < 2; ++vt)
#pragma unroll
        for (int i = 0; i < 16; ++i) sX[(lt * 32 + vt * 16 + i) * 64 + lane] = num[vt][i];
    }
    __syncthreads();
    if (d == 0) {
      float ss = 0.f;
#pragma unroll
      for (int vt = 0; vt < 2; ++vt)
#pragma unroll
        for (int i = 0; i < 16; ++i) { num[vt][i] += sX[(lt * 32 + vt * 16 + i) * 64 + lane]; ss += num[vt][i] * num[vt][i]; }
      ss = xor_sum<32>(ss);
      const float rstd = 1.0f / sqrtf(ss * (1.0f / 64) + 1e-6f);
      const int r = row_of(b, 64 * c + l);
#pragma unroll
      for (int vt = 0; vt < 2; ++vt)
#pragma unroll
        for (int g = 0; g < 4; ++g) {
          const int v0 = vt * 32 + 8 * g + 4 * hh;
          const u32x2 ou = *(const u32x2*)(p.Z + (size_t)r * NZP + ZC_MLO + h * 64 + v0);
          const f32x4 gv = *(const f32x4*)(p.g_mlstm_out + layer * 256 + h * 64 + v0);
          const float o0 = u2f(ou.x << 16), o1 = u2f(ou.x & 0xffff0000u), o2 = u2f(ou.y << 16), o3 = u2f(ou.y & 0xffff0000u);
          f32x4 y = {sigmoidf_(o0) * num[vt][4 * g] * rstd * gv[0], sigmoidf_(o1) * num[vt][4 * g + 1] * rstd * gv[1],
                     sigmoidf_(o2) * num[vt][4 * g + 2] * rstd * gv[2], sigmoidf_(o3) * num[vt][4 * g + 3] * rstd * gv[3]};
          st_bf16x4(p.Y + (size_t)r * D + 256 + h * 64 + v0, y);
        }
    }
    __syncthreads();
  }
}
DI void ph_gla_local(const Params& p, char* lds, int bid, int nblk) {
  bf16_t* sKd = (bf16_t*)lds;
  const int t = TIDX, lane = t & 63, wid = t >> 6, l31 = lane & 31, hh = lane >> 5;
  const int d = wid & 1, vt = wid >> 1;
#pragma unroll 1
  for (int u = bid; u < SCAN_UNITS; u += nblk) {
    int b, c, h; scan_unit(u, b, c, h);
    {
      const int dd = t >> 7, l = (t >> 1) & 63, k0 = (t & 1) * 16, j = step_of(dd, c), pos = dd ? 63 - l : l;
      const float* gcr = p.GC + (((size_t)b * 2 + dd) * TK + 64 * j + pos) * 128 + h * 32 + k0;
      const float* ger = p.GC + (((size_t)b * 2 + dd) * TK + 64 * j + 63) * 128 + h * 32 + k0;
      const bf16_t* kr = p.Z + (size_t)row_of(b, 64 * c + l) * NZP + ZC_GK + h * 32 + k0;
#pragma unroll
      for (int q = 0; q < 16; ++q) sKd[(dd * 64 + l) * 33 + k0 + q] = f2bf(bf2f(kr[q]) * fast_exp2((ger[q] - gcr[q]) * LOG2E));
    }
    __syncthreads();
    const int j = step_of(d, c);
    const size_t uu = (((size_t)b * 2 + d) * NCK + j) * 4 + h;
    f32x16 acc = (f32x16)(0.f);
    const bf16_t* vsrc = p.GVt + (((size_t)b * 4 + h) * 64 + vt * 32 + l31) * TK + 64 * c;
#pragma unroll
    for (int ks = 0; ks < 4; ++ks) {
      const bf16x8 af = *(const bf16x8*)(vsrc + ks * 16 + 8 * hh);
      bf16x8 bfr;
#pragma unroll
      for (int q = 0; q < 8; ++q) bfr[q] = (short)sKd[(d * 64 + ks * 16 + 8 * hh + q) * 33 + l31];
      acc = MFMA32(af, bfr, acc);
    }
#pragma unroll
    for (int i = 0; i < 16; ++i) p.GS[uu * 2048 + (size_t)(vt * 32 + (i & 3) + 8 * (i >> 2) + 4 * hh) * 32 + l31] = acc[i];
    __syncthreads();
  }
}
constexpr int GO_Q = 0, GO_K = 2 * 64 * 80, GO_V = 2 * GO_K, GO_X = GO_V + 64 * VROW, GO_LDS = GO_X + 16384;
DI void ph_gla_out(const Params& p, int layer, int need_ctx, char* lds, int bid, int nblk) {
  float* sX = (float*)(lds + GO_X);
  const int t = TIDX, lane = t & 63, wid = t >> 6, l31 = lane & 31, hh = lane >> 5;
  const int lt = wid & 1, d = wid >> 1;
#pragma unroll 1
  for (int u = bid; u < (need_ctx ? SCAN_UNITS : SCAN_LAT_UNITS); u += nblk) {
    int b, c, h; scan_unit(u, b, c, h);
    {
      const int dd = t >> 7, l = (t >> 1) & 63, k0 = (t & 1) * 16, j = step_of(dd, c), pos = dd ? 63 - l : l;
      const float* gcr = p.GC + (((size_t)b * 2 + dd) * TK + 64 * j + pos) * 128 + h * 32 + k0;
      const bf16_t* zr = p.Z + (size_t)row_of(b, 64 * c + l) * NZP;
      bf16_t* qd = (bf16_t*)(lds + GO_Q + (dd * 64 + l) * 80) + k0; bf16_t* kd = (bf16_t*)(lds + GO_K + (dd * 64 + l) * 80) + k0;
#pragma unroll
      for (int q = 0; q < 16; ++q) {
        const float g = gcr[q];
        qd[q] = f2bf(bf2f(zr[ZC_GQ + h * 32 + k0 + q]) * 0.17677669529663687f * fast_exp2(g * LOG2E));
        kd[q] = f2bf(bf2f(zr[ZC_GK + h * 32 + k0 + q]) * fast_exp2(-g * LOG2E));
      }
      const int row = t >> 2, seg = (t & 3) * 16;
      const bf16_t* vs = p.GVt + (((size_t)b * 4 + h) * 64 + row) * TK + 64 * c + seg;
      const u32x4 v0 = ldg16(vs), v1 = ldg16(vs + 8);
      u32x2* dv = (u32x2*)(lds + GO_V + row * VROW + seg * 2);
      u32x2 q2; q2.x = v0.x; q2.y = v0.y; dv[0] = q2; q2.x = v0.z; q2.y = v0.w; dv[1] = q2; q2.x = v1.x; q2.y = v1.y; dv[2] = q2; q2.x = v1.z; q2.y = v1.w; dv[3] = q2;
    }
    __syncthreads();
    const int j = step_of(d, c);
    const size_t uu = (((size_t)b * 2 + d) * NCK + j) * 4 + h;
    const int l = lt * 32 + l31;
    bf16x8 qf[2];
#pragma unroll
    for (int ks = 0; ks < 2; ++ks) qf[ks] = lds_frag(lds + GO_Q + (d * 64 + l) * 80 + (ks * 16 + 8 * hh) * 2);
    f32x16 O[2]; O[0] = (f32x16)(0.f); O[1] = (f32x16)(0.f);
#pragma unroll
    for (int st = 0; st < 2; ++st) {
      if (d == 0 ? st <= lt : st >= lt) {
        f32x16 S = (f32x16)(0.f);
#pragma unroll
        for (int ks = 0; ks < 2; ++ks) S = MFMA32(lds_frag(lds + GO_K + (d * 64 + st * 32 + l31) * 80 + (ks * 16 + 8 * hh) * 2), qf[ks], S);
#pragma unroll
        for (int i = 0; i < 16; ++i) {
          const int s = st * 32 + (i & 3) + 8 * (i >> 2) + 4 * hh;
          const bool ok = d == 0 ? s <= l : s >= l;
          S[i] = ok ? S[i] : 0.f;
        }
#pragma unroll
        for (int kst = 0; kst < 2; ++kst) {
          const bf16x8 pf = pack8(S, kst);
#pragma unroll
          for (int vt = 0; vt < 2; ++vt) {
            const char* vp = lds + GO_V + (vt * 32 + l31) * VROW + (st * 32 + kst * 16 + 4 * hh) * 2;
            const s16x4 lo = *(const s16x4*)vp, hi = *(const s16x4*)(vp + 16);
            O[vt] = MFMA32(__builtin_shufflevector(lo, hi, 0, 1, 2, 3, 4, 5, 6, 7), pf, O[vt]);
          }
        }
      }
    }
#pragma unroll
    for (int vt = 0; vt < 2; ++vt)
#pragma unroll
      for (int ks = 0; ks < 2; ++ks) O[vt] = MFMA32(cvt8(p.GS + uu * 2048 + (size_t)(vt * 32 + l31) * 32 + ks * 16 + 8 * hh), qf[ks], O[vt]);
    if (d == 1) {
#pragma unroll
      for (int vt = 0; vt < 2; ++vt)
#pragma unroll
        for (int i = 0; i < 16; ++i) sX[(lt * 32 + vt * 16 + i) * 64 + lane] = O[vt][i];
    }
    __syncthreads();
    if (d == 0) {
      float ss = 0.f;
#pragma unroll
      for (int vt = 0; vt < 2; ++vt)
#pragma unroll
        for (int i = 0; i < 16; ++i) { O[vt][i] += sX[(lt * 32 + vt * 16 + i) * 64 + lane]; ss += O[vt][i] * O[vt][i]; }
      ss = xor_sum<32>(ss);
      const float rstd = 1.0f / sqrtf(ss * (1.0f / 64) + 1e-6f);
      const int r = row_of(b, 64 * c + l);
#pragma unroll
      for (int vt = 0; vt < 2; ++vt)
#pragma unroll
        for (int g = 0; g < 4; ++g) {
          const int v0 = vt * 32 + 8 * g + 4 * hh;
          const u32x2 ru = *(const u32x2*)(p.Z + (size_t)r * NZP + ZC_GR + h * 64 + v0);
          const f32x4 gv = *(const f32x4*)(p.g_gla_out + layer * 256 + h * 64 + v0);
          const float r0 = u2f(ru.x << 16), r1 = u2f(ru.x & 0xffff0000u), r2 = u2f(ru.y << 16), r3 = u2f(ru.y & 0xffff0000u);
          f32x4 y = {siluf_(r0) * O[vt][4 * g] * rstd * gv[0], siluf_(r1) * O[vt][4 * g + 1] * rstd * gv[1],
                     siluf_(r2) * O[vt][4 * g + 2] * rstd * gv[2], siluf_(r3) * O[vt][4 * g + 3] * rstd * gv[3]};
          st_bf16x4(p.Y + (size_t)r * D + 512 + h * 64 + v0, y);
        }
    }
    __syncthreads();
  }
}

DI float fast_logsigmoid(float x) {
  const float e = fast_exp2(-fabsf(x) * LOG2E);
#ifdef CPU_EMU
  return fminf(x, 0.f) - log1pf(e);
#else
  return fminf(x, 0.f) - 0.6931471805599453f * __builtin_amdgcn_logf(1.0f + e);
#endif
}
DI float wave_incl_scan(float v, int lane) {
#pragma unroll
  for (int dd = 1; dd < 64; dd <<= 1) { const float o = u2f((unsigned)lane_up((int)f2u(v), dd, lane)); if (lane >= dd) v += o; }
  return v;
}
constexpr int GCUM_LDS = 4 * 64 * 33 * 4;
DI void ph_gates_cum(const Params& p, int layer, char* lds, int bid, int nblk) {
  const int t = TIDX, lane = t & 63, wid = t >> 6;
  float* stg = (float*)lds + wid * 64 * 33;
  const float* wal = p.w_alpha2 + (size_t)layer * 2 * 16 * 128;
#pragma unroll 1
  for (int u = bid * 4 + wid; u < NB * 2 * NCK; u += nblk * 4) {
    const int j = u % NCK, d = (u / NCK) & 1, b = u / (2 * NCK);
    const int pp = 64 * j + lane, s = seq_of(d, pp);
    const bf16_t* z = p.Z + (size_t)row_of(b, s) * NZP;
    const size_t ob = ((size_t)b * 2 + d) * TK + pp;
    {
      const u32x2 iu = *(const u32x2*)(z + ZC_MLIG + d * 4), fu = *(const u32x2*)(z + ZC_MLFG + d * 4);
      const float ig[4] = {u2f(iu.x << 16), u2f(iu.x & 0xffff0000u), u2f(iu.y << 16), u2f(iu.y & 0xffff0000u)};
      const float fg[4] = {u2f(fu.x << 16), u2f(fu.x & 0xffff0000u), u2f(fu.y << 16), u2f(fu.y & 0xffff0000u)};
      f32x4 oc, oi;
#pragma unroll
      for (int h = 0; h < 4; ++h) {
        oi[h] = ig[h] + p.b_igate[layer * 8 + d * 4 + h];
        oc[h] = wave_incl_scan(fast_logsigmoid(fg[h] + p.b_fgate[layer * 8 + d * 4 + h]), lane);
      }
      *(f32x4*)(p.BC + ob * 4) = oc; *(f32x4*)(p.IGS + ob * 4) = oi;
    }
    float a[16];
    { float f0[8], f1[8]; unpack8(ldg16(z + ZC_GA + d * 16), f0); unpack8(ldg16(z + ZC_GA + d * 16 + 8), f1);
#pragma unroll
      for (int q = 0; q < 8; ++q) { a[q] = f0[q]; a[8 + q] = f1[q]; } }
    const float* W = wal + (size_t)d * 16 * 128;
#pragma unroll 1
    for (int cg = 0; cg < 4; ++cg) {
#pragma unroll 4
      for (int c = 0; c < 32; ++c) {
        const int ch = cg * 32 + c;
        float zg = p.b_alpha[layer * 256 + d * 128 + ch];
#pragma unroll
        for (int q = 0; q < 16; ++q) zg += a[q] * W[q * 128 + ch];
        stg[lane * 33 + c] = wave_incl_scan(fast_logsigmoid(zg) * (1.0f / 16.0f), lane);
      }
      WAVE_SYNC();
#pragma unroll
      for (int k = 0; k < 32; ++k) { const int pos = k * 2 + (lane >> 5), c = lane & 31; p.GC[(((size_t)b * 2 + d) * TK + 64 * j + pos) * 128 + cg * 32 + c] = stg[pos * 33 + c]; }
      WAVE_SYNC();
    }
  }
}
#define XB_TMO      128
#define XB_XCNT(j)  (256  + 64 * (j))
#define XB_XSUB(j)  (1280 + 64 * (j))
#define XB_XGEN(j)  (2304 + 64 * (j))
#define XB_TOP      3328
#define XB_TOPGEN   3392
#define XCD_BAR_WORDS 3456
#define XB_SPIN_CAP (1u << 28)
#define LAS __attribute__((address_space(3)))

__device__ __forceinline__ unsigned xb_ld(unsigned* p)              { return __hip_atomic_load(p, __ATOMIC_RELAXED, __HIP_MEMORY_SCOPE_AGENT); }
__device__ __forceinline__ unsigned xb_add(unsigned* p, unsigned v) { return __hip_atomic_fetch_add(p, v, __ATOMIC_RELAXED, __HIP_MEMORY_SCOPE_AGENT); }
__device__ __forceinline__ unsigned xb_xcc_id() { return (unsigned)__builtin_amdgcn_s_getreg((3 << 11) | 20) & 0xFu; }
#define XB_SPIN(cond, bar) do { unsigned _sp = 0; while (cond) { __builtin_amdgcn_s_sleep(1); \
    if ((++_sp & 255u) == 0u) { if (xb_ld(&(bar)[XB_TMO])) break; if (_sp > XB_SPIN_CAP) { atomicAdd(&(bar)[XB_TMO], 1u); break; } } } } while (0)

struct XcdBarrier {
    unsigned* bar; unsigned x;
    volatile LAS unsigned* st;
};

__device__ __forceinline__ XcdBarrier xcd_barrier_post(unsigned* bar, volatile LAS unsigned* st) {
    XcdBarrier b; b.bar = bar; b.x = xb_xcc_id(); b.st = st;
    if (threadIdx.x == 0) (void)xb_add(&bar[XB_XCNT(b.x)], 1u);
    return b;
}
__device__ __forceinline__ void xcd_barrier_complete(unsigned* bar, unsigned x, unsigned& nloc, unsigned& nx) {
    const unsigned G = gridDim.x * gridDim.y * gridDim.z;
    unsigned sum, cnt, mine, sp = 0u;
    for (;;) {
        sum = 0u; cnt = 0u; mine = 0u;
#pragma unroll
        for (unsigned j = 0; j < 16; ++j) { const unsigned c = xb_ld(&bar[XB_XCNT(j)]); sum += c; cnt += (c > 0u) ? 1u : 0u; mine = (j == x) ? c : mine; }
        if (sum == G) break;
        __builtin_amdgcn_s_sleep(1);
        if ((++sp & 255u) == 0u) { if (xb_ld(&bar[XB_TMO])) break; if (sp > XB_SPIN_CAP) { atomicAdd(&bar[XB_TMO], 1u); break; } }
    }
    nloc = mine > 0u ? mine : 1u; nx = cnt > 0u ? cnt : 1u;
}

__device__ __forceinline__ void xcd_barrier(const XcdBarrier& b) {
    asm volatile("s_waitcnt vmcnt(0)" ::: "memory");
    __syncthreads();
    if (threadIdx.x == 0) {
        unsigned* bar = b.bar;
        __builtin_amdgcn_s_waitcnt(0);
        unsigned nloc = b.st[0], nx = b.st[1];
        if (nloc == 0u) { xcd_barrier_complete(bar, b.x, nloc, nx); b.st[0] = nloc; b.st[1] = nx; }
        const unsigned old = xb_add(&bar[XB_XSUB(b.x)], 1u);
        const unsigned gen = old / nloc;
        if (old + 1u == (gen + 1u) * nloc) {
            __builtin_amdgcn_fence(__ATOMIC_RELEASE, "agent");
            asm volatile("s_waitcnt vmcnt(0)" ::: "memory");
            const unsigned og = xb_add(&bar[XB_TOP], 1u);
            const unsigned tg = og / nx;
            if (og + 1u == (tg + 1u) * nx) xb_add(&bar[XB_TOPGEN], 1u);
            else XB_SPIN(xb_ld(&bar[XB_TOPGEN]) == tg, bar);
            __builtin_amdgcn_fence(__ATOMIC_ACQUIRE, "agent");
            xb_add(&bar[XB_XGEN(b.x)], 1u);
            asm volatile("s_waitcnt vmcnt(0)" ::: "memory");
        } else {
            XB_SPIN(xb_ld(&bar[XB_XGEN(b.x)]) == gen, bar);
            __builtin_amdgcn_fence(__ATOMIC_ACQUIRE, "agent");
            asm volatile("s_waitcnt vmcnt(0)" ::: "memory");
        }
    }
    __syncthreads();
}

#define GS_LOOP(N, CALL) for (long gi = (long)bid * NTHR + TIDX; gi < (long)(N); gi += (long)nblk * NTHR) { CALL; }
#ifndef PROBE
#define PROBE 0
#endif
#ifndef PROBE_MASK
#define PROBE_MASK 0
#endif
#ifndef FAST_SCAN
#define FAST_SCAN 1
#endif
constexpr int N_PHASES = 16;
constexpr int MEGA_LDS = GEMM_LDS > TOPK_LDS ? GEMM_LDS : TOPK_LDS;

constexpr bool WT_ED_IN_Y = (size_t)NE * FF * D * 2 <= (size_t)R * D * 2;
DI void conv_expert(const Params& p, int which, int layer, char* lds, int bid, int nblk, int busy) {
  __syncthreads();
  if (bid < busy) return;
  if (which == 0) ph_wt(p.w_e_gate + (size_t)layer * NE * D * FF, p.Wt_eg, D, FF, FF, NE, (long)D * FF, (long)FF * D, nullptr, lds, bid - busy, nblk - busy);
  else if (which == 1) ph_wt(p.w_e_up + (size_t)layer * NE * D * FF, p.Wt_eu, D, FF, FF, NE, (long)D * FF, (long)FF * D, nullptr, lds, bid - busy, nblk - busy);
  else ph_wt(p.w_e_down + (size_t)layer * NE * FF * D, p.Wt_ed, FF, D, D, NE, (long)FF * D, (long)D * FF, nullptr, lds, bid - busy, nblk - busy);
}
template <int PH>
DI void run_phase(const Params& p, int l, char* lds, int bid, int nblk) {
  const int need_ctx = (l == 0);
  const int rows = need_ctx ? R : RL;
  const float* xl_in = l == 0 ? p.x : p.out;
  const float* xc_in = l == 0 ? p.ctx : p.xc;
  bf16_t* QRAW = p.YO; bf16_t* KVRAW = p.YO + (size_t)R * 384;
  if constexpr (PH == 0) {
    ph_mods(p, lds, bid, nblk);
#pragma unroll 1
    for (int ll = 0; ll < 2; ++ll) {
      ph_wt(p.w_in + (size_t)ll * D * NZ, p.Wt_in + ll * WSZ_IN, D, NZ, NZP, 1, 0L, 0L, nullptr, lds, bid, nblk);
      ph_wt(p.w_gate + (size_t)ll * D * 4096, p.Wt_gate + ll * WSZ_GATE, D, 4096, 4096, 1, 0L, 0L, nullptr, lds, bid, nblk);
      ph_wt(p.w_branch + (size_t)ll * 4 * 256 * D, p.Wt_branch + ll * WSZ_BR, 256, D, D, 4, (long)256 * D, (long)D * 256, nullptr, lds, bid, nblk);
      ph_wt(p.w_out + (size_t)ll * D * D, p.Wt_out + ll * WSZ_OUT, D, D, D, 1, 0L, 0L, nullptr, lds, bid, nblk);
      ph_wt(p.w_uq + (size_t)ll * 256 * 384, p.Wt_uq + ll * WSZ_UQ, 256, 384, 384, 1, 0L, 0L, p.g_q_lat + ll * 256, lds, bid, nblk);
      ph_wt(p.w_ukv + (size_t)ll * 128 * 512, p.Wt_ukv + ll * WSZ_UKV, 128, 512, 512, 1, 0L, 0L, p.g_kv_lat + ll * 128, lds, bid, nblk);
    }
  } else if constexpr (PH == 1) {
    ph_modulate(p, l, xl_in, xc_in, bid, nblk);
  } else if constexpr (PH == 2) {
    ph_gemm_plain(p.H, D, p.Wt_in + l * WSZ_IN, D, R, NZP, D, p.Z, NZP, lds, bid, nblk);
#if PROBE == 63
    ph_gemm_probe<3>(p.H, D, p.Wt_in + l * WSZ_IN, D, R, NZP, D, p.mods + 40000, lds, bid, nblk);
#elif PROBE == 66
    ph_gemm_probe<6>(p.H, D, p.Wt_in + l * WSZ_IN, D, R, NZP, D, p.mods + 40000, lds, bid, nblk);
#elif PROBE == 67
    ph_gemm_plain<1>(p.H, D, p.Wt_in + l * WSZ_IN, D, R, NZP, D, p.Z, NZP, lds, bid, nblk);
#elif PROBE == 68
    ph_gemm_plain<2>(p.H, D, p.Wt_in + l * WSZ_IN, D, R, NZP, D, p.Z, NZP, lds, bid, nblk);
#elif PROBE == 5
    ph_gemm_plain(p.H, D, p.Wt_in + l * WSZ_IN, D, R, NZP, D, p.Z, NZP, lds, bid, nblk);
#endif
  } else if constexpr (PH == 3) {
    ph_mla_up(p, l, QRAW, KVRAW, lds, bid, nblk);
  } else if constexpr (PH == 4) {
    ph_prep(p, l, QRAW, KVRAW, lds, bid, nblk);
#if PROBE == 41
    ph_prep(p, l, QRAW, KVRAW, lds, bid, nblk);
#elif PROBE == 43
    ph_prep<1>(p, l, QRAW, KVRAW, lds, bid, nblk);
#elif PROBE == 44
    ph_prep<2>(p, l, QRAW, KVRAW, lds, bid, nblk);
#endif
    __syncthreads();
    ph_gates_cum(p, l, lds, bid, nblk);
#if PROBE == 42
    ph_gates_cum(p, l, lds, bid, nblk);
#endif
  } else if constexpr (PH == 5) {
#if FAST_SCAN
    ph_ml_local(p, lds, bid, nblk);
    ph_gla_local(p, lds, bid, nblk);
#else
    GS_LOOP((long)NUNIT * 4160, nvb_ml_local(gi, p));
    GS_LOOP((long)NUNIT * 2048, nvb_gla_local(gi, p));
#endif
  } else if constexpr (PH == 6) {
#if FAST_SCAN
    ph_ml_scan(p, bid, nblk);
    ph_gla_scan(p, (bid + nblk - 260 % nblk) % nblk, nblk);
#else
    GS_LOOP((long)NB * 2 * 4 * 4160, nvb_ml_scan(gi, p));
    GS_LOOP((long)NB * 2 * 4 * 2048, nvb_gla_scan(gi, p));
#endif
    ph_attn(p, l, need_ctx, lds, bid, nblk);
#if PROBE >= 10 && PROBE < 20
    if (l == 0) ph_attn_mla_probe<PROBE - 10>(p, lds, bid, nblk);
#elif PROBE == 1
    ph_attn_diff(p, l, need_ctx, lds, bid, nblk);
#elif PROBE == 2
    ph_attn_mla(p, need_ctx, lds, bid, nblk);
#endif
  } else if constexpr (PH == 7) {
#if FAST_SCAN
    ph_ml_out(p, l, need_ctx, lds, bid, nblk);
    ph_gla_out(p, l, need_ctx, lds, bid, nblk);
#else
    GS_LOOP((long)NUNIT * 4096, nvb_ml_out(gi, p, need_ctx));
    GS_LOOP((long)NUNIT * 4096, nvb_gla_out(gi, p, need_ctx));
#endif
  } else if constexpr (PH == 8) {
#if !FAST_SCAN
    GS_LOOP((long)R * 4, nvb_ml_finish(gi, p, l, need_ctx));
    GS_LOOP((long)R * 4, nvb_gla_finish(gi, p, l, need_ctx));
#endif
  } else if constexpr (PH == 9) {
    ph_merge(p, l, rows, lds, bid, nblk);
#if PROBE == 3
    ph_merge(p, l, rows, lds, bid, nblk);
#endif
    if (l == 0) conv_expert(p, 1, 0, lds, bid, nblk, ((rows / 128) * (D / 64)) % nblk);
  } else if constexpr (PH == 10) {
    ph_gemm_plain(p.MG, D, p.Wt_out + l * WSZ_OUT, D, rows, D, D, p.YO, D, lds, bid, nblk);
    if (WT_ED_IN_Y && l == 0) conv_expert(p, 2, 0, lds, bid, nblk, ((rows / 128) * (D / 128)) % nblk);
  } else if constexpr (PH == 11) {
    ph_resid_mix(p, l, xl_in, xc_in, rows, lds, bid, nblk);
  } else if constexpr (PH == 12) {
    ph_topk(p, need_ctx, lds, bid, nblk);
    conv_expert(p, 0, l, lds, bid, nblk, 0);
    if (l == 1) conv_expert(p, 1, 1, lds, bid, nblk, 0);
    if (l == 1 || !WT_ED_IN_Y) conv_expert(p, 2, l, lds, bid, nblk, 0);
  } else if constexpr (PH == 13) {
    ph_moe1(p, need_ctx, lds, bid, nblk);
#if PROBE == 4
    ph_moe1(p, need_ctx, lds, bid, nblk);
#endif
  } else if constexpr (PH == 14) {
    ph_moe2(p, need_ctx, lds, bid, nblk);
#if PROBE == 4
    ph_moe2(p, need_ctx, lds, bid, nblk);
#endif
  } else if constexpr (PH == 15) {
    ph_resid_ffn(p, l, rows, bid, nblk);
  }
}

template <int PH> __global__ void __launch_bounds__(256, 2) k_phase(Params p, int l) {
  DYN_LDS(lds);
  run_phase<PH>(p, l, lds, blockIdx.x, gridDim.x);
}

#if !defined(CPU_EMU) && !MK_MULTI
typedef const Params __attribute__((address_space(4)))* KParams;
DI KParams kp_fresh() { KParams k = (KParams)__builtin_amdgcn_kernarg_segment_ptr(); asm volatile("" : "+s"(k)); return k; }
#define PHASE(PH, L) do { asm volatile("; PHASE_MARK " #PH); KParams k_ = kp_fresh(); run_phase<PH>(*(const Params*)k_, (L), lds, bid, nblk); if (PROBE == 20 + PH || ((PROBE_MASK >> PH) & 1) || (PROBE == 100 + PH && (L) == 0) || (PROBE == 99 && (PH == 4 || PH == 5))) { __syncthreads(); run_phase<PH>(*(const Params*)k_, (L), lds, bid, nblk); } XcdBarrier b_ = bar; asm volatile("" : "+s"(b_.bar), "+s"(b_.x)); xcd_barrier(b_); if (PROBE == 50) xcd_barrier(b_); } while (0)
__global__ void __launch_bounds__(256, 2) k_mega(Params pv) {
  DYN_LDS(lds_all);
  if (threadIdx.x == 0) *(uint4*)lds_all = make_uint4(0u, 0u, 0u, 0u);
  __syncthreads();
  XcdBarrier bar = xcd_barrier_post(pv.bar, (volatile LAS unsigned*)lds_all);
  char* lds = lds_all + 256;
  const int bid = blockIdx.x, nblk = gridDim.x;
  PHASE(0, 0);
#pragma unroll 1
  for (int l = 0; l < 2; ++l) {
    if (l == 0) PHASE(1, l);
    PHASE(2, l); PHASE(3, l); PHASE(4, l); PHASE(5, l); PHASE(6, l); PHASE(7, l);
#if !FAST_SCAN
    PHASE(8, l);
#endif

    PHASE(9, l); PHASE(10, l); PHASE(11, l); PHASE(12, l); PHASE(13, l); PHASE(14, l); PHASE(15, l);
  }
}
#endif
#ifdef CPU_EMU
void emu_check(const Params& p, int layer, int stage);
#define EMU_CHECK(stg) emu_check(p, l, stg)
static int g_nlayers = getenv("NLAYERS") ? atoi(getenv("NLAYERS")) : 2;
#else
#define EMU_CHECK(stg)
#endif
static void fill_params(Params& p, void* const* d_in, void* d_out, void* d_ws) {
  const float** f = (const float**)&p;
  for (int i = 0; i < 33; ++i) f[i] = (const float*)d_in[i];
  p.out = (float*)d_out;
  map_workspace(p, (char*)d_ws);
}
#define LAUNCH_PHASE(PH, L) LAUNCH((k_phase<PH>), grid, 256, MEGA_LDS, stream, p, L)

extern "C" void kernel_launch(void* const* d_in, const int* in_sizes, int n_in, void* d_out, int out_size, void* d_ws,
                              size_t ws_size, hipStream_t stream) {
  Params p{};
  fill_params(p, d_in, d_out, d_ws);
  if (p.ws_need > ws_size) return;
#ifdef CPU_EMU
  const int grid = 16;
  LAUNCH_PHASE(0, 0);
  for (int l = 0; l < g_nlayers; ++l) {
    if (l == 0) LAUNCH_PHASE(1, l);
    LAUNCH_PHASE(2, l); LAUNCH_PHASE(3, l); LAUNCH_PHASE(4, l); LAUNCH_PHASE(5, l); LAUNCH_PHASE(6, l); LAUNCH_PHASE(7, l); LAUNCH_PHASE(8, l);
    EMU_CHECK(1);
    LAUNCH_PHASE(9, l); LAUNCH_PHASE(10, l); LAUNCH_PHASE(11, l);
    EMU_CHECK(2);
    LAUNCH_PHASE(12, l); LAUNCH_PHASE(13, l); LAUNCH_PHASE(14, l); LAUNCH_PHASE(15, l);
    EMU_CHECK(3);
  }
#else
  static int grid = 0;
  if (grid == 0) {
    int dev = 0, cus = 0, per_cu = 0;
    (void)hipGetDevice(&dev);
    (void)hipDeviceGetAttribute(&cus, hipDeviceAttributeMultiprocessorCount, dev);
#if MK_MULTI
    (void)hipFuncSetAttribute((const void*)k_phase<0>, hipFuncAttributeMaxDynamicSharedMemorySize, MEGA_LDS);
    (void)hipFuncSetAttribute((const void*)k_phase<1>, hipFuncAttributeMaxDynamicSharedMemorySize, MEGA_LDS);
    (void)hipFuncSetAttribute((const void*)k_phase<2>, hipFuncAttributeMaxDynamicSharedMemorySize, MEGA_LDS);
    (void)hipFuncSetAttribute((const void*)k_phase<3>, hipFuncAttributeMaxDynamicSharedMemorySize, MEGA_LDS);
    (void)hipFuncSetAttribute((const void*)k_phase<4>, hipFuncAttributeMaxDynamicSharedMemorySize, MEGA_LDS);
    (void)hipFuncSetAttribute((const void*)k_phase<5>, hipFuncAttributeMaxDynamicSharedMemorySize, MEGA_LDS);
    (void)hipFuncSetAttribute((const void*)k_phase<6>, hipFuncAttributeMaxDynamicSharedMemorySize, MEGA_LDS);
    (void)hipFuncSetAttribute((const void*)k_phase<7>, hipFuncAttributeMaxDynamicSharedMemorySize, MEGA_LDS);
    (void)hipFuncSetAttribute((const void*)k_phase<8>, hipFuncAttributeMaxDynamicSharedMemorySize, MEGA_LDS);
    (void)hipFuncSetAttribute((const void*)k_phase<9>, hipFuncAttributeMaxDynamicSharedMemorySize, MEGA_LDS);
    (void)hipFuncSetAttribute((const void*)k_phase<10>, hipFuncAttributeMaxDynamicSharedMemorySize, MEGA_LDS);
    (void)hipFuncSetAttribute((const void*)k_phase<11>, hipFuncAttributeMaxDynamicSharedMemorySize, MEGA_LDS);
    (void)hipFuncSetAttribute((const void*)k_phase<12>, hipFuncAttributeMaxDynamicSharedMemorySize, MEGA_LDS);
    (void)hipFuncSetAttribute((const void*)k_phase<13>, hipFuncAttributeMaxDynamicSharedMemorySize, MEGA_LDS);
    (void)hipFuncSetAttribute((const void*)k_phase<14>, hipFuncAttributeMaxDynamicSharedMemorySize, MEGA_LDS);
    (void)hipFuncSetAttribute((const void*)k_phase<15>, hipFuncAttributeMaxDynamicSharedMemorySize, MEGA_LDS);
    grid = (cus > 0 ? cus : 256) * 2;
#else
    if (hipFuncSetAttribute((const void*)k_mega, hipFuncAttributeMaxDynamicSharedMemorySize, MEGA_LDS + 256) != hipSuccess) { grid = -1; return; }
    if (hipOccupancyMaxActiveBlocksPerMultiprocessor(&per_cu, (const void*)k_mega, 256, MEGA_LDS + 256) != hipSuccess) per_cu = 0;
    (void)hipGetLastError();
    if (per_cu < 1) { grid = -1; return; }
    grid = (cus > 0 ? cus : 256) * (per_cu < 2 ? per_cu : 2);
#endif
  }
  if (grid < 0) return;
#if MK_MULTI
  LAUNCH_PHASE(0, 0);
  for (int l = 0; l < 2; ++l) {
    if (l == 0) LAUNCH_PHASE(1, l);
    LAUNCH_PHASE(2, l); LAUNCH_PHASE(3, l); LAUNCH_PHASE(4, l); LAUNCH_PHASE(5, l); LAUNCH_PHASE(6, l); LAUNCH_PHASE(7, l); LAUNCH_PHASE(8, l);
    LAUNCH_PHASE(9, l); LAUNCH_PHASE(10, l); LAUNCH_PHASE(11, l); LAUNCH_PHASE(12, l); LAUNCH_PHASE(13, l); LAUNCH_PHASE(14, l); LAUNCH_PHASE(15, l);
  }
#else
  (void)hipMemsetAsync(p.bar, 0, XCD_BAR_WORDS * sizeof(unsigned), stream);
  k_mega<<<dim3(grid), dim3(256), MEGA_LDS + 256, stream>>>(p);
#endif
#endif
}
```

```cpp
#ifndef CPU_EMU
#include <hip/hip_runtime.h>
#endif
#include <stdint.h>
#include <stddef.h>

#ifndef T_LAT
#define T_LAT 16384
#endif
#ifndef T_CTX
#define T_CTX 256
#endif

#ifndef MK_MULTI
#define MK_MULTI 0
#endif
#define DI __device__ __forceinline__
typedef unsigned short bf16_t;
typedef short bf16x8 __attribute__((ext_vector_type(8)));
typedef short s16x4 __attribute__((ext_vector_type(4)));
typedef float f32x4 __attribute__((ext_vector_type(4)));
typedef float f32x16 __attribute__((ext_vector_type(16)));
typedef unsigned u32x4 __attribute__((ext_vector_type(4)));
typedef unsigned u32x2 __attribute__((ext_vector_type(2)));
typedef float f32x2 __attribute__((ext_vector_type(2)));

#ifdef CPU_EMU
static inline float u2f(unsigned u) { float f; memcpy(&f, &u, 4); return f; }
static inline unsigned f2u(float f) { unsigned u; memcpy(&u, &f, 4); return u; }
#define MFMA32(a, b, c) emu_mfma_32x32x16((a), (b), (c))
#define MFMA16(a, b, c) emu_mfma_16x16x32((a), (b), (c))
static inline float fast_exp2(float x) { return exp2f(x); }
static inline float fast_rcp(float x) { return 1.0f / x; }
static inline float fast_rsq(float x) { return 1.0f / sqrtf(x); }
static inline float hw_sin_rev(float x) { return sinf(6.283185307179586f * x); }
static inline float hw_cos_rev(float x) { return cosf(6.283185307179586f * x); }
#define LAUNCH(kern, grid, block, lds, stream, ...) emu::launch(dim3(grid), dim3(block), (size_t)(lds), [=]() { kern(__VA_ARGS__); })
#define DYN_LDS(name) char* name = emu_dynlds()
#define SCHED_BARRIER()
#define TIDX ((int)threadIdx.x)
#define WAVE_SYNC() emu::wave_barrier()
#define SETPRIO(x)
#define IGLP_OPT()
template <int M> static inline float xor_sum(float v) { return v + __shfl_xor(v, M); }
template <int M> static inline float xor_max(float v) { return fmaxf(v, __shfl_xor(v, M)); }
template <int M> static inline int xor_sum_i(int v) { return v + __shfl_xor(v, M); }
static inline int lane_bcast(int v, int src) { return __shfl(v, src); }
static inline float lane_get(float v, int src) { return __shfl(v, src); }
static inline int lane_up(int v, int d, int lane) { (void)lane; return __shfl_up(v, d); }
#else
DI float u2f(unsigned u) { return __uint_as_float(u); }
DI unsigned f2u(float f) { return __float_as_uint(f); }
#define MFMA32(a, b, c) __builtin_amdgcn_mfma_f32_32x32x16_bf16((a), (b), (c), 0, 0, 0)
#define MFMA16(a, b, c) __builtin_amdgcn_mfma_f32_16x16x32_bf16((a), (b), (c), 0, 0, 0)
DI float fast_exp2(float x) { return __builtin_amdgcn_exp2f(x); }
DI float fast_rcp(float x) { return __builtin_amdgcn_rcpf(x); }
DI float fast_rsq(float x) { return __builtin_amdgcn_rsqf(x); }
DI float hw_sin_rev(float x) { return __builtin_amdgcn_sinf(x); }
DI float hw_cos_rev(float x) { return __builtin_amdgcn_cosf(x); }
#define LAUNCH(kern, grid, block, lds, stream, ...) kern<<<dim3(grid), dim3(block), (lds), (stream)>>>(__VA_ARGS__)
#define DYN_LDS(name) extern __shared__ __attribute__((aligned(16))) char name[]
#define SCHED_BARRIER() __builtin_amdgcn_sched_barrier(0)
DI int tid_fresh() { int t = (int)threadIdx.x; asm volatile("" : "+v"(t)); return t; }
#define TIDX tid_fresh()
#define WAVE_SYNC() __builtin_amdgcn_wave_barrier()
#define SETPRIO(x) __builtin_amdgcn_s_setprio(x)
#define IGLP_OPT() __builtin_amdgcn_iglp_opt(0)
#ifdef USE_SHFL
template <int M> DI float xor_sum(float v) { return v + __shfl_xor(v, M); }
template <int M> DI float xor_max(float v) { return fmaxf(v, __shfl_xor(v, M)); }
template <int M> DI int xor_sum_i(int v) { return v + __shfl_xor(v, M); }
DI int lane_bcast(int v, int src) { return __shfl(v, src); }
DI int lane_up(int v, int d, int lane) { (void)lane; return __shfl_up(v, d); }
#else
template <int M> DI int xor_partner_bits(int bits) { return __builtin_amdgcn_ds_swizzle(bits, (M << 10) | 0x1f); }
DI void half_swap(unsigned& a, unsigned& b) { asm volatile("s_nop 1\n\tv_permlane32_swap_b32 %0, %1\n\ts_nop 1" : "+v"(a), "+v"(b)); }
template <int M> DI float xor_sum(float v) {
  if constexpr (M < 32) return v + __builtin_bit_cast(float, xor_partner_bits<M>(__builtin_bit_cast(int, v)));
  else { unsigned a = __builtin_bit_cast(unsigned, v), b = a; half_swap(a, b); return __builtin_bit_cast(float, a) + __builtin_bit_cast(float, b); }
}
template <int M> DI float xor_max(float v) {
  if constexpr (M < 32) return fmaxf(v, __builtin_bit_cast(float, xor_partner_bits<M>(__builtin_bit_cast(int, v))));
  else { unsigned a = __builtin_bit_cast(unsigned, v), b = a; half_swap(a, b); return fmaxf(__builtin_bit_cast(float, a), __builtin_bit_cast(float, b)); }
}
template <int M> DI int xor_sum_i(int v) {
  if constexpr (M < 32) return v + xor_partner_bits<M>(v);
  else { unsigned a = (unsigned)v, b = a; half_swap(a, b); return (int)(a + b); }
}
DI int lane_bcast(int v, int src) { return __builtin_amdgcn_readlane(v, src); }
DI float lane_get(float v, int src) { return __builtin_bit_cast(float, __builtin_amdgcn_ds_bpermute(src << 2, __builtin_bit_cast(int, v))); }
DI int lane_up(int v, int d, int lane) { return __builtin_amdgcn_ds_bpermute(((lane - d) & 63) << 2, v); }
#endif
#endif

DI float bf2f(bf16_t v) { return u2f(((unsigned)v) << 16); }
#ifdef CPU_EMU
DI bf16_t f2bf(float f) { unsigned u = f2u(f); u += 0x7fffu + ((u >> 16) & 1u); return (bf16_t)(u >> 16); }
DI unsigned pack2bf(float lo, float hi) { return (unsigned)f2bf(lo) | ((unsigned)f2bf(hi) << 16); }
static inline unsigned wave_ballot16(bool pr) { unsigned m = 0; for (int e = 0; e < 16; ++e) m |= (__shfl(pr ? 1 : 0, e) ? 1u : 0u) << e; return m; }
static inline bool wave_any(bool pr) { int v = pr ? 1 : 0; v |= __shfl_xor(v, 1); v |= __shfl_xor(v, 2); v |= __shfl_xor(v, 4); v |= __shfl_xor(v, 8); v |= __shfl_xor(v, 16); v |= __shfl_xor(v, 32); return v != 0; }
#else
typedef float f32x2_ __attribute__((ext_vector_type(2)));
typedef __bf16 bf16x2_hw __attribute__((ext_vector_type(2)));
DI unsigned pack2bf(float lo, float hi) { const f32x2_ v = {lo, hi}; return __builtin_bit_cast(unsigned, __builtin_convertvector(v, bf16x2_hw)); }
DI bf16_t f2bf(float f) { return (bf16_t)(pack2bf(f, f) & 0xffffu); }
DI bool wave_any(bool pr) { return __builtin_amdgcn_ballot_w64(pr) != 0ull; }
DI unsigned wave_ballot16(bool pr) { return (unsigned)__builtin_amdgcn_ballot_w64(pr) & 0xffffu; }
#endif
DI float sigmoidf_(float x) { return 1.0f / (1.0f + expf(-x)); }
DI float siluf_(float x) { return x / (1.0f + expf(-x)); }
DI float logsigmoidf_(float x) { return fminf(x, 0.0f) - log1pf(expf(-fabsf(x))); }

constexpr int D = 1024, NB = 2, TL = T_LAT, TC = T_CTX, TK = TL + TC;
constexpr int RL = NB * TL, RC = NB * TC, R = RL + RC;
constexpr int NZ = 3024, NZP = 3072;
constexpr int ZC_QLAT = 0, ZC_KVLAT = 256, ZC_KROPE = 384, ZC_MLQK = 416, ZC_MLV = 928, ZC_MLO = 1184, ZC_MLIG = 1440,
              ZC_MLFG = 1448, ZC_GQ = 1456, ZC_GK = 1584, ZC_GV = 1712, ZC_GR = 1968, ZC_GA = 2224, ZC_DQ = 2256,
              ZC_DK = 2512, ZC_DV = 2768;
constexpr int NCK = TK / 64, NCC = TC / 64, NCL = TL / 64;
constexpr int NE = 16, FF = 1408, CAPL = 2 * TL / 16, CAPC = 2 * TC / 16, CAPT = CAPL + CAPC, NSLOT = NB * CAPT;
constexpr size_t WSZ_IN = (size_t)NZP * D, WSZ_UQ = 384 * 256, WSZ_UKV = 512 * 128, WSZ_GATE = (size_t)4096 * D, WSZ_BR = (size_t)4 * D * 256, WSZ_OUT = (size_t)D * D;
constexpr int NUNIT = NB * 2 * NCK * 4;
constexpr float LOG2E = 1.4426950408889634f;
constexpr float QS_MLA = 0.10206207261596577f * LOG2E;
constexpr float QS_DIFF = 0.17677669529663687f * LOG2E;

DI int row_of(int b, int s) { return s < TC ? RL + b * TC + s : b * TL + (s - TC); }
DI void bs_of(int r, int& b, int& s) { if (r < RL) { b = r / TL; s = TC + (r % TL); } else { int q = r - RL; b = q / TC; s = q % TC; } }
DI int seq_of(int d, int p) { return d == 0 ? p : (p < TC ? TC - 1 - p : TK - 1 - (p - TC)); }
DI int step_of(int d, int c) { return d == 0 ? c : (c < NCC ? NCC - 1 - c : NCC + (NCK - 1 - c)); }

struct Params {
  const float *x, *c, *ctx, *c_ctx, *w_ada, *b_ada, *g_mix_pre, *g_mix_post, *g_ffn_pre, *g_ffn_post, *w_in, *g_q_lat, *w_uq,
      *g_kv_lat, *w_ukv, *w_conv, *b_conv, *b_igate, *b_fgate, *g_mlstm_out, *w_alpha2, *b_alpha, *g_gla_out, *diff_lambda,
      *g_diff_out, *w_branch, *w_gate, *b_gate, *w_out, *w_router, *w_e_gate, *w_e_up, *w_e_down;
  float* out;
  float *mods, *xc;
  bf16_t *H, *Z, *Qm, *Km, *Vtm, *Qd, *Kd, *Vtd, *MQ, *MK, *Y, *MG, *YO, *HID, *YE, *MVt, *GVt;
  float *BC, *IGS, *GC, *MC, *MN, *MM, *GS, *HD, *OD, *AFF, *SELV;
  int *SEL, *INV;
  bf16_t *Wt_in, *Wt_uq, *Wt_ukv, *Wt_gate, *Wt_branch, *Wt_out, *Wt_eg, *Wt_eu, *Wt_ed;
  unsigned* bar;
  size_t ws_need;
};

static inline size_t al256(size_t x) { return (x + 255) & ~(size_t)255; }
static inline void map_workspace(Params& p, char* ws) {
  size_t o = 0;
  auto take = [&](size_t bytes) { size_t r = o; o += al256(bytes); return ws + r; };
  p.bar = (unsigned*)take(16384);
  p.mods = (float*)take((size_t)2 * 3 * 6144 * 4);
  p.xc = (float*)take((size_t)RC * D * 4);
  p.BC = (float*)take((size_t)NB * 2 * TK * 4 * 4);
  p.IGS = (float*)take((size_t)NB * 2 * TK * 4 * 4);
  p.AFF = (float*)take((size_t)NB * NE * TK * 4);
  p.SEL = (int*)take((size_t)NE * NSLOT * 4);
  p.SELV = (float*)take((size_t)NE * NSLOT * 4);
  p.INV = (int*)take((size_t)R * NE * 4);
  p.MM = (float*)take((size_t)NUNIT * 4 * 4);
  p.MN = (float*)take((size_t)NUNIT * 64 * 4);
  p.Wt_in = (bf16_t*)take((size_t)2 * WSZ_IN * 2);
  p.Wt_uq = (bf16_t*)take((size_t)2 * WSZ_UQ * 2);
  p.Wt_ukv = (bf16_t*)take((size_t)2 * WSZ_UKV * 2);
  p.Wt_gate = (bf16_t*)take((size_t)2 * WSZ_GATE * 2);
  p.Wt_branch = (bf16_t*)take((size_t)2 * WSZ_BR * 2);
  p.Wt_out = (bf16_t*)take((size_t)2 * WSZ_OUT * 2);
  p.H = (bf16_t*)take((size_t)R * D * 2);
  size_t szA = (size_t)R * NZP * 2, szHID = (size_t)NE * NSLOT * FF * 2;
  char* A = take(szA > szHID ? szA : szHID);
  p.Z = (bf16_t*)A; p.HID = (bf16_t*)A;
  size_t szQm = al256((size_t)NB * 4 * TK * 96 * 2), szVt = al256((size_t)NB * 4 * 64 * TK * 2), szQd = al256((size_t)NB * 8 * TK * 32 * 2);
  size_t szB1 = 2 * szQm + 2 * szVt + 2 * szQd;
  size_t szHD = al256((size_t)2 * NB * TK * 256 * 4);
  size_t szYE = (size_t)NE * NSLOT * D * 2;
  size_t szB = szB1; if (2 * szHD > szB) szB = 2 * szHD; if (szYE > szB) szB = szYE;
  char* Bq = take(szB);
  p.Qm = (bf16_t*)Bq; p.Km = (bf16_t*)(Bq + szQm); p.Vtm = (bf16_t*)(Bq + 2 * szQm);
  p.Qd = (bf16_t*)(Bq + 2 * szQm + szVt); p.Kd = (bf16_t*)(Bq + 2 * szQm + szVt + szQd); p.Vtd = (bf16_t*)(Bq + 2 * szQm + szVt + 2 * szQd);
  p.YE = (bf16_t*)Bq;
  p.GC = (float*)take((size_t)NB * 2 * TK * 128 * 4);
  p.MVt = (bf16_t*)take((size_t)NB * 4 * 64 * TK * 2);
  p.GVt = (bf16_t*)take((size_t)NB * 4 * 64 * TK * 2);
  size_t szW = (size_t)NE * FF * D * 2;
  size_t szMC = (size_t)NUNIT * 4096 * 4, szRD = (size_t)R * D * 2;
  size_t szC = szMC; if (szRD > szC) szC = szRD; if (szW > szC) szC = szW;
  char* C = take(szC);
  p.MC = (float*)C; p.MG = (bf16_t*)C; p.Wt_eg = (bf16_t*)C;
  size_t szMQ = al256((size_t)NB * TK * 256 * 2), szGS = (size_t)NUNIT * 2048 * 4;
  size_t szD = 2 * szMQ + szGS; if (szW > szD) szD = szW;
  char* Dq = take(szD);
  p.MQ = (bf16_t*)Dq; p.MK = (bf16_t*)(Dq + szMQ); p.GS = (float*)(Dq + 2 * szMQ); p.Wt_eu = (bf16_t*)Dq;
  size_t szF = 2 * szRD > szW ? 2 * szRD : szW;
  char* F = take(szF);
  p.Y = (bf16_t*)F; p.YO = (bf16_t*)(F + szRD); p.Wt_ed = (bf16_t*)F;
  p.HD = (float*)Bq; p.OD = (float*)(Bq + szHD);
  p.ws_need = o;
}
#define GTID ((long)blockIdx.x * blockDim.x + threadIdx.x)

DI float lam_of(const Params& p, int layer, float& lam_init) {
  const float* lv = p.diff_lambda + layer * 128;
  float s1 = 0.f, s2 = 0.f;
  for (int i = 0; i < 32; ++i) { s1 += lv[i] * lv[32 + i]; s2 += lv[64 + i] * lv[96 + i]; }
  lam_init = layer == 0 ? 0.2f : 0.35550906759096f;
  return expf(s1) - expf(s2) + lam_init;
}
DI void rope_cs(int s, int jj, float& cs, float& sn) {
  int t = s - TC;
  int pos = (jj < 16) ? (t / 64) : (t % 64);
  float ang = (float)pos * exp2f(-1.6609640474436813f * (float)(jj & 7));
  double rev = (double)ang * 0.15915494309189535;
  rev -= floor(rev + 0.5);
  float rf = (float)rev;
  cs = hw_cos_rev(rf); sn = hw_sin_rev(rf);
}
template <class G> DI float rope_elem(G get, int s, int jj) {
  if (s < TC) return get(jj);
  float cs, sn; rope_cs(s, jj, cs, sn);
  float a = get(jj), b = get(jj ^ 8);
  return (jj & 8) ? (a * cs + b * sn) : (a * cs - b * sn);
}

DI void nvb_mods(long GI, const Params& p) {
  long i = GI; if (i >= 2 * 3 * 6144) return;
  int col = (int)(i % 6144), w = (int)((i / 6144) % 3), l = (int)(i / (3 * 6144));
  const float* cv = w < 2 ? p.c + w * 1024 : p.c_ctx;
  const float* W = p.w_ada + (size_t)l * 1024 * 6144;
  float acc = 0.f;
  for (int k = 0; k < 1024; ++k) acc += siluf_(cv[k]) * W[(size_t)k * 6144 + col];
  p.mods[i] = acc + p.b_ada[l * 6144 + col];
}
__global__ void __launch_bounds__(256) nv_wt(const float* in, bf16_t* out, int K, int N, int NP, long in_bs, long out_bs, const float* gain) {
  long i = GTID; if (i >= (long)NP * K) return;
  int k = (int)(i % K), n = (int)(i / K);
  const float* I = in + (size_t)blockIdx.y * in_bs; bf16_t* O = out + (size_t)blockIdx.y * out_bs;
  O[(size_t)n * K + k] = n < N ? f2bf(I[(size_t)k * N + n] * (gain ? gain[k] : 1.0f)) : (bf16_t)0;
}
__global__ void __launch_bounds__(256) nv_modulate(Params p, int layer, int which, const float* xl, const float* xcx, int nrows) {
  long r = GTID; if (r >= nrows) return;
  int w = r < RL ? (int)(r / TL) : 2;
  const float* mb = p.mods + (size_t)(layer * 3 + w) * 6144;
  const float* shift = mb + (which ? 3 : 0) * 1024; const float* scale = mb + (which ? 4 : 1) * 1024;
  const float* g = (which ? p.g_ffn_pre : p.g_mix_pre) + layer * 1024;
  const float* x = r < RL ? xl + (size_t)r * D : xcx + (size_t)(r - RL) * D;
  float ss = 0.f; for (int k = 0; k < D; ++k) ss += x[k] * x[k];
  float rstd = 1.0f / sqrtf(ss / D + 1e-6f);
  for (int k = 0; k < D; ++k) p.H[(size_t)r * D + k] = f2bf(x[k] * rstd * g[k] * (1.f + scale[k]) + shift[k]);
}
__global__ void __launch_bounds__(256) nv_gemm(const bf16_t* A, int lda, const bf16_t* Bt, int ldb, int M, int N, int K, bf16_t* C, int ldc) {
  long i = GTID; if (i >= (long)M * N) return;
  int n = (int)(i % N), m = (int)(i / N);
  const bf16_t* a = A + (size_t)m * lda; const bf16_t* b = Bt + (size_t)n * ldb;
  float acc = 0.f;
  for (int k = 0; k < K; ++k) acc += bf2f(a[k]) * bf2f(b[k]);
  C[(size_t)m * ldc + n] = f2bf(acc);
}
__global__ void __launch_bounds__(256) nv_mla_q(Params p, int layer) {
  long i = GTID; if (i >= (long)R * 4 * 96) return;
  int j = (int)(i % 96), h = (int)((i / 96) % 4), r = (int)(i / 384);
  int b, s; bs_of(r, b, s);
  const bf16_t* z = p.Z + (size_t)r * NZP + ZC_QLAT;
  const float* g = p.g_q_lat + layer * 256; const float* W = p.w_uq + (size_t)layer * 256 * 384;
  float ss = 0.f; for (int k = 0; k < 256; ++k) { float v = bf2f(z[k]); ss += v * v; }
  float rstd = 1.0f / sqrtf(ss / 256 + 1e-6f);
  auto dot = [&](int col) { float a = 0.f; for (int k = 0; k < 256; ++k) a += bf2f(z[k]) * rstd * g[k] * W[(size_t)k * 384 + col]; return a; };
  float v;
  if (j < 64) v = dot(h * 96 + j);
  else v = rope_elem([&](int jj) { return dot(h * 96 + 64 + jj); }, s, j - 64);
  p.Qm[(((size_t)b * 4 + h) * TK + s) * 96 + j] = f2bf(v * QS_MLA);
}
__global__ void __launch_bounds__(256) nv_mla_kv(Params p, int layer) {
  long i = GTID; if (i >= (long)R * 4 * 160) return;
  int j = (int)(i % 160), h = (int)((i / 160) % 4), r = (int)(i / 640);
  int b, s; bs_of(r, b, s);
  const bf16_t* z = p.Z + (size_t)r * NZP;
  if (j < 128) {
    const bf16_t* zl = z + ZC_KVLAT; const float* g = p.g_kv_lat + layer * 128; const float* W = p.w_ukv + (size_t)layer * 128 * 512;
    float ss = 0.f; for (int k = 0; k < 128; ++k) { float v = bf2f(zl[k]); ss += v * v; }
    float rstd = 1.0f / sqrtf(ss / 128 + 1e-6f);
    float a = 0.f; for (int k = 0; k < 128; ++k) a += bf2f(zl[k]) * rstd * g[k] * W[(size_t)k * 512 + h * 128 + j];
    if (j < 64) p.Km[(((size_t)b * 4 + h) * TK + s) * 96 + j] = f2bf(a);
    else p.Vtm[(((size_t)b * 4 + h) * 64 + (j - 64)) * TK + s] = f2bf(a);
  } else {
    int jj = j - 128;
    float v = rope_elem([&](int q) { return bf2f(z[ZC_KROPE + q]); }, s, jj);
    p.Km[(((size_t)b * 4 + h) * TK + s) * 96 + 64 + jj] = f2bf(v);
  }
}
__global__ void __launch_bounds__(256) nv_diff_prep(Params p) {
  long i = GTID; if (i >= (long)R * 768) return;
  int c = (int)(i % 768), r = (int)(i / 768);
  int b, s; bs_of(r, b, s);
  const bf16_t* z = p.Z + (size_t)r * NZP;
  if (c < 512) {
    int qk = c / 256, cc = c % 256, hm = cc / 32, jj = cc % 32;
    const bf16_t* src = z + (qk ? ZC_DK : ZC_DQ) + hm * 32;
    float v = rope_elem([&](int q) { return bf2f(src[q]); }, s, jj);
    if (qk == 0) p.Qd[(((size_t)b * 8 + hm) * TK + s) * 32 + jj] = f2bf(v * QS_DIFF);
    else p.Kd[(((size_t)b * 8 + hm) * TK + s) * 32 + jj] = f2bf(v);
  } else {
    int cc = c - 512, h = cc / 64, dv = cc % 64;
    p.Vtd[(((size_t)b * 4 + h) * 64 + dv) * TK + s] = z[ZC_DV + cc];
  }
}
__global__ void __launch_bounds__(256) nv_ml_prep(Params p, int layer) {
  long i = GTID; if (i >= (long)R * 512) return;
  int ch = (int)(i % 512), r = (int)(i / 512);
  int b, s; bs_of(r, b, s);
  bool first = (s == 0) || (s == TC), last = (s == TC - 1) || (s == TK - 1);
  const float* w = p.w_conv + (size_t)layer * 3 * 512;
  float acc = p.b_conv[layer * 512 + ch];
  acc += bf2f(p.Z[(size_t)r * NZP + ZC_MLQK + ch]) * w[512 + ch];
  if (!first) acc += bf2f(p.Z[(size_t)row_of(b, s - 1) * NZP + ZC_MLQK + ch]) * w[ch];
  if (!last) acc += bf2f(p.Z[(size_t)row_of(b, s + 1) * NZP + ZC_MLQK + ch]) * w[1024 + ch];
  float v = siluf_(acc);
  if (ch < 256) p.MQ[((size_t)b * TK + s) * 256 + ch] = f2bf(v);
  else p.MK[((size_t)b * TK + s) * 256 + ch - 256] = f2bf(v * 0.125f);
}
DI void nvb_ml_gates(long GI, const Params& p, int layer) {
  long i = GI; if (i >= (long)NB * 2 * NCK * 4) return;
  int h = (int)(i % 4), j = (int)((i / 4) % NCK), d = (int)((i / (4 * NCK)) % 2), b = (int)(i / (8 * NCK));
  float bi = p.b_igate[layer * 8 + d * 4 + h], bfg = p.b_fgate[layer * 8 + d * 4 + h];
  float cum = 0.f;
  for (int l = 0; l < 64; ++l) {
    int pp = 64 * j + l, s = seq_of(d, pp); const bf16_t* z = p.Z + (size_t)row_of(b, s) * NZP;
    float ig = bf2f(z[ZC_MLIG + d * 4 + h]) + bi;
    float lf = logsigmoidf_(bf2f(z[ZC_MLFG + d * 4 + h]) + bfg);
    cum += lf;
    size_t o = (((size_t)b * 2 + d) * TK + pp) * 4 + h;
    p.BC[o] = cum; p.IGS[o] = ig;
  }
}
DI void nvb_gla_cum(long GI, const Params& p, int layer) {
  long i = GI; if (i >= (long)NB * 2 * NCK * 128) return;
  int ch = (int)(i % 128), j = (int)((i / 128) % NCK), d = (int)((i / (128 * NCK)) % 2), b = (int)(i / (256 * NCK));
  const float* W = p.w_alpha2 + (size_t)layer * 2 * 16 * 128 + (size_t)d * 16 * 128;
  float ba = p.b_alpha[layer * 256 + d * 128 + ch];
  float cum = 0.f;
  for (int l = 0; l < 64; ++l) {
    int pp = 64 * j + l, s = seq_of(d, pp); const bf16_t* z = p.Z + (size_t)row_of(b, s) * NZP + ZC_GA + d * 16;
    float zg = ba; for (int q = 0; q < 16; ++q) zg += bf2f(z[q]) * W[q * 128 + ch];
    cum += logsigmoidf_(zg) * (1.0f / 16.0f);
    p.GC[(((size_t)b * 2 + d) * TK + pp) * 128 + ch] = cum;
  }
}
__global__ void __launch_bounds__(256) nv_attn_mla(Params p, int need_ctx) {
  long i = GTID; if (i >= (long)NB * 4 * TK) return;
  int s = (int)(i % TK), h = (int)((i / TK) % 4), b = (int)(i / (4 * TK));
  if (s < TC && !need_ctx) return;
  int nk = s < TC ? TC : TK;
  const bf16_t* q = p.Qm + (((size_t)b * 4 + h) * TK + s) * 96;
  const bf16_t* K = p.Km + ((size_t)b * 4 + h) * TK * 96;
  const bf16_t* Vt = p.Vtm + ((size_t)b * 4 + h) * 64 * TK;
  float qf[96], o[64];
  _Pragma("unroll") for (int k = 0; k < 96; ++k) qf[k] = bf2f(q[k]);
  _Pragma("unroll") for (int k = 0; k < 64; ++k) o[k] = 0.f;
  float m = -1e30f, l = 0.f;
  for (int t = 0; t < nk; ++t) {
    float sc = 0.f; _Pragma("unroll") for (int k = 0; k < 96; ++k) sc += qf[k] * bf2f(K[(size_t)t * 96 + k]);
    float mn = fmaxf(m, sc), a = exp2f(m - mn), pr = exp2f(sc - mn);
    l = l * a + pr;
    _Pragma("unroll") for (int k = 0; k < 64; ++k) o[k] = o[k] * a + pr * bf2f(Vt[(size_t)k * TK + t]);
    m = mn;
  }
  int r = row_of(b, s);
  _Pragma("unroll") for (int k = 0; k < 64; ++k) p.Y[(size_t)r * D + h * 64 + k] = f2bf(o[k] / l);
}
__global__ void __launch_bounds__(256) nv_attn_diff(Params p, int layer, int need_ctx) {
  long i = GTID; if (i >= (long)NB * 4 * TK) return;
  int s = (int)(i % TK), h = (int)((i / TK) % 4), b = (int)(i / (4 * TK));
  if (s < TC && !need_ctx) return;
  int nk = s < TC ? TC : TK;
  float lam_init; float lam = lam_of(p, layer, lam_init);
  const bf16_t* Vt = p.Vtd + ((size_t)b * 4 + h) * 64 * TK;
  float res[64];
  _Pragma("unroll") for (int k = 0; k < 64; ++k) res[k] = 0.f;
  _Pragma("unroll") for (int mp = 0; mp < 2; ++mp) {
    const bf16_t* q = p.Qd + (((size_t)b * 8 + h * 2 + mp) * TK + s) * 32;
    const bf16_t* K = p.Kd + ((size_t)b * 8 + h * 2 + mp) * TK * 32;
    float qf[32], o[64];
    _Pragma("unroll") for (int k = 0; k < 32; ++k) qf[k] = bf2f(q[k]);
    _Pragma("unroll") for (int k = 0; k < 64; ++k) o[k] = 0.f;
    float m = -1e30f, l = 0.f;
    for (int t = 0; t < nk; ++t) {
      float sc = 0.f; _Pragma("unroll") for (int k = 0; k < 32; ++k) sc += qf[k] * bf2f(K[(size_t)t * 32 + k]);
      float mn = fmaxf(m, sc), a = exp2f(m - mn), pr = exp2f(sc - mn);
      l = l * a + pr;
      _Pragma("unroll") for (int k = 0; k < 64; ++k) o[k] = o[k] * a + pr * bf2f(Vt[(size_t)k * TK + t]);
      m = mn;
    }
    float wgt = mp == 0 ? 1.f : -lam;
    _Pragma("unroll") for (int k = 0; k < 64; ++k) res[k] += wgt * o[k] / l;
  }
  float ss = 0.f; _Pragma("unroll") for (int k = 0; k < 64; ++k) ss += res[k] * res[k];
  float rstd = 1.0f / sqrtf(ss / 64 + 1e-6f);
  int r = row_of(b, s);
  _Pragma("unroll") for (int k = 0; k < 64; ++k) p.Y[(size_t)r * D + 768 + h * 64 + k] = f2bf(res[k] * rstd * p.g_diff_out[layer * 256 + h * 64 + k] * (1.f - lam_init));
}
DI void nvb_ml_local(long GI, const Params& p) {
  long i = GI; if (i >= (long)NUNIT * 4160) return;
  int e = (int)(i % 4160); long u = i / 4160;
  int h = (int)(u % 4), j = (int)((u / 4) % NCK), d = (int)((u / (4 * NCK)) % 2), b = (int)(u / (8 * NCK));
  const float* bc = p.BC + (((size_t)b * 2 + d) * TK + 64 * j) * 4 + h; const float* ig = p.IGS + (((size_t)b * 2 + d) * TK + 64 * j) * 4 + h;
  float bend = bc[63 * 4], ml = -1e30f;
  for (int l = 0; l < 64; ++l) ml = fmaxf(ml, bend - bc[l * 4] + ig[l * 4]);
  if (e == 4096 + 0) { p.MM[u * 4 + 0] = ml; p.MM[u * 4 + 1] = bend; }
  float acc = 0.f;
  if (e < 4096) {
    int v = e / 64, k = e % 64;
    for (int l = 0; l < 64; ++l) {
      int s = seq_of(d, 64 * j + l); float w = expf(bend - bc[l * 4] + ig[l * 4] - ml);
      acc += w * bf2f(p.Z[(size_t)row_of(b, s) * NZP + ZC_MLV + h * 64 + v]) * bf2f(p.MK[((size_t)b * TK + s) * 256 + h * 64 + k]);
    }
    p.MC[(size_t)u * 4096 + e] = acc;
  } else {
    int k = e - 4096;
    for (int l = 0; l < 64; ++l) {
      int s = seq_of(d, 64 * j + l); float w = expf(bend - bc[l * 4] + ig[l * 4] - ml);
      acc += w * bf2f(p.MK[((size_t)b * TK + s) * 256 + h * 64 + k]);
    }
    p.MN[(size_t)u * 64 + k] = acc;
  }
}
DI void nvb_ml_scan(long GI, const Params& p) {
  long i = GI; if (i >= (long)NB * 2 * 4 * 4160) return;
  int e = (int)(i % 4160); int ch = (int)(i / 4160); int h = ch % 4, bd = ch / 4;
  float st = 0.f, m = -1e30f;
  for (int j = 0; j < NCK; ++j) {
    size_t u = ((size_t)bd * NCK + j) * 4 + h;
    float ml = p.MM[u * 4 + 0], be = p.MM[u * 4 + 1];
    float mn = fmaxf(be + m, ml), a = expf(be + m - mn), g = expf(ml - mn);
    float* slot = e < 4096 ? &p.MC[u * 4096 + e] : &p.MN[u * 64 + (e - 4096)];
    float loc = *slot; *slot = st; st = a * st + g * loc;
    if (e == 0) p.MM[u * 4 + 2] = m;
    m = mn;
  }
}
DI void nvb_ml_out(long GI, const Params& p, int need_ctx) {
  long i = GI; if (i >= (long)NUNIT * 4096) return;
  int v = (int)(i % 64), l = (int)((i / 64) % 64); long u = i / 4096;
  int h = (int)(u % 4), j = (int)((u / 4) % NCK), d = (int)((u / (4 * NCK)) % 2), b = (int)(u / (8 * NCK));
  if (j < NCC && !need_ctx) return;
  const float* bc = p.BC + (((size_t)b * 2 + d) * TK + 64 * j) * 4 + h; const float* ig = p.IGS + (((size_t)b * 2 + d) * TK + 64 * j) * 4 + h;
  float m0 = p.MM[u * 4 + 2];
  int sl = seq_of(d, 64 * j + l);
  const bf16_t* q = p.MQ + ((size_t)b * TK + sl) * 256 + h * 64;
  float bl = bc[l * 4];
  float inter = bl + m0, mt = inter;
  for (int t = 0; t <= l; ++t) mt = fmaxf(mt, bl - bc[t * 4] + ig[t * 4]);
  float num = 0.f, den = 0.f;
  for (int t = 0; t <= l; ++t) {
    int st = seq_of(d, 64 * j + t);
    const bf16_t* k = p.MK + ((size_t)b * TK + st) * 256 + h * 64;
    float qk = 0.f; for (int c = 0; c < 64; ++c) qk += bf2f(q[c]) * bf2f(k[c]);
    float sv = expf(bl - bc[t * 4] + ig[t * 4] - mt) * qk;
    num += sv * bf2f(p.Z[(size_t)row_of(b, st) * NZP + ZC_MLV + h * 64 + v]); den += sv;
  }
  float ai = expf(inter - mt);
  float qc = 0.f, qn = 0.f;
  for (int c = 0; c < 64; ++c) { qc += bf2f(q[c]) * p.MC[(size_t)u * 4096 + v * 64 + c]; qn += bf2f(q[c]) * p.MN[(size_t)u * 64 + c]; }
  num += ai * qc; den += ai * qn;
  p.HD[(((size_t)d * NB + b) * TK + sl) * 256 + h * 64 + v] = num / fmaxf(fabsf(den), expf(-mt));
}
DI void nvb_ml_finish(long GI, const Params& p, int layer, int need_ctx) {
  long i = GI; if (i >= (long)R * 4) return;
  int h = (int)(i % 4), r = (int)(i / 4); int b, s; bs_of(r, b, s);
  if (s < TC && !need_ctx) return;
  const float* h0 = p.HD + (((size_t)0 * NB + b) * TK + s) * 256 + h * 64; const float* h1 = p.HD + (((size_t)1 * NB + b) * TK + s) * 256 + h * 64;
  float ss = 0.f; for (int v = 0; v < 64; ++v) { float t = h0[v] + h1[v]; ss += t * t; }
  float rstd = 1.0f / sqrtf(ss / 64 + 1e-6f);
  for (int v = 0; v < 64; ++v) {
    float o = bf2f(p.Z[(size_t)r * NZP + ZC_MLO + h * 64 + v]);
    p.Y[(size_t)r * D + 256 + h * 64 + v] = f2bf(sigmoidf_(o) * (h0[v] + h1[v]) * rstd * p.g_mlstm_out[layer * 256 + h * 64 + v]);
  }
}
DI void nvb_gla_local(long GI, const Params& p) {
  long i = GI; if (i >= (long)NUNIT * 2048) return;
  int v = (int)(i % 64), k = (int)((i / 64) % 32); long u = i / 2048;
  int h = (int)(u % 4), j = (int)((u / 4) % NCK), d = (int)((u / (4 * NCK)) % 2), b = (int)(u / (8 * NCK));
  const float* gc = p.GC + (((size_t)b * 2 + d) * TK + 64 * j) * 128 + h * 32 + k;
  float ge = gc[63 * 128], acc = 0.f;
  for (int l = 0; l < 64; ++l) {
    int s = seq_of(d, 64 * j + l); const bf16_t* z = p.Z + (size_t)row_of(b, s) * NZP;
    acc += bf2f(z[ZC_GK + h * 32 + k]) * expf(ge - gc[l * 128]) * bf2f(z[ZC_GV + h * 64 + v]);
  }
  p.GS[(size_t)u * 2048 + v * 32 + k] = acc;
}
DI void nvb_gla_scan(long GI, const Params& p) {
  long i = GI; if (i >= (long)NB * 2 * 4 * 2048) return;
  int e = (int)(i % 2048); int ch = (int)(i / 2048); int h = ch % 4, bd = ch / 4; int k = e % 32;
  float st = 0.f;
  for (int j = 0; j < NCK; ++j) {
    size_t u = ((size_t)bd * NCK + j) * 4 + h;
    float ge = p.GC[((size_t)bd * TK + 64 * j + 63) * 128 + h * 32 + k];
    float loc = p.GS[u * 2048 + e]; p.GS[u * 2048 + e] = st; st = expf(ge) * st + loc;
  }
}
DI void nvb_gla_out(long GI, const Params& p, int need_ctx) {
  long i = GI; if (i >= (long)NUNIT * 4096) return;
  int v = (int)(i % 64), l = (int)((i / 64) % 64); long u = i / 4096;
  int h = (int)(u % 4), j = (int)((u / 4) % NCK), d = (int)((u / (4 * NCK)) % 2), b = (int)(u / (8 * NCK));
  if (j < NCC && !need_ctx) return;
  const float* gc = p.GC + (((size_t)b * 2 + d) * TK + 64 * j) * 128 + h * 32;
  int sl = seq_of(d, 64 * j + l);
  const bf16_t* q = p.Z + (size_t)row_of(b, sl) * NZP + ZC_GQ + h * 32;
  const float qs = 0.17677669529663687f;
  float acc = 0.f;
  for (int t = 0; t <= l; ++t) {
    int st = seq_of(d, 64 * j + t); const bf16_t* z = p.Z + (size_t)row_of(b, st) * NZP;
    float att = 0.f; for (int k = 0; k < 32; ++k) att += bf2f(q[k]) * qs * expf(gc[l * 128 + k] - gc[t * 128 + k]) * bf2f(z[ZC_GK + h * 32 + k]);
    acc += att * bf2f(z[ZC_GV + h * 64 + v]);
  }
  for (int k = 0; k < 32; ++k) acc += bf2f(q[k]) * qs * expf(gc[l * 128 + k]) * p.GS[(size_t)u * 2048 + v * 32 + k];
  p.OD[(((size_t)d * NB + b) * TK + sl) * 256 + h * 64 + v] = acc;
}
DI void nvb_gla_finish(long GI, const Params& p, int layer, int need_ctx) {
  long i = GI; if (i >= (long)R * 4) return;
  int h = (int)(i % 4), r = (int)(i / 4); int b, s; bs_of(r, b, s);
  if (s < TC && !need_ctx) return;
  const float* h0 = p.OD + (((size_t)0 * NB + b) * TK + s) * 256 + h * 64; const float* h1 = p.OD + (((size_t)1 * NB + b) * TK + s) * 256 + h * 64;
  float ss = 0.f; for (int v = 0; v < 64; ++v) { float t = h0[v] + h1[v]; ss += t * t; }
  float rstd = 1.0f / sqrtf(ss / 64 + 1e-6f);
  for (int v = 0; v < 64; ++v) {
    float rr = bf2f(p.Z[(size_t)r * NZP + ZC_GR + h * 64 + v]);
    p.Y[(size_t)r * D + 512 + h * 64 + v] = f2bf(siluf_(rr) * (h0[v] + h1[v]) * rstd * p.g_gla_out[layer * 256 + h * 64 + v]);
  }
}
__global__ void __launch_bounds__(256) nv_merge(Params p, int layer, int nrows) {
  long i = GTID; if (i >= (long)nrows * D) return;
  int j = (int)(i % D), r = (int)(i / D);
  float acc = 0.f;
  for (int n = 0; n < 4; ++n) {
    const bf16_t* wg = p.Wt_gate + (size_t)(n * 1024 + j) * D; const bf16_t* wb = p.Wt_branch + ((size_t)n * D + j) * 256;
    float g = p.b_gate[layer * 4096 + n * 1024 + j], pr = 0.f;
    for (int k = 0; k < D; ++k) g += bf2f(p.H[(size_t)r * D + k]) * bf2f(wg[k]);
    for (int k = 0; k < 256; ++k) pr += bf2f(p.Y[(size_t)r * D + n * 256 + k]) * bf2f(wb[k]);
    acc += sigmoidf_(g) * pr;
  }
  p.MG[(size_t)r * D + j] = f2bf(acc);
}
__global__ void __launch_bounds__(256) nv_resid_mix(Params p, int layer, const float* xl_in, const float* xc_in, int nrows) {
  long r = GTID; if (r >= nrows) return;
  int w = r < RL ? (int)(r / TL) : 2;
  const float* mb = p.mods + (size_t)(layer * 3 + w) * 6144;
  const float* xin = r < RL ? xl_in + (size_t)r * D : xc_in + (size_t)(r - RL) * D;
  float* xo = r < RL ? p.out + (size_t)r * D : p.xc + (size_t)(r - RL) * D;
  const bf16_t* yo = p.YO + (size_t)r * D;
  float ss = 0.f; for (int k = 0; k < D; ++k) { float v = bf2f(yo[k]); ss += v * v; }
  float rstd = 1.0f / sqrtf(ss / D + 1e-6f);
  float s2 = 0.f;
  for (int k = 0; k < D; ++k) { float xn = xin[k] + mb[2 * 1024 + k] * bf2f(yo[k]) * rstd * p.g_mix_post[layer * 1024 + k]; xo[k] = xn; s2 += xn * xn; }
  float rstd2 = 1.0f / sqrtf(s2 / D + 1e-6f);
  float lg[16]; _Pragma("unroll") for (int e = 0; e < 16; ++e) lg[e] = 0.f;
  const float* wr = p.w_router + (size_t)layer * D * 16;
  for (int k = 0; k < D; ++k) {
    float h2 = xo[k] * rstd2 * p.g_ffn_pre[layer * 1024 + k] * (1.f + mb[4 * 1024 + k]) + mb[3 * 1024 + k];
    p.H[(size_t)r * D + k] = f2bf(h2);
    _Pragma("unroll") for (int e = 0; e < 16; ++e) lg[e] += h2 * wr[k * 16 + e];
  }
  float mx = lg[0]; _Pragma("unroll") for (int e = 1; e < 16; ++e) mx = fmaxf(mx, lg[e]);
  float sm = 0.f; _Pragma("unroll") for (int e = 0; e < 16; ++e) { lg[e] = expf(lg[e] - mx); sm += lg[e]; }
  int b, s; bs_of((int)r, b, s);
  _Pragma("unroll") for (int e = 0; e < 16; ++e) p.AFF[((size_t)b * NE + e) * TK + s] = lg[e] / sm;
}
__global__ void __launch_bounds__(256) nv_topk(Params p, int need_ctx) {
  long i = GTID; if (i >= NB * NE * 2) return;
  int seg = (int)(i % 2), e = (int)((i / 2) % NE), b = (int)(i / (2 * NE));
  int s0 = seg ? TC : 0, n = seg ? TL : TC, cap = seg ? CAPL : CAPC, slot0 = seg ? b * CAPL : NB * CAPL + b * CAPC;
  if (seg == 0 && !need_ctx) { for (int q = 0; q < cap; ++q) p.SEL[(size_t)e * NSLOT + slot0 + q] = -1; return; }
  const float* a = p.AFF + ((size_t)b * NE + e) * TK + s0;
  unsigned thr = 0;
  for (int bit = 31; bit >= 0; --bit) {
    unsigned cand = thr | (1u << bit); int cnt = 0;
    for (int t = 0; t < n; ++t) cnt += (f2u(a[t]) >= cand);
    if (cnt >= cap) thr = cand;
  }
  int ngt = 0; for (int t = 0; t < n; ++t) ngt += (f2u(a[t]) > thr);
  int neq = cap - ngt, q = 0;
  for (int t = 0; t < n; ++t) {
    unsigned u = f2u(a[t]); int r = row_of(b, s0 + t); int sel = -1;
    if (u > thr) sel = q++; else if (u == thr && neq > 0) { sel = q++; --neq; }
    if (sel >= 0) { p.SEL[(size_t)e * NSLOT + slot0 + sel] = r; p.SELV[(size_t)e * NSLOT + slot0 + sel] = a[t]; }
    p.INV[(size_t)r * NE + e] = sel >= 0 ? slot0 + sel : -1;
  }
}
__global__ void __launch_bounds__(256) nv_moe1(Params p) {
  long i = GTID; if (i >= (long)NE * NSLOT * FF) return;
  int f = (int)(i % FF), slot = (int)((i / FF) % NSLOT), e = (int)(i / ((long)FF * NSLOT));
  int r = p.SEL[(size_t)e * NSLOT + slot];
  float out = 0.f;
  if (r >= 0) {
    const bf16_t* wg = p.Wt_eg + ((size_t)e * FF + f) * D; const bf16_t* wu = p.Wt_eu + ((size_t)e * FF + f) * D; const bf16_t* h = p.H + (size_t)r * D;
    float g = 0.f, u = 0.f; for (int k = 0; k < D; ++k) { float hv = bf2f(h[k]); g += hv * bf2f(wg[k]); u += hv * bf2f(wu[k]); }
    out = siluf_(g) * u;
  }
  p.HID[((size_t)e * NSLOT + slot) * FF + f] = f2bf(out);
}
__global__ void __launch_bounds__(256) nv_moe2(Params p) {
  long i = GTID; if (i >= (long)NE * NSLOT * D) return;
  int j = (int)(i % D), slot = (int)((i / D) % NSLOT), e = (int)(i / ((long)D * NSLOT));
  int r = p.SEL[(size_t)e * NSLOT + slot];
  float out = 0.f;
  if (r >= 0) {
    const bf16_t* wd = p.Wt_ed + ((size_t)e * D + j) * FF; const bf16_t* h = p.HID + ((size_t)e * NSLOT + slot) * FF;
    float a = 0.f; for (int k = 0; k < FF; ++k) a += bf2f(h[k]) * bf2f(wd[k]);
    out = a * p.SELV[(size_t)e * NSLOT + slot];
  }
  p.YE[((size_t)e * NSLOT + slot) * D + j] = f2bf(out);
}
__global__ void __launch_bounds__(256) nv_resid_ffn(Params p, int layer, int nrows) {
  long r = GTID; if (r >= nrows) return;
  int w = r < RL ? (int)(r / TL) : 2;
  const float* mb = p.mods + (size_t)(layer * 3 + w) * 6144;
  float* xo = r < RL ? p.out + (size_t)r * D : p.xc + (size_t)(r - RL) * D;
  float ss = 0.f;
  for (int k = 0; k < D; ++k) {
    float f = 0.f;
    for (int e = 0; e < NE; ++e) { int sl = p.INV[(size_t)r * NE + e]; if (sl >= 0) f += bf2f(p.YE[((size_t)e * NSLOT + sl) * D + k]); }
    ss += f * f;
  }
  float rstd = 1.0f / sqrtf(ss / D + 1e-6f);
  for (int k = 0; k < D; ++k) {
    float f = 0.f;
    for (int e = 0; e < NE; ++e) { int sl = p.INV[(size_t)r * NE + e]; if (sl >= 0) f += bf2f(p.YE[((size_t)e * NSLOT + sl) * D + k]); }
    xo[k] += mb[5 * 1024 + k] * f * rstd * p.g_ffn_post[layer * 1024 + k];
  }
}

__global__ void __launch_bounds__(256) nv_mods(Params p) { nvb_mods(GTID, p); }
__global__ void __launch_bounds__(256) nv_ml_gates(Params p, int layer) { nvb_ml_gates(GTID, p, layer); }
__global__ void __launch_bounds__(256) nv_gla_cum(Params p, int layer) { nvb_gla_cum(GTID, p, layer); }
__global__ void __launch_bounds__(256) nv_ml_local(Params p) { nvb_ml_local(GTID, p); }
__global__ void __launch_bounds__(256) nv_ml_scan(Params p) { nvb_ml_scan(GTID, p); }
__global__ void __launch_bounds__(256) nv_ml_out(Params p, int need_ctx) { nvb_ml_out(GTID, p, need_ctx); }
__global__ void __launch_bounds__(256) nv_ml_finish(Params p, int layer, int need_ctx) { nvb_ml_finish(GTID, p, layer, need_ctx); }
__global__ void __launch_bounds__(256) nv_gla_local(Params p) { nvb_gla_local(GTID, p); }
__global__ void __launch_bounds__(256) nv_gla_scan(Params p) { nvb_gla_scan(GTID, p); }
__global__ void __launch_bounds__(256) nv_gla_out(Params p, int need_ctx) { nvb_gla_out(GTID, p, need_ctx); }
__global__ void __launch_bounds__(256) nv_gla_finish(Params p, int layer, int need_ctx) { nvb_gla_finish(GTID, p, layer, need_ctx); }
constexpr int LROW = 144;
constexpr int A_BYTES = 128 * LROW;
constexpr int NTHR = 256;
#ifndef ATT_THR
#define ATT_THR 16.0f
#endif

DI int xcd_swz(int u, int nt) { return (nt & 7) ? u : (u & 7) * (nt >> 3) + (u >> 3); }
template <int GW> DI void grp_tile(int L, int ntm, int ntn, int& tm, int& tn) {
  const int gsz = ntm * GW; int g = 0;
  while (L >= gsz) { L -= gsz; ++g; }
  tm = L / GW; tn = g * GW + (L & (GW - 1)); (void)ntn;
}
DI u32x4 ldg16(const void* p) { return *(const u32x4*)p; }
DI void sts16(char* p, u32x4 v) { *(u32x4*)p = v; }
DI bf16x8 lds_frag(const char* p) { return *(const bf16x8*)p; }

template <int WN, int KFIX = 0>
DI void gemm_kloop(f32x4 (&acc)[4][WN], const bf16_t* const (&ap)[4], const bf16_t* const (&bp)[WN], int nk, char* lds) {
  constexpr int STAGE = A_BYTES + 32 * WN * LROW;
  const int t = TIDX, lane = t & 63, wid = t >> 6, wr = wid >> 1, wc = wid & 1;
  const int lr = t >> 3, lcb = (t & 7) * 16;
  const int fr = lane & 15, fq = lane >> 4;
  const int aoff = (wr * 64 + fr) * LROW + fq * 16, boff = A_BYTES + (wc * WN * 16 + fr) * LROW + fq * 16, soff = lr * LROW + lcb;
  u32x4 ra0[4], rb0[WN], ra1[4], rb1[WN];
  auto gload = [&](u32x4 (&ra)[4], u32x4 (&rb)[WN], int kt) {
#pragma unroll
    for (int i = 0; i < 4; ++i) ra[i] = ldg16(ap[i] + (KFIX ? (kt & 1) : kt) * 64);
#pragma unroll
    for (int i = 0; i < WN; ++i) rb[i] = ldg16(bp[i] + (KFIX ? (kt & 1) : kt) * 64);
  };
  auto sstore = [&](const u32x4 (&ra)[4], const u32x4 (&rb)[WN], char* st) {
#pragma unroll
    for (int i = 0; i < 4; ++i) sts16(st + soff + 32 * i * LROW, ra[i]);
#pragma unroll
    for (int i = 0; i < WN; ++i) sts16(st + A_BYTES + soff + 32 * i * LROW, rb[i]);
  };
  auto compute = [&](const char* cur) {
#pragma unroll
    for (int ks = 0; ks < 2; ++ks) {
      bf16x8 af[4], bfr[WN];
#pragma unroll
      for (int m = 0; m < 4; ++m) af[m] = lds_frag(cur + aoff + m * 16 * LROW + ks * 64);
#pragma unroll
      for (int n = 0; n < WN; ++n) bfr[n] = lds_frag(cur + boff + n * 16 * LROW + ks * 64);
#pragma unroll
      for (int m = 0; m < 4; ++m)
#pragma unroll
        for (int n = 0; n < WN; ++n) acc[m][n] = MFMA16(bfr[n], af[m], acc[m][n]);
    }
    IGLP_OPT();
  };
  gload(ra0, rb0, 0);
  gload(ra1, rb1, 1);
  sstore(ra0, rb0, lds);
  __syncthreads();
#pragma unroll 1
  for (int kt = 0; kt < nk; kt += 2) {
    if (kt + 2 < nk) gload(ra0, rb0, kt + 2);
    compute(lds);
    sstore(ra1, rb1, lds + STAGE);
    __syncthreads();
    if (kt + 3 < nk) gload(ra1, rb1, kt + 3);
    compute(lds + STAGE);
    if (kt + 2 < nk) sstore(ra0, rb0, lds);
    __syncthreads();
  }
}
template <int WN> DI void acc_zero(f32x4 (&acc)[4][WN]) {
#pragma unroll
  for (int m = 0; m < 4; ++m)
#pragma unroll
    for (int n = 0; n < WN; ++n) acc[m][n] = (f32x4){0.f, 0.f, 0.f, 0.f};
}
DI void st_bf16x4(bf16_t* p, f32x4 v) { u32x2 o; o.x = pack2bf(v.x, v.y); o.y = pack2bf(v.z, v.w); *(u32x2*)p = o; }

template <int WN, class RowOk>
DI void store_wave_tile(const f32x4 (&acc)[4][WN], bf16_t* C, size_t ldc, char* ldsw, int lane, RowOk row_ok) {
  constexpr int PITCH = WN * 32 + 16, CPR = WN * 2;
  const int fr = lane & 15, fq = lane >> 4;
#pragma unroll
  for (int m = 0; m < 4; ++m)
#pragma unroll
    for (int n = 0; n < WN; ++n) { u32x2 o; o.x = pack2bf(acc[m][n][0], acc[m][n][1]); o.y = pack2bf(acc[m][n][2], acc[m][n][3]); *(u32x2*)(ldsw + (m * 16 + fr) * PITCH + n * 32 + fq * 8) = o; }
  WAVE_SYNC();
  constexpr int RPP = 64 / CPR;
#pragma unroll
  for (int ps = 0; ps < 64 / RPP; ++ps) {
    const int r = ps * RPP + lane / CPR, c = lane % CPR;
    const u32x4 v = *(const u32x4*)(ldsw + r * PITCH + c * 16);
    if (row_ok(r)) *(u32x4*)(C + (size_t)r * ldc + c * 8) = v;
  }
  WAVE_SYNC();
}
template <int NOSTORE = 0>
DI void gemm_plain_tile(const bf16_t* A, int lda, const bf16_t* Bt, int ldb, int K, bf16_t* C, int ldc, int tm, int tn, char* lds) {
  const int t = TIDX, lane = t & 63, wid = t >> 6, wr = wid >> 1, wc = wid & 1, lr = t >> 3, lc = (t & 7) * 8, fr = lane & 15, fq = lane >> 4;
  const bf16_t* ap[4]; const bf16_t* bp[4];
#pragma unroll
  for (int i = 0; i < 4; ++i) { ap[i] = A + (size_t)(tm * 128 + lr + 32 * i) * lda + lc; bp[i] = Bt + (size_t)(tn * 128 + lr + 32 * i) * ldb + lc; }
  f32x4 acc[4][4]; acc_zero<4>(acc);
  gemm_kloop<4, NOSTORE == 2>(acc, ap, bp, K / 64, lds);
  if (NOSTORE) { float s = 0.f;
#pragma unroll
    for (int m = 0; m < 4; ++m)
#pragma unroll
      for (int n = 0; n < 4; ++n) s += acc[m][n][0] + acc[m][n][3];
    if (s == 123456.789f) C[0] = 1; return; }
  store_wave_tile<4>(acc, C + (size_t)(tm * 128 + wr * 64) * ldc + tn * 128 + wc * 64, (size_t)ldc, lds + wid * (64 * 144), lane, [](int) { return true; });
  __syncthreads();
}
template <int NOSTORE = 0>
DI void ph_gemm_plain(const bf16_t* A, int lda, const bf16_t* Bt, int ldb, int M, int N, int K, bf16_t* C, int ldc, char* lds, int bid, int nblk) {
  const int ntn = N / 128, nt = (M / 128) * ntn;
  for (int u = bid; u < nt; u += nblk) { int tm, tn; grp_tile<8>(xcd_swz(u, nt), M / 128, ntn, tm, tn); gemm_plain_tile<NOSTORE>(A, lda, Bt, ldb, K, C, ldc, tm, tn, lds); }
}
DI void ph_mla_up(const Params& p, int layer, bf16_t* QRAW, bf16_t* KVRAW, char* lds, int bid, int nblk) {
  const int ntq = (R / 128) * 3, ntkv = (R / 128) * 4;
  for (int tile = bid; tile < ntq + ntkv; tile += nblk) {
    if (tile < ntq) gemm_plain_tile(p.Z + ZC_QLAT, NZP, p.Wt_uq + layer * WSZ_UQ, 256, 256, QRAW, 384, tile / 3, tile % 3, lds);
    else { int u = tile - ntq; gemm_plain_tile(p.Z + ZC_KVLAT, NZP, p.Wt_ukv + layer * WSZ_UKV, 128, 128, KVRAW, 512, u / 4, u % 4, lds); }
  }
}
constexpr int LROW32 = 80;
template <int WM, int WN, bool DEEP>
DI void gemm_kloop_g(f32x4 (&acc)[WM][WN], const bf16_t* const (&ap)[WM / 2], const bf16_t* const (&bp)[WN / 2], int nk, char* lds) {
  constexpr int NA = WM / 2, NBB = WN / 2, A_B = 32 * WM * LROW32, STAGE = (32 * WM + 32 * WN) * LROW32;
  const int t = TIDX, lane = t & 63, wid = t >> 6, wr = wid >> 1, wc = wid & 1, fr = lane & 15, fq = lane >> 4;
  const int aoff = (wr * 16 * WM + fr) * LROW32 + fq * 16, boff = A_B + (wc * 16 * WN + fr) * LROW32 + fq * 16, soff = (t >> 2) * LROW32 + (t & 3) * 16;
  u32x4 ra0[NA], rb0[NBB], ra1[NA], rb1[NBB];
  auto gload = [&](u32x4 (&ra)[NA], u32x4 (&rb)[NBB], int kt) {
#pragma unroll
    for (int i = 0; i < NA; ++i) ra[i] = ldg16(ap[i] + kt * 32);
#pragma unroll
    for (int i = 0; i < NBB; ++i) rb[i] = ldg16(bp[i] + kt * 32);
  };
  auto sstore = [&](const u32x4 (&ra)[NA], const u32x4 (&rb)[NBB], char* st) {
#pragma unroll
    for (int i = 0; i < NA; ++i) sts16(st + soff + 64 * i * LROW32, ra[i]);
#pragma unroll
    for (int i = 0; i < NBB; ++i) sts16(st + A_B + soff + 64 * i * LROW32, rb[i]);
  };
  auto compute = [&](const char* cur) {
    bf16x8 af[WM];
#pragma unroll
    for (int m = 0; m < WM; ++m) af[m] = lds_frag(cur + aoff + m * 16 * LROW32);
#pragma unroll
    for (int n = 0; n < WN; ++n) {
      const bf16x8 bfr = lds_frag(cur + boff + n * 16 * LROW32);
#pragma unroll
      for (int m = 0; m < WM; ++m) acc[m][n] = MFMA16(bfr, af[m], acc[m][n]);
    }
    IGLP_OPT();
  };
  gload(ra0, rb0, 0);
  if (DEEP) gload(ra1, rb1, 1);
  sstore(ra0, rb0, lds);
  __syncthreads();
#pragma unroll 1
  for (int kt = 0; kt < nk; kt += 2) {
    if (DEEP) { if (kt + 2 < nk) gload(ra0, rb0, kt + 2); } else gload(ra1, rb1, kt + 1);
    compute(lds);
    sstore(ra1, rb1, lds + STAGE);
    __syncthreads();
    if (DEEP) { if (kt + 3 < nk) gload(ra1, rb1, kt + 3); } else if (kt + 2 < nk) gload(ra0, rb0, kt + 2);
    compute(lds + STAGE);
    if (kt + 2 < nk) sstore(ra0, rb0, lds);
    __syncthreads();
  }
}
template <int WM, int WN> DI void acc_zero_g(f32x4 (&acc)[WM][WN]) {
#pragma unroll
  for (int m = 0; m < WM; ++m)
#pragma unroll
    for (int n = 0; n < WN; ++n) acc[m][n] = (f32x4){0.f, 0.f, 0.f, 0.f};
}
DI void ph_merge(const Params& p, int layer, int rows, char* lds, int bid, int nblk) {
  const int t = TIDX, lane = t & 63, wid = t >> 6, wr = wid >> 1, wc = wid & 1, fr = lane & 15, fq = lane >> 4;
  const int lr = t >> 2, lc = (t & 3) * 8;
  const int ntn = D / 64, nt = (rows / 128) * ntn;
#pragma unroll 1
  for (int u = bid; u < nt; u += nblk) {
    int tm, tn; grp_tile<4>(xcd_swz(u, nt), rows / 128, ntn, tm, tn);
    f32x4 accS[4][2]; acc_zero_g<4, 2>(accS);
#pragma unroll 1
    for (int np = 0; np < 2; ++np) {
      f32x4 accG[4][4]; acc_zero_g<4, 4>(accG);
      {
        const bf16_t* ap[2]; const bf16_t* bp[2];
#pragma unroll
        for (int i = 0; i < 2; ++i) ap[i] = p.H + (size_t)(tm * 128 + lr + 64 * i) * D + lc;
#pragma unroll
        for (int i = 0; i < 2; ++i) { const int rho = lr + 64 * i, wci = rho >> 6, n = 2 * np + ((rho >> 5) & 1), c = rho & 31;
          bp[i] = p.Wt_gate + layer * WSZ_GATE + ((size_t)n * 1024 + tn * 64 + wci * 32 + c) * D + lc; }
        gemm_kloop_g<4, 4, true>(accG, ap, bp, D / 32, lds);
      }
#pragma unroll 1
      for (int q = 0; q < 2; ++q) {
        const int n = 2 * np + q;
        f32x4 accP[4][2]; acc_zero_g<4, 2>(accP);
        const bf16_t* ap[2]; const bf16_t* bp[1];
#pragma unroll
        for (int i = 0; i < 2; ++i) ap[i] = p.Y + (size_t)(tm * 128 + lr + 64 * i) * D + n * 256 + lc;
        bp[0] = p.Wt_branch + layer * WSZ_BR + ((size_t)n * D + tn * 64 + lr) * 256 + lc;
        gemm_kloop_g<4, 2, false>(accP, ap, bp, 8, lds);
#pragma unroll
        for (int nn = 0; nn < 2; ++nn) {
          const f32x4 bv = *(const f32x4*)(p.b_gate + layer * 4096 + n * 1024 + tn * 64 + wc * 32 + nn * 16 + 4 * fq);
#pragma unroll
          for (int m = 0; m < 4; ++m)
#pragma unroll
            for (int j = 0; j < 4; ++j) { const float g = q ? accG[m][2 + nn][j] : accG[m][nn][j]; accS[m][nn][j] += accP[m][nn][j] * fast_rcp(1.0f + fast_exp2(-LOG2E * (g + bv[j]))); }
        }
      }
    }
    store_wave_tile<2>(accS, p.MG + (size_t)(tm * 128 + wr * 64) * D + tn * 64 + wc * 32, (size_t)D, lds + wid * (64 * 80), lane, [](int) { return true; });
    __syncthreads();
  }
}
template <int WM>
DI void gemm_plain_tile_g(const bf16_t* A, int lda, const bf16_t* Bt, int ldb, int K, bf16_t* C, int ldc, int row0, int col0, char* lds) {
  const int t = TIDX, lane = t & 63, wid = t >> 6, wr = wid >> 1, wc = wid & 1, fr = lane & 15, fq = lane >> 4, lr = t >> 2, lc = (t & 3) * 8;
  const bf16_t* ap[WM / 2]; const bf16_t* bp[2];
#pragma unroll
  for (int i = 0; i < WM / 2; ++i) ap[i] = A + (size_t)(row0 + lr + 64 * i) * lda + lc;
#pragma unroll
  for (int i = 0; i < 2; ++i) bp[i] = Bt + (size_t)(col0 + lr + 64 * i) * ldb + lc;
  f32x4 acc[WM][4]; acc_zero_g<WM, 4>(acc);
  gemm_kloop_g<WM, 4, true>(acc, ap, bp, K / 32, lds);
#pragma unroll
  for (int m = 0; m < WM; ++m)
#pragma unroll
    for (int n = 0; n < 4; ++n)
      st_bf16x4(C + (size_t)(row0 + wr * 16 * WM + m * 16 + fr) * ldc + col0 + wc * 64 + n * 16 + 4 * fq, acc[m][n]);
}
DI void ph_gemm_plain2(const bf16_t* A, int lda, const bf16_t* Bt, int ldb, int M, int N, int K, bf16_t* C, int ldc, char* lds, int bid, int nblk) {
  const int ntn = N / 128, nt = (M / 256) * ntn, nfull = (nt / nblk) * nblk;
#pragma unroll 1
  for (int tile = bid; tile < nfull; tile += nblk) gemm_plain_tile_g<8>(A, lda, Bt, ldb, K, C, ldc, (tile / ntn) * 256, (tile % ntn) * 128, lds);
#pragma unroll 1
  for (int h = bid; h < 2 * (nt - nfull); h += nblk) { const int tile = nfull + (h >> 1); gemm_plain_tile_g<4>(A, lda, Bt, ldb, K, C, ldc, (tile / ntn) * 256 + (h & 1) * 128, (tile % ntn) * 128, lds); }
}
DI void gemm_kloop32(f32x16 (&acc)[2][2], const bf16_t* const (&ap)[4], const bf16_t* const (&bp)[4], int nk, char* lds) {
  constexpr int STAGE = A_BYTES + 128 * LROW;
  const int t = TIDX, lane = t & 63, wid = t >> 6, wr = wid >> 1, wc = wid & 1, l31 = lane & 31, hh = lane >> 5;
  const int aoff = (wr * 64 + l31) * LROW + hh * 16, boff = A_BYTES + (wc * 64 + l31) * LROW + hh * 16, soff = (t >> 3) * LROW + (t & 7) * 16;
  u32x4 ra0[4], rb0[4], ra1[4], rb1[4];
  auto gload = [&](u32x4 (&ra)[4], u32x4 (&rb)[4], int kt) {
#pragma unroll
    for (int i = 0; i < 4; ++i) { ra[i] = ldg16(ap[i] + kt * 64); rb[i] = ldg16(bp[i] + kt * 64); }
  };
  auto sstore = [&](const u32x4 (&ra)[4], const u32x4 (&rb)[4], char* st) {
#pragma unroll
    for (int i = 0; i < 4; ++i) { sts16(st + soff + 32 * i * LROW, ra[i]); sts16(st + A_BYTES + soff + 32 * i * LROW, rb[i]); }
  };
  auto compute = [&](const char* cur) {
#pragma unroll
    for (int ks = 0; ks < 4; ++ks) {
      bf16x8 af[2], bfr[2];
#pragma unroll
      for (int m = 0; m < 2; ++m) af[m] = lds_frag(cur + aoff + m * 32 * LROW + ks * 32);
#pragma unroll
      for (int n = 0; n < 2; ++n) bfr[n] = lds_frag(cur + boff + n * 32 * LROW + ks * 32);
#pragma unroll
      for (int m = 0; m < 2; ++m)
#pragma unroll
        for (int n = 0; n < 2; ++n) acc[m][n] = MFMA32(bfr[n], af[m], acc[m][n]);
    }
  };
  gload(ra0, rb0, 0); gload(ra1, rb1, 1);
  sstore(ra0, rb0, lds);
  __syncthreads();
#pragma unroll 1
  for (int kt = 0; kt < nk; kt += 2) {
    if (kt + 2 < nk) gload(ra0, rb0, kt + 2);
    compute(lds);
    sstore(ra1, rb1, lds + STAGE);
    __syncthreads();
    if (kt + 3 < nk) gload(ra1, rb1, kt + 3);
    compute(lds + STAGE);
    if (kt + 2 < nk) sstore(ra0, rb0, lds);
    __syncthreads();
  }
}
DI void ph_gemm_plain32(const bf16_t* A, int lda, const bf16_t* Bt, int ldb, int M, int N, int K, bf16_t* C, int ldc, char* lds, int bid, int nblk) {
  const int t = TIDX, lane = t & 63, wid = t >> 6, wr = wid >> 1, wc = wid & 1, lr = t >> 3, lc = (t & 7) * 8, l31 = lane & 31, hh = lane >> 5;
  const int ntn = N / 128, nt = (M / 128) * ntn;
#pragma unroll 1
  for (int tile = bid; tile < nt; tile += nblk) {
    const int tm = tile / ntn, tn = tile % ntn;
    const bf16_t* ap[4]; const bf16_t* bp[4];
#pragma unroll
    for (int i = 0; i < 4; ++i) { ap[i] = A + (size_t)(tm * 128 + lr + 32 * i) * lda + lc; bp[i] = Bt + (size_t)(tn * 128 + lr + 32 * i) * ldb + lc; }
    f32x16 acc[2][2];
#pragma unroll
    for (int m = 0; m < 2; ++m)
#pragma unroll
      for (int n = 0; n < 2; ++n) acc[m][n] = (f32x16)(0.f);
    gemm_kloop32(acc, ap, bp, K / 64, lds);
#pragma unroll
    for (int m = 0; m < 2; ++m)
#pragma unroll
      for (int n = 0; n < 2; ++n)
#pragma unroll
        for (int g = 0; g < 4; ++g) {
          f32x4 o = {acc[m][n][4 * g], acc[m][n][4 * g + 1], acc[m][n][4 * g + 2], acc[m][n][4 * g + 3]};
          st_bf16x4(C + (size_t)(tm * 128 + wr * 64 + m * 32 + l31) * ldc + tn * 128 + wc * 64 + n * 32 + 8 * g + 4 * hh, o);
        }
  }
}
template <int MODE>
DI void ph_gemm_probe(const bf16_t* A, int lda, const bf16_t* Bt, int ldb, int M, int N, int K, float* sink, char* lds, int bid, int nblk) {
  const int t = TIDX, lane = t & 63, wid = t >> 6, wr = wid >> 1, wc = wid & 1, lr = t >> 3, lc = (t & 7) * 8, fr = lane & 15, fq = lane >> 4;
  const int ntn = N / 128, nt = (M / 128) * ntn, nk = K / 64;
  constexpr int STAGE = A_BYTES + 128 * LROW;
  const int aoff = (wr * 64 + fr) * LROW + fq * 16, boff = A_BYTES + (wc * 64 + fr) * LROW + fq * 16;
#pragma unroll 1
  for (int tile = bid; tile < nt; tile += nblk) {
    f32x4 acc[4][4]; acc_zero<4>(acc);
    bf16x8 af[4], bfr[4];
    const int tm = tile / ntn, tn = tile % ntn;
    const bf16_t* ap[4]; const bf16_t* bp[4];
#pragma unroll
    for (int i = 0; i < 4; ++i) { ap[i] = A + (size_t)(tm * 128 + lr + 32 * i) * lda + lc; bp[i] = Bt + (size_t)(tn * 128 + lr + 32 * i) * ldb + lc; }
    u32x4 ra[4], rb[4], junk = {0u, 0u, 0u, 0u};
#pragma unroll
    for (int i = 0; i < 4; ++i) { ra[i] = junk; rb[i] = junk; }
#pragma unroll 1
    for (int kt = 0; kt < nk; ++kt) {
      const char* cur = lds + (kt & 1) * STAGE;
#pragma unroll
      for (int i = 0; i < 4; ++i) { ra[i] = ldg16(ap[i] + kt * 64); if (MODE == 3) rb[i] = ldg16(bp[i] + kt * 64); }
#pragma unroll
      for (int ks = 0; ks < 2; ++ks) {
#pragma unroll
        for (int m = 0; m < 4; ++m) { af[m] = lds_frag(cur + aoff + m * 16 * LROW + ks * 64); bfr[m] = lds_frag(cur + boff + m * 16 * LROW + ks * 64); }
#pragma unroll
        for (int m = 0; m < 4; ++m)
#pragma unroll
          for (int n = 0; n < 4; ++n) acc[m][n] = MFMA16(bfr[n], af[m], acc[m][n]);
      }
      junk.x ^= ra[0].x ^ ra[1].y ^ ra[2].z ^ ra[3].w ^ rb[0].x ^ rb[1].y ^ rb[2].z ^ rb[3].w;
      __syncthreads();
    }
    float s = (float)(junk.x & 1u);
#pragma unroll
    for (int m = 0; m < 4; ++m)
#pragma unroll
      for (int n = 0; n < 4; ++n) s += acc[m][n][0] + acc[m][n][3];
    if (s == 123456.789f) sink[0] = s;
  }
}
DI void ph_moe1(const Params& p, int need_ctx, char* lds, int bid, int nblk) {
  const int t = TIDX, lane = t & 63, wid = t >> 6, wr = wid >> 1, wc = wid & 1, lr = t >> 3, lc = (t & 7) * 8, fr = lane & 15, fq = lane >> 4;
  constexpr int NTN = FF / 64;
  const int NTM = need_ctx ? (NSLOT + 127) / 128 : (NB * CAPL) / 128;
  for (int u = bid; u < NE * NTM * NTN; u += nblk) {
    const int tile = xcd_swz(u, NE * NTM * NTN), e = tile / (NTM * NTN), rem = tile % (NTM * NTN);
    int tm, tn, rr = rem, g = 0;
    if (rr >= NTM * 8) { rr -= NTM * 8; g = 1; }
    if (rr >= NTM * 8) { rr -= NTM * 8; g = 2; }
    if (g < 2) { tm = rr >> 3; tn = g * 8 + (rr & 7); } else { tm = rr / (NTN - 16); tn = 16 + rr - tm * (NTN - 16); }
    const bf16_t* ap[4]; const bf16_t* bp[4];
#pragma unroll
    for (int i = 0; i < 4; ++i) {
      const int slot = tm * 128 + lr + 32 * i;
      int r = slot < NSLOT ? p.SEL[(size_t)e * NSLOT + slot] : -1;
      ap[i] = p.H + (size_t)(r < 0 ? 0 : r) * D + lc;
      const int rho = lr + 32 * i, wci = rho >> 6, gu = (rho >> 5) & 1, col = wci * 32 + (rho & 31);
      bp[i] = (gu ? p.Wt_eu : p.Wt_eg) + ((size_t)e * FF + tn * 64 + col) * D + lc;
    }
    f32x4 acc[4][4]; acc_zero<4>(acc);
    gemm_kloop<4>(acc, ap, bp, D / 64, lds);
    f32x4 hid[4][2];
#pragma unroll
    for (int m = 0; m < 4; ++m) {
      const int slot = tm * 128 + wr * 64 + m * 16 + fr;
      const bool valid = slot < NSLOT && p.SEL[(size_t)e * NSLOT + (slot < NSLOT ? slot : 0)] >= 0;
#pragma unroll
      for (int n = 0; n < 2; ++n)
#pragma unroll
        for (int j = 0; j < 4; ++j) { const float g = acc[m][n][j], u = acc[m][n + 2][j]; hid[m][n][j] = valid ? g * u * fast_rcp(1.0f + fast_exp2(-LOG2E * g)) : 0.f; }
    }
    const int slot0 = tm * 128 + wr * 64;
    store_wave_tile<2>(hid, p.HID + ((size_t)e * NSLOT + slot0) * FF + tn * 64 + wc * 32, (size_t)FF, lds + wid * (64 * 80), lane, [&](int r) { return slot0 + r < NSLOT; });
    __syncthreads();
  }
}
DI void ph_moe2(const Params& p, int need_ctx, char* lds, int bid, int nblk) {
  const int t = TIDX, lane = t & 63, wid = t >> 6, wr = wid >> 1, wc = wid & 1, lr = t >> 3, lc = (t & 7) * 8, fr = lane & 15, fq = lane >> 4;
  constexpr int NTN = D / 128;
  const int NTM = need_ctx ? (NSLOT + 127) / 128 : (NB * CAPL) / 128;
  for (int u = bid; u < NE * NTM * NTN; u += nblk) {
    const int tile = xcd_swz(u, NE * NTM * NTN), e = tile / (NTM * NTN), rem = tile % (NTM * NTN), tm = rem / NTN, tn = rem % NTN;
    const bf16_t* ap[4]; const bf16_t* bp[4];
#pragma unroll
    for (int i = 0; i < 4; ++i) {
      int slot = tm * 128 + lr + 32 * i; if (slot >= NSLOT) slot = NSLOT - 1;
      ap[i] = p.HID + ((size_t)e * NSLOT + slot) * FF + lc;
      bp[i] = p.Wt_ed + ((size_t)e * D + tn * 128 + lr + 32 * i) * FF + lc;
    }
    f32x4 acc[4][4]; acc_zero<4>(acc);
    gemm_kloop<4>(acc, ap, bp, FF / 64, lds);
#pragma unroll
    for (int m = 0; m < 4; ++m) {
      const int slot = tm * 128 + wr * 64 + m * 16 + fr;
      const float val = (slot < NSLOT && p.SEL[(size_t)e * NSLOT + (slot < NSLOT ? slot : 0)] >= 0) ? p.SELV[(size_t)e * NSLOT + slot] : 0.f;
#pragma unroll
      for (int n = 0; n < 4; ++n) { acc[m][n].x *= val; acc[m][n].y *= val; acc[m][n].z *= val; acc[m][n].w *= val; }
    }
    const int slot0 = tm * 128 + wr * 64;
    store_wave_tile<4>(acc, p.YE + ((size_t)e * NSLOT + slot0) * D + tn * 128 + wc * 64, (size_t)D, lds + wid * (64 * 144), lane, [&](int r) { return slot0 + r < NSLOT; });
    __syncthreads();
  }
}
constexpr int GEMM_LDS = 2 * (A_BYTES + 128 * LROW);

DI void unpack8(u32x4 v, float (&f)[8]) {
  f[0] = u2f(v.x << 16); f[1] = u2f(v.x & 0xffff0000u); f[2] = u2f(v.y << 16); f[3] = u2f(v.y & 0xffff0000u);
  f[4] = u2f(v.z << 16); f[5] = u2f(v.z & 0xffff0000u); f[6] = u2f(v.w << 16); f[7] = u2f(v.w & 0xffff0000u);
}
DI u32x4 pack8f(const float (&f)[8]) { u32x4 v; v.x = pack2bf(f[0], f[1]); v.y = pack2bf(f[2], f[3]); v.z = pack2bf(f[4], f[5]); v.w = pack2bf(f[6], f[7]); return v; }
DI void rope8(float (&a)[8], const float (&pr)[8], int cc, const float* cs, const float* sn) {
  const int ax = (cc >> 1) * 8; const bool second = cc & 1;
#pragma unroll
  for (int i = 0; i < 8; ++i) a[i] = second ? a[i] * cs[ax + i] + pr[i] * sn[ax + i] : a[i] * cs[ax + i] - pr[i] * sn[ax + i];
}
constexpr int PREP_LDS = 64 * 4 + 2 * 512 * 4 + 32 * 528;
template <int PARTS = 3>
DI void ph_prep(const Params& p, int layer, const bf16_t* QRAW, const bf16_t* KVRAW, char* lds, int bid, int nblk) {
  float* s_rstd = (float*)lds;
  float* s_cs = s_rstd + 64;
  float* s_sn = s_cs + 512;
  bf16_t* s_t = (bf16_t*)(s_sn + 512);
  const int t = TIDX;
  constexpr int UPB = TK / 32, NU = NB * UPB;
  const float* wcv = p.w_conv + (size_t)layer * 3 * 512;
#pragma unroll 1
  for (int u = bid; u < NU; u += nblk) {
    int b, s0;
    if (u < NB * (TL / 32)) { b = u / (TL / 32); s0 = TC + (u % (TL / 32)) * 32; } else { const int v = u - NB * (TL / 32); b = v / (TC / 32); s0 = (v % (TC / 32)) * 32; }
    const int r0 = row_of(b, s0);
    {
      const int tok = t >> 3, part = t & 7;
      const bf16_t* z = p.Z + (size_t)(r0 + tok) * NZP;
      float sq = 0.f, sk = 0.f, f[8];
#pragma unroll
      for (int k = 0; k < 4; ++k) { unpack8(ldg16(z + ZC_QLAT + part * 32 + k * 8), f);
#pragma unroll
        for (int i = 0; i < 8; ++i) sq += f[i] * f[i]; }
#pragma unroll
      for (int k = 0; k < 2; ++k) { unpack8(ldg16(z + ZC_KVLAT + part * 16 + k * 8), f);
#pragma unroll
        for (int i = 0; i < 8; ++i) sk += f[i] * f[i]; }
      sq = xor_sum<1>(sq); sk = xor_sum<1>(sk);
      sq = xor_sum<2>(sq); sk = xor_sum<2>(sk);
      sq = xor_sum<4>(sq); sk = xor_sum<4>(sk);
      if (part == 0) { s_rstd[tok * 2] = 1.0f / sqrtf(sq * (1.0f / 256) + 1e-6f); s_rstd[tok * 2 + 1] = 1.0f / sqrtf(sk * (1.0f / 128) + 1e-6f); }
    }
    for (int i = t; i < 512; i += NTHR) {
      const int tok = i >> 4, af = i & 15, s = s0 + tok;
      float cs = 1.f, sn = 0.f;
      if (s >= TC) rope_cs(s, (af >> 3) * 16 + (af & 7), cs, sn);
      s_cs[i] = cs; s_sn[i] = sn;
    }
    __syncthreads();
    if (PARTS & 1) {
#pragma unroll 2
    for (int i = t; i < 32 * 48; i += NTHR) {
      const int tok = i / 48, c = i % 48, h = c / 12, ch = c % 12;
      const float rq = s_rstd[tok * 2] * QS_MLA, rkv = s_rstd[tok * 2 + 1];
      const bf16_t* q = QRAW + (size_t)(r0 + tok) * 384 + h * 96;
      float a[8], pr[8];
      unpack8(ldg16(q + ch * 8), a);
      if (ch >= 8) { unpack8(ldg16(q + 64 + ((ch - 8) ^ 1) * 8), pr); rope8(a, pr, ch - 8, s_cs + tok * 16, s_sn + tok * 16); }
#pragma unroll
      for (int e = 0; e < 8; ++e) a[e] *= rq;
      *(u32x4*)(p.Qm + (((size_t)b * 4 + h) * TK + s0 + tok) * 96 + ch * 8) = pack8f(a);
      if (ch < 8) {
        unpack8(ldg16(KVRAW + (size_t)(r0 + tok) * 512 + h * 128 + ch * 8), a);
#pragma unroll
        for (int e = 0; e < 8; ++e) a[e] *= rkv;
      } else {
        const bf16_t* z = p.Z + (size_t)(r0 + tok) * NZP + ZC_KROPE;
        unpack8(ldg16(z + (ch - 8) * 8), a); unpack8(ldg16(z + ((ch - 8) ^ 1) * 8), pr);
        rope8(a, pr, ch - 8, s_cs + tok * 16, s_sn + tok * 16);
      }
      *(u32x4*)(p.Km + (((size_t)b * 4 + h) * TK + s0 + tok) * 96 + ch * 8) = pack8f(a);
    }
#pragma unroll 2
    for (int i = t; i < 32 * 64; i += NTHR) {
      const int tok = i >> 6, c = i & 63, qk = c >> 5, hm = (c >> 2) & 7, cc = c & 3;
      const bf16_t* src = p.Z + (size_t)(r0 + tok) * NZP + (qk ? ZC_DK : ZC_DQ) + hm * 32;
      float a[8], pr[8];
      unpack8(ldg16(src + cc * 8), a); unpack8(ldg16(src + (cc ^ 1) * 8), pr);
      rope8(a, pr, cc, s_cs + tok * 16, s_sn + tok * 16);
      if (qk == 0) {
#pragma unroll
        for (int e = 0; e < 8; ++e) a[e] *= QS_DIFF;
        *(u32x4*)(p.Qd + (((size_t)b * 8 + hm) * TK + s0 + tok) * 32 + cc * 8) = pack8f(a);
      } else *(u32x4*)(p.Kd + (((size_t)b * 8 + hm) * TK + s0 + tok) * 32 + cc * 8) = pack8f(a);
    }
#pragma unroll 2
    for (int i = t; i < 32 * 64; i += NTHR) {
      const int tok = i >> 6, c8 = (i & 63) * 8, s = s0 + tok;
      const bool first = (s == 0) || (s == TC), last = (s == TC - 1) || (s == TK - 1);
      const bf16_t* z = p.Z + (size_t)(r0 + tok) * NZP + ZC_MLQK + c8;
      float x0[8], xm[8], xp[8], o[8];
      unpack8(ldg16(z), x0);
      if (!first) unpack8(ldg16(z - NZP), xm);
      if (!last) unpack8(ldg16(z + NZP), xp);
      float bc8[8], w0[8], w1[8], w2[8];
      *(f32x4*)bc8 = *(const f32x4*)(p.b_conv + layer * 512 + c8); *(f32x4*)(bc8 + 4) = *(const f32x4*)(p.b_conv + layer * 512 + c8 + 4);
      *(f32x4*)w0 = *(const f32x4*)(wcv + c8); *(f32x4*)(w0 + 4) = *(const f32x4*)(wcv + c8 + 4);
      *(f32x4*)w1 = *(const f32x4*)(wcv + 512 + c8); *(f32x4*)(w1 + 4) = *(const f32x4*)(wcv + 512 + c8 + 4);
      *(f32x4*)w2 = *(const f32x4*)(wcv + 1024 + c8); *(f32x4*)(w2 + 4) = *(const f32x4*)(wcv + 1024 + c8 + 4);
#pragma unroll
      for (int e = 0; e < 8; ++e) {
        float acc = bc8[e] + x0[e] * w1[e];
        if (!first) acc += xm[e] * w0[e];
        if (!last) acc += xp[e] * w2[e];
        o[e] = acc * fast_rcp(1.0f + fast_exp2(-LOG2E * acc));
      }
      if (c8 < 256) *(u32x4*)(p.MQ + ((size_t)b * TK + s) * 256 + c8) = pack8f(o);
      else {
#pragma unroll
        for (int e = 0; e < 8; ++e) o[e] *= 0.125f;
        *(u32x4*)(p.MK + ((size_t)b * TK + s) * 256 + c8 - 256) = pack8f(o);
      }
    }
    }
#pragma unroll 1
    for (int w = 0; w < ((PARTS & 2) ? 4 : 0); ++w) {
      __syncthreads();
#pragma unroll
      for (int k = 0; k < 4; ++k) {
        const int i = t + k * NTHR, tok = i >> 5, c8 = (i & 31) * 8;
        u32x4 v;
        if (w == 0) { float a[8]; const int h = c8 >> 6; unpack8(ldg16(KVRAW + (size_t)(r0 + tok) * 512 + h * 128 + 64 + (c8 & 63)), a); const float rkv = s_rstd[tok * 2 + 1];
#pragma unroll
          for (int e = 0; e < 8; ++e) a[e] *= rkv;
          v = pack8f(a); }
        else v = ldg16(p.Z + (size_t)(r0 + tok) * NZP + (w == 1 ? ZC_DV : (w == 2 ? ZC_MLV : ZC_GV)) + c8);
        *(u32x4*)(s_t + tok * 264 + c8) = v;
      }
      __syncthreads();
      bf16_t* dst = w == 0 ? p.Vtm : (w == 1 ? p.Vtd : (w == 2 ? p.MVt : p.GVt));
#pragma unroll
      for (int k = 0; k < 4; ++k) {
        const int i = t + k * NTHR, tg = i & 3, ch = i >> 2;
        u32x4 v;
        v.x = (unsigned)s_t[(tg * 8 + 0) * 264 + ch] | ((unsigned)s_t[(tg * 8 + 1) * 264 + ch] << 16);
        v.y = (unsigned)s_t[(tg * 8 + 2) * 264 + ch] | ((unsigned)s_t[(tg * 8 + 3) * 264 + ch] << 16);
        v.z = (unsigned)s_t[(tg * 8 + 4) * 264 + ch] | ((unsigned)s_t[(tg * 8 + 5) * 264 + ch] << 16);
        v.w = (unsigned)s_t[(tg * 8 + 6) * 264 + ch] | ((unsigned)s_t[(tg * 8 + 7) * 264 + ch] << 16);
        *(u32x4*)(dst + (((size_t)b * 4 + (ch >> 6)) * 64 + (ch & 63)) * TK + s0 + tg * 8) = v;
      }
    }
    __syncthreads();
  }
}
constexpr int VROW = 136;
constexpr int VROW_A = 144;
template <int DQK> struct AttnCfg {
  static constexpr int KROW = DQK * 2 + 16;
  static constexpr int KBYTES = 64 * KROW, VBYTES = 64 * VROW_A, STAGE = KBYTES + VBYTES;
  static constexpr int KCH = 64 * DQK * 2 / 16 / NTHR;
};
DI bf16x8 pack8(const f32x16& x, int s) {
  u32x4 pk; pk.x = pack2bf(x[8 * s], x[8 * s + 1]); pk.y = pack2bf(x[8 * s + 2], x[8 * s + 3]); pk.z = pack2bf(x[8 * s + 4], x[8 * s + 5]); pk.w = pack2bf(x[8 * s + 6], x[8 * s + 7]);
  return __builtin_bit_cast(bf16x8, pk);
}
struct TrueC { static constexpr bool value = true; };
struct FalseC { static constexpr bool value = false; };
template <int DQK, int NMAP, int VAR = 0>
DI void attn_unit(const bf16_t* __restrict__ Qb, const bf16_t* __restrict__ Kb, size_t mstride, const bf16_t* __restrict__ Vt, int q0, int nkeys,
                  f32x16 (&O)[NMAP][2], float (&lsum)[NMAP], char* lds) {
  constexpr int DM = DQK / NMAP;
  constexpr int KS = DM / 16;
  using C = AttnCfg<DQK>;
  constexpr int CPM = 64 * DM * 2 / 16;
  constexpr int CPR = DM * 2 / 16;
  const int t = TIDX, lane = t & 63, wid = t >> 6, l31 = lane & 31, hh = lane >> 5;
  bf16x8 qf[NMAP][KS];
#pragma unroll
  for (int m = 0; m < NMAP; ++m)
#pragma unroll
    for (int ks = 0; ks < KS; ++ks) qf[m][ks] = *(const bf16x8*)(Qb + m * mstride + (size_t)(q0 + wid * 32 + l31) * DM + ks * 16 + 8 * hh);
  float mref[NMAP];
  f32x4 lacc[NMAP];
  const short onev = ((lane & 15) < 2 && ((lane >> 4) & 1) == (lane & 15)) ? (short)0x3F80 : (short)0;
  const bf16x8 ones_a = {onev, onev, onev, onev, onev, onev, onev, onev};
#pragma unroll
  for (int m = 0; m < NMAP; ++m) { mref[m] = 0.f; lacc[m] = (f32x4){0.f, 0.f, 0.f, 0.f}; O[m][0] = (f32x16)(0.f); O[m][1] = (f32x16)(0.f); }
  u32x4 rk[C::KCH], rv[2];
  const bf16_t* kg[C::KCH]; int klds[C::KCH];
#pragma unroll
  for (int i = 0; i < C::KCH; ++i) { const int c = t + i * NTHR, m = c / CPM, cc = c % CPM; kg[i] = Kb + m * mstride + cc * 8; klds[i] = (cc / CPR) * C::KROW + m * DM * 2 + (cc % CPR) * 16; }
  const bf16_t* vg = Vt + (size_t)(t >> 3) * TK + (t & 7) * 8;
  const int vlds = C::KBYTES + (t >> 3) * VROW_A + ((t & 7) >> 1) * 32 + ((t & 1) ? 8 : 0);
  const int kfoff = l31 * C::KROW + 16 * hh, vfoff = C::KBYTES + l31 * VROW_A + 16 * hh;
  const int nt = nkeys / 64;
#pragma unroll
  for (int i = 0; i < C::KCH; ++i) rk[i] = ldg16(kg[i]);
  rv[0] = ldg16(vg); rv[1] = ldg16(vg + (size_t)32 * TK);
  auto tile = [&](const int kt, auto chk_c, auto ref_c) __attribute__((always_inline)) {
    constexpr bool CHK = decltype(chk_c)::value, REF = decltype(ref_c)::value;
    char* cur = lds + (kt & 1) * C::STAGE;
    if (VAR != 2) {
#pragma unroll
    for (int i = 0; i < C::KCH; ++i) sts16(cur + klds[i], rk[i]);
#pragma unroll
    for (int i = 0; i < 2; ++i) { char* d = cur + vlds + i * 32 * VROW_A; u32x2 lo, hi; lo.x = rv[i].x; lo.y = rv[i].y; hi.x = rv[i].z; hi.y = rv[i].w; *(u32x2*)d = lo; *(u32x2*)(d + 16) = hi; }
    __syncthreads();
    }
    if (VAR != 2 && kt + 1 < nt) {
      const int kn = VAR == 3 ? ((kt + 1) & 1) : kt + 1;
#pragma unroll
      for (int i = 0; i < C::KCH; ++i) rk[i] = ldg16(kg[i] + (size_t)kn * 64 * DM);
      rv[0] = ldg16(vg + kn * 64); rv[1] = ldg16(vg + (size_t)32 * TK + kn * 64);
    }
    bf16x8 kf[NMAP][2][KS];
#pragma unroll
    for (int k2 = 0; k2 < 2; ++k2)
#pragma unroll
      for (int ks = 0; ks < KS; ++ks) kf[0][k2][ks] = lds_frag(cur + kfoff + k2 * 32 * C::KROW + ks * 32);
    f32x16 S[NMAP][2];
    S[0][0] = (f32x16)(0.f); S[0][1] = (f32x16)(0.f);
#pragma unroll
    for (int ks = 0; ks < KS; ++ks)
#pragma unroll
      for (int k2 = 0; k2 < 2; ++k2) S[0][k2] = MFMA32(kf[0][k2][ks], qf[0][ks], S[0][k2]);
    bf16x8 vf[4][2];
#pragma unroll
    for (int kst = 0; kst < 4; ++kst)
#pragma unroll
      for (int dvt = 0; dvt < 2; ++dvt) vf[kst][dvt] = lds_frag(cur + vfoff + dvt * 32 * VROW_A + kst * 32);
#pragma unroll
    for (int m = 1; m < NMAP; ++m)
#pragma unroll
      for (int k2 = 0; k2 < 2; ++k2)
#pragma unroll
        for (int ks = 0; ks < KS; ++ks) kf[m][k2][ks] = lds_frag(cur + kfoff + k2 * 32 * C::KROW + m * DM * 2 + ks * 32);
#pragma unroll
    for (int m = 0; m < NMAP; ++m) {
      if (m > 0) {
        SCHED_BARRIER();
        S[m][0] = (f32x16)(0.f); S[m][1] = (f32x16)(0.f);
#pragma unroll
        for (int ks = 0; ks < KS; ++ks)
#pragma unroll
          for (int k2 = 0; k2 < 2; ++k2) S[m][k2] = MFMA32(kf[m][k2][ks], qf[m][ks], S[m][k2]);
      }
      if (VAR != 1) {
      if (CHK && (kt & 7) == 0) {
        float mx = fmaxf(S[m][0][0], S[m][1][0]);
#pragma unroll
        for (int i = 1; i < 16; ++i) mx = fmaxf(mx, fmaxf(S[m][0][i], S[m][1][i]));
        mx = xor_max<32>(mx);
        const float rel = mx - mref[m];
        const float delta = (kt == 0) ? ((mx > ATT_THR || mx < -ATT_THR) ? mx : 0.0f) : (rel > ATT_THR ? rel : 0.0f);
        if (wave_any(delta != 0.0f)) {
          const float alpha = fast_exp2(-delta);
          mref[m] += delta; lacc[m][0] *= alpha; lacc[m][1] *= lane_get(alpha, (lane & 15) + 16);
#pragma unroll
          for (int dvt = 0; dvt < 2; ++dvt)
#pragma unroll
            for (int i = 0; i < 16; ++i) O[m][dvt][i] *= alpha;
        }
      }
      if constexpr (REF) {
        if (wave_any(mref[m] != 0.0f)) {
          const f32x2 nm = {-mref[m], -mref[m]};
#pragma unroll
          for (int k2 = 0; k2 < 2; ++k2)
#pragma unroll
            for (int i = 0; i < 16; i += 2) { const f32x2 x = (f32x2){S[m][k2][i], S[m][k2][i + 1]} + nm; S[m][k2][i] = x.x; S[m][k2][i + 1] = x.y; }
        }
      }
#pragma unroll
      for (int k2 = 0; k2 < 2; ++k2)
#pragma unroll
        for (int i = 0; i < 16; ++i) S[m][k2][i] = fast_exp2(S[m][k2][i]);
      }
#pragma unroll
      for (int kst = 0; kst < 4; ++kst) {
        const bf16x8 pf = pack8(S[m][kst >> 1], kst & 1);
#pragma unroll
        for (int dvt = 0; dvt < 2; ++dvt) O[m][dvt] = MFMA32(vf[kst][dvt], pf, O[m][dvt]);
        lacc[m] = MFMA16(ones_a, pf, lacc[m]);
      }
    }
  };
  int kt = 0;
#pragma unroll 1
  while (kt < nt) {
    tile(kt, TrueC{}, TrueC{});
    ++kt;
    bool nz = false;
#pragma unroll
    for (int m = 0; m < NMAP; ++m) nz = nz || (mref[m] != 0.0f);
    if (!wave_any(nz)) {
      const int k8 = (kt + 7) & ~7, kend = k8 < nt ? k8 : nt;
#pragma unroll 1
      for (; kt < kend; ++kt) tile(kt, FalseC{}, FalseC{});
    }
  }
  __syncthreads();
#pragma unroll
  for (int m = 0; m < NMAP; ++m) { const float a0 = lane_get(lacc[m][0], lane & 15), a1 = lane_get(lacc[m][1], lane & 15); lsum[m] = l31 < 16 ? a0 : a1; }
}
constexpr int ATT_QB = TK / 128;
constexpr int ATT_LDS = 2 * AttnCfg<96>::STAGE;
constexpr int ATT_QBL = TL / 128, ATT_QBC = TC / 128, ATT_LAT_UNITS = NB * 4 * ATT_QBL, ATT_UNITS = ATT_LAT_UNITS + NB * 4 * ATT_QBC;
DI void att_unit(int u, int& bh, int& qb) {
  if (u < ATT_LAT_UNITS) { bh = u & 7; qb = ATT_QBC + (u >> 3); } else { const int v = u - ATT_LAT_UNITS; bh = v & 7; qb = v >> 3; }
}
DI void ph_attn_diff(const Params& p, int layer, int need_ctx, char* lds, int bid, int nblk) {
  const int lane = TIDX & 63, wid = TIDX >> 6, l31 = lane & 31, hh = lane >> 5;
  float lam_init; const float lam = lam_of(p, layer, lam_init);
#pragma unroll 1
  for (int u = bid; u < (need_ctx ? ATT_UNITS : ATT_LAT_UNITS); u += nblk) {
    int bh, qb; att_unit(u, bh, qb);
    const int b = bh >> 2, h = bh & 3, q0 = qb * 128;
    const int r = row_of(b, q0 + wid * 32 + l31);
    f32x16 O[2][2]; float ls[2];
    attn_unit<64, 2>(p.Qd + ((size_t)b * 8 + h * 2) * TK * 32, p.Kd + ((size_t)b * 8 + h * 2) * TK * 32, (size_t)TK * 32, p.Vtd + ((size_t)b * 4 + h) * 64 * TK, q0,
                     q0 < TC ? TC : TK, O, ls, lds);
    const float i0 = 1.0f / ls[0], i1 = lam / ls[1];
    float ss = 0.f;
#pragma unroll
    for (int dvt = 0; dvt < 2; ++dvt)
#pragma unroll
      for (int i = 0; i < 16; ++i) { const float o = O[0][dvt][i] * i0 - O[1][dvt][i] * i1; O[0][dvt][i] = o; ss += o * o; }
    ss = xor_sum<32>(ss);
    const float rstd = (1.0f - lam_init) / sqrtf(ss * (1.0f / 64) + 1e-6f);
    const float* gd = p.g_diff_out + layer * 256 + h * 64;
#pragma unroll
    for (int dvt = 0; dvt < 2; ++dvt)
#pragma unroll
      for (int g = 0; g < 4; ++g) {
        const int dv = dvt * 32 + 8 * g + 4 * hh;
        const f32x4 gv = *(const f32x4*)(gd + dv);
        f32x4 o = {O[0][dvt][4 * g] * rstd * gv[0], O[0][dvt][4 * g + 1] * rstd * gv[1], O[0][dvt][4 * g + 2] * rstd * gv[2], O[0][dvt][4 * g + 3] * rstd * gv[3]};
        st_bf16x4(p.Y + (size_t)r * D + 768 + h * 64 + dv, o);
      }
  }
}
DI void ph_attn_mla(const Params& p, int need_ctx, char* lds, int bid, int nblk) {
  const int lane = TIDX & 63, wid = TIDX >> 6, l31 = lane & 31, hh = lane >> 5;
#pragma unroll 1
  for (int u = bid; u < (need_ctx ? ATT_UNITS : ATT_LAT_UNITS); u += nblk) {
    int bh, qb; att_unit(u, bh, qb);
    const int b = bh >> 2, h = bh & 3, q0 = qb * 128;
    const int r = row_of(b, q0 + wid * 32 + l31);
    f32x16 O[1][2]; float ls[1];
    attn_unit<96, 1>(p.Qm + ((size_t)b * 4 + h) * TK * 96, p.Km + ((size_t)b * 4 + h) * TK * 96, 0, p.Vtm + ((size_t)b * 4 + h) * 64 * TK, q0, q0 < TC ? TC : TK, O, ls, lds);
    const float inv = 1.0f / ls[0];
#pragma unroll
    for (int dvt = 0; dvt < 2; ++dvt)
#pragma unroll
      for (int g = 0; g < 4; ++g) {
        f32x4 o = {O[0][dvt][4 * g] * inv, O[0][dvt][4 * g + 1] * inv, O[0][dvt][4 * g + 2] * inv, O[0][dvt][4 * g + 3] * inv};
        st_bf16x4(p.Y + (size_t)r * D + h * 64 + dvt * 32 + 8 * g + 4 * hh, o);
      }
  }
}
template <int VAR> DI void ph_attn_mla_probe(const Params& p, char* lds, int bid, int nblk) {
  const int lane = TIDX & 63, wid = TIDX >> 6, l31 = lane & 31, hh = lane >> 5;
#pragma unroll 1
  for (int u = bid; u < ATT_LAT_UNITS; u += nblk) {
    int bh, qb; att_unit(u, bh, qb);
    const int b = bh >> 2, h = bh & 3, q0 = qb * 128;
    const int r = row_of(b, q0 + wid * 32 + l31);
    f32x16 O[1][2]; float ls[1];
    attn_unit<96, 1, VAR>(p.Qm + ((size_t)b * 4 + h) * TK * 96, p.Km + ((size_t)b * 4 + h) * TK * 96, 0, p.Vtm + ((size_t)b * 4 + h) * 64 * TK, q0, TK, O, ls, lds);
    const float inv = 1.0f / ls[0];
#pragma unroll
    for (int dvt = 0; dvt < 2; ++dvt)
#pragma unroll
      for (int g = 0; g < 4; ++g) {
        f32x4 o = {O[0][dvt][4 * g] * inv, O[0][dvt][4 * g + 1] * inv, O[0][dvt][4 * g + 2] * inv, O[0][dvt][4 * g + 3] * inv};
        *(f32x4*)(p.out + (size_t)r * D + h * 64 + dvt * 32 + 8 * g + 4 * hh) = o;
      }
  }
}
DI void ph_attn(const Params& p, int layer, int need_ctx, char* lds, int bid, int nblk) {
  ph_attn_diff(p, layer, need_ctx, lds, bid, nblk);
  ph_attn_mla(p, need_ctx, lds, bid, nblk);
}

DI float wave_sum(float v) {
  v = xor_sum<1>(v); v = xor_sum<2>(v); v = xor_sum<4>(v); v = xor_sum<8>(v); v = xor_sum<16>(v); v = xor_sum<32>(v);
  return v;
}
DI void ld_row16(const float* row, int lane, f32x4 (&v)[4]) {
#pragma unroll
  for (int i = 0; i < 4; ++i) v[i] = *(const f32x4*)(row + 256 * i + 4 * lane);
}
DI void ld_row16_bf(const bf16_t* row, int lane, f32x4 (&v)[4]) {
#pragma unroll
  for (int i = 0; i < 4; ++i) { const u32x2 u = *(const u32x2*)(row + 256 * i + 4 * lane); v[i] = (f32x4){u2f(u.x << 16), u2f(u.x & 0xffff0000u), u2f(u.y << 16), u2f(u.y & 0xffff0000u)}; }
}
DI void ph_modulate(const Params& p, int layer, const float* xl, const float* xcx, int bid, int nblk) {
  const int lane = TIDX & 63, wid = TIDX >> 6;
  const float* g = p.g_mix_pre + layer * 1024;
  for (int r = bid * 4 + wid; r < R; r += nblk * 4) {
    const int w = r < RL ? r / TL : 2;
    const float* mb = p.mods + (size_t)(layer * 3 + w) * 6144;
    const float* x = r < RL ? xl + (size_t)r * D : xcx + (size_t)(r - RL) * D;
    f32x4 xv[4], gv[4], sc[4], sh[4];
    ld_row16(x, lane, xv); ld_row16(g, lane, gv); ld_row16(mb + 1024, lane, sc); ld_row16(mb, lane, sh);
    float ss = 0.f;
#pragma unroll
    for (int i = 0; i < 4; ++i)
#pragma unroll
      for (int e = 0; e < 4; ++e) ss += xv[i][e] * xv[i][e];
    const float rstd = 1.0f / sqrtf(wave_sum(ss) * (1.0f / D) + 1e-6f);
#pragma unroll
    for (int i = 0; i < 4; ++i) {
      f32x4 o;
#pragma unroll
      for (int e = 0; e < 4; ++e) o[e] = xv[i][e] * rstd * gv[i][e] * (1.f + sc[i][e]) + sh[i][e];
      st_bf16x4(p.H + (size_t)r * D + 256 * i + 4 * lane, o);
    }
  }
}
DI void ph_resid_mix(const Params& p, int layer, const float* xl_in, const float* xc_in, int rows, char* lds, int bid, int nblk) {
  const int lane = TIDX & 63, wid = TIDX >> 6;
  const float* wr = p.w_router + (size_t)layer * D * 16;
  for (int i = TIDX; i < D * 4; i += NTHR) { const int k = i >> 2, q = i & 3; *(f32x4*)(lds + k * 64 + (k >> 2) * 16 + q * 16) = *(const f32x4*)(wr + k * 16 + q * 4); }
  __syncthreads();
  int wprev = -1;
  f32x4 ac[4], gs[4], s3[4];
  for (int r = bid * 4 + wid; r < rows; r += nblk * 4) {
    const int w = r < RL ? r / TL : 2;
    const float* xin = r < RL ? xl_in + (size_t)r * D : xc_in + (size_t)(r - RL) * D;
    float* xo = r < RL ? p.out + (size_t)r * D : p.xc + (size_t)(r - RL) * D;
    f32x4 yv[4], xv[4];
    ld_row16_bf(p.YO + (size_t)r * D, lane, yv); ld_row16(xin, lane, xv);
    if (w != wprev) {
      const float* mb = p.mods + (size_t)(layer * 3 + w) * 6144;
      f32x4 a[4], c[4];
      ld_row16(mb + 2 * 1024, lane, a); ld_row16(p.g_mix_post + layer * 1024, lane, c);
#pragma unroll
      for (int i = 0; i < 4; ++i) ac[i] = a[i] * c[i];
      ld_row16(p.g_ffn_pre + layer * 1024, lane, a); ld_row16(mb + 4 * 1024, lane, c); ld_row16(mb + 3 * 1024, lane, s3);
#pragma unroll
      for (int i = 0; i < 4; ++i) gs[i] = a[i] * (c[i] + 1.0f);
      wprev = w;
    }
    float ss = 0.f;
#pragma unroll
    for (int i = 0; i < 4; ++i)
#pragma unroll
      for (int e = 0; e < 4; ++e) ss += yv[i][e] * yv[i][e];
    const float rstd = 1.0f / sqrtf(wave_sum(ss) * (1.0f / D) + 1e-6f);
    float s2 = 0.f;
#pragma unroll
    for (int i = 0; i < 4; ++i) {
#pragma unroll
      for (int e = 0; e < 4; ++e) { xv[i][e] += ac[i][e] * yv[i][e] * rstd; s2 += xv[i][e] * xv[i][e]; }
      *(f32x4*)(xo + 256 * i + 4 * lane) = xv[i];
    }
    const float rstd2 = 1.0f / sqrtf(wave_sum(s2) * (1.0f / D) + 1e-6f);
    float lg[16];
#pragma unroll
    for (int e = 0; e < 16; ++e) lg[e] = 0.f;
#pragma unroll
    for (int i = 0; i < 4; ++i) {
      f32x4 h2;
#pragma unroll
      for (int e = 0; e < 4; ++e) h2[e] = xv[i][e] * rstd2 * gs[i][e] + s3[i][e];
      st_bf16x4(p.H + (size_t)r * D + 256 * i + 4 * lane, h2);
#pragma unroll
      for (int e = 0; e < 4; ++e) {
        const char* wk = lds + (256 * i + 4 * lane + e) * 64 + (64 * i + lane) * 16;
#pragma unroll
        for (int q = 0; q < 4; ++q) { const f32x4 wv = *(const f32x4*)(wk + 16 * q); lg[4 * q] += h2[e] * wv[0]; lg[4 * q + 1] += h2[e] * wv[1]; lg[4 * q + 2] += h2[e] * wv[2]; lg[4 * q + 3] += h2[e] * wv[3]; }
      }
    }
#pragma unroll
    for (int e = 0; e < 16; ++e) lg[e] = wave_sum(lg[e]);
    float mx = lg[0];
#pragma unroll
    for (int e = 1; e < 16; ++e) mx = fmaxf(mx, lg[e]);
    float sm = 0.f;
#pragma unroll
    for (int e = 0; e < 16; ++e) { lg[e] = expf(lg[e] - mx); sm += lg[e]; }
    int b, s; bs_of(r, b, s);
    float mine = 0.f;
#pragma unroll
    for (int e = 0; e < 16; ++e) mine = (lane == e) ? lg[e] / sm : mine;
    if (lane < 16) p.AFF[((size_t)b * NE + lane) * TK + s] = mine;
  }
}
DI void ph_resid_ffn(const Params& p, int layer, int rows, int bid, int nblk) {
  const int lane = TIDX & 63, wid = TIDX >> 6;
  int r = bid * 4 + wid;
  int inv_n = (r < rows && lane < NE) ? p.INV[(size_t)r * NE + lane] : -1;
  int wprev = -1;
  f32x4 ac[4], gs[4], sh[4];
#pragma unroll 1
  for (; r < rows; r += nblk * 4) {
    const int w = r < RL ? r / TL : 2;
    if (w != wprev) {
      const float* mb = p.mods + (size_t)(layer * 3 + w) * 6144;
      f32x4 a[4], c[4];
      ld_row16(mb + 5 * 1024, lane, a); ld_row16(p.g_ffn_post + layer * 1024, lane, c);
#pragma unroll
      for (int i = 0; i < 4; ++i) ac[i] = a[i] * c[i];
      if (layer == 0) {
        const float* mb1 = p.mods + (size_t)(3 + w) * 6144;
        ld_row16(p.g_mix_pre + 1024, lane, a); ld_row16(mb1 + 1024, lane, c); ld_row16(mb1, lane, sh);
#pragma unroll
        for (int i = 0; i < 4; ++i) gs[i] = a[i] * (c[i] + 1.0f);
      }
      wprev = w;
    }
    float* xo = r < RL ? p.out + (size_t)r * D : p.xc + (size_t)(r - RL) * D;
    const int myinv = inv_n;
    { const int rn = r + nblk * 4; inv_n = (rn < rows && lane < NE) ? p.INV[(size_t)rn * NE + lane] : -1; }
    f32x4 f[4], xv[4];
    ld_row16(xo, lane, xv);
#pragma unroll
    for (int i = 0; i < 4; ++i) f[i] = (f32x4){0.f, 0.f, 0.f, 0.f};
    unsigned mask = wave_ballot16(myinv >= 0);
#pragma unroll 1
    while (mask) {
      const int e0 = __builtin_ctz(mask); mask &= mask - 1;
      const bool two = mask != 0u;
      const int e1 = two ? __builtin_ctz(mask) : e0; if (two) mask &= mask - 1;
      const int s0 = lane_bcast(myinv, e0), s1 = lane_bcast(myinv, e1);
      f32x4 y0[4], y1[4];
      ld_row16_bf(p.YE + ((size_t)e0 * NSLOT + s0) * D, lane, y0); ld_row16_bf(p.YE + ((size_t)e1 * NSLOT + s1) * D, lane, y1);
      const float w1 = two ? 1.0f : 0.0f;
#pragma unroll
      for (int i = 0; i < 4; ++i) f[i] += y0[i] + y1[i] * w1;
    }
    float ss = 0.f;
#pragma unroll
    for (int i = 0; i < 4; ++i)
#pragma unroll
      for (int e = 0; e < 4; ++e) ss += f[i][e] * f[i][e];
    const float rstd = 1.0f / sqrtf(wave_sum(ss) * (1.0f / D) + 1e-6f);
    float s2 = 0.f;
#pragma unroll
    for (int i = 0; i < 4; ++i) {
#pragma unroll
      for (int e = 0; e < 4; ++e) { xv[i][e] += ac[i][e] * f[i][e] * rstd; s2 += xv[i][e] * xv[i][e]; }
      *(f32x4*)(xo + 256 * i + 4 * lane) = xv[i];
    }
    if (layer == 0) {
      const float rstd2 = 1.0f / sqrtf(wave_sum(s2) * (1.0f / D) + 1e-6f);
#pragma unroll
      for (int i = 0; i < 4; ++i) {
        f32x4 o;
#pragma unroll
        for (int e = 0; e < 4; ++e) o[e] = xv[i][e] * rstd2 * gs[i][e] + sh[i][e];
        st_bf16x4(p.H + (size_t)r * D + 256 * i + 4 * lane, o);
      }
    }
  }
}
DI void ph_mods(const Params& p, char* lds, int bid, int nblk) {
  float* sc = (float*)lds;
  const int t = TIDX;
  for (int i = t; i < 3 * 1024; i += NTHR) { const float v = i < 2048 ? p.c[i] : p.c_ctx[i - 2048]; sc[i] = v / (1.0f + expf(-v)); }
  __syncthreads();
#pragma unroll 1
  for (long gi = (long)bid * NTHR + t; gi < 2 * 3 * 6144; gi += (long)nblk * NTHR) {
    const int col = (int)(gi % 6144), w = (int)((gi / 6144) % 3), l = (int)(gi / (3 * 6144));
    const float* W = p.w_ada + (size_t)l * 1024 * 6144 + col; const float* s = sc + w * 1024;
    float acc[8];
#pragma unroll
    for (int q = 0; q < 8; ++q) acc[q] = 0.f;
#pragma unroll 1
    for (int k = 0; k < 1024; k += 8) {
#pragma unroll
      for (int q = 0; q < 8; ++q) acc[q] += s[k + q] * W[(size_t)(k + q) * 6144];
    }
    p.mods[gi] = ((acc[0] + acc[1]) + (acc[2] + acc[3])) + ((acc[4] + acc[5]) + (acc[6] + acc[7])) + p.b_ada[l * 6144 + col];
  }
  __syncthreads();
}
constexpr int TOPK_LDS = TL * 4 + 2048;
DI int block_sum_i(int v, int* red) {
  const int lane = TIDX & 63, wid = TIDX >> 6;
  v = xor_sum_i<1>(v); v = xor_sum_i<2>(v); v = xor_sum_i<4>(v); v = xor_sum_i<8>(v); v = xor_sum_i<16>(v); v = xor_sum_i<32>(v);
  __syncthreads();
  if (lane == 0) red[wid] = v;
  __syncthreads();
  return red[0] + red[1] + red[2] + red[3];
}
DI int block_excl_scan(int v, int* red) {
  const int lane = TIDX & 63, wid = TIDX >> 6;
  int inc = v;
#pragma unroll
  for (int d = 1; d < 64; d <<= 1) { const int o = lane_up(inc, d, lane); if (lane >= d) inc += o; }
  __syncthreads();
  if (lane == 63) red[wid] = inc;
  __syncthreads();
  int base = 0;
  for (int q = 0; q < wid; ++q) base += red[q];
  return base + inc - v;
}
DI void ph_topk(const Params& p, int need_ctx, char* lds, int bid, int nblk) {
  unsigned* vals = (unsigned*)lds; int* red = (int*)(lds + TL * 4 + 1024);
  const int t = TIDX;
  for (int u = bid; u < NB * NE * 2; u += nblk) {
    const int seg = u & 1, e = (u >> 1) % NE, b = u / (2 * NE);
    const int s0 = seg ? TC : 0, n = seg ? TL : TC, cap = seg ? CAPL : CAPC, slot0 = seg ? b * CAPL : NB * CAPL + b * CAPC;
    if (seg == 0 && !need_ctx) { for (int q = t; q < cap; q += NTHR) p.SEL[(size_t)e * NSLOT + slot0 + q] = -1; continue; }
    const float* a = p.AFF + ((size_t)b * NE + e) * TK + s0;
    const int vpt = (n + NTHR - 1) / NTHR, i0 = t * vpt, i1 = (i0 + vpt < n) ? i0 + vpt : n;
    for (int i = t; i < n; i += NTHR) vals[i + i / vpt] = f2u(a[i]);
    __syncthreads();
    unsigned thr = 0;
    for (int bit = 31; bit >= 0; --bit) {
      const unsigned cand = thr | (1u << bit);
      int cnt = 0;
      for (int i = i0; i < i1; ++i) cnt += (vals[i + t] >= cand);
      if (block_sum_i(cnt, red) >= cap) thr = cand;
    }
    int cgt = 0, ceq = 0;
    for (int i = i0; i < i1; ++i) { cgt += (vals[i + t] > thr); ceq += (vals[i + t] == thr); }
    const int ngt = block_sum_i(cgt, red);
    const int neq = cap - ngt;
    int eqoff = block_excl_scan(ceq, red);
    int csel = 0;
    { int er = eqoff; for (int i = i0; i < i1; ++i) { if (vals[i + t] > thr) ++csel; else if (vals[i + t] == thr) { if (er < neq) ++csel; ++er; } } }
    int q = block_excl_scan(csel, red);
    for (int i = i0; i < i1; ++i) {
      const unsigned v = vals[i + t]; int sel = -1;
      if (v > thr) sel = q++; else if (v == thr) { if (eqoff < neq) sel = q++; ++eqoff; }
      const int r = row_of(b, s0 + i);
      if (sel >= 0) { p.SEL[(size_t)e * NSLOT + slot0 + sel] = r; p.SELV[(size_t)e * NSLOT + slot0 + sel] = u2f(v); }
      p.INV[(size_t)r * NE + e] = sel >= 0 ? slot0 + sel : -1;
    }
    __syncthreads();
  }
}
DI void ph_wt(const float* in, bf16_t* out, int K, int N, int NP, int nbatch, long in_bs, long out_bs, const float* gain, char* lds, int bid, int nblk) {
  float* tile = (float*)lds;
  const int t = TIDX, tk = K / 64, tn = NP / 64, ntile = nbatch * tk * tn;
  f32x4 v[4];
  auto gload = [&](int u) {
    const int bt = u / (tk * tn), rem = u % (tk * tn), k0 = (rem / tn) * 64, n0 = (rem % tn) * 64;
    const float* I = in + (size_t)bt * in_bs;
#pragma unroll
    for (int i = 0; i < 4; ++i) {
      const int idx = t + i * NTHR, kk = idx >> 4, n4 = (idx & 15) * 4;
      v[i] = (f32x4){0.f, 0.f, 0.f, 0.f};
      if (n0 + n4 < N) v[i] = *(const f32x4*)(I + (size_t)(k0 + kk) * N + n0 + n4);
      if (gain) { const float g = gain[k0 + kk]; v[i][0] *= g; v[i][1] *= g; v[i][2] *= g; v[i][3] *= g; }
    }
  };
  if (bid < ntile) gload(bid);
#pragma unroll 1
  for (int u = bid; u < ntile; u += nblk) {
    const int bt = u / (tk * tn), rem = u % (tk * tn), k0 = (rem / tn) * 64, n0 = (rem % tn) * 64;
    bf16_t* O = out + (size_t)bt * out_bs;
#pragma unroll
    for (int i = 0; i < 4; ++i) { const int idx = t + i * NTHR, kk = idx >> 4, n4 = (idx & 15) * 4; float* d = tile + kk * 65 + n4; d[0] = v[i][0]; d[1] = v[i][1]; d[2] = v[i][2]; d[3] = v[i][3]; }
    __syncthreads();
    if (u + nblk < ntile) gload(u + nblk);
#pragma unroll
    for (int i = 0; i < 2; ++i) {
      const int idx = t + i * NTHR, kg = idx & 7, nn = idx >> 3;
      float a[8];
#pragma unroll
      for (int e = 0; e < 8; ++e) a[e] = tile[(kg * 8 + e) * 65 + nn];
      u32x4 o; o.x = pack2bf(a[0], a[1]); o.y = pack2bf(a[2], a[3]); o.z = pack2bf(a[4], a[5]); o.w = pack2bf(a[6], a[7]);
      *(u32x4*)(O + (size_t)(n0 + nn) * K + k0 + kg * 8) = o;
    }
    __syncthreads();
  }
}
DI float wave_max(float v) {
  v = xor_max<1>(v); v = xor_max<2>(v); v = xor_max<4>(v); v = xor_max<8>(v); v = xor_max<16>(v); v = xor_max<32>(v);
  return v;
}
DI bf16x8 cvt8(const float* f) {
  const f32x4 a = *(const f32x4*)f, b = *(const f32x4*)(f + 4);
  u32x4 pk; pk.x = pack2bf(a[0], a[1]); pk.y = pack2bf(a[2], a[3]); pk.z = pack2bf(b[0], b[1]); pk.w = pack2bf(b[2], b[3]);
  return __builtin_bit_cast(bf16x8, pk);
}
constexpr int SCAN_UNITS = NB * NCK * 4, SCAN_LAT_UNITS = NB * NCL * 4;
DI void scan_unit(int u, int& b, int& c, int& h) {
  h = u & 3;
  if (u < SCAN_LAT_UNITS) { c = NCC + (u >> 2) % NCL; b = u / (4 * NCL); } else { const int v = u - SCAN_LAT_UNITS; c = (v >> 2) % NCC; b = v / (4 * NCC); }
}

DI void ph_ml_local(const Params& p, char* lds, int bid, int nblk) {
  bf16_t* sK = (bf16_t*)lds;
  float* sW = (float*)(lds + 64 * 132);
  const int t = TIDX, lane = t & 63, wid = t >> 6, l31 = lane & 31, hh = lane >> 5;
  const int d = wid & 1, vt = wid >> 1;
#pragma unroll 1
  for (int u = bid; u < SCAN_UNITS; u += nblk) {
    int b, c, h; scan_unit(u, b, c, h);
    {
      const int row = t >> 2, seg = (t & 3) * 16;
      const bf16_t* src = p.MK + ((size_t)b * TK + 64 * c + row) * 256 + h * 64 + seg;
      const u32x4 a = ldg16(src), bb = ldg16(src + 8);
      unsigned* dst = (unsigned*)((char*)sK + row * 132 + seg * 2);
      dst[0] = a.x; dst[1] = a.y; dst[2] = a.z; dst[3] = a.w; dst[4] = bb.x; dst[5] = bb.y; dst[6] = bb.z; dst[7] = bb.w;
    }
    if (t < 128) {
      const int dd = t >> 6, l = t & 63, j = step_of(dd, c), pos = dd ? 63 - l : l;
      const size_t o = (((size_t)b * 2 + dd) * TK + 64 * j) * 4 + h;
      const float bend = p.BC[o + 63 * 4], wl = bend - p.BC[o + pos * 4] + p.IGS[o + pos * 4];
      const float ml = wave_max(wl);
      sW[dd * 64 + l] = expf(wl - ml);
      if (l == 0) { const size_t uu = (((size_t)b * 2 + dd) * NCK + j) * 4 + h; p.MM[uu * 4] = ml; p.MM[uu * 4 + 1] = bend; }
    }
    __syncthreads();
    const int j = step_of(d, c);
    const size_t uu = (((size_t)b * 2 + d) * NCK + j) * 4 + h;
    f32x16 acc[2]; acc[0] = (f32x16)(0.f); acc[1] = (f32x16)(0.f);
    const bf16_t* vsrc = p.MVt + (((size_t)b * 4 + h) * 64 + vt * 32 + l31) * TK + 64 * c;
#pragma unroll
    for (int ks = 0; ks < 4; ++ks) {
      const bf16x8 a = *(const bf16x8*)(vsrc + ks * 16 + 8 * hh);
      const float* w = sW + d * 64 + ks * 16 + 8 * hh;
      u32x4 pk;
      pk.x = pack2bf(bf2f((bf16_t)a[0]) * w[0], bf2f((bf16_t)a[1]) * w[1]); pk.y = pack2bf(bf2f((bf16_t)a[2]) * w[2], bf2f((bf16_t)a[3]) * w[3]);
      pk.z = pack2bf(bf2f((bf16_t)a[4]) * w[4], bf2f((bf16_t)a[5]) * w[5]); pk.w = pack2bf(bf2f((bf16_t)a[6]) * w[6], bf2f((bf16_t)a[7]) * w[7]);
      const bf16x8 af = __builtin_bit_cast(bf16x8, pk);
#pragma unroll
      for (int kt = 0; kt < 2; ++kt) {
        bf16x8 bfr;
#pragma unroll
        for (int q = 0; q < 8; ++q) bfr[q] = (short)sK[(ks * 16 + 8 * hh + q) * 66 + kt * 32 + l31];
        acc[kt] = MFMA32(af, bfr, acc[kt]);
      }
    }
#pragma unroll
    for (int kt = 0; kt < 2; ++kt)
#pragma unroll
      for (int i = 0; i < 16; ++i) p.MC[uu * 4096 + (size_t)(vt * 32 + (i & 3) + 8 * (i >> 2) + 4 * hh) * 64 + kt * 32 + l31] = acc[kt][i];
    float nl = 0.f;
    for (int q = 0; q < 32; ++q) { const int l = hh * 32 + q; nl += sW[d * 64 + l] * bf2f(sK[l * 66 + vt * 32 + l31]); }
    nl = xor_sum<32>(nl);
    if (hh == 0) p.MN[uu * 64 + vt * 32 + l31] = nl;
    __syncthreads();
  }
}
constexpr int SCAN_PF = 8;
DI void ph_ml_scan(const Params& p, int bid, int nblk) {
  for (long gi = (long)bid * NTHR + TIDX; gi < (long)NB * 2 * 4 * 4160; gi += (long)nblk * NTHR) {
    const int e = (int)(gi % 4160), ch = (int)(gi / 4160), h = ch & 3, bd = ch >> 2;
    float* base = e < 4096 ? p.MC + (((size_t)bd * NCK) * 4 + h) * 4096 + e : p.MN + (((size_t)bd * NCK) * 4 + h) * 64 + (e - 4096);
    const size_t stride = e < 4096 ? 4 * 4096 : 4 * 64;
    float* mm = p.MM + (((size_t)bd * NCK) * 4 + h) * 4;
    float st = 0.f, m = -1e30f;
    float cl[SCAN_PF], cm[SCAN_PF], cb[SCAN_PF], nl[SCAN_PF], nm[SCAN_PF], nb[SCAN_PF];
#pragma unroll
    for (int q = 0; q < SCAN_PF; ++q) if (q < NCK) { cl[q] = base[(size_t)q * stride]; cm[q] = mm[q * 16]; cb[q] = mm[q * 16 + 1]; }
#pragma unroll 1
    for (int jb = 0; jb < NCK; jb += SCAN_PF) {
#pragma unroll
      for (int q = 0; q < SCAN_PF; ++q) { const int j = jb + SCAN_PF + q; if (j < NCK) { nl[q] = base[(size_t)j * stride]; nm[q] = mm[j * 16]; nb[q] = mm[j * 16 + 1]; } }
#pragma unroll
      for (int q = 0; q < SCAN_PF; ++q) {
        const int j = jb + q;
        if (j < NCK) {
          const float mn = fmaxf(cb[q] + m, cm[q]), a = expf(cb[q] + m - mn), g = expf(cm[q] - mn);
          base[(size_t)j * stride] = st;
          st = a * st + g * cl[q];
          if (e == 0) mm[j * 16 + 2] = m;
          m = mn;
        }
      }
#pragma unroll
      for (int q = 0; q < SCAN_PF; ++q) { cl[q] = nl[q]; cm[q] = nm[q]; cb[q] = nb[q]; }
    }
  }
}
DI void ph_gla_scan(const Params& p, int bid, int nblk) {
  for (long gi = (long)bid * NTHR + TIDX; gi < (long)NB * 2 * 4 * 2048; gi += (long)nblk * NTHR) {
    const int e = (int)(gi % 2048), ch = (int)(gi / 2048), h = ch & 3, bd = ch >> 2, k = e & 31;
    float* base = p.GS + (((size_t)bd * NCK) * 4 + h) * 2048 + e;
    const float* ge = p.GC + ((size_t)bd * TK + 63) * 128 + h * 32 + k;
    float st = 0.f;
    float cl[SCAN_PF], cg[SCAN_PF], nl[SCAN_PF], ng[SCAN_PF];
#pragma unroll
    for (int q = 0; q < SCAN_PF; ++q) if (q < NCK) { cl[q] = base[(size_t)q * 4 * 2048]; cg[q] = ge[(size_t)q * 64 * 128]; }
#pragma unroll 1
    for (int jb = 0; jb < NCK; jb += SCAN_PF) {
#pragma unroll
      for (int q = 0; q < SCAN_PF; ++q) { const int j = jb + SCAN_PF + q; if (j < NCK) { nl[q] = base[(size_t)j * 4 * 2048]; ng[q] = ge[(size_t)j * 64 * 128]; } }
#pragma unroll
      for (int q = 0; q < SCAN_PF; ++q) {
        const int j = jb + q;
        if (j < NCK) { base[(size_t)j * 4 * 2048] = st; st = expf(cg[q]) * st + cl[q]; }
      }
#pragma unroll
      for (int q = 0; q < SCAN_PF; ++q) { cl[q] = nl[q]; cg[q] = ng[q]; }
    }
  }
}
constexpr int MO_K = 0, MO_V = 64 * 144, MO_A = MO_V + 64 * VROW, MO_PM = MO_A + 512, MO_N0 = MO_PM + 512, MO_X = MO_N0 + 512, MO_LDS = MO_X + 16384;
DI void ph_ml_out(const Params& p, int layer, int need_ctx, char* lds, int bid, int nblk) {
  float* sA = (float*)(lds + MO_A); float* sPM = (float*)(lds + MO_PM); float* sN0 = (float*)(lds + MO_N0); float* sX = (float*)(lds + MO_X);
  const int t = TIDX, lane = t & 63, wid = t >> 6, l31 = lane & 31, hh = lane >> 5;
  const int lt = wid & 1, d = wid >> 1;
#pragma unroll 1
  for (int u = bid; u < (need_ctx ? SCAN_UNITS : SCAN_LAT_UNITS); u += nblk) {
    int b, c, h; scan_unit(u, b, c, h);
    {
      const int row = t >> 2, seg = (t & 3) * 16;
      const bf16_t* ks = p.MK + ((size_t)b * TK + 64 * c + row) * 256 + h * 64 + seg;
      sts16(lds + MO_K + row * 144 + seg * 2, ldg16(ks)); sts16(lds + MO_K + row * 144 + seg * 2 + 16, ldg16(ks + 8));
      const bf16_t* vs = p.MVt + (((size_t)b * 4 + h) * 64 + row) * TK + 64 * c + seg;
      const u32x4 v0 = ldg16(vs), v1 = ldg16(vs + 8);
      u32x2* dv = (u32x2*)(lds + MO_V + row * VROW + seg * 2);
      u32x2 q; q.x = v0.x; q.y = v0.y; dv[0] = q; q.x = v0.z; q.y = v0.w; dv[1] = q; q.x = v1.x; q.y = v1.y; dv[2] = q; q.x = v1.z; q.y = v1.w; dv[3] = q;
    }
    if (t < 128) {
      const int dd = t >> 6, s = t & 63, j = step_of(dd, c), pos = dd ? 63 - s : s;
      const size_t o = (((size_t)b * 2 + dd) * TK + 64 * j) * 4 + h;
      sA[dd * 64 + s] = p.IGS[o + pos * 4] - p.BC[o + pos * 4];
      const size_t uu = (((size_t)b * 2 + dd) * NCK + j) * 4 + h;
      sN0[dd * 64 + s] = p.MN[uu * 64 + s];
    }
    __syncthreads();
    if (t < 2) {
      float m = -1e30f;
      if (t == 0) { for (int s = 0; s < 64; ++s) { m = fmaxf(m, sA[s]); sPM[s] = m; } }
      else { for (int s = 63; s >= 0; --s) { m = fmaxf(m, sA[64 + s]); sPM[64 + s] = m; } }
    }
    __syncthreads();
    const int j = step_of(d, c);
    const size_t uu = (((size_t)b * 2 + d) * NCK + j) * 4 + h;
    const int l = lt * 32 + l31, pos = d ? 63 - l : l;
    const float bl = p.BC[(((size_t)b * 2 + d) * TK + 64 * j + pos) * 4 + h];
    const float inter = bl + p.MM[uu * 4 + 2];
    const float mt = fmaxf(inter, bl + sPM[d * 64 + l]);
    const float aint = expf(inter - mt);
    bf16x8 qf[4];
#pragma unroll
    for (int ks = 0; ks < 4; ++ks) qf[ks] = *(const bf16x8*)(p.MQ + ((size_t)b * TK + 64 * c + l) * 256 + h * 64 + ks * 16 + 8 * hh);
    f32x16 num[2]; num[0] = (f32x16)(0.f); num[1] = (f32x16)(0.f);
    float den = 0.f;
#pragma unroll
    for (int st = 0; st < 2; ++st) {
      if (d == 0 ? st <= lt : st >= lt) {
        f32x16 S = (f32x16)(0.f);
#pragma unroll
        for (int ks = 0; ks < 4; ++ks) S = MFMA32(lds_frag(lds + MO_K + (st * 32 + l31) * 144 + (ks * 16 + 8 * hh) * 2), qf[ks], S);
#pragma unroll
        for (int i = 0; i < 16; ++i) {
          const int s = st * 32 + (i & 3) + 8 * (i >> 2) + 4 * hh;
          const bool ok = d == 0 ? s <= l : s >= l;
          const float e = ok ? fast_exp2((bl + sA[d * 64 + s] - mt) * LOG2E) * S[i] : 0.f;
          S[i] = e; den += e;
        }
#pragma unroll
        for (int kst = 0; kst < 2; ++kst) {
          const bf16x8 pf = pack8(S, kst);
#pragma unroll
          for (int vt = 0; vt < 2; ++vt) {
            const char* vp = lds + MO_V + (vt * 32 + l31) * VROW + (st * 32 + kst * 16 + 4 * hh) * 2;
            const s16x4 lo = *(const s16x4*)vp, hi = *(const s16x4*)(vp + 16);
            num[vt] = MFMA32(__builtin_shufflevector(lo, hi, 0, 1, 2, 3, 4, 5, 6, 7), pf, num[vt]);
          }
        }
      }
    }
    f32x16 accI[2]; accI[0] = (f32x16)(0.f); accI[1] = (f32x16)(0.f);
#pragma unroll
    for (int vt = 0; vt < 2; ++vt)
#pragma unroll
      for (int ks = 0; ks < 4; ++ks) accI[vt] = MFMA32(cvt8(p.MC + uu * 4096 + (size_t)(vt * 32 + l31) * 64 + ks * 16 + 8 * hh), qf[ks], accI[vt]);
    float qn = 0.f;
#pragma unroll
    for (int ks = 0; ks < 4; ++ks)
#pragma unroll
      for (int q = 0; q < 8; ++q) qn += bf2f((bf16_t)qf[ks][q]) * sN0[d * 64 + ks * 16 + 8 * hh + q];
    den = xor_sum<32>(den + aint * qn);
    const float inv = 1.0f / fmaxf(fabsf(den), expf(-mt));
#pragma unroll
    for (int vt = 0; vt < 2; ++vt)
#pragma unroll
      for (int i = 0; i < 16; ++i) num[vt][i] = (num[vt][i] + aint * accI[vt][i]) * inv;
    if (d == 1) {
#pragma unroll
      for (int vt = 0; vt < 2; ++vt)
#pragma unroll
        for (int i = 0; i < 16; ++i) sX[(lt * 32 + vt * 16 + i) * 64 + lane] = num[vt][i];
    }
    __syncthreads();
    if (d == 0) {
      float ss = 0.f;
#pragma unroll
      for (int vt = 0; vt < 2; ++vt)
#pragma unroll
        for (int i = 0; i < 16; ++i) { num[vt][i] += sX[(lt * 32 + vt * 16 + i) * 64 + lane]; ss += num[vt][i] * num[vt][i]; }
      ss = xor_sum<32>(ss);
      const float rstd = 1.0f / sqrtf(ss * (1.0f / 64) + 1e-6f);
      const int r = row_of(b, 64 * c + l);
#pragma unroll
      for (int vt = 0; vt < 2; ++vt)
#pragma unroll
        for (int g = 0; g < 4; ++g) {
          const int v0 = vt * 32 + 8 * g + 4 * hh;
          const u32x2 ou = *(const u32x2*)(p.Z + (size_t)r * NZP + ZC_MLO + h * 64 + v0);
          const f32x4 gv = *(const f32x4*)(p.g_mlstm_out + layer * 256 + h * 64 + v0);
          const float o0 = u2f(ou.x << 16), o1 = u2f(ou.x & 0xffff0000u), o2 = u2f(ou.y << 16), o3 = u2f(ou.y & 0xffff0000u);
          f32x4 y = {sigmoidf_(o0) * num[vt][4 * g] * rstd * gv[0], sigmoidf_(o1) * num[vt][4 * g + 1] * rstd * gv[1],
                     sigmoidf_(o2) * num[vt][4 * g + 2] * rstd * gv[2], sigmoidf_(o3) * num[vt][4 * g + 3] * rstd * gv[3]};
          st_bf16x4(p.Y + (size_t)r * D + 256 + h * 64 + v0, y);
        }
    }
    __syncthreads();
  }
}
DI void ph_gla_local(const Params& p, char* lds, int bid, int nblk) {
  bf16_t* sKd = (bf16_t*)lds;
  const int t = TIDX, lane = t & 63, wid = t >> 6, l31 = lane & 31, hh = lane >> 5;
  const int d = wid & 1, vt = wid >> 1;
#pragma unroll 1
  for (int u = bid; u < SCAN_UNITS; u += nblk) {
    int b, c, h; scan_unit(u, b, c, h);
    {
      const int dd = t >> 7, l = (t >> 1) & 63, k0 = (t & 1) * 16, j = step_of(dd, c), pos = dd ? 63 - l : l;
      const float* gcr = p.GC + (((size_t)b * 2 + dd) * TK + 64 * j + pos) * 128 + h * 32 + k0;
      const float* ger = p.GC + (((size_t)b * 2 + dd) * TK + 64 * j + 63) * 128 + h * 32 + k0;
      const bf16_t* kr = p.Z + (size_t)row_of(b, 64 * c + l) * NZP + ZC_GK + h * 32 + k0;
#pragma unroll
      for (int q = 0; q < 16; ++q) sKd[(dd * 64 + l) * 33 + k0 + q] = f2bf(bf2f(kr[q]) * fast_exp2((ger[q] - gcr[q]) * LOG2E));
    }
    __syncthreads();
    const int j = step_of(d, c);
    const size_t uu = (((size_t)b * 2 + d) * NCK + j) * 4 + h;
    f32x16 acc = (f32x16)(0.f);
    const bf16_t* vsrc = p.GVt + (((size_t)b * 4 + h) * 64 + vt * 32 + l31) * TK + 64 * c;
#pragma unroll
    for (int ks = 0; ks < 4; ++ks) {
      const bf16x8 af = *(const bf16x8*)(vsrc + ks * 16 + 8 * hh);
      bf16x8 bfr;
#pragma unroll
      for (int q = 0; q < 8; ++q) bfr[q] = (short)sKd[(d * 64 + ks * 16 + 8 * hh + q) * 33 + l31];
      acc = MFMA32(af, bfr, acc);
    }
#pragma unroll
    for (int i = 0; i < 16; ++i) p.GS[uu * 2048 + (size_t)(vt * 32 + (i & 3) + 8 * (i >> 2) + 4 * hh) * 32 + l31] = acc[i];
    __syncthreads();
  }
}
constexpr int GO_Q = 0, GO_K = 2 * 64 * 80, GO_V = 2 * GO_K, GO_X = GO_V + 64 * VROW, GO_LDS = GO_X + 16384;
DI void ph_gla_out(const Params& p, int layer, int need_ctx, char* lds, int bid, int nblk) {
  float* sX = (float*)(lds + GO_X);
  const int t = TIDX, lane = t & 63, wid = t >> 6, l31 = lane & 31, hh = lane >> 5;
  const int lt = wid & 1, d = wid >> 1;
#pragma unroll 1
  for (int u = bid; u < (need_ctx ? SCAN_UNITS : SCAN_LAT_UNITS); u += nblk) {
    int b, c, h; scan_unit(u, b, c, h);
    {
      const int dd = t >> 7, l = (t >> 1) & 63, k0 = (t & 1) * 16, j = step_of(dd, c), pos = dd ? 63 - l : l;
      const float* gcr = p.GC + (((size_t)b * 2 + dd) * TK + 64 * j + pos) * 128 + h * 32 + k0;
      const bf16_t* zr = p.Z + (size_t)row_of(b, 64 * c + l) * NZP;
      bf16_t* qd = (bf16_t*)(lds + GO_Q + (dd * 64 + l) * 80) + k0; bf16_t* kd = (bf16_t*)(lds + GO_K + (dd * 64 + l) * 80) + k0;
#pragma unroll
      for (int q = 0; q < 16; ++q) {
        const float g = gcr[q];
        qd[q] = f2bf(bf2f(zr[ZC_GQ + h * 32 + k0 + q]) * 0.17677669529663687f * fast_exp2(g * LOG2E));
        kd[q] = f2bf(bf2f(zr[ZC_GK + h * 32 + k0 + q]) * fast_exp2(-g * LOG2E));
      }
      const int row = t >> 2, seg = (t & 3) * 16;
      const bf16_t* vs = p.GVt + (((size_t)b * 4 + h) * 64 + row) * TK + 64 * c + seg;
      const u32x4 v0 = ldg16(vs), v1 = ldg16(vs + 8);
      u32x2* dv = (u32x2*)(lds + GO_V + row * VROW + seg * 2);
      u32x2 q2; q2.x = v0.x; q2.y = v0.y; dv[0] = q2; q2.x = v0.z; q2.y = v0.w; dv[1] = q2; q2.x = v1.x; q2.y = v1.y; dv[2] = q2; q2.x = v1.z; q2.y = v1.w; dv[3] = q2;
    }
    __syncthreads();
    const int j = step_of(d, c);
    const size_t uu = (((size_t)b * 2 + d) * NCK + j) * 4 + h;
    const int l = lt * 32 + l31;
    bf16x8 qf[2];
#pragma unroll
    for (int ks = 0; ks < 2; ++ks) qf[ks] = lds_frag(lds + GO_Q + (d * 64 + l) * 80 + (ks * 16 + 8 * hh) * 2);
    f32x16 O[2]; O[0] = (f32x16)(0.f); O[1] = (f32x16)(0.f);
#pragma unroll
    for (int st = 0; st < 2; ++st) {
      if (d == 0 ? st <= lt : st >= lt) {
        f32x16 S = (f32x16)(0.f);
#pragma unroll
        for (int ks = 0; ks < 2; ++ks) S = MFMA32(lds_frag(lds + GO_K + (d * 64 + st * 32 + l31) * 80 + (ks * 16 + 8 * hh) * 2), qf[ks], S);
#pragma unroll
        for (int i = 0; i < 16; ++i) {
          const int s = st * 32 + (i & 3) + 8 * (i >> 2) + 4 * hh;
          const bool ok = d == 0 ? s <= l : s >= l;
          S[i] = ok ? S[i] : 0.f;
        }
#pragma unroll
        for (int kst = 0; kst < 2; ++kst) {
          const bf16x8 pf = pack8(S, kst);
#pragma unroll
          for (int vt = 0; vt < 2; ++vt) {
            const char* vp = lds + GO_V + (vt * 32 + l31) * VROW + (st * 32 + kst * 16 + 4 * hh) * 2;
            const s16x4 lo = *(const s16x4*)vp, hi = *(const s16x4*)(vp + 16);
            O[vt] = MFMA32(__builtin_shufflevector(lo, hi, 0, 1, 2, 3, 4, 5, 6, 7), pf, O[vt]);
          }
        }
      }
    }
#pragma unroll
    for (int vt = 0; vt < 2; ++vt)
#pragma unroll
      for (int ks = 0; ks < 2; ++ks) O[vt] = MFMA32(cvt8(p.GS + uu * 2048 + (size_t)(vt * 32 + l31) * 32 + ks * 16 + 8 * hh), qf[ks], O[vt]);
    if (d == 1) {
#pragma unroll
      for (int vt = 0; vt < 2; ++vt)
#pragma unroll
        for (int i = 0; i < 16; ++i) sX[(lt * 32 + vt * 16 + i) * 64 + lane] = O[vt][i];
    }
    __syncthreads();
    if (d == 0) {
      float ss = 0.f;
#pragma unroll
      for (int vt = 0; vt < 2; ++vt)
#pragma unroll
        for (int i = 0; i < 16; ++i) { O[vt][i] += sX[(lt * 32 + vt * 16 + i) * 64 + lane]; ss += O[vt][i] * O[vt][i]; }
      ss = xor_sum<32>(ss);
      const float rstd = 1.0f / sqrtf(ss * (1.0f / 64) + 1e-6f);
      const int r = row_of(b, 64 * c + l);
#pragma unroll
      for (int vt = 0; vt < 2; ++vt)
#pragma unroll
        for (int g = 0; g < 4; ++g) {
          const int v0 = vt * 32 + 8 * g + 4 * hh;
          const u32x2 ru = *(const u32x2*)(p.Z + (size_t)r * NZP + ZC_GR + h * 64 + v0);
          const f32x4 gv = *(const f32x4*)(p.g_gla_out + layer * 256 + h * 64 + v0);
          const float r0 = u2f(ru.x << 16), r1 = u2f(ru.x & 0xffff0000u), r2 = u2f(ru.y << 16), r3 = u2f(ru.y & 0xffff0000u);
          f32x4 y = {siluf_(r0) * O[vt][4 * g] * rstd * gv[0], siluf_(r1) * O[vt][4 * g + 1] * rstd * gv[1],
                     siluf_(r2) * O[vt][4 * g + 2] * rstd * gv[2], siluf_(r3) * O[vt][4 * g + 3] * rstd * gv[3]};
          st_bf16x4(p.Y + (size_t)r * D + 512 + h * 64 + v0, y);
        }
    }
    __syncthreads();
  }
}

DI float fast_logsigmoid(float x) {
  const float e = fast_exp2(-fabsf(x) * LOG2E);
#ifdef CPU_EMU
  return fminf(x, 0.f) - log1pf(e);
#else
  return fminf(x, 0.f) - 0.6931471805599453f * __builtin_amdgcn_logf(1.0f + e);
#endif
}
DI float wave_incl_scan(float v, int lane) {
#pragma unroll
  for (int dd = 1; dd < 64; dd <<= 1) { const float o = u2f((unsigned)lane_up((int)f2u(v), dd, lane)); if (lane >= dd) v += o; }
  return v;
}
constexpr int GCUM_LDS = 4 * 64 * 33 * 4;
DI void ph_gates_cum(const Params& p, int layer, char* lds, int bid, int nblk) {
  const int t = TIDX, lane = t & 63, wid = t >> 6;
  float* stg = (float*)lds + wid * 64 * 33;
  const float* wal = p.w_alpha2 + (size_t)layer * 2 * 16 * 128;
#pragma unroll 1
  for (int u = bid * 4 + wid; u < NB * 2 * NCK; u += nblk * 4) {
    const int j = u % NCK, d = (u / NCK) & 1, b = u / (2 * NCK);
    const int pp = 64 * j + lane, s = seq_of(d, pp);
    const bf16_t* z = p.Z + (size_t)row_of(b, s) * NZP;
    const size_t ob = ((size_t)b * 2 + d) * TK + pp;
    {
      const u32x2 iu = *(const u32x2*)(z + ZC_MLIG + d * 4), fu = *(const u32x2*)(z + ZC_MLFG + d * 4);
      const float ig[4] = {u2f(iu.x << 16), u2f(iu.x & 0xffff0000u), u2f(iu.y << 16), u2f(iu.y & 0xffff0000u)};
      const float fg[4] = {u2f(fu.x << 16), u2f(fu.x & 0xffff0000u), u2f(fu.y << 16), u2f(fu.y & 0xffff0000u)};
      f32x4 oc, oi;
#pragma unroll
      for (int h = 0; h < 4; ++h) {
        oi[h] = ig[h] + p.b_igate[layer * 8 + d * 4 + h];
        oc[h] = wave_incl_scan(fast_logsigmoid(fg[h] + p.b_fgate[layer * 8 + d * 4 + h]), lane);
      }
      *(f32x4*)(p.BC + ob * 4) = oc; *(f32x4*)(p.IGS + ob * 4) = oi;
    }
    float a[16];
    { float f0[8], f1[8]; unpack8(ldg16(z + ZC_GA + d * 16), f0); unpack8(ldg16(z + ZC_GA + d * 16 + 8), f1);
#pragma unroll
      for (int q = 0; q < 8; ++q) { a[q] = f0[q]; a[8 + q] = f1[q]; } }
    const float* W = wal + (size_t)d * 16 * 128;
#pragma unroll 1
    for (int cg = 0; cg < 4; ++cg) {
#pragma unroll 4
      for (int c = 0; c < 32; ++c) {
        const int ch = cg * 32 + c;
        float zg = p.b_alpha[layer * 256 + d * 128 + ch];
#pragma unroll
        for (int q = 0; q < 16; ++q) zg += a[q] * W[q * 128 + ch];
        stg[lane * 33 + c] = wave_incl_scan(fast_logsigmoid(zg) * (1.0f / 16.0f), lane);
      }
      WAVE_SYNC();
#pragma unroll
      for (int k = 0; k < 32; ++k) { const int pos = k * 2 + (lane >> 5), c = lane & 31; p.GC[(((size_t)b * 2 + d) * TK + 64 * j + pos) * 128 + cg * 32 + c] = stg[pos * 33 + c]; }
      WAVE_SYNC();
    }
  }
}
#define XB_TMO      128
#define XB_XCNT(j)  (256  + 64 * (j))
#define XB_XSUB(j)  (1280 + 64 * (j))
#define XB_XGEN(j)  (2304 + 64 * (j))
#define XB_TOP      3328
#define XB_TOPGEN   3392
#define XCD_BAR_WORDS 3456
#define XB_SPIN_CAP (1u << 28)
#define LAS __attribute__((address_space(3)))

__device__ __forceinline__ unsigned xb_ld(unsigned* p)              { return __hip_atomic_load(p, __ATOMIC_RELAXED, __HIP_MEMORY_SCOPE_AGENT); }
__device__ __forceinline__ unsigned xb_add(unsigned* p, unsigned v) { return __hip_atomic_fetch_add(p, v, __ATOMIC_RELAXED, __HIP_MEMORY_SCOPE_AGENT); }
__device__ __forceinline__ unsigned xb_xcc_id() { return (unsigned)__builtin_amdgcn_s_getreg((3 << 11) | 20) & 0xFu; }
#define XB_SPIN(cond, bar) do { unsigned _sp = 0; while (cond) { __builtin_amdgcn_s_sleep(1); \
    if ((++_sp & 255u) == 0u) { if (xb_ld(&(bar)[XB_TMO])) break; if (_sp > XB_SPIN_CAP) { atomicAdd(&(bar)[XB_TMO], 1u); break; } } } } while (0)

struct XcdBarrier {
    unsigned* bar; unsigned x;
    volatile LAS unsigned* st;
};

__device__ __forceinline__ XcdBarrier xcd_barrier_post(unsigned* bar, volatile LAS unsigned* st) {
    XcdBarrier b; b.bar = bar; b.x = xb_xcc_id(); b.st = st;
    if (threadIdx.x == 0) (void)xb_add(&bar[XB_XCNT(b.x)], 1u);
    return b;
}
__device__ __forceinline__ void xcd_barrier_complete(unsigned* bar, unsigned x, unsigned& nloc, unsigned& nx) {
    const unsigned G = gridDim.x * gridDim.y * gridDim.z;
    unsigned sum, cnt, mine, sp = 0u;
    for (;;) {
        sum = 0u; cnt = 0u; mine = 0u;
#pragma unroll
        for (unsigned j = 0; j < 16; ++j) { const unsigned c = xb_ld(&bar[XB_XCNT(j)]); sum += c; cnt += (c > 0u) ? 1u : 0u; mine = (j == x) ? c : mine; }
        if (sum == G) break;
        __builtin_amdgcn_s_sleep(1);
        if ((++sp & 255u) == 0u) { if (xb_ld(&bar[XB_TMO])) break; if (sp > XB_SPIN_CAP) { atomicAdd(&bar[XB_TMO], 1u); break; } }
    }
    nloc = mine > 0u ? mine : 1u; nx = cnt > 0u ? cnt : 1u;
}

__device__ __forceinline__ void xcd_barrier(const XcdBarrier& b) {
    asm volatile("s_waitcnt vmcnt(0)" ::: "memory");
    __syncthreads();
    if (threadIdx.x == 0) {
        unsigned* bar = b.bar;
        __builtin_amdgcn_s_waitcnt(0);
        unsigned nloc = b.st[0], nx = b.st[1];
        if (nloc == 0u) { xcd_barrier_complete(bar, b.x, nloc, nx); b.st[0] = nloc; b.st[1] = nx; }
        const unsigned old = xb_add(&bar[XB_XSUB(b.x)], 1u);
        const unsigned gen = old / nloc;
        if (old + 1u == (gen + 1u) * nloc) {
            __builtin_amdgcn_fence(__ATOMIC_RELEASE, "agent");
            asm volatile("s_waitcnt vmcnt(0)" ::: "memory");
            const unsigned og = xb_add(&bar[XB_TOP], 1u);
            const unsigned tg = og / nx;
            if (og + 1u == (tg + 1u) * nx) xb_add(&bar[XB_TOPGEN], 1u);
            else XB_SPIN(xb_ld(&bar[XB_TOPGEN]) == tg, bar);
            __builtin_amdgcn_fence(__ATOMIC_ACQUIRE, "agent");
            xb_add(&bar[XB_XGEN(b.x)], 1u);
            asm volatile("s_waitcnt vmcnt(0)" ::: "memory");
        } else {
            XB_SPIN(xb_ld(&bar[XB_XGEN(b.x)]) == gen, bar);
            __builtin_amdgcn_fence(__ATOMIC_ACQUIRE, "agent");
            asm volatile("s_waitcnt vmcnt(0)" ::: "memory");
        }
    }
    __syncthreads();
}

#define GS_LOOP(N, CALL) for (long gi = (long)bid * NTHR + TIDX; gi < (long)(N); gi += (long)nblk * NTHR) { CALL; }
#ifndef PROBE
#define PROBE 0
#endif
#ifndef PROBE_MASK
#define PROBE_MASK 0
#endif
#ifndef FAST_SCAN
#define FAST_SCAN 1
#endif
constexpr int N_PHASES = 16;
constexpr int MEGA_LDS = GEMM_LDS > TOPK_LDS ? GEMM_LDS : TOPK_LDS;

constexpr bool WT_ED_IN_Y = (size_t)NE * FF * D * 2 <= (size_t)R * D * 2;
DI void conv_expert(const Params& p, int which, int layer, char* lds, int bid, int nblk, int busy) {
  __syncthreads();
  if (bid < busy) return;
  if (which == 0) ph_wt(p.w_e_gate + (size_t)layer * NE * D * FF, p.Wt_eg, D, FF, FF, NE, (long)D * FF, (long)FF * D, nullptr, lds, bid - busy, nblk - busy);
  else if (which == 1) ph_wt(p.w_e_up + (size_t)layer * NE * D * FF, p.Wt_eu, D, FF, FF, NE, (long)D * FF, (long)FF * D, nullptr, lds, bid - busy, nblk - busy);
  else ph_wt(p.w_e_down + (size_t)layer * NE * FF * D, p.Wt_ed, FF, D, D, NE, (long)FF * D, (long)D * FF, nullptr, lds, bid - busy, nblk - busy);
}
template <int PH>
DI void run_phase(const Params& p, int l, char* lds, int bid, int nblk) {
  const int need_ctx = (l == 0);
  const int rows = need_ctx ? R : RL;
  const float* xl_in = l == 0 ? p.x : p.out;
  const float* xc_in = l == 0 ? p.ctx : p.xc;
  bf16_t* QRAW = p.YO; bf16_t* KVRAW = p.YO + (size_t)R * 384;
  if constexpr (PH == 0) {
    ph_mods(p, lds, bid, nblk);
#pragma unroll 1
    for (int ll = 0; ll < 2; ++ll) {
      ph_wt(p.w_in + (size_t)ll * D * NZ, p.Wt_in + ll * WSZ_IN, D, NZ, NZP, 1, 0L, 0L, nullptr, lds, bid, nblk);
      ph_wt(p.w_gate + (size_t)ll * D * 4096, p.Wt_gate + ll * WSZ_GATE, D, 4096, 4096, 1, 0L, 0L, nullptr, lds, bid, nblk);
      ph_wt(p.w_branch + (size_t)ll * 4 * 256 * D, p.Wt_branch + ll * WSZ_BR, 256, D, D, 4, (long)256 * D, (long)D * 256, nullptr, lds, bid, nblk);
      ph_wt(p.w_out + (size_t)ll * D * D, p.Wt_out + ll * WSZ_OUT, D, D, D, 1, 0L, 0L, nullptr, lds, bid, nblk);
      ph_wt(p.w_uq + (size_t)ll * 256 * 384, p.Wt_uq + ll * WSZ_UQ, 256, 384, 384, 1, 0L, 0L, p.g_q_lat + ll * 256, lds, bid, nblk);
      ph_wt(p.w_ukv + (size_t)ll * 128 * 512, p.Wt_ukv + ll * WSZ_UKV, 128, 512, 512, 1, 0L, 0L, p.g_kv_lat + ll * 128, lds, bid, nblk);
    }
  } else if constexpr (PH == 1) {
    ph_modulate(p, l, xl_in, xc_in, bid, nblk);
  } else if constexpr (PH == 2) {
    ph_gemm_plain(p.H, D, p.Wt_in + l * WSZ_IN, D, R, NZP, D, p.Z, NZP, lds, bid, nblk);
#if PROBE == 63
    ph_gemm_probe<3>(p.H, D, p.Wt_in + l * WSZ_IN, D, R, NZP, D, p.mods + 40000, lds, bid, nblk);
#elif PROBE == 66
    ph_gemm_probe<6>(p.H, D, p.Wt_in + l * WSZ_IN, D, R, NZP, D, p.mods + 40000, lds, bid, nblk);
#elif PROBE == 67
    ph_gemm_plain<1>(p.H, D, p.Wt_in + l * WSZ_IN, D, R, NZP, D, p.Z, NZP, lds, bid, nblk);
#elif PROBE == 68
    ph_gemm_plain<2>(p.H, D, p.Wt_in + l * WSZ_IN, D, R, NZP, D, p.Z, NZP, lds, bid, nblk);
#elif PROBE == 5
    ph_gemm_plain(p.H, D, p.Wt_in + l * WSZ_IN, D, R, NZP, D, p.Z, NZP, lds, bid, nblk);
#endif
  } else if constexpr (PH == 3) {
    ph_mla_up(p, l, QRAW, KVRAW, lds, bid, nblk);
  } else if constexpr (PH == 4) {
    ph_prep(p, l, QRAW, KVRAW, lds, bid, nblk);
#if PROBE == 41
    ph_prep(p, l, QRAW, KVRAW, lds, bid, nblk);
#elif PROBE == 43
    ph_prep<1>(p, l, QRAW, KVRAW, lds, bid, nblk);
#elif PROBE == 44
    ph_prep<2>(p, l, QRAW, KVRAW, lds, bid, nblk);
#endif
    __syncthreads();
    ph_gates_cum(p, l, lds, bid, nblk);
#if PROBE == 42
    ph_gates_cum(p, l, lds, bid, nblk);
#endif
  } else if constexpr (PH == 5) {
#if FAST_SCAN
    ph_ml_local(p, lds, bid, nblk);
    ph_gla_local(p, lds, bid, nblk);
#else
    GS_LOOP((long)NUNIT * 4160, nvb_ml_local(gi, p));
    GS_LOOP((long)NUNIT * 2048, nvb_gla_local(gi, p));
#endif
  } else if constexpr (PH == 6) {
#if FAST_SCAN
    ph_ml_scan(p, bid, nblk);
    ph_gla_scan(p, (bid + nblk - 260 % nblk) % nblk, nblk);
#else
    GS_LOOP((long)NB * 2 * 4 * 4160, nvb_ml_scan(gi, p));
    GS_LOOP((long)NB * 2 * 4 * 2048, nvb_gla_scan(gi, p));
#endif
    ph_attn(p, l, need_ctx, lds, bid, nblk);
#if PROBE >= 10 && PROBE < 20
    if (l == 0) ph_attn_mla_probe<PROBE - 10>(p, lds, bid, nblk);
#elif PROBE == 1
    ph_attn_diff(p, l, need_ctx, lds, bid, nblk);
#elif PROBE == 2
    ph_attn_mla(p, need_ctx, lds, bid, nblk);
#endif
  } else if constexpr (PH == 7) {
#if FAST_SCAN
    ph_ml_out(p, l, need_ctx, lds, bid, nblk);
    ph_gla_out(p, l, need_ctx, lds, bid, nblk);
#else
    GS_LOOP((long)NUNIT * 4096, nvb_ml_out(gi, p, need_ctx));
    GS_LOOP((long)NUNIT * 4096, nvb_gla_out(gi, p, need_ctx));
#endif
  } else if constexpr (PH == 8) {
#if !FAST_SCAN
    GS_LOOP((long)R * 4, nvb_ml_finish(gi, p, l, need_ctx));
    GS_LOOP((long)R * 4, nvb_gla_finish(gi, p, l, need_ctx));
#endif
  } else if constexpr (PH == 9) {
    ph_merge(p, l, rows, lds, bid, nblk);
#if PROBE == 3
    ph_merge(p, l, rows, lds, bid, nblk);
#endif
    if (l == 0) conv_expert(p, 1, 0, lds, bid, nblk, ((rows / 128) * (D / 64)) % nblk);
  } else if constexpr (PH == 10) {
    ph_gemm_plain(p.MG, D, p.Wt_out + l * WSZ_OUT, D, rows, D, D, p.YO, D, lds, bid, nblk);
    if (WT_ED_IN_Y && l == 0) conv_expert(p, 2, 0, lds, bid, nblk, ((rows / 128) * (D / 128)) % nblk);
  } else if constexpr (PH == 11) {
    ph_resid_mix(p, l, xl_in, xc_in, rows, lds, bid, nblk);
  } else if constexpr (PH == 12) {
    ph_topk(p, need_ctx, lds, bid, nblk);
    const int tkb = NB * NE * 2 < nblk ? NB * NE * 2 : 0;
    conv_expert(p, 0, l, lds, bid, nblk, tkb);
    if (l == 1) conv_expert(p, 1, 1, lds, bid, nblk, tkb);
    if (l == 1 || !WT_ED_IN_Y) conv_expert(p, 2, l, lds, bid, nblk, tkb);
  } else if constexpr (PH == 13) {
    ph_moe1(p, need_ctx, lds, bid, nblk);
#if PROBE == 4
    ph_moe1(p, need_ctx, lds, bid, nblk);
#endif
  } else if constexpr (PH == 14) {
    ph_moe2(p, need_ctx, lds, bid, nblk);
#if PROBE == 4
    ph_moe2(p, need_ctx, lds, bid, nblk);
#endif
  } else if constexpr (PH == 15) {
    ph_resid_ffn(p, l, rows, bid, nblk);
  }
}

template <int PH> __global__ void __launch_bounds__(256, 2) k_phase(Params p, int l) {
  DYN_LDS(lds);
  run_phase<PH>(p, l, lds, blockIdx.x, gridDim.x);
}

#if !defined(CPU_EMU) && !MK_MULTI
typedef const Params __attribute__((address_space(4)))* KParams;
DI KParams kp_fresh() { KParams k = (KParams)__builtin_amdgcn_kernarg_segment_ptr(); asm volatile("" : "+s"(k)); return k; }
#define PHASE(PH, L) do { asm volatile("; PHASE_MARK " #PH); KParams k_ = kp_fresh(); run_phase<PH>(*(const Params*)k_, (L), lds, bid, nblk); if (PROBE == 20 + PH || ((PROBE_MASK >> PH) & 1) || (PROBE == 100 + PH && (L) == 0) || (PROBE == 99 && (PH == 4 || PH == 5))) { __syncthreads(); run_phase<PH>(*(const Params*)k_, (L), lds, bid, nblk); } XcdBarrier b_ = bar; asm volatile("" : "+s"(b_.bar), "+s"(b_.x)); xcd_barrier(b_); if (PROBE == 50) xcd_barrier(b_); } while (0)
__global__ void __launch_bounds__(256, 2) k_mega(Params pv) {
  DYN_LDS(lds_all);
  if (threadIdx.x == 0) *(uint4*)lds_all = make_uint4(0u, 0u, 0u, 0u);
  __syncthreads();
  XcdBarrier bar = xcd_barrier_post(pv.bar, (volatile LAS unsigned*)lds_all);
  char* lds = lds_all + 256;
  const int bid = blockIdx.x, nblk = gridDim.x;
  PHASE(0, 0);
#pragma unroll 1
  for (int l = 0; l < 2; ++l) {
    if (l == 0) PHASE(1, l);
    PHASE(2, l); PHASE(3, l); PHASE(4, l); PHASE(5, l); PHASE(6, l); PHASE(7, l);
#if !FAST_SCAN
    PHASE(8, l);
#endif

    PHASE(9, l); PHASE(10, l); PHASE(11, l); PHASE(12, l); PHASE(13, l); PHASE(14, l); PHASE(15, l);
  }
}
#endif
#ifdef CPU_EMU
void emu_check(const Params& p, int layer, int stage);
#define EMU_CHECK(stg) emu_check(p, l, stg)
static int g_nlayers = getenv("NLAYERS") ? atoi(getenv("NLAYERS")) : 2;
#else
#define EMU_CHECK(stg)
#endif
static void fill_params(Params& p, void* const* d_in, void* d_out, void* d_ws) {
  const float** f = (const float**)&p;
  for (int i = 0; i < 33; ++i) f[i] = (const float*)d_in[i];
  p.out = (float*)d_out;
  map_workspace(p, (char*)d_ws);
}
#define LAUNCH_PHASE(PH, L) LAUNCH((k_phase<PH>), grid, 256, MEGA_LDS, stream, p, L)

extern "C" void kernel_launch(void* const* d_in, const int* in_sizes, int n_in, void* d_out, int out_size, void* d_ws,
                              size_t ws_size, hipStream_t stream) {
  Params p{};
  fill_params(p, d_in, d_out, d_ws);
  if (p.ws_need > ws_size) return;
#ifdef CPU_EMU
  const int grid = 16;
  LAUNCH_PHASE(0, 0);
  for (int l = 0; l < g_nlayers; ++l) {
    if (l == 0) LAUNCH_PHASE(1, l);
    LAUNCH_PHASE(2, l); LAUNCH_PHASE(3, l); LAUNCH_PHASE(4, l); LAUNCH_PHASE(5, l); LAUNCH_PHASE(6, l); LAUNCH_PHASE(7, l); LAUNCH_PHASE(8, l);
    EMU_CHECK(1);
    LAUNCH_PHASE(9, l); LAUNCH_PHASE(10, l); LAUNCH_PHASE(11, l);
    EMU_CHECK(2);
    LAUNCH_PHASE(12, l); LAUNCH_PHASE(13, l); LAUNCH_PHASE(14, l); LAUNCH_PHASE(15, l);
    EMU_CHECK(3);
  }
#else
  static int grid = 0;
  if (grid == 0) {
    int dev = 0, cus = 0, per_cu = 0;
    (void)hipGetDevice(&dev);
    (void)hipDeviceGetAttribute(&cus, hipDeviceAttributeMultiprocessorCount, dev);
#if MK_MULTI
    (void)hipFuncSetAttribute((const void*)k_phase<0>, hipFuncAttributeMaxDynamicSharedMemorySize, MEGA_LDS);
    (void)hipFuncSetAttribute((const void*)k_phase<1>, hipFuncAttributeMaxDynamicSharedMemorySize, MEGA_LDS);
    (void)hipFuncSetAttribute((const void*)k_phase<2>, hipFuncAttributeMaxDynamicSharedMemorySize, MEGA_LDS);
    (void)hipFuncSetAttribute((const void*)k_phase<3>, hipFuncAttributeMaxDynamicSharedMemorySize, MEGA_LDS);
    (void)hipFuncSetAttribute((const void*)k_phase<4>, hipFuncAttributeMaxDynamicSharedMemorySize, MEGA_LDS);
    (void)hipFuncSetAttribute((const void*)k_phase<5>, hipFuncAttributeMaxDynamicSharedMemorySize, MEGA_LDS);
    (void)hipFuncSetAttribute((const void*)k_phase<6>, hipFuncAttributeMaxDynamicSharedMemorySize, MEGA_LDS);
    (void)hipFuncSetAttribute((const void*)k_phase<7>, hipFuncAttributeMaxDynamicSharedMemorySize, MEGA_LDS);
    (void)hipFuncSetAttribute((const void*)k_phase<8>, hipFuncAttributeMaxDynamicSharedMemorySize, MEGA_LDS);
    (void)hipFuncSetAttribute((const void*)k_phase<9>, hipFuncAttributeMaxDynamicSharedMemorySize, MEGA_LDS);
    (void)hipFuncSetAttribute((const void*)k_phase<10>, hipFuncAttributeMaxDynamicSharedMemorySize, MEGA_LDS);
    (void)hipFuncSetAttribute((const void*)k_phase<11>, hipFuncAttributeMaxDynamicSharedMemorySize, MEGA_LDS);
    (void)hipFuncSetAttribute((const void*)k_phase<12>, hipFuncAttributeMaxDynamicSharedMemorySize, MEGA_LDS);
    (void)hipFuncSetAttribute((const void*)k_phase<13>, hipFuncAttributeMaxDynamicSharedMemorySize, MEGA_LDS);
    (void)hipFuncSetAttribute((const void*)k_phase<14>, hipFuncAttributeMaxDynamicSharedMemorySize, MEGA_LDS);
    (void)hipFuncSetAttribute((const void*)k_phase<15>, hipFuncAttributeMaxDynamicSharedMemorySize, MEGA_LDS);
    grid = (cus > 0 ? cus : 256) * 2;
#else
    if (hipFuncSetAttribute((const void*)k_mega, hipFuncAttributeMaxDynamicSharedMemorySize, MEGA_LDS + 256) != hipSuccess) { grid = -1; return; }
    if (hipOccupancyMaxActiveBlocksPerMultiprocessor(&per_cu, (const void*)k_mega, 256, MEGA_LDS + 256) != hipSuccess) per_cu = 0;
    (void)hipGetLastError();
    if (per_cu < 1) { grid = -1; return; }
    grid = (cus > 0 ? cus : 256) * (per_cu < 2 ? per_cu : 2);
#endif
  }
  if (grid < 0) return;
#if MK_MULTI
  LAUNCH_PHASE(0, 0);
  for (int l = 0; l < 2; ++l) {
    if (l == 0) LAUNCH_PHASE(1, l);
    LAUNCH_PHASE(2, l); LAUNCH_PHASE(3, l); LAUNCH_PHASE(4, l); LAUNCH_PHASE(5, l); LAUNCH_PHASE(6, l); LAUNCH_PHASE(7, l); LAUNCH_PHASE(8, l);
    LAUNCH_PHASE(9, l); LAUNCH_PHASE(10, l); LAUNCH_PHASE(11, l); LAUNCH_PHASE(12, l); LAUNCH_PHASE(13, l); LAUNCH_PHASE(14, l); LAUNCH_PHASE(15, l);
  }
#else
  (void)hipMemsetAsync(p.bar, 0, XCD_BAR_WORDS * sizeof(unsigned), stream);
  k_mega<<<dim3(grid), dim3(256), MEGA_LDS + 256, stream>>>(p);
#endif
#endif
}
```

```cpp
#ifndef CPU_EMU
#include <hip/hip_runtime.h>
#endif
#include <stdint.h>
#include <stddef.h>

#ifndef T_LAT
#define T_LAT 16384
#endif
#ifndef T_CTX
#define T_CTX 256
#endif

#ifndef MK_MULTI
#define MK_MULTI 0
#endif
#define DI __device__ __forceinline__
typedef unsigned short bf16_t;
typedef short bf16x8 __attribute__((ext_vector_type(8)));
typedef short s16x4 __attribute__((ext_vector_type(4)));
typedef float f32x4 __attribute__((ext_vector_type(4)));
typedef float f32x16 __attribute__((ext_vector_type(16)));
typedef unsigned u32x4 __attribute__((ext_vector_type(4)));
typedef unsigned u32x2 __attribute__((ext_vector_type(2)));
typedef float f32x2 __attribute__((ext_vector_type(2)));

#ifdef CPU_EMU
static inline float u2f(unsigned u) { float f; memcpy(&f, &u, 4); return f; }
static inline unsigned f2u(float f) { unsigned u; memcpy(&u, &f, 4); return u; }
#define MFMA32(a, b, c) emu_mfma_32x32x16((a), (b), (c))
#define MFMA16(a, b, c) emu_mfma_16x16x32((a), (b), (c))
static inline float fast_exp2(float x) { return exp2f(x); }
static inline float fast_rcp(float x) { return 1.0f / x; }
static inline float fast_rsq(float x) { return 1.0f / sqrtf(x); }
static inline float hw_sin_rev(float x) { return sinf(6.283185307179586f * x); }
static inline float hw_cos_rev(float x) { return cosf(6.283185307179586f * x); }
#define LAUNCH(kern, grid, block, lds, stream, ...) emu::launch(dim3(grid), dim3(block), (size_t)(lds), [=]() { kern(__VA_ARGS__); })
#define DYN_LDS(name) char* name = emu_dynlds()
#define SCHED_BARRIER()
#define TIDX ((int)threadIdx.x)
#define WAVE_SYNC() emu::wave_barrier()
#define SETPRIO(x)
#define IGLP_OPT()
template <int M> static inline float xor_sum(float v) { return v + __shfl_xor(v, M); }
template <int M> static inline float xor_max(float v) { return fmaxf(v, __shfl_xor(v, M)); }
template <int M> static inline int xor_sum_i(int v) { return v + __shfl_xor(v, M); }
static inline int lane_bcast(int v, int src) { return __shfl(v, src); }
static inline float lane_get(float v, int src) { return __shfl(v, src); }
static inline int lane_up(int v, int d, int lane) { (void)lane; return __shfl_up(v, d); }
#else
DI float u2f(unsigned u) { return __uint_as_float(u); }
DI unsigned f2u(float f) { return __float_as_uint(f); }
#define MFMA32(a, b, c) __builtin_amdgcn_mfma_f32_32x32x16_bf16((a), (b), (c), 0, 0, 0)
#define MFMA16(a, b, c) __builtin_amdgcn_mfma_f32_16x16x32_bf16((a), (b), (c), 0, 0, 0)
DI float fast_exp2(float x) { return __builtin_amdgcn_exp2f(x); }
DI float fast_rcp(float x) { return __builtin_amdgcn_rcpf(x); }
DI float fast_rsq(float x) { return __builtin_amdgcn_rsqf(x); }
DI float hw_sin_rev(float x) { return __builtin_amdgcn_sinf(x); }
DI float hw_cos_rev(float x) { return __builtin_amdgcn_cosf(x); }
#define LAUNCH(kern, grid, block, lds, stream, ...) kern<<<dim3(grid), dim3(block), (lds), (stream)>>>(__VA_ARGS__)
#define DYN_LDS(name) extern __shared__ __attribute__((aligned(16))) char name[]
#define SCHED_BARRIER() __builtin_amdgcn_sched_barrier(0)
DI int tid_fresh() { int t = (int)threadIdx.x; asm volatile("" : "+v"(t)); return t; }
#define TIDX tid_fresh()
#define WAVE_SYNC() __builtin_amdgcn_wave_barrier()
#define SETPRIO(x) __builtin_amdgcn_s_setprio(x)
#define IGLP_OPT() __builtin_amdgcn_iglp_opt(0)
#ifdef USE_SHFL
template <int M> DI float xor_sum(float v) { return v + __shfl_xor(v, M); }
template <int M> DI float xor_max(float v) { return fmaxf(v, __shfl_xor(v, M)); }
template <int M> DI int xor_sum_i(int v) { return v + __shfl_xor(v, M); }
DI int lane_bcast(int v, int src) { return __shfl(v, src); }
DI int lane_up(int v, int d, int lane) { (void)lane; return __shfl_up(v, d); }
#else
template <int M> DI int xor_partner_bits(int bits) { return __builtin_amdgcn_ds_swizzle(bits, (M << 10) | 0x1f); }
DI void half_swap(unsigned& a, unsigned& b) { asm volatile("s_nop 1\n\tv_permlane32_swap_b32 %0, %1\n\ts_nop 1" : "+v"(a), "+v"(b)); }
template <int M> DI float xor_sum(float v) {
  if constexpr (M < 32) return v + __builtin_bit_cast(float, xor_partner_bits<M>(__builtin_bit_cast(int, v)));
  else { unsigned a = __builtin_bit_cast(unsigned, v), b = a; half_swap(a, b); return __builtin_bit_cast(float, a) + __builtin_bit_cast(float, b); }
}
template <int M> DI float xor_max(float v) {
  if constexpr (M < 32) return fmaxf(v, __builtin_bit_cast(float, xor_partner_bits<M>(__builtin_bit_cast(int, v))));
  else { unsigned a = __builtin_bit_cast(unsigned, v), b = a; half_swap(a, b); return fmaxf(__builtin_bit_cast(float, a), __builtin_bit_cast(float, b)); }
}
template <int M> DI int xor_sum_i(int v) {
  if constexpr (M < 32) return v + xor_partner_bits<M>(v);
  else { unsigned a = (unsigned)v, b = a; half_swap(a, b); return (int)(a + b); }
}
DI int lane_bcast(int v, int src) { return __builtin_amdgcn_readlane(v, src); }
DI float lane_get(float v, int src) { return __builtin_bit_cast(float, __builtin_amdgcn_ds_bpermute(src << 2, __builtin_bit_cast(int, v))); }
DI int lane_up(int v, int d, int lane) { return __builtin_amdgcn_ds_bpermute(((lane - d) & 63) << 2, v); }
#endif
#endif

DI float bf2f(bf16_t v) { return u2f(((unsigned)v) << 16); }
#ifdef CPU_EMU
DI bf16_t f2bf(float f) { unsigned u = f2u(f); u += 0x7fffu + ((u >> 16) & 1u); return (bf16_t)(u >> 16); }
DI unsigned pack2bf(float lo, float hi) { return (unsigned)f2bf(lo) | ((unsigned)f2bf(hi) << 16); }
static inline unsigned wave_ballot16(bool pr) { unsigned m = 0; for (int e = 0; e < 16; ++e) m |= (__shfl(pr ? 1 : 0, e) ? 1u : 0u) << e; return m; }
static inline bool wave_any(bool pr) { int v = pr ? 1 : 0; v |= __shfl_xor(v, 1); v |= __shfl_xor(v, 2); v |= __shfl_xor(v, 4); v |= __shfl_xor(v, 8); v |= __shfl_xor(v, 16); v |= __shfl_xor(v, 32); return v != 0; }
#else
typedef float f32x2_ __attribute__((ext_vector_type(2)));
typedef __bf16 bf16x2_hw __attribute__((ext_vector_type(2)));
DI unsigned pack2bf(float lo, float hi) { const f32x2_ v = {lo, hi}; return __builtin_bit_cast(unsigned, __builtin_convertvector(v, bf16x2_hw)); }
DI bf16_t f2bf(float f) { return (bf16_t)(pack2bf(f, f) & 0xffffu); }
DI bool wave_any(bool pr) { return __builtin_amdgcn_ballot_w64(pr) != 0ull; }
DI unsigned wave_ballot16(bool pr) { return (unsigned)__builtin_amdgcn_ballot_w64(pr) & 0xffffu; }
#endif
DI float sigmoidf_(float x) { return 1.0f / (1.0f + expf(-x)); }
DI float siluf_(float x) { return x / (1.0f + expf(-x)); }
DI float logsigmoidf_(float x) { return fminf(x, 0.0f) - log1pf(expf(-fabsf(x))); }

constexpr int D = 1024, NB = 2, TL = T_LAT, TC = T_CTX, TK = TL + TC;
constexpr int RL = NB * TL, RC = NB * TC, R = RL + RC;
constexpr int NZ = 3024, NZP = 3072;
constexpr int ZC_QLAT = 0, ZC_KVLAT = 256, ZC_KROPE = 384, ZC_MLQK = 416, ZC_MLV = 928, ZC_MLO = 1184, ZC_MLIG = 1440,
              ZC_MLFG = 1448, ZC_GQ = 1456, ZC_GK = 1584, ZC_GV = 1712, ZC_GR = 1968, ZC_GA = 2224, ZC_DQ = 2256,
              ZC_DK = 2512, ZC_DV = 2768;
constexpr int NCK = TK / 64, NCC = TC / 64, NCL = TL / 64;
constexpr int NE = 16, FF = 1408, CAPL = 2 * TL / 16, CAPC = 2 * TC / 16, CAPT = CAPL + CAPC, NSLOT = NB * CAPT;
constexpr size_t WSZ_IN = (size_t)NZP * D, WSZ_UQ = 384 * 256, WSZ_UKV = 512 * 128, WSZ_GATE = (size_t)4096 * D, WSZ_BR = (size_t)4 * D * 256, WSZ_OUT = (size_t)D * D;
constexpr int NUNIT = NB * 2 * NCK * 4;
constexpr float LOG2E = 1.4426950408889634f;
constexpr float QS_MLA = 0.10206207261596577f * LOG2E;
constexpr float QS_DIFF = 0.17677669529663687f * LOG2E;

DI int row_of(int b, int s) { return s < TC ? RL + b * TC + s : b * TL + (s - TC); }
DI void bs_of(int r, int& b, int& s) { if (r < RL) { b = r / TL; s = TC + (r % TL); } else { int q = r - RL; b = q / TC; s = q % TC; } }
DI int seq_of(int d, int p) { return d == 0 ? p : (p < TC ? TC - 1 - p : TK - 1 - (p - TC)); }
DI int step_of(int d, int c) { return d == 0 ? c : (c < NCC ? NCC - 1 - c : NCC + (NCK - 1 - c)); }

struct Params {
  const float *x, *c, *ctx, *c_ctx, *w_ada, *b_ada, *g_mix_pre, *g_mix_post, *g_ffn_pre, *g_ffn_post, *w_in, *g_q_lat, *w_uq,
      *g_kv_lat, *w_ukv, *w_conv, *b_conv, *b_igate, *b_fgate, *g_mlstm_out, *w_alpha2, *b_alpha, *g_gla_out, *diff_lambda,
      *g_diff_out, *w_branch, *w_gate, *b_gate, *w_out, *w_router, *w_e_gate, *w_e_up, *w_e_down;
  float* out;
  float *mods, *xc;
  bf16_t *H, *Z, *Qm, *Km, *Vtm, *Qd, *Kd, *Vtd, *MQ, *MK, *Y, *MG, *YO, *HID, *YE, *MVt, *GVt;
  float *BC, *IGS, *GC, *MC, *MN, *MM, *GS, *HD, *OD, *AFF, *SELV;
  int *SEL, *INV;
  bf16_t *Wt_in, *Wt_uq, *Wt_ukv, *Wt_gate, *Wt_branch, *Wt_out, *Wt_eg, *Wt_eu, *Wt_ed;
  unsigned* bar;
  size_t ws_need;
};

static inline size_t al256(size_t x) { return (x + 255) & ~(size_t)255; }
static inline void map_workspace(Params& p, char* ws) {
  size_t o = 0;
  auto take = [&](size_t bytes) { size_t r = o; o += al256(bytes); return ws + r; };
  p.bar = (unsigned*)take(16384);
  p.mods = (float*)take((size_t)2 * 3 * 6144 * 4);
  p.xc = (float*)take((size_t)RC * D * 4);
  p.BC = (float*)take((size_t)NB * 2 * TK * 4 * 4);
  p.IGS = (float*)take((size_t)NB * 2 * TK * 4 * 4);
  p.AFF = (float*)take((size_t)NB * NE * TK * 4);
  p.SEL = (int*)take((size_t)NE * NSLOT * 4);
  p.SELV = (float*)take((size_t)NE * NSLOT * 4);
  p.INV = (int*)take((size_t)R * NE * 4);
  p.MM = (float*)take((size_t)NUNIT * 4 * 4);
  p.MN = (float*)take((size_t)NUNIT * 64 * 4);
  p.Wt_in = (bf16_t*)take((size_t)2 * WSZ_IN * 2);
  p.Wt_uq = (bf16_t*)take((size_t)2 * WSZ_UQ * 2);
  p.Wt_ukv = (bf16_t*)take((size_t)2 * WSZ_UKV * 2);
  p.Wt_gate = (bf16_t*)take((size_t)2 * WSZ_GATE * 2);
  p.Wt_branch = (bf16_t*)take((size_t)2 * WSZ_BR * 2);
  p.Wt_out = (bf16_t*)take((size_t)2 * WSZ_OUT * 2);
  p.H = (bf16_t*)take((size_t)R * D * 2);
  size_t szA = (size_t)R * NZP * 2, szHID = (size_t)NE * NSLOT * FF * 2;
  char* A = take(szA > szHID ? szA : szHID);
  p.Z = (bf16_t*)A; p.HID = (bf16_t*)A;
  size_t szQm = al256((size_t)NB * 4 * TK * 96 * 2), szVt = al256((size_t)NB * 4 * 64 * TK * 2), szQd = al256((size_t)NB * 8 * TK * 32 * 2);
  size_t szB1 = 2 * szQm + 2 * szVt + 2 * szQd;
  size_t szHD = al256((size_t)2 * NB * TK * 256 * 4);
  size_t szYE = (size_t)NE * NSLOT * D * 2;
  size_t szB = szB1; if (2 * szHD > szB) szB = 2 * szHD; if (szYE > szB) szB = szYE;
  char* Bq = take(szB);
  p.Qm = (bf16_t*)Bq; p.Km = (bf16_t*)(Bq + szQm); p.Vtm = (bf16_t*)(Bq + 2 * szQm);
  p.Qd = (bf16_t*)(Bq + 2 * szQm + szVt); p.Kd = (bf16_t*)(Bq + 2 * szQm + szVt + szQd); p.Vtd = (bf16_t*)(Bq + 2 * szQm + szVt + 2 * szQd);
  p.YE = (bf16_t*)Bq;
  p.GC = (float*)take((size_t)NB * 2 * TK * 128 * 4);
  p.MVt = (bf16_t*)take((size_t)NB * 4 * 64 * TK * 2);
  p.GVt = (bf16_t*)take((size_t)NB * 4 * 64 * TK * 2);
  size_t szW = (size_t)NE * FF * D * 2;
  size_t szMC = (size_t)NUNIT * 4096 * 4, szRD = (size_t)R * D * 2;
  size_t szC = szMC; if (szRD > szC) szC = szRD; if (szW > szC) szC = szW;
  char* C = take(szC);
  p.MC = (float*)C; p.MG = (bf16_t*)C; p.Wt_eg = (bf16_t*)C;
  size_t szMQ = al256((size_t)NB * TK * 256 * 2), szGS = (size_t)NUNIT * 2048 * 4;
  size_t szD = 2 * szMQ + szGS; if (szW > szD) szD = szW;
  char* Dq = take(szD);
  p.MQ = (bf16_t*)Dq; p.MK = (bf16_t*)(Dq + szMQ); p.GS = (float*)(Dq + 2 * szMQ); p.Wt_eu = (bf16_t*)Dq;
  size_t szF = 2 * szRD > szW ? 2 * szRD : szW;
  char* F = take(szF);
  p.Y = (bf16_t*)F; p.YO = (bf16_t*)(F + szRD); p.Wt_ed = (bf16_t*)F;
  p.HD = (float*)Bq; p.OD = (float*)(Bq + szHD);
  p.ws_need = o;
}
#define GTID ((long)blockIdx.x * blockDim.x + threadIdx.x)

DI float lam_of(const Params& p, int layer, float& lam_init) {
  const float* lv = p.diff_lambda + layer * 128;
  float s1 = 0.f, s2 = 0.f;
  for (int i = 0; i < 32; ++i) { s1 += lv[i] * lv[32 + i]; s2 += lv[64 + i] * lv[96 + i]; }
  lam_init = layer == 0 ? 0.2f : 0.35550906759096f;
  return expf(s1) - expf(s2) + lam_init;
}
DI void rope_cs(int s, int jj, float& cs, float& sn) {
  int t = s - TC;
  int pos = (jj < 16) ? (t / 64) : (t % 64);
  float ang = (float)pos * exp2f(-1.6609640474436813f * (float)(jj & 7));
  double rev = (double)ang * 0.15915494309189535;
  rev -= floor(rev + 0.5);
  float rf = (float)rev;
  cs = hw_cos_rev(rf); sn = hw_sin_rev(rf);
}
template <class G> DI float rope_elem(G get, int s, int jj) {
  if (s < TC) return get(jj);
  float cs, sn; rope_cs(s, jj, cs, sn);
  float a = get(jj), b = get(jj ^ 8);
  return (jj & 8) ? (a * cs + b * sn) : (a * cs - b * sn);
}

DI void nvb_mods(long GI, const Params& p) {
  long i = GI; if (i >= 2 * 3 * 6144) return;
  int col = (int)(i % 6144), w = (int)((i / 6144) % 3), l = (int)(i / (3 * 6144));
  const float* cv = w < 2 ? p.c + w * 1024 : p.c_ctx;
  const float* W = p.w_ada + (size_t)l * 1024 * 6144;
  float acc = 0.f;
  for (int k = 0; k < 1024; ++k) acc += siluf_(cv[k]) * W[(size_t)k * 6144 + col];
  p.mods[i] = acc + p.b_ada[l * 6144 + col];
}
__global__ void __launch_bounds__(256) nv_wt(const float* in, bf16_t* out, int K, int N, int NP, long in_bs, long out_bs, const float* gain) {
  long i = GTID; if (i >= (long)NP * K) return;
  int k = (int)(i % K), n = (int)(i / K);
  const float* I = in + (size_t)blockIdx.y * in_bs; bf16_t* O = out + (size_t)blockIdx.y * out_bs;
  O[(size_t)n * K + k] = n < N ? f2bf(I[(size_t)k * N + n] * (gain ? gain[k] : 1.0f)) : (bf16_t)0;
}
__global__ void __launch_bounds__(256) nv_modulate(Params p, int layer, int which, const float* xl, const float* xcx, int nrows) {
  long r = GTID; if (r >= nrows) return;
  int w = r < RL ? (int)(r / TL) : 2;
  const float* mb = p.mods + (size_t)(layer * 3 + w) * 6144;
  const float* shift = mb + (which ? 3 : 0) * 1024; const float* scale = mb + (which ? 4 : 1) * 1024;
  const float* g = (which ? p.g_ffn_pre : p.g_mix_pre) + layer * 1024;
  const float* x = r < RL ? xl + (size_t)r * D : xcx + (size_t)(r - RL) * D;
  float ss = 0.f; for (int k = 0; k < D; ++k) ss += x[k] * x[k];
  float rstd = 1.0f / sqrtf(ss / D + 1e-6f);
  for (int k = 0; k < D; ++k) p.H[(size_t)r * D + k] = f2bf(x[k] * rstd * g[k] * (1.f + scale[k]) + shift[k]);
}
__global__ void __launch_bounds__(256) nv_gemm(const bf16_t* A, int lda, const bf16_t* Bt, int ldb, int M, int N, int K, bf16_t* C, int ldc) {
  long i = GTID; if (i >= (long)M * N) return;
  int n = (int)(i % N), m = (int)(i / N);
  const bf16_t* a = A + (size_t)m * lda; const bf16_t* b = Bt + (size_t)n * ldb;
  float acc = 0.f;
  for (int k = 0; k < K; ++k) acc += bf2f(a[k]) * bf2f(b[k]);
  C[(size_t)m * ldc + n] = f2bf(acc);
}
__global__ void __launch_bounds__(256) nv_mla_q(Params p, int layer) {
  long i = GTID; if (i >= (long)R * 4 * 96) return;
  int j = (int)(i % 96), h = (int)((i / 96) % 4), r = (int)(i / 384);
  int b, s; bs_of(r, b, s);
  const bf16_t* z = p.Z + (size_t)r * NZP + ZC_QLAT;
  const float* g = p.g_q_lat + layer * 256; const float* W = p.w_uq + (size_t)layer * 256 * 384;
  float ss = 0.f; for (int k = 0; k < 256; ++k) { float v = bf2f(z[k]); ss += v * v; }
  float rstd = 1.0f / sqrtf(ss / 256 + 1e-6f);
  auto dot = [&](int col) { float a = 0.f; for (int k = 0; k < 256; ++k) a += bf2f(z[k]) * rstd * g[k] * W[(size_t)k * 384 + col]; return a; };
  float v;
  if (j < 64) v = dot(h * 96 + j);
  else v = rope_elem([&](int jj) { return dot(h * 96 + 64 + jj); }, s, j - 64);
  p.Qm[(((size_t)b * 4 + h) * TK + s) * 96 + j] = f2bf(v * QS_MLA);
}
__global__ void __launch_bounds__(256) nv_mla_kv(Params p, int layer) {
  long i = GTID; if (i >= (long)R * 4 * 160) return;
  int j = (int)(i % 160), h = (int)((i / 160) % 4), r = (int)(i / 640);
  int b, s; bs_of(r, b, s);
  const bf16_t* z = p.Z + (size_t)r * NZP;
  if (j < 128) {
    const bf16_t* zl = z + ZC_KVLAT; const float* g = p.g_kv_lat + layer * 128; const float* W = p.w_ukv + (size_t)layer * 128 * 512;
    float ss = 0.f; for (int k = 0; k < 128; ++k) { float v = bf2f(zl[k]); ss += v * v; }
    float rstd = 1.0f / sqrtf(ss / 128 + 1e-6f);
    float a = 0.f; for (int k = 0; k < 128; ++k) a += bf2f(zl[k]) * rstd * g[k] * W[(size_t)k * 512 + h * 128 + j];
    if (j < 64) p.Km[(((size_t)b * 4 + h) * TK + s) * 96 + j] = f2bf(a);
    else p.Vtm[(((size_t)b * 4 + h) * 64 + (j - 64)) * TK + s] = f2bf(a);
  } else {
    int jj = j - 128;
    float v = rope_elem([&](int q) { return bf2f(z[ZC_KROPE + q]); }, s, jj);
    p.Km[(((size_t)b * 4 + h) * TK + s) * 96 + 64 + jj] = f2bf(v);
  }
}
__global__ void __launch_bounds__(256) nv_diff_prep(Params p) {
  long i = GTID; if (i >= (long)R * 768) return;
  int c = (int)(i % 768), r = (int)(i / 768);
  int b, s; bs_of(r, b, s);
  const bf16_t* z = p.Z + (size_t)r * NZP;
  if (c < 512) {
    int qk = c / 256, cc = c % 256, hm = cc / 32, jj = cc % 32;
    const bf16_t* src = z + (qk ? ZC_DK : ZC_DQ) + hm * 32;
    float v = rope_elem([&](int q) { return bf2f(src[q]); }, s, jj);
    if (qk == 0) p.Qd[(((size_t)b * 8 + hm) * TK + s) * 32 + jj] = f2bf(v * QS_DIFF);
    else p.Kd[(((size_t)b * 8 + hm) * TK + s) * 32 + jj] = f2bf(v);
  } else {
    int cc = c - 512, h = cc / 64, dv = cc % 64;
    p.Vtd[(((size_t)b * 4 + h) * 64 + dv) * TK + s] = z[ZC_DV + cc];
  }
}
__global__ void __launch_bounds__(256) nv_ml_prep(Params p, int layer) {
  long i = GTID; if (i >= (long)R * 512) return;
  int ch = (int)(i % 512), r = (int)(i / 512);
  int b, s; bs_of(r, b, s);
  bool first = (s == 0) || (s == TC), last = (s == TC - 1) || (s == TK - 1);
  const float* w = p.w_conv + (size_t)layer * 3 * 512;
  float acc = p.b_conv[layer * 512 + ch];
  acc += bf2f(p.Z[(size_t)r * NZP + ZC_MLQK + ch]) * w[512 + ch];
  if (!first) acc += bf2f(p.Z[(size_t)row_of(b, s - 1) * NZP + ZC_MLQK + ch]) * w[ch];
  if (!last) acc += bf2f(p.Z[(size_t)row_of(b, s + 1) * NZP + ZC_MLQK + ch]) * w[1024 + ch];
  float v = siluf_(acc);
  if (ch < 256) p.MQ[((size_t)b * TK + s) * 256 + ch] = f2bf(v);
  else p.MK[((size_t)b * TK + s) * 256 + ch - 256] = f2bf(v * 0.125f);
}
DI void nvb_ml_gates(long GI, const Params& p, int layer) {
  long i = GI; if (i >= (long)NB * 2 * NCK * 4) return;
  int h = (int)(i % 4), j = (int)((i / 4) % NCK), d = (int)((i / (4 * NCK)) % 2), b = (int)(i / (8 * NCK));
  float bi = p.b_igate[layer * 8 + d * 4 + h], bfg = p.b_fgate[layer * 8 + d * 4 + h];
  float cum = 0.f;
  for (int l = 0; l < 64; ++l) {
    int pp = 64 * j + l, s = seq_of(d, pp); const bf16_t* z = p.Z + (size_t)row_of(b, s) * NZP;
    float ig = bf2f(z[ZC_MLIG + d * 4 + h]) + bi;
    float lf = logsigmoidf_(bf2f(z[ZC_MLFG + d * 4 + h]) + bfg);
    cum += lf;
    size_t o = (((size_t)b * 2 + d) * TK + pp) * 4 + h;
    p.BC[o] = cum; p.IGS[o] = ig;
  }
}
DI void nvb_gla_cum(long GI, const Params& p, int layer) {
  long i = GI; if (i >= (long)NB * 2 * NCK * 128) return;
  int ch = (int)(i % 128), j = (int)((i / 128) % NCK), d = (int)((i / (128 * NCK)) % 2), b = (int)(i / (256 * NCK));
  const float* W = p.w_alpha2 + (size_t)layer * 2 * 16 * 128 + (size_t)d * 16 * 128;
  float ba = p.b_alpha[layer * 256 + d * 128 + ch];
  float cum = 0.f;
  for (int l = 0; l < 64; ++l) {
    int pp = 64 * j + l, s = seq_of(d, pp); const bf16_t* z = p.Z + (size_t)row_of(b, s) * NZP + ZC_GA + d * 16;
    float zg = ba; for (int q = 0; q < 16; ++q) zg += bf2f(z[q]) * W[q * 128 + ch];
    cum += logsigmoidf_(zg) * (1.0f / 16.0f);
    p.GC[(((size_t)b * 2 + d) * TK + pp) * 128 + ch] = cum;
  }
}
__global__ void __launch_bounds__(256) nv_attn_mla(Params p, int need_ctx) {
  long i = GTID; if (i >= (long)NB * 4 * TK) return;
  int s = (int)(i % TK), h = (int)((i / TK) % 4), b = (int)(i / (4 * TK));
  if (s < TC && !need_ctx) return;
  int nk = s < TC ? TC : TK;
  const bf16_t* q = p.Qm + (((size_t)b * 4 + h) * TK + s) * 96;
  const bf16_t* K = p.Km + ((size_t)b * 4 + h) * TK * 96;
  const bf16_t* Vt = p.Vtm + ((size_t)b * 4 + h) * 64 * TK;
  float qf[96], o[64];
  _Pragma("unroll") for (int k = 0; k < 96; ++k) qf[k] = bf2f(q[k]);
  _Pragma("unroll") for (int k = 0; k < 64; ++k) o[k] = 0.f;
  float m = -1e30f, l = 0.f;
  for (int t = 0; t < nk; ++t) {
    float sc = 0.f; _Pragma("unroll") for (int k = 0; k < 96; ++k) sc += qf[k] * bf2f(K[(size_t)t * 96 + k]);
    float mn = fmaxf(m, sc), a = exp2f(m - mn), pr = exp2f(sc - mn);
    l = l * a + pr;
    _Pragma("unroll") for (int k = 0; k < 64; ++k) o[k] = o[k] * a + pr * bf2f(Vt[(size_t)k * TK + t]);
    m = mn;
  }
  int r = row_of(b, s);
  _Pragma("unroll") for (int k = 0; k < 64; ++k) p.Y[(size_t)r * D + h * 64 + k] = f2bf(o[k] / l);
}
__global__ void __launch_bounds__(256) nv_attn_diff(Params p, int layer, int need_ctx) {
  long i = GTID; if (i >= (long)NB * 4 * TK) return;
  int s = (int)(i % TK), h = (int)((i / TK) % 4), b = (int)(i / (4 * TK));
  if (s < TC && !need_ctx) return;
  int nk = s < TC ? TC : TK;
  float lam_init; float lam = lam_of(p, layer, lam_init);
  const bf16_t* Vt = p.Vtd + ((size_t)b * 4 + h) * 64 * TK;
  float res[64];
  _Pragma("unroll") for (int k = 0; k < 64; ++k) res[k] = 0.f;
  _Pragma("unroll") for (int mp = 0; mp < 2; ++mp) {
    const bf16_t* q = p.Qd + (((size_t)b * 8 + h * 2 + mp) * TK + s) * 32;
    const bf16_t* K = p.Kd + ((size_t)b * 8 + h * 2 + mp) * TK * 32;
    float qf[32], o[64];
    _Pragma("unroll") for (int k = 0; k < 32; ++k) qf[k] = bf2f(q[k]);
    _Pragma("unroll") for (int k = 0; k < 64; ++k) o[k] = 0.f;
    float m = -1e30f, l = 0.f;
    for (int t = 0; t < nk; ++t) {
      float sc = 0.f; _Pragma("unroll") for (int k = 0; k < 32; ++k) sc += qf[k] * bf2f(K[(size_t)t * 32 + k]);
      float mn = fmaxf(m, sc), a = exp2f(m - mn), pr = exp2f(sc - mn);
      l = l * a + pr;
      _Pragma("unroll") for (int k = 0; k < 64; ++k) o[k] = o[k] * a + pr * bf2f(Vt[(size_t)k * TK + t]);
      m = mn;
    }
    float wgt = mp == 0 ? 1.f : -lam;
    _Pragma("unroll") for (int k = 0; k < 64; ++k) res[k] += wgt * o[k] / l;
  }
  float ss = 0.f; _Pragma("unroll") for (int k = 0; k < 64; ++k) ss += res[k] * res[k];
  float rstd = 1.0f / sqrtf(ss / 64 + 1e-6f);
  int r = row_of(b, s);
  _Pragma("unroll") for (int k = 0; k < 64; ++k) p.Y[(size_t)r * D + 768 + h * 64 + k] = f2bf(res[k] * rstd * p.g_diff_out[layer * 256 + h * 64 + k] * (1.f - lam_init));
}
DI void nvb_ml_local(long GI, const Params& p) {
  long i = GI; if (i >= (long)NUNIT * 4160) return;
  int e = (int)(i % 4160); long u = i / 4160;
  int h = (int)(u % 4), j = (int)((u / 4) % NCK), d = (int)((u / (4 * NCK)) % 2), b = (int)(u / (8 * NCK));
  const float* bc = p.BC + (((size_t)b * 2 + d) * TK + 64 * j) * 4 + h; const float* ig = p.IGS + (((size_t)b * 2 + d) * TK + 64 * j) * 4 + h;
  float bend = bc[63 * 4], ml = -1e30f;
  for (int l = 0; l < 64; ++l) ml = fmaxf(ml, bend - bc[l * 4] + ig[l * 4]);
  if (e == 4096 + 0) { p.MM[u * 4 + 0] = ml; p.MM[u * 4 + 1] = bend; }
  float acc = 0.f;
  if (e < 4096) {
    int v = e / 64, k = e % 64;
    for (int l = 0; l < 64; ++l) {
      int s = seq_of(d, 64 * j + l); float w = expf(bend - bc[l * 4] + ig[l * 4] - ml);
      acc += w * bf2f(p.Z[(size_t)row_of(b, s) * NZP + ZC_MLV + h * 64 + v]) * bf2f(p.MK[((size_t)b * TK + s) * 256 + h * 64 + k]);
    }
    p.MC[(size_t)u * 4096 + e] = acc;
  } else {
    int k = e - 4096;
    for (int l = 0; l < 64; ++l) {
      int s = seq_of(d, 64 * j + l); float w = expf(bend - bc[l * 4] + ig[l * 4] - ml);
      acc += w * bf2f(p.MK[((size_t)b * TK + s) * 256 + h * 64 + k]);
    }
    p.MN[(size_t)u * 64 + k] = acc;
  }
}
DI void nvb_ml_scan(long GI, const Params& p) {
  long i = GI; if (i >= (long)NB * 2 * 4 * 4160) return;
  int e = (int)(i % 4160); int ch = (int)(i / 4160); int h = ch % 4, bd = ch / 4;
  float st = 0.f, m = -1e30f;
  for (int j = 0; j < NCK; ++j) {
    size_t u = ((size_t)bd * NCK + j) * 4 + h;
    float ml = p.MM[u * 4 + 0], be = p.MM[u * 4 + 1];
    float mn = fmaxf(be + m, ml), a = expf(be + m - mn), g = expf(ml - mn);
    float* slot = e < 4096 ? &p.MC[u * 4096 + e] : &p.MN[u * 64 + (e - 4096)];
    float loc = *slot; *slot = st; st = a * st + g * loc;
    if (e == 0) p.MM[u * 4 + 2] = m;
    m = mn;
  }
}
DI void nvb_ml_out(long GI, const Params& p, int need_ctx) {
  long i = GI; if (i >= (long)NUNIT * 4096) return;
  int v = (int)(i % 64), l = (int)((i / 64) % 64); long u = i / 4096;
  int h = (int)(u % 4), j = (int)((u / 4) % NCK), d = (int)((u / (4 * NCK)) % 2), b = (int)(u / (8 * NCK));
  if (j < NCC && !need_ctx) return;
  const float* bc = p.BC + (((size_t)b * 2 + d) * TK + 64 * j) * 4 + h; const float* ig = p.IGS + (((size_t)b * 2 + d) * TK + 64 * j) * 4 + h;
  float m0 = p.MM[u * 4 + 2];
  int sl = seq_of(d, 64 * j + l);
  const bf16_t* q = p.MQ + ((size_t)b * TK + sl) * 256 + h * 64;
  float bl = bc[l * 4];
  float inter = bl + m0, mt = inter;
  for (int t = 0; t <= l; ++t) mt = fmaxf(mt, bl - bc[t * 4] + ig[t * 4]);
  float num = 0.f, den = 0.f;
  for (int t = 0; t <= l; ++t) {
    int st = seq_of(d, 64 * j + t);
    const bf16_t* k = p.MK + ((size_t)b * TK + st) * 256 + h * 64;
    float qk = 0.f; for (int c = 0; c < 64; ++c) qk += bf2f(q[c]) * bf2f(k[c]);
    float sv = expf(bl - bc[t * 4] + ig[t * 4] - mt) * qk;
    num += sv * bf2f(p.Z[(size_t)row_of(b, st) * NZP + ZC_MLV + h * 64 + v]); den += sv;
  }
  float ai = expf(inter - mt);
  float qc = 0.f, qn = 0.f;
  for (int c = 0; c < 64; ++c) { qc += bf2f(q[c]) * p.MC[(size_t)u * 4096 + v * 64 + c]; qn += bf2f(q[c]) * p.MN[(size_t)u * 64 + c]; }
  num += ai * qc; den += ai * qn;
  p.HD[(((size_t)d * NB + b) * TK + sl) * 256 + h * 64 + v] = num / fmaxf(fabsf(den), expf(-mt));
}
DI void nvb_ml_finish(long GI, const Params& p, int layer, int need_ctx) {
  long i = GI; if (i >= (long)R * 4) return;
  int h = (int)(i % 4), r = (int)(i / 4); int b, s; bs_of(r, b, s);
  if (s < TC && !need_ctx) return;
  const float* h0 = p.HD + (((size_t)0 * NB + b) * TK + s) * 256 + h * 64; const float* h1 = p.HD + (((size_t)1 * NB + b) * TK + s) * 256 + h * 64;
  float ss = 0.f; for (int v = 0; v < 64; ++v) { float t = h0[v] + h1[v]; ss += t * t; }
  float rstd = 1.0f / sqrtf(ss / 64 + 1e-6f);
  for (int v = 0; v < 64; ++v) {
    float o = bf2f(p.Z[(size_t)r * NZP + ZC_MLO + h * 64 + v]);
    p.Y[(size_t)r * D + 256 + h * 64 + v] = f2bf(sigmoidf_(o) * (h0[v] + h1[v]) * rstd * p.g_mlstm_out[layer * 256 + h * 64 + v]);
  }
}
DI void nvb_gla_local(long GI, const Params& p) {
  long i = GI; if (i >= (long)NUNIT * 2048) return;
  int v = (int)(i % 64), k = (int)((i / 64) % 32); long u = i / 2048;
  int h = (int)(u % 4), j = (int)((u / 4) % NCK), d = (int)((u / (4 * NCK)) % 2), b = (int)(u / (8 * NCK));
  const float* gc = p.GC + (((size_t)b * 2 + d) * TK + 64 * j) * 128 + h * 32 + k;
  float ge = gc[63 * 128], acc = 0.f;
  for (int l = 0; l < 64; ++l) {
    int s = seq_of(d, 64 * j + l); const bf16_t* z = p.Z + (size_t)row_of(b, s) * NZP;
    acc += bf2f(z[ZC_GK + h * 32 + k]) * expf(ge - gc[l * 128]) * bf2f(z[ZC_GV + h * 64 + v]);
  }
  p.GS[(size_t)u * 2048 + v * 32 + k] = acc;
}
DI void nvb_gla_scan(long GI, const Params& p) {
  long i = GI; if (i >= (long)NB * 2 * 4 * 2048) return;
  int e = (int)(i % 2048); int ch = (int)(i / 2048); int h = ch % 4, bd = ch / 4; int k = e % 32;
  float st = 0.f;
  for (int j = 0; j < NCK; ++j) {
    size_t u = ((size_t)bd * NCK + j) * 4 + h;
    float ge = p.GC[((size_t)bd * TK + 64 * j + 63) * 128 + h * 32 + k];
    float loc = p.GS[u * 2048 + e]; p.GS[u * 2048 + e] = st; st = expf(ge) * st + loc;
  }
}
DI void nvb_gla_out(long GI, const Params& p, int need_ctx) {
  long i = GI; if (i >= (long)NUNIT * 4096) return;
  int v = (int)(i % 64), l = (int)((i / 64) % 64); long u = i / 4096;
  int h = (int)(u % 4), j = (int)((u / 4) % NCK), d = (int)((u / (4 * NCK)) % 2), b = (int)(u / (8 * NCK));
  if (j < NCC && !need_ctx) return;
  const float* gc = p.GC + (((size_t)b * 2 + d) * TK + 64 * j) * 128 + h * 32;
  int sl = seq_of(d, 64 * j + l);
  const bf16_t* q = p.Z + (size_t)row_of(b, sl) * NZP + ZC_GQ + h * 32;
  const float qs = 0.17677669529663687f;
  float acc = 0.f;
  for (int t = 0; t <= l; ++t) {
    int st = seq_of(d, 64 * j + t); const bf16_t* z = p.Z + (size_t)row_of(b, st) * NZP;
    float att = 0.f; for (int k = 0; k < 32; ++k) att += bf2f(q[k]) * qs * expf(gc[l * 128 + k] - gc[t * 128 + k]) * bf2f(z[ZC_GK + h * 32 + k]);
    acc += att * bf2f(z[ZC_GV + h * 64 + v]);
  }
  for (int k = 0; k < 32; ++k) acc += bf2f(q[k]) * qs * expf(gc[l * 128 + k]) * p.GS[(size_t)u * 2048 + v * 32 + k];
  p.OD[(((size_t)d * NB + b) * TK + sl) * 256 + h * 64 + v] = acc;
}
DI void nvb_gla_finish(long GI, const Params& p, int layer, int need_ctx) {
  long i = GI; if (i >= (long)R * 4) return;
  int h = (int)(i % 4), r = (int)(i / 4); int b, s; bs_of(r, b, s);
  if (s < TC && !need_ctx) return;
  const float* h0 = p.OD + (((size_t)0 * NB + b) * TK + s) * 256 + h * 64; const float* h1 = p.OD + (((size_t)1 * NB + b) * TK + s) * 256 + h * 64;
  float ss = 0.f; for (int v = 0; v < 64; ++v) { float t = h0[v] + h1[v]; ss += t * t; }
  float rstd = 1.0f / sqrtf(ss / 64 + 1e-6f);
  for (int v = 0; v < 64; ++v) {
    float rr = bf2f(p.Z[(size_t)r * NZP + ZC_GR + h * 64 + v]);
    p.Y[(size_t)r * D + 512 + h * 64 + v] = f2bf(siluf_(rr) * (h0[v] + h1[v]) * rstd * p.g_gla_out[layer * 256 + h * 64 + v]);
  }
}
__global__ void __launch_bounds__(256) nv_merge(Params p, int layer, int nrows) {
  long i = GTID; if (i >= (long)nrows * D) return;
  int j = (int)(i % D), r = (int)(i / D);
  float acc = 0.f;
  for (int n = 0; n < 4; ++n) {
    const bf16_t* wg = p.Wt_gate + (size_t)(n * 1024 + j) * D; const bf16_t* wb = p.Wt_branch + ((size_t)n * D + j) * 256;
    float g = p.b_gate[layer * 4096 + n * 1024 + j], pr = 0.f;
    for (int k = 0; k < D; ++k) g += bf2f(p.H[(size_t)r * D + k]) * bf2f(wg[k]);
    for (int k = 0; k < 256; ++k) pr += bf2f(p.Y[(size_t)r * D + n * 256 + k]) * bf2f(wb[k]);
    acc += sigmoidf_(g) * pr;
  }
  p.MG[(size_t)r * D + j] = f2bf(acc);
}
__global__ void __launch_bounds__(256) nv_resid_mix(Params p, int layer, const float* xl_in, const float* xc_in, int nrows) {
  long r = GTID; if (r >= nrows) return;
  int w = r < RL ? (int)(r / TL) : 2;
  const float* mb = p.mods + (size_t)(layer * 3 + w) * 6144;
  const float* xin = r < RL ? xl_in + (size_t)r * D : xc_in + (size_t)(r - RL) * D;
  float* xo = r < RL ? p.out + (size_t)r * D : p.xc + (size_t)(r - RL) * D;
  const bf16_t* yo = p.YO + (size_t)r * D;
  float ss = 0.f; for (int k = 0; k < D; ++k) { float v = bf2f(yo[k]); ss += v * v; }
  float rstd = 1.0f / sqrtf(ss / D + 1e-6f);
  float s2 = 0.f;
  for (int k = 0; k < D; ++k) { float xn = xin[k] + mb[2 * 1024 + k] * bf2f(yo[k]) * rstd * p.g_mix_post[layer * 1024 + k]; xo[k] = xn; s2 += xn * xn; }
  float rstd2 = 1.0f / sqrtf(s2 / D + 1e-6f);
  float lg[16]; _Pragma("unroll") for (int e = 0; e < 16; ++e) lg[e] = 0.f;
  const float* wr = p.w_router + (size_t)layer * D * 16;
  for (int k = 0; k < D; ++k) {
    float h2 = xo[k] * rstd2 * p.g_ffn_pre[layer * 1024 + k] * (1.f + mb[4 * 1024 + k]) + mb[3 * 1024 + k];
    p.H[(size_t)r * D + k] = f2bf(h2);
    _Pragma("unroll") for (int e = 0; e < 16; ++e) lg[e] += h2 * wr[k * 16 + e];
  }
  float mx = lg[0]; _Pragma("unroll") for (int e = 1; e < 16; ++e) mx = fmaxf(mx, lg[e]);
  float sm = 0.f; _Pragma("unroll") for (int e = 0; e < 16; ++e) { lg[e] = expf(lg[e] - mx); sm += lg[e]; }
  int b, s; bs_of((int)r, b, s);
  _Pragma("unroll") for (int e = 0; e < 16; ++e) p.AFF[((size_t)b * NE + e) * TK + s] = lg[e] / sm;
}
__global__ void __launch_bounds__(256) nv_topk(Params p, int need_ctx) {
  long i = GTID; if (i >= NB * NE * 2) return;
  int seg = (int)(i % 2), e = (int)((i / 2) % NE), b = (int)(i / (2 * NE));
  int s0 = seg ? TC : 0, n = seg ? TL : TC, cap = seg ? CAPL : CAPC, slot0 = seg ? b * CAPL : NB * CAPL + b * CAPC;
  if (seg == 0 && !need_ctx) { for (int q = 0; q < cap; ++q) p.SEL[(size_t)e * NSLOT + slot0 + q] = -1; return; }
  const float* a = p.AFF + ((size_t)b * NE + e) * TK + s0;
  unsigned thr = 0;
  for (int bit = 31; bit >= 0; --bit) {
    unsigned cand = thr | (1u << bit); int cnt = 0;
    for (int t = 0; t < n; ++t) cnt += (f2u(a[t]) >= cand);
    if (cnt >= cap) thr = cand;
  }
  int ngt = 0; for (int t = 0; t < n; ++t) ngt += (f2u(a[t]) > thr);
  int neq = cap - ngt, q = 0;
  for (int t = 0; t < n; ++t) {
    unsigned u = f2u(a[t]); int r = row_of(b, s0 + t); int sel = -1;
    if (u > thr) sel = q++; else if (u == thr && neq > 0) { sel = q++; --neq; }
    if (sel >= 0) { p.SEL[(size_t)e * NSLOT + slot0 + sel] = r; p.SELV[(size_t)e * NSLOT + slot0 + sel] = a[t]; }
    p.INV[(size_t)r * NE + e] = sel >= 0 ? slot0 + sel : -1;
  }
}
__global__ void __launch_bounds__(256) nv_moe1(Params p) {
  long i = GTID; if (i >= (long)NE * NSLOT * FF) return;
  int f = (int)(i % FF), slot = (int)((i / FF) % NSLOT), e = (int)(i / ((long)FF * NSLOT));
  int r = p.SEL[(size_t)e * NSLOT + slot];
  float out = 0.f;
  if (r >= 0) {
    const bf16_t* wg = p.Wt_eg + ((size_t)e * FF + f) * D; const bf16_t* wu = p.Wt_eu + ((size_t)e * FF + f) * D; const bf16_t* h = p.H + (size_t)r * D;
    float g = 0.f, u = 0.f; for (int k = 0; k < D; ++k) { float hv = bf2f(h[k]); g += hv * bf2f(wg[k]); u += hv * bf2f(wu[k]); }
    out = siluf_(g) * u;
  }
  p.HID[((size_t)e * NSLOT + slot) * FF + f] = f2bf(out);
}
__global__ void __launch_bounds__(256) nv_moe2(Params p) {
  long i = GTID; if (i >= (long)NE * NSLOT * D) return;
  int j = (int)(i % D), slot = (int)((i / D) % NSLOT), e = (int)(i / ((long)D * NSLOT));
  int r = p.SEL[(size_t)e * NSLOT + slot];
  float out = 0.f;
  if (r >= 0) {
    const bf16_t* wd = p.Wt_ed + ((size_t)e * D + j) * FF; const bf16_t* h = p.HID + ((size_t)e * NSLOT + slot) * FF;
    float a = 0.f; for (int k = 0; k < FF; ++k) a += bf2f(h[k]) * bf2f(wd[k]);
    out = a * p.SELV[(size_t)e * NSLOT + slot];
  }
  p.YE[((size_t)e * NSLOT + slot) * D + j] = f2bf(out);
}
__global__ void __launch_bounds__(256) nv_resid_ffn(Params p, int layer, int nrows) {
  long r = GTID; if (r >= nrows) return;
  int w = r < RL ? (int)(r / TL) : 2;
  const float* mb = p.mods + (size_t)(layer * 3 + w) * 6144;
  float* xo = r < RL ? p.out + (size_t)r * D : p.xc + (size_t)(r - RL) * D;
  float ss = 0.f;
  for (int k = 0; k < D; ++k) {
    float f = 0.f;
    for (int e = 0; e < NE; ++e) { int sl = p.INV[(size_t)r * NE + e]; if (sl >= 0) f += bf2f(p.YE[((size_t)e * NSLOT + sl) * D + k]); }
    ss += f * f;
  }
  float rstd = 1.0f / sqrtf(ss / D + 1e-6f);
  for (int k = 0; k < D; ++k) {
    float f = 0.f;
    for (int e = 0; e < NE; ++e) { int sl = p.INV[(size_t)r * NE + e]; if (sl >= 0) f += bf2f(p.YE[((size_t)e * NSLOT + sl) * D + k]); }
    xo[k] += mb[5 * 1024 + k] * f * rstd * p.g_ffn_post[layer * 1024 + k];
  }
}

__global__ void __launch_bounds__(256) nv_mods(Params p) { nvb_mods(GTID, p); }
__global__ void __launch_bounds__(256) nv_ml_gates(Params p, int layer) { nvb_ml_gates(GTID, p, layer); }
__global__ void __launch_bounds__(256) nv_gla_cum(Params p, int layer) { nvb_gla_cum(GTID, p, layer); }
__global__ void __launch_bounds__(256) nv_ml_local(Params p) { nvb_ml_local(GTID, p); }
__global__ void __launch_bounds__(256) nv_ml_scan(Params p) { nvb_ml_scan(GTID, p); }
__global__ void __launch_bounds__(256) nv_ml_out(Params p, int need_ctx) { nvb_ml_out(GTID, p, need_ctx); }
__global__ void __launch_bounds__(256) nv_ml_finish(Params p, int layer, int need_ctx) { nvb_ml_finish(GTID, p, layer, need_ctx); }
__global__ void __launch_bounds__(256) nv_gla_local(Params p) { nvb_gla_local(GTID, p); }
__global__ void __launch_bounds__(256) nv_gla_scan(Params p) { nvb_gla_scan(GTID, p); }
__global__ void __launch_bounds__(256) nv_gla_out(Params p, int need_ctx) { nvb_gla_out(GTID, p, need_ctx); }
__global__ void __launch_bounds__(256) nv_gla_finish(Params p, int layer, int need_ctx) { nvb_gla_finish(GTID, p, layer, need_ctx); }
constexpr int LROW = 144;
constexpr int A_BYTES = 128 * LROW;
constexpr int NTHR = 256;
#ifndef ATT_THR
#define ATT_THR 16.0f
#endif

DI int xcd_swz(int u, int nt) { return (nt & 7) ? u : (u & 7) * (nt >> 3) + (u >> 3); }
template <int GW> DI void grp_tile(int L, int ntm, int ntn, int& tm, int& tn) {
  const int gsz = ntm * GW; int g = 0;
  while (L >= gsz) { L -= gsz; ++g; }
  tm = L / GW; tn = g * GW + (L & (GW - 1)); (void)ntn;
}
DI u32x4 ldg16(const void* p) { return *(const u32x4*)p; }
DI void sts16(char* p, u32x4 v) { *(u32x4*)p = v; }
DI bf16x8 lds_frag(const char* p) { return *(const bf16x8*)p; }

template <int WN, int KFIX = 0>
DI void gemm_kloop(f32x4 (&acc)[4][WN], const bf16_t* const (&ap)[4], const bf16_t* const (&bp)[WN], int nk, char* lds) {
  constexpr int STAGE = A_BYTES + 32 * WN * LROW;
  const int t = TIDX, lane = t & 63, wid = t >> 6, wr = wid >> 1, wc = wid & 1;
  const int lr = t >> 3, lcb = (t & 7) * 16;
  const int fr = lane & 15, fq = lane >> 4;
  const int aoff = (wr * 64 + fr) * LROW + fq * 16, boff = A_BYTES + (wc * WN * 16 + fr) * LROW + fq * 16, soff = lr * LROW + lcb;
  u32x4 ra0[4], rb0[WN], ra1[4], rb1[WN];
  auto gload = [&](u32x4 (&ra)[4], u32x4 (&rb)[WN], int kt) {
#pragma unroll
    for (int i = 0; i < 4; ++i) ra[i] = ldg16(ap[i] + (KFIX ? (kt & 1) : kt) * 64);
#pragma unroll
    for (int i = 0; i < WN; ++i) rb[i] = ldg16(bp[i] + (KFIX ? (kt & 1) : kt) * 64);
  };
  auto sstore = [&](const u32x4 (&ra)[4], const u32x4 (&rb)[WN], char* st) {
#pragma unroll
    for (int i = 0; i < 4; ++i) sts16(st + soff + 32 * i * LROW, ra[i]);
#pragma unroll
    for (int i = 0; i < WN; ++i) sts16(st + A_BYTES + soff + 32 * i * LROW, rb[i]);
  };
  auto compute = [&](const char* cur) {
#pragma unroll
    for (int ks = 0; ks < 2; ++ks) {
      bf16x8 af[4], bfr[WN];
#pragma unroll
      for (int m = 0; m < 4; ++m) af[m] = lds_frag(cur + aoff + m * 16 * LROW + ks * 64);
#pragma unroll
      for (int n = 0; n < WN; ++n) bfr[n] = lds_frag(cur + boff + n * 16 * LROW + ks * 64);
#pragma unroll
      for (int m = 0; m < 4; ++m)
#pragma unroll
        for (int n = 0; n < WN; ++n) acc[m][n] = MFMA16(bfr[n], af[m], acc[m][n]);
    }
    IGLP_OPT();
  };
  gload(ra0, rb0, 0);
  gload(ra1, rb1, 1);
  sstore(ra0, rb0, lds);
  __syncthreads();
#pragma unroll 1
  for (int kt = 0; kt < nk; kt += 2) {
    if (kt + 2 < nk) gload(ra0, rb0, kt + 2);
    compute(lds);
    sstore(ra1, rb1, lds + STAGE);
    __syncthreads();
    if (kt + 3 < nk) gload(ra1, rb1, kt + 3);
    compute(lds + STAGE);
    if (kt + 2 < nk) sstore(ra0, rb0, lds);
    __syncthreads();
  }
}
template <int WN> DI void acc_zero(f32x4 (&acc)[4][WN]) {
#pragma unroll
  for (int m = 0; m < 4; ++m)
#pragma unroll
    for (int n = 0; n < WN; ++n) acc[m][n] = (f32x4){0.f, 0.f, 0.f, 0.f};
}
DI void st_bf16x4(bf16_t* p, f32x4 v) { u32x2 o; o.x = pack2bf(v.x, v.y); o.y = pack2bf(v.z, v.w); *(u32x2*)p = o; }

template <int WN, class RowOk>
DI void store_wave_tile(const f32x4 (&acc)[4][WN], bf16_t* C, size_t ldc, char* ldsw, int lane, RowOk row_ok) {
  constexpr int PITCH = WN * 32 + 16, CPR = WN * 2;
  const int fr = lane & 15, fq = lane >> 4;
#pragma unroll
  for (int m = 0; m < 4; ++m)
#pragma unroll
    for (int n = 0; n < WN; ++n) { u32x2 o; o.x = pack2bf(acc[m][n][0], acc[m][n][1]); o.y = pack2bf(acc[m][n][2], acc[m][n][3]); *(u32x2*)(ldsw + (m * 16 + fr) * PITCH + n * 32 + fq * 8) = o; }
  WAVE_SYNC();
  constexpr int RPP = 64 / CPR;
#pragma unroll
  for (int ps = 0; ps < 64 / RPP; ++ps) {
    const int r = ps * RPP + lane / CPR, c = lane % CPR;
    const u32x4 v = *(const u32x4*)(ldsw + r * PITCH + c * 16);
    if (row_ok(r)) *(u32x4*)(C + (size_t)r * ldc + c * 8) = v;
  }
  WAVE_SYNC();
}
template <int NOSTORE = 0>
DI void gemm_plain_tile(const bf16_t* A, int lda, const bf16_t* Bt, int ldb, int K, bf16_t* C, int ldc, int tm, int tn, char* lds) {
  const int t = TIDX, lane = t & 63, wid = t >> 6, wr = wid >> 1, wc = wid & 1, lr = t >> 3, lc = (t & 7) * 8, fr = lane & 15, fq = lane >> 4;
  const bf16_t* ap[4]; const bf16_t* bp[4];
#pragma unroll
  for (int i = 0; i < 4; ++i) { ap[i] = A + (size_t)(tm * 128 + lr + 32 * i) * lda + lc; bp[i] = Bt + (size_t)(tn * 128 + lr + 32 * i) * ldb + lc; }
  f32x4 acc[4][4]; acc_zero<4>(acc);
  gemm_kloop<4, NOSTORE == 2>(acc, ap, bp, K / 64, lds);
  if (NOSTORE) { float s = 0.f;
#pragma unroll
    for (int m = 0; m < 4; ++m)
#pragma unroll
      for (int n = 0; n < 4; ++n) s += acc[m][n][0] + acc[m][n][3];
    if (s == 123456.789f) C[0] = 1; return; }
  store_wave_tile<4>(acc, C + (size_t)(tm * 128 + wr * 64) * ldc + tn * 128 + wc * 64, (size_t)ldc, lds + wid * (64 * 144), lane, [](int) { return true; });
  __syncthreads();
}
template <int NOSTORE = 0>
DI void ph_gemm_plain(const bf16_t* A, int lda, const bf16_t* Bt, int ldb, int M, int N, int K, bf16_t* C, int ldc, char* lds, int bid, int nblk) {
  const int ntn = N / 128, nt = (M / 128) * ntn;
  for (int u = bid; u < nt; u += nblk) { int tm, tn; grp_tile<8>(xcd_swz(u, nt), M / 128, ntn, tm, tn); gemm_plain_tile<NOSTORE>(A, lda, Bt, ldb, K, C, ldc, tm, tn, lds); }
}
DI void ph_mla_up(const Params& p, int layer, bf16_t* QRAW, bf16_t* KVRAW, char* lds, int bid, int nblk) {
  const int ntq = (R / 128) * 3, ntkv = (R / 128) * 4;
  for (int tile = bid; tile < ntq + ntkv; tile += nblk) {
    if (tile < ntq) gemm_plain_tile(p.Z + ZC_QLAT, NZP, p.Wt_uq + layer * WSZ_UQ, 256, 256, QRAW, 384, tile / 3, tile % 3, lds);
    else { int u = tile - ntq; gemm_plain_tile(p.Z + ZC_KVLAT, NZP, p.Wt_ukv + layer * WSZ_UKV, 128, 128, KVRAW, 512, u / 4, u % 4, lds); }
  }
}
constexpr int LROW32 = 80;
template <int WM, int WN, bool DEEP>
DI void gemm_kloop_g(f32x4 (&acc)[WM][WN], const bf16_t* const (&ap)[WM / 2], const bf16_t* const (&bp)[WN / 2], int nk, char* lds) {
  constexpr int NA = WM / 2, NBB = WN / 2, A_B = 32 * WM * LROW32, STAGE = (32 * WM + 32 * WN) * LROW32;
  const int t = TIDX, lane = t & 63, wid = t >> 6, wr = wid >> 1, wc = wid & 1, fr = lane & 15, fq = lane >> 4;
  const int aoff = (wr * 16 * WM + fr) * LROW32 + fq * 16, boff = A_B + (wc * 16 * WN + fr) * LROW32 + fq * 16, soff = (t >> 2) * LROW32 + (t & 3) * 16;
  u32x4 ra0[NA], rb0[NBB], ra1[NA], rb1[NBB];
  auto gload = [&](u32x4 (&ra)[NA], u32x4 (&rb)[NBB], int kt) {
#pragma unroll
    for (int i = 0; i < NA; ++i) ra[i] = ldg16(ap[i] + kt * 32);
#pragma unroll
    for (int i = 0; i < NBB; ++i) rb[i] = ldg16(bp[i] + kt * 32);
  };
  auto sstore = [&](const u32x4 (&ra)[NA], const u32x4 (&rb)[NBB], char* st) {
#pragma unroll
    for (int i = 0; i < NA; ++i) sts16(st + soff + 64 * i * LROW32, ra[i]);
#pragma unroll
    for (int i = 0; i < NBB; ++i) sts16(st + A_B + soff + 64 * i * LROW32, rb[i]);
  };
  auto compute = [&](const char* cur) {
    bf16x8 af[WM];
#pragma unroll
    for (int m = 0; m < WM; ++m) af[m] = lds_frag(cur + aoff + m * 16 * LROW32);
#pragma unroll
    for (int n = 0; n < WN; ++n) {
      const bf16x8 bfr = lds_frag(cur + boff + n * 16 * LROW32);
#pragma unroll
      for (int m = 0; m < WM; ++m) acc[m][n] = MFMA16(bfr, af[m], acc[m][n]);
    }
    IGLP_OPT();
  };
  gload(ra0, rb0, 0);
  if (DEEP) gload(ra1, rb1, 1);
  sstore(ra0, rb0, lds);
  __syncthreads();
#pragma unroll 1
  for (int kt = 0; kt < nk; kt += 2) {
    if (DEEP) { if (kt + 2 < nk) gload(ra0, rb0, kt + 2); } else gload(ra1, rb1, kt + 1);
    compute(lds);
    sstore(ra1, rb1, lds + STAGE);
    __syncthreads();
    if (DEEP) { if (kt + 3 < nk) gload(ra1, rb1, kt + 3); } else if (kt + 2 < nk) gload(ra0, rb0, kt + 2);
    compute(lds + STAGE);
    if (kt + 2 < nk) sstore(ra0, rb0, lds);
    __syncthreads();
  }
}
template <int WM, int WN> DI void acc_zero_g(f32x4 (&acc)[WM][WN]) {
#pragma unroll
  for (int m = 0; m < WM; ++m)
#pragma unroll
    for (int n = 0; n < WN; ++n) acc[m][n] = (f32x4){0.f, 0.f, 0.f, 0.f};
}
DI void ph_merge(const Params& p, int layer, int rows, char* lds, int bid, int nblk) {
  const int t = TIDX, lane = t & 63, wid = t >> 6, wr = wid >> 1, wc = wid & 1, fr = lane & 15, fq = lane >> 4;
  const int lr = t >> 2, lc = (t & 3) * 8;
  const int ntn = D / 64, nt = (rows / 128) * ntn;
#pragma unroll 1
  for (int u = bid; u < nt; u += nblk) {
    int tm, tn; grp_tile<4>(xcd_swz(u, nt), rows / 128, ntn, tm, tn);
    f32x4 accS[4][2]; acc_zero_g<4, 2>(accS);
#pragma unroll 1
    for (int np = 0; np < 2; ++np) {
      f32x4 accG[4][4]; acc_zero_g<4, 4>(accG);
      {
        const bf16_t* ap[2]; const bf16_t* bp[2];
#pragma unroll
        for (int i = 0; i < 2; ++i) ap[i] = p.H + (size_t)(tm * 128 + lr + 64 * i) * D + lc;
#pragma unroll
        for (int i = 0; i < 2; ++i) { const int rho = lr + 64 * i, wci = rho >> 6, n = 2 * np + ((rho >> 5) & 1), c = rho & 31;
          bp[i] = p.Wt_gate + layer * WSZ_GATE + ((size_t)n * 1024 + tn * 64 + wci * 32 + c) * D + lc; }
        gemm_kloop_g<4, 4, true>(accG, ap, bp, D / 32, lds);
      }
#pragma unroll 1
      for (int q = 0; q < 2; ++q) {
        const int n = 2 * np + q;
        f32x4 accP[4][2]; acc_zero_g<4, 2>(accP);
        const bf16_t* ap[2]; const bf16_t* bp[1];
#pragma unroll
        for (int i = 0; i < 2; ++i) ap[i] = p.Y + (size_t)(tm * 128 + lr + 64 * i) * D + n * 256 + lc;
        bp[0] = p.Wt_branch + layer * WSZ_BR + ((size_t)n * D + tn * 64 + lr) * 256 + lc;
        gemm_kloop_g<4, 2, false>(accP, ap, bp, 8, lds);
#pragma unroll
        for (int nn = 0; nn < 2; ++nn) {
          const f32x4 bv = *(const f32x4*)(p.b_gate + layer * 4096 + n * 1024 + tn * 64 + wc * 32 + nn * 16 + 4 * fq);
#pragma unroll
          for (int m = 0; m < 4; ++m)
#pragma unroll
            for (int j = 0; j < 4; ++j) { const float g = q ? accG[m][2 + nn][j] : accG[m][nn][j]; accS[m][nn][j] += accP[m][nn][j] * fast_rcp(1.0f + fast_exp2(-LOG2E * (g + bv[j]))); }
        }
      }
    }
    store_wave_tile<2>(accS, p.MG + (size_t)(tm * 128 + wr * 64) * D + tn * 64 + wc * 32, (size_t)D, lds + wid * (64 * 80), lane, [](int) { return true; });
    __syncthreads();
  }
}
template <int WM>
DI void gemm_plain_tile_g(const bf16_t* A, int lda, const bf16_t* Bt, int ldb, int K, bf16_t* C, int ldc, int row0, int col0, char* lds) {
  const int t = TIDX, lane = t & 63, wid = t >> 6, wr = wid >> 1, wc = wid & 1, fr = lane & 15, fq = lane >> 4, lr = t >> 2, lc = (t & 3) * 8;
  const bf16_t* ap[WM / 2]; const bf16_t* bp[2];
#pragma unroll
  for (int i = 0; i < WM / 2; ++i) ap[i] = A + (size_t)(row0 + lr + 64 * i) * lda + lc;
#pragma unroll
  for (int i = 0; i < 2; ++i) bp[i] = Bt + (size_t)(col0 + lr + 64 * i) * ldb + lc;
  f32x4 acc[WM][4]; acc_zero_g<WM, 4>(acc);
  gemm_kloop_g<WM, 4, true>(acc, ap, bp, K / 32, lds);
#pragma unroll
  for (int m = 0; m < WM; ++m)
#pragma unroll
    for (int n = 0; n < 4; ++n)
      st_bf16x4(C + (size_t)(row0 + wr * 16 * WM + m * 16 + fr) * ldc + col0 + wc * 64 + n * 16 + 4 * fq, acc[m][n]);
}
DI void ph_gemm_plain2(const bf16_t* A, int lda, const bf16_t* Bt, int ldb, int M, int N, int K, bf16_t* C, int ldc, char* lds, int bid, int nblk) {
  const int ntn = N / 128, nt = (M / 256) * ntn, nfull = (nt / nblk) * nblk;
#pragma unroll 1
  for (int tile = bid; tile < nfull; tile += nblk) gemm_plain_tile_g<8>(A, lda, Bt, ldb, K, C, ldc, (tile / ntn) * 256, (tile % ntn) * 128, lds);
#pragma unroll 1
  for (int h = bid; h < 2 * (nt - nfull); h += nblk) { const int tile = nfull + (h >> 1); gemm_plain_tile_g<4>(A, lda, Bt, ldb, K, C, ldc, (tile / ntn) * 256 + (h & 1) * 128, (tile % ntn) * 128, lds); }
}
DI void gemm_kloop32(f32x16 (&acc)[2][2], const bf16_t* const (&ap)[4], const bf16_t* const (&bp)[4], int nk, char* lds) {
  constexpr int STAGE = A_BYTES + 128 * LROW;
  const int t = TIDX, lane = t & 63, wid = t >> 6, wr = wid >> 1, wc = wid & 1, l31 = lane & 31, hh = lane >> 5;
  const int aoff = (wr * 64 + l31) * LROW + hh * 16, boff = A_BYTES + (wc * 64 + l31) * LROW + hh * 16, soff = (t >> 3) * LROW + (t & 7) * 16;
  u32x4 ra0[4], rb0[4], ra1[4], rb1[4];
  auto gload = [&](u32x4 (&ra)[4], u32x4 (&rb)[4], int kt) {
#pragma unroll
    for (int i = 0; i < 4; ++i) { ra[i] = ldg16(ap[i] + kt * 64); rb[i] = ldg16(bp[i] + kt * 64); }
  };
  auto sstore = [&](const u32x4 (&ra)[4], const u32x4 (&rb)[4], char* st) {
#pragma unroll
    for (int i = 0; i < 4; ++i) { sts16(st + soff + 32 * i * LROW, ra[i]); sts16(st + A_BYTES + soff + 32 * i * LROW, rb[i]); }
  };
  auto compute = [&](const char* cur) {
#pragma unroll
    for (int ks = 0; ks < 4; ++ks) {
      bf16x8 af[2], bfr[2];
#pragma unroll
      for (int m = 0; m < 2; ++m) af[m] = lds_frag(cur + aoff + m * 32 * LROW + ks * 32);
#pragma unroll
      for (int n = 0; n < 2; ++n) bfr[n] = lds_frag(cur + boff + n * 32 * LROW + ks * 32);
#pragma unroll
      for (int m = 0; m < 2; ++m)
#pragma unroll
        for (int n = 0; n < 2; ++n) acc[m][n] = MFMA32(bfr[n], af[m], acc[m][n]);
    }
  };
  gload(ra0, rb0, 0); gload(ra1, rb1, 1);
  sstore(ra0, rb0, lds);
  __syncthreads();
#pragma unroll 1
  for (int kt = 0; kt < nk; kt += 2) {
    if (kt + 2 < nk) gload(ra0, rb0, kt + 2);
    compute(lds);
    sstore(ra1, rb1, lds + STAGE);
    __syncthreads();
    if (kt + 3 < nk) gload(ra1, rb1, kt + 3);
    compute(lds + STAGE);
    if (kt + 2 < nk) sstore(ra0, rb0, lds);
    __syncthreads();
  }
}
DI void ph_gemm_plain32(const bf16_t* A, int lda, const bf16_t* Bt, int ldb, int M, int N, int K, bf16_t* C, int ldc, char* lds, int bid, int nblk) {
  const int t = TIDX, lane = t & 63, wid = t >> 6, wr = wid >> 1, wc = wid & 1, lr = t >> 3, lc = (t & 7) * 8, l31 = lane & 31, hh = lane >> 5;
  const int ntn = N / 128, nt = (M / 128) * ntn;
#pragma unroll 1
  for (int tile = bid; tile < nt; tile += nblk) {
    const int tm = tile / ntn, tn = tile % ntn;
    const bf16_t* ap[4]; const bf16_t* bp[4];
#pragma unroll
    for (int i = 0; i < 4; ++i) { ap[i] = A + (size_t)(tm * 128 + lr + 32 * i) * lda + lc; bp[i] = Bt + (size_t)(tn * 128 + lr + 32 * i) * ldb + lc; }
    f32x16 acc[2][2];
#pragma unroll
    for (int m = 0; m < 2; ++m)
#pragma unroll
      for (int n = 0; n < 2; ++n) acc[m][n] = (f32x16)(0.f);
    gemm_kloop32(acc, ap, bp, K / 64, lds);
#pragma unroll
    for (int m = 0; m < 2; ++m)
#pragma unroll
      for (int n = 0; n < 2; ++n)
#pragma unroll
        for (int g = 0; g < 4; ++g) {
          f32x4 o = {acc[m][n][4 * g], acc[m][n][4 * g + 1], acc[m][n][4 * g + 2], acc[m][n][4 * g + 3]};
          st_bf16x4(C + (size_t)(tm * 128 + wr * 64 + m * 32 + l31) * ldc + tn * 128 + wc * 64 + n * 32 + 8 * g + 4 * hh, o);
        }
  }
}
template <int MODE>
DI void ph_gemm_probe(const bf16_t* A, int lda, const bf16_t* Bt, int ldb, int M, int N, int K, float* sink, char* lds, int bid, int nblk) {
  const int t = TIDX, lane = t & 63, wid = t >> 6, wr = wid >> 1, wc = wid & 1, lr = t >> 3, lc = (t & 7) * 8, fr = lane & 15, fq = lane >> 4;
  const int ntn = N / 128, nt = (M / 128) * ntn, nk = K / 64;
  constexpr int STAGE = A_BYTES + 128 * LROW;
  const int aoff = (wr * 64 + fr) * LROW + fq * 16, boff = A_BYTES + (wc * 64 + fr) * LROW + fq * 16;
#pragma unroll 1
  for (int tile = bid; tile < nt; tile += nblk) {
    f32x4 acc[4][4]; acc_zero<4>(acc);
    bf16x8 af[4], bfr[4];
    const int tm = tile / ntn, tn = tile % ntn;
    const bf16_t* ap[4]; const bf16_t* bp[4];
#pragma unroll
    for (int i = 0; i < 4; ++i) { ap[i] = A + (size_t)(tm * 128 + lr + 32 * i) * lda + lc; bp[i] = Bt + (size_t)(tn * 128 + lr + 32 * i) * ldb + lc; }
    u32x4 ra[4], rb[4], junk = {0u, 0u, 0u, 0u};
#pragma unroll
    for (int i = 0; i < 4; ++i) { ra[i] = junk; rb[i] = junk; }
#pragma unroll 1
    for (int kt = 0; kt < nk; ++kt) {
      const char* cur = lds + (kt & 1) * STAGE;
#pragma unroll
      for (int i = 0; i < 4; ++i) { ra[i] = ldg16(ap[i] + kt * 64); if (MODE == 3) rb[i] = ldg16(bp[i] + kt * 64); }
#pragma unroll
      for (int ks = 0; ks < 2; ++ks) {
#pragma unroll
        for (int m = 0; m < 4; ++m) { af[m] = lds_frag(cur + aoff + m * 16 * LROW + ks * 64); bfr[m] = lds_frag(cur + boff + m * 16 * LROW + ks * 64); }
#pragma unroll
        for (int m = 0; m < 4; ++m)
#pragma unroll
          for (int n = 0; n < 4; ++n) acc[m][n] = MFMA16(bfr[n], af[m], acc[m][n]);
      }
      junk.x ^= ra[0].x ^ ra[1].y ^ ra[2].z ^ ra[3].w ^ rb[0].x ^ rb[1].y ^ rb[2].z ^ rb[3].w;
      __syncthreads();
    }
    float s = (float)(junk.x & 1u);
#pragma unroll
    for (int m = 0; m < 4; ++m)
#pragma unroll
      for (int n = 0; n < 4; ++n) s += acc[m][n][0] + acc[m][n][3];
    if (s == 123456.789f) sink[0] = s;
  }
}
DI void ph_moe1(const Params& p, int need_ctx, char* lds, int bid, int nblk) {
  const int t = TIDX, lane = t & 63, wid = t >> 6, wr = wid >> 1, wc = wid & 1, lr = t >> 3, lc = (t & 7) * 8, fr = lane & 15, fq = lane >> 4;
  constexpr int NTN = FF / 64;
  const int NTM = need_ctx ? (NSLOT + 127) / 128 : (NB * CAPL) / 128;
  for (int u = bid; u < NE * NTM * NTN; u += nblk) {
    const int tile = xcd_swz(u, NE * NTM * NTN), e = tile / (NTM * NTN), rem = tile % (NTM * NTN);
    int tm, tn, rr = rem, g = 0;
    if (rr >= NTM * 8) { rr -= NTM * 8; g = 1; }
    if (rr >= NTM * 8) { rr -= NTM * 8; g = 2; }
    if (g < 2) { tm = rr >> 3; tn = g * 8 + (rr & 7); } else { tm = rr / (NTN - 16); tn = 16 + rr - tm * (NTN - 16); }
    const bf16_t* ap[4]; const bf16_t* bp[4];
#pragma unroll
    for (int i = 0; i < 4; ++i) {
      const int slot = tm * 128 + lr + 32 * i;
      int r = slot < NSLOT ? p.SEL[(size_t)e * NSLOT + slot] : -1;
      ap[i] = p.H + (size_t)(r < 0 ? 0 : r) * D + lc;
      const int rho = lr + 32 * i, wci = rho >> 6, gu = (rho >> 5) & 1, col = wci * 32 + (rho & 31);
      bp[i] = (gu ? p.Wt_eu : p.Wt_eg) + ((size_t)e * FF + tn * 64 + col) * D + lc;
    }
    f32x4 acc[4][4]; acc_zero<4>(acc);
    gemm_kloop<4>(acc, ap, bp, D / 64, lds);
    f32x4 hid[4][2];
#pragma unroll
    for (int m = 0; m < 4; ++m) {
      const int slot = tm * 128 + wr * 64 + m * 16 + fr;
      const bool valid = slot < NSLOT && p.SEL[(size_t)e * NSLOT + (slot < NSLOT ? slot : 0)] >= 0;
#pragma unroll
      for (int n = 0; n < 2; ++n)
#pragma unroll
        for (int j = 0; j < 4; ++j) { const float g = acc[m][n][j], u = acc[m][n + 2][j]; hid[m][n][j] = valid ? g * u * fast_rcp(1.0f + fast_exp2(-LOG2E * g)) : 0.f; }
    }
    const int slot0 = tm * 128 + wr * 64;
    store_wave_tile<2>(hid, p.HID + ((size_t)e * NSLOT + slot0) * FF + tn * 64 + wc * 32, (size_t)FF, lds + wid * (64 * 80), lane, [&](int r) { return slot0 + r < NSLOT; });
    __syncthreads();
  }
}
DI void ph_moe2(const Params& p, int need_ctx, char* lds, int bid, int nblk) {
  const int t = TIDX, lane = t & 63, wid = t >> 6, wr = wid >> 1, wc = wid & 1, lr = t >> 3, lc = (t & 7) * 8, fr = lane & 15, fq = lane >> 4;
  constexpr int NTN = D / 128;
  const int NTM = need_ctx ? (NSLOT + 127) / 128 : (NB * CAPL) / 128;
  for (int u = bid; u < NE * NTM * NTN; u += nblk) {
    const int tile = xcd_swz(u, NE * NTM * NTN), e = tile / (NTM * NTN), rem = tile % (NTM * NTN), tm = rem / NTN, tn = rem % NTN;
    const bf16_t* ap[4]; const bf16_t* bp[4];
#pragma unroll
    for (int i = 0; i < 4; ++i) {
      int slot = tm * 128 + lr + 32 * i; if (slot >= NSLOT) slot = NSLOT - 1;
      ap[i] = p.HID + ((size_t)e * NSLOT + slot) * FF + lc;
      bp[i] = p.Wt_ed + ((size_t)e * D + tn * 128 + lr + 32 * i) * FF + lc;
    }
    f32x4 acc[4][4]; acc_zero<4>(acc);
    gemm_kloop<4>(acc, ap, bp, FF / 64, lds);
#pragma unroll
    for (int m = 0; m < 4; ++m) {
      const int slot = tm * 128 + wr * 64 + m * 16 + fr;
      const float val = (slot < NSLOT && p.SEL[(size_t)e * NSLOT + (slot < NSLOT ? slot : 0)] >= 0) ? p.SELV[(size_t)e * NSLOT + slot] : 0.f;
#pragma unroll
      for (int n = 0; n < 4; ++n) { acc[m][n].x *= val; acc[m][n].y *= val; acc[m][n].z *= val; acc[m][n].w *= val; }
    }
    const int slot0 = tm * 128 + wr * 64;
    store_wave_tile<4>(acc, p.YE + ((size_t)e * NSLOT + slot0) * D + tn * 128 + wc * 64, (size_t)D, lds + wid * (64 * 144), lane, [&](int r) { return slot0 + r < NSLOT; });
    __syncthreads();
  }
}
constexpr int GEMM_LDS = 2 * (A_BYTES + 128 * LROW);

DI void unpack8(u32x4 v, float (&f)[8]) {
  f[0] = u2f(v.x << 16); f[1] = u2f(v.x & 0xffff0000u); f[2] = u2f(v.y << 16); f[3] = u2f(v.y & 0xffff0000u);
  f[4] = u2f(v.z << 16); f[5] = u2f(v.z & 0xffff0000u); f[6] = u2f(v.w << 16); f[7] = u2f(v.w & 0xffff0000u);
}
DI u32x4 pack8f(const float (&f)[8]) { u32x4 v; v.x = pack2bf(f[0], f[1]); v.y = pack2bf(f[2], f[3]); v.z = pack2bf(f[4], f[5]); v.w = pack2bf(f[6], f[7]); return v; }
DI void rope8(float (&a)[8], const float (&pr)[8], int cc, const float* cs, const float* sn) {
  const int ax = (cc >> 1) * 8; const bool second = cc & 1;
#pragma unroll
  for (int i = 0; i < 8; ++i) a[i] = second ? a[i] * cs[ax + i] + pr[i] * sn[ax + i] : a[i] * cs[ax + i] - pr[i] * sn[ax + i];
}
constexpr int PREP_LDS = 64 * 4 + 2 * 512 * 4 + 32 * 528;
template <int PARTS = 3>
DI void ph_prep(const Params& p, int layer, const bf16_t* QRAW, const bf16_t* KVRAW, char* lds, int bid, int nblk) {
  float* s_rstd = (float*)lds;
  float* s_cs = s_rstd + 64;
  float* s_sn = s_cs + 512;
  bf16_t* s_t = (bf16_t*)(s_sn + 512);
  const int t = TIDX;
  constexpr int UPB = TK / 32, NU = NB * UPB;
  const float* wcv = p.w_conv + (size_t)layer * 3 * 512;
  f32x4 bcv[2], w0v[2], w1v[2], w2v[2];
  { const int c8 = (t & 63) * 8;
#pragma unroll
    for (int q = 0; q < 2; ++q) { bcv[q] = *(const f32x4*)(p.b_conv + layer * 512 + c8 + 4 * q); w0v[q] = *(const f32x4*)(wcv + c8 + 4 * q); w1v[q] = *(const f32x4*)(wcv + 512 + c8 + 4 * q); w2v[q] = *(const f32x4*)(wcv + 1024 + c8 + 4 * q); } }
#pragma unroll 1
  for (int u = bid; u < NU; u += nblk) {
    int b, s0;
    if (u < NB * (TL / 32)) { b = u / (TL / 32); s0 = TC + (u % (TL / 32)) * 32; } else { const int v = u - NB * (TL / 32); b = v / (TC / 32); s0 = (v % (TC / 32)) * 32; }
    const int r0 = row_of(b, s0);
    {
      const int tok = t >> 3, part = t & 7;
      const bf16_t* z = p.Z + (size_t)(r0 + tok) * NZP;
      float sq = 0.f, sk = 0.f, f[8];
#pragma unroll
      for (int k = 0; k < 4; ++k) { unpack8(ldg16(z + ZC_QLAT + part * 32 + k * 8), f);
#pragma unroll
        for (int i = 0; i < 8; ++i) sq += f[i] * f[i]; }
#pragma unroll
      for (int k = 0; k < 2; ++k) { unpack8(ldg16(z + ZC_KVLAT + part * 16 + k * 8), f);
#pragma unroll
        for (int i = 0; i < 8; ++i) sk += f[i] * f[i]; }
      sq = xor_sum<1>(sq); sk = xor_sum<1>(sk);
      sq = xor_sum<2>(sq); sk = xor_sum<2>(sk);
      sq = xor_sum<4>(sq); sk = xor_sum<4>(sk);
      if (part == 0) { s_rstd[tok * 2] = 1.0f / sqrtf(sq * (1.0f / 256) + 1e-6f); s_rstd[tok * 2 + 1] = 1.0f / sqrtf(sk * (1.0f / 128) + 1e-6f); }
    }
    for (int i = t; i < 512; i += NTHR) {
      const int tok = i >> 4, af = i & 15, s = s0 + tok;
      float cs = 1.f, sn = 0.f;
      if (s >= TC) rope_cs(s, (af >> 3) * 16 + (af & 7), cs, sn);
      s_cs[i] = cs; s_sn[i] = sn;
    }
    __syncthreads();
    if (PARTS & 1) {
#pragma unroll 2
    for (int i = t; i < 32 * 48; i += NTHR) {
      const int tok = i / 48, c = i % 48, h = c / 12, ch = c % 12;
      const float rq = s_rstd[tok * 2] * QS_MLA, rkv = s_rstd[tok * 2 + 1];
      const bf16_t* q = QRAW + (size_t)(r0 + tok) * 384 + h * 96;
      float a[8], pr[8];
      unpack8(ldg16(q + ch * 8), a);
      if (ch >= 8) { unpack8(ldg16(q + 64 + ((ch - 8) ^ 1) * 8), pr); rope8(a, pr, ch - 8, s_cs + tok * 16, s_sn + tok * 16); }
#pragma unroll
      for (int e = 0; e < 8; ++e) a[e] *= rq;
      *(u32x4*)(p.Qm + (((size_t)b * 4 + h) * TK + s0 + tok) * 96 + ch * 8) = pack8f(a);
      if (ch < 8) {
        unpack8(ldg16(KVRAW + (size_t)(r0 + tok) * 512 + h * 128 + ch * 8), a);
#pragma unroll
        for (int e = 0; e < 8; ++e) a[e] *= rkv;
      } else {
        const bf16_t* z = p.Z + (size_t)(r0 + tok) * NZP + ZC_KROPE;
        unpack8(ldg16(z + (ch - 8) * 8), a); unpack8(ldg16(z + ((ch - 8) ^ 1) * 8), pr);
        rope8(a, pr, ch - 8, s_cs + tok * 16, s_sn + tok * 16);
      }
      *(u32x4*)(p.Km + (((size_t)b * 4 + h) * TK + s0 + tok) * 96 + ch * 8) = pack8f(a);
    }
#pragma unroll 2
    for (int i = t; i < 32 * 64; i += NTHR) {
      const int tok = i >> 6, c = i & 63, qk = c >> 5, hm = (c >> 2) & 7, cc = c & 3;
      const bf16_t* src = p.Z + (size_t)(r0 + tok) * NZP + (qk ? ZC_DK : ZC_DQ) + hm * 32;
      float a[8], pr[8];
      unpack8(ldg16(src + cc * 8), a); unpack8(ldg16(src + (cc ^ 1) * 8), pr);
      rope8(a, pr, cc, s_cs + tok * 16, s_sn + tok * 16);
      if (qk == 0) {
#pragma unroll
        for (int e = 0; e < 8; ++e) a[e] *= QS_DIFF;
        *(u32x4*)(p.Qd + (((size_t)b * 8 + hm) * TK + s0 + tok) * 32 + cc * 8) = pack8f(a);
      } else *(u32x4*)(p.Kd + (((size_t)b * 8 + hm) * TK + s0 + tok) * 32 + cc * 8) = pack8f(a);
    }
#pragma unroll 2
    for (int i = t; i < 32 * 64; i += NTHR) {
      const int tok = i >> 6, c8 = (i & 63) * 8, s = s0 + tok;
      const bool first = (s == 0) || (s == TC), last = (s == TC - 1) || (s == TK - 1);
      const bf16_t* z = p.Z + (size_t)(r0 + tok) * NZP + ZC_MLQK + c8;
      float x0[8], xm[8], xp[8], o[8];
      unpack8(ldg16(z), x0);
      if (!first) unpack8(ldg16(z - NZP), xm);
      if (!last) unpack8(ldg16(z + NZP), xp);
#pragma unroll
      for (int e = 0; e < 8; ++e) {
        float acc = bcv[e >> 2][e & 3] + x0[e] * w1v[e >> 2][e & 3];
        if (!first) acc += xm[e] * w0v[e >> 2][e & 3];
        if (!last) acc += xp[e] * w2v[e >> 2][e & 3];
        o[e] = acc * fast_rcp(1.0f + fast_exp2(-LOG2E * acc));
      }
      if (c8 < 256) *(u32x4*)(p.MQ + ((size_t)b * TK + s) * 256 + c8) = pack8f(o);
      else {
#pragma unroll
        for (int e = 0; e < 8; ++e) o[e] *= 0.125f;
        *(u32x4*)(p.MK + ((size_t)b * TK + s) * 256 + c8 - 256) = pack8f(o);
      }
    }
    }
#pragma unroll 1
    for (int w = 0; w < ((PARTS & 2) ? 4 : 0); ++w) {
      __syncthreads();
#pragma unroll
      for (int k = 0; k < 4; ++k) {
        const int i = t + k * NTHR, tok = i >> 5, c8 = (i & 31) * 8;
        u32x4 v;
        if (w == 0) { float a[8]; const int h = c8 >> 6; unpack8(ldg16(KVRAW + (size_t)(r0 + tok) * 512 + h * 128 + 64 + (c8 & 63)), a); const float rkv = s_rstd[tok * 2 + 1];
#pragma unroll
          for (int e = 0; e < 8; ++e) a[e] *= rkv;
          v = pack8f(a); }
        else v = ldg16(p.Z + (size_t)(r0 + tok) * NZP + (w == 1 ? ZC_DV : (w == 2 ? ZC_MLV : ZC_GV)) + c8);
        *(u32x4*)(s_t + tok * 264 + c8) = v;
      }
      __syncthreads();
      bf16_t* dst = w == 0 ? p.Vtm : (w == 1 ? p.Vtd : (w == 2 ? p.MVt : p.GVt));
#pragma unroll
      for (int k = 0; k < 4; ++k) {
        const int i = t + k * NTHR, tg = i & 3, ch = i >> 2;
        u32x4 v;
        v.x = (unsigned)s_t[(tg * 8 + 0) * 264 + ch] | ((unsigned)s_t[(tg * 8 + 1) * 264 + ch] << 16);
        v.y = (unsigned)s_t[(tg * 8 + 2) * 264 + ch] | ((unsigned)s_t[(tg * 8 + 3) * 264 + ch] << 16);
        v.z = (unsigned)s_t[(tg * 8 + 4) * 264 + ch] | ((unsigned)s_t[(tg * 8 + 5) * 264 + ch] << 16);
        v.w = (unsigned)s_t[(tg * 8 + 6) * 264 + ch] | ((unsigned)s_t[(tg * 8 + 7) * 264 + ch] << 16);
        *(u32x4*)(dst + (((size_t)b * 4 + (ch >> 6)) * 64 + (ch & 63)) * TK + s0 + tg * 8) = v;
      }
    }
    __syncthreads();
  }
}
constexpr int VROW = 136;
constexpr int VROW_A = 144;
template <int DQK> struct AttnCfg {
  static constexpr int KROW = DQK * 2 + 16;
  static constexpr int KBYTES = 64 * KROW, VBYTES = 64 * VROW_A, STAGE = KBYTES + VBYTES;
  static constexpr int KCH = 64 * DQK * 2 / 16 / NTHR;
};
DI bf16x8 pack8(const f32x16& x, int s) {
  u32x4 pk; pk.x = pack2bf(x[8 * s], x[8 * s + 1]); pk.y = pack2bf(x[8 * s + 2], x[8 * s + 3]); pk.z = pack2bf(x[8 * s + 4], x[8 * s + 5]); pk.w = pack2bf(x[8 * s + 6], x[8 * s + 7]);
  return __builtin_bit_cast(bf16x8, pk);
}
struct TrueC { static constexpr bool value = true; };
struct FalseC { static constexpr bool value = false; };
template <int DQK, int NMAP, int VAR = 0>
DI void attn_unit(const bf16_t* __restrict__ Qb, const bf16_t* __restrict__ Kb, size_t mstride, const bf16_t* __restrict__ Vt, int q0, int nkeys,
                  f32x16 (&O)[NMAP][2], float (&lsum)[NMAP], char* lds) {
  constexpr int DM = DQK / NMAP;
  constexpr int KS = DM / 16;
  using C = AttnCfg<DQK>;
  constexpr int CPM = 64 * DM * 2 / 16;
  constexpr int CPR = DM * 2 / 16;
  const int t = TIDX, lane = t & 63, wid = t >> 6, l31 = lane & 31, hh = lane >> 5;
  bf16x8 qf[NMAP][KS];
#pragma unroll
  for (int m = 0; m < NMAP; ++m)
#pragma unroll
    for (int ks = 0; ks < KS; ++ks) qf[m][ks] = *(const bf16x8*)(Qb + m * mstride + (size_t)(q0 + wid * 32 + l31) * DM + ks * 16 + 8 * hh);
  float mref[NMAP];
  f32x4 lacc[NMAP];
  const short onev = ((lane & 15) < 2 && ((lane >> 4) & 1) == (lane & 15)) ? (short)0x3F80 : (short)0;
  const bf16x8 ones_a = {onev, onev, onev, onev, onev, onev, onev, onev};
#pragma unroll
  for (int m = 0; m < NMAP; ++m) { mref[m] = 0.f; lacc[m] = (f32x4){0.f, 0.f, 0.f, 0.f}; O[m][0] = (f32x16)(0.f); O[m][1] = (f32x16)(0.f); }
  u32x4 rk[C::KCH], rv[2];
  const bf16_t* kg[C::KCH]; int klds[C::KCH];
#pragma unroll
  for (int i = 0; i < C::KCH; ++i) { const int c = t + i * NTHR, m = c / CPM, cc = c % CPM; kg[i] = Kb + m * mstride + cc * 8; klds[i] = (cc / CPR) * C::KROW + m * DM * 2 + (cc % CPR) * 16; }
  const bf16_t* vg = Vt + (size_t)(t >> 3) * TK + (t & 7) * 8;
  const int vlds = C::KBYTES + (t >> 3) * VROW_A + ((t & 7) >> 1) * 32 + ((t & 1) ? 8 : 0);
  const int kfoff = l31 * C::KROW + 16 * hh, vfoff = C::KBYTES + l31 * VROW_A + 16 * hh;
  const int nt = nkeys / 64;
#pragma unroll
  for (int i = 0; i < C::KCH; ++i) rk[i] = ldg16(kg[i]);
  rv[0] = ldg16(vg); rv[1] = ldg16(vg + (size_t)32 * TK);
  auto tile = [&](const int kt, auto chk_c, auto ref_c) __attribute__((always_inline)) {
    constexpr bool CHK = decltype(chk_c)::value, REF = decltype(ref_c)::value;
    char* cur = lds + (kt & 1) * C::STAGE;
    if (VAR != 2) {
#pragma unroll
    for (int i = 0; i < C::KCH; ++i) sts16(cur + klds[i], rk[i]);
#pragma unroll
    for (int i = 0; i < 2; ++i) { char* d = cur + vlds + i * 32 * VROW_A; u32x2 lo, hi; lo.x = rv[i].x; lo.y = rv[i].y; hi.x = rv[i].z; hi.y = rv[i].w; *(u32x2*)d = lo; *(u32x2*)(d + 16) = hi; }
    __syncthreads();
    }
    if (VAR != 2 && kt + 1 < nt) {
      const int kn = VAR == 3 ? ((kt + 1) & 1) : kt + 1;
#pragma unroll
      for (int i = 0; i < C::KCH; ++i) rk[i] = ldg16(kg[i] + (size_t)kn * 64 * DM);
      rv[0] = ldg16(vg + kn * 64); rv[1] = ldg16(vg + (size_t)32 * TK + kn * 64);
    }
    bf16x8 kf[NMAP][2][KS];
#pragma unroll
    for (int k2 = 0; k2 < 2; ++k2)
#pragma unroll
      for (int ks = 0; ks < KS; ++ks) kf[0][k2][ks] = lds_frag(cur + kfoff + k2 * 32 * C::KROW + ks * 32);
    f32x16 S[NMAP][2];
    S[0][0] = (f32x16)(0.f); S[0][1] = (f32x16)(0.f);
#pragma unroll
    for (int ks = 0; ks < KS; ++ks)
#pragma unroll
      for (int k2 = 0; k2 < 2; ++k2) S[0][k2] = MFMA32(kf[0][k2][ks], qf[0][ks], S[0][k2]);
    bf16x8 vf[4][2];
#pragma unroll
    for (int kst = 0; kst < 4; ++kst)
#pragma unroll
      for (int dvt = 0; dvt < 2; ++dvt) vf[kst][dvt] = lds_frag(cur + vfoff + dvt * 32 * VROW_A + kst * 32);
#pragma unroll
    for (int m = 1; m < NMAP; ++m)
#pragma unroll
      for (int k2 = 0; k2 < 2; ++k2)
#pragma unroll
        for (int ks = 0; ks < KS; ++ks) kf[m][k2][ks] = lds_frag(cur + kfoff + k2 * 32 * C::KROW + m * DM * 2 + ks * 32);
#pragma unroll
    for (int m = 0; m < NMAP; ++m) {
      if (m > 0) {
        SCHED_BARRIER();
        S[m][0] = (f32x16)(0.f); S[m][1] = (f32x16)(0.f);
#pragma unroll
        for (int ks = 0; ks < KS; ++ks)
#pragma unroll
          for (int k2 = 0; k2 < 2; ++k2) S[m][k2] = MFMA32(kf[m][k2][ks], qf[m][ks], S[m][k2]);
      }
      if (VAR != 1) {
      if (CHK && (kt & 7) == 0) {
        float mx = fmaxf(S[m][0][0], S[m][1][0]);
#pragma unroll
        for (int i = 1; i < 16; ++i) mx = fmaxf(mx, fmaxf(S[m][0][i], S[m][1][i]));
        mx = xor_max<32>(mx);
        const float rel = mx - mref[m];
        const float delta = (kt == 0) ? ((mx > ATT_THR || mx < -ATT_THR) ? mx : 0.0f) : (rel > ATT_THR ? rel : 0.0f);
        if (wave_any(delta != 0.0f)) {
          const float alpha = fast_exp2(-delta);
          mref[m] += delta; lacc[m][0] *= alpha; lacc[m][1] *= lane_get(alpha, (lane & 15) + 16);
#pragma unroll
          for (int dvt = 0; dvt < 2; ++dvt)
#pragma unroll
            for (int i = 0; i < 16; ++i) O[m][dvt][i] *= alpha;
        }
      }
      if constexpr (REF) {
        if (wave_any(mref[m] != 0.0f)) {
          const f32x2 nm = {-mref[m], -mref[m]};
#pragma unroll
          for (int k2 = 0; k2 < 2; ++k2)
#pragma unroll
            for (int i = 0; i < 16; i += 2) { const f32x2 x = (f32x2){S[m][k2][i], S[m][k2][i + 1]} + nm; S[m][k2][i] = x.x; S[m][k2][i + 1] = x.y; }
        }
      }
#pragma unroll
      for (int k2 = 0; k2 < 2; ++k2)
#pragma unroll
        for (int i = 0; i < 16; ++i) S[m][k2][i] = fast_exp2(S[m][k2][i]);
      }
#pragma unroll
      for (int kst = 0; kst < 4; ++kst) {
        const bf16x8 pf = pack8(S[m][kst >> 1], kst & 1);
#pragma unroll
        for (int dvt = 0; dvt < 2; ++dvt) O[m][dvt] = MFMA32(vf[kst][dvt], pf, O[m][dvt]);
        lacc[m] = MFMA16(ones_a, pf, lacc[m]);
      }
    }
  };
  int kt = 0;
#pragma unroll 1
  while (kt < nt) {
    tile(kt, TrueC{}, TrueC{});
    ++kt;
    bool nz = false;
#pragma unroll
    for (int m = 0; m < NMAP; ++m) nz = nz || (mref[m] != 0.0f);
    if (!wave_any(nz)) {
      const int k8 = (kt + 7) & ~7, kend = k8 < nt ? k8 : nt;
#pragma unroll 1
      for (; kt < kend; ++kt) tile(kt, FalseC{}, FalseC{});
    }
  }
  __syncthreads();
#pragma unroll
  for (int m = 0; m < NMAP; ++m) { const float a0 = lane_get(lacc[m][0], lane & 15), a1 = lane_get(lacc[m][1], lane & 15); lsum[m] = l31 < 16 ? a0 : a1; }
}
constexpr int ATT_QB = TK / 128;
constexpr int ATT_LDS = 2 * AttnCfg<96>::STAGE;
constexpr int ATT_QBL = TL / 128, ATT_QBC = TC / 128, ATT_LAT_UNITS = NB * 4 * ATT_QBL, ATT_UNITS = ATT_LAT_UNITS + NB * 4 * ATT_QBC;
DI void att_unit(int u, int& bh, int& qb) {
  if (u < ATT_LAT_UNITS) { bh = u & 7; qb = ATT_QBC + (u >> 3); } else { const int v = u - ATT_LAT_UNITS; bh = v & 7; qb = v >> 3; }
}
DI void ph_attn_diff(const Params& p, int layer, int need_ctx, char* lds, int bid, int nblk) {
  const int lane = TIDX & 63, wid = TIDX >> 6, l31 = lane & 31, hh = lane >> 5;
  float lam_init; const float lam = lam_of(p, layer, lam_init);
#pragma unroll 1
  for (int u = bid; u < (need_ctx ? ATT_UNITS : ATT_LAT_UNITS); u += nblk) {
    int bh, qb; att_unit(u, bh, qb);
    const int b = bh >> 2, h = bh & 3, q0 = qb * 128;
    const int r = row_of(b, q0 + wid * 32 + l31);
    f32x16 O[2][2]; float ls[2];
    attn_unit<64, 2>(p.Qd + ((size_t)b * 8 + h * 2) * TK * 32, p.Kd + ((size_t)b * 8 + h * 2) * TK * 32, (size_t)TK * 32, p.Vtd + ((size_t)b * 4 + h) * 64 * TK, q0,
                     q0 < TC ? TC : TK, O, ls, lds);
    const float i0 = 1.0f / ls[0], i1 = lam / ls[1];
    float ss = 0.f;
#pragma unroll
    for (int dvt = 0; dvt < 2; ++dvt)
#pragma unroll
      for (int i = 0; i < 16; ++i) { const float o = O[0][dvt][i] * i0 - O[1][dvt][i] * i1; O[0][dvt][i] = o; ss += o * o; }
    ss = xor_sum<32>(ss);
    const float rstd = (1.0f - lam_init) / sqrtf(ss * (1.0f / 64) + 1e-6f);
    const float* gd = p.g_diff_out + layer * 256 + h * 64;
#pragma unroll
    for (int dvt = 0; dvt < 2; ++dvt)
#pragma unroll
      for (int g = 0; g < 4; ++g) {
        const int dv = dvt * 32 + 8 * g + 4 * hh;
        const f32x4 gv = *(const f32x4*)(gd + dv);
        f32x4 o = {O[0][dvt][4 * g] * rstd * gv[0], O[0][dvt][4 * g + 1] * rstd * gv[1], O[0][dvt][4 * g + 2] * rstd * gv[2], O[0][dvt][4 * g + 3] * rstd * gv[3]};
        st_bf16x4(p.Y + (size_t)r * D + 768 + h * 64 + dv, o);
      }
  }
}
DI void ph_attn_mla(const Params& p, int need_ctx, char* lds, int bid, int nblk) {
  const int lane = TIDX & 63, wid = TIDX >> 6, l31 = lane & 31, hh = lane >> 5;
#pragma unroll 1
  for (int u = bid; u < (need_ctx ? ATT_UNITS : ATT_LAT_UNITS); u += nblk) {
    int bh, qb; att_unit(u, bh, qb);
    const int b = bh >> 2, h = bh & 3, q0 = qb * 128;
    const int r = row_of(b, q0 + wid * 32 + l31);
    f32x16 O[1][2]; float ls[1];
    attn_unit<96, 1>(p.Qm + ((size_t)b * 4 + h) * TK * 96, p.Km + ((size_t)b * 4 + h) * TK * 96, 0, p.Vtm + ((size_t)b * 4 + h) * 64 * TK, q0, q0 < TC ? TC : TK, O, ls, lds);
    const float inv = 1.0f / ls[0];
#pragma unroll
    for (int dvt = 0; dvt < 2; ++dvt)
#pragma unroll
      for (int g = 0; g < 4; ++g) {
        f32x4 o = {O[0][dvt][4 * g] * inv, O[0][dvt][4 * g + 1] * inv, O[0][dvt][4 * g + 2] * inv, O[0][dvt][4 * g + 3] * inv};
        st_bf16x4(p.Y + (size_t)r * D + h * 64 + dvt * 32 + 8 * g + 4 * hh, o);
      }
  }
}
template <int VAR> DI void ph_attn_mla_probe(const Params& p, char* lds, int bid, int nblk) {
  const int lane = TIDX & 63, wid = TIDX >> 6, l31 = lane & 31, hh = lane >> 5;
#pragma unroll 1
  for (int u = bid; u < ATT_LAT_UNITS; u += nblk) {
    int bh, qb; att_unit(u, bh, qb);
    const int b = bh >> 2, h = bh & 3, q0 = qb * 128;
    const int r = row_of(b, q0 + wid * 32 + l31);
    f32x16 O[1][2]; float ls[1];
    attn_unit<96, 1, VAR>(p.Qm + ((size_t)b * 4 + h) * TK * 96, p.Km + ((size_t)b * 4 + h) * TK * 96, 0, p.Vtm + ((size_t)b * 4 + h) * 64 * TK, q0, TK, O, ls, lds);
    const float inv = 1.0f / ls[0];
#pragma unroll
    for (int dvt = 0; dvt < 2; ++dvt)
#pragma unroll
      for (int g = 0; g < 4; ++g) {
        f32x4 o = {O[0][dvt][4 * g] * inv, O[0][dvt][4 * g + 1] * inv, O[0][dvt][4 * g + 2] * inv, O[0][dvt][4 * g + 3] * inv};
        *(f32x4*)(p.out + (size_t)r * D + h * 64 + dvt * 32 + 8 * g + 4 * hh) = o;
      }
  }
}
DI void ph_attn(const Params& p, int layer, int need_ctx, char* lds, int bid, int nblk) {
  ph_attn_diff(p, layer, need_ctx, lds, bid, nblk);
  ph_attn_mla(p, need_ctx, lds, bid, nblk);
}

DI float wave_sum(float v) {
  v = xor_sum<1>(v); v = xor_sum<2>(v); v = xor_sum<4>(v); v = xor_sum<8>(v); v = xor_sum<16>(v); v = xor_sum<32>(v);
  return v;
}
DI void ld_row16(const float* row, int lane, f32x4 (&v)[4]) {
#pragma unroll
  for (int i = 0; i < 4; ++i) v[i] = *(const f32x4*)(row + 256 * i + 4 * lane);
}
DI void ld_row16_bf(const bf16_t* row, int lane, f32x4 (&v)[4]) {
#pragma unroll
  for (int i = 0; i < 4; ++i) { const u32x2 u = *(const u32x2*)(row + 256 * i + 4 * lane); v[i] = (f32x4){u2f(u.x << 16), u2f(u.x & 0xffff0000u), u2f(u.y << 16), u2f(u.y & 0xffff0000u)}; }
}
DI void ph_modulate(const Params& p, int layer, const float* xl, const float* xcx, int bid, int nblk) {
  const int lane = TIDX & 63, wid = TIDX >> 6;
  const float* g = p.g_mix_pre + layer * 1024;
  for (int r = bid * 4 + wid; r < R; r += nblk * 4) {
    const int w = r < RL ? r / TL : 2;
    const float* mb = p.mods + (size_t)(layer * 3 + w) * 6144;
    const float* x = r < RL ? xl + (size_t)r * D : xcx + (size_t)(r - RL) * D;
    f32x4 xv[4], gv[4], sc[4], sh[4];
    ld_row16(x, lane, xv); ld_row16(g, lane, gv); ld_row16(mb + 1024, lane, sc); ld_row16(mb, lane, sh);
    float ss = 0.f;
#pragma unroll
    for (int i = 0; i < 4; ++i)
#pragma unroll
      for (int e = 0; e < 4; ++e) ss += xv[i][e] * xv[i][e];
    const float rstd = 1.0f / sqrtf(wave_sum(ss) * (1.0f / D) + 1e-6f);
#pragma unroll
    for (int i = 0; i < 4; ++i) {
      f32x4 o;
#pragma unroll
      for (int e = 0; e < 4; ++e) o[e] = xv[i][e] * rstd * gv[i][e] * (1.f + sc[i][e]) + sh[i][e];
      st_bf16x4(p.H + (size_t)r * D + 256 * i + 4 * lane, o);
    }
  }
}
DI void ph_resid_mix(const Params& p, int layer, const float* xl_in, const float* xc_in, int rows, char* lds, int bid, int nblk) {
  const int lane = TIDX & 63, wid = TIDX >> 6;
  const float* wr = p.w_router + (size_t)layer * D * 16;
  for (int i = TIDX; i < D * 4; i += NTHR) { const int k = i >> 2, q = i & 3; *(f32x4*)(lds + k * 64 + (k >> 2) * 16 + q * 16) = *(const f32x4*)(wr + k * 16 + q * 4); }
  __syncthreads();
  int wprev = -1;
  f32x4 ac[4], gs[4], s3[4];
  for (int r = bid * 4 + wid; r < rows; r += nblk * 4) {
    const int w = r < RL ? r / TL : 2;
    const float* xin = r < RL ? xl_in + (size_t)r * D : xc_in + (size_t)(r - RL) * D;
    float* xo = r < RL ? p.out + (size_t)r * D : p.xc + (size_t)(r - RL) * D;
    f32x4 yv[4], xv[4];
    ld_row16_bf(p.YO + (size_t)r * D, lane, yv); ld_row16(xin, lane, xv);
    if (w != wprev) {
      const float* mb = p.mods + (size_t)(layer * 3 + w) * 6144;
      f32x4 a[4], c[4];
      ld_row16(mb + 2 * 1024, lane, a); ld_row16(p.g_mix_post + layer * 1024, lane, c);
#pragma unroll
      for (int i = 0; i < 4; ++i) ac[i] = a[i] * c[i];
      ld_row16(p.g_ffn_pre + layer * 1024, lane, a); ld_row16(mb + 4 * 1024, lane, c); ld_row16(mb + 3 * 1024, lane, s3);
#pragma unroll
      for (int i = 0; i < 4; ++i) gs[i] = a[i] * (c[i] + 1.0f);
      wprev = w;
    }
    float ss = 0.f;
#pragma unroll
    for (int i = 0; i < 4; ++i)
#pragma unroll
      for (int e = 0; e < 4; ++e) ss += yv[i][e] * yv[i][e];
    const float rstd = 1.0f / sqrtf(wave_sum(ss) * (1.0f / D) + 1e-6f);
    float s2 = 0.f;
#pragma unroll
    for (int i = 0; i < 4; ++i) {
#pragma unroll
      for (int e = 0; e < 4; ++e) { xv[i][e] += ac[i][e] * yv[i][e] * rstd; s2 += xv[i][e] * xv[i][e]; }
      *(f32x4*)(xo + 256 * i + 4 * lane) = xv[i];
    }
    const float rstd2 = 1.0f / sqrtf(wave_sum(s2) * (1.0f / D) + 1e-6f);
    float lg[16];
#pragma unroll
    for (int e = 0; e < 16; ++e) lg[e] = 0.f;
#pragma unroll
    for (int i = 0; i < 4; ++i) {
      f32x4 h2;
#pragma unroll
      for (int e = 0; e < 4; ++e) h2[e] = xv[i][e] * rstd2 * gs[i][e] + s3[i][e];
      st_bf16x4(p.H + (size_t)r * D + 256 * i + 4 * lane, h2);
#pragma unroll
      for (int e = 0; e < 4; ++e) {
        const char* wk = lds + (256 * i + 4 * lane + e) * 64 + (64 * i + lane) * 16;
#pragma unroll
        for (int q = 0; q < 4; ++q) { const f32x4 wv = *(const f32x4*)(wk + 16 * q); lg[4 * q] += h2[e] * wv[0]; lg[4 * q + 1] += h2[e] * wv[1]; lg[4 * q + 2] += h2[e] * wv[2]; lg[4 * q + 3] += h2[e] * wv[3]; }
      }
    }
#pragma unroll
    for (int e = 0; e < 16; ++e) lg[e] = wave_sum(lg[e]);
    float mx = lg[0];
#pragma unroll
    for (int e = 1; e < 16; ++e) mx = fmaxf(mx, lg[e]);
    float sm = 0.f;
#pragma unroll
    for (int e = 0; e < 16; ++e) { lg[e] = expf(lg[e] - mx); sm += lg[e]; }
    int b, s; bs_of(r, b, s);
    float mine = 0.f;
#pragma unroll
    for (int e = 0; e < 16; ++e) mine = (lane == e) ? lg[e] / sm : mine;
    if (lane < 16) p.AFF[((size_t)b * NE + lane) * TK + s] = mine;
  }
}
DI void ph_resid_ffn(const Params& p, int layer, int rows, int bid, int nblk) {
  const int lane = TIDX & 63, wid = TIDX >> 6;
  int r = bid * 4 + wid;
  int inv_n = (r < rows && lane < NE) ? p.INV[(size_t)r * NE + lane] : -1;
  int wprev = -1;
  f32x4 ac[4], gs[4], sh[4];
#pragma unroll 1
  for (; r < rows; r += nblk * 4) {
    const int w = r < RL ? r / TL : 2;
    if (w != wprev) {
      const float* mb = p.mods + (size_t)(layer * 3 + w) * 6144;
      f32x4 a[4], c[4];
      ld_row16(mb + 5 * 1024, lane, a); ld_row16(p.g_ffn_post + layer * 1024, lane, c);
#pragma unroll
      for (int i = 0; i < 4; ++i) ac[i] = a[i] * c[i];
      if (layer == 0) {
        const float* mb1 = p.mods + (size_t)(3 + w) * 6144;
        ld_row16(p.g_mix_pre + 1024, lane, a); ld_row16(mb1 + 1024, lane, c); ld_row16(mb1, lane, sh);
#pragma unroll
        for (int i = 0; i < 4; ++i) gs[i] = a[i] * (c[i] + 1.0f);
      }
      wprev = w;
    }
    float* xo = r < RL ? p.out + (size_t)r * D : p.xc + (size_t)(r - RL) * D;
    const int myinv = inv_n;
    { const int rn = r + nblk * 4; inv_n = (rn < rows && lane < NE) ? p.INV[(size_t)rn * NE + lane] : -1; }
    f32x4 f[4], xv[4];
    ld_row16(xo, lane, xv);
#pragma unroll
    for (int i = 0; i < 4; ++i) f[i] = (f32x4){0.f, 0.f, 0.f, 0.f};
    unsigned mask = wave_ballot16(myinv >= 0);
#pragma unroll 1
    while (mask) {
      const int e0 = __builtin_ctz(mask); mask &= mask - 1;
      const bool two = mask != 0u;
      const int e1 = two ? __builtin_ctz(mask) : e0; if (two) mask &= mask - 1;
      const int s0 = lane_bcast(myinv, e0), s1 = lane_bcast(myinv, e1);
      f32x4 y0[4], y1[4];
      ld_row16_bf(p.YE + ((size_t)e0 * NSLOT + s0) * D, lane, y0); ld_row16_bf(p.YE + ((size_t)e1 * NSLOT + s1) * D, lane, y1);
      const float w1 = two ? 1.0f : 0.0f;
#pragma unroll
      for (int i = 0; i < 4; ++i) f[i] += y0[i] + y1[i] * w1;
    }
    float ss = 0.f;
#pragma unroll
    for (int i = 0; i < 4; ++i)
#pragma unroll
      for (int e = 0; e < 4; ++e) ss += f[i][e] * f[i][e];
    const float rstd = 1.0f / sqrtf(wave_sum(ss) * (1.0f / D) + 1e-6f);
    float s2 = 0.f;
#pragma unroll
    for (int i = 0; i < 4; ++i) {
#pragma unroll
      for (int e = 0; e < 4; ++e) { xv[i][e] += ac[i][e] * f[i][e] * rstd; s2 += xv[i][e] * xv[i][e]; }
      *(f32x4*)(xo + 256 * i + 4 * lane) = xv[i];
    }
    if (layer == 0) {
      const float rstd2 = 1.0f / sqrtf(wave_sum(s2) * (1.0f / D) + 1e-6f);
#pragma unroll
      for (int i = 0; i < 4; ++i) {
        f32x4 o;
#pragma unroll
        for (int e = 0; e < 4; ++e) o[e] = xv[i][e] * rstd2 * gs[i][e] + sh[i][e];
        st_bf16x4(p.H + (size_t)r * D + 256 * i + 4 * lane, o);
      }
    }
  }
}
DI void ph_mods(const Params& p, char* lds, int bid, int nblk) {
  float* sc = (float*)lds;
  const int t = TIDX;
  for (int i = t; i < 3 * 1024; i += NTHR) { const float v = i < 2048 ? p.c[i] : p.c_ctx[i - 2048]; sc[i] = v / (1.0f + expf(-v)); }
  __syncthreads();
#pragma unroll 1
  for (long gi = (long)bid * NTHR + t; gi < 2 * 3 * 6144; gi += (long)nblk * NTHR) {
    const int col = (int)(gi % 6144), w = (int)((gi / 6144) % 3), l = (int)(gi / (3 * 6144));
    const float* W = p.w_ada + (size_t)l * 1024 * 6144 + col; const float* s = sc + w * 1024;
    float acc[8];
#pragma unroll
    for (int q = 0; q < 8; ++q) acc[q] = 0.f;
#pragma unroll 1
    for (int k = 0; k < 1024; k += 8) {
#pragma unroll
      for (int q = 0; q < 8; ++q) acc[q] += s[k + q] * W[(size_t)(k + q) * 6144];
    }
    p.mods[gi] = ((acc[0] + acc[1]) + (acc[2] + acc[3])) + ((acc[4] + acc[5]) + (acc[6] + acc[7])) + p.b_ada[l * 6144 + col];
  }
  __syncthreads();
}
constexpr int TOPK_LDS = TL * 4 + 2048;
DI int block_sum_i(int v, int* red) {
  const int lane = TIDX & 63, wid = TIDX >> 6;
  v = xor_sum_i<1>(v); v = xor_sum_i<2>(v); v = xor_sum_i<4>(v); v = xor_sum_i<8>(v); v = xor_sum_i<16>(v); v = xor_sum_i<32>(v);
  __syncthreads();
  if (lane == 0) red[wid] = v;
  __syncthreads();
  return red[0] + red[1] + red[2] + red[3];
}
DI int block_excl_scan(int v, int* red) {
  const int lane = TIDX & 63, wid = TIDX >> 6;
  int inc = v;
#pragma unroll
  for (int d = 1; d < 64; d <<= 1) { const int o = lane_up(inc, d, lane); if (lane >= d) inc += o; }
  __syncthreads();
  if (lane == 63) red[wid] = inc;
  __syncthreads();
  int base = 0;
  for (int q = 0; q < wid; ++q) base += red[q];
  return base + inc - v;
}
DI void ph_topk(const Params& p, int need_ctx, char* lds, int bid, int nblk) {
  unsigned* vals = (unsigned*)lds; int* red = (int*)(lds + TL * 4 + 1024);
  const int t = TIDX;
  for (int u = bid; u < NB * NE * 2; u += nblk) {
    const int seg = u & 1, e = (u >> 1) % NE, b = u / (2 * NE);
    const int s0 = seg ? TC : 0, n = seg ? TL : TC, cap = seg ? CAPL : CAPC, slot0 = seg ? b * CAPL : NB * CAPL + b * CAPC;
    if (seg == 0 && !need_ctx) { for (int q = t; q < cap; q += NTHR) p.SEL[(size_t)e * NSLOT + slot0 + q] = -1; continue; }
    const float* a = p.AFF + ((size_t)b * NE + e) * TK + s0;
    const int vpt = (n + NTHR - 1) / NTHR, i0 = t * vpt, i1 = (i0 + vpt < n) ? i0 + vpt : n;
    for (int i = t; i < n; i += NTHR) vals[i + i / vpt] = f2u(a[i]);
    __syncthreads();
    unsigned thr = 0;
    for (int bit = 31; bit >= 0; --bit) {
      const unsigned cand = thr | (1u << bit);
      int cnt = 0;
      for (int i = i0; i < i1; ++i) cnt += (vals[i + t] >= cand);
      if (block_sum_i(cnt, red) >= cap) thr = cand;
    }
    int cgt = 0, ceq = 0;
    for (int i = i0; i < i1; ++i) { cgt += (vals[i + t] > thr); ceq += (vals[i + t] == thr); }
    const int ngt = block_sum_i(cgt, red);
    const int neq = cap - ngt;
    int eqoff = block_excl_scan(ceq, red);
    int csel = 0;
    { int er = eqoff; for (int i = i0; i < i1; ++i) { if (vals[i + t] > thr) ++csel; else if (vals[i + t] == thr) { if (er < neq) ++csel; ++er; } } }
    int q = block_excl_scan(csel, red);
    for (int i = i0; i < i1; ++i) {
      const unsigned v = vals[i + t]; int sel = -1;
      if (v > thr) sel = q++; else if (v == thr) { if (eqoff < neq) sel = q++; ++eqoff; }
      const int r = row_of(b, s0 + i);
      if (sel >= 0) { p.SEL[(size_t)e * NSLOT + slot0 + sel] = r; p.SELV[(size_t)e * NSLOT + slot0 + sel] = u2f(v); }
      p.INV[(size_t)r * NE + e] = sel >= 0 ? slot0 + sel : -1;
    }
    __syncthreads();
  }
}
DI void ph_wt(const float* in, bf16_t* out, int K, int N, int NP, int nbatch, long in_bs, long out_bs, const float* gain, char* lds, int bid, int nblk) {
  float* tile = (float*)lds;
  const int t = TIDX, tk = K / 64, tn = NP / 64, ntile = nbatch * tk * tn;
  f32x4 v[4];
  auto gload = [&](int u) {
    const int bt = u / (tk * tn), rem = u % (tk * tn), k0 = (rem / tn) * 64, n0 = (rem % tn) * 64;
    const float* I = in + (size_t)bt * in_bs;
#pragma unroll
    for (int i = 0; i < 4; ++i) {
      const int idx = t + i * NTHR, kk = idx >> 4, n4 = (idx & 15) * 4;
      v[i] = (f32x4){0.f, 0.f, 0.f, 0.f};
      if (n0 + n4 < N) v[i] = *(const f32x4*)(I + (size_t)(k0 + kk) * N + n0 + n4);
      if (gain) { const float g = gain[k0 + kk]; v[i][0] *= g; v[i][1] *= g; v[i][2] *= g; v[i][3] *= g; }
    }
  };
  if (bid < ntile) gload(bid);
#pragma unroll 1
  for (int u = bid; u < ntile; u += nblk) {
    const int bt = u / (tk * tn), rem = u % (tk * tn), k0 = (rem / tn) * 64, n0 = (rem % tn) * 64;
    bf16_t* O = out + (size_t)bt * out_bs;
#pragma unroll
    for (int i = 0; i < 4; ++i) { const int idx = t + i * NTHR, kk = idx >> 4, n4 = (idx & 15) * 4; float* d = tile + kk * 65 + n4; d[0] = v[i][0]; d[1] = v[i][1]; d[2] = v[i][2]; d[3] = v[i][3]; }
    __syncthreads();
    if (u + nblk < ntile) gload(u + nblk);
#pragma unroll
    for (int i = 0; i < 2; ++i) {
      const int idx = t + i * NTHR, kg = idx & 7, nn = idx >> 3;
      float a[8];
#pragma unroll
      for (int e = 0; e < 8; ++e) a[e] = tile[(kg * 8 + e) * 65 + nn];
      u32x4 o; o.x = pack2bf(a[0], a[1]); o.y = pack2bf(a[2], a[3]); o.z = pack2bf(a[4], a[5]); o.w = pack2bf(a[6], a[7]);
      *(u32x4*)(O + (size_t)(n0 + nn) * K + k0 + kg * 8) = o;
    }
    __syncthreads();
  }
}
DI float wave_max(float v) {
  v = xor_max<1>(v); v = xor_max<2>(v); v = xor_max<4>(v); v = xor_max<8>(v); v = xor_max<16>(v); v = xor_max<32>(v);
  return v;
}
DI bf16x8 cvt8(const float* f) {
  const f32x4 a = *(const f32x4*)f, b = *(const f32x4*)(f + 4);
  u32x4 pk; pk.x = pack2bf(a[0], a[1]); pk.y = pack2bf(a[2], a[3]); pk.z = pack2bf(b[0], b[1]); pk.w = pack2bf(b[2], b[3]);
  return __builtin_bit_cast(bf16x8, pk);
}
constexpr int SCAN_UNITS = NB * NCK * 4, SCAN_LAT_UNITS = NB * NCL * 4;
DI void scan_unit(int u, int& b, int& c, int& h) {
  h = u & 3;
  if (u < SCAN_LAT_UNITS) { c = NCC + (u >> 2) % NCL; b = u / (4 * NCL); } else { const int v = u - SCAN_LAT_UNITS; c = (v >> 2) % NCC; b = v / (4 * NCC); }
}

DI void ph_ml_local(const Params& p, char* lds, int bid, int nblk) {
  bf16_t* sK = (bf16_t*)lds;
  float* sW = (float*)(lds + 64 * 132);
  const int t = TIDX, lane = t & 63, wid = t >> 6, l31 = lane & 31, hh = lane >> 5;
  const int d = wid & 1, vt = wid >> 1;
#pragma unroll 1
  for (int u = bid; u < SCAN_UNITS; u += nblk) {
    int b, c, h; scan_unit(u, b, c, h);
    {
      const int row = t >> 2, seg = (t & 3) * 16;
      const bf16_t* src = p.MK + ((size_t)b * TK + 64 * c + row) * 256 + h * 64 + seg;
      const u32x4 a = ldg16(src), bb = ldg16(src + 8);
      unsigned* dst = (unsigned*)((char*)sK + row * 132 + seg * 2);
      dst[0] = a.x; dst[1] = a.y; dst[2] = a.z; dst[3] = a.w; dst[4] = bb.x; dst[5] = bb.y; dst[6] = bb.z; dst[7] = bb.w;
    }
    if (t < 128) {
      const int dd = t >> 6, l = t & 63, j = step_of(dd, c), pos = dd ? 63 - l : l;
      const size_t o = (((size_t)b * 2 + dd) * TK + 64 * j) * 4 + h;
      const float bend = p.BC[o + 63 * 4], wl = bend - p.BC[o + pos * 4] + p.IGS[o + pos * 4];
      const float ml = wave_max(wl);
      sW[dd * 64 + l] = expf(wl - ml);
      if (l == 0) { const size_t uu = (((size_t)b * 2 + dd) * NCK + j) * 4 + h; p.MM[uu * 4] = ml; p.MM[uu * 4 + 1] = bend; }
    }
    __syncthreads();
    const int j = step_of(d, c);
    const size_t uu = (((size_t)b * 2 + d) * NCK + j) * 4 + h;
    f32x16 acc[2]; acc[0] = (f32x16)(0.f); acc[1] = (f32x16)(0.f);
    const bf16_t* vsrc = p.MVt + (((size_t)b * 4 + h) * 64 + vt * 32 + l31) * TK + 64 * c;
#pragma unroll
    for (int ks = 0; ks < 4; ++ks) {
      const bf16x8 a = *(const bf16x8*)(vsrc + ks * 16 + 8 * hh);
      const float* w = sW + d * 64 + ks * 16 + 8 * hh;
      u32x4 pk;
      pk.x = pack2bf(bf2f((bf16_t)a[0]) * w[0], bf2f((bf16_t)a[1]) * w[1]); pk.y = pack2bf(bf2f((bf16_t)a[2]) * w[2], bf2f((bf16_t)a[3]) * w[3]);
      pk.z = pack2bf(bf2f((bf16_t)a[4]) * w[4], bf2f((bf16_t)a[5]) * w[5]); pk.w = pack2bf(bf2f((bf16_t)a[6]) * w[6], bf2f((bf16_t)a[7]) * w[7]);
      const bf16x8 af = __builtin_bit_cast(bf16x8, pk);
#pragma unroll
      for (int kt = 0; kt < 2; ++kt) {
        bf16x8 bfr;
#pragma unroll
        for (int q = 0; q < 8; ++q) bfr[q] = (short)sK[(ks * 16 + 8 * hh + q) * 66 + kt * 32 + l31];
        acc[kt] = MFMA32(af, bfr, acc[kt]);
      }
    }
#pragma unroll
    for (int kt = 0; kt < 2; ++kt)
#pragma unroll
      for (int i = 0; i < 16; ++i) p.MC[uu * 4096 + (size_t)(vt * 32 + (i & 3) + 8 * (i >> 2) + 4 * hh) * 64 + kt * 32 + l31] = acc[kt][i];
    float nl = 0.f;
    for (int q = 0; q < 32; ++q) { const int l = hh * 32 + q; nl += sW[d * 64 + l] * bf2f(sK[l * 66 + vt * 32 + l31]); }
    nl = xor_sum<32>(nl);
    if (hh == 0) p.MN[uu * 64 + vt * 32 + l31] = nl;
    __syncthreads();
  }
}
constexpr int SCAN_PF = 8;
DI void ph_ml_scan(const Params& p, int bid, int nblk) {
  for (long gi = (long)bid * NTHR + TIDX; gi < (long)NB * 2 * 4 * 4160; gi += (long)nblk * NTHR) {
    const int e = (int)(gi % 4160), ch = (int)(gi / 4160), h = ch & 3, bd = ch >> 2;
    float* base = e < 4096 ? p.MC + (((size_t)bd * NCK) * 4 + h) * 4096 + e : p.MN + (((size_t)bd * NCK) * 4 + h) * 64 + (e - 4096);
    const size_t stride = e < 4096 ? 4 * 4096 : 4 * 64;
    float* mm = p.MM + (((size_t)bd * NCK) * 4 + h) * 4;
    float st = 0.f, m = -1e30f;
    float cl[SCAN_PF], cm[SCAN_PF], cb[SCAN_PF], nl[SCAN_PF], nm[SCAN_PF], nb[SCAN_PF];
#pragma unroll
    for (int q = 0; q < SCAN_PF; ++q) if (q < NCK) { cl[q] = base[(size_t)q * stride]; cm[q] = mm[q * 16]; cb[q] = mm[q * 16 + 1]; }
#pragma unroll 1
    for (int jb = 0; jb < NCK; jb += SCAN_PF) {
#pragma unroll
      for (int q = 0; q < SCAN_PF; ++q) { const int j = jb + SCAN_PF + q; if (j < NCK) { nl[q] = base[(size_t)j * stride]; nm[q] = mm[j * 16]; nb[q] = mm[j * 16 + 1]; } }
#pragma unroll
      for (int q = 0; q < SCAN_PF; ++q) {
        const int j = jb + q;
        if (j < NCK) {
          const float mn = fmaxf(cb[q] + m, cm[q]), a = expf(cb[q] + m - mn), g = expf(cm[q] - mn);
          base[(size_t)j * stride] = st;
          st = a * st + g * cl[q];
          if (e == 0) mm[j * 16 + 2] = m;
          m = mn;
        }
      }
#pragma unroll
      for (int q = 0; q < SCAN_PF; ++q) { cl[q] = nl[q]; cm[q] = nm[q]; cb[q] = nb[q]; }
    }
  }
}
DI void ph_gla_scan(const Params& p, int bid, int nblk) {
  for (long gi = (long)bid * NTHR + TIDX; gi < (long)NB * 2 * 4 * 2048; gi += (long)nblk * NTHR) {
    const int e = (int)(gi % 2048), ch = (int)(gi / 2048), h = ch & 3, bd = ch >> 2, k = e & 31;
    float* base = p.GS + (((size_t)bd * NCK) * 4 + h) * 2048 + e;
    const float* ge = p.GC + ((size_t)bd * TK + 63) * 128 + h * 32 + k;
    float st = 0.f;
    float cl[SCAN_PF], cg[SCAN_PF], nl[SCAN_PF], ng[SCAN_PF];
#pragma unroll
    for (int q = 0; q < SCAN_PF; ++q) if (q < NCK) { cl[q] = base[(size_t)q * 4 * 2048]; cg[q] = ge[(size_t)q * 64 * 128]; }
#pragma unroll 1
    for (int jb = 0; jb < NCK; jb += SCAN_PF) {
#pragma unroll
      for (int q = 0; q < SCAN_PF; ++q) { const int j = jb + SCAN_PF + q; if (j < NCK) { nl[q] = base[(size_t)j * 4 * 2048]; ng[q] = ge[(size_t)j * 64 * 128]; } }
#pragma unroll
      for (int q = 0; q < SCAN_PF; ++q) {
        const int j = jb + q;
        if (j < NCK) { base[(size_t)j * 4 * 2048] = st; st = expf(cg[q]) * st + cl[q]; }
      }
#pragma unroll
      for (int q = 0; q < SCAN_PF; ++q) { cl[q] = nl[q]; cg[q] = ng[q]; }
    }
  }
}
constexpr int MO_K = 0, MO_V = 64 * 144, MO_A = MO_V + 64 * VROW, MO_PM = MO_A + 512, MO_N0 = MO_PM + 512, MO_X = MO_N0 + 512, MO_LDS = MO_X + 16384;
DI void ph_ml_out(const Params& p, int layer, int need_ctx, char* lds, int bid, int nblk) {
  float* sA = (float*)(lds + MO_A); float* sPM = (float*)(lds + MO_PM); float* sN0 = (float*)(lds + MO_N0); float* sX = (float*)(lds + MO_X);
  const int t = TIDX, lane = t & 63, wid = t >> 6, l31 = lane & 31, hh = lane >> 5;
  const int lt = wid & 1, d = wid >> 1;
#pragma unroll 1
  for (int u = bid; u < (need_ctx ? SCAN_UNITS : SCAN_LAT_UNITS); u += nblk) {
    int b, c, h; scan_unit(u, b, c, h);
    {
      const int row = t >> 2, seg = (t & 3) * 16;
      const bf16_t* ks = p.MK + ((size_t)b * TK + 64 * c + row) * 256 + h * 64 + seg;
      sts16(lds + MO_K + row * 144 + seg * 2, ldg16(ks)); sts16(lds + MO_K + row * 144 + seg * 2 + 16, ldg16(ks + 8));
      const bf16_t* vs = p.MVt + (((size_t)b * 4 + h) * 64 + row) * TK + 64 * c + seg;
      const u32x4 v0 = ldg16(vs), v1 = ldg16(vs + 8);
      u32x2* dv = (u32x2*)(lds + MO_V + row * VROW + seg * 2);
      u32x2 q; q.x = v0.x; q.y = v0.y; dv[0] = q; q.x = v0.z; q.y = v0.w; dv[1] = q; q.x = v1.x; q.y = v1.y; dv[2] = q; q.x = v1.z; q.y = v1.w; dv[3] = q;
    }
    if (t < 128) {
      const int dd = t >> 6, s = t & 63, j = step_of(dd, c), pos = dd ? 63 - s : s;
      const size_t o = (((size_t)b * 2 + dd) * TK + 64 * j) * 4 + h;
      sA[dd * 64 + s] = p.IGS[o + pos * 4] - p.BC[o + pos * 4];
      const size_t uu = (((size_t)b * 2 + dd) * NCK + j) * 4 + h;
      sN0[dd * 64 + s] = p.MN[uu * 64 + s];
    }
    __syncthreads();
    if (t < 2) {
      float m = -1e30f;
      if (t == 0) { for (int s = 0; s < 64; ++s) { m = fmaxf(m, sA[s]); sPM[s] = m; } }
      else { for (int s = 63; s >= 0; --s) { m = fmaxf(m, sA[64 + s]); sPM[64 + s] = m; } }
    }
    __syncthreads();
    const int j = step_of(d, c);
    const size_t uu = (((size_t)b * 2 + d) * NCK + j) * 4 + h;
    const int l = lt * 32 + l31, pos = d ? 63 - l : l;
    const float bl = p.BC[(((size_t)b * 2 + d) * TK + 64 * j + pos) * 4 + h];
    const float inter = bl + p.MM[uu * 4 + 2];
    const float mt = fmaxf(inter, bl + sPM[d * 64 + l]);
    const float aint = expf(inter - mt);
    bf16x8 qf[4];
#pragma unroll
    for (int ks = 0; ks < 4; ++ks) qf[ks] = *(const bf16x8*)(p.MQ + ((size_t)b * TK + 64 * c + l) * 256 + h * 64 + ks * 16 + 8 * hh);
    f32x16 num[2]; num[0] = (f32x16)(0.f); num[1] = (f32x16)(0.f);
    float den = 0.f;
#pragma unroll
    for (int st = 0; st < 2; ++st) {
      if (d == 0 ? st <= lt : st >= lt) {
        f32x16 S = (f32x16)(0.f);
#pragma unroll
        for (int ks = 0; ks < 4; ++ks) S = MFMA32(lds_frag(lds + MO_K + (st * 32 + l31) * 144 + (ks * 16 + 8 * hh) * 2), qf[ks], S);
#pragma unroll
        for (int i = 0; i < 16; ++i) {
          const int s = st * 32 + (i & 3) + 8 * (i >> 2) + 4 * hh;
          const bool ok = d == 0 ? s <= l : s >= l;
          const float e = ok ? fast_exp2((bl + sA[d * 64 + s] - mt) * LOG2E) * S[i] : 0.f;
          S[i] = e; den += e;
        }
#pragma unroll
        for (int kst = 0; kst < 2; ++kst) {
          const bf16x8 pf = pack8(S, kst);
#pragma unroll
          for (int vt = 0; vt < 2; ++vt) {
            const char* vp = lds + MO_V + (vt * 32 + l31) * VROW + (st * 32 + kst * 16 + 4 * hh) * 2;
            const s16x4 lo = *(const s16x4*)vp, hi = *(const s16x4*)(vp + 16);
            num[vt] = MFMA32(__builtin_shufflevector(lo, hi, 0, 1, 2, 3, 4, 5, 6, 7), pf, num[vt]);
          }
        }
      }
    }
    f32x16 accI[2]; accI[0] = (f32x16)(0.f); accI[1] = (f32x16)(0.f);
#pragma unroll
    for (int vt = 0; vt < 2; ++vt)
#pragma unroll
      for (int ks = 0; ks < 4; ++ks) accI[vt] = MFMA32(cvt8(p.MC + uu * 4096 + (size_t)(vt * 32 + l31) * 64 + ks * 16 + 8 * hh), qf[ks], accI[vt]);
    float qn = 0.f;
#pragma unroll
    for (int ks = 0; ks < 4; ++ks)
#pragma unroll
      for (int q = 0; q < 8; ++q) qn += bf2f((bf16_t)qf[ks][q]) * sN0[d * 64 + ks * 16 + 8 * hh + q];
    den = xor_sum<32>(den + aint * qn);
    const float inv = 1.0f / fmaxf(fabsf(den), expf(-mt));
#pragma unroll
    for (int vt = 0; vt < 2; ++vt)
#pragma unroll
      for (int i = 0; i < 16; ++i) num[vt][i] = (num[vt][i] + aint * accI[vt][i]) * inv;
    if (d == 1) {
#pragma unroll
      for (int vt = 0; vt < 2; ++vt)
#pragma unroll
        for (int i = 0; i < 16; ++i) sX[(lt * 32 + vt * 16 + i) * 64 + lane] = num[vt][i];
    }
    __syncthreads();
    if (d == 0) {
      float ss = 0.f;
#pragma unroll
      for (int vt = 0; vt < 2; ++vt)
#pragma unroll
        for (int i = 0; i < 16; ++i) { num[vt][i] += sX[(lt * 32 + vt * 16 + i) * 64 + lane]; ss += num[vt][i] * num[vt][i]; }
      ss = xor_sum<32>(ss);
      const float rstd = 1.0f / sqrtf(ss * (1.0f / 64) + 1e-6f);
      const int r = row_of(b, 64 * c + l);
#pragma unroll
      for (int vt = 0; vt < 2; ++vt)
#pragma unroll
        for (int g = 0; g < 4; ++g) {
          const int v0 = vt * 32 + 8 * g + 4 * hh;
          const u32x2 ou = *(const u32x2*)(p.Z + (size_t)r * NZP + ZC_MLO + h * 64 + v0);
          const f32x4 gv = *(const f32x4*)(p.g_mlstm_out + layer * 256 + h * 64 + v0);
          const float o0 = u2f(ou.x << 16), o1 = u2f(ou.x & 0xffff0000u), o2 = u2f(ou.y << 16), o3 = u2f(ou.y & 0xffff0000u);
          f32x4 y = {sigmoidf_(o0) * num[vt][4 * g] * rstd * gv[0], sigmoidf_(o1) * num[vt][4 * g + 1] * rstd * gv[1],
                     sigmoidf_(o2) * num[vt][4 * g + 2] * rstd * gv[2], sigmoidf_(o3) * num[vt][4 * g + 3] * rstd * gv[3]};
          st_bf16x4(p.Y + (size_t)r * D + 256 + h * 64 + v0, y);
        }
    }
    __syncthreads();
  }
}
DI void ph_gla_local(const Params& p, char* lds, int bid, int nblk) {
  bf16_t* sKd = (bf16_t*)lds;
  const int t = TIDX, lane = t & 63, wid = t >> 6, l31 = lane & 31, hh = lane >> 5;
  const int d = wid & 1, vt = wid >> 1;
#pragma unroll 1
  for (int u = bid; u < SCAN_UNITS; u += nblk) {
    int b, c, h; scan_unit(u, b, c, h);
    {
      const int dd = t >> 7, l = (t >> 1) & 63, k0 = (t & 1) * 16, j = step_of(dd, c), pos = dd ? 63 - l : l;
      const float* gcr = p.GC + (((size_t)b * 2 + dd) * TK + 64 * j + pos) * 128 + h * 32 + k0;
      const float* ger = p.GC + (((size_t)b * 2 + dd) * TK + 64 * j + 63) * 128 + h * 32 + k0;
      const bf16_t* kr = p.Z + (size_t)row_of(b, 64 * c + l) * NZP + ZC_GK + h * 32 + k0;
#pragma unroll
      for (int q = 0; q < 16; ++q) sKd[(dd * 64 + l) * 33 + k0 + q] = f2bf(bf2f(kr[q]) * fast_exp2((ger[q] - gcr[q]) * LOG2E));
    }
    __syncthreads();
    const int j = step_of(d, c);
    const size_t uu = (((size_t)b * 2 + d) * NCK + j) * 4 + h;
    f32x16 acc = (f32x16)(0.f);
    const bf16_t* vsrc = p.GVt + (((size_t)b * 4 + h) * 64 + vt * 32 + l31) * TK + 64 * c;
#pragma unroll
    for (int ks = 0; ks < 4; ++ks) {
      const bf16x8 af = *(const bf16x8*)(vsrc + ks * 16 + 8 * hh);
      bf16x8 bfr;
#pragma unroll
      for (int q = 0; q < 8; ++q) bfr[q] = (short)sKd[(d * 64 + ks * 16 + 8 * hh + q) * 33 + l31];
      acc = MFMA32(af, bfr, acc);
    }
#pragma unroll
    for (int i = 0; i < 16; ++i) p.GS[uu * 2048 + (size_t)(vt * 32 + (i & 3) + 8 * (i >> 2) + 4 * hh) * 32 + l31] = acc[i];
    __syncthreads();
  }
}
constexpr int GO_Q = 0, GO_K = 2 * 64 * 80, GO_V = 2 * GO_K, GO_X = GO_V + 64 * VROW, GO_LDS = GO_X + 16384;
DI void ph_gla_out(const Params& p, int layer, int need_ctx, char* lds, int bid, int nblk) {
  float* sX = (float*)(lds + GO_X);
  const int t = TIDX, lane = t & 63, wid = t >> 6, l31 = lane & 31, hh = lane >> 5;
  const int lt = wid & 1, d = wid >> 1;
#pragma unroll 1
  for (int u = bid; u < (need_ctx ? SCAN_UNITS : SCAN_LAT_UNITS); u += nblk) {
    int b, c, h; scan_unit(u, b, c, h);
    {
      const int dd = t >> 7, l = (t >> 1) & 63, k0 = (t & 1) * 16, j = step_of(dd, c), pos = dd ? 63 - l : l;
      const float* gcr = p.GC + (((size_t)b * 2 + dd) * TK + 64 * j + pos) * 128 + h * 32 + k0;
      const bf16_t* zr = p.Z + (size_t)row_of(b, 64 * c + l) * NZP;
      bf16_t* qd = (bf16_t*)(lds + GO_Q + (dd * 64 + l) * 80) + k0; bf16_t* kd = (bf16_t*)(lds + GO_K + (dd * 64 + l) * 80) + k0;
#pragma unroll
      for (int q = 0; q < 16; ++q) {
        const float g = gcr[q];
        qd[q] = f2bf(bf2f(zr[ZC_GQ + h * 32 + k0 + q]) * 0.17677669529663687f * fast_exp2(g * LOG2E));
        kd[q] = f2bf(bf2f(zr[ZC_GK + h * 32 + k0 + q]) * fast_exp2(-g * LOG2E));
      }
      const int row = t >> 2, seg = (t & 3) * 16;
      const bf16_t* vs = p.GVt + (((size_t)b * 4 + h) * 64 + row) * TK + 64 * c + seg;
      const u32x4 v0 = ldg16(vs), v1 = ldg16(vs + 8);
      u32x2* dv = (u32x2*)(lds + GO_V + row * VROW + seg * 2);
      u32x2 q2; q2.x = v0.x; q2.y = v0.y; dv[0] = q2; q2.x = v0.z; q2.y = v0.w; dv[1] = q2; q2.x = v1.x; q2.y = v1.y; dv[2] = q2; q2.x = v1.z; q2.y = v1.w; dv[3] = q2;
    }
    __syncthreads();
    const int j = step_of(d, c);
    const size_t uu = (((size_t)b * 2 + d) * NCK + j) * 4 + h;
    const int l = lt * 32 + l31;
    bf16x8 qf[2];
#pragma unroll
    for (int ks = 0; ks < 2; ++ks) qf[ks] = lds_frag(lds + GO_Q + (d * 64 + l) * 80 + (ks * 16 + 8 * hh) * 2);
    f32x16 O[2]; O[0] = (f32x16)(0.f); O[1] = (f32x16)(0.f);
#pragma unroll
    for (int st = 0; st < 2; ++st) {
      if (d == 0 ? st <= lt : st >= lt) {
        f32x16 S = (f32x16)(0.f);
#pragma unroll
        for (int ks = 0; ks < 2; ++ks) S = MFMA32(lds_frag(lds + GO_K + (d * 64 + st * 32 + l31) * 80 + (ks * 16 + 8 * hh) * 2), qf[ks], S);
#pragma unroll
        for (int i = 0; i < 16; ++i) {
          const int s = st * 32 + (i & 3) + 8 * (i >> 2) + 4 * hh;
          const bool ok = d == 0 ? s <= l : s >= l;
          S[i] = ok ? S[i] : 0.f;
        }
#pragma unroll
        for (int kst = 0; kst < 2; ++kst) {
          const bf16x8 pf = pack8(S, kst);
#pragma unroll
          for (int vt = 0; vt < 2; ++vt) {
            const char* vp = lds + GO_V + (vt * 32 + l31) * VROW + (st * 32 + kst * 16 + 4 * hh) * 2;
            const s16x4 lo = *(const s16x4*)vp, hi = *(const s16x4*)(vp + 16);
            O[vt] = MFMA32(__builtin_shufflevector(lo, hi, 0, 1, 2, 3, 4, 5, 6, 7), pf, O[vt]);
          }
        }
      }
    }
#pragma unroll
    for (int vt = 0; vt < 2; ++vt)
#pragma unroll
      for (int ks = 0; ks < 2; ++ks) O[vt] = MFMA32(cvt8(p.GS + uu * 2048 + (size_t)(vt * 32 + l31) * 32 + ks * 16 + 8 * hh), qf[ks], O[vt]);
    if (d == 1) {
#pragma unroll
      for (int vt = 0; vt < 2; ++vt)
#pragma unroll
        for (int i = 0; i < 16; ++i) sX[(lt * 32 + vt * 16 + i) * 64 + lane] = O[vt][i];
    }
    __syncthreads();
    if (d == 0) {
      float ss = 0.f;
#pragma unroll
      for (int vt = 0; vt < 2; ++vt)
#pragma unroll
        for (int i = 0; i < 16; ++i) { O[vt][i] += sX[(lt * 32 + vt * 16 + i) * 64 + lane]; ss += O[vt][i] * O[vt][i]; }
      ss = xor_sum<32>(ss);
      const float rstd = 1.0f / sqrtf(ss * (1.0f / 64) + 1e-6f);
      const int r = row_of(b, 64 * c + l);
#pragma unroll
      for (int vt = 0; vt < 2; ++vt)
#pragma unroll
        for (int g = 0; g < 4; ++g) {
          const int v0 = vt * 32 + 8 * g + 4 * hh;
          const u32x2 ru = *(const u32x2*)(p.Z + (size_t)r * NZP + ZC_GR + h * 64 + v0);
          const f32x4 gv = *(const f32x4*)(p.g_gla_out + layer * 256 + h * 64 + v0);
          const float r0 = u2f(ru.x << 16), r1 = u2f(ru.x & 0xffff0000u), r2 = u2f(ru.y << 16), r3 = u2f(ru.y & 0xffff0000u);
          f32x4 y = {siluf_(r0) * O[vt][4 * g] * rstd * gv[0], siluf_(r1) * O[vt][4 * g + 1] * rstd * gv[1],
                     siluf_(r2) * O[vt][4 * g + 2] * rstd * gv[2], siluf_(r3) * O[vt][4 * g + 3] * rstd * gv[3]};
          st_bf16x4(p.Y + (size_t)r * D + 512 + h * 64 + v0, y);
        }
    }
    __syncthreads();
  }
}

DI float fast_logsigmoid(float x) {
  const float e = fast_exp2(-fabsf(x) * LOG2E);
#ifdef CPU_EMU
  return fminf(x, 0.f) - log1pf(e);
#else
  return fminf(x, 0.f) - 0.6931471805599453f * __builtin_amdgcn_logf(1.0f + e);
#endif
}
DI float wave_incl_scan(float v, int lane) {
#pragma unroll
  for (int dd = 1; dd < 64; dd <<= 1) { const float o = u2f((unsigned)lane_up((int)f2u(v), dd, lane)); if (lane >= dd) v += o; }
  return v;
}
constexpr int GCUM_LDS = 4 * 64 * 33 * 4;
DI void ph_gates_cum(const Params& p, int layer, char* lds, int bid, int nblk) {
  const int t = TIDX, lane = t & 63, wid = t >> 6;
  float* stg = (float*)lds + wid * 64 * 33;
  const float* wal = p.w_alpha2 + (size_t)layer * 2 * 16 * 128;
#pragma unroll 1
  for (int u = bid * 4 + wid; u < NB * 2 * NCK; u += nblk * 4) {
    const int j = u % NCK, d = (u / NCK) & 1, b = u / (2 * NCK);
    const int pp = 64 * j + lane, s = seq_of(d, pp);
    const bf16_t* z = p.Z + (size_t)row_of(b, s) * NZP;
    const size_t ob = ((size_t)b * 2 + d) * TK + pp;
    {
      const u32x2 iu = *(const u32x2*)(z + ZC_MLIG + d * 4), fu = *(const u32x2*)(z + ZC_MLFG + d * 4);
      const float ig[4] = {u2f(iu.x << 16), u2f(iu.x & 0xffff0000u), u2f(iu.y << 16), u2f(iu.y & 0xffff0000u)};
      const float fg[4] = {u2f(fu.x << 16), u2f(fu.x & 0xffff0000u), u2f(fu.y << 16), u2f(fu.y & 0xffff0000u)};
      f32x4 oc, oi;
#pragma unroll
      for (int h = 0; h < 4; ++h) {
        oi[h] = ig[h] + p.b_igate[layer * 8 + d * 4 + h];
        oc[h] = wave_incl_scan(fast_logsigmoid(fg[h] + p.b_fgate[layer * 8 + d * 4 + h]), lane);
      }
      *(f32x4*)(p.BC + ob * 4) = oc; *(f32x4*)(p.IGS + ob * 4) = oi;
    }
    float a[16];
    { float f0[8], f1[8]; unpack8(ldg16(z + ZC_GA + d * 16), f0); unpack8(ldg16(z + ZC_GA + d * 16 + 8), f1);
#pragma unroll
      for (int q = 0; q < 8; ++q) { a[q] = f0[q]; a[8 + q] = f1[q]; } }
    const float* W = wal + (size_t)d * 16 * 128;
#pragma unroll 1
    for (int cg = 0; cg < 4; ++cg) {
#pragma unroll 4
      for (int c = 0; c < 32; ++c) {
        const int ch = cg * 32 + c;
        float zg = p.b_alpha[layer * 256 + d * 128 + ch];
#pragma unroll
        for (int q = 0; q < 16; ++q) zg += a[q] * W[q * 128 + ch];
        stg[lane * 33 + c] = wave_incl_scan(fast_logsigmoid(zg) * (1.0f / 16.0f), lane);
      }
      WAVE_SYNC();
#pragma unroll
      for (int k = 0; k < 32; ++k) { const int pos = k * 2 + (lane >> 5), c = lane & 31; p.GC[(((size_t)b * 2 + d) * TK + 64 * j + pos) * 128 + cg * 32 + c] = stg[pos * 33 + c]; }
      WAVE_SYNC();
    }
  }
}
#define XB_TMO      128
#define XB_XCNT(j)  (256  + 64 * (j))
#define XB_XSUB(j)  (1280 + 64 * (j))
#define XB_XGEN(j)  (2304 + 64 * (j))
#define XB_TOP      3328
#define XB_TOPGEN   3392
#define XCD_BAR_WORDS 3456
#define XB_SPIN_CAP (1u << 28)
#define LAS __attribute__((address_space(3)))

__device__ __forceinline__ unsigned xb_ld(unsigned* p)              { return __hip_atomic_load(p, __ATOMIC_RELAXED, __HIP_MEMORY_SCOPE_AGENT); }
__device__ __forceinline__ unsigned xb_add(unsigned* p, unsigned v) { return __hip_atomic_fetch_add(p, v, __ATOMIC_RELAXED, __HIP_MEMORY_SCOPE_AGENT); }
__device__ __forceinline__ unsigned xb_xcc_id() { return (unsigned)__builtin_amdgcn_s_getreg((3 << 11) | 20) & 0xFu; }
#define XB_SPIN(cond, bar) do { unsigned _sp = 0; while (cond) { __builtin_amdgcn_s_sleep(1); \
    if ((++_sp & 255u) == 0u) { if (xb_ld(&(bar)[XB_TMO])) break; if (_sp > XB_SPIN_CAP) { atomicAdd(&(bar)[XB_TMO], 1u); break; } } } } while (0)

struct XcdBarrier {
    unsigned* bar; unsigned x;
    volatile LAS unsigned* st;
};

__device__ __forceinline__ XcdBarrier xcd_barrier_post(unsigned* bar, volatile LAS unsigned* st) {
    XcdBarrier b; b.bar = bar; b.x = xb_xcc_id(); b.st = st;
    if (threadIdx.x == 0) (void)xb_add(&bar[XB_XCNT(b.x)], 1u);
    return b;
}
__device__ __forceinline__ void xcd_barrier_complete(unsigned* bar, unsigned x, unsigned& nloc, unsigned& nx) {
    const unsigned G = gridDim.x * gridDim.y * gridDim.z;
    unsigned sum, cnt, mine, sp = 0u;
    for (;;) {
        sum = 0u; cnt = 0u; mine = 0u;
#pragma unroll
        for (unsigned j = 0; j < 16; ++j) { const unsigned c = xb_ld(&bar[XB_XCNT(j)]); sum += c; cnt += (c > 0u) ? 1u : 0u; mine = (j == x) ? c : mine; }
        if (sum == G) break;
        __builtin_amdgcn_s_sleep(1);
        if ((++sp & 255u) == 0u) { if (xb_ld(&bar[XB_TMO])) break; if (sp > XB_SPIN_CAP) { atomicAdd(&bar[XB_TMO], 1u); break; } }
    }
    nloc = mine > 0u ? mine : 1u; nx = cnt > 0u ? cnt : 1u;
}

__device__ __forceinline__ void xcd_barrier(const XcdBarrier& b) {
    asm volatile("s_waitcnt vmcnt(0)" ::: "memory");
    __syncthreads();
    if (threadIdx.x == 0) {
        unsigned* bar = b.bar;
        __builtin_amdgcn_s_waitcnt(0);
        unsigned nloc = b.st[0], nx = b.st[1];
        if (nloc == 0u) { xcd_barrier_complete(bar, b.x, nloc, nx); b.st[0] = nloc; b.st[1] = nx; }
        const unsigned old = xb_add(&bar[XB_XSUB(b.x)], 1u);
        const unsigned gen = old / nloc;
        if (old + 1u == (gen + 1u) * nloc) {
            __builtin_amdgcn_fence(__ATOMIC_RELEASE, "agent");
            asm volatile("s_waitcnt vmcnt(0)" ::: "memory");
            const unsigned og = xb_add(&bar[XB_TOP], 1u);
            const unsigned tg = og / nx;
            if (og + 1u == (tg + 1u) * nx) xb_add(&bar[XB_TOPGEN], 1u);
            else XB_SPIN(xb_ld(&bar[XB_TOPGEN]) == tg, bar);
            __builtin_amdgcn_fence(__ATOMIC_ACQUIRE, "agent");
            xb_add(&bar[XB_XGEN(b.x)], 1u);
            asm volatile("s_waitcnt vmcnt(0)" ::: "memory");
        } else {
            XB_SPIN(xb_ld(&bar[XB_XGEN(b.x)]) == gen, bar);
            __builtin_amdgcn_fence(__ATOMIC_ACQUIRE, "agent");
            asm volatile("s_waitcnt vmcnt(0)" ::: "memory");
        }
    }
    __syncthreads();
}

#define GS_LOOP(N, CALL) for (long gi = (long)bid * NTHR + TIDX; gi < (long)(N); gi += (long)nblk * NTHR) { CALL; }
#ifndef PROBE
#define PROBE 0
#endif
#ifndef PROBE_MASK
#define PROBE_MASK 0
#endif
#ifndef FAST_SCAN
#define FAST_SCAN 1
#endif
constexpr int N_PHASES = 16;
constexpr int MEGA_LDS = GEMM_LDS > TOPK_LDS ? GEMM_LDS : TOPK_LDS;

constexpr bool WT_ED_IN_Y = (size_t)NE * FF * D * 2 <= (size_t)R * D * 2;
DI void conv_expert(const Params& p, int which, int layer, char* lds, int bid, int nblk, int busy) {
  __syncthreads();
  if (bid < busy) return;
  if (which == 0) ph_wt(p.w_e_gate + (size_t)layer * NE * D * FF, p.Wt_eg, D, FF, FF, NE, (long)D * FF, (long)FF * D, nullptr, lds, bid - busy, nblk - busy);
  else if (which == 1) ph_wt(p.w_e_up + (size_t)layer * NE * D * FF, p.Wt_eu, D, FF, FF, NE, (long)D * FF, (long)FF * D, nullptr, lds, bid - busy, nblk - busy);
  else ph_wt(p.w_e_down + (size_t)layer * NE * FF * D, p.Wt_ed, FF, D, D, NE, (long)FF * D, (long)D * FF, nullptr, lds, bid - busy, nblk - busy);
}
template <int PH>
DI void run_phase(const Params& p, int l, char* lds, int bid, int nblk) {
  const int need_ctx = (l == 0);
  const int rows = need_ctx ? R : RL;
  const float* xl_in = l == 0 ? p.x : p.out;
  const float* xc_in = l == 0 ? p.ctx : p.xc;
  bf16_t* QRAW = p.YO; bf16_t* KVRAW = p.YO + (size_t)R * 384;
  if constexpr (PH == 0) {
    ph_mods(p, lds, bid, nblk);
#pragma unroll 1
    for (int ll = 0; ll < 2; ++ll) {
      ph_wt(p.w_in + (size_t)ll * D * NZ, p.Wt_in + ll * WSZ_IN, D, NZ, NZP, 1, 0L, 0L, nullptr, lds, bid, nblk);
      ph_wt(p.w_gate + (size_t)ll * D * 4096, p.Wt_gate + ll * WSZ_GATE, D, 4096, 4096, 1, 0L, 0L, nullptr, lds, bid, nblk);
      ph_wt(p.w_branch + (size_t)ll * 4 * 256 * D, p.Wt_branch + ll * WSZ_BR, 256, D, D, 4, (long)256 * D, (long)D * 256, nullptr, lds, bid, nblk);
      ph_wt(p.w_out + (size_t)ll * D * D, p.Wt_out + ll * WSZ_OUT, D, D, D, 1, 0L, 0L, nullptr, lds, bid, nblk);
      ph_wt(p.w_uq + (size_t)ll * 256 * 384, p.Wt_uq + ll * WSZ_UQ, 256, 384, 384, 1, 0L, 0L, p.g_q_lat + ll * 256, lds, bid, nblk);
      ph_wt(p.w_ukv + (size_t)ll * 128 * 512, p.Wt_ukv + ll * WSZ_UKV, 128, 512, 512, 1, 0L, 0L, p.g_kv_lat + ll * 128, lds, bid, nblk);
    }
  } else if constexpr (PH == 1) {
    ph_modulate(p, l, xl_in, xc_in, bid, nblk);
  } else if constexpr (PH == 2) {
    ph_gemm_plain(p.H, D, p.Wt_in + l * WSZ_IN, D, R, NZP, D, p.Z, NZP, lds, bid, nblk);
#if PROBE == 63
    ph_gemm_probe<3>(p.H, D, p.Wt_in + l * WSZ_IN, D, R, NZP, D, p.mods + 40000, lds, bid, nblk);
#elif PROBE == 66
    ph_gemm_probe<6>(p.H, D, p.Wt_in + l * WSZ_IN, D, R, NZP, D, p.mods + 40000, lds, bid, nblk);
#elif PROBE == 67
    ph_gemm_plain<1>(p.H, D, p.Wt_in + l * WSZ_IN, D, R, NZP, D, p.Z, NZP, lds, bid, nblk);
#elif PROBE == 68
    ph_gemm_plain<2>(p.H, D, p.Wt_in + l * WSZ_IN, D, R, NZP, D, p.Z, NZP, lds, bid, nblk);
#elif PROBE == 5
    ph_gemm_plain(p.H, D, p.Wt_in + l * WSZ_IN, D, R, NZP, D, p.Z, NZP, lds, bid, nblk);
#endif
  } else if constexpr (PH == 3) {
    ph_mla_up(p, l, QRAW, KVRAW, lds, bid, nblk);
  } else if constexpr (PH == 4) {
    ph_prep(p, l, QRAW, KVRAW, lds, bid, nblk);
#if PROBE == 41
    ph_prep(p, l, QRAW, KVRAW, lds, bid, nblk);
#elif PROBE == 43
    ph_prep<1>(p, l, QRAW, KVRAW, lds, bid, nblk);
#elif PROBE == 44
    ph_prep<2>(p, l, QRAW, KVRAW, lds, bid, nblk);
#endif
    __syncthreads();
    ph_gates_cum(p, l, lds, bid, nblk);
#if PROBE == 42
    ph_gates_cum(p, l, lds, bid, nblk);
#endif
  } else if constexpr (PH == 5) {
#if FAST_SCAN
    ph_ml_local(p, lds, bid, nblk);
    ph_gla_local(p, lds, bid, nblk);
#else
    GS_LOOP((long)NUNIT * 4160, nvb_ml_local(gi, p));
    GS_LOOP((long)NUNIT * 2048, nvb_gla_local(gi, p));
#endif
  } else if constexpr (PH == 6) {
#if FAST_SCAN
    ph_ml_scan(p, bid, nblk);
    ph_gla_scan(p, (bid + nblk - 260 % nblk) % nblk, nblk);
#else
    GS_LOOP((long)NB * 2 * 4 * 4160, nvb_ml_scan(gi, p));
    GS_LOOP((long)NB * 2 * 4 * 2048, nvb_gla_scan(gi, p));
#endif
    ph_attn(p, l, need_ctx, lds, bid, nblk);
#if PROBE >= 10 && PROBE < 20
    if (l == 0) ph_attn_mla_probe<PROBE - 10>(p, lds, bid, nblk);
#elif PROBE == 1
    ph_attn_diff(p, l, need_ctx, lds, bid, nblk);
#elif PROBE == 2
    ph_attn_mla(p, need_ctx, lds, bid, nblk);
#endif
  } else if constexpr (PH == 7) {
#if FAST_SCAN
    ph_ml_out(p, l, need_ctx, lds, bid, nblk);
    ph_gla_out(p, l, need_ctx, lds, bid, nblk);
#else
    GS_LOOP((long)NUNIT * 4096, nvb_ml_out(gi, p, need_ctx));
    GS_LOOP((long)NUNIT * 4096, nvb_gla_out(gi, p, need_ctx));
#endif
  } else if constexpr (PH == 8) {
#if !FAST_SCAN
    GS_LOOP((long)R * 4, nvb_ml_finish(gi, p, l, need_ctx));
    GS_LOOP((long)R * 4, nvb_gla_finish(gi, p, l, need_ctx));
#endif
  } else if constexpr (PH == 9) {
    ph_merge(p, l, rows, lds, bid, nblk);
#if PROBE == 3
    ph_merge(p, l, rows, lds, bid, nblk);
#endif
    if (l == 0) conv_expert(p, 1, 0, lds, bid, nblk, ((rows / 128) * (D / 64)) % nblk);
  } else if constexpr (PH == 10) {
    ph_gemm_plain(p.MG, D, p.Wt_out + l * WSZ_OUT, D, rows, D, D, p.YO, D, lds, bid, nblk);
    if (WT_ED_IN_Y && l == 0) conv_expert(p, 2, 0, lds, bid, nblk, ((rows / 128) * (D / 128)) % nblk);
  } else if constexpr (PH == 11) {
    ph_resid_mix(p, l, xl_in, xc_in, rows, lds, bid, nblk);
  } else if constexpr (PH == 12) {
    ph_topk(p, need_ctx, lds, bid, nblk);
    const int tkb = NB * NE * 2 < nblk ? NB * NE * 2 : 0;
    conv_expert(p, 0, l, lds, bid, nblk, tkb);
    if (l == 1) conv_expert(p, 1, 1, lds, bid, nblk, tkb);
    if (l == 1 || !WT_ED_IN_Y) conv_expert(p, 2, l, lds, bid, nblk, tkb);
  } else if constexpr (PH == 13) {
    ph_moe1(p, need_ctx, lds, bid, nblk);
#if PROBE == 4
    ph_moe1(p, need_ctx, lds, bid, nblk);
#endif
  } else if constexpr (PH == 14) {
    ph_moe2(p, need_ctx, lds, bid, nblk);
#if PROBE == 4
    ph_moe2(p, need_ctx, lds, bid, nblk);
#endif
  } else if constexpr (PH == 15) {
    ph_resid_ffn(p, l, rows, bid, nblk);
  }
}

template <int PH> __global__ void __launch_bounds__(256, 2) k_phase(Params p, int l) {
  DYN_LDS(lds);
  run_phase<PH>(p, l, lds, blockIdx.x, gridDim.x);
}

#if !defined(CPU_EMU) && !MK_MULTI
typedef const Params __attribute__((address_space(4)))* KParams;
DI KParams kp_fresh() { KParams k = (KParams)__builtin_amdgcn_kernarg_segment_ptr(); asm volatile("" : "+s"(k)); return k; }
#define PHASE(PH, L) do { asm volatile("; PHASE_MARK " #PH); KParams k_ = kp_fresh(); run_phase<PH>(*(const Params*)k_, (L), lds, bid, nblk); if (PROBE == 20 + PH || ((PROBE_MASK >> PH) & 1) || (PROBE == 100 + PH && (L) == 0) || (PROBE == 99 && (PH == 4 || PH == 5))) { __syncthreads(); run_phase<PH>(*(const Params*)k_, (L), lds, bid, nblk); } XcdBarrier b_ = bar; asm volatile("" : "+s"(b_.bar), "+s"(b_.x)); xcd_barrier(b_); if (PROBE == 50) xcd_barrier(b_); } while (0)
__global__ void __launch_bounds__(256, 2) k_mega(Params pv) {
  DYN_LDS(lds_all);
  if (threadIdx.x == 0) *(uint4*)lds_all = make_uint4(0u, 0u, 0u, 0u);
  __syncthreads();
  XcdBarrier bar = xcd_barrier_post(pv.bar, (volatile LAS unsigned*)lds_all);
  char* lds = lds_all + 256;
  const int bid = blockIdx.x, nblk = gridDim.x;
  PHASE(0, 0);
#pragma unroll 1
  for (int l = 0; l < 2; ++l) {
    if (l == 0) PHASE(1, l);
    PHASE(2, l); PHASE(3, l); PHASE(4, l); PHASE(5, l); PHASE(6, l); PHASE(7, l);
#if !FAST_SCAN
    PHASE(8, l);
#endif

    PHASE(9, l); PHASE(10, l); PHASE(11, l); PHASE(12, l); PHASE(13, l); PHASE(14, l); PHASE(15, l);
  }
}
#endif
#ifdef CPU_EMU
void emu_check(const Params& p, int layer, int stage);
#define EMU_CHECK(stg) emu_check(p, l, stg)
static int g_nlayers = getenv("NLAYERS") ? atoi(getenv("NLAYERS")) : 2;
#else
#define EMU_CHECK(stg)
#endif
static void fill_params(Params& p, void* const* d_in, void* d_out, void* d_ws) {
  const float** f = (const float**)&p;
  for (int i = 0; i < 33; ++i) f[i] = (const float*)d_in[i];
  p.out = (float*)d_out;
  map_workspace(p, (char*)d_ws);
}
#define LAUNCH_PHASE(PH, L) LAUNCH((k_phase<PH>), grid, 256, MEGA_LDS, stream, p, L)

extern "C" void kernel_launch(void* const* d_in, const int* in_sizes, int n_in, void* d_out, int out_size, void* d_ws,
                              size_t ws_size, hipStream_t stream) {
  Params p{};
  fill_params(p, d_in, d_out, d_ws);
  if (p.ws_need > ws_size) return;
#ifdef CPU_EMU
  const int grid = 16;
  LAUNCH_PHASE(0, 0);
  for (int l = 0; l < g_nlayers; ++l) {
    if (l == 0) LAUNCH_PHASE(1, l);
    LAUNCH_PHASE(2, l); LAUNCH_PHASE(3, l); LAUNCH_PHASE(4, l); LAUNCH_PHASE(5, l); LAUNCH_PHASE(6, l); LAUNCH_PHASE(7, l); LAUNCH_PHASE(8, l);
    EMU_CHECK(1);
    LAUNCH_PHASE(9, l); LAUNCH_PHASE(10, l); LAUNCH_PHASE(11, l);
    EMU_CHECK(2);
    LAUNCH_PHASE(12, l); LAUNCH_PHASE(13, l); LAUNCH_PHASE(14, l); LAUNCH_PHASE(15, l);
    EMU_CHECK(3);
  }
#else
  static int grid = 0;
  if (grid == 0) {
    int dev = 0, cus = 0, per_cu = 0;
    (void)hipGetDevice(&dev);
    (void)hipDeviceGetAttribute(&cus, hipDeviceAttributeMultiprocessorCount, dev);
#if MK_MULTI
    (void)hipFuncSetAttribute((const void*)k_phase<0>, hipFuncAttributeMaxDynamicSharedMemorySize, MEGA_LDS);
    (void)hipFuncSetAttribute((const void*)k_phase<1>, hipFuncAttributeMaxDynamicSharedMemorySize, MEGA_LDS);
    (void)hipFuncSetAttribute((const void*)k_phase<2>, hipFuncAttributeMaxDynamicSharedMemorySize, MEGA_LDS);
    (void)hipFuncSetAttribute((const void*)k_phase<3>, hipFuncAttributeMaxDynamicSharedMemorySize, MEGA_LDS);
    (void)hipFuncSetAttribute((const void*)k_phase<4>, hipFuncAttributeMaxDynamicSharedMemorySize, MEGA_LDS);
    (void)hipFuncSetAttribute((const void*)k_phase<5>, hipFuncAttributeMaxDynamicSharedMemorySize, MEGA_LDS);
    (void)hipFuncSetAttribute((const void*)k_phase<6>, hipFuncAttributeMaxDynamicSharedMemorySize, MEGA_LDS);
    (void)hipFuncSetAttribute((const void*)k_phase<7>, hipFuncAttributeMaxDynamicSharedMemorySize, MEGA_LDS);
    (void)hipFuncSetAttribute((const void*)k_phase<8>, hipFuncAttributeMaxDynamicSharedMemorySize, MEGA_LDS);
    (void)hipFuncSetAttribute((const void*)k_phase<9>, hipFuncAttributeMaxDynamicSharedMemorySize, MEGA_LDS);
    (void)hipFuncSetAttribute((const void*)k_phase<10>, hipFuncAttributeMaxDynamicSharedMemorySize, MEGA_LDS);
    (void)hipFuncSetAttribute((const void*)k_phase<11>, hipFuncAttributeMaxDynamicSharedMemorySize, MEGA_LDS);
    (void)hipFuncSetAttribute((const void*)k_phase<12>, hipFuncAttributeMaxDynamicSharedMemorySize, MEGA_LDS);
    (void)hipFuncSetAttribute((const void*)k_phase<13>, hipFuncAttributeMaxDynamicSharedMemorySize, MEGA_LDS);
    (void)hipFuncSetAttribute((const void*)k_phase<14>, hipFuncAttributeMaxDynamicSharedMemorySize, MEGA_LDS);
    (void)hipFuncSetAttribute((const void*)k_phase<15>, hipFuncAttributeMaxDynamicSharedMemorySize, MEGA_LDS);
    grid = (cus > 0 ? cus : 256) * 2;
#else
    if (hipFuncSetAttribute((const void*)k_mega, hipFuncAttributeMaxDynamicSharedMemorySize, MEGA_LDS + 256) != hipSuccess) { grid = -1; return; }
    if (hipOccupancyMaxActiveBlocksPerMultiprocessor(&per_cu, (const void*)k_mega, 256, MEGA_LDS + 256) != hipSuccess) per_cu = 0;
    (void)hipGetLastError();
    if (per_cu < 1) { grid = -1; return; }
    grid = (cus > 0 ? cus : 256) * (per_cu < 2 ? per_cu : 2);
#endif
  }
  if (grid < 0) return;
#if MK_MULTI
  LAUNCH_PHASE(0, 0);
  for (int l = 0; l < 2; ++l) {
    if (l == 0) LAUNCH_PHASE(1, l);
    LAUNCH_PHASE(2, l); LAUNCH_PHASE(3, l); LAUNCH_PHASE(4, l); LAUNCH_PHASE(5, l); LAUNCH_PHASE(6, l); LAUNCH_PHASE(7, l); LAUNCH_PHASE(8, l);
    LAUNCH_PHASE(9, l); LAUNCH_PHASE(10, l); LAUNCH_PHASE(11, l); LAUNCH_PHASE(12, l); LAUNCH_PHASE(13, l); LAUNCH_PHASE(14, l); LAUNCH_PHASE(15, l);
  }
#else
  (void)hipMemsetAsync(p.bar, 0, XCD_BAR_WORDS * sizeof(unsigned), stream);
  k_mega<<<dim3(grid), dim3(256), MEGA_LDS + 256, stream>>>(p);
#endif
#endif
}
```

```cpp
#ifndef CPU_EMU
#include <hip/hip_runtime.h>
#endif
#include <stdint.h>
#include <stddef.h>

#ifndef T_LAT
#define T_LAT 16384
#endif
#ifndef T_CTX
#define T_CTX 256
#endif

#ifndef MK_MULTI
#define MK_MULTI 0
#endif
#define DI __device__ __forceinline__
typedef unsigned short bf16_t;
typedef short bf16x8 __attribute__((ext_vector_type(8)));
typedef short s16x4 __attribute__((ext_vector_type(4)));
typedef float f32x4 __attribute__((ext_vector_type(4)));
typedef float f32x16 __attribute__((ext_vector_type(16)));
typedef unsigned u32x4 __attribute__((ext_vector_type(4)));
typedef unsigned u32x2 __attribute__((ext_vector_type(2)));
typedef float f32x2 __attribute__((ext_vector_type(2)));

#ifdef CPU_EMU
static inline float u2f(unsigned u) { float f; memcpy(&f, &u, 4); return f; }
static inline unsigned f2u(float f) { unsigned u; memcpy(&u, &f, 4); return u; }
#define MFMA32(a, b, c) emu_mfma_32x32x16((a), (b), (c))
#define MFMA16(a, b, c) emu_mfma_16x16x32((a), (b), (c))
static inline float fast_exp2(float x) { return exp2f(x); }
static inline float fast_rcp(float x) { return 1.0f / x; }
static inline float fast_rsq(float x) { return 1.0f / sqrtf(x); }
static inline float hw_sin_rev(float x) { return sinf(6.283185307179586f * x); }
static inline float hw_cos_rev(float x) { return cosf(6.283185307179586f * x); }
#define LAUNCH(kern, grid, block, lds, stream, ...) emu::launch(dim3(grid), dim3(block), (size_t)(lds), [=]() { kern(__VA_ARGS__); })
#define DYN_LDS(name) char* name = emu_dynlds()
#define SCHED_BARRIER()
#define TIDX ((int)threadIdx.x)
#define WAVE_SYNC() emu::wave_barrier()
#define SETPRIO(x)
#define IGLP_OPT()
template <int M> static inline float xor_sum(float v) { return v + __shfl_xor(v, M); }
template <int M> static inline float xor_max(float v) { return fmaxf(v, __shfl_xor(v, M)); }
template <int M> static inline int xor_sum_i(int v) { return v + __shfl_xor(v, M); }
static inline int lane_bcast(int v, int src) { return __shfl(v, src); }
static inline float lane_get(float v, int src) { return __shfl(v, src); }
static inline int lane_up(int v, int d, int lane) { (void)lane; return __shfl_up(v, d); }
#else
DI float u2f(unsigned u) { return __uint_as_float(u); }
DI unsigned f2u(float f) { return __float_as_uint(f); }
#define MFMA32(a, b, c) __builtin_amdgcn_mfma_f32_32x32x16_bf16((a), (b), (c), 0, 0, 0)
#define MFMA16(a, b, c) __builtin_amdgcn_mfma_f32_16x16x32_bf16((a), (b), (c), 0, 0, 0)
DI float fast_exp2(float x) { return __builtin_amdgcn_exp2f(x); }
DI float fast_rcp(float x) { return __builtin_amdgcn_rcpf(x); }
DI float fast_rsq(float x) { return __builtin_amdgcn_rsqf(x); }
DI float hw_sin_rev(float x) { return __builtin_amdgcn_sinf(x); }
DI float hw_cos_rev(float x) { return __builtin_amdgcn_cosf(x); }
#define LAUNCH(kern, grid, block, lds, stream, ...) kern<<<dim3(grid), dim3(block), (lds), (stream)>>>(__VA_ARGS__)
#define DYN_LDS(name) extern __shared__ __attribute__((aligned(16))) char name[]
#define SCHED_BARRIER() __builtin_amdgcn_sched_barrier(0)
DI int tid_fresh() { int t = (int)threadIdx.x; asm volatile("" : "+v"(t)); return t; }
#define TIDX tid_fresh()
#define WAVE_SYNC() __builtin_amdgcn_wave_barrier()
#define SETPRIO(x) __builtin_amdgcn_s_setprio(x)
#define IGLP_OPT() __builtin_amdgcn_iglp_opt(0)
#ifdef USE_SHFL
template <int M> DI float xor_sum(float v) { return v + __shfl_xor(v, M); }
template <int M> DI float xor_max(float v) { return fmaxf(v, __shfl_xor(v, M)); }
template <int M> DI int xor_sum_i(int v) { return v + __shfl_xor(v, M); }
DI int lane_bcast(int v, int src) { return __shfl(v, src); }
DI int lane_up(int v, int d, int lane) { (void)lane; return __shfl_up(v, d); }
#else
template <int M> DI int xor_partner_bits(int bits) { return __builtin_amdgcn_ds_swizzle(bits, (M << 10) | 0x1f); }
DI void half_swap(unsigned& a, unsigned& b) { asm volatile("s_nop 1\n\tv_permlane32_swap_b32 %0, %1\n\ts_nop 1" : "+v"(a), "+v"(b)); }
template <int M> DI float xor_sum(float v) {
  if constexpr (M < 32) return v + __builtin_bit_cast(float, xor_partner_bits<M>(__builtin_bit_cast(int, v)));
  else { unsigned a = __builtin_bit_cast(unsigned, v), b = a; half_swap(a, b); return __builtin_bit_cast(float, a) + __builtin_bit_cast(float, b); }
}
template <int M> DI float xor_max(float v) {
  if constexpr (M < 32) return fmaxf(v, __builtin_bit_cast(float, xor_partner_bits<M>(__builtin_bit_cast(int, v))));
  else { unsigned a = __builtin_bit_cast(unsigned, v), b = a; half_swap(a, b); return fmaxf(__builtin_bit_cast(float, a), __builtin_bit_cast(float, b)); }
}
template <int M> DI int xor_sum_i(int v) {
  if constexpr (M < 32) return v + xor_partner_bits<M>(v);
  else { unsigned a = (unsigned)v, b = a; half_swap(a, b); return (int)(a + b); }
}
DI int lane_bcast(int v, int src) { return __builtin_amdgcn_readlane(v, src); }
DI float lane_get(float v, int src) { return __builtin_bit_cast(float, __builtin_amdgcn_ds_bpermute(src << 2, __builtin_bit_cast(int, v))); }
DI int lane_up(int v, int d, int lane) { return __builtin_amdgcn_ds_bpermute(((lane - d) & 63) << 2, v); }
#endif
#endif

DI float bf2f(bf16_t v) { return u2f(((unsigned)v) << 16); }
#ifdef CPU_EMU
DI bf16_t f2bf(float f) { unsigned u = f2u(f); u += 0x7fffu + ((u >> 16) & 1u); return (bf16_t)(u >> 16); }
DI unsigned pack2bf(float lo, float hi) { return (unsigned)f2bf(lo) | ((unsigned)f2bf(hi) << 16); }
static inline unsigned wave_ballot16(bool pr) { unsigned m = 0; for (int e = 0; e < 16; ++e) m |= (__shfl(pr ? 1 : 0, e) ? 1u : 0u) << e; return m; }
static inline bool wave_any(bool pr) { int v = pr ? 1 : 0; v |= __shfl_xor(v, 1); v |= __shfl_xor(v, 2); v |= __shfl_xor(v, 4); v |= __shfl_xor(v, 8); v |= __shfl_xor(v, 16); v |= __shfl_xor(v, 32); return v != 0; }
#else
typedef float f32x2_ __attribute__((ext_vector_type(2)));
typedef __bf16 bf16x2_hw __attribute__((ext_vector_type(2)));
DI unsigned pack2bf(float lo, float hi) { const f32x2_ v = {lo, hi}; return __builtin_bit_cast(unsigned, __builtin_convertvector(v, bf16x2_hw)); }
DI bf16_t f2bf(float f) { return (bf16_t)(pack2bf(f, f) & 0xffffu); }
DI bool wave_any(bool pr) { return __builtin_amdgcn_ballot_w64(pr) != 0ull; }
DI unsigned wave_ballot16(bool pr) { return (unsigned)__builtin_amdgcn_ballot_w64(pr) & 0xffffu; }
#endif
DI float sigmoidf_(float x) { return 1.0f / (1.0f + expf(-x)); }
DI float siluf_(float x) { return x / (1.0f + expf(-x)); }
DI float logsigmoidf_(float x) { return fminf(x, 0.0f) - log1pf(expf(-fabsf(x))); }

constexpr int D = 1024, NB = 2, TL = T_LAT, TC = T_CTX, TK = TL + TC;
constexpr int RL = NB * TL, RC = NB * TC, R = RL + RC;
constexpr int NZ = 3024, NZP = 3072;
constexpr int ZC_QLAT = 0, ZC_KVLAT = 256, ZC_KROPE = 384, ZC_MLQK = 416, ZC_MLV = 928, ZC_MLO = 1184, ZC_MLIG = 1440,
              ZC_MLFG = 1448, ZC_GQ = 1456, ZC_GK = 1584, ZC_GV = 1712, ZC_GR = 1968, ZC_GA = 2224, ZC_DQ = 2256,
              ZC_DK = 2512, ZC_DV = 2768;
constexpr int NCK = TK / 64, NCC = TC / 64, NCL = TL / 64;
constexpr int NE = 16, FF = 1408, CAPL = 2 * TL / 16, CAPC = 2 * TC / 16, CAPT = CAPL + CAPC, NSLOT = NB * CAPT;
constexpr size_t WSZ_IN = (size_t)NZP * D, WSZ_UQ = 384 * 256, WSZ_UKV = 512 * 128, WSZ_GATE = (size_t)4096 * D, WSZ_BR = (size_t)4 * D * 256, WSZ_OUT = (size_t)D * D;
constexpr int NUNIT = NB * 2 * NCK * 4;
constexpr float LOG2E = 1.4426950408889634f;
constexpr float QS_MLA = 0.10206207261596577f * LOG2E;
constexpr float QS_DIFF = 0.17677669529663687f * LOG2E;

DI int row_of(int b, int s) { return s < TC ? RL + b * TC + s : b * TL + (s - TC); }
DI void bs_of(int r, int& b, int& s) { if (r < RL) { b = r / TL; s = TC + (r % TL); } else { int q = r - RL; b = q / TC; s = q % TC; } }
DI int seq_of(int d, int p) { return d == 0 ? p : (p < TC ? TC - 1 - p : TK - 1 - (p - TC)); }
DI int step_of(int d, int c) { return d == 0 ? c : (c < NCC ? NCC - 1 - c : NCC + (NCK - 1 - c)); }

struct Params {
  const float *x, *c, *ctx, *c_ctx, *w_ada, *b_ada, *g_mix_pre, *g_mix_post, *g_ffn_pre, *g_ffn_post, *w_in, *g_q_lat, *w_uq,
      *g_kv_lat, *w_ukv, *w_conv, *b_conv, *b_igate, *b_fgate, *g_mlstm_out, *w_alpha2, *b_alpha, *g_gla_out, *diff_lambda,
      *g_diff_out, *w_branch, *w_gate, *b_gate, *w_out, *w_router, *w_e_gate, *w_e_up, *w_e_down;
  float* out;
  float *mods, *xc;
  bf16_t *H, *Z, *Qm, *Km, *Vtm, *Qd, *Kd, *Vtd, *MQ, *MK, *Y, *MG, *YO, *HID, *YE, *MVt, *GVt;
  float *BC, *IGS, *GC, *MC, *MN, *MM, *GS, *HD, *OD, *AFF, *SELV;
  int *SEL, *INV;
  bf16_t *Wt_in, *Wt_uq, *Wt_ukv, *Wt_gate, *Wt_branch, *Wt_out, *Wt_eg, *Wt_eu, *Wt_ed;
  unsigned* bar;
  size_t ws_need;
};

static inline size_t al256(size_t x) { return (x + 255) & ~(size_t)255; }
static inline void map_workspace(Params& p, char* ws) {
  size_t o = 0;
  auto take = [&](size_t bytes) { size_t r = o; o += al256(bytes); return ws + r; };
  p.bar = (unsigned*)take(16384);
  p.mods = (float*)take((size_t)2 * 3 * 6144 * 4);
  p.xc = (float*)take((size_t)RC * D * 4);
  p.BC = (float*)take((size_t)NB * 2 * TK * 4 * 4);
  p.IGS = (float*)take((size_t)NB * 2 * TK * 4 * 4);
  p.AFF = (float*)take((size_t)NB * NE * TK * 4);
  p.SEL = (int*)take((size_t)NE * NSLOT * 4);
  p.SELV = (float*)take((size_t)NE * NSLOT * 4);
  p.INV = (int*)take((size_t)R * NE * 4);
  p.MM = (float*)take((size_t)NUNIT * 4 * 4);
  p.MN = (float*)take((size_t)NUNIT * 64 * 4);
  p.Wt_in = (bf16_t*)take((size_t)2 * WSZ_IN * 2);
  p.Wt_uq = (bf16_t*)take((size_t)2 * WSZ_UQ * 2);
  p.Wt_ukv = (bf16_t*)take((size_t)2 * WSZ_UKV * 2);
  p.Wt_gate = (bf16_t*)take((size_t)2 * WSZ_GATE * 2);
  p.Wt_branch = (bf16_t*)take((size_t)2 * WSZ_BR * 2);
  p.Wt_out = (bf16_t*)take((size_t)2 * WSZ_OUT * 2);
  p.H = (bf16_t*)take((size_t)R * D * 2);
  size_t szA = (size_t)R * NZP * 2, szHID = (size_t)NE * NSLOT * FF * 2;
  char* A = take(szA > szHID ? szA : szHID);
  p.Z = (bf16_t*)A; p.HID = (bf16_t*)A;
  size_t szQm = al256((size_t)NB * 4 * TK * 96 * 2), szVt = al256((size_t)NB * 4 * 64 * TK * 2), szQd = al256((size_t)NB * 8 * TK * 32 * 2);
  size_t szB1 = 2 * szQm + 2 * szVt + 2 * szQd;
  size_t szHD = al256((size_t)2 * NB * TK * 256 * 4);
  size_t szYE = (size_t)NE * NSLOT * D * 2;
  size_t szB = szB1; if (2 * szHD > szB) szB = 2 * szHD; if (szYE > szB) szB = szYE;
  char* Bq = take(szB);
  p.Qm = (bf16_t*)Bq; p.Km = (bf16_t*)(Bq + szQm); p.Vtm = (bf16_t*)(Bq + 2 * szQm);
  p.Qd = (bf16_t*)(Bq + 2 * szQm + szVt); p.Kd = (bf16_t*)(Bq + 2 * szQm + szVt + szQd); p.Vtd = (bf16_t*)(Bq + 2 * szQm + szVt + 2 * szQd);
  p.YE = (bf16_t*)Bq;
  p.GC = (float*)take((size_t)NB * 2 * TK * 128 * 4);
  p.MVt = (bf16_t*)take((size_t)NB * 4 * 64 * TK * 2);
  p.GVt = (bf16_t*)take((size_t)NB * 4 * 64 * TK * 2);
  size_t szW = (size_t)NE * FF * D * 2;
  size_t szMC = (size_t)NUNIT * 4096 * 4, szRD = (size_t)R * D * 2;
  size_t szC = szMC; if (szRD > szC) szC = szRD; if (szW > szC) szC = szW;
  char* C = take(szC);
  p.MC = (float*)C; p.MG = (bf16_t*)C; p.Wt_eg = (bf16_t*)C;
  size_t szMQ = al256((size_t)NB * TK * 256 * 2), szGS = (size_t)NUNIT * 2048 * 4;
  size_t szD = 2 * szMQ + szGS; if (szW > szD) szD = szW;
  char* Dq = take(szD);
  p.MQ = (bf16_t*)Dq; p.MK = (bf16_t*)(Dq + szMQ); p.GS = (float*)(Dq + 2 * szMQ); p.Wt_eu = (bf16_t*)Dq;
  size_t szF = 2 * szRD > szW ? 2 * szRD : szW;
  char* F = take(szF);
  p.Y = (bf16_t*)F; p.YO = (bf16_t*)(F + szRD); p.Wt_ed = (bf16_t*)F;
  p.HD = (float*)Bq; p.OD = (float*)(Bq + szHD);
  p.ws_need = o;
}
#define GTID ((long)blockIdx.x * blockDim.x + threadIdx.x)

DI float lam_of(const Params& p, int layer, float& lam_init) {
  const float* lv = p.diff_lambda + layer * 128;
  float s1 = 0.f, s2 = 0.f;
  for (int i = 0; i < 32; ++i) { s1 += lv[i] * lv[32 + i]; s2 += lv[64 + i] * lv[96 + i]; }
  lam_init = layer == 0 ? 0.2f : 0.35550906759096f;
  return expf(s1) - expf(s2) + lam_init;
}
DI void rope_cs(int s, int jj, float& cs, float& sn) {
  int t = s - TC;
  int pos = (jj < 16) ? (t / 64) : (t % 64);
  float ang = (float)pos * exp2f(-1.6609640474436813f * (float)(jj & 7));
  double rev = (double)ang * 0.15915494309189535;
  rev -= floor(rev + 0.5);
  float rf = (float)rev;
  cs = hw_cos_rev(rf); sn = hw_sin_rev(rf);
}
template <class G> DI float rope_elem(G get, int s, int jj) {
  if (s < TC) return get(jj);
  float cs, sn; rope_cs(s, jj, cs, sn);
  float a = get(jj), b = get(jj ^ 8);
  return (jj & 8) ? (a * cs + b * sn) : (a * cs - b * sn);
}

DI void nvb_mods(long GI, const Params& p) {
  long i = GI; if (i >= 2 * 3 * 6144) return;
  int col = (int)(i % 6144), w = (int)((i / 6144) % 3), l = (int)(i / (3 * 6144));
  const float* cv = w < 2 ? p.c + w * 1024 : p.c_ctx;
  const float* W = p.w_ada + (size_t)l * 1024 * 6144;
  float acc = 0.f;
  for (int k = 0; k < 1024; ++k) acc += siluf_(cv[k]) * W[(size_t)k * 6144 + col];
  p.mods[i] = acc + p.b_ada[l * 6144 + col];
}
__global__ void __launch_bounds__(256) nv_wt(const float* in, bf16_t* out, int K, int N, int NP, long in_bs, long out_bs, const float* gain) {
  long i = GTID; if (i >= (long)NP * K) return;
  int k = (int)(i % K), n = (int)(i / K);
  const float* I = in + (size_t)blockIdx.y * in_bs; bf16_t* O = out + (size_t)blockIdx.y * out_bs;
  O[(size_t)n * K + k] = n < N ? f2bf(I[(size_t)k * N + n] * (gain ? gain[k] : 1.0f)) : (bf16_t)0;
}
__global__ void __launch_bounds__(256) nv_modulate(Params p, int layer, int which, const float* xl, const float* xcx, int nrows) {
  long r = GTID; if (r >= nrows) return;
  int w = r < RL ? (int)(r / TL) : 2;
  const float* mb = p.mods + (size_t)(layer * 3 + w) * 6144;
  const float* shift = mb + (which ? 3 : 0) * 1024; const float* scale = mb + (which ? 4 : 1) * 1024;
  const float* g = (which ? p.g_ffn_pre : p.g_mix_pre) + layer * 1024;
  const float* x = r < RL ? xl + (size_t)r * D : xcx + (size_t)(r - RL) * D;
  float ss = 0.f; for (int k = 0; k < D; ++k) ss += x[k] * x[k];
  float rstd = 1.0f / sqrtf(ss / D + 1e-6f);
  for (int k = 0; k < D; ++k) p.H[(size_t)r * D + k] = f2bf(x[k] * rstd * g[k] * (1.f + scale[k]) + shift[k]);
}
__global__ void __launch_bounds__(256) nv_gemm(const bf16_t* A, int lda, const bf16_t* Bt, int ldb, int M, int N, int K, bf16_t* C, int ldc) {
  long i = GTID; if (i >= (long)M * N) return;
  int n = (int)(i % N), m = (int)(i / N);
  const bf16_t* a = A + (size_t)m * lda; const bf16_t* b = Bt + (size_t)n * ldb;
  float acc = 0.f;
  for (int k = 0; k < K; ++k) acc += bf2f(a[k]) * bf2f(b[k]);
  C[(size_t)m * ldc + n] = f2bf(acc);
}
__global__ void __launch_bounds__(256) nv_mla_q(Params p, int layer) {
  long i = GTID; if (i >= (long)R * 4 * 96) return;
  int j = (int)(i % 96), h = (int)((i / 96) % 4), r = (int)(i / 384);
  int b, s; bs_of(r, b, s);
  const bf16_t* z = p.Z + (size_t)r * NZP + ZC_QLAT;
  const float* g = p.g_q_lat + layer * 256; const float* W = p.w_uq + (size_t)layer * 256 * 384;
  float ss = 0.f; for (int k = 0; k < 256; ++k) { float v = bf2f(z[k]); ss += v * v; }
  float rstd = 1.0f / sqrtf(ss / 256 + 1e-6f);
  auto dot = [&](int col) { float a = 0.f; for (int k = 0; k < 256; ++k) a += bf2f(z[k]) * rstd * g[k] * W[(size_t)k * 384 + col]; return a; };
  float v;
  if (j < 64) v = dot(h * 96 + j);
  else v = rope_elem([&](int jj) { return dot(h * 96 + 64 + jj); }, s, j - 64);
  p.Qm[(((size_t)b * 4 + h) * TK + s) * 96 + j] = f2bf(v * QS_MLA);
}
__global__ void __launch_bounds__(256) nv_mla_kv(Params p, int layer) {
  long i = GTID; if (i >= (long)R * 4 * 160) return;
  int j = (int)(i % 160), h = (int)((i / 160) % 4), r = (int)(i / 640);
  int b, s; bs_of(r, b, s);
  const bf16_t* z = p.Z + (size_t)r * NZP;
  if (j < 128) {
    const bf16_t* zl = z + ZC_KVLAT; const float* g = p.g_kv_lat + layer * 128; const float* W = p.w_ukv + (size_t)layer * 128 * 512;
    float ss = 0.f; for (int k = 0; k < 128; ++k) { float v = bf2f(zl[k]); ss += v * v; }
    float rstd = 1.0f / sqrtf(ss / 128 + 1e-6f);
    float a = 0.f; for (int k = 0; k < 128; ++k) a += bf2f(zl[k]) * rstd * g[k] * W[(size_t)k * 512 + h * 128 + j];
    if (j < 64) p.Km[(((size_t)b * 4 + h) * TK + s) * 96 + j] = f2bf(a);
    else p.Vtm[(((size_t)b * 4 + h) * 64 + (j - 64)) * TK + s] = f2bf(a);
  } else {
    int jj = j - 128;
    float v = rope_elem([&](int q) { return bf2f(z[ZC_KROPE + q]); }, s, jj);
    p.Km[(((size_t)b * 4 + h) * TK + s) * 96 + 64 + jj] = f2bf(v);
  }
}
__global__ void __launch_bounds__(256) nv_diff_prep(Params p) {
  long i = GTID; if (i >= (long)R * 768) return;
  int c = (int)(i % 768), r = (int)(i / 768);
  int b, s; bs_of(r, b, s);
  const bf16_t* z = p.Z + (size_t)r * NZP;
  if (c < 512) {
    int qk = c / 256, cc = c % 256, hm = cc / 32, jj = cc % 32;
    const bf16_t* src = z + (qk ? ZC_DK : ZC_DQ) + hm * 32;
    float v = rope_elem([&](int q) { return bf2f(src[q]); }, s, jj);
    if (qk == 0) p.Qd[(((size_t)b * 8 + hm) * TK + s) * 32 + jj] = f2bf(v * QS_DIFF);
    else p.Kd[(((size_t)b * 8 + hm) * TK + s) * 32 + jj] = f2bf(v);
  } else {
    int cc = c - 512, h = cc / 64, dv = cc % 64;
    p.Vtd[(((size_t)b * 4 + h) * 64 + dv) * TK + s] = z[ZC_DV + cc];
  }
}
__global__ void __launch_bounds__(256) nv_ml_prep(Params p, int layer) {
  long i = GTID; if (i >= (long)R * 512) return;
  int ch = (int)(i % 512), r = (int)(i / 512);
  int b, s; bs_of(r, b, s);
  bool first = (s == 0) || (s == TC), last = (s == TC - 1) || (s == TK - 1);
  const float* w = p.w_conv + (size_t)layer * 3 * 512;
  float acc = p.b_conv[layer * 512 + ch];
  acc += bf2f(p.Z[(size_t)r * NZP + ZC_MLQK + ch]) * w[512 + ch];
  if (!first) acc += bf2f(p.Z[(size_t)row_of(b, s - 1) * NZP + ZC_MLQK + ch]) * w[ch];
  if (!last) acc += bf2f(p.Z[(size_t)row_of(b, s + 1) * NZP + ZC_MLQK + ch]) * w[1024 + ch];
  float v = siluf_(acc);
  if (ch < 256) p.MQ[((size_t)b * TK + s) * 256 + ch] = f2bf(v);
  else p.MK[((size_t)b * TK + s) * 256 + ch - 256] = f2bf(v * 0.125f);
}
DI void nvb_ml_gates(long GI, const Params& p, int layer) {
  long i = GI; if (i >= (long)NB * 2 * NCK * 4) return;
  int h = (int)(i % 4), j = (int)((i / 4) % NCK), d = (int)((i / (4 * NCK)) % 2), b = (int)(i / (8 * NCK));
  float bi = p.b_igate[layer * 8 + d * 4 + h], bfg = p.b_fgate[layer * 8 + d * 4 + h];
  float cum = 0.f;
  for (int l = 0; l < 64; ++l) {
    int pp = 64 * j + l, s = seq_of(d, pp); const bf16_t* z = p.Z + (size_t)row_of(b, s) * NZP;
    float ig = bf2f(z[ZC_MLIG + d * 4 + h]) + bi;
    float lf = logsigmoidf_(bf2f(z[ZC_MLFG + d * 4 + h]) + bfg);
    cum += lf;
    size_t o = (((size_t)b * 2 + d) * TK + pp) * 4 + h;
    p.BC[o] = cum; p.IGS[o] = ig;
  }
}
DI void nvb_gla_cum(long GI, const Params& p, int layer) {
  long i = GI; if (i >= (long)NB * 2 * NCK * 128) return;
  int ch = (int)(i % 128), j = (int)((i / 128) % NCK), d = (int)((i / (128 * NCK)) % 2), b = (int)(i / (256 * NCK));
  const float* W = p.w_alpha2 + (size_t)layer * 2 * 16 * 128 + (size_t)d * 16 * 128;
  float ba = p.b_alpha[layer * 256 + d * 128 + ch];
  float cum = 0.f;
  for (int l = 0; l < 64; ++l) {
    int pp = 64 * j + l, s = seq_of(d, pp); const bf16_t* z = p.Z + (size_t)row_of(b, s) * NZP + ZC_GA + d * 16;
    float zg = ba; for (int q = 0; q < 16; ++q) zg += bf2f(z[q]) * W[q * 128 + ch];
    cum += logsigmoidf_(zg) * (1.0f / 16.0f);
    p.GC[(((size_t)b * 2 + d) * TK + pp) * 128 + ch] = cum;
  }
}
__global__ void __launch_bounds__(256) nv_attn_mla(Params p, int need_ctx) {
  long i = GTID; if (i >= (long)NB * 4 * TK) return;
  int s = (int)(i % TK), h = (int)((i / TK) % 4), b = (int)(i / (4 * TK));
  if (s < TC && !need_ctx) return;
  int nk = s < TC ? TC : TK;
  const bf16_t* q = p.Qm + (((size_t)b * 4 + h) * TK + s) * 96;
  const bf16_t* K = p.Km + ((size_t)b * 4 + h) * TK * 96;
  const bf16_t* Vt = p.Vtm + ((size_t)b * 4 + h) * 64 * TK;
  float qf[96], o[64];
  _Pragma("unroll") for (int k = 0; k < 96; ++k) qf[k] = bf2f(q[k]);
  _Pragma("unroll") for (int k = 0; k < 64; ++k) o[k] = 0.f;
  float m = -1e30f, l = 0.f;
  for (int t = 0; t < nk; ++t) {
    float sc = 0.f; _Pragma("unroll") for (int k = 0; k < 96; ++k) sc += qf[k] * bf2f(K[(size_t)t * 96 + k]);
    float mn = fmaxf(m, sc), a = exp2f(m - mn), pr = exp2f(sc - mn);
    l = l * a + pr;
    _Pragma("unroll") for (int k = 0; k < 64; ++k) o[k] = o[k] * a + pr * bf2f(Vt[(size_t)k * TK + t]);
    m = mn;
  }
  int r = row_of(b, s);
  _Pragma("unroll") for (int k = 0; k < 64; ++k) p.Y[(size_t)r * D + h * 64 + k] = f2bf(o[k] / l);
}
__global__ void __launch_bounds__(256) nv_attn_diff(Params p, int layer, int need_ctx) {
  long i = GTID; if (i >= (long)NB * 4 * TK) return;
  int s = (int)(i % TK), h = (int)((i / TK) % 4), b = (int)(i / (4 * TK));
  if (s < TC && !need_ctx) return;
  int nk = s < TC ? TC : TK;
  float lam_init; float lam = lam_of(p, layer, lam_init);
  const bf16_t* Vt = p.Vtd + ((size_t)b * 4 + h) * 64 * TK;
  float res[64];
  _Pragma("unroll") for (int k = 0; k < 64; ++k) res[k] = 0.f;
  _Pragma("unroll") for (int mp = 0; mp < 2; ++mp) {
    const bf16_t* q = p.Qd + (((size_t)b * 8 + h * 2 + mp) * TK + s) * 32;
    const bf16_t* K = p.Kd + ((size_t)b * 8 + h * 2 + mp) * TK * 32;
    float qf[32], o[64];
    _Pragma("unroll") for (int k = 0; k < 32; ++k) qf[k] = bf2f(q[k]);
    _Pragma("unroll") for (int k = 0; k < 64; ++k) o[k] = 0.f;
    float m = -1e30f, l = 0.f;
    for (int t = 0; t < nk; ++t) {
      float sc = 0.f; _Pragma("unroll") for (int k = 0; k < 32; ++k) sc += qf[k] * bf2f(K[(size_t)t * 32 + k]);
      float mn = fmaxf(m, sc), a = exp2f(m - mn), pr = exp2f(sc - mn);
      l = l * a + pr;
      _Pragma("unroll") for (int k = 0; k < 64; ++k) o[k] = o[k] * a + pr * bf2f(Vt[(size_t)k * TK + t]);
      m = mn;
    }
    float wgt = mp == 0 ? 1.f : -lam;
    _Pragma("unroll") for (int k = 0; k < 64; ++k) res[k] += wgt * o[k] / l;
  }
  float ss = 0.f; _Pragma("unroll") for (int k = 0; k < 64; ++k) ss += res[k] * res[k];
  float rstd = 1.0f / sqrtf(ss / 64 + 1e-6f);
  int r = row_of(b, s);
  _Pragma("unroll") for (int k = 0; k < 64; ++k) p.Y[(size_t)r * D + 768 + h * 64 + k] = f2bf(res[k] * rstd * p.g_diff_out[layer * 256 + h * 64 + k] * (1.f - lam_init));
}
DI void nvb_ml_local(long GI, const Params& p) {
  long i = GI; if (i >= (long)NUNIT * 4160) return;
  int e = (int)(i % 4160); long u = i / 4160;
  int h = (int)(u % 4), j = (int)((u / 4) % NCK), d = (int)((u / (4 * NCK)) % 2), b = (int)(u / (8 * NCK));
  const float* bc = p.BC + (((size_t)b * 2 + d) * TK + 64 * j) * 4 + h; const float* ig = p.IGS + (((size_t)b * 2 + d) * TK + 64 * j) * 4 + h;
  float bend = bc[63 * 4], ml = -1e30f;
  for (int l = 0; l < 64; ++l) ml = fmaxf(ml, bend - bc[l * 4] + ig[l * 4]);
  if (e == 4096 + 0) { p.MM[u * 4 + 0] = ml; p.MM[u * 4 + 1] = bend; }
  float acc = 0.f;
  if (e < 4096) {
    int v = e / 64, k = e % 64;
    for (int l = 0; l < 64; ++l) {
      int s = seq_of(d, 64 * j + l); float w = expf(bend - bc[l * 4] + ig[l * 4] - ml);
      acc += w * bf2f(p.Z[(size_t)row_of(b, s) * NZP + ZC_MLV + h * 64 + v]) * bf2f(p.MK[((size_t)b * TK + s) * 256 + h * 64 + k]);
    }
    p.MC[(size_t)u * 4096 + e] = acc;
  } else {
    int k = e - 4096;
    for (int l = 0; l < 64; ++l) {
      int s = seq_of(d, 64 * j + l); float w = expf(bend - bc[l * 4] + ig[l * 4] - ml);
      acc += w * bf2f(p.MK[((size_t)b * TK + s) * 256 + h * 64 + k]);
    }
    p.MN[(size_t)u * 64 + k] = acc;
  }
}
DI void nvb_ml_scan(long GI, const Params& p) {
  long i = GI; if (i >= (long)NB * 2 * 4 * 4160) return;
  int e = (int)(i % 4160); int ch = (int)(i / 4160); int h = ch % 4, bd = ch / 4;
  float st = 0.f, m = -1e30f;
  for (int j = 0; j < NCK; ++j) {
    size_t u = ((size_t)bd * NCK + j) * 4 + h;
    float ml = p.MM[u * 4 + 0], be = p.MM[u * 4 + 1];
    float mn = fmaxf(be + m, ml), a = expf(be + m - mn), g = expf(ml - mn);
    float* slot = e < 4096 ? &p.MC[u * 4096 + e] : &p.MN[u * 64 + (e - 4096)];
    float loc = *slot; *slot = st; st = a * st + g * loc;
    if (e == 0) p.MM[u * 4 + 2] = m;
    m = mn;
  }
}
DI void nvb_ml_out(long GI, const Params& p, int need_ctx) {
  long i = GI; if (i >= (long)NUNIT * 4096) return;
  int v = (int)(i % 64), l = (int)((i / 64) % 64); long u = i / 4096;
  int h = (int)(u % 4), j = (int)((u / 4) % NCK), d = (int)((u / (4 * NCK)) % 2), b = (int)(u / (8 * NCK));
  if (j < NCC && !need_ctx) return;
  const float* bc = p.BC + (((size_t)b * 2 + d) * TK + 64 * j) * 4 + h; const float* ig = p.IGS + (((size_t)b * 2 + d) * TK + 64 * j) * 4 + h;
  float m0 = p.MM[u * 4 + 2];
  int sl = seq_of(d, 64 * j + l);
  const bf16_t* q = p.MQ + ((size_t)b * TK + sl) * 256 + h * 64;
  float bl = bc[l * 4];
  float inter = bl + m0, mt = inter;
  for (int t = 0; t <= l; ++t) mt = fmaxf(mt, bl - bc[t * 4] + ig[t * 4]);
  float num = 0.f, den = 0.f;
  for (int t = 0; t <= l; ++t) {
    int st = seq_of(d, 64 * j + t);
    const bf16_t* k = p.MK + ((size_t)b * TK + st) * 256 + h * 64;
    float qk = 0.f; for (int c = 0; c < 64; ++c) qk += bf2f(q[c]) * bf2f(k[c]);
    float sv = expf(bl - bc[t * 4] + ig[t * 4] - mt) * qk;
    num += sv * bf2f(p.Z[(size_t)row_of(b, st) * NZP + ZC_MLV + h * 64 + v]); den += sv;
  }
  float ai = expf(inter - mt);
  float qc = 0.f, qn = 0.f;
  for (int c = 0; c < 64; ++c) { qc += bf2f(q[c]) * p.MC[(size_t)u * 4096 + v * 64 + c]; qn += bf2f(q[c]) * p.MN[(size_t)u * 64 + c]; }
  num += ai * qc; den += ai * qn;
  p.HD[(((size_t)d * NB + b) * TK + sl) * 256 + h * 64 + v] = num / fmaxf(fabsf(den), expf(-mt));
}
DI void nvb_ml_finish(long GI, const Params& p, int layer, int need_ctx) {
  long i = GI; if (i >= (long)R * 4) return;
  int h = (int)(i % 4), r = (int)(i / 4); int b, s; bs_of(r, b, s);
  if (s < TC && !need_ctx) return;
  const float* h0 = p.HD + (((size_t)0 * NB + b) * TK + s) * 256 + h * 64; const float* h1 = p.HD + (((size_t)1 * NB + b) * TK + s) * 256 + h * 64;
  float ss = 0.f; for (int v = 0; v < 64; ++v) { float t = h0[v] + h1[v]; ss += t * t; }
  float rstd = 1.0f / sqrtf(ss / 64 + 1e-6f);
  for (int v = 0; v < 64; ++v) {
    float o = bf2f(p.Z[(size_t)r * NZP + ZC_MLO + h * 64 + v]);
    p.Y[(size_t)r * D + 256 + h * 64 + v] = f2bf(sigmoidf_(o) * (h0[v] + h1[v]) * rstd * p.g_mlstm_out[layer * 256 + h * 64 + v]);
  }
}
DI void nvb_gla_local(long GI, const Params& p) {
  long i = GI; if (i >= (long)NUNIT * 2048) return;
  int v = (int)(i % 64), k = (int)((i / 64) % 32); long u = i / 2048;
  int h = (int)(u % 4), j = (int)((u / 4) % NCK), d = (int)((u / (4 * NCK)) % 2), b = (int)(u / (8 * NCK));
  const float* gc = p.GC + (((size_t)b * 2 + d) * TK + 64 * j) * 128 + h * 32 + k;
  float ge = gc[63 * 128], acc = 0.f;
  for (int l = 0; l < 64; ++l) {
    int s = seq_of(d, 64 * j + l); const bf16_t* z = p.Z + (size_t)row_of(b, s) * NZP;
    acc += bf2f(z[ZC_GK + h * 32 + k]) * expf(ge - gc[l * 128]) * bf2f(z[ZC_GV + h * 64 + v]);
  }
  p.GS[(size_t)u * 2048 + v * 32 + k] = acc;
}
DI void nvb_gla_scan(long GI, const Params& p) {
  long i = GI; if (i >= (long)NB * 2 * 4 * 2048) return;
  int e = (int)(i % 2048); int ch = (int)(i / 2048); int h = ch % 4, bd = ch / 4; int k = e % 32;
  float st = 0.f;
  for (int j = 0; j < NCK; ++j) {
    size_t u = ((size_t)bd * NCK + j) * 4 + h;
    float ge = p.GC[((size_t)bd * TK + 64 * j + 63) * 128 + h * 32 + k];
    float loc = p.GS[u * 2048 + e]; p.GS[u * 2048 + e] = st; st = expf(ge) * st + loc;
  }
}
DI void nvb_gla_out(long GI, const Params& p, int need_ctx) {
  long i = GI; if (i >= (long)NUNIT * 4096) return;
  int v = (int)(i % 64), l = (int)((i / 64) % 64); long u = i / 4096;
  int h = (int)(u % 4), j = (int)((u / 4) % NCK), d = (int)((u / (4 * NCK)) % 2), b = (int)(u / (8 * NCK));
  if (j < NCC && !need_ctx) return;
  const float* gc = p.GC + (((size_t)b * 2 + d) * TK + 64 * j) * 128 + h * 32;
  int sl = seq_of(d, 64 * j + l);
  const bf16_t* q = p.Z + (size_t)row_of(b, sl) * NZP + ZC_GQ + h * 32;
  const float qs = 0.17677669529663687f;
  float acc = 0.f;
  for (int t = 0; t <= l; ++t) {
    int st = seq_of(d, 64 * j + t); const bf16_t* z = p.Z + (size_t)row_of(b, st) * NZP;
    float att = 0.f; for (int k = 0; k < 32; ++k) att += bf2f(q[k]) * qs * expf(gc[l * 128 + k] - gc[t * 128 + k]) * bf2f(z[ZC_GK + h * 32 + k]);
    acc += att * bf2f(z[ZC_GV + h * 64 + v]);
  }
  for (int k = 0; k < 32; ++k) acc += bf2f(q[k]) * qs * expf(gc[l * 128 + k]) * p.GS[(size_t)u * 2048 + v * 32 + k];
  p.OD[(((size_t)d * NB + b) * TK + sl) * 256 + h * 64 + v] = acc;
}
DI void nvb_gla_finish(long GI, const Params& p, int layer, int need_ctx) {
  long i = GI; if (i >= (long)R * 4) return;
  int h = (int)(i % 4), r = (int)(i / 4); int b, s; bs_of(r, b, s);
  if (s < TC && !need_ctx) return;
  const float* h0 = p.OD + (((size_t)0 * NB + b) * TK + s) * 256 + h * 64; const float* h1 = p.OD + (((size_t)1 * NB + b) * TK + s) * 256 + h * 64;
  float ss = 0.f; for (int v = 0; v < 64; ++v) { float t = h0[v] + h1[v]; ss += t * t; }
  float rstd = 1.0f / sqrtf(ss / 64 + 1e-6f);
  for (int v = 0; v < 64; ++v) {
    float rr = bf2f(p.Z[(size_t)r * NZP + ZC_GR + h * 64 + v]);
    p.Y[(size_t)r * D + 512 + h * 64 + v] = f2bf(siluf_(rr) * (h0[v] + h1[v]) * rstd * p.g_gla_out[layer * 256 + h * 64 + v]);
  }
}
__global__ void __launch_bounds__(256) nv_merge(Params p, int layer, int nrows) {
  long i = GTID; if (i >= (long)nrows * D) return;
  int j = (int)(i % D), r = (int)(i / D);
  float acc = 0.f;
  for (int n = 0; n < 4; ++n) {
    const bf16_t* wg = p.Wt_gate + (size_t)(n * 1024 + j) * D; const bf16_t* wb = p.Wt_branch + ((size_t)n * D + j) * 256;
    float g = p.b_gate[layer * 4096 + n * 1024 + j], pr = 0.f;
    for (int k = 0; k < D; ++k) g += bf2f(p.H[(size_t)r * D + k]) * bf2f(wg[k]);
    for (int k = 0; k < 256; ++k) pr += bf2f(p.Y[(size_t)r * D + n * 256 + k]) * bf2f(wb[k]);
    acc += sigmoidf_(g) * pr;
  }
  p.MG[(size_t)r * D + j] = f2bf(acc);
}
__global__ void __launch_bounds__(256) nv_resid_mix(Params p, int layer, const float* xl_in, const float* xc_in, int nrows) {
  long r = GTID; if (r >= nrows) return;
  int w = r < RL ? (int)(r / TL) : 2;
  const float* mb = p.mods + (size_t)(layer * 3 + w) * 6144;
  const float* xin = r < RL ? xl_in + (size_t)r * D : xc_in + (size_t)(r - RL) * D;
  float* xo = r < RL ? p.out + (size_t)r * D : p.xc + (size_t)(r - RL) * D;
  const bf16_t* yo = p.YO + (size_t)r * D;
  float ss = 0.f; for (int k = 0; k < D; ++k) { float v = bf2f(yo[k]); ss += v * v; }
  float rstd = 1.0f / sqrtf(ss / D + 1e-6f);
  float s2 = 0.f;
  for (int k = 0; k < D; ++k) { float xn = xin[k] + mb[2 * 1024 + k] * bf2f(yo[k]) * rstd * p.g_mix_post[layer * 1024 + k]; xo[k] = xn; s2 += xn * xn; }
  float rstd2 = 1.0f / sqrtf(s2 / D + 1e-6f);
  float lg[16]; _Pragma("unroll") for (int e = 0; e < 16; ++e) lg[e] = 0.f;
  const float* wr = p.w_router + (size_t)layer * D * 16;
  for (int k = 0; k < D; ++k) {
    float h2 = xo[k] * rstd2 * p.g_ffn_pre[layer * 1024 + k] * (1.f + mb[4 * 1024 + k]) + mb[3 * 1024 + k];
    p.H[(size_t)r * D + k] = f2bf(h2);
    _Pragma("unroll") for (int e = 0; e < 16; ++e) lg[e] += h2 * wr[k * 16 + e];
  }
  float mx = lg[0]; _Pragma("unroll") for (int e = 1; e < 16; ++e) mx = fmaxf(mx, lg[e]);
  float sm = 0.f; _Pragma("unroll") for (int e = 0; e < 16; ++e) { lg[e] = expf(lg[e] - mx); sm += lg[e]; }
  int b, s; bs_of((int)r, b, s);
  _Pragma("unroll") for (int e = 0; e < 16; ++e) p.AFF[((size_t)b * NE + e) * TK + s] = lg[e] / sm;
}
__global__ void __launch_bounds__(256) nv_topk(Params p, int need_ctx) {
  long i = GTID; if (i >= NB * NE * 2) return;
  int seg = (int)(i % 2), e = (int)((i / 2) % NE), b = (int)(i / (2 * NE));
  int s0 = seg ? TC : 0, n = seg ? TL : TC, cap = seg ? CAPL : CAPC, slot0 = seg ? b * CAPL : NB * CAPL + b * CAPC;
  if (seg == 0 && !need_ctx) { for (int q = 0; q < cap; ++q) p.SEL[(size_t)e * NSLOT + slot0 + q] = -1; return; }
  const float* a = p.AFF + ((size_t)b * NE + e) * TK + s0;
  unsigned thr = 0;
  for (int bit = 31; bit >= 0; --bit) {
    unsigned cand = thr | (1u << bit); int cnt = 0;
    for (int t = 0; t < n; ++t) cnt += (f2u(a[t]) >= cand);
    if (cnt >= cap) thr = cand;
  }
  int ngt = 0; for (int t = 0; t < n; ++t) ngt += (f2u(a[t]) > thr);
  int neq = cap - ngt, q = 0;
  for (int t = 0; t < n; ++t) {
    unsigned u = f2u(a[t]); int r = row_of(b, s0 + t); int sel = -1;
    if (u > thr) sel = q++; else if (u == thr && neq > 0) { sel = q++; --neq; }
    if (sel >= 0) { p.SEL[(size_t)e * NSLOT + slot0 + sel] = r; p.SELV[(size_t)e * NSLOT + slot0 + sel] = a[t]; }
    p.INV[(size_t)r * NE + e] = sel >= 0 ? slot0 + sel : -1;
  }
}
__global__ void __launch_bounds__(256) nv_moe1(Params p) {
  long i = GTID; if (i >= (long)NE * NSLOT * FF) return;
  int f = (int)(i % FF), slot = (int)((i / FF) % NSLOT), e = (int)(i / ((long)FF * NSLOT));
  int r = p.SEL[(size_t)e * NSLOT + slot];
  float out = 0.f;
  if (r >= 0) {
    const bf16_t* wg = p.Wt_eg + ((size_t)e * FF + f) * D; const bf16_t* wu = p.Wt_eu + ((size_t)e * FF + f) * D; const bf16_t* h = p.H + (size_t)r * D;
    float g = 0.f, u = 0.f; for (int k = 0; k < D; ++k) { float hv = bf2f(h[k]); g += hv * bf2f(wg[k]); u += hv * bf2f(wu[k]); }
    out = siluf_(g) * u;
  }
  p.HID[((size_t)e * NSLOT + slot) * FF + f] = f2bf(out);
}
__global__ void __launch_bounds__(256) nv_moe2(Params p) {
  long i = GTID; if (i >= (long)NE * NSLOT * D) return;
  int j = (int)(i % D), slot = (int)((i / D) % NSLOT), e = (int)(i / ((long)D * NSLOT));
  int r = p.SEL[(size_t)e * NSLOT + slot];
  float out = 0.f;
  if (r >= 0) {
    const bf16_t* wd = p.Wt_ed + ((size_t)e * D + j) * FF; const bf16_t* h = p.HID + ((size_t)e * NSLOT + slot) * FF;
    float a = 0.f; for (int k = 0; k < FF; ++k) a += bf2f(h[k]) * bf2f(wd[k]);
    out = a * p.SELV[(size_t)e * NSLOT + slot];
  }
  p.YE[((size_t)e * NSLOT + slot) * D + j] = f2bf(out);
}
__global__ void __launch_bounds__(256) nv_resid_ffn(Params p, int layer, int nrows) {
  long r = GTID; if (r >= nrows) return;
  int w = r < RL ? (int)(r / TL) : 2;
  const float* mb = p.mods + (size_t)(layer * 3 + w) * 6144;
  float* xo = r < RL ? p.out + (size_t)r * D : p.xc + (size_t)(r - RL) * D;
  float ss = 0.f;
  for (int k = 0; k < D; ++k) {
    float f = 0.f;
    for (int e = 0; e < NE; ++e) { int sl = p.INV[(size_t)r * NE + e]; if (sl >= 0) f += bf2f(p.YE[((size_t)e * NSLOT + sl) * D + k]); }
    ss += f * f;
  }
  float rstd = 1.0f / sqrtf(ss / D + 1e-6f);
  for (int k = 0; k < D; ++k) {
    float f = 0.f;
    for (int e = 0; e < NE; ++e) { int sl = p.INV[(size_t)r * NE + e]; if (sl >= 0) f += bf2f(p.YE[((size_t)e * NSLOT + sl) * D + k]); }
    xo[k] += mb[5 * 1024 + k] * f * rstd * p.g_ffn_post[layer * 1024 + k];
  }
}

__global__ void __launch_bounds__(256) nv_mods(Params p) { nvb_mods(GTID, p); }
__global__ void __launch_bounds__(256) nv_ml_gates(Params p, int layer) { nvb_ml_gates(GTID, p, layer); }
__global__ void __launch_bounds__(256) nv_gla_cum(Params p, int layer) { nvb_gla_cum(GTID, p, layer); }
__global__ void __launch_bounds__(256) nv_ml_local(Params p) { nvb_ml_local(GTID, p); }
__global__ void __launch_bounds__(256) nv_ml_scan(Params p) { nvb_ml_scan(GTID, p); }
__global__ void __launch_bounds__(256) nv_ml_out(Params p, int need_ctx) { nvb_ml_out(GTID, p, need_ctx); }
__global__ void __launch_bounds__(256) nv_ml_finish(Params p, int layer, int need_ctx) { nvb_ml_finish(GTID, p, layer, need_ctx); }
__global__ void __launch_bounds__(256) nv_gla_local(Params p) { nvb_gla_local(GTID, p); }
__global__ void __launch_bounds__(256) nv_gla_scan(Params p) { nvb_gla_scan(GTID, p); }
__global__ void __launch_bounds__(256) nv_gla_out(Params p, int need_ctx) { nvb_gla_out(GTID, p, need_ctx); }
__global__ void __launch_bounds__(256) nv_gla_finish(Params p, int layer, int need_ctx) { nvb_gla_finish(GTID, p, layer, need_ctx); }
constexpr int LROW = 144;
constexpr int A_BYTES = 128 * LROW;
constexpr int NTHR = 256;
#ifndef ATT_THR
#define ATT_THR 16.0f
#endif

DI int xcd_swz(int u, int nt) { return (nt & 7) ? u : (u & 7) * (nt >> 3) + (u >> 3); }
template <int GW> DI void grp_tile(int L, int ntm, int ntn, int& tm, int& tn) {
  const int gsz = ntm * GW; int g = 0;
  while (L >= gsz) { L -= gsz; ++g; }
  tm = L / GW; tn = g * GW + (L & (GW - 1)); (void)ntn;
}
DI u32x4 ldg16(const void* p) { return *(const u32x4*)p; }
DI void sts16(char* p, u32x4 v) { *(u32x4*)p = v; }
DI bf16x8 lds_frag(const char* p) { return *(const bf16x8*)p; }

template <int WN, int KFIX = 0>
DI void gemm_kloop(f32x4 (&acc)[4][WN], const bf16_t* const (&ap)[4], const bf16_t* const (&bp)[WN], int nk, char* lds) {
  constexpr int STAGE = A_BYTES + 32 * WN * LROW;
  const int t = TIDX, lane = t & 63, wid = t >> 6, wr = wid >> 1, wc = wid & 1;
  const int lr = t >> 3, lcb = (t & 7) * 16;
  const int fr = lane & 15, fq = lane >> 4;
  const int aoff = (wr * 64 + fr) * LROW + fq * 16, boff = A_BYTES + (wc * WN * 16 + fr) * LROW + fq * 16, soff = lr * LROW + lcb;
  u32x4 ra0[4], rb0[WN], ra1[4], rb1[WN];
  auto gload = [&](u32x4 (&ra)[4], u32x4 (&rb)[WN], int kt) {
#pragma unroll
    for (int i = 0; i < 4; ++i) ra[i] = ldg16(ap[i] + (KFIX ? (kt & 1) : kt) * 64);
#pragma unroll
    for (int i = 0; i < WN; ++i) rb[i] = ldg16(bp[i] + (KFIX ? (kt & 1) : kt) * 64);
  };
  auto sstore = [&](const u32x4 (&ra)[4], const u32x4 (&rb)[WN], char* st) {
#pragma unroll
    for (int i = 0; i < 4; ++i) sts16(st + soff + 32 * i * LROW, ra[i]);
#pragma unroll
    for (int i = 0; i < WN; ++i) sts16(st + A_BYTES + soff + 32 * i * LROW, rb[i]);
  };
  auto compute = [&](const char* cur) {
#pragma unroll
    for (int ks = 0; ks < 2; ++ks) {
      bf16x8 af[4], bfr[WN];
#pragma unroll
      for (int m = 0; m < 4; ++m) af[m] = lds_frag(cur + aoff + m * 16 * LROW + ks * 64);
#pragma unroll
      for (int n = 0; n < WN; ++n) bfr[n] = lds_frag(cur + boff + n * 16 * LROW + ks * 64);
#pragma unroll
      for (int m = 0; m < 4; ++m)
#pragma unroll
        for (int n = 0; n < WN; ++n) acc[m][n] = MFMA16(bfr[n], af[m], acc[m][n]);
    }
    IGLP_OPT();
  };
  gload(ra0, rb0, 0);
  gload(ra1, rb1, 1);
  sstore(ra0, rb0, lds);
  __syncthreads();
#pragma unroll 1
  for (int kt = 0; kt < nk; kt += 2) {
    if (kt + 2 < nk) gload(ra0, rb0, kt + 2);
    compute(lds);
    sstore(ra1, rb1, lds + STAGE);
    __syncthreads();
    if (kt + 3 < nk) gload(ra1, rb1, kt + 3);
    compute(lds + STAGE);
    if (kt + 2 < nk) sstore(ra0, rb0, lds);
    __syncthreads();
  }
}
struct KRegs { u32x4 ra0[4], rb0[4], ra1[4], rb1[4]; };
template <class NextPtrs>
DI void gemm_kloop_x(f32x4 (&acc)[4][4], const bf16_t* const (&ap)[4], const bf16_t* const (&bp)[4], int nk, char* lds, KRegs& R, bool pre,
                     NextPtrs nextp, bool has_next) {
  constexpr int WN = 4, STAGE = A_BYTES + 32 * WN * LROW;
  const int t = TIDX, lane = t & 63, wid = t >> 6, wr = wid >> 1, wc = wid & 1;
  const int lr = t >> 3, lcb = (t & 7) * 16;
  const int fr = lane & 15, fq = lane >> 4;
  const int aoff = (wr * 64 + fr) * LROW + fq * 16, boff = A_BYTES + (wc * WN * 16 + fr) * LROW + fq * 16, soff = lr * LROW + lcb;
  auto gload = [&](u32x4 (&ra)[4], u32x4 (&rb)[4], const bf16_t* const (&a)[4], const bf16_t* const (&b)[4], int kt) __attribute__((always_inline)) {
#pragma unroll
    for (int i = 0; i < 4; ++i) ra[i] = ldg16(a[i] + kt * 64);
#pragma unroll
    for (int i = 0; i < 4; ++i) rb[i] = ldg16(b[i] + kt * 64);
  };
  auto sstore = [&](const u32x4 (&ra)[4], const u32x4 (&rb)[4], char* st) __attribute__((always_inline)) {
#pragma unroll
    for (int i = 0; i < 4; ++i) sts16(st + soff + 32 * i * LROW, ra[i]);
#pragma unroll
    for (int i = 0; i < 4; ++i) sts16(st + A_BYTES + soff + 32 * i * LROW, rb[i]);
  };
  auto compute = [&](const char* cur) __attribute__((always_inline)) {
#pragma unroll
    for (int ks = 0; ks < 2; ++ks) {
      bf16x8 af[4], bfr[4];
#pragma unroll
      for (int m = 0; m < 4; ++m) af[m] = lds_frag(cur + aoff + m * 16 * LROW + ks * 64);
#pragma unroll
      for (int n = 0; n < 4; ++n) bfr[n] = lds_frag(cur + boff + n * 16 * LROW + ks * 64);
#pragma unroll
      for (int m = 0; m < 4; ++m)
#pragma unroll
        for (int n = 0; n < 4; ++n) acc[m][n] = MFMA16(bfr[n], af[m], acc[m][n]);
    }
    IGLP_OPT();
  };
  if (!pre) gload(R.ra0, R.rb0, ap, bp, 0);
  gload(R.ra1, R.rb1, ap, bp, 1);
  sstore(R.ra0, R.rb0, lds);
  __syncthreads();
#pragma unroll 1
  for (int kt = 0; kt < nk; kt += 2) {
    if (kt + 2 < nk) gload(R.ra0, R.rb0, ap, bp, kt + 2); else if (has_next) { const bf16_t* na[4]; const bf16_t* nb[4]; nextp(na, nb); gload(R.ra0, R.rb0, na, nb, 0); }
    compute(lds);
    sstore(R.ra1, R.rb1, lds + STAGE);
    __syncthreads();
    if (kt + 3 < nk) gload(R.ra1, R.rb1, ap, bp, kt + 3);
    compute(lds + STAGE);
    if (kt + 2 < nk) sstore(R.ra0, R.rb0, lds);
    __syncthreads();
  }
}
template <int WN> DI void acc_zero(f32x4 (&acc)[4][WN]) {
#pragma unroll
  for (int m = 0; m < 4; ++m)
#pragma unroll
    for (int n = 0; n < WN; ++n) acc[m][n] = (f32x4){0.f, 0.f, 0.f, 0.f};
}
DI void st_bf16x4(bf16_t* p, f32x4 v) { u32x2 o; o.x = pack2bf(v.x, v.y); o.y = pack2bf(v.z, v.w); *(u32x2*)p = o; }

template <int WN, class RowOk>
DI void store_wave_tile(const f32x4 (&acc)[4][WN], bf16_t* C, size_t ldc, char* ldsw, int lane, RowOk row_ok) {
  constexpr int PITCH = WN * 32 + 16, CPR = WN * 2;
  const int fr = lane & 15, fq = lane >> 4;
#pragma unroll
  for (int m = 0; m < 4; ++m)
#pragma unroll
    for (int n = 0; n < WN; ++n) { u32x2 o; o.x = pack2bf(acc[m][n][0], acc[m][n][1]); o.y = pack2bf(acc[m][n][2], acc[m][n][3]); *(u32x2*)(ldsw + (m * 16 + fr) * PITCH + n * 32 + fq * 8) = o; }
  WAVE_SYNC();
  constexpr int RPP = 64 / CPR;
#pragma unroll
  for (int ps = 0; ps < 64 / RPP; ++ps) {
    const int r = ps * RPP + lane / CPR, c = lane % CPR;
    const u32x4 v = *(const u32x4*)(ldsw + r * PITCH + c * 16);
    if (row_ok(r)) *(u32x4*)(C + (size_t)r * ldc + c * 8) = v;
  }
  WAVE_SYNC();
}
template <int NOSTORE = 0>
DI void gemm_plain_tile(const bf16_t* A, int lda, const bf16_t* Bt, int ldb, int K, bf16_t* C, int ldc, int tm, int tn, char* lds) {
  const int t = TIDX, lane = t & 63, wid = t >> 6, wr = wid >> 1, wc = wid & 1, lr = t >> 3, lc = (t & 7) * 8, fr = lane & 15, fq = lane >> 4;
  const bf16_t* ap[4]; const bf16_t* bp[4];
#pragma unroll
  for (int i = 0; i < 4; ++i) { ap[i] = A + (size_t)(tm * 128 + lr + 32 * i) * lda + lc; bp[i] = Bt + (size_t)(tn * 128 + lr + 32 * i) * ldb + lc; }
  f32x4 acc[4][4]; acc_zero<4>(acc);
  gemm_kloop<4, NOSTORE == 2>(acc, ap, bp, K / 64, lds);
  if (NOSTORE) { float s = 0.f;
#pragma unroll
    for (int m = 0; m < 4; ++m)
#pragma unroll
      for (int n = 0; n < 4; ++n) s += acc[m][n][0] + acc[m][n][3];
    if (s == 123456.789f) C[0] = 1; return; }
  store_wave_tile<4>(acc, C + (size_t)(tm * 128 + wr * 64) * ldc + tn * 128 + wc * 64, (size_t)ldc, lds + wid * (64 * 144), lane, [](int) { return true; });
  __syncthreads();
}
template <int NOSTORE = 0>
DI void ph_gemm_plain(const bf16_t* A, int lda, const bf16_t* Bt, int ldb, int M, int N, int K, bf16_t* C, int ldc, char* lds, int bid, int nblk) {
  const int ntn = N / 128, nt = (M / 128) * ntn;
  for (int u = bid; u < nt; u += nblk) { int tm, tn; grp_tile<8>(xcd_swz(u, nt), M / 128, ntn, tm, tn); gemm_plain_tile<NOSTORE>(A, lda, Bt, ldb, K, C, ldc, tm, tn, lds); }
}
DI void ph_mla_up(const Params& p, int layer, bf16_t* QRAW, bf16_t* KVRAW, char* lds, int bid, int nblk) {
  const int ntq = (R / 128) * 3, ntkv = (R / 128) * 4;
  for (int tile = bid; tile < ntq + ntkv; tile += nblk) {
    if (tile < ntq) gemm_plain_tile(p.Z + ZC_QLAT, NZP, p.Wt_uq + layer * WSZ_UQ, 256, 256, QRAW, 384, tile / 3, tile % 3, lds);
    else { int u = tile - ntq; gemm_plain_tile(p.Z + ZC_KVLAT, NZP, p.Wt_ukv + layer * WSZ_UKV, 128, 128, KVRAW, 512, u / 4, u % 4, lds); }
  }
}
constexpr int LROW32 = 80;
template <int WM, int WN, bool DEEP>
DI void gemm_kloop_g(f32x4 (&acc)[WM][WN], const bf16_t* const (&ap)[WM / 2], const bf16_t* const (&bp)[WN / 2], int nk, char* lds) {
  constexpr int NA = WM / 2, NBB = WN / 2, A_B = 32 * WM * LROW32, STAGE = (32 * WM + 32 * WN) * LROW32;
  const int t = TIDX, lane = t & 63, wid = t >> 6, wr = wid >> 1, wc = wid & 1, fr = lane & 15, fq = lane >> 4;
  const int aoff = (wr * 16 * WM + fr) * LROW32 + fq * 16, boff = A_B + (wc * 16 * WN + fr) * LROW32 + fq * 16, soff = (t >> 2) * LROW32 + (t & 3) * 16;
  u32x4 ra0[NA], rb0[NBB], ra1[NA], rb1[NBB];
  auto gload = [&](u32x4 (&ra)[NA], u32x4 (&rb)[NBB], int kt) {
#pragma unroll
    for (int i = 0; i < NA; ++i) ra[i] = ldg16(ap[i] + kt * 32);
#pragma unroll
    for (int i = 0; i < NBB; ++i) rb[i] = ldg16(bp[i] + kt * 32);
  };
  auto sstore = [&](const u32x4 (&ra)[NA], const u32x4 (&rb)[NBB], char* st) {
#pragma unroll
    for (int i = 0; i < NA; ++i) sts16(st + soff + 64 * i * LROW32, ra[i]);
#pragma unroll
    for (int i = 0; i < NBB; ++i) sts16(st + A_B + soff + 64 * i * LROW32, rb[i]);
  };
  auto compute = [&](const char* cur) {
    bf16x8 af[WM];
#pragma unroll
    for (int m = 0; m < WM; ++m) af[m] = lds_frag(cur + aoff + m * 16 * LROW32);
#pragma unroll
    for (int n = 0; n < WN; ++n) {
      const bf16x8 bfr = lds_frag(cur + boff + n * 16 * LROW32);
#pragma unroll
      for (int m = 0; m < WM; ++m) acc[m][n] = MFMA16(bfr, af[m], acc[m][n]);
    }
    IGLP_OPT();
  };
  gload(ra0, rb0, 0);
  if (DEEP) gload(ra1, rb1, 1);
  sstore(ra0, rb0, lds);
  __syncthreads();
#pragma unroll 1
  for (int kt = 0; kt < nk; kt += 2) {
    if (DEEP) { if (kt + 2 < nk) gload(ra0, rb0, kt + 2); } else gload(ra1, rb1, kt + 1);
    compute(lds);
    sstore(ra1, rb1, lds + STAGE);
    __syncthreads();
    if (DEEP) { if (kt + 3 < nk) gload(ra1, rb1, kt + 3); } else if (kt + 2 < nk) gload(ra0, rb0, kt + 2);
    compute(lds + STAGE);
    if (kt + 2 < nk) sstore(ra0, rb0, lds);
    __syncthreads();
  }
}
template <int WM, int WN> DI void acc_zero_g(f32x4 (&acc)[WM][WN]) {
#pragma unroll
  for (int m = 0; m < WM; ++m)
#pragma unroll
    for (int n = 0; n < WN; ++n) acc[m][n] = (f32x4){0.f, 0.f, 0.f, 0.f};
}
DI void ph_merge(const Params& p, int layer, int rows, char* lds, int bid, int nblk) {
  const int t = TIDX, lane = t & 63, wid = t >> 6, wr = wid >> 1, wc = wid & 1, fr = lane & 15, fq = lane >> 4;
  const int lr = t >> 2, lc = (t & 3) * 8;
  const int ntn = D / 64, nt = (rows / 128) * ntn;
#pragma unroll 1
  for (int u = bid; u < nt; u += nblk) {
    int tm, tn; grp_tile<4>(xcd_swz(u, nt), rows / 128, ntn, tm, tn);
    f32x4 accS[4][2]; acc_zero_g<4, 2>(accS);
#pragma unroll 1
    for (int np = 0; np < 2; ++np) {
      f32x4 accG[4][4]; acc_zero_g<4, 4>(accG);
      {
        const bf16_t* ap[2]; const bf16_t* bp[2];
#pragma unroll
        for (int i = 0; i < 2; ++i) ap[i] = p.H + (size_t)(tm * 128 + lr + 64 * i) * D + lc;
#pragma unroll
        for (int i = 0; i < 2; ++i) { const int rho = lr + 64 * i, wci = rho >> 6, n = 2 * np + ((rho >> 5) & 1), c = rho & 31;
          bp[i] = p.Wt_gate + layer * WSZ_GATE + ((size_t)n * 1024 + tn * 64 + wci * 32 + c) * D + lc; }
        gemm_kloop_g<4, 4, true>(accG, ap, bp, D / 32, lds);
      }
#pragma unroll 1
      for (int q = 0; q < 2; ++q) {
        const int n = 2 * np + q;
        f32x4 accP[4][2]; acc_zero_g<4, 2>(accP);
        const bf16_t* ap[2]; const bf16_t* bp[1];
#pragma unroll
        for (int i = 0; i < 2; ++i) ap[i] = p.Y + (size_t)(tm * 128 + lr + 64 * i) * D + n * 256 + lc;
        bp[0] = p.Wt_branch + layer * WSZ_BR + ((size_t)n * D + tn * 64 + lr) * 256 + lc;
        gemm_kloop_g<4, 2, false>(accP, ap, bp, 8, lds);
#pragma unroll
        for (int nn = 0; nn < 2; ++nn) {
          const f32x4 bv = *(const f32x4*)(p.b_gate + layer * 4096 + n * 1024 + tn * 64 + wc * 32 + nn * 16 + 4 * fq);
#pragma unroll
          for (int m = 0; m < 4; ++m)
#pragma unroll
            for (int j = 0; j < 4; ++j) { const float g = q ? accG[m][2 + nn][j] : accG[m][nn][j]; accS[m][nn][j] += accP[m][nn][j] * fast_rcp(1.0f + fast_exp2(-LOG2E * (g + bv[j]))); }
        }
      }
    }
    store_wave_tile<2>(accS, p.MG + (size_t)(tm * 128 + wr * 64) * D + tn * 64 + wc * 32, (size_t)D, lds + wid * (64 * 80), lane, [](int) { return true; });
    __syncthreads();
  }
}
template <int WM>
DI void gemm_plain_tile_g(const bf16_t* A, int lda, const bf16_t* Bt, int ldb, int K, bf16_t* C, int ldc, int row0, int col0, char* lds) {
  const int t = TIDX, lane = t & 63, wid = t >> 6, wr = wid >> 1, wc = wid & 1, fr = lane & 15, fq = lane >> 4, lr = t >> 2, lc = (t & 3) * 8;
  const bf16_t* ap[WM / 2]; const bf16_t* bp[2];
#pragma unroll
  for (int i = 0; i < WM / 2; ++i) ap[i] = A + (size_t)(row0 + lr + 64 * i) * lda + lc;
#pragma unroll
  for (int i = 0; i < 2; ++i) bp[i] = Bt + (size_t)(col0 + lr + 64 * i) * ldb + lc;
  f32x4 acc[WM][4]; acc_zero_g<WM, 4>(acc);
  gemm_kloop_g<WM, 4, true>(acc, ap, bp, K / 32, lds);
#pragma unroll
  for (int m = 0; m < WM; ++m)
#pragma unroll
    for (int n = 0; n < 4; ++n)
      st_bf16x4(C + (size_t)(row0 + wr * 16 * WM + m * 16 + fr) * ldc + col0 + wc * 64 + n * 16 + 4 * fq, acc[m][n]);
}
DI void ph_gemm_plain2(const bf16_t* A, int lda, const bf16_t* Bt, int ldb, int M, int N, int K, bf16_t* C, int ldc, char* lds, int bid, int nblk) {
  const int ntn = N / 128, nt = (M / 256) * ntn, nfull = (nt / nblk) * nblk;
#pragma unroll 1
  for (int tile = bid; tile < nfull; tile += nblk) gemm_plain_tile_g<8>(A, lda, Bt, ldb, K, C, ldc, (tile / ntn) * 256, (tile % ntn) * 128, lds);
#pragma unroll 1
  for (int h = bid; h < 2 * (nt - nfull); h += nblk) { const int tile = nfull + (h >> 1); gemm_plain_tile_g<4>(A, lda, Bt, ldb, K, C, ldc, (tile / ntn) * 256 + (h & 1) * 128, (tile % ntn) * 128, lds); }
}
DI void gemm_kloop32(f32x16 (&acc)[2][2], const bf16_t* const (&ap)[4], const bf16_t* const (&bp)[4], int nk, char* lds) {
  constexpr int STAGE = A_BYTES + 128 * LROW;
  const int t = TIDX, lane = t & 63, wid = t >> 6, wr = wid >> 1, wc = wid & 1, l31 = lane & 31, hh = lane >> 5;
  const int aoff = (wr * 64 + l31) * LROW + hh * 16, boff = A_BYTES + (wc * 64 + l31) * LROW + hh * 16, soff = (t >> 3) * LROW + (t & 7) * 16;
  u32x4 ra0[4], rb0[4], ra1[4], rb1[4];
  auto gload = [&](u32x4 (&ra)[4], u32x4 (&rb)[4], int kt) {
#pragma unroll
    for (int i = 0; i < 4; ++i) { ra[i] = ldg16(ap[i] + kt * 64); rb[i] = ldg16(bp[i] + kt * 64); }
  };
  auto sstore = [&](const u32x4 (&ra)[4], const u32x4 (&rb)[4], char* st) {
#pragma unroll
    for (int i = 0; i < 4; ++i) { sts16(st + soff + 32 * i * LROW, ra[i]); sts16(st + A_BYTES + soff + 32 * i * LROW, rb[i]); }
  };
  auto compute = [&](const char* cur) {
#pragma unroll
    for (int ks = 0; ks < 4; ++ks) {
      bf16x8 af[2], bfr[2];
#pragma unroll
      for (int m = 0; m < 2; ++m) af[m] = lds_frag(cur + aoff + m * 32 * LROW + ks * 32);
#pragma unroll
      for (int n = 0; n < 2; ++n) bfr[n] = lds_frag(cur + boff + n * 32 * LROW + ks * 32);
#pragma unroll
      for (int m = 0; m < 2; ++m)
#pragma unroll
        for (int n = 0; n < 2; ++n) acc[m][n] = MFMA32(bfr[n], af[m], acc[m][n]);
    }
  };
  gload(ra0, rb0, 0); gload(ra1, rb1, 1);
  sstore(ra0, rb0, lds);
  __syncthreads();
#pragma unroll 1
  for (int kt = 0; kt < nk; kt += 2) {
    if (kt + 2 < nk) gload(ra0, rb0, kt + 2);
    compute(lds);
    sstore(ra1, rb1, lds + STAGE);
    __syncthreads();
    if (kt + 3 < nk) gload(ra1, rb1, kt + 3);
    compute(lds + STAGE);
    if (kt + 2 < nk) sstore(ra0, rb0, lds);
    __syncthreads();
  }
}
DI void ph_gemm_plain32(const bf16_t* A, int lda, const bf16_t* Bt, int ldb, int M, int N, int K, bf16_t* C, int ldc, char* lds, int bid, int nblk) {
  const int t = TIDX, lane = t & 63, wid = t >> 6, wr = wid >> 1, wc = wid & 1, lr = t >> 3, lc = (t & 7) * 8, l31 = lane & 31, hh = lane >> 5;
  const int ntn = N / 128, nt = (M / 128) * ntn;
#pragma unroll 1
  for (int tile = bid; tile < nt; tile += nblk) {
    const int tm = tile / ntn, tn = tile % ntn;
    const bf16_t* ap[4]; const bf16_t* bp[4];
#pragma unroll
    for (int i = 0; i < 4; ++i) { ap[i] = A + (size_t)(tm * 128 + lr + 32 * i) * lda + lc; bp[i] = Bt + (size_t)(tn * 128 + lr + 32 * i) * ldb + lc; }
    f32x16 acc[2][2];
#pragma unroll
    for (int m = 0; m < 2; ++m)
#pragma unroll
      for (int n = 0; n < 2; ++n) acc[m][n] = (f32x16)(0.f);
    gemm_kloop32(acc, ap, bp, K / 64, lds);
#pragma unroll
    for (int m = 0; m < 2; ++m)
#pragma unroll
      for (int n = 0; n < 2; ++n)
#pragma unroll
        for (int g = 0; g < 4; ++g) {
          f32x4 o = {acc[m][n][4 * g], acc[m][n][4 * g + 1], acc[m][n][4 * g + 2], acc[m][n][4 * g + 3]};
          st_bf16x4(C + (size_t)(tm * 128 + wr * 64 + m * 32 + l31) * ldc + tn * 128 + wc * 64 + n * 32 + 8 * g + 4 * hh, o);
        }
  }
}
template <int MODE>
DI void ph_gemm_probe(const bf16_t* A, int lda, const bf16_t* Bt, int ldb, int M, int N, int K, float* sink, char* lds, int bid, int nblk) {
  const int t = TIDX, lane = t & 63, wid = t >> 6, wr = wid >> 1, wc = wid & 1, lr = t >> 3, lc = (t & 7) * 8, fr = lane & 15, fq = lane >> 4;
  const int ntn = N / 128, nt = (M / 128) * ntn, nk = K / 64;
  constexpr int STAGE = A_BYTES + 128 * LROW;
  const int aoff = (wr * 64 + fr) * LROW + fq * 16, boff = A_BYTES + (wc * 64 + fr) * LROW + fq * 16;
#pragma unroll 1
  for (int tile = bid; tile < nt; tile += nblk) {
    f32x4 acc[4][4]; acc_zero<4>(acc);
    bf16x8 af[4], bfr[4];
    const int tm = tile / ntn, tn = tile % ntn;
    const bf16_t* ap[4]; const bf16_t* bp[4];
#pragma unroll
    for (int i = 0; i < 4; ++i) { ap[i] = A + (size_t)(tm * 128 + lr + 32 * i) * lda + lc; bp[i] = Bt + (size_t)(tn * 128 + lr + 32 * i) * ldb + lc; }
    u32x4 ra[4], rb[4], junk = {0u, 0u, 0u, 0u};
#pragma unroll
    for (int i = 0; i < 4; ++i) { ra[i] = junk; rb[i] = junk; }
#pragma unroll 1
    for (int kt = 0; kt < nk; ++kt) {
      const char* cur = lds + (kt & 1) * STAGE;
#pragma unroll
      for (int i = 0; i < 4; ++i) { ra[i] = ldg16(ap[i] + kt * 64); if (MODE == 3) rb[i] = ldg16(bp[i] + kt * 64); }
#pragma unroll
      for (int ks = 0; ks < 2; ++ks) {
#pragma unroll
        for (int m = 0; m < 4; ++m) { af[m] = lds_frag(cur + aoff + m * 16 * LROW + ks * 64); bfr[m] = lds_frag(cur + boff + m * 16 * LROW + ks * 64); }
#pragma unroll
        for (int m = 0; m < 4; ++m)
#pragma unroll
          for (int n = 0; n < 4; ++n) acc[m][n] = MFMA16(bfr[n], af[m], acc[m][n]);
      }
      junk.x ^= ra[0].x ^ ra[1].y ^ ra[2].z ^ ra[3].w ^ rb[0].x ^ rb[1].y ^ rb[2].z ^ rb[3].w;
      __syncthreads();
    }
    float s = (float)(junk.x & 1u);
#pragma unroll
    for (int m = 0; m < 4; ++m)
#pragma unroll
      for (int n = 0; n < 4; ++n) s += acc[m][n][0] + acc[m][n][3];
    if (s == 123456.789f) sink[0] = s;
  }
}
DI void ph_moe1(const Params& p, int need_ctx, char* lds, int bid, int nblk) {
  const int t = TIDX, lane = t & 63, wid = t >> 6, wr = wid >> 1, wc = wid & 1, lr = t >> 3, lc = (t & 7) * 8, fr = lane & 15, fq = lane >> 4;
  constexpr int NTN = FF / 64;
  const int NTM = need_ctx ? (NSLOT + 127) / 128 : (NB * CAPL) / 128;
  for (int u = bid; u < NE * NTM * NTN; u += nblk) {
    const int tile = xcd_swz(u, NE * NTM * NTN), e = tile / (NTM * NTN), rem = tile % (NTM * NTN);
    int tm, tn, rr = rem, g = 0;
    if (rr >= NTM * 8) { rr -= NTM * 8; g = 1; }
    if (rr >= NTM * 8) { rr -= NTM * 8; g = 2; }
    if (g < 2) { tm = rr >> 3; tn = g * 8 + (rr & 7); } else { tm = rr / (NTN - 16); tn = 16 + rr - tm * (NTN - 16); }
    const bf16_t* ap[4]; const bf16_t* bp[4];
#pragma unroll
    for (int i = 0; i < 4; ++i) {
      const int slot = tm * 128 + lr + 32 * i;
      int r = slot < NSLOT ? p.SEL[(size_t)e * NSLOT + slot] : -1;
      ap[i] = p.H + (size_t)(r < 0 ? 0 : r) * D + lc;
      const int rho = lr + 32 * i, wci = rho >> 6, gu = (rho >> 5) & 1, col = wci * 32 + (rho & 31);
      bp[i] = (gu ? p.Wt_eu : p.Wt_eg) + ((size_t)e * FF + tn * 64 + col) * D + lc;
    }
    f32x4 acc[4][4]; acc_zero<4>(acc);
    gemm_kloop<4>(acc, ap, bp, D / 64, lds);
    f32x4 hid[4][2];
#pragma unroll
    for (int m = 0; m < 4; ++m) {
      const int slot = tm * 128 + wr * 64 + m * 16 + fr;
      const bool valid = slot < NSLOT && p.SEL[(size_t)e * NSLOT + (slot < NSLOT ? slot : 0)] >= 0;
#pragma unroll
      for (int n = 0; n < 2; ++n)
#pragma unroll
        for (int j = 0; j < 4; ++j) { const float g = acc[m][n][j], u = acc[m][n + 2][j]; hid[m][n][j] = valid ? g * u * fast_rcp(1.0f + fast_exp2(-LOG2E * g)) : 0.f; }
    }
    const int slot0 = tm * 128 + wr * 64;
    store_wave_tile<2>(hid, p.HID + ((size_t)e * NSLOT + slot0) * FF + tn * 64 + wc * 32, (size_t)FF, lds + wid * (64 * 80), lane, [&](int r) { return slot0 + r < NSLOT; });
    __syncthreads();
  }
}
DI void ph_moe2(const Params& p, int need_ctx, char* lds, int bid, int nblk) {
  const int t = TIDX, lane = t & 63, wid = t >> 6, wr = wid >> 1, wc = wid & 1, lr = t >> 3, lc = (t & 7) * 8, fr = lane & 15, fq = lane >> 4;
  constexpr int NTN = D / 128;
  const int NTM = need_ctx ? (NSLOT + 127) / 128 : (NB * CAPL) / 128;
  const int ntile = NE * NTM * NTN;
  auto ptrs = [&](int u, const bf16_t* (&ap)[4], const bf16_t* (&bp)[4]) __attribute__((always_inline)) {
    const int tile = xcd_swz(u, ntile), e = tile / (NTM * NTN), rem = tile % (NTM * NTN), tm = rem / NTN, tn = rem % NTN;
#pragma unroll
    for (int i = 0; i < 4; ++i) {
      int slot = tm * 128 + lr + 32 * i; if (slot >= NSLOT) slot = NSLOT - 1;
      ap[i] = p.HID + ((size_t)e * NSLOT + slot) * FF + lc;
      bp[i] = p.Wt_ed + ((size_t)e * D + tn * 128 + lr + 32 * i) * FF + lc;
    }
  };
  KRegs kr; bool pre = false;
#pragma unroll 1
  for (int u = bid; u < ntile; u += nblk) {
    const int tile = xcd_swz(u, ntile), e = tile / (NTM * NTN), rem = tile % (NTM * NTN), tm = rem / NTN, tn = rem % NTN;
    const bool has_next = u + nblk < ntile;
    const bf16_t* ap[4]; const bf16_t* bp[4];
    ptrs(u, ap, bp);
    f32x4 acc[4][4]; acc_zero<4>(acc);
    gemm_kloop_x(acc, ap, bp, FF / 64, lds, kr, pre, [&](const bf16_t* (&na)[4], const bf16_t* (&nb)[4]) __attribute__((always_inline)) { ptrs(u + nblk, na, nb); }, has_next);
    pre = has_next;
#pragma unroll
    for (int m = 0; m < 4; ++m) {
      const int slot = tm * 128 + wr * 64 + m * 16 + fr;
      const float val = (slot < NSLOT && p.SEL[(size_t)e * NSLOT + (slot < NSLOT ? slot : 0)] >= 0) ? p.SELV[(size_t)e * NSLOT + slot] : 0.f;
#pragma unroll
      for (int n = 0; n < 4; ++n) { acc[m][n].x *= val; acc[m][n].y *= val; acc[m][n].z *= val; acc[m][n].w *= val; }
    }
    const int slot0 = tm * 128 + wr * 64;
    store_wave_tile<4>(acc, p.YE + ((size_t)e * NSLOT + slot0) * D + tn * 128 + wc * 64, (size_t)D, lds + wid * (64 * 144), lane, [&](int r) { return slot0 + r < NSLOT; });
    __syncthreads();
  }
}
constexpr int GEMM_LDS = 2 * (A_BYTES + 128 * LROW);

DI void unpack8(u32x4 v, float (&f)[8]) {
  f[0] = u2f(v.x << 16); f[1] = u2f(v.x & 0xffff0000u); f[2] = u2f(v.y << 16); f[3] = u2f(v.y & 0xffff0000u);
  f[4] = u2f(v.z << 16); f[5] = u2f(v.z & 0xffff0000u); f[6] = u2f(v.w << 16); f[7] = u2f(v.w & 0xffff0000u);
}
DI u32x4 pack8f(const float (&f)[8]) { u32x4 v; v.x = pack2bf(f[0], f[1]); v.y = pack2bf(f[2], f[3]); v.z = pack2bf(f[4], f[5]); v.w = pack2bf(f[6], f[7]); return v; }
DI void rope8(float (&a)[8], const float (&pr)[8], int cc, const float* cs, const float* sn) {
  const int ax = (cc >> 1) * 8; const bool second = cc & 1;
#pragma unroll
  for (int i = 0; i < 8; ++i) a[i] = second ? a[i] * cs[ax + i] + pr[i] * sn[ax + i] : a[i] * cs[ax + i] - pr[i] * sn[ax + i];
}
constexpr int PREP_LDS = 64 * 4 + 2 * 512 * 4 + 32 * 528;
template <int PARTS = 3>
DI void ph_prep(const Params& p, int layer, const bf16_t* QRAW, const bf16_t* KVRAW, char* lds, int bid, int nblk) {
  float* s_rstd = (float*)lds;
  float* s_cs = s_rstd + 64;
  float* s_sn = s_cs + 512;
  bf16_t* s_t = (bf16_t*)(s_sn + 512);
  const int t = TIDX;
  constexpr int UPB = TK / 32, NU = NB * UPB;
  const float* wcv = p.w_conv + (size_t)layer * 3 * 512;
  f32x4 bcv[2], w0v[2], w1v[2], w2v[2];
  { const int c8 = (t & 63) * 8;
#pragma unroll
    for (int q = 0; q < 2; ++q) { bcv[q] = *(const f32x4*)(p.b_conv + layer * 512 + c8 + 4 * q); w0v[q] = *(const f32x4*)(wcv + c8 + 4 * q); w1v[q] = *(const f32x4*)(wcv + 512 + c8 + 4 * q); w2v[q] = *(const f32x4*)(wcv + 1024 + c8 + 4 * q); } }
#pragma unroll 1
  for (int u = bid; u < NU; u += nblk) {
    int b, s0;
    if (u < NB * (TL / 32)) { b = u / (TL / 32); s0 = TC + (u % (TL / 32)) * 32; } else { const int v = u - NB * (TL / 32); b = v / (TC / 32); s0 = (v % (TC / 32)) * 32; }
    const int r0 = row_of(b, s0);
    {
      const int tok = t >> 3, part = t & 7;
      const bf16_t* z = p.Z + (size_t)(r0 + tok) * NZP;
      float sq = 0.f, sk = 0.f, f[8];
#pragma unroll
      for (int k = 0; k < 4; ++k) { unpack8(ldg16(z + ZC_QLAT + part * 32 + k * 8), f);
#pragma unroll
        for (int i = 0; i < 8; ++i) sq += f[i] * f[i]; }
#pragma unroll
      for (int k = 0; k < 2; ++k) { unpack8(ldg16(z + ZC_KVLAT + part * 16 + k * 8), f);
#pragma unroll
        for (int i = 0; i < 8; ++i) sk += f[i] * f[i]; }
      sq = xor_sum<1>(sq); sk = xor_sum<1>(sk);
      sq = xor_sum<2>(sq); sk = xor_sum<2>(sk);
      sq = xor_sum<4>(sq); sk = xor_sum<4>(sk);
      if (part == 0) { s_rstd[tok * 2] = 1.0f / sqrtf(sq * (1.0f / 256) + 1e-6f); s_rstd[tok * 2 + 1] = 1.0f / sqrtf(sk * (1.0f / 128) + 1e-6f); }
    }
    for (int i = t; i < 512; i += NTHR) {
      const int tok = i >> 4, af = i & 15, s = s0 + tok;
      float cs = 1.f, sn = 0.f;
      if (s >= TC) rope_cs(s, (af >> 3) * 16 + (af & 7), cs, sn);
      s_cs[i] = cs; s_sn[i] = sn;
    }
    __syncthreads();
    if (PARTS & 1) {
#pragma unroll 2
    for (int i = t; i < 32 * 48; i += NTHR) {
      const int tok = i / 48, c = i % 48, h = c / 12, ch = c % 12;
      const float rq = s_rstd[tok * 2] * QS_MLA, rkv = s_rstd[tok * 2 + 1];
      const bf16_t* q = QRAW + (size_t)(r0 + tok) * 384 + h * 96;
      float a[8], pr[8];
      unpack8(ldg16(q + ch * 8), a);
      if (ch >= 8) { unpack8(ldg16(q + 64 + ((ch - 8) ^ 1) * 8), pr); rope8(a, pr, ch - 8, s_cs + tok * 16, s_sn + tok * 16); }
#pragma unroll
      for (int e = 0; e < 8; ++e) a[e] *= rq;
      *(u32x4*)(p.Qm + (((size_t)b * 4 + h) * TK + s0 + tok) * 96 + ch * 8) = pack8f(a);
      if (ch < 8) {
        unpack8(ldg16(KVRAW + (size_t)(r0 + tok) * 512 + h * 128 + ch * 8), a);
#pragma unroll
        for (int e = 0; e < 8; ++e) a[e] *= rkv;
      } else {
        const bf16_t* z = p.Z + (size_t)(r0 + tok) * NZP + ZC_KROPE;
        unpack8(ldg16(z + (ch - 8) * 8), a); unpack8(ldg16(z + ((ch - 8) ^ 1) * 8), pr);
        rope8(a, pr, ch - 8, s_cs + tok * 16, s_sn + tok * 16);
      }
      *(u32x4*)(p.Km + (((size_t)b * 4 + h) * TK + s0 + tok) * 96 + ch * 8) = pack8f(a);
    }
#pragma unroll 2
    for (int i = t; i < 32 * 64; i += NTHR) {
      const int tok = i >> 6, c = i & 63, qk = c >> 5, hm = (c >> 2) & 7, cc = c & 3;
      const bf16_t* src = p.Z + (size_t)(r0 + tok) * NZP + (qk ? ZC_DK : ZC_DQ) + hm * 32;
      float a[8], pr[8];
      unpack8(ldg16(src + cc * 8), a); unpack8(ldg16(src + (cc ^ 1) * 8), pr);
      rope8(a, pr, cc, s_cs + tok * 16, s_sn + tok * 16);
      if (qk == 0) {
#pragma unroll
        for (int e = 0; e < 8; ++e) a[e] *= QS_DIFF;
        *(u32x4*)(p.Qd + (((size_t)b * 8 + hm) * TK + s0 + tok) * 32 + cc * 8) = pack8f(a);
      } else *(u32x4*)(p.Kd + (((size_t)b * 8 + hm) * TK + s0 + tok) * 32 + cc * 8) = pack8f(a);
    }
#pragma unroll 2
    for (int i = t; i < 32 * 64; i += NTHR) {
      const int tok = i >> 6, c8 = (i & 63) * 8, s = s0 + tok;
      const bool first = (s == 0) || (s == TC), last = (s == TC - 1) || (s == TK - 1);
      const bf16_t* z = p.Z + (size_t)(r0 + tok) * NZP + ZC_MLQK + c8;
      float x0[8], xm[8], xp[8], o[8];
      unpack8(ldg16(z), x0);
      if (!first) unpack8(ldg16(z - NZP), xm);
      if (!last) unpack8(ldg16(z + NZP), xp);
#pragma unroll
      for (int e = 0; e < 8; ++e) {
        float acc = bcv[e >> 2][e & 3] + x0[e] * w1v[e >> 2][e & 3];
        if (!first) acc += xm[e] * w0v[e >> 2][e & 3];
        if (!last) acc += xp[e] * w2v[e >> 2][e & 3];
        o[e] = acc * fast_rcp(1.0f + fast_exp2(-LOG2E * acc));
      }
      if (c8 < 256) *(u32x4*)(p.MQ + ((size_t)b * TK + s) * 256 + c8) = pack8f(o);
      else {
#pragma unroll
        for (int e = 0; e < 8; ++e) o[e] *= 0.125f;
        *(u32x4*)(p.MK + ((size_t)b * TK + s) * 256 + c8 - 256) = pack8f(o);
      }
    }
    }
#pragma unroll 1
    for (int w = 0; w < ((PARTS & 2) ? 4 : 0); ++w) {
      __syncthreads();
#pragma unroll
      for (int k = 0; k < 4; ++k) {
        const int i = t + k * NTHR, tok = i >> 5, c8 = (i & 31) * 8;
        u32x4 v;
        if (w == 0) { float a[8]; const int h = c8 >> 6; unpack8(ldg16(KVRAW + (size_t)(r0 + tok) * 512 + h * 128 + 64 + (c8 & 63)), a); const float rkv = s_rstd[tok * 2 + 1];
#pragma unroll
          for (int e = 0; e < 8; ++e) a[e] *= rkv;
          v = pack8f(a); }
        else v = ldg16(p.Z + (size_t)(r0 + tok) * NZP + (w == 1 ? ZC_DV : (w == 2 ? ZC_MLV : ZC_GV)) + c8);
        *(u32x4*)(s_t + tok * 264 + c8) = v;
      }
      __syncthreads();
      bf16_t* dst = w == 0 ? p.Vtm : (w == 1 ? p.Vtd : (w == 2 ? p.MVt : p.GVt));
#pragma unroll
      for (int k = 0; k < 4; ++k) {
        const int i = t + k * NTHR, tg = i & 3, ch = i >> 2;
        u32x4 v;
        v.x = (unsigned)s_t[(tg * 8 + 0) * 264 + ch] | ((unsigned)s_t[(tg * 8 + 1) * 264 + ch] << 16);
        v.y = (unsigned)s_t[(tg * 8 + 2) * 264 + ch] | ((unsigned)s_t[(tg * 8 + 3) * 264 + ch] << 16);
        v.z = (unsigned)s_t[(tg * 8 + 4) * 264 + ch] | ((unsigned)s_t[(tg * 8 + 5) * 264 + ch] << 16);
        v.w = (unsigned)s_t[(tg * 8 + 6) * 264 + ch] | ((unsigned)s_t[(tg * 8 + 7) * 264 + ch] << 16);
        *(u32x4*)(dst + (((size_t)b * 4 + (ch >> 6)) * 64 + (ch & 63)) * TK + s0 + tg * 8) = v;
      }
    }
    __syncthreads();
  }
}
constexpr int VROW = 136;
constexpr int VROW_A = 144;
template <int DQK> struct AttnCfg {
  static constexpr int KROW = DQK * 2 + 16;
  static constexpr int KBYTES = 64 * KROW, VBYTES = 64 * VROW_A, STAGE = KBYTES + VBYTES;
  static constexpr int KCH = 64 * DQK * 2 / 16 / NTHR;
};
DI bf16x8 pack8(const f32x16& x, int s) {
  u32x4 pk; pk.x = pack2bf(x[8 * s], x[8 * s + 1]); pk.y = pack2bf(x[8 * s + 2], x[8 * s + 3]); pk.z = pack2bf(x[8 * s + 4], x[8 * s + 5]); pk.w = pack2bf(x[8 * s + 6], x[8 * s + 7]);
  return __builtin_bit_cast(bf16x8, pk);
}
struct TrueC { static constexpr bool value = true; };
struct FalseC { static constexpr bool value = false; };
template <int DQK, int NMAP, int VAR = 0>
DI void attn_unit(const bf16_t* __restrict__ Qb, const bf16_t* __restrict__ Kb, size_t mstride, const bf16_t* __restrict__ Vt, int q0, int nkeys,
                  f32x16 (&O)[NMAP][2], float (&lsum)[NMAP], char* lds) {
  constexpr int DM = DQK / NMAP;
  constexpr int KS = DM / 16;
  using C = AttnCfg<DQK>;
  constexpr int CPM = 64 * DM * 2 / 16;
  constexpr int CPR = DM * 2 / 16;
  const int t = TIDX, lane = t & 63, wid = t >> 6, l31 = lane & 31, hh = lane >> 5;
  bf16x8 qf[NMAP][KS];
#pragma unroll
  for (int m = 0; m < NMAP; ++m)
#pragma unroll
    for (int ks = 0; ks < KS; ++ks) qf[m][ks] = *(const bf16x8*)(Qb + m * mstride + (size_t)(q0 + wid * 32 + l31) * DM + ks * 16 + 8 * hh);
  float mref[NMAP];
  f32x4 lacc[NMAP];
  const short onev = ((lane & 15) < 2 && ((lane >> 4) & 1) == (lane & 15)) ? (short)0x3F80 : (short)0;
  const bf16x8 ones_a = {onev, onev, onev, onev, onev, onev, onev, onev};
#pragma unroll
  for (int m = 0; m < NMAP; ++m) { mref[m] = 0.f; lacc[m] = (f32x4){0.f, 0.f, 0.f, 0.f}; O[m][0] = (f32x16)(0.f); O[m][1] = (f32x16)(0.f); }
  u32x4 rk[C::KCH], rv[2];
  const bf16_t* kg[C::KCH]; int klds[C::KCH];
#pragma unroll
  for (int i = 0; i < C::KCH; ++i) { const int c = t + i * NTHR, m = c / CPM, cc = c % CPM; kg[i] = Kb + m * mstride + cc * 8; klds[i] = (cc / CPR) * C::KROW + m * DM * 2 + (cc % CPR) * 16; }
  const bf16_t* vg = Vt + (size_t)(t >> 3) * TK + (t & 7) * 8;
  const int vlds = C::KBYTES + (t >> 3) * VROW_A + ((t & 7) >> 1) * 32 + ((t & 1) ? 8 : 0);
  const int kfoff = l31 * C::KROW + 16 * hh, vfoff = C::KBYTES + l31 * VROW_A + 16 * hh;
  const int nt = nkeys / 64;
#pragma unroll
  for (int i = 0; i < C::KCH; ++i) rk[i] = ldg16(kg[i]);
  rv[0] = ldg16(vg); rv[1] = ldg16(vg + (size_t)32 * TK);
  auto tile = [&](const int kt, auto chk_c, auto ref_c) __attribute__((always_inline)) {
    constexpr bool CHK = decltype(chk_c)::value, REF = decltype(ref_c)::value;
    char* cur = lds + (kt & 1) * C::STAGE;
    if (VAR != 2) {
#pragma unroll
    for (int i = 0; i < C::KCH; ++i) sts16(cur + klds[i], rk[i]);
#pragma unroll
    for (int i = 0; i < 2; ++i) { char* d = cur + vlds + i * 32 * VROW_A; u32x2 lo, hi; lo.x = rv[i].x; lo.y = rv[i].y; hi.x = rv[i].z; hi.y = rv[i].w; *(u32x2*)d = lo; *(u32x2*)(d + 16) = hi; }
    __syncthreads();
    }
    if (VAR != 2 && kt + 1 < nt) {
      const int kn = VAR == 3 ? ((kt + 1) & 1) : kt + 1;
#pragma unroll
      for (int i = 0; i < C::KCH; ++i) rk[i] = ldg16(kg[i] + (size_t)kn * 64 * DM);
      rv[0] = ldg16(vg + kn * 64); rv[1] = ldg16(vg + (size_t)32 * TK + kn * 64);
    }
    bf16x8 kf[NMAP][2][KS];
#pragma unroll
    for (int k2 = 0; k2 < 2; ++k2)
#pragma unroll
      for (int ks = 0; ks < KS; ++ks) kf[0][k2][ks] = lds_frag(cur + kfoff + k2 * 32 * C::KROW + ks * 32);
    f32x16 S[NMAP][2];
    S[0][0] = (f32x16)(0.f); S[0][1] = (f32x16)(0.f);
#pragma unroll
    for (int ks = 0; ks < KS; ++ks)
#pragma unroll
      for (int k2 = 0; k2 < 2; ++k2) S[0][k2] = MFMA32(kf[0][k2][ks], qf[0][ks], S[0][k2]);
    bf16x8 vf[4][2];
#pragma unroll
    for (int kst = 0; kst < 4; ++kst)
#pragma unroll
      for (int dvt = 0; dvt < 2; ++dvt) vf[kst][dvt] = lds_frag(cur + vfoff + dvt * 32 * VROW_A + kst * 32);
#pragma unroll
    for (int m = 1; m < NMAP; ++m)
#pragma unroll
      for (int k2 = 0; k2 < 2; ++k2)
#pragma unroll
        for (int ks = 0; ks < KS; ++ks) kf[m][k2][ks] = lds_frag(cur + kfoff + k2 * 32 * C::KROW + m * DM * 2 + ks * 32);
#pragma unroll
    for (int m = 0; m < NMAP; ++m) {
      if (m > 0) {
        SCHED_BARRIER();
        S[m][0] = (f32x16)(0.f); S[m][1] = (f32x16)(0.f);
#pragma unroll
        for (int ks = 0; ks < KS; ++ks)
#pragma unroll
          for (int k2 = 0; k2 < 2; ++k2) S[m][k2] = MFMA32(kf[m][k2][ks], qf[m][ks], S[m][k2]);
      }
      if (VAR != 1) {
      if (CHK && (kt & 7) == 0) {
        float mx = fmaxf(S[m][0][0], S[m][1][0]);
#pragma unroll
        for (int i = 1; i < 16; ++i) mx = fmaxf(mx, fmaxf(S[m][0][i], S[m][1][i]));
        mx = xor_max<32>(mx);
        const float rel = mx - mref[m];
        const float delta = (kt == 0) ? ((mx > ATT_THR || mx < -ATT_THR) ? mx : 0.0f) : (rel > ATT_THR ? rel : 0.0f);
        if (wave_any(delta != 0.0f)) {
          const float alpha = fast_exp2(-delta);
          mref[m] += delta; lacc[m][0] *= alpha; lacc[m][1] *= lane_get(alpha, (lane & 15) + 16);
#pragma unroll
          for (int dvt = 0; dvt < 2; ++dvt)
#pragma unroll
            for (int i = 0; i < 16; ++i) O[m][dvt][i] *= alpha;
        }
      }
      if constexpr (REF) {
        if (wave_any(mref[m] != 0.0f)) {
          const f32x2 nm = {-mref[m], -mref[m]};
#pragma unroll
          for (int k2 = 0; k2 < 2; ++k2)
#pragma unroll
            for (int i = 0; i < 16; i += 2) { const f32x2 x = (f32x2){S[m][k2][i], S[m][k2][i + 1]} + nm; S[m][k2][i] = x.x; S[m][k2][i + 1] = x.y; }
        }
      }
#pragma unroll
      for (int k2 = 0; k2 < 2; ++k2)
#pragma unroll
        for (int i = 0; i < 16; ++i) S[m][k2][i] = fast_exp2(S[m][k2][i]);
      }
#pragma unroll
      for (int kst = 0; kst < 4; ++kst) {
        const bf16x8 pf = pack8(S[m][kst >> 1], kst & 1);
#pragma unroll
        for (int dvt = 0; dvt < 2; ++dvt) O[m][dvt] = MFMA32(vf[kst][dvt], pf, O[m][dvt]);
        lacc[m] = MFMA16(ones_a, pf, lacc[m]);
      }
    }
  };
  int kt = 0;
#pragma unroll 1
  while (kt < nt) {
    tile(kt, TrueC{}, TrueC{});
    ++kt;
    bool nz = false;
#pragma unroll
    for (int m = 0; m < NMAP; ++m) nz = nz || (mref[m] != 0.0f);
    if (!wave_any(nz)) {
      const int k8 = (kt + 7) & ~7, kend = k8 < nt ? k8 : nt;
#pragma unroll 1
      for (; kt < kend; ++kt) tile(kt, FalseC{}, FalseC{});
    }
  }
  __syncthreads();
#pragma unroll
  for (int m = 0; m < NMAP; ++m) { const float a0 = lane_get(lacc[m][0], lane & 15), a1 = lane_get(lacc[m][1], lane & 15); lsum[m] = l31 < 16 ? a0 : a1; }
}
constexpr int ATT_QB = TK / 128;
constexpr int ATT_LDS = 2 * AttnCfg<96>::STAGE;
constexpr int ATT_QBL = TL / 128, ATT_QBC = TC / 128, ATT_LAT_UNITS = NB * 4 * ATT_QBL, ATT_UNITS = ATT_LAT_UNITS + NB * 4 * ATT_QBC;
DI void att_unit(int u, int& bh, int& qb) {
  if (u < ATT_LAT_UNITS) { bh = u & 7; qb = ATT_QBC + (u >> 3); } else { const int v = u - ATT_LAT_UNITS; bh = v & 7; qb = v >> 3; }
}
DI void ph_attn_diff(const Params& p, int layer, int need_ctx, char* lds, int bid, int nblk) {
  const int lane = TIDX & 63, wid = TIDX >> 6, l31 = lane & 31, hh = lane >> 5;
  float lam_init; const float lam = lam_of(p, layer, lam_init);
#pragma unroll 1
  for (int u = bid; u < (need_ctx ? ATT_UNITS : ATT_LAT_UNITS); u += nblk) {
    int bh, qb; att_unit(u, bh, qb);
    const int b = bh >> 2, h = bh & 3, q0 = qb * 128;
    const int r = row_of(b, q0 + wid * 32 + l31);
    f32x16 O[2][2]; float ls[2];
    attn_unit<64, 2>(p.Qd + ((size_t)b * 8 + h * 2) * TK * 32, p.Kd + ((size_t)b * 8 + h * 2) * TK * 32, (size_t)TK * 32, p.Vtd + ((size_t)b * 4 + h) * 64 * TK, q0,
                     q0 < TC ? TC : TK, O, ls, lds);
    const float i0 = 1.0f / ls[0], i1 = lam / ls[1];
    float ss = 0.f;
#pragma unroll
    for (int dvt = 0; dvt < 2; ++dvt)
#pragma unroll
      for (int i = 0; i < 16; ++i) { const float o = O[0][dvt][i] * i0 - O[1][dvt][i] * i1; O[0][dvt][i] = o; ss += o * o; }
    ss = xor_sum<32>(ss);
    const float rstd = (1.0f - lam_init) / sqrtf(ss * (1.0f / 64) + 1e-6f);
    const float* gd = p.g_diff_out + layer * 256 + h * 64;
#pragma unroll
    for (int dvt = 0; dvt < 2; ++dvt)
#pragma unroll
      for (int g = 0; g < 4; ++g) {
        const int dv = dvt * 32 + 8 * g + 4 * hh;
        const f32x4 gv = *(const f32x4*)(gd + dv);
        f32x4 o = {O[0][dvt][4 * g] * rstd * gv[0], O[0][dvt][4 * g + 1] * rstd * gv[1], O[0][dvt][4 * g + 2] * rstd * gv[2], O[0][dvt][4 * g + 3] * rstd * gv[3]};
        st_bf16x4(p.Y + (size_t)r * D + 768 + h * 64 + dv, o);
      }
  }
}
DI void ph_attn_mla(const Params& p, int need_ctx, char* lds, int bid, int nblk) {
  const int lane = TIDX & 63, wid = TIDX >> 6, l31 = lane & 31, hh = lane >> 5;
#pragma unroll 1
  for (int u = bid; u < (need_ctx ? ATT_UNITS : ATT_LAT_UNITS); u += nblk) {
    int bh, qb; att_unit(u, bh, qb);
    const int b = bh >> 2, h = bh & 3, q0 = qb * 128;
    const int r = row_of(b, q0 + wid * 32 + l31);
    f32x16 O[1][2]; float ls[1];
    attn_unit<96, 1>(p.Qm + ((size_t)b * 4 + h) * TK * 96, p.Km + ((size_t)b * 4 + h) * TK * 96, 0, p.Vtm + ((size_t)b * 4 + h) * 64 * TK, q0, q0 < TC ? TC : TK, O, ls, lds);
    const float inv = 1.0f / ls[0];
#pragma unroll
    for (int dvt = 0; dvt < 2; ++dvt)
#pragma unroll
      for (int g = 0; g < 4; ++g) {
        f32x4 o = {O[0][dvt][4 * g] * inv, O[0][dvt][4 * g + 1] * inv, O[0][dvt][4 * g + 2] * inv, O[0][dvt][4 * g + 3] * inv};
        st_bf16x4(p.Y + (size_t)r * D + h * 64 + dvt * 32 + 8 * g + 4 * hh, o);
      }
  }
}
template <int VAR> DI void ph_attn_mla_probe(const Params& p, char* lds, int bid, int nblk) {
  const int lane = TIDX & 63, wid = TIDX >> 6, l31 = lane & 31, hh = lane >> 5;
#pragma unroll 1
  for (int u = bid; u < ATT_LAT_UNITS; u += nblk) {
    int bh, qb; att_unit(u, bh, qb);
    const int b = bh >> 2, h = bh & 3, q0 = qb * 128;
    const int r = row_of(b, q0 + wid * 32 + l31);
    f32x16 O[1][2]; float ls[1];
    attn_unit<96, 1, VAR>(p.Qm + ((size_t)b * 4 + h) * TK * 96, p.Km + ((size_t)b * 4 + h) * TK * 96, 0, p.Vtm + ((size_t)b * 4 + h) * 64 * TK, q0, TK, O, ls, lds);
    const float inv = 1.0f / ls[0];
#pragma unroll
    for (int dvt = 0; dvt < 2; ++dvt)
#pragma unroll
      for (int g = 0; g < 4; ++g) {
        f32x4 o = {O[0][dvt][4 * g] * inv, O[0][dvt][4 * g + 1] * inv, O[0][dvt][4 * g + 2] * inv, O[0][dvt][4 * g + 3] * inv};
        *(f32x4*)(p.out + (size_t)r * D + h * 64 + dvt * 32 + 8 * g + 4 * hh) = o;
      }
  }
}
DI void ph_attn(const Params& p, int layer, int need_ctx, char* lds, int bid, int nblk) {
  ph_attn_diff(p, layer, need_ctx, lds, bid, nblk);
  ph_attn_mla(p, need_ctx, lds, bid, nblk);
}

DI float wave_sum(float v) {
  v = xor_sum<1>(v); v = xor_sum<2>(v); v = xor_sum<4>(v); v = xor_sum<8>(v); v = xor_sum<16>(v); v = xor_sum<32>(v);
  return v;
}
DI void ld_row16(const float* row, int lane, f32x4 (&v)[4]) {
#pragma unroll
  for (int i = 0; i < 4; ++i) v[i] = *(const f32x4*)(row + 256 * i + 4 * lane);
}
DI void ld_row16_bf(const bf16_t* row, int lane, f32x4 (&v)[4]) {
#pragma unroll
  for (int i = 0; i < 4; ++i) { const u32x2 u = *(const u32x2*)(row + 256 * i + 4 * lane); v[i] = (f32x4){u2f(u.x << 16), u2f(u.x & 0xffff0000u), u2f(u.y << 16), u2f(u.y & 0xffff0000u)}; }
}
DI void ph_modulate(const Params& p, int layer, const float* xl, const float* xcx, int bid, int nblk) {
  const int lane = TIDX & 63, wid = TIDX >> 6;
  const float* g = p.g_mix_pre + layer * 1024;
  int wprev = -1;
  f32x4 gs[4], sh[4];
  for (int r = bid * 4 + wid; r < R; r += nblk * 4) {
    const int w = r < RL ? r / TL : 2;
    const float* x = r < RL ? xl + (size_t)r * D : xcx + (size_t)(r - RL) * D;
    f32x4 xv[4];
    ld_row16(x, lane, xv);
    if (w != wprev) {
      const float* mb = p.mods + (size_t)(layer * 3 + w) * 6144;
      f32x4 gv[4], sc[4];
      ld_row16(g, lane, gv); ld_row16(mb + 1024, lane, sc); ld_row16(mb, lane, sh);
#pragma unroll
      for (int i = 0; i < 4; ++i) gs[i] = gv[i] * (sc[i] + 1.0f);
      wprev = w;
    }
    float ss = 0.f;
#pragma unroll
    for (int i = 0; i < 4; ++i)
#pragma unroll
      for (int e = 0; e < 4; ++e) ss += xv[i][e] * xv[i][e];
    const float rstd = 1.0f / sqrtf(wave_sum(ss) * (1.0f / D) + 1e-6f);
#pragma unroll
    for (int i = 0; i < 4; ++i) {
      f32x4 o;
#pragma unroll
      for (int e = 0; e < 4; ++e) o[e] = xv[i][e] * rstd * gs[i][e] + sh[i][e];
      st_bf16x4(p.H + (size_t)r * D + 256 * i + 4 * lane, o);
    }
  }
}
DI void ph_resid_mix(const Params& p, int layer, const float* xl_in, const float* xc_in, int rows, char* lds, int bid, int nblk) {
  const int lane = TIDX & 63, wid = TIDX >> 6;
  const float* wr = p.w_router + (size_t)layer * D * 16;
  for (int i = TIDX; i < D * 4; i += NTHR) { const int k = i >> 2, q = i & 3; *(f32x4*)(lds + k * 64 + (k >> 2) * 16 + q * 16) = *(const f32x4*)(wr + k * 16 + q * 4); }
  __syncthreads();
  int wprev = -1;
  f32x4 ac[4], gs[4], s3[4];
  const int rpb = (rows + nblk - 1) / nblk, rend = (bid + 1) * rpb < rows ? (bid + 1) * rpb : rows;
  for (int r = bid * rpb + wid; r < rend; r += 4) {
    const int w = r < RL ? r / TL : 2;
    const float* xin = r < RL ? xl_in + (size_t)r * D : xc_in + (size_t)(r - RL) * D;
    float* xo = r < RL ? p.out + (size_t)r * D : p.xc + (size_t)(r - RL) * D;
    f32x4 yv[4], xv[4];
    ld_row16_bf(p.YO + (size_t)r * D, lane, yv); ld_row16(xin, lane, xv);
    if (w != wprev) {
      const float* mb = p.mods + (size_t)(layer * 3 + w) * 6144;
      f32x4 a[4], c[4];
      ld_row16(mb + 2 * 1024, lane, a); ld_row16(p.g_mix_post + layer * 1024, lane, c);
#pragma unroll
      for (int i = 0; i < 4; ++i) ac[i] = a[i] * c[i];
      ld_row16(p.g_ffn_pre + layer * 1024, lane, a); ld_row16(mb + 4 * 1024, lane, c); ld_row16(mb + 3 * 1024, lane, s3);
#pragma unroll
      for (int i = 0; i < 4; ++i) gs[i] = a[i] * (c[i] + 1.0f);
      wprev = w;
    }
    float ss = 0.f;
#pragma unroll
    for (int i = 0; i < 4; ++i)
#pragma unroll
      for (int e = 0; e < 4; ++e) ss += yv[i][e] * yv[i][e];
    const float rstd = 1.0f / sqrtf(wave_sum(ss) * (1.0f / D) + 1e-6f);
    float s2 = 0.f;
#pragma unroll
    for (int i = 0; i < 4; ++i) {
#pragma unroll
      for (int e = 0; e < 4; ++e) { xv[i][e] += ac[i][e] * yv[i][e] * rstd; s2 += xv[i][e] * xv[i][e]; }
      *(f32x4*)(xo + 256 * i + 4 * lane) = xv[i];
    }
    const float rstd2 = 1.0f / sqrtf(wave_sum(s2) * (1.0f / D) + 1e-6f);
    float lg[16];
#pragma unroll
    for (int e = 0; e < 16; ++e) lg[e] = 0.f;
#pragma unroll
    for (int i = 0; i < 4; ++i) {
      f32x4 h2;
#pragma unroll
      for (int e = 0; e < 4; ++e) h2[e] = xv[i][e] * rstd2 * gs[i][e] + s3[i][e];
      st_bf16x4(p.H + (size_t)r * D + 256 * i + 4 * lane, h2);
#pragma unroll
      for (int e = 0; e < 4; ++e) {
        const char* wk = lds + (256 * i + 4 * lane + e) * 64 + (64 * i + lane) * 16;
#pragma unroll
        for (int q = 0; q < 4; ++q) { const f32x4 wv = *(const f32x4*)(wk + 16 * q); lg[4 * q] += h2[e] * wv[0]; lg[4 * q + 1] += h2[e] * wv[1]; lg[4 * q + 2] += h2[e] * wv[2]; lg[4 * q + 3] += h2[e] * wv[3]; }
      }
    }
#pragma unroll
    for (int e = 0; e < 16; ++e) lg[e] = wave_sum(lg[e]);
    float mx = lg[0];
#pragma unroll
    for (int e = 1; e < 16; ++e) mx = fmaxf(mx, lg[e]);
    float sm = 0.f;
#pragma unroll
    for (int e = 0; e < 16; ++e) { lg[e] = expf(lg[e] - mx); sm += lg[e]; }
    int b, s; bs_of(r, b, s);
    float mine = 0.f;
#pragma unroll
    for (int e = 0; e < 16; ++e) mine = (lane == e) ? lg[e] / sm : mine;
    if (lane < 16) p.AFF[((size_t)b * NE + lane) * TK + s] = mine;
  }
}
DI void ph_resid_ffn(const Params& p, int layer, int rows, int bid, int nblk) {
  const int lane = TIDX & 63, wid = TIDX >> 6;
  int r = bid * 4 + wid;
  int inv_n = (r < rows && lane < NE) ? p.INV[(size_t)lane * R + r] : -1;
  int wprev = -1;
  f32x4 ac[4], gs[4], sh[4];
#pragma unroll 1
  for (; r < rows; r += nblk * 4) {
    const int w = r < RL ? r / TL : 2;
    if (w != wprev) {
      const float* mb = p.mods + (size_t)(layer * 3 + w) * 6144;
      f32x4 a[4], c[4];
      ld_row16(mb + 5 * 1024, lane, a); ld_row16(p.g_ffn_post + layer * 1024, lane, c);
#pragma unroll
      for (int i = 0; i < 4; ++i) ac[i] = a[i] * c[i];
      if (layer == 0) {
        const float* mb1 = p.mods + (size_t)(3 + w) * 6144;
        ld_row16(p.g_mix_pre + 1024, lane, a); ld_row16(mb1 + 1024, lane, c); ld_row16(mb1, lane, sh);
#pragma unroll
        for (int i = 0; i < 4; ++i) gs[i] = a[i] * (c[i] + 1.0f);
      }
      wprev = w;
    }
    float* xo = r < RL ? p.out + (size_t)r * D : p.xc + (size_t)(r - RL) * D;
    const int myinv = inv_n;
    { const int rn = r + nblk * 4; inv_n = (rn < rows && lane < NE) ? p.INV[(size_t)lane * R + rn] : -1; }
    f32x4 f[4], xv[4];
    ld_row16(xo, lane, xv);
#pragma unroll
    for (int i = 0; i < 4; ++i) f[i] = (f32x4){0.f, 0.f, 0.f, 0.f};
    unsigned mask = wave_ballot16(myinv >= 0);
#pragma unroll 1
    while (mask) {
      const int e0 = __builtin_ctz(mask); mask &= mask - 1;
      const bool two = mask != 0u;
      const int e1 = two ? __builtin_ctz(mask) : e0; if (two) mask &= mask - 1;
      const int s0 = lane_bcast(myinv, e0), s1 = lane_bcast(myinv, e1);
      f32x4 y0[4], y1[4];
      ld_row16_bf(p.YE + ((size_t)e0 * NSLOT + s0) * D, lane, y0); ld_row16_bf(p.YE + ((size_t)e1 * NSLOT + s1) * D, lane, y1);
      const float w1 = two ? 1.0f : 0.0f;
#pragma unroll
      for (int i = 0; i < 4; ++i) f[i] += y0[i] + y1[i] * w1;
    }
    float ss = 0.f;
#pragma unroll
    for (int i = 0; i < 4; ++i)
#pragma unroll
      for (int e = 0; e < 4; ++e) ss += f[i][e] * f[i][e];
    const float rstd = 1.0f / sqrtf(wave_sum(ss) * (1.0f / D) + 1e-6f);
    float s2 = 0.f;
#pragma unroll
    for (int i = 0; i < 4; ++i) {
#pragma unroll
      for (int e = 0; e < 4; ++e) { xv[i][e] += ac[i][e] * f[i][e] * rstd; s2 += xv[i][e] * xv[i][e]; }
      *(f32x4*)(xo + 256 * i + 4 * lane) = xv[i];
    }
    if (layer == 0) {
      const float rstd2 = 1.0f / sqrtf(wave_sum(s2) * (1.0f / D) + 1e-6f);
#pragma unroll
      for (int i = 0; i < 4; ++i) {
        f32x4 o;
#pragma unroll
        for (int e = 0; e < 4; ++e) o[e] = xv[i][e] * rstd2 * gs[i][e] + sh[i][e];
        st_bf16x4(p.H + (size_t)r * D + 256 * i + 4 * lane, o);
      }
    }
  }
}
DI void ph_mods(const Params& p, char* lds, int bid, int nblk) {
  float* sc = (float*)lds;
  const int t = TIDX;
  for (int i = t; i < 3 * 1024; i += NTHR) { const float v = i < 2048 ? p.c[i] : p.c_ctx[i - 2048]; sc[i] = v / (1.0f + expf(-v)); }
  __syncthreads();
#pragma unroll 1
  for (long gi = (long)bid * NTHR + t; gi < 2 * 3 * 6144; gi += (long)nblk * NTHR) {
    const int col = (int)(gi % 6144), w = (int)((gi / 6144) % 3), l = (int)(gi / (3 * 6144));
    const float* W = p.w_ada + (size_t)l * 1024 * 6144 + col; const float* s = sc + w * 1024;
    float acc[8];
#pragma unroll
    for (int q = 0; q < 8; ++q) acc[q] = 0.f;
#pragma unroll 1
    for (int k = 0; k < 1024; k += 8) {
#pragma unroll
      for (int q = 0; q < 8; ++q) acc[q] += s[k + q] * W[(size_t)(k + q) * 6144];
    }
    p.mods[gi] = ((acc[0] + acc[1]) + (acc[2] + acc[3])) + ((acc[4] + acc[5]) + (acc[6] + acc[7])) + p.b_ada[l * 6144 + col];
  }
  __syncthreads();
}
constexpr int TOPK_LDS = TL * 4 + 2048;
DI int block_sum_i(int v, int* red) {
  const int lane = TIDX & 63, wid = TIDX >> 6;
  v = xor_sum_i<1>(v); v = xor_sum_i<2>(v); v = xor_sum_i<4>(v); v = xor_sum_i<8>(v); v = xor_sum_i<16>(v); v = xor_sum_i<32>(v);
  __syncthreads();
  if (lane == 0) red[wid] = v;
  __syncthreads();
  return red[0] + red[1] + red[2] + red[3];
}
DI int block_excl_scan(int v, int* red) {
  const int lane = TIDX & 63, wid = TIDX >> 6;
  int inc = v;
#pragma unroll
  for (int d = 1; d < 64; d <<= 1) { const int o = lane_up(inc, d, lane); if (lane >= d) inc += o; }
  __syncthreads();
  if (lane == 63) red[wid] = inc;
  __syncthreads();
  int base = 0;
  for (int q = 0; q < wid; ++q) base += red[q];
  return base + inc - v;
}
DI void ph_topk(const Params& p, int need_ctx, char* lds, int bid, int nblk) {
  unsigned* vals = (unsigned*)lds; int* red = (int*)(lds + TL * 4 + 1024);
  const int t = TIDX;
  for (int u = bid; u < NB * NE * 2; u += nblk) {
    const int seg = u & 1, e = (u >> 1) % NE, b = u / (2 * NE);
    const int s0 = seg ? TC : 0, n = seg ? TL : TC, cap = seg ? CAPL : CAPC, slot0 = seg ? b * CAPL : NB * CAPL + b * CAPC;
    if (seg == 0 && !need_ctx) { for (int q = t; q < cap; q += NTHR) p.SEL[(size_t)e * NSLOT + slot0 + q] = -1; continue; }
    const float* a = p.AFF + ((size_t)b * NE + e) * TK + s0;
    const int vpt = (n + NTHR - 1) / NTHR, i0 = t * vpt, i1 = (i0 + vpt < n) ? i0 + vpt : n;
    for (int i = t; i < n; i += NTHR) vals[i + i / vpt] = f2u(a[i]);
    __syncthreads();
    unsigned thr = 0;
    for (int bit = 31; bit >= 0; --bit) {
      const unsigned cand = thr | (1u << bit);
      int cnt = 0;
      for (int i = i0; i < i1; ++i) cnt += (vals[i + t] >= cand);
      if (block_sum_i(cnt, red) >= cap) thr = cand;
    }
    int cgt = 0, ceq = 0;
    for (int i = i0; i < i1; ++i) { cgt += (vals[i + t] > thr); ceq += (vals[i + t] == thr); }
    const int ngt = block_sum_i(cgt, red);
    const int neq = cap - ngt;
    int eqoff = block_excl_scan(ceq, red);
    int csel = 0;
    { int er = eqoff; for (int i = i0; i < i1; ++i) { if (vals[i + t] > thr) ++csel; else if (vals[i + t] == thr) { if (er < neq) ++csel; ++er; } } }
    int q = block_excl_scan(csel, red);
    for (int i = i0; i < i1; ++i) {
      const unsigned v = vals[i + t]; int sel = -1;
      if (v > thr) sel = q++; else if (v == thr) { if (eqoff < neq) sel = q++; ++eqoff; }
      const int r = row_of(b, s0 + i);
      if (sel >= 0) { p.SEL[(size_t)e * NSLOT + slot0 + sel] = r; p.SELV[(size_t)e * NSLOT + slot0 + sel] = u2f(v); }
      p.INV[(size_t)e * R + r] = sel >= 0 ? slot0 + sel : -1;
    }
    __syncthreads();
  }
}
DI void ph_wt(const float* in, bf16_t* out, int K, int N, int NP, int nbatch, long in_bs, long out_bs, const float* gain, char* lds, int bid, int nblk) {
  float* tile = (float*)lds;
  const int t = TIDX, tk = K / 64, tn = NP / 64, ntile = nbatch * tk * tn;
  f32x4 v[4];
  auto gload = [&](int u) {
    const int bt = u / (tk * tn), rem = u % (tk * tn), k0 = (rem / tn) * 64, n0 = (rem % tn) * 64;
    const float* I = in + (size_t)bt * in_bs;
#pragma unroll
    for (int i = 0; i < 4; ++i) {
      const int idx = t + i * NTHR, kk = idx >> 4, n4 = (idx & 15) * 4;
      v[i] = (f32x4){0.f, 0.f, 0.f, 0.f};
      if (n0 + n4 < N) v[i] = *(const f32x4*)(I + (size_t)(k0 + kk) * N + n0 + n4);
      if (gain) { const float g = gain[k0 + kk]; v[i][0] *= g; v[i][1] *= g; v[i][2] *= g; v[i][3] *= g; }
    }
  };
  if (bid < ntile) gload(bid);
#pragma unroll 1
  for (int u = bid; u < ntile; u += nblk) {
    const int bt = u / (tk * tn), rem = u % (tk * tn), k0 = (rem / tn) * 64, n0 = (rem % tn) * 64;
    bf16_t* O = out + (size_t)bt * out_bs;
#pragma unroll
    for (int i = 0; i < 4; ++i) { const int idx = t + i * NTHR, kk = idx >> 4, n4 = (idx & 15) * 4; float* d = tile + kk * 65 + n4; d[0] = v[i][0]; d[1] = v[i][1]; d[2] = v[i][2]; d[3] = v[i][3]; }
    __syncthreads();
    if (u + nblk < ntile) gload(u + nblk);
#pragma unroll
    for (int i = 0; i < 2; ++i) {
      const int idx = t + i * NTHR, kg = idx & 7, nn = idx >> 3;
      float a[8];
#pragma unroll
      for (int e = 0; e < 8; ++e) a[e] = tile[(kg * 8 + e) * 65 + nn];
      u32x4 o; o.x = pack2bf(a[0], a[1]); o.y = pack2bf(a[2], a[3]); o.z = pack2bf(a[4], a[5]); o.w = pack2bf(a[6], a[7]);
      *(u32x4*)(O + (size_t)(n0 + nn) * K + k0 + kg * 8) = o;
    }
    __syncthreads();
  }
}
DI float wave_max(float v) {
  v = xor_max<1>(v); v = xor_max<2>(v); v = xor_max<4>(v); v = xor_max<8>(v); v = xor_max<16>(v); v = xor_max<32>(v);
  return v;
}
DI bf16x8 cvt8(const float* f) {
  const f32x4 a = *(const f32x4*)f, b = *(const f32x4*)(f + 4);
  u32x4 pk; pk.x = pack2bf(a[0], a[1]); pk.y = pack2bf(a[2], a[3]); pk.z = pack2bf(b[0], b[1]); pk.w = pack2bf(b[2], b[3]);
  return __builtin_bit_cast(bf16x8, pk);
}
constexpr int SCAN_UNITS = NB * NCK * 4, SCAN_LAT_UNITS = NB * NCL * 4;
DI void scan_unit(int u, int& b, int& c, int& h) {
  h = u & 3;
  if (u < SCAN_LAT_UNITS) { c = NCC + (u >> 2) % NCL; b = u / (4 * NCL); } else { const int v = u - SCAN_LAT_UNITS; c = (v >> 2) % NCC; b = v / (4 * NCC); }
}

DI void ph_ml_local(const Params& p, char* lds, int bid, int nblk) {
  bf16_t* sK = (bf16_t*)lds;
  float* sW = (float*)(lds + 64 * 132);
  const int t = TIDX, lane = t & 63, wid = t >> 6, l31 = lane & 31, hh = lane >> 5;
  const int d = wid & 1, vt = wid >> 1;
#pragma unroll 1
  for (int u = bid; u < SCAN_UNITS; u += nblk) {
    int b, c, h; scan_unit(u, b, c, h);
    {
      const int row = t >> 2, seg = (t & 3) * 16;
      const bf16_t* src = p.MK + ((size_t)b * TK + 64 * c + row) * 256 + h * 64 + seg;
      const u32x4 a = ldg16(src), bb = ldg16(src + 8);
      unsigned* dst = (unsigned*)((char*)sK + row * 132 + seg * 2);
      dst[0] = a.x; dst[1] = a.y; dst[2] = a.z; dst[3] = a.w; dst[4] = bb.x; dst[5] = bb.y; dst[6] = bb.z; dst[7] = bb.w;
    }
    if (t < 128) {
      const int dd = t >> 6, l = t & 63, j = step_of(dd, c), pos = dd ? 63 - l : l;
      const size_t o = (((size_t)b * 2 + dd) * TK + 64 * j) * 4 + h;
      const float bend = p.BC[o + 63 * 4], wl = bend - p.BC[o + pos * 4] + p.IGS[o + pos * 4];
      const float ml = wave_max(wl);
      sW[dd * 64 + l] = expf(wl - ml);
      if (l == 0) { const size_t uu = (((size_t)b * 2 + dd) * NCK + j) * 4 + h; p.MM[uu * 4] = ml; p.MM[uu * 4 + 1] = bend; }
    }
    __syncthreads();
    const int j = step_of(d, c);
    const size_t uu = (((size_t)b * 2 + d) * NCK + j) * 4 + h;
    f32x16 acc[2]; acc[0] = (f32x16)(0.f); acc[1] = (f32x16)(0.f);
    const bf16_t* vsrc = p.MVt + (((size_t)b * 4 + h) * 64 + vt * 32 + l31) * TK + 64 * c;
#pragma unroll
    for (int ks = 0; ks < 4; ++ks) {
      const bf16x8 a = *(const bf16x8*)(vsrc + ks * 16 + 8 * hh);
      const float* w = sW + d * 64 + ks * 16 + 8 * hh;
      u32x4 pk;
      pk.x = pack2bf(bf2f((bf16_t)a[0]) * w[0], bf2f((bf16_t)a[1]) * w[1]); pk.y = pack2bf(bf2f((bf16_t)a[2]) * w[2], bf2f((bf16_t)a[3]) * w[3]);
      pk.z = pack2bf(bf2f((bf16_t)a[4]) * w[4], bf2f((bf16_t)a[5]) * w[5]); pk.w = pack2bf(bf2f((bf16_t)a[6]) * w[6], bf2f((bf16_t)a[7]) * w[7]);
      const bf16x8 af = __builtin_bit_cast(bf16x8, pk);
#pragma unroll
      for (int kt = 0; kt < 2; ++kt) {
        bf16x8 bfr;
#pragma unroll
        for (int q = 0; q < 8; ++q) bfr[q] = (short)sK[(ks * 16 + 8 * hh + q) * 66 + kt * 32 + l31];
        acc[kt] = MFMA32(af, bfr, acc[kt]);
      }
    }
#pragma unroll
    for (int kt = 0; kt < 2; ++kt)
#pragma unroll
      for (int i = 0; i < 16; ++i) p.MC[uu * 4096 + (size_t)(vt * 32 + (i & 3) + 8 * (i >> 2) + 4 * hh) * 64 + kt * 32 + l31] = acc[kt][i];
    float nl = 0.f;
    for (int q = 0; q < 32; ++q) { const int l = hh * 32 + q; nl += sW[d * 64 + l] * bf2f(sK[l * 66 + vt * 32 + l31]); }
    nl = xor_sum<32>(nl);
    if (hh == 0) p.MN[uu * 64 + vt * 32 + l31] = nl;
    __syncthreads();
  }
}
constexpr int SCAN_PF = 8;
DI void ph_ml_scan(const Params& p, int bid, int nblk) {
  for (long gi = (long)bid * NTHR + TIDX; gi < (long)NB * 2 * 4 * 4160; gi += (long)nblk * NTHR) {
    const int e = (int)(gi % 4160), ch = (int)(gi / 4160), h = ch & 3, bd = ch >> 2;
    float* base = e < 4096 ? p.MC + (((size_t)bd * NCK) * 4 + h) * 4096 + e : p.MN + (((size_t)bd * NCK) * 4 + h) * 64 + (e - 4096);
    const size_t stride = e < 4096 ? 4 * 4096 : 4 * 64;
    float* mm = p.MM + (((size_t)bd * NCK) * 4 + h) * 4;
    float st = 0.f, m = -1e30f;
    float cl[SCAN_PF], cm[SCAN_PF], cb[SCAN_PF], nl[SCAN_PF], nm[SCAN_PF], nb[SCAN_PF];
#pragma unroll
    for (int q = 0; q < SCAN_PF; ++q) if (q < NCK) { cl[q] = base[(size_t)q * stride]; cm[q] = mm[q * 16]; cb[q] = mm[q * 16 + 1]; }
#pragma unroll 1
    for (int jb = 0; jb < NCK; jb += SCAN_PF) {
#pragma unroll
      for (int q = 0; q < SCAN_PF; ++q) { const int j = jb + SCAN_PF + q; if (j < NCK) { nl[q] = base[(size_t)j * stride]; nm[q] = mm[j * 16]; nb[q] = mm[j * 16 + 1]; } }
#pragma unroll
      for (int q = 0; q < SCAN_PF; ++q) {
        const int j = jb + q;
        if (j < NCK) {
          const float mn = fmaxf(cb[q] + m, cm[q]), a = expf(cb[q] + m - mn), g = expf(cm[q] - mn);
          base[(size_t)j * stride] = st;
          st = a * st + g * cl[q];
          if (e == 0) mm[j * 16 + 2] = m;
          m = mn;
        }
      }
#pragma unroll
      for (int q = 0; q < SCAN_PF; ++q) { cl[q] = nl[q]; cm[q] = nm[q]; cb[q] = nb[q]; }
    }
  }
}
DI void ph_gla_scan(const Params& p, int bid, int nblk) {
  for (long gi = (long)bid * NTHR + TIDX; gi < (long)NB * 2 * 4 * 2048; gi += (long)nblk * NTHR) {
    const int e = (int)(gi % 2048), ch = (int)(gi / 2048), h = ch & 3, bd = ch >> 2, k = e & 31;
    float* base = p.GS + (((size_t)bd * NCK) * 4 + h) * 2048 + e;
    const float* ge = p.GC + ((size_t)bd * TK + 63) * 128 + h * 32 + k;
    float st = 0.f;
    float cl[SCAN_PF], cg[SCAN_PF], nl[SCAN_PF], ng[SCAN_PF];
#pragma unroll
    for (int q = 0; q < SCAN_PF; ++q) if (q < NCK) { cl[q] = base[(size_t)q * 4 * 2048]; cg[q] = ge[(size_t)q * 64 * 128]; }
#pragma unroll 1
    for (int jb = 0; jb < NCK; jb += SCAN_PF) {
#pragma unroll
      for (int q = 0; q < SCAN_PF; ++q) { const int j = jb + SCAN_PF + q; if (j < NCK) { nl[q] = base[(size_t)j * 4 * 2048]; ng[q] = ge[(size_t)j * 64 * 128]; } }
#pragma unroll
      for (int q = 0; q < SCAN_PF; ++q) {
        const int j = jb + q;
        if (j < NCK) { base[(size_t)j * 4 * 2048] = st; st = expf(cg[q]) * st + cl[q]; }
      }
#pragma unroll
      for (int q = 0; q < SCAN_PF; ++q) { cl[q] = nl[q]; cg[q] = ng[q]; }
    }
  }
}
constexpr int MO_K = 0, MO_V = 64 * 144, MO_A = MO_V + 64 * VROW, MO_PM = MO_A + 512, MO_N0 = MO_PM + 512, MO_X = MO_N0 + 512, MO_LDS = MO_X + 16384;
DI void ph_ml_out(const Params& p, int layer, int need_ctx, char* lds, int bid, int nblk) {
  float* sA = (float*)(lds + MO_A); float* sPM = (float*)(lds + MO_PM); float* sN0 = (float*)(lds + MO_N0); float* sX = (float*)(lds + MO_X);
  const int t = TIDX, lane = t & 63, wid = t >> 6, l31 = lane & 31, hh = lane >> 5;
  const int lt = wid & 1, d = wid >> 1;
#pragma unroll 1
  for (int u = bid; u < (need_ctx ? SCAN_UNITS : SCAN_LAT_UNITS); u += nblk) {
    int b, c, h; scan_unit(u, b, c, h);
    {
      const int row = t >> 2, seg = (t & 3) * 16;
      const bf16_t* ks = p.MK + ((size_t)b * TK + 64 * c + row) * 256 + h * 64 + seg;
      sts16(lds + MO_K + row * 144 + seg * 2, ldg16(ks)); sts16(lds + MO_K + row * 144 + seg * 2 + 16, ldg16(ks + 8));
      const bf16_t* vs = p.MVt + (((size_t)b * 4 + h) * 64 + row) * TK + 64 * c + seg;
      const u32x4 v0 = ldg16(vs), v1 = ldg16(vs + 8);
      u32x2* dv = (u32x2*)(lds + MO_V + row * VROW + seg * 2);
      u32x2 q; q.x = v0.x; q.y = v0.y; dv[0] = q; q.x = v0.z; q.y = v0.w; dv[1] = q; q.x = v1.x; q.y = v1.y; dv[2] = q; q.x = v1.z; q.y = v1.w; dv[3] = q;
    }
    if (t < 128) {
      const int dd = t >> 6, s = t & 63, j = step_of(dd, c), pos = dd ? 63 - s : s;
      const size_t o = (((size_t)b * 2 + dd) * TK + 64 * j) * 4 + h;
      sA[dd * 64 + s] = p.IGS[o + pos * 4] - p.BC[o + pos * 4];
      const size_t uu = (((size_t)b * 2 + dd) * NCK + j) * 4 + h;
      sN0[dd * 64 + s] = p.MN[uu * 64 + s];
    }
    __syncthreads();
    if (t < 2) {
      float m = -1e30f;
      if (t == 0) { for (int s = 0; s < 64; ++s) { m = fmaxf(m, sA[s]); sPM[s] = m; } }
      else { for (int s = 63; s >= 0; --s) { m = fmaxf(m, sA[64 + s]); sPM[64 + s] = m; } }
    }
    __syncthreads();
    const int j = step_of(d, c);
    const size_t uu = (((size_t)b * 2 + d) * NCK + j) * 4 + h;
    const int l = lt * 32 + l31, pos = d ? 63 - l : l;
    const float bl = p.BC[(((size_t)b * 2 + d) * TK + 64 * j + pos) * 4 + h];
    const float inter = bl + p.MM[uu * 4 + 2];
    const float mt = fmaxf(inter, bl + sPM[d * 64 + l]);
    const float aint = expf(inter - mt);
    bf16x8 qf[4];
#pragma unroll
    for (int ks = 0; ks < 4; ++ks) qf[ks] = *(const bf16x8*)(p.MQ + ((size_t)b * TK + 64 * c + l) * 256 + h * 64 + ks * 16 + 8 * hh);
    f32x16 num[2]; num[0] = (f32x16)(0.f); num[1] = (f32x16)(0.f);
    float den = 0.f;
#pragma unroll
    for (int st = 0; st < 2; ++st) {
      if (d == 0 ? st <= lt : st >= lt) {
        f32x16 S = (f32x16)(0.f);
#pragma unroll
        for (int ks = 0; ks < 4; ++ks) S = MFMA32(lds_frag(lds + MO_K + (st * 32 + l31) * 144 + (ks * 16 + 8 * hh) * 2), qf[ks], S);
#pragma unroll
        for (int i = 0; i < 16; ++i) {
          const int s = st * 32 + (i & 3) + 8 * (i >> 2) + 4 * hh;
          const bool ok = d == 0 ? s <= l : s >= l;
          const float e = ok ? fast_exp2((bl + sA[d * 64 + s] - mt) * LOG2E) * S[i] : 0.f;
          S[i] = e; den += e;
        }
#pragma unroll
        for (int kst = 0; kst < 2; ++kst) {
          const bf16x8 pf = pack8(S, kst);
#pragma unroll
          for (int vt = 0; vt < 2; ++vt) {
            const char* vp = lds + MO_V + (vt * 32 + l31) * VROW + (st * 32 + kst * 16 + 4 * hh) * 2;
            const s16x4 lo = *(const s16x4*)vp, hi = *(const s16x4*)(vp + 16);
            num[vt] = MFMA32(__builtin_shufflevector(lo, hi, 0, 1, 2, 3, 4, 5, 6, 7), pf, num[vt]);
          }
        }
      }
    }
    f32x16 accI[2]; accI[0] = (f32x16)(0.f); accI[1] = (f32x16)(0.f);
#pragma unroll
    for (int vt = 0; vt < 2; ++vt)
#pragma unroll
      for (int ks = 0; ks < 4; ++ks) accI[vt] = MFMA32(cvt8(p.MC + uu * 4096 + (size_t)(vt * 32 + l31) * 64 + ks * 16 + 8 * hh), qf[ks], accI[vt]);
    float qn = 0.f;
#pragma unroll
    for (int ks = 0; ks < 4; ++ks)
#pragma unroll
      for (int q = 0; q < 8; ++q) qn += bf2f((bf16_t)qf[ks][q]) * sN0[d * 64 + ks * 16 + 8 * hh + q];
    den = xor_sum<32>(den + aint * qn);
    const float inv = 1.0f / fmaxf(fabsf(den), expf(-mt));
#pragma unroll
    for (int vt = 0; vt < 2; ++vt)
#pragma unroll
      for (int i = 0; i < 16; ++i) num[vt][i] = (num[vt][i] + aint * accI[vt][i]) * inv;
    if (d == 1) {
#pragma unroll
      for (int vt = 0; vt < 2; ++vt)
#pragma unroll
        for (int i = 0; i < 16; ++i) sX[(lt * 32 + vt * 16 + i) * 64 + lane] = num[vt][i];
    }
    __syncthreads();
    if (d == 0) {
      float ss = 0.f;
#pragma unroll
      for (int vt = 0; vt < 2; ++vt)
#pragma unroll
        for (int i = 0; i < 16; ++i) { num[vt][i] += sX[(lt * 32 + vt * 16 + i) * 64 + lane]; ss += num[vt][i] * num[vt][i]; }
      ss = xor_sum<32>(ss);
      const float rstd = 1.0f / sqrtf(ss * (1.0f / 64) + 1e-6f);
      const int r = row_of(b, 64 * c + l);
#pragma unroll
      for (int vt = 0; vt < 2; ++vt)
#pragma unroll
        for (int g = 0; g < 4; ++g) {
          const int v0 = vt * 32 + 8 * g + 4 * hh;
          const u32x2 ou = *(const u32x2*)(p.Z + (size_t)r * NZP + ZC_MLO + h * 64 + v0);
          const f32x4 gv = *(const f32x4*)(p.g_mlstm_out + layer * 256 + h * 64 + v0);
          const float o0 = u2f(ou.x << 16), o1 = u2f(ou.x & 0xffff0000u), o2 = u2f(ou.y << 16), o3 = u2f(ou.y & 0xffff0000u);
          f32x4 y = {sigmoidf_(o0) * num[vt][4 * g] * rstd * gv[0], sigmoidf_(o1) * num[vt][4 * g + 1] * rstd * gv[1],
                     sigmoidf_(o2) * num[vt][4 * g + 2] * rstd * gv[2], sigmoidf_(o3) * num[vt][4 * g + 3] * rstd * gv[3]};
          st_bf16x4(p.Y + (size_t)r * D + 256 + h * 64 + v0, y);
        }
    }
    __syncthreads();
  }
}
DI void ph_gla_local(const Params& p, char* lds, int bid, int nblk) {
  bf16_t* sKd = (bf16_t*)lds;
  const int t = TIDX, lane = t & 63, wid = t >> 6, l31 = lane & 31, hh = lane >> 5;
  const int d = wid & 1, vt = wid >> 1;
#pragma unroll 1
  for (int u = bid; u < SCAN_UNITS; u += nblk) {
    int b, c, h; scan_unit(u, b, c, h);
    {
      const int dd = t >> 7, l = (t >> 1) & 63, k0 = (t & 1) * 16, j = step_of(dd, c), pos = dd ? 63 - l : l;
      const float* gcr = p.GC + (((size_t)b * 2 + dd) * TK + 64 * j + pos) * 128 + h * 32 + k0;
      const float* ger = p.GC + (((size_t)b * 2 + dd) * TK + 64 * j + 63) * 128 + h * 32 + k0;
      const bf16_t* kr = p.Z + (size_t)row_of(b, 64 * c + l) * NZP + ZC_GK + h * 32 + k0;
#pragma unroll
      for (int q = 0; q < 16; ++q) sKd[(dd * 64 + l) * 33 + k0 + q] = f2bf(bf2f(kr[q]) * fast_exp2((ger[q] - gcr[q]) * LOG2E));
    }
    __syncthreads();
    const int j = step_of(d, c);
    const size_t uu = (((size_t)b * 2 + d) * NCK + j) * 4 + h;
    f32x16 acc = (f32x16)(0.f);
    const bf16_t* vsrc = p.GVt + (((size_t)b * 4 + h) * 64 + vt * 32 + l31) * TK + 64 * c;
#pragma unroll
    for (int ks = 0; ks < 4; ++ks) {
      const bf16x8 af = *(const bf16x8*)(vsrc + ks * 16 + 8 * hh);
      bf16x8 bfr;
#pragma unroll
      for (int q = 0; q < 8; ++q) bfr[q] = (short)sKd[(d * 64 + ks * 16 + 8 * hh + q) * 33 + l31];
      acc = MFMA32(af, bfr, acc);
    }
#pragma unroll
    for (int i = 0; i < 16; ++i) p.GS[uu * 2048 + (size_t)(vt * 32 + (i & 3) + 8 * (i >> 2) + 4 * hh) * 32 + l31] = acc[i];
    __syncthreads();
  }
}
constexpr int GO_Q = 0, GO_K = 2 * 64 * 80, GO_V = 2 * GO_K, GO_X = GO_V + 64 * VROW, GO_LDS = GO_X + 16384;
DI void ph_gla_out(const Params& p, int layer, int need_ctx, char* lds, int bid, int nblk) {
  float* sX = (float*)(lds + GO_X);
  const int t = TIDX, lane = t & 63, wid = t >> 6, l31 = lane & 31, hh = lane >> 5;
  const int lt = wid & 1, d = wid >> 1;
#pragma unroll 1
  for (int u = bid; u < (need_ctx ? SCAN_UNITS : SCAN_LAT_UNITS); u += nblk) {
    int b, c, h; scan_unit(u, b, c, h);
    {
      const int dd = t >> 7, l = (t >> 1) & 63, k0 = (t & 1) * 16, j = step_of(dd, c), pos = dd ? 63 - l : l;
      const float* gcr = p.GC + (((size_t)b * 2 + dd) * TK + 64 * j + pos) * 128 + h * 32 + k0;
      const bf16_t* zr = p.Z + (size_t)row_of(b, 64 * c + l) * NZP;
      bf16_t* qd = (bf16_t*)(lds + GO_Q + (dd * 64 + l) * 80) + k0; bf16_t* kd = (bf16_t*)(lds + GO_K + (dd * 64 + l) * 80) + k0;
#pragma unroll
      for (int q = 0; q < 16; ++q) {
        const float g = gcr[q];
        qd[q] = f2bf(bf2f(zr[ZC_GQ + h * 32 + k0 + q]) * 0.17677669529663687f * fast_exp2(g * LOG2E));
        kd[q] = f2bf(bf2f(zr[ZC_GK + h * 32 + k0 + q]) * fast_exp2(-g * LOG2E));
      }
      const int row = t >> 2, seg = (t & 3) * 16;
      const bf16_t* vs = p.GVt + (((size_t)b * 4 + h) * 64 + row) * TK + 64 * c + seg;
      const u32x4 v0 = ldg16(vs), v1 = ldg16(vs + 8);
      u32x2* dv = (u32x2*)(lds + GO_V + row * VROW + seg * 2);
      u32x2 q2; q2.x = v0.x; q2.y = v0.y; dv[0] = q2; q2.x = v0.z; q2.y = v0.w; dv[1] = q2; q2.x = v1.x; q2.y = v1.y; dv[2] = q2; q2.x = v1.z; q2.y = v1.w; dv[3] = q2;
    }
    __syncthreads();
    const int j = step_of(d, c);
    const size_t uu = (((size_t)b * 2 + d) * NCK + j) * 4 + h;
    const int l = lt * 32 + l31;
    bf16x8 qf[2];
#pragma unroll
    for (int ks = 0; ks < 2; ++ks) qf[ks] = lds_frag(lds + GO_Q + (d * 64 + l) * 80 + (ks * 16 + 8 * hh) * 2);
    f32x16 O[2]; O[0] = (f32x16)(0.f); O[1] = (f32x16)(0.f);
#pragma unroll
    for (int st = 0; st < 2; ++st) {
      if (d == 0 ? st <= lt : st >= lt) {
        f32x16 S = (f32x16)(0.f);
#pragma unroll
        for (int ks = 0; ks < 2; ++ks) S = MFMA32(lds_frag(lds + GO_K + (d * 64 + st * 32 + l31) * 80 + (ks * 16 + 8 * hh) * 2), qf[ks], S);
#pragma unroll
        for (int i = 0; i < 16; ++i) {
          const int s = st * 32 + (i & 3) + 8 * (i >> 2) + 4 * hh;
          const bool ok = d == 0 ? s <= l : s >= l;
          S[i] = ok ? S[i] : 0.f;
        }
#pragma unroll
        for (int kst = 0; kst < 2; ++kst) {
          const bf16x8 pf = pack8(S, kst);
#pragma unroll
          for (int vt = 0; vt < 2; ++vt) {
            const char* vp = lds + GO_V + (vt * 32 + l31) * VROW + (st * 32 + kst * 16 + 4 * hh) * 2;
            const s16x4 lo = *(const s16x4*)vp, hi = *(const s16x4*)(vp + 16);
            O[vt] = MFMA32(__builtin_shufflevector(lo, hi, 0, 1, 2, 3, 4, 5, 6, 7), pf, O[vt]);
          }
        }
      }
    }
#pragma unroll
    for (int vt = 0; vt < 2; ++vt)
#pragma unroll
      for (int ks = 0; ks < 2; ++ks) O[vt] = MFMA32(cvt8(p.GS + uu * 2048 + (size_t)(vt * 32 + l31) * 32 + ks * 16 + 8 * hh), qf[ks], O[vt]);
    if (d == 1) {
#pragma unroll
      for (int vt = 0; vt < 2; ++vt)
#pragma unroll
        for (int i = 0; i < 16; ++i) sX[(lt * 32 + vt * 16 + i) * 64 + lane] = O[vt][i];
    }
    __syncthreads();
    if (d == 0) {
      float ss = 0.f;
#pragma unroll
      for (int vt = 0; vt < 2; ++vt)
#pragma unroll
        for (int i = 0; i < 16; ++i) { O[vt][i] += sX[(lt * 32 + vt * 16 + i) * 64 + lane]; ss += O[vt][i] * O[vt][i]; }
      ss = xor_sum<32>(ss);
      const float rstd = 1.0f / sqrtf(ss * (1.0f / 64) + 1e-6f);
      const int r = row_of(b, 64 * c + l);
#pragma unroll
      for (int vt = 0; vt < 2; ++vt)
#pragma unroll
        for (int g = 0; g < 4; ++g) {
          const int v0 = vt * 32 + 8 * g + 4 * hh;
          const u32x2 ru = *(const u32x2*)(p.Z + (size_t)r * NZP + ZC_GR + h * 64 + v0);
          const f32x4 gv = *(const f32x4*)(p.g_gla_out + layer * 256 + h * 64 + v0);
          const float r0 = u2f(ru.x << 16), r1 = u2f(ru.x & 0xffff0000u), r2 = u2f(ru.y << 16), r3 = u2f(ru.y & 0xffff0000u);
          f32x4 y = {siluf_(r0) * O[vt][4 * g] * rstd * gv[0], siluf_(r1) * O[vt][4 * g + 1] * rstd * gv[1],
                     siluf_(r2) * O[vt][4 * g + 2] * rstd * gv[2], siluf_(r3) * O[vt][4 * g + 3] * rstd * gv[3]};
          st_bf16x4(p.Y + (size_t)r * D + 512 + h * 64 + v0, y);
        }
    }
    __syncthreads();
  }
}

DI float fast_logsigmoid(float x) {
  const float e = fast_exp2(-fabsf(x) * LOG2E);
#ifdef CPU_EMU
  return fminf(x, 0.f) - log1pf(e);
#else
  return fminf(x, 0.f) - 0.6931471805599453f * __builtin_amdgcn_logf(1.0f + e);
#endif
}
DI float wave_incl_scan(float v, int lane) {
#pragma unroll
  for (int dd = 1; dd < 64; dd <<= 1) { const float o = u2f((unsigned)lane_up((int)f2u(v), dd, lane)); if (lane >= dd) v += o; }
  return v;
}
constexpr int GCUM_LDS = 4 * 64 * 33 * 4;
DI void ph_gates_cum(const Params& p, int layer, char* lds, int bid, int nblk) {
  const int t = TIDX, lane = t & 63, wid = t >> 6;
  float* stg = (float*)lds + wid * 64 * 33;
  const float* wal = p.w_alpha2 + (size_t)layer * 2 * 16 * 128;
#pragma unroll 1
  for (int u = bid * 4 + wid; u < NB * 2 * NCK; u += nblk * 4) {
    const int j = u % NCK, d = (u / NCK) & 1, b = u / (2 * NCK);
    const int pp = 64 * j + lane, s = seq_of(d, pp);
    const bf16_t* z = p.Z + (size_t)row_of(b, s) * NZP;
    const size_t ob = ((size_t)b * 2 + d) * TK + pp;
    {
      const u32x2 iu = *(const u32x2*)(z + ZC_MLIG + d * 4), fu = *(const u32x2*)(z + ZC_MLFG + d * 4);
      const float ig[4] = {u2f(iu.x << 16), u2f(iu.x & 0xffff0000u), u2f(iu.y << 16), u2f(iu.y & 0xffff0000u)};
      const float fg[4] = {u2f(fu.x << 16), u2f(fu.x & 0xffff0000u), u2f(fu.y << 16), u2f(fu.y & 0xffff0000u)};
      f32x4 oc, oi;
#pragma unroll
      for (int h = 0; h < 4; ++h) {
        oi[h] = ig[h] + p.b_igate[layer * 8 + d * 4 + h];
        oc[h] = wave_incl_scan(fast_logsigmoid(fg[h] + p.b_fgate[layer * 8 + d * 4 + h]), lane);
      }
      *(f32x4*)(p.BC + ob * 4) = oc; *(f32x4*)(p.IGS + ob * 4) = oi;
    }
    float a[16];
    { float f0[8], f1[8]; unpack8(ldg16(z + ZC_GA + d * 16), f0); unpack8(ldg16(z + ZC_GA + d * 16 + 8), f1);
#pragma unroll
      for (int q = 0; q < 8; ++q) { a[q] = f0[q]; a[8 + q] = f1[q]; } }
    const float* W = wal + (size_t)d * 16 * 128;
#pragma unroll 1
    for (int cg = 0; cg < 4; ++cg) {
#pragma unroll 4
      for (int c = 0; c < 32; ++c) {
        const int ch = cg * 32 + c;
        float zg = p.b_alpha[layer * 256 + d * 128 + ch];
#pragma unroll
        for (int q = 0; q < 16; ++q) zg += a[q] * W[q * 128 + ch];
        stg[lane * 33 + c] = wave_incl_scan(fast_logsigmoid(zg) * (1.0f / 16.0f), lane);
      }
      WAVE_SYNC();
#pragma unroll
      for (int k = 0; k < 32; ++k) { const int pos = k * 2 + (lane >> 5), c = lane & 31; p.GC[(((size_t)b * 2 + d) * TK + 64 * j + pos) * 128 + cg * 32 + c] = stg[pos * 33 + c]; }
      WAVE_SYNC();
    }
  }
}
#define XB_TMO      128
#define XB_XCNT(j)  (256  + 64 * (j))
#define XB_XSUB(j)  (1280 + 64 * (j))
#define XB_XGEN(j)  (2304 + 64 * (j))
#define XB_TOP      3328
#define XB_TOPGEN   3392
#define XCD_BAR_WORDS 3456
#define XB_SPIN_CAP (1u << 28)
#define LAS __attribute__((address_space(3)))

__device__ __forceinline__ unsigned xb_ld(unsigned* p)              { return __hip_atomic_load(p, __ATOMIC_RELAXED, __HIP_MEMORY_SCOPE_AGENT); }
__device__ __forceinline__ unsigned xb_add(unsigned* p, unsigned v) { return __hip_atomic_fetch_add(p, v, __ATOMIC_RELAXED, __HIP_MEMORY_SCOPE_AGENT); }
__device__ __forceinline__ unsigned xb_xcc_id() { return (unsigned)__builtin_amdgcn_s_getreg((3 << 11) | 20) & 0xFu; }
#define XB_SPIN(cond, bar) do { unsigned _sp = 0; while (cond) { __builtin_amdgcn_s_sleep(1); \
    if ((++_sp & 255u) == 0u) { if (xb_ld(&(bar)[XB_TMO])) break; if (_sp > XB_SPIN_CAP) { atomicAdd(&(bar)[XB_TMO], 1u); break; } } } } while (0)

struct XcdBarrier {
    unsigned* bar; unsigned x;
    volatile LAS unsigned* st;
};

__device__ __forceinline__ XcdBarrier xcd_barrier_post(unsigned* bar, volatile LAS unsigned* st) {
    XcdBarrier b; b.bar = bar; b.x = xb_xcc_id(); b.st = st;
    if (threadIdx.x == 0) (void)xb_add(&bar[XB_XCNT(b.x)], 1u);
    return b;
}
__device__ __forceinline__ void xcd_barrier_complete(unsigned* bar, unsigned x, unsigned& nloc, unsigned& nx) {
    const unsigned G = gridDim.x * gridDim.y * gridDim.z;
    unsigned sum, cnt, mine, sp = 0u;
    for (;;) {
        sum = 0u; cnt = 0u; mine = 0u;
#pragma unroll
        for (unsigned j = 0; j < 16; ++j) { const unsigned c = xb_ld(&bar[XB_XCNT(j)]); sum += c; cnt += (c > 0u) ? 1u : 0u; mine = (j == x) ? c : mine; }
        if (sum == G) break;
        __builtin_amdgcn_s_sleep(1);
        if ((++sp & 255u) == 0u) { if (xb_ld(&bar[XB_TMO])) break; if (sp > XB_SPIN_CAP) { atomicAdd(&bar[XB_TMO], 1u); break; } }
    }
    nloc = mine > 0u ? mine : 1u; nx = cnt > 0u ? cnt : 1u;
}

__device__ __forceinline__ void xcd_barrier(const XcdBarrier& b) {
    asm volatile("s_waitcnt vmcnt(0)" ::: "memory");
    __syncthreads();
    if (threadIdx.x == 0) {
        unsigned* bar = b.bar;
        __builtin_amdgcn_s_waitcnt(0);
        unsigned nloc = b.st[0], nx = b.st[1];
        if (nloc == 0u) { xcd_barrier_complete(bar, b.x, nloc, nx); b.st[0] = nloc; b.st[1] = nx; }
        const unsigned old = xb_add(&bar[XB_XSUB(b.x)], 1u);
        const unsigned gen = old / nloc;
        if (old + 1u == (gen + 1u) * nloc) {
            __builtin_amdgcn_fence(__ATOMIC_RELEASE, "agent");
            asm volatile("s_waitcnt vmcnt(0)" ::: "memory");
            const unsigned og = xb_add(&bar[XB_TOP], 1u);
            const unsigned tg = og / nx;
            if (og + 1u == (tg + 1u) * nx) xb_add(&bar[XB_TOPGEN], 1u);
            else XB_SPIN(xb_ld(&bar[XB_TOPGEN]) == tg, bar);
            __builtin_amdgcn_fence(__ATOMIC_ACQUIRE, "agent");
            xb_add(&bar[XB_XGEN(b.x)], 1u);
            asm volatile("s_waitcnt vmcnt(0)" ::: "memory");
        } else {
            XB_SPIN(xb_ld(&bar[XB_XGEN(b.x)]) == gen, bar);
            __builtin_amdgcn_fence(__ATOMIC_ACQUIRE, "agent");
            asm volatile("s_waitcnt vmcnt(0)" ::: "memory");
        }
    }
    __syncthreads();
}

#define GS_LOOP(N, CALL) for (long gi = (long)bid * NTHR + TIDX; gi < (long)(N); gi += (long)nblk * NTHR) { CALL; }
#ifndef PROBE
#define PROBE 0
#endif
#ifndef PROBE_MASK
#define PROBE_MASK 0
#endif
#ifndef FAST_SCAN
#define FAST_SCAN 1
#endif
constexpr int N_PHASES = 16;
constexpr int MEGA_LDS = GEMM_LDS > TOPK_LDS ? GEMM_LDS : TOPK_LDS;

constexpr bool WT_ED_IN_Y = (size_t)NE * FF * D * 2 <= (size_t)R * D * 2;
DI void conv_expert(const Params& p, int which, int layer, char* lds, int bid, int nblk, int busy) {
  __syncthreads();
  if (bid < busy) return;
  if (which == 0) ph_wt(p.w_e_gate + (size_t)layer * NE * D * FF, p.Wt_eg, D, FF, FF, NE, (long)D * FF, (long)FF * D, nullptr, lds, bid - busy, nblk - busy);
  else if (which == 1) ph_wt(p.w_e_up + (size_t)layer * NE * D * FF, p.Wt_eu, D, FF, FF, NE, (long)D * FF, (long)FF * D, nullptr, lds, bid - busy, nblk - busy);
  else ph_wt(p.w_e_down + (size_t)layer * NE * FF * D, p.Wt_ed, FF, D, D, NE, (long)FF * D, (long)D * FF, nullptr, lds, bid - busy, nblk - busy);
}
template <int PH>
DI void run_phase(const Params& p, int l, char* lds, int bid, int nblk) {
  const int need_ctx = (l == 0);
  const int rows = need_ctx ? R : RL;
  const float* xl_in = l == 0 ? p.x : p.out;
  const float* xc_in = l == 0 ? p.ctx : p.xc;
  bf16_t* QRAW = p.YO; bf16_t* KVRAW = p.YO + (size_t)R * 384;
  if constexpr (PH == 0) {
    ph_mods(p, lds, bid, nblk);
#pragma unroll 1
    for (int ll = 0; ll < 2; ++ll) {
      ph_wt(p.w_in + (size_t)ll * D * NZ, p.Wt_in + ll * WSZ_IN, D, NZ, NZP, 1, 0L, 0L, nullptr, lds, bid, nblk);
      ph_wt(p.w_gate + (size_t)ll * D * 4096, p.Wt_gate + ll * WSZ_GATE, D, 4096, 4096, 1, 0L, 0L, nullptr, lds, bid, nblk);
      ph_wt(p.w_branch + (size_t)ll * 4 * 256 * D, p.Wt_branch + ll * WSZ_BR, 256, D, D, 4, (long)256 * D, (long)D * 256, nullptr, lds, bid, nblk);
      ph_wt(p.w_out + (size_t)ll * D * D, p.Wt_out + ll * WSZ_OUT, D, D, D, 1, 0L, 0L, nullptr, lds, bid, nblk);
      ph_wt(p.w_uq + (size_t)ll * 256 * 384, p.Wt_uq + ll * WSZ_UQ, 256, 384, 384, 1, 0L, 0L, p.g_q_lat + ll * 256, lds, bid, nblk);
      ph_wt(p.w_ukv + (size_t)ll * 128 * 512, p.Wt_ukv + ll * WSZ_UKV, 128, 512, 512, 1, 0L, 0L, p.g_kv_lat + ll * 128, lds, bid, nblk);
    }
  } else if constexpr (PH == 1) {
    ph_modulate(p, l, xl_in, xc_in, bid, nblk);
  } else if constexpr (PH == 2) {
    ph_gemm_plain(p.H, D, p.Wt_in + l * WSZ_IN, D, R, NZP, D, p.Z, NZP, lds, bid, nblk);
#if PROBE == 63
    ph_gemm_probe<3>(p.H, D, p.Wt_in + l * WSZ_IN, D, R, NZP, D, p.mods + 40000, lds, bid, nblk);
#elif PROBE == 66
    ph_gemm_probe<6>(p.H, D, p.Wt_in + l * WSZ_IN, D, R, NZP, D, p.mods + 40000, lds, bid, nblk);
#elif PROBE == 67
    ph_gemm_plain<1>(p.H, D, p.Wt_in + l * WSZ_IN, D, R, NZP, D, p.Z, NZP, lds, bid, nblk);
#elif PROBE == 68
    ph_gemm_plain<2>(p.H, D, p.Wt_in + l * WSZ_IN, D, R, NZP, D, p.Z, NZP, lds, bid, nblk);
#elif PROBE == 5
    ph_gemm_plain(p.H, D, p.Wt_in + l * WSZ_IN, D, R, NZP, D, p.Z, NZP, lds, bid, nblk);
#endif
  } else if constexpr (PH == 3) {
    ph_mla_up(p, l, QRAW, KVRAW, lds, bid, nblk);
  } else if constexpr (PH == 4) {
    ph_prep(p, l, QRAW, KVRAW, lds, bid, nblk);
#if PROBE == 41
    ph_prep(p, l, QRAW, KVRAW, lds, bid, nblk);
#elif PROBE == 43
    ph_prep<1>(p, l, QRAW, KVRAW, lds, bid, nblk);
#elif PROBE == 44
    ph_prep<2>(p, l, QRAW, KVRAW, lds, bid, nblk);
#endif
    __syncthreads();
    ph_gates_cum(p, l, lds, bid, nblk);
#if PROBE == 42
    ph_gates_cum(p, l, lds, bid, nblk);
#endif
  } else if constexpr (PH == 5) {
#if FAST_SCAN
    ph_ml_local(p, lds, bid, nblk);
    ph_gla_local(p, lds, bid, nblk);
#else
    GS_LOOP((long)NUNIT * 4160, nvb_ml_local(gi, p));
    GS_LOOP((long)NUNIT * 2048, nvb_gla_local(gi, p));
#endif
  } else if constexpr (PH == 6) {
#if FAST_SCAN
    ph_ml_scan(p, bid, nblk);
    ph_gla_scan(p, (bid + nblk - 260 % nblk) % nblk, nblk);
#else
    GS_LOOP((long)NB * 2 * 4 * 4160, nvb_ml_scan(gi, p));
    GS_LOOP((long)NB * 2 * 4 * 2048, nvb_gla_scan(gi, p));
#endif
    ph_attn(p, l, need_ctx, lds, bid, nblk);
#if PROBE >= 10 && PROBE < 20
    if (l == 0) ph_attn_mla_probe<PROBE - 10>(p, lds, bid, nblk);
#elif PROBE == 1
    ph_attn_diff(p, l, need_ctx, lds, bid, nblk);
#elif PROBE == 2
    ph_attn_mla(p, need_ctx, lds, bid, nblk);
#endif
  } else if constexpr (PH == 7) {
#if FAST_SCAN
    ph_ml_out(p, l, need_ctx, lds, bid, nblk);
    ph_gla_out(p, l, need_ctx, lds, bid, nblk);
#else
    GS_LOOP((long)NUNIT * 4096, nvb_ml_out(gi, p, need_ctx));
    GS_LOOP((long)NUNIT * 4096, nvb_gla_out(gi, p, need_ctx));
#endif
  } else if constexpr (PH == 8) {
#if !FAST_SCAN
    GS_LOOP((long)R * 4, nvb_ml_finish(gi, p, l, need_ctx));
    GS_LOOP((long)R * 4, nvb_gla_finish(gi, p, l, need_ctx));
#endif
  } else if constexpr (PH == 9) {
    ph_merge(p, l, rows, lds, bid, nblk);
#if PROBE == 3
    ph_merge(p, l, rows, lds, bid, nblk);
#endif
    if (l == 0) conv_expert(p, 1, 0, lds, bid, nblk, ((rows / 128) * (D / 64)) % nblk);
  } else if constexpr (PH == 10) {
    ph_gemm_plain(p.MG, D, p.Wt_out + l * WSZ_OUT, D, rows, D, D, p.YO, D, lds, bid, nblk);
    if (WT_ED_IN_Y && l == 0) conv_expert(p, 2, 0, lds, bid, nblk, ((rows / 128) * (D / 128)) % nblk);
  } else if constexpr (PH == 11) {
    ph_resid_mix(p, l, xl_in, xc_in, rows, lds, bid, nblk);
  } else if constexpr (PH == 12) {
    ph_topk(p, need_ctx, lds, bid, nblk);
    const int tkb = NB * NE * 2 < nblk ? NB * NE * 2 : 0;
    conv_expert(p, 0, l, lds, bid, nblk, tkb);
    if (l == 1) conv_expert(p, 1, 1, lds, bid, nblk, tkb);
    if (l == 1 || !WT_ED_IN_Y) conv_expert(p, 2, l, lds, bid, nblk, tkb);
  } else if constexpr (PH == 13) {
    ph_moe1(p, need_ctx, lds, bid, nblk);
#if PROBE == 4
    ph_moe1(p, need_ctx, lds, bid, nblk);
#endif
  } else if constexpr (PH == 14) {
    ph_moe2(p, need_ctx, lds, bid, nblk);
#if PROBE == 4
    ph_moe2(p, need_ctx, lds, bid, nblk);
#endif
  } else if constexpr (PH == 15) {
    ph_resid_ffn(p, l, rows, bid, nblk);
  }
}

template <int PH> __global__ void __launch_bounds__(256, 2) k_phase(Params p, int l) {
  DYN_LDS(lds);
  run_phase<PH>(p, l, lds, blockIdx.x, gridDim.x);
}

#if !defined(CPU_EMU) && !MK_MULTI
typedef const Params __attribute__((address_space(4)))* KParams;
DI KParams kp_fresh() { KParams k = (KParams)__builtin_amdgcn_kernarg_segment_ptr(); asm volatile("" : "+s"(k)); return k; }
#define PHASE(PH, L) do { asm volatile("; PHASE_MARK " #PH); KParams k_ = kp_fresh(); run_phase<PH>(*(const Params*)k_, (L), lds, bid, nblk); if (PROBE == 20 + PH || ((PROBE_MASK >> PH) & 1) || (PROBE == 100 + PH && (L) == 0) || (PROBE == 99 && (PH == 4 || PH == 5))) { __syncthreads(); run_phase<PH>(*(const Params*)k_, (L), lds, bid, nblk); } XcdBarrier b_ = bar; asm volatile("" : "+s"(b_.bar), "+s"(b_.x)); xcd_barrier(b_); if (PROBE == 50) xcd_barrier(b_); } while (0)
__global__ void __launch_bounds__(256, 2) k_mega(Params pv) {
  DYN_LDS(lds_all);
  if (threadIdx.x == 0) *(uint4*)lds_all = make_uint4(0u, 0u, 0u, 0u);
  __syncthreads();
  XcdBarrier bar = xcd_barrier_post(pv.bar, (volatile LAS unsigned*)lds_all);
  char* lds = lds_all + 256;
  const int bid = blockIdx.x, nblk = gridDim.x;
  PHASE(0, 0);
#pragma unroll 1
  for (int l = 0; l < 2; ++l) {
    if (l == 0) PHASE(1, l);
    PHASE(2, l); PHASE(3, l); PHASE(4, l); PHASE(5, l); PHASE(6, l); PHASE(7, l);
#if !FAST_SCAN
    PHASE(8, l);
#endif

    PHASE(9, l); PHASE(10, l); PHASE(11, l); PHASE(12, l); PHASE(13, l); PHASE(14, l); PHASE(15, l);
  }
}
#endif
#ifdef CPU_EMU
void emu_check(const Params& p, int layer, int stage);
#define EMU_CHECK(stg) emu_check(p, l, stg)
static int g_nlayers = getenv("NLAYERS") ? atoi(getenv("NLAYERS")) : 2;
#else
#define EMU_CHECK(stg)
#endif
static void fill_params(Params& p, void* const* d_in, void* d_out, void* d_ws) {
  const float** f = (const float**)&p;
  for (int i = 0; i < 33; ++i) f[i] = (const float*)d_in[i];
  p.out = (float*)d_out;
  map_workspace(p, (char*)d_ws);
}
#define LAUNCH_PHASE(PH, L) LAUNCH((k_phase<PH>), grid, 256, MEGA_LDS, stream, p, L)

extern "C" void kernel_launch(void* const* d_in, const int* in_sizes, int n_in, void* d_out, int out_size, void* d_ws,
                              size_t ws_size, hipStream_t stream) {
  Params p{};
  fill_params(p, d_in, d_out, d_ws);
  if (p.ws_need > ws_size) return;
#ifdef CPU_EMU
  const int grid = 16;
  LAUNCH_PHASE(0, 0);
  for (int l = 0; l < g_nlayers; ++l) {
    if (l == 0) LAUNCH_PHASE(1, l);
    LAUNCH_PHASE(2, l); LAUNCH_PHASE(3, l); LAUNCH_PHASE(4, l); LAUNCH_PHASE(5, l); LAUNCH_PHASE(6, l); LAUNCH_PHASE(7, l); LAUNCH_PHASE(8, l);
    EMU_CHECK(1);
    LAUNCH_PHASE(9, l); LAUNCH_PHASE(10, l); LAUNCH_PHASE(11, l);
    EMU_CHECK(2);
    LAUNCH_PHASE(12, l); LAUNCH_PHASE(13, l); LAUNCH_PHASE(14, l); LAUNCH_PHASE(15, l);
    EMU_CHECK(3);
  }
#else
  static int grid = 0;
  if (grid == 0) {
    int dev = 0, cus = 0, per_cu = 0;
    (void)hipGetDevice(&dev);
    (void)hipDeviceGetAttribute(&cus, hipDeviceAttributeMultiprocessorCount, dev);
#if MK_MULTI
    (void)hipFuncSetAttribute((const void*)k_phase<0>, hipFuncAttributeMaxDynamicSharedMemorySize, MEGA_LDS);
    (void)hipFuncSetAttribute((const void*)k_phase<1>, hipFuncAttributeMaxDynamicSharedMemorySize, MEGA_LDS);
    (void)hipFuncSetAttribute((const void*)k_phase<2>, hipFuncAttributeMaxDynamicSharedMemorySize, MEGA_LDS);
    (void)hipFuncSetAttribute((const void*)k_phase<3>, hipFuncAttributeMaxDynamicSharedMemorySize, MEGA_LDS);
    (void)hipFuncSetAttribute((const void*)k_phase<4>, hipFuncAttributeMaxDynamicSharedMemorySize, MEGA_LDS);
    (void)hipFuncSetAttribute((const void*)k_phase<5>, hipFuncAttributeMaxDynamicSharedMemorySize, MEGA_LDS);
    (void)hipFuncSetAttribute((const void*)k_phase<6>, hipFuncAttributeMaxDynamicSharedMemorySize, MEGA_LDS);
    (void)hipFuncSetAttribute((const void*)k_phase<7>, hipFuncAttributeMaxDynamicSharedMemorySize, MEGA_LDS);
    (void)hipFuncSetAttribute((const void*)k_phase<8>, hipFuncAttributeMaxDynamicSharedMemorySize, MEGA_LDS);
    (void)hipFuncSetAttribute((const void*)k_phase<9>, hipFuncAttributeMaxDynamicSharedMemorySize, MEGA_LDS);
    (void)hipFuncSetAttribute((const void*)k_phase<10>, hipFuncAttributeMaxDynamicSharedMemorySize, MEGA_LDS);
    (void)hipFuncSetAttribute((const void*)k_phase<11>, hipFuncAttributeMaxDynamicSharedMemorySize, MEGA_LDS);
    (void)hipFuncSetAttribute((const void*)k_phase<12>, hipFuncAttributeMaxDynamicSharedMemorySize, MEGA_LDS);
    (void)hipFuncSetAttribute((const void*)k_phase<13>, hipFuncAttributeMaxDynamicSharedMemorySize, MEGA_LDS);
    (void)hipFuncSetAttribute((const void*)k_phase<14>, hipFuncAttributeMaxDynamicSharedMemorySize, MEGA_LDS);
    (void)hipFuncSetAttribute((const void*)k_phase<15>, hipFuncAttributeMaxDynamicSharedMemorySize, MEGA_LDS);
    grid = (cus > 0 ? cus : 256) * 2;
#else
    if (hipFuncSetAttribute((const void*)k_mega, hipFuncAttributeMaxDynamicSharedMemorySize, MEGA_LDS + 256) != hipSuccess) { grid = -1; return; }
    if (hipOccupancyMaxActiveBlocksPerMultiprocessor(&per_cu, (const void*)k_mega, 256, MEGA_LDS + 256) != hipSuccess) per_cu = 0;
    (void)hipGetLastError();
    if (per_cu < 1) { grid = -1; return; }
    grid = (cus > 0 ? cus : 256) * (per_cu < 2 ? per_cu : 2);
#endif
  }
  if (grid < 0) return;
#if MK_MULTI
  LAUNCH_PHASE(0, 0);
  for (int l = 0; l < 2; ++l) {
    if (l == 0) LAUNCH_PHASE(1, l);
    LAUNCH_PHASE(2, l); LAUNCH_PHASE(3, l); LAUNCH_PHASE(4, l); LAUNCH_PHASE(5, l); LAUNCH_PHASE(6, l); LAUNCH_PHASE(7, l); LAUNCH_PHASE(8, l);
    LAUNCH_PHASE(9, l); LAUNCH_PHASE(10, l); LAUNCH_PHASE(11, l); LAUNCH_PHASE(12, l); LAUNCH_PHASE(13, l); LAUNCH_PHASE(14, l); LAUNCH_PHASE(15, l);
  }
#else
  (void)hipMemsetAsync(p.bar, 0, XCD_BAR_WORDS * sizeof(unsigned), stream);
  k_mega<<<dim3(grid), dim3(256), MEGA_LDS + 256, stream>>>(p);
#endif
#endif
}
```

```cpp
#ifndef CPU_EMU
#include <hip/hip_runtime.h>
#endif
#include <stdint.h>
#include <stddef.h>

#ifndef T_LAT
#define T_LAT 16384
#endif
#ifndef T_CTX
#define T_CTX 256
#endif

#ifndef MK_MULTI
#define MK_MULTI 0
#endif
#define DI __device__ __forceinline__
typedef unsigned short bf16_t;
typedef short bf16x8 __attribute__((ext_vector_type(8)));
typedef short s16x4 __attribute__((ext_vector_type(4)));
typedef float f32x4 __attribute__((ext_vector_type(4)));
typedef float f32x16 __attribute__((ext_vector_type(16)));
typedef unsigned u32x4 __attribute__((ext_vector_type(4)));
typedef unsigned u32x2 __attribute__((ext_vector_type(2)));
typedef float f32x2 __attribute__((ext_vector_type(2)));

#ifdef CPU_EMU
static inline float u2f(unsigned u) { float f; memcpy(&f, &u, 4); return f; }
static inline unsigned f2u(float f) { unsigned u; memcpy(&u, &f, 4); return u; }
#define MFMA32(a, b, c) emu_mfma_32x32x16((a), (b), (c))
#define MFMA16(a, b, c) emu_mfma_16x16x32((a), (b), (c))
static inline float fast_exp2(float x) { return exp2f(x); }
static inline float fast_rcp(float x) { return 1.0f / x; }
static inline float fast_rsq(float x) { return 1.0f / sqrtf(x); }
static inline float hw_sin_rev(float x) { return sinf(6.283185307179586f * x); }
static inline float hw_cos_rev(float x) { return cosf(6.283185307179586f * x); }
#define LAUNCH(kern, grid, block, lds, stream, ...) emu::launch(dim3(grid), dim3(block), (size_t)(lds), [=]() { kern(__VA_ARGS__); })
#define DYN_LDS(name) char* name = emu_dynlds()
#define SCHED_BARRIER()
#define TIDX ((int)threadIdx.x)
#define WAVE_SYNC() emu::wave_barrier()
#define SETPRIO(x)
#define IGLP_OPT()
template <int M> static inline float xor_sum(float v) { return v + __shfl_xor(v, M); }
template <int M> static inline float xor_max(float v) { return fmaxf(v, __shfl_xor(v, M)); }
template <int M> static inline int xor_sum_i(int v) { return v + __shfl_xor(v, M); }
static inline int lane_bcast(int v, int src) { return __shfl(v, src); }
static inline float lane_get(float v, int src) { return __shfl(v, src); }
static inline int lane_up(int v, int d, int lane) { (void)lane; return __shfl_up(v, d); }
#else
DI float u2f(unsigned u) { return __uint_as_float(u); }
DI unsigned f2u(float f) { return __float_as_uint(f); }
#define MFMA32(a, b, c) __builtin_amdgcn_mfma_f32_32x32x16_bf16((a), (b), (c), 0, 0, 0)
#define MFMA16(a, b, c) __builtin_amdgcn_mfma_f32_16x16x32_bf16((a), (b), (c), 0, 0, 0)
DI float fast_exp2(float x) { return __builtin_amdgcn_exp2f(x); }
DI float fast_rcp(float x) { return __builtin_amdgcn_rcpf(x); }
DI float fast_rsq(float x) { return __builtin_amdgcn_rsqf(x); }
DI float hw_sin_rev(float x) { return __builtin_amdgcn_sinf(x); }
DI float hw_cos_rev(float x) { return __builtin_amdgcn_cosf(x); }
#define LAUNCH(kern, grid, block, lds, stream, ...) kern<<<dim3(grid), dim3(block), (lds), (stream)>>>(__VA_ARGS__)
#define DYN_LDS(name) extern __shared__ __attribute__((aligned(16))) char name[]
#define SCHED_BARRIER() __builtin_amdgcn_sched_barrier(0)
DI int tid_fresh() { int t = (int)threadIdx.x; asm volatile("" : "+v"(t)); return t; }
#define TIDX tid_fresh()
#define WAVE_SYNC() __builtin_amdgcn_wave_barrier()
#define SETPRIO(x) __builtin_amdgcn_s_setprio(x)
#define IGLP_OPT() __builtin_amdgcn_iglp_opt(0)
#ifdef USE_SHFL
template <int M> DI float xor_sum(float v) { return v + __shfl_xor(v, M); }
template <int M> DI float xor_max(float v) { return fmaxf(v, __shfl_xor(v, M)); }
template <int M> DI int xor_sum_i(int v) { return v + __shfl_xor(v, M); }
DI int lane_bcast(int v, int src) { return __shfl(v, src); }
DI int lane_up(int v, int d, int lane) { (void)lane; return __shfl_up(v, d); }
#else
template <int M> DI int xor_partner_bits(int bits) { return __builtin_amdgcn_ds_swizzle(bits, (M << 10) | 0x1f); }
DI void half_swap(unsigned& a, unsigned& b) { asm volatile("s_nop 1\n\tv_permlane32_swap_b32 %0, %1\n\ts_nop 1" : "+v"(a), "+v"(b)); }
template <int M> DI float xor_sum(float v) {
  if constexpr (M < 32) return v + __builtin_bit_cast(float, xor_partner_bits<M>(__builtin_bit_cast(int, v)));
  else { unsigned a = __builtin_bit_cast(unsigned, v), b = a; half_swap(a, b); return __builtin_bit_cast(float, a) + __builtin_bit_cast(float, b); }
}
template <int M> DI float xor_max(float v) {
  if constexpr (M < 32) return fmaxf(v, __builtin_bit_cast(float, xor_partner_bits<M>(__builtin_bit_cast(int, v))));
  else { unsigned a = __builtin_bit_cast(unsigned, v), b = a; half_swap(a, b); return fmaxf(__builtin_bit_cast(float, a), __builtin_bit_cast(float, b)); }
}
template <int M> DI int xor_sum_i(int v) {
  if constexpr (M < 32) return v + xor_partner_bits<M>(v);
  else { unsigned a = (unsigned)v, b = a; half_swap(a, b); return (int)(a + b); }
}
DI int lane_bcast(int v, int src) { return __builtin_amdgcn_readlane(v, src); }
DI float lane_get(float v, int src) { return __builtin_bit_cast(float, __builtin_amdgcn_ds_bpermute(src << 2, __builtin_bit_cast(int, v))); }
DI int lane_up(int v, int d, int lane) { return __builtin_amdgcn_ds_bpermute(((lane - d) & 63) << 2, v); }
#endif
#endif

DI float bf2f(bf16_t v) { return u2f(((unsigned)v) << 16); }
#ifdef CPU_EMU
DI bf16_t f2bf(float f) { unsigned u = f2u(f); u += 0x7fffu + ((u >> 16) & 1u); return (bf16_t)(u >> 16); }
DI unsigned pack2bf(float lo, float hi) { return (unsigned)f2bf(lo) | ((unsigned)f2bf(hi) << 16); }
static inline unsigned wave_ballot16(bool pr) { unsigned m = 0; for (int e = 0; e < 16; ++e) m |= (__shfl(pr ? 1 : 0, e) ? 1u : 0u) << e; return m; }
static inline bool wave_any(bool pr) { int v = pr ? 1 : 0; v |= __shfl_xor(v, 1); v |= __shfl_xor(v, 2); v |= __shfl_xor(v, 4); v |= __shfl_xor(v, 8); v |= __shfl_xor(v, 16); v |= __shfl_xor(v, 32); return v != 0; }
#else
typedef float f32x2_ __attribute__((ext_vector_type(2)));
typedef __bf16 bf16x2_hw __attribute__((ext_vector_type(2)));
DI unsigned pack2bf(float lo, float hi) { const f32x2_ v = {lo, hi}; return __builtin_bit_cast(unsigned, __builtin_convertvector(v, bf16x2_hw)); }
DI bf16_t f2bf(float f) { return (bf16_t)(pack2bf(f, f) & 0xffffu); }
DI bool wave_any(bool pr) { return __builtin_amdgcn_ballot_w64(pr) != 0ull; }
DI unsigned wave_ballot16(bool pr) { return (unsigned)__builtin_amdgcn_ballot_w64(pr) & 0xffffu; }
#endif
DI float sigmoidf_(float x) { return 1.0f / (1.0f + expf(-x)); }
DI float siluf_(float x) { return x / (1.0f + expf(-x)); }
DI float logsigmoidf_(float x) { return fminf(x, 0.0f) - log1pf(expf(-fabsf(x))); }

constexpr int D = 1024, NB = 2, TL = T_LAT, TC = T_CTX, TK = TL + TC;
constexpr int RL = NB * TL, RC = NB * TC, R = RL + RC;
constexpr int NZ = 3024, NZP = 3072;
constexpr int ZC_QLAT = 0, ZC_KVLAT = 256, ZC_KROPE = 384, ZC_MLQK = 416, ZC_MLV = 928, ZC_MLO = 1184, ZC_MLIG = 1440,
              ZC_MLFG = 1448, ZC_GQ = 1456, ZC_GK = 1584, ZC_GV = 1712, ZC_GR = 1968, ZC_GA = 2224, ZC_DQ = 2256,
              ZC_DK = 2512, ZC_DV = 2768;
constexpr int NCK = TK / 64, NCC = TC / 64, NCL = TL / 64;
constexpr int NE = 16, FF = 1408, CAPL = 2 * TL / 16, CAPC = 2 * TC / 16, CAPT = CAPL + CAPC, NSLOT = NB * CAPT;
constexpr size_t WSZ_IN = (size_t)NZP * D, WSZ_UQ = 384 * 256, WSZ_UKV = 512 * 128, WSZ_GATE = (size_t)4096 * D, WSZ_BR = (size_t)4 * D * 256, WSZ_OUT = (size_t)D * D;
constexpr int NUNIT = NB * 2 * NCK * 4;
constexpr float LOG2E = 1.4426950408889634f;
constexpr float QS_MLA = 0.10206207261596577f * LOG2E;
constexpr float QS_DIFF = 0.17677669529663687f * LOG2E;

DI int row_of(int b, int s) { return s < TC ? RL + b * TC + s : b * TL + (s - TC); }
DI void bs_of(int r, int& b, int& s) { if (r < RL) { b = r / TL; s = TC + (r % TL); } else { int q = r - RL; b = q / TC; s = q % TC; } }
DI int seq_of(int d, int p) { return d == 0 ? p : (p < TC ? TC - 1 - p : TK - 1 - (p - TC)); }
DI int step_of(int d, int c) { return d == 0 ? c : (c < NCC ? NCC - 1 - c : NCC + (NCK - 1 - c)); }

struct Params {
  const float *x, *c, *ctx, *c_ctx, *w_ada, *b_ada, *g_mix_pre, *g_mix_post, *g_ffn_pre, *g_ffn_post, *w_in, *g_q_lat, *w_uq,
      *g_kv_lat, *w_ukv, *w_conv, *b_conv, *b_igate, *b_fgate, *g_mlstm_out, *w_alpha2, *b_alpha, *g_gla_out, *diff_lambda,
      *g_diff_out, *w_branch, *w_gate, *b_gate, *w_out, *w_router, *w_e_gate, *w_e_up, *w_e_down;
  float* out;
  float *mods, *xc;
  bf16_t *H, *Z, *Qm, *Km, *Vtm, *Qd, *Kd, *Vtd, *MQ, *MK, *Y, *MG, *YO, *HID, *YE, *MVt, *GVt;
  float *BC, *IGS, *GC, *MC, *MN, *MM, *GS, *HD, *OD, *AFF, *SELV;
  int *SEL, *INV;
  bf16_t *Wt_in, *Wt_uq, *Wt_ukv, *Wt_gate, *Wt_branch, *Wt_out, *Wt_eg, *Wt_eu, *Wt_ed;
  unsigned* bar;
  size_t ws_need;
};

static inline size_t al256(size_t x) { return (x + 255) & ~(size_t)255; }
static inline void map_workspace(Params& p, char* ws) {
  size_t o = 0;
  auto take = [&](size_t bytes) { size_t r = o; o += al256(bytes); return ws + r; };
  p.bar = (unsigned*)take(16384);
  p.mods = (float*)take((size_t)2 * 3 * 6144 * 4);
  p.xc = (float*)take((size_t)RC * D * 4);
  p.BC = (float*)take((size_t)NB * 2 * TK * 4 * 4);
  p.IGS = (float*)take((size_t)NB * 2 * TK * 4 * 4);
  p.AFF = (float*)take((size_t)NB * NE * TK * 4);
  p.SEL = (int*)take((size_t)NE * NSLOT * 4);
  p.SELV = (float*)take((size_t)NE * NSLOT * 4);
  p.INV = (int*)take((size_t)R * NE * 4);
  p.MM = (float*)take((size_t)NUNIT * 4 * 4);
  p.MN = (float*)take((size_t)NUNIT * 64 * 4);
  p.Wt_in = (bf16_t*)take((size_t)2 * WSZ_IN * 2);
  p.Wt_uq = (bf16_t*)take((size_t)2 * WSZ_UQ * 2);
  p.Wt_ukv = (bf16_t*)take((size_t)2 * WSZ_UKV * 2);
  p.Wt_gate = (bf16_t*)take((size_t)2 * WSZ_GATE * 2);
  p.Wt_branch = (bf16_t*)take((size_t)2 * WSZ_BR * 2);
  p.Wt_out = (bf16_t*)take((size_t)2 * WSZ_OUT * 2);
  p.H = (bf16_t*)take((size_t)R * D * 2);
  size_t szA = (size_t)R * NZP * 2, szHID = (size_t)NE * NSLOT * FF * 2;
  char* A = take(szA > szHID ? szA : szHID);
  p.Z = (bf16_t*)A; p.HID = (bf16_t*)A;
  size_t szQm = al256((size_t)NB * 4 * TK * 96 * 2), szVt = al256((size_t)NB * 4 * 64 * TK * 2), szQd = al256((size_t)NB * 8 * TK * 32 * 2);
  size_t szB1 = 2 * szQm + 2 * szVt + 2 * szQd;
  size_t szHD = al256((size_t)2 * NB * TK * 256 * 4);
  size_t szYE = (size_t)NE * NSLOT * D * 2;
  size_t szB = szB1; if (2 * szHD > szB) szB = 2 * szHD; if (szYE > szB) szB = szYE;
  char* Bq = take(szB);
  p.Qm = (bf16_t*)Bq; p.Km = (bf16_t*)(Bq + szQm); p.Vtm = (bf16_t*)(Bq + 2 * szQm);
  p.Qd = (bf16_t*)(Bq + 2 * szQm + szVt); p.Kd = (bf16_t*)(Bq + 2 * szQm + szVt + szQd); p.Vtd = (bf16_t*)(Bq + 2 * szQm + szVt + 2 * szQd);
  p.YE = (bf16_t*)Bq;
  p.GC = (float*)take((size_t)NB * 2 * TK * 128 * 4);
  p.MVt = (bf16_t*)take((size_t)NB * 4 * 64 * TK * 2);
  p.GVt = (bf16_t*)take((size_t)NB * 4 * 64 * TK * 2);
  size_t szW = (size_t)NE * FF * D * 2;
  size_t szMC = (size_t)NUNIT * 4096 * 4, szRD = (size_t)R * D * 2;
  size_t szC = szMC; if (szRD > szC) szC = szRD; if (szW > szC) szC = szW;
  char* C = take(szC);
  p.MC = (float*)C; p.MG = (bf16_t*)C; p.Wt_eg = (bf16_t*)C;
  size_t szMQ = al256((size_t)NB * TK * 256 * 2), szGS = (size_t)NUNIT * 2048 * 4;
  size_t szD = 2 * szMQ + szGS; if (szW > szD) szD = szW;
  char* Dq = take(szD);
  p.MQ = (bf16_t*)Dq; p.MK = (bf16_t*)(Dq + szMQ); p.GS = (float*)(Dq + 2 * szMQ); p.Wt_eu = (bf16_t*)Dq;
  size_t szF = 2 * szRD > szW ? 2 * szRD : szW;
  char* F = take(szF);
  p.Y = (bf16_t*)F; p.YO = (bf16_t*)(F + szRD); p.Wt_ed = (bf16_t*)F;
  p.HD = (float*)Bq; p.OD = (float*)(Bq + szHD);
  p.ws_need = o;
}
#define GTID ((long)blockIdx.x * blockDim.x + threadIdx.x)

DI float lam_of(const Params& p, int layer, float& lam_init) {
  const float* lv = p.diff_lambda + layer * 128;
  float s1 = 0.f, s2 = 0.f;
  for (int i = 0; i < 32; ++i) { s1 += lv[i] * lv[32 + i]; s2 += lv[64 + i] * lv[96 + i]; }
  lam_init = layer == 0 ? 0.2f : 0.35550906759096f;
  return expf(s1) - expf(s2) + lam_init;
}
DI void rope_cs(int s, int jj, float& cs, float& sn) {
  int t = s - TC;
  int pos = (jj < 16) ? (t / 64) : (t % 64);
  float ang = (float)pos * exp2f(-1.6609640474436813f * (float)(jj & 7));
  double rev = (double)ang * 0.15915494309189535;
  rev -= floor(rev + 0.5);
  float rf = (float)rev;
  cs = hw_cos_rev(rf); sn = hw_sin_rev(rf);
}
template <class G> DI float rope_elem(G get, int s, int jj) {
  if (s < TC) return get(jj);
  float cs, sn; rope_cs(s, jj, cs, sn);
  float a = get(jj), b = get(jj ^ 8);
  return (jj & 8) ? (a * cs + b * sn) : (a * cs - b * sn);
}

DI void nvb_mods(long GI, const Params& p) {
  long i = GI; if (i >= 2 * 3 * 6144) return;
  int col = (int)(i % 6144), w = (int)((i / 6144) % 3), l = (int)(i / (3 * 6144));
  const float* cv = w < 2 ? p.c + w * 1024 : p.c_ctx;
  const float* W = p.w_ada + (size_t)l * 1024 * 6144;
  float acc = 0.f;
  for (int k = 0; k < 1024; ++k) acc += siluf_(cv[k]) * W[(size_t)k * 6144 + col];
  p.mods[i] = acc + p.b_ada[l * 6144 + col];
}
__global__ void __launch_bounds__(256) nv_wt(const float* in, bf16_t* out, int K, int N, int NP, long in_bs, long out_bs, const float* gain) {
  long i = GTID; if (i >= (long)NP * K) return;
  int k = (int)(i % K), n = (int)(i / K);
  const float* I = in + (size_t)blockIdx.y * in_bs; bf16_t* O = out + (size_t)blockIdx.y * out_bs;
  O[(size_t)n * K + k] = n < N ? f2bf(I[(size_t)k * N + n] * (gain ? gain[k] : 1.0f)) : (bf16_t)0;
}
__global__ void __launch_bounds__(256) nv_modulate(Params p, int layer, int which, const float* xl, const float* xcx, int nrows) {
  long r = GTID; if (r >= nrows) return;
  int w = r < RL ? (int)(r / TL) : 2;
  const float* mb = p.mods + (size_t)(layer * 3 + w) * 6144;
  const float* shift = mb + (which ? 3 : 0) * 1024; const float* scale = mb + (which ? 4 : 1) * 1024;
  const float* g = (which ? p.g_ffn_pre : p.g_mix_pre) + layer * 1024;
  const float* x = r < RL ? xl + (size_t)r * D : xcx + (size_t)(r - RL) * D;
  float ss = 0.f; for (int k = 0; k < D; ++k) ss += x[k] * x[k];
  float rstd = 1.0f / sqrtf(ss / D + 1e-6f);
  for (int k = 0; k < D; ++k) p.H[(size_t)r * D + k] = f2bf(x[k] * rstd * g[k] * (1.f + scale[k]) + shift[k]);
}
__global__ void __launch_bounds__(256) nv_gemm(const bf16_t* A, int lda, const bf16_t* Bt, int ldb, int M, int N, int K, bf16_t* C, int ldc) {
  long i = GTID; if (i >= (long)M * N) return;
  int n = (int)(i % N), m = (int)(i / N);
  const bf16_t* a = A + (size_t)m * lda; const bf16_t* b = Bt + (size_t)n * ldb;
  float acc = 0.f;
  for (int k = 0; k < K; ++k) acc += bf2f(a[k]) * bf2f(b[k]);
  C[(size_t)m * ldc + n] = f2bf(acc);
}
__global__ void __launch_bounds__(256) nv_mla_q(Params p, int layer) {
  long i = GTID; if (i >= (long)R * 4 * 96) return;
  int j = (int)(i % 96), h = (int)((i / 96) % 4), r = (int)(i / 384);
  int b, s; bs_of(r, b, s);
  const bf16_t* z = p.Z + (size_t)r * NZP + ZC_QLAT;
  const float* g = p.g_q_lat + layer * 256; const float* W = p.w_uq + (size_t)layer * 256 * 384;
  float ss = 0.f; for (int k = 0; k < 256; ++k) { float v = bf2f(z[k]); ss += v * v; }
  float rstd = 1.0f / sqrtf(ss / 256 + 1e-6f);
  auto dot = [&](int col) { float a = 0.f; for (int k = 0; k < 256; ++k) a += bf2f(z[k]) * rstd * g[k] * W[(size_t)k * 384 + col]; return a; };
  float v;
  if (j < 64) v = dot(h * 96 + j);
  else v = rope_elem([&](int jj) { return dot(h * 96 + 64 + jj); }, s, j - 64);
  p.Qm[(((size_t)b * 4 + h) * TK + s) * 96 + j] = f2bf(v * QS_MLA);
}
__global__ void __launch_bounds__(256) nv_mla_kv(Params p, int layer) {
  long i = GTID; if (i >= (long)R * 4 * 160) return;
  int j = (int)(i % 160), h = (int)((i / 160) % 4), r = (int)(i / 640);
  int b, s; bs_of(r, b, s);
  const bf16_t* z = p.Z + (size_t)r * NZP;
  if (j < 128) {
    const bf16_t* zl = z + ZC_KVLAT; const float* g = p.g_kv_lat + layer * 128; const float* W = p.w_ukv + (size_t)layer * 128 * 512;
    float ss = 0.f; for (int k = 0; k < 128; ++k) { float v = bf2f(zl[k]); ss += v * v; }
    float rstd = 1.0f / sqrtf(ss / 128 + 1e-6f);
    float a = 0.f; for (int k = 0; k < 128; ++k) a += bf2f(zl[k]) * rstd * g[k] * W[(size_t)k * 512 + h * 128 + j];
    if (j < 64) p.Km[(((size_t)b * 4 + h) * TK + s) * 96 + j] = f2bf(a);
    else p.Vtm[(((size_t)b * 4 + h) * 64 + (j - 64)) * TK + s] = f2bf(a);
  } else {
    int jj = j - 128;
    float v = rope_elem([&](int q) { return bf2f(z[ZC_KROPE + q]); }, s, jj);
    p.Km[(((size_t)b * 4 + h) * TK + s) * 96 + 64 + jj] = f2bf(v);
  }
}
__global__ void __launch_bounds__(256) nv_diff_prep(Params p) {
  long i = GTID; if (i >= (long)R * 768) return;
  int c = (int)(i % 768), r = (int)(i / 768);
  int b, s; bs_of(r, b, s);
  const bf16_t* z = p.Z + (size_t)r * NZP;
  if (c < 512) {
    int qk = c / 256, cc = c % 256, hm = cc / 32, jj = cc % 32;
    const bf16_t* src = z + (qk ? ZC_DK : ZC_DQ) + hm * 32;
    float v = rope_elem([&](int q) { return bf2f(src[q]); }, s, jj);
    if (qk == 0) p.Qd[(((size_t)b * 8 + hm) * TK + s) * 32 + jj] = f2bf(v * QS_DIFF);
    else p.Kd[(((size_t)b * 8 + hm) * TK + s) * 32 + jj] = f2bf(v);
  } else {
    int cc = c - 512, h = cc / 64, dv = cc % 64;
    p.Vtd[(((size_t)b * 4 + h) * 64 + dv) * TK + s] = z[ZC_DV + cc];
  }
}
__global__ void __launch_bounds__(256) nv_ml_prep(Params p, int layer) {
  long i = GTID; if (i >= (long)R * 512) return;
  int ch = (int)(i % 512), r = (int)(i / 512);
  int b, s; bs_of(r, b, s);
  bool first = (s == 0) || (s == TC), last = (s == TC - 1) || (s == TK - 1);
  const float* w = p.w_conv + (size_t)layer * 3 * 512;
  float acc = p.b_conv[layer * 512 + ch];
  acc += bf2f(p.Z[(size_t)r * NZP + ZC_MLQK + ch]) * w[512 + ch];
  if (!first) acc += bf2f(p.Z[(size_t)row_of(b, s - 1) * NZP + ZC_MLQK + ch]) * w[ch];
  if (!last) acc += bf2f(p.Z[(size_t)row_of(b, s + 1) * NZP + ZC_MLQK + ch]) * w[1024 + ch];
  float v = siluf_(acc);
  if (ch < 256) p.MQ[((size_t)b * TK + s) * 256 + ch] = f2bf(v);
  else p.MK[((size_t)b * TK + s) * 256 + ch - 256] = f2bf(v * 0.125f);
}
DI void nvb_ml_gates(long GI, const Params& p, int layer) {
  long i = GI; if (i >= (long)NB * 2 * NCK * 4) return;
  int h = (int)(i % 4), j = (int)((i / 4) % NCK), d = (int)((i / (4 * NCK)) % 2), b = (int)(i / (8 * NCK));
  float bi = p.b_igate[layer * 8 + d * 4 + h], bfg = p.b_fgate[layer * 8 + d * 4 + h];
  float cum = 0.f;
  for (int l = 0; l < 64; ++l) {
    int pp = 64 * j + l, s = seq_of(d, pp); const bf16_t* z = p.Z + (size_t)row_of(b, s) * NZP;
    float ig = bf2f(z[ZC_MLIG + d * 4 + h]) + bi;
    float lf = logsigmoidf_(bf2f(z[ZC_MLFG + d * 4 + h]) + bfg);
    cum += lf;
    size_t o = (((size_t)b * 2 + d) * TK + pp) * 4 + h;
    p.BC[o] = cum; p.IGS[o] = ig;
  }
}
DI void nvb_gla_cum(long GI, const Params& p, int layer) {
  long i = GI; if (i >= (long)NB * 2 * NCK * 128) return;
  int ch = (int)(i % 128), j = (int)((i / 128) % NCK), d = (int)((i / (128 * NCK)) % 2), b = (int)(i / (256 * NCK));
  const float* W = p.w_alpha2 + (size_t)layer * 2 * 16 * 128 + (size_t)d * 16 * 128;
  float ba = p.b_alpha[layer * 256 + d * 128 + ch];
  float cum = 0.f;
  for (int l = 0; l < 64; ++l) {
    int pp = 64 * j + l, s = seq_of(d, pp); const bf16_t* z = p.Z + (size_t)row_of(b, s) * NZP + ZC_GA + d * 16;
    float zg = ba; for (int q = 0; q < 16; ++q) zg += bf2f(z[q]) * W[q * 128 + ch];
    cum += logsigmoidf_(zg) * (1.0f / 16.0f);
    p.GC[(((size_t)b * 2 + d) * TK + pp) * 128 + ch] = cum;
  }
}
__global__ void __launch_bounds__(256) nv_attn_mla(Params p, int need_ctx) {
  long i = GTID; if (i >= (long)NB * 4 * TK) return;
  int s = (int)(i % TK), h = (int)((i / TK) % 4), b = (int)(i / (4 * TK));
  if (s < TC && !need_ctx) return;
  int nk = s < TC ? TC : TK;
  const bf16_t* q = p.Qm + (((size_t)b * 4 + h) * TK + s) * 96;
  const bf16_t* K = p.Km + ((size_t)b * 4 + h) * TK * 96;
  const bf16_t* Vt = p.Vtm + ((size_t)b * 4 + h) * 64 * TK;
  float qf[96], o[64];
  _Pragma("unroll") for (int k = 0; k < 96; ++k) qf[k] = bf2f(q[k]);
  _Pragma("unroll") for (int k = 0; k < 64; ++k) o[k] = 0.f;
  float m = -1e30f, l = 0.f;
  for (int t = 0; t < nk; ++t) {
    float sc = 0.f; _Pragma("unroll") for (int k = 0; k < 96; ++k) sc += qf[k] * bf2f(K[(size_t)t * 96 + k]);
    float mn = fmaxf(m, sc), a = exp2f(m - mn), pr = exp2f(sc - mn);
    l = l * a + pr;
    _Pragma("unroll") for (int k = 0; k < 64; ++k) o[k] = o[k] * a + pr * bf2f(Vt[(size_t)k * TK + t]);
    m = mn;
  }
  int r = row_of(b, s);
  _Pragma("unroll") for (int k = 0; k < 64; ++k) p.Y[(size_t)r * D + h * 64 + k] = f2bf(o[k] / l);
}
__global__ void __launch_bounds__(256) nv_attn_diff(Params p, int layer, int need_ctx) {
  long i = GTID; if (i >= (long)NB * 4 * TK) return;
  int s = (int)(i % TK), h = (int)((i / TK) % 4), b = (int)(i / (4 * TK));
  if (s < TC && !need_ctx) return;
  int nk = s < TC ? TC : TK;
  float lam_init; float lam = lam_of(p, layer, lam_init);
  const bf16_t* Vt = p.Vtd + ((size_t)b * 4 + h) * 64 * TK;
  float res[64];
  _Pragma("unroll") for (int k = 0; k < 64; ++k) res[k] = 0.f;
  _Pragma("unroll") for (int mp = 0; mp < 2; ++mp) {
    const bf16_t* q = p.Qd + (((size_t)b * 8 + h * 2 + mp) * TK + s) * 32;
    const bf16_t* K = p.Kd + ((size_t)b * 8 + h * 2 + mp) * TK * 32;
    float qf[32], o[64];
    _Pragma("unroll") for (int k = 0; k < 32; ++k) qf[k] = bf2f(q[k]);
    _Pragma("unroll") for (int k = 0; k < 64; ++k) o[k] = 0.f;
    float m = -1e30f, l = 0.f;
    for (int t = 0; t < nk; ++t) {
      float sc = 0.f; _Pragma("unroll") for (int k = 0; k < 32; ++k) sc += qf[k] * bf2f(K[(size_t)t * 32 + k]);
      float mn = fmaxf(m, sc), a = exp2f(m - mn), pr = exp2f(sc - mn);
      l = l * a + pr;
      _Pragma("unroll") for (int k = 0; k < 64; ++k) o[k] = o[k] * a + pr * bf2f(Vt[(size_t)k * TK + t]);
      m = mn;
    }
    float wgt = mp == 0 ? 1.f : -lam;
    _Pragma("unroll") for (int k = 0; k < 64; ++k) res[k] += wgt * o[k] / l;
  }
  float ss = 0.f; _Pragma("unroll") for (int k = 0; k < 64; ++k) ss += res[k] * res[k];
  float rstd = 1.0f / sqrtf(ss / 64 + 1e-6f);
  int r = row_of(b, s);
  _Pragma("unroll") for (int k = 0; k < 64; ++k) p.Y[(size_t)r * D + 768 + h * 64 + k] = f2bf(res[k] * rstd * p.g_diff_out[layer * 256 + h * 64 + k] * (1.f - lam_init));
}
DI void nvb_ml_local(long GI, const Params& p) {
  long i = GI; if (i >= (long)NUNIT * 4160) return;
  int e = (int)(i % 4160); long u = i / 4160;
  int h = (int)(u % 4), j = (int)((u / 4) % NCK), d = (int)((u / (4 * NCK)) % 2), b = (int)(u / (8 * NCK));
  const float* bc = p.BC + (((size_t)b * 2 + d) * TK + 64 * j) * 4 + h; const float* ig = p.IGS + (((size_t)b * 2 + d) * TK + 64 * j) * 4 + h;
  float bend = bc[63 * 4], ml = -1e30f;
  for (int l = 0; l < 64; ++l) ml = fmaxf(ml, bend - bc[l * 4] + ig[l * 4]);
  if (e == 4096 + 0) { p.MM[u * 4 + 0] = ml; p.MM[u * 4 + 1] = bend; }
  float acc = 0.f;
  if (e < 4096) {
    int v = e / 64, k = e % 64;
    for (int l = 0; l < 64; ++l) {
      int s = seq_of(d, 64 * j + l); float w = expf(bend - bc[l * 4] + ig[l * 4] - ml);
      acc += w * bf2f(p.Z[(size_t)row_of(b, s) * NZP + ZC_MLV + h * 64 + v]) * bf2f(p.MK[((size_t)b * TK + s) * 256 + h * 64 + k]);
    }
    p.MC[(size_t)u * 4096 + e] = acc;
  } else {
    int k = e - 4096;
    for (int l = 0; l < 64; ++l) {
      int s = seq_of(d, 64 * j + l); float w = expf(bend - bc[l * 4] + ig[l * 4] - ml);
      acc += w * bf2f(p.MK[((size_t)b * TK + s) * 256 + h * 64 + k]);
    }
    p.MN[(size_t)u * 64 + k] = acc;
  }
}
DI void nvb_ml_scan(long GI, const Params& p) {
  long i = GI; if (i >= (long)NB * 2 * 4 * 4160) return;
  int e = (int)(i % 4160); int ch = (int)(i / 4160); int h = ch % 4, bd = ch / 4;
  float st = 0.f, m = -1e30f;
  for (int j = 0; j < NCK; ++j) {
    size_t u = ((size_t)bd * NCK + j) * 4 + h;
    float ml = p.MM[u * 4 + 0], be = p.MM[u * 4 + 1];
    float mn = fmaxf(be + m, ml), a = expf(be + m - mn), g = expf(ml - mn);
    float* slot = e < 4096 ? &p.MC[u * 4096 + e] : &p.MN[u * 64 + (e - 4096)];
    float loc = *slot; *slot = st; st = a * st + g * loc;
    if (e == 0) p.MM[u * 4 + 2] = m;
    m = mn;
  }
}
DI void nvb_ml_out(long GI, const Params& p, int need_ctx) {
  long i = GI; if (i >= (long)NUNIT * 4096) return;
  int v = (int)(i % 64), l = (int)((i / 64) % 64); long u = i / 4096;
  int h = (int)(u % 4), j = (int)((u / 4) % NCK), d = (int)((u / (4 * NCK)) % 2), b = (int)(u / (8 * NCK));
  if (j < NCC && !need_ctx) return;
  const float* bc = p.BC + (((size_t)b * 2 + d) * TK + 64 * j) * 4 + h; const float* ig = p.IGS + (((size_t)b * 2 + d) * TK + 64 * j) * 4 + h;
  float m0 = p.MM[u * 4 + 2];
  int sl = seq_of(d, 64 * j + l);
  const bf16_t* q = p.MQ + ((size_t)b * TK + sl) * 256 + h * 64;
  float bl = bc[l * 4];
  float inter = bl + m0, mt = inter;
  for (int t = 0; t <= l; ++t) mt = fmaxf(mt, bl - bc[t * 4] + ig[t * 4]);
  float num = 0.f, den = 0.f;
  for (int t = 0; t <= l; ++t) {
    int st = seq_of(d, 64 * j + t);
    const bf16_t* k = p.MK + ((size_t)b * TK + st) * 256 + h * 64;
    float qk = 0.f; for (int c = 0; c < 64; ++c) qk += bf2f(q[c]) * bf2f(k[c]);
    float sv = expf(bl - bc[t * 4] + ig[t * 4] - mt) * qk;
    num += sv * bf2f(p.Z[(size_t)row_of(b, st) * NZP + ZC_MLV + h * 64 + v]); den += sv;
  }
  float ai = expf(inter - mt);
  float qc = 0.f, qn = 0.f;
  for (int c = 0; c < 64; ++c) { qc += bf2f(q[c]) * p.MC[(size_t)u * 4096 + v * 64 + c]; qn += bf2f(q[c]) * p.MN[(size_t)u * 64 + c]; }
  num += ai * qc; den += ai * qn;
  p.HD[(((size_t)d * NB + b) * TK + sl) * 256 + h * 64 + v] = num / fmaxf(fabsf(den), expf(-mt));
}
DI void nvb_ml_finish(long GI, const Params& p, int layer, int need_ctx) {
  long i = GI; if (i >= (long)R * 4) return;
  int h = (int)(i % 4), r = (int)(i / 4); int b, s; bs_of(r, b, s);
  if (s < TC && !need_ctx) return;
  const float* h0 = p.HD + (((size_t)0 * NB + b) * TK + s) * 256 + h * 64; const float* h1 = p.HD + (((size_t)1 * NB + b) * TK + s) * 256 + h * 64;
  float ss = 0.f; for (int v = 0; v < 64; ++v) { float t = h0[v] + h1[v]; ss += t * t; }
  float rstd = 1.0f / sqrtf(ss / 64 + 1e-6f);
  for (int v = 0; v < 64; ++v) {
    float o = bf2f(p.Z[(size_t)r * NZP + ZC_MLO + h * 64 + v]);
    p.Y[(size_t)r * D + 256 + h * 64 + v] = f2bf(sigmoidf_(o) * (h0[v] + h1[v]) * rstd * p.g_mlstm_out[layer * 256 + h * 64 + v]);
  }
}
DI void nvb_gla_local(long GI, const Params& p) {
  long i = GI; if (i >= (long)NUNIT * 2048) return;
  int v = (int)(i % 64), k = (int)((i / 64) % 32); long u = i / 2048;
  int h = (int)(u % 4), j = (int)((u / 4) % NCK), d = (int)((u / (4 * NCK)) % 2), b = (int)(u / (8 * NCK));
  const float* gc = p.GC + (((size_t)b * 2 + d) * TK + 64 * j) * 128 + h * 32 + k;
  float ge = gc[63 * 128], acc = 0.f;
  for (int l = 0; l < 64; ++l) {
    int s = seq_of(d, 64 * j + l); const bf16_t* z = p.Z + (size_t)row_of(b, s) * NZP;
    acc += bf2f(z[ZC_GK + h * 32 + k]) * expf(ge - gc[l * 128]) * bf2f(z[ZC_GV + h * 64 + v]);
  }
  p.GS[(size_t)u * 2048 + v * 32 + k] = acc;
}
DI void nvb_gla_scan(long GI, const Params& p) {
  long i = GI; if (i >= (long)NB * 2 * 4 * 2048) return;
  int e = (int)(i % 2048); int ch = (int)(i / 2048); int h = ch % 4, bd = ch / 4; int k = e % 32;
  float st = 0.f;
  for (int j = 0; j < NCK; ++j) {
    size_t u = ((size_t)bd * NCK + j) * 4 + h;
    float ge = p.GC[((size_t)bd * TK + 64 * j + 63) * 128 + h * 32 + k];
    float loc = p.GS[u * 2048 + e]; p.GS[u * 2048 + e] = st; st = expf(ge) * st + loc;
  }
}
DI void nvb_gla_out(long GI, const Params& p, int need_ctx) {
  long i = GI; if (i >= (long)NUNIT * 4096) return;
  int v = (int)(i % 64), l = (int)((i / 64) % 64); long u = i / 4096;
  int h = (int)(u % 4), j = (int)((u / 4) % NCK), d = (int)((u / (4 * NCK)) % 2), b = (int)(u / (8 * NCK));
  if (j < NCC && !need_ctx) return;
  const float* gc = p.GC + (((size_t)b * 2 + d) * TK + 64 * j) * 128 + h * 32;
  int sl = seq_of(d, 64 * j + l);
  const bf16_t* q = p.Z + (size_t)row_of(b, sl) * NZP + ZC_GQ + h * 32;
  const float qs = 0.17677669529663687f;
  float acc = 0.f;
  for (int t = 0; t <= l; ++t) {
    int st = seq_of(d, 64 * j + t); const bf16_t* z = p.Z + (size_t)row_of(b, st) * NZP;
    float att = 0.f; for (int k = 0; k < 32; ++k) att += bf2f(q[k]) * qs * expf(gc[l * 128 + k] - gc[t * 128 + k]) * bf2f(z[ZC_GK + h * 32 + k]);
    acc += att * bf2f(z[ZC_GV + h * 64 + v]);
  }
  for (int k = 0; k < 32; ++k) acc += bf2f(q[k]) * qs * expf(gc[l * 128 + k]) * p.GS[(size_t)u * 2048 + v * 32 + k];
  p.OD[(((size_t)d * NB + b) * TK + sl) * 256 + h * 64 + v] = acc;
}
DI void nvb_gla_finish(long GI, const Params& p, int layer, int need_ctx) {
  long i = GI; if (i >= (long)R * 4) return;
  int h = (int)(i % 4), r = (int)(i / 4); int b, s; bs_of(r, b, s);
  if (s < TC && !need_ctx) return;
  const float* h0 = p.OD + (((size_t)0 * NB + b) * TK + s) * 256 + h * 64; const float* h1 = p.OD + (((size_t)1 * NB + b) * TK + s) * 256 + h * 64;
  float ss = 0.f; for (int v = 0; v < 64; ++v) { float t = h0[v] + h1[v]; ss += t * t; }
  float rstd = 1.0f / sqrtf(ss / 64 + 1e-6f);
  for (int v = 0; v < 64; ++v) {
    float rr = bf2f(p.Z[(size_t)r * NZP + ZC_GR + h * 64 + v]);
    p.Y[(size_t)r * D + 512 + h * 64 + v] = f2bf(siluf_(rr) * (h0[v] + h1[v]) * rstd * p.g_gla_out[layer * 256 + h * 64 + v]);
  }
}
__global__ void __launch_bounds__(256) nv_merge(Params p, int layer, int nrows) {
  long i = GTID; if (i >= (long)nrows * D) return;
  int j = (int)(i % D), r = (int)(i / D);
  float acc = 0.f;
  for (int n = 0; n < 4; ++n) {
    const bf16_t* wg = p.Wt_gate + (size_t)(n * 1024 + j) * D; const bf16_t* wb = p.Wt_branch + ((size_t)n * D + j) * 256;
    float g = p.b_gate[layer * 4096 + n * 1024 + j], pr = 0.f;
    for (int k = 0; k < D; ++k) g += bf2f(p.H[(size_t)r * D + k]) * bf2f(wg[k]);
    for (int k = 0; k < 256; ++k) pr += bf2f(p.Y[(size_t)r * D + n * 256 + k]) * bf2f(wb[k]);
    acc += sigmoidf_(g) * pr;
  }
  p.MG[(size_t)r * D + j] = f2bf(acc);
}
__global__ void __launch_bounds__(256) nv_resid_mix(Params p, int layer, const float* xl_in, const float* xc_in, int nrows) {
  long r = GTID; if (r >= nrows) return;
  int w = r < RL ? (int)(r / TL) : 2;
  const float* mb = p.mods + (size_t)(layer * 3 + w) * 6144;
  const float* xin = r < RL ? xl_in + (size_t)r * D : xc_in + (size_t)(r - RL) * D;
  float* xo = r < RL ? p.out + (size_t)r * D : p.xc + (size_t)(r - RL) * D;
  const bf16_t* yo = p.YO + (size_t)r * D;
  float ss = 0.f; for (int k = 0; k < D; ++k) { float v = bf2f(yo[k]); ss += v * v; }
  float rstd = 1.0f / sqrtf(ss / D + 1e-6f);
  float s2 = 0.f;
  for (int k = 0; k < D; ++k) { float xn = xin[k] + mb[2 * 1024 + k] * bf2f(yo[k]) * rstd * p.g_mix_post[layer * 1024 + k]; xo[k] = xn; s2 += xn * xn; }
  float rstd2 = 1.0f / sqrtf(s2 / D + 1e-6f);
  float lg[16]; _Pragma("unroll") for (int e = 0; e < 16; ++e) lg[e] = 0.f;
  const float* wr = p.w_router + (size_t)layer * D * 16;
  for (int k = 0; k < D; ++k) {
    float h2 = xo[k] * rstd2 * p.g_ffn_pre[layer * 1024 + k] * (1.f + mb[4 * 1024 + k]) + mb[3 * 1024 + k];
    p.H[(size_t)r * D + k] = f2bf(h2);
    _Pragma("unroll") for (int e = 0; e < 16; ++e) lg[e] += h2 * wr[k * 16 + e];
  }
  float mx = lg[0]; _Pragma("unroll") for (int e = 1; e < 16; ++e) mx = fmaxf(mx, lg[e]);
  float sm = 0.f; _Pragma("unroll") for (int e = 0; e < 16; ++e) { lg[e] = expf(lg[e] - mx); sm += lg[e]; }
  int b, s; bs_of((int)r, b, s);
  _Pragma("unroll") for (int e = 0; e < 16; ++e) p.AFF[((size_t)b * NE + e) * TK + s] = lg[e] / sm;
}
__global__ void __launch_bounds__(256) nv_topk(Params p, int need_ctx) {
  long i = GTID; if (i >= NB * NE * 2) return;
  int seg = (int)(i % 2), e = (int)((i / 2) % NE), b = (int)(i / (2 * NE));
  int s0 = seg ? TC : 0, n = seg ? TL : TC, cap = seg ? CAPL : CAPC, slot0 = seg ? b * CAPL : NB * CAPL + b * CAPC;
  if (seg == 0 && !need_ctx) { for (int q = 0; q < cap; ++q) p.SEL[(size_t)e * NSLOT + slot0 + q] = -1; return; }
  const float* a = p.AFF + ((size_t)b * NE + e) * TK + s0;
  unsigned thr = 0;
  for (int bit = 31; bit >= 0; --bit) {
    unsigned cand = thr | (1u << bit); int cnt = 0;
    for (int t = 0; t < n; ++t) cnt += (f2u(a[t]) >= cand);
    if (cnt >= cap) thr = cand;
  }
  int ngt = 0; for (int t = 0; t < n; ++t) ngt += (f2u(a[t]) > thr);
  int neq = cap - ngt, q = 0;
  for (int t = 0; t < n; ++t) {
    unsigned u = f2u(a[t]); int r = row_of(b, s0 + t); int sel = -1;
    if (u > thr) sel = q++; else if (u == thr && neq > 0) { sel = q++; --neq; }
    if (sel >= 0) { p.SEL[(size_t)e * NSLOT + slot0 + sel] = r; p.SELV[(size_t)e * NSLOT + slot0 + sel] = a[t]; }
    p.INV[(size_t)r * NE + e] = sel >= 0 ? slot0 + sel : -1;
  }
}
__global__ void __launch_bounds__(256) nv_moe1(Params p) {
  long i = GTID; if (i >= (long)NE * NSLOT * FF) return;
  int f = (int)(i % FF), slot = (int)((i / FF) % NSLOT), e = (int)(i / ((long)FF * NSLOT));
  int r = p.SEL[(size_t)e * NSLOT + slot];
  float out = 0.f;
  if (r >= 0) {
    const bf16_t* wg = p.Wt_eg + ((size_t)e * FF + f) * D; const bf16_t* wu = p.Wt_eu + ((size_t)e * FF + f) * D; const bf16_t* h = p.H + (size_t)r * D;
    float g = 0.f, u = 0.f; for (int k = 0; k < D; ++k) { float hv = bf2f(h[k]); g += hv * bf2f(wg[k]); u += hv * bf2f(wu[k]); }
    out = siluf_(g) * u;
  }
  p.HID[((size_t)e * NSLOT + slot) * FF + f] = f2bf(out);
}
__global__ void __launch_bounds__(256) nv_moe2(Params p) {
  long i = GTID; if (i >= (long)NE * NSLOT * D) return;
  int j = (int)(i % D), slot = (int)((i / D) % NSLOT), e = (int)(i / ((long)D * NSLOT));
  int r = p.SEL[(size_t)e * NSLOT + slot];
  float out = 0.f;
  if (r >= 0) {
    const bf16_t* wd = p.Wt_ed + ((size_t)e * D + j) * FF; const bf16_t* h = p.HID + ((size_t)e * NSLOT + slot) * FF;
    float a = 0.f; for (int k = 0; k < FF; ++k) a += bf2f(h[k]) * bf2f(wd[k]);
    out = a * p.SELV[(size_t)e * NSLOT + slot];
  }
  p.YE[((size_t)e * NSLOT + slot) * D + j] = f2bf(out);
}
__global__ void __launch_bounds__(256) nv_resid_ffn(Params p, int layer, int nrows) {
  long r = GTID; if (r >= nrows) return;
  int w = r < RL ? (int)(r / TL) : 2;
  const float* mb = p.mods + (size_t)(layer * 3 + w) * 6144;
  float* xo = r < RL ? p.out + (size_t)r * D : p.xc + (size_t)(r - RL) * D;
  float ss = 0.f;
  for (int k = 0; k < D; ++k) {
    float f = 0.f;
    for (int e = 0; e < NE; ++e) { int sl = p.INV[(size_t)r * NE + e]; if (sl >= 0) f += bf2f(p.YE[((size_t)e * NSLOT + sl) * D + k]); }
    ss += f * f;
  }
  float rstd = 1.0f / sqrtf(ss / D + 1e-6f);
  for (int k = 0; k < D; ++k) {
    float f = 0.f;
    for (int e = 0; e < NE; ++e) { int sl = p.INV[(size_t)r * NE + e]; if (sl >= 0) f += bf2f(p.YE[((size_t)e * NSLOT + sl) * D + k]); }
    xo[k] += mb[5 * 1024 + k] * f * rstd * p.g_ffn_post[layer * 1024 + k];
  }
}

__global__ void __launch_bounds__(256) nv_mods(Params p) { nvb_mods(GTID, p); }
__global__ void __launch_bounds__(256) nv_ml_gates(Params p, int layer) { nvb_ml_gates(GTID, p, layer); }
__global__ void __launch_bounds__(256) nv_gla_cum(Params p, int layer) { nvb_gla_cum(GTID, p, layer); }
__global__ void __launch_bounds__(256) nv_ml_local(Params p) { nvb_ml_local(GTID, p); }
__global__ void __launch_bounds__(256) nv_ml_scan(Params p) { nvb_ml_scan(GTID, p); }
__global__ void __launch_bounds__(256) nv_ml_out(Params p, int need_ctx) { nvb_ml_out(GTID, p, need_ctx); }
__global__ void __launch_bounds__(256) nv_ml_finish(Params p, int layer, int need_ctx) { nvb_ml_finish(GTID, p, layer, need_ctx); }
__global__ void __launch_bounds__(256) nv_gla_local(Params p) { nvb_gla_local(GTID, p); }
__global__ void __launch_bounds__(256) nv_gla_scan(Params p) { nvb_gla_scan(GTID, p); }
__global__ void __launch_bounds__(256) nv_gla_out(Params p, int need_ctx) { nvb_gla_out(GTID, p, need_ctx); }
__global__ void __launch_bounds__(256) nv_gla_finish(Params p, int layer, int need_ctx) { nvb_gla_finish(GTID, p, layer, need_ctx); }
constexpr int LROW = 144;
constexpr int A_BYTES = 128 * LROW;
constexpr int NTHR = 256;
#ifndef ATT_THR
#define ATT_THR 16.0f
#endif

DI int xcd_swz(int u, int nt) { return (nt & 7) ? u : (u & 7) * (nt >> 3) + (u >> 3); }
template <int GW> DI void grp_tile(int L, int ntm, int ntn, int& tm, int& tn) {
  const int gsz = ntm * GW; int g = 0;
  while (L >= gsz) { L -= gsz; ++g; }
  tm = L / GW; tn = g * GW + (L & (GW - 1)); (void)ntn;
}
DI u32x4 ldg16(const void* p) { return *(const u32x4*)p; }
DI void sts16(char* p, u32x4 v) { *(u32x4*)p = v; }
DI bf16x8 lds_frag(const char* p) { return *(const bf16x8*)p; }

template <int WN, int KFIX = 0>
DI void gemm_kloop(f32x4 (&acc)[4][WN], const bf16_t* const (&ap)[4], const bf16_t* const (&bp)[WN], int nk, char* lds) {
  constexpr int STAGE = A_BYTES + 32 * WN * LROW;
  const int t = TIDX, lane = t & 63, wid = t >> 6, wr = wid >> 1, wc = wid & 1;
  const int lr = t >> 3, lcb = (t & 7) * 16;
  const int fr = lane & 15, fq = lane >> 4;
  const int aoff = (wr * 64 + fr) * LROW + fq * 16, boff = A_BYTES + (wc * WN * 16 + fr) * LROW + fq * 16, soff = lr * LROW + lcb;
  u32x4 ra0[4], rb0[WN], ra1[4], rb1[WN];
  auto gload = [&](u32x4 (&ra)[4], u32x4 (&rb)[WN], int kt) {
#pragma unroll
    for (int i = 0; i < 4; ++i) ra[i] = ldg16(ap[i] + (KFIX ? (kt & 1) : kt) * 64);
#pragma unroll
    for (int i = 0; i < WN; ++i) rb[i] = ldg16(bp[i] + (KFIX ? (kt & 1) : kt) * 64);
  };
  auto sstore = [&](const u32x4 (&ra)[4], const u32x4 (&rb)[WN], char* st) {
#pragma unroll
    for (int i = 0; i < 4; ++i) sts16(st + soff + 32 * i * LROW, ra[i]);
#pragma unroll
    for (int i = 0; i < WN; ++i) sts16(st + A_BYTES + soff + 32 * i * LROW, rb[i]);
  };
  auto compute = [&](const char* cur) {
#pragma unroll
    for (int ks = 0; ks < 2; ++ks) {
      bf16x8 af[4], bfr[WN];
#pragma unroll
      for (int m = 0; m < 4; ++m) af[m] = lds_frag(cur + aoff + m * 16 * LROW + ks * 64);
#pragma unroll
      for (int n = 0; n < WN; ++n) bfr[n] = lds_frag(cur + boff + n * 16 * LROW + ks * 64);
#pragma unroll
      for (int m = 0; m < 4; ++m)
#pragma unroll
        for (int n = 0; n < WN; ++n) acc[m][n] = MFMA16(bfr[n], af[m], acc[m][n]);
    }
    IGLP_OPT();
  };
  gload(ra0, rb0, 0);
  gload(ra1, rb1, 1);
  sstore(ra0, rb0, lds);
  __syncthreads();
#pragma unroll 1
  for (int kt = 0; kt < nk; kt += 2) {
    if (kt + 2 < nk) gload(ra0, rb0, kt + 2);
    compute(lds);
    sstore(ra1, rb1, lds + STAGE);
    __syncthreads();
    if (kt + 3 < nk) gload(ra1, rb1, kt + 3);
    compute(lds + STAGE);
    if (kt + 2 < nk) sstore(ra0, rb0, lds);
    __syncthreads();
  }
}
struct KRegs { u32x4 ra0[4], rb0[4], ra1[4], rb1[4]; };
DI const bf16_t* row_addr(const bf16_t* base, int off) { return base + off; }
DI const bf16_t* row_addr(const bf16_t*, const bf16_t* ptr) { return ptr; }
template <class T, class NextPtrs>
DI void gemm_kloop_x(f32x4 (&acc)[4][4], const bf16_t* Ab, const T (&ap)[4], const bf16_t* Bb0, const bf16_t* Bb1, const T (&bp)[4], int nk, char* lds,
                     KRegs& R, bool pre, NextPtrs nextp, bool has_next) {
  constexpr int WN = 4, STAGE = A_BYTES + 32 * WN * LROW;
  const int t = TIDX, lane = t & 63, wid = t >> 6, wr = wid >> 1, wc = wid & 1;
  const int lr = t >> 3, lcb = (t & 7) * 16;
  const int fr = lane & 15, fq = lane >> 4;
  const int aoff = (wr * 64 + fr) * LROW + fq * 16, boff = A_BYTES + (wc * WN * 16 + fr) * LROW + fq * 16, soff = lr * LROW + lcb;
  auto gload = [&](u32x4 (&ra)[4], u32x4 (&rb)[4], const T (&a)[4], const T (&b)[4], int kt) __attribute__((always_inline)) {
#pragma unroll
    for (int i = 0; i < 4; ++i) ra[i] = ldg16(row_addr(Ab, a[i]) + kt * 64);
#pragma unroll
    for (int i = 0; i < 4; ++i) rb[i] = ldg16(row_addr((i & 1) ? Bb1 : Bb0, b[i]) + kt * 64);
  };
  auto sstore = [&](const u32x4 (&ra)[4], const u32x4 (&rb)[4], char* st) __attribute__((always_inline)) {
#pragma unroll
    for (int i = 0; i < 4; ++i) sts16(st + soff + 32 * i * LROW, ra[i]);
#pragma unroll
    for (int i = 0; i < 4; ++i) sts16(st + A_BYTES + soff + 32 * i * LROW, rb[i]);
  };
  auto compute = [&](const char* cur) __attribute__((always_inline)) {
#pragma unroll
    for (int ks = 0; ks < 2; ++ks) {
      bf16x8 af[4], bfr[4];
#pragma unroll
      for (int m = 0; m < 4; ++m) af[m] = lds_frag(cur + aoff + m * 16 * LROW + ks * 64);
#pragma unroll
      for (int n = 0; n < 4; ++n) bfr[n] = lds_frag(cur + boff + n * 16 * LROW + ks * 64);
#pragma unroll
      for (int m = 0; m < 4; ++m)
#pragma unroll
        for (int n = 0; n < 4; ++n) acc[m][n] = MFMA16(bfr[n], af[m], acc[m][n]);
    }
    IGLP_OPT();
  };
  if (!pre) gload(R.ra0, R.rb0, ap, bp, 0);
  gload(R.ra1, R.rb1, ap, bp, 1);
  sstore(R.ra0, R.rb0, lds);
  __syncthreads();
#pragma unroll 1
  for (int kt = 0; kt < nk; kt += 2) {
    if (kt + 2 < nk) gload(R.ra0, R.rb0, ap, bp, kt + 2); else if (has_next) { T na[4], nb[4]; nextp(na, nb); gload(R.ra0, R.rb0, na, nb, 0); }
    compute(lds);
    sstore(R.ra1, R.rb1, lds + STAGE);
    __syncthreads();
    if (kt + 3 < nk) gload(R.ra1, R.rb1, ap, bp, kt + 3);
    compute(lds + STAGE);
    if (kt + 2 < nk) sstore(R.ra0, R.rb0, lds);
    __syncthreads();
  }
}
template <int WN> DI void acc_zero(f32x4 (&acc)[4][WN]) {
#pragma unroll
  for (int m = 0; m < 4; ++m)
#pragma unroll
    for (int n = 0; n < WN; ++n) acc[m][n] = (f32x4){0.f, 0.f, 0.f, 0.f};
}
DI void st_bf16x4(bf16_t* p, f32x4 v) { u32x2 o; o.x = pack2bf(v.x, v.y); o.y = pack2bf(v.z, v.w); *(u32x2*)p = o; }

template <int WN, class RowOk>
DI void store_wave_tile(const f32x4 (&acc)[4][WN], bf16_t* C, size_t ldc, char* ldsw, int lane, RowOk row_ok) {
  constexpr int PITCH = WN * 32 + 16, CPR = WN * 2;
  const int fr = lane & 15, fq = lane >> 4;
#pragma unroll
  for (int m = 0; m < 4; ++m)
#pragma unroll
    for (int n = 0; n < WN; ++n) { u32x2 o; o.x = pack2bf(acc[m][n][0], acc[m][n][1]); o.y = pack2bf(acc[m][n][2], acc[m][n][3]); *(u32x2*)(ldsw + (m * 16 + fr) * PITCH + n * 32 + fq * 8) = o; }
  WAVE_SYNC();
  constexpr int RPP = 64 / CPR;
#pragma unroll
  for (int ps = 0; ps < 64 / RPP; ++ps) {
    const int r = ps * RPP + lane / CPR, c = lane % CPR;
    const u32x4 v = *(const u32x4*)(ldsw + r * PITCH + c * 16);
    if (row_ok(r)) *(u32x4*)(C + (size_t)r * ldc + c * 8) = v;
  }
  WAVE_SYNC();
}
template <int NOSTORE = 0>
DI void gemm_plain_tile(const bf16_t* A, int lda, const bf16_t* Bt, int ldb, int K, bf16_t* C, int ldc, int tm, int tn, char* lds) {
  const int t = TIDX, lane = t & 63, wid = t >> 6, wr = wid >> 1, wc = wid & 1, lr = t >> 3, lc = (t & 7) * 8, fr = lane & 15, fq = lane >> 4;
  const bf16_t* ap[4]; const bf16_t* bp[4];
#pragma unroll
  for (int i = 0; i < 4; ++i) { ap[i] = A + (size_t)(tm * 128 + lr + 32 * i) * lda + lc; bp[i] = Bt + (size_t)(tn * 128 + lr + 32 * i) * ldb + lc; }
  f32x4 acc[4][4]; acc_zero<4>(acc);
  gemm_kloop<4, NOSTORE == 2>(acc, ap, bp, K / 64, lds);
  if (NOSTORE) { float s = 0.f;
#pragma unroll
    for (int m = 0; m < 4; ++m)
#pragma unroll
      for (int n = 0; n < 4; ++n) s += acc[m][n][0] + acc[m][n][3];
    if (s == 123456.789f) C[0] = 1; return; }
  store_wave_tile<4>(acc, C + (size_t)(tm * 128 + wr * 64) * ldc + tn * 128 + wc * 64, (size_t)ldc, lds + wid * (64 * 144), lane, [](int) { return true; });
  __syncthreads();
}
template <int NOSTORE = 0>
DI void ph_gemm_plain(const bf16_t* A, int lda, const bf16_t* Bt, int ldb, int M, int N, int K, bf16_t* C, int ldc, char* lds, int bid, int nblk) {
  const int ntn = N / 128, nt = (M / 128) * ntn;
  for (int u = bid; u < nt; u += nblk) { int tm, tn; grp_tile<8>(xcd_swz(u, nt), M / 128, ntn, tm, tn); gemm_plain_tile<NOSTORE>(A, lda, Bt, ldb, K, C, ldc, tm, tn, lds); }
}
DI void ph_mla_up(const Params& p, int layer, bf16_t* QRAW, bf16_t* KVRAW, char* lds, int bid, int nblk) {
  const int ntq = (R / 128) * 3, ntkv = (R / 128) * 4;
  for (int tile = bid; tile < ntq + ntkv; tile += nblk) {
    if (tile < ntq) gemm_plain_tile(p.Z + ZC_QLAT, NZP, p.Wt_uq + layer * WSZ_UQ, 256, 256, QRAW, 384, tile / 3, tile % 3, lds);
    else { int u = tile - ntq; gemm_plain_tile(p.Z + ZC_KVLAT, NZP, p.Wt_ukv + layer * WSZ_UKV, 128, 128, KVRAW, 512, u / 4, u % 4, lds); }
  }
}
constexpr int LROW32 = 80;
template <int WM, int WN, bool DEEP>
DI void gemm_kloop_g(f32x4 (&acc)[WM][WN], const bf16_t* const (&ap)[WM / 2], const bf16_t* const (&bp)[WN / 2], int nk, char* lds) {
  constexpr int NA = WM / 2, NBB = WN / 2, A_B = 32 * WM * LROW32, STAGE = (32 * WM + 32 * WN) * LROW32;
  const int t = TIDX, lane = t & 63, wid = t >> 6, wr = wid >> 1, wc = wid & 1, fr = lane & 15, fq = lane >> 4;
  const int aoff = (wr * 16 * WM + fr) * LROW32 + fq * 16, boff = A_B + (wc * 16 * WN + fr) * LROW32 + fq * 16, soff = (t >> 2) * LROW32 + (t & 3) * 16;
  u32x4 ra0[NA], rb0[NBB], ra1[NA], rb1[NBB];
  auto gload = [&](u32x4 (&ra)[NA], u32x4 (&rb)[NBB], int kt) {
#pragma unroll
    for (int i = 0; i < NA; ++i) ra[i] = ldg16(ap[i] + kt * 32);
#pragma unroll
    for (int i = 0; i < NBB; ++i) rb[i] = ldg16(bp[i] + kt * 32);
  };
  auto sstore = [&](const u32x4 (&ra)[NA], const u32x4 (&rb)[NBB], char* st) {
#pragma unroll
    for (int i = 0; i < NA; ++i) sts16(st + soff + 64 * i * LROW32, ra[i]);
#pragma unroll
    for (int i = 0; i < NBB; ++i) sts16(st + A_B + soff + 64 * i * LROW32, rb[i]);
  };
  auto compute = [&](const char* cur) {
    bf16x8 af[WM];
#pragma unroll
    for (int m = 0; m < WM; ++m) af[m] = lds_frag(cur + aoff + m * 16 * LROW32);
#pragma unroll
    for (int n = 0; n < WN; ++n) {
      const bf16x8 bfr = lds_frag(cur + boff + n * 16 * LROW32);
#pragma unroll
      for (int m = 0; m < WM; ++m) acc[m][n] = MFMA16(bfr, af[m], acc[m][n]);
    }
    IGLP_OPT();
  };
  gload(ra0, rb0, 0);
  if (DEEP) gload(ra1, rb1, 1);
  sstore(ra0, rb0, lds);
  __syncthreads();
#pragma unroll 1
  for (int kt = 0; kt < nk; kt += 2) {
    if (DEEP) { if (kt + 2 < nk) gload(ra0, rb0, kt + 2); } else gload(ra1, rb1, kt + 1);
    compute(lds);
    sstore(ra1, rb1, lds + STAGE);
    __syncthreads();
    if (DEEP) { if (kt + 3 < nk) gload(ra1, rb1, kt + 3); } else if (kt + 2 < nk) gload(ra0, rb0, kt + 2);
    compute(lds + STAGE);
    if (kt + 2 < nk) sstore(ra0, rb0, lds);
    __syncthreads();
  }
}
template <int WM, int WN> DI void acc_zero_g(f32x4 (&acc)[WM][WN]) {
#pragma unroll
  for (int m = 0; m < WM; ++m)
#pragma unroll
    for (int n = 0; n < WN; ++n) acc[m][n] = (f32x4){0.f, 0.f, 0.f, 0.f};
}
DI void ph_merge(const Params& p, int layer, int rows, char* lds, int bid, int nblk) {
  const int t = TIDX, lane = t & 63, wid = t >> 6, wr = wid >> 1, wc = wid & 1, fr = lane & 15, fq = lane >> 4;
  const int lr = t >> 2, lc = (t & 3) * 8;
  const int ntn = D / 64, nt = (rows / 128) * ntn;
#pragma unroll 1
  for (int u = bid; u < nt; u += nblk) {
    int tm, tn; grp_tile<4>(xcd_swz(u, nt), rows / 128, ntn, tm, tn);
    f32x4 accS[4][2]; acc_zero_g<4, 2>(accS);
#pragma unroll 1
    for (int np = 0; np < 2; ++np) {
      f32x4 accG[4][4]; acc_zero_g<4, 4>(accG);
      {
        const bf16_t* ap[2]; const bf16_t* bp[2];
#pragma unroll
        for (int i = 0; i < 2; ++i) ap[i] = p.H + (size_t)(tm * 128 + lr + 64 * i) * D + lc;
#pragma unroll
        for (int i = 0; i < 2; ++i) { const int rho = lr + 64 * i, wci = rho >> 6, n = 2 * np + ((rho >> 5) & 1), c = rho & 31;
          bp[i] = p.Wt_gate + layer * WSZ_GATE + ((size_t)n * 1024 + tn * 64 + wci * 32 + c) * D + lc; }
        gemm_kloop_g<4, 4, true>(accG, ap, bp, D / 32, lds);
      }
#pragma unroll 1
      for (int q = 0; q < 2; ++q) {
        const int n = 2 * np + q;
        f32x4 accP[4][2]; acc_zero_g<4, 2>(accP);
        const bf16_t* ap[2]; const bf16_t* bp[1];
#pragma unroll
        for (int i = 0; i < 2; ++i) ap[i] = p.Y + (size_t)(tm * 128 + lr + 64 * i) * D + n * 256 + lc;
        bp[0] = p.Wt_branch + layer * WSZ_BR + ((size_t)n * D + tn * 64 + lr) * 256 + lc;
        gemm_kloop_g<4, 2, false>(accP, ap, bp, 8, lds);
#pragma unroll
        for (int nn = 0; nn < 2; ++nn) {
          const f32x4 bv = *(const f32x4*)(p.b_gate + layer * 4096 + n * 1024 + tn * 64 + wc * 32 + nn * 16 + 4 * fq);
#pragma unroll
          for (int m = 0; m < 4; ++m)
#pragma unroll
            for (int j = 0; j < 4; ++j) { const float g = q ? accG[m][2 + nn][j] : accG[m][nn][j]; accS[m][nn][j] += accP[m][nn][j] * fast_rcp(1.0f + fast_exp2(-LOG2E * (g + bv[j]))); }
        }
      }
    }
    store_wave_tile<2>(accS, p.MG + (size_t)(tm * 128 + wr * 64) * D + tn * 64 + wc * 32, (size_t)D, lds + wid * (64 * 80), lane, [](int) { return true; });
    __syncthreads();
  }
}
template <int WM>
DI void gemm_plain_tile_g(const bf16_t* A, int lda, const bf16_t* Bt, int ldb, int K, bf16_t* C, int ldc, int row0, int col0, char* lds) {
  const int t = TIDX, lane = t & 63, wid = t >> 6, wr = wid >> 1, wc = wid & 1, fr = lane & 15, fq = lane >> 4, lr = t >> 2, lc = (t & 3) * 8;
  const bf16_t* ap[WM / 2]; const bf16_t* bp[2];
#pragma unroll
  for (int i = 0; i < WM / 2; ++i) ap[i] = A + (size_t)(row0 + lr + 64 * i) * lda + lc;
#pragma unroll
  for (int i = 0; i < 2; ++i) bp[i] = Bt + (size_t)(col0 + lr + 64 * i) * ldb + lc;
  f32x4 acc[WM][4]; acc_zero_g<WM, 4>(acc);
  gemm_kloop_g<WM, 4, true>(acc, ap, bp, K / 32, lds);
#pragma unroll
  for (int m = 0; m < WM; ++m)
#pragma unroll
    for (int n = 0; n < 4; ++n)
      st_bf16x4(C + (size_t)(row0 + wr * 16 * WM + m * 16 + fr) * ldc + col0 + wc * 64 + n * 16 + 4 * fq, acc[m][n]);
}
DI void ph_gemm_plain2(const bf16_t* A, int lda, const bf16_t* Bt, int ldb, int M, int N, int K, bf16_t* C, int ldc, char* lds, int bid, int nblk) {
  const int ntn = N / 128, nt = (M / 256) * ntn, nfull = (nt / nblk) * nblk;
#pragma unroll 1
  for (int tile = bid; tile < nfull; tile += nblk) gemm_plain_tile_g<8>(A, lda, Bt, ldb, K, C, ldc, (tile / ntn) * 256, (tile % ntn) * 128, lds);
#pragma unroll 1
  for (int h = bid; h < 2 * (nt - nfull); h += nblk) { const int tile = nfull + (h >> 1); gemm_plain_tile_g<4>(A, lda, Bt, ldb, K, C, ldc, (tile / ntn) * 256 + (h & 1) * 128, (tile % ntn) * 128, lds); }
}
DI void gemm_kloop32(f32x16 (&acc)[2][2], const bf16_t* const (&ap)[4], const bf16_t* const (&bp)[4], int nk, char* lds) {
  constexpr int STAGE = A_BYTES + 128 * LROW;
  const int t = TIDX, lane = t & 63, wid = t >> 6, wr = wid >> 1, wc = wid & 1, l31 = lane & 31, hh = lane >> 5;
  const int aoff = (wr * 64 + l31) * LROW + hh * 16, boff = A_BYTES + (wc * 64 + l31) * LROW + hh * 16, soff = (t >> 3) * LROW + (t & 7) * 16;
  u32x4 ra0[4], rb0[4], ra1[4], rb1[4];
  auto gload = [&](u32x4 (&ra)[4], u32x4 (&rb)[4], int kt) {
#pragma unroll
    for (int i = 0; i < 4; ++i) { ra[i] = ldg16(ap[i] + kt * 64); rb[i] = ldg16(bp[i] + kt * 64); }
  };
  auto sstore = [&](const u32x4 (&ra)[4], const u32x4 (&rb)[4], char* st) {
#pragma unroll
    for (int i = 0; i < 4; ++i) { sts16(st + soff + 32 * i * LROW, ra[i]); sts16(st + A_BYTES + soff + 32 * i * LROW, rb[i]); }
  };
  auto compute = [&](const char* cur) {
#pragma unroll
    for (int ks = 0; ks < 4; ++ks) {
      bf16x8 af[2], bfr[2];
#pragma unroll
      for (int m = 0; m < 2; ++m) af[m] = lds_frag(cur + aoff + m * 32 * LROW + ks * 32);
#pragma unroll
      for (int n = 0; n < 2; ++n) bfr[n] = lds_frag(cur + boff + n * 32 * LROW + ks * 32);
#pragma unroll
      for (int m = 0; m < 2; ++m)
#pragma unroll
        for (int n = 0; n < 2; ++n) acc[m][n] = MFMA32(bfr[n], af[m], acc[m][n]);
    }
  };
  gload(ra0, rb0, 0); gload(ra1, rb1, 1);
  sstore(ra0, rb0, lds);
  __syncthreads();
#pragma unroll 1
  for (int kt = 0; kt < nk; kt += 2) {
    if (kt + 2 < nk) gload(ra0, rb0, kt + 2);
    compute(lds);
    sstore(ra1, rb1, lds + STAGE);
    __syncthreads();
    if (kt + 3 < nk) gload(ra1, rb1, kt + 3);
    compute(lds + STAGE);
    if (kt + 2 < nk) sstore(ra0, rb0, lds);
    __syncthreads();
  }
}
DI void ph_gemm_plain32(const bf16_t* A, int lda, const bf16_t* Bt, int ldb, int M, int N, int K, bf16_t* C, int ldc, char* lds, int bid, int nblk) {
  const int t = TIDX, lane = t & 63, wid = t >> 6, wr = wid >> 1, wc = wid & 1, lr = t >> 3, lc = (t & 7) * 8, l31 = lane & 31, hh = lane >> 5;
  const int ntn = N / 128, nt = (M / 128) * ntn;
#pragma unroll 1
  for (int tile = bid; tile < nt; tile += nblk) {
    const int tm = tile / ntn, tn = tile % ntn;
    const bf16_t* ap[4]; const bf16_t* bp[4];
#pragma unroll
    for (int i = 0; i < 4; ++i) { ap[i] = A + (size_t)(tm * 128 + lr + 32 * i) * lda + lc; bp[i] = Bt + (size_t)(tn * 128 + lr + 32 * i) * ldb + lc; }
    f32x16 acc[2][2];
#pragma unroll
    for (int m = 0; m < 2; ++m)
#pragma unroll
      for (int n = 0; n < 2; ++n) acc[m][n] = (f32x16)(0.f);
    gemm_kloop32(acc, ap, bp, K / 64, lds);
#pragma unroll
    for (int m = 0; m < 2; ++m)
#pragma unroll
      for (int n = 0; n < 2; ++n)
#pragma unroll
        for (int g = 0; g < 4; ++g) {
          f32x4 o = {acc[m][n][4 * g], acc[m][n][4 * g + 1], acc[m][n][4 * g + 2], acc[m][n][4 * g + 3]};
          st_bf16x4(C + (size_t)(tm * 128 + wr * 64 + m * 32 + l31) * ldc + tn * 128 + wc * 64 + n * 32 + 8 * g + 4 * hh, o);
        }
  }
}
template <int MODE>
DI void ph_gemm_probe(const bf16_t* A, int lda, const bf16_t* Bt, int ldb, int M, int N, int K, float* sink, char* lds, int bid, int nblk) {
  const int t = TIDX, lane = t & 63, wid = t >> 6, wr = wid >> 1, wc = wid & 1, lr = t >> 3, lc = (t & 7) * 8, fr = lane & 15, fq = lane >> 4;
  const int ntn = N / 128, nt = (M / 128) * ntn, nk = K / 64;
  constexpr int STAGE = A_BYTES + 128 * LROW;
  const int aoff = (wr * 64 + fr) * LROW + fq * 16, boff = A_BYTES + (wc * 64 + fr) * LROW + fq * 16;
#pragma unroll 1
  for (int tile = bid; tile < nt; tile += nblk) {
    f32x4 acc[4][4]; acc_zero<4>(acc);
    bf16x8 af[4], bfr[4];
    const int tm = tile / ntn, tn = tile % ntn;
    const bf16_t* ap[4]; const bf16_t* bp[4];
#pragma unroll
    for (int i = 0; i < 4; ++i) { ap[i] = A + (size_t)(tm * 128 + lr + 32 * i) * lda + lc; bp[i] = Bt + (size_t)(tn * 128 + lr + 32 * i) * ldb + lc; }
    u32x4 ra[4], rb[4], junk = {0u, 0u, 0u, 0u};
#pragma unroll
    for (int i = 0; i < 4; ++i) { ra[i] = junk; rb[i] = junk; }
#pragma unroll 1
    for (int kt = 0; kt < nk; ++kt) {
      const char* cur = lds + (kt & 1) * STAGE;
#pragma unroll
      for (int i = 0; i < 4; ++i) { ra[i] = ldg16(ap[i] + kt * 64); if (MODE == 3) rb[i] = ldg16(bp[i] + kt * 64); }
#pragma unroll
      for (int ks = 0; ks < 2; ++ks) {
#pragma unroll
        for (int m = 0; m < 4; ++m) { af[m] = lds_frag(cur + aoff + m * 16 * LROW + ks * 64); bfr[m] = lds_frag(cur + boff + m * 16 * LROW + ks * 64); }
#pragma unroll
        for (int m = 0; m < 4; ++m)
#pragma unroll
          for (int n = 0; n < 4; ++n) acc[m][n] = MFMA16(bfr[n], af[m], acc[m][n]);
      }
      junk.x ^= ra[0].x ^ ra[1].y ^ ra[2].z ^ ra[3].w ^ rb[0].x ^ rb[1].y ^ rb[2].z ^ rb[3].w;
      __syncthreads();
    }
    float s = (float)(junk.x & 1u);
#pragma unroll
    for (int m = 0; m < 4; ++m)
#pragma unroll
      for (int n = 0; n < 4; ++n) s += acc[m][n][0] + acc[m][n][3];
    if (s == 123456.789f) sink[0] = s;
  }
}
DI void ph_moe1(const Params& p, int need_ctx, char* lds, int bid, int nblk) {
  const int t = TIDX, lane = t & 63, wid = t >> 6, wr = wid >> 1, wc = wid & 1, lr = t >> 3, lc = (t & 7) * 8, fr = lane & 15, fq = lane >> 4;
  constexpr int NTN = FF / 64;
  const int NTM = need_ctx ? (NSLOT + 127) / 128 : (NB * CAPL) / 128;
  const int ntile = NE * NTM * NTN;
  auto tile_of = [&](int u, int& e, int& tm, int& tn) __attribute__((always_inline)) {
    const int tile = xcd_swz(u, ntile), rem = tile % (NTM * NTN);
    e = tile / (NTM * NTN);
    int rr = rem, g = 0;
    if (rr >= NTM * 8) { rr -= NTM * 8; g = 1; }
    if (rr >= NTM * 8) { rr -= NTM * 8; g = 2; }
    if (g < 2) { tm = rr >> 3; tn = g * 8 + (rr & 7); } else { tm = rr / (NTN - 16); tn = 16 + rr - tm * (NTN - 16); }
  };
  int rnx[4];
  auto sel_rows = [&](int u) __attribute__((always_inline)) {
    int e, tm, tn; tile_of(u, e, tm, tn);
#pragma unroll
    for (int i = 0; i < 4; ++i) { const int slot = tm * 128 + lr + 32 * i; rnx[i] = slot < NSLOT ? p.SEL[(size_t)e * NSLOT + slot] : -1; }
  };
  auto offs = [&](int u, const int (&rs)[4], int (&ao)[4], int (&bo)[4]) __attribute__((always_inline)) {
    int e, tm, tn; tile_of(u, e, tm, tn);
#pragma unroll
    for (int i = 0; i < 4; ++i) {
      ao[i] = (rs[i] < 0 ? 0 : rs[i]) * D + lc;
      const int rho = lr + 32 * i, wci = rho >> 6, col = wci * 32 + (rho & 31);
      bo[i] = (e * FF + tn * 64 + col) * D + lc;
    }
  };
  KRegs kr; bool pre = false;
  if (bid < ntile) sel_rows(bid);
#pragma unroll 1
  for (int u = bid; u < ntile; u += nblk) {
    int e, tm, tn; tile_of(u, e, tm, tn);
    const bool has_next = u + nblk < ntile;
    int ap[4], bp[4];
    offs(u, rnx, ap, bp);
    if (has_next) sel_rows(u + nblk);
    f32x4 acc[4][4]; acc_zero<4>(acc);
    gemm_kloop_x(acc, p.H, ap, p.Wt_eg, p.Wt_eu, bp, D / 64, lds, kr, pre, [&](int (&na)[4], int (&nb)[4]) __attribute__((always_inline)) { offs(u + nblk, rnx, na, nb); }, has_next);
    pre = has_next;
    f32x4 hid[4][2];
#pragma unroll
    for (int m = 0; m < 4; ++m) {
      const int slot = tm * 128 + wr * 64 + m * 16 + fr;
      const bool valid = slot < NSLOT && p.SEL[(size_t)e * NSLOT + (slot < NSLOT ? slot : 0)] >= 0;
#pragma unroll
      for (int n = 0; n < 2; ++n)
#pragma unroll
        for (int j = 0; j < 4; ++j) { const float g = acc[m][n][j], u = acc[m][n + 2][j]; hid[m][n][j] = valid ? g * u * fast_rcp(1.0f + fast_exp2(-LOG2E * g)) : 0.f; }
    }
    const int slot0 = tm * 128 + wr * 64;
    store_wave_tile<2>(hid, p.HID + ((size_t)e * NSLOT + slot0) * FF + tn * 64 + wc * 32, (size_t)FF, lds + wid * (64 * 80), lane, [&](int r) { return slot0 + r < NSLOT; });
    __syncthreads();
  }
}
DI void ph_moe2(const Params& p, int need_ctx, char* lds, int bid, int nblk) {
  const int t = TIDX, lane = t & 63, wid = t >> 6, wr = wid >> 1, wc = wid & 1, lr = t >> 3, lc = (t & 7) * 8, fr = lane & 15, fq = lane >> 4;
  constexpr int NTN = D / 128;
  const int NTM = need_ctx ? (NSLOT + 127) / 128 : (NB * CAPL) / 128;
  const int ntile = NE * NTM * NTN;
  auto ptrs = [&](int u, const bf16_t* (&ap)[4], const bf16_t* (&bp)[4]) __attribute__((always_inline)) {
    const int tile = xcd_swz(u, ntile), e = tile / (NTM * NTN), rem = tile % (NTM * NTN), tm = rem / NTN, tn = rem % NTN;
#pragma unroll
    for (int i = 0; i < 4; ++i) {
      int slot = tm * 128 + lr + 32 * i; if (slot >= NSLOT) slot = NSLOT - 1;
      ap[i] = p.HID + ((size_t)e * NSLOT + slot) * FF + lc;
      bp[i] = p.Wt_ed + ((size_t)e * D + tn * 128 + lr + 32 * i) * FF + lc;
    }
  };
  KRegs kr; bool pre = false;
#pragma unroll 1
  for (int u = bid; u < ntile; u += nblk) {
    const int tile = xcd_swz(u, ntile), e = tile / (NTM * NTN), rem = tile % (NTM * NTN), tm = rem / NTN, tn = rem % NTN;
    const bool has_next = u + nblk < ntile;
    const bf16_t* ap[4]; const bf16_t* bp[4];
    ptrs(u, ap, bp);
    f32x4 acc[4][4]; acc_zero<4>(acc);
    gemm_kloop_x(acc, p.HID, ap, p.Wt_ed, p.Wt_ed, bp, FF / 64, lds, kr, pre, [&](const bf16_t* (&na)[4], const bf16_t* (&nb)[4]) __attribute__((always_inline)) { ptrs(u + nblk, na, nb); }, has_next);
    pre = has_next;
#pragma unroll
    for (int m = 0; m < 4; ++m) {
      const int slot = tm * 128 + wr * 64 + m * 16 + fr;
      const float val = (slot < NSLOT && p.SEL[(size_t)e * NSLOT + (slot < NSLOT ? slot : 0)] >= 0) ? p.SELV[(size_t)e * NSLOT + slot] : 0.f;
#pragma unroll
      for (int n = 0; n < 4; ++n) { acc[m][n].x *= val; acc[m][n].y *= val; acc[m][n].z *= val; acc[m][n].w *= val; }
    }
    const int slot0 = tm * 128 + wr * 64;
    store_wave_tile<4>(acc, p.YE + ((size_t)e * NSLOT + slot0) * D + tn * 128 + wc * 64, (size_t)D, lds + wid * (64 * 144), lane, [&](int r) { return slot0 + r < NSLOT; });
    __syncthreads();
  }
}
constexpr int GEMM_LDS = 2 * (A_BYTES + 128 * LROW);

DI void unpack8(u32x4 v, float (&f)[8]) {
  f[0] = u2f(v.x << 16); f[1] = u2f(v.x & 0xffff0000u); f[2] = u2f(v.y << 16); f[3] = u2f(v.y & 0xffff0000u);
  f[4] = u2f(v.z << 16); f[5] = u2f(v.z & 0xffff0000u); f[6] = u2f(v.w << 16); f[7] = u2f(v.w & 0xffff0000u);
}
DI u32x4 pack8f(const float (&f)[8]) { u32x4 v; v.x = pack2bf(f[0], f[1]); v.y = pack2bf(f[2], f[3]); v.z = pack2bf(f[4], f[5]); v.w = pack2bf(f[6], f[7]); return v; }
DI void rope8(float (&a)[8], const float (&pr)[8], int cc, const float* cs, const float* sn) {
  const int ax = (cc >> 1) * 8; const bool second = cc & 1;
#pragma unroll
  for (int i = 0; i < 8; ++i) a[i] = second ? a[i] * cs[ax + i] + pr[i] * sn[ax + i] : a[i] * cs[ax + i] - pr[i] * sn[ax + i];
}
constexpr int PREP_LDS = 64 * 4 + 2 * 512 * 4 + 32 * 528;
template <int PARTS = 3>
DI void ph_prep(const Params& p, int layer, const bf16_t* QRAW, const bf16_t* KVRAW, char* lds, int bid, int nblk) {
  float* s_rstd = (float*)lds;
  float* s_cs = s_rstd + 64;
  float* s_sn = s_cs + 512;
  bf16_t* s_t = (bf16_t*)(s_sn + 512);
  const int t = TIDX;
  constexpr int UPB = TK / 32, NU = NB * UPB;
  const float* wcv = p.w_conv + (size_t)layer * 3 * 512;
  f32x4 bcv[2], w0v[2], w1v[2], w2v[2];
  { const int c8 = (t & 63) * 8;
#pragma unroll
    for (int q = 0; q < 2; ++q) { bcv[q] = *(const f32x4*)(p.b_conv + layer * 512 + c8 + 4 * q); w0v[q] = *(const f32x4*)(wcv + c8 + 4 * q); w1v[q] = *(const f32x4*)(wcv + 512 + c8 + 4 * q); w2v[q] = *(const f32x4*)(wcv + 1024 + c8 + 4 * q); } }
#pragma unroll 1
  for (int u = bid; u < NU; u += nblk) {
    int b, s0;
    if (u < NB * (TL / 32)) { b = u / (TL / 32); s0 = TC + (u % (TL / 32)) * 32; } else { const int v = u - NB * (TL / 32); b = v / (TC / 32); s0 = (v % (TC / 32)) * 32; }
    const int r0 = row_of(b, s0);
    {
      const int tok = t >> 3, part = t & 7;
      const bf16_t* z = p.Z + (size_t)(r0 + tok) * NZP;
      float sq = 0.f, sk = 0.f, f[8];
#pragma unroll
      for (int k = 0; k < 4; ++k) { unpack8(ldg16(z + ZC_QLAT + part * 32 + k * 8), f);
#pragma unroll
        for (int i = 0; i < 8; ++i) sq += f[i] * f[i]; }
#pragma unroll
      for (int k = 0; k < 2; ++k) { unpack8(ldg16(z + ZC_KVLAT + part * 16 + k * 8), f);
#pragma unroll
        for (int i = 0; i < 8; ++i) sk += f[i] * f[i]; }
      sq = xor_sum<1>(sq); sk = xor_sum<1>(sk);
      sq = xor_sum<2>(sq); sk = xor_sum<2>(sk);
      sq = xor_sum<4>(sq); sk = xor_sum<4>(sk);
      if (part == 0) { s_rstd[tok * 2] = 1.0f / sqrtf(sq * (1.0f / 256) + 1e-6f); s_rstd[tok * 2 + 1] = 1.0f / sqrtf(sk * (1.0f / 128) + 1e-6f); }
    }
    for (int i = t; i < 512; i += NTHR) {
      const int tok = i >> 4, af = i & 15, s = s0 + tok;
      float cs = 1.f, sn = 0.f;
      if (s >= TC) rope_cs(s, (af >> 3) * 16 + (af & 7), cs, sn);
      s_cs[i] = cs; s_sn[i] = sn;
    }
    __syncthreads();
    if (PARTS & 1) {
#pragma unroll 2
    for (int i = t; i < 32 * 48; i += NTHR) {
      const int tok = i / 48, c = i % 48, h = c / 12, ch = c % 12;
      const float rq = s_rstd[tok * 2] * QS_MLA, rkv = s_rstd[tok * 2 + 1];
      const bf16_t* q = QRAW + (size_t)(r0 + tok) * 384 + h * 96;
      float a[8], pr[8];
      unpack8(ldg16(q + ch * 8), a);
      if (ch >= 8) { unpack8(ldg16(q + 64 + ((ch - 8) ^ 1) * 8), pr); rope8(a, pr, ch - 8, s_cs + tok * 16, s_sn + tok * 16); }
#pragma unroll
      for (int e = 0; e < 8; ++e) a[e] *= rq;
      *(u32x4*)(p.Qm + (((size_t)b * 4 + h) * TK + s0 + tok) * 96 + ch * 8) = pack8f(a);
      if (ch < 8) {
        unpack8(ldg16(KVRAW + (size_t)(r0 + tok) * 512 + h * 128 + ch * 8), a);
#pragma unroll
        for (int e = 0; e < 8; ++e) a[e] *= rkv;
      } else {
        const bf16_t* z = p.Z + (size_t)(r0 + tok) * NZP + ZC_KROPE;
        unpack8(ldg16(z + (ch - 8) * 8), a); unpack8(ldg16(z + ((ch - 8) ^ 1) * 8), pr);
        rope8(a, pr, ch - 8, s_cs + tok * 16, s_sn + tok * 16);
      }
      *(u32x4*)(p.Km + (((size_t)b * 4 + h) * TK + s0 + tok) * 96 + ch * 8) = pack8f(a);
    }
#pragma unroll 2
    for (int i = t; i < 32 * 64; i += NTHR) {
      const int tok = i >> 6, c = i & 63, qk = c >> 5, hm = (c >> 2) & 7, cc = c & 3;
      const bf16_t* src = p.Z + (size_t)(r0 + tok) * NZP + (qk ? ZC_DK : ZC_DQ) + hm * 32;
      float a[8], pr[8];
      unpack8(ldg16(src + cc * 8), a); unpack8(ldg16(src + (cc ^ 1) * 8), pr);
      rope8(a, pr, cc, s_cs + tok * 16, s_sn + tok * 16);
      if (qk == 0) {
#pragma unroll
        for (int e = 0; e < 8; ++e) a[e] *= QS_DIFF;
        *(u32x4*)(p.Qd + (((size_t)b * 8 + hm) * TK + s0 + tok) * 32 + cc * 8) = pack8f(a);
      } else *(u32x4*)(p.Kd + (((size_t)b * 8 + hm) * TK + s0 + tok) * 32 + cc * 8) = pack8f(a);
    }
#pragma unroll 2
    for (int i = t; i < 32 * 64; i += NTHR) {
      const int tok = i >> 6, c8 = (i & 63) * 8, s = s0 + tok;
      const bool first = (s == 0) || (s == TC), last = (s == TC - 1) || (s == TK - 1);
      const bf16_t* z = p.Z + (size_t)(r0 + tok) * NZP + ZC_MLQK + c8;
      float x0[8], xm[8], xp[8], o[8];
      unpack8(ldg16(z), x0);
      if (!first) unpack8(ldg16(z - NZP), xm);
      if (!last) unpack8(ldg16(z + NZP), xp);
#pragma unroll
      for (int e = 0; e < 8; ++e) {
        float acc = bcv[e >> 2][e & 3] + x0[e] * w1v[e >> 2][e & 3];
        if (!first) acc += xm[e] * w0v[e >> 2][e & 3];
        if (!last) acc += xp[e] * w2v[e >> 2][e & 3];
        o[e] = acc * fast_rcp(1.0f + fast_exp2(-LOG2E * acc));
      }
      if (c8 < 256) *(u32x4*)(p.MQ + ((size_t)b * TK + s) * 256 + c8) = pack8f(o);
      else {
#pragma unroll
        for (int e = 0; e < 8; ++e) o[e] *= 0.125f;
        *(u32x4*)(p.MK + ((size_t)b * TK + s) * 256 + c8 - 256) = pack8f(o);
      }
    }
    }
#pragma unroll 1
    for (int w = 0; w < ((PARTS & 2) ? 4 : 0); ++w) {
      __syncthreads();
#pragma unroll
      for (int k = 0; k < 4; ++k) {
        const int i = t + k * NTHR, tok = i >> 5, c8 = (i & 31) * 8;
        u32x4 v;
        if (w == 0) { float a[8]; const int h = c8 >> 6; unpack8(ldg16(KVRAW + (size_t)(r0 + tok) * 512 + h * 128 + 64 + (c8 & 63)), a); const float rkv = s_rstd[tok * 2 + 1];
#pragma unroll
          for (int e = 0; e < 8; ++e) a[e] *= rkv;
          v = pack8f(a); }
        else v = ldg16(p.Z + (size_t)(r0 + tok) * NZP + (w == 1 ? ZC_DV : (w == 2 ? ZC_MLV : ZC_GV)) + c8);
        *(u32x4*)(s_t + tok * 264 + c8) = v;
      }
      __syncthreads();
      bf16_t* dst = w == 0 ? p.Vtm : (w == 1 ? p.Vtd : (w == 2 ? p.MVt : p.GVt));
#pragma unroll
      for (int k = 0; k < 4; ++k) {
        const int i = t + k * NTHR, tg = i & 3, ch = i >> 2;
        u32x4 v;
        v.x = (unsigned)s_t[(tg * 8 + 0) * 264 + ch] | ((unsigned)s_t[(tg * 8 + 1) * 264 + ch] << 16);
        v.y = (unsigned)s_t[(tg * 8 + 2) * 264 + ch] | ((unsigned)s_t[(tg * 8 + 3) * 264 + ch] << 16);
        v.z = (unsigned)s_t[(tg * 8 + 4) * 264 + ch] | ((unsigned)s_t[(tg * 8 + 5) * 264 + ch] << 16);
        v.w = (unsigned)s_t[(tg * 8 + 6) * 264 + ch] | ((unsigned)s_t[(tg * 8 + 7) * 264 + ch] << 16);
        *(u32x4*)(dst + (((size_t)b * 4 + (ch >> 6)) * 64 + (ch & 63)) * TK + s0 + tg * 8) = v;
      }
    }
    __syncthreads();
  }
}
constexpr int VROW = 136;
constexpr int VROW_A = 144;
template <int DQK> struct AttnCfg {
  static constexpr int KROW = DQK * 2 + 16;
  static constexpr int KBYTES = 64 * KROW, VBYTES = 64 * VROW_A, STAGE = KBYTES + VBYTES;
  static constexpr int KCH = 64 * DQK * 2 / 16 / NTHR;
};
DI bf16x8 pack8(const f32x16& x, int s) {
  u32x4 pk; pk.x = pack2bf(x[8 * s], x[8 * s + 1]); pk.y = pack2bf(x[8 * s + 2], x[8 * s + 3]); pk.z = pack2bf(x[8 * s + 4], x[8 * s + 5]); pk.w = pack2bf(x[8 * s + 6], x[8 * s + 7]);
  return __builtin_bit_cast(bf16x8, pk);
}
struct TrueC { static constexpr bool value = true; };
struct FalseC { static constexpr bool value = false; };
template <int DQK, int NMAP, int VAR = 0>
DI void attn_unit(const bf16_t* __restrict__ Qb, const bf16_t* __restrict__ Kb, size_t mstride, const bf16_t* __restrict__ Vt, int q0, int nkeys,
                  f32x16 (&O)[NMAP][2], float (&lsum)[NMAP], char* lds) {
  constexpr int DM = DQK / NMAP;
  constexpr int KS = DM / 16;
  using C = AttnCfg<DQK>;
  constexpr int CPM = 64 * DM * 2 / 16;
  constexpr int CPR = DM * 2 / 16;
  const int t = TIDX, lane = t & 63, wid = t >> 6, l31 = lane & 31, hh = lane >> 5;
  bf16x8 qf[NMAP][KS];
#pragma unroll
  for (int m = 0; m < NMAP; ++m)
#pragma unroll
    for (int ks = 0; ks < KS; ++ks) qf[m][ks] = *(const bf16x8*)(Qb + m * mstride + (size_t)(q0 + wid * 32 + l31) * DM + ks * 16 + 8 * hh);
  float mref[NMAP];
  f32x4 lacc[NMAP];
  const short onev = ((lane & 15) < 2 && ((lane >> 4) & 1) == (lane & 15)) ? (short)0x3F80 : (short)0;
  const bf16x8 ones_a = {onev, onev, onev, onev, onev, onev, onev, onev};
#pragma unroll
  for (int m = 0; m < NMAP; ++m) { mref[m] = 0.f; lacc[m] = (f32x4){0.f, 0.f, 0.f, 0.f}; O[m][0] = (f32x16)(0.f); O[m][1] = (f32x16)(0.f); }
  u32x4 rk[C::KCH], rv[2];
  const bf16_t* kg[C::KCH]; int klds[C::KCH];
#pragma unroll
  for (int i = 0; i < C::KCH; ++i) { const int c = t + i * NTHR, m = c / CPM, cc = c % CPM; kg[i] = Kb + m * mstride + cc * 8; klds[i] = (cc / CPR) * C::KROW + m * DM * 2 + (cc % CPR) * 16; }
  const bf16_t* vg = Vt + (size_t)(t >> 3) * TK + (t & 7) * 8;
  const int vlds = C::KBYTES + (t >> 3) * VROW_A + ((t & 7) >> 1) * 32 + ((t & 1) ? 8 : 0);
  const int kfoff = l31 * C::KROW + 16 * hh, vfoff = C::KBYTES + l31 * VROW_A + 16 * hh;
  const int nt = nkeys / 64;
#pragma unroll
  for (int i = 0; i < C::KCH; ++i) rk[i] = ldg16(kg[i]);
  rv[0] = ldg16(vg); rv[1] = ldg16(vg + (size_t)32 * TK);
  auto tile = [&](const int kt, auto chk_c, auto ref_c) __attribute__((always_inline)) {
    constexpr bool CHK = decltype(chk_c)::value, REF = decltype(ref_c)::value;
    char* cur = lds + (kt & 1) * C::STAGE;
    if (VAR != 2) {
#pragma unroll
    for (int i = 0; i < C::KCH; ++i) sts16(cur + klds[i], rk[i]);
#pragma unroll
    for (int i = 0; i < 2; ++i) { char* d = cur + vlds + i * 32 * VROW_A; u32x2 lo, hi; lo.x = rv[i].x; lo.y = rv[i].y; hi.x = rv[i].z; hi.y = rv[i].w; *(u32x2*)d = lo; *(u32x2*)(d + 16) = hi; }
    __syncthreads();
    }
    if (VAR != 2 && kt + 1 < nt) {
      const int kn = VAR == 3 ? ((kt + 1) & 1) : kt + 1;
#pragma unroll
      for (int i = 0; i < C::KCH; ++i) rk[i] = ldg16(kg[i] + (size_t)kn * 64 * DM);
      rv[0] = ldg16(vg + kn * 64); rv[1] = ldg16(vg + (size_t)32 * TK + kn * 64);
    }
    bf16x8 kf[NMAP][2][KS];
#pragma unroll
    for (int k2 = 0; k2 < 2; ++k2)
#pragma unroll
      for (int ks = 0; ks < KS; ++ks) kf[0][k2][ks] = lds_frag(cur + kfoff + k2 * 32 * C::KROW + ks * 32);
    f32x16 S[NMAP][2];
    S[0][0] = (f32x16)(0.f); S[0][1] = (f32x16)(0.f);
#pragma unroll
    for (int ks = 0; ks < KS; ++ks)
#pragma unroll
      for (int k2 = 0; k2 < 2; ++k2) S[0][k2] = MFMA32(kf[0][k2][ks], qf[0][ks], S[0][k2]);
    bf16x8 vf[4][2];
#pragma unroll
    for (int kst = 0; kst < 4; ++kst)
#pragma unroll
      for (int dvt = 0; dvt < 2; ++dvt) vf[kst][dvt] = lds_frag(cur + vfoff + dvt * 32 * VROW_A + kst * 32);
#pragma unroll
    for (int m = 1; m < NMAP; ++m)
#pragma unroll
      for (int k2 = 0; k2 < 2; ++k2)
#pragma unroll
        for (int ks = 0; ks < KS; ++ks) kf[m][k2][ks] = lds_frag(cur + kfoff + k2 * 32 * C::KROW + m * DM * 2 + ks * 32);
#pragma unroll
    for (int m = 0; m < NMAP; ++m) {
      if (m > 0) {
        SCHED_BARRIER();
        S[m][0] = (f32x16)(0.f); S[m][1] = (f32x16)(0.f);
#pragma unroll
        for (int ks = 0; ks < KS; ++ks)
#pragma unroll
          for (int k2 = 0; k2 < 2; ++k2) S[m][k2] = MFMA32(kf[m][k2][ks], qf[m][ks], S[m][k2]);
      }
      if (VAR != 1) {
      if (CHK && (kt & 7) == 0) {
        float mx = fmaxf(S[m][0][0], S[m][1][0]);
#pragma unroll
        for (int i = 1; i < 16; ++i) mx = fmaxf(mx, fmaxf(S[m][0][i], S[m][1][i]));
        mx = xor_max<32>(mx);
        const float rel = mx - mref[m];
        const float delta = (kt == 0) ? ((mx > ATT_THR || mx < -ATT_THR) ? mx : 0.0f) : (rel > ATT_THR ? rel : 0.0f);
        if (wave_any(delta != 0.0f)) {
          const float alpha = fast_exp2(-delta);
          mref[m] += delta; lacc[m][0] *= alpha; lacc[m][1] *= lane_get(alpha, (lane & 15) + 16);
#pragma unroll
          for (int dvt = 0; dvt < 2; ++dvt)
#pragma unroll
            for (int i = 0; i < 16; ++i) O[m][dvt][i] *= alpha;
        }
      }
      if constexpr (REF) {
        if (wave_any(mref[m] != 0.0f)) {
          const f32x2 nm = {-mref[m], -mref[m]};
#pragma unroll
          for (int k2 = 0; k2 < 2; ++k2)
#pragma unroll
            for (int i = 0; i < 16; i += 2) { const f32x2 x = (f32x2){S[m][k2][i], S[m][k2][i + 1]} + nm; S[m][k2][i] = x.x; S[m][k2][i + 1] = x.y; }
        }
      }
#pragma unroll
      for (int k2 = 0; k2 < 2; ++k2)
#pragma unroll
        for (int i = 0; i < 16; ++i) S[m][k2][i] = fast_exp2(S[m][k2][i]);
      }
#pragma unroll
      for (int kst = 0; kst < 4; ++kst) {
        const bf16x8 pf = pack8(S[m][kst >> 1], kst & 1);
#pragma unroll
        for (int dvt = 0; dvt < 2; ++dvt) O[m][dvt] = MFMA32(vf[kst][dvt], pf, O[m][dvt]);
        lacc[m] = MFMA16(ones_a, pf, lacc[m]);
      }
    }
  };
  int kt = 0;
#pragma unroll 1
  while (kt < nt) {
    tile(kt, TrueC{}, TrueC{});
    ++kt;
    bool nz = false;
#pragma unroll
    for (int m = 0; m < NMAP; ++m) nz = nz || (mref[m] != 0.0f);
    if (!wave_any(nz)) {
      const int k8 = (kt + 7) & ~7, kend = k8 < nt ? k8 : nt;
#pragma unroll 1
      for (; kt < kend; ++kt) tile(kt, FalseC{}, FalseC{});
    }
  }
  __syncthreads();
#pragma unroll
  for (int m = 0; m < NMAP; ++m) { const float a0 = lane_get(lacc[m][0], lane & 15), a1 = lane_get(lacc[m][1], lane & 15); lsum[m] = l31 < 16 ? a0 : a1; }
}
constexpr int ATT_QB = TK / 128;
constexpr int ATT_LDS = 2 * AttnCfg<96>::STAGE;
constexpr int ATT_QBL = TL / 128, ATT_QBC = TC / 128, ATT_LAT_UNITS = NB * 4 * ATT_QBL, ATT_UNITS = ATT_LAT_UNITS + NB * 4 * ATT_QBC;
DI void att_unit(int u, int& bh, int& qb) {
  if (u < ATT_LAT_UNITS) { bh = u & 7; qb = ATT_QBC + (u >> 3); } else { const int v = u - ATT_LAT_UNITS; bh = v & 7; qb = v >> 3; }
}
DI void ph_attn_diff(const Params& p, int layer, int need_ctx, char* lds, int bid, int nblk) {
  const int lane = TIDX & 63, wid = TIDX >> 6, l31 = lane & 31, hh = lane >> 5;
  float lam_init; const float lam = lam_of(p, layer, lam_init);
#pragma unroll 1
  for (int u = bid; u < (need_ctx ? ATT_UNITS : ATT_LAT_UNITS); u += nblk) {
    int bh, qb; att_unit(u, bh, qb);
    const int b = bh >> 2, h = bh & 3, q0 = qb * 128;
    const int r = row_of(b, q0 + wid * 32 + l31);
    f32x16 O[2][2]; float ls[2];
    attn_unit<64, 2>(p.Qd + ((size_t)b * 8 + h * 2) * TK * 32, p.Kd + ((size_t)b * 8 + h * 2) * TK * 32, (size_t)TK * 32, p.Vtd + ((size_t)b * 4 + h) * 64 * TK, q0,
                     q0 < TC ? TC : TK, O, ls, lds);
    const float i0 = 1.0f / ls[0], i1 = lam / ls[1];
    float ss = 0.f;
#pragma unroll
    for (int dvt = 0; dvt < 2; ++dvt)
#pragma unroll
      for (int i = 0; i < 16; ++i) { const float o = O[0][dvt][i] * i0 - O[1][dvt][i] * i1; O[0][dvt][i] = o; ss += o * o; }
    ss = xor_sum<32>(ss);
    const float rstd = (1.0f - lam_init) / sqrtf(ss * (1.0f / 64) + 1e-6f);
    const float* gd = p.g_diff_out + layer * 256 + h * 64;
#pragma unroll
    for (int dvt = 0; dvt < 2; ++dvt)
#pragma unroll
      for (int g = 0; g < 4; ++g) {
        const int dv = dvt * 32 + 8 * g + 4 * hh;
        const f32x4 gv = *(const f32x4*)(gd + dv);
        f32x4 o = {O[0][dvt][4 * g] * rstd * gv[0], O[0][dvt][4 * g + 1] * rstd * gv[1], O[0][dvt][4 * g + 2] * rstd * gv[2], O[0][dvt][4 * g + 3] * rstd * gv[3]};
        st_bf16x4(p.Y + (size_t)r * D + 768 + h * 64 + dv, o);
      }
  }
}
DI void ph_attn_mla(const Params& p, int need_ctx, char* lds, int bid, int nblk) {
  const int lane = TIDX & 63, wid = TIDX >> 6, l31 = lane & 31, hh = lane >> 5;
#pragma unroll 1
  for (int u = bid; u < (need_ctx ? ATT_UNITS : ATT_LAT_UNITS); u += nblk) {
    int bh, qb; att_unit(u, bh, qb);
    const int b = bh >> 2, h = bh & 3, q0 = qb * 128;
    const int r = row_of(b, q0 + wid * 32 + l31);
    f32x16 O[1][2]; float ls[1];
    attn_unit<96, 1>(p.Qm + ((size_t)b * 4 + h) * TK * 96, p.Km + ((size_t)b * 4 + h) * TK * 96, 0, p.Vtm + ((size_t)b * 4 + h) * 64 * TK, q0, q0 < TC ? TC : TK, O, ls, lds);
    const float inv = 1.0f / ls[0];
#pragma unroll
    for (int dvt = 0; dvt < 2; ++dvt)
#pragma unroll
      for (int g = 0; g < 4; ++g) {
        f32x4 o = {O[0][dvt][4 * g] * inv, O[0][dvt][4 * g + 1] * inv, O[0][dvt][4 * g + 2] * inv, O[0][dvt][4 * g + 3] * inv};
        st_bf16x4(p.Y + (size_t)r * D + h * 64 + dvt * 32 + 8 * g + 4 * hh, o);
      }
  }
}
template <int VAR> DI void ph_attn_mla_probe(const Params& p, char* lds, int bid, int nblk) {
  const int lane = TIDX & 63, wid = TIDX >> 6, l31 = lane & 31, hh = lane >> 5;
#pragma unroll 1
  for (int u = bid; u < ATT_LAT_UNITS; u += nblk) {
    int bh, qb; att_unit(u, bh, qb);
    const int b = bh >> 2, h = bh & 3, q0 = qb * 128;
    const int r = row_of(b, q0 + wid * 32 + l31);
    f32x16 O[1][2]; float ls[1];
    attn_unit<96, 1, VAR>(p.Qm + ((size_t)b * 4 + h) * TK * 96, p.Km + ((size_t)b * 4 + h) * TK * 96, 0, p.Vtm + ((size_t)b * 4 + h) * 64 * TK, q0, TK, O, ls, lds);
    const float inv = 1.0f / ls[0];
#pragma unroll
    for (int dvt = 0; dvt < 2; ++dvt)
#pragma unroll
      for (int g = 0; g < 4; ++g) {
        f32x4 o = {O[0][dvt][4 * g] * inv, O[0][dvt][4 * g + 1] * inv, O[0][dvt][4 * g + 2] * inv, O[0][dvt][4 * g + 3] * inv};
        *(f32x4*)(p.out + (size_t)r * D + h * 64 + dvt * 32 + 8 * g + 4 * hh) = o;
      }
  }
}
DI void ph_attn(const Params& p, int layer, int need_ctx, char* lds, int bid, int nblk) {
  ph_attn_diff(p, layer, need_ctx, lds, bid, nblk);
  ph_attn_mla(p, need_ctx, lds, bid, nblk);
}

DI float wave_sum(float v) {
  v = xor_sum<1>(v); v = xor_sum<2>(v); v = xor_sum<4>(v); v = xor_sum<8>(v); v = xor_sum<16>(v); v = xor_sum<32>(v);
  return v;
}
DI void ld_row16(const float* row, int lane, f32x4 (&v)[4]) {
#pragma unroll
  for (int i = 0; i < 4; ++i) v[i] = *(const f32x4*)(row + 256 * i + 4 * lane);
}
DI void ld_row16_bf(const bf16_t* row, int lane, f32x4 (&v)[4]) {
#pragma unroll
  for (int i = 0; i < 4; ++i) { const u32x2 u = *(const u32x2*)(row + 256 * i + 4 * lane); v[i] = (f32x4){u2f(u.x << 16), u2f(u.x & 0xffff0000u), u2f(u.y << 16), u2f(u.y & 0xffff0000u)}; }
}
DI void ph_modulate(const Params& p, int layer, const float* xl, const float* xcx, int bid, int nblk) {
  const int lane = TIDX & 63, wid = TIDX >> 6;
  const float* g = p.g_mix_pre + layer * 1024;
  int wprev = -1;
  f32x4 gs[4], sh[4];
  for (int r = bid * 4 + wid; r < R; r += nblk * 4) {
    const int w = r < RL ? r / TL : 2;
    const float* x = r < RL ? xl + (size_t)r * D : xcx + (size_t)(r - RL) * D;
    f32x4 xv[4];
    ld_row16(x, lane, xv);
    if (w != wprev) {
      const float* mb = p.mods + (size_t)(layer * 3 + w) * 6144;
      f32x4 gv[4], sc[4];
      ld_row16(g, lane, gv); ld_row16(mb + 1024, lane, sc); ld_row16(mb, lane, sh);
#pragma unroll
      for (int i = 0; i < 4; ++i) gs[i] = gv[i] * (sc[i] + 1.0f);
      wprev = w;
    }
    float ss = 0.f;
#pragma unroll
    for (int i = 0; i < 4; ++i)
#pragma unroll
      for (int e = 0; e < 4; ++e) ss += xv[i][e] * xv[i][e];
    const float rstd = 1.0f / sqrtf(wave_sum(ss) * (1.0f / D) + 1e-6f);
#pragma unroll
    for (int i = 0; i < 4; ++i) {
      f32x4 o;
#pragma unroll
      for (int e = 0; e < 4; ++e) o[e] = xv[i][e] * rstd * gs[i][e] + sh[i][e];
      st_bf16x4(p.H + (size_t)r * D + 256 * i + 4 * lane, o);
    }
  }
}
DI void ph_resid_mix(const Params& p, int layer, const float* xl_in, const float* xc_in, int rows, char* lds, int bid, int nblk) {
  const int lane = TIDX & 63, wid = TIDX >> 6;
  const float* wr = p.w_router + (size_t)layer * D * 16;
  for (int i = TIDX; i < D * 4; i += NTHR) { const int k = i >> 2, q = i & 3; *(f32x4*)(lds + k * 64 + (k >> 2) * 16 + q * 16) = *(const f32x4*)(wr + k * 16 + q * 4); }
  __syncthreads();
  int wprev = -1;
  f32x4 ac[4], gs[4], s3[4];
  const int rpb = (rows + nblk - 1) / nblk, rend = (bid + 1) * rpb < rows ? (bid + 1) * rpb : rows;
  for (int r = bid * rpb + wid; r < rend; r += 4) {
    const int w = r < RL ? r / TL : 2;
    const float* xin = r < RL ? xl_in + (size_t)r * D : xc_in + (size_t)(r - RL) * D;
    float* xo = r < RL ? p.out + (size_t)r * D : p.xc + (size_t)(r - RL) * D;
    f32x4 yv[4], xv[4];
    ld_row16_bf(p.YO + (size_t)r * D, lane, yv); ld_row16(xin, lane, xv);
    if (w != wprev) {
      const float* mb = p.mods + (size_t)(layer * 3 + w) * 6144;
      f32x4 a[4], c[4];
      ld_row16(mb + 2 * 1024, lane, a); ld_row16(p.g_mix_post + layer * 1024, lane, c);
#pragma unroll
      for (int i = 0; i < 4; ++i) ac[i] = a[i] * c[i];
      ld_row16(p.g_ffn_pre + layer * 1024, lane, a); ld_row16(mb + 4 * 1024, lane, c); ld_row16(mb + 3 * 1024, lane, s3);
#pragma unroll
      for (int i = 0; i < 4; ++i) gs[i] = a[i] * (c[i] + 1.0f);
      wprev = w;
    }
    float ss = 0.f;
#pragma unroll
    for (int i = 0; i < 4; ++i)
#pragma unroll
      for (int e = 0; e < 4; ++e) ss += yv[i][e] * yv[i][e];
    const float rstd = 1.0f / sqrtf(wave_sum(ss) * (1.0f / D) + 1e-6f);
    float s2 = 0.f;
#pragma unroll
    for (int i = 0; i < 4; ++i) {
#pragma unroll
      for (int e = 0; e < 4; ++e) { xv[i][e] += ac[i][e] * yv[i][e] * rstd; s2 += xv[i][e] * xv[i][e]; }
      *(f32x4*)(xo + 256 * i + 4 * lane) = xv[i];
    }
    const float rstd2 = 1.0f / sqrtf(wave_sum(s2) * (1.0f / D) + 1e-6f);
    float lg[16];
#pragma unroll
    for (int e = 0; e < 16; ++e) lg[e] = 0.f;
#pragma unroll
    for (int i = 0; i < 4; ++i) {
      f32x4 h2;
#pragma unroll
      for (int e = 0; e < 4; ++e) h2[e] = xv[i][e] * rstd2 * gs[i][e] + s3[i][e];
      st_bf16x4(p.H + (size_t)r * D + 256 * i + 4 * lane, h2);
#pragma unroll
      for (int e = 0; e < 4; ++e) {
        const char* wk = lds + (256 * i + 4 * lane + e) * 64 + (64 * i + lane) * 16;
#pragma unroll
        for (int q = 0; q < 4; ++q) { const f32x4 wv = *(const f32x4*)(wk + 16 * q); lg[4 * q] += h2[e] * wv[0]; lg[4 * q + 1] += h2[e] * wv[1]; lg[4 * q + 2] += h2[e] * wv[2]; lg[4 * q + 3] += h2[e] * wv[3]; }
      }
    }
#pragma unroll
    for (int e = 0; e < 16; ++e) lg[e] = wave_sum(lg[e]);
    float mx = lg[0];
#pragma unroll
    for (int e = 1; e < 16; ++e) mx = fmaxf(mx, lg[e]);
    float sm = 0.f;
#pragma unroll
    for (int e = 0; e < 16; ++e) { lg[e] = expf(lg[e] - mx); sm += lg[e]; }
    int b, s; bs_of(r, b, s);
    float mine = 0.f;
#pragma unroll
    for (int e = 0; e < 16; ++e) mine = (lane == e) ? lg[e] / sm : mine;
    if (lane < 16) p.AFF[((size_t)b * NE + lane) * TK + s] = mine;
  }
}
DI void ph_resid_ffn(const Params& p, int layer, int rows, int bid, int nblk) {
  const int lane = TIDX & 63, wid = TIDX >> 6;
  int r = bid * 4 + wid;
  int inv_n = (r < rows && lane < NE) ? p.INV[(size_t)lane * R + r] : -1;
  int wprev = -1;
  f32x4 ac[4], gs[4], sh[4];
#pragma unroll 1
  for (; r < rows; r += nblk * 4) {
    const int w = r < RL ? r / TL : 2;
    if (w != wprev) {
      const float* mb = p.mods + (size_t)(layer * 3 + w) * 6144;
      f32x4 a[4], c[4];
      ld_row16(mb + 5 * 1024, lane, a); ld_row16(p.g_ffn_post + layer * 1024, lane, c);
#pragma unroll
      for (int i = 0; i < 4; ++i) ac[i] = a[i] * c[i];
      if (layer == 0) {
        const float* mb1 = p.mods + (size_t)(3 + w) * 6144;
        ld_row16(p.g_mix_pre + 1024, lane, a); ld_row16(mb1 + 1024, lane, c); ld_row16(mb1, lane, sh);
#pragma unroll
        for (int i = 0; i < 4; ++i) gs[i] = a[i] * (c[i] + 1.0f);
      }
      wprev = w;
    }
    float* xo = r < RL ? p.out + (size_t)r * D : p.xc + (size_t)(r - RL) * D;
    const int myinv = inv_n;
    { const int rn = r + nblk * 4; inv_n = (rn < rows && lane < NE) ? p.INV[(size_t)lane * R + rn] : -1; }
    f32x4 f[4], xv[4];
    ld_row16(xo, lane, xv);
#pragma unroll
    for (int i = 0; i < 4; ++i) f[i] = (f32x4){0.f, 0.f, 0.f, 0.f};
    unsigned mask = wave_ballot16(myinv >= 0);
#pragma unroll 1
    while (mask) {
      const int e0 = __builtin_ctz(mask); mask &= mask - 1;
      const bool two = mask != 0u;
      const int e1 = two ? __builtin_ctz(mask) : e0; if (two) mask &= mask - 1;
      const int s0 = lane_bcast(myinv, e0), s1 = lane_bcast(myinv, e1);
      f32x4 y0[4], y1[4];
      ld_row16_bf(p.YE + ((size_t)e0 * NSLOT + s0) * D, lane, y0); ld_row16_bf(p.YE + ((size_t)e1 * NSLOT + s1) * D, lane, y1);
      const float w1 = two ? 1.0f : 0.0f;
#pragma unroll
      for (int i = 0; i < 4; ++i) f[i] += y0[i] + y1[i] * w1;
    }
    float ss = 0.f;
#pragma unroll
    for (int i = 0; i < 4; ++i)
#pragma unroll
      for (int e = 0; e < 4; ++e) ss += f[i][e] * f[i][e];
    const float rstd = 1.0f / sqrtf(wave_sum(ss) * (1.0f / D) + 1e-6f);
    float s2 = 0.f;
#pragma unroll
    for (int i = 0; i < 4; ++i) {
#pragma unroll
      for (int e = 0; e < 4; ++e) { xv[i][e] += ac[i][e] * f[i][e] * rstd; s2 += xv[i][e] * xv[i][e]; }
      *(f32x4*)(xo + 256 * i + 4 * lane) = xv[i];
    }
    if (layer == 0) {
      const float rstd2 = 1.0f / sqrtf(wave_sum(s2) * (1.0f / D) + 1e-6f);
#pragma unroll
      for (int i = 0; i < 4; ++i) {
        f32x4 o;
#pragma unroll
        for (int e = 0; e < 4; ++e) o[e] = xv[i][e] * rstd2 * gs[i][e] + sh[i][e];
        st_bf16x4(p.H + (size_t)r * D + 256 * i + 4 * lane, o);
      }
    }
  }
}
DI void ph_mods(const Params& p, char* lds, int bid, int nblk) {
  float* sc = (float*)lds;
  const int t = TIDX;
  for (int i = t; i < 3 * 1024; i += NTHR) { const float v = i < 2048 ? p.c[i] : p.c_ctx[i - 2048]; sc[i] = v / (1.0f + expf(-v)); }
  __syncthreads();
#pragma unroll 1
  for (long gi = (long)bid * NTHR + t; gi < 2 * 3 * 6144; gi += (long)nblk * NTHR) {
    const int col = (int)(gi % 6144), w = (int)((gi / 6144) % 3), l = (int)(gi / (3 * 6144));
    const float* W = p.w_ada + (size_t)l * 1024 * 6144 + col; const float* s = sc + w * 1024;
    float acc[8];
#pragma unroll
    for (int q = 0; q < 8; ++q) acc[q] = 0.f;
#pragma unroll 1
    for (int k = 0; k < 1024; k += 8) {
#pragma unroll
      for (int q = 0; q < 8; ++q) acc[q] += s[k + q] * W[(size_t)(k + q) * 6144];
    }
    p.mods[gi] = ((acc[0] + acc[1]) + (acc[2] + acc[3])) + ((acc[4] + acc[5]) + (acc[6] + acc[7])) + p.b_ada[l * 6144 + col];
  }
  __syncthreads();
}
constexpr int TOPK_LDS = TL * 4 + 2048;
DI int block_sum_i(int v, int* red) {
  const int lane = TIDX & 63, wid = TIDX >> 6;
  v = xor_sum_i<1>(v); v = xor_sum_i<2>(v); v = xor_sum_i<4>(v); v = xor_sum_i<8>(v); v = xor_sum_i<16>(v); v = xor_sum_i<32>(v);
  __syncthreads();
  if (lane == 0) red[wid] = v;
  __syncthreads();
  return red[0] + red[1] + red[2] + red[3];
}
DI int block_excl_scan(int v, int* red) {
  const int lane = TIDX & 63, wid = TIDX >> 6;
  int inc = v;
#pragma unroll
  for (int d = 1; d < 64; d <<= 1) { const int o = lane_up(inc, d, lane); if (lane >= d) inc += o; }
  __syncthreads();
  if (lane == 63) red[wid] = inc;
  __syncthreads();
  int base = 0;
  for (int q = 0; q < wid; ++q) base += red[q];
  return base + inc - v;
}
DI void ph_topk(const Params& p, int need_ctx, char* lds, int bid, int nblk) {
  unsigned* vals = (unsigned*)lds; int* red = (int*)(lds + TL * 4 + 1024);
  const int t = TIDX;
  for (int u = bid; u < NB * NE * 2; u += nblk) {
    const int seg = u & 1, e = (u >> 1) % NE, b = u / (2 * NE);
    const int s0 = seg ? TC : 0, n = seg ? TL : TC, cap = seg ? CAPL : CAPC, slot0 = seg ? b * CAPL : NB * CAPL + b * CAPC;
    if (seg == 0 && !need_ctx) { for (int q = t; q < cap; q += NTHR) p.SEL[(size_t)e * NSLOT + slot0 + q] = -1; continue; }
    const float* a = p.AFF + ((size_t)b * NE + e) * TK + s0;
    const int vpt = (n + NTHR - 1) / NTHR, i0 = t * vpt, i1 = (i0 + vpt < n) ? i0 + vpt : n;
    for (int i = t; i < n; i += NTHR) vals[i + i / vpt] = f2u(a[i]);
    __syncthreads();
    unsigned thr = 0;
    for (int bit = 31; bit >= 0; --bit) {
      const unsigned cand = thr | (1u << bit);
      int cnt = 0;
      for (int i = i0; i < i1; ++i) cnt += (vals[i + t] >= cand);
      if (block_sum_i(cnt, red) >= cap) thr = cand;
    }
    int cgt = 0, ceq = 0;
    for (int i = i0; i < i1; ++i) { cgt += (vals[i + t] > thr); ceq += (vals[i + t] == thr); }
    const int ngt = block_sum_i(cgt, red);
    const int neq = cap - ngt;
    int eqoff = block_excl_scan(ceq, red);
    int csel = 0;
    { int er = eqoff; for (int i = i0; i < i1; ++i) { if (vals[i + t] > thr) ++csel; else if (vals[i + t] == thr) { if (er < neq) ++csel; ++er; } } }
    int q = block_excl_scan(csel, red);
    for (int i = i0; i < i1; ++i) {
      const unsigned v = vals[i + t]; int sel = -1;
      if (v > thr) sel = q++; else if (v == thr) { if (eqoff < neq) sel = q++; ++eqoff; }
      const int r = row_of(b, s0 + i);
      if (sel >= 0) { p.SEL[(size_t)e * NSLOT + slot0 + sel] = r; p.SELV[(size_t)e * NSLOT + slot0 + sel] = u2f(v); }
      p.INV[(size_t)e * R + r] = sel >= 0 ? slot0 + sel : -1;
    }
    __syncthreads();
  }
}
DI void ph_wt(const float* in, bf16_t* out, int K, int N, int NP, int nbatch, long in_bs, long out_bs, const float* gain, char* lds, int bid, int nblk) {
  float* tile = (float*)lds;
  const int t = TIDX, tk = K / 64, tn = NP / 64, ntile = nbatch * tk * tn;
  f32x4 v[4];
  auto gload = [&](int u) {
    const int bt = u / (tk * tn), rem = u % (tk * tn), k0 = (rem / tn) * 64, n0 = (rem % tn) * 64;
    const float* I = in + (size_t)bt * in_bs;
#pragma unroll
    for (int i = 0; i < 4; ++i) {
      const int idx = t + i * NTHR, kk = idx >> 4, n4 = (idx & 15) * 4;
      v[i] = (f32x4){0.f, 0.f, 0.f, 0.f};
      if (n0 + n4 < N) v[i] = *(const f32x4*)(I + (size_t)(k0 + kk) * N + n0 + n4);
      if (gain) { const float g = gain[k0 + kk]; v[i][0] *= g; v[i][1] *= g; v[i][2] *= g; v[i][3] *= g; }
    }
  };
  if (bid < ntile) gload(bid);
#pragma unroll 1
  for (int u = bid; u < ntile; u += nblk) {
    const int bt = u / (tk * tn), rem = u % (tk * tn), k0 = (rem / tn) * 64, n0 = (rem % tn) * 64;
    bf16_t* O = out + (size_t)bt * out_bs;
#pragma unroll
    for (int i = 0; i < 4; ++i) { const int idx = t + i * NTHR, kk = idx >> 4, n4 = (idx & 15) * 4; float* d = tile + kk * 65 + n4; d[0] = v[i][0]; d[1] = v[i][1]; d[2] = v[i][2]; d[3] = v[i][3]; }
    __syncthreads();
    if (u + nblk < ntile) gload(u + nblk);
#pragma unroll
    for (int i = 0; i < 2; ++i) {
      const int idx = t + i * NTHR, kg = idx & 7, nn = idx >> 3;
      float a[8];
#pragma unroll
      for (int e = 0; e < 8; ++e) a[e] = tile[(kg * 8 + e) * 65 + nn];
      u32x4 o; o.x = pack2bf(a[0], a[1]); o.y = pack2bf(a[2], a[3]); o.z = pack2bf(a[4], a[5]); o.w = pack2bf(a[6], a[7]);
      *(u32x4*)(O + (size_t)(n0 + nn) * K + k0 + kg * 8) = o;
    }
    __syncthreads();
  }
}
DI float wave_max(float v) {
  v = xor_max<1>(v); v = xor_max<2>(v); v = xor_max<4>(v); v = xor_max<8>(v); v = xor_max<16>(v); v = xor_max<32>(v);
  return v;
}
DI bf16x8 cvt8(const float* f) {
  const f32x4 a = *(const f32x4*)f, b = *(const f32x4*)(f + 4);
  u32x4 pk; pk.x = pack2bf(a[0], a[1]); pk.y = pack2bf(a[2], a[3]); pk.z = pack2bf(b[0], b[1]); pk.w = pack2bf(b[2], b[3]);
  return __builtin_bit_cast(bf16x8, pk);
}
constexpr int SCAN_UNITS = NB * NCK * 4, SCAN_LAT_UNITS = NB * NCL * 4;
DI void scan_unit(int u, int& b, int& c, int& h) {
  h = u & 3;
  if (u < SCAN_LAT_UNITS) { c = NCC + (u >> 2) % NCL; b = u / (4 * NCL); } else { const int v = u - SCAN_LAT_UNITS; c = (v >> 2) % NCC; b = v / (4 * NCC); }
}

DI void ph_ml_local(const Params& p, char* lds, int bid, int nblk) {
  bf16_t* sK = (bf16_t*)lds;
  float* sW = (float*)(lds + 64 * 132);
  const int t = TIDX, lane = t & 63, wid = t >> 6, l31 = lane & 31, hh = lane >> 5;
  const int d = wid & 1, vt = wid >> 1;
#pragma unroll 1
  for (int u = bid; u < SCAN_UNITS; u += nblk) {
    int b, c, h; scan_unit(u, b, c, h);
    {
      const int row = t >> 2, seg = (t & 3) * 16;
      const bf16_t* src = p.MK + ((size_t)b * TK + 64 * c + row) * 256 + h * 64 + seg;
      const u32x4 a = ldg16(src), bb = ldg16(src + 8);
      unsigned* dst = (unsigned*)((char*)sK + row * 132 + seg * 2);
      dst[0] = a.x; dst[1] = a.y; dst[2] = a.z; dst[3] = a.w; dst[4] = bb.x; dst[5] = bb.y; dst[6] = bb.z; dst[7] = bb.w;
    }
    if (t < 128) {
      const int dd = t >> 6, l = t & 63, j = step_of(dd, c), pos = dd ? 63 - l : l;
      const size_t o = (((size_t)b * 2 + dd) * TK + 64 * j) * 4 + h;
      const float bend = p.BC[o + 63 * 4], wl = bend - p.BC[o + pos * 4] + p.IGS[o + pos * 4];
      const float ml = wave_max(wl);
      sW[dd * 64 + l] = expf(wl - ml);
      if (l == 0) { const size_t uu = (((size_t)b * 2 + dd) * NCK + j) * 4 + h; p.MM[uu * 4] = ml; p.MM[uu * 4 + 1] = bend; }
    }
    __syncthreads();
    const int j = step_of(d, c);
    const size_t uu = (((size_t)b * 2 + d) * NCK + j) * 4 + h;
    f32x16 acc[2]; acc[0] = (f32x16)(0.f); acc[1] = (f32x16)(0.f);
    const bf16_t* vsrc = p.MVt + (((size_t)b * 4 + h) * 64 + vt * 32 + l31) * TK + 64 * c;
#pragma unroll
    for (int ks = 0; ks < 4; ++ks) {
      const bf16x8 a = *(const bf16x8*)(vsrc + ks * 16 + 8 * hh);
      const float* w = sW + d * 64 + ks * 16 + 8 * hh;
      u32x4 pk;
      pk.x = pack2bf(bf2f((bf16_t)a[0]) * w[0], bf2f((bf16_t)a[1]) * w[1]); pk.y = pack2bf(bf2f((bf16_t)a[2]) * w[2], bf2f((bf16_t)a[3]) * w[3]);
      pk.z = pack2bf(bf2f((bf16_t)a[4]) * w[4], bf2f((bf16_t)a[5]) * w[5]); pk.w = pack2bf(bf2f((bf16_t)a[6]) * w[6], bf2f((bf16_t)a[7]) * w[7]);
      const bf16x8 af = __builtin_bit_cast(bf16x8, pk);
#pragma unroll
      for (int kt = 0; kt < 2; ++kt) {
        bf16x8 bfr;
#pragma unroll
        for (int q = 0; q < 8; ++q) bfr[q] = (short)sK[(ks * 16 + 8 * hh + q) * 66 + kt * 32 + l31];
        acc[kt] = MFMA32(af, bfr, acc[kt]);
      }
    }
#pragma unroll
    for (int kt = 0; kt < 2; ++kt)
#pragma unroll
      for (int i = 0; i < 16; ++i) p.MC[uu * 4096 + (size_t)(vt * 32 + (i & 3) + 8 * (i >> 2) + 4 * hh) * 64 + kt * 32 + l31] = acc[kt][i];
    float nl = 0.f;
    for (int q = 0; q < 32; ++q) { const int l = hh * 32 + q; nl += sW[d * 64 + l] * bf2f(sK[l * 66 + vt * 32 + l31]); }
    nl = xor_sum<32>(nl);
    if (hh == 0) p.MN[uu * 64 + vt * 32 + l31] = nl;
    __syncthreads();
  }
}
constexpr int SCAN_PF = 8;
DI void ph_ml_scan(const Params& p, int bid, int nblk) {
  for (long gi = (long)bid * NTHR + TIDX; gi < (long)NB * 2 * 4 * 4160; gi += (long)nblk * NTHR) {
    const int e = (int)(gi % 4160), ch = (int)(gi / 4160), h = ch & 3, bd = ch >> 2;
    float* base = e < 4096 ? p.MC + (((size_t)bd * NCK) * 4 + h) * 4096 + e : p.MN + (((size_t)bd * NCK) * 4 + h) * 64 + (e - 4096);
    const size_t stride = e < 4096 ? 4 * 4096 : 4 * 64;
    float* mm = p.MM + (((size_t)bd * NCK) * 4 + h) * 4;
    float st = 0.f, m = -1e30f;
    float cl[SCAN_PF], cm[SCAN_PF], cb[SCAN_PF], nl[SCAN_PF], nm[SCAN_PF], nb[SCAN_PF];
#pragma unroll
    for (int q = 0; q < SCAN_PF; ++q) if (q < NCK) { cl[q] = base[(size_t)q * stride]; cm[q] = mm[q * 16]; cb[q] = mm[q * 16 + 1]; }
#pragma unroll 1
    for (int jb = 0; jb < NCK; jb += SCAN_PF) {
#pragma unroll
      for (int q = 0; q < SCAN_PF; ++q) { const int j = jb + SCAN_PF + q; if (j < NCK) { nl[q] = base[(size_t)j * stride]; nm[q] = mm[j * 16]; nb[q] = mm[j * 16 + 1]; } }
#pragma unroll
      for (int q = 0; q < SCAN_PF; ++q) {
        const int j = jb + q;
        if (j < NCK) {
          const float mn = fmaxf(cb[q] + m, cm[q]), a = expf(cb[q] + m - mn), g = expf(cm[q] - mn);
          base[(size_t)j * stride] = st;
          st = a * st + g * cl[q];
          if (e == 0) mm[j * 16 + 2] = m;
          m = mn;
        }
      }
#pragma unroll
      for (int q = 0; q < SCAN_PF; ++q) { cl[q] = nl[q]; cm[q] = nm[q]; cb[q] = nb[q]; }
    }
  }
}
DI void ph_gla_scan(const Params& p, int bid, int nblk) {
  for (long gi = (long)bid * NTHR + TIDX; gi < (long)NB * 2 * 4 * 2048; gi += (long)nblk * NTHR) {
    const int e = (int)(gi % 2048), ch = (int)(gi / 2048), h = ch & 3, bd = ch >> 2, k = e & 31;
    float* base = p.GS + (((size_t)bd * NCK) * 4 + h) * 2048 + e;
    const float* ge = p.GC + ((size_t)bd * TK + 63) * 128 + h * 32 + k;
    float st = 0.f;
    float cl[SCAN_PF], cg[SCAN_PF], nl[SCAN_PF], ng[SCAN_PF];
#pragma unroll
    for (int q = 0; q < SCAN_PF; ++q) if (q < NCK) { cl[q] = base[(size_t)q * 4 * 2048]; cg[q] = ge[(size_t)q * 64 * 128]; }
#pragma unroll 1
    for (int jb = 0; jb < NCK; jb += SCAN_PF) {
#pragma unroll
      for (int q = 0; q < SCAN_PF; ++q) { const int j = jb + SCAN_PF + q; if (j < NCK) { nl[q] = base[(size_t)j * 4 * 2048]; ng[q] = ge[(size_t)j * 64 * 128]; } }
#pragma unroll
      for (int q = 0; q < SCAN_PF; ++q) {
        const int j = jb + q;
        if (j < NCK) { base[(size_t)j * 4 * 2048] = st; st = expf(cg[q]) * st + cl[q]; }
      }
#pragma unroll
      for (int q = 0; q < SCAN_PF; ++q) { cl[q] = nl[q]; cg[q] = ng[q]; }
    }
  }
}
constexpr int MO_K = 0, MO_V = 64 * 144, MO_A = MO_V + 64 * VROW, MO_PM = MO_A + 512, MO_N0 = MO_PM + 512, MO_X = MO_N0 + 512, MO_LDS = MO_X + 16384;
DI void ph_ml_out(const Params& p, int layer, int need_ctx, char* lds, int bid, int nblk) {
  float* sA = (float*)(lds + MO_A); float* sPM = (float*)(lds + MO_PM); float* sN0 = (float*)(lds + MO_N0); float* sX = (float*)(lds + MO_X);
  const int t = TIDX, lane = t & 63, wid = t >> 6, l31 = lane & 31, hh = lane >> 5;
  const int lt = wid & 1, d = wid >> 1;
#pragma unroll 1
  for (int u = bid; u < (need_ctx ? SCAN_UNITS : SCAN_LAT_UNITS); u += nblk) {
    int b, c, h; scan_unit(u, b, c, h);
    {
      const int row = t >> 2, seg = (t & 3) * 16;
      const bf16_t* ks = p.MK + ((size_t)b * TK + 64 * c + row) * 256 + h * 64 + seg;
      sts16(lds + MO_K + row * 144 + seg * 2, ldg16(ks)); sts16(lds + MO_K + row * 144 + seg * 2 + 16, ldg16(ks + 8));
      const bf16_t* vs = p.MVt + (((size_t)b * 4 + h) * 64 + row) * TK + 64 * c + seg;
      const u32x4 v0 = ldg16(vs), v1 = ldg16(vs + 8);
      u32x2* dv = (u32x2*)(lds + MO_V + row * VROW + seg * 2);
      u32x2 q; q.x = v0.x; q.y = v0.y; dv[0] = q; q.x = v0.z; q.y = v0.w; dv[1] = q; q.x = v1.x; q.y = v1.y; dv[2] = q; q.x = v1.z; q.y = v1.w; dv[3] = q;
    }
    if (t < 128) {
      const int dd = t >> 6, s = t & 63, j = step_of(dd, c), pos = dd ? 63 - s : s;
      const size_t o = (((size_t)b * 2 + dd) * TK + 64 * j) * 4 + h;
      sA[dd * 64 + s] = p.IGS[o + pos * 4] - p.BC[o + pos * 4];
      const size_t uu = (((size_t)b * 2 + dd) * NCK + j) * 4 + h;
      sN0[dd * 64 + s] = p.MN[uu * 64 + s];
    }
    __syncthreads();
    if (t < 2) {
      float m = -1e30f;
      if (t == 0) { for (int s = 0; s < 64; ++s) { m = fmaxf(m, sA[s]); sPM[s] = m; } }
      else { for (int s = 63; s >= 0; --s) { m = fmaxf(m, sA[64 + s]); sPM[64 + s] = m; } }
    }
    __syncthreads();
    const int j = step_of(d, c);
    const size_t uu = (((size_t)b * 2 + d) * NCK + j) * 4 + h;
    const int l = lt * 32 + l31, pos = d ? 63 - l : l;
    const float bl = p.BC[(((size_t)b * 2 + d) * TK + 64 * j + pos) * 4 + h];
    const float inter = bl + p.MM[uu * 4 + 2];
    const float mt = fmaxf(inter, bl + sPM[d * 64 + l]);
    const float aint = expf(inter - mt);
    bf16x8 qf[4];
#pragma unroll
    for (int ks = 0; ks < 4; ++ks) qf[ks] = *(const bf16x8*)(p.MQ + ((size_t)b * TK + 64 * c + l) * 256 + h * 64 + ks * 16 + 8 * hh);
    f32x16 num[2]; num[0] = (f32x16)(0.f); num[1] = (f32x16)(0.f);
    float den = 0.f;
#pragma unroll
    for (int st = 0; st < 2; ++st) {
      if (d == 0 ? st <= lt : st >= lt) {
        f32x16 S = (f32x16)(0.f);
#pragma unroll
        for (int ks = 0; ks < 4; ++ks) S = MFMA32(lds_frag(lds + MO_K + (st * 32 + l31) * 144 + (ks * 16 + 8 * hh) * 2), qf[ks], S);
#pragma unroll
        for (int i = 0; i < 16; ++i) {
          const int s = st * 32 + (i & 3) + 8 * (i >> 2) + 4 * hh;
          const bool ok = d == 0 ? s <= l : s >= l;
          const float e = ok ? fast_exp2((bl + sA[d * 64 + s] - mt) * LOG2E) * S[i] : 0.f;
          S[i] = e; den += e;
        }
#pragma unroll
        for (int kst = 0; kst < 2; ++kst) {
          const bf16x8 pf = pack8(S, kst);
#pragma unroll
          for (int vt = 0; vt < 2; ++vt) {
            const char* vp = lds + MO_V + (vt * 32 + l31) * VROW + (st * 32 + kst * 16 + 4 * hh) * 2;
            const s16x4 lo = *(const s16x4*)vp, hi = *(const s16x4*)(vp + 16);
            num[vt] = MFMA32(__builtin_shufflevector(lo, hi, 0, 1, 2, 3, 4, 5, 6, 7), pf, num[vt]);
          }
        }
      }
    }
    f32x16 accI[2]; accI[0] = (f32x16)(0.f); accI[1] = (f32x16)(0.f);
#pragma unroll
    for (int vt = 0; vt < 2; ++vt)
#pragma unroll
      for (int ks = 0; ks < 4; ++ks) accI[vt] = MFMA32(cvt8(p.MC + uu * 4096 + (size_t)(vt * 32 + l31) * 64 + ks * 16 + 8 * hh), qf[ks], accI[vt]);
    float qn = 0.f;
#pragma unroll
    for (int ks = 0; ks < 4; ++ks)
#pragma unroll
      for (int q = 0; q < 8; ++q) qn += bf2f((bf16_t)qf[ks][q]) * sN0[d * 64 + ks * 16 + 8 * hh + q];
    den = xor_sum<32>(den + aint * qn);
    const float inv = 1.0f / fmaxf(fabsf(den), expf(-mt));
#pragma unroll
    for (int vt = 0; vt < 2; ++vt)
#pragma unroll
      for (int i = 0; i < 16; ++i) num[vt][i] = (num[vt][i] + aint * accI[vt][i]) * inv;
    if (d == 1) {
#pragma unroll
      for (int vt = 0; vt < 2; ++vt)
#pragma unroll
        for (int i = 0; i < 16; ++i) sX[(lt * 32 + vt * 16 + i) * 64 + lane] = num[vt][i];
    }
    __syncthreads();
    if (d == 0) {
      float ss = 0.f;
#pragma unroll
      for (int vt = 0; vt < 2; ++vt)
#pragma unroll
        for (int i = 0; i < 16; ++i) { num[vt][i] += sX[(lt * 32 + vt * 16 + i) * 64 + lane]; ss += num[vt][i] * num[vt][i]; }
      ss = xor_sum<32>(ss);
      const float rstd = 1.0f / sqrtf(ss * (1.0f / 64) + 1e-6f);
      const int r = row_of(b, 64 * c + l);
#pragma unroll
      for (int vt = 0; vt < 2; ++vt)
#pragma unroll
        for (int g = 0; g < 4; ++g) {
          const int v0 = vt * 32 + 8 * g + 4 * hh;
          const u32x2 ou = *(const u32x2*)(p.Z + (size_t)r * NZP + ZC_MLO + h * 64 + v0);
          const f32x4 gv = *(const f32x4*)(p.g_mlstm_out + layer * 256 + h * 64 + v0);
          const float o0 = u2f(ou.x << 16), o1 = u2f(ou.x & 0xffff0000u), o2 = u2f(ou.y << 16), o3 = u2f(ou.y & 0xffff0000u);
          f32x4 y = {sigmoidf_(o0) * num[vt][4 * g] * rstd * gv[0], sigmoidf_(o1) * num[vt][4 * g + 1] * rstd * gv[1],
                     sigmoidf_(o2) * num[vt][4 * g + 2] * rstd * gv[2], sigmoidf_(o3) * num[vt][4 * g + 3] * rstd * gv[3]};
          st_bf16x4(p.Y + (size_t)r * D + 256 + h * 64 + v0, y);
        }
    }
    __syncthreads();
  }
}
DI void ph_gla_local(const Params& p, char* lds, int bid, int nblk) {
  bf16_t* sKd = (bf16_t*)lds;
  const int t = TIDX, lane = t & 63, wid = t >> 6, l31 = lane & 31, hh = lane >> 5;
  const int d = wid & 1, vt = wid >> 1;
#pragma unroll 1
  for (int u = bid; u < SCAN_UNITS; u += nblk) {
    int b, c, h; scan_unit(u, b, c, h);
    {
      const int dd = t >> 7, l = (t >> 1) & 63, k0 = (t & 1) * 16, j = step_of(dd, c), pos = dd ? 63 - l : l;
      const float* gcr = p.GC + (((size_t)b * 2 + dd) * TK + 64 * j + pos) * 128 + h * 32 + k0;
      const float* ger = p.GC + (((size_t)b * 2 + dd) * TK + 64 * j + 63) * 128 + h * 32 + k0;
      const bf16_t* kr = p.Z + (size_t)row_of(b, 64 * c + l) * NZP + ZC_GK + h * 32 + k0;
#pragma unroll
      for (int q = 0; q < 16; ++q) sKd[(dd * 64 + l) * 33 + k0 + q] = f2bf(bf2f(kr[q]) * fast_exp2((ger[q] - gcr[q]) * LOG2E));
    }
    __syncthreads();
    const int j = step_of(d, c);
    const size_t uu = (((size_t)b * 2 + d) * NCK + j) * 4 + h;
    f32x16 acc = (f32x16)(0.f);
    const bf16_t* vsrc = p.GVt + (((size_t)b * 4 + h) * 64 + vt * 32 + l31) * TK + 64 * c;
#pragma unroll
    for (int ks = 0; ks < 4; ++ks) {
      const bf16x8 af = *(const bf16x8*)(vsrc + ks * 16 + 8 * hh);
      bf16x8 bfr;
#pragma unroll
      for (int q = 0; q < 8; ++q) bfr[q] = (short)sKd[(d * 64 + ks * 16 + 8 * hh + q) * 33 + l31];
      acc = MFMA32(af, bfr, acc);
    }
#pragma unroll
    for (int i = 0; i < 16; ++i) p.GS[uu * 2048 + (size_t)(vt * 32 + (i & 3) + 8 * (i >> 2) + 4 * hh) * 32 + l31] = acc[i];
    __syncthreads();
  }
}
constexpr int GO_Q = 0, GO_K = 2 * 64 * 80, GO_V = 2 * GO_K, GO_X = GO_V + 64 * VROW, GO_LDS = GO_X + 16384;
DI void ph_gla_out(const Params& p, int layer, int need_ctx, char* lds, int bid, int nblk) {
  float* sX = (float*)(lds + GO_X);
  const int t = TIDX, lane = t & 63, wid = t >> 6, l31 = lane & 31, hh = lane >> 5;
  const int lt = wid & 1, d = wid >> 1;
#pragma unroll 1
  for (int u = bid; u < (need_ctx ? SCAN_UNITS : SCAN_LAT_UNITS); u += nblk) {
    int b, c, h; scan_unit(u, b, c, h);
    {
      const int dd = t >> 7, l = (t >> 1) & 63, k0 = (t & 1) * 16, j = step_of(dd, c), pos = dd ? 63 - l : l;
      const float* gcr = p.GC + (((size_t)b * 2 + dd) * TK + 64 * j + pos) * 128 + h * 32 + k0;
      const bf16_t* zr = p.Z + (size_t)row_of(b, 64 * c + l) * NZP;
      bf16_t* qd = (bf16_t*)(lds + GO_Q + (dd * 64 + l) * 80) + k0; bf16_t* kd = (bf16_t*)(lds + GO_K + (dd * 64 + l) * 80) + k0;
#pragma unroll
      for (int q = 0; q < 16; ++q) {
        const float g = gcr[q];
        qd[q] = f2bf(bf2f(zr[ZC_GQ + h * 32 + k0 + q]) * 0.17677669529663687f * fast_exp2(g * LOG2E));
        kd[q] = f2bf(bf2f(zr[ZC_GK + h * 32 + k0 + q]) * fast_exp2(-g * LOG2E));
      }
      const int row = t >> 2, seg = (t & 3) * 16;
      const bf16_t* vs = p.GVt + (((size_t)b * 4 + h) * 64 + row) * TK + 64 * c + seg;
      const u32x4 v0 = ldg16(vs), v1 = ldg16(vs + 8);
      u32x2* dv = (u32x2*)(lds + GO_V + row * VROW + seg * 2);
      u32x2 q2; q2.x = v0.x; q2.y = v0.y; dv[0] = q2; q2.x = v0.z; q2.y = v0.w; dv[1] = q2; q2.x = v1.x; q2.y = v1.y; dv[2] = q2; q2.x = v1.z; q2.y = v1.w; dv[3] = q2;
    }
    __syncthreads();
    const int j = step_of(d, c);
    const size_t uu = (((size_t)b * 2 + d) * NCK + j) * 4 + h;
    const int l = lt * 32 + l31;
    bf16x8 qf[2];
#pragma unroll
    for (int ks = 0; ks < 2; ++ks) qf[ks] = lds_frag(lds + GO_Q + (d * 64 + l) * 80 + (ks * 16 + 8 * hh) * 2);
    f32x16 O[2]; O[0] = (f32x16)(0.f); O[1] = (f32x16)(0.f);
#pragma unroll
    for (int st = 0; st < 2; ++st) {
      if (d == 0 ? st <= lt : st >= lt) {
        f32x16 S = (f32x16)(0.f);
#pragma unroll
        for (int ks = 0; ks < 2; ++ks) S = MFMA32(lds_frag(lds + GO_K + (d * 64 + st * 32 + l31) * 80 + (ks * 16 + 8 * hh) * 2), qf[ks], S);
#pragma unroll
        for (int i = 0; i < 16; ++i) {
          const int s = st * 32 + (i & 3) + 8 * (i >> 2) + 4 * hh;
          const bool ok = d == 0 ? s <= l : s >= l;
          S[i] = ok ? S[i] : 0.f;
        }
#pragma unroll
        for (int kst = 0; kst < 2; ++kst) {
          const bf16x8 pf = pack8(S, kst);
#pragma unroll
          for (int vt = 0; vt < 2; ++vt) {
            const char* vp = lds + GO_V + (vt * 32 + l31) * VROW + (st * 32 + kst * 16 + 4 * hh) * 2;
            const s16x4 lo = *(const s16x4*)vp, hi = *(const s16x4*)(vp + 16);
            O[vt] = MFMA32(__builtin_shufflevector(lo, hi, 0, 1, 2, 3, 4, 5, 6, 7), pf, O[vt]);
          }
        }
      }
    }
#pragma unroll
    for (int vt = 0; vt < 2; ++vt)
#pragma unroll
      for (int ks = 0; ks < 2; ++ks) O[vt] = MFMA32(cvt8(p.GS + uu * 2048 + (size_t)(vt * 32 + l31) * 32 + ks * 16 + 8 * hh), qf[ks], O[vt]);
    if (d == 1) {
#pragma unroll
      for (int vt = 0; vt < 2; ++vt)
#pragma unroll
        for (int i = 0; i < 16; ++i) sX[(lt * 32 + vt * 16 + i) * 64 + lane] = O[vt][i];
    }
    __syncthreads();
    if (d == 0) {
      float ss = 0.f;
#pragma unroll
      for (int vt = 0; vt < 2; ++vt)
#pragma unroll
        for (int i = 0; i < 16; ++i) { O[vt][i] += sX[(lt * 32 + vt * 16 + i) * 64 + lane]; ss += O[vt][i] * O[vt][i]; }
      ss = xor_sum<32>(ss);
      const float rstd = 1.0f / sqrtf(ss * (1.0f / 64) + 1e-6f);
      const int r = row_of(b, 64 * c + l);
#pragma unroll
      for (int vt = 0; vt < 2; ++vt)
#pragma unroll
        for (int g = 0; g < 4; ++g) {
          const int v0 = vt * 32 + 8 * g + 4 * hh;
          const u32x2 ru = *(const u32x2*)(p.Z + (size_t)r * NZP + ZC_GR + h * 64 + v0);
          const f32x4 gv = *(const f32x4*)(p.g_gla_out + layer * 256 + h * 64 + v0);
          const float r0 = u2f(ru.x << 16), r1 = u2f(ru.x & 0xffff0000u), r2 = u2f(ru.y << 16), r3 = u2f(ru.y & 0xffff0000u);
          f32x4 y = {siluf_(r0) * O[vt][4 * g] * rstd * gv[0], siluf_(r1) * O[vt][4 * g + 1] * rstd * gv[1],
                     siluf_(r2) * O[vt][4 * g + 2] * rstd * gv[2], siluf_(r3) * O[vt][4 * g + 3] * rstd * gv[3]};
          st_bf16x4(p.Y + (size_t)r * D + 512 + h * 64 + v0, y);
        }
    }
    __syncthreads();
  }
}

DI float fast_logsigmoid(float x) {
  const float e = fast_exp2(-fabsf(x) * LOG2E);
#ifdef CPU_EMU
  return fminf(x, 0.f) - log1pf(e);
#else
  return fminf(x, 0.f) - 0.6931471805599453f * __builtin_amdgcn_logf(1.0f + e);
#endif
}
DI float wave_incl_scan(float v, int lane) {
#pragma unroll
  for (int dd = 1; dd < 64; dd <<= 1) { const float o = u2f((unsigned)lane_up((int)f2u(v), dd, lane)); if (lane >= dd) v += o; }
  return v;
}
constexpr int GCUM_LDS = 4 * 64 * 33 * 4;
DI void ph_gates_cum(const Params& p, int layer, char* lds, int bid, int nblk) {
  const int t = TIDX, lane = t & 63, wid = t >> 6;
  float* stg = (float*)lds + wid * 64 * 33;
  const float* wal = p.w_alpha2 + (size_t)layer * 2 * 16 * 128;
#pragma unroll 1
  for (int u = bid * 4 + wid; u < NB * 2 * NCK; u += nblk * 4) {
    const int j = u % NCK, d = (u / NCK) & 1, b = u / (2 * NCK);
    const int pp = 64 * j + lane, s = seq_of(d, pp);
    const bf16_t* z = p.Z + (size_t)row_of(b, s) * NZP;
    const size_t ob = ((size_t)b * 2 + d) * TK + pp;
    {
      const u32x2 iu = *(const u32x2*)(z + ZC_MLIG + d * 4), fu = *(const u32x2*)(z + ZC_MLFG + d * 4);
      const float ig[4] = {u2f(iu.x << 16), u2f(iu.x & 0xffff0000u), u2f(iu.y << 16), u2f(iu.y & 0xffff0000u)};
      const float fg[4] = {u2f(fu.x << 16), u2f(fu.x & 0xffff0000u), u2f(fu.y << 16), u2f(fu.y & 0xffff0000u)};
      f32x4 oc, oi;
#pragma unroll
      for (int h = 0; h < 4; ++h) {
        oi[h] = ig[h] + p.b_igate[layer * 8 + d * 4 + h];
        oc[h] = wave_incl_scan(fast_logsigmoid(fg[h] + p.b_fgate[layer * 8 + d * 4 + h]), lane);
      }
      *(f32x4*)(p.BC + ob * 4) = oc; *(f32x4*)(p.IGS + ob * 4) = oi;
    }
    float a[16];
    { float f0[8], f1[8]; unpack8(ldg16(z + ZC_GA + d * 16), f0); unpack8(ldg16(z + ZC_GA + d * 16 + 8), f1);
#pragma unroll
      for (int q = 0; q < 8; ++q) { a[q] = f0[q]; a[8 + q] = f1[q]; } }
    const float* W = wal + (size_t)d * 16 * 128;
#pragma unroll 1
    for (int cg = 0; cg < 4; ++cg) {
#pragma unroll 4
      for (int c = 0; c < 32; ++c) {
        const int ch = cg * 32 + c;
        float zg = p.b_alpha[layer * 256 + d * 128 + ch];
#pragma unroll
        for (int q = 0; q < 16; ++q) zg += a[q] * W[q * 128 + ch];
        stg[lane * 33 + c] = wave_incl_scan(fast_logsigmoid(zg) * (1.0f / 16.0f), lane);
      }
      WAVE_SYNC();
#pragma unroll
      for (int k = 0; k < 32; ++k) { const int pos = k * 2 + (lane >> 5), c = lane & 31; p.GC[(((size_t)b * 2 + d) * TK + 64 * j + pos) * 128 + cg * 32 + c] = stg[pos * 33 + c]; }
      WAVE_SYNC();
    }
  }
}
#define XB_TMO      128
#define XB_XCNT(j)  (256  + 64 * (j))
#define XB_XSUB(j)  (1280 + 64 * (j))
#define XB_XGEN(j)  (2304 + 64 * (j))
#define XB_TOP      3328
#define XB_TOPGEN   3392
#define XCD_BAR_WORDS 3456
#define XB_SPIN_CAP (1u << 28)
#define LAS __attribute__((address_space(3)))

__device__ __forceinline__ unsigned xb_ld(unsigned* p)              { return __hip_atomic_load(p, __ATOMIC_RELAXED, __HIP_MEMORY_SCOPE_AGENT); }
__device__ __forceinline__ unsigned xb_add(unsigned* p, unsigned v) { return __hip_atomic_fetch_add(p, v, __ATOMIC_RELAXED, __HIP_MEMORY_SCOPE_AGENT); }
__device__ __forceinline__ unsigned xb_xcc_id() { return (unsigned)__builtin_amdgcn_s_getreg((3 << 11) | 20) & 0xFu; }
#define XB_SPIN(cond, bar) do { unsigned _sp = 0; while (cond) { __builtin_amdgcn_s_sleep(1); \
    if ((++_sp & 255u) == 0u) { if (xb_ld(&(bar)[XB_TMO])) break; if (_sp > XB_SPIN_CAP) { atomicAdd(&(bar)[XB_TMO], 1u); break; } } } } while (0)

struct XcdBarrier {
    unsigned* bar; unsigned x;
    volatile LAS unsigned* st;
};

__device__ __forceinline__ XcdBarrier xcd_barrier_post(unsigned* bar, volatile LAS unsigned* st) {
    XcdBarrier b; b.bar = bar; b.x = xb_xcc_id(); b.st = st;
    if (threadIdx.x == 0) (void)xb_add(&bar[XB_XCNT(b.x)], 1u);
    return b;
}
__device__ __forceinline__ void xcd_barrier_complete(unsigned* bar, unsigned x, unsigned& nloc, unsigned& nx) {
    const unsigned G = gridDim.x * gridDim.y * gridDim.z;
    unsigned sum, cnt, mine, sp = 0u;
    for (;;) {
        sum = 0u; cnt = 0u; mine = 0u;
#pragma unroll
        for (unsigned j = 0; j < 16; ++j) { const unsigned c = xb_ld(&bar[XB_XCNT(j)]); sum += c; cnt += (c > 0u) ? 1u : 0u; mine = (j == x) ? c : mine; }
        if (sum == G) break;
        __builtin_amdgcn_s_sleep(1);
        if ((++sp & 255u) == 0u) { if (xb_ld(&bar[XB_TMO])) break; if (sp > XB_SPIN_CAP) { atomicAdd(&bar[XB_TMO], 1u); break; } }
    }
    nloc = mine > 0u ? mine : 1u; nx = cnt > 0u ? cnt : 1u;
}

__device__ __forceinline__ void xcd_barrier(const XcdBarrier& b) {
    asm volatile("s_waitcnt vmcnt(0)" ::: "memory");
    __syncthreads();
    if (threadIdx.x == 0) {
        unsigned* bar = b.bar;
        __builtin_amdgcn_s_waitcnt(0);
        unsigned nloc = b.st[0], nx = b.st[1];
        if (nloc == 0u) { xcd_barrier_complete(bar, b.x, nloc, nx); b.st[0] = nloc; b.st[1] = nx; }
        const unsigned old = xb_add(&bar[XB_XSUB(b.x)], 1u);
        const unsigned gen = old / nloc;
        if (old + 1u == (gen + 1u) * nloc) {
            __builtin_amdgcn_fence(__ATOMIC_RELEASE, "agent");
            asm volatile("s_waitcnt vmcnt(0)" ::: "memory");
            const unsigned og = xb_add(&bar[XB_TOP], 1u);
            const unsigned tg = og / nx;
            if (og + 1u == (tg + 1u) * nx) xb_add(&bar[XB_TOPGEN], 1u);
            else XB_SPIN(xb_ld(&bar[XB_TOPGEN]) == tg, bar);
            __builtin_amdgcn_fence(__ATOMIC_ACQUIRE, "agent");
            xb_add(&bar[XB_XGEN(b.x)], 1u);
            asm volatile("s_waitcnt vmcnt(0)" ::: "memory");
        } else {
            XB_SPIN(xb_ld(&bar[XB_XGEN(b.x)]) == gen, bar);
            __builtin_amdgcn_fence(__ATOMIC_ACQUIRE, "agent");
            asm volatile("s_waitcnt vmcnt(0)" ::: "memory");
        }
    }
    __syncthreads();
}

#define GS_LOOP(N, CALL) for (long gi = (long)bid * NTHR + TIDX; gi < (long)(N); gi += (long)nblk * NTHR) { CALL; }
#ifndef PROBE
#define PROBE 0
#endif
#ifndef PROBE_MASK
#define PROBE_MASK 0
#endif
#ifndef FAST_SCAN
#define FAST_SCAN 1
#endif
constexpr int N_PHASES = 16;
constexpr int MEGA_LDS = GEMM_LDS > TOPK_LDS ? GEMM_LDS : TOPK_LDS;

constexpr bool WT_ED_IN_Y = (size_t)NE * FF * D * 2 <= (size_t)R * D * 2;
DI void conv_expert(const Params& p, int which, int layer, char* lds, int bid, int nblk, int busy) {
  __syncthreads();
  if (bid < busy) return;
  if (which == 0) ph_wt(p.w_e_gate + (size_t)layer * NE * D * FF, p.Wt_eg, D, FF, FF, NE, (long)D * FF, (long)FF * D, nullptr, lds, bid - busy, nblk - busy);
  else if (which == 1) ph_wt(p.w_e_up + (size_t)layer * NE * D * FF, p.Wt_eu, D, FF, FF, NE, (long)D * FF, (long)FF * D, nullptr, lds, bid - busy, nblk - busy);
  else ph_wt(p.w_e_down + (size_t)layer * NE * FF * D, p.Wt_ed, FF, D, D, NE, (long)FF * D, (long)D * FF, nullptr, lds, bid - busy, nblk - busy);
}
template <int PH>
DI void run_phase(const Params& p, int l, char* lds, int bid, int nblk) {
  const int need_ctx = (l == 0);
  const int rows = need_ctx ? R : RL;
  const float* xl_in = l == 0 ? p.x : p.out;
  const float* xc_in = l == 0 ? p.ctx : p.xc;
  bf16_t* QRAW = p.YO; bf16_t* KVRAW = p.YO + (size_t)R * 384;
  if constexpr (PH == 0) {
    ph_mods(p, lds, bid, nblk);
#pragma unroll 1
    for (int ll = 0; ll < 2; ++ll) {
      ph_wt(p.w_in + (size_t)ll * D * NZ, p.Wt_in + ll * WSZ_IN, D, NZ, NZP, 1, 0L, 0L, nullptr, lds, bid, nblk);
      ph_wt(p.w_gate + (size_t)ll * D * 4096, p.Wt_gate + ll * WSZ_GATE, D, 4096, 4096, 1, 0L, 0L, nullptr, lds, bid, nblk);
      ph_wt(p.w_branch + (size_t)ll * 4 * 256 * D, p.Wt_branch + ll * WSZ_BR, 256, D, D, 4, (long)256 * D, (long)D * 256, nullptr, lds, bid, nblk);
      ph_wt(p.w_out + (size_t)ll * D * D, p.Wt_out + ll * WSZ_OUT, D, D, D, 1, 0L, 0L, nullptr, lds, bid, nblk);
      ph_wt(p.w_uq + (size_t)ll * 256 * 384, p.Wt_uq + ll * WSZ_UQ, 256, 384, 384, 1, 0L, 0L, p.g_q_lat + ll * 256, lds, bid, nblk);
      ph_wt(p.w_ukv + (size_t)ll * 128 * 512, p.Wt_ukv + ll * WSZ_UKV, 128, 512, 512, 1, 0L, 0L, p.g_kv_lat + ll * 128, lds, bid, nblk);
    }
  } else if constexpr (PH == 1) {
    ph_modulate(p, l, xl_in, xc_in, bid, nblk);
  } else if constexpr (PH == 2) {
    ph_gemm_plain(p.H, D, p.Wt_in + l * WSZ_IN, D, R, NZP, D, p.Z, NZP, lds, bid, nblk);
#if PROBE == 63
    ph_gemm_probe<3>(p.H, D, p.Wt_in + l * WSZ_IN, D, R, NZP, D, p.mods + 40000, lds, bid, nblk);
#elif PROBE == 66
    ph_gemm_probe<6>(p.H, D, p.Wt_in + l * WSZ_IN, D, R, NZP, D, p.mods + 40000, lds, bid, nblk);
#elif PROBE == 67
    ph_gemm_plain<1>(p.H, D, p.Wt_in + l * WSZ_IN, D, R, NZP, D, p.Z, NZP, lds, bid, nblk);
#elif PROBE == 68
    ph_gemm_plain<2>(p.H, D, p.Wt_in + l * WSZ_IN, D, R, NZP, D, p.Z, NZP, lds, bid, nblk);
#elif PROBE == 5
    ph_gemm_plain(p.H, D, p.Wt_in + l * WSZ_IN, D, R, NZP, D, p.Z, NZP, lds, bid, nblk);
#endif
  } else if constexpr (PH == 3) {
    ph_mla_up(p, l, QRAW, KVRAW, lds, bid, nblk);
  } else if constexpr (PH == 4) {
    ph_prep(p, l, QRAW, KVRAW, lds, bid, nblk);
#if PROBE == 41
    ph_prep(p, l, QRAW, KVRAW, lds, bid, nblk);
#elif PROBE == 43
    ph_prep<1>(p, l, QRAW, KVRAW, lds, bid, nblk);
#elif PROBE == 44
    ph_prep<2>(p, l, QRAW, KVRAW, lds, bid, nblk);
#endif
    __syncthreads();
    ph_gates_cum(p, l, lds, bid, nblk);
#if PROBE == 42
    ph_gates_cum(p, l, lds, bid, nblk);
#endif
  } else if constexpr (PH == 5) {
#if FAST_SCAN
    ph_ml_local(p, lds, bid, nblk);
    ph_gla_local(p, lds, bid, nblk);
#else
    GS_LOOP((long)NUNIT * 4160, nvb_ml_local(gi, p));
    GS_LOOP((long)NUNIT * 2048, nvb_gla_local(gi, p));
#endif
  } else if constexpr (PH == 6) {
#if FAST_SCAN
    ph_ml_scan(p, bid, nblk);
    ph_gla_scan(p, (bid + nblk - 260 % nblk) % nblk, nblk);
#else
    GS_LOOP((long)NB * 2 * 4 * 4160, nvb_ml_scan(gi, p));
    GS_LOOP((long)NB * 2 * 4 * 2048, nvb_gla_scan(gi, p));
#endif
    ph_attn(p, l, need_ctx, lds, bid, nblk);
#if PROBE >= 10 && PROBE < 20
    if (l == 0) ph_attn_mla_probe<PROBE - 10>(p, lds, bid, nblk);
#elif PROBE == 1
    ph_attn_diff(p, l, need_ctx, lds, bid, nblk);
#elif PROBE == 2
    ph_attn_mla(p, need_ctx, lds, bid, nblk);
#endif
  } else if constexpr (PH == 7) {
#if FAST_SCAN
    ph_ml_out(p, l, need_ctx, lds, bid, nblk);
    ph_gla_out(p, l, need_ctx, lds, bid, nblk);
#else
    GS_LOOP((long)NUNIT * 4096, nvb_ml_out(gi, p, need_ctx));
    GS_LOOP((long)NUNIT * 4096, nvb_gla_out(gi, p, need_ctx));
#endif
  } else if constexpr (PH == 8) {
#if !FAST_SCAN
    GS_LOOP((long)R * 4, nvb_ml_finish(gi, p, l, need_ctx));
    GS_LOOP((long)R * 4, nvb_gla_finish(gi, p, l, need_ctx));
#endif
  } else if constexpr (PH == 9) {
    ph_merge(p, l, rows, lds, bid, nblk);
#if PROBE == 3
    ph_merge(p, l, rows, lds, bid, nblk);
#endif
    if (l == 0) conv_expert(p, 1, 0, lds, bid, nblk, ((rows / 128) * (D / 64)) % nblk);
  } else if constexpr (PH == 10) {
    ph_gemm_plain(p.MG, D, p.Wt_out + l * WSZ_OUT, D, rows, D, D, p.YO, D, lds, bid, nblk);
    if (WT_ED_IN_Y && l == 0) conv_expert(p, 2, 0, lds, bid, nblk, ((rows / 128) * (D / 128)) % nblk);
  } else if constexpr (PH == 11) {
    ph_resid_mix(p, l, xl_in, xc_in, rows, lds, bid, nblk);
  } else if constexpr (PH == 12) {
    ph_topk(p, need_ctx, lds, bid, nblk);
    const int tkb = NB * NE * 2 < nblk ? NB * NE * 2 : 0;
    conv_expert(p, 0, l, lds, bid, nblk, tkb);
    if (l == 1) conv_expert(p, 1, 1, lds, bid, nblk, tkb);
    if (l == 1 || !WT_ED_IN_Y) conv_expert(p, 2, l, lds, bid, nblk, tkb);
  } else if constexpr (PH == 13) {
    ph_moe1(p, need_ctx, lds, bid, nblk);
#if PROBE == 4
    ph_moe1(p, need_ctx, lds, bid, nblk);
#endif
  } else if constexpr (PH == 14) {
    ph_moe2(p, need_ctx, lds, bid, nblk);
#if PROBE == 4
    ph_moe2(p, need_ctx, lds, bid, nblk);
#endif
  } else if constexpr (PH == 15) {
    ph_resid_ffn(p, l, rows, bid, nblk);
  }
}

template <int PH> __global__ void __launch_bounds__(256, 2) k_phase(Params p, int l) {
  DYN_LDS(lds);
  run_phase<PH>(p, l, lds, blockIdx.x, gridDim.x);
}

#if !defined(CPU_EMU) && !MK_MULTI
typedef const Params __attribute__((address_space(4)))* KParams;
DI KParams kp_fresh() { KParams k = (KParams)__builtin_amdgcn_kernarg_segment_ptr(); asm volatile("" : "+s"(k)); return k; }
#define PHASE(PH, L) do { asm volatile("; PHASE_MARK " #PH); KParams k_ = kp_fresh(); run_phase<PH>(*(const Params*)k_, (L), lds, bid, nblk); if (PROBE == 20 + PH || ((PROBE_MASK >> PH) & 1) || (PROBE == 100 + PH && (L) == 0) || (PROBE == 99 && (PH == 4 || PH == 5))) { __syncthreads(); run_phase<PH>(*(const Params*)k_, (L), lds, bid, nblk); } XcdBarrier b_ = bar; asm volatile("" : "+s"(b_.bar), "+s"(b_.x)); xcd_barrier(b_); if (PROBE == 50) xcd_barrier(b_); } while (0)
__global__ void __launch_bounds__(256, 2) k_mega(Params pv) {
  DYN_LDS(lds_all);
  if (threadIdx.x == 0) *(uint4*)lds_all = make_uint4(0u, 0u, 0u, 0u);
  __syncthreads();
  XcdBarrier bar = xcd_barrier_post(pv.bar, (volatile LAS unsigned*)lds_all);
  char* lds = lds_all + 256;
  const int bid = blockIdx.x, nblk = gridDim.x;
  PHASE(0, 0);
#pragma unroll 1
  for (int l = 0; l < 2; ++l) {
    if (l == 0) PHASE(1, l);
    PHASE(2, l); PHASE(3, l); PHASE(4, l); PHASE(5, l); PHASE(6, l); PHASE(7, l);
#if !FAST_SCAN
    PHASE(8, l);
#endif

    PHASE(9, l); PHASE(10, l); PHASE(11, l); PHASE(12, l); PHASE(13, l); PHASE(14, l); PHASE(15, l);
  }
}
#endif
#ifdef CPU_EMU
void emu_check(const Params& p, int layer, int stage);
#define EMU_CHECK(stg) emu_check(p, l, stg)
static int g_nlayers = getenv("NLAYERS") ? atoi(getenv("NLAYERS")) : 2;
#else
#define EMU_CHECK(stg)
#endif
static void fill_params(Params& p, void* const* d_in, void* d_out, void* d_ws) {
  const float** f = (const float**)&p;
  for (int i = 0; i < 33; ++i) f[i] = (const float*)d_in[i];
  p.out = (float*)d_out;
  map_workspace(p, (char*)d_ws);
}
#define LAUNCH_PHASE(PH, L) LAUNCH((k_phase<PH>), grid, 256, MEGA_LDS, stream, p, L)

extern "C" void kernel_launch(void* const* d_in, const int* in_sizes, int n_in, void* d_out, int out_size, void* d_ws,
                              size_t ws_size, hipStream_t stream) {
  Params p{};
  fill_params(p, d_in, d_out, d_ws);
  if (p.ws_need > ws_size) return;
#ifdef CPU_EMU
  const int grid = 16;
  LAUNCH_PHASE(0, 0);
  for (int l = 0; l < g_nlayers; ++l) {
    if (l == 0) LAUNCH_PHASE(1, l);
    LAUNCH_PHASE(2, l); LAUNCH_PHASE(3, l); LAUNCH_PHASE(4, l); LAUNCH_PHASE(5, l); LAUNCH_PHASE(6, l); LAUNCH_PHASE(7, l); LAUNCH_PHASE(8, l);
    EMU_CHECK(1);
    LAUNCH_PHASE(9, l); LAUNCH_PHASE(10, l); LAUNCH_PHASE(11, l);
    EMU_CHECK(2);
    LAUNCH_PHASE(12, l); LAUNCH_PHASE(13, l); LAUNCH_PHASE(14, l); LAUNCH_PHASE(15, l);
    EMU_CHECK(3);
  }
#else
  static int grid = 0;
  if (grid == 0) {
    int dev = 0, cus = 0, per_cu = 0;
    (void)hipGetDevice(&dev);
    (void)hipDeviceGetAttribute(&cus, hipDeviceAttributeMultiprocessorCount, dev);
#if MK_MULTI
    (void)hipFuncSetAttribute((const void*)k_phase<0>, hipFuncAttributeMaxDynamicSharedMemorySize, MEGA_LDS);
    (void)hipFuncSetAttribute((const void*)k_phase<1>, hipFuncAttributeMaxDynamicSharedMemorySize, MEGA_LDS);
    (void)hipFuncSetAttribute((const void*)k_phase<2>, hipFuncAttributeMaxDynamicSharedMemorySize, MEGA_LDS);
    (void)hipFuncSetAttribute((const void*)k_phase<3>, hipFuncAttributeMaxDynamicSharedMemorySize, MEGA_LDS);
    (void)hipFuncSetAttribute((const void*)k_phase<4>, hipFuncAttributeMaxDynamicSharedMemorySize, MEGA_LDS);
    (void)hipFuncSetAttribute((const void*)k_phase<5>, hipFuncAttributeMaxDynamicSharedMemorySize, MEGA_LDS);
    (void)hipFuncSetAttribute((const void*)k_phase<6>, hipFuncAttributeMaxDynamicSharedMemorySize, MEGA_LDS);
    (void)hipFuncSetAttribute((const void*)k_phase<7>, hipFuncAttributeMaxDynamicSharedMemorySize, MEGA_LDS);
    (void)hipFuncSetAttribute((const void*)k_phase<8>, hipFuncAttributeMaxDynamicSharedMemorySize, MEGA_LDS);
    (void)hipFuncSetAttribute((const void*)k_phase<9>, hipFuncAttributeMaxDynamicSharedMemorySize, MEGA_LDS);
    (void)hipFuncSetAttribute((const void*)k_phase<10>, hipFuncAttributeMaxDynamicSharedMemorySize, MEGA_LDS);
    (void)hipFuncSetAttribute((const void*)k_phase<11>, hipFuncAttributeMaxDynamicSharedMemorySize, MEGA_LDS);
    (void)hipFuncSetAttribute((const void*)k_phase<12>, hipFuncAttributeMaxDynamicSharedMemorySize, MEGA_LDS);
    (void)hipFuncSetAttribute((const void*)k_phase<13>, hipFuncAttributeMaxDynamicSharedMemorySize, MEGA_LDS);
    (void)hipFuncSetAttribute((const void*)k_phase<14>, hipFuncAttributeMaxDynamicSharedMemorySize, MEGA_LDS);
    (void)hipFuncSetAttribute((const void*)k_phase<15>, hipFuncAttributeMaxDynamicSharedMemorySize, MEGA_LDS);
    grid = (cus > 0 ? cus : 256) * 2;
#else
    if (hipFuncSetAttribute((const void*)k_mega, hipFuncAttributeMaxDynamicSharedMemorySize, MEGA_LDS + 256) != hipSuccess) { grid = -1; return; }
    if (hipOccupancyMaxActiveBlocksPerMultiprocessor(&per_cu, (const void*)k_mega, 256, MEGA_LDS + 256) != hipSuccess) per_cu = 0;
    (void)hipGetLastError();
    if (per_cu < 1) { grid = -1; return; }
    grid = (cus > 0 ? cus : 256) * (per_cu < 2 ? per_cu : 2);
#endif
  }
  if (grid < 0) return;
#if MK_MULTI
  LAUNCH_PHASE(0, 0);
  for (int l = 0; l < 2; ++l) {
    if (l == 0) LAUNCH_PHASE(1, l);
    LAUNCH_PHASE(2, l); LAUNCH_PHASE(3, l); LAUNCH_PHASE(4, l); LAUNCH_PHASE(5, l); LAUNCH_PHASE(6, l); LAUNCH_PHASE(7, l); LAUNCH_PHASE(8, l);
    LAUNCH_PHASE(9, l); LAUNCH_PHASE(10, l); LAUNCH_PHASE(11, l); LAUNCH_PHASE(12, l); LAUNCH_PHASE(13, l); LAUNCH_PHASE(14, l); LAUNCH_PHASE(15, l);
  }
#else
  (void)hipMemsetAsync(p.bar, 0, XCD_BAR_WORDS * sizeof(unsigned), stream);
  k_mega<<<dim3(grid), dim3(256), MEGA_LDS + 256, stream>>>(p);
#endif
#endif
}
```
